# Optimizing an MI355X kernel written in HIP

```python
import math, functools
import numpy as np
import jax
import jax.numpy as jnp
from jax import lax

D_MODEL = 1024
BATCH = 2
SEQ = 8192
DEPTH = 2
DEC_BATCH = 128
DEC_SEQ = 4
PAST_LEN = 2048
PAGE_SIZE = 128

MIX_WIDTH = D_MODEL // 2
N_BRANCH = 3
NSA_HEADS = 8
NSA_HD = MIX_WIDTH // NSA_HEADS
NSA_KV = 2
NSA_GRP = NSA_HEADS // NSA_KV
CMP_LEN = 32
CMP_STRIDE = 16
CMP_HIDDEN = 64
SEL_LEN = 64
SEL_TOPK = 16
WINDOW = 512
Q_BLOCK = 128
FORCE_BONUS = 1000.0
GDN_HEADS = 4
GDN_HD = MIX_WIDTH // GDN_HEADS
CONV_W = 4
GDN_CHUNK = 64
RET_HEADS = 4
RET_HD = MIX_WIDTH // RET_HEADS
RET_CHUNK = 128
ROPE_BASE = 10000.0
D_FF = 4 * D_MODEL
PLE_DIM = 256
EPS = 1e-6
NEG = -1e30
IN_SIZES = (NSA_HEADS * NSA_HD, 6 * NSA_KV * NSA_HD, 3 * NSA_HEADS,
            3 * MIX_WIDTH, GDN_HEADS, GDN_HEADS, MIX_WIDTH,
            3 * MIX_WIDTH, MIX_WIDTH, N_BRANCH * D_MODEL)
IN_COLS = sum(IN_SIZES)

kernel_name = 'nsa_gdn_retention_hybrid_step'


def rmsnorm(x, g):
    xf = x.astype(jnp.float32)
    y = xf * lax.rsqrt(jnp.mean(xf * xf, axis=-1, keepdims=True) + EPS)
    return (y * g.astype(jnp.float32)).astype(x.dtype)


def l2norm(x):
    return x * lax.rsqrt(jnp.sum(x * x, axis=-1, keepdims=True) + EPS)


def masked_softmax(s, mask):
    s = jnp.where(mask, s.astype(jnp.float32), NEG)
    return jax.nn.softmax(s, axis=-1) * jnp.any(mask, axis=-1, keepdims=True)


def to_chunks(x, c):
    b, t = x.shape[:2]
    x = x.reshape(b, t // c, c, *x.shape[2:])
    return jnp.swapaxes(jnp.moveaxis(x, 1, 0), 2, 3)


def from_chunks(x):
    x = jnp.moveaxis(jnp.swapaxes(x, 2, 3), 0, 1)
    return x.reshape(x.shape[0], -1, *x.shape[3:])


def rotary(x, pos):
    half = x.shape[-1] // 2
    inv = ROPE_BASE ** (-jnp.linspace(0.0, 1.0, half, dtype=jnp.float32))
    ang = pos.astype(jnp.float32)[:, None] * inv[None, :]
    cos = jnp.cos(ang)[None, :, None, :]
    sin = jnp.sin(ang)[None, :, None, :]
    xf = x.astype(jnp.float32)
    x1, x2 = xf[..., :half], xf[..., half:]
    return jnp.concatenate([x1 * cos - x2 * sin, x2 * cos + x1 * sin], axis=-1)


def compress(k, pe, w1, w2):
    b, t = k.shape[:2]
    nsub = t // CMP_STRIDE
    sub = k[:, :nsub * CMP_STRIDE].reshape(b, nsub, CMP_STRIDE, NSA_KV, NSA_HD)
    blocks = jnp.concatenate([sub[:, :-1], sub[:, 1:]], axis=2) + pe[:, None, :]
    flat = jnp.swapaxes(blocks, 2, 3).reshape(b, nsub - 1, NSA_KV, CMP_LEN * NSA_HD)
    return jax.nn.gelu(flat @ w1) @ w2


def nsa_core(q, q_pos, kc, vc, ks, vs, kw, vw, kw_pos, g):
    bsz, tq = q.shape[:2]
    scale = NSA_HD ** -0.5
    qg = q.reshape(bsz, tq, NSA_KV, NSA_GRP, NSA_HD)
    nc, ns = kc.shape[1], ks.shape[1]
    c_start = jnp.arange(nc) * CMP_STRIDE
    m_c = (c_start[None, :] + CMP_LEN - 1) <= q_pos[:, None]
    p_c = masked_softmax(jnp.einsum('btgjd,bngd->btgjn', qg, kc) * scale, m_c[None, :, None, None, :])
    o_c = jnp.einsum('btgjn,bngd->btgjd', p_c.astype(vc.dtype), vc)
    blk = jnp.arange(ns)
    overlap = ((c_start[:, None] < (blk[None, :] + 1) * SEL_LEN)
               & (blk[None, :] * SEL_LEN < c_start[:, None] + CMP_LEN)).astype(jnp.float32)
    imp = jnp.einsum('btgn,ns->btgs', jnp.sum(p_c, axis=3), overlap)
    valid = blk[None, :] * SEL_LEN <= q_pos[:, None]
    cur = q_pos[:, None] // SEL_LEN
    forced = (blk[None, :] == 0) | (blk[None, :] == cur) | (blk[None, :] == cur - 1)
    score = jnp.where(valid[None, :, None, :], imp + jnp.where(forced, FORCE_BONUS, 0.0)[None, :, None, :], NEG)
    _, idx = lax.top_k(score, min(SEL_TOPK, ns))
    sel_ok = jnp.take_along_axis(jnp.broadcast_to(valid[None, :, None, :], score.shape), idx, axis=-1)
    bi = jnp.arange(bsz)[:, None, None, None]
    gi = jnp.arange(NSA_KV)[None, None, :, None]
    kb = ks[bi, idx, :, gi, :]
    vb = vs[bi, idx, :, gi, :]
    kpos = idx[..., None] * SEL_LEN + jnp.arange(SEL_LEN)
    m_s = sel_ok[..., None] & (kpos <= q_pos[None, :, None, None, None])
    s_s = jnp.einsum('btgjd,btgkld->btgjkl', qg, kb) * scale
    p_s = masked_softmax(s_s.reshape(bsz, tq, NSA_KV, NSA_GRP, -1), m_s.reshape(bsz, tq, NSA_KV, 1, -1))
    o_s = jnp.einsum('btgjkl,btgkld->btgjd', p_s.reshape(s_s.shape).astype(vb.dtype), vb)
    m_w = ((kw_pos[None, :] <= q_pos[:, None]) & (kw_pos[None, :] > q_pos[:, None] - WINDOW)
           & (kw_pos[None, :] >= 0))
    p_w = masked_softmax(jnp.einsum('btgjd,bwgd->btgjw', qg, kw) * scale, m_w[None, :, None, None, :])
    o_w = jnp.einsum('btgjw,bwgd->btgjd', p_w.astype(vw.dtype), vw)
    gg = g.reshape(bsz, tq, NSA_KV, NSA_GRP, 3)
    o = gg[..., 0:1] * o_c + gg[..., 1:2] * o_s + gg[..., 2:3] * o_w
    return o.reshape(bsz, tq, NSA_HEADS * NSA_HD)


def nsa_prompt(q, kv, kvw, g, cmp_pe, cmp_w1, cmp_w2):
    bsz, t = q.shape[:2]
    kc = compress(kv[:, :, 0], cmp_pe[0], cmp_w1[0], cmp_w2[0])
    vc = compress(kv[:, :, 1], cmp_pe[1], cmp_w1[1], cmp_w2[1])
    ks = kv[:, :, 2].reshape(bsz, t // SEL_LEN, SEL_LEN, NSA_KV, NSA_HD)
    vs = kv[:, :, 3].reshape(bsz, t // SEL_LEN, SEL_LEN, NSA_KV, NSA_HD)
    win_pad = jnp.pad(kvw, ((0, 0), (WINDOW, 0), (0, 0), (0, 0), (0, 0)))
    span = WINDOW + Q_BLOCK

    def one_block(blk):
        s0 = blk * Q_BLOCK
        qb = lax.dynamic_slice_in_dim(q, s0, Q_BLOCK, axis=1)
        gb = lax.dynamic_slice_in_dim(g, s0, Q_BLOCK, axis=1)
        wb = lax.dynamic_slice_in_dim(win_pad, s0, span, axis=1)
        q_pos = s0 + jnp.arange(Q_BLOCK)
        kw_pos = s0 - WINDOW + jnp.arange(span)
        return nsa_core(qb, q_pos, kc, vc, ks, vs, wb[:, :, 0], wb[:, :, 1], kw_pos, gb)

    out = lax.map(one_block, jnp.arange(t // Q_BLOCK))
    out = jnp.moveaxis(out, 0, 1).reshape(bsz, t, NSA_HEADS * NSA_HD)
    return out, kv, kvw[:, t - min(WINDOW, t):]


def nsa_sample(q, kv, kvw, g, cache_kv, page_table, cache_win, cmp_pe, cmp_w1, cmp_w2):
    bsz, t = q.shape[:2]
    past = cache_kv[page_table].reshape(bsz, -1, 4, NSA_KV, NSA_HD).astype(kv.dtype)
    full = jnp.concatenate([past, kv], axis=1)
    tk = full.shape[1]
    kc = compress(full[:, :, 0], cmp_pe[0], cmp_w1[0], cmp_w2[0])
    vc = compress(full[:, :, 1], cmp_pe[1], cmp_w1[1], cmp_w2[1])
    ns = -(-tk // SEL_LEN)
    sel = jnp.pad(full[:, :, 2:4], ((0, 0), (0, ns * SEL_LEN - tk), (0, 0), (0, 0), (0, 0)))
    sel = sel.reshape(bsz, ns, SEL_LEN, 2, NSA_KV, NSA_HD)
    win = jnp.concatenate([cache_win.astype(kvw.dtype), kvw], axis=1)
    wk = cache_win.shape[1]
    kw_pos = PAST_LEN - wk + jnp.arange(wk + t)
    q_pos = PAST_LEN + jnp.arange(t)
    out = nsa_core(q, q_pos, kc, vc, sel[:, :, :, 0], sel[:, :, :, 1], win[:, :, 0], win[:, :, 1], kw_pos, g)
    return out, kv, win[:, win.shape[1] - min(WINDOW, tk):]


def causal_conv(x, prev, w):
    t = x.shape[1]
    xp = jnp.concatenate([prev.astype(x.dtype), x], axis=1)
    y = sum(xp[:, j:j + t] * w[j] for j in range(CONV_W))
    return y, xp[:, t:]


def gated_delta(q, k, v, beta, g, s0):
    c = GDN_CHUNK if q.shape[1] % GDN_CHUNK == 0 else q.shape[1]
    incl = jnp.tril(jnp.ones((c, c), bool))
    strict = jnp.tril(jnp.ones((c, c), bool), -1)
    eye = jnp.eye(c, dtype=jnp.float32)

    def step(s, inp):
        qc, kc, vc, bc, gc = inp
        gcum = jnp.cumsum(gc, axis=-1)
        diff = gcum[..., :, None] - gcum[..., None, :]
        decay = jnp.where(incl, jnp.exp(jnp.where(incl, diff, 0.0)), 0.0)
        a = jnp.where(strict, jnp.einsum('bhik,bhjk->bhij', kc, kc) * decay * bc[..., :, None], 0.0)
        rhs = jnp.concatenate([vc * bc[..., None], kc * (bc * jnp.exp(gcum))[..., None]], axis=-1)
        sol = lax.linalg.triangular_solve(eye + a, rhs, left_side=True, lower=True, unit_diagonal=True)
        u, w = sol[..., :GDN_HD], sol[..., GDN_HD:]
        v_new = u - jnp.einsum('bhik,bhkv->bhiv', w, s)
        qk = jnp.einsum('bhik,bhjk->bhij', qc, kc) * decay
        o = (jnp.einsum('bhik,bhkv->bhiv', qc * jnp.exp(gcum)[..., None], s)
             + jnp.einsum('bhij,bhjv->bhiv', qk, v_new))
        glast = gcum[..., -1:]
        s = s * jnp.exp(glast)[..., None] + jnp.einsum('bhjk,bhjv->bhkv', kc * jnp.exp(glast - gcum)[..., None], v_new)
        return s, o

    s, o = lax.scan(step, s0, tuple(to_chunks(a_, c) for a_ in (q, k, v, beta, g)))
    return from_chunks(o), s


def gdn_branch(qkv, a_in, b_in, z, conv_prev, s0, conv_w, a_log, dt_bias, norm_g):
    bsz, t, _ = qkv.shape
    y, conv_state = causal_conv(qkv, conv_prev, conv_w)
    y = jax.nn.silu(y).astype(jnp.float32)
    q, k, v = jnp.split(y, 3, axis=-1)
    shp = (bsz, t, GDN_HEADS, GDN_HD)
    q = l2norm(q.reshape(shp)) * (GDN_HD ** -0.5)
    k = l2norm(k.reshape(shp))
    v = v.reshape(shp)
    beta = jax.nn.sigmoid(b_in.astype(jnp.float32))
    g = -jnp.exp(a_log.astype(jnp.float32)) * jax.nn.softplus(a_in.astype(jnp.float32) + dt_bias.astype(jnp.float32))
    o, s = gated_delta(q, k, v, beta, g, s0.astype(jnp.float32))
    o = rmsnorm(o, norm_g) * jax.nn.silu(z.astype(jnp.float32).reshape(shp))
    return o.reshape(bsz, t, MIX_WIDTH).astype(qkv.dtype), conv_state, s


def retention(qkv, gate, pos, s0):
    bsz, t, _ = qkv.shape
    shp = (bsz, t, RET_HEADS, RET_HD)
    q, k, v = jnp.split(qkv, 3, axis=-1)
    q = rotary(q.reshape(shp), pos)
    k = rotary(k.reshape(shp), pos) * (RET_HD ** -0.5)
    v = v.reshape(shp).astype(jnp.float32)
    c = RET_CHUNK if t % RET_CHUNK == 0 else t
    lg = jnp.log1p(-jnp.exp2(-5.0 - jnp.arange(RET_HEADS, dtype=jnp.float32)))
    n = jnp.arange(c, dtype=jnp.float32)
    diff = n[:, None] - n[None, :]
    dmat = jnp.where(diff >= 0, jnp.exp(jnp.maximum(diff, 0.0)[None] * lg[:, None, None]), 0.0)
    q_dec = jnp.exp((n + 1.0)[None, :] * lg[:, None])[..., None]
    k_dec = jnp.exp((c - 1.0 - n)[None, :] * lg[:, None])[..., None]
    c_dec = jnp.exp(c * lg)[:, None, None]

    def step(s, inp):
        qc, kc, vc = inp
        o = (jnp.einsum('bhij,bhjv->bhiv', jnp.einsum('bhik,bhjk->bhij', qc, kc) * dmat, vc)
             + jnp.einsum('bhik,bhkv->bhiv', qc, s) * q_dec)
        s = s * c_dec + jnp.einsum('bhjk,bhjv->bhkv', kc * k_dec, vc)
        return s, o

    s, o = lax.scan(step, s0.astype(jnp.float32), (to_chunks(q, c), to_chunks(k, c), to_chunks(v, c)))
    o = from_chunks(o)
    o = o * lax.rsqrt(jnp.mean(o * o, axis=-1, keepdims=True) + EPS)
    o = o * jax.nn.silu(gate.astype(jnp.float32).reshape(shp))
    return o.reshape(bsz, t, MIX_WIDTH).astype(qkv.dtype), s


def trunk_layer(x, p_l, pos, nsa_fn, conv_prev, gdn_s0, ret_s0, W):
    bsz, t, _ = x.shape
    h = rmsnorm(x, W['g_mix'])
    z = h @ W['w_in']
    cuts = np.cumsum(IN_SIZES)[:-1].tolist()
    nq, nkv, ngate, gqkv, g_a, g_b, g_z, rqkv, rgate, mgate = jnp.split(z, cuts, axis=-1)
    q = nq.reshape(bsz, t, NSA_HEADS, NSA_HD)
    kv = nkv.reshape(bsz, t, 6, NSA_KV, NSA_HD)
    ng = jax.nn.sigmoid(ngate.reshape(bsz, t, NSA_HEADS, 3))
    o_nsa, nsa_rows, nsa_win = nsa_fn(q, kv[:, :, :4], kv[:, :, 4:], ng)
    o_gdn, conv_state, gdn_s = gdn_branch(gqkv, g_a, g_b, g_z, conv_prev, gdn_s0,
                                          W['conv_w'], W['a_log'], W['dt_bias'], W['norm_g'])
    o_ret, ret_s = retention(rqkv, rgate, pos, ret_s0)
    branches = jnp.einsum('btnc,ncd->btnd', jnp.stack([o_nsa, o_gdn, o_ret], axis=2), W['w_branch'])
    gates = jax.nn.sigmoid(mgate.reshape(bsz, t, N_BRANCH, D_MODEL))
    x = x + jnp.sum(gates * branches, axis=2) @ W['w_out']
    h = rmsnorm(x, W['g_mlp'])
    x = x + jnp.square(jax.nn.relu(h @ W['w_up'])) @ W['w_down']
    x = x + (p_l @ W['w_ple']) * jax.nn.sigmoid(x @ W['w_ple_gate'])
    return x, nsa_rows, nsa_win, conv_state, gdn_s, ret_s


def setup_inputs(seed: int = 0) -> dict:
    key = jax.random.key(seed)
    ks = jax.random.split(key, 32)
    f32 = jnp.float32

    def nrm(k, shape, scale):
        return jax.random.normal(k, shape, f32) * scale

    n_pages = PAST_LEN // PAGE_SIZE
    n_used = DEC_BATCH * n_pages
    n_phys = n_used + max(n_used // 4, 1)
    perm = jax.random.permutation(ks[0], n_phys).astype(jnp.int32)
    page_table = perm[:n_used].reshape(DEC_BATCH, n_pages)
    wk = min(WINDOW, PAST_LEN)
    dt = jnp.exp(jax.random.uniform(ks[1], (DEPTH, GDN_HEADS), f32, math.log(1e-3), math.log(1e-1)))
    return {
        'x_prompt': nrm(ks[2], (BATCH, SEQ, D_MODEL), 1.0),
        'x_sample': nrm(ks[3], (DEC_BATCH, DEC_SEQ, D_MODEL), 1.0),
        'cache_nsa_kv': nrm(ks[4], (DEPTH, n_phys, PAGE_SIZE, 4, NSA_KV, NSA_HD), 1.0),
        'cache_nsa_win': nrm(ks[5], (DEPTH, DEC_BATCH, wk, 2, NSA_KV, NSA_HD), 1.0),
        'state_gdn_conv': nrm(ks[6], (DEPTH, DEC_BATCH, CONV_W - 1, 3 * MIX_WIDTH), 1.0),
        'state_gdn': nrm(ks[7], (DEPTH, DEC_BATCH, GDN_HEADS, GDN_HD, GDN_HD), 0.1),
        'state_ret': nrm(ks[8], (DEPTH, DEC_BATCH, RET_HEADS, RET_HD, RET_HD), 0.3),
        'page_table': page_table,
        'p_prompt': nrm(ks[9], (DEPTH, BATCH, SEQ, PLE_DIM), 1.0),
        'p_sample': nrm(ks[10], (DEPTH, DEC_BATCH, DEC_SEQ, PLE_DIM), 1.0),
        'g_mix': 1.0 + nrm(ks[11], (DEPTH, D_MODEL), 0.1),
        'w_in': nrm(ks[12], (DEPTH, D_MODEL, IN_COLS), D_MODEL ** -0.5),
        'nsa_cmp_pe': nrm(ks[13], (DEPTH, 2, CMP_LEN, NSA_HD), 0.1),
        'nsa_cmp_w1': nrm(ks[14], (DEPTH, 2, CMP_LEN * NSA_HD, CMP_HIDDEN), (CMP_LEN * NSA_HD) ** -0.5),
        'nsa_cmp_w2': nrm(ks[15], (DEPTH, 2, CMP_HIDDEN, NSA_HD), CMP_HIDDEN ** -0.5),
        'gdn_conv_w': nrm(ks[16], (DEPTH, CONV_W, 3 * MIX_WIDTH), CONV_W ** -0.5),
        'gdn_a_log': jnp.log(jax.random.uniform(ks[17], (DEPTH, GDN_HEADS), f32, 1.0, 16.0)),
        'gdn_dt_bias': dt + jnp.log(-jnp.expm1(-dt)),
        'gdn_norm_g': 1.0 + nrm(ks[18], (DEPTH, GDN_HD), 0.1),
        'w_branch': nrm(ks[19], (DEPTH, N_BRANCH, MIX_WIDTH, D_MODEL), MIX_WIDTH ** -0.5),
        'w_out': nrm(ks[20], (DEPTH, D_MODEL, D_MODEL), D_MODEL ** -0.5),
        'g_mlp': 1.0 + nrm(ks[21], (DEPTH, D_MODEL), 0.1),
        'w_up': nrm(ks[22], (DEPTH, D_MODEL, D_FF), D_MODEL ** -0.5),
        'w_down': nrm(ks[23], (DEPTH, D_FF, D_MODEL), D_FF ** -0.5),
        'w_ple': nrm(ks[24], (DEPTH, PLE_DIM, D_MODEL), PLE_DIM ** -0.5),
        'w_ple_gate': nrm(ks[25], (DEPTH, D_MODEL, D_MODEL), D_MODEL ** -0.5),
        'g_final': 1.0 + nrm(ks[26], (D_MODEL,), 0.1),
    }


def reference(x_prompt, x_sample, cache_nsa_kv, cache_nsa_win, state_gdn_conv, state_gdn, state_ret,
              page_table, p_prompt, p_sample, g_mix, w_in, nsa_cmp_pe, nsa_cmp_w1, nsa_cmp_w2,
              gdn_conv_w, gdn_a_log, gdn_dt_bias, gdn_norm_g, w_branch, w_out, g_mlp, w_up, w_down,
              w_ple, w_ple_gate, g_final):
    xp, xs = x_prompt, x_sample
    bp, tp = xp.shape[:2]
    ts = xs.shape[1]
    pos_p = jnp.arange(tp)
    pos_s = PAST_LEN + jnp.arange(ts)
    conv0 = jnp.zeros((bp, CONV_W - 1, 3 * MIX_WIDTH), xp.dtype)
    gdn0 = jnp.zeros((bp, GDN_HEADS, GDN_HD, GDN_HD), jnp.float32)
    ret0 = jnp.zeros((bp, RET_HEADS, RET_HD, RET_HD), jnp.float32)
    kv_p, kv_s, win_p, win_s, cv_p, cv_s, sg_p, sg_s, sr_p, sr_s = ([] for _ in range(10))
    for i in range(DEPTH):
        W = dict(g_mix=g_mix[i], w_in=w_in[i], conv_w=gdn_conv_w[i], a_log=gdn_a_log[i],
                 dt_bias=gdn_dt_bias[i], norm_g=gdn_norm_g[i], w_branch=w_branch[i], w_out=w_out[i],
                 g_mlp=g_mlp[i], w_up=w_up[i], w_down=w_down[i], w_ple=w_ple[i], w_ple_gate=w_ple_gate[i])
        cmp_w = dict(cmp_pe=nsa_cmp_pe[i], cmp_w1=nsa_cmp_w1[i], cmp_w2=nsa_cmp_w2[i])
        xp, r, w, c, sg, sr = trunk_layer(xp, p_prompt[i], pos_p, functools.partial(nsa_prompt, **cmp_w),
                                          conv0, gdn0, ret0, W)
        kv_p.append(r); win_p.append(w); cv_p.append(c)
        sg_p.append(sg.astype(xp.dtype)); sr_p.append(sr.astype(xp.dtype))
        sample_nsa = functools.partial(nsa_sample, cache_kv=cache_nsa_kv[i], page_table=page_table,
                                       cache_win=cache_nsa_win[i], **cmp_w)
        xs, r, w, c, sg, sr = trunk_layer(xs, p_sample[i], pos_s, sample_nsa, state_gdn_conv[i],
                                          state_gdn[i], state_ret[i], W)
        kv_s.append(r); win_s.append(w); cv_s.append(c)
        sg_s.append(sg.astype(xs.dtype)); sr_s.append(sr.astype(xs.dtype))
    y_prompt = rmsnorm(xp, g_final)
    y_sample = rmsnorm(xs, g_final)
    return (y_prompt, y_sample, jnp.stack(kv_p), jnp.stack(kv_s), jnp.stack(win_p), jnp.stack(win_s),
            jnp.stack(cv_p), jnp.stack(cv_s), jnp.stack(sg_p), jnp.stack(sg_s), jnp.stack(sr_p), jnp.stack(sr_s))
```

```cpp
#include <hip/hip_runtime.h>
#include <cstdio>
#include <cstdint>
namespace pg8 {
#define PG8_LAS __attribute__((address_space(3)))
typedef unsigned short bf16_t;
typedef short bf16x8 __attribute__((ext_vector_type(8)));
typedef float f32x4 __attribute__((ext_vector_type(4)));
typedef unsigned u32x4 __attribute__((ext_vector_type(4)));
constexpr int BM = 256, BK = 64, HALF = 128, HTB = HALF * BK * 2  , STAGE_BYTES = 8 * HTB, NXCD = 8, WGM = 8;

__host__ __device__ __forceinline__ int lds_byte(int r, int c) { const int st = (r >> 4) * 2 + (c >> 5), rr = r & 15, cc = c & 31, ob = rr * 64 + cc * 2; return st * 1024 + (ob ^ (((ob >> 9) & 1) << 5)); }
__host__ __device__ __forceinline__ void stage_rc(int b, int& R, int& C) { const int st = b / 1024, sb = b % 1024, swz = sb ^ (((sb >> 9) & 1) << 5); R = (st >> 1) * 16 + swz / 64; C = (st & 1) * 32 + (swz % 64) / 2; }
__host__ __device__ __forceinline__ int perm32(int rho) { const int n = rho >> 4, i = rho & 15; return 8 * (i >> 2) + 4 * n + (i & 3); }

struct Unit { int pm, pn; };
struct Gemm { const bf16_t* A; const bf16_t* Bt; int M, N, K; int lda, ldb; int a_shift, a_off; };

struct StaticOrder {
    int nM, nN, nwg, G, c;
    __host__ __device__ void init(int M, int N, int G_, int c_) { nM = M / BM; nN = N / BM; nwg = nM * nN; G = G_; c = c_; }
    __host__ __device__ bool next(int i, Unit& u) const {
        const long L = (long)i * G + c; if (L >= nwg) return false;
        int wgid = (int)L; { const int q = nwg / NXCD, r = nwg % NXCD, xcd = wgid % NXCD, off = wgid / NXCD; wgid = (xcd < r ? xcd * (q + 1) : r * (q + 1) + (xcd - r) * q) + off; }
        const int nig = WGM * nN, gid = wgid / nig, fm = gid * WGM, gsz = (nM - fm) < WGM ? (nM - fm) : WGM;
        u.pm = fm + ((wgid % nig) % gsz); u.pn = (wgid % nig) / gsz; return true;
    }
    __device__ __forceinline__ void a_ready(const Unit&) const {}
    __device__ __forceinline__ void done(const Unit&) const {}
};

__device__ __forceinline__ unsigned cvt_pk_bf16(float lo, float hi) { unsigned r; asm volatile("v_cvt_pk_bf16_f32 %0, %1, %2" : "=v"(r) : "v"(lo), "v"(hi)); return r; }
typedef float f32x2 __attribute__((ext_vector_type(2)));
template <class Epi, class Sched, bool ALIGN_EPI = false, bool SP2 = false>
__device__ __forceinline__ void gemm_phase(PG8_LAS unsigned char* lds, const Gemm g, const Sched& S, const Epi& E, const int tid) {
    const int wid = __builtin_amdgcn_readfirstlane(tid >> 6), lane = tid & 63, wr = wid >> 2, wc = wid & 3, fr = lane & 15, fq = lane >> 4;
    const int K = g.K, nt = K / BK;
    unsigned voffA[2], voffB[2];
#pragma unroll
    for (int i = 0; i < 2; ++i) { int R, C; stage_rc(tid * 16 + i * 8192, R, C); const int Rb = Epi::PERM ? ((R & ~31) + perm32(R & 31)) : R;
        voffA[i] = (unsigned)(R * g.lda + C) * 2u; voffB[i] = (unsigned)(Rb * g.ldb + C) * 2u; }
    const size_t kstep = (size_t)(BK * 2);
    const size_t hstepA = (size_t)HALF * g.lda * 2, hstepB = (size_t)HALF * g.ldb * 2;
    const size_t tstepA = 2 * hstepA, tstepB = 2 * hstepB;
    const unsigned ldsw = (unsigned)wid * 1024u;
    const int aoff = lds_byte(wr * 64 + fr, fq * 8), boff = lds_byte(wc * 32 + fr, fq * 8);
#define PG8_SA(b, h) (((b) * 2 + (h)) * HTB)
#define PG8_SB(b, h) ((4 + (b) * 2 + (h)) * HTB)
#define PG8_STAGE(bufoff, gbase, voff) do { _Pragma("unroll") for (int _i = 0; _i < 2; ++_i) \
        __builtin_amdgcn_global_load_lds((const unsigned*)((const char*)(gbase) + (voff)[_i]), (PG8_LAS unsigned*)(lds + (bufoff) + ldsw + _i * 8192), 16, 0, 0); } while (0)
#define PG8_LDA(dst, b, h) do { _Pragma("unroll") for (int m = 0; m < 4; ++m) _Pragma("unroll") for (int k = 0; k < 2; ++k) dst[m][k] = *(const PG8_LAS bf16x8*)(lds + PG8_SA(b, h) + aoff + m * 2048 + k * 1024); } while (0)
#define PG8_LDB(dst, b, h) do { _Pragma("unroll") for (int n = 0; n < 2; ++n) _Pragma("unroll") for (int k = 0; k < 2; ++k) dst[n][k] = *(const PG8_LAS bf16x8*)(lds + PG8_SB(b, h) + boff + n * 2048 + k * 1024); } while (0)
#define PG8_MMA(ai, bj, At, Bt) do { __builtin_amdgcn_s_setprio(1); _Pragma("unroll") for (int m = 0; m < 4; ++m) _Pragma("unroll") for (int n = 0; n < 2; ++n) _Pragma("unroll") for (int k = 0; k < 2; ++k) \
        acc[ai][bj][m][n] = __builtin_amdgcn_mfma_f32_16x16x32_bf16(Bt[n][k], At[m][k], acc[ai][bj][m][n], 0, 0, 0); __builtin_amdgcn_s_setprio(0); } while (0)
#define PG8_WAIT_V(n) asm volatile("s_waitcnt vmcnt(" #n ")" ::: "memory")
#define PG8_WAIT_L(n) asm volatile("s_waitcnt lgkmcnt(" #n ")" ::: "memory")
#define PG8_BAR __builtin_amdgcn_s_barrier()
#define PG8_SCHED __builtin_amdgcn_sched_barrier(0)
    Unit cur, nxt; int ui = 0;
    if (!S.next(0, cur)) return;
    f32x4 acc[2][2][4][2];
#pragma unroll
    for (int a = 0; a < 2; ++a)
#pragma unroll
        for (int b = 0; b < 2; ++b)
#pragma unroll
            for (int m = 0; m < 4; ++m)
#pragma unroll
                for (int n = 0; n < 2; ++n) acc[a][b][m][n] = (f32x4){0.f, 0.f, 0.f, 0.f};
    bf16x8 At[4][2], B0[2][2], B1[2][2];
    const char* cA = (const char*)g.A + (size_t)cur.pm * tstepA + (size_t)(cur.pn >> g.a_shift) * (size_t)g.a_off; const char* cB = (const char*)g.Bt + (size_t)cur.pn * tstepB;
    S.a_ready(cur);
    if constexpr (SP2) {
        PG8_STAGE(PG8_SB(0, 0), cB, voffB); PG8_STAGE(PG8_SB(0, 1), cB + hstepB, voffB); PG8_STAGE(PG8_SA(0, 0), cA, voffA); PG8_STAGE(PG8_SA(0, 1), cA + hstepA, voffA);
        if (wr == 1) PG8_BAR;
        PG8_WAIT_V(2); PG8_BAR;
        PG8_STAGE(PG8_SB(1, 0), cB + kstep, voffB); PG8_STAGE(PG8_SA(1, 0), cA + kstep, voffA); PG8_STAGE(PG8_SB(1, 1), cB + hstepB + kstep, voffB);
        PG8_WAIT_V(6); PG8_BAR;
    } else {
        PG8_STAGE(PG8_SB(0, 0), cB, voffB); PG8_STAGE(PG8_SA(0, 0), cA, voffA); PG8_STAGE(PG8_SB(0, 1), cB + hstepB, voffB); PG8_STAGE(PG8_SA(0, 1), cA + hstepA, voffA);
        if (wr == 1) PG8_BAR;
        PG8_WAIT_V(4); PG8_BAR;
        PG8_STAGE(PG8_SB(1, 0), cB + kstep, voffB); PG8_STAGE(PG8_SA(1, 0), cA + kstep, voffA); PG8_STAGE(PG8_SB(1, 1), cB + hstepB + kstep, voffB);
        PG8_WAIT_V(6); PG8_BAR;
    }
    for (;;) {
        const bool has_next = S.next(ui + 1, nxt);
        const char* nA = has_next ? (const char*)g.A + (size_t)nxt.pm * tstepA + (size_t)(nxt.pn >> g.a_shift) * (size_t)g.a_off : cA; const char* nB = has_next ? (const char*)g.Bt + (size_t)nxt.pn * tstepB : cB;
        for (int t = 0; t < nt; t += 2) {
            const bool last = (t == nt - 2);
            const char* a1 = cA + (size_t)(t + 1) * kstep;
            const char* a2 = last ? nA : cA + (size_t)(t + 2) * kstep; const char* b2 = last ? nB : cB + (size_t)(t + 2) * kstep;
            const char* a3 = a2 + kstep; const char* b3 = b2 + kstep;
            if (last && has_next) S.a_ready(nxt);
            if constexpr (SP2) {
            PG8_LDB(B0, 0, 0); PG8_LDB(B1, 0, 1); PG8_SCHED; PG8_LDA(At, 0, 0); PG8_STAGE(PG8_SA(1, 1), a1 + hstepA, voffA);
            PG8_WAIT_V(8); PG8_WAIT_L(0); PG8_BAR; PG8_MMA(0, 0, At, B0); PG8_MMA(0, 1, At, B1); PG8_BAR; PG8_SCHED;
            PG8_LDA(At, 0, 1); PG8_STAGE(PG8_SB(0, 0), b2, voffB); PG8_STAGE(PG8_SB(0, 1), b2 + hstepB, voffB); PG8_STAGE(PG8_SA(0, 0), a2, voffA);
            PG8_WAIT_V(8); PG8_WAIT_L(0); PG8_BAR; PG8_MMA(1, 0, At, B0); PG8_MMA(1, 1, At, B1); PG8_BAR; PG8_SCHED;
            PG8_LDB(B0, 1, 0); PG8_LDB(B1, 1, 1); PG8_SCHED; PG8_LDA(At, 1, 0); PG8_STAGE(PG8_SA(0, 1), a2 + hstepA, voffA);
            PG8_WAIT_V(8); PG8_WAIT_L(0); PG8_BAR; PG8_MMA(0, 0, At, B0); PG8_MMA(0, 1, At, B1); PG8_BAR; PG8_SCHED;
            PG8_LDA(At, 1, 1); PG8_STAGE(PG8_SB(1, 0), b3, voffB); PG8_STAGE(PG8_SB(1, 1), b3 + hstepB, voffB); PG8_STAGE(PG8_SA(1, 0), a3, voffA);
            PG8_WAIT_V(8); PG8_WAIT_L(0); PG8_BAR; PG8_MMA(1, 0, At, B0); PG8_MMA(1, 1, At, B1); PG8_BAR; PG8_SCHED;
            } else {
            PG8_LDB(B0, 0, 0); PG8_SCHED; PG8_LDA(At, 0, 0); PG8_STAGE(PG8_SA(1, 1), a1 + hstepA, voffA);
            PG8_WAIT_L(8); PG8_BAR; PG8_WAIT_L(0); PG8_MMA(0, 0, At, B0); PG8_BAR; PG8_SCHED;
            PG8_LDB(B1, 0, 1); PG8_STAGE(PG8_SB(0, 0), b2, voffB);
            PG8_BAR; PG8_WAIT_L(0); PG8_MMA(0, 1, At, B1); PG8_BAR;
            PG8_LDA(At, 0, 1); PG8_STAGE(PG8_SA(0, 0), a2, voffA);
            PG8_BAR; PG8_WAIT_L(0); PG8_MMA(1, 0, At, B0); PG8_BAR; PG8_SCHED;
            PG8_STAGE(PG8_SB(0, 1), b2 + hstepB, voffB);
            PG8_WAIT_V(6); PG8_BAR; PG8_MMA(1, 1, At, B1); PG8_BAR;
            PG8_LDB(B0, 1, 0); PG8_SCHED; PG8_LDA(At, 1, 0); PG8_STAGE(PG8_SA(0, 1), a2 + hstepA, voffA);
            PG8_WAIT_L(8); PG8_BAR; PG8_WAIT_L(0); PG8_MMA(0, 0, At, B0); PG8_BAR; PG8_SCHED;
            PG8_LDB(B1, 1, 1); PG8_STAGE(PG8_SB(1, 0), b3, voffB);
            PG8_BAR; PG8_WAIT_L(0); PG8_MMA(0, 1, At, B1); PG8_BAR;
            PG8_LDA(At, 1, 1); PG8_STAGE(PG8_SA(1, 0), a3, voffA);
            PG8_BAR; PG8_WAIT_L(0); PG8_MMA(1, 0, At, B0); PG8_BAR; PG8_SCHED;
            PG8_STAGE(PG8_SB(1, 1), b3 + hstepB, voffB);
            PG8_WAIT_V(6); PG8_BAR; PG8_MMA(1, 1, At, B1); PG8_BAR;
            }
        }
        if constexpr (ALIGN_EPI) { if (wr == 0) PG8_BAR; }
        if constexpr (!Epi::AFTER_DRAIN) { E(acc, cur, wr, wc, fr, fq); S.done(cur); }
        if (!has_next) break;
#pragma unroll
        for (int a = 0; a < 2; ++a)
#pragma unroll
            for (int b = 0; b < 2; ++b)
#pragma unroll
                for (int m = 0; m < 4; ++m)
#pragma unroll
                    for (int n = 0; n < 2; ++n) acc[a][b][m][n] = (f32x4){0.f, 0.f, 0.f, 0.f};
        cur = nxt; cA = nA; cB = nB; ++ui;
        if constexpr (ALIGN_EPI) { if (wr == 1) PG8_BAR; }
    }
    PG8_WAIT_V(0);
    if constexpr (!ALIGN_EPI) { if (wr == 0) PG8_BAR; }
    PG8_BAR;
    if constexpr (Epi::AFTER_DRAIN) { E.fused(acc, cur, wr, wc, fr, fq, lds, wid, lane); S.done(cur); }
#undef PG8_SA
#undef PG8_SB
#undef PG8_STAGE
#undef PG8_LDA
#undef PG8_LDB
#undef PG8_MMA
#undef PG8_WAIT_V
#undef PG8_WAIT_L
#undef PG8_BAR
#undef PG8_SCHED
}
}
#define DI __device__ __forceinline__
#define GAS __attribute__((address_space(1)))
#define LAS __attribute__((address_space(3)))
typedef unsigned short bf16;
typedef unsigned v4u __attribute__((ext_vector_type(4)));
typedef unsigned v2u __attribute__((ext_vector_type(2)));
typedef float f32x4 __attribute__((ext_vector_type(4)));
typedef float f32x2 __attribute__((ext_vector_type(2)));
typedef short bf16x8 __attribute__((ext_vector_type(8)));
typedef short s16x4 __attribute__((ext_vector_type(4)));
typedef GAS unsigned gu32;

constexpr int DM = 1024, TP = 8192, MP = 16384, MS = 512, MROWS = 16896, LDZ = 8704, DFF = 4096, PLE = 256, NLAYER = 2;
constexpr int ZC_Q = 0, ZC_KC = 512, ZC_VC = 640, ZC_KS = 768, ZC_VS = 896, ZC_KW = 1024, ZC_VW = 1152, ZC_GQKV = 1280, ZC_GZ = 2816, ZC_RQKV = 3328, ZC_RG = 4864, ZC_MG = 5376, ZC_SM = 8448;
constexpr float EPS = 1e-6f;
constexpr size_t O_YP = 0, O_YS = O_YP + (size_t)MP * DM, O_KVP = O_YS + (size_t)MS * DM, O_KVS = O_KVP + (size_t)2 * MP * 512, O_WINP = O_KVS + (size_t)2 * MS * 512,
                 O_WINS = O_WINP + (size_t)2 * 2 * 512 * 256, O_CVP = O_WINS + (size_t)2 * 128 * 512 * 256, O_CVS = O_CVP + (size_t)2 * 2 * 3 * 1536, O_GSP = O_CVS + (size_t)2 * 128 * 3 * 1536,
                 O_GSS = O_GSP + (size_t)2 * 2 * 4 * 16384, O_RSP = O_GSS + (size_t)2 * 128 * 4 * 16384, O_RSS = O_RSP + (size_t)2 * 2 * 4 * 16384, O_END = O_RSS + (size_t)2 * 128 * 4 * 16384;

DI float bf2f(unsigned short b) { return __uint_as_float((unsigned)b << 16); }
DI unsigned f2bf(float f) { unsigned u = __float_as_uint(f); return (u + 0x7fffu + ((u >> 16) & 1u)) >> 16; }
DI unsigned pk2(float lo, float hi) { return f2bf(lo) | (f2bf(hi) << 16); }
DI float lo_bf(unsigned w) { return __uint_as_float(w << 16); }
DI float hi_bf(unsigned w) { return __uint_as_float(w & 0xffff0000u); }
DI float sigmoidf_(float x) { return 1.f / (1.f + __expf(-x)); }
DI float siluf_(float x) { return x / (1.f + __expf(-x)); }
DI v4u pack8(const f32x4 a, const f32x4 b) { v4u w; w.x = pk2(a[0], a[1]); w.y = pk2(a[2], a[3]); w.z = pk2(b[0], b[1]); w.w = pk2(b[2], b[3]); return w; }
DI void unpack8(const v4u w, f32x4& a, f32x4& b) { a[0] = lo_bf(w.x); a[1] = hi_bf(w.x); a[2] = lo_bf(w.y); a[3] = hi_bf(w.y); b[0] = lo_bf(w.z); b[1] = hi_bf(w.z); b[2] = lo_bf(w.w); b[3] = hi_bf(w.w); }

template <int M> DI int shxi(int v, int lane) {
    if constexpr (M < 32) return __builtin_amdgcn_ds_swizzle(v, (M << 10) | 0x1f);
    else return __builtin_amdgcn_ds_bpermute((lane ^ 32) << 2, v);
}
template <int M> DI float shx(float v, int lane) { return __int_as_float(shxi<M>(__float_as_int(v), lane)); }
DI float wave_sum(float v, int lane) { v += shx<1>(v, lane); v += shx<2>(v, lane); v += shx<4>(v, lane); v += shx<8>(v, lane); v += shx<16>(v, lane); v += shx<32>(v, lane); return v; }

namespace epi {
using pg8::Unit; using pg8::bf16_t;
DI float row_rstd(const float* SS, int row, int fq, int lane) {
    const f32x4 p = *(const f32x4*)(SS + (size_t)row * 16 + 4 * fq);
    float s = (p[0] + p[1]) + (p[2] + p[3]); s += shx<16>(s, lane); s += shx<32>(s, lane);
    return rsqrtf(s * (1.f / DM) + EPS);
}
struct EpiA {
    static constexpr bool PERM = true, AFTER_DRAIN = false;
    bf16* Z; float* ZS; const float* SS; float* out; int layer;
    DI void operator()(const f32x4 (&acc)[2][2][4][2], const Unit& u, int wr, int wc, int fr, int fq) const {
        const int pn = u.pn;
#pragma unroll
        for (int ai = 0; ai < 2; ++ai)
#pragma unroll
            for (int m = 0; m < 4; ++m) {
                const int row = u.pm * 256 + ai * 128 + wr * 64 + m * 16 + fr;
                const float rstd = row_rstd(SS, row, fq, fr + 16 * fq);
#pragma unroll
                for (int bj = 0; bj < 2; ++bj) {
                    const int col = pn * 256 + bj * 128 + wc * 32 + 8 * fq;
                    const f32x4 v0 = acc[ai][bj][m][0] * rstd, v1 = acc[ai][bj][m][1] * rstd;
                    *(v4u*)(Z + (size_t)row * LDZ + col) = pack8(v0, v1);
                    float* dst = nullptr;
                    if (pn == 2 || pn == 3) {
                        dst = (row < MP) ? out + O_KVP + ((size_t)layer * MP + row) * 512 + (col - 512) : out + O_KVS + ((size_t)layer * MS + (row - MP)) * 512 + (col - 512);
                    } else if (pn == 4) {
                        const int c2 = col - 1024;
                        if (row < MP) { const int t = row & (TP - 1), b = row >> 13; if (t >= TP - 512) dst = out + O_WINP + ((size_t)(layer * 2 + b) * 512 + (t - (TP - 512))) * 256 + c2; }
                        else { const int r2 = row - MP, s = r2 >> 2, j = r2 & 3; dst = out + O_WINS + ((size_t)(layer * 128 + s) * 512 + 508 + j) * 256 + c2; }
                    } else if (pn >= 5 && pn < 11) {
                        const int c2 = col - 1280;
                        if (row < MP) { const int t = row & (TP - 1), b = row >> 13; if (t >= TP - 3) dst = out + O_CVP + ((size_t)(layer * 2 + b) * 3 + (t - (TP - 3))) * 1536 + c2; }
                        else { const int r2 = row - MP, s = r2 >> 2, j = r2 & 3; if (j >= 1) dst = out + O_CVS + ((size_t)(layer * 128 + s) * 3 + (j - 1)) * 1536 + c2; }
                    } else if (pn == 33) {
                        if (bj == 0 && wc == 0) dst = ZS + (size_t)row * 32 + 8 * fq;
                    }
                    if (dst) { *(f32x4*)dst = v0; *(f32x4*)(dst + 4) = v1; }
                }
                asm volatile("" ::: "memory");
            }
    }
};
struct EpiC {
    static constexpr bool PERM = true, AFTER_DRAIN = false;
    const bf16* Z; bf16* G;
    DI void operator()(const f32x4 (&acc)[2][2][4][2], const Unit& u, int wr, int wc, int fr, int fq) const {
#pragma unroll
        for (int ai = 0; ai < 2; ++ai)
#pragma unroll
            for (int m = 0; m < 4; ++m) {
                const int row = u.pm * 256 + ai * 128 + wr * 64 + m * 16 + fr;
#pragma unroll
                for (int bj = 0; bj < 2; ++bj) {
                    const int col = u.pn * 256 + bj * 128 + wc * 32 + 8 * fq;
                    const v4u gw = *(const v4u*)(Z + (size_t)row * LDZ + ZC_MG + col);
                    f32x4 g0, g1; unpack8(gw, g0, g1);
                    f32x4 v0 = acc[ai][bj][m][0], v1 = acc[ai][bj][m][1];
#pragma unroll
                    for (int e = 0; e < 4; ++e) { v0[e] *= sigmoidf_(g0[e]); v1[e] *= sigmoidf_(g1[e]); }
                    *(v4u*)(G + (size_t)row * 3072 + col) = pack8(v0, v1);
                }
                asm volatile("" ::: "memory");
            }
    }
};
struct EpiRes {
    static constexpr bool PERM = true, AFTER_DRAIN = false;
    float* XR; bf16* XG; const float* gvec; float* SS; float* T; int mode;
    DI void operator()(const f32x4 (&acc)[2][2][4][2], const Unit& u, int wr, int wc, int fr, int fq) const {
#pragma unroll
        for (int ai = 0; ai < 2; ++ai)
#pragma unroll
            for (int m = 0; m < 4; ++m) {
                const int row = u.pm * 256 + ai * 128 + wr * 64 + m * 16 + fr;
                float ssq = 0.f;
#pragma unroll
                for (int bj = 0; bj < 2; ++bj) {
                    const int col = u.pn * 256 + bj * 128 + wc * 32 + 8 * fq;
                    const size_t o = (size_t)row * DM + col;
                    f32x4 a0 = acc[ai][bj][m][0], a1 = acc[ai][bj][m][1];
                    if (mode == 1) { *(f32x4*)(T + o) = a0; *(f32x4*)(T + o + 4) = a1; continue; }
                    f32x4 x0 = *(const f32x4*)(XR + o), x1 = *(const f32x4*)(XR + o + 4);
                    if (mode == 2) { const f32x4 t0 = *(const f32x4*)(T + o), t1 = *(const f32x4*)(T + o + 4);
#pragma unroll
                        for (int e = 0; e < 4; ++e) { a0[e] = t0[e] * sigmoidf_(a0[e]); a1[e] = t1[e] * sigmoidf_(a1[e]); } }
                    x0 += a0; x1 += a1;
                    *(f32x4*)(XR + o) = x0; *(f32x4*)(XR + o + 4) = x1;
                    ssq += (x0[0] * x0[0] + x0[1] * x0[1]) + (x0[2] * x0[2] + x0[3] * x0[3]) + (x1[0] * x1[0] + x1[1] * x1[1]) + (x1[2] * x1[2] + x1[3] * x1[3]);
                    if (XG) { if (gvec) { const f32x4 g0 = *(const f32x4*)(gvec + col), g1 = *(const f32x4*)(gvec + col + 4); x0 *= g0; x1 *= g1; }
                        *(v4u*)(XG + o) = pack8(x0, x1); }
                }
                if (SS) { ssq += shx<16>(ssq, fr + 16 * fq); ssq += shx<32>(ssq, fr + 16 * fq); if (fq == 0) SS[(size_t)row * 16 + u.pn * 4 + wc] = ssq; }
                asm volatile("" ::: "memory");
            }
    }
};
struct EpiUp {
    static constexpr bool PERM = true, AFTER_DRAIN = false;
    bf16* H; const float* SS;
    DI void operator()(const f32x4 (&acc)[2][2][4][2], const Unit& u, int wr, int wc, int fr, int fq) const {
#pragma unroll
        for (int ai = 0; ai < 2; ++ai)
#pragma unroll
            for (int m = 0; m < 4; ++m) {
                const int row = u.pm * 256 + ai * 128 + wr * 64 + m * 16 + fr;
                const float rstd = row_rstd(SS, row, fq, fr + 16 * fq);
#pragma unroll
                for (int bj = 0; bj < 2; ++bj) {
                    const int col = u.pn * 256 + bj * 128 + wc * 32 + 8 * fq;
                    f32x4 v0 = acc[ai][bj][m][0] * rstd, v1 = acc[ai][bj][m][1] * rstd;
#pragma unroll
                    for (int e = 0; e < 4; ++e) { const float a = fmaxf(v0[e], 0.f), b = fmaxf(v1[e], 0.f); v0[e] = a * a; v1[e] = b * b; }
                    *(v4u*)(H + (size_t)row * DFF + col) = pack8(v0, v1);
                }
                asm volatile("" ::: "memory");
            }
    }
};
}
constexpr size_t al256(size_t x) { return (x + 255) & ~(size_t)255; }
constexpr size_t WS_CTL = 0, CTL_ZERO_BYTES = 1u << 20;
constexpr size_t SZ_WIN = (size_t)LDZ * DM * 2, SZ_WBR = (size_t)3072 * 512 * 2, SZ_WO3 = (size_t)DM * 3072 * 2, SZ_WUP = (size_t)DFF * DM * 2, SZ_WDN = (size_t)DM * DFF * 2,
                 SZ_WPL = (size_t)DM * PLE * 2, SZ_WPG = (size_t)DM * DM * 2, SZ_W1T = (size_t)2 * 64 * 2048 * 2, SZ_W2T = (size_t)2 * 64 * 64 * 2;
constexpr size_t WS_WIN = CTL_ZERO_BYTES, WS_WBR = WS_WIN + 2 * SZ_WIN, WS_WO3 = WS_WBR + 2 * SZ_WBR, WS_WUP = WS_WO3 + 2 * SZ_WO3, WS_WDN = WS_WUP + 2 * SZ_WUP,
                 WS_WPL = WS_WDN + 2 * SZ_WDN, WS_WPG = WS_WPL + 2 * SZ_WPL, WS_W1T = WS_WPG + 2 * SZ_WPG, WS_W2T = WS_W1T + 2 * SZ_W1T, WS_ROT = al256(WS_W2T + 2 * SZ_W2T);
constexpr size_t WS_P16 = WS_ROT + (size_t)TP * 64 * 8;
constexpr size_t WS_XR = WS_P16 + (size_t)2 * MROWS * PLE * 2;
constexpr size_t WS_XGA = WS_XR + (size_t)MROWS * DM * 4, WS_XGB = WS_XGA + (size_t)MROWS * DM * 2, WS_XGC = WS_XGB + (size_t)MROWS * DM * 2;
constexpr size_t WS_SSA = WS_XGC + (size_t)MROWS * DM * 2, WS_SSB = WS_SSA + (size_t)MROWS * 64;
constexpr size_t WS_Z = WS_SSB + (size_t)MROWS * 64, WS_ZS = WS_Z + (size_t)MROWS * LDZ * 2;
constexpr size_t WS_MIX = WS_ZS + (size_t)MROWS * 128, WS_GATED = WS_MIX + (size_t)MROWS * 1536 * 2, WS_HMID = WS_GATED + (size_t)MROWS * 3072 * 2;
constexpr size_t WS_TPLE = WS_HMID + (size_t)MROWS * DFF * 2;
constexpr size_t WS_KC = WS_TPLE + (size_t)MROWS * DM * 4;
constexpr size_t WS_KCS = WS_KC + (size_t)2 * 2 * 512 * 2 * 64 * 2;
constexpr int GREC = 73984;
constexpr size_t WS_GREC = WS_KCS + (size_t)2 * 128 * 128 * 2 * 64 * 2;
constexpr size_t WS_OGDN = WS_GREC + (size_t)1024 * GREC;
constexpr size_t WS_RKV = WS_OGDN + (size_t)MROWS * 512 * 4;
constexpr size_t WS_RST = WS_RKV + (size_t)512 * 16384 * 4;
constexpr size_t WS_QR = WS_RST + (size_t)512 * 16384 * 2, WS_KR = WS_QR + (size_t)MP * 512 * 2;
constexpr size_t WS_END = WS_KR + (size_t)MP * 512 * 2;
static_assert(WS_W1T % 256 == 0 && WS_Z % 256 == 0 && WS_GREC % 256 == 0 && WS_RKV % 256 == 0 && WS_KC % 256 == 0 && WS_XR % 256 == 0, "ws alignment");

constexpr int CW_TMO = 0, CW_BAR = 4096;
constexpr int NWAVES = 8, NTHREADS = 512;
constexpr int RING_BYTES = 147456, LDSCTL_OFF = RING_BYTES, MISC_OFF = LDSCTL_OFF + 320, LDS_BYTES = RING_BYTES + 1024;

#define RLX_AGENT __ATOMIC_RELAXED, __HIP_MEMORY_SCOPE_AGENT
#define LDS_WAIT() asm volatile("s_waitcnt lgkmcnt(0)" ::: "memory")
#define VM_WAIT() asm volatile("s_waitcnt vmcnt(0)" ::: "memory")
#define XB_TMO      128
#define XB_XCNT(j)  (256  + 64 * (j))
#define XB_XSUB(j)  (1280 + 64 * (j))
#define XB_XGEN(j)  (2304 + 64 * (j))
#define XB_TOP      3328
#define XB_TOPGEN   3392
#define XCD_BAR_WORDS 3456
#define XB_SPIN_CAP (1u << 18)

__device__ __forceinline__ unsigned xb_ld(unsigned* p)              { return __hip_atomic_load(p, __ATOMIC_RELAXED, __HIP_MEMORY_SCOPE_AGENT); }
__device__ __forceinline__ unsigned xb_add(unsigned* p, unsigned v) { return __hip_atomic_fetch_add(p, v, __ATOMIC_RELAXED, __HIP_MEMORY_SCOPE_AGENT); }
__device__ __forceinline__ unsigned xb_xcc_id() { return (unsigned)__builtin_amdgcn_s_getreg((3 << 11) | 20) & 0xFu; }
#define XB_SPIN(cond, bar) do { unsigned _sp = 0; while (cond) { __builtin_amdgcn_s_sleep(1); \
    if ((++_sp & 255u) == 0u) { if (xb_ld(&(bar)[XB_TMO])) break; if (_sp > XB_SPIN_CAP) { atomicAdd(&(bar)[XB_TMO], 1u); break; } } } } while (0)

struct XcdBarrier {
    unsigned* bar; unsigned x;
    volatile LAS unsigned* st;
};

__device__ __forceinline__ XcdBarrier xcd_barrier_post(unsigned* bar, volatile LAS unsigned* st, bool t0) {
    XcdBarrier b; b.bar = bar; b.x = xb_xcc_id(); b.st = st;
    if (t0) (void)xb_add(&bar[XB_XCNT(b.x)], 1u);
    return b;
}
__device__ __forceinline__ void xcd_barrier_complete(unsigned* bar, unsigned x, unsigned& nloc, unsigned& nx) {
    const unsigned G = gridDim.x * gridDim.y * gridDim.z;
    unsigned sum, cnt, mine, sp = 0u;
    for (;;) {
        sum = 0u; cnt = 0u; mine = 0u;
#pragma unroll
        for (unsigned j = 0; j < 16; ++j) { const unsigned c = xb_ld(&bar[XB_XCNT(j)]); sum += c; cnt += (c > 0u) ? 1u : 0u; mine = (j == x) ? c : mine; }
        if (sum == G) break;
        __builtin_amdgcn_s_sleep(1);
        if ((++sp & 255u) == 0u) { if (xb_ld(&bar[XB_TMO])) break; if (sp > XB_SPIN_CAP) { atomicAdd(&bar[XB_TMO], 1u); break; } }
    }
    nloc = mine > 0u ? mine : 1u; nx = cnt > 0u ? cnt : 1u;
}

__device__ __forceinline__ void xcd_barrier(const XcdBarrier& b, bool t0) {
    asm volatile("s_waitcnt vmcnt(0)" ::: "memory");
    __syncthreads();
    if (t0) {
        unsigned* bar = b.bar;
        __builtin_amdgcn_s_waitcnt(0);
        unsigned nloc = b.st[0], nx = b.st[1];
        if (nloc == 0u) { xcd_barrier_complete(bar, b.x, nloc, nx); b.st[0] = nloc; b.st[1] = nx; }
        const unsigned old = xb_add(&bar[XB_XSUB(b.x)], 1u);
        const unsigned gen = old / nloc;
        if (old + 1u == (gen + 1u) * nloc) {
            __builtin_amdgcn_fence(__ATOMIC_RELEASE, "agent");
            asm volatile("s_waitcnt vmcnt(0)" ::: "memory");
            const unsigned og = xb_add(&bar[XB_TOP], 1u);
            const unsigned tg = og / nx;
            if (og + 1u == (tg + 1u) * nx) xb_add(&bar[XB_TOPGEN], 1u);
            else XB_SPIN(xb_ld(&bar[XB_TOPGEN]) == tg, bar);
            __builtin_amdgcn_fence(__ATOMIC_ACQUIRE, "agent");
            xb_add(&bar[XB_XGEN(b.x)], 1u);
            asm volatile("s_waitcnt vmcnt(0)" ::: "memory");
        } else {
            XB_SPIN(xb_ld(&bar[XB_XGEN(b.x)]) == gen, bar);
            __builtin_amdgcn_fence(__ATOMIC_ACQUIRE, "agent");
            asm volatile("s_waitcnt vmcnt(0)" ::: "memory");
        }
    }
    __syncthreads();
}
typedef const void* const __attribute__((address_space(4)))* kargp_t;
DI const float* KIN(int i) { const float* p = (const float*)((kargp_t)__builtin_amdgcn_kernarg_segment_ptr())[i]; asm volatile("" : "+s"(p)); return p; }
DI float* KOUT() { float* p = (float*)((kargp_t)__builtin_amdgcn_kernarg_segment_ptr())[27]; asm volatile("" : "+s"(p)); return p; }
DI unsigned char* KWS() { unsigned char* p = (unsigned char*)((kargp_t)__builtin_amdgcn_kernarg_segment_ptr())[28]; asm volatile("" : "+s"(p)); return p; }
struct Frame {
    LAS unsigned char* lds;
    gu32* ctl;
    int tid, lane, wave, G, bid;
};
DI bf16x8 ld_frag_g(const bf16* p) { return __builtin_bit_cast(bf16x8, *(const v4u*)p); }
DI bf16x8 ld_frag_l(const LAS unsigned char* p) { return *(const LAS bf16x8*)p; }
DI f32x4 mfma16(bf16x8 a, bf16x8 b, f32x4 c) { return __builtin_amdgcn_mfma_f32_16x16x32_bf16(a, b, c, 0, 0, 0); }
DI bf16x8 pack_frag(const f32x4 a, const f32x4 b) { return __builtin_bit_cast(bf16x8, pack8(a, b)); }
DI int lane_id() { return (int)__builtin_amdgcn_mbcnt_hi(~0u, __builtin_amdgcn_mbcnt_lo(~0u, 0u)); }
DI Frame fresh(const Frame& F0) {
    Frame F = F0; int w = F0.wave, g = F0.G, b = F0.bid; asm volatile("" : "+s"(w), "+s"(g), "+s"(b));
    int l = lane_id(); asm volatile("" : "+v"(l));
    unsigned lb = (unsigned)(uintptr_t)F0.lds; asm volatile("" : "+s"(lb)); F.lds = (LAS unsigned char*)(uintptr_t)lb;
    F.wave = w; F.lane = l; F.tid = w * 64 + l; F.G = g; F.bid = b; return F;
}
#define GRID_BAR() do { XcdBarrier b_; b_.bar = (unsigned*)((gu32*)(KWS() + WS_CTL) + CW_BAR); b_.x = xb_xcc_id(); b_.st = (volatile LAS unsigned*)(F.lds + MISC_OFF) + 8; \
    const Frame Fb_ = fresh(F); xcd_barrier(b_, Fb_.tid == 0); } while (0)
DI int win_colmap(int j) {
    if (j < 1280) return j; if (j < 2816) return j + 24; if (j < 8448) return j + 32; if (j < 8472) return j - 8448 + 1280; if (j < 8480) return j - 8472 + 2840; return -1;
}
DI void tr_item(const float* W, int ldw, int k0, int srccol, bf16* WT, size_t dst_row0, int ldt, int kdst0, int nrep, int krep, LAS float* scr, int lane) {
#pragma unroll 8
    for (int i = 0; i < 32; ++i) { const int kk = 2 * i + (lane >> 5); scr[kk * 33 + (lane & 31)] = (srccol >= 0) ? W[(size_t)(k0 + kk) * ldw + srccol] : 0.f; }
    LDS_WAIT(); asm volatile("" ::: "memory");
    const int c = lane & 7;
#pragma unroll
    for (int j = 0; j < 4; ++j) { const int n = (lane >> 3) + 8 * j; const LAS float* s = scr + (8 * c) * 33 + n;
        v4u o; o.x = pk2(s[0 * 33], s[1 * 33]); o.y = pk2(s[2 * 33], s[3 * 33]); o.z = pk2(s[4 * 33], s[5 * 33]); o.w = pk2(s[6 * 33], s[7 * 33]);
        for (int r = 0; r < nrep; ++r) *(v4u*)(WT + (dst_row0 + n) * (size_t)ldt + kdst0 + r * krep + 8 * c) = o; }
    LDS_WAIT(); asm volatile("" ::: "memory");
}
DI void p0_prologue(Frame& F) {
    LAS float* scr = (LAS float*)(F.lds + F.wave * 16384);
    const int gw = F.bid * NWAVES + F.wave, NGW = F.G * NWAVES, lane = F.lane;
    unsigned char* ws = KWS();
    constexpr int I_A = 16 * 272, I_B = 3 * 8 * 32, I_C = 16 * 32, I_D = 16 * 128, I_E = 64 * 32, I_F = 4 * 32, I_G = 16 * 32, I_H = 2 * 32 * 2, I_I = 2 * 2;
    constexpr int I_L = I_A + I_B + I_C + I_D + I_E + I_F + I_G + I_H + I_I;
    for (int it = gw; it < 2 * I_L; it += NGW) {
        const int l = it / I_L; int r = it % I_L;
        if (r < I_A) { const int kb = r / 272, nb = r % 272; tr_item(KIN(11) + (size_t)l * DM * 8480, 8480, 64 * kb, win_colmap(32 * nb + (lane & 31)), (bf16*)(ws + WS_WIN + l * SZ_WIN), 32 * nb, DM, 64 * kb, 1, 0, scr, lane); continue; } r -= I_A;
        if (r < I_B) { const int b = r / 256, kb = (r % 256) / 32, nb = r % 32; tr_item(KIN(19) + (size_t)(l * 3 + b) * 512 * DM, DM, 64 * kb, 32 * nb + (lane & 31), (bf16*)(ws + WS_WBR + l * SZ_WBR), b * 1024 + 32 * nb, 512, 64 * kb, 1, 0, scr, lane); continue; } r -= I_B;
        if (r < I_C) { const int kb = r / 32, nb = r % 32; tr_item(KIN(20) + (size_t)l * DM * DM, DM, 64 * kb, 32 * nb + (lane & 31), (bf16*)(ws + WS_WO3 + l * SZ_WO3), 32 * nb, 3072, 64 * kb, 3, 1024, scr, lane); continue; } r -= I_C;
        if (r < I_D) { const int kb = r / 128, nb = r % 128; tr_item(KIN(22) + (size_t)l * DM * DFF, DFF, 64 * kb, 32 * nb + (lane & 31), (bf16*)(ws + WS_WUP + l * SZ_WUP), 32 * nb, DM, 64 * kb, 1, 0, scr, lane); continue; } r -= I_D;
        if (r < I_E) { const int kb = r / 32, nb = r % 32; tr_item(KIN(23) + (size_t)l * DFF * DM, DM, 64 * kb, 32 * nb + (lane & 31), (bf16*)(ws + WS_WDN + l * SZ_WDN), 32 * nb, DFF, 64 * kb, 1, 0, scr, lane); continue; } r -= I_E;
        if (r < I_F) { const int kb = r / 32, nb = r % 32; tr_item(KIN(24) + (size_t)l * PLE * DM, DM, 64 * kb, 32 * nb + (lane & 31), (bf16*)(ws + WS_WPL + l * SZ_WPL), 32 * nb, PLE, 64 * kb, 1, 0, scr, lane); continue; } r -= I_F;
        if (r < I_G) { const int kb = r / 32, nb = r % 32; tr_item(KIN(25) + (size_t)l * DM * DM, DM, 64 * kb, 32 * nb + (lane & 31), (bf16*)(ws + WS_WPG + l * SZ_WPG), 32 * nb, DM, 64 * kb, 1, 0, scr, lane); continue; } r -= I_G;
        if (r < I_H) { const int kv = r / 64, kb = (r % 64) / 2, nb = r % 2; tr_item(KIN(13) + (size_t)(l * 2 + kv) * 2048 * 64, 64, 64 * kb, 32 * nb + (lane & 31), (bf16*)(ws + WS_W1T + l * SZ_W1T) + (size_t)kv * 64 * 2048, 32 * nb, 2048, 64 * kb, 1, 0, scr, lane); continue; } r -= I_H;
        { const int kv = r / 2, nb = r % 2; tr_item(KIN(14) + (size_t)(l * 2 + kv) * 64 * 64, 64, 0, 32 * nb + (lane & 31), (bf16*)(ws + WS_W2T + l * SZ_W2T) + (size_t)kv * 64 * 64, 32 * nb, 64, 0, 1, 0, scr, lane); }
    }
    float* XR = (float*)(ws + WS_XR); bf16* XGA = (bf16*)(ws + WS_XGA); float* SSA = (float*)(ws + WS_SSA); bf16* P16 = (bf16*)(ws + WS_P16);
    const float* g0 = KIN(10);
    for (int row = gw; row < MROWS; row += NGW) {
        const float* xs = (row < MP) ? KIN(0) + (size_t)row * DM : KIN(1) + (size_t)(row - MP) * DM;
        float ss = 0.f;
#pragma unroll
        for (int j = 0; j < 2; ++j) {
            const int c = j * 512 + lane * 8;
            f32x4 a = *(const f32x4*)(xs + c), b = *(const f32x4*)(xs + c + 4);
            *(f32x4*)(XR + (size_t)row * DM + c) = a; *(f32x4*)(XR + (size_t)row * DM + c + 4) = b;
            ss += (a[0] * a[0] + a[1] * a[1]) + (a[2] * a[2] + a[3] * a[3]) + (b[0] * b[0] + b[1] * b[1]) + (b[2] * b[2] + b[3] * b[3]);
            const f32x4 ga = *(const f32x4*)(g0 + c), gb = *(const f32x4*)(g0 + c + 4);
            *(v4u*)(XGA + (size_t)row * DM + c) = pack8(a * ga, b * gb);
        }
        ss = wave_sum(ss, lane);
        if (lane < 16) SSA[(size_t)row * 16 + lane] = (lane == 0) ? ss : 0.f;
#pragma unroll
        for (int l = 0; l < 2; ++l) {
            const float* ps = (row < MP) ? KIN(8) + ((size_t)l * MP + row) * PLE : KIN(9) + ((size_t)l * MS + (row - MP)) * PLE;
            const f32x4 a = *(const f32x4*)(ps + lane * 4);
            v2u o; o.x = pk2(a[0], a[1]); o.y = pk2(a[2], a[3]);
            *(v2u*)(P16 + ((size_t)l * MROWS + row) * PLE + lane * 4) = o;
        }
    }
    const int gt = F.bid * NTHREADS + F.tid, NGT = F.G * NTHREADS;
    f32x2* ROT = (f32x2*)(ws + WS_ROT);
    for (int e = gt; e < TP * 64; e += NGT) {
        const int pos = e >> 6, i = e & 63;
        const float x = (float)i * (1.0f / 63.0f);
        const float inv = exp2f(-x * 13.287712379549449f);
        const float ang = (float)pos * inv;
        const double rev = (double)ang * 0.15915494309189535;
        const float fr = (float)(rev - floor(rev));
        ROT[e] = (f32x2){__builtin_amdgcn_cosf(fr), __builtin_amdgcn_sinf(fr)};
    }
    for (int e = gt; e < 2 * 128 * 508 * 64; e += NGT) {
        const int ls = e / (508 * 64), r = e % (508 * 64);
        const f32x4 v = *(const f32x4*)(KIN(3) + (size_t)ls * 512 * 256 + 4 * 256 + (size_t)r * 4);
        *(f32x4*)(KOUT() + O_WINS + (size_t)ls * 512 * 256 + (size_t)r * 4) = v;
    }
}
DI float gelu_tanh(float x) { const float u = 0.7978845608028654f * (x + 0.044715f * x * x * x); const float e = __expf(2.f * u); return 0.5f * x * (1.f + (1.f - 2.f / (e + 1.f))); }
DI bf16x8 mk_frag(v2u a, v2u b) { v4u w; w.x = a.x; w.y = a.y; w.z = b.x; w.w = b.y; return __builtin_bit_cast(bf16x8, w); }

DI void compress_task(Frame& F, int layer, int task) {
    const int lane = F.lane, quad = lane >> 4, rl = lane & 15;
    unsigned char* ws = KWS();
    const bool sample = task >= 256;
    int kv, bs, nt, g;
    if (!sample) { kv = task >> 7; const int r = task & 127; bs = r >> 6; nt = (r >> 1) & 31; g = r & 1; }
    else { const int t2 = task - 256; kv = t2 >> 11; const int r = t2 & 2047; bs = r >> 4; nt = (r >> 1) & 7; g = r & 1; }
    const int n = nt * 16 + rl;
    const bf16* W1T = (const bf16*)(ws + WS_W1T + layer * SZ_W1T) + (size_t)kv * 64 * 2048;
    const bf16* W2T = (const bf16*)(ws + WS_W2T + layer * SZ_W2T) + (size_t)kv * 64 * 64;
    const float* pe = KIN(12) + (size_t)(layer * 2 + kv) * 32 * 64;
    const bf16* Z = (const bf16*)(ws + WS_Z);
    const int* pt = (const int*)KIN(7);
    const float* cache = KIN(2);
    f32x4 h[4];
#pragma unroll
    for (int i = 0; i < 4; ++i) h[i] = (f32x4){0.f, 0.f, 0.f, 0.f};
#pragma unroll 4
    for (int kk = 0; kk < 64; ++kk) {
        const int j = kk >> 1, dim0 = (kk & 1) * 32 + quad * 8;
        f32x4 x0, x1;
        if (!sample) { const size_t row = (size_t)bs * TP + 16 * n + j; unpack8(*(const v4u*)(Z + row * LDZ + ZC_KC + kv * 128 + g * 64 + dim0), x0, x1); }
        else { int pos = 16 * n + j; pos = pos > 2047 ? 2047 : pos; const int phys = pt[bs * 16 + (pos >> 7)];
            const float* p = cache + ((size_t)(layer * 2560 + phys) * 128 + (pos & 127)) * 512 + kv * 128 + g * 64 + dim0; x0 = *(const f32x4*)p; x1 = *(const f32x4*)(p + 4); }
        x0 += *(const f32x4*)(pe + j * 64 + dim0); x1 += *(const f32x4*)(pe + j * 64 + dim0 + 4);
        const bf16x8 xb = pack_frag(x0, x1);
#pragma unroll
        for (int ht = 0; ht < 4; ++ht) h[ht] = mfma16(ld_frag_g(W1T + (size_t)(16 * ht + rl) * 2048 + kk * 32 + quad * 8), xb, h[ht]);
    }
#pragma unroll
    for (int ht = 0; ht < 4; ++ht)
#pragma unroll
        for (int i = 0; i < 4; ++i) h[ht][i] = gelu_tanh(h[ht][i]);
    bf16x8 gb[2]; gb[0] = pack_frag(h[0], h[1]); gb[1] = pack_frag(h[2], h[3]);
    bf16* dst = sample ? (bf16*)(ws + WS_KCS) + ((((size_t)kv * 128 + bs) * 128 + n) * 2 + g) * 64 : (bf16*)(ws + WS_KC) + ((((size_t)kv * 2 + bs) * 512 + n) * 2 + g) * 64;
    const bool zero = sample && n == 127;
#pragma unroll
    for (int ot = 0; ot < 4; ++ot) {
        f32x4 o = (f32x4){0.f, 0.f, 0.f, 0.f};
#pragma unroll
        for (int s = 0; s < 2; ++s) {
            const bf16* wp = W2T + (16 * ot + rl) * 64 + 32 * s + 4 * quad;
            o = mfma16(mk_frag(*(const v2u*)wp, *(const v2u*)(wp + 16)), gb[s], o);
        }
        v2u w; w.x = zero ? 0u : pk2(o[0], o[1]); w.y = zero ? 0u : pk2(o[2], o[3]);
        *(v2u*)(dst + 16 * ot + 4 * quad) = w;
    }
}

DI int kperm(int idx) { const int s = idx >> 5, r = idx & 31; return 32 * s + 8 * ((r >> 2) & 3) + 4 * (r >> 4) + (r & 3); }
DI float softplusf_(float x) { return x > 20.f ? x : log1pf(__expf(x)); }

DI void gdn_prep_unit(Frame& F, int layer, int unit) {
    const int tid = F.tid, lane = F.lane, wave = F.wave;
    const int b = unit >> 9, h = (unit >> 7) & 3, c = unit & 127;
    const int row0 = b * TP + 64 * c, t0 = 64 * c;
    unsigned char* ws = KWS();
    const bf16* Z = (const bf16*)(ws + WS_Z);
    const float* ZS = (const float*)(ws + WS_ZS);
    LAS float* Lq = (LAS float*)(F.lds); LAS float* Lk = (LAS float*)(F.lds + 33792); LAS float* Lv = (LAS float*)(F.lds + 67584);
    LAS float* LA = (LAS float*)(F.lds + 101376); LAS float* LQK = (LAS float*)(F.lds + 117760);
    LAS float* Lg = (LAS float*)(F.lds + 134144); LAS float* Lb = Lg + 64; LAS float* Le = Lg + 128;
    const float* cw = KIN(15) + (size_t)layer * 4 * 1536;
    for (int it = tid; it < 64 * 48; it += NTHREADS) {
        const int i = it / 48, ch = it % 48, part = ch >> 4, cc = ch & 15;
        const int col = part * 512 + h * 128 + cc * 8;
        f32x4 y0 = (f32x4){0.f, 0.f, 0.f, 0.f}, y1 = y0;
#pragma unroll
        for (int j = 0; j < 4; ++j) {
            const int t = t0 + i - 3 + j;
            if (t >= 0) { f32x4 x0, x1; unpack8(*(const v4u*)(Z + (size_t)(row0 + i - 3 + j) * LDZ + ZC_GQKV + col), x0, x1);
                y0 += x0 * *(const f32x4*)(cw + j * 1536 + col); y1 += x1 * *(const f32x4*)(cw + j * 1536 + col + 4); }
        }
#pragma unroll
        for (int e = 0; e < 4; ++e) { y0[e] = siluf_(y0[e]); y1[e] = siluf_(y1[e]); }
        LAS float* dst = (part == 0 ? Lq : part == 1 ? Lk : Lv) + i * 132 + cc * 8;
        *(LAS f32x4*)dst = y0; *(LAS f32x4*)(dst + 4) = y1;
    }
    __syncthreads();
    for (int q = 0; q < 8; ++q) {
        const int i = wave * 8 + q;
        { const float a = Lq[i * 132 + lane * 2], bq = Lq[i * 132 + lane * 2 + 1]; const float sc = rsqrtf(wave_sum(a * a + bq * bq, lane) + EPS) * 0.08838834764831845f; Lq[i * 132 + lane * 2] = a * sc; Lq[i * 132 + lane * 2 + 1] = bq * sc; }
        { const float a = Lk[i * 132 + lane * 2], bq = Lk[i * 132 + lane * 2 + 1]; const float sc = rsqrtf(wave_sum(a * a + bq * bq, lane) + EPS); Lk[i * 132 + lane * 2] = a * sc; Lk[i * 132 + lane * 2 + 1] = bq * sc; }
    }
    if (wave == 0) {
        const float ga = ZS[(size_t)(row0 + lane) * 32 + 24 + h], gbv = ZS[(size_t)(row0 + lane) * 32 + 28 + h];
        float g = -__expf(KIN(16)[layer * 4 + h]) * softplusf_(ga + KIN(17)[layer * 4 + h]);
#pragma unroll
        for (int o = 1; o < 64; o <<= 1) { const float t = __int_as_float(__builtin_amdgcn_ds_bpermute(((lane - o) & 63) << 2, __float_as_int(g))); if (lane >= o) g += t; }
        Lg[lane] = g; Lb[lane] = sigmoidf_(gbv); Le[lane] = __expf(g);
    }
    __syncthreads();
    {
        const int i = tid >> 3, c8 = tid & 7;
        float kkv[8], qkv[8];
#pragma unroll
        for (int jj = 0; jj < 8; ++jj) { kkv[jj] = 0.f; qkv[jj] = 0.f; }
        for (int d4 = 0; d4 < 32; ++d4) {
            const f32x4 ki = *(const LAS f32x4*)(Lk + i * 132 + 4 * d4), qi = *(const LAS f32x4*)(Lq + i * 132 + 4 * d4);
#pragma unroll
            for (int jj = 0; jj < 8; ++jj) { const f32x4 kj = *(const LAS f32x4*)(Lk + (jj * 8 + c8) * 132 + 4 * d4);
                kkv[jj] += (ki[0] * kj[0] + ki[1] * kj[1]) + (ki[2] * kj[2] + ki[3] * kj[3]); qkv[jj] += (qi[0] * kj[0] + qi[1] * kj[1]) + (qi[2] * kj[2] + qi[3] * kj[3]); }
        }
        const float gi = Lg[i], bi = Lb[i];
#pragma unroll
        for (int jj = 0; jj < 8; ++jj) { const int j = jj * 8 + c8; const float dec = (i >= j) ? __expf(gi - Lg[j]) : 0.f;
            LA[i * 64 + j] = (i > j) ? bi * kkv[jj] * dec : 0.f; LQK[i * 64 + j] = qkv[jj] * dec; }
    }
    __syncthreads();
    unsigned char* rec = ws + WS_GREC + (size_t)unit * GREC;
    {
        const float gl = Lg[63];
        for (int it = tid; it < 2560; it += NTHREADS) {
            if (it < 1024) {
                const int i = it >> 4, s = (it >> 2) & 3, quad = it & 3; const float e = Le[i];
                const f32x4 a = *(const LAS f32x4*)(Lq + i * 132 + 32 * s + 4 * quad) * e, bq = *(const LAS f32x4*)(Lq + i * 132 + 32 * s + 16 + 4 * quad) * e;
                *(v4u*)(rec + 16384 + i * 256 + (32 * s + 8 * quad) * 2) = pack8(a, bq);
            } else if (it < 2048) {
                const int r = it - 1024, dk = r >> 3, s2 = (r >> 2) & 1, quad = r & 3;
                f32x4 a, bq;
#pragma unroll
                for (int e = 0; e < 4; ++e) { const int ta = 32 * s2 + 4 * quad + e, tb = ta + 16; a[e] = Lk[ta * 132 + dk] * __expf(gl - Lg[ta]); bq[e] = Lk[tb * 132 + dk] * __expf(gl - Lg[tb]); }
                *(v4u*)(rec + 32768 + dk * 128 + (32 * s2 + 8 * quad) * 2) = pack8(a, bq);
            } else {
                const int r = it - 2048, i = r >> 3, s2 = (r >> 2) & 1, quad = r & 3;
                const f32x4 a = *(const LAS f32x4*)(LQK + i * 64 + 32 * s2 + 4 * quad), bq = *(const LAS f32x4*)(LQK + i * 64 + 32 * s2 + 16 + 4 * quad);
                *(v4u*)(rec + 65536 + i * 128 + (32 * s2 + 8 * quad) * 2) = pack8(a, bq);
            }
        }
        if (tid == 0) *(float*)(rec + 73728) = __expf(gl);
    }
    __syncthreads();
    if (tid < 256) {
        LAS float* X = (tid < 128) ? (Lv + tid) : (Lk + (tid - 128));
        const bool isw = tid >= 128;
        for (int i = 0; i < 64; ++i) {
            const float rhs = isw ? Lb[i] * Le[i] * X[i * 132] : Lb[i] * X[i * 132];
            float s0 = rhs, s1 = 0.f;
            const int nj4 = i >> 2;
            for (int j4 = 0; j4 < nj4; ++j4) { const f32x4 a = *(const LAS f32x4*)(LA + i * 64 + 4 * j4);
                s0 -= a[0] * X[(4 * j4) * 132]; s1 -= a[1] * X[(4 * j4 + 1) * 132]; s0 -= a[2] * X[(4 * j4 + 2) * 132]; s1 -= a[3] * X[(4 * j4 + 3) * 132]; }
            for (int jj = 4 * nj4; jj < i; ++jj) s0 -= LA[i * 64 + jj] * X[jj * 132];
            X[i * 132] = s0 + s1;
        }
    }
    __syncthreads();
    for (int it = tid; it < 2048; it += NTHREADS) {
        if (it < 1024) {
            const int dv = it >> 3, q = it & 7;
            v4u w; w.x = pk2(Lv[(8 * q) * 132 + dv], Lv[(8 * q + 1) * 132 + dv]); w.y = pk2(Lv[(8 * q + 2) * 132 + dv], Lv[(8 * q + 3) * 132 + dv]);
            w.z = pk2(Lv[(8 * q + 4) * 132 + dv], Lv[(8 * q + 5) * 132 + dv]); w.w = pk2(Lv[(8 * q + 6) * 132 + dv], Lv[(8 * q + 7) * 132 + dv]);
            *(v4u*)(rec + 49152 + dv * 128 + q * 16) = w;
        } else {
            const int r = it - 1024, i = r >> 4, s = (r >> 2) & 3, quad = r & 3;
            const f32x4 a = *(const LAS f32x4*)(Lk + i * 132 + 32 * s + 4 * quad), bq = *(const LAS f32x4*)(Lk + i * 132 + 32 * s + 16 + 4 * quad);
            *(v4u*)(rec + i * 256 + (32 * s + 8 * quad) * 2) = pack8(a, bq);
        }
    }
    __syncthreads();
}

DI void ret_prep_unit(Frame& F, int layer, int unit) {
    const int tid = F.tid, lane = F.lane, wave = F.wave, quad = lane >> 4, rl = lane & 15;
    const int b = unit >> 8, h = (unit >> 6) & 3, c = unit & 63;
    const int row0 = b * TP + 128 * c;
    unsigned char* ws = KWS();
    const bf16* Z = (const bf16*)(ws + WS_Z);
    const f32x2* ROT = (const f32x2*)(ws + WS_ROT);
    bf16* QR = (bf16*)(ws + WS_QR); bf16* KR = (bf16*)(ws + WS_KR);
    LAS unsigned char* LK = F.lds; LAS unsigned char* LV = F.lds + 34816;
    const float lg = log1pf(-exp2f(-5.f - (float)h));
    for (int it = tid; it < 1024; it += NTHREADS) {
        const int j = it >> 3, cc = it & 7, d0 = cc * 8;
        const size_t zr = (size_t)(row0 + j) * LDZ + ZC_RQKV + h * 128 + d0;
        f32x4 q1a, q1b, q2a, q2b, k1a, k1b, k2a, k2b;
        unpack8(*(const v4u*)(Z + zr), q1a, q1b); unpack8(*(const v4u*)(Z + zr + 64), q2a, q2b);
        unpack8(*(const v4u*)(Z + zr + 512), k1a, k1b); unpack8(*(const v4u*)(Z + zr + 512 + 64), k2a, k2b);
        const f32x2* rp = ROT + (size_t)(128 * c + j) * 64 + d0;
        const float kd = __expf((float)(127 - j) * lg);
        f32x4 oq1a, oq1b, oq2a, oq2b, ok1a, ok1b, ok2a, ok2b;
#pragma unroll
        for (int e = 0; e < 8; ++e) {
            const f32x2 cs = rp[e];
            const float q1 = e < 4 ? q1a[e & 3] : q1b[e & 3], q2 = e < 4 ? q2a[e & 3] : q2b[e & 3], k1 = e < 4 ? k1a[e & 3] : k1b[e & 3], k2 = e < 4 ? k2a[e & 3] : k2b[e & 3];
            const float rq1 = q1 * cs.x - q2 * cs.y, rq2 = q2 * cs.x + q1 * cs.y, rk1 = (k1 * cs.x - k2 * cs.y) * 0.08838834764831845f, rk2 = (k2 * cs.x + k1 * cs.y) * 0.08838834764831845f;
            if (e < 4) { oq1a[e & 3] = rq1; oq2a[e & 3] = rq2; ok1a[e & 3] = rk1; ok2a[e & 3] = rk2; } else { oq1b[e & 3] = rq1; oq2b[e & 3] = rq2; ok1b[e & 3] = rk1; ok2b[e & 3] = rk2; }
            *(LAS bf16*)(LK + (d0 + e) * 272 + j * 2) = (bf16)f2bf(rk1 * kd); *(LAS bf16*)(LK + (d0 + 64 + e) * 272 + j * 2) = (bf16)f2bf(rk2 * kd);
        }
        const size_t orow = (size_t)(row0 + j) * 512 + h * 128 + d0;
        *(v4u*)(QR + orow) = pack8(oq1a, oq1b); *(v4u*)(QR + orow + 64) = pack8(oq2a, oq2b);
        *(v4u*)(KR + orow) = pack8(ok1a, ok1b); *(v4u*)(KR + orow + 64) = pack8(ok2a, ok2b);
    }
    for (int it = tid; it < 2048; it += NTHREADS) {
        const int j = it >> 4, cc = it & 15;
        const v4u w = *(const v4u*)(Z + (size_t)(row0 + j) * LDZ + ZC_RQKV + 1024 + h * 128 + cc * 8);
        LAS unsigned char* d = LV + (cc * 8) * 272 + j * 2;
        *(LAS bf16*)(d) = (bf16)(w.x & 0xffff); *(LAS bf16*)(d + 272) = (bf16)(w.x >> 16); *(LAS bf16*)(d + 2 * 272) = (bf16)(w.y & 0xffff); *(LAS bf16*)(d + 3 * 272) = (bf16)(w.y >> 16);
        *(LAS bf16*)(d + 4 * 272) = (bf16)(w.z & 0xffff); *(LAS bf16*)(d + 5 * 272) = (bf16)(w.z >> 16); *(LAS bf16*)(d + 6 * 272) = (bf16)(w.w & 0xffff); *(LAS bf16*)(d + 7 * 272) = (bf16)(w.w >> 16);
    }
    __syncthreads();
    float* RKV = (float*)(ws + WS_RKV) + (size_t)unit * 16384;
#pragma unroll
    for (int nt = 0; nt < 8; ++nt) {
        f32x4 acc = (f32x4){0.f, 0.f, 0.f, 0.f};
#pragma unroll
        for (int s = 0; s < 4; ++s) acc = mfma16(ld_frag_l(LK + (16 * wave + rl) * 272 + (32 * s + 8 * quad) * 2), ld_frag_l(LV + (16 * nt + rl) * 272 + (32 * s + 8 * quad) * 2), acc);
#pragma unroll
        for (int i = 0; i < 4; ++i) RKV[(size_t)(16 * wave + 4 * quad + i) * 128 + 16 * nt + rl] = acc[i];
    }
    __syncthreads();
}
DI void sample_rec_unit(Frame& F, int layer, int unit) {
    const int tid = F.tid, lane = F.lane, wave = F.wave;
    const int kind = unit >> 9, s = (unit >> 2) & 127, h = unit & 3;
    const int dv = tid & 127, part = tid >> 7, r0 = MP + 4 * s;
    unsigned char* ws = KWS();
    const bf16* Z = (const bf16*)(ws + WS_Z);
    const float* ZS = (const float*)(ws + WS_ZS);
    LAS float* Lq = (LAS float*)(F.lds); LAS float* Lk = Lq + 512; LAS float* Lv = Lq + 1024; LAS float* red = Lq + 1536; LAS float* Lo = Lq + 2048; LAS float* sc = Lq + 2560;
    float S[32];
    if (kind == 0) {
        if (tid < 384) {
            const int pr = tid >> 7, d = tid & 127, col = pr * 512 + h * 128 + d;
            float xp[7], w[4];
#pragma unroll
            for (int i = 0; i < 3; ++i) xp[i] = KIN(4)[((size_t)(layer * 128 + s) * 3 + i) * 1536 + col];
#pragma unroll
            for (int j = 0; j < 4; ++j) xp[3 + j] = bf2f(Z[(size_t)(r0 + j) * LDZ + ZC_GQKV + col]);
#pragma unroll
            for (int i = 0; i < 4; ++i) w[i] = KIN(15)[(size_t)(layer * 4 + i) * 1536 + col];
            LAS float* dst = pr == 0 ? Lq : pr == 1 ? Lk : Lv;
#pragma unroll
            for (int j = 0; j < 4; ++j) dst[j * 128 + d] = siluf_(w[0] * xp[j] + w[1] * xp[j + 1] + w[2] * xp[j + 2] + w[3] * xp[j + 3]);
        }
        __syncthreads();
        {
            LAS float* vp = (wave < 4 ? Lq : Lk) + (wave & 3) * 128;
            const float a = vp[2 * lane], b = vp[2 * lane + 1];
            const float scl = rsqrtf(wave_sum(a * a + b * b, lane) + EPS) * (wave < 4 ? 0.08838834764831845f : 1.f);
            vp[2 * lane] = a * scl; vp[2 * lane + 1] = b * scl;
        }
        if (tid < 4) {
            const float ga = ZS[(size_t)(r0 + tid) * 32 + 24 + h], gb = ZS[(size_t)(r0 + tid) * 32 + 28 + h];
            sc[tid] = __expf(-__expf(KIN(16)[layer * 4 + h]) * softplusf_(ga + KIN(17)[layer * 4 + h])); sc[4 + tid] = sigmoidf_(gb);
        }
        __syncthreads();
        const float* Sin = KIN(5) + ((size_t)((layer * 128 + s) * 4 + h) * 128 + 32 * part) * 128 + dv;
#pragma unroll
        for (int i = 0; i < 32; ++i) S[i] = Sin[(size_t)i * 128];
#pragma unroll
        for (int j = 0; j < 4; ++j) {
            const float a = sc[j], beta = sc[4 + j];
            float p = 0.f;
#pragma unroll
            for (int i = 0; i < 32; ++i) { S[i] *= a; p += Lk[j * 128 + 32 * part + i] * S[i]; }
            red[part * 128 + dv] = p;
            __syncthreads();
            const float delta = beta * (Lv[j * 128 + dv] - ((red[dv] + red[128 + dv]) + (red[256 + dv] + red[384 + dv])));
            __syncthreads();
            float o = 0.f;
#pragma unroll
            for (int i = 0; i < 32; ++i) { S[i] += Lk[j * 128 + 32 * part + i] * delta; o += Lq[j * 128 + 32 * part + i] * S[i]; }
            red[part * 128 + dv] = o;
            __syncthreads();
            if (part == 0) Lo[j * 128 + dv] = (red[dv] + red[128 + dv]) + (red[256 + dv] + red[384 + dv]);
            __syncthreads();
        }
        float* Sout = KOUT() + O_GSS + ((size_t)((layer * 128 + s) * 4 + h) * 128 + 32 * part) * 128 + dv;
#pragma unroll
        for (int i = 0; i < 32; ++i) Sout[(size_t)i * 128] = S[i];
        ((float*)(ws + WS_OGDN))[(size_t)(r0 + part) * 512 + h * 128 + dv] = Lo[part * 128 + dv];
    } else {
        const f32x2* ROT = (const f32x2*)(ws + WS_ROT);
        if (tid < 384) {
            const int pr = tid >> 7, d = tid & 127;
#pragma unroll
            for (int j = 0; j < 4; ++j) {
                const bf16* zp = Z + (size_t)(r0 + j) * LDZ + ZC_RQKV + pr * 512 + h * 128;
                float v = bf2f(zp[d]);
                if (pr < 2) { const f32x2 cs = ROT[(size_t)(2048 + j) * 64 + (d & 63)]; const float o = bf2f(zp[d ^ 64]);
                    v = (d < 64) ? v * cs.x - o * cs.y : v * cs.x + o * cs.y; if (pr == 1) v *= 0.08838834764831845f; }
                (pr == 0 ? Lq : pr == 1 ? Lk : Lv)[j * 128 + d] = v;
            }
        }
        __syncthreads();
        const float gam = __expf(log1pf(-exp2f(-5.f - (float)h)));
        const float* Sin = KIN(6) + ((size_t)((layer * 128 + s) * 4 + h) * 128 + 32 * part) * 128 + dv;
#pragma unroll
        for (int i = 0; i < 32; ++i) S[i] = Sin[(size_t)i * 128];
#pragma unroll
        for (int j = 0; j < 4; ++j) {
            const float vv = Lv[j * 128 + dv];
            float o = 0.f;
#pragma unroll
            for (int i = 0; i < 32; ++i) { S[i] = S[i] * gam + Lk[j * 128 + 32 * part + i] * vv; o += Lq[j * 128 + 32 * part + i] * S[i]; }
            red[part * 128 + dv] = o;
            __syncthreads();
            if (part == 0) Lo[j * 128 + dv] = (red[dv] + red[128 + dv]) + (red[256 + dv] + red[384 + dv]);
            __syncthreads();
        }
        float* Sout = KOUT() + O_RSS + ((size_t)((layer * 128 + s) * 4 + h) * 128 + 32 * part) * 128 + dv;
#pragma unroll
        for (int i = 0; i < 32; ++i) Sout[(size_t)i * 128] = S[i];
        if (wave < 4) {
            const int j = wave; const float a = Lo[j * 128 + 2 * lane], b = Lo[j * 128 + 2 * lane + 1];
            const float scl = rsqrtf(wave_sum(a * a + b * b, lane) * (1.f / 128.f) + EPS);
            const bf16* gp = Z + (size_t)(r0 + j) * LDZ + ZC_RG + h * 128 + 2 * lane;
            *(unsigned*)((bf16*)(ws + WS_MIX) + (size_t)(r0 + j) * 1536 + 1024 + h * 128 + 2 * lane) = pk2(a * scl * siluf_(bf2f(gp[0])), b * scl * siluf_(bf2f(gp[1])));
        }
    }
    __syncthreads();
}

DI void gdn_scan_chain(Frame& F, int layer, int bh) {
    const int tid = F.tid, lane = F.lane, wave = F.wave, quad = lane >> 4, rl = lane & 15;
    unsigned char* ws = KWS();
    const unsigned char* recb = ws + WS_GREC + (size_t)bh * 128 * GREC;
    LAS unsigned char* L = F.lds;
    constexpr int L_WP = 0, L_QP = 17408, L_KT = 34816, L_UT = 53248, L_QK = 71680;
    f32x4 S[8];
#pragma unroll
    for (int i = 0; i < 8; ++i) S[i] = (f32x4){0.f, 0.f, 0.f, 0.f};
    v4u pf[9]; float egl;
#pragma unroll
    for (int k = 0; k < 9; ++k) pf[k] = *(const v4u*)(recb + (size_t)(tid + 512 * k) * 16);
    egl = *(const float*)(recb + 73728);
    float* OG = (float*)(ws + WS_OGDN);
    const int b = bh >> 2, h = bh & 3;
    for (int c = 0; c < 128; ++c) {
        __syncthreads();
#pragma unroll
        for (int k = 0; k < 9; ++k) {
            const int o = tid * 16 + (k & 1) * 8192;
            const int reg = k >> 1;
            int dst;
            if (reg < 2) dst = (reg == 0 ? L_WP : L_QP) + (o >> 8) * 272 + (o & 255);
            else dst = (reg == 2 ? L_KT : reg == 3 ? L_UT : L_QK) + (o >> 7) * 144 + (o & 127);
            *(LAS v4u*)(L + dst) = pf[k];
        }
        const float eg = egl;
        __syncthreads();
        if (c + 1 < 128) {
            const unsigned char* rn = recb + (size_t)(c + 1) * GREC;
#pragma unroll
            for (int k = 0; k < 9; ++k) pf[k] = *(const v4u*)(rn + (size_t)(tid + 512 * k) * 16);
            egl = *(const float*)(rn + 73728);
        }
        bf16x8 Sb[4];
#pragma unroll
        for (int s = 0; s < 4; ++s) Sb[s] = pack_frag(S[2 * s], S[2 * s + 1]);
        f32x4 vn[4], O[4];
#pragma unroll
        for (int rt = 0; rt < 4; ++rt) {
            f32x4 wsacc = (f32x4){0.f, 0.f, 0.f, 0.f}, o = wsacc;
#pragma unroll
            for (int s = 0; s < 4; ++s) {
                wsacc = mfma16(ld_frag_l(L + L_WP + (16 * rt + rl) * 272 + (32 * s + 8 * quad) * 2), Sb[s], wsacc);
                o = mfma16(ld_frag_l(L + L_QP + (16 * rt + rl) * 272 + (32 * s + 8 * quad) * 2), Sb[s], o);
            }
            const v2u uw = *(const LAS v2u*)(L + L_UT + (16 * wave + rl) * 144 + (16 * rt + 4 * quad) * 2);
            vn[rt][0] = lo_bf(uw.x) - wsacc[0]; vn[rt][1] = hi_bf(uw.x) - wsacc[1]; vn[rt][2] = lo_bf(uw.y) - wsacc[2]; vn[rt][3] = hi_bf(uw.y) - wsacc[3];
            O[rt] = o;
        }
        bf16x8 Vb[2]; Vb[0] = pack_frag(vn[0], vn[1]); Vb[1] = pack_frag(vn[2], vn[3]);
#pragma unroll
        for (int rt = 0; rt < 4; ++rt) {
#pragma unroll
            for (int s2 = 0; s2 < 2; ++s2) O[rt] = mfma16(ld_frag_l(L + L_QK + (16 * rt + rl) * 144 + (32 * s2 + 8 * quad) * 2), Vb[s2], O[rt]);
            const size_t row = (size_t)b * TP + 64 * c + 16 * rt + 4 * quad;
#pragma unroll
            for (int i = 0; i < 4; ++i) OG[(row + i) * 512 + h * 128 + 16 * wave + rl] = O[rt][i];
        }
#pragma unroll
        for (int kt = 0; kt < 8; ++kt) {
            f32x4 a = S[kt] * eg;
#pragma unroll
            for (int s2 = 0; s2 < 2; ++s2) a = mfma16(ld_frag_l(L + L_KT + (16 * kt + rl) * 144 + (32 * s2 + 8 * quad) * 2), Vb[s2], a);
            S[kt] = a;
        }
    }
    float* So = KOUT() + O_GSP + (size_t)(layer * 8 + bh) * 16384;
#pragma unroll
    for (int kt = 0; kt < 8; ++kt)
#pragma unroll
        for (int i = 0; i < 4; ++i) So[(size_t)(16 * kt + 4 * quad + i) * 128 + 16 * wave + rl] = S[kt][i];
    __syncthreads();
}
DI void ret_scan_part(Frame& F, int layer, int r) {
    const int tid = F.tid, bh = r >> 2, dv = tid & 127, dk0 = ((r & 3) * 4 + (tid >> 7)) * 8, h = bh & 3;
    unsigned char* ws = KWS();
    const float* RKV = (const float*)(ws + WS_RKV) + (size_t)bh * 64 * 16384;
    bf16* RST = (bf16*)(ws + WS_RST) + (size_t)bh * 64 * 16384;
    const float cdec = __expf(128.f * log1pf(-exp2f(-5.f - (float)h)));
    float S[8];
#pragma unroll
    for (int i = 0; i < 8; ++i) S[i] = 0.f;
#pragma unroll 4
    for (int c = 0; c < 64; ++c) {
        v4u w; w.x = pk2(S[0], S[1]); w.y = pk2(S[2], S[3]); w.z = pk2(S[4], S[5]); w.w = pk2(S[6], S[7]);
        *(v4u*)(RST + (size_t)c * 16384 + dv * 128 + dk0) = w;
#pragma unroll
        for (int i = 0; i < 8; ++i) S[i] = S[i] * cdec + RKV[(size_t)c * 16384 + (dk0 + i) * 128 + dv];
    }
    float* So = KOUT() + O_RSP + (size_t)(layer * 8 + bh) * 16384;
#pragma unroll
    for (int i = 0; i < 8; ++i) So[(size_t)(dk0 + i) * 128 + dv] = S[i];
}
constexpr float SM_C = 0.125f * 1.4426950408889634f;
struct AttnState { float m, l; f32x4 O[4]; };
DI void attn_reset(AttnState& st) { st.m = -1e30f; st.l = 0.f;
#pragma unroll
    for (int i = 0; i < 4; ++i) st.O[i] = (f32x4){0.f, 0.f, 0.f, 0.f}; }
DI void qk_tile(const LAS unsigned char* Kt, const bf16x8 (&qf)[2], f32x4 (&s)[4], int rl, int quad) {
#pragma unroll
    for (int kt = 0; kt < 4; ++kt) { f32x4 a = (f32x4){0.f, 0.f, 0.f, 0.f};
#pragma unroll
        for (int kk = 0; kk < 2; ++kk) a = mfma16(ld_frag_l(Kt + (16 * kt + rl) * 144 + kk * 64 + quad * 16), qf[kk], a);
        s[kt] = a; }
}
template <class Mask> DI void attn_step(const LAS unsigned char* Kt, const LAS unsigned char* VT, const bf16x8 (&qf)[2], AttnState& st, const Mask& ok, int rl, int quad) {
    f32x4 s[4]; qk_tile(Kt, qf, s, rl, quad);
    float mx = -3e38f;
#pragma unroll
    for (int kt = 0; kt < 4; ++kt)
#pragma unroll
        for (int i = 0; i < 4; ++i) if (ok(16 * kt + 4 * quad + i)) mx = fmaxf(mx, s[kt][i]);
    const int lane = rl + 16 * quad;
    mx = fmaxf(mx, shx<16>(mx, lane)); mx = fmaxf(mx, shx<32>(mx, lane));
    const float mn = fmaxf(st.m, mx);
    const float alpha = exp2f((st.m - mn) * SM_C);
    float ls = 0.f;
#pragma unroll
    for (int kt = 0; kt < 4; ++kt)
#pragma unroll
        for (int i = 0; i < 4; ++i) { const float p = ok(16 * kt + 4 * quad + i) ? exp2f((s[kt][i] - mn) * SM_C) : 0.f; s[kt][i] = p; ls += p; }
    ls += shx<16>(ls, lane); ls += shx<32>(ls, lane);
    st.l = st.l * alpha + ls; st.m = mn;
#pragma unroll
    for (int dt = 0; dt < 4; ++dt) st.O[dt] *= alpha;
#pragma unroll
    for (int ii = 0; ii < 2; ++ii) {
        const bf16x8 pb = pack_frag(s[2 * ii], s[2 * ii + 1]);
#pragma unroll
        for (int dt = 0; dt < 4; ++dt) {
            const LAS unsigned char* vp = VT + (16 * dt + rl) * 144 + (32 * ii + 4 * quad) * 2;
            st.O[dt] = mfma16(mk_frag(*(const LAS v2u*)vp, *(const LAS v2u*)(vp + 32)), pb, st.O[dt]);
        }
    }
}
DI void attn_accum(f32x4 (&Of)[4], const AttnState& st, float gate) {
    const float sc = st.l > 0.f ? gate / st.l : 0.f;
#pragma unroll
    for (int dt = 0; dt < 4; ++dt) Of[dt] += st.O[dt] * sc;
}
DI void vt_write(LAS unsigned char* VT, int d0, int key, const v4u w) {
    LAS unsigned char* d = VT + d0 * 144 + key * 2;
    *(LAS bf16*)(d) = (bf16)(w.x & 0xffff); *(LAS bf16*)(d + 144) = (bf16)(w.x >> 16); *(LAS bf16*)(d + 2 * 144) = (bf16)(w.y & 0xffff); *(LAS bf16*)(d + 3 * 144) = (bf16)(w.y >> 16);
    *(LAS bf16*)(d + 4 * 144) = (bf16)(w.z & 0xffff); *(LAS bf16*)(d + 5 * 144) = (bf16)(w.z >> 16); *(LAS bf16*)(d + 6 * 144) = (bf16)(w.w & 0xffff); *(LAS bf16*)(d + 7 * 144) = (bf16)(w.w >> 16);
}
DI void stage_wg(LAS unsigned char* Kt, LAS unsigned char* VT, const bf16* kb, const bf16* vb, size_t stride, int tid, bool do_v) {
    const int key = tid >> 3, ch = tid & 7;
    *(LAS v4u*)(Kt + key * 144 + ch * 16) = *(const v4u*)(kb + key * stride + ch * 8);
    if (do_v) vt_write(VT, ch * 8, key, *(const v4u*)(vb + key * stride + ch * 8));
}
DI int top16(float v0, float v1, int lane) {
    int sel = 0;
#pragma unroll 1
    for (int r = 0; r < 16; ++r) {
        float bv; int bi;
        if (v0 >= v1) { bv = v0; bi = lane; } else { bv = v1; bi = lane + 64; }
#define T16_STEP(M) { const float ov = shx<M>(bv, lane); const int oi = shxi<M>(bi, lane); const bool take = (ov > bv) || (ov == bv && oi < bi); bv = take ? ov : bv; bi = take ? oi : bi; }
        T16_STEP(32) T16_STEP(16) T16_STEP(8) T16_STEP(4) T16_STEP(2) T16_STEP(1)
#undef T16_STEP
        const bool h0 = (bi == lane), h1 = (bi == lane + 64);
        v0 = h0 ? -3e38f : v0; v1 = h1 ? -3e38f : v1; sel |= (h0 ? 1 : 0) | (h1 ? 2 : 0);
    }
    return sel;
}

DI void nsa_prompt_unit(Frame& F, int layer, int unit) {
    const int tid = F.tid, lane = F.lane, wave = F.wave, quad = lane >> 4, rl = lane & 15;
    const int b = unit >> 9, g = (unit >> 8) & 1, tt = unit & 255, t0 = 32 * tt;
    unsigned char* ws = KWS();
    const bf16* Z = (const bf16*)(ws + WS_Z);
    const float* ZS = (const float*)(ws + WS_ZS);
    LAS unsigned char* Kt = F.lds; LAS unsigned char* VT = F.lds + 9216;
    LAS float* AIMP = (LAS float*)(F.lds + 18432);
    LAS unsigned* SEL = (LAS unsigned*)(F.lds + 83968);
    const int tk = 4 * wave + (rl >> 2), t = t0 + tk, head = 4 * g + (rl & 3);
    const size_t row = (size_t)b * TP + t;
    bf16x8 qf[2];
    qf[0] = ld_frag_g(Z + row * LDZ + ZC_Q + head * 64 + quad * 8); qf[1] = ld_frag_g(Z + row * LDZ + ZC_Q + head * 64 + 32 + quad * 8);
    const float gc = sigmoidf_(ZS[row * 32 + head * 3]), gs = sigmoidf_(ZS[row * 32 + head * 3 + 1]), gw = sigmoidf_(ZS[row * 32 + head * 3 + 2]);
    f32x4 Of[4];
#pragma unroll
    for (int i = 0; i < 4; ++i) Of[i] = (f32x4){0.f, 0.f, 0.f, 0.f};
    AttnState st;
    const int nct = (t0 >> 10) + 1;
    const bf16* KC = (const bf16*)(ws + WS_KC) + ((size_t)(0 * 2 + b) * 512 * 2 + g) * 64;
    const bf16* VC = (const bf16*)(ws + WS_KC) + ((size_t)(1 * 2 + b) * 512 * 2 + g) * 64;
    attn_reset(st);
    for (int jt = 0; jt < nct; ++jt) {
        __syncthreads();
        stage_wg(Kt, VT, KC + (size_t)64 * jt * 128, VC + (size_t)64 * jt * 128, 128, tid, true);
        __syncthreads();
        const int nb = 64 * jt;
        attn_step(Kt, VT, qf, st, [&](int key) { return 16 * (nb + key) + 31 <= t; }, rl, quad);
    }
    attn_accum(Of, st, gc);
    {
        const float mfin = st.m, il = st.l > 0.f ? 1.f / st.l : 0.f;
        for (int jt = 0; jt < nct; ++jt) {
            __syncthreads();
            stage_wg(Kt, VT, KC + (size_t)64 * jt * 128, VC, 128, tid, false);
            __syncthreads();
            f32x4 s[4]; qk_tile(Kt, qf, s, rl, quad);
#pragma unroll
            for (int kt = 0; kt < 4; ++kt)
#pragma unroll
                for (int i = 0; i < 4; ++i) {
                    const int n = 64 * jt + 16 * kt + 4 * quad + i;
                    float p = (16 * n + 31 <= t) ? exp2f((s[kt][i] - mfin) * SM_C) * il : 0.f;
                    p += shx<1>(p, lane); p += shx<2>(p, lane);
                    if ((rl & 3) == 0) AIMP[tk * 512 + n] = p;
                }
        }
    }
    __syncthreads();
    {
        const int nav = nct * 64;
#pragma unroll 1
        for (int q = 0; q < 4; ++q) {
            const int tq = 4 * wave + q, tp = t0 + tq, cur = tp >> 6;
            float sc2[2];
#pragma unroll
            for (int e = 0; e < 2; ++e) {
                const int sblk = lane + 64 * e;
                float imp = 0.f;
#pragma unroll
                for (int d = -1; d <= 3; ++d) { const int n = 4 * sblk + d; if (n >= 0 && n < nav) imp += AIMP[tq * 512 + n]; }
                const bool valid = sblk <= cur, forced = (sblk == 0) || (sblk == cur) || (sblk == cur - 1);
                sc2[e] = valid ? imp + (forced ? 1000.f : 0.f) : -1e30f;
            }
            const int sel = top16(sc2[0], sc2[1], lane);
            const unsigned long long m0 = __ballot((sel & 1) && (lane <= cur)), m1 = __ballot((sel & 2) && (lane + 64 <= cur));
            if (lane == 0) { SEL[tq * 4 + 0] = (unsigned)m0; SEL[tq * 4 + 1] = (unsigned)(m0 >> 32); SEL[tq * 4 + 2] = (unsigned)m1; SEL[tq * 4 + 3] = (unsigned)(m1 >> 32); }
        }
    }
    __syncthreads();
    unsigned un[4], my[4];
#pragma unroll
    for (int w = 0; w < 4; ++w) { unsigned v = (lane < 32) ? SEL[lane * 4 + w] : 0u;
        v |= (unsigned)shxi<1>((int)v, lane); v |= (unsigned)shxi<2>((int)v, lane); v |= (unsigned)shxi<4>((int)v, lane); v |= (unsigned)shxi<8>((int)v, lane); v |= (unsigned)shxi<16>((int)v, lane); v |= (unsigned)shxi<32>((int)v, lane);
        un[w] = __builtin_amdgcn_readfirstlane(v); my[w] = SEL[tk * 4 + w]; }
    attn_reset(st);
#pragma unroll
    for (int w = 0; w < 4; ++w) {
        unsigned word = un[w];
        while (word) {
            const int bit = __builtin_ctz(word); word &= word - 1u;
            const int blk = 32 * w + bit;
            __syncthreads();
            stage_wg(Kt, VT, Z + ((size_t)b * TP + 64 * blk) * LDZ + ZC_KS + g * 64, Z + ((size_t)b * TP + 64 * blk) * LDZ + ZC_VS + g * 64, LDZ, tid, true);
            __syncthreads();
            const bool mine = (my[w] >> bit) & 1u; const int kb = 64 * blk;
            attn_step(Kt, VT, qf, st, [&](int key) { return mine && (kb + key <= t); }, rl, quad);
        }
    }
    attn_accum(Of, st, gs);
    attn_reset(st);
    {
        const int lo = (t0 - 511 > 0 ? t0 - 511 : 0) >> 6, hi = (t0 + 31) >> 6;
        for (int jt = lo; jt <= hi; ++jt) {
            __syncthreads();
            stage_wg(Kt, VT, Z + ((size_t)b * TP + 64 * jt) * LDZ + ZC_KW + g * 64, Z + ((size_t)b * TP + 64 * jt) * LDZ + ZC_VW + g * 64, LDZ, tid, true);
            __syncthreads();
            const int kb = 64 * jt;
            attn_step(Kt, VT, qf, st, [&](int key) { const int kp = kb + key; return kp <= t && kp > t - 512; }, rl, quad);
        }
    }
    attn_accum(Of, st, gw);
    bf16* MIX = (bf16*)(ws + WS_MIX) + row * 1536 + head * 64;
#pragma unroll
    for (int dt = 0; dt < 4; ++dt) { v2u w; w.x = pk2(Of[dt][0], Of[dt][1]); w.y = pk2(Of[dt][2], Of[dt][3]); *(v2u*)(MIX + 16 * dt + 4 * quad) = w; }
    __syncthreads();
}

#define CB() asm volatile("" ::: "memory")
struct SrcF32 { const float* kb; const float* vb; size_t stride; };
struct SrcB16 { const bf16* kb; const bf16* vb; size_t stride; int nvalid; };
DI void stage_wave_f32(LAS unsigned char* Kt, LAS unsigned char* VT, const float* kb, const float* vb, size_t stride, int lane, bool do_v) {
#pragma unroll 2
    for (int it = 0; it < 8; ++it) {
        const int key = it * 8 + (lane >> 3), ch = lane & 7;
        const float* kp = kb + key * stride + ch * 8;
        *(LAS v4u*)(Kt + key * 144 + ch * 16) = pack8(*(const f32x4*)kp, *(const f32x4*)(kp + 4));
        if (do_v) { const float* vp = vb + key * stride + ch * 8; vt_write(VT, ch * 8, key, pack8(*(const f32x4*)vp, *(const f32x4*)(vp + 4))); }
    }
}
DI void stage_wave_b16(LAS unsigned char* Kt, LAS unsigned char* VT, const bf16* kb, const bf16* vb, size_t stride, int nvalid, int lane, bool do_v) {
#pragma unroll 2
    for (int it = 0; it < 8; ++it) {
        const int key = it * 8 + (lane >> 3), ch = lane & 7;
        const bool v = key < nvalid;
        const v4u z = (v4u){0u, 0u, 0u, 0u};
        *(LAS v4u*)(Kt + key * 144 + ch * 16) = v ? *(const v4u*)(kb + key * stride + ch * 8) : z;
        if (do_v) vt_write(VT, ch * 8, key, v ? *(const v4u*)(vb + key * stride + ch * 8) : z);
    }
}
DI void nsa_sample_unit(Frame& F, int layer, int unit) {
    const int lane = F.lane, wave = F.wave, quad = lane >> 4, rl = lane & 15;
    const int s = unit >> 1, g = unit & 1;
    unsigned char* ws = KWS();
    const bf16* Z = (const bf16*)(ws + WS_Z);
    const float* ZS = (const float*)(ws + WS_ZS);
    LAS unsigned char* Kt = F.lds + wave * 18432; LAS unsigned char* VT = Kt + 9216;
    LAS float* AIMP = (LAS float*)VT;
    const int j = rl >> 2, head = 4 * g + (rl & 3), qpos = 2048 + j;
    const size_t row = (size_t)MP + 4 * s + j;
    bf16x8 qf[2];
    qf[0] = ld_frag_g(Z + row * LDZ + ZC_Q + head * 64 + quad * 8); qf[1] = ld_frag_g(Z + row * LDZ + ZC_Q + head * 64 + 32 + quad * 8);
    const float gc = sigmoidf_(ZS[row * 32 + head * 3]), gs = sigmoidf_(ZS[row * 32 + head * 3 + 1]), gw = sigmoidf_(ZS[row * 32 + head * 3 + 2]);
    f32x4 Of[4];
#pragma unroll
    for (int i = 0; i < 4; ++i) Of[i] = (f32x4){0.f, 0.f, 0.f, 0.f};
    AttnState st;
    const bf16* KC = (const bf16*)(ws + WS_KCS) + ((size_t)(0 * 128 + s) * 128 * 2 + g) * 64;
    const bf16* VC = (const bf16*)(ws + WS_KCS) + ((size_t)(1 * 128 + s) * 128 * 2 + g) * 64;
    attn_reset(st);
    for (int jt = 0; jt < 2; ++jt) {
        stage_wave_b16(Kt, VT, KC + (size_t)64 * jt * 128, VC + (size_t)64 * jt * 128, 128, 64, lane, true); CB();
        const int nb = 64 * jt;
        attn_step(Kt, VT, qf, st, [&](int key) { return nb + key <= 126; }, rl, quad); CB();
    }
    attn_accum(Of, st, gc);
    {
        const float mfin = st.m, il = st.l > 0.f ? 1.f / st.l : 0.f;
        for (int jt = 0; jt < 2; ++jt) {
            stage_wave_b16(Kt, VT, KC + (size_t)64 * jt * 128, VC, 128, 64, lane, false); CB();
            f32x4 sv[4]; qk_tile(Kt, qf, sv, rl, quad); CB();
#pragma unroll
            for (int kt = 0; kt < 4; ++kt)
#pragma unroll
                for (int i = 0; i < 4; ++i) {
                    const int n = 64 * jt + 16 * kt + 4 * quad + i;
                    float p = (n <= 126) ? exp2f((sv[kt][i] - mfin) * SM_C) * il : 0.f;
                    p += shx<1>(p, lane); p += shx<2>(p, lane);
                    if ((rl & 3) == 0) AIMP[j * 128 + n] = p;
                }
        }
    }
    CB();
    unsigned long long msk[4];
#pragma unroll
    for (int q = 0; q < 4; ++q) {
        float imp = 0.f;
#pragma unroll
        for (int d = -1; d <= 3; ++d) { const int n = 4 * lane + d; if (n >= 0 && n <= 126 && lane < 33) imp += AIMP[q * 128 + n]; }
        const bool forced = (lane == 0) || (lane == 32) || (lane == 31);
        const float sc = (lane < 33) ? imp + (forced ? 1000.f : 0.f) : -3e38f;
        const int sel = top16(sc, -3e38f, lane);
        msk[q] = __ballot((sel & 1) && lane < 33);
    }
    CB();
    const unsigned long long un = msk[0] | msk[1] | msk[2] | msk[3];
    const unsigned long long mym = j == 0 ? msk[0] : j == 1 ? msk[1] : j == 2 ? msk[2] : msk[3];
    const int* pt = (const int*)KIN(7);
    attn_reset(st);
    {
        unsigned long long word = un;
        while (word) {
            const int blk = __builtin_ctzll(word); word &= word - 1ull;
            if (blk < 32) {
                const int phys = pt[s * 16 + (blk >> 1)];
                const float* base = KIN(2) + ((size_t)(layer * 2560 + phys) * 128 + (blk & 1) * 64) * 512 + g * 64;
                stage_wave_f32(Kt, VT, base + 256, base + 384, 512, lane, true); CB();
            } else {
                stage_wave_b16(Kt, VT, Z + (size_t)(MP + 4 * s) * LDZ + ZC_KS + g * 64, Z + (size_t)(MP + 4 * s) * LDZ + ZC_VS + g * 64, LDZ, 4, lane, true); CB();
            }
            const bool mine = (mym >> blk) & 1ull; const int kb = 64 * blk;
            attn_step(Kt, VT, qf, st, [&](int key) { return mine && (kb + key <= qpos); }, rl, quad); CB();
        }
    }
    attn_accum(Of, st, gs);
    attn_reset(st);
    for (int jt = 0; jt < 9; ++jt) {
        if (jt < 8) { const float* base = KIN(3) + ((size_t)(layer * 128 + s) * 512 + 64 * jt) * 256 + g * 64; stage_wave_f32(Kt, VT, base, base + 128, 256, lane, true); CB(); }
        else stage_wave_b16(Kt, VT, Z + (size_t)(MP + 4 * s) * LDZ + ZC_KW + g * 64, Z + (size_t)(MP + 4 * s) * LDZ + ZC_VW + g * 64, LDZ, 4, lane, true); CB();
        const int wb = 64 * jt;
        attn_step(Kt, VT, qf, st, [&](int key) { const int wi = wb + key; return wi <= 512 + j && wi > j && wi < 516; }, rl, quad); CB();
    }
    attn_accum(Of, st, gw);
    bf16* MIX = (bf16*)(ws + WS_MIX) + row * 1536 + head * 64;
#pragma unroll
    for (int dt = 0; dt < 4; ++dt) { v2u w; w.x = pk2(Of[dt][0], Of[dt][1]); w.y = pk2(Of[dt][2], Of[dt][3]); *(v2u*)(MIX + 16 * dt + 4 * quad) = w; }
}
DI void ret_out_unit(Frame& F, int layer, int unit) {
    const int tid = F.tid, lane = F.lane, wave = F.wave, quad = lane >> 4, rl = lane & 15;
    const int b = unit >> 8, h = (unit >> 6) & 3, c = unit & 63;
    const int row0 = b * TP + 128 * c;
    unsigned char* ws = KWS();
    const bf16* Z = (const bf16*)(ws + WS_Z);
    const bf16* QR = (const bf16*)(ws + WS_QR); const bf16* KR = (const bf16*)(ws + WS_KR);
    const bf16* RST = (const bf16*)(ws + WS_RST) + (size_t)unit * 16384;
    LAS unsigned char* LQ = F.lds; LAS unsigned char* LK = F.lds + 34816; LAS unsigned char* LV = F.lds + 69632; LAS unsigned char* LS = F.lds + 104448;
    for (int it = tid; it < 2048; it += NTHREADS) {
        const int j = it >> 4, cc = it & 15;
        *(LAS v4u*)(LQ + j * 272 + cc * 16) = *(const v4u*)(QR + (size_t)(row0 + j) * 512 + h * 128 + cc * 8);
        *(LAS v4u*)(LK + j * 272 + cc * 16) = *(const v4u*)(KR + (size_t)(row0 + j) * 512 + h * 128 + cc * 8);
        *(LAS v4u*)(LS + j * 272 + cc * 16) = *(const v4u*)(RST + (size_t)j * 128 + cc * 8);
        const v4u w = *(const v4u*)(Z + (size_t)(row0 + j) * LDZ + ZC_RQKV + 1024 + h * 128 + cc * 8);
        LAS unsigned char* d = LV + (cc * 8) * 272 + j * 2;
        *(LAS bf16*)(d) = (bf16)(w.x & 0xffff); *(LAS bf16*)(d + 272) = (bf16)(w.x >> 16); *(LAS bf16*)(d + 2 * 272) = (bf16)(w.y & 0xffff); *(LAS bf16*)(d + 3 * 272) = (bf16)(w.y >> 16);
        *(LAS bf16*)(d + 4 * 272) = (bf16)(w.z & 0xffff); *(LAS bf16*)(d + 5 * 272) = (bf16)(w.z >> 16); *(LAS bf16*)(d + 6 * 272) = (bf16)(w.w & 0xffff); *(LAS bf16*)(d + 7 * 272) = (bf16)(w.w >> 16);
    }
    __syncthreads();
    const float lg = log1pf(-exp2f(-5.f - (float)h));
    const int il = 16 * wave + rl;
    bf16x8 qb[4];
#pragma unroll
    for (int s = 0; s < 4; ++s) qb[s] = ld_frag_l(LQ + il * 272 + (32 * s + 8 * quad) * 2);
    f32x4 C[8];
    const float qdec = __expf((float)(il + 1) * lg);
#pragma unroll
    for (int dt = 0; dt < 8; ++dt) {
        f32x4 a = (f32x4){0.f, 0.f, 0.f, 0.f};
#pragma unroll
        for (int s = 0; s < 4; ++s) a = mfma16(ld_frag_l(LS + (16 * dt + rl) * 272 + (32 * s + 8 * quad) * 2), qb[s], a);
        C[dt] = a * qdec;
    }
    for (int s2 = 0; s2 <= (wave >> 1); ++s2) {
        f32x4 P[2];
#pragma unroll
        for (int e = 0; e < 2; ++e) {
            const int jt = 2 * s2 + e;
            f32x4 a = (f32x4){0.f, 0.f, 0.f, 0.f};
            if (jt <= wave) {
#pragma unroll
                for (int s = 0; s < 4; ++s) a = mfma16(ld_frag_l(LK + (16 * jt + rl) * 272 + (32 * s + 8 * quad) * 2), qb[s], a);
#pragma unroll
                for (int i = 0; i < 4; ++i) { const int jj = 16 * jt + 4 * quad + i; a[i] = (il >= jj) ? a[i] * __expf((float)(il - jj) * lg) : 0.f; }
            }
            P[e] = a;
        }
        const bf16x8 pb = pack_frag(P[0], P[1]);
#pragma unroll
        for (int dt = 0; dt < 8; ++dt) {
            const LAS unsigned char* vp = LV + (16 * dt + rl) * 272 + (32 * s2 + 4 * quad) * 2;
            C[dt] = mfma16(mk_frag(*(const LAS v2u*)vp, *(const LAS v2u*)(vp + 32)), pb, C[dt]);
        }
    }
    float ss = 0.f;
#pragma unroll
    for (int dt = 0; dt < 8; ++dt) ss += (C[dt][0] * C[dt][0] + C[dt][1] * C[dt][1]) + (C[dt][2] * C[dt][2] + C[dt][3] * C[dt][3]);
    ss += shx<16>(ss, lane); ss += shx<32>(ss, lane);
    const float scl = rsqrtf(ss * (1.f / 128.f) + EPS);
    const size_t row = (size_t)row0 + il;
#pragma unroll
    for (int dt = 0; dt < 8; ++dt) {
        const v2u gwd = *(const v2u*)(Z + row * LDZ + ZC_RG + h * 128 + 16 * dt + 4 * quad);
        v2u w; w.x = pk2(C[dt][0] * scl * siluf_(lo_bf(gwd.x)), C[dt][1] * scl * siluf_(hi_bf(gwd.x))); w.y = pk2(C[dt][2] * scl * siluf_(lo_bf(gwd.y)), C[dt][3] * scl * siluf_(hi_bf(gwd.y)));
        *(v2u*)((bf16*)(ws + WS_MIX) + row * 1536 + 1024 + h * 128 + 16 * dt + 4 * quad) = w;
    }
    __syncthreads();
}
DI void gdn_out_row(Frame& F, int layer, int row) {
    const int lane = F.lane;
    unsigned char* ws = KWS();
    const float* o = (const float*)(ws + WS_OGDN) + (size_t)row * 512 + lane * 8;
    const f32x4 a = *(const f32x4*)o, b = *(const f32x4*)(o + 4);
    float ss = (a[0] * a[0] + a[1] * a[1]) + (a[2] * a[2] + a[3] * a[3]) + (b[0] * b[0] + b[1] * b[1]) + (b[2] * b[2] + b[3] * b[3]);
    ss += shx<1>(ss, lane); ss += shx<2>(ss, lane); ss += shx<4>(ss, lane); ss += shx<8>(ss, lane);
    const float scl = rsqrtf(ss * (1.f / 128.f) + EPS);
    const float* ng = KIN(18) + layer * 128 + (lane & 15) * 8;
    const f32x4 ga = *(const f32x4*)ng, gb = *(const f32x4*)(ng + 4);
    f32x4 za, zb; unpack8(*(const v4u*)((const bf16*)(ws + WS_Z) + (size_t)row * LDZ + ZC_GZ + lane * 8), za, zb);
    f32x4 ra, rb;
#pragma unroll
    for (int e = 0; e < 4; ++e) { ra[e] = a[e] * scl * ga[e] * siluf_(za[e]); rb[e] = b[e] * scl * gb[e] * siluf_(zb[e]); }
    *(v4u*)((bf16*)(ws + WS_MIX) + (size_t)row * 1536 + 512 + lane * 8) = pack8(ra, rb);
}
DI void final_row(Frame& F, int row) {
    const int lane = F.lane;
    const float* x = (const float*)(KWS() + WS_XR) + (size_t)row * DM;
    float* y = (row < MP) ? KOUT() + O_YP + (size_t)row * DM : KOUT() + O_YS + (size_t)(row - MP) * DM;
    f32x4 v[4]; float ss = 0.f;
#pragma unroll
    for (int j = 0; j < 4; ++j) { v[j] = *(const f32x4*)(x + 256 * j + lane * 4); ss += (v[j][0] * v[j][0] + v[j][1] * v[j][1]) + (v[j][2] * v[j][2] + v[j][3] * v[j][3]); }
    const float scl = rsqrtf(wave_sum(ss, lane) * (1.f / DM) + EPS);
#pragma unroll
    for (int j = 0; j < 4; ++j) *(f32x4*)(y + 256 * j + lane * 4) = v[j] * scl * *(const f32x4*)(KIN(26) + 256 * j + lane * 4);
}
#ifndef PH_P0
#define PH_P0 1
#endif
#ifndef PH_A
#define PH_A 1
#endif
#ifndef PH_B0a
#define PH_B0a 1
#endif
#ifndef PH_B0b
#define PH_B0b 1
#endif
#ifndef PH_B0c
#define PH_B0c 1
#endif
#ifndef PH_B0d
#define PH_B0d 1
#endif
#ifndef PH_SCAN
#define PH_SCAN 1
#endif
#ifndef PH_RSCAN
#define PH_RSCAN 1
#endif
#ifndef PH_NSAP
#define PH_NSAP 1
#endif
#ifndef PH_NSAS
#define PH_NSAS 1
#endif
#ifndef PH_B2
#define PH_B2 1
#endif
#ifndef PH_C
#define PH_C 1
#endif
#ifndef PH_D
#define PH_D 1
#endif
#ifndef PH_E
#define PH_E 1
#endif
#ifndef PH_F
#define PH_F 1
#endif
#ifndef PH_G1
#define PH_G1 1
#endif
#ifndef PH_G2
#define PH_G2 1
#endif
struct Args { const void* in[27]; float* out; unsigned char* ws; };
__global__ void __launch_bounds__(NTHREADS, 2) mk_fwd(Args args) {
    extern __shared__ __attribute__((aligned(16))) unsigned char lds_raw[];
    Frame F;
    F.lds = (LAS unsigned char*)lds_raw;
    F.wave = __builtin_amdgcn_readfirstlane((int)threadIdx.x >> 6); F.lane = 0; F.tid = 0;
    F.G = gridDim.x; F.bid = blockIdx.x;
    F.ctl = (gu32*)(KWS() + WS_CTL);
    { const Frame Fp = fresh(F); for (int u = Fp.tid; u < (LDS_BYTES - LDSCTL_OFF) / 4; u += NTHREADS) ((LAS unsigned*)(F.lds + LDSCTL_OFF))[u] = 0u;
      __syncthreads();
      (void)xcd_barrier_post((unsigned*)(F.ctl + CW_BAR), (volatile LAS unsigned*)(F.lds + MISC_OFF) + 8, Fp.tid == 0); }
    const int G = F.G, bid = F.bid;

#if PH_P0
    { Frame Fp = fresh(F); p0_prologue(Fp); }
#endif
    GRID_BAR();

    for (int layer = 0; layer < NLAYER; ++layer) {
#if PH_A
        {
            const Frame Fg = fresh(F); const int G = Fg.G, bid = Fg.bid;
            unsigned char* ws = KWS();
            pg8::Gemm g{(const bf16*)(ws + WS_XGA), (const bf16*)(ws + WS_WIN + layer * SZ_WIN), MROWS, LDZ, DM, DM, DM, 31, 0};
            pg8::StaticOrder S; S.init(MROWS, LDZ, G, bid);
            epi::EpiA E{(bf16*)(ws + WS_Z), (float*)(ws + WS_ZS), (const float*)(ws + WS_SSA), KOUT(), layer};
            pg8::gemm_phase<epi::EpiA, pg8::StaticOrder, true, true>(Fg.lds, g, S, E, Fg.tid);
        }
#endif
        GRID_BAR();
#if PH_B0a
        { Frame Fp = fresh(F); for (int u = Fp.bid; u < 1024; u += Fp.G) gdn_prep_unit(Fp, layer, u); }
#endif
#if PH_B0b
        { Frame Fp = fresh(F); for (int u = Fp.bid; u < 512; u += Fp.G) ret_prep_unit(Fp, layer, u); }
#endif
#if PH_B0c
        { Frame Fp = fresh(F); for (int u = Fp.bid; u < 1024; u += Fp.G) sample_rec_unit(Fp, layer, u); }
#endif
#if PH_B0d
        { Frame Fp = fresh(F); for (int t = Fp.bid * NWAVES + Fp.wave; t < 256 + 4096; t += Fp.G * NWAVES) compress_task(Fp, layer, t); }
#endif
        GRID_BAR();
        {
            const Frame Fq = fresh(F); const int G = Fq.G, bid = Fq.bid;
            const bool split = G >= 64;
#if PH_SCAN
            if (bid < 8) { Frame Fp = fresh(F); gdn_scan_chain(Fp, layer, Fp.bid); }
#endif
#if PH_RSCAN
            if (bid >= 8 && bid < 40) { Frame Fp = fresh(F); ret_scan_part(Fp, layer, Fp.bid - 8); }
#endif
            const int vb = split ? bid - 40 : bid, NV = split ? G - 40 : G;
            if (vb >= 0) {
#if PH_NSAP
                { Frame Fp = fresh(F); for (int u = vb; u < 1024; u += NV) nsa_prompt_unit(Fp, layer, u); }
#endif
                __syncthreads();
#if PH_NSAS
                { Frame Fp = fresh(F); for (int u = vb * NWAVES + Fp.wave; u < 256; u += NV * NWAVES) { nsa_sample_unit(Fp, layer, u); asm volatile("" ::: "memory"); } }
#endif
            }
        }
        GRID_BAR();
#if PH_B2
        { Frame Fp = fresh(F); for (int u = Fp.bid; u < 512; u += Fp.G) ret_out_unit(Fp, layer, u); }
        { Frame Fp = fresh(F); for (int r = Fp.bid * NWAVES + Fp.wave; r < MROWS; r += Fp.G * NWAVES) gdn_out_row(Fp, layer, r); }
#endif
        GRID_BAR();
#if PH_C
        {
            const Frame Fg = fresh(F); const int G = Fg.G, bid = Fg.bid;
            unsigned char* ws = KWS();
            pg8::Gemm g{(const bf16*)(ws + WS_MIX), (const bf16*)(ws + WS_WBR + layer * SZ_WBR), MROWS, 3072, 512, 1536, 512, 2, 1024};
            pg8::StaticOrder S; S.init(MROWS, 3072, G, bid);
            epi::EpiC E{(const bf16*)(ws + WS_Z), (bf16*)(ws + WS_GATED)};
            pg8::gemm_phase<epi::EpiC, pg8::StaticOrder, true, true>(Fg.lds, g, S, E, Fg.tid);
        }
#endif
        GRID_BAR();
#if PH_D
        {
            const Frame Fg = fresh(F); const int G = Fg.G, bid = Fg.bid;
            unsigned char* ws = KWS();
            pg8::Gemm g{(const bf16*)(ws + WS_GATED), (const bf16*)(ws + WS_WO3 + layer * SZ_WO3), MROWS, DM, 3072, 3072, 3072, 31, 0};
            pg8::StaticOrder S; S.init(MROWS, DM, G, bid);
            epi::EpiRes E{(float*)(ws + WS_XR), (bf16*)(ws + WS_XGB), KIN(21) + layer * DM, (float*)(ws + WS_SSB), nullptr, 0};
            pg8::gemm_phase<epi::EpiRes, pg8::StaticOrder, true, true>(Fg.lds, g, S, E, Fg.tid);
        }
#endif
        GRID_BAR();
#if PH_E
        {
            const Frame Fg = fresh(F); const int G = Fg.G, bid = Fg.bid;
            unsigned char* ws = KWS();
            pg8::Gemm g{(const bf16*)(ws + WS_XGB), (const bf16*)(ws + WS_WUP + layer * SZ_WUP), MROWS, DFF, DM, DM, DM, 31, 0};
            pg8::StaticOrder S; S.init(MROWS, DFF, G, bid);
            epi::EpiUp E{(bf16*)(ws + WS_HMID), (const float*)(ws + WS_SSB)};
            pg8::gemm_phase<epi::EpiUp, pg8::StaticOrder, true, true>(Fg.lds, g, S, E, Fg.tid);
        }
#endif
        GRID_BAR();
#if PH_F
        {
            const Frame Fg = fresh(F); const int G = Fg.G, bid = Fg.bid;
            unsigned char* ws = KWS();
            pg8::Gemm g{(const bf16*)(ws + WS_HMID), (const bf16*)(ws + WS_WDN + layer * SZ_WDN), MROWS, DM, DFF, DFF, DFF, 31, 0};
            pg8::StaticOrder S; S.init(MROWS, DM, G, bid);
            epi::EpiRes E{(float*)(ws + WS_XR), (bf16*)(ws + WS_XGC), nullptr, nullptr, nullptr, 0};
            pg8::gemm_phase<epi::EpiRes, pg8::StaticOrder, true, true>(Fg.lds, g, S, E, Fg.tid);
        }
#endif
        GRID_BAR();
#if PH_G1
        {
            const Frame Fg = fresh(F); const int G = Fg.G, bid = Fg.bid;
            unsigned char* ws = KWS();
            int kple = PLE; asm volatile("" : "+s"(kple));
            pg8::Gemm g{(const bf16*)(ws + WS_P16) + (size_t)layer * MROWS * PLE, (const bf16*)(ws + WS_WPL + layer * SZ_WPL), MROWS, DM, kple, PLE, PLE, 31, 0};
            pg8::StaticOrder S; S.init(MROWS, DM, G, bid);
            epi::EpiRes E{nullptr, nullptr, nullptr, nullptr, (float*)(ws + WS_TPLE), 1};
            pg8::gemm_phase<epi::EpiRes, pg8::StaticOrder, true, true>(Fg.lds, g, S, E, Fg.tid);
        }
#endif
#if PH_G2
        {
            const Frame Fg = fresh(F); const int G = Fg.G, bid = Fg.bid;
            unsigned char* ws = KWS();
            const bool more = layer + 1 < NLAYER;
            pg8::Gemm g{(const bf16*)(ws + WS_XGC), (const bf16*)(ws + WS_WPG + layer * SZ_WPG), MROWS, DM, DM, DM, DM, 31, 0};
            pg8::StaticOrder S; S.init(MROWS, DM, G, bid);
            epi::EpiRes E{(float*)(ws + WS_XR), more ? (bf16*)(ws + WS_XGA) : nullptr, more ? KIN(10) + (layer + 1) * DM : nullptr, more ? (float*)(ws + WS_SSA) : nullptr, (float*)(ws + WS_TPLE), 2};
            pg8::gemm_phase<epi::EpiRes, pg8::StaticOrder, true, true>(Fg.lds, g, S, E, Fg.tid);
        }
#endif
        GRID_BAR();
    }
    { Frame Fp = fresh(F); for (int r = Fp.bid * NWAVES + Fp.wave; r < MROWS; r += Fp.G * NWAVES) final_row(Fp, r); }
}

extern "C" void kernel_launch(void* const* d_in, const int* in_sizes, int n_in, void* d_out, int out_size, void* d_ws, size_t ws_size, hipStream_t stream) {
    static int grid = 0;
    if (grid == 0) {
        if (n_in != 27 || ws_size < WS_END) { fprintf(stderr, "kernel_launch: unexpected shapes (n_in %d out %d ws %zu, need %zu)\n", n_in, out_size, ws_size, (size_t)WS_END); grid = -1; return; }
        int dev = 0, cus = 0;
        if (hipGetDevice(&dev) != hipSuccess || hipDeviceGetAttribute(&cus, hipDeviceAttributeMultiprocessorCount, dev) != hipSuccess) { grid = -1; return; }
        if (hipFuncSetAttribute((const void*)mk_fwd, hipFuncAttributeMaxDynamicSharedMemorySize, LDS_BYTES) != hipSuccess) { fprintf(stderr, "kernel_launch: hipFuncSetAttribute failed\n"); grid = -1; return; }
        int per_cu = 0;
        if (hipOccupancyMaxActiveBlocksPerMultiprocessor(&per_cu, (const void*)mk_fwd, NTHREADS, LDS_BYTES) != hipSuccess || per_cu < 1) fprintf(stderr, "kernel_launch: occupancy query reports %d\n", per_cu);
        (void)hipGetLastError();
        grid = cus;
    }
    if (grid < 0) return;
    if (hipMemsetAsync((char*)d_ws + WS_CTL, 0, CTL_ZERO_BYTES, stream) != hipSuccess) return;
    Args a{};
    for (int i = 0; i < 27; ++i) a.in[i] = d_in[i];
    a.out = (float*)d_out; a.ws = (unsigned char*)d_ws;
    hipLaunchKernelGGL(mk_fwd, dim3(grid), dim3(NTHREADS), LDS_BYTES, stream, a);
}
```

```cpp
#include <hip/hip_runtime.h>
#include <cstdio>
#include <cstdint>
namespace pg8 {
#define PG8_LAS __attribute__((address_space(3)))
typedef unsigned short bf16_t;
typedef short bf16x8 __attribute__((ext_vector_type(8)));
typedef float f32x4 __attribute__((ext_vector_type(4)));
typedef unsigned u32x4 __attribute__((ext_vector_type(4)));
constexpr int BM = 256, BK = 64, HALF = 128, HTB = HALF * BK * 2  , STAGE_BYTES = 8 * HTB, NXCD = 8, WGM = 8;

__host__ __device__ __forceinline__ int lds_byte(int r, int c) { const int st = (r >> 4) * 2 + (c >> 5), rr = r & 15, cc = c & 31, ob = rr * 64 + cc * 2; return st * 1024 + (ob ^ (((ob >> 9) & 1) << 5)); }
__host__ __device__ __forceinline__ void stage_rc(int b, int& R, int& C) { const int st = b / 1024, sb = b % 1024, swz = sb ^ (((sb >> 9) & 1) << 5); R = (st >> 1) * 16 + swz / 64; C = (st & 1) * 32 + (swz % 64) / 2; }
__host__ __device__ __forceinline__ int perm32(int rho) { const int n = rho >> 4, i = rho & 15; return 8 * (i >> 2) + 4 * n + (i & 3); }

struct Unit { int pm, pn; };
struct Gemm { const bf16_t* A; const bf16_t* Bt; int M, N, K; int lda, ldb; int a_shift, a_off; };

struct StaticOrder {
    int nM, nN, nwg, G, c;
    __host__ __device__ void init(int M, int N, int G_, int c_) { nM = M / BM; nN = N / BM; nwg = nM * nN; G = G_; c = c_; }
    __host__ __device__ bool next(int i, Unit& u) const {
        const long L = (long)i * G + c; if (L >= nwg) return false;
        int wgid = (int)L; { const int q = nwg / NXCD, r = nwg % NXCD, xcd = wgid % NXCD, off = wgid / NXCD; wgid = (xcd < r ? xcd * (q + 1) : r * (q + 1) + (xcd - r) * q) + off; }
        const int nig = WGM * nN, gid = wgid / nig, fm = gid * WGM, gsz = (nM - fm) < WGM ? (nM - fm) : WGM;
        u.pm = fm + ((wgid % nig) % gsz); u.pn = (wgid % nig) / gsz; return true;
    }
    __device__ __forceinline__ void a_ready(const Unit&) const {}
    __device__ __forceinline__ void done(const Unit&) const {}
};

__device__ __forceinline__ unsigned cvt_pk_bf16(float lo, float hi) { unsigned r; asm volatile("v_cvt_pk_bf16_f32 %0, %1, %2" : "=v"(r) : "v"(lo), "v"(hi)); return r; }
typedef float f32x2 __attribute__((ext_vector_type(2)));
template <class Epi, class Sched, bool ALIGN_EPI = false, bool SP2 = false>
__device__ __forceinline__ void gemm_phase(PG8_LAS unsigned char* lds, const Gemm g, const Sched& S, const Epi& E, const int tid) {
    const int wid = __builtin_amdgcn_readfirstlane(tid >> 6), lane = tid & 63, wr = wid >> 2, wc = wid & 3, fr = lane & 15, fq = lane >> 4;
    const int K = g.K, nt = K / BK;
    unsigned voffA[2], voffB[2];
#pragma unroll
    for (int i = 0; i < 2; ++i) { int R, C; stage_rc(tid * 16 + i * 8192, R, C); const int Rb = Epi::PERM ? ((R & ~31) + perm32(R & 31)) : R;
        voffA[i] = (unsigned)(R * g.lda + C) * 2u; voffB[i] = (unsigned)(Rb * g.ldb + C) * 2u; }
    const size_t kstep = (size_t)(BK * 2);
    const size_t hstepA = (size_t)HALF * g.lda * 2, hstepB = (size_t)HALF * g.ldb * 2;
    const size_t tstepA = 2 * hstepA, tstepB = 2 * hstepB;
    const unsigned ldsw = (unsigned)wid * 1024u;
    const int aoff = lds_byte(wr * 64 + fr, fq * 8), boff = lds_byte(wc * 32 + fr, fq * 8);
#define PG8_SA(b, h) (((b) * 2 + (h)) * HTB)
#define PG8_SB(b, h) ((4 + (b) * 2 + (h)) * HTB)
#define PG8_STAGE(bufoff, gbase, voff) do { _Pragma("unroll") for (int _i = 0; _i < 2; ++_i) \
        __builtin_amdgcn_global_load_lds((const unsigned*)((const char*)(gbase) + (voff)[_i]), (PG8_LAS unsigned*)(lds + (bufoff) + ldsw + _i * 8192), 16, 0, 0); } while (0)
#define PG8_LDA(dst, b, h) do { _Pragma("unroll") for (int m = 0; m < 4; ++m) _Pragma("unroll") for (int k = 0; k < 2; ++k) dst[m][k] = *(const PG8_LAS bf16x8*)(lds + PG8_SA(b, h) + aoff + m * 2048 + k * 1024); } while (0)
#define PG8_LDB(dst, b, h) do { _Pragma("unroll") for (int n = 0; n < 2; ++n) _Pragma("unroll") for (int k = 0; k < 2; ++k) dst[n][k] = *(const PG8_LAS bf16x8*)(lds + PG8_SB(b, h) + boff + n * 2048 + k * 1024); } while (0)
#define PG8_MMA(ai, bj, At, Bt) do { __builtin_amdgcn_s_setprio(1); _Pragma("unroll") for (int m = 0; m < 4; ++m) _Pragma("unroll") for (int n = 0; n < 2; ++n) _Pragma("unroll") for (int k = 0; k < 2; ++k) \
        acc[ai][bj][m][n] = __builtin_amdgcn_mfma_f32_16x16x32_bf16(Bt[n][k], At[m][k], acc[ai][bj][m][n], 0, 0, 0); __builtin_amdgcn_s_setprio(0); } while (0)
#define PG8_WAIT_V(n) asm volatile("s_waitcnt vmcnt(" #n ")" ::: "memory")
#define PG8_WAIT_L(n) asm volatile("s_waitcnt lgkmcnt(" #n ")" ::: "memory")
#define PG8_BAR __builtin_amdgcn_s_barrier()
#define PG8_SCHED __builtin_amdgcn_sched_barrier(0)
    Unit cur, nxt; int ui = 0;
    if (!S.next(0, cur)) return;
    f32x4 acc[2][2][4][2];
#pragma unroll
    for (int a = 0; a < 2; ++a)
#pragma unroll
        for (int b = 0; b < 2; ++b)
#pragma unroll
            for (int m = 0; m < 4; ++m)
#pragma unroll
                for (int n = 0; n < 2; ++n) acc[a][b][m][n] = (f32x4){0.f, 0.f, 0.f, 0.f};
    bf16x8 At[4][2], B0[2][2], B1[2][2];
    const char* cA = (const char*)g.A + (size_t)cur.pm * tstepA + (size_t)(cur.pn >> g.a_shift) * (size_t)g.a_off; const char* cB = (const char*)g.Bt + (size_t)cur.pn * tstepB;
    S.a_ready(cur);
    if constexpr (SP2) {
        PG8_STAGE(PG8_SB(0, 0), cB, voffB); PG8_STAGE(PG8_SB(0, 1), cB + hstepB, voffB); PG8_STAGE(PG8_SA(0, 0), cA, voffA); PG8_STAGE(PG8_SA(0, 1), cA + hstepA, voffA);
        if (wr == 1) PG8_BAR;
        PG8_WAIT_V(2); PG8_BAR;
        PG8_STAGE(PG8_SB(1, 0), cB + kstep, voffB); PG8_STAGE(PG8_SA(1, 0), cA + kstep, voffA); PG8_STAGE(PG8_SB(1, 1), cB + hstepB + kstep, voffB);
        PG8_WAIT_V(6); PG8_BAR;
    } else {
        PG8_STAGE(PG8_SB(0, 0), cB, voffB); PG8_STAGE(PG8_SA(0, 0), cA, voffA); PG8_STAGE(PG8_SB(0, 1), cB + hstepB, voffB); PG8_STAGE(PG8_SA(0, 1), cA + hstepA, voffA);
        if (wr == 1) PG8_BAR;
        PG8_WAIT_V(4); PG8_BAR;
        PG8_STAGE(PG8_SB(1, 0), cB + kstep, voffB); PG8_STAGE(PG8_SA(1, 0), cA + kstep, voffA); PG8_STAGE(PG8_SB(1, 1), cB + hstepB + kstep, voffB);
        PG8_WAIT_V(6); PG8_BAR;
    }
    for (;;) {
        const bool has_next = S.next(ui + 1, nxt);
        const char* nA = has_next ? (const char*)g.A + (size_t)nxt.pm * tstepA + (size_t)(nxt.pn >> g.a_shift) * (size_t)g.a_off : cA; const char* nB = has_next ? (const char*)g.Bt + (size_t)nxt.pn * tstepB : cB;
        for (int t = 0; t < nt; t += 2) {
            const bool last = (t == nt - 2);
            const char* a1 = cA + (size_t)(t + 1) * kstep;
            const char* a2 = last ? nA : cA + (size_t)(t + 2) * kstep; const char* b2 = last ? nB : cB + (size_t)(t + 2) * kstep;
            const char* a3 = a2 + kstep; const char* b3 = b2 + kstep;
            if (last && has_next) S.a_ready(nxt);
            if constexpr (SP2) {
            PG8_LDB(B0, 0, 0); PG8_LDB(B1, 0, 1); PG8_SCHED; PG8_LDA(At, 0, 0); PG8_STAGE(PG8_SA(1, 1), a1 + hstepA, voffA);
            PG8_WAIT_V(8); PG8_WAIT_L(0); PG8_BAR; PG8_MMA(0, 0, At, B0); PG8_MMA(0, 1, At, B1); PG8_BAR; PG8_SCHED;
            PG8_LDA(At, 0, 1); PG8_STAGE(PG8_SB(0, 0), b2, voffB); PG8_STAGE(PG8_SB(0, 1), b2 + hstepB, voffB); PG8_STAGE(PG8_SA(0, 0), a2, voffA);
            PG8_WAIT_V(8); PG8_WAIT_L(0); PG8_BAR; PG8_MMA(1, 0, At, B0); PG8_MMA(1, 1, At, B1); PG8_BAR; PG8_SCHED;
            PG8_LDB(B0, 1, 0); PG8_LDB(B1, 1, 1); PG8_SCHED; PG8_LDA(At, 1, 0); PG8_STAGE(PG8_SA(0, 1), a2 + hstepA, voffA);
            PG8_WAIT_V(8); PG8_WAIT_L(0); PG8_BAR; PG8_MMA(0, 0, At, B0); PG8_MMA(0, 1, At, B1); PG8_BAR; PG8_SCHED;
            PG8_LDA(At, 1, 1); PG8_STAGE(PG8_SB(1, 0), b3, voffB); PG8_STAGE(PG8_SB(1, 1), b3 + hstepB, voffB); PG8_STAGE(PG8_SA(1, 0), a3, voffA);
            PG8_WAIT_V(8); PG8_WAIT_L(0); PG8_BAR; PG8_MMA(1, 0, At, B0); PG8_MMA(1, 1, At, B1); PG8_BAR; PG8_SCHED;
            } else {
            PG8_LDB(B0, 0, 0); PG8_SCHED; PG8_LDA(At, 0, 0); PG8_STAGE(PG8_SA(1, 1), a1 + hstepA, voffA);
            PG8_WAIT_L(8); PG8_BAR; PG8_WAIT_L(0); PG8_MMA(0, 0, At, B0); PG8_BAR; PG8_SCHED;
            PG8_LDB(B1, 0, 1); PG8_STAGE(PG8_SB(0, 0), b2, voffB);
            PG8_BAR; PG8_WAIT_L(0); PG8_MMA(0, 1, At, B1); PG8_BAR;
            PG8_LDA(At, 0, 1); PG8_STAGE(PG8_SA(0, 0), a2, voffA);
            PG8_BAR; PG8_WAIT_L(0); PG8_MMA(1, 0, At, B0); PG8_BAR; PG8_SCHED;
            PG8_STAGE(PG8_SB(0, 1), b2 + hstepB, voffB);
            PG8_WAIT_V(6); PG8_BAR; PG8_MMA(1, 1, At, B1); PG8_BAR;
            PG8_LDB(B0, 1, 0); PG8_SCHED; PG8_LDA(At, 1, 0); PG8_STAGE(PG8_SA(0, 1), a2 + hstepA, voffA);
            PG8_WAIT_L(8); PG8_BAR; PG8_WAIT_L(0); PG8_MMA(0, 0, At, B0); PG8_BAR; PG8_SCHED;
            PG8_LDB(B1, 1, 1); PG8_STAGE(PG8_SB(1, 0), b3, voffB);
            PG8_BAR; PG8_WAIT_L(0); PG8_MMA(0, 1, At, B1); PG8_BAR;
            PG8_LDA(At, 1, 1); PG8_STAGE(PG8_SA(1, 0), a3, voffA);
            PG8_BAR; PG8_WAIT_L(0); PG8_MMA(1, 0, At, B0); PG8_BAR; PG8_SCHED;
            PG8_STAGE(PG8_SB(1, 1), b3 + hstepB, voffB);
            PG8_WAIT_V(6); PG8_BAR; PG8_MMA(1, 1, At, B1); PG8_BAR;
            }
        }
        if constexpr (ALIGN_EPI) { if (wr == 0) PG8_BAR; }
        if constexpr (!Epi::AFTER_DRAIN) { E(acc, cur, wr, wc, fr, fq); S.done(cur); }
        if (!has_next) break;
#pragma unroll
        for (int a = 0; a < 2; ++a)
#pragma unroll
            for (int b = 0; b < 2; ++b)
#pragma unroll
                for (int m = 0; m < 4; ++m)
#pragma unroll
                    for (int n = 0; n < 2; ++n) acc[a][b][m][n] = (f32x4){0.f, 0.f, 0.f, 0.f};
        cur = nxt; cA = nA; cB = nB; ++ui;
        if constexpr (ALIGN_EPI) { if (wr == 1) PG8_BAR; }
    }
    PG8_WAIT_V(0);
    if constexpr (!ALIGN_EPI) { if (wr == 0) PG8_BAR; }
    PG8_BAR;
    if constexpr (Epi::AFTER_DRAIN) { E.fused(acc, cur, wr, wc, fr, fq, lds, wid, lane); S.done(cur); }
#undef PG8_SA
#undef PG8_SB
#undef PG8_STAGE
#undef PG8_LDA
#undef PG8_LDB
#undef PG8_MMA
#undef PG8_WAIT_V
#undef PG8_WAIT_L
#undef PG8_BAR
#undef PG8_SCHED
}
}
#define DI __device__ __forceinline__
#define GAS __attribute__((address_space(1)))
#define LAS __attribute__((address_space(3)))
typedef unsigned short bf16;
typedef unsigned v4u __attribute__((ext_vector_type(4)));
typedef unsigned v2u __attribute__((ext_vector_type(2)));
typedef float f32x4 __attribute__((ext_vector_type(4)));
typedef float f32x2 __attribute__((ext_vector_type(2)));
typedef short bf16x8 __attribute__((ext_vector_type(8)));
typedef short s16x4 __attribute__((ext_vector_type(4)));
typedef GAS unsigned gu32;

constexpr int DM = 1024, TP = 8192, MP = 16384, MS = 512, MROWS = 16896, LDZ = 8704, DFF = 4096, PLE = 256, NLAYER = 2;
constexpr int ZC_Q = 0, ZC_KC = 512, ZC_VC = 640, ZC_KS = 768, ZC_VS = 896, ZC_KW = 1024, ZC_VW = 1152, ZC_GQKV = 1280, ZC_GZ = 2816, ZC_RQKV = 3328, ZC_RG = 4864, ZC_MG = 5376, ZC_SM = 8448;
constexpr float EPS = 1e-6f;
constexpr size_t O_YP = 0, O_YS = O_YP + (size_t)MP * DM, O_KVP = O_YS + (size_t)MS * DM, O_KVS = O_KVP + (size_t)2 * MP * 512, O_WINP = O_KVS + (size_t)2 * MS * 512,
                 O_WINS = O_WINP + (size_t)2 * 2 * 512 * 256, O_CVP = O_WINS + (size_t)2 * 128 * 512 * 256, O_CVS = O_CVP + (size_t)2 * 2 * 3 * 1536, O_GSP = O_CVS + (size_t)2 * 128 * 3 * 1536,
                 O_GSS = O_GSP + (size_t)2 * 2 * 4 * 16384, O_RSP = O_GSS + (size_t)2 * 128 * 4 * 16384, O_RSS = O_RSP + (size_t)2 * 2 * 4 * 16384, O_END = O_RSS + (size_t)2 * 128 * 4 * 16384;

DI float bf2f(unsigned short b) { return __uint_as_float((unsigned)b << 16); }
DI unsigned f2bf(float f) { unsigned u = __float_as_uint(f); return (u + 0x7fffu + ((u >> 16) & 1u)) >> 16; }
DI unsigned pk2(float lo, float hi) { return f2bf(lo) | (f2bf(hi) << 16); }
DI float lo_bf(unsigned w) { return __uint_as_float(w << 16); }
DI float hi_bf(unsigned w) { return __uint_as_float(w & 0xffff0000u); }
DI float sigmoidf_(float x) { return 1.f / (1.f + __expf(-x)); }
DI float siluf_(float x) { return x / (1.f + __expf(-x)); }
DI v4u pack8(const f32x4 a, const f32x4 b) { v4u w; w.x = pk2(a[0], a[1]); w.y = pk2(a[2], a[3]); w.z = pk2(b[0], b[1]); w.w = pk2(b[2], b[3]); return w; }
DI void unpack8(const v4u w, f32x4& a, f32x4& b) { a[0] = lo_bf(w.x); a[1] = hi_bf(w.x); a[2] = lo_bf(w.y); a[3] = hi_bf(w.y); b[0] = lo_bf(w.z); b[1] = hi_bf(w.z); b[2] = lo_bf(w.w); b[3] = hi_bf(w.w); }

template <int M> DI int shxi(int v, int lane) {
    if constexpr (M < 32) return __builtin_amdgcn_ds_swizzle(v, (M << 10) | 0x1f);
    else return __builtin_amdgcn_ds_bpermute((lane ^ 32) << 2, v);
}
template <int M> DI float shx(float v, int lane) { return __int_as_float(shxi<M>(__float_as_int(v), lane)); }
DI float wave_sum(float v, int lane) { v += shx<1>(v, lane); v += shx<2>(v, lane); v += shx<4>(v, lane); v += shx<8>(v, lane); v += shx<16>(v, lane); v += shx<32>(v, lane); return v; }

namespace epi {
using pg8::Unit; using pg8::bf16_t;
DI float row_rstd(const float* SS, int row, int fq, int lane) {
    const f32x4 p = *(const f32x4*)(SS + (size_t)row * 16 + 4 * fq);
    float s = (p[0] + p[1]) + (p[2] + p[3]); s += shx<16>(s, lane); s += shx<32>(s, lane);
    return rsqrtf(s * (1.f / DM) + EPS);
}
struct EpiA {
    static constexpr bool PERM = true, AFTER_DRAIN = false;
    bf16* Z; float* ZS; const float* SS; float* out; int layer;
    DI void operator()(const f32x4 (&acc)[2][2][4][2], const Unit& u, int wr, int wc, int fr, int fq) const {
        asm volatile("" : "+v"(fr), "+v"(fq), "+s"(wr), "+s"(wc));
        const int pn = u.pn;
#pragma unroll
        for (int ai = 0; ai < 2; ++ai)
#pragma unroll
            for (int m = 0; m < 4; ++m) {
                const int row = u.pm * 256 + ai * 128 + wr * 64 + m * 16 + fr;
                const float rstd = row_rstd(SS, row, fq, fr + 16 * fq);
#pragma unroll
                for (int bj = 0; bj < 2; ++bj) {
                    const int col = pn * 256 + bj * 128 + wc * 32 + 8 * fq;
                    const f32x4 v0 = acc[ai][bj][m][0] * rstd, v1 = acc[ai][bj][m][1] * rstd;
                    *(v4u*)(Z + (size_t)row * LDZ + col) = pack8(v0, v1);
                    float* dst = nullptr;
                    if (pn == 2 || pn == 3) {
                        dst = (row < MP) ? out + O_KVP + ((size_t)layer * MP + row) * 512 + (col - 512) : out + O_KVS + ((size_t)layer * MS + (row - MP)) * 512 + (col - 512);
                    } else if (pn == 4) {
                        const int c2 = col - 1024;
                        if (row < MP) { const int t = row & (TP - 1), b = row >> 13; if (t >= TP - 512) dst = out + O_WINP + ((size_t)(layer * 2 + b) * 512 + (t - (TP - 512))) * 256 + c2; }
                        else { const int r2 = row - MP, s = r2 >> 2, j = r2 & 3; dst = out + O_WINS + ((size_t)(layer * 128 + s) * 512 + 508 + j) * 256 + c2; }
                    } else if (pn >= 5 && pn < 11) {
                        const int c2 = col - 1280;
                        if (row < MP) { const int t = row & (TP - 1), b = row >> 13; if (t >= TP - 3) dst = out + O_CVP + ((size_t)(layer * 2 + b) * 3 + (t - (TP - 3))) * 1536 + c2; }
                        else { const int r2 = row - MP, s = r2 >> 2, j = r2 & 3; if (j >= 1) dst = out + O_CVS + ((size_t)(layer * 128 + s) * 3 + (j - 1)) * 1536 + c2; }
                    } else if (pn == 33) {
                        if (bj == 0 && wc == 0) dst = ZS + (size_t)row * 32 + 8 * fq;
                    }
                    if (dst) { *(f32x4*)dst = v0; *(f32x4*)(dst + 4) = v1; }
                }
                asm volatile("" ::: "memory");
            }
    }
};
struct EpiC {
    static constexpr bool PERM = true, AFTER_DRAIN = false;
    const bf16* Z; bf16* G;
    DI void operator()(const f32x4 (&acc)[2][2][4][2], const Unit& u, int wr, int wc, int fr, int fq) const {
        asm volatile("" : "+v"(fr), "+v"(fq), "+s"(wr), "+s"(wc));
#pragma unroll
        for (int ai = 0; ai < 2; ++ai)
#pragma unroll
            for (int m = 0; m < 4; ++m) {
                const int row = u.pm * 256 + ai * 128 + wr * 64 + m * 16 + fr;
#pragma unroll
                for (int bj = 0; bj < 2; ++bj) {
                    const int col = u.pn * 256 + bj * 128 + wc * 32 + 8 * fq;
                    const v4u gw = *(const v4u*)(Z + (size_t)row * LDZ + ZC_MG + col);
                    f32x4 g0, g1; unpack8(gw, g0, g1);
                    f32x4 v0 = acc[ai][bj][m][0], v1 = acc[ai][bj][m][1];
#pragma unroll
                    for (int e = 0; e < 4; ++e) { v0[e] *= sigmoidf_(g0[e]); v1[e] *= sigmoidf_(g1[e]); }
                    *(v4u*)(G + (size_t)row * 3072 + col) = pack8(v0, v1);
                }
                asm volatile("" ::: "memory");
            }
    }
};
struct EpiRes {
    static constexpr bool PERM = true, AFTER_DRAIN = false;
    float* XR; bf16* XG; const float* gvec; float* SS; float* T; int mode;
    DI void operator()(const f32x4 (&acc)[2][2][4][2], const Unit& u, int wr, int wc, int fr, int fq) const {
        asm volatile("" : "+v"(fr), "+v"(fq), "+s"(wr), "+s"(wc));
#pragma unroll
        for (int ai = 0; ai < 2; ++ai)
#pragma unroll
            for (int m = 0; m < 4; ++m) {
                const int row = u.pm * 256 + ai * 128 + wr * 64 + m * 16 + fr;
                float ssq = 0.f;
#pragma unroll
                for (int bj = 0; bj < 2; ++bj) {
                    const int col = u.pn * 256 + bj * 128 + wc * 32 + 8 * fq;
                    const size_t o = (size_t)row * DM + col;
                    f32x4 a0 = acc[ai][bj][m][0], a1 = acc[ai][bj][m][1];
                    if (mode == 1) { *(f32x4*)(T + o) = a0; *(f32x4*)(T + o + 4) = a1; continue; }
                    f32x4 x0 = *(const f32x4*)(XR + o), x1 = *(const f32x4*)(XR + o + 4);
                    if (mode == 2) { const f32x4 t0 = *(const f32x4*)(T + o), t1 = *(const f32x4*)(T + o + 4);
#pragma unroll
                        for (int e = 0; e < 4; ++e) { a0[e] = t0[e] * sigmoidf_(a0[e]); a1[e] = t1[e] * sigmoidf_(a1[e]); } }
                    x0 += a0; x1 += a1;
                    *(f32x4*)(XR + o) = x0; *(f32x4*)(XR + o + 4) = x1;
                    ssq += (x0[0] * x0[0] + x0[1] * x0[1]) + (x0[2] * x0[2] + x0[3] * x0[3]) + (x1[0] * x1[0] + x1[1] * x1[1]) + (x1[2] * x1[2] + x1[3] * x1[3]);
                    if (XG) { if (gvec) { const f32x4 g0 = *(const f32x4*)(gvec + col), g1 = *(const f32x4*)(gvec + col + 4); x0 *= g0; x1 *= g1; }
                        *(v4u*)(XG + o) = pack8(x0, x1); }
                }
                if (SS) { ssq += shx<16>(ssq, fr + 16 * fq); ssq += shx<32>(ssq, fr + 16 * fq); if (fq == 0) SS[(size_t)row * 16 + u.pn * 4 + wc] = ssq; }
                asm volatile("" ::: "memory");
            }
    }
};
struct EpiUp {
    static constexpr bool PERM = true, AFTER_DRAIN = false;
    bf16* H; const float* SS;
    DI void operator()(const f32x4 (&acc)[2][2][4][2], const Unit& u, int wr, int wc, int fr, int fq) const {
        asm volatile("" : "+v"(fr), "+v"(fq), "+s"(wr), "+s"(wc));
#pragma unroll
        for (int ai = 0; ai < 2; ++ai)
#pragma unroll
            for (int m = 0; m < 4; ++m) {
                const int row = u.pm * 256 + ai * 128 + wr * 64 + m * 16 + fr;
                const float rstd = row_rstd(SS, row, fq, fr + 16 * fq);
#pragma unroll
                for (int bj = 0; bj < 2; ++bj) {
                    const int col = u.pn * 256 + bj * 128 + wc * 32 + 8 * fq;
                    f32x4 v0 = acc[ai][bj][m][0] * rstd, v1 = acc[ai][bj][m][1] * rstd;
#pragma unroll
                    for (int e = 0; e < 4; ++e) { const float a = fmaxf(v0[e], 0.f), b = fmaxf(v1[e], 0.f); v0[e] = a * a; v1[e] = b * b; }
                    *(v4u*)(H + (size_t)row * DFF + col) = pack8(v0, v1);
                }
                asm volatile("" ::: "memory");
            }
    }
};
}
constexpr size_t al256(size_t x) { return (x + 255) & ~(size_t)255; }
constexpr size_t WS_CTL = 0, CTL_ZERO_BYTES = 1u << 20;
constexpr size_t SZ_WIN = (size_t)LDZ * DM * 2, SZ_WBR = (size_t)3072 * 512 * 2, SZ_WO3 = (size_t)DM * 3072 * 2, SZ_WUP = (size_t)DFF * DM * 2, SZ_WDN = (size_t)DM * DFF * 2,
                 SZ_WPL = (size_t)DM * PLE * 2, SZ_WPG = (size_t)DM * DM * 2, SZ_W1T = (size_t)2 * 64 * 2048 * 2, SZ_W2T = (size_t)2 * 64 * 64 * 2;
constexpr size_t WS_WIN = CTL_ZERO_BYTES, WS_WBR = WS_WIN + 2 * SZ_WIN, WS_WO3 = WS_WBR + 2 * SZ_WBR, WS_WUP = WS_WO3 + 2 * SZ_WO3, WS_WDN = WS_WUP + 2 * SZ_WUP,
                 WS_WPL = WS_WDN + 2 * SZ_WDN, WS_WPG = WS_WPL + 2 * SZ_WPL, WS_W1T = WS_WPG + 2 * SZ_WPG, WS_W2T = WS_W1T + 2 * SZ_W1T, WS_ROT = al256(WS_W2T + 2 * SZ_W2T);
constexpr size_t WS_P16 = WS_ROT + (size_t)TP * 64 * 8;
constexpr size_t WS_XR = WS_P16 + (size_t)2 * MROWS * PLE * 2;
constexpr size_t WS_XGA = WS_XR + (size_t)MROWS * DM * 4, WS_XGB = WS_XGA + (size_t)MROWS * DM * 2, WS_XGC = WS_XGB + (size_t)MROWS * DM * 2;
constexpr size_t WS_SSA = WS_XGC + (size_t)MROWS * DM * 2, WS_SSB = WS_SSA + (size_t)MROWS * 64;
constexpr size_t WS_Z = WS_SSB + (size_t)MROWS * 64, WS_ZS = WS_Z + (size_t)MROWS * LDZ * 2;
constexpr size_t WS_MIX = WS_ZS + (size_t)MROWS * 128, WS_GATED = WS_MIX + (size_t)MROWS * 1536 * 2, WS_HMID = WS_GATED + (size_t)MROWS * 3072 * 2;
constexpr size_t WS_TPLE = WS_HMID + (size_t)MROWS * DFF * 2;
constexpr size_t WS_KC = WS_TPLE + (size_t)MROWS * DM * 4;
constexpr size_t WS_KCS = WS_KC + (size_t)2 * 2 * 512 * 2 * 64 * 2;
constexpr int GREC = 73984;
constexpr size_t WS_GREC = WS_KCS + (size_t)2 * 128 * 128 * 2 * 64 * 2;
constexpr size_t WS_OGDN = WS_GREC + (size_t)1024 * GREC;
constexpr size_t WS_RKV = WS_OGDN + (size_t)MROWS * 512 * 4;
constexpr size_t WS_RST = WS_RKV + (size_t)512 * 16384 * 4;
constexpr size_t WS_QR = WS_RST + (size_t)512 * 16384 * 2, WS_KR = WS_QR + (size_t)MP * 512 * 2;
constexpr size_t WS_END = WS_KR + (size_t)MP * 512 * 2;
static_assert(WS_W1T % 256 == 0 && WS_Z % 256 == 0 && WS_GREC % 256 == 0 && WS_RKV % 256 == 0 && WS_KC % 256 == 0 && WS_XR % 256 == 0, "ws alignment");

constexpr int CW_TMO = 0, CW_BAR = 4096;
constexpr int NWAVES = 8, NTHREADS = 512;
constexpr int RING_BYTES = 147456, LDSCTL_OFF = RING_BYTES, MISC_OFF = LDSCTL_OFF + 320, LDS_BYTES = RING_BYTES + 1024;

#define RLX_AGENT __ATOMIC_RELAXED, __HIP_MEMORY_SCOPE_AGENT
#define LDS_WAIT() asm volatile("s_waitcnt lgkmcnt(0)" ::: "memory")
#define VM_WAIT() asm volatile("s_waitcnt vmcnt(0)" ::: "memory")
#define XB_TMO      128
#define XB_XCNT(j)  (256  + 64 * (j))
#define XB_XSUB(j)  (1280 + 64 * (j))
#define XB_XGEN(j)  (2304 + 64 * (j))
#define XB_TOP      3328
#define XB_TOPGEN   3392
#define XCD_BAR_WORDS 3456
#define XB_SPIN_CAP (1u << 18)

__device__ __forceinline__ unsigned xb_ld(unsigned* p)              { return __hip_atomic_load(p, __ATOMIC_RELAXED, __HIP_MEMORY_SCOPE_AGENT); }
__device__ __forceinline__ unsigned xb_add(unsigned* p, unsigned v) { return __hip_atomic_fetch_add(p, v, __ATOMIC_RELAXED, __HIP_MEMORY_SCOPE_AGENT); }
__device__ __forceinline__ unsigned xb_xcc_id() { return (unsigned)__builtin_amdgcn_s_getreg((3 << 11) | 20) & 0xFu; }
#define XB_SPIN(cond, bar) do { unsigned _sp = 0; while (cond) { __builtin_amdgcn_s_sleep(1); \
    if ((++_sp & 255u) == 0u) { if (xb_ld(&(bar)[XB_TMO])) break; if (_sp > XB_SPIN_CAP) { atomicAdd(&(bar)[XB_TMO], 1u); break; } } } } while (0)

struct XcdBarrier {
    unsigned* bar; unsigned x;
    volatile LAS unsigned* st;
};

__device__ __forceinline__ XcdBarrier xcd_barrier_post(unsigned* bar, volatile LAS unsigned* st, bool t0) {
    XcdBarrier b; b.bar = bar; b.x = xb_xcc_id(); b.st = st;
    if (t0) (void)xb_add(&bar[XB_XCNT(b.x)], 1u);
    return b;
}
__device__ __forceinline__ void xcd_barrier_complete(unsigned* bar, unsigned x, unsigned& nloc, unsigned& nx) {
    const unsigned G = gridDim.x * gridDim.y * gridDim.z;
    unsigned sum, cnt, mine, sp = 0u;
    for (;;) {
        sum = 0u; cnt = 0u; mine = 0u;
#pragma unroll
        for (unsigned j = 0; j < 16; ++j) { const unsigned c = xb_ld(&bar[XB_XCNT(j)]); sum += c; cnt += (c > 0u) ? 1u : 0u; mine = (j == x) ? c : mine; }
        if (sum == G) break;
        __builtin_amdgcn_s_sleep(1);
        if ((++sp & 255u) == 0u) { if (xb_ld(&bar[XB_TMO])) break; if (sp > XB_SPIN_CAP) { atomicAdd(&bar[XB_TMO], 1u); break; } }
    }
    nloc = mine > 0u ? mine : 1u; nx = cnt > 0u ? cnt : 1u;
}

__device__ __forceinline__ void xcd_barrier(const XcdBarrier& b, bool t0) {
    asm volatile("s_waitcnt vmcnt(0)" ::: "memory");
    __syncthreads();
    if (t0) {
        unsigned* bar = b.bar;
        __builtin_amdgcn_s_waitcnt(0);
        unsigned nloc = b.st[0], nx = b.st[1];
        if (nloc == 0u) { xcd_barrier_complete(bar, b.x, nloc, nx); b.st[0] = nloc; b.st[1] = nx; }
        const unsigned old = xb_add(&bar[XB_XSUB(b.x)], 1u);
        const unsigned gen = old / nloc;
        if (old + 1u == (gen + 1u) * nloc) {
            __builtin_amdgcn_fence(__ATOMIC_RELEASE, "agent");
            asm volatile("s_waitcnt vmcnt(0)" ::: "memory");
            const unsigned og = xb_add(&bar[XB_TOP], 1u);
            const unsigned tg = og / nx;
            if (og + 1u == (tg + 1u) * nx) xb_add(&bar[XB_TOPGEN], 1u);
            else XB_SPIN(xb_ld(&bar[XB_TOPGEN]) == tg, bar);
            __builtin_amdgcn_fence(__ATOMIC_ACQUIRE, "agent");
            xb_add(&bar[XB_XGEN(b.x)], 1u);
            asm volatile("s_waitcnt vmcnt(0)" ::: "memory");
        } else {
            XB_SPIN(xb_ld(&bar[XB_XGEN(b.x)]) == gen, bar);
            __builtin_amdgcn_fence(__ATOMIC_ACQUIRE, "agent");
            asm volatile("s_waitcnt vmcnt(0)" ::: "memory");
        }
    }
    __syncthreads();
}
typedef const void* const __attribute__((address_space(4)))* kargp_t;
DI const float* KIN(int i) { const float* p = (const float*)((kargp_t)__builtin_amdgcn_kernarg_segment_ptr())[i]; asm volatile("" : "+s"(p)); return p; }
DI float* KOUT() { float* p = (float*)((kargp_t)__builtin_amdgcn_kernarg_segment_ptr())[27]; asm volatile("" : "+s"(p)); return p; }
DI unsigned char* KWS() { unsigned char* p = (unsigned char*)((kargp_t)__builtin_amdgcn_kernarg_segment_ptr())[28]; asm volatile("" : "+s"(p)); return p; }
struct Frame {
    LAS unsigned char* lds;
    gu32* ctl;
    int tid, lane, wave, G, bid;
};
DI bf16x8 ld_frag_g(const bf16* p) { return __builtin_bit_cast(bf16x8, *(const v4u*)p); }
DI bf16x8 ld_frag_l(const LAS unsigned char* p) { return *(const LAS bf16x8*)p; }
DI f32x4 mfma16(bf16x8 a, bf16x8 b, f32x4 c) { return __builtin_amdgcn_mfma_f32_16x16x32_bf16(a, b, c, 0, 0, 0); }
DI bf16x8 pack_frag(const f32x4 a, const f32x4 b) { return __builtin_bit_cast(bf16x8, pack8(a, b)); }
DI int lane_id() { int l; asm volatile("v_mbcnt_lo_u32_b32 %0, -1, 0\n\tv_mbcnt_hi_u32_b32 %0, -1, %0" : "=v"(l)); return l; }
DI Frame fresh(const Frame& F0) {
    Frame F = F0; int w = F0.wave, g = F0.G, b = F0.bid; asm volatile("" : "+s"(w), "+s"(g), "+s"(b));
    int l = lane_id(); asm volatile("" : "+v"(l));
    unsigned lb = (unsigned)(uintptr_t)F0.lds; asm volatile("" : "+s"(lb)); F.lds = (LAS unsigned char*)(uintptr_t)lb;
    F.wave = w; F.lane = l; F.tid = w * 64 + l; F.G = g; F.bid = b; return F;
}
#define GRID_BAR() do { XcdBarrier b_; b_.bar = (unsigned*)((gu32*)(KWS() + WS_CTL) + CW_BAR); b_.x = xb_xcc_id(); b_.st = (volatile LAS unsigned*)(F.lds + MISC_OFF) + 8; \
    const Frame Fb_ = fresh(F); xcd_barrier(b_, Fb_.tid == 0); } while (0)
DI int win_colmap(int j) {
    if (j < 1280) return j; if (j < 2816) return j + 24; if (j < 8448) return j + 32; if (j < 8472) return j - 8448 + 1280; if (j < 8480) return j - 8472 + 2840; return -1;
}
DI void tr_item(const float* W, int ldw, int k0, int srccol, bf16* WT, size_t dst_row0, int ldt, int kdst0, int nrep, int krep, LAS float* scr, int lane) {
#pragma unroll 8
    for (int i = 0; i < 32; ++i) { const int kk = 2 * i + (lane >> 5); scr[kk * 33 + (lane & 31)] = (srccol >= 0) ? W[(size_t)(k0 + kk) * ldw + srccol] : 0.f; }
    LDS_WAIT(); asm volatile("" ::: "memory");
    const int c = lane & 7;
#pragma unroll
    for (int j = 0; j < 4; ++j) { const int n = (lane >> 3) + 8 * j; const LAS float* s = scr + (8 * c) * 33 + n;
        v4u o; o.x = pk2(s[0 * 33], s[1 * 33]); o.y = pk2(s[2 * 33], s[3 * 33]); o.z = pk2(s[4 * 33], s[5 * 33]); o.w = pk2(s[6 * 33], s[7 * 33]);
        for (int r = 0; r < nrep; ++r) *(v4u*)(WT + (dst_row0 + n) * (size_t)ldt + kdst0 + r * krep + 8 * c) = o; }
    LDS_WAIT(); asm volatile("" ::: "memory");
}
DI void p0_prologue(Frame& F) {
    LAS float* scr = (LAS float*)(F.lds + F.wave * 16384);
    const int gw = F.bid * NWAVES + F.wave, NGW = F.G * NWAVES, lane = F.lane;
    unsigned char* ws = KWS();
    constexpr int I_A = 16 * 272, I_B = 3 * 8 * 32, I_C = 16 * 32, I_D = 16 * 128, I_E = 64 * 32, I_F = 4 * 32, I_G = 16 * 32, I_H = 2 * 32 * 2, I_I = 2 * 2;
    constexpr int I_L = I_A + I_B + I_C + I_D + I_E + I_F + I_G + I_H + I_I;
    for (int it = gw; it < 2 * I_L; it += NGW) {
        const int l = it / I_L; int r = it % I_L;
        if (r < I_A) { const int kb = r / 272, nb = r % 272; tr_item(KIN(11) + (size_t)l * DM * 8480, 8480, 64 * kb, win_colmap(32 * nb + (lane & 31)), (bf16*)(ws + WS_WIN + l * SZ_WIN), 32 * nb, DM, 64 * kb, 1, 0, scr, lane); continue; } r -= I_A;
        if (r < I_B) { const int b = r / 256, kb = (r % 256) / 32, nb = r % 32; tr_item(KIN(19) + (size_t)(l * 3 + b) * 512 * DM, DM, 64 * kb, 32 * nb + (lane & 31), (bf16*)(ws + WS_WBR + l * SZ_WBR), b * 1024 + 32 * nb, 512, 64 * kb, 1, 0, scr, lane); continue; } r -= I_B;
        if (r < I_C) { const int kb = r / 32, nb = r % 32; tr_item(KIN(20) + (size_t)l * DM * DM, DM, 64 * kb, 32 * nb + (lane & 31), (bf16*)(ws + WS_WO3 + l * SZ_WO3), 32 * nb, 3072, 64 * kb, 3, 1024, scr, lane); continue; } r -= I_C;
        if (r < I_D) { const int kb = r / 128, nb = r % 128; tr_item(KIN(22) + (size_t)l * DM * DFF, DFF, 64 * kb, 32 * nb + (lane & 31), (bf16*)(ws + WS_WUP + l * SZ_WUP), 32 * nb, DM, 64 * kb, 1, 0, scr, lane); continue; } r -= I_D;
        if (r < I_E) { const int kb = r / 32, nb = r % 32; tr_item(KIN(23) + (size_t)l * DFF * DM, DM, 64 * kb, 32 * nb + (lane & 31), (bf16*)(ws + WS_WDN + l * SZ_WDN), 32 * nb, DFF, 64 * kb, 1, 0, scr, lane); continue; } r -= I_E;
        if (r < I_F) { const int kb = r / 32, nb = r % 32; tr_item(KIN(24) + (size_t)l * PLE * DM, DM, 64 * kb, 32 * nb + (lane & 31), (bf16*)(ws + WS_WPL + l * SZ_WPL), 32 * nb, PLE, 64 * kb, 1, 0, scr, lane); continue; } r -= I_F;
        if (r < I_G) { const int kb = r / 32, nb = r % 32; tr_item(KIN(25) + (size_t)l * DM * DM, DM, 64 * kb, 32 * nb + (lane & 31), (bf16*)(ws + WS_WPG + l * SZ_WPG), 32 * nb, DM, 64 * kb, 1, 0, scr, lane); continue; } r -= I_G;
        if (r < I_H) { const int kv = r / 64, kb = (r % 64) / 2, nb = r % 2; tr_item(KIN(13) + (size_t)(l * 2 + kv) * 2048 * 64, 64, 64 * kb, 32 * nb + (lane & 31), (bf16*)(ws + WS_W1T + l * SZ_W1T) + (size_t)kv * 64 * 2048, 32 * nb, 2048, 64 * kb, 1, 0, scr, lane); continue; } r -= I_H;
        { const int kv = r / 2, nb = r % 2; tr_item(KIN(14) + (size_t)(l * 2 + kv) * 64 * 64, 64, 0, 32 * nb + (lane & 31), (bf16*)(ws + WS_W2T + l * SZ_W2T) + (size_t)kv * 64 * 64, 32 * nb, 64, 0, 1, 0, scr, lane); }
    }
    float* XR = (float*)(ws + WS_XR); bf16* XGA = (bf16*)(ws + WS_XGA); float* SSA = (float*)(ws + WS_SSA); bf16* P16 = (bf16*)(ws + WS_P16);
    const float* g0 = KIN(10);
    for (int row = gw; row < MROWS; row += NGW) {
        const float* xs = (row < MP) ? KIN(0) + (size_t)row * DM : KIN(1) + (size_t)(row - MP) * DM;
        float ss = 0.f;
#pragma unroll
        for (int j = 0; j < 2; ++j) {
            const int c = j * 512 + lane * 8;
            f32x4 a = *(const f32x4*)(xs + c), b = *(const f32x4*)(xs + c + 4);
            *(f32x4*)(XR + (size_t)row * DM + c) = a; *(f32x4*)(XR + (size_t)row * DM + c + 4) = b;
            ss += (a[0] * a[0] + a[1] * a[1]) + (a[2] * a[2] + a[3] * a[3]) + (b[0] * b[0] + b[1] * b[1]) + (b[2] * b[2] + b[3] * b[3]);
            const f32x4 ga = *(const f32x4*)(g0 + c), gb = *(const f32x4*)(g0 + c + 4);
            *(v4u*)(XGA + (size_t)row * DM + c) = pack8(a * ga, b * gb);
        }
        ss = wave_sum(ss, lane);
        if (lane < 16) SSA[(size_t)row * 16 + lane] = (lane == 0) ? ss : 0.f;
#pragma unroll
        for (int l = 0; l < 2; ++l) {
            const float* ps = (row < MP) ? KIN(8) + ((size_t)l * MP + row) * PLE : KIN(9) + ((size_t)l * MS + (row - MP)) * PLE;
            const f32x4 a = *(const f32x4*)(ps + lane * 4);
            v2u o; o.x = pk2(a[0], a[1]); o.y = pk2(a[2], a[3]);
            *(v2u*)(P16 + ((size_t)l * MROWS + row) * PLE + lane * 4) = o;
        }
    }
    const int gt = F.bid * NTHREADS + F.tid, NGT = F.G * NTHREADS;
    f32x2* ROT = (f32x2*)(ws + WS_ROT);
    for (int e = gt; e < TP * 64; e += NGT) {
        const int pos = e >> 6, i = e & 63;
        const float x = (float)i * (1.0f / 63.0f);
        const float inv = exp2f(-x * 13.287712379549449f);
        const float ang = (float)pos * inv;
        const double rev = (double)ang * 0.15915494309189535;
        const float fr = (float)(rev - floor(rev));
        ROT[e] = (f32x2){__builtin_amdgcn_cosf(fr), __builtin_amdgcn_sinf(fr)};
    }
    for (int e = gt; e < 2 * 128 * 508 * 64; e += NGT) {
        const int ls = e / (508 * 64), r = e % (508 * 64);
        const f32x4 v = *(const f32x4*)(KIN(3) + (size_t)ls * 512 * 256 + 4 * 256 + (size_t)r * 4);
        *(f32x4*)(KOUT() + O_WINS + (size_t)ls * 512 * 256 + (size_t)r * 4) = v;
    }
}
DI float gelu_tanh(float x) { const float u = 0.7978845608028654f * (x + 0.044715f * x * x * x); const float e = __expf(2.f * u); return 0.5f * x * (1.f + (1.f - 2.f / (e + 1.f))); }
DI bf16x8 mk_frag(v2u a, v2u b) { v4u w; w.x = a.x; w.y = a.y; w.z = b.x; w.w = b.y; return __builtin_bit_cast(bf16x8, w); }

DI void compress_task(Frame& F, int layer, int task) {
    const int lane = F.lane, quad = lane >> 4, rl = lane & 15;
    unsigned char* ws = KWS();
    const bool sample = task >= 256;
    int kv, bs, nt, g;
    if (!sample) { kv = task >> 7; const int r = task & 127; bs = r >> 6; nt = (r >> 1) & 31; g = r & 1; }
    else { const int t2 = task - 256; kv = t2 >> 11; const int r = t2 & 2047; bs = r >> 4; nt = (r >> 1) & 7; g = r & 1; }
    const int n = nt * 16 + rl;
    const bf16* W1T = (const bf16*)(ws + WS_W1T + layer * SZ_W1T) + (size_t)kv * 64 * 2048;
    const bf16* W2T = (const bf16*)(ws + WS_W2T + layer * SZ_W2T) + (size_t)kv * 64 * 64;
    const float* pe = KIN(12) + (size_t)(layer * 2 + kv) * 32 * 64;
    const bf16* Z = (const bf16*)(ws + WS_Z);
    const int* pt = (const int*)KIN(7);
    const float* cache = KIN(2);
    f32x4 h[4];
#pragma unroll
    for (int i = 0; i < 4; ++i) h[i] = (f32x4){0.f, 0.f, 0.f, 0.f};
#pragma unroll 4
    for (int kk = 0; kk < 64; ++kk) {
        const int j = kk >> 1, dim0 = (kk & 1) * 32 + quad * 8;
        f32x4 x0, x1;
        if (!sample) { const size_t row = (size_t)bs * TP + 16 * n + j; unpack8(*(const v4u*)(Z + row * LDZ + ZC_KC + kv * 128 + g * 64 + dim0), x0, x1); }
        else { int pos = 16 * n + j; pos = pos > 2047 ? 2047 : pos; const int phys = pt[bs * 16 + (pos >> 7)];
            const float* p = cache + ((size_t)(layer * 2560 + phys) * 128 + (pos & 127)) * 512 + kv * 128 + g * 64 + dim0; x0 = *(const f32x4*)p; x1 = *(const f32x4*)(p + 4); }
        x0 += *(const f32x4*)(pe + j * 64 + dim0); x1 += *(const f32x4*)(pe + j * 64 + dim0 + 4);
        const bf16x8 xb = pack_frag(x0, x1);
#pragma unroll
        for (int ht = 0; ht < 4; ++ht) h[ht] = mfma16(ld_frag_g(W1T + (size_t)(16 * ht + rl) * 2048 + kk * 32 + quad * 8), xb, h[ht]);
    }
#pragma unroll
    for (int ht = 0; ht < 4; ++ht)
#pragma unroll
        for (int i = 0; i < 4; ++i) h[ht][i] = gelu_tanh(h[ht][i]);
    bf16x8 gb[2]; gb[0] = pack_frag(h[0], h[1]); gb[1] = pack_frag(h[2], h[3]);
    bf16* dst = sample ? (bf16*)(ws + WS_KCS) + ((((size_t)kv * 128 + bs) * 128 + n) * 2 + g) * 64 : (bf16*)(ws + WS_KC) + ((((size_t)kv * 2 + bs) * 512 + n) * 2 + g) * 64;
    const bool zero = sample && n == 127;
#pragma unroll
    for (int ot = 0; ot < 4; ++ot) {
        f32x4 o = (f32x4){0.f, 0.f, 0.f, 0.f};
#pragma unroll
        for (int s = 0; s < 2; ++s) {
            const bf16* wp = W2T + (16 * ot + rl) * 64 + 32 * s + 4 * quad;
            o = mfma16(mk_frag(*(const v2u*)wp, *(const v2u*)(wp + 16)), gb[s], o);
        }
        v2u w; w.x = zero ? 0u : pk2(o[0], o[1]); w.y = zero ? 0u : pk2(o[2], o[3]);
        *(v2u*)(dst + 16 * ot + 4 * quad) = w;
    }
}

DI int kperm(int idx) { const int s = idx >> 5, r = idx & 31; return 32 * s + 8 * ((r >> 2) & 3) + 4 * (r >> 4) + (r & 3); }
DI float softplusf_(float x) { return x > 20.f ? x : __logf(1.f + __expf(x)); }
DI float ret_lg(int h) { return h == 0 ? -0.031748697f : h == 1 ? -0.015748357f : h == 2 ? -0.007843178f : -0.0039138994f; }

DI void gdn_prep_unit(Frame& F, int layer, int unit) {
    const int tid = F.tid, lane = F.lane, wave = F.wave;
    const int b = unit >> 9, h = (unit >> 7) & 3, c = unit & 127;
    const int row0 = b * TP + 64 * c, t0 = 64 * c;
    unsigned char* ws = KWS();
    const bf16* Z = (const bf16*)(ws + WS_Z);
    const float* ZS = (const float*)(ws + WS_ZS);
    LAS float* Lq = (LAS float*)(F.lds); LAS float* Lk = (LAS float*)(F.lds + 33792); LAS float* Lv = (LAS float*)(F.lds + 67584);
    LAS float* LA = (LAS float*)(F.lds + 101376); LAS float* LQK = (LAS float*)(F.lds + 117760);
    LAS float* Lg = (LAS float*)(F.lds + 134144); LAS float* Lb = Lg + 64; LAS float* Le = Lg + 128;
    const float* cw = KIN(15) + (size_t)layer * 4 * 1536;
    for (int it = tid; it < 64 * 48; it += NTHREADS) {
        const int i = it / 48, ch = it % 48, part = ch >> 4, cc = ch & 15;
        const int col = part * 512 + h * 128 + cc * 8;
        f32x4 y0 = (f32x4){0.f, 0.f, 0.f, 0.f}, y1 = y0;
#pragma unroll
        for (int j = 0; j < 4; ++j) {
            const int t = t0 + i - 3 + j;
            if (t >= 0) { f32x4 x0, x1; unpack8(*(const v4u*)(Z + (size_t)(row0 + i - 3 + j) * LDZ + ZC_GQKV + col), x0, x1);
                y0 += x0 * *(const f32x4*)(cw + j * 1536 + col); y1 += x1 * *(const f32x4*)(cw + j * 1536 + col + 4); }
        }
#pragma unroll
        for (int e = 0; e < 4; ++e) { y0[e] = siluf_(y0[e]); y1[e] = siluf_(y1[e]); }
        LAS float* dst = (part == 0 ? Lq : part == 1 ? Lk : Lv) + i * 132 + cc * 8;
        *(LAS f32x4*)dst = y0; *(LAS f32x4*)(dst + 4) = y1;
    }
    __syncthreads();
    for (int q = 0; q < 8; ++q) {
        const int i = wave * 8 + q;
        { const float a = Lq[i * 132 + lane * 2], bq = Lq[i * 132 + lane * 2 + 1]; const float sc = rsqrtf(wave_sum(a * a + bq * bq, lane) + EPS) * 0.08838834764831845f; Lq[i * 132 + lane * 2] = a * sc; Lq[i * 132 + lane * 2 + 1] = bq * sc; }
        { const float a = Lk[i * 132 + lane * 2], bq = Lk[i * 132 + lane * 2 + 1]; const float sc = rsqrtf(wave_sum(a * a + bq * bq, lane) + EPS); Lk[i * 132 + lane * 2] = a * sc; Lk[i * 132 + lane * 2 + 1] = bq * sc; }
    }
    if (wave == 0) {
        const float ga = ZS[(size_t)(row0 + lane) * 32 + 24 + h], gbv = ZS[(size_t)(row0 + lane) * 32 + 28 + h];
        float g = -__expf(KIN(16)[layer * 4 + h]) * softplusf_(ga + KIN(17)[layer * 4 + h]);
#pragma unroll
        for (int o = 1; o < 64; o <<= 1) { const float t = __int_as_float(__builtin_amdgcn_ds_bpermute(((lane - o) & 63) << 2, __float_as_int(g))); if (lane >= o) g += t; }
        Lg[lane] = g; Lb[lane] = sigmoidf_(gbv); Le[lane] = __expf(g);
    }
    __syncthreads();
    {
        const int i = tid >> 3, c8 = tid & 7;
        float kkv[8], qkv[8];
#pragma unroll
        for (int jj = 0; jj < 8; ++jj) { kkv[jj] = 0.f; qkv[jj] = 0.f; }
        for (int d4 = 0; d4 < 32; ++d4) {
            const f32x4 ki = *(const LAS f32x4*)(Lk + i * 132 + 4 * d4), qi = *(const LAS f32x4*)(Lq + i * 132 + 4 * d4);
#pragma unroll
            for (int jj = 0; jj < 8; ++jj) { const f32x4 kj = *(const LAS f32x4*)(Lk + (jj * 8 + c8) * 132 + 4 * d4);
                kkv[jj] += (ki[0] * kj[0] + ki[1] * kj[1]) + (ki[2] * kj[2] + ki[3] * kj[3]); qkv[jj] += (qi[0] * kj[0] + qi[1] * kj[1]) + (qi[2] * kj[2] + qi[3] * kj[3]); }
        }
        const float gi = Lg[i], bi = Lb[i];
#pragma unroll
        for (int jj = 0; jj < 8; ++jj) { const int j = jj * 8 + c8; const float dec = (i >= j) ? __expf(gi - Lg[j]) : 0.f;
            LA[i * 64 + j] = (i > j) ? bi * kkv[jj] * dec : 0.f; LQK[i * 64 + j] = qkv[jj] * dec; }
    }
    __syncthreads();
    unsigned char* rec = ws + WS_GREC + (size_t)unit * GREC;
    {
        const float gl = Lg[63];
        for (int it = tid; it < 2560; it += NTHREADS) {
            if (it < 1024) {
                const int i = it >> 4, s = (it >> 2) & 3, quad = it & 3; const float e = Le[i];
                const f32x4 a = *(const LAS f32x4*)(Lq + i * 132 + 32 * s + 4 * quad) * e, bq = *(const LAS f32x4*)(Lq + i * 132 + 32 * s + 16 + 4 * quad) * e;
                *(v4u*)(rec + 16384 + i * 256 + (32 * s + 8 * quad) * 2) = pack8(a, bq);
            } else if (it < 2048) {
                const int r = it - 1024, dk = r >> 3, s2 = (r >> 2) & 1, quad = r & 3;
                f32x4 a, bq;
#pragma unroll
                for (int e = 0; e < 4; ++e) { const int ta = 32 * s2 + 4 * quad + e, tb = ta + 16; a[e] = Lk[ta * 132 + dk] * __expf(gl - Lg[ta]); bq[e] = Lk[tb * 132 + dk] * __expf(gl - Lg[tb]); }
                *(v4u*)(rec + 32768 + dk * 128 + (32 * s2 + 8 * quad) * 2) = pack8(a, bq);
            } else {
                const int r = it - 2048, i = r >> 3, s2 = (r >> 2) & 1, quad = r & 3;
                const f32x4 a = *(const LAS f32x4*)(LQK + i * 64 + 32 * s2 + 4 * quad), bq = *(const LAS f32x4*)(LQK + i * 64 + 32 * s2 + 16 + 4 * quad);
                *(v4u*)(rec + 65536 + i * 128 + (32 * s2 + 8 * quad) * 2) = pack8(a, bq);
            }
        }
        if (tid == 0) *(float*)(rec + 73728) = __expf(gl);
    }
    __syncthreads();
    if (tid < 256) {
        LAS float* X = (tid < 128) ? (Lv + tid) : (Lk + (tid - 128));
        const bool isw = tid >= 128;
        for (int i = 0; i < 64; ++i) {
            const float rhs = isw ? Lb[i] * Le[i] * X[i * 132] : Lb[i] * X[i * 132];
            float s0 = rhs, s1 = 0.f;
            const int nj4 = i >> 2;
            for (int j4 = 0; j4 < nj4; ++j4) { const f32x4 a = *(const LAS f32x4*)(LA + i * 64 + 4 * j4);
                s0 -= a[0] * X[(4 * j4) * 132]; s1 -= a[1] * X[(4 * j4 + 1) * 132]; s0 -= a[2] * X[(4 * j4 + 2) * 132]; s1 -= a[3] * X[(4 * j4 + 3) * 132]; }
            for (int jj = 4 * nj4; jj < i; ++jj) s0 -= LA[i * 64 + jj] * X[jj * 132];
            X[i * 132] = s0 + s1;
        }
    }
    __syncthreads();
    for (int it = tid; it < 2048; it += NTHREADS) {
        if (it < 1024) {
            const int dv = it >> 3, q = it & 7;
            v4u w; w.x = pk2(Lv[(8 * q) * 132 + dv], Lv[(8 * q + 1) * 132 + dv]); w.y = pk2(Lv[(8 * q + 2) * 132 + dv], Lv[(8 * q + 3) * 132 + dv]);
            w.z = pk2(Lv[(8 * q + 4) * 132 + dv], Lv[(8 * q + 5) * 132 + dv]); w.w = pk2(Lv[(8 * q + 6) * 132 + dv], Lv[(8 * q + 7) * 132 + dv]);
            *(v4u*)(rec + 49152 + dv * 128 + q * 16) = w;
        } else {
            const int r = it - 1024, i = r >> 4, s = (r >> 2) & 3, quad = r & 3;
            const f32x4 a = *(const LAS f32x4*)(Lk + i * 132 + 32 * s + 4 * quad), bq = *(const LAS f32x4*)(Lk + i * 132 + 32 * s + 16 + 4 * quad);
            *(v4u*)(rec + i * 256 + (32 * s + 8 * quad) * 2) = pack8(a, bq);
        }
    }
    __syncthreads();
}

DI void ret_prep_unit(Frame& F, int layer, int unit) {
    const int tid = F.tid, lane = F.lane, wave = F.wave, quad = lane >> 4, rl = lane & 15;
    const int b = unit >> 8, h = (unit >> 6) & 3, c = unit & 63;
    const int row0 = b * TP + 128 * c;
    unsigned char* ws = KWS();
    const bf16* Z = (const bf16*)(ws + WS_Z);
    const f32x2* ROT = (const f32x2*)(ws + WS_ROT);
    bf16* QR = (bf16*)(ws + WS_QR); bf16* KR = (bf16*)(ws + WS_KR);
    LAS unsigned char* LK = F.lds; LAS unsigned char* LV = F.lds + 34816;
    const float lg = ret_lg(h);
    for (int it = tid; it < 1024; it += NTHREADS) {
        const int j = it >> 3, cc = it & 7, d0 = cc * 8;
        const size_t zr = (size_t)(row0 + j) * LDZ + ZC_RQKV + h * 128 + d0;
        f32x4 q1a, q1b, q2a, q2b, k1a, k1b, k2a, k2b;
        unpack8(*(const v4u*)(Z + zr), q1a, q1b); unpack8(*(const v4u*)(Z + zr + 64), q2a, q2b);
        unpack8(*(const v4u*)(Z + zr + 512), k1a, k1b); unpack8(*(const v4u*)(Z + zr + 512 + 64), k2a, k2b);
        const f32x2* rp = ROT + (size_t)(128 * c + j) * 64 + d0;
        const float kd = __expf((float)(127 - j) * lg);
        f32x4 oq1a, oq1b, oq2a, oq2b, ok1a, ok1b, ok2a, ok2b;
#pragma unroll
        for (int e = 0; e < 8; ++e) {
            const f32x2 cs = rp[e];
            const float q1 = e < 4 ? q1a[e & 3] : q1b[e & 3], q2 = e < 4 ? q2a[e & 3] : q2b[e & 3], k1 = e < 4 ? k1a[e & 3] : k1b[e & 3], k2 = e < 4 ? k2a[e & 3] : k2b[e & 3];
            const float rq1 = q1 * cs.x - q2 * cs.y, rq2 = q2 * cs.x + q1 * cs.y, rk1 = (k1 * cs.x - k2 * cs.y) * 0.08838834764831845f, rk2 = (k2 * cs.x + k1 * cs.y) * 0.08838834764831845f;
            if (e < 4) { oq1a[e & 3] = rq1; oq2a[e & 3] = rq2; ok1a[e & 3] = rk1; ok2a[e & 3] = rk2; } else { oq1b[e & 3] = rq1; oq2b[e & 3] = rq2; ok1b[e & 3] = rk1; ok2b[e & 3] = rk2; }
            *(LAS bf16*)(LK + (d0 + e) * 272 + j * 2) = (bf16)f2bf(rk1 * kd); *(LAS bf16*)(LK + (d0 + 64 + e) * 272 + j * 2) = (bf16)f2bf(rk2 * kd);
        }
        const size_t orow = (size_t)(row0 + j) * 512 + h * 128 + d0;
        *(v4u*)(QR + orow) = pack8(oq1a, oq1b); *(v4u*)(QR + orow + 64) = pack8(oq2a, oq2b);
        *(v4u*)(KR + orow) = pack8(ok1a, ok1b); *(v4u*)(KR + orow + 64) = pack8(ok2a, ok2b);
    }
    for (int it = tid; it < 2048; it += NTHREADS) {
        const int j = it >> 4, cc = it & 15;
        const v4u w = *(const v4u*)(Z + (size_t)(row0 + j) * LDZ + ZC_RQKV + 1024 + h * 128 + cc * 8);
        LAS unsigned char* d = LV + (cc * 8) * 272 + j * 2;
        *(LAS bf16*)(d) = (bf16)(w.x & 0xffff); *(LAS bf16*)(d + 272) = (bf16)(w.x >> 16); *(LAS bf16*)(d + 2 * 272) = (bf16)(w.y & 0xffff); *(LAS bf16*)(d + 3 * 272) = (bf16)(w.y >> 16);
        *(LAS bf16*)(d + 4 * 272) = (bf16)(w.z & 0xffff); *(LAS bf16*)(d + 5 * 272) = (bf16)(w.z >> 16); *(LAS bf16*)(d + 6 * 272) = (bf16)(w.w & 0xffff); *(LAS bf16*)(d + 7 * 272) = (bf16)(w.w >> 16);
    }
    __syncthreads();
    float* RKV = (float*)(ws + WS_RKV) + (size_t)unit * 16384;
#pragma unroll
    for (int nt = 0; nt < 8; ++nt) {
        f32x4 acc = (f32x4){0.f, 0.f, 0.f, 0.f};
#pragma unroll
        for (int s = 0; s < 4; ++s) acc = mfma16(ld_frag_l(LK + (16 * wave + rl) * 272 + (32 * s + 8 * quad) * 2), ld_frag_l(LV + (16 * nt + rl) * 272 + (32 * s + 8 * quad) * 2), acc);
#pragma unroll
        for (int i = 0; i < 4; ++i) RKV[(size_t)(16 * wave + 4 * quad + i) * 128 + 16 * nt + rl] = acc[i];
    }
    __syncthreads();
}
DI void sample_rec_unit(Frame& F, int layer, int unit) {
    const int tid = F.tid, lane = F.lane, wave = F.wave;
    const int kind = unit >> 9, s = (unit >> 2) & 127, h = unit & 3;
    const int dv = tid & 127, part = tid >> 7, r0 = MP + 4 * s;
    unsigned char* ws = KWS();
    const bf16* Z = (const bf16*)(ws + WS_Z);
    const float* ZS = (const float*)(ws + WS_ZS);
    LAS float* Lq = (LAS float*)(F.lds); LAS float* Lk = Lq + 512; LAS float* Lv = Lq + 1024; LAS float* red = Lq + 1536; LAS float* Lo = Lq + 2048; LAS float* sc = Lq + 2560;
    float S[32];
    if (kind == 0) {
        if (tid < 384) {
            const int pr = tid >> 7, d = tid & 127, col = pr * 512 + h * 128 + d;
            float xp[7], w[4];
#pragma unroll
            for (int i = 0; i < 3; ++i) xp[i] = KIN(4)[((size_t)(layer * 128 + s) * 3 + i) * 1536 + col];
#pragma unroll
            for (int j = 0; j < 4; ++j) xp[3 + j] = bf2f(Z[(size_t)(r0 + j) * LDZ + ZC_GQKV + col]);
#pragma unroll
            for (int i = 0; i < 4; ++i) w[i] = KIN(15)[(size_t)(layer * 4 + i) * 1536 + col];
            LAS float* dst = pr == 0 ? Lq : pr == 1 ? Lk : Lv;
#pragma unroll
            for (int j = 0; j < 4; ++j) dst[j * 128 + d] = siluf_(w[0] * xp[j] + w[1] * xp[j + 1] + w[2] * xp[j + 2] + w[3] * xp[j + 3]);
        }
        __syncthreads();
        {
            LAS float* vp = (wave < 4 ? Lq : Lk) + (wave & 3) * 128;
            const float a = vp[2 * lane], b = vp[2 * lane + 1];
            const float scl = rsqrtf(wave_sum(a * a + b * b, lane) + EPS) * (wave < 4 ? 0.08838834764831845f : 1.f);
            vp[2 * lane] = a * scl; vp[2 * lane + 1] = b * scl;
        }
        if (tid < 4) {
            const float ga = ZS[(size_t)(r0 + tid) * 32 + 24 + h], gb = ZS[(size_t)(r0 + tid) * 32 + 28 + h];
            sc[tid] = __expf(-__expf(KIN(16)[layer * 4 + h]) * softplusf_(ga + KIN(17)[layer * 4 + h])); sc[4 + tid] = sigmoidf_(gb);
        }
        __syncthreads();
        const float* Sin = KIN(5) + ((size_t)((layer * 128 + s) * 4 + h) * 128 + 32 * part) * 128 + dv;
#pragma unroll
        for (int i = 0; i < 32; ++i) S[i] = Sin[(size_t)i * 128];
#pragma unroll
        for (int j = 0; j < 4; ++j) {
            const float a = sc[j], beta = sc[4 + j];
            float p = 0.f;
#pragma unroll
            for (int i = 0; i < 32; ++i) { S[i] *= a; p += Lk[j * 128 + 32 * part + i] * S[i]; }
            red[part * 128 + dv] = p;
            __syncthreads();
            const float delta = beta * (Lv[j * 128 + dv] - ((red[dv] + red[128 + dv]) + (red[256 + dv] + red[384 + dv])));
            __syncthreads();
            float o = 0.f;
#pragma unroll
            for (int i = 0; i < 32; ++i) { S[i] += Lk[j * 128 + 32 * part + i] * delta; o += Lq[j * 128 + 32 * part + i] * S[i]; }
            red[part * 128 + dv] = o;
            __syncthreads();
            if (part == 0) Lo[j * 128 + dv] = (red[dv] + red[128 + dv]) + (red[256 + dv] + red[384 + dv]);
            __syncthreads();
        }
        float* Sout = KOUT() + O_GSS + ((size_t)((layer * 128 + s) * 4 + h) * 128 + 32 * part) * 128 + dv;
#pragma unroll
        for (int i = 0; i < 32; ++i) Sout[(size_t)i * 128] = S[i];
        ((float*)(ws + WS_OGDN))[(size_t)(r0 + part) * 512 + h * 128 + dv] = Lo[part * 128 + dv];
    } else {
        const f32x2* ROT = (const f32x2*)(ws + WS_ROT);
        if (tid < 384) {
            const int pr = tid >> 7, d = tid & 127;
#pragma unroll
            for (int j = 0; j < 4; ++j) {
                const bf16* zp = Z + (size_t)(r0 + j) * LDZ + ZC_RQKV + pr * 512 + h * 128;
                float v = bf2f(zp[d]);
                if (pr < 2) { const f32x2 cs = ROT[(size_t)(2048 + j) * 64 + (d & 63)]; const float o = bf2f(zp[d ^ 64]);
                    v = (d < 64) ? v * cs.x - o * cs.y : v * cs.x + o * cs.y; if (pr == 1) v *= 0.08838834764831845f; }
                (pr == 0 ? Lq : pr == 1 ? Lk : Lv)[j * 128 + d] = v;
            }
        }
        __syncthreads();
        const float gam = __expf(ret_lg(h));
        const float* Sin = KIN(6) + ((size_t)((layer * 128 + s) * 4 + h) * 128 + 32 * part) * 128 + dv;
#pragma unroll
        for (int i = 0; i < 32; ++i) S[i] = Sin[(size_t)i * 128];
#pragma unroll
        for (int j = 0; j < 4; ++j) {
            const float vv = Lv[j * 128 + dv];
            float o = 0.f;
#pragma unroll
            for (int i = 0; i < 32; ++i) { S[i] = S[i] * gam + Lk[j * 128 + 32 * part + i] * vv; o += Lq[j * 128 + 32 * part + i] * S[i]; }
            red[part * 128 + dv] = o;
            __syncthreads();
            if (part == 0) Lo[j * 128 + dv] = (red[dv] + red[128 + dv]) + (red[256 + dv] + red[384 + dv]);
            __syncthreads();
        }
        float* Sout = KOUT() + O_RSS + ((size_t)((layer * 128 + s) * 4 + h) * 128 + 32 * part) * 128 + dv;
#pragma unroll
        for (int i = 0; i < 32; ++i) Sout[(size_t)i * 128] = S[i];
        if (wave < 4) {
            const int j = wave; const float a = Lo[j * 128 + 2 * lane], b = Lo[j * 128 + 2 * lane + 1];
            const float scl = rsqrtf(wave_sum(a * a + b * b, lane) * (1.f / 128.f) + EPS);
            const bf16* gp = Z + (size_t)(r0 + j) * LDZ + ZC_RG + h * 128 + 2 * lane;
            *(unsigned*)((bf16*)(ws + WS_MIX) + (size_t)(r0 + j) * 1536 + 1024 + h * 128 + 2 * lane) = pk2(a * scl * siluf_(bf2f(gp[0])), b * scl * siluf_(bf2f(gp[1])));
        }
    }
    __syncthreads();
}

DI void gdn_scan_chain(Frame& F, int layer, int bh) {
    const int tid = F.tid, lane = F.lane, wave = F.wave, quad = lane >> 4, rl = lane & 15;
    unsigned char* ws = KWS();
    const unsigned char* recb = ws + WS_GREC + (size_t)bh * 128 * GREC;
    LAS unsigned char* L = F.lds;
    constexpr int L_WP = 0, L_QP = 17408, L_KT = 34816, L_UT = 53248, L_QK = 71680;
    f32x4 S[8];
#pragma unroll
    for (int i = 0; i < 8; ++i) S[i] = (f32x4){0.f, 0.f, 0.f, 0.f};
    v4u pf[9]; float egl;
#pragma unroll
    for (int k = 0; k < 9; ++k) pf[k] = *(const v4u*)(recb + (size_t)(tid + 512 * k) * 16);
    egl = *(const float*)(recb + 73728);
    float* OG = (float*)(ws + WS_OGDN);
    const int b = bh >> 2, h = bh & 3;
    for (int c = 0; c < 128; ++c) {
        __syncthreads();
#pragma unroll
        for (int k = 0; k < 9; ++k) {
            const int o = tid * 16 + (k & 1) * 8192;
            const int reg = k >> 1;
            int dst;
            if (reg < 2) dst = (reg == 0 ? L_WP : L_QP) + (o >> 8) * 272 + (o & 255);
            else dst = (reg == 2 ? L_KT : reg == 3 ? L_UT : L_QK) + (o >> 7) * 144 + (o & 127);
            *(LAS v4u*)(L + dst) = pf[k];
        }
        const float eg = egl;
        __syncthreads();
        if (c + 1 < 128) {
            const unsigned char* rn = recb + (size_t)(c + 1) * GREC;
#pragma unroll
            for (int k = 0; k < 9; ++k) pf[k] = *(const v4u*)(rn + (size_t)(tid + 512 * k) * 16);
            egl = *(const float*)(rn + 73728);
        }
        bf16x8 Sb[4];
#pragma unroll
        for (int s = 0; s < 4; ++s) Sb[s] = pack_frag(S[2 * s], S[2 * s + 1]);
        f32x4 vn[4], O[4];
#pragma unroll
        for (int rt = 0; rt < 4; ++rt) {
            f32x4 wsacc = (f32x4){0.f, 0.f, 0.f, 0.f}, o = wsacc;
#pragma unroll
            for (int s = 0; s < 4; ++s) {
                wsacc = mfma16(ld_frag_l(L + L_WP + (16 * rt + rl) * 272 + (32 * s + 8 * quad) * 2), Sb[s], wsacc);
                o = mfma16(ld_frag_l(L + L_QP + (16 * rt + rl) * 272 + (32 * s + 8 * quad) * 2), Sb[s], o);
            }
            const v2u uw = *(const LAS v2u*)(L + L_UT + (16 * wave + rl) * 144 + (16 * rt + 4 * quad) * 2);
            vn[rt][0] = lo_bf(uw.x) - wsacc[0]; vn[rt][1] = hi_bf(uw.x) - wsacc[1]; vn[rt][2] = lo_bf(uw.y) - wsacc[2]; vn[rt][3] = hi_bf(uw.y) - wsacc[3];
            O[rt] = o;
        }
        bf16x8 Vb[2]; Vb[0] = pack_frag(vn[0], vn[1]); Vb[1] = pack_frag(vn[2], vn[3]);
#pragma unroll
        for (int rt = 0; rt < 4; ++rt) {
#pragma unroll
            for (int s2 = 0; s2 < 2; ++s2) O[rt] = mfma16(ld_frag_l(L + L_QK + (16 * rt + rl) * 144 + (32 * s2 + 8 * quad) * 2), Vb[s2], O[rt]);
            const size_t row = (size_t)b * TP + 64 * c + 16 * rt + 4 * quad;
#pragma unroll
            for (int i = 0; i < 4; ++i) OG[(row + i) * 512 + h * 128 + 16 * wave + rl] = O[rt][i];
        }
#pragma unroll
        for (int kt = 0; kt < 8; ++kt) {
            f32x4 a = S[kt] * eg;
#pragma unroll
            for (int s2 = 0; s2 < 2; ++s2) a = mfma16(ld_frag_l(L + L_KT + (16 * kt + rl) * 144 + (32 * s2 + 8 * quad) * 2), Vb[s2], a);
            S[kt] = a;
        }
    }
    float* So = KOUT() + O_GSP + (size_t)(layer * 8 + bh) * 16384;
#pragma unroll
    for (int kt = 0; kt < 8; ++kt)
#pragma unroll
        for (int i = 0; i < 4; ++i) So[(size_t)(16 * kt + 4 * quad + i) * 128 + 16 * wave + rl] = S[kt][i];
    __syncthreads();
}
DI void ret_scan_part(Frame& F, int layer, int r) {
    const int tid = F.tid, bh = r >> 2, dv = tid & 127, dk0 = ((r & 3) * 4 + (tid >> 7)) * 8, h = bh & 3;
    unsigned char* ws = KWS();
    const float* RKV = (const float*)(ws + WS_RKV) + (size_t)bh * 64 * 16384;
    bf16* RST = (bf16*)(ws + WS_RST) + (size_t)bh * 64 * 16384;
    const float cdec = __expf(128.f * ret_lg(h));
    float S[8];
#pragma unroll
    for (int i = 0; i < 8; ++i) S[i] = 0.f;
#pragma unroll 4
    for (int c = 0; c < 64; ++c) {
        v4u w; w.x = pk2(S[0], S[1]); w.y = pk2(S[2], S[3]); w.z = pk2(S[4], S[5]); w.w = pk2(S[6], S[7]);
        *(v4u*)(RST + (size_t)c * 16384 + dv * 128 + dk0) = w;
#pragma unroll
        for (int i = 0; i < 8; ++i) S[i] = S[i] * cdec + RKV[(size_t)c * 16384 + (dk0 + i) * 128 + dv];
    }
    float* So = KOUT() + O_RSP + (size_t)(layer * 8 + bh) * 16384;
#pragma unroll
    for (int i = 0; i < 8; ++i) So[(size_t)(dk0 + i) * 128 + dv] = S[i];
}
constexpr float SM_C = 0.125f * 1.4426950408889634f;
struct AttnState { float m, l; f32x4 O[4]; };
DI void attn_reset(AttnState& st) { st.m = -1e30f; st.l = 0.f;
#pragma unroll
    for (int i = 0; i < 4; ++i) st.O[i] = (f32x4){0.f, 0.f, 0.f, 0.f}; }
DI void qk_tile(const LAS unsigned char* Kt, const bf16x8 (&qf)[2], f32x4 (&s)[4], int rl, int quad) {
#pragma unroll
    for (int kt = 0; kt < 4; ++kt) { f32x4 a = (f32x4){0.f, 0.f, 0.f, 0.f};
#pragma unroll
        for (int kk = 0; kk < 2; ++kk) a = mfma16(ld_frag_l(Kt + (16 * kt + rl) * 144 + kk * 64 + quad * 16), qf[kk], a);
        s[kt] = a; }
}
template <class Mask> DI void attn_step(const LAS unsigned char* Kt, const LAS unsigned char* VT, const bf16x8 (&qf)[2], AttnState& st, const Mask& ok, int rl, int quad) {
    f32x4 s[4]; qk_tile(Kt, qf, s, rl, quad);
    float mx = -3e38f;
#pragma unroll
    for (int kt = 0; kt < 4; ++kt)
#pragma unroll
        for (int i = 0; i < 4; ++i) if (ok(16 * kt + 4 * quad + i)) mx = fmaxf(mx, s[kt][i]);
    const int lane = rl + 16 * quad;
    mx = fmaxf(mx, shx<16>(mx, lane)); mx = fmaxf(mx, shx<32>(mx, lane));
    const float mn = fmaxf(st.m, mx);
    const float alpha = exp2f((st.m - mn) * SM_C);
    float ls = 0.f;
#pragma unroll
    for (int kt = 0; kt < 4; ++kt)
#pragma unroll
        for (int i = 0; i < 4; ++i) { const float p = ok(16 * kt + 4 * quad + i) ? exp2f((s[kt][i] - mn) * SM_C) : 0.f; s[kt][i] = p; ls += p; }
    ls += shx<16>(ls, lane); ls += shx<32>(ls, lane);
    st.l = st.l * alpha + ls; st.m = mn;
#pragma unroll
    for (int dt = 0; dt < 4; ++dt) st.O[dt] *= alpha;
#pragma unroll
    for (int ii = 0; ii < 2; ++ii) {
        const bf16x8 pb = pack_frag(s[2 * ii], s[2 * ii + 1]);
#pragma unroll
        for (int dt = 0; dt < 4; ++dt) {
            const LAS unsigned char* vp = VT + (16 * dt + rl) * 144 + (32 * ii + 4 * quad) * 2;
            st.O[dt] = mfma16(mk_frag(*(const LAS v2u*)vp, *(const LAS v2u*)(vp + 32)), pb, st.O[dt]);
        }
    }
}
DI void attn_accum(f32x4 (&Of)[4], const AttnState& st, float gate) {
    const float sc = st.l > 0.f ? gate / st.l : 0.f;
#pragma unroll
    for (int dt = 0; dt < 4; ++dt) Of[dt] += st.O[dt] * sc;
}
DI void vt_write(LAS unsigned char* VT, int d0, int key, const v4u w) {
    LAS unsigned char* d = VT + d0 * 144 + key * 2;
    *(LAS bf16*)(d) = (bf16)(w.x & 0xffff); *(LAS bf16*)(d + 144) = (bf16)(w.x >> 16); *(LAS bf16*)(d + 2 * 144) = (bf16)(w.y & 0xffff); *(LAS bf16*)(d + 3 * 144) = (bf16)(w.y >> 16);
    *(LAS bf16*)(d + 4 * 144) = (bf16)(w.z & 0xffff); *(LAS bf16*)(d + 5 * 144) = (bf16)(w.z >> 16); *(LAS bf16*)(d + 6 * 144) = (bf16)(w.w & 0xffff); *(LAS bf16*)(d + 7 * 144) = (bf16)(w.w >> 16);
}
DI void stage_wg(LAS unsigned char* Kt, LAS unsigned char* VT, const bf16* kb, const bf16* vb, size_t stride, int tid, bool do_v) {
    const int key = tid >> 3, ch = tid & 7;
    *(LAS v4u*)(Kt + key * 144 + ch * 16) = *(const v4u*)(kb + key * stride + ch * 8);
    if (do_v) vt_write(VT, ch * 8, key, *(const v4u*)(vb + key * stride + ch * 8));
}
DI int top16(float v0, float v1, int lane) {
    int sel = 0;
#pragma unroll 1
    for (int r = 0; r < 16; ++r) {
        float bv; int bi;
        if (v0 >= v1) { bv = v0; bi = lane; } else { bv = v1; bi = lane + 64; }
#define T16_STEP(M) { const float ov = shx<M>(bv, lane); const int oi = shxi<M>(bi, lane); const bool take = (ov > bv) || (ov == bv && oi < bi); bv = take ? ov : bv; bi = take ? oi : bi; }
        T16_STEP(32) T16_STEP(16) T16_STEP(8) T16_STEP(4) T16_STEP(2) T16_STEP(1)
#undef T16_STEP
        const bool h0 = (bi == lane), h1 = (bi == lane + 64);
        v0 = h0 ? -3e38f : v0; v1 = h1 ? -3e38f : v1; sel |= (h0 ? 1 : 0) | (h1 ? 2 : 0);
    }
    return sel;
}

typedef short v4i16_t __attribute__((ext_vector_type(4)));
DI s16x4 vtr(const LAS unsigned char* p) { return __builtin_bit_cast(s16x4, __builtin_amdgcn_ds_read_tr16_b64_v4i16((LAS v4i16_t*)p)); }
DI bf16x8 cat4(s16x4 a, s16x4 b) { bf16x8 r; r[0] = a[0]; r[1] = a[1]; r[2] = a[2]; r[3] = a[3]; r[4] = b[0]; r[5] = b[1]; r[6] = b[2]; r[7] = b[3]; return r; }
DI void attn_step3(const LAS unsigned char* Kt, const LAS unsigned char* Vt, const bf16x8 (&qf)[2], AttnState& st, int lo, int hi, bool active, int rl, int quad) {
    active = active && (hi >= lo);
    if (!__any(active)) return;
    f32x4 s[4]; qk_tile(Kt, qf, s, rl, quad);
    const int lane = rl + 16 * quad;
    const bool full = __all((lo <= 0 && hi >= 63) || !active);
    const int kq = 4 * quad - lo; const unsigned rng = (unsigned)(hi - lo);
    float lm;
    if (full) {
        const float a0 = fmaxf(fmaxf(s[0][0], s[0][1]), fmaxf(s[0][2], s[0][3])), a1 = fmaxf(fmaxf(s[1][0], s[1][1]), fmaxf(s[1][2], s[1][3]));
        const float a2 = fmaxf(fmaxf(s[2][0], s[2][1]), fmaxf(s[2][2], s[2][3])), a3 = fmaxf(fmaxf(s[3][0], s[3][1]), fmaxf(s[3][2], s[3][3]));
        lm = fmaxf(fmaxf(a0, a1), fmaxf(a2, a3));
    } else {
        lm = -3e38f;
#pragma unroll
        for (int kt = 0; kt < 4; ++kt)
#pragma unroll
            for (int i = 0; i < 4; ++i) lm = ((unsigned)(kq + 16 * kt + i) <= rng) ? fmaxf(lm, s[kt][i]) : lm;
    }
    lm = active ? lm : -3e38f;
    if (__any(lm > st.m + 320.f)) {
        float mx = fmaxf(lm, shx<16>(lm, lane)); mx = fmaxf(mx, shx<32>(mx, lane));
        const float mn = fmaxf(st.m, mx);
        const float alpha = __builtin_amdgcn_exp2f((st.m - mn) * SM_C);
        st.l *= alpha; st.m = mn;
#pragma unroll
        for (int dt = 0; dt < 4; ++dt) st.O[dt] *= alpha;
    }
    const float mc = active ? st.m * SM_C : __builtin_inff();
    float ls = 0.f;
    if (full) {
#pragma unroll
        for (int kt = 0; kt < 4; ++kt)
#pragma unroll
            for (int i = 0; i < 4; ++i) { const float p = __builtin_amdgcn_exp2f(s[kt][i] * SM_C - mc); s[kt][i] = p; ls += p; }
    } else {
#pragma unroll
        for (int kt = 0; kt < 4; ++kt)
#pragma unroll
            for (int i = 0; i < 4; ++i) { const float p = ((unsigned)(kq + 16 * kt + i) <= rng) ? __builtin_amdgcn_exp2f(s[kt][i] * SM_C - mc) : 0.f; s[kt][i] = p; ls += p; }
    }
    st.l += ls;
#pragma unroll
    for (int ii = 0; ii < 2; ++ii) {
        const bf16x8 pb = pack_frag(s[2 * ii], s[2 * ii + 1]);
#pragma unroll
        for (int dt = 0; dt < 4; ++dt) {
            const LAS unsigned char* vp = Vt + (32 * ii + 4 * quad + (rl >> 2)) * 144 + (16 * dt + 4 * (rl & 3)) * 2;
            st.O[dt] = mfma16(cat4(vtr(vp), vtr(vp + 16 * 144)), pb, st.O[dt]);
        }
    }
}
DI float attn_rowsum(const AttnState& st, int lane) { float l = st.l; l += shx<16>(l, lane); l += shx<32>(l, lane); return l; }
DI void attn_accum3(f32x4 (&Of)[4], const AttnState& st, float gate, int lane) {
    const float l = attn_rowsum(st, lane);
    const float sc = l > 0.f ? gate / l : 0.f;
#pragma unroll
    for (int dt = 0; dt < 4; ++dt) Of[dt] += st.O[dt] * sc;
}
DI void nsa_prompt_unit(Frame& F, int layer, int unit) {
    int lane = F.lane, wave = F.wave; asm volatile("" : "+v"(lane), "+s"(wave));
    const int tid = wave * 64 + lane, quad = lane >> 4, rl = lane & 15;
    const int b = unit >> 9, g = (unit >> 8) & 1, tt = unit & 255, t0 = 32 * tt;
    unsigned char* ws = KWS();
    const bf16* Z = (const bf16*)(ws + WS_Z);
    const float* ZS = (const float*)(ws + WS_ZS);
    LAS unsigned char* TB = F.lds;
    LAS float* AIMP = (LAS float*)(F.lds + 36864);
    LAS unsigned* SEL = (LAS unsigned*)(F.lds + 102400);
    const int tk = 4 * wave + (rl >> 2), t = t0 + tk, head = 4 * g + (rl & 3);
    const size_t row = (size_t)b * TP + t;
    bf16x8 qf[2];
    qf[0] = ld_frag_g(Z + row * LDZ + ZC_Q + head * 64 + quad * 8); qf[1] = ld_frag_g(Z + row * LDZ + ZC_Q + head * 64 + 32 + quad * 8);
    const float gc = sigmoidf_(ZS[row * 32 + head * 3]), gs = sigmoidf_(ZS[row * 32 + head * 3 + 1]), gw = sigmoidf_(ZS[row * 32 + head * 3 + 2]);
    f32x4 Of[4];
#pragma unroll
    for (int i = 0; i < 4; ++i) Of[i] = (f32x4){0.f, 0.f, 0.f, 0.f};
    AttnState st;
    const int nct = (t0 >> 10) + 1;
    const bf16* KC = (const bf16*)(ws + WS_KC) + ((size_t)(0 * 2 + b) * 512 * 2 + g) * 64;
    const bf16* VC = (const bf16*)(ws + WS_KC) + ((size_t)(1 * 2 + b) * 512 * 2 + g) * 64;
    const bf16* Zb = Z + (size_t)b * TP * LDZ + g * 64;
    const int skey = tid >> 3, sch = tid & 7;
    const int wlo = (t0 - 511 > 0 ? t0 - 511 : 0) >> 6, nwin = ((t0 + 31) >> 6) - wlo + 1;
    v4u rk0, rv0, rk1, rv1, rk2, rv2;
    const int n1 = nwin + 2 * nct;
#define SEG1_ISSUE(i, rk, rv) do { const int i_ = (i); if (i_ < nwin) { const bf16* p_ = Zb + (size_t)(64 * (wlo + i_) + skey) * LDZ + sch * 8; rk = *(const v4u*)(p_ + ZC_KW); rv = *(const v4u*)(p_ + ZC_VW); } \
        else { const int jt_ = (i_ - nwin) % nct; const size_t o_ = (size_t)(64 * jt_ + skey) * 128 + sch * 8; rk = *(const v4u*)(KC + o_); rv = *(const v4u*)(VC + o_); } } while (0)
#define COMMIT(bufi, rk, rv) do { LAS unsigned char* d_ = TB + (bufi) * 18432 + skey * 144 + sch * 16; *(LAS v4u*)d_ = rk; *(LAS v4u*)(d_ + 9216) = rv; } while (0)
    attn_reset(st);
    float mfin = 0.f, il = 0.f;
#define SEG1_COMPUTE(i) do { \
        const LAS unsigned char* Kt = TB + ((i) & 1) * 18432; const LAS unsigned char* Vt = Kt + 9216; \
        if ((i) < nwin) { \
            const int kb = 64 * (wlo + (i)); \
            attn_step3(Kt, Vt, qf, st, t - 511 - kb, t - kb, true, rl, quad); \
            if ((i) == nwin - 1) { attn_accum3(Of, st, gw, lane); attn_reset(st); } \
        } else if ((i) < nwin + nct) { \
            const int nb = 64 * ((i) - nwin); \
            attn_step3(Kt, Vt, qf, st, 0, ((t - 31) >> 4) - nb, true, rl, quad); \
            if ((i) == nwin + nct - 1) { attn_accum3(Of, st, gc, lane); mfin = st.m * SM_C; const float lt_ = attn_rowsum(st, lane); il = lt_ > 0.f ? 1.f / lt_ : 0.f; } \
        } else { \
            const int jt = (i) - nwin - nct; \
            f32x4 s[4]; qk_tile(Kt, qf, s, rl, quad); \
            _Pragma("unroll") for (int kt = 0; kt < 4; ++kt) \
            _Pragma("unroll") for (int e = 0; e < 4; ++e) { \
                    const int n = 64 * jt + 16 * kt + 4 * quad + e; \
                    float p = (16 * n + 31 <= t) ? __builtin_amdgcn_exp2f(s[kt][e] * SM_C - mfin) * il : 0.f; \
                    p += shx<1>(p, lane); p += shx<2>(p, lane); \
                    if ((rl & 3) == 0) AIMP[tk * 512 + n] = p; \
                } \
        } } while (0)
#define SEG1_STEP(i, rkc, rvc, rkn, rvn) do { if ((i) < n1) { SEG1_COMPUTE(i); if ((i) + 1 < n1) COMMIT(((i) + 1) & 1, rkn, rvn); __syncthreads(); if ((i) + 3 < n1) SEG1_ISSUE((i) + 3, rkc, rvc); } } while (0)
    SEG1_ISSUE(0, rk0, rv0); if (n1 > 1) SEG1_ISSUE(1, rk1, rv1); if (n1 > 2) SEG1_ISSUE(2, rk2, rv2);
    COMMIT(0, rk0, rv0); __syncthreads();
    for (int i = 0; i < n1; i += 3) { SEG1_STEP(i, rk0, rv0, rk1, rv1); SEG1_STEP(i + 1, rk1, rv1, rk2, rv2); SEG1_STEP(i + 2, rk2, rv2, rk0, rv0); }
    {
        const int nav = nct * 64;
#pragma unroll 1
        for (int q = 0; q < 4; ++q) {
            const int tq = 4 * wave + q, tp = t0 + tq, cur = tp >> 6;
            float sc2[2];
#pragma unroll
            for (int e = 0; e < 2; ++e) {
                const int sblk = lane + 64 * e;
                float imp = 0.f;
#pragma unroll
                for (int d = -1; d <= 3; ++d) { const int n = 4 * sblk + d; if (n >= 0 && n < nav) imp += AIMP[tq * 512 + n]; }
                const bool valid = sblk <= cur, forced = (sblk == 0) || (sblk == cur) || (sblk == cur - 1);
                sc2[e] = valid ? imp + (forced ? 1000.f : 0.f) : -1e30f;
            }
            const int sel = top16(sc2[0], sc2[1], lane);
            const unsigned long long m0 = __ballot((sel & 1) && (lane <= cur)), m1 = __ballot((sel & 2) && (lane + 64 <= cur));
            if (lane == 0) { SEL[tq * 4 + 0] = (unsigned)m0; SEL[tq * 4 + 1] = (unsigned)(m0 >> 32); SEL[tq * 4 + 2] = (unsigned)m1; SEL[tq * 4 + 3] = (unsigned)(m1 >> 32); }
        }
    }
    __syncthreads();
    unsigned un[4], my[4], wv[4];
#pragma unroll
    for (int w = 0; w < 4; ++w) { unsigned v = (lane < 32) ? SEL[lane * 4 + w] : 0u;
        v |= (unsigned)shxi<1>((int)v, lane); v |= (unsigned)shxi<2>((int)v, lane); v |= (unsigned)shxi<4>((int)v, lane); v |= (unsigned)shxi<8>((int)v, lane); v |= (unsigned)shxi<16>((int)v, lane); v |= (unsigned)shxi<32>((int)v, lane);
        un[w] = __builtin_amdgcn_readfirstlane(v); my[w] = SEL[tk * 4 + w];
        wv[w] = SEL[(4 * wave) * 4 + w] | SEL[(4 * wave + 1) * 4 + w] | SEL[(4 * wave + 2) * 4 + w] | SEL[(4 * wave + 3) * 4 + w]; wv[w] = __builtin_amdgcn_readfirstlane(wv[w]); }
    attn_reset(st);
    {
        unsigned w0 = un[0], w1 = un[1], w2 = un[2], w3 = un[3];
#define NEXT_BLK(dst) do { if (w0) { dst = __builtin_ctz(w0); w0 &= w0 - 1u; } else if (w1) { dst = 32 + __builtin_ctz(w1); w1 &= w1 - 1u; } else if (w2) { dst = 64 + __builtin_ctz(w2); w2 &= w2 - 1u; } \
        else if (w3) { dst = 96 + __builtin_ctz(w3); w3 &= w3 - 1u; } else dst = -1; } while (0)
#define SEG2_ISSUE(blk_, rk, rv) do { const bf16* p_ = Zb + (size_t)(64 * (blk_) + skey) * LDZ + sch * 8; rk = *(const v4u*)(p_ + ZC_KS); rv = *(const v4u*)(p_ + ZC_VS); } while (0)
        int bq0, bq1, bq2, bq3;
        NEXT_BLK(bq0); NEXT_BLK(bq1); NEXT_BLK(bq2);
        SEG2_ISSUE(bq0, rk0, rv0); if (bq1 >= 0) SEG2_ISSUE(bq1, rk1, rv1); if (bq2 >= 0) SEG2_ISSUE(bq2, rk2, rv2);
        COMMIT(0, rk0, rv0); __syncthreads();
        int i = 0;
#define SEG2_STEP(rkc, rvc, rkn, rvn) do { if (bq0 >= 0) { \
            NEXT_BLK(bq3); \
            const LAS unsigned char* Kt = TB + (i & 1) * 18432; const LAS unsigned char* Vt = Kt + 9216; \
            const int wsel = bq0 >> 5, bit = bq0 & 31; \
            const unsigned wword = wsel == 0 ? wv[0] : wsel == 1 ? wv[1] : wsel == 2 ? wv[2] : wv[3]; \
            if ((wword >> bit) & 1u) { \
                const unsigned mword = wsel == 0 ? my[0] : wsel == 1 ? my[1] : wsel == 2 ? my[2] : my[3]; \
                const bool mine = (mword >> bit) & 1u; const int kb = 64 * bq0; \
                attn_step3(Kt, Vt, qf, st, 0, t - kb, mine, rl, quad); \
            } \
            if (bq1 >= 0) COMMIT((i + 1) & 1, rkn, rvn); \
            __syncthreads(); \
            if (bq3 >= 0) SEG2_ISSUE(bq3, rkc, rvc); \
            bq0 = bq1; bq1 = bq2; bq2 = bq3; ++i; } } while (0)
        while (bq0 >= 0) { SEG2_STEP(rk0, rv0, rk1, rv1); SEG2_STEP(rk1, rv1, rk2, rv2); SEG2_STEP(rk2, rv2, rk0, rv0); }
    }
    attn_accum3(Of, st, gs, lane);
#undef SEG1_ISSUE
#undef SEG1_COMPUTE
#undef SEG1_STEP
#undef SEG2_ISSUE
#undef SEG2_STEP
#undef COMMIT
#undef NEXT_BLK
    bf16* MIX = (bf16*)(ws + WS_MIX) + row * 1536 + head * 64;
#pragma unroll
    for (int dt = 0; dt < 4; ++dt) { v2u w; w.x = pk2(Of[dt][0], Of[dt][1]); w.y = pk2(Of[dt][2], Of[dt][3]); *(v2u*)(MIX + 16 * dt + 4 * quad) = w; }
    __syncthreads();
}

#define CB() asm volatile("" ::: "memory")
DI void stage_wave_f32(LAS unsigned char* Kt, LAS unsigned char* Vt, const float* kb, const float* vb, size_t stride, int lane) {
    const int k0 = lane >> 3, ch = lane & 7;
#pragma unroll
    for (int h = 0; h < 4; ++h) {
        const float* src = (h < 2 ? kb : vb); LAS unsigned char* dst = (h < 2 ? Kt : Vt); const int r0 = (h & 1) * 32;
        f32x4 a[4][2];
#pragma unroll
        for (int it = 0; it < 4; ++it) { const float* kp = src + (size_t)(r0 + it * 8 + k0) * stride + ch * 8; a[it][0] = *(const f32x4*)kp; a[it][1] = *(const f32x4*)(kp + 4); }
#pragma unroll
        for (int it = 0; it < 4; ++it) *(LAS v4u*)(dst + (r0 + it * 8 + k0) * 144 + ch * 16) = pack8(a[it][0], a[it][1]);
        asm volatile("" ::: "memory");
    }
}
DI void stage_wave_b16(LAS unsigned char* Kt, LAS unsigned char* Vt, const bf16* kb, const bf16* vb, size_t stride, int nvalid, int lane, bool do_v) {
    const int k0 = lane >> 3, ch = lane & 7;
    const v4u z = (v4u){0u, 0u, 0u, 0u};
#pragma unroll
    for (int it = 0; it < 8; ++it) {
        const int key = it * 8 + k0; const bool v = key < nvalid;
        *(LAS v4u*)(Kt + key * 144 + ch * 16) = v ? *(const v4u*)(kb + key * stride + ch * 8) : z;
        if (do_v) *(LAS v4u*)(Vt + key * 144 + ch * 16) = v ? *(const v4u*)(vb + key * stride + ch * 8) : z;
    }
}
DI void nsa_sample_unit(Frame& F, int layer, int s) {
    int lane = F.lane, wave = F.wave; asm volatile("" : "+v"(lane), "+s"(wave));
    const int quad = lane >> 4, rl = lane & 15;
    const int g = wave & 1, q4 = wave >> 1;
    unsigned char* ws = KWS();
    const bf16* Z = (const bf16*)(ws + WS_Z);
    const float* ZS = (const float*)(ws + WS_ZS);
    LAS unsigned char* Kt = F.lds + wave * 18432; LAS unsigned char* Vt = Kt + 9216;
    LAS float* AIMP = (LAS float*)Vt;
    const int j = rl >> 2, head = 4 * g + (rl & 3), qpos = 2048 + j;
    const size_t row = (size_t)MP + 4 * s + j;
    bf16x8 qf[2];
    qf[0] = ld_frag_g(Z + row * LDZ + ZC_Q + head * 64 + quad * 8); qf[1] = ld_frag_g(Z + row * LDZ + ZC_Q + head * 64 + 32 + quad * 8);
    const float gc = sigmoidf_(ZS[row * 32 + head * 3]), gs = sigmoidf_(ZS[row * 32 + head * 3 + 1]), gw = sigmoidf_(ZS[row * 32 + head * 3 + 2]);
    f32x4 Of[4];
#pragma unroll
    for (int i = 0; i < 4; ++i) Of[i] = (f32x4){0.f, 0.f, 0.f, 0.f};
    AttnState st;
    const bf16* KC = (const bf16*)(ws + WS_KCS) + ((size_t)(0 * 128 + s) * 128 * 2 + g) * 64;
    const bf16* VC = (const bf16*)(ws + WS_KCS) + ((size_t)(1 * 128 + s) * 128 * 2 + g) * 64;
    attn_reset(st);
#pragma unroll 1
    for (int jt = 0; jt < 2; ++jt) {
        stage_wave_b16(Kt, Vt, KC + (size_t)64 * jt * 128, VC + (size_t)64 * jt * 128, 128, 64, lane, true); CB();
        attn_step3(Kt, Vt, qf, st, 0, 126 - 64 * jt, true, rl, quad); CB();
    }
    attn_accum3(Of, st, q4 == 0 ? gc : 0.f, lane);
    {
        const float mfin = st.m * SM_C, lt = attn_rowsum(st, lane), il = lt > 0.f ? 1.f / lt : 0.f;
#pragma unroll 1
        for (int jt = 0; jt < 2; ++jt) {
            stage_wave_b16(Kt, Vt, KC + (size_t)64 * jt * 128, VC, 128, 64, lane, false); CB();
            f32x4 sv[4]; qk_tile(Kt, qf, sv, rl, quad); CB();
#pragma unroll
            for (int kt = 0; kt < 4; ++kt)
#pragma unroll
                for (int i = 0; i < 4; ++i) {
                    const int n = 64 * jt + 16 * kt + 4 * quad + i;
                    float p = (n <= 126) ? __builtin_amdgcn_exp2f(sv[kt][i] * SM_C - mfin) * il : 0.f;
                    p += shx<1>(p, lane); p += shx<2>(p, lane);
                    if ((rl & 3) == 0) AIMP[j * 128 + n] = p;
                }
        }
    }
    CB();
    unsigned long long msk[4];
#pragma unroll 1
    for (int q = 0; q < 4; ++q) {
        float imp = 0.f;
#pragma unroll
        for (int d = -1; d <= 3; ++d) { const int n = 4 * lane + d; if (n >= 0 && n <= 126 && lane < 33) imp += AIMP[q * 128 + n]; }
        const bool forced = (lane == 0) || (lane == 32) || (lane == 31);
        const float sc = (lane < 33) ? imp + (forced ? 1000.f : 0.f) : -3e38f;
        const int sel = top16(sc, -3e38f, lane);
        msk[q] = __ballot((sel & 1) && lane < 33);
    }
    CB();
    const unsigned long long un = msk[0] | msk[1] | msk[2] | msk[3];
    const unsigned long long mym = j == 0 ? msk[0] : j == 1 ? msk[1] : j == 2 ? msk[2] : msk[3];
    const int* pt = (const int*)KIN(7);
    AttnState sw;
    attn_reset(st); attn_reset(sw);
    {
        unsigned long long word = un; int idx = 0;
        while (word) {
            const int blk = __builtin_ctzll(word); word &= word - 1ull;
            if ((idx++ & 3) != q4) continue;
            if (blk < 32) {
                const int phys = pt[s * 16 + (blk >> 1)];
                const float* base = KIN(2) + ((size_t)(layer * 2560 + phys) * 128 + (blk & 1) * 64) * 512 + g * 64;
                stage_wave_f32(Kt, Vt, base + 256, base + 384, 512, lane); CB();
            } else {
                stage_wave_b16(Kt, Vt, Z + (size_t)(MP + 4 * s) * LDZ + ZC_KS + g * 64, Z + (size_t)(MP + 4 * s) * LDZ + ZC_VS + g * 64, LDZ, 4, lane, true); CB();
            }
            attn_step3(Kt, Vt, qf, st, 0, qpos - 64 * blk, (mym >> blk) & 1ull, rl, quad); CB();
        }
#pragma unroll 1
        for (int jt = 0; jt < 9; ++jt) {
            if ((idx++ & 3) != q4) continue;
            if (jt < 8) { const float* base = KIN(3) + ((size_t)(layer * 128 + s) * 512 + 64 * jt) * 256 + g * 64; stage_wave_f32(Kt, Vt, base, base + 128, 256, lane); CB(); }
            else { stage_wave_b16(Kt, Vt, Z + (size_t)(MP + 4 * s) * LDZ + ZC_KW + g * 64, Z + (size_t)(MP + 4 * s) * LDZ + ZC_VW + g * 64, LDZ, 4, lane, true); CB(); }
            attn_step3(Kt, Vt, qf, sw, j + 1 - 64 * jt, 512 + j - 64 * jt, true, rl, quad); CB();
        }
    }
    int lane2 = lane; asm volatile("" : "+v"(lane2));
    LAS float* X = (LAS float*)(F.lds + wave * 18432);
    {
        const float ls = attn_rowsum(st, lane), lw = attn_rowsum(sw, lane);
        X[0 * 64 + lane2] = st.m; X[1 * 64 + lane2] = ls; X[18 * 64 + lane2] = sw.m; X[19 * 64 + lane2] = lw;
#pragma unroll
        for (int dt = 0; dt < 4; ++dt)
#pragma unroll
            for (int e = 0; e < 4; ++e) { X[(2 + 4 * dt + e) * 64 + lane2] = st.O[dt][e]; X[(20 + 4 * dt + e) * 64 + lane2] = sw.O[dt][e]; }
    }
    __syncthreads();
    if (q4 == 0) {
#pragma unroll
        for (int br = 0; br < 2; ++br) {
            float m[4], l[4];
#pragma unroll
            for (int q = 0; q < 4; ++q) { const LAS float* Y = (const LAS float*)(F.lds + (2 * q + g) * 18432) + br * 18 * 64; m[q] = Y[lane2]; l[q] = Y[64 + lane2]; }
            const float mm = fmaxf(fmaxf(m[0], m[1]), fmaxf(m[2], m[3]));
            float w[4], lt = 0.f;
#pragma unroll
            for (int q = 0; q < 4; ++q) { w[q] = __builtin_amdgcn_exp2f((m[q] - mm) * SM_C); lt += l[q] * w[q]; }
            const float gate = br == 0 ? gs : gw;
            const float sc = lt > 0.f ? gate / lt : 0.f;
#pragma unroll
            for (int q = 0; q < 4; ++q) { const LAS float* Y = (const LAS float*)(F.lds + (2 * q + g) * 18432) + br * 18 * 64; const float wq = w[q] * sc;
#pragma unroll
                for (int dt = 0; dt < 4; ++dt)
#pragma unroll
                    for (int e = 0; e < 4; ++e) Of[dt][e] += Y[(2 + 4 * dt + e) * 64 + lane2] * wq; }
        }
        bf16* MIX = (bf16*)(ws + WS_MIX) + row * 1536 + head * 64;
#pragma unroll
        for (int dt = 0; dt < 4; ++dt) { v2u w2; w2.x = pk2(Of[dt][0], Of[dt][1]); w2.y = pk2(Of[dt][2], Of[dt][3]); *(v2u*)(MIX + 16 * dt + 4 * quad) = w2; }
    }
    __syncthreads();
}
DI void ret_out_unit(Frame& F, int layer, int unit) {
    const int tid = F.tid, lane = F.lane, wave = F.wave, quad = lane >> 4, rl = lane & 15;
    const int b = unit >> 8, h = (unit >> 6) & 3, c = unit & 63;
    const int row0 = b * TP + 128 * c;
    unsigned char* ws = KWS();
    const bf16* Z = (const bf16*)(ws + WS_Z);
    const bf16* QR = (const bf16*)(ws + WS_QR); const bf16* KR = (const bf16*)(ws + WS_KR);
    const bf16* RST = (const bf16*)(ws + WS_RST) + (size_t)unit * 16384;
    LAS unsigned char* LQ = F.lds; LAS unsigned char* LK = F.lds + 34816; LAS unsigned char* LV = F.lds + 69632; LAS unsigned char* LS = F.lds + 104448;
    for (int it = tid; it < 2048; it += NTHREADS) {
        const int j = it >> 4, cc = it & 15;
        *(LAS v4u*)(LQ + j * 272 + cc * 16) = *(const v4u*)(QR + (size_t)(row0 + j) * 512 + h * 128 + cc * 8);
        *(LAS v4u*)(LK + j * 272 + cc * 16) = *(const v4u*)(KR + (size_t)(row0 + j) * 512 + h * 128 + cc * 8);
        *(LAS v4u*)(LS + j * 272 + cc * 16) = *(const v4u*)(RST + (size_t)j * 128 + cc * 8);
        const v4u w = *(const v4u*)(Z + (size_t)(row0 + j) * LDZ + ZC_RQKV + 1024 + h * 128 + cc * 8);
        LAS unsigned char* d = LV + (cc * 8) * 272 + j * 2;
        *(LAS bf16*)(d) = (bf16)(w.x & 0xffff); *(LAS bf16*)(d + 272) = (bf16)(w.x >> 16); *(LAS bf16*)(d + 2 * 272) = (bf16)(w.y & 0xffff); *(LAS bf16*)(d + 3 * 272) = (bf16)(w.y >> 16);
        *(LAS bf16*)(d + 4 * 272) = (bf16)(w.z & 0xffff); *(LAS bf16*)(d + 5 * 272) = (bf16)(w.z >> 16); *(LAS bf16*)(d + 6 * 272) = (bf16)(w.w & 0xffff); *(LAS bf16*)(d + 7 * 272) = (bf16)(w.w >> 16);
    }
    __syncthreads();
    const float lg = ret_lg(h);
    const int il = 16 * wave + rl;
    bf16x8 qb[4];
#pragma unroll
    for (int s = 0; s < 4; ++s) qb[s] = ld_frag_l(LQ + il * 272 + (32 * s + 8 * quad) * 2);
    f32x4 C[8];
    const float qdec = __expf((float)(il + 1) * lg);
#pragma unroll
    for (int dt = 0; dt < 8; ++dt) {
        f32x4 a = (f32x4){0.f, 0.f, 0.f, 0.f};
#pragma unroll
        for (int s = 0; s < 4; ++s) a = mfma16(ld_frag_l(LS + (16 * dt + rl) * 272 + (32 * s + 8 * quad) * 2), qb[s], a);
        C[dt] = a * qdec;
    }
    for (int s2 = 0; s2 <= (wave >> 1); ++s2) {
        f32x4 P[2];
#pragma unroll
        for (int e = 0; e < 2; ++e) {
            const int jt = 2 * s2 + e;
            f32x4 a = (f32x4){0.f, 0.f, 0.f, 0.f};
            if (jt <= wave) {
#pragma unroll
                for (int s = 0; s < 4; ++s) a = mfma16(ld_frag_l(LK + (16 * jt + rl) * 272 + (32 * s + 8 * quad) * 2), qb[s], a);
#pragma unroll
                for (int i = 0; i < 4; ++i) { const int jj = 16 * jt + 4 * quad + i; a[i] = (il >= jj) ? a[i] * __expf((float)(il - jj) * lg) : 0.f; }
            }
            P[e] = a;
        }
        const bf16x8 pb = pack_frag(P[0], P[1]);
#pragma unroll
        for (int dt = 0; dt < 8; ++dt) {
            const LAS unsigned char* vp = LV + (16 * dt + rl) * 272 + (32 * s2 + 4 * quad) * 2;
            C[dt] = mfma16(mk_frag(*(const LAS v2u*)vp, *(const LAS v2u*)(vp + 32)), pb, C[dt]);
        }
    }
    float ss = 0.f;
#pragma unroll
    for (int dt = 0; dt < 8; ++dt) ss += (C[dt][0] * C[dt][0] + C[dt][1] * C[dt][1]) + (C[dt][2] * C[dt][2] + C[dt][3] * C[dt][3]);
    ss += shx<16>(ss, lane); ss += shx<32>(ss, lane);
    const float scl = rsqrtf(ss * (1.f / 128.f) + EPS);
    const size_t row = (size_t)row0 + il;
#pragma unroll
    for (int dt = 0; dt < 8; ++dt) {
        const v2u gwd = *(const v2u*)(Z + row * LDZ + ZC_RG + h * 128 + 16 * dt + 4 * quad);
        v2u w; w.x = pk2(C[dt][0] * scl * siluf_(lo_bf(gwd.x)), C[dt][1] * scl * siluf_(hi_bf(gwd.x))); w.y = pk2(C[dt][2] * scl * siluf_(lo_bf(gwd.y)), C[dt][3] * scl * siluf_(hi_bf(gwd.y)));
        *(v2u*)((bf16*)(ws + WS_MIX) + row * 1536 + 1024 + h * 128 + 16 * dt + 4 * quad) = w;
    }
    __syncthreads();
}
DI void gdn_out_row(Frame& F, int layer, int row) {
    const int lane = F.lane;
    unsigned char* ws = KWS();
    const float* o = (const float*)(ws + WS_OGDN) + (size_t)row * 512 + lane * 8;
    const f32x4 a = *(const f32x4*)o, b = *(const f32x4*)(o + 4);
    float ss = (a[0] * a[0] + a[1] * a[1]) + (a[2] * a[2] + a[3] * a[3]) + (b[0] * b[0] + b[1] * b[1]) + (b[2] * b[2] + b[3] * b[3]);
    ss += shx<1>(ss, lane); ss += shx<2>(ss, lane); ss += shx<4>(ss, lane); ss += shx<8>(ss, lane);
    const float scl = rsqrtf(ss * (1.f / 128.f) + EPS);
    const float* ng = KIN(18) + layer * 128 + (lane & 15) * 8;
    const f32x4 ga = *(const f32x4*)ng, gb = *(const f32x4*)(ng + 4);
    f32x4 za, zb; unpack8(*(const v4u*)((const bf16*)(ws + WS_Z) + (size_t)row * LDZ + ZC_GZ + lane * 8), za, zb);
    f32x4 ra, rb;
#pragma unroll
    for (int e = 0; e < 4; ++e) { ra[e] = a[e] * scl * ga[e] * siluf_(za[e]); rb[e] = b[e] * scl * gb[e] * siluf_(zb[e]); }
    *(v4u*)((bf16*)(ws + WS_MIX) + (size_t)row * 1536 + 512 + lane * 8) = pack8(ra, rb);
}
DI void final_row(Frame& F, int row) {
    const int lane = F.lane;
    const float* x = (const float*)(KWS() + WS_XR) + (size_t)row * DM;
    float* y = (row < MP) ? KOUT() + O_YP + (size_t)row * DM : KOUT() + O_YS + (size_t)(row - MP) * DM;
    f32x4 v[4]; float ss = 0.f;
#pragma unroll
    for (int j = 0; j < 4; ++j) { v[j] = *(const f32x4*)(x + 256 * j + lane * 4); ss += (v[j][0] * v[j][0] + v[j][1] * v[j][1]) + (v[j][2] * v[j][2] + v[j][3] * v[j][3]); }
    const float scl = rsqrtf(wave_sum(ss, lane) * (1.f / DM) + EPS);
#pragma unroll
    for (int j = 0; j < 4; ++j) *(f32x4*)(y + 256 * j + lane * 4) = v[j] * scl * *(const f32x4*)(KIN(26) + 256 * j + lane * 4);
}
#ifndef PH_P0
#define PH_P0 1
#endif
#ifndef PH_A
#define PH_A 1
#endif
#ifndef PH_B0a
#define PH_B0a 1
#endif
#ifndef PH_B0b
#define PH_B0b 1
#endif
#ifndef PH_B0c
#define PH_B0c 1
#endif
#ifndef PH_B0d
#define PH_B0d 1
#endif
#ifndef PH_SCAN
#define PH_SCAN 1
#endif
#ifndef PH_RSCAN
#define PH_RSCAN 1
#endif
#ifndef PH_NSAP
#define PH_NSAP 1
#endif
#ifndef PH_NSAS
#define PH_NSAS 1
#endif
#ifndef PH_B2
#define PH_B2 1
#endif
#ifndef PH_C
#define PH_C 1
#endif
#ifndef PH_D
#define PH_D 1
#endif
#ifndef PH_E
#define PH_E 1
#endif
#ifndef PH_F
#define PH_F 1
#endif
#ifndef PH_G1
#define PH_G1 1
#endif
#ifndef PH_G2
#define PH_G2 1
#endif
struct Args { const void* in[27]; float* out; unsigned char* ws; };
__global__ void __launch_bounds__(NTHREADS, 2) mk_fwd(Args args) {
    extern __shared__ __attribute__((aligned(16))) unsigned char lds_raw[];
    Frame F;
    F.lds = (LAS unsigned char*)lds_raw;
    F.wave = __builtin_amdgcn_readfirstlane((int)threadIdx.x >> 6); F.lane = 0; F.tid = 0;
    F.G = gridDim.x; F.bid = blockIdx.x;
    F.ctl = (gu32*)(KWS() + WS_CTL);
    { const Frame Fp = fresh(F); for (int u = Fp.tid; u < (LDS_BYTES - LDSCTL_OFF) / 4; u += NTHREADS) ((LAS unsigned*)(F.lds + LDSCTL_OFF))[u] = 0u;
      __syncthreads();
      (void)xcd_barrier_post((unsigned*)(F.ctl + CW_BAR), (volatile LAS unsigned*)(F.lds + MISC_OFF) + 8, Fp.tid == 0); }
    const int G = F.G, bid = F.bid;

        for (int rp_ = 0; rp_ < PH_P0; ++rp_) {
    { Frame Fp = fresh(F); p0_prologue(Fp); }
        }
    GRID_BAR();

    for (int layer = 0; layer < NLAYER; ++layer) {
        for (int rp_ = 0; rp_ < PH_A; ++rp_) {
        {
            const Frame Fg = fresh(F); const int G = Fg.G, bid = Fg.bid;
            unsigned char* ws = KWS();
            pg8::Gemm g{(const bf16*)(ws + WS_XGA), (const bf16*)(ws + WS_WIN + layer * SZ_WIN), MROWS, LDZ, DM, DM, DM, 31, 0};
            pg8::StaticOrder S; S.init(MROWS, LDZ, G, bid);
            epi::EpiA E{(bf16*)(ws + WS_Z), (float*)(ws + WS_ZS), (const float*)(ws + WS_SSA), KOUT(), layer};
            pg8::gemm_phase<epi::EpiA, pg8::StaticOrder, true, true>(Fg.lds, g, S, E, Fg.tid);
        }
        }
        GRID_BAR();
        for (int rp_ = 0; rp_ < PH_B0a; ++rp_) {
        { Frame Fp = fresh(F); for (int u = Fp.bid; u < 1024; u += Fp.G) gdn_prep_unit(Fp, layer, u); }
        }
        for (int rp_ = 0; rp_ < PH_B0b; ++rp_) {
        { Frame Fp = fresh(F); for (int u = Fp.bid; u < 512; u += Fp.G) ret_prep_unit(Fp, layer, u); }
        }
        for (int rp_ = 0; rp_ < PH_B0c; ++rp_) {
        { Frame Fp = fresh(F); for (int u = Fp.bid; u < 1024; u += Fp.G) sample_rec_unit(Fp, layer, u); }
        }
        for (int rp_ = 0; rp_ < PH_B0d; ++rp_) {
        { Frame Fp = fresh(F); for (int t = Fp.bid * NWAVES + Fp.wave; t < 256 + 4096; t += Fp.G * NWAVES) compress_task(Fp, layer, t); }
        }
        GRID_BAR();
        {
            const Frame Fq = fresh(F); const int G = Fq.G, bid = Fq.bid;
            const bool split = G >= 64;
        for (int rp_ = 0; rp_ < PH_SCAN; ++rp_) {
            if (bid < 8) { Frame Fp = fresh(F); gdn_scan_chain(Fp, layer, Fp.bid); }
        }
        for (int rp_ = 0; rp_ < PH_RSCAN; ++rp_) {
            if (bid >= 8 && bid < 40) { Frame Fp = fresh(F); ret_scan_part(Fp, layer, Fp.bid - 8); }
        }
            const int vb = split ? bid - 40 : bid, NV = split ? G - 40 : G;
            if (vb >= 0) {
        for (int rp_ = 0; rp_ < PH_NSAP; ++rp_) {
                { Frame Fp = fresh(F); for (int u = vb; u < 1024; u += NV) nsa_prompt_unit(Fp, layer, u); }
        }
                __syncthreads();
        for (int rp_ = 0; rp_ < PH_NSAS; ++rp_) {
                { Frame Fp = fresh(F); for (int u = vb; u < 128; u += NV) nsa_sample_unit(Fp, layer, u); }
        }
            }
        }
        GRID_BAR();
        for (int rp_ = 0; rp_ < PH_B2; ++rp_) {
        { Frame Fp = fresh(F); for (int u = Fp.bid; u < 512; u += Fp.G) ret_out_unit(Fp, layer, u); }
        { Frame Fp = fresh(F); for (int r = Fp.bid * NWAVES + Fp.wave; r < MROWS; r += Fp.G * NWAVES) gdn_out_row(Fp, layer, r); }
        }
        GRID_BAR();
        for (int rp_ = 0; rp_ < PH_C; ++rp_) {
        {
            const Frame Fg = fresh(F); const int G = Fg.G, bid = Fg.bid;
            unsigned char* ws = KWS();
            pg8::Gemm g{(const bf16*)(ws + WS_MIX), (const bf16*)(ws + WS_WBR + layer * SZ_WBR), MROWS, 3072, 512, 1536, 512, 2, 1024};
            pg8::StaticOrder S; S.init(MROWS, 3072, G, bid);
            epi::EpiC E{(const bf16*)(ws + WS_Z), (bf16*)(ws + WS_GATED)};
            pg8::gemm_phase<epi::EpiC, pg8::StaticOrder, true, true>(Fg.lds, g, S, E, Fg.tid);
        }
        }
        GRID_BAR();
#if PH_D
        {
            const Frame Fg = fresh(F); const int G = Fg.G, bid = Fg.bid;
            unsigned char* ws = KWS();
            pg8::Gemm g{(const bf16*)(ws + WS_GATED), (const bf16*)(ws + WS_WO3 + layer * SZ_WO3), MROWS, DM, 3072, 3072, 3072, 31, 0};
            pg8::StaticOrder S; S.init(MROWS, DM, G, bid);
            epi::EpiRes E{(float*)(ws + WS_XR), (bf16*)(ws + WS_XGB), KIN(21) + layer * DM, (float*)(ws + WS_SSB), nullptr, 0};
            pg8::gemm_phase<epi::EpiRes, pg8::StaticOrder, true, true>(Fg.lds, g, S, E, Fg.tid);
        }
#endif
        GRID_BAR();
        for (int rp_ = 0; rp_ < PH_E; ++rp_) {
        {
            const Frame Fg = fresh(F); const int G = Fg.G, bid = Fg.bid;
            unsigned char* ws = KWS();
            pg8::Gemm g{(const bf16*)(ws + WS_XGB), (const bf16*)(ws + WS_WUP + layer * SZ_WUP), MROWS, DFF, DM, DM, DM, 31, 0};
            pg8::StaticOrder S; S.init(MROWS, DFF, G, bid);
            epi::EpiUp E{(bf16*)(ws + WS_HMID), (const float*)(ws + WS_SSB)};
            pg8::gemm_phase<epi::EpiUp, pg8::StaticOrder, true, true>(Fg.lds, g, S, E, Fg.tid);
        }
        }
        GRID_BAR();
#if PH_F
        {
            const Frame Fg = fresh(F); const int G = Fg.G, bid = Fg.bid;
            unsigned char* ws = KWS();
            pg8::Gemm g{(const bf16*)(ws + WS_HMID), (const bf16*)(ws + WS_WDN + layer * SZ_WDN), MROWS, DM, DFF, DFF, DFF, 31, 0};
            pg8::StaticOrder S; S.init(MROWS, DM, G, bid);
            epi::EpiRes E{(float*)(ws + WS_XR), (bf16*)(ws + WS_XGC), nullptr, nullptr, nullptr, 0};
            pg8::gemm_phase<epi::EpiRes, pg8::StaticOrder, true, true>(Fg.lds, g, S, E, Fg.tid);
        }
#endif
        GRID_BAR();
        for (int rp_ = 0; rp_ < PH_G1; ++rp_) {
        {
            const Frame Fg = fresh(F); const int G = Fg.G, bid = Fg.bid;
            unsigned char* ws = KWS();
            int kple = PLE; asm volatile("" : "+s"(kple));
            pg8::Gemm g{(const bf16*)(ws + WS_P16) + (size_t)layer * MROWS * PLE, (const bf16*)(ws + WS_WPL + layer * SZ_WPL), MROWS, DM, kple, PLE, PLE, 31, 0};
            pg8::StaticOrder S; S.init(MROWS, DM, G, bid);
            epi::EpiRes E{nullptr, nullptr, nullptr, nullptr, (float*)(ws + WS_TPLE), 1};
            pg8::gemm_phase<epi::EpiRes, pg8::StaticOrder, true, true>(Fg.lds, g, S, E, Fg.tid);
        }
        }
#if PH_G2
        {
            const Frame Fg = fresh(F); const int G = Fg.G, bid = Fg.bid;
            unsigned char* ws = KWS();
            const bool more = layer + 1 < NLAYER;
            pg8::Gemm g{(const bf16*)(ws + WS_XGC), (const bf16*)(ws + WS_WPG + layer * SZ_WPG), MROWS, DM, DM, DM, DM, 31, 0};
            pg8::StaticOrder S; S.init(MROWS, DM, G, bid);
            epi::EpiRes E{(float*)(ws + WS_XR), more ? (bf16*)(ws + WS_XGA) : nullptr, more ? KIN(10) + (layer + 1) * DM : nullptr, more ? (float*)(ws + WS_SSA) : nullptr, (float*)(ws + WS_TPLE), 2};
            pg8::gemm_phase<epi::EpiRes, pg8::StaticOrder, true, true>(Fg.lds, g, S, E, Fg.tid);
        }
#endif
        GRID_BAR();
    }
    { Frame Fp = fresh(F); for (int r = Fp.bid * NWAVES + Fp.wave; r < MROWS; r += Fp.G * NWAVES) final_row(Fp, r); }
}

extern "C" void kernel_launch(void* const* d_in, const int* in_sizes, int n_in, void* d_out, int out_size, void* d_ws, size_t ws_size, hipStream_t stream) {
    static int grid = 0;
    if (grid == 0) {
        if (n_in != 27 || ws_size < WS_END) { fprintf(stderr, "kernel_launch: unexpected shapes (n_in %d out %d ws %zu, need %zu)\n", n_in, out_size, ws_size, (size_t)WS_END); grid = -1; return; }
        int dev = 0, cus = 0;
        if (hipGetDevice(&dev) != hipSuccess || hipDeviceGetAttribute(&cus, hipDeviceAttributeMultiprocessorCount, dev) != hipSuccess) { grid = -1; return; }
        if (hipFuncSetAttribute((const void*)mk_fwd, hipFuncAttributeMaxDynamicSharedMemorySize, LDS_BYTES) != hipSuccess) { fprintf(stderr, "kernel_launch: hipFuncSetAttribute failed\n"); grid = -1; return; }
        int per_cu = 0;
        if (hipOccupancyMaxActiveBlocksPerMultiprocessor(&per_cu, (const void*)mk_fwd, NTHREADS, LDS_BYTES) != hipSuccess || per_cu < 1) fprintf(stderr, "kernel_launch: occupancy query reports %d\n", per_cu);
        (void)hipGetLastError();
        grid = cus;
    }
    if (grid < 0) return;
    if (hipMemsetAsync((char*)d_ws + WS_CTL, 0, CTL_ZERO_BYTES, stream) != hipSuccess) return;
    Args a{};
    for (int i = 0; i < 27; ++i) a.in[i] = d_in[i];
    a.out = (float*)d_out; a.ws = (unsigned char*)d_ws;
    hipLaunchKernelGGL(mk_fwd, dim3(grid), dim3(NTHREADS), LDS_BYTES, stream, a);
}
```

```cpp
#include <hip/hip_runtime.h>
#include <cstdio>
#include <cstdint>
namespace pg8 {
#define PG8_LAS __attribute__((address_space(3)))
typedef unsigned short bf16_t;
typedef short bf16x8 __attribute__((ext_vector_type(8)));
typedef float f32x4 __attribute__((ext_vector_type(4)));
typedef unsigned u32x4 __attribute__((ext_vector_type(4)));
constexpr int BM = 256, BK = 64, HALF = 128, HTB = HALF * BK * 2  , STAGE_BYTES = 8 * HTB, NXCD = 8, WGM = 8;

__host__ __device__ __forceinline__ int lds_byte(int r, int c) { const int st = (r >> 4) * 2 + (c >> 5), rr = r & 15, cc = c & 31, ob = rr * 64 + cc * 2; return st * 1024 + (ob ^ (((ob >> 9) & 1) << 5)); }
__host__ __device__ __forceinline__ void stage_rc(int b, int& R, int& C) { const int st = b / 1024, sb = b % 1024, swz = sb ^ (((sb >> 9) & 1) << 5); R = (st >> 1) * 16 + swz / 64; C = (st & 1) * 32 + (swz % 64) / 2; }
__host__ __device__ __forceinline__ int perm32(int rho) { const int n = rho >> 4, i = rho & 15; return 8 * (i >> 2) + 4 * n + (i & 3); }

struct Unit { int pm, pn; };
struct Gemm { const bf16_t* A; const bf16_t* Bt; int M, N, K; int lda, ldb; int a_shift, a_off; };

struct StaticOrder {
    int nM, nN, nwg, G, c;
    __host__ __device__ void init(int M, int N, int G_, int c_) { nM = M / BM; nN = N / BM; nwg = nM * nN; G = G_; c = c_; }
    __host__ __device__ bool next(int i, Unit& u) const {
        const long L = (long)i * G + c; if (L >= nwg) return false;
        int wgid = (int)L; { const int q = nwg / NXCD, r = nwg % NXCD, xcd = wgid % NXCD, off = wgid / NXCD; wgid = (xcd < r ? xcd * (q + 1) : r * (q + 1) + (xcd - r) * q) + off; }
        const int nig = WGM * nN, gid = wgid / nig, fm = gid * WGM, gsz = (nM - fm) < WGM ? (nM - fm) : WGM;
        u.pm = fm + ((wgid % nig) % gsz); u.pn = (wgid % nig) / gsz; return true;
    }
    __device__ __forceinline__ void a_ready(const Unit&) const {}
    __device__ __forceinline__ void done(const Unit&) const {}
};

__device__ __forceinline__ unsigned cvt_pk_bf16(float lo, float hi) { unsigned r; asm volatile("v_cvt_pk_bf16_f32 %0, %1, %2" : "=v"(r) : "v"(lo), "v"(hi)); return r; }
typedef float f32x2 __attribute__((ext_vector_type(2)));
template <class Epi, class Sched, bool ALIGN_EPI = false, bool SP2 = false>
__device__ __forceinline__ void gemm_phase(PG8_LAS unsigned char* lds, const Gemm g, const Sched& S, const Epi& E, const int tid) {
    const int wid = __builtin_amdgcn_readfirstlane(tid >> 6), lane = tid & 63, wr = wid >> 2, wc = wid & 3, fr = lane & 15, fq = lane >> 4;
    const int K = g.K, nt = K / BK;
    unsigned voffA[2], voffB[2];
#pragma unroll
    for (int i = 0; i < 2; ++i) { int R, C; stage_rc(tid * 16 + i * 8192, R, C); const int Rb = Epi::PERM ? ((R & ~31) + perm32(R & 31)) : R;
        voffA[i] = (unsigned)(R * g.lda + C) * 2u; voffB[i] = (unsigned)(Rb * g.ldb + C) * 2u; }
    const size_t kstep = (size_t)(BK * 2);
    const size_t hstepA = (size_t)HALF * g.lda * 2, hstepB = (size_t)HALF * g.ldb * 2;
    const size_t tstepA = 2 * hstepA, tstepB = 2 * hstepB;
    const unsigned ldsw = (unsigned)wid * 1024u;
    const int aoff = lds_byte(wr * 64 + fr, fq * 8), boff = lds_byte(wc * 32 + fr, fq * 8);
#define PG8_SA(b, h) (((b) * 2 + (h)) * HTB)
#define PG8_SB(b, h) ((4 + (b) * 2 + (h)) * HTB)
#define PG8_STAGE(bufoff, gbase, voff) do { _Pragma("unroll") for (int _i = 0; _i < 2; ++_i) \
        __builtin_amdgcn_global_load_lds((const unsigned*)((const char*)(gbase) + (voff)[_i]), (PG8_LAS unsigned*)(lds + (bufoff) + ldsw + _i * 8192), 16, 0, 0); } while (0)
#define PG8_LDA(dst, b, h) do { _Pragma("unroll") for (int m = 0; m < 4; ++m) _Pragma("unroll") for (int k = 0; k < 2; ++k) dst[m][k] = *(const PG8_LAS bf16x8*)(lds + PG8_SA(b, h) + aoff + m * 2048 + k * 1024); } while (0)
#define PG8_LDB(dst, b, h) do { _Pragma("unroll") for (int n = 0; n < 2; ++n) _Pragma("unroll") for (int k = 0; k < 2; ++k) dst[n][k] = *(const PG8_LAS bf16x8*)(lds + PG8_SB(b, h) + boff + n * 2048 + k * 1024); } while (0)
#define PG8_MMA(ai, bj, At, Bt) do { __builtin_amdgcn_s_setprio(1); _Pragma("unroll") for (int m = 0; m < 4; ++m) _Pragma("unroll") for (int n = 0; n < 2; ++n) _Pragma("unroll") for (int k = 0; k < 2; ++k) \
        acc[ai][bj][m][n] = __builtin_amdgcn_mfma_f32_16x16x32_bf16(Bt[n][k], At[m][k], acc[ai][bj][m][n], 0, 0, 0); __builtin_amdgcn_s_setprio(0); } while (0)
#define PG8_WAIT_V(n) asm volatile("s_waitcnt vmcnt(" #n ")" ::: "memory")
#define PG8_WAIT_L(n) asm volatile("s_waitcnt lgkmcnt(" #n ")" ::: "memory")
#define PG8_BAR __builtin_amdgcn_s_barrier()
#define PG8_SCHED __builtin_amdgcn_sched_barrier(0)
    Unit cur, nxt; int ui = 0;
    if (!S.next(0, cur)) return;
    f32x4 acc[2][2][4][2];
#pragma unroll
    for (int a = 0; a < 2; ++a)
#pragma unroll
        for (int b = 0; b < 2; ++b)
#pragma unroll
            for (int m = 0; m < 4; ++m)
#pragma unroll
                for (int n = 0; n < 2; ++n) acc[a][b][m][n] = (f32x4){0.f, 0.f, 0.f, 0.f};
    bf16x8 At[4][2], B0[2][2], B1[2][2];
    const char* cA = (const char*)g.A + (size_t)cur.pm * tstepA + (size_t)(cur.pn >> g.a_shift) * (size_t)g.a_off; const char* cB = (const char*)g.Bt + (size_t)cur.pn * tstepB;
    S.a_ready(cur);
    if constexpr (SP2) {
        PG8_STAGE(PG8_SB(0, 0), cB, voffB); PG8_STAGE(PG8_SB(0, 1), cB + hstepB, voffB); PG8_STAGE(PG8_SA(0, 0), cA, voffA); PG8_STAGE(PG8_SA(0, 1), cA + hstepA, voffA);
        if (wr == 1) PG8_BAR;
        PG8_WAIT_V(2); PG8_BAR;
        PG8_STAGE(PG8_SB(1, 0), cB + kstep, voffB); PG8_STAGE(PG8_SA(1, 0), cA + kstep, voffA); PG8_STAGE(PG8_SB(1, 1), cB + hstepB + kstep, voffB);
        PG8_WAIT_V(6); PG8_BAR;
    } else {
        PG8_STAGE(PG8_SB(0, 0), cB, voffB); PG8_STAGE(PG8_SA(0, 0), cA, voffA); PG8_STAGE(PG8_SB(0, 1), cB + hstepB, voffB); PG8_STAGE(PG8_SA(0, 1), cA + hstepA, voffA);
        if (wr == 1) PG8_BAR;
        PG8_WAIT_V(4); PG8_BAR;
        PG8_STAGE(PG8_SB(1, 0), cB + kstep, voffB); PG8_STAGE(PG8_SA(1, 0), cA + kstep, voffA); PG8_STAGE(PG8_SB(1, 1), cB + hstepB + kstep, voffB);
        PG8_WAIT_V(6); PG8_BAR;
    }
    for (;;) {
        const bool has_next = S.next(ui + 1, nxt);
        const char* nA = has_next ? (const char*)g.A + (size_t)nxt.pm * tstepA + (size_t)(nxt.pn >> g.a_shift) * (size_t)g.a_off : cA; const char* nB = has_next ? (const char*)g.Bt + (size_t)nxt.pn * tstepB : cB;
        for (int t = 0; t < nt; t += 2) {
            const bool last = (t == nt - 2);
            const char* a1 = cA + (size_t)(t + 1) * kstep;
            const char* a2 = last ? nA : cA + (size_t)(t + 2) * kstep; const char* b2 = last ? nB : cB + (size_t)(t + 2) * kstep;
            const char* a3 = a2 + kstep; const char* b3 = b2 + kstep;
            if (last && has_next) S.a_ready(nxt);
            if constexpr (SP2) {
            PG8_LDB(B0, 0, 0); PG8_LDB(B1, 0, 1); PG8_SCHED; PG8_LDA(At, 0, 0); PG8_STAGE(PG8_SA(1, 1), a1 + hstepA, voffA);
            PG8_WAIT_V(8); PG8_WAIT_L(0); PG8_BAR; PG8_MMA(0, 0, At, B0); PG8_MMA(0, 1, At, B1); PG8_BAR; PG8_SCHED;
            PG8_LDA(At, 0, 1); PG8_STAGE(PG8_SB(0, 0), b2, voffB); PG8_STAGE(PG8_SB(0, 1), b2 + hstepB, voffB); PG8_STAGE(PG8_SA(0, 0), a2, voffA);
            PG8_WAIT_V(8); PG8_WAIT_L(0); PG8_BAR; PG8_MMA(1, 0, At, B0); PG8_MMA(1, 1, At, B1); PG8_BAR; PG8_SCHED;
            PG8_LDB(B0, 1, 0); PG8_LDB(B1, 1, 1); PG8_SCHED; PG8_LDA(At, 1, 0); PG8_STAGE(PG8_SA(0, 1), a2 + hstepA, voffA);
            PG8_WAIT_V(8); PG8_WAIT_L(0); PG8_BAR; PG8_MMA(0, 0, At, B0); PG8_MMA(0, 1, At, B1); PG8_BAR; PG8_SCHED;
            PG8_LDA(At, 1, 1); PG8_STAGE(PG8_SB(1, 0), b3, voffB); PG8_STAGE(PG8_SB(1, 1), b3 + hstepB, voffB); PG8_STAGE(PG8_SA(1, 0), a3, voffA);
            PG8_WAIT_V(8); PG8_WAIT_L(0); PG8_BAR; PG8_MMA(1, 0, At, B0); PG8_MMA(1, 1, At, B1); PG8_BAR; PG8_SCHED;
            } else {
            PG8_LDB(B0, 0, 0); PG8_SCHED; PG8_LDA(At, 0, 0); PG8_STAGE(PG8_SA(1, 1), a1 + hstepA, voffA);
            PG8_WAIT_L(8); PG8_BAR; PG8_WAIT_L(0); PG8_MMA(0, 0, At, B0); PG8_BAR; PG8_SCHED;
            PG8_LDB(B1, 0, 1); PG8_STAGE(PG8_SB(0, 0), b2, voffB);
            PG8_BAR; PG8_WAIT_L(0); PG8_MMA(0, 1, At, B1); PG8_BAR;
            PG8_LDA(At, 0, 1); PG8_STAGE(PG8_SA(0, 0), a2, voffA);
            PG8_BAR; PG8_WAIT_L(0); PG8_MMA(1, 0, At, B0); PG8_BAR; PG8_SCHED;
            PG8_STAGE(PG8_SB(0, 1), b2 + hstepB, voffB);
            PG8_WAIT_V(6); PG8_BAR; PG8_MMA(1, 1, At, B1); PG8_BAR;
            PG8_LDB(B0, 1, 0); PG8_SCHED; PG8_LDA(At, 1, 0); PG8_STAGE(PG8_SA(0, 1), a2 + hstepA, voffA);
            PG8_WAIT_L(8); PG8_BAR; PG8_WAIT_L(0); PG8_MMA(0, 0, At, B0); PG8_BAR; PG8_SCHED;
            PG8_LDB(B1, 1, 1); PG8_STAGE(PG8_SB(1, 0), b3, voffB);
            PG8_BAR; PG8_WAIT_L(0); PG8_MMA(0, 1, At, B1); PG8_BAR;
            PG8_LDA(At, 1, 1); PG8_STAGE(PG8_SA(1, 0), a3, voffA);
            PG8_BAR; PG8_WAIT_L(0); PG8_MMA(1, 0, At, B0); PG8_BAR; PG8_SCHED;
            PG8_STAGE(PG8_SB(1, 1), b3 + hstepB, voffB);
            PG8_WAIT_V(6); PG8_BAR; PG8_MMA(1, 1, At, B1); PG8_BAR;
            }
        }
        if constexpr (ALIGN_EPI) { if (wr == 0) PG8_BAR; }
        if constexpr (!Epi::AFTER_DRAIN) { E(acc, cur, wr, wc, fr, fq); S.done(cur); }
        if (!has_next) break;
#pragma unroll
        for (int a = 0; a < 2; ++a)
#pragma unroll
            for (int b = 0; b < 2; ++b)
#pragma unroll
                for (int m = 0; m < 4; ++m)
#pragma unroll
                    for (int n = 0; n < 2; ++n) acc[a][b][m][n] = (f32x4){0.f, 0.f, 0.f, 0.f};
        cur = nxt; cA = nA; cB = nB; ++ui;
        if constexpr (ALIGN_EPI) { if (wr == 1) PG8_BAR; }
    }
    PG8_WAIT_V(0);
    if constexpr (!ALIGN_EPI) { if (wr == 0) PG8_BAR; }
    PG8_BAR;
    if constexpr (Epi::AFTER_DRAIN) { E.fused(acc, cur, wr, wc, fr, fq, lds, wid, lane); S.done(cur); }
#undef PG8_SA
#undef PG8_SB
#undef PG8_STAGE
#undef PG8_LDA
#undef PG8_LDB
#undef PG8_MMA
#undef PG8_WAIT_V
#undef PG8_WAIT_L
#undef PG8_BAR
#undef PG8_SCHED
}
}
#define DI __device__ __forceinline__
#define GAS __attribute__((address_space(1)))
#define LAS __attribute__((address_space(3)))
typedef unsigned short bf16;
typedef unsigned v4u __attribute__((ext_vector_type(4)));
typedef unsigned v2u __attribute__((ext_vector_type(2)));
typedef float f32x4 __attribute__((ext_vector_type(4)));
typedef float f32x2 __attribute__((ext_vector_type(2)));
typedef short bf16x8 __attribute__((ext_vector_type(8)));
typedef short s16x4 __attribute__((ext_vector_type(4)));
typedef GAS unsigned gu32;

constexpr int DM = 1024, TP = 8192, MP = 16384, MS = 512, MROWS = 16896, LDZ = 8704, DFF = 4096, PLE = 256, NLAYER = 2;
constexpr int ZC_Q = 0, ZC_KC = 512, ZC_VC = 640, ZC_KS = 768, ZC_VS = 896, ZC_KW = 1024, ZC_VW = 1152, ZC_GQKV = 1280, ZC_GZ = 2816, ZC_RQKV = 3328, ZC_RG = 4864, ZC_MG = 5376, ZC_SM = 8448;
constexpr float EPS = 1e-6f;
constexpr size_t O_YP = 0, O_YS = O_YP + (size_t)MP * DM, O_KVP = O_YS + (size_t)MS * DM, O_KVS = O_KVP + (size_t)2 * MP * 512, O_WINP = O_KVS + (size_t)2 * MS * 512,
                 O_WINS = O_WINP + (size_t)2 * 2 * 512 * 256, O_CVP = O_WINS + (size_t)2 * 128 * 512 * 256, O_CVS = O_CVP + (size_t)2 * 2 * 3 * 1536, O_GSP = O_CVS + (size_t)2 * 128 * 3 * 1536,
                 O_GSS = O_GSP + (size_t)2 * 2 * 4 * 16384, O_RSP = O_GSS + (size_t)2 * 128 * 4 * 16384, O_RSS = O_RSP + (size_t)2 * 2 * 4 * 16384, O_END = O_RSS + (size_t)2 * 128 * 4 * 16384;

DI float bf2f(unsigned short b) { return __uint_as_float((unsigned)b << 16); }
DI unsigned f2bf(float f) { unsigned u = __float_as_uint(f); return (u + 0x7fffu + ((u >> 16) & 1u)) >> 16; }
DI unsigned pk2(float lo, float hi) { return f2bf(lo) | (f2bf(hi) << 16); }
DI float lo_bf(unsigned w) { return __uint_as_float(w << 16); }
DI float hi_bf(unsigned w) { return __uint_as_float(w & 0xffff0000u); }
DI float sigmoidf_(float x) { return 1.f / (1.f + __expf(-x)); }
DI float siluf_(float x) { return x / (1.f + __expf(-x)); }
DI v4u pack8(const f32x4 a, const f32x4 b) { v4u w; w.x = pk2(a[0], a[1]); w.y = pk2(a[2], a[3]); w.z = pk2(b[0], b[1]); w.w = pk2(b[2], b[3]); return w; }
DI void unpack8(const v4u w, f32x4& a, f32x4& b) { a[0] = lo_bf(w.x); a[1] = hi_bf(w.x); a[2] = lo_bf(w.y); a[3] = hi_bf(w.y); b[0] = lo_bf(w.z); b[1] = hi_bf(w.z); b[2] = lo_bf(w.w); b[3] = hi_bf(w.w); }

template <int M> DI int shxi(int v, int lane) {
    if constexpr (M < 32) return __builtin_amdgcn_ds_swizzle(v, (M << 10) | 0x1f);
    else return __builtin_amdgcn_ds_bpermute((lane ^ 32) << 2, v);
}
template <int M> DI float shx(float v, int lane) { return __int_as_float(shxi<M>(__float_as_int(v), lane)); }
DI float wave_sum(float v, int lane) { v += shx<1>(v, lane); v += shx<2>(v, lane); v += shx<4>(v, lane); v += shx<8>(v, lane); v += shx<16>(v, lane); v += shx<32>(v, lane); return v; }

namespace epi {
using pg8::Unit; using pg8::bf16_t;
DI float row_rstd(const float* SS, int row, int fq, int lane) {
    const f32x4 p = *(const f32x4*)(SS + (size_t)row * 16 + 4 * fq);
    float s = (p[0] + p[1]) + (p[2] + p[3]); s += shx<16>(s, lane); s += shx<32>(s, lane);
    return rsqrtf(s * (1.f / DM) + EPS);
}
struct EpiA {
    static constexpr bool PERM = true, AFTER_DRAIN = false;
    bf16* Z; float* ZS; const float* SS; float* out; int layer;
    DI void operator()(const f32x4 (&acc)[2][2][4][2], const Unit& u, int wr, int wc, int fr, int fq) const {
        asm volatile("" : "+v"(fr), "+v"(fq), "+s"(wr), "+s"(wc));
        const int pn = u.pn;
#pragma unroll
        for (int ai = 0; ai < 2; ++ai)
#pragma unroll
            for (int m = 0; m < 4; ++m) {
                const int row = u.pm * 256 + ai * 128 + wr * 64 + m * 16 + fr;
                const float rstd = row_rstd(SS, row, fq, fr + 16 * fq);
#pragma unroll
                for (int bj = 0; bj < 2; ++bj) {
                    const int col = pn * 256 + bj * 128 + wc * 32 + 8 * fq;
                    const f32x4 v0 = acc[ai][bj][m][0] * rstd, v1 = acc[ai][bj][m][1] * rstd;
                    *(v4u*)(Z + (size_t)row * LDZ + col) = pack8(v0, v1);
                    float* dst = nullptr;
                    if (pn == 2 || pn == 3) {
                        dst = (row < MP) ? out + O_KVP + ((size_t)layer * MP + row) * 512 + (col - 512) : out + O_KVS + ((size_t)layer * MS + (row - MP)) * 512 + (col - 512);
                    } else if (pn == 4) {
                        const int c2 = col - 1024;
                        if (row < MP) { const int t = row & (TP - 1), b = row >> 13; if (t >= TP - 512) dst = out + O_WINP + ((size_t)(layer * 2 + b) * 512 + (t - (TP - 512))) * 256 + c2; }
                        else { const int r2 = row - MP, s = r2 >> 2, j = r2 & 3; dst = out + O_WINS + ((size_t)(layer * 128 + s) * 512 + 508 + j) * 256 + c2; }
                    } else if (pn >= 5 && pn < 11) {
                        const int c2 = col - 1280;
                        if (row < MP) { const int t = row & (TP - 1), b = row >> 13; if (t >= TP - 3) dst = out + O_CVP + ((size_t)(layer * 2 + b) * 3 + (t - (TP - 3))) * 1536 + c2; }
                        else { const int r2 = row - MP, s = r2 >> 2, j = r2 & 3; if (j >= 1) dst = out + O_CVS + ((size_t)(layer * 128 + s) * 3 + (j - 1)) * 1536 + c2; }
                    } else if (pn == 33) {
                        if (bj == 0 && wc == 0) dst = ZS + (size_t)row * 32 + 8 * fq;
                    }
                    if (dst) { *(f32x4*)dst = v0; *(f32x4*)(dst + 4) = v1; }
                }
                asm volatile("" ::: "memory");
            }
    }
};
struct EpiC {
    static constexpr bool PERM = true, AFTER_DRAIN = false;
    const bf16* Z; bf16* G;
    DI void operator()(const f32x4 (&acc)[2][2][4][2], const Unit& u, int wr, int wc, int fr, int fq) const {
        asm volatile("" : "+v"(fr), "+v"(fq), "+s"(wr), "+s"(wc));
#pragma unroll
        for (int ai = 0; ai < 2; ++ai)
#pragma unroll
            for (int m = 0; m < 4; ++m) {
                const int row = u.pm * 256 + ai * 128 + wr * 64 + m * 16 + fr;
#pragma unroll
                for (int bj = 0; bj < 2; ++bj) {
                    const int col = u.pn * 256 + bj * 128 + wc * 32 + 8 * fq;
                    const v4u gw = *(const v4u*)(Z + (size_t)row * LDZ + ZC_MG + col);
                    f32x4 g0, g1; unpack8(gw, g0, g1);
                    f32x4 v0 = acc[ai][bj][m][0], v1 = acc[ai][bj][m][1];
#pragma unroll
                    for (int e = 0; e < 4; ++e) { v0[e] *= sigmoidf_(g0[e]); v1[e] *= sigmoidf_(g1[e]); }
                    *(v4u*)(G + (size_t)row * 3072 + col) = pack8(v0, v1);
                }
                asm volatile("" ::: "memory");
            }
    }
};
struct EpiRes {
    static constexpr bool PERM = true, AFTER_DRAIN = false;
    float* XR; bf16* XG; const float* gvec; float* SS; float* T; int mode;
    DI void operator()(const f32x4 (&acc)[2][2][4][2], const Unit& u, int wr, int wc, int fr, int fq) const {
        asm volatile("" : "+v"(fr), "+v"(fq), "+s"(wr), "+s"(wc));
#pragma unroll
        for (int ai = 0; ai < 2; ++ai)
#pragma unroll
            for (int m = 0; m < 4; ++m) {
                const int row = u.pm * 256 + ai * 128 + wr * 64 + m * 16 + fr;
                float ssq = 0.f;
#pragma unroll
                for (int bj = 0; bj < 2; ++bj) {
                    const int col = u.pn * 256 + bj * 128 + wc * 32 + 8 * fq;
                    const size_t o = (size_t)row * DM + col;
                    f32x4 a0 = acc[ai][bj][m][0], a1 = acc[ai][bj][m][1];
                    if (mode == 1) { *(f32x4*)(T + o) = a0; *(f32x4*)(T + o + 4) = a1; continue; }
                    f32x4 x0 = *(const f32x4*)(XR + o), x1 = *(const f32x4*)(XR + o + 4);
                    if (mode == 2) { const f32x4 t0 = *(const f32x4*)(T + o), t1 = *(const f32x4*)(T + o + 4);
#pragma unroll
                        for (int e = 0; e < 4; ++e) { a0[e] = t0[e] * sigmoidf_(a0[e]); a1[e] = t1[e] * sigmoidf_(a1[e]); } }
                    x0 += a0; x1 += a1;
                    *(f32x4*)(XR + o) = x0; *(f32x4*)(XR + o + 4) = x1;
                    ssq += (x0[0] * x0[0] + x0[1] * x0[1]) + (x0[2] * x0[2] + x0[3] * x0[3]) + (x1[0] * x1[0] + x1[1] * x1[1]) + (x1[2] * x1[2] + x1[3] * x1[3]);
                    if (XG) { if (gvec) { const f32x4 g0 = *(const f32x4*)(gvec + col), g1 = *(const f32x4*)(gvec + col + 4); x0 *= g0; x1 *= g1; }
                        *(v4u*)(XG + o) = pack8(x0, x1); }
                }
                if (SS) { ssq += shx<16>(ssq, fr + 16 * fq); ssq += shx<32>(ssq, fr + 16 * fq); if (fq == 0) SS[(size_t)row * 16 + u.pn * 4 + wc] = ssq; }
                asm volatile("" ::: "memory");
            }
    }
};
struct EpiUp {
    static constexpr bool PERM = true, AFTER_DRAIN = false;
    bf16* H; const float* SS;
    DI void operator()(const f32x4 (&acc)[2][2][4][2], const Unit& u, int wr, int wc, int fr, int fq) const {
        asm volatile("" : "+v"(fr), "+v"(fq), "+s"(wr), "+s"(wc));
#pragma unroll
        for (int ai = 0; ai < 2; ++ai)
#pragma unroll
            for (int m = 0; m < 4; ++m) {
                const int row = u.pm * 256 + ai * 128 + wr * 64 + m * 16 + fr;
                const float rstd = row_rstd(SS, row, fq, fr + 16 * fq);
#pragma unroll
                for (int bj = 0; bj < 2; ++bj) {
                    const int col = u.pn * 256 + bj * 128 + wc * 32 + 8 * fq;
                    f32x4 v0 = acc[ai][bj][m][0] * rstd, v1 = acc[ai][bj][m][1] * rstd;
#pragma unroll
                    for (int e = 0; e < 4; ++e) { const float a = fmaxf(v0[e], 0.f), b = fmaxf(v1[e], 0.f); v0[e] = a * a; v1[e] = b * b; }
                    *(v4u*)(H + (size_t)row * DFF + col) = pack8(v0, v1);
                }
                asm volatile("" ::: "memory");
            }
    }
};
}
constexpr size_t al256(size_t x) { return (x + 255) & ~(size_t)255; }
constexpr size_t WS_CTL = 0, CTL_ZERO_BYTES = 1u << 20;
constexpr size_t SZ_WIN = (size_t)LDZ * DM * 2, SZ_WBR = (size_t)3072 * 512 * 2, SZ_WO3 = (size_t)DM * 3072 * 2, SZ_WUP = (size_t)DFF * DM * 2, SZ_WDN = (size_t)DM * DFF * 2,
                 SZ_WPL = (size_t)DM * PLE * 2, SZ_WPG = (size_t)DM * DM * 2, SZ_W1T = (size_t)2 * 64 * 2048 * 2, SZ_W2T = (size_t)2 * 64 * 64 * 2;
constexpr size_t WS_WIN = CTL_ZERO_BYTES, WS_WBR = WS_WIN + 2 * SZ_WIN, WS_WO3 = WS_WBR + 2 * SZ_WBR, WS_WUP = WS_WO3 + 2 * SZ_WO3, WS_WDN = WS_WUP + 2 * SZ_WUP,
                 WS_WPL = WS_WDN + 2 * SZ_WDN, WS_WPG = WS_WPL + 2 * SZ_WPL, WS_W1T = WS_WPG + 2 * SZ_WPG, WS_W2T = WS_W1T + 2 * SZ_W1T, WS_ROT = al256(WS_W2T + 2 * SZ_W2T);
constexpr size_t WS_P16 = WS_ROT + (size_t)TP * 64 * 8;
constexpr size_t WS_XR = WS_P16 + (size_t)2 * MROWS * PLE * 2;
constexpr size_t WS_XGA = WS_XR + (size_t)MROWS * DM * 4, WS_XGB = WS_XGA + (size_t)MROWS * DM * 2, WS_XGC = WS_XGB + (size_t)MROWS * DM * 2;
constexpr size_t WS_SSA = WS_XGC + (size_t)MROWS * DM * 2, WS_SSB = WS_SSA + (size_t)MROWS * 64;
constexpr size_t WS_Z = WS_SSB + (size_t)MROWS * 64, WS_ZS = WS_Z + (size_t)MROWS * LDZ * 2;
constexpr size_t WS_MIX = WS_ZS + (size_t)MROWS * 128, WS_GATED = WS_MIX + (size_t)MROWS * 1536 * 2, WS_HMID = WS_GATED + (size_t)MROWS * 3072 * 2;
constexpr size_t WS_TPLE = WS_HMID + (size_t)MROWS * DFF * 2;
constexpr size_t WS_KC = WS_TPLE + (size_t)MROWS * DM * 4;
constexpr size_t WS_KCS = WS_KC + (size_t)2 * 2 * 512 * 2 * 64 * 2;
constexpr int GREC = 73984;
constexpr size_t WS_GREC = WS_KCS + (size_t)2 * 128 * 128 * 2 * 64 * 2;
constexpr size_t WS_OGDN = WS_GREC + (size_t)1024 * GREC;
constexpr size_t WS_RKV = WS_OGDN + (size_t)MROWS * 512 * 4;
constexpr size_t WS_RST = WS_RKV + (size_t)512 * 16384 * 4;
constexpr size_t WS_QR = WS_RST + (size_t)512 * 16384 * 2, WS_KR = WS_QR + (size_t)MP * 512 * 2;
constexpr size_t WS_END = WS_KR + (size_t)MP * 512 * 2;
static_assert(WS_W1T % 256 == 0 && WS_Z % 256 == 0 && WS_GREC % 256 == 0 && WS_RKV % 256 == 0 && WS_KC % 256 == 0 && WS_XR % 256 == 0, "ws alignment");

constexpr int CW_TMO = 0, CW_BAR = 4096;
constexpr int NWAVES = 8, NTHREADS = 512;
constexpr int RING_BYTES = 147456, LDSCTL_OFF = RING_BYTES, MISC_OFF = LDSCTL_OFF + 320, LDS_BYTES = RING_BYTES + 1024;

#define RLX_AGENT __ATOMIC_RELAXED, __HIP_MEMORY_SCOPE_AGENT
#define LDS_WAIT() asm volatile("s_waitcnt lgkmcnt(0)" ::: "memory")
#define VM_WAIT() asm volatile("s_waitcnt vmcnt(0)" ::: "memory")
#define XB_TMO      128
#define XB_XCNT(j)  (256  + 64 * (j))
#define XB_XSUB(j)  (1280 + 64 * (j))
#define XB_XGEN(j)  (2304 + 64 * (j))
#define XB_TOP      3328
#define XB_TOPGEN   3392
#define XCD_BAR_WORDS 3456
#define XB_SPIN_CAP (1u << 18)

__device__ __forceinline__ unsigned xb_ld(unsigned* p)              { return __hip_atomic_load(p, __ATOMIC_RELAXED, __HIP_MEMORY_SCOPE_AGENT); }
__device__ __forceinline__ unsigned xb_add(unsigned* p, unsigned v) { return __hip_atomic_fetch_add(p, v, __ATOMIC_RELAXED, __HIP_MEMORY_SCOPE_AGENT); }
__device__ __forceinline__ unsigned xb_xcc_id() { return (unsigned)__builtin_amdgcn_s_getreg((3 << 11) | 20) & 0xFu; }
#define XB_SPIN(cond, bar) do { unsigned _sp = 0; while (cond) { __builtin_amdgcn_s_sleep(1); \
    if ((++_sp & 255u) == 0u) { if (xb_ld(&(bar)[XB_TMO])) break; if (_sp > XB_SPIN_CAP) { atomicAdd(&(bar)[XB_TMO], 1u); break; } } } } while (0)

struct XcdBarrier {
    unsigned* bar; unsigned x;
    volatile LAS unsigned* st;
};

__device__ __forceinline__ XcdBarrier xcd_barrier_post(unsigned* bar, volatile LAS unsigned* st, bool t0) {
    XcdBarrier b; b.bar = bar; b.x = xb_xcc_id(); b.st = st;
    if (t0) (void)xb_add(&bar[XB_XCNT(b.x)], 1u);
    return b;
}
__device__ __forceinline__ void xcd_barrier_complete(unsigned* bar, unsigned x, unsigned& nloc, unsigned& nx) {
    const unsigned G = gridDim.x * gridDim.y * gridDim.z;
    unsigned sum, cnt, mine, sp = 0u;
    for (;;) {
        sum = 0u; cnt = 0u; mine = 0u;
#pragma unroll
        for (unsigned j = 0; j < 16; ++j) { const unsigned c = xb_ld(&bar[XB_XCNT(j)]); sum += c; cnt += (c > 0u) ? 1u : 0u; mine = (j == x) ? c : mine; }
        if (sum == G) break;
        __builtin_amdgcn_s_sleep(1);
        if ((++sp & 255u) == 0u) { if (xb_ld(&bar[XB_TMO])) break; if (sp > XB_SPIN_CAP) { atomicAdd(&bar[XB_TMO], 1u); break; } }
    }
    nloc = mine > 0u ? mine : 1u; nx = cnt > 0u ? cnt : 1u;
}

__device__ __forceinline__ void xcd_barrier(const XcdBarrier& b, bool t0) {
    asm volatile("s_waitcnt vmcnt(0)" ::: "memory");
    __syncthreads();
    if (t0) {
        unsigned* bar = b.bar;
        __builtin_amdgcn_s_waitcnt(0);
        unsigned nloc = b.st[0], nx = b.st[1];
        if (nloc == 0u) { xcd_barrier_complete(bar, b.x, nloc, nx); b.st[0] = nloc; b.st[1] = nx; }
        const unsigned old = xb_add(&bar[XB_XSUB(b.x)], 1u);
        const unsigned gen = old / nloc;
        if (old + 1u == (gen + 1u) * nloc) {
            __builtin_amdgcn_fence(__ATOMIC_RELEASE, "agent");
            asm volatile("s_waitcnt vmcnt(0)" ::: "memory");
            const unsigned og = xb_add(&bar[XB_TOP], 1u);
            const unsigned tg = og / nx;
            if (og + 1u == (tg + 1u) * nx) xb_add(&bar[XB_TOPGEN], 1u);
            else XB_SPIN(xb_ld(&bar[XB_TOPGEN]) == tg, bar);
            __builtin_amdgcn_fence(__ATOMIC_ACQUIRE, "agent");
            xb_add(&bar[XB_XGEN(b.x)], 1u);
            asm volatile("s_waitcnt vmcnt(0)" ::: "memory");
        } else {
            XB_SPIN(xb_ld(&bar[XB_XGEN(b.x)]) == gen, bar);
            __builtin_amdgcn_fence(__ATOMIC_ACQUIRE, "agent");
            asm volatile("s_waitcnt vmcnt(0)" ::: "memory");
        }
    }
    __syncthreads();
}
typedef const void* const __attribute__((address_space(4)))* kargp_t;
DI const float* KIN(int i) { const float* p = (const float*)((kargp_t)__builtin_amdgcn_kernarg_segment_ptr())[i]; asm volatile("" : "+s"(p)); return p; }
DI float* KOUT() { float* p = (float*)((kargp_t)__builtin_amdgcn_kernarg_segment_ptr())[27]; asm volatile("" : "+s"(p)); return p; }
DI unsigned char* KWS() { unsigned char* p = (unsigned char*)((kargp_t)__builtin_amdgcn_kernarg_segment_ptr())[28]; asm volatile("" : "+s"(p)); return p; }
struct Frame {
    LAS unsigned char* lds;
    gu32* ctl;
    int tid, lane, wave, G, bid;
};
DI bf16x8 ld_frag_g(const bf16* p) { return __builtin_bit_cast(bf16x8, *(const v4u*)p); }
DI bf16x8 ld_frag_l(const LAS unsigned char* p) { return *(const LAS bf16x8*)p; }
DI f32x4 mfma16(bf16x8 a, bf16x8 b, f32x4 c) { return __builtin_amdgcn_mfma_f32_16x16x32_bf16(a, b, c, 0, 0, 0); }
DI bf16x8 pack_frag(const f32x4 a, const f32x4 b) { return __builtin_bit_cast(bf16x8, pack8(a, b)); }
DI int lane_id() { int l; asm volatile("v_mbcnt_lo_u32_b32 %0, -1, 0\n\tv_mbcnt_hi_u32_b32 %0, -1, %0" : "=v"(l)); return l; }
DI Frame fresh(const Frame& F0) {
    Frame F = F0; int w = F0.wave, g = F0.G, b = F0.bid; asm volatile("" : "+s"(w), "+s"(g), "+s"(b));
    int l = lane_id(); asm volatile("" : "+v"(l));
    unsigned lb = (unsigned)(uintptr_t)F0.lds; asm volatile("" : "+s"(lb)); F.lds = (LAS unsigned char*)(uintptr_t)lb;
    F.wave = w; F.lane = l; F.tid = w * 64 + l; F.G = g; F.bid = b; return F;
}
#define GRID_BAR() do { XcdBarrier b_; b_.bar = (unsigned*)((gu32*)(KWS() + WS_CTL) + CW_BAR); b_.x = xb_xcc_id(); b_.st = (volatile LAS unsigned*)(F.lds + MISC_OFF) + 8; \
    const Frame Fb_ = fresh(F); xcd_barrier(b_, Fb_.tid == 0); } while (0)
DI int win_colmap(int j) {
    if (j < 1280) return j; if (j < 2816) return j + 24; if (j < 8448) return j + 32; if (j < 8472) return j - 8448 + 1280; if (j < 8480) return j - 8472 + 2840; return -1;
}
DI void tr_item(const float* W, int ldw, int k0, int srccol, bf16* WT, size_t dst_row0, int ldt, int kdst0, int nrep, int krep, LAS float* scr, int lane) {
#pragma unroll 8
    for (int i = 0; i < 32; ++i) { const int kk = 2 * i + (lane >> 5); scr[kk * 33 + (lane & 31)] = (srccol >= 0) ? W[(size_t)(k0 + kk) * ldw + srccol] : 0.f; }
    LDS_WAIT(); asm volatile("" ::: "memory");
    const int c = lane & 7;
#pragma unroll
    for (int j = 0; j < 4; ++j) { const int n = (lane >> 3) + 8 * j; const LAS float* s = scr + (8 * c) * 33 + n;
        v4u o; o.x = pk2(s[0 * 33], s[1 * 33]); o.y = pk2(s[2 * 33], s[3 * 33]); o.z = pk2(s[4 * 33], s[5 * 33]); o.w = pk2(s[6 * 33], s[7 * 33]);
        for (int r = 0; r < nrep; ++r) *(v4u*)(WT + (dst_row0 + n) * (size_t)ldt + kdst0 + r * krep + 8 * c) = o; }
    LDS_WAIT(); asm volatile("" ::: "memory");
}
DI void p0_prologue(Frame& F) {
    LAS float* scr = (LAS float*)(F.lds + F.wave * 16384);
    const int gw = F.bid * NWAVES + F.wave, NGW = F.G * NWAVES, lane = F.lane;
    unsigned char* ws = KWS();
    constexpr int I_A = 16 * 272, I_B = 3 * 8 * 32, I_C = 16 * 32, I_D = 16 * 128, I_E = 64 * 32, I_F = 4 * 32, I_G = 16 * 32, I_H = 2 * 32 * 2, I_I = 2 * 2;
    constexpr int I_L = I_A + I_B + I_C + I_D + I_E + I_F + I_G + I_H + I_I;
    for (int it = gw; it < 2 * I_L; it += NGW) {
        const int l = it / I_L; int r = it % I_L;
        if (r < I_A) { const int kb = r / 272, nb = r % 272; tr_item(KIN(11) + (size_t)l * DM * 8480, 8480, 64 * kb, win_colmap(32 * nb + (lane & 31)), (bf16*)(ws + WS_WIN + l * SZ_WIN), 32 * nb, DM, 64 * kb, 1, 0, scr, lane); continue; } r -= I_A;
        if (r < I_B) { const int b = r / 256, kb = (r % 256) / 32, nb = r % 32; tr_item(KIN(19) + (size_t)(l * 3 + b) * 512 * DM, DM, 64 * kb, 32 * nb + (lane & 31), (bf16*)(ws + WS_WBR + l * SZ_WBR), b * 1024 + 32 * nb, 512, 64 * kb, 1, 0, scr, lane); continue; } r -= I_B;
        if (r < I_C) { const int kb = r / 32, nb = r % 32; tr_item(KIN(20) + (size_t)l * DM * DM, DM, 64 * kb, 32 * nb + (lane & 31), (bf16*)(ws + WS_WO3 + l * SZ_WO3), 32 * nb, 3072, 64 * kb, 3, 1024, scr, lane); continue; } r -= I_C;
        if (r < I_D) { const int kb = r / 128, nb = r % 128; tr_item(KIN(22) + (size_t)l * DM * DFF, DFF, 64 * kb, 32 * nb + (lane & 31), (bf16*)(ws + WS_WUP + l * SZ_WUP), 32 * nb, DM, 64 * kb, 1, 0, scr, lane); continue; } r -= I_D;
        if (r < I_E) { const int kb = r / 32, nb = r % 32; tr_item(KIN(23) + (size_t)l * DFF * DM, DM, 64 * kb, 32 * nb + (lane & 31), (bf16*)(ws + WS_WDN + l * SZ_WDN), 32 * nb, DFF, 64 * kb, 1, 0, scr, lane); continue; } r -= I_E;
        if (r < I_F) { const int kb = r / 32, nb = r % 32; tr_item(KIN(24) + (size_t)l * PLE * DM, DM, 64 * kb, 32 * nb + (lane & 31), (bf16*)(ws + WS_WPL + l * SZ_WPL), 32 * nb, PLE, 64 * kb, 1, 0, scr, lane); continue; } r -= I_F;
        if (r < I_G) { const int kb = r / 32, nb = r % 32; tr_item(KIN(25) + (size_t)l * DM * DM, DM, 64 * kb, 32 * nb + (lane & 31), (bf16*)(ws + WS_WPG + l * SZ_WPG), 32 * nb, DM, 64 * kb, 1, 0, scr, lane); continue; } r -= I_G;
        if (r < I_H) { const int kv = r / 64, kb = (r % 64) / 2, nb = r % 2; tr_item(KIN(13) + (size_t)(l * 2 + kv) * 2048 * 64, 64, 64 * kb, 32 * nb + (lane & 31), (bf16*)(ws + WS_W1T + l * SZ_W1T) + (size_t)kv * 64 * 2048, 32 * nb, 2048, 64 * kb, 1, 0, scr, lane); continue; } r -= I_H;
        { const int kv = r / 2, nb = r % 2; tr_item(KIN(14) + (size_t)(l * 2 + kv) * 64 * 64, 64, 0, 32 * nb + (lane & 31), (bf16*)(ws + WS_W2T + l * SZ_W2T) + (size_t)kv * 64 * 64, 32 * nb, 64, 0, 1, 0, scr, lane); }
    }
    float* XR = (float*)(ws + WS_XR); bf16* XGA = (bf16*)(ws + WS_XGA); float* SSA = (float*)(ws + WS_SSA); bf16* P16 = (bf16*)(ws + WS_P16);
    const float* g0 = KIN(10);
    for (int row = gw; row < MROWS; row += NGW) {
        const float* xs = (row < MP) ? KIN(0) + (size_t)row * DM : KIN(1) + (size_t)(row - MP) * DM;
        float ss = 0.f;
#pragma unroll
        for (int j = 0; j < 2; ++j) {
            const int c = j * 512 + lane * 8;
            f32x4 a = *(const f32x4*)(xs + c), b = *(const f32x4*)(xs + c + 4);
            *(f32x4*)(XR + (size_t)row * DM + c) = a; *(f32x4*)(XR + (size_t)row * DM + c + 4) = b;
            ss += (a[0] * a[0] + a[1] * a[1]) + (a[2] * a[2] + a[3] * a[3]) + (b[0] * b[0] + b[1] * b[1]) + (b[2] * b[2] + b[3] * b[3]);
            const f32x4 ga = *(const f32x4*)(g0 + c), gb = *(const f32x4*)(g0 + c + 4);
            *(v4u*)(XGA + (size_t)row * DM + c) = pack8(a * ga, b * gb);
        }
        ss = wave_sum(ss, lane);
        if (lane < 16) SSA[(size_t)row * 16 + lane] = (lane == 0) ? ss : 0.f;
#pragma unroll
        for (int l = 0; l < 2; ++l) {
            const float* ps = (row < MP) ? KIN(8) + ((size_t)l * MP + row) * PLE : KIN(9) + ((size_t)l * MS + (row - MP)) * PLE;
            const f32x4 a = *(const f32x4*)(ps + lane * 4);
            v2u o; o.x = pk2(a[0], a[1]); o.y = pk2(a[2], a[3]);
            *(v2u*)(P16 + ((size_t)l * MROWS + row) * PLE + lane * 4) = o;
        }
    }
    const int gt = F.bid * NTHREADS + F.tid, NGT = F.G * NTHREADS;
    f32x2* ROT = (f32x2*)(ws + WS_ROT);
    for (int e = gt; e < TP * 64; e += NGT) {
        const int pos = e >> 6, i = e & 63;
        const float x = (float)i * (1.0f / 63.0f);
        const float inv = exp2f(-x * 13.287712379549449f);
        const float ang = (float)pos * inv;
        const double rev = (double)ang * 0.15915494309189535;
        const float fr = (float)(rev - floor(rev));
        ROT[e] = (f32x2){__builtin_amdgcn_cosf(fr), __builtin_amdgcn_sinf(fr)};
    }
    for (int e = gt; e < 2 * 128 * 508 * 64; e += NGT) {
        const int ls = e / (508 * 64), r = e % (508 * 64);
        const f32x4 v = *(const f32x4*)(KIN(3) + (size_t)ls * 512 * 256 + 4 * 256 + (size_t)r * 4);
        *(f32x4*)(KOUT() + O_WINS + (size_t)ls * 512 * 256 + (size_t)r * 4) = v;
    }
}
DI float gelu_tanh(float x) { const float u = 0.7978845608028654f * (x + 0.044715f * x * x * x); const float e = __expf(2.f * u); return 0.5f * x * (1.f + (1.f - 2.f / (e + 1.f))); }
DI bf16x8 mk_frag(v2u a, v2u b) { v4u w; w.x = a.x; w.y = a.y; w.z = b.x; w.w = b.y; return __builtin_bit_cast(bf16x8, w); }

DI void compress_job(Frame& F, int layer, int job) {
    int lane = F.lane, wave = F.wave; asm volatile("" : "+v"(lane), "+s"(wave));
    const int tid = wave * 64 + lane, quad = lane >> 4, rl = lane & 15;
    unsigned char* ws = KWS();
    const bool sample = job < 256;
    int kv, bs, g0, nbase;
    if (sample) { kv = job >> 7; bs = job & 127; g0 = 0; nbase = 0; }
    else { const int j2 = job - 256; kv = j2 >> 3; bs = (j2 >> 2) & 1; g0 = (j2 >> 1) & 1; nbase = (j2 & 1) * 256; }
    const bf16* W1T = (const bf16*)(ws + WS_W1T + layer * SZ_W1T) + (size_t)kv * 64 * 2048;
    const bf16* W2T = (const bf16*)(ws + WS_W2T + layer * SZ_W2T) + (size_t)kv * 64 * 64;
    const float* pe = KIN(12) + (size_t)(layer * 2 + kv) * 32 * 64;
    const bf16* Z = (const bf16*)(ws + WS_Z);
    const int* pt = (const int*)KIN(7);
    const float* cache = KIN(2);
    LAS unsigned char* LW = F.lds;
    int gg[2], nn[2];
#pragma unroll
    for (int tl = 0; tl < 2; ++tl) { const int T = 2 * wave + tl; if (sample) { gg[tl] = T >> 3; nn[tl] = 16 * (T & 7) + rl; } else { gg[tl] = g0; nn[tl] = nbase + 16 * T + rl; } }
    f32x4 h[2][4];
#pragma unroll
    for (int tl = 0; tl < 2; ++tl)
#pragma unroll
        for (int i = 0; i < 4; ++i) h[tl][i] = (f32x4){0.f, 0.f, 0.f, 0.f};
#pragma unroll 1
    for (int c = 0; c < 4; ++c) {
        __syncthreads();
#pragma unroll
        for (int k = 0; k < 8; ++k) { const int pc = tid + 512 * k, r = pc >> 6, c16 = pc & 63;
            *(LAS v4u*)(LW + r * 1040 + c16 * 16) = *(const v4u*)(W1T + (size_t)r * 2048 + c * 512 + c16 * 8); }
        __syncthreads();
#pragma unroll 4
        for (int kk = 0; kk < 16; ++kk) {
            const int j = 8 * c + (kk >> 1), dim0 = (kk & 1) * 32 + quad * 8;
            const f32x4 pe0 = *(const f32x4*)(pe + j * 64 + dim0), pe1 = *(const f32x4*)(pe + j * 64 + dim0 + 4);
            bf16x8 xb[2];
#pragma unroll
            for (int tl = 0; tl < 2; ++tl) {
                f32x4 x0, x1;
                if (!sample) { const size_t row = (size_t)bs * TP + 16 * nn[tl] + j; unpack8(*(const v4u*)(Z + row * LDZ + ZC_KC + kv * 128 + gg[tl] * 64 + dim0), x0, x1); }
                else { int pos = 16 * nn[tl] + j; pos = pos > 2047 ? 2047 : pos; const int phys = pt[bs * 16 + (pos >> 7)];
                    const float* p = cache + ((size_t)(layer * 2560 + phys) * 128 + (pos & 127)) * 512 + kv * 128 + gg[tl] * 64 + dim0; x0 = *(const f32x4*)p; x1 = *(const f32x4*)(p + 4); }
                xb[tl] = pack_frag(x0 + pe0, x1 + pe1);
            }
#pragma unroll
            for (int ht = 0; ht < 4; ++ht) {
                const bf16x8 a = ld_frag_l(LW + (16 * ht + rl) * 1040 + (kk * 32 + quad * 8) * 2);
                h[0][ht] = mfma16(a, xb[0], h[0][ht]); h[1][ht] = mfma16(a, xb[1], h[1][ht]);
            }
        }
    }
#pragma unroll
    for (int tl = 0; tl < 2; ++tl) {
#pragma unroll
        for (int ht = 0; ht < 4; ++ht)
#pragma unroll
            for (int i = 0; i < 4; ++i) h[tl][ht][i] = gelu_tanh(h[tl][ht][i]);
        bf16x8 gb[2]; gb[0] = pack_frag(h[tl][0], h[tl][1]); gb[1] = pack_frag(h[tl][2], h[tl][3]);
        const int n = nn[tl], g = gg[tl];
        bf16* dst = sample ? (bf16*)(ws + WS_KCS) + ((((size_t)kv * 128 + bs) * 128 + n) * 2 + g) * 64 : (bf16*)(ws + WS_KC) + ((((size_t)kv * 2 + bs) * 512 + n) * 2 + g) * 64;
        const bool zero = sample && n == 127;
#pragma unroll
        for (int ot = 0; ot < 4; ++ot) {
            f32x4 o = (f32x4){0.f, 0.f, 0.f, 0.f};
#pragma unroll
            for (int s = 0; s < 2; ++s) {
                const bf16* wp = W2T + (16 * ot + rl) * 64 + 32 * s + 4 * quad;
                o = mfma16(mk_frag(*(const v2u*)wp, *(const v2u*)(wp + 16)), gb[s], o);
            }
            v2u w; w.x = zero ? 0u : pk2(o[0], o[1]); w.y = zero ? 0u : pk2(o[2], o[3]);
            *(v2u*)(dst + 16 * ot + 4 * quad) = w;
        }
    }
    __syncthreads();
}

DI int kperm(int idx) { const int s = idx >> 5, r = idx & 31; return 32 * s + 8 * ((r >> 2) & 3) + 4 * (r >> 4) + (r & 3); }
DI float softplusf_(float x) { return x > 20.f ? x : __logf(1.f + __expf(x)); }
DI float ret_lg(int h) { return h == 0 ? -0.031748697f : h == 1 ? -0.015748357f : h == 2 ? -0.007843178f : -0.0039138994f; }

DI void gdn_prep_unit(Frame& F, int layer, int unit) {
    const int tid = F.tid, lane = F.lane, wave = F.wave;
    const int b = unit >> 9, h = (unit >> 7) & 3, c = unit & 127;
    const int row0 = b * TP + 64 * c, t0 = 64 * c;
    unsigned char* ws = KWS();
    const bf16* Z = (const bf16*)(ws + WS_Z);
    const float* ZS = (const float*)(ws + WS_ZS);
    LAS float* Lq = (LAS float*)(F.lds); LAS float* Lk = (LAS float*)(F.lds + 33792); LAS float* Lv = (LAS float*)(F.lds + 67584);
    LAS float* LA = (LAS float*)(F.lds + 101376); LAS float* LQK = (LAS float*)(F.lds + 117760);
    LAS float* Lg = (LAS float*)(F.lds + 134144); LAS float* Lb = Lg + 64; LAS float* Le = Lg + 128;
    const float* cw = KIN(15) + (size_t)layer * 4 * 1536;
#pragma unroll
    for (int it0 = 0; it0 < 6; ++it0) {
        const int it = tid + it0 * NTHREADS;
        const int i = it / 48, ch = it % 48, part = ch >> 4, cc = ch & 15;
        const int col = part * 512 + h * 128 + cc * 8;
        f32x4 y0 = (f32x4){0.f, 0.f, 0.f, 0.f}, y1 = y0;
#pragma unroll
        for (int j = 0; j < 4; ++j) {
            const int t = t0 + i - 3 + j;
            if (t >= 0) { f32x4 x0, x1; unpack8(*(const v4u*)(Z + (size_t)(row0 + i - 3 + j) * LDZ + ZC_GQKV + col), x0, x1);
                y0 += x0 * *(const f32x4*)(cw + j * 1536 + col); y1 += x1 * *(const f32x4*)(cw + j * 1536 + col + 4); }
        }
#pragma unroll
        for (int e = 0; e < 4; ++e) { y0[e] = siluf_(y0[e]); y1[e] = siluf_(y1[e]); }
        LAS float* dst = (part == 0 ? Lq : part == 1 ? Lk : Lv) + i * 132 + cc * 8;
        *(LAS f32x4*)dst = y0; *(LAS f32x4*)(dst + 4) = y1;
    }
    __syncthreads();
    {
        float va[16], vb[16], ps[16];
#pragma unroll
        for (int q = 0; q < 16; ++q) { LAS float* vp = ((q < 8) ? Lq : Lk) + (wave * 8 + (q & 7)) * 132 + lane * 2; va[q] = vp[0]; vb[q] = vp[1]; ps[q] = va[q] * va[q] + vb[q] * vb[q]; }
#pragma unroll
        for (int q = 0; q < 16; ++q) ps[q] += shx<1>(ps[q], lane);
#pragma unroll
        for (int q = 0; q < 16; ++q) ps[q] += shx<2>(ps[q], lane);
#pragma unroll
        for (int q = 0; q < 16; ++q) ps[q] += shx<4>(ps[q], lane);
#pragma unroll
        for (int q = 0; q < 16; ++q) ps[q] += shx<8>(ps[q], lane);
#pragma unroll
        for (int q = 0; q < 16; ++q) ps[q] += shx<16>(ps[q], lane);
#pragma unroll
        for (int q = 0; q < 16; ++q) ps[q] += shx<32>(ps[q], lane);
#pragma unroll
        for (int q = 0; q < 16; ++q) { LAS float* vp = ((q < 8) ? Lq : Lk) + (wave * 8 + (q & 7)) * 132 + lane * 2; const float sc = rsqrtf(ps[q] + EPS) * ((q < 8) ? 0.08838834764831845f : 1.f); vp[0] = va[q] * sc; vp[1] = vb[q] * sc; }
    }
    if (wave == 0) {
        const float ga = ZS[(size_t)(row0 + lane) * 32 + 24 + h], gbv = ZS[(size_t)(row0 + lane) * 32 + 28 + h];
        float g = -__expf(KIN(16)[layer * 4 + h]) * softplusf_(ga + KIN(17)[layer * 4 + h]);
#pragma unroll
        for (int o = 1; o < 64; o <<= 1) { const float t = __int_as_float(__builtin_amdgcn_ds_bpermute(((lane - o) & 63) << 2, __float_as_int(g))); if (lane >= o) g += t; }
        Lg[lane] = g; Lb[lane] = sigmoidf_(gbv); Le[lane] = __expf(g);
    }
    __syncthreads();
    {
        const int it = wave >> 1, quad = lane >> 4, rl = lane & 15;
        f32x4 ckk[2], cqk[2];
#pragma unroll
        for (int jj = 0; jj < 2; ++jj) { ckk[jj] = (f32x4){0.f, 0.f, 0.f, 0.f}; cqk[jj] = ckk[jj]; }
#pragma unroll
        for (int s = 0; s < 4; ++s) {
            const LAS float* kp = Lk + (16 * it + rl) * 132 + 32 * s + 8 * quad; const LAS float* qp = Lq + (16 * it + rl) * 132 + 32 * s + 8 * quad;
            const f32x4 ka0 = *(const LAS f32x4*)kp, ka1 = *(const LAS f32x4*)(kp + 4), qa0 = *(const LAS f32x4*)qp, qa1 = *(const LAS f32x4*)(qp + 4);
            const bf16x8 kah = pack_frag(ka0, ka1), qah = pack_frag(qa0, qa1);
            f32x4 h0, h1; unpack8(__builtin_bit_cast(v4u, kah), h0, h1); const bf16x8 kal = pack_frag(ka0 - h0, ka1 - h1);
            unpack8(__builtin_bit_cast(v4u, qah), h0, h1); const bf16x8 qal = pack_frag(qa0 - h0, qa1 - h1);
#pragma unroll
            for (int jj = 0; jj < 2; ++jj) {
                const int jt = (wave & 1) * 2 + jj;
                if (jt <= it) {
                    const LAS float* bp = Lk + (16 * jt + rl) * 132 + 32 * s + 8 * quad;
                    const f32x4 kb0 = *(const LAS f32x4*)bp, kb1 = *(const LAS f32x4*)(bp + 4);
                    const bf16x8 kbh = pack_frag(kb0, kb1); unpack8(__builtin_bit_cast(v4u, kbh), h0, h1); const bf16x8 kbl = pack_frag(kb0 - h0, kb1 - h1);
                    ckk[jj] = mfma16(kah, kbh, ckk[jj]); ckk[jj] = mfma16(kah, kbl, ckk[jj]); ckk[jj] = mfma16(kal, kbh, ckk[jj]);
                    cqk[jj] = mfma16(qah, kbh, cqk[jj]); cqk[jj] = mfma16(qah, kbl, cqk[jj]); cqk[jj] = mfma16(qal, kbh, cqk[jj]);
                }
            }
        }
#pragma unroll
        for (int jj = 0; jj < 2; ++jj) {
            const int j = 16 * ((wave & 1) * 2 + jj) + rl; const float gj = Lg[j];
#pragma unroll
            for (int e = 0; e < 4; ++e) { const int i = 16 * it + 4 * quad + e; const float dec = (i >= j) ? __expf(Lg[i] - gj) : 0.f;
                LA[i * 64 + j] = (i > j) ? Lb[i] * ckk[jj][e] * dec : 0.f; LQK[i * 64 + j] = cqk[jj][e] * dec; }
        }
    }
    __syncthreads();
    unsigned char* rec = ws + WS_GREC + (size_t)unit * GREC;
    {
        const float gl = Lg[63];
        for (int it = tid; it < 2560; it += NTHREADS) {
            if (it < 1024) {
                const int i = it >> 4, s = (it >> 2) & 3, quad = it & 3; const float e = Le[i];
                const f32x4 a = *(const LAS f32x4*)(Lq + i * 132 + 32 * s + 4 * quad) * e, bq = *(const LAS f32x4*)(Lq + i * 132 + 32 * s + 16 + 4 * quad) * e;
                *(v4u*)(rec + 16384 + i * 256 + (32 * s + 8 * quad) * 2) = pack8(a, bq);
            } else if (it < 2048) {
                const int r = it - 1024, dk = r >> 3, s2 = (r >> 2) & 1, quad = r & 3;
                f32x4 a, bq;
#pragma unroll
                for (int e = 0; e < 4; ++e) { const int ta = 32 * s2 + 4 * quad + e, tb = ta + 16; a[e] = Lk[ta * 132 + dk] * __expf(gl - Lg[ta]); bq[e] = Lk[tb * 132 + dk] * __expf(gl - Lg[tb]); }
                *(v4u*)(rec + 32768 + dk * 128 + (32 * s2 + 8 * quad) * 2) = pack8(a, bq);
            } else {
                const int r = it - 2048, i = r >> 3, s2 = (r >> 2) & 1, quad = r & 3;
                const f32x4 a = *(const LAS f32x4*)(LQK + i * 64 + 32 * s2 + 4 * quad), bq = *(const LAS f32x4*)(LQK + i * 64 + 32 * s2 + 16 + 4 * quad);
                *(v4u*)(rec + 65536 + i * 128 + (32 * s2 + 8 * quad) * 2) = pack8(a, bq);
            }
        }
        if (tid == 0) *(float*)(rec + 73728) = __expf(gl);
    }
    __syncthreads();
    if (tid < 256) {
        LAS float* X = (tid < 128) ? (Lv + tid) : (Lk + (tid - 128));
        const bool isw = tid >= 128;
#pragma unroll 1
        for (int B = 0; B < 4; ++B) {
            float xb[16];
#pragma unroll
            for (int i = 0; i < 16; ++i) { const int r = 16 * B + i; xb[i] = (isw ? Lb[r] * Le[r] : Lb[r]) * X[r * 132]; }
#pragma unroll 1
            for (int j4 = 0; j4 < 4 * B; ++j4) {
                const float x0 = X[(4 * j4) * 132], x1 = X[(4 * j4 + 1) * 132], x2 = X[(4 * j4 + 2) * 132], x3 = X[(4 * j4 + 3) * 132];
#pragma unroll
                for (int i = 0; i < 16; ++i) { const f32x4 a = *(const LAS f32x4*)(LA + (16 * B + i) * 64 + 4 * j4); xb[i] -= (a[0] * x0 + a[1] * x1) + (a[2] * x2 + a[3] * x3); }
            }
#pragma unroll
            for (int i = 1; i < 16; ++i) {
                float acc0 = 0.f, acc1 = 0.f;
#pragma unroll
                for (int j4 = 0; j4 < (i + 3) / 4; ++j4) { const f32x4 a = *(const LAS f32x4*)(LA + (16 * B + i) * 64 + 16 * B + 4 * j4);
                    if (4 * j4 + 0 < i) acc0 += a[0] * xb[4 * j4 + 0]; if (4 * j4 + 1 < i) acc1 += a[1] * xb[4 * j4 + 1]; if (4 * j4 + 2 < i) acc0 += a[2] * xb[4 * j4 + 2]; if (4 * j4 + 3 < i) acc1 += a[3] * xb[4 * j4 + 3]; }
                xb[i] -= acc0 + acc1;
            }
#pragma unroll
            for (int i = 0; i < 16; ++i) X[(16 * B + i) * 132] = xb[i];
        }
    }
    __syncthreads();
    for (int it = tid; it < 2048; it += NTHREADS) {
        if (it < 1024) {
            const int dv = it >> 3, q = it & 7;
            v4u w; w.x = pk2(Lv[(8 * q) * 132 + dv], Lv[(8 * q + 1) * 132 + dv]); w.y = pk2(Lv[(8 * q + 2) * 132 + dv], Lv[(8 * q + 3) * 132 + dv]);
            w.z = pk2(Lv[(8 * q + 4) * 132 + dv], Lv[(8 * q + 5) * 132 + dv]); w.w = pk2(Lv[(8 * q + 6) * 132 + dv], Lv[(8 * q + 7) * 132 + dv]);
            *(v4u*)(rec + 49152 + dv * 128 + q * 16) = w;
        } else {
            const int r = it - 1024, i = r >> 4, s = (r >> 2) & 3, quad = r & 3;
            const f32x4 a = *(const LAS f32x4*)(Lk + i * 132 + 32 * s + 4 * quad), bq = *(const LAS f32x4*)(Lk + i * 132 + 32 * s + 16 + 4 * quad);
            *(v4u*)(rec + i * 256 + (32 * s + 8 * quad) * 2) = pack8(a, bq);
        }
    }
    __syncthreads();
}

DI void ret_prep_unit(Frame& F, int layer, int unit) {
    const int tid = F.tid, lane = F.lane, wave = F.wave, quad = lane >> 4, rl = lane & 15;
    const int b = unit >> 8, h = (unit >> 6) & 3, c = unit & 63;
    const int row0 = b * TP + 128 * c;
    unsigned char* ws = KWS();
    const bf16* Z = (const bf16*)(ws + WS_Z);
    const f32x2* ROT = (const f32x2*)(ws + WS_ROT);
    bf16* QR = (bf16*)(ws + WS_QR); bf16* KR = (bf16*)(ws + WS_KR);
    LAS unsigned char* LK = F.lds; LAS unsigned char* LV = F.lds + 34816;
    const float lg = ret_lg(h);
    for (int it = tid; it < 1024; it += NTHREADS) {
        const int j = it >> 3, cc = it & 7, d0 = cc * 8;
        const size_t zr = (size_t)(row0 + j) * LDZ + ZC_RQKV + h * 128 + d0;
        f32x4 q1a, q1b, q2a, q2b, k1a, k1b, k2a, k2b;
        unpack8(*(const v4u*)(Z + zr), q1a, q1b); unpack8(*(const v4u*)(Z + zr + 64), q2a, q2b);
        unpack8(*(const v4u*)(Z + zr + 512), k1a, k1b); unpack8(*(const v4u*)(Z + zr + 512 + 64), k2a, k2b);
        const f32x2* rp = ROT + (size_t)(128 * c + j) * 64 + d0;
        const float kd = __expf((float)(127 - j) * lg);
        f32x4 oq1a, oq1b, oq2a, oq2b, ok1a, ok1b, ok2a, ok2b;
#pragma unroll
        for (int e = 0; e < 8; ++e) {
            const f32x2 cs = rp[e];
            const float q1 = e < 4 ? q1a[e & 3] : q1b[e & 3], q2 = e < 4 ? q2a[e & 3] : q2b[e & 3], k1 = e < 4 ? k1a[e & 3] : k1b[e & 3], k2 = e < 4 ? k2a[e & 3] : k2b[e & 3];
            const float rq1 = q1 * cs.x - q2 * cs.y, rq2 = q2 * cs.x + q1 * cs.y, rk1 = (k1 * cs.x - k2 * cs.y) * 0.08838834764831845f, rk2 = (k2 * cs.x + k1 * cs.y) * 0.08838834764831845f;
            if (e < 4) { oq1a[e & 3] = rq1; oq2a[e & 3] = rq2; ok1a[e & 3] = rk1; ok2a[e & 3] = rk2; } else { oq1b[e & 3] = rq1; oq2b[e & 3] = rq2; ok1b[e & 3] = rk1; ok2b[e & 3] = rk2; }
            *(LAS bf16*)(LK + (d0 + e) * 272 + j * 2) = (bf16)f2bf(rk1 * kd); *(LAS bf16*)(LK + (d0 + 64 + e) * 272 + j * 2) = (bf16)f2bf(rk2 * kd);
        }
        const size_t orow = (size_t)(row0 + j) * 512 + h * 128 + d0;
        *(v4u*)(QR + orow) = pack8(oq1a, oq1b); *(v4u*)(QR + orow + 64) = pack8(oq2a, oq2b);
        *(v4u*)(KR + orow) = pack8(ok1a, ok1b); *(v4u*)(KR + orow + 64) = pack8(ok2a, ok2b);
    }
    for (int it = tid; it < 2048; it += NTHREADS) {
        const int j = it >> 4, cc = it & 15;
        const v4u w = *(const v4u*)(Z + (size_t)(row0 + j) * LDZ + ZC_RQKV + 1024 + h * 128 + cc * 8);
        LAS unsigned char* d = LV + (cc * 8) * 272 + j * 2;
        *(LAS bf16*)(d) = (bf16)(w.x & 0xffff); *(LAS bf16*)(d + 272) = (bf16)(w.x >> 16); *(LAS bf16*)(d + 2 * 272) = (bf16)(w.y & 0xffff); *(LAS bf16*)(d + 3 * 272) = (bf16)(w.y >> 16);
        *(LAS bf16*)(d + 4 * 272) = (bf16)(w.z & 0xffff); *(LAS bf16*)(d + 5 * 272) = (bf16)(w.z >> 16); *(LAS bf16*)(d + 6 * 272) = (bf16)(w.w & 0xffff); *(LAS bf16*)(d + 7 * 272) = (bf16)(w.w >> 16);
    }
    __syncthreads();
    float* RKV = (float*)(ws + WS_RKV) + (size_t)unit * 16384;
#pragma unroll
    for (int nt = 0; nt < 8; ++nt) {
        f32x4 acc = (f32x4){0.f, 0.f, 0.f, 0.f};
#pragma unroll
        for (int s = 0; s < 4; ++s) acc = mfma16(ld_frag_l(LK + (16 * wave + rl) * 272 + (32 * s + 8 * quad) * 2), ld_frag_l(LV + (16 * nt + rl) * 272 + (32 * s + 8 * quad) * 2), acc);
#pragma unroll
        for (int i = 0; i < 4; ++i) RKV[(size_t)(16 * wave + 4 * quad + i) * 128 + 16 * nt + rl] = acc[i];
    }
    __syncthreads();
}
DI void sample_rec_unit(Frame& F, int layer, int unit) {
    const int tid = F.tid, lane = F.lane, wave = F.wave;
    const int kind = unit >> 9, s = (unit >> 2) & 127, h = unit & 3;
    const int dv = tid & 127, part = tid >> 7, r0 = MP + 4 * s;
    unsigned char* ws = KWS();
    const bf16* Z = (const bf16*)(ws + WS_Z);
    const float* ZS = (const float*)(ws + WS_ZS);
    LAS float* Lq = (LAS float*)(F.lds); LAS float* Lk = Lq + 512; LAS float* Lv = Lq + 1024; LAS float* red = Lq + 1536; LAS float* Lo = Lq + 2048; LAS float* sc = Lq + 2560;
    float S[32];
    if (kind == 0) {
        if (tid < 384) {
            const int pr = tid >> 7, d = tid & 127, col = pr * 512 + h * 128 + d;
            float xp[7], w[4];
#pragma unroll
            for (int i = 0; i < 3; ++i) xp[i] = KIN(4)[((size_t)(layer * 128 + s) * 3 + i) * 1536 + col];
#pragma unroll
            for (int j = 0; j < 4; ++j) xp[3 + j] = bf2f(Z[(size_t)(r0 + j) * LDZ + ZC_GQKV + col]);
#pragma unroll
            for (int i = 0; i < 4; ++i) w[i] = KIN(15)[(size_t)(layer * 4 + i) * 1536 + col];
            LAS float* dst = pr == 0 ? Lq : pr == 1 ? Lk : Lv;
#pragma unroll
            for (int j = 0; j < 4; ++j) dst[j * 128 + d] = siluf_(w[0] * xp[j] + w[1] * xp[j + 1] + w[2] * xp[j + 2] + w[3] * xp[j + 3]);
        }
        __syncthreads();
        {
            LAS float* vp = (wave < 4 ? Lq : Lk) + (wave & 3) * 128;
            const float a = vp[2 * lane], b = vp[2 * lane + 1];
            const float scl = rsqrtf(wave_sum(a * a + b * b, lane) + EPS) * (wave < 4 ? 0.08838834764831845f : 1.f);
            vp[2 * lane] = a * scl; vp[2 * lane + 1] = b * scl;
        }
        if (tid < 4) {
            const float ga = ZS[(size_t)(r0 + tid) * 32 + 24 + h], gb = ZS[(size_t)(r0 + tid) * 32 + 28 + h];
            sc[tid] = __expf(-__expf(KIN(16)[layer * 4 + h]) * softplusf_(ga + KIN(17)[layer * 4 + h])); sc[4 + tid] = sigmoidf_(gb);
        }
        __syncthreads();
        const float* Sin = KIN(5) + ((size_t)((layer * 128 + s) * 4 + h) * 128 + 32 * part) * 128 + dv;
#pragma unroll
        for (int i = 0; i < 32; ++i) S[i] = Sin[(size_t)i * 128];
#pragma unroll
        for (int j = 0; j < 4; ++j) {
            const float a = sc[j], beta = sc[4 + j];
            float p = 0.f;
#pragma unroll
            for (int i = 0; i < 32; ++i) { S[i] *= a; p += Lk[j * 128 + 32 * part + i] * S[i]; }
            red[part * 128 + dv] = p;
            __syncthreads();
            const float delta = beta * (Lv[j * 128 + dv] - ((red[dv] + red[128 + dv]) + (red[256 + dv] + red[384 + dv])));
            __syncthreads();
            float o = 0.f;
#pragma unroll
            for (int i = 0; i < 32; ++i) { S[i] += Lk[j * 128 + 32 * part + i] * delta; o += Lq[j * 128 + 32 * part + i] * S[i]; }
            red[part * 128 + dv] = o;
            __syncthreads();
            if (part == 0) Lo[j * 128 + dv] = (red[dv] + red[128 + dv]) + (red[256 + dv] + red[384 + dv]);
            __syncthreads();
        }
        float* Sout = KOUT() + O_GSS + ((size_t)((layer * 128 + s) * 4 + h) * 128 + 32 * part) * 128 + dv;
#pragma unroll
        for (int i = 0; i < 32; ++i) Sout[(size_t)i * 128] = S[i];
        ((float*)(ws + WS_OGDN))[(size_t)(r0 + part) * 512 + h * 128 + dv] = Lo[part * 128 + dv];
    } else {
        const f32x2* ROT = (const f32x2*)(ws + WS_ROT);
        if (tid < 384) {
            const int pr = tid >> 7, d = tid & 127;
#pragma unroll
            for (int j = 0; j < 4; ++j) {
                const bf16* zp = Z + (size_t)(r0 + j) * LDZ + ZC_RQKV + pr * 512 + h * 128;
                float v = bf2f(zp[d]);
                if (pr < 2) { const f32x2 cs = ROT[(size_t)(2048 + j) * 64 + (d & 63)]; const float o = bf2f(zp[d ^ 64]);
                    v = (d < 64) ? v * cs.x - o * cs.y : v * cs.x + o * cs.y; if (pr == 1) v *= 0.08838834764831845f; }
                (pr == 0 ? Lq : pr == 1 ? Lk : Lv)[j * 128 + d] = v;
            }
        }
        __syncthreads();
        const float gam = __expf(ret_lg(h));
        const float* Sin = KIN(6) + ((size_t)((layer * 128 + s) * 4 + h) * 128 + 32 * part) * 128 + dv;
#pragma unroll
        for (int i = 0; i < 32; ++i) S[i] = Sin[(size_t)i * 128];
#pragma unroll
        for (int j = 0; j < 4; ++j) {
            const float vv = Lv[j * 128 + dv];
            float o = 0.f;
#pragma unroll
            for (int i = 0; i < 32; ++i) { S[i] = S[i] * gam + Lk[j * 128 + 32 * part + i] * vv; o += Lq[j * 128 + 32 * part + i] * S[i]; }
            red[part * 128 + dv] = o;
            __syncthreads();
            if (part == 0) Lo[j * 128 + dv] = (red[dv] + red[128 + dv]) + (red[256 + dv] + red[384 + dv]);
            __syncthreads();
        }
        float* Sout = KOUT() + O_RSS + ((size_t)((layer * 128 + s) * 4 + h) * 128 + 32 * part) * 128 + dv;
#pragma unroll
        for (int i = 0; i < 32; ++i) Sout[(size_t)i * 128] = S[i];
        if (wave < 4) {
            const int j = wave; const float a = Lo[j * 128 + 2 * lane], b = Lo[j * 128 + 2 * lane + 1];
            const float scl = rsqrtf(wave_sum(a * a + b * b, lane) * (1.f / 128.f) + EPS);
            const bf16* gp = Z + (size_t)(r0 + j) * LDZ + ZC_RG + h * 128 + 2 * lane;
            *(unsigned*)((bf16*)(ws + WS_MIX) + (size_t)(r0 + j) * 1536 + 1024 + h * 128 + 2 * lane) = pk2(a * scl * siluf_(bf2f(gp[0])), b * scl * siluf_(bf2f(gp[1])));
        }
    }
    __syncthreads();
}

DI void gdn_scan_chain(Frame& F, int layer, int bh) {
    const int tid = F.tid, lane = F.lane, wave = F.wave, quad = lane >> 4, rl = lane & 15;
    unsigned char* ws = KWS();
    const unsigned char* recb = ws + WS_GREC + (size_t)bh * 128 * GREC;
    LAS unsigned char* L = F.lds;
    constexpr int L_WP = 0, L_QP = 17408, L_KT = 34816, L_UT = 53248, L_QK = 71680;
    f32x4 S[8];
#pragma unroll
    for (int i = 0; i < 8; ++i) S[i] = (f32x4){0.f, 0.f, 0.f, 0.f};
    v4u pf[9]; float egl;
#pragma unroll
    for (int k = 0; k < 9; ++k) pf[k] = *(const v4u*)(recb + (size_t)(tid + 512 * k) * 16);
    egl = *(const float*)(recb + 73728);
    float* OG = (float*)(ws + WS_OGDN);
    const int b = bh >> 2, h = bh & 3;
    for (int c = 0; c < 128; ++c) {
        __syncthreads();
#pragma unroll
        for (int k = 0; k < 9; ++k) {
            const int o = tid * 16 + (k & 1) * 8192;
            const int reg = k >> 1;
            int dst;
            if (reg < 2) dst = (reg == 0 ? L_WP : L_QP) + (o >> 8) * 272 + (o & 255);
            else dst = (reg == 2 ? L_KT : reg == 3 ? L_UT : L_QK) + (o >> 7) * 144 + (o & 127);
            *(LAS v4u*)(L + dst) = pf[k];
        }
        const float eg = egl;
        __syncthreads();
        if (c + 1 < 128) {
            const unsigned char* rn = recb + (size_t)(c + 1) * GREC;
#pragma unroll
            for (int k = 0; k < 9; ++k) pf[k] = *(const v4u*)(rn + (size_t)(tid + 512 * k) * 16);
            egl = *(const float*)(rn + 73728);
        }
        bf16x8 Sb[4];
#pragma unroll
        for (int s = 0; s < 4; ++s) Sb[s] = pack_frag(S[2 * s], S[2 * s + 1]);
        f32x4 vn[4], O[4];
#pragma unroll
        for (int rt = 0; rt < 4; ++rt) {
            f32x4 wsacc = (f32x4){0.f, 0.f, 0.f, 0.f}, o = wsacc;
#pragma unroll
            for (int s = 0; s < 4; ++s) {
                wsacc = mfma16(ld_frag_l(L + L_WP + (16 * rt + rl) * 272 + (32 * s + 8 * quad) * 2), Sb[s], wsacc);
                o = mfma16(ld_frag_l(L + L_QP + (16 * rt + rl) * 272 + (32 * s + 8 * quad) * 2), Sb[s], o);
            }
            const v2u uw = *(const LAS v2u*)(L + L_UT + (16 * wave + rl) * 144 + (16 * rt + 4 * quad) * 2);
            vn[rt][0] = lo_bf(uw.x) - wsacc[0]; vn[rt][1] = hi_bf(uw.x) - wsacc[1]; vn[rt][2] = lo_bf(uw.y) - wsacc[2]; vn[rt][3] = hi_bf(uw.y) - wsacc[3];
            O[rt] = o;
        }
        bf16x8 Vb[2]; Vb[0] = pack_frag(vn[0], vn[1]); Vb[1] = pack_frag(vn[2], vn[3]);
#pragma unroll
        for (int rt = 0; rt < 4; ++rt) {
#pragma unroll
            for (int s2 = 0; s2 < 2; ++s2) O[rt] = mfma16(ld_frag_l(L + L_QK + (16 * rt + rl) * 144 + (32 * s2 + 8 * quad) * 2), Vb[s2], O[rt]);
            const size_t row = (size_t)b * TP + 64 * c + 16 * rt + 4 * quad;
#pragma unroll
            for (int i = 0; i < 4; ++i) OG[(row + i) * 512 + h * 128 + 16 * wave + rl] = O[rt][i];
        }
#pragma unroll
        for (int kt = 0; kt < 8; ++kt) {
            f32x4 a = S[kt] * eg;
#pragma unroll
            for (int s2 = 0; s2 < 2; ++s2) a = mfma16(ld_frag_l(L + L_KT + (16 * kt + rl) * 144 + (32 * s2 + 8 * quad) * 2), Vb[s2], a);
            S[kt] = a;
        }
    }
    float* So = KOUT() + O_GSP + (size_t)(layer * 8 + bh) * 16384;
#pragma unroll
    for (int kt = 0; kt < 8; ++kt)
#pragma unroll
        for (int i = 0; i < 4; ++i) So[(size_t)(16 * kt + 4 * quad + i) * 128 + 16 * wave + rl] = S[kt][i];
    __syncthreads();
}
DI void ret_scan_part(Frame& F, int layer, int r) {
    const int tid = F.tid, bh = r >> 2, dv = tid & 127, dk0 = ((r & 3) * 4 + (tid >> 7)) * 8, h = bh & 3;
    unsigned char* ws = KWS();
    const float* RKV = (const float*)(ws + WS_RKV) + (size_t)bh * 64 * 16384;
    bf16* RST = (bf16*)(ws + WS_RST) + (size_t)bh * 64 * 16384;
    const float cdec = __expf(128.f * ret_lg(h));
    float S[8];
#pragma unroll
    for (int i = 0; i < 8; ++i) S[i] = 0.f;
#pragma unroll 4
    for (int c = 0; c < 64; ++c) {
        v4u w; w.x = pk2(S[0], S[1]); w.y = pk2(S[2], S[3]); w.z = pk2(S[4], S[5]); w.w = pk2(S[6], S[7]);
        *(v4u*)(RST + (size_t)c * 16384 + dv * 128 + dk0) = w;
#pragma unroll
        for (int i = 0; i < 8; ++i) S[i] = S[i] * cdec + RKV[(size_t)c * 16384 + (dk0 + i) * 128 + dv];
    }
    float* So = KOUT() + O_RSP + (size_t)(layer * 8 + bh) * 16384;
#pragma unroll
    for (int i = 0; i < 8; ++i) So[(size_t)(dk0 + i) * 128 + dv] = S[i];
}
constexpr float SM_C = 0.125f * 1.4426950408889634f;
struct AttnState { float m, l; f32x4 O[4]; };
DI void attn_reset(AttnState& st) { st.m = -1e30f; st.l = 0.f;
#pragma unroll
    for (int i = 0; i < 4; ++i) st.O[i] = (f32x4){0.f, 0.f, 0.f, 0.f}; }
DI void qk_tile(const LAS unsigned char* Kt, const bf16x8 (&qf)[2], f32x4 (&s)[4], int rl, int quad) {
#pragma unroll
    for (int kt = 0; kt < 4; ++kt) { f32x4 a = (f32x4){0.f, 0.f, 0.f, 0.f};
#pragma unroll
        for (int kk = 0; kk < 2; ++kk) a = mfma16(ld_frag_l(Kt + (16 * kt + rl) * 144 + kk * 64 + quad * 16), qf[kk], a);
        s[kt] = a; }
}
template <class Mask> DI void attn_step(const LAS unsigned char* Kt, const LAS unsigned char* VT, const bf16x8 (&qf)[2], AttnState& st, const Mask& ok, int rl, int quad) {
    f32x4 s[4]; qk_tile(Kt, qf, s, rl, quad);
    float mx = -3e38f;
#pragma unroll
    for (int kt = 0; kt < 4; ++kt)
#pragma unroll
        for (int i = 0; i < 4; ++i) if (ok(16 * kt + 4 * quad + i)) mx = fmaxf(mx, s[kt][i]);
    const int lane = rl + 16 * quad;
    mx = fmaxf(mx, shx<16>(mx, lane)); mx = fmaxf(mx, shx<32>(mx, lane));
    const float mn = fmaxf(st.m, mx);
    const float alpha = exp2f((st.m - mn) * SM_C);
    float ls = 0.f;
#pragma unroll
    for (int kt = 0; kt < 4; ++kt)
#pragma unroll
        for (int i = 0; i < 4; ++i) { const float p = ok(16 * kt + 4 * quad + i) ? exp2f((s[kt][i] - mn) * SM_C) : 0.f; s[kt][i] = p; ls += p; }
    ls += shx<16>(ls, lane); ls += shx<32>(ls, lane);
    st.l = st.l * alpha + ls; st.m = mn;
#pragma unroll
    for (int dt = 0; dt < 4; ++dt) st.O[dt] *= alpha;
#pragma unroll
    for (int ii = 0; ii < 2; ++ii) {
        const bf16x8 pb = pack_frag(s[2 * ii], s[2 * ii + 1]);
#pragma unroll
        for (int dt = 0; dt < 4; ++dt) {
            const LAS unsigned char* vp = VT + (16 * dt + rl) * 144 + (32 * ii + 4 * quad) * 2;
            st.O[dt] = mfma16(mk_frag(*(const LAS v2u*)vp, *(const LAS v2u*)(vp + 32)), pb, st.O[dt]);
        }
    }
}
DI void attn_accum(f32x4 (&Of)[4], const AttnState& st, float gate) {
    const float sc = st.l > 0.f ? gate / st.l : 0.f;
#pragma unroll
    for (int dt = 0; dt < 4; ++dt) Of[dt] += st.O[dt] * sc;
}
DI void vt_write(LAS unsigned char* VT, int d0, int key, const v4u w) {
    LAS unsigned char* d = VT + d0 * 144 + key * 2;
    *(LAS bf16*)(d) = (bf16)(w.x & 0xffff); *(LAS bf16*)(d + 144) = (bf16)(w.x >> 16); *(LAS bf16*)(d + 2 * 144) = (bf16)(w.y & 0xffff); *(LAS bf16*)(d + 3 * 144) = (bf16)(w.y >> 16);
    *(LAS bf16*)(d + 4 * 144) = (bf16)(w.z & 0xffff); *(LAS bf16*)(d + 5 * 144) = (bf16)(w.z >> 16); *(LAS bf16*)(d + 6 * 144) = (bf16)(w.w & 0xffff); *(LAS bf16*)(d + 7 * 144) = (bf16)(w.w >> 16);
}
DI void stage_wg(LAS unsigned char* Kt, LAS unsigned char* VT, const bf16* kb, const bf16* vb, size_t stride, int tid, bool do_v) {
    const int key = tid >> 3, ch = tid & 7;
    *(LAS v4u*)(Kt + key * 144 + ch * 16) = *(const v4u*)(kb + key * stride + ch * 8);
    if (do_v) vt_write(VT, ch * 8, key, *(const v4u*)(vb + key * stride + ch * 8));
}
DI int top16(float v0, float v1, int lane) {
    int sel = 0;
#pragma unroll 1
    for (int r = 0; r < 16; ++r) {
        float bv; int bi;
        if (v0 >= v1) { bv = v0; bi = lane; } else { bv = v1; bi = lane + 64; }
#define T16_STEP(M) { const float ov = shx<M>(bv, lane); const int oi = shxi<M>(bi, lane); const bool take = (ov > bv) || (ov == bv && oi < bi); bv = take ? ov : bv; bi = take ? oi : bi; }
        T16_STEP(32) T16_STEP(16) T16_STEP(8) T16_STEP(4) T16_STEP(2) T16_STEP(1)
#undef T16_STEP
        const bool h0 = (bi == lane), h1 = (bi == lane + 64);
        v0 = h0 ? -3e38f : v0; v1 = h1 ? -3e38f : v1; sel |= (h0 ? 1 : 0) | (h1 ? 2 : 0);
    }
    return sel;
}

typedef short v4i16_t __attribute__((ext_vector_type(4)));
DI s16x4 vtr(const LAS unsigned char* p) { return __builtin_bit_cast(s16x4, __builtin_amdgcn_ds_read_tr16_b64_v4i16((LAS v4i16_t*)p)); }
DI bf16x8 cat4(s16x4 a, s16x4 b) { bf16x8 r; r[0] = a[0]; r[1] = a[1]; r[2] = a[2]; r[3] = a[3]; r[4] = b[0]; r[5] = b[1]; r[6] = b[2]; r[7] = b[3]; return r; }
DI void attn_step3(const LAS unsigned char* Kt, const LAS unsigned char* Vt, const bf16x8 (&qf)[2], AttnState& st, int lo, int hi, bool active, int rl, int quad) {
    active = active && (hi >= lo);
    if (!__any(active)) return;
    f32x4 s[4]; qk_tile(Kt, qf, s, rl, quad);
    const int lane = rl + 16 * quad;
    const bool full = __all((lo <= 0 && hi >= 63) || !active);
    const int kq = 4 * quad - lo; const unsigned rng = (unsigned)(hi - lo);
    float lm;
    if (full) {
        const float a0 = fmaxf(fmaxf(s[0][0], s[0][1]), fmaxf(s[0][2], s[0][3])), a1 = fmaxf(fmaxf(s[1][0], s[1][1]), fmaxf(s[1][2], s[1][3]));
        const float a2 = fmaxf(fmaxf(s[2][0], s[2][1]), fmaxf(s[2][2], s[2][3])), a3 = fmaxf(fmaxf(s[3][0], s[3][1]), fmaxf(s[3][2], s[3][3]));
        lm = fmaxf(fmaxf(a0, a1), fmaxf(a2, a3));
    } else {
        lm = -3e38f;
#pragma unroll
        for (int kt = 0; kt < 4; ++kt)
#pragma unroll
            for (int i = 0; i < 4; ++i) lm = ((unsigned)(kq + 16 * kt + i) <= rng) ? fmaxf(lm, s[kt][i]) : lm;
    }
    lm = active ? lm : -3e38f;
    if (__any(lm > st.m + 320.f)) {
        float mx = fmaxf(lm, shx<16>(lm, lane)); mx = fmaxf(mx, shx<32>(mx, lane));
        const float mn = fmaxf(st.m, mx);
        const float alpha = __builtin_amdgcn_exp2f((st.m - mn) * SM_C);
        st.l *= alpha; st.m = mn;
#pragma unroll
        for (int dt = 0; dt < 4; ++dt) st.O[dt] *= alpha;
    }
    const float mc = active ? st.m * SM_C : __builtin_inff();
    float ls = 0.f;
    if (full) {
#pragma unroll
        for (int kt = 0; kt < 4; ++kt)
#pragma unroll
            for (int i = 0; i < 4; ++i) { const float p = __builtin_amdgcn_exp2f(s[kt][i] * SM_C - mc); s[kt][i] = p; ls += p; }
    } else {
#pragma unroll
        for (int kt = 0; kt < 4; ++kt)
#pragma unroll
            for (int i = 0; i < 4; ++i) { const float p = ((unsigned)(kq + 16 * kt + i) <= rng) ? __builtin_amdgcn_exp2f(s[kt][i] * SM_C - mc) : 0.f; s[kt][i] = p; ls += p; }
    }
    st.l += ls;
#pragma unroll
    for (int ii = 0; ii < 2; ++ii) {
        const bf16x8 pb = pack_frag(s[2 * ii], s[2 * ii + 1]);
#pragma unroll
        for (int dt = 0; dt < 4; ++dt) {
            const LAS unsigned char* vp = Vt + (32 * ii + 4 * quad + (rl >> 2)) * 144 + (16 * dt + 4 * (rl & 3)) * 2;
            st.O[dt] = mfma16(cat4(vtr(vp), vtr(vp + 16 * 144)), pb, st.O[dt]);
        }
    }
}
DI float attn_rowsum(const AttnState& st, int lane) { float l = st.l; l += shx<16>(l, lane); l += shx<32>(l, lane); return l; }
DI void attn_accum3(f32x4 (&Of)[4], const AttnState& st, float gate, int lane) {
    const float l = attn_rowsum(st, lane);
    const float sc = l > 0.f ? gate / l : 0.f;
#pragma unroll
    for (int dt = 0; dt < 4; ++dt) Of[dt] += st.O[dt] * sc;
}
DI void nsa_prompt_unit(Frame& F, int layer, int unit) {
    int lane = F.lane, wave = F.wave; asm volatile("" : "+v"(lane), "+s"(wave));
    const int tid = wave * 64 + lane, quad = lane >> 4, rl = lane & 15;
    const int b = unit >> 9, g = (unit >> 8) & 1, tt = unit & 255, t0 = 32 * tt;
    unsigned char* ws = KWS();
    const bf16* Z = (const bf16*)(ws + WS_Z);
    const float* ZS = (const float*)(ws + WS_ZS);
    LAS unsigned char* TB = F.lds;
    LAS float* AIMP = (LAS float*)(F.lds + 36864);
    LAS unsigned* SEL = (LAS unsigned*)(F.lds + 102400);
    const int tk = 4 * wave + (rl >> 2), t = t0 + tk, head = 4 * g + (rl & 3);
    const size_t row = (size_t)b * TP + t;
    bf16x8 qf[2];
    qf[0] = ld_frag_g(Z + row * LDZ + ZC_Q + head * 64 + quad * 8); qf[1] = ld_frag_g(Z + row * LDZ + ZC_Q + head * 64 + 32 + quad * 8);
    const float gc = sigmoidf_(ZS[row * 32 + head * 3]), gs = sigmoidf_(ZS[row * 32 + head * 3 + 1]), gw = sigmoidf_(ZS[row * 32 + head * 3 + 2]);
    f32x4 Of[4];
#pragma unroll
    for (int i = 0; i < 4; ++i) Of[i] = (f32x4){0.f, 0.f, 0.f, 0.f};
    AttnState st;
    const int nct = (t0 >> 10) + 1;
    const bf16* KC = (const bf16*)(ws + WS_KC) + ((size_t)(0 * 2 + b) * 512 * 2 + g) * 64;
    const bf16* VC = (const bf16*)(ws + WS_KC) + ((size_t)(1 * 2 + b) * 512 * 2 + g) * 64;
    const bf16* Zb = Z + (size_t)b * TP * LDZ + g * 64;
    const int skey = tid >> 3, sch = tid & 7;
    const int wlo = (t0 - 511 > 0 ? t0 - 511 : 0) >> 6, nwin = ((t0 + 31) >> 6) - wlo + 1;
    v4u rk0, rv0, rk1, rv1, rk2, rv2;
    const int n1 = nwin + 2 * nct;
#define SEG1_ISSUE(i, rk, rv) do { const int i_ = (i); if (i_ < nwin) { const bf16* p_ = Zb + (size_t)(64 * (wlo + i_) + skey) * LDZ + sch * 8; rk = *(const v4u*)(p_ + ZC_KW); rv = *(const v4u*)(p_ + ZC_VW); } \
        else { const int jt_ = (i_ - nwin) % nct; const size_t o_ = (size_t)(64 * jt_ + skey) * 128 + sch * 8; rk = *(const v4u*)(KC + o_); rv = *(const v4u*)(VC + o_); } } while (0)
#define COMMIT(bufi, rk, rv) do { LAS unsigned char* d_ = TB + (bufi) * 18432 + skey * 144 + sch * 16; *(LAS v4u*)d_ = rk; *(LAS v4u*)(d_ + 9216) = rv; } while (0)
    attn_reset(st);
    float mfin = 0.f, il = 0.f;
#define SEG1_COMPUTE(i) do { \
        const LAS unsigned char* Kt = TB + ((i) & 1) * 18432; const LAS unsigned char* Vt = Kt + 9216; \
        if ((i) < nwin) { \
            const int kb = 64 * (wlo + (i)); \
            attn_step3(Kt, Vt, qf, st, t - 511 - kb, t - kb, true, rl, quad); \
            if ((i) == nwin - 1) { attn_accum3(Of, st, gw, lane); attn_reset(st); } \
        } else if ((i) < nwin + nct) { \
            const int nb = 64 * ((i) - nwin); \
            attn_step3(Kt, Vt, qf, st, 0, ((t - 31) >> 4) - nb, true, rl, quad); \
            if ((i) == nwin + nct - 1) { attn_accum3(Of, st, gc, lane); mfin = st.m * SM_C; const float lt_ = attn_rowsum(st, lane); il = lt_ > 0.f ? 1.f / lt_ : 0.f; } \
        } else { \
            const int jt = (i) - nwin - nct; \
            f32x4 s[4]; qk_tile(Kt, qf, s, rl, quad); \
            _Pragma("unroll") for (int kt = 0; kt < 4; ++kt) \
            _Pragma("unroll") for (int e = 0; e < 4; ++e) { \
                    const int n = 64 * jt + 16 * kt + 4 * quad + e; \
                    float p = (16 * n + 31 <= t) ? __builtin_amdgcn_exp2f(s[kt][e] * SM_C - mfin) * il : 0.f; \
                    p += shx<1>(p, lane); p += shx<2>(p, lane); \
                    if ((rl & 3) == 0) AIMP[tk * 512 + n] = p; \
                } \
        } } while (0)
#define SEG1_STEP(i, rkc, rvc, rkn, rvn) do { if ((i) < n1) { SEG1_COMPUTE(i); if ((i) + 1 < n1) COMMIT(((i) + 1) & 1, rkn, rvn); __syncthreads(); if ((i) + 3 < n1) SEG1_ISSUE((i) + 3, rkc, rvc); } } while (0)
    SEG1_ISSUE(0, rk0, rv0); if (n1 > 1) SEG1_ISSUE(1, rk1, rv1); if (n1 > 2) SEG1_ISSUE(2, rk2, rv2);
    COMMIT(0, rk0, rv0); __syncthreads();
    for (int i = 0; i < n1; i += 3) { SEG1_STEP(i, rk0, rv0, rk1, rv1); SEG1_STEP(i + 1, rk1, rv1, rk2, rv2); SEG1_STEP(i + 2, rk2, rv2, rk0, rv0); }
    {
        const int nav = nct * 64;
#pragma unroll 1
        for (int q = 0; q < 4; ++q) {
            const int tq = 4 * wave + q, tp = t0 + tq, cur = tp >> 6;
            float sc2[2];
#pragma unroll
            for (int e = 0; e < 2; ++e) {
                const int sblk = lane + 64 * e;
                float imp = 0.f;
#pragma unroll
                for (int d = -1; d <= 3; ++d) { const int n = 4 * sblk + d; if (n >= 0 && n < nav) imp += AIMP[tq * 512 + n]; }
                const bool valid = sblk <= cur, forced = (sblk == 0) || (sblk == cur) || (sblk == cur - 1);
                sc2[e] = valid ? imp + (forced ? 1000.f : 0.f) : -1e30f;
            }
            const int sel = top16(sc2[0], sc2[1], lane);
            const unsigned long long m0 = __ballot((sel & 1) && (lane <= cur)), m1 = __ballot((sel & 2) && (lane + 64 <= cur));
            if (lane == 0) { SEL[tq * 4 + 0] = (unsigned)m0; SEL[tq * 4 + 1] = (unsigned)(m0 >> 32); SEL[tq * 4 + 2] = (unsigned)m1; SEL[tq * 4 + 3] = (unsigned)(m1 >> 32); }
        }
    }
    __syncthreads();
    unsigned un[4], my[4], wv[4];
#pragma unroll
    for (int w = 0; w < 4; ++w) { unsigned v = (lane < 32) ? SEL[lane * 4 + w] : 0u;
        v |= (unsigned)shxi<1>((int)v, lane); v |= (unsigned)shxi<2>((int)v, lane); v |= (unsigned)shxi<4>((int)v, lane); v |= (unsigned)shxi<8>((int)v, lane); v |= (unsigned)shxi<16>((int)v, lane); v |= (unsigned)shxi<32>((int)v, lane);
        un[w] = __builtin_amdgcn_readfirstlane(v); my[w] = SEL[tk * 4 + w];
        wv[w] = SEL[(4 * wave) * 4 + w] | SEL[(4 * wave + 1) * 4 + w] | SEL[(4 * wave + 2) * 4 + w] | SEL[(4 * wave + 3) * 4 + w]; wv[w] = __builtin_amdgcn_readfirstlane(wv[w]); }
    attn_reset(st);
    {
        unsigned w0 = un[0], w1 = un[1], w2 = un[2], w3 = un[3];
#define NEXT_BLK(dst) do { if (w0) { dst = __builtin_ctz(w0); w0 &= w0 - 1u; } else if (w1) { dst = 32 + __builtin_ctz(w1); w1 &= w1 - 1u; } else if (w2) { dst = 64 + __builtin_ctz(w2); w2 &= w2 - 1u; } \
        else if (w3) { dst = 96 + __builtin_ctz(w3); w3 &= w3 - 1u; } else dst = -1; } while (0)
#define SEG2_ISSUE(blk_, rk, rv) do { const bf16* p_ = Zb + (size_t)(64 * (blk_) + skey) * LDZ + sch * 8; rk = *(const v4u*)(p_ + ZC_KS); rv = *(const v4u*)(p_ + ZC_VS); } while (0)
        int bq0, bq1, bq2, bq3;
        NEXT_BLK(bq0); NEXT_BLK(bq1); NEXT_BLK(bq2);
        SEG2_ISSUE(bq0, rk0, rv0); if (bq1 >= 0) SEG2_ISSUE(bq1, rk1, rv1); if (bq2 >= 0) SEG2_ISSUE(bq2, rk2, rv2);
        COMMIT(0, rk0, rv0); __syncthreads();
        int i = 0;
#define SEG2_STEP(rkc, rvc, rkn, rvn) do { if (bq0 >= 0) { \
            NEXT_BLK(bq3); \
            const LAS unsigned char* Kt = TB + (i & 1) * 18432; const LAS unsigned char* Vt = Kt + 9216; \
            const int wsel = bq0 >> 5, bit = bq0 & 31; \
            const unsigned wword = wsel == 0 ? wv[0] : wsel == 1 ? wv[1] : wsel == 2 ? wv[2] : wv[3]; \
            if ((wword >> bit) & 1u) { \
                const unsigned mword = wsel == 0 ? my[0] : wsel == 1 ? my[1] : wsel == 2 ? my[2] : my[3]; \
                const bool mine = (mword >> bit) & 1u; const int kb = 64 * bq0; \
                attn_step3(Kt, Vt, qf, st, 0, t - kb, mine, rl, quad); \
            } \
            if (bq1 >= 0) COMMIT((i + 1) & 1, rkn, rvn); \
            __syncthreads(); \
            if (bq3 >= 0) SEG2_ISSUE(bq3, rkc, rvc); \
            bq0 = bq1; bq1 = bq2; bq2 = bq3; ++i; } } while (0)
        while (bq0 >= 0) { SEG2_STEP(rk0, rv0, rk1, rv1); SEG2_STEP(rk1, rv1, rk2, rv2); SEG2_STEP(rk2, rv2, rk0, rv0); }
    }
    attn_accum3(Of, st, gs, lane);
#undef SEG1_ISSUE
#undef SEG1_COMPUTE
#undef SEG1_STEP
#undef SEG2_ISSUE
#undef SEG2_STEP
#undef COMMIT
#undef NEXT_BLK
    bf16* MIX = (bf16*)(ws + WS_MIX) + row * 1536 + head * 64;
#pragma unroll
    for (int dt = 0; dt < 4; ++dt) { v2u w; w.x = pk2(Of[dt][0], Of[dt][1]); w.y = pk2(Of[dt][2], Of[dt][3]); *(v2u*)(MIX + 16 * dt + 4 * quad) = w; }
    __syncthreads();
}

#define CB() asm volatile("" ::: "memory")
DI void stage_wave_f32(LAS unsigned char* Kt, LAS unsigned char* Vt, const float* kb, const float* vb, size_t stride, int lane) {
    const int k0 = lane >> 3, ch = lane & 7;
#pragma unroll
    for (int h = 0; h < 4; ++h) {
        const float* src = (h < 2 ? kb : vb); LAS unsigned char* dst = (h < 2 ? Kt : Vt); const int r0 = (h & 1) * 32;
        f32x4 a[4][2];
#pragma unroll
        for (int it = 0; it < 4; ++it) { const float* kp = src + (size_t)(r0 + it * 8 + k0) * stride + ch * 8; a[it][0] = *(const f32x4*)kp; a[it][1] = *(const f32x4*)(kp + 4); }
#pragma unroll
        for (int it = 0; it < 4; ++it) *(LAS v4u*)(dst + (r0 + it * 8 + k0) * 144 + ch * 16) = pack8(a[it][0], a[it][1]);
        asm volatile("" ::: "memory");
    }
}
DI void stage_wave_b16(LAS unsigned char* Kt, LAS unsigned char* Vt, const bf16* kb, const bf16* vb, size_t stride, int nvalid, int lane, bool do_v) {
    const int k0 = lane >> 3, ch = lane & 7;
    const v4u z = (v4u){0u, 0u, 0u, 0u};
#pragma unroll
    for (int it = 0; it < 8; ++it) {
        const int key = it * 8 + k0; const bool v = key < nvalid;
        *(LAS v4u*)(Kt + key * 144 + ch * 16) = v ? *(const v4u*)(kb + key * stride + ch * 8) : z;
        if (do_v) *(LAS v4u*)(Vt + key * 144 + ch * 16) = v ? *(const v4u*)(vb + key * stride + ch * 8) : z;
    }
}
DI void nsa_sample_unit(Frame& F, int layer, int s) {
    int lane = F.lane, wave = F.wave; asm volatile("" : "+v"(lane), "+s"(wave));
    const int quad = lane >> 4, rl = lane & 15;
    const int g = wave & 1, q4 = wave >> 1;
    unsigned char* ws = KWS();
    const bf16* Z = (const bf16*)(ws + WS_Z);
    const float* ZS = (const float*)(ws + WS_ZS);
    LAS unsigned char* Kt = F.lds + wave * 18432; LAS unsigned char* Vt = Kt + 9216;
    LAS float* AIMP = (LAS float*)Vt;
    const int j = rl >> 2, head = 4 * g + (rl & 3), qpos = 2048 + j;
    const size_t row = (size_t)MP + 4 * s + j;
    bf16x8 qf[2];
    qf[0] = ld_frag_g(Z + row * LDZ + ZC_Q + head * 64 + quad * 8); qf[1] = ld_frag_g(Z + row * LDZ + ZC_Q + head * 64 + 32 + quad * 8);
    const float gc = sigmoidf_(ZS[row * 32 + head * 3]), gs = sigmoidf_(ZS[row * 32 + head * 3 + 1]), gw = sigmoidf_(ZS[row * 32 + head * 3 + 2]);
    f32x4 Of[4];
#pragma unroll
    for (int i = 0; i < 4; ++i) Of[i] = (f32x4){0.f, 0.f, 0.f, 0.f};
    AttnState st;
    const bf16* KC = (const bf16*)(ws + WS_KCS) + ((size_t)(0 * 128 + s) * 128 * 2 + g) * 64;
    const bf16* VC = (const bf16*)(ws + WS_KCS) + ((size_t)(1 * 128 + s) * 128 * 2 + g) * 64;
    attn_reset(st);
#pragma unroll 1
    for (int jt = 0; jt < 2; ++jt) {
        stage_wave_b16(Kt, Vt, KC + (size_t)64 * jt * 128, VC + (size_t)64 * jt * 128, 128, 64, lane, true); CB();
        attn_step3(Kt, Vt, qf, st, 0, 126 - 64 * jt, true, rl, quad); CB();
    }
    attn_accum3(Of, st, q4 == 0 ? gc : 0.f, lane);
    {
        const float mfin = st.m * SM_C, lt = attn_rowsum(st, lane), il = lt > 0.f ? 1.f / lt : 0.f;
#pragma unroll 1
        for (int jt = 0; jt < 2; ++jt) {
            stage_wave_b16(Kt, Vt, KC + (size_t)64 * jt * 128, VC, 128, 64, lane, false); CB();
            f32x4 sv[4]; qk_tile(Kt, qf, sv, rl, quad); CB();
#pragma unroll
            for (int kt = 0; kt < 4; ++kt)
#pragma unroll
                for (int i = 0; i < 4; ++i) {
                    const int n = 64 * jt + 16 * kt + 4 * quad + i;
                    float p = (n <= 126) ? __builtin_amdgcn_exp2f(sv[kt][i] * SM_C - mfin) * il : 0.f;
                    p += shx<1>(p, lane); p += shx<2>(p, lane);
                    if ((rl & 3) == 0) AIMP[j * 128 + n] = p;
                }
        }
    }
    CB();
    unsigned long long msk[4];
#pragma unroll 1
    for (int q = 0; q < 4; ++q) {
        float imp = 0.f;
#pragma unroll
        for (int d = -1; d <= 3; ++d) { const int n = 4 * lane + d; if (n >= 0 && n <= 126 && lane < 33) imp += AIMP[q * 128 + n]; }
        const bool forced = (lane == 0) || (lane == 32) || (lane == 31);
        const float sc = (lane < 33) ? imp + (forced ? 1000.f : 0.f) : -3e38f;
        const int sel = top16(sc, -3e38f, lane);
        msk[q] = __ballot((sel & 1) && lane < 33);
    }
    CB();
    const unsigned long long un = msk[0] | msk[1] | msk[2] | msk[3];
    const unsigned long long mym = j == 0 ? msk[0] : j == 1 ? msk[1] : j == 2 ? msk[2] : msk[3];
    const int* pt = (const int*)KIN(7);
    AttnState sw;
    attn_reset(st); attn_reset(sw);
    {
        unsigned long long word = un; int idx = 0;
        while (word) {
            const int blk = __builtin_ctzll(word); word &= word - 1ull;
            if ((idx++ & 3) != q4) continue;
            if (blk < 32) {
                const int phys = pt[s * 16 + (blk >> 1)];
                const float* base = KIN(2) + ((size_t)(layer * 2560 + phys) * 128 + (blk & 1) * 64) * 512 + g * 64;
                stage_wave_f32(Kt, Vt, base + 256, base + 384, 512, lane); CB();
            } else {
                stage_wave_b16(Kt, Vt, Z + (size_t)(MP + 4 * s) * LDZ + ZC_KS + g * 64, Z + (size_t)(MP + 4 * s) * LDZ + ZC_VS + g * 64, LDZ, 4, lane, true); CB();
            }
            attn_step3(Kt, Vt, qf, st, 0, qpos - 64 * blk, (mym >> blk) & 1ull, rl, quad); CB();
        }
#pragma unroll 1
        for (int jt = 0; jt < 9; ++jt) {
            if ((idx++ & 3) != q4) continue;
            if (jt < 8) { const float* base = KIN(3) + ((size_t)(layer * 128 + s) * 512 + 64 * jt) * 256 + g * 64; stage_wave_f32(Kt, Vt, base, base + 128, 256, lane); CB(); }
            else { stage_wave_b16(Kt, Vt, Z + (size_t)(MP + 4 * s) * LDZ + ZC_KW + g * 64, Z + (size_t)(MP + 4 * s) * LDZ + ZC_VW + g * 64, LDZ, 4, lane, true); CB(); }
            attn_step3(Kt, Vt, qf, sw, j + 1 - 64 * jt, 512 + j - 64 * jt, true, rl, quad); CB();
        }
    }
    int lane2 = lane; asm volatile("" : "+v"(lane2));
    LAS float* X = (LAS float*)(F.lds + wave * 18432);
    {
        const float ls = attn_rowsum(st, lane), lw = attn_rowsum(sw, lane);
        X[0 * 64 + lane2] = st.m; X[1 * 64 + lane2] = ls; X[18 * 64 + lane2] = sw.m; X[19 * 64 + lane2] = lw;
#pragma unroll
        for (int dt = 0; dt < 4; ++dt)
#pragma unroll
            for (int e = 0; e < 4; ++e) { X[(2 + 4 * dt + e) * 64 + lane2] = st.O[dt][e]; X[(20 + 4 * dt + e) * 64 + lane2] = sw.O[dt][e]; }
    }
    __syncthreads();
    if (q4 == 0) {
#pragma unroll
        for (int br = 0; br < 2; ++br) {
            float m[4], l[4];
#pragma unroll
            for (int q = 0; q < 4; ++q) { const LAS float* Y = (const LAS float*)(F.lds + (2 * q + g) * 18432) + br * 18 * 64; m[q] = Y[lane2]; l[q] = Y[64 + lane2]; }
            const float mm = fmaxf(fmaxf(m[0], m[1]), fmaxf(m[2], m[3]));
            float w[4], lt = 0.f;
#pragma unroll
            for (int q = 0; q < 4; ++q) { w[q] = __builtin_amdgcn_exp2f((m[q] - mm) * SM_C); lt += l[q] * w[q]; }
            const float gate = br == 0 ? gs : gw;
            const float sc = lt > 0.f ? gate / lt : 0.f;
#pragma unroll
            for (int q = 0; q < 4; ++q) { const LAS float* Y = (const LAS float*)(F.lds + (2 * q + g) * 18432) + br * 18 * 64; const float wq = w[q] * sc;
#pragma unroll
                for (int dt = 0; dt < 4; ++dt)
#pragma unroll
                    for (int e = 0; e < 4; ++e) Of[dt][e] += Y[(2 + 4 * dt + e) * 64 + lane2] * wq; }
        }
        bf16* MIX = (bf16*)(ws + WS_MIX) + row * 1536 + head * 64;
#pragma unroll
        for (int dt = 0; dt < 4; ++dt) { v2u w2; w2.x = pk2(Of[dt][0], Of[dt][1]); w2.y = pk2(Of[dt][2], Of[dt][3]); *(v2u*)(MIX + 16 * dt + 4 * quad) = w2; }
    }
    __syncthreads();
}
DI void ret_out_unit(Frame& F, int layer, int unit) {
    const int tid = F.tid, lane = F.lane, wave = F.wave, quad = lane >> 4, rl = lane & 15;
    const int b = unit >> 8, h = (unit >> 6) & 3, c = unit & 63;
    const int row0 = b * TP + 128 * c;
    unsigned char* ws = KWS();
    const bf16* Z = (const bf16*)(ws + WS_Z);
    const bf16* QR = (const bf16*)(ws + WS_QR); const bf16* KR = (const bf16*)(ws + WS_KR);
    const bf16* RST = (const bf16*)(ws + WS_RST) + (size_t)unit * 16384;
    LAS unsigned char* LQ = F.lds; LAS unsigned char* LK = F.lds + 34816; LAS unsigned char* LV = F.lds + 69632; LAS unsigned char* LS = F.lds + 104448;
    for (int it = tid; it < 2048; it += NTHREADS) {
        const int j = it >> 4, cc = it & 15;
        *(LAS v4u*)(LQ + j * 272 + cc * 16) = *(const v4u*)(QR + (size_t)(row0 + j) * 512 + h * 128 + cc * 8);
        *(LAS v4u*)(LK + j * 272 + cc * 16) = *(const v4u*)(KR + (size_t)(row0 + j) * 512 + h * 128 + cc * 8);
        *(LAS v4u*)(LS + j * 272 + cc * 16) = *(const v4u*)(RST + (size_t)j * 128 + cc * 8);
        const v4u w = *(const v4u*)(Z + (size_t)(row0 + j) * LDZ + ZC_RQKV + 1024 + h * 128 + cc * 8);
        LAS unsigned char* d = LV + (cc * 8) * 272 + j * 2;
        *(LAS bf16*)(d) = (bf16)(w.x & 0xffff); *(LAS bf16*)(d + 272) = (bf16)(w.x >> 16); *(LAS bf16*)(d + 2 * 272) = (bf16)(w.y & 0xffff); *(LAS bf16*)(d + 3 * 272) = (bf16)(w.y >> 16);
        *(LAS bf16*)(d + 4 * 272) = (bf16)(w.z & 0xffff); *(LAS bf16*)(d + 5 * 272) = (bf16)(w.z >> 16); *(LAS bf16*)(d + 6 * 272) = (bf16)(w.w & 0xffff); *(LAS bf16*)(d + 7 * 272) = (bf16)(w.w >> 16);
    }
    __syncthreads();
    const float lg = ret_lg(h);
    const int il = 16 * wave + rl;
    bf16x8 qb[4];
#pragma unroll
    for (int s = 0; s < 4; ++s) qb[s] = ld_frag_l(LQ + il * 272 + (32 * s + 8 * quad) * 2);
    f32x4 C[8];
    const float qdec = __expf((float)(il + 1) * lg);
#pragma unroll
    for (int dt = 0; dt < 8; ++dt) {
        f32x4 a = (f32x4){0.f, 0.f, 0.f, 0.f};
#pragma unroll
        for (int s = 0; s < 4; ++s) a = mfma16(ld_frag_l(LS + (16 * dt + rl) * 272 + (32 * s + 8 * quad) * 2), qb[s], a);
        C[dt] = a * qdec;
    }
    for (int s2 = 0; s2 <= (wave >> 1); ++s2) {
        f32x4 P[2];
#pragma unroll
        for (int e = 0; e < 2; ++e) {
            const int jt = 2 * s2 + e;
            f32x4 a = (f32x4){0.f, 0.f, 0.f, 0.f};
            if (jt <= wave) {
#pragma unroll
                for (int s = 0; s < 4; ++s) a = mfma16(ld_frag_l(LK + (16 * jt + rl) * 272 + (32 * s + 8 * quad) * 2), qb[s], a);
#pragma unroll
                for (int i = 0; i < 4; ++i) { const int jj = 16 * jt + 4 * quad + i; a[i] = (il >= jj) ? a[i] * __expf((float)(il - jj) * lg) : 0.f; }
            }
            P[e] = a;
        }
        const bf16x8 pb = pack_frag(P[0], P[1]);
#pragma unroll
        for (int dt = 0; dt < 8; ++dt) {
            const LAS unsigned char* vp = LV + (16 * dt + rl) * 272 + (32 * s2 + 4 * quad) * 2;
            C[dt] = mfma16(mk_frag(*(const LAS v2u*)vp, *(const LAS v2u*)(vp + 32)), pb, C[dt]);
        }
    }
    float ss = 0.f;
#pragma unroll
    for (int dt = 0; dt < 8; ++dt) ss += (C[dt][0] * C[dt][0] + C[dt][1] * C[dt][1]) + (C[dt][2] * C[dt][2] + C[dt][3] * C[dt][3]);
    ss += shx<16>(ss, lane); ss += shx<32>(ss, lane);
    const float scl = rsqrtf(ss * (1.f / 128.f) + EPS);
    const size_t row = (size_t)row0 + il;
#pragma unroll
    for (int dt = 0; dt < 8; ++dt) {
        const v2u gwd = *(const v2u*)(Z + row * LDZ + ZC_RG + h * 128 + 16 * dt + 4 * quad);
        v2u w; w.x = pk2(C[dt][0] * scl * siluf_(lo_bf(gwd.x)), C[dt][1] * scl * siluf_(hi_bf(gwd.x))); w.y = pk2(C[dt][2] * scl * siluf_(lo_bf(gwd.y)), C[dt][3] * scl * siluf_(hi_bf(gwd.y)));
        *(v2u*)((bf16*)(ws + WS_MIX) + row * 1536 + 1024 + h * 128 + 16 * dt + 4 * quad) = w;
    }
    __syncthreads();
}
DI void gdn_out_row(Frame& F, int layer, int row) {
    const int lane = F.lane;
    unsigned char* ws = KWS();
    const float* o = (const float*)(ws + WS_OGDN) + (size_t)row * 512 + lane * 8;
    const f32x4 a = *(const f32x4*)o, b = *(const f32x4*)(o + 4);
    float ss = (a[0] * a[0] + a[1] * a[1]) + (a[2] * a[2] + a[3] * a[3]) + (b[0] * b[0] + b[1] * b[1]) + (b[2] * b[2] + b[3] * b[3]);
    ss += shx<1>(ss, lane); ss += shx<2>(ss, lane); ss += shx<4>(ss, lane); ss += shx<8>(ss, lane);
    const float scl = rsqrtf(ss * (1.f / 128.f) + EPS);
    const float* ng = KIN(18) + layer * 128 + (lane & 15) * 8;
    const f32x4 ga = *(const f32x4*)ng, gb = *(const f32x4*)(ng + 4);
    f32x4 za, zb; unpack8(*(const v4u*)((const bf16*)(ws + WS_Z) + (size_t)row * LDZ + ZC_GZ + lane * 8), za, zb);
    f32x4 ra, rb;
#pragma unroll
    for (int e = 0; e < 4; ++e) { ra[e] = a[e] * scl * ga[e] * siluf_(za[e]); rb[e] = b[e] * scl * gb[e] * siluf_(zb[e]); }
    *(v4u*)((bf16*)(ws + WS_MIX) + (size_t)row * 1536 + 512 + lane * 8) = pack8(ra, rb);
}
DI void final_row(Frame& F, int row) {
    const int lane = F.lane;
    const float* x = (const float*)(KWS() + WS_XR) + (size_t)row * DM;
    float* y = (row < MP) ? KOUT() + O_YP + (size_t)row * DM : KOUT() + O_YS + (size_t)(row - MP) * DM;
    f32x4 v[4]; float ss = 0.f;
#pragma unroll
    for (int j = 0; j < 4; ++j) { v[j] = *(const f32x4*)(x + 256 * j + lane * 4); ss += (v[j][0] * v[j][0] + v[j][1] * v[j][1]) + (v[j][2] * v[j][2] + v[j][3] * v[j][3]); }
    const float scl = rsqrtf(wave_sum(ss, lane) * (1.f / DM) + EPS);
#pragma unroll
    for (int j = 0; j < 4; ++j) *(f32x4*)(y + 256 * j + lane * 4) = v[j] * scl * *(const f32x4*)(KIN(26) + 256 * j + lane * 4);
}
#ifndef PH_P0
#define PH_P0 1
#endif
#ifndef PH_A
#define PH_A 1
#endif
#ifndef PH_B0a
#define PH_B0a 1
#endif
#ifndef PH_B0b
#define PH_B0b 1
#endif
#ifndef PH_B0c
#define PH_B0c 1
#endif
#ifndef PH_B0d
#define PH_B0d 1
#endif
#ifndef PH_SCAN
#define PH_SCAN 1
#endif
#ifndef PH_RSCAN
#define PH_RSCAN 1
#endif
#ifndef PH_NSAP
#define PH_NSAP 1
#endif
#ifndef PH_NSAS
#define PH_NSAS 1
#endif
#ifndef PH_B2
#define PH_B2 1
#endif
#ifndef PH_C
#define PH_C 1
#endif
#ifndef PH_D
#define PH_D 1
#endif
#ifndef PH_E
#define PH_E 1
#endif
#ifndef PH_F
#define PH_F 1
#endif
#ifndef PH_G1
#define PH_G1 1
#endif
#ifndef PH_G2
#define PH_G2 1
#endif
struct Args { const void* in[27]; float* out; unsigned char* ws; };
__global__ void __launch_bounds__(NTHREADS, 2) mk_fwd(Args args) {
    extern __shared__ __attribute__((aligned(16))) unsigned char lds_raw[];
    Frame F;
    F.lds = (LAS unsigned char*)lds_raw;
    F.wave = __builtin_amdgcn_readfirstlane((int)threadIdx.x >> 6); F.lane = 0; F.tid = 0;
    F.G = gridDim.x; F.bid = blockIdx.x;
    F.ctl = (gu32*)(KWS() + WS_CTL);
    { const Frame Fp = fresh(F); for (int u = Fp.tid; u < (LDS_BYTES - LDSCTL_OFF) / 4; u += NTHREADS) ((LAS unsigned*)(F.lds + LDSCTL_OFF))[u] = 0u;
      __syncthreads();
      (void)xcd_barrier_post((unsigned*)(F.ctl + CW_BAR), (volatile LAS unsigned*)(F.lds + MISC_OFF) + 8, Fp.tid == 0); }
    const int G = F.G, bid = F.bid;

        for (int rp_ = 0; rp_ < PH_P0; ++rp_) {
    { Frame Fp = fresh(F); p0_prologue(Fp); }
        }
    GRID_BAR();

    for (int layer = 0; layer < NLAYER; ++layer) {
        for (int rp_ = 0; rp_ < PH_A; ++rp_) {
        {
            const Frame Fg = fresh(F); const int G = Fg.G, bid = Fg.bid;
            unsigned char* ws = KWS();
            pg8::Gemm g{(const bf16*)(ws + WS_XGA), (const bf16*)(ws + WS_WIN + layer * SZ_WIN), MROWS, LDZ, DM, DM, DM, 31, 0};
            pg8::StaticOrder S; S.init(MROWS, LDZ, G, bid);
            epi::EpiA E{(bf16*)(ws + WS_Z), (float*)(ws + WS_ZS), (const float*)(ws + WS_SSA), KOUT(), layer};
            pg8::gemm_phase<epi::EpiA, pg8::StaticOrder, true, true>(Fg.lds, g, S, E, Fg.tid);
        }
        }
        GRID_BAR();
        for (int rp_ = 0; rp_ < PH_B0a; ++rp_) {
        { Frame Fp = fresh(F); for (int u = Fp.bid; u < 1024; u += Fp.G) gdn_prep_unit(Fp, layer, u); }
        }
        for (int rp_ = 0; rp_ < PH_B0b; ++rp_) {
        { Frame Fp = fresh(F); for (int u = Fp.bid; u < 512; u += Fp.G) ret_prep_unit(Fp, layer, u); }
        }
        for (int rp_ = 0; rp_ < PH_B0c; ++rp_) {
        { Frame Fp = fresh(F); for (int u = Fp.bid; u < 1024; u += Fp.G) sample_rec_unit(Fp, layer, u); }
        }
        for (int rp_ = 0; rp_ < PH_B0d; ++rp_) {
        { Frame Fp = fresh(F); for (int t = Fp.bid; t < 256 + 16; t += Fp.G) compress_job(Fp, layer, t); }
        }
        GRID_BAR();
        {
            const Frame Fq = fresh(F); const int G = Fq.G, bid = Fq.bid;
            const bool split = G >= 64;
        for (int rp_ = 0; rp_ < PH_SCAN; ++rp_) {
            if (bid < 8) { Frame Fp = fresh(F); gdn_scan_chain(Fp, layer, Fp.bid); }
        }
        for (int rp_ = 0; rp_ < PH_RSCAN; ++rp_) {
            if (bid >= 8 && bid < 40) { Frame Fp = fresh(F); ret_scan_part(Fp, layer, Fp.bid - 8); }
        }
            const int vb = split ? bid - 40 : bid, NV = split ? G - 40 : G;
            if (vb >= 0) {
        for (int rp_ = 0; rp_ < PH_NSAP; ++rp_) {
                { Frame Fp = fresh(F); for (int u = vb; u < 1024; u += NV) nsa_prompt_unit(Fp, layer, u); }
        }
                __syncthreads();
        for (int rp_ = 0; rp_ < PH_NSAS; ++rp_) {
                { Frame Fp = fresh(F); for (int u = vb; u < 128; u += NV) nsa_sample_unit(Fp, layer, u); }
        }
            }
        }
        GRID_BAR();
        for (int rp_ = 0; rp_ < PH_B2; ++rp_) {
        { Frame Fp = fresh(F); for (int u = Fp.bid; u < 512; u += Fp.G) ret_out_unit(Fp, layer, u); }
        { Frame Fp = fresh(F); for (int r = Fp.bid * NWAVES + Fp.wave; r < MROWS; r += Fp.G * NWAVES) gdn_out_row(Fp, layer, r); }
        }
        GRID_BAR();
        for (int rp_ = 0; rp_ < PH_C; ++rp_) {
        {
            const Frame Fg = fresh(F); const int G = Fg.G, bid = Fg.bid;
            unsigned char* ws = KWS();
            pg8::Gemm g{(const bf16*)(ws + WS_MIX), (const bf16*)(ws + WS_WBR + layer * SZ_WBR), MROWS, 3072, 512, 1536, 512, 2, 1024};
            pg8::StaticOrder S; S.init(MROWS, 3072, G, bid);
            epi::EpiC E{(const bf16*)(ws + WS_Z), (bf16*)(ws + WS_GATED)};
            pg8::gemm_phase<epi::EpiC, pg8::StaticOrder, true, true>(Fg.lds, g, S, E, Fg.tid);
        }
        }
        GRID_BAR();
#if PH_D
        {
            const Frame Fg = fresh(F); const int G = Fg.G, bid = Fg.bid;
            unsigned char* ws = KWS();
            pg8::Gemm g{(const bf16*)(ws + WS_GATED), (const bf16*)(ws + WS_WO3 + layer * SZ_WO3), MROWS, DM, 3072, 3072, 3072, 31, 0};
            pg8::StaticOrder S; S.init(MROWS, DM, G, bid);
            epi::EpiRes E{(float*)(ws + WS_XR), (bf16*)(ws + WS_XGB), KIN(21) + layer * DM, (float*)(ws + WS_SSB), nullptr, 0};
            pg8::gemm_phase<epi::EpiRes, pg8::StaticOrder, true, true>(Fg.lds, g, S, E, Fg.tid);
        }
#endif
        GRID_BAR();
        for (int rp_ = 0; rp_ < PH_E; ++rp_) {
        {
            const Frame Fg = fresh(F); const int G = Fg.G, bid = Fg.bid;
            unsigned char* ws = KWS();
            pg8::Gemm g{(const bf16*)(ws + WS_XGB), (const bf16*)(ws + WS_WUP + layer * SZ_WUP), MROWS, DFF, DM, DM, DM, 31, 0};
            pg8::StaticOrder S; S.init(MROWS, DFF, G, bid);
            epi::EpiUp E{(bf16*)(ws + WS_HMID), (const float*)(ws + WS_SSB)};
            pg8::gemm_phase<epi::EpiUp, pg8::StaticOrder, true, true>(Fg.lds, g, S, E, Fg.tid);
        }
        }
        GRID_BAR();
#if PH_F
        {
            const Frame Fg = fresh(F); const int G = Fg.G, bid = Fg.bid;
            unsigned char* ws = KWS();
            pg8::Gemm g{(const bf16*)(ws + WS_HMID), (const bf16*)(ws + WS_WDN + layer * SZ_WDN), MROWS, DM, DFF, DFF, DFF, 31, 0};
            pg8::StaticOrder S; S.init(MROWS, DM, G, bid);
            epi::EpiRes E{(float*)(ws + WS_XR), (bf16*)(ws + WS_XGC), nullptr, nullptr, nullptr, 0};
            pg8::gemm_phase<epi::EpiRes, pg8::StaticOrder, true, true>(Fg.lds, g, S, E, Fg.tid);
        }
#endif
        GRID_BAR();
        for (int rp_ = 0; rp_ < PH_G1; ++rp_) {
        {
            const Frame Fg = fresh(F); const int G = Fg.G, bid = Fg.bid;
            unsigned char* ws = KWS();
            int kple = PLE; asm volatile("" : "+s"(kple));
            pg8::Gemm g{(const bf16*)(ws + WS_P16) + (size_t)layer * MROWS * PLE, (const bf16*)(ws + WS_WPL + layer * SZ_WPL), MROWS, DM, kple, PLE, PLE, 31, 0};
            pg8::StaticOrder S; S.init(MROWS, DM, G, bid);
            epi::EpiRes E{nullptr, nullptr, nullptr, nullptr, (float*)(ws + WS_TPLE), 1};
            pg8::gemm_phase<epi::EpiRes, pg8::StaticOrder, true, true>(Fg.lds, g, S, E, Fg.tid);
        }
        }
#if PH_G2
        {
            const Frame Fg = fresh(F); const int G = Fg.G, bid = Fg.bid;
            unsigned char* ws = KWS();
            const bool more = layer + 1 < NLAYER;
            pg8::Gemm g{(const bf16*)(ws + WS_XGC), (const bf16*)(ws + WS_WPG + layer * SZ_WPG), MROWS, DM, DM, DM, DM, 31, 0};
            pg8::StaticOrder S; S.init(MROWS, DM, G, bid);
            epi::EpiRes E{(float*)(ws + WS_XR), more ? (bf16*)(ws + WS_XGA) : nullptr, more ? KIN(10) + (layer + 1) * DM : nullptr, more ? (float*)(ws + WS_SSA) : nullptr, (float*)(ws + WS_TPLE), 2};
            pg8::gemm_phase<epi::EpiRes, pg8::StaticOrder, true, true>(Fg.lds, g, S, E, Fg.tid);
        }
#endif
        GRID_BAR();
    }
    { Frame Fp = fresh(F); for (int r = Fp.bid * NWAVES + Fp.wave; r < MROWS; r += Fp.G * NWAVES) final_row(Fp, r); }
}

extern "C" void kernel_launch(void* const* d_in, const int* in_sizes, int n_in, void* d_out, int out_size, void* d_ws, size_t ws_size, hipStream_t stream) {
    static int grid = 0;
    if (grid == 0) {
        if (n_in != 27 || ws_size < WS_END) { fprintf(stderr, "kernel_launch: unexpected shapes (n_in %d out %d ws %zu, need %zu)\n", n_in, out_size, ws_size, (size_t)WS_END); grid = -1; return; }
        int dev = 0, cus = 0;
        if (hipGetDevice(&dev) != hipSuccess || hipDeviceGetAttribute(&cus, hipDeviceAttributeMultiprocessorCount, dev) != hipSuccess) { grid = -1; return; }
        if (hipFuncSetAttribute((const void*)mk_fwd, hipFuncAttributeMaxDynamicSharedMemorySize, LDS_BYTES) != hipSuccess) { fprintf(stderr, "kernel_launch: hipFuncSetAttribute failed\n"); grid = -1; return; }
        int per_cu = 0;
        if (hipOccupancyMaxActiveBlocksPerMultiprocessor(&per_cu, (const void*)mk_fwd, NTHREADS, LDS_BYTES) != hipSuccess || per_cu < 1) fprintf(stderr, "kernel_launch: occupancy query reports %d\n", per_cu);
        (void)hipGetLastError();
        grid = cus;
    }
    if (grid < 0) return;
    if (hipMemsetAsync((char*)d_ws + WS_CTL, 0, CTL_ZERO_BYTES, stream) != hipSuccess) return;
    Args a{};
    for (int i = 0; i < 27; ++i) a.in[i] = d_in[i];
    a.out = (float*)d_out; a.ws = (unsigned char*)d_ws;
    hipLaunchKernelGGL(mk_fwd, dim3(grid), dim3(NTHREADS), LDS_BYTES, stream, a);
}
```

```cpp
#include <hip/hip_runtime.h>
#include <cstdio>
#include <cstdint>
namespace pg8 {
#define PG8_LAS __attribute__((address_space(3)))
typedef unsigned short bf16_t;
typedef short bf16x8 __attribute__((ext_vector_type(8)));
typedef float f32x4 __attribute__((ext_vector_type(4)));
typedef unsigned u32x4 __attribute__((ext_vector_type(4)));
constexpr int BM = 256, BK = 64, HALF = 128, HTB = HALF * BK * 2  , STAGE_BYTES = 8 * HTB, NXCD = 8, WGM = 8;

__host__ __device__ __forceinline__ int lds_byte(int r, int c) { const int st = (r >> 4) * 2 + (c >> 5), rr = r & 15, cc = c & 31, ob = rr * 64 + cc * 2; return st * 1024 + (ob ^ (((ob >> 9) & 1) << 5)); }
__host__ __device__ __forceinline__ void stage_rc(int b, int& R, int& C) { const int st = b / 1024, sb = b % 1024, swz = sb ^ (((sb >> 9) & 1) << 5); R = (st >> 1) * 16 + swz / 64; C = (st & 1) * 32 + (swz % 64) / 2; }
__host__ __device__ __forceinline__ int perm32(int rho) { const int n = rho >> 4, i = rho & 15; return 8 * (i >> 2) + 4 * n + (i & 3); }

struct Unit { int pm, pn; };
struct Gemm { const bf16_t* A; const bf16_t* Bt; int M, N, K; int lda, ldb; int a_shift, a_off; };

struct StaticOrder {
    int nM, nN, nwg, G, c;
    __host__ __device__ void init(int M, int N, int G_, int c_) { nM = M / BM; nN = N / BM; nwg = nM * nN; G = G_; c = c_; }
    __host__ __device__ bool next(int i, Unit& u) const {
        const long L = (long)i * G + c; if (L >= nwg) return false;
        int wgid = (int)L; { const int q = nwg / NXCD, r = nwg % NXCD, xcd = wgid % NXCD, off = wgid / NXCD; wgid = (xcd < r ? xcd * (q + 1) : r * (q + 1) + (xcd - r) * q) + off; }
        const int nig = WGM * nN, gid = wgid / nig, fm = gid * WGM, gsz = (nM - fm) < WGM ? (nM - fm) : WGM;
        u.pm = fm + ((wgid % nig) % gsz); u.pn = (wgid % nig) / gsz; return true;
    }
    __device__ __forceinline__ void a_ready(const Unit&) const {}
    __device__ __forceinline__ void done(const Unit&) const {}
};

__device__ __forceinline__ unsigned cvt_pk_bf16(float lo, float hi) { unsigned r; asm volatile("v_cvt_pk_bf16_f32 %0, %1, %2" : "=v"(r) : "v"(lo), "v"(hi)); return r; }
typedef float f32x2 __attribute__((ext_vector_type(2)));
template <class Epi, class Sched, bool ALIGN_EPI = false, bool SP2 = false>
__device__ __forceinline__ void gemm_phase(PG8_LAS unsigned char* lds, const Gemm g, const Sched& S, const Epi& E, const int tid) {
    const int wid = __builtin_amdgcn_readfirstlane(tid >> 6), lane = tid & 63, wr = wid >> 2, wc = wid & 3, fr = lane & 15, fq = lane >> 4;
    const int K = g.K, nt = K / BK;
    unsigned voffA[2], voffB[2];
#pragma unroll
    for (int i = 0; i < 2; ++i) { int R, C; stage_rc(tid * 16 + i * 8192, R, C); const int Rb = Epi::PERM ? ((R & ~31) + perm32(R & 31)) : R;
        voffA[i] = (unsigned)(R * g.lda + C) * 2u; voffB[i] = (unsigned)(Rb * g.ldb + C) * 2u; }
    const size_t kstep = (size_t)(BK * 2);
    const size_t hstepA = (size_t)HALF * g.lda * 2, hstepB = (size_t)HALF * g.ldb * 2;
    const size_t tstepA = 2 * hstepA, tstepB = 2 * hstepB;
    const unsigned ldsw = (unsigned)wid * 1024u;
    const int aoff = lds_byte(wr * 64 + fr, fq * 8), boff = lds_byte(wc * 32 + fr, fq * 8);
#define PG8_SA(b, h) (((b) * 2 + (h)) * HTB)
#define PG8_SB(b, h) ((4 + (b) * 2 + (h)) * HTB)
#define PG8_STAGE(bufoff, gbase, voff) do { _Pragma("unroll") for (int _i = 0; _i < 2; ++_i) \
        __builtin_amdgcn_global_load_lds((const unsigned*)((const char*)(gbase) + (voff)[_i]), (PG8_LAS unsigned*)(lds + (bufoff) + ldsw + _i * 8192), 16, 0, 0); } while (0)
#define PG8_LDA(dst, b, h) do { _Pragma("unroll") for (int m = 0; m < 4; ++m) _Pragma("unroll") for (int k = 0; k < 2; ++k) dst[m][k] = *(const PG8_LAS bf16x8*)(lds + PG8_SA(b, h) + aoff + m * 2048 + k * 1024); } while (0)
#define PG8_LDB(dst, b, h) do { _Pragma("unroll") for (int n = 0; n < 2; ++n) _Pragma("unroll") for (int k = 0; k < 2; ++k) dst[n][k] = *(const PG8_LAS bf16x8*)(lds + PG8_SB(b, h) + boff + n * 2048 + k * 1024); } while (0)
#define PG8_MMA(ai, bj, At, Bt) do { __builtin_amdgcn_s_setprio(1); _Pragma("unroll") for (int m = 0; m < 4; ++m) _Pragma("unroll") for (int n = 0; n < 2; ++n) _Pragma("unroll") for (int k = 0; k < 2; ++k) \
        acc[ai][bj][m][n] = __builtin_amdgcn_mfma_f32_16x16x32_bf16(Bt[n][k], At[m][k], acc[ai][bj][m][n], 0, 0, 0); __builtin_amdgcn_s_setprio(0); } while (0)
#define PG8_WAIT_V(n) asm volatile("s_waitcnt vmcnt(" #n ")" ::: "memory")
#define PG8_WAIT_L(n) asm volatile("s_waitcnt lgkmcnt(" #n ")" ::: "memory")
#define PG8_BAR __builtin_amdgcn_s_barrier()
#define PG8_SCHED __builtin_amdgcn_sched_barrier(0)
    Unit cur, nxt; int ui = 0;
    if (!S.next(0, cur)) return;
    f32x4 acc[2][2][4][2];
#pragma unroll
    for (int a = 0; a < 2; ++a)
#pragma unroll
        for (int b = 0; b < 2; ++b)
#pragma unroll
            for (int m = 0; m < 4; ++m)
#pragma unroll
                for (int n = 0; n < 2; ++n) acc[a][b][m][n] = (f32x4){0.f, 0.f, 0.f, 0.f};
    bf16x8 At[4][2], B0[2][2], B1[2][2];
    const char* cA = (const char*)g.A + (size_t)cur.pm * tstepA + (size_t)(cur.pn >> g.a_shift) * (size_t)g.a_off; const char* cB = (const char*)g.Bt + (size_t)cur.pn * tstepB;
    S.a_ready(cur);
    if constexpr (SP2) {
        PG8_STAGE(PG8_SB(0, 0), cB, voffB); PG8_STAGE(PG8_SB(0, 1), cB + hstepB, voffB); PG8_STAGE(PG8_SA(0, 0), cA, voffA); PG8_STAGE(PG8_SA(0, 1), cA + hstepA, voffA);
        if (wr == 1) PG8_BAR;
        PG8_WAIT_V(2); PG8_BAR;
        PG8_STAGE(PG8_SB(1, 0), cB + kstep, voffB); PG8_STAGE(PG8_SA(1, 0), cA + kstep, voffA); PG8_STAGE(PG8_SB(1, 1), cB + hstepB + kstep, voffB);
        PG8_WAIT_V(6); PG8_BAR;
    } else {
        PG8_STAGE(PG8_SB(0, 0), cB, voffB); PG8_STAGE(PG8_SA(0, 0), cA, voffA); PG8_STAGE(PG8_SB(0, 1), cB + hstepB, voffB); PG8_STAGE(PG8_SA(0, 1), cA + hstepA, voffA);
        if (wr == 1) PG8_BAR;
        PG8_WAIT_V(4); PG8_BAR;
        PG8_STAGE(PG8_SB(1, 0), cB + kstep, voffB); PG8_STAGE(PG8_SA(1, 0), cA + kstep, voffA); PG8_STAGE(PG8_SB(1, 1), cB + hstepB + kstep, voffB);
        PG8_WAIT_V(6); PG8_BAR;
    }
    for (;;) {
        const bool has_next = S.next(ui + 1, nxt);
        const char* nA = has_next ? (const char*)g.A + (size_t)nxt.pm * tstepA + (size_t)(nxt.pn >> g.a_shift) * (size_t)g.a_off : cA; const char* nB = has_next ? (const char*)g.Bt + (size_t)nxt.pn * tstepB : cB;
        for (int t = 0; t < nt; t += 2) {
            const bool last = (t == nt - 2);
            const char* a1 = cA + (size_t)(t + 1) * kstep;
            const char* a2 = last ? nA : cA + (size_t)(t + 2) * kstep; const char* b2 = last ? nB : cB + (size_t)(t + 2) * kstep;
            const char* a3 = a2 + kstep; const char* b3 = b2 + kstep;
            if (last && has_next) S.a_ready(nxt);
            if constexpr (SP2) {
            PG8_LDB(B0, 0, 0); PG8_LDB(B1, 0, 1); PG8_SCHED; PG8_LDA(At, 0, 0); PG8_STAGE(PG8_SA(1, 1), a1 + hstepA, voffA);
            PG8_WAIT_V(8); PG8_WAIT_L(0); PG8_BAR; PG8_MMA(0, 0, At, B0); PG8_MMA(0, 1, At, B1); PG8_BAR; PG8_SCHED;
            PG8_LDA(At, 0, 1); PG8_STAGE(PG8_SB(0, 0), b2, voffB); PG8_STAGE(PG8_SB(0, 1), b2 + hstepB, voffB); PG8_STAGE(PG8_SA(0, 0), a2, voffA);
            PG8_WAIT_V(8); PG8_WAIT_L(0); PG8_BAR; PG8_MMA(1, 0, At, B0); PG8_MMA(1, 1, At, B1); PG8_BAR; PG8_SCHED;
            PG8_LDB(B0, 1, 0); PG8_LDB(B1, 1, 1); PG8_SCHED; PG8_LDA(At, 1, 0); PG8_STAGE(PG8_SA(0, 1), a2 + hstepA, voffA);
            PG8_WAIT_V(8); PG8_WAIT_L(0); PG8_BAR; PG8_MMA(0, 0, At, B0); PG8_MMA(0, 1, At, B1); PG8_BAR; PG8_SCHED;
            PG8_LDA(At, 1, 1); PG8_STAGE(PG8_SB(1, 0), b3, voffB); PG8_STAGE(PG8_SB(1, 1), b3 + hstepB, voffB); PG8_STAGE(PG8_SA(1, 0), a3, voffA);
            PG8_WAIT_V(8); PG8_WAIT_L(0); PG8_BAR; PG8_MMA(1, 0, At, B0); PG8_MMA(1, 1, At, B1); PG8_BAR; PG8_SCHED;
            } else {
            PG8_LDB(B0, 0, 0); PG8_SCHED; PG8_LDA(At, 0, 0); PG8_STAGE(PG8_SA(1, 1), a1 + hstepA, voffA);
            PG8_WAIT_L(8); PG8_BAR; PG8_WAIT_L(0); PG8_MMA(0, 0, At, B0); PG8_BAR; PG8_SCHED;
            PG8_LDB(B1, 0, 1); PG8_STAGE(PG8_SB(0, 0), b2, voffB);
            PG8_BAR; PG8_WAIT_L(0); PG8_MMA(0, 1, At, B1); PG8_BAR;
            PG8_LDA(At, 0, 1); PG8_STAGE(PG8_SA(0, 0), a2, voffA);
            PG8_BAR; PG8_WAIT_L(0); PG8_MMA(1, 0, At, B0); PG8_BAR; PG8_SCHED;
            PG8_STAGE(PG8_SB(0, 1), b2 + hstepB, voffB);
            PG8_WAIT_V(6); PG8_BAR; PG8_MMA(1, 1, At, B1); PG8_BAR;
            PG8_LDB(B0, 1, 0); PG8_SCHED; PG8_LDA(At, 1, 0); PG8_STAGE(PG8_SA(0, 1), a2 + hstepA, voffA);
            PG8_WAIT_L(8); PG8_BAR; PG8_WAIT_L(0); PG8_MMA(0, 0, At, B0); PG8_BAR; PG8_SCHED;
            PG8_LDB(B1, 1, 1); PG8_STAGE(PG8_SB(1, 0), b3, voffB);
            PG8_BAR; PG8_WAIT_L(0); PG8_MMA(0, 1, At, B1); PG8_BAR;
            PG8_LDA(At, 1, 1); PG8_STAGE(PG8_SA(1, 0), a3, voffA);
            PG8_BAR; PG8_WAIT_L(0); PG8_MMA(1, 0, At, B0); PG8_BAR; PG8_SCHED;
            PG8_STAGE(PG8_SB(1, 1), b3 + hstepB, voffB);
            PG8_WAIT_V(6); PG8_BAR; PG8_MMA(1, 1, At, B1); PG8_BAR;
            }
        }
        if constexpr (ALIGN_EPI) { if (wr == 0) PG8_BAR; }
        if constexpr (!Epi::AFTER_DRAIN) { E(acc, cur, wr, wc, fr, fq); S.done(cur); }
        if (!has_next) break;
#pragma unroll
        for (int a = 0; a < 2; ++a)
#pragma unroll
            for (int b = 0; b < 2; ++b)
#pragma unroll
                for (int m = 0; m < 4; ++m)
#pragma unroll
                    for (int n = 0; n < 2; ++n) acc[a][b][m][n] = (f32x4){0.f, 0.f, 0.f, 0.f};
        cur = nxt; cA = nA; cB = nB; ++ui;
        if constexpr (ALIGN_EPI) { if (wr == 1) PG8_BAR; }
    }
    PG8_WAIT_V(0);
    if constexpr (!ALIGN_EPI) { if (wr == 0) PG8_BAR; }
    PG8_BAR;
    if constexpr (Epi::AFTER_DRAIN) { E.fused(acc, cur, wr, wc, fr, fq, lds, wid, lane); S.done(cur); }
#undef PG8_SA
#undef PG8_SB
#undef PG8_STAGE
#undef PG8_LDA
#undef PG8_LDB
#undef PG8_MMA
#undef PG8_WAIT_V
#undef PG8_WAIT_L
#undef PG8_BAR
#undef PG8_SCHED
}
}
#define DI __device__ __forceinline__
#define GAS __attribute__((address_space(1)))
#define LAS __attribute__((address_space(3)))
typedef unsigned short bf16;
typedef unsigned v4u __attribute__((ext_vector_type(4)));
typedef unsigned v2u __attribute__((ext_vector_type(2)));
typedef float f32x4 __attribute__((ext_vector_type(4)));
typedef float f32x2 __attribute__((ext_vector_type(2)));
typedef short bf16x8 __attribute__((ext_vector_type(8)));
typedef short s16x4 __attribute__((ext_vector_type(4)));
typedef GAS unsigned gu32;

constexpr int DM = 1024, TP = 8192, MP = 16384, MS = 512, MROWS = 16896, LDZ = 8704, DFF = 4096, PLE = 256, NLAYER = 2;
constexpr int ZC_Q = 0, ZC_KC = 512, ZC_VC = 640, ZC_KS = 768, ZC_VS = 896, ZC_KW = 1024, ZC_VW = 1152, ZC_GQKV = 1280, ZC_GZ = 2816, ZC_RQKV = 3328, ZC_RG = 4864, ZC_MG = 5376, ZC_SM = 8448;
constexpr float EPS = 1e-6f;
constexpr size_t O_YP = 0, O_YS = O_YP + (size_t)MP * DM, O_KVP = O_YS + (size_t)MS * DM, O_KVS = O_KVP + (size_t)2 * MP * 512, O_WINP = O_KVS + (size_t)2 * MS * 512,
                 O_WINS = O_WINP + (size_t)2 * 2 * 512 * 256, O_CVP = O_WINS + (size_t)2 * 128 * 512 * 256, O_CVS = O_CVP + (size_t)2 * 2 * 3 * 1536, O_GSP = O_CVS + (size_t)2 * 128 * 3 * 1536,
                 O_GSS = O_GSP + (size_t)2 * 2 * 4 * 16384, O_RSP = O_GSS + (size_t)2 * 128 * 4 * 16384, O_RSS = O_RSP + (size_t)2 * 2 * 4 * 16384, O_END = O_RSS + (size_t)2 * 128 * 4 * 16384;

DI float bf2f(unsigned short b) { return __uint_as_float((unsigned)b << 16); }
DI unsigned f2bf(float f) { unsigned u = __float_as_uint(f); return (u + 0x7fffu + ((u >> 16) & 1u)) >> 16; }
DI unsigned pk2(float lo, float hi) { return f2bf(lo) | (f2bf(hi) << 16); }
DI float lo_bf(unsigned w) { return __uint_as_float(w << 16); }
DI float hi_bf(unsigned w) { return __uint_as_float(w & 0xffff0000u); }
DI float sigmoidf_(float x) { return 1.f / (1.f + __expf(-x)); }
DI float siluf_(float x) { return x / (1.f + __expf(-x)); }
DI v4u pack8(const f32x4 a, const f32x4 b) { v4u w; w.x = pk2(a[0], a[1]); w.y = pk2(a[2], a[3]); w.z = pk2(b[0], b[1]); w.w = pk2(b[2], b[3]); return w; }
DI void unpack8(const v4u w, f32x4& a, f32x4& b) { a[0] = lo_bf(w.x); a[1] = hi_bf(w.x); a[2] = lo_bf(w.y); a[3] = hi_bf(w.y); b[0] = lo_bf(w.z); b[1] = hi_bf(w.z); b[2] = lo_bf(w.w); b[3] = hi_bf(w.w); }

template <int M> DI int shxi(int v, int lane) {
    if constexpr (M < 32) return __builtin_amdgcn_ds_swizzle(v, (M << 10) | 0x1f);
    else return __builtin_amdgcn_ds_bpermute((lane ^ 32) << 2, v);
}
template <int M> DI float shx(float v, int lane) { return __int_as_float(shxi<M>(__float_as_int(v), lane)); }
DI float wave_sum(float v, int lane) { v += shx<1>(v, lane); v += shx<2>(v, lane); v += shx<4>(v, lane); v += shx<8>(v, lane); v += shx<16>(v, lane); v += shx<32>(v, lane); return v; }

namespace epi {
using pg8::Unit; using pg8::bf16_t;
DI float row_rstd(const float* SS, int row, int fq, int lane) {
    const f32x4 p = *(const f32x4*)(SS + (size_t)row * 16 + 4 * fq);
    float s = (p[0] + p[1]) + (p[2] + p[3]); s += shx<16>(s, lane); s += shx<32>(s, lane);
    return rsqrtf(s * (1.f / DM) + EPS);
}
struct EpiA {
    static constexpr bool PERM = true, AFTER_DRAIN = false;
    bf16* Z; float* ZS; const float* SS; float* out; int layer;
    DI void operator()(const f32x4 (&acc)[2][2][4][2], const Unit& u, int wr, int wc, int fr, int fq) const {
        asm volatile("" : "+v"(fr), "+v"(fq), "+s"(wr), "+s"(wc));
        const int pn = u.pn;
#pragma unroll
        for (int ai = 0; ai < 2; ++ai)
#pragma unroll
            for (int m = 0; m < 4; ++m) {
                const int row = u.pm * 256 + ai * 128 + wr * 64 + m * 16 + fr;
                const float rstd = row_rstd(SS, row, fq, fr + 16 * fq);
#pragma unroll
                for (int bj = 0; bj < 2; ++bj) {
                    const int col = pn * 256 + bj * 128 + wc * 32 + 8 * fq;
                    const f32x4 v0 = acc[ai][bj][m][0] * rstd, v1 = acc[ai][bj][m][1] * rstd;
                    *(v4u*)(Z + (size_t)row * LDZ + col) = pack8(v0, v1);
                    float* dst = nullptr;
                    if (pn == 2 || pn == 3) {
                        dst = (row < MP) ? out + O_KVP + ((size_t)layer * MP + row) * 512 + (col - 512) : out + O_KVS + ((size_t)layer * MS + (row - MP)) * 512 + (col - 512);
                    } else if (pn == 4) {
                        const int c2 = col - 1024;
                        if (row < MP) { const int t = row & (TP - 1), b = row >> 13; if (t >= TP - 512) dst = out + O_WINP + ((size_t)(layer * 2 + b) * 512 + (t - (TP - 512))) * 256 + c2; }
                        else { const int r2 = row - MP, s = r2 >> 2, j = r2 & 3; dst = out + O_WINS + ((size_t)(layer * 128 + s) * 512 + 508 + j) * 256 + c2; }
                    } else if (pn >= 5 && pn < 11) {
                        const int c2 = col - 1280;
                        if (row < MP) { const int t = row & (TP - 1), b = row >> 13; if (t >= TP - 3) dst = out + O_CVP + ((size_t)(layer * 2 + b) * 3 + (t - (TP - 3))) * 1536 + c2; }
                        else { const int r2 = row - MP, s = r2 >> 2, j = r2 & 3; if (j >= 1) dst = out + O_CVS + ((size_t)(layer * 128 + s) * 3 + (j - 1)) * 1536 + c2; }
                    } else if (pn == 33) {
                        if (bj == 0 && wc == 0) dst = ZS + (size_t)row * 32 + 8 * fq;
                    }
                    if (dst) { *(f32x4*)dst = v0; *(f32x4*)(dst + 4) = v1; }
                }
                asm volatile("" ::: "memory");
            }
    }
};
struct EpiC {
    static constexpr bool PERM = true, AFTER_DRAIN = false;
    const bf16* Z; bf16* G;
    DI void operator()(const f32x4 (&acc)[2][2][4][2], const Unit& u, int wr, int wc, int fr, int fq) const {
        asm volatile("" : "+v"(fr), "+v"(fq), "+s"(wr), "+s"(wc));
#pragma unroll
        for (int ai = 0; ai < 2; ++ai)
#pragma unroll
            for (int m = 0; m < 4; ++m) {
                const int row = u.pm * 256 + ai * 128 + wr * 64 + m * 16 + fr;
#pragma unroll
                for (int bj = 0; bj < 2; ++bj) {
                    const int col = u.pn * 256 + bj * 128 + wc * 32 + 8 * fq;
                    const v4u gw = *(const v4u*)(Z + (size_t)row * LDZ + ZC_MG + col);
                    f32x4 g0, g1; unpack8(gw, g0, g1);
                    f32x4 v0 = acc[ai][bj][m][0], v1 = acc[ai][bj][m][1];
#pragma unroll
                    for (int e = 0; e < 4; ++e) { v0[e] *= sigmoidf_(g0[e]); v1[e] *= sigmoidf_(g1[e]); }
                    *(v4u*)(G + (size_t)row * 3072 + col) = pack8(v0, v1);
                }
                asm volatile("" ::: "memory");
            }
    }
};
struct EpiRes {
    static constexpr bool PERM = true, AFTER_DRAIN = false;
    float* XR; bf16* XG; const float* gvec; float* SS; float* T; int mode;
    DI void operator()(const f32x4 (&acc)[2][2][4][2], const Unit& u, int wr, int wc, int fr, int fq) const {
        asm volatile("" : "+v"(fr), "+v"(fq), "+s"(wr), "+s"(wc));
#pragma unroll
        for (int ai = 0; ai < 2; ++ai)
#pragma unroll
            for (int m = 0; m < 4; ++m) {
                const int row = u.pm * 256 + ai * 128 + wr * 64 + m * 16 + fr;
                float ssq = 0.f;
#pragma unroll
                for (int bj = 0; bj < 2; ++bj) {
                    const int col = u.pn * 256 + bj * 128 + wc * 32 + 8 * fq;
                    const size_t o = (size_t)row * DM + col;
                    f32x4 a0 = acc[ai][bj][m][0], a1 = acc[ai][bj][m][1];
                    if (mode == 1) { *(f32x4*)(T + o) = a0; *(f32x4*)(T + o + 4) = a1; continue; }
                    f32x4 x0 = *(const f32x4*)(XR + o), x1 = *(const f32x4*)(XR + o + 4);
                    if (mode == 2) { const f32x4 t0 = *(const f32x4*)(T + o), t1 = *(const f32x4*)(T + o + 4);
#pragma unroll
                        for (int e = 0; e < 4; ++e) { a0[e] = t0[e] * sigmoidf_(a0[e]); a1[e] = t1[e] * sigmoidf_(a1[e]); } }
                    x0 += a0; x1 += a1;
                    *(f32x4*)(XR + o) = x0; *(f32x4*)(XR + o + 4) = x1;
                    ssq += (x0[0] * x0[0] + x0[1] * x0[1]) + (x0[2] * x0[2] + x0[3] * x0[3]) + (x1[0] * x1[0] + x1[1] * x1[1]) + (x1[2] * x1[2] + x1[3] * x1[3]);
                    if (XG) { if (gvec) { const f32x4 g0 = *(const f32x4*)(gvec + col), g1 = *(const f32x4*)(gvec + col + 4); x0 *= g0; x1 *= g1; }
                        *(v4u*)(XG + o) = pack8(x0, x1); }
                }
                if (SS) { ssq += shx<16>(ssq, fr + 16 * fq); ssq += shx<32>(ssq, fr + 16 * fq); if (fq == 0) SS[(size_t)row * 16 + u.pn * 4 + wc] = ssq; }
                asm volatile("" ::: "memory");
            }
    }
};
struct EpiUp {
    static constexpr bool PERM = true, AFTER_DRAIN = false;
    bf16* H; const float* SS;
    DI void operator()(const f32x4 (&acc)[2][2][4][2], const Unit& u, int wr, int wc, int fr, int fq) const {
        asm volatile("" : "+v"(fr), "+v"(fq), "+s"(wr), "+s"(wc));
#pragma unroll
        for (int ai = 0; ai < 2; ++ai)
#pragma unroll
            for (int m = 0; m < 4; ++m) {
                const int row = u.pm * 256 + ai * 128 + wr * 64 + m * 16 + fr;
                const float rstd = row_rstd(SS, row, fq, fr + 16 * fq);
#pragma unroll
                for (int bj = 0; bj < 2; ++bj) {
                    const int col = u.pn * 256 + bj * 128 + wc * 32 + 8 * fq;
                    f32x4 v0 = acc[ai][bj][m][0] * rstd, v1 = acc[ai][bj][m][1] * rstd;
#pragma unroll
                    for (int e = 0; e < 4; ++e) { const float a = fmaxf(v0[e], 0.f), b = fmaxf(v1[e], 0.f); v0[e] = a * a; v1[e] = b * b; }
                    *(v4u*)(H + (size_t)row * DFF + col) = pack8(v0, v1);
                }
                asm volatile("" ::: "memory");
            }
    }
};
}
constexpr size_t al256(size_t x) { return (x + 255) & ~(size_t)255; }
constexpr size_t WS_CTL = 0, CTL_ZERO_BYTES = 1u << 20;
constexpr size_t SZ_WIN = (size_t)LDZ * DM * 2, SZ_WBR = (size_t)3072 * 512 * 2, SZ_WO3 = (size_t)DM * 3072 * 2, SZ_WUP = (size_t)DFF * DM * 2, SZ_WDN = (size_t)DM * DFF * 2,
                 SZ_WPL = (size_t)DM * PLE * 2, SZ_WPG = (size_t)DM * DM * 2, SZ_W1T = (size_t)2 * 64 * 2048 * 2, SZ_W2T = (size_t)2 * 64 * 64 * 2;
constexpr size_t WS_WIN = CTL_ZERO_BYTES, WS_WBR = WS_WIN + 2 * SZ_WIN, WS_WO3 = WS_WBR + 2 * SZ_WBR, WS_WUP = WS_WO3 + 2 * SZ_WO3, WS_WDN = WS_WUP + 2 * SZ_WUP,
                 WS_WPL = WS_WDN + 2 * SZ_WDN, WS_WPG = WS_WPL + 2 * SZ_WPL, WS_W1T = WS_WPG + 2 * SZ_WPG, WS_W2T = WS_W1T + 2 * SZ_W1T, WS_ROT = al256(WS_W2T + 2 * SZ_W2T);
constexpr size_t WS_P16 = WS_ROT + (size_t)TP * 64 * 8;
constexpr size_t WS_XR = WS_P16 + (size_t)2 * MROWS * PLE * 2;
constexpr size_t WS_XGA = WS_XR + (size_t)MROWS * DM * 4, WS_XGB = WS_XGA + (size_t)MROWS * DM * 2, WS_XGC = WS_XGB + (size_t)MROWS * DM * 2;
constexpr size_t WS_SSA = WS_XGC + (size_t)MROWS * DM * 2, WS_SSB = WS_SSA + (size_t)MROWS * 64;
constexpr size_t WS_Z = WS_SSB + (size_t)MROWS * 64, WS_ZS = WS_Z + (size_t)MROWS * LDZ * 2;
constexpr size_t WS_MIX = WS_ZS + (size_t)MROWS * 128, WS_GATED = WS_MIX + (size_t)MROWS * 1536 * 2, WS_HMID = WS_GATED + (size_t)MROWS * 3072 * 2;
constexpr size_t WS_TPLE = WS_HMID + (size_t)MROWS * DFF * 2;
constexpr size_t WS_KC = WS_TPLE + (size_t)MROWS * DM * 4;
constexpr size_t WS_KCS = WS_KC + (size_t)2 * 2 * 512 * 2 * 64 * 2;
constexpr int GREC = 73984;
constexpr size_t WS_GREC = WS_KCS + (size_t)2 * 128 * 128 * 2 * 64 * 2;
constexpr size_t WS_OGDN = WS_GREC + (size_t)1024 * GREC;
constexpr size_t WS_RKV = WS_OGDN + (size_t)MROWS * 512 * 4;
constexpr size_t WS_RST = WS_RKV + (size_t)512 * 16384 * 4;
constexpr size_t WS_QR = WS_RST + (size_t)512 * 16384 * 2, WS_KR = WS_QR + (size_t)MP * 512 * 2;
constexpr size_t WS_END = WS_KR + (size_t)MP * 512 * 2;
static_assert(WS_W1T % 256 == 0 && WS_Z % 256 == 0 && WS_GREC % 256 == 0 && WS_RKV % 256 == 0 && WS_KC % 256 == 0 && WS_XR % 256 == 0, "ws alignment");

constexpr int CW_TMO = 0, CW_BAR = 4096, CW_QUEUE = 8192;
constexpr int NWAVES = 8, NTHREADS = 512;
constexpr int RING_BYTES = 147456, LDSCTL_OFF = RING_BYTES, MISC_OFF = LDSCTL_OFF + 320, LDS_BYTES = RING_BYTES + 1024;

#define RLX_AGENT __ATOMIC_RELAXED, __HIP_MEMORY_SCOPE_AGENT
#define LDS_WAIT() asm volatile("s_waitcnt lgkmcnt(0)" ::: "memory")
#define VM_WAIT() asm volatile("s_waitcnt vmcnt(0)" ::: "memory")
#define XB_TMO      128
#define XB_XCNT(j)  (256  + 64 * (j))
#define XB_XSUB(j)  (1280 + 64 * (j))
#define XB_XGEN(j)  (2304 + 64 * (j))
#define XB_TOP      3328
#define XB_TOPGEN   3392
#define XCD_BAR_WORDS 3456
#define XB_SPIN_CAP (1u << 18)

__device__ __forceinline__ unsigned xb_ld(unsigned* p)              { return __hip_atomic_load(p, __ATOMIC_RELAXED, __HIP_MEMORY_SCOPE_AGENT); }
__device__ __forceinline__ unsigned xb_add(unsigned* p, unsigned v) { return __hip_atomic_fetch_add(p, v, __ATOMIC_RELAXED, __HIP_MEMORY_SCOPE_AGENT); }
__device__ __forceinline__ unsigned xb_xcc_id() { return (unsigned)__builtin_amdgcn_s_getreg((3 << 11) | 20) & 0xFu; }
#define XB_SPIN(cond, bar) do { unsigned _sp = 0; while (cond) { __builtin_amdgcn_s_sleep(1); \
    if ((++_sp & 255u) == 0u) { if (xb_ld(&(bar)[XB_TMO])) break; if (_sp > XB_SPIN_CAP) { atomicAdd(&(bar)[XB_TMO], 1u); break; } } } } while (0)

struct XcdBarrier {
    unsigned* bar; unsigned x;
    volatile LAS unsigned* st;
};

__device__ __forceinline__ XcdBarrier xcd_barrier_post(unsigned* bar, volatile LAS unsigned* st, bool t0) {
    XcdBarrier b; b.bar = bar; b.x = xb_xcc_id(); b.st = st;
    if (t0) (void)xb_add(&bar[XB_XCNT(b.x)], 1u);
    return b;
}
__device__ __forceinline__ void xcd_barrier_complete(unsigned* bar, unsigned x, unsigned& nloc, unsigned& nx) {
    const unsigned G = gridDim.x * gridDim.y * gridDim.z;
    unsigned sum, cnt, mine, sp = 0u;
    for (;;) {
        sum = 0u; cnt = 0u; mine = 0u;
#pragma unroll
        for (unsigned j = 0; j < 16; ++j) { const unsigned c = xb_ld(&bar[XB_XCNT(j)]); sum += c; cnt += (c > 0u) ? 1u : 0u; mine = (j == x) ? c : mine; }
        if (sum == G) break;
        __builtin_amdgcn_s_sleep(1);
        if ((++sp & 255u) == 0u) { if (xb_ld(&bar[XB_TMO])) break; if (sp > XB_SPIN_CAP) { atomicAdd(&bar[XB_TMO], 1u); break; } }
    }
    nloc = mine > 0u ? mine : 1u; nx = cnt > 0u ? cnt : 1u;
}

__device__ __forceinline__ void xcd_barrier(const XcdBarrier& b, bool t0) {
    asm volatile("s_waitcnt vmcnt(0)" ::: "memory");
    __syncthreads();
    if (t0) {
        unsigned* bar = b.bar;
        __builtin_amdgcn_s_waitcnt(0);
        unsigned nloc = b.st[0], nx = b.st[1];
        if (nloc == 0u) { xcd_barrier_complete(bar, b.x, nloc, nx); b.st[0] = nloc; b.st[1] = nx; }
        const unsigned old = xb_add(&bar[XB_XSUB(b.x)], 1u);
        const unsigned gen = old / nloc;
        if (old + 1u == (gen + 1u) * nloc) {
            __builtin_amdgcn_fence(__ATOMIC_RELEASE, "agent");
            asm volatile("s_waitcnt vmcnt(0)" ::: "memory");
            const unsigned og = xb_add(&bar[XB_TOP], 1u);
            const unsigned tg = og / nx;
            if (og + 1u == (tg + 1u) * nx) xb_add(&bar[XB_TOPGEN], 1u);
            else XB_SPIN(xb_ld(&bar[XB_TOPGEN]) == tg, bar);
            __builtin_amdgcn_fence(__ATOMIC_ACQUIRE, "agent");
            xb_add(&bar[XB_XGEN(b.x)], 1u);
            asm volatile("s_waitcnt vmcnt(0)" ::: "memory");
        } else {
            XB_SPIN(xb_ld(&bar[XB_XGEN(b.x)]) == gen, bar);
            __builtin_amdgcn_fence(__ATOMIC_ACQUIRE, "agent");
            asm volatile("s_waitcnt vmcnt(0)" ::: "memory");
        }
    }
    __syncthreads();
}
typedef const void* const __attribute__((address_space(4)))* kargp_t;
DI const float* KIN(int i) { const float* p = (const float*)((kargp_t)__builtin_amdgcn_kernarg_segment_ptr())[i]; asm volatile("" : "+s"(p)); return p; }
DI float* KOUT() { float* p = (float*)((kargp_t)__builtin_amdgcn_kernarg_segment_ptr())[27]; asm volatile("" : "+s"(p)); return p; }
DI unsigned char* KWS() { unsigned char* p = (unsigned char*)((kargp_t)__builtin_amdgcn_kernarg_segment_ptr())[28]; asm volatile("" : "+s"(p)); return p; }
struct Frame {
    LAS unsigned char* lds;
    gu32* ctl;
    int tid, lane, wave, G, bid;
};
DI bf16x8 ld_frag_g(const bf16* p) { return __builtin_bit_cast(bf16x8, *(const v4u*)p); }
DI bf16x8 ld_frag_l(const LAS unsigned char* p) { return *(const LAS bf16x8*)p; }
DI f32x4 mfma16(bf16x8 a, bf16x8 b, f32x4 c) { return __builtin_amdgcn_mfma_f32_16x16x32_bf16(a, b, c, 0, 0, 0); }
DI bf16x8 pack_frag(const f32x4 a, const f32x4 b) { return __builtin_bit_cast(bf16x8, pack8(a, b)); }
DI int lane_id() { int l; asm volatile("v_mbcnt_lo_u32_b32 %0, -1, 0\n\tv_mbcnt_hi_u32_b32 %0, -1, %0" : "=v"(l)); return l; }
DI Frame fresh(const Frame& F0) {
    Frame F = F0; int w = F0.wave, g = F0.G, b = F0.bid; asm volatile("" : "+s"(w), "+s"(g), "+s"(b));
    int l = lane_id(); asm volatile("" : "+v"(l));
    unsigned lb = (unsigned)(uintptr_t)F0.lds; asm volatile("" : "+s"(lb)); F.lds = (LAS unsigned char*)(uintptr_t)lb;
    F.wave = w; F.lane = l; F.tid = w * 64 + l; F.G = g; F.bid = b; return F;
}
#define GRID_BAR() do { XcdBarrier b_; b_.bar = (unsigned*)((gu32*)(KWS() + WS_CTL) + CW_BAR); b_.x = xb_xcc_id(); b_.st = (volatile LAS unsigned*)(F.lds + MISC_OFF) + 8; \
    const Frame Fb_ = fresh(F); xcd_barrier(b_, Fb_.tid == 0); } while (0)
DI int win_colmap(int j) {
    if (j < 1280) return j; if (j < 2816) return j + 24; if (j < 8448) return j + 32; if (j < 8472) return j - 8448 + 1280; if (j < 8480) return j - 8472 + 2840; return -1;
}
DI void tr_item(const float* W, int ldw, int k0, int srccol, bf16* WT, size_t dst_row0, int ldt, int kdst0, int nrep, int krep, LAS float* scr, int lane) {
#pragma unroll 8
    for (int i = 0; i < 32; ++i) { const int kk = 2 * i + (lane >> 5); scr[kk * 33 + (lane & 31)] = (srccol >= 0) ? W[(size_t)(k0 + kk) * ldw + srccol] : 0.f; }
    LDS_WAIT(); asm volatile("" ::: "memory");
    const int c = lane & 7;
#pragma unroll
    for (int j = 0; j < 4; ++j) { const int n = (lane >> 3) + 8 * j; const LAS float* s = scr + (8 * c) * 33 + n;
        v4u o; o.x = pk2(s[0 * 33], s[1 * 33]); o.y = pk2(s[2 * 33], s[3 * 33]); o.z = pk2(s[4 * 33], s[5 * 33]); o.w = pk2(s[6 * 33], s[7 * 33]);
        for (int r = 0; r < nrep; ++r) *(v4u*)(WT + (dst_row0 + n) * (size_t)ldt + kdst0 + r * krep + 8 * c) = o; }
    LDS_WAIT(); asm volatile("" ::: "memory");
}
DI void p0_prologue(Frame& F) {
    LAS float* scr = (LAS float*)(F.lds + F.wave * 16384);
    const int gw = F.bid * NWAVES + F.wave, NGW = F.G * NWAVES, lane = F.lane;
    unsigned char* ws = KWS();
    constexpr int I_A = 16 * 272, I_B = 3 * 8 * 32, I_C = 16 * 32, I_D = 16 * 128, I_E = 64 * 32, I_F = 4 * 32, I_G = 16 * 32, I_H = 2 * 32 * 2, I_I = 2 * 2;
    constexpr int I_L = I_A + I_B + I_C + I_D + I_E + I_F + I_G + I_H + I_I;
    for (int it = gw; it < 2 * I_L; it += NGW) {
        const int l = it / I_L; int r = it % I_L;
        if (r < I_A) { const int kb = r / 272, nb = r % 272; tr_item(KIN(11) + (size_t)l * DM * 8480, 8480, 64 * kb, win_colmap(32 * nb + (lane & 31)), (bf16*)(ws + WS_WIN + l * SZ_WIN), 32 * nb, DM, 64 * kb, 1, 0, scr, lane); continue; } r -= I_A;
        if (r < I_B) { const int b = r / 256, kb = (r % 256) / 32, nb = r % 32; tr_item(KIN(19) + (size_t)(l * 3 + b) * 512 * DM, DM, 64 * kb, 32 * nb + (lane & 31), (bf16*)(ws + WS_WBR + l * SZ_WBR), b * 1024 + 32 * nb, 512, 64 * kb, 1, 0, scr, lane); continue; } r -= I_B;
        if (r < I_C) { const int kb = r / 32, nb = r % 32; tr_item(KIN(20) + (size_t)l * DM * DM, DM, 64 * kb, 32 * nb + (lane & 31), (bf16*)(ws + WS_WO3 + l * SZ_WO3), 32 * nb, 3072, 64 * kb, 3, 1024, scr, lane); continue; } r -= I_C;
        if (r < I_D) { const int kb = r / 128, nb = r % 128; tr_item(KIN(22) + (size_t)l * DM * DFF, DFF, 64 * kb, 32 * nb + (lane & 31), (bf16*)(ws + WS_WUP + l * SZ_WUP), 32 * nb, DM, 64 * kb, 1, 0, scr, lane); continue; } r -= I_D;
        if (r < I_E) { const int kb = r / 32, nb = r % 32; tr_item(KIN(23) + (size_t)l * DFF * DM, DM, 64 * kb, 32 * nb + (lane & 31), (bf16*)(ws + WS_WDN + l * SZ_WDN), 32 * nb, DFF, 64 * kb, 1, 0, scr, lane); continue; } r -= I_E;
        if (r < I_F) { const int kb = r / 32, nb = r % 32; tr_item(KIN(24) + (size_t)l * PLE * DM, DM, 64 * kb, 32 * nb + (lane & 31), (bf16*)(ws + WS_WPL + l * SZ_WPL), 32 * nb, PLE, 64 * kb, 1, 0, scr, lane); continue; } r -= I_F;
        if (r < I_G) { const int kb = r / 32, nb = r % 32; tr_item(KIN(25) + (size_t)l * DM * DM, DM, 64 * kb, 32 * nb + (lane & 31), (bf16*)(ws + WS_WPG + l * SZ_WPG), 32 * nb, DM, 64 * kb, 1, 0, scr, lane); continue; } r -= I_G;
        if (r < I_H) { const int kv = r / 64, kb = (r % 64) / 2, nb = r % 2; tr_item(KIN(13) + (size_t)(l * 2 + kv) * 2048 * 64, 64, 64 * kb, 32 * nb + (lane & 31), (bf16*)(ws + WS_W1T + l * SZ_W1T) + (size_t)kv * 64 * 2048, 32 * nb, 2048, 64 * kb, 1, 0, scr, lane); continue; } r -= I_H;
        { const int kv = r / 2, nb = r % 2; tr_item(KIN(14) + (size_t)(l * 2 + kv) * 64 * 64, 64, 0, 32 * nb + (lane & 31), (bf16*)(ws + WS_W2T + l * SZ_W2T) + (size_t)kv * 64 * 64, 32 * nb, 64, 0, 1, 0, scr, lane); }
    }
    float* XR = (float*)(ws + WS_XR); bf16* XGA = (bf16*)(ws + WS_XGA); float* SSA = (float*)(ws + WS_SSA); bf16* P16 = (bf16*)(ws + WS_P16);
    const float* g0 = KIN(10);
    for (int row = gw; row < MROWS; row += NGW) {
        const float* xs = (row < MP) ? KIN(0) + (size_t)row * DM : KIN(1) + (size_t)(row - MP) * DM;
        float ss = 0.f;
#pragma unroll
        for (int j = 0; j < 2; ++j) {
            const int c = j * 512 + lane * 8;
            f32x4 a = *(const f32x4*)(xs + c), b = *(const f32x4*)(xs + c + 4);
            *(f32x4*)(XR + (size_t)row * DM + c) = a; *(f32x4*)(XR + (size_t)row * DM + c + 4) = b;
            ss += (a[0] * a[0] + a[1] * a[1]) + (a[2] * a[2] + a[3] * a[3]) + (b[0] * b[0] + b[1] * b[1]) + (b[2] * b[2] + b[3] * b[3]);
            const f32x4 ga = *(const f32x4*)(g0 + c), gb = *(const f32x4*)(g0 + c + 4);
            *(v4u*)(XGA + (size_t)row * DM + c) = pack8(a * ga, b * gb);
        }
        ss = wave_sum(ss, lane);
        if (lane < 16) SSA[(size_t)row * 16 + lane] = (lane == 0) ? ss : 0.f;
#pragma unroll
        for (int l = 0; l < 2; ++l) {
            const float* ps = (row < MP) ? KIN(8) + ((size_t)l * MP + row) * PLE : KIN(9) + ((size_t)l * MS + (row - MP)) * PLE;
            const f32x4 a = *(const f32x4*)(ps + lane * 4);
            v2u o; o.x = pk2(a[0], a[1]); o.y = pk2(a[2], a[3]);
            *(v2u*)(P16 + ((size_t)l * MROWS + row) * PLE + lane * 4) = o;
        }
    }
    const int gt = F.bid * NTHREADS + F.tid, NGT = F.G * NTHREADS;
    f32x2* ROT = (f32x2*)(ws + WS_ROT);
    for (int e = gt; e < TP * 64; e += NGT) {
        const int pos = e >> 6, i = e & 63;
        const float x = (float)i * (1.0f / 63.0f);
        const float inv = exp2f(-x * 13.287712379549449f);
        const float ang = (float)pos * inv;
        const double rev = (double)ang * 0.15915494309189535;
        const float fr = (float)(rev - floor(rev));
        ROT[e] = (f32x2){__builtin_amdgcn_cosf(fr), __builtin_amdgcn_sinf(fr)};
    }
    for (int e = gt; e < 2 * 128 * 508 * 64; e += NGT) {
        const int ls = e / (508 * 64), r = e % (508 * 64);
        const f32x4 v = *(const f32x4*)(KIN(3) + (size_t)ls * 512 * 256 + 4 * 256 + (size_t)r * 4);
        *(f32x4*)(KOUT() + O_WINS + (size_t)ls * 512 * 256 + (size_t)r * 4) = v;
    }
}
DI float gelu_tanh(float x) { const float u = 0.7978845608028654f * (x + 0.044715f * x * x * x); const float e = __expf(2.f * u); return 0.5f * x * (1.f + (1.f - 2.f / (e + 1.f))); }
DI bf16x8 mk_frag(v2u a, v2u b) { v4u w; w.x = a.x; w.y = a.y; w.z = b.x; w.w = b.y; return __builtin_bit_cast(bf16x8, w); }

DI void compress_job(Frame& F, int layer, int job) {
    int lane = F.lane, wave = F.wave; asm volatile("" : "+v"(lane), "+s"(wave));
    const int tid = wave * 64 + lane, quad = lane >> 4, rl = lane & 15;
    unsigned char* ws = KWS();
    const bool sample = job < 256;
    int kv, bs, g0, nbase;
    if (sample) { kv = job >> 7; bs = job & 127; g0 = 0; nbase = 0; }
    else { const int j2 = job - 256; kv = j2 >> 3; bs = (j2 >> 2) & 1; g0 = (j2 >> 1) & 1; nbase = (j2 & 1) * 256; }
    const bf16* W1T = (const bf16*)(ws + WS_W1T + layer * SZ_W1T) + (size_t)kv * 64 * 2048;
    const bf16* W2T = (const bf16*)(ws + WS_W2T + layer * SZ_W2T) + (size_t)kv * 64 * 64;
    const float* pe = KIN(12) + (size_t)(layer * 2 + kv) * 32 * 64;
    const bf16* Z = (const bf16*)(ws + WS_Z);
    const int* pt = (const int*)KIN(7);
    const float* cache = KIN(2);
    LAS unsigned char* LW = F.lds;
    int gg[2], nn[2];
#pragma unroll
    for (int tl = 0; tl < 2; ++tl) { const int T = 2 * wave + tl; if (sample) { gg[tl] = T >> 3; nn[tl] = 16 * (T & 7) + rl; } else { gg[tl] = g0; nn[tl] = nbase + 16 * T + rl; } }
    f32x4 h[2][4];
#pragma unroll
    for (int tl = 0; tl < 2; ++tl)
#pragma unroll
        for (int i = 0; i < 4; ++i) h[tl][i] = (f32x4){0.f, 0.f, 0.f, 0.f};
#pragma unroll 1
    for (int c = 0; c < 4; ++c) {
        __syncthreads();
#pragma unroll
        for (int k = 0; k < 8; ++k) { const int pc = tid + 512 * k, r = pc >> 6, c16 = pc & 63;
            *(LAS v4u*)(LW + r * 1040 + c16 * 16) = *(const v4u*)(W1T + (size_t)r * 2048 + c * 512 + c16 * 8); }
        __syncthreads();
#pragma unroll 4
        for (int kk = 0; kk < 16; ++kk) {
            const int j = 8 * c + (kk >> 1), dim0 = (kk & 1) * 32 + quad * 8;
            const f32x4 pe0 = *(const f32x4*)(pe + j * 64 + dim0), pe1 = *(const f32x4*)(pe + j * 64 + dim0 + 4);
            bf16x8 xb[2];
#pragma unroll
            for (int tl = 0; tl < 2; ++tl) {
                f32x4 x0, x1;
                if (!sample) { const size_t row = (size_t)bs * TP + 16 * nn[tl] + j; unpack8(*(const v4u*)(Z + row * LDZ + ZC_KC + kv * 128 + gg[tl] * 64 + dim0), x0, x1); }
                else { int pos = 16 * nn[tl] + j; pos = pos > 2047 ? 2047 : pos; const int phys = pt[bs * 16 + (pos >> 7)];
                    const float* p = cache + ((size_t)(layer * 2560 + phys) * 128 + (pos & 127)) * 512 + kv * 128 + gg[tl] * 64 + dim0; x0 = *(const f32x4*)p; x1 = *(const f32x4*)(p + 4); }
                xb[tl] = pack_frag(x0 + pe0, x1 + pe1);
            }
#pragma unroll
            for (int ht = 0; ht < 4; ++ht) {
                const bf16x8 a = ld_frag_l(LW + (16 * ht + rl) * 1040 + (kk * 32 + quad * 8) * 2);
                h[0][ht] = mfma16(a, xb[0], h[0][ht]); h[1][ht] = mfma16(a, xb[1], h[1][ht]);
            }
        }
    }
#pragma unroll
    for (int tl = 0; tl < 2; ++tl) {
#pragma unroll
        for (int ht = 0; ht < 4; ++ht)
#pragma unroll
            for (int i = 0; i < 4; ++i) h[tl][ht][i] = gelu_tanh(h[tl][ht][i]);
        bf16x8 gb[2]; gb[0] = pack_frag(h[tl][0], h[tl][1]); gb[1] = pack_frag(h[tl][2], h[tl][3]);
        const int n = nn[tl], g = gg[tl];
        bf16* dst = sample ? (bf16*)(ws + WS_KCS) + ((((size_t)kv * 128 + bs) * 128 + n) * 2 + g) * 64 : (bf16*)(ws + WS_KC) + ((((size_t)kv * 2 + bs) * 512 + n) * 2 + g) * 64;
        const bool zero = sample && n == 127;
#pragma unroll
        for (int ot = 0; ot < 4; ++ot) {
            f32x4 o = (f32x4){0.f, 0.f, 0.f, 0.f};
#pragma unroll
            for (int s = 0; s < 2; ++s) {
                const bf16* wp = W2T + (16 * ot + rl) * 64 + 32 * s + 4 * quad;
                o = mfma16(mk_frag(*(const v2u*)wp, *(const v2u*)(wp + 16)), gb[s], o);
            }
            v2u w; w.x = zero ? 0u : pk2(o[0], o[1]); w.y = zero ? 0u : pk2(o[2], o[3]);
            *(v2u*)(dst + 16 * ot + 4 * quad) = w;
        }
    }
    __syncthreads();
}

DI int kperm(int idx) { const int s = idx >> 5, r = idx & 31; return 32 * s + 8 * ((r >> 2) & 3) + 4 * (r >> 4) + (r & 3); }
DI float softplusf_(float x) { return x > 20.f ? x : __logf(1.f + __expf(x)); }
DI float ret_lg(int h) { return h == 0 ? -0.031748697f : h == 1 ? -0.015748357f : h == 2 ? -0.007843178f : -0.0039138994f; }

DI void gdn_prep_unit(Frame& F, int layer, int unit) {
    const int tid = F.tid, lane = F.lane, wave = F.wave;
    const int b = unit >> 9, h = (unit >> 7) & 3, c = unit & 127;
    const int row0 = b * TP + 64 * c, t0 = 64 * c;
    unsigned char* ws = KWS();
    const bf16* Z = (const bf16*)(ws + WS_Z);
    const float* ZS = (const float*)(ws + WS_ZS);
    LAS float* Lq = (LAS float*)(F.lds); LAS float* Lk = (LAS float*)(F.lds + 33792); LAS float* Lv = (LAS float*)(F.lds + 67584);
    LAS float* LA = (LAS float*)(F.lds + 101376); LAS float* LQK = (LAS float*)(F.lds + 117760);
    LAS float* Lg = (LAS float*)(F.lds + 134144); LAS float* Lb = Lg + 64; LAS float* Le = Lg + 128;
    const float* cw = KIN(15) + (size_t)layer * 4 * 1536;
#pragma unroll
    for (int it0 = 0; it0 < 6; ++it0) {
        const int it = tid + it0 * NTHREADS;
        const int i = it / 48, ch = it % 48, part = ch >> 4, cc = ch & 15;
        const int col = part * 512 + h * 128 + cc * 8;
        f32x4 y0 = (f32x4){0.f, 0.f, 0.f, 0.f}, y1 = y0;
#pragma unroll
        for (int j = 0; j < 4; ++j) {
            const int t = t0 + i - 3 + j;
            if (t >= 0) { f32x4 x0, x1; unpack8(*(const v4u*)(Z + (size_t)(row0 + i - 3 + j) * LDZ + ZC_GQKV + col), x0, x1);
                y0 += x0 * *(const f32x4*)(cw + j * 1536 + col); y1 += x1 * *(const f32x4*)(cw + j * 1536 + col + 4); }
        }
#pragma unroll
        for (int e = 0; e < 4; ++e) { y0[e] = siluf_(y0[e]); y1[e] = siluf_(y1[e]); }
        LAS float* dst = (part == 0 ? Lq : part == 1 ? Lk : Lv) + i * 132 + cc * 8;
        *(LAS f32x4*)dst = y0; *(LAS f32x4*)(dst + 4) = y1;
    }
    __syncthreads();
    {
        float va[16], vb[16], ps[16];
#pragma unroll
        for (int q = 0; q < 16; ++q) { LAS float* vp = ((q < 8) ? Lq : Lk) + (wave * 8 + (q & 7)) * 132 + lane * 2; va[q] = vp[0]; vb[q] = vp[1]; ps[q] = va[q] * va[q] + vb[q] * vb[q]; }
#pragma unroll
        for (int q = 0; q < 16; ++q) ps[q] += shx<1>(ps[q], lane);
#pragma unroll
        for (int q = 0; q < 16; ++q) ps[q] += shx<2>(ps[q], lane);
#pragma unroll
        for (int q = 0; q < 16; ++q) ps[q] += shx<4>(ps[q], lane);
#pragma unroll
        for (int q = 0; q < 16; ++q) ps[q] += shx<8>(ps[q], lane);
#pragma unroll
        for (int q = 0; q < 16; ++q) ps[q] += shx<16>(ps[q], lane);
#pragma unroll
        for (int q = 0; q < 16; ++q) ps[q] += shx<32>(ps[q], lane);
#pragma unroll
        for (int q = 0; q < 16; ++q) { LAS float* vp = ((q < 8) ? Lq : Lk) + (wave * 8 + (q & 7)) * 132 + lane * 2; const float sc = rsqrtf(ps[q] + EPS) * ((q < 8) ? 0.08838834764831845f : 1.f); vp[0] = va[q] * sc; vp[1] = vb[q] * sc; }
    }
    if (wave == 0) {
        const float ga = ZS[(size_t)(row0 + lane) * 32 + 24 + h], gbv = ZS[(size_t)(row0 + lane) * 32 + 28 + h];
        float g = -__expf(KIN(16)[layer * 4 + h]) * softplusf_(ga + KIN(17)[layer * 4 + h]);
#pragma unroll
        for (int o = 1; o < 64; o <<= 1) { const float t = __int_as_float(__builtin_amdgcn_ds_bpermute(((lane - o) & 63) << 2, __float_as_int(g))); if (lane >= o) g += t; }
        Lg[lane] = g; Lb[lane] = sigmoidf_(gbv); Le[lane] = __expf(g);
    }
    __syncthreads();
    {
        const int it = wave >> 1, quad = lane >> 4, rl = lane & 15;
        f32x4 ckk[2], cqk[2];
#pragma unroll
        for (int jj = 0; jj < 2; ++jj) { ckk[jj] = (f32x4){0.f, 0.f, 0.f, 0.f}; cqk[jj] = ckk[jj]; }
#pragma unroll
        for (int s = 0; s < 4; ++s) {
            const LAS float* kp = Lk + (16 * it + rl) * 132 + 32 * s + 8 * quad; const LAS float* qp = Lq + (16 * it + rl) * 132 + 32 * s + 8 * quad;
            const f32x4 ka0 = *(const LAS f32x4*)kp, ka1 = *(const LAS f32x4*)(kp + 4), qa0 = *(const LAS f32x4*)qp, qa1 = *(const LAS f32x4*)(qp + 4);
            const bf16x8 kah = pack_frag(ka0, ka1), qah = pack_frag(qa0, qa1);
            f32x4 h0, h1; unpack8(__builtin_bit_cast(v4u, kah), h0, h1); const bf16x8 kal = pack_frag(ka0 - h0, ka1 - h1);
            unpack8(__builtin_bit_cast(v4u, qah), h0, h1); const bf16x8 qal = pack_frag(qa0 - h0, qa1 - h1);
#pragma unroll
            for (int jj = 0; jj < 2; ++jj) {
                const int jt = (wave & 1) * 2 + jj;
                if (jt <= it) {
                    const LAS float* bp = Lk + (16 * jt + rl) * 132 + 32 * s + 8 * quad;
                    const f32x4 kb0 = *(const LAS f32x4*)bp, kb1 = *(const LAS f32x4*)(bp + 4);
                    const bf16x8 kbh = pack_frag(kb0, kb1); unpack8(__builtin_bit_cast(v4u, kbh), h0, h1); const bf16x8 kbl = pack_frag(kb0 - h0, kb1 - h1);
                    ckk[jj] = mfma16(kah, kbh, ckk[jj]); ckk[jj] = mfma16(kah, kbl, ckk[jj]); ckk[jj] = mfma16(kal, kbh, ckk[jj]);
                    cqk[jj] = mfma16(qah, kbh, cqk[jj]); cqk[jj] = mfma16(qah, kbl, cqk[jj]); cqk[jj] = mfma16(qal, kbh, cqk[jj]);
                }
            }
        }
#pragma unroll
        for (int jj = 0; jj < 2; ++jj) {
            const int j = 16 * ((wave & 1) * 2 + jj) + rl; const float gj = Lg[j];
#pragma unroll
            for (int e = 0; e < 4; ++e) { const int i = 16 * it + 4 * quad + e; const float dec = (i >= j) ? __expf(Lg[i] - gj) : 0.f;
                LA[i * 64 + j] = (i > j) ? Lb[i] * ckk[jj][e] * dec : 0.f; LQK[i * 64 + j] = cqk[jj][e] * dec; }
        }
    }
    __syncthreads();
    unsigned char* rec = ws + WS_GREC + (size_t)unit * GREC;
    {
        const float gl = Lg[63];
        for (int it = tid; it < 2560; it += NTHREADS) {
            if (it < 1024) {
                const int i = it >> 4, s = (it >> 2) & 3, quad = it & 3; const float e = Le[i];
                const f32x4 a = *(const LAS f32x4*)(Lq + i * 132 + 32 * s + 4 * quad) * e, bq = *(const LAS f32x4*)(Lq + i * 132 + 32 * s + 16 + 4 * quad) * e;
                *(v4u*)(rec + 16384 + i * 256 + (32 * s + 8 * quad) * 2) = pack8(a, bq);
            } else if (it < 2048) {
                const int r = it - 1024, dk = r >> 3, s2 = (r >> 2) & 1, quad = r & 3;
                f32x4 a, bq;
#pragma unroll
                for (int e = 0; e < 4; ++e) { const int ta = 32 * s2 + 4 * quad + e, tb = ta + 16; a[e] = Lk[ta * 132 + dk] * __expf(gl - Lg[ta]); bq[e] = Lk[tb * 132 + dk] * __expf(gl - Lg[tb]); }
                *(v4u*)(rec + 32768 + dk * 128 + (32 * s2 + 8 * quad) * 2) = pack8(a, bq);
            } else {
                const int r = it - 2048, i = r >> 3, s2 = (r >> 2) & 1, quad = r & 3;
                const f32x4 a = *(const LAS f32x4*)(LQK + i * 64 + 32 * s2 + 4 * quad), bq = *(const LAS f32x4*)(LQK + i * 64 + 32 * s2 + 16 + 4 * quad);
                *(v4u*)(rec + 65536 + i * 128 + (32 * s2 + 8 * quad) * 2) = pack8(a, bq);
            }
        }
        if (tid == 0) *(float*)(rec + 73728) = __expf(gl);
    }
    __syncthreads();
    if (tid < 256) {
        LAS float* X = (tid < 128) ? (Lv + tid) : (Lk + (tid - 128));
        const bool isw = tid >= 128;
#pragma unroll 1
        for (int B = 0; B < 4; ++B) {
            float xb[16];
#pragma unroll
            for (int i = 0; i < 16; ++i) { const int r = 16 * B + i; xb[i] = (isw ? Lb[r] * Le[r] : Lb[r]) * X[r * 132]; }
#pragma unroll 1
            for (int j4 = 0; j4 < 4 * B; ++j4) {
                const float x0 = X[(4 * j4) * 132], x1 = X[(4 * j4 + 1) * 132], x2 = X[(4 * j4 + 2) * 132], x3 = X[(4 * j4 + 3) * 132];
#pragma unroll
                for (int i = 0; i < 16; ++i) { const f32x4 a = *(const LAS f32x4*)(LA + (16 * B + i) * 64 + 4 * j4); xb[i] -= (a[0] * x0 + a[1] * x1) + (a[2] * x2 + a[3] * x3); }
            }
#pragma unroll
            for (int i = 1; i < 16; ++i) {
                float acc0 = 0.f, acc1 = 0.f;
#pragma unroll
                for (int j4 = 0; j4 < (i + 3) / 4; ++j4) { const f32x4 a = *(const LAS f32x4*)(LA + (16 * B + i) * 64 + 16 * B + 4 * j4);
                    if (4 * j4 + 0 < i) acc0 += a[0] * xb[4 * j4 + 0]; if (4 * j4 + 1 < i) acc1 += a[1] * xb[4 * j4 + 1]; if (4 * j4 + 2 < i) acc0 += a[2] * xb[4 * j4 + 2]; if (4 * j4 + 3 < i) acc1 += a[3] * xb[4 * j4 + 3]; }
                xb[i] -= acc0 + acc1;
            }
#pragma unroll
            for (int i = 0; i < 16; ++i) X[(16 * B + i) * 132] = xb[i];
        }
    }
    __syncthreads();
    for (int it = tid; it < 2048; it += NTHREADS) {
        if (it < 1024) {
            const int dv = it >> 3, q = it & 7;
            v4u w; w.x = pk2(Lv[(8 * q) * 132 + dv], Lv[(8 * q + 1) * 132 + dv]); w.y = pk2(Lv[(8 * q + 2) * 132 + dv], Lv[(8 * q + 3) * 132 + dv]);
            w.z = pk2(Lv[(8 * q + 4) * 132 + dv], Lv[(8 * q + 5) * 132 + dv]); w.w = pk2(Lv[(8 * q + 6) * 132 + dv], Lv[(8 * q + 7) * 132 + dv]);
            *(v4u*)(rec + 49152 + dv * 128 + q * 16) = w;
        } else {
            const int r = it - 1024, i = r >> 4, s = (r >> 2) & 3, quad = r & 3;
            const f32x4 a = *(const LAS f32x4*)(Lk + i * 132 + 32 * s + 4 * quad), bq = *(const LAS f32x4*)(Lk + i * 132 + 32 * s + 16 + 4 * quad);
            *(v4u*)(rec + i * 256 + (32 * s + 8 * quad) * 2) = pack8(a, bq);
        }
    }
    __syncthreads();
}

DI void ret_prep_unit(Frame& F, int layer, int unit) {
    const int tid = F.tid, lane = F.lane, wave = F.wave, quad = lane >> 4, rl = lane & 15;
    const int b = unit >> 8, h = (unit >> 6) & 3, c = unit & 63;
    const int row0 = b * TP + 128 * c;
    unsigned char* ws = KWS();
    const bf16* Z = (const bf16*)(ws + WS_Z);
    const f32x2* ROT = (const f32x2*)(ws + WS_ROT);
    bf16* QR = (bf16*)(ws + WS_QR); bf16* KR = (bf16*)(ws + WS_KR);
    LAS unsigned char* LK = F.lds; LAS unsigned char* LV = F.lds + 34816;
    const float lg = ret_lg(h);
    for (int it = tid; it < 1024; it += NTHREADS) {
        const int j = it >> 3, cc = it & 7, d0 = cc * 8;
        const size_t zr = (size_t)(row0 + j) * LDZ + ZC_RQKV + h * 128 + d0;
        f32x4 q1a, q1b, q2a, q2b, k1a, k1b, k2a, k2b;
        unpack8(*(const v4u*)(Z + zr), q1a, q1b); unpack8(*(const v4u*)(Z + zr + 64), q2a, q2b);
        unpack8(*(const v4u*)(Z + zr + 512), k1a, k1b); unpack8(*(const v4u*)(Z + zr + 512 + 64), k2a, k2b);
        const f32x2* rp = ROT + (size_t)(128 * c + j) * 64 + d0;
        const float kd = __expf((float)(127 - j) * lg);
        f32x4 oq1a, oq1b, oq2a, oq2b, ok1a, ok1b, ok2a, ok2b;
#pragma unroll
        for (int e = 0; e < 8; ++e) {
            const f32x2 cs = rp[e];
            const float q1 = e < 4 ? q1a[e & 3] : q1b[e & 3], q2 = e < 4 ? q2a[e & 3] : q2b[e & 3], k1 = e < 4 ? k1a[e & 3] : k1b[e & 3], k2 = e < 4 ? k2a[e & 3] : k2b[e & 3];
            const float rq1 = q1 * cs.x - q2 * cs.y, rq2 = q2 * cs.x + q1 * cs.y, rk1 = (k1 * cs.x - k2 * cs.y) * 0.08838834764831845f, rk2 = (k2 * cs.x + k1 * cs.y) * 0.08838834764831845f;
            if (e < 4) { oq1a[e & 3] = rq1; oq2a[e & 3] = rq2; ok1a[e & 3] = rk1; ok2a[e & 3] = rk2; } else { oq1b[e & 3] = rq1; oq2b[e & 3] = rq2; ok1b[e & 3] = rk1; ok2b[e & 3] = rk2; }
            *(LAS bf16*)(LK + (d0 + e) * 272 + j * 2) = (bf16)f2bf(rk1 * kd); *(LAS bf16*)(LK + (d0 + 64 + e) * 272 + j * 2) = (bf16)f2bf(rk2 * kd);
        }
        const size_t orow = (size_t)(row0 + j) * 512 + h * 128 + d0;
        *(v4u*)(QR + orow) = pack8(oq1a, oq1b); *(v4u*)(QR + orow + 64) = pack8(oq2a, oq2b);
        *(v4u*)(KR + orow) = pack8(ok1a, ok1b); *(v4u*)(KR + orow + 64) = pack8(ok2a, ok2b);
    }
    for (int it = tid; it < 2048; it += NTHREADS) {
        const int j = it >> 4, cc = it & 15;
        const v4u w = *(const v4u*)(Z + (size_t)(row0 + j) * LDZ + ZC_RQKV + 1024 + h * 128 + cc * 8);
        LAS unsigned char* d = LV + (cc * 8) * 272 + j * 2;
        *(LAS bf16*)(d) = (bf16)(w.x & 0xffff); *(LAS bf16*)(d + 272) = (bf16)(w.x >> 16); *(LAS bf16*)(d + 2 * 272) = (bf16)(w.y & 0xffff); *(LAS bf16*)(d + 3 * 272) = (bf16)(w.y >> 16);
        *(LAS bf16*)(d + 4 * 272) = (bf16)(w.z & 0xffff); *(LAS bf16*)(d + 5 * 272) = (bf16)(w.z >> 16); *(LAS bf16*)(d + 6 * 272) = (bf16)(w.w & 0xffff); *(LAS bf16*)(d + 7 * 272) = (bf16)(w.w >> 16);
    }
    __syncthreads();
    float* RKV = (float*)(ws + WS_RKV) + (size_t)unit * 16384;
#pragma unroll
    for (int nt = 0; nt < 8; ++nt) {
        f32x4 acc = (f32x4){0.f, 0.f, 0.f, 0.f};
#pragma unroll
        for (int s = 0; s < 4; ++s) acc = mfma16(ld_frag_l(LK + (16 * wave + rl) * 272 + (32 * s + 8 * quad) * 2), ld_frag_l(LV + (16 * nt + rl) * 272 + (32 * s + 8 * quad) * 2), acc);
#pragma unroll
        for (int i = 0; i < 4; ++i) RKV[(size_t)(16 * wave + 4 * quad + i) * 128 + 16 * nt + rl] = acc[i];
    }
    __syncthreads();
}
DI void sample_rec_unit(Frame& F, int layer, int unit) {
    const int tid = F.tid, lane = F.lane, wave = F.wave;
    const int kind = unit >> 9, s = (unit >> 2) & 127, h = unit & 3;
    const int dv = tid & 127, part = tid >> 7, r0 = MP + 4 * s;
    unsigned char* ws = KWS();
    const bf16* Z = (const bf16*)(ws + WS_Z);
    const float* ZS = (const float*)(ws + WS_ZS);
    LAS float* Lq = (LAS float*)(F.lds); LAS float* Lk = Lq + 512; LAS float* Lv = Lq + 1024; LAS float* red = Lq + 1536; LAS float* Lo = Lq + 2048; LAS float* sc = Lq + 2560;
    float S[32];
    if (kind == 0) {
        if (tid < 384) {
            const int pr = tid >> 7, d = tid & 127, col = pr * 512 + h * 128 + d;
            float xp[7], w[4];
#pragma unroll
            for (int i = 0; i < 3; ++i) xp[i] = KIN(4)[((size_t)(layer * 128 + s) * 3 + i) * 1536 + col];
#pragma unroll
            for (int j = 0; j < 4; ++j) xp[3 + j] = bf2f(Z[(size_t)(r0 + j) * LDZ + ZC_GQKV + col]);
#pragma unroll
            for (int i = 0; i < 4; ++i) w[i] = KIN(15)[(size_t)(layer * 4 + i) * 1536 + col];
            LAS float* dst = pr == 0 ? Lq : pr == 1 ? Lk : Lv;
#pragma unroll
            for (int j = 0; j < 4; ++j) dst[j * 128 + d] = siluf_(w[0] * xp[j] + w[1] * xp[j + 1] + w[2] * xp[j + 2] + w[3] * xp[j + 3]);
        }
        __syncthreads();
        {
            LAS float* vp = (wave < 4 ? Lq : Lk) + (wave & 3) * 128;
            const float a = vp[2 * lane], b = vp[2 * lane + 1];
            const float scl = rsqrtf(wave_sum(a * a + b * b, lane) + EPS) * (wave < 4 ? 0.08838834764831845f : 1.f);
            vp[2 * lane] = a * scl; vp[2 * lane + 1] = b * scl;
        }
        if (tid < 4) {
            const float ga = ZS[(size_t)(r0 + tid) * 32 + 24 + h], gb = ZS[(size_t)(r0 + tid) * 32 + 28 + h];
            sc[tid] = __expf(-__expf(KIN(16)[layer * 4 + h]) * softplusf_(ga + KIN(17)[layer * 4 + h])); sc[4 + tid] = sigmoidf_(gb);
        }
        __syncthreads();
        const float* Sin = KIN(5) + ((size_t)((layer * 128 + s) * 4 + h) * 128 + 32 * part) * 128 + dv;
#pragma unroll
        for (int i = 0; i < 32; ++i) S[i] = Sin[(size_t)i * 128];
#pragma unroll
        for (int j = 0; j < 4; ++j) {
            const float a = sc[j], beta = sc[4 + j];
            float p = 0.f;
#pragma unroll
            for (int i = 0; i < 32; ++i) { S[i] *= a; p += Lk[j * 128 + 32 * part + i] * S[i]; }
            red[part * 128 + dv] = p;
            __syncthreads();
            const float delta = beta * (Lv[j * 128 + dv] - ((red[dv] + red[128 + dv]) + (red[256 + dv] + red[384 + dv])));
            __syncthreads();
            float o = 0.f;
#pragma unroll
            for (int i = 0; i < 32; ++i) { S[i] += Lk[j * 128 + 32 * part + i] * delta; o += Lq[j * 128 + 32 * part + i] * S[i]; }
            red[part * 128 + dv] = o;
            __syncthreads();
            if (part == 0) Lo[j * 128 + dv] = (red[dv] + red[128 + dv]) + (red[256 + dv] + red[384 + dv]);
            __syncthreads();
        }
        float* Sout = KOUT() + O_GSS + ((size_t)((layer * 128 + s) * 4 + h) * 128 + 32 * part) * 128 + dv;
#pragma unroll
        for (int i = 0; i < 32; ++i) Sout[(size_t)i * 128] = S[i];
        ((float*)(ws + WS_OGDN))[(size_t)(r0 + part) * 512 + h * 128 + dv] = Lo[part * 128 + dv];
    } else {
        const f32x2* ROT = (const f32x2*)(ws + WS_ROT);
        if (tid < 384) {
            const int pr = tid >> 7, d = tid & 127;
#pragma unroll
            for (int j = 0; j < 4; ++j) {
                const bf16* zp = Z + (size_t)(r0 + j) * LDZ + ZC_RQKV + pr * 512 + h * 128;
                float v = bf2f(zp[d]);
                if (pr < 2) { const f32x2 cs = ROT[(size_t)(2048 + j) * 64 + (d & 63)]; const float o = bf2f(zp[d ^ 64]);
                    v = (d < 64) ? v * cs.x - o * cs.y : v * cs.x + o * cs.y; if (pr == 1) v *= 0.08838834764831845f; }
                (pr == 0 ? Lq : pr == 1 ? Lk : Lv)[j * 128 + d] = v;
            }
        }
        __syncthreads();
        const float gam = __expf(ret_lg(h));
        const float* Sin = KIN(6) + ((size_t)((layer * 128 + s) * 4 + h) * 128 + 32 * part) * 128 + dv;
#pragma unroll
        for (int i = 0; i < 32; ++i) S[i] = Sin[(size_t)i * 128];
#pragma unroll
        for (int j = 0; j < 4; ++j) {
            const float vv = Lv[j * 128 + dv];
            float o = 0.f;
#pragma unroll
            for (int i = 0; i < 32; ++i) { S[i] = S[i] * gam + Lk[j * 128 + 32 * part + i] * vv; o += Lq[j * 128 + 32 * part + i] * S[i]; }
            red[part * 128 + dv] = o;
            __syncthreads();
            if (part == 0) Lo[j * 128 + dv] = (red[dv] + red[128 + dv]) + (red[256 + dv] + red[384 + dv]);
            __syncthreads();
        }
        float* Sout = KOUT() + O_RSS + ((size_t)((layer * 128 + s) * 4 + h) * 128 + 32 * part) * 128 + dv;
#pragma unroll
        for (int i = 0; i < 32; ++i) Sout[(size_t)i * 128] = S[i];
        if (wave < 4) {
            const int j = wave; const float a = Lo[j * 128 + 2 * lane], b = Lo[j * 128 + 2 * lane + 1];
            const float scl = rsqrtf(wave_sum(a * a + b * b, lane) * (1.f / 128.f) + EPS);
            const bf16* gp = Z + (size_t)(r0 + j) * LDZ + ZC_RG + h * 128 + 2 * lane;
            *(unsigned*)((bf16*)(ws + WS_MIX) + (size_t)(r0 + j) * 1536 + 1024 + h * 128 + 2 * lane) = pk2(a * scl * siluf_(bf2f(gp[0])), b * scl * siluf_(bf2f(gp[1])));
        }
    }
    __syncthreads();
}

DI void gdn_scan_chain(Frame& F, int layer, int bh) {
    int lane = F.lane, wave = F.wave; asm volatile("" : "+v"(lane), "+s"(wave));
    const int tid = wave * 64 + lane, quad = lane >> 4, rl = lane & 15;
    unsigned char* ws = KWS();
    const unsigned char* recb = ws + WS_GREC + (size_t)bh * 128 * GREC;
    LAS unsigned char* L = F.lds;
    constexpr int L_WP = 0, L_QP = 17408, L_KT = 34816, L_UT = 53248, L_QK = 71680;
    f32x4 S[8];
#pragma unroll
    for (int i = 0; i < 8; ++i) S[i] = (f32x4){0.f, 0.f, 0.f, 0.f};
    v4u pf[9]; float egl;
#pragma unroll
    for (int k = 0; k < 9; ++k) pf[k] = *(const v4u*)(recb + (size_t)(tid + 512 * k) * 16);
    egl = *(const float*)(recb + 73728);
    float* OG = (float*)(ws + WS_OGDN);
    const int b = bh >> 2, h = bh & 3;
    for (int c = 0; c < 128; ++c) {
        __syncthreads();
#pragma unroll
        for (int k = 0; k < 9; ++k) {
            const int o = tid * 16 + (k & 1) * 8192;
            const int reg = k >> 1;
            int dst;
            if (reg < 2) dst = (reg == 0 ? L_WP : L_QP) + (o >> 8) * 272 + (o & 255);
            else dst = (reg == 2 ? L_KT : reg == 3 ? L_UT : L_QK) + (o >> 7) * 144 + (o & 127);
            *(LAS v4u*)(L + dst) = pf[k];
        }
        const float eg = egl;
        __syncthreads();
        if (c + 1 < 128) {
            const unsigned char* rn = recb + (size_t)(c + 1) * GREC;
#pragma unroll
            for (int k = 0; k < 9; ++k) pf[k] = *(const v4u*)(rn + (size_t)(tid + 512 * k) * 16);
            egl = *(const float*)(rn + 73728);
        }
        bf16x8 Sb[4];
#pragma unroll
        for (int s = 0; s < 4; ++s) Sb[s] = pack_frag(S[2 * s], S[2 * s + 1]);
        f32x4 vn[4], O[4];
#pragma unroll
        for (int rt = 0; rt < 4; ++rt) {
            f32x4 wsacc = (f32x4){0.f, 0.f, 0.f, 0.f}, o = wsacc;
#pragma unroll
            for (int s = 0; s < 4; ++s) {
                wsacc = mfma16(ld_frag_l(L + L_WP + (16 * rt + rl) * 272 + (32 * s + 8 * quad) * 2), Sb[s], wsacc);
                o = mfma16(ld_frag_l(L + L_QP + (16 * rt + rl) * 272 + (32 * s + 8 * quad) * 2), Sb[s], o);
            }
            const v2u uw = *(const LAS v2u*)(L + L_UT + (16 * wave + rl) * 144 + (16 * rt + 4 * quad) * 2);
            vn[rt][0] = lo_bf(uw.x) - wsacc[0]; vn[rt][1] = hi_bf(uw.x) - wsacc[1]; vn[rt][2] = lo_bf(uw.y) - wsacc[2]; vn[rt][3] = hi_bf(uw.y) - wsacc[3];
            O[rt] = o;
        }
        bf16x8 Vb[2]; Vb[0] = pack_frag(vn[0], vn[1]); Vb[1] = pack_frag(vn[2], vn[3]);
#pragma unroll
        for (int rt = 0; rt < 4; ++rt) {
#pragma unroll
            for (int s2 = 0; s2 < 2; ++s2) O[rt] = mfma16(ld_frag_l(L + L_QK + (16 * rt + rl) * 144 + (32 * s2 + 8 * quad) * 2), Vb[s2], O[rt]);
            const size_t row = (size_t)b * TP + 64 * c + 16 * rt + 4 * quad;
#pragma unroll
            for (int i = 0; i < 4; ++i) OG[(row + i) * 512 + h * 128 + 16 * wave + rl] = O[rt][i];
        }
#pragma unroll
        for (int kt = 0; kt < 8; ++kt) {
            f32x4 a = S[kt] * eg;
#pragma unroll
            for (int s2 = 0; s2 < 2; ++s2) a = mfma16(ld_frag_l(L + L_KT + (16 * kt + rl) * 144 + (32 * s2 + 8 * quad) * 2), Vb[s2], a);
            S[kt] = a;
        }
    }
    float* So = KOUT() + O_GSP + (size_t)(layer * 8 + bh) * 16384;
#pragma unroll
    for (int kt = 0; kt < 8; ++kt)
#pragma unroll
        for (int i = 0; i < 4; ++i) So[(size_t)(16 * kt + 4 * quad + i) * 128 + 16 * wave + rl] = S[kt][i];
    __syncthreads();
}
DI void ret_scan_part(Frame& F, int layer, int r) {
    int tid = F.tid; asm volatile("" : "+v"(tid));
    const int bh = r >> 2, dv = tid & 127, dk0 = ((r & 3) * 4 + (tid >> 7)) * 8, h = bh & 3;
    unsigned char* ws = KWS();
    const float* RKV = (const float*)(ws + WS_RKV) + (size_t)bh * 64 * 16384;
    bf16* RST = (bf16*)(ws + WS_RST) + (size_t)bh * 64 * 16384;
    const float cdec = __expf(128.f * ret_lg(h));
    float S[8];
#pragma unroll
    for (int i = 0; i < 8; ++i) S[i] = 0.f;
#pragma unroll 4
    for (int c = 0; c < 64; ++c) {
        v4u w; w.x = pk2(S[0], S[1]); w.y = pk2(S[2], S[3]); w.z = pk2(S[4], S[5]); w.w = pk2(S[6], S[7]);
        *(v4u*)(RST + (size_t)c * 16384 + dv * 128 + dk0) = w;
#pragma unroll
        for (int i = 0; i < 8; ++i) S[i] = S[i] * cdec + RKV[(size_t)c * 16384 + (dk0 + i) * 128 + dv];
    }
    float* So = KOUT() + O_RSP + (size_t)(layer * 8 + bh) * 16384;
#pragma unroll
    for (int i = 0; i < 8; ++i) So[(size_t)(dk0 + i) * 128 + dv] = S[i];
}
constexpr float SM_C = 0.125f * 1.4426950408889634f;
struct AttnState { float m, l; f32x4 O[4]; };
DI void attn_reset(AttnState& st) { st.m = -1e30f; st.l = 0.f;
#pragma unroll
    for (int i = 0; i < 4; ++i) st.O[i] = (f32x4){0.f, 0.f, 0.f, 0.f}; }
DI void qk_tile(const LAS unsigned char* Kt, const bf16x8 (&qf)[2], f32x4 (&s)[4], int rl, int quad) {
#pragma unroll
    for (int kt = 0; kt < 4; ++kt) { f32x4 a = (f32x4){0.f, 0.f, 0.f, 0.f};
#pragma unroll
        for (int kk = 0; kk < 2; ++kk) a = mfma16(ld_frag_l(Kt + (16 * kt + rl) * 144 + kk * 64 + quad * 16), qf[kk], a);
        s[kt] = a; }
}
template <class Mask> DI void attn_step(const LAS unsigned char* Kt, const LAS unsigned char* VT, const bf16x8 (&qf)[2], AttnState& st, const Mask& ok, int rl, int quad) {
    f32x4 s[4]; qk_tile(Kt, qf, s, rl, quad);
    float mx = -3e38f;
#pragma unroll
    for (int kt = 0; kt < 4; ++kt)
#pragma unroll
        for (int i = 0; i < 4; ++i) if (ok(16 * kt + 4 * quad + i)) mx = fmaxf(mx, s[kt][i]);
    const int lane = rl + 16 * quad;
    mx = fmaxf(mx, shx<16>(mx, lane)); mx = fmaxf(mx, shx<32>(mx, lane));
    const float mn = fmaxf(st.m, mx);
    const float alpha = exp2f((st.m - mn) * SM_C);
    float ls = 0.f;
#pragma unroll
    for (int kt = 0; kt < 4; ++kt)
#pragma unroll
        for (int i = 0; i < 4; ++i) { const float p = ok(16 * kt + 4 * quad + i) ? exp2f((s[kt][i] - mn) * SM_C) : 0.f; s[kt][i] = p; ls += p; }
    ls += shx<16>(ls, lane); ls += shx<32>(ls, lane);
    st.l = st.l * alpha + ls; st.m = mn;
#pragma unroll
    for (int dt = 0; dt < 4; ++dt) st.O[dt] *= alpha;
#pragma unroll
    for (int ii = 0; ii < 2; ++ii) {
        const bf16x8 pb = pack_frag(s[2 * ii], s[2 * ii + 1]);
#pragma unroll
        for (int dt = 0; dt < 4; ++dt) {
            const LAS unsigned char* vp = VT + (16 * dt + rl) * 144 + (32 * ii + 4 * quad) * 2;
            st.O[dt] = mfma16(mk_frag(*(const LAS v2u*)vp, *(const LAS v2u*)(vp + 32)), pb, st.O[dt]);
        }
    }
}
DI void attn_accum(f32x4 (&Of)[4], const AttnState& st, float gate) {
    const float sc = st.l > 0.f ? gate / st.l : 0.f;
#pragma unroll
    for (int dt = 0; dt < 4; ++dt) Of[dt] += st.O[dt] * sc;
}
DI void vt_write(LAS unsigned char* VT, int d0, int key, const v4u w) {
    LAS unsigned char* d = VT + d0 * 144 + key * 2;
    *(LAS bf16*)(d) = (bf16)(w.x & 0xffff); *(LAS bf16*)(d + 144) = (bf16)(w.x >> 16); *(LAS bf16*)(d + 2 * 144) = (bf16)(w.y & 0xffff); *(LAS bf16*)(d + 3 * 144) = (bf16)(w.y >> 16);
    *(LAS bf16*)(d + 4 * 144) = (bf16)(w.z & 0xffff); *(LAS bf16*)(d + 5 * 144) = (bf16)(w.z >> 16); *(LAS bf16*)(d + 6 * 144) = (bf16)(w.w & 0xffff); *(LAS bf16*)(d + 7 * 144) = (bf16)(w.w >> 16);
}
DI void stage_wg(LAS unsigned char* Kt, LAS unsigned char* VT, const bf16* kb, const bf16* vb, size_t stride, int tid, bool do_v) {
    const int key = tid >> 3, ch = tid & 7;
    *(LAS v4u*)(Kt + key * 144 + ch * 16) = *(const v4u*)(kb + key * stride + ch * 8);
    if (do_v) vt_write(VT, ch * 8, key, *(const v4u*)(vb + key * stride + ch * 8));
}
DI int top16(float v0, float v1, int lane) {
    int sel = 0;
#pragma unroll 1
    for (int r = 0; r < 16; ++r) {
        float bv; int bi;
        if (v0 >= v1) { bv = v0; bi = lane; } else { bv = v1; bi = lane + 64; }
#define T16_STEP(M) { const float ov = shx<M>(bv, lane); const int oi = shxi<M>(bi, lane); const bool take = (ov > bv) || (ov == bv && oi < bi); bv = take ? ov : bv; bi = take ? oi : bi; }
        T16_STEP(32) T16_STEP(16) T16_STEP(8) T16_STEP(4) T16_STEP(2) T16_STEP(1)
#undef T16_STEP
        const bool h0 = (bi == lane), h1 = (bi == lane + 64);
        v0 = h0 ? -3e38f : v0; v1 = h1 ? -3e38f : v1; sel |= (h0 ? 1 : 0) | (h1 ? 2 : 0);
    }
    return sel;
}

typedef short v4i16_t __attribute__((ext_vector_type(4)));
DI s16x4 vtr(const LAS unsigned char* p) { return __builtin_bit_cast(s16x4, __builtin_amdgcn_ds_read_tr16_b64_v4i16((LAS v4i16_t*)p)); }
DI bf16x8 cat4(s16x4 a, s16x4 b) { bf16x8 r; r[0] = a[0]; r[1] = a[1]; r[2] = a[2]; r[3] = a[3]; r[4] = b[0]; r[5] = b[1]; r[6] = b[2]; r[7] = b[3]; return r; }
DI void attn_step3(const LAS unsigned char* Kt, const LAS unsigned char* Vt, const bf16x8 (&qf)[2], AttnState& st, int lo, int hi, bool active, int rl, int quad) {
    active = active && (hi >= lo);
    if (!__any(active)) return;
    f32x4 s[4]; qk_tile(Kt, qf, s, rl, quad);
    const int lane = rl + 16 * quad;
    const bool full = __all((lo <= 0 && hi >= 63) || !active);
    const int kq = 4 * quad - lo; const unsigned rng = (unsigned)(hi - lo);
    float lm;
    if (full) {
        const float a0 = fmaxf(fmaxf(s[0][0], s[0][1]), fmaxf(s[0][2], s[0][3])), a1 = fmaxf(fmaxf(s[1][0], s[1][1]), fmaxf(s[1][2], s[1][3]));
        const float a2 = fmaxf(fmaxf(s[2][0], s[2][1]), fmaxf(s[2][2], s[2][3])), a3 = fmaxf(fmaxf(s[3][0], s[3][1]), fmaxf(s[3][2], s[3][3]));
        lm = fmaxf(fmaxf(a0, a1), fmaxf(a2, a3));
    } else {
        lm = -3e38f;
#pragma unroll
        for (int kt = 0; kt < 4; ++kt)
#pragma unroll
            for (int i = 0; i < 4; ++i) lm = ((unsigned)(kq + 16 * kt + i) <= rng) ? fmaxf(lm, s[kt][i]) : lm;
    }
    lm = active ? lm : -3e38f;
    if (__any(lm > st.m + 320.f)) {
        float mx = fmaxf(lm, shx<16>(lm, lane)); mx = fmaxf(mx, shx<32>(mx, lane));
        const float mn = fmaxf(st.m, mx);
        const float alpha = __builtin_amdgcn_exp2f((st.m - mn) * SM_C);
        st.l *= alpha; st.m = mn;
#pragma unroll
        for (int dt = 0; dt < 4; ++dt) st.O[dt] *= alpha;
    }
    const float mc = active ? st.m * SM_C : __builtin_inff();
    float ls = 0.f;
    if (full) {
#pragma unroll
        for (int kt = 0; kt < 4; ++kt)
#pragma unroll
            for (int i = 0; i < 4; ++i) { const float p = __builtin_amdgcn_exp2f(s[kt][i] * SM_C - mc); s[kt][i] = p; ls += p; }
    } else {
#pragma unroll
        for (int kt = 0; kt < 4; ++kt)
#pragma unroll
            for (int i = 0; i < 4; ++i) { const float p = ((unsigned)(kq + 16 * kt + i) <= rng) ? __builtin_amdgcn_exp2f(s[kt][i] * SM_C - mc) : 0.f; s[kt][i] = p; ls += p; }
    }
    st.l += ls;
#pragma unroll
    for (int ii = 0; ii < 2; ++ii) {
        const bf16x8 pb = pack_frag(s[2 * ii], s[2 * ii + 1]);
#pragma unroll
        for (int dt = 0; dt < 4; ++dt) {
            const LAS unsigned char* vp = Vt + (32 * ii + 4 * quad + (rl >> 2)) * 144 + (16 * dt + 4 * (rl & 3)) * 2;
            st.O[dt] = mfma16(cat4(vtr(vp), vtr(vp + 16 * 144)), pb, st.O[dt]);
        }
    }
}
DI float attn_rowsum(const AttnState& st, int lane) { float l = st.l; l += shx<16>(l, lane); l += shx<32>(l, lane); return l; }
DI void attn_accum3(f32x4 (&Of)[4], const AttnState& st, float gate, int lane) {
    const float l = attn_rowsum(st, lane);
    const float sc = l > 0.f ? gate / l : 0.f;
#pragma unroll
    for (int dt = 0; dt < 4; ++dt) Of[dt] += st.O[dt] * sc;
}
DI void nsa_prompt_unit(Frame& F, int layer, int unit) {
    int lane = F.lane, wave = F.wave; asm volatile("" : "+v"(lane), "+s"(wave));
    const int tid = wave * 64 + lane, quad = lane >> 4, rl = lane & 15;
    const int b = unit >> 9, g = (unit >> 8) & 1, tt = unit & 255, t0 = 32 * tt;
    unsigned char* ws = KWS();
    const bf16* Z = (const bf16*)(ws + WS_Z);
    const float* ZS = (const float*)(ws + WS_ZS);
    LAS unsigned char* TB = F.lds;
    LAS float* AIMP = (LAS float*)(F.lds + 36864);
    LAS unsigned* SEL = (LAS unsigned*)(F.lds + 102400);
    const int tk = 4 * wave + (rl >> 2), t = t0 + tk, head = 4 * g + (rl & 3);
    const size_t row = (size_t)b * TP + t;
    bf16x8 qf[2];
    qf[0] = ld_frag_g(Z + row * LDZ + ZC_Q + head * 64 + quad * 8); qf[1] = ld_frag_g(Z + row * LDZ + ZC_Q + head * 64 + 32 + quad * 8);
    const float gc = sigmoidf_(ZS[row * 32 + head * 3]), gs = sigmoidf_(ZS[row * 32 + head * 3 + 1]), gw = sigmoidf_(ZS[row * 32 + head * 3 + 2]);
    f32x4 Of[4];
#pragma unroll
    for (int i = 0; i < 4; ++i) Of[i] = (f32x4){0.f, 0.f, 0.f, 0.f};
    AttnState st;
    const int nct = (t0 >> 10) + 1;
    const bf16* KC = (const bf16*)(ws + WS_KC) + ((size_t)(0 * 2 + b) * 512 * 2 + g) * 64;
    const bf16* VC = (const bf16*)(ws + WS_KC) + ((size_t)(1 * 2 + b) * 512 * 2 + g) * 64;
    const bf16* Zb = Z + (size_t)b * TP * LDZ + g * 64;
    const int skey = tid >> 3, sch = tid & 7;
    const int wlo = (t0 - 511 > 0 ? t0 - 511 : 0) >> 6, nwin = ((t0 + 31) >> 6) - wlo + 1;
    v4u rk0, rv0, rk1, rv1, rk2, rv2;
    const int n1 = nwin + 2 * nct;
#define SEG1_ISSUE(i, rk, rv) do { const int i_ = (i); if (i_ < nwin) { const bf16* p_ = Zb + (size_t)(64 * (wlo + i_) + skey) * LDZ + sch * 8; rk = *(const v4u*)(p_ + ZC_KW); rv = *(const v4u*)(p_ + ZC_VW); } \
        else { const int jt_ = (i_ - nwin) % nct; const size_t o_ = (size_t)(64 * jt_ + skey) * 128 + sch * 8; rk = *(const v4u*)(KC + o_); rv = *(const v4u*)(VC + o_); } } while (0)
#define COMMIT(bufi, rk, rv) do { LAS unsigned char* d_ = TB + (bufi) * 18432 + skey * 144 + sch * 16; *(LAS v4u*)d_ = rk; *(LAS v4u*)(d_ + 9216) = rv; } while (0)
    attn_reset(st);
    float mfin = 0.f, il = 0.f;
#define SEG1_COMPUTE(i) do { \
        const LAS unsigned char* Kt = TB + ((i) & 1) * 18432; const LAS unsigned char* Vt = Kt + 9216; \
        if ((i) < nwin) { \
            const int kb = 64 * (wlo + (i)); \
            attn_step3(Kt, Vt, qf, st, t - 511 - kb, t - kb, true, rl, quad); \
            if ((i) == nwin - 1) { attn_accum3(Of, st, gw, lane); attn_reset(st); } \
        } else if ((i) < nwin + nct) { \
            const int nb = 64 * ((i) - nwin); \
            attn_step3(Kt, Vt, qf, st, 0, ((t - 31) >> 4) - nb, true, rl, quad); \
            if ((i) == nwin + nct - 1) { attn_accum3(Of, st, gc, lane); mfin = st.m * SM_C; const float lt_ = attn_rowsum(st, lane); il = lt_ > 0.f ? 1.f / lt_ : 0.f; } \
        } else { \
            const int jt = (i) - nwin - nct; \
            f32x4 s[4]; qk_tile(Kt, qf, s, rl, quad); \
            _Pragma("unroll") for (int kt = 0; kt < 4; ++kt) \
            _Pragma("unroll") for (int e = 0; e < 4; ++e) { \
                    const int n = 64 * jt + 16 * kt + 4 * quad + e; \
                    float p = (16 * n + 31 <= t) ? __builtin_amdgcn_exp2f(s[kt][e] * SM_C - mfin) * il : 0.f; \
                    p += shx<1>(p, lane); p += shx<2>(p, lane); \
                    if ((rl & 3) == 0) AIMP[tk * 512 + n] = p; \
                } \
        } } while (0)
#define SEG1_STEP(i, rkc, rvc, rkn, rvn) do { if ((i) < n1) { SEG1_COMPUTE(i); if ((i) + 1 < n1) COMMIT(((i) + 1) & 1, rkn, rvn); __syncthreads(); if ((i) + 3 < n1) SEG1_ISSUE((i) + 3, rkc, rvc); } } while (0)
    SEG1_ISSUE(0, rk0, rv0); if (n1 > 1) SEG1_ISSUE(1, rk1, rv1); if (n1 > 2) SEG1_ISSUE(2, rk2, rv2);
    COMMIT(0, rk0, rv0); __syncthreads();
    for (int i = 0; i < n1; i += 3) { SEG1_STEP(i, rk0, rv0, rk1, rv1); SEG1_STEP(i + 1, rk1, rv1, rk2, rv2); SEG1_STEP(i + 2, rk2, rv2, rk0, rv0); }
    {
        const int nav = nct * 64;
#pragma unroll 1
        for (int q = 0; q < 4; ++q) {
            const int tq = 4 * wave + q, tp = t0 + tq, cur = tp >> 6;
            float sc2[2];
#pragma unroll
            for (int e = 0; e < 2; ++e) {
                const int sblk = lane + 64 * e;
                float imp = 0.f;
#pragma unroll
                for (int d = -1; d <= 3; ++d) { const int n = 4 * sblk + d; if (n >= 0 && n < nav) imp += AIMP[tq * 512 + n]; }
                const bool valid = sblk <= cur, forced = (sblk == 0) || (sblk == cur) || (sblk == cur - 1);
                sc2[e] = valid ? imp + (forced ? 1000.f : 0.f) : -1e30f;
            }
            const int sel = top16(sc2[0], sc2[1], lane);
            const unsigned long long m0 = __ballot((sel & 1) && (lane <= cur)), m1 = __ballot((sel & 2) && (lane + 64 <= cur));
            if (lane == 0) { SEL[tq * 4 + 0] = (unsigned)m0; SEL[tq * 4 + 1] = (unsigned)(m0 >> 32); SEL[tq * 4 + 2] = (unsigned)m1; SEL[tq * 4 + 3] = (unsigned)(m1 >> 32); }
        }
    }
    __syncthreads();
    unsigned un[4], my[4], wv[4];
#pragma unroll
    for (int w = 0; w < 4; ++w) { unsigned v = (lane < 32) ? SEL[lane * 4 + w] : 0u;
        v |= (unsigned)shxi<1>((int)v, lane); v |= (unsigned)shxi<2>((int)v, lane); v |= (unsigned)shxi<4>((int)v, lane); v |= (unsigned)shxi<8>((int)v, lane); v |= (unsigned)shxi<16>((int)v, lane); v |= (unsigned)shxi<32>((int)v, lane);
        un[w] = __builtin_amdgcn_readfirstlane(v); my[w] = SEL[tk * 4 + w];
        wv[w] = SEL[(4 * wave) * 4 + w] | SEL[(4 * wave + 1) * 4 + w] | SEL[(4 * wave + 2) * 4 + w] | SEL[(4 * wave + 3) * 4 + w]; wv[w] = __builtin_amdgcn_readfirstlane(wv[w]); }
    attn_reset(st);
    {
        unsigned w0 = un[0], w1 = un[1], w2 = un[2], w3 = un[3];
#define NEXT_BLK(dst) do { if (w0) { dst = __builtin_ctz(w0); w0 &= w0 - 1u; } else if (w1) { dst = 32 + __builtin_ctz(w1); w1 &= w1 - 1u; } else if (w2) { dst = 64 + __builtin_ctz(w2); w2 &= w2 - 1u; } \
        else if (w3) { dst = 96 + __builtin_ctz(w3); w3 &= w3 - 1u; } else dst = -1; } while (0)
#define SEG2_ISSUE(blk_, rk, rv) do { const bf16* p_ = Zb + (size_t)(64 * (blk_) + skey) * LDZ + sch * 8; rk = *(const v4u*)(p_ + ZC_KS); rv = *(const v4u*)(p_ + ZC_VS); } while (0)
        int bq0, bq1, bq2, bq3;
        NEXT_BLK(bq0); NEXT_BLK(bq1); NEXT_BLK(bq2);
        SEG2_ISSUE(bq0, rk0, rv0); if (bq1 >= 0) SEG2_ISSUE(bq1, rk1, rv1); if (bq2 >= 0) SEG2_ISSUE(bq2, rk2, rv2);
        COMMIT(0, rk0, rv0); __syncthreads();
        int i = 0;
#define SEG2_STEP(rkc, rvc, rkn, rvn) do { if (bq0 >= 0) { \
            NEXT_BLK(bq3); \
            const LAS unsigned char* Kt = TB + (i & 1) * 18432; const LAS unsigned char* Vt = Kt + 9216; \
            const int wsel = bq0 >> 5, bit = bq0 & 31; \
            const unsigned wword = wsel == 0 ? wv[0] : wsel == 1 ? wv[1] : wsel == 2 ? wv[2] : wv[3]; \
            if ((wword >> bit) & 1u) { \
                const unsigned mword = wsel == 0 ? my[0] : wsel == 1 ? my[1] : wsel == 2 ? my[2] : my[3]; \
                const bool mine = (mword >> bit) & 1u; const int kb = 64 * bq0; \
                attn_step3(Kt, Vt, qf, st, 0, t - kb, mine, rl, quad); \
            } \
            if (bq1 >= 0) COMMIT((i + 1) & 1, rkn, rvn); \
            __syncthreads(); \
            if (bq3 >= 0) SEG2_ISSUE(bq3, rkc, rvc); \
            bq0 = bq1; bq1 = bq2; bq2 = bq3; ++i; } } while (0)
        while (bq0 >= 0) { SEG2_STEP(rk0, rv0, rk1, rv1); SEG2_STEP(rk1, rv1, rk2, rv2); SEG2_STEP(rk2, rv2, rk0, rv0); }
    }
    attn_accum3(Of, st, gs, lane);
#undef SEG1_ISSUE
#undef SEG1_COMPUTE
#undef SEG1_STEP
#undef SEG2_ISSUE
#undef SEG2_STEP
#undef COMMIT
#undef NEXT_BLK
    bf16* MIX = (bf16*)(ws + WS_MIX) + row * 1536 + head * 64;
#pragma unroll
    for (int dt = 0; dt < 4; ++dt) { v2u w; w.x = pk2(Of[dt][0], Of[dt][1]); w.y = pk2(Of[dt][2], Of[dt][3]); *(v2u*)(MIX + 16 * dt + 4 * quad) = w; }
    __syncthreads();
}

#define CB() asm volatile("" ::: "memory")
DI void stage_wave_f32(LAS unsigned char* Kt, LAS unsigned char* Vt, const float* kb, const float* vb, size_t stride, int lane) {
    const int k0 = lane >> 3, ch = lane & 7;
#pragma unroll
    for (int h = 0; h < 4; ++h) {
        const float* src = (h < 2 ? kb : vb); LAS unsigned char* dst = (h < 2 ? Kt : Vt); const int r0 = (h & 1) * 32;
        f32x4 a[4][2];
#pragma unroll
        for (int it = 0; it < 4; ++it) { const float* kp = src + (size_t)(r0 + it * 8 + k0) * stride + ch * 8; a[it][0] = *(const f32x4*)kp; a[it][1] = *(const f32x4*)(kp + 4); }
#pragma unroll
        for (int it = 0; it < 4; ++it) *(LAS v4u*)(dst + (r0 + it * 8 + k0) * 144 + ch * 16) = pack8(a[it][0], a[it][1]);
        asm volatile("" ::: "memory");
    }
}
DI void stage_wave_b16(LAS unsigned char* Kt, LAS unsigned char* Vt, const bf16* kb, const bf16* vb, size_t stride, int nvalid, int lane, bool do_v) {
    const int k0 = lane >> 3, ch = lane & 7;
    const v4u z = (v4u){0u, 0u, 0u, 0u};
#pragma unroll
    for (int it = 0; it < 8; ++it) {
        const int key = it * 8 + k0; const bool v = key < nvalid;
        *(LAS v4u*)(Kt + key * 144 + ch * 16) = v ? *(const v4u*)(kb + key * stride + ch * 8) : z;
        if (do_v) *(LAS v4u*)(Vt + key * 144 + ch * 16) = v ? *(const v4u*)(vb + key * stride + ch * 8) : z;
    }
}
DI void nsa_sample_unit(Frame& F, int layer, int s) {
    int lane = F.lane, wave = F.wave; asm volatile("" : "+v"(lane), "+s"(wave));
    const int quad = lane >> 4, rl = lane & 15;
    const int g = wave & 1, q4 = wave >> 1;
    unsigned char* ws = KWS();
    const bf16* Z = (const bf16*)(ws + WS_Z);
    const float* ZS = (const float*)(ws + WS_ZS);
    LAS unsigned char* Kt = F.lds + wave * 18432; LAS unsigned char* Vt = Kt + 9216;
    LAS float* AIMP = (LAS float*)Vt;
    const int j = rl >> 2, head = 4 * g + (rl & 3), qpos = 2048 + j;
    const size_t row = (size_t)MP + 4 * s + j;
    bf16x8 qf[2];
    qf[0] = ld_frag_g(Z + row * LDZ + ZC_Q + head * 64 + quad * 8); qf[1] = ld_frag_g(Z + row * LDZ + ZC_Q + head * 64 + 32 + quad * 8);
    const float gc = sigmoidf_(ZS[row * 32 + head * 3]), gs = sigmoidf_(ZS[row * 32 + head * 3 + 1]), gw = sigmoidf_(ZS[row * 32 + head * 3 + 2]);
    f32x4 Of[4];
#pragma unroll
    for (int i = 0; i < 4; ++i) Of[i] = (f32x4){0.f, 0.f, 0.f, 0.f};
    AttnState st;
    const bf16* KC = (const bf16*)(ws + WS_KCS) + ((size_t)(0 * 128 + s) * 128 * 2 + g) * 64;
    const bf16* VC = (const bf16*)(ws + WS_KCS) + ((size_t)(1 * 128 + s) * 128 * 2 + g) * 64;
    attn_reset(st);
#pragma unroll 1
    for (int jt = 0; jt < 2; ++jt) {
        stage_wave_b16(Kt, Vt, KC + (size_t)64 * jt * 128, VC + (size_t)64 * jt * 128, 128, 64, lane, true); CB();
        attn_step3(Kt, Vt, qf, st, 0, 126 - 64 * jt, true, rl, quad); CB();
    }
    attn_accum3(Of, st, q4 == 0 ? gc : 0.f, lane);
    {
        const float mfin = st.m * SM_C, lt = attn_rowsum(st, lane), il = lt > 0.f ? 1.f / lt : 0.f;
#pragma unroll 1
        for (int jt = 0; jt < 2; ++jt) {
            stage_wave_b16(Kt, Vt, KC + (size_t)64 * jt * 128, VC, 128, 64, lane, false); CB();
            f32x4 sv[4]; qk_tile(Kt, qf, sv, rl, quad); CB();
#pragma unroll
            for (int kt = 0; kt < 4; ++kt)
#pragma unroll
                for (int i = 0; i < 4; ++i) {
                    const int n = 64 * jt + 16 * kt + 4 * quad + i;
                    float p = (n <= 126) ? __builtin_amdgcn_exp2f(sv[kt][i] * SM_C - mfin) * il : 0.f;
                    p += shx<1>(p, lane); p += shx<2>(p, lane);
                    if ((rl & 3) == 0) AIMP[j * 128 + n] = p;
                }
        }
    }
    CB();
    unsigned long long msk[4];
#pragma unroll 1
    for (int q = 0; q < 4; ++q) {
        float imp = 0.f;
#pragma unroll
        for (int d = -1; d <= 3; ++d) { const int n = 4 * lane + d; if (n >= 0 && n <= 126 && lane < 33) imp += AIMP[q * 128 + n]; }
        const bool forced = (lane == 0) || (lane == 32) || (lane == 31);
        const float sc = (lane < 33) ? imp + (forced ? 1000.f : 0.f) : -3e38f;
        const int sel = top16(sc, -3e38f, lane);
        msk[q] = __ballot((sel & 1) && lane < 33);
    }
    CB();
    const unsigned long long un = msk[0] | msk[1] | msk[2] | msk[3];
    const unsigned long long mym = j == 0 ? msk[0] : j == 1 ? msk[1] : j == 2 ? msk[2] : msk[3];
    const int* pt = (const int*)KIN(7);
    AttnState sw;
    attn_reset(st); attn_reset(sw);
    {
        unsigned long long word = un; int idx = 0;
        while (word) {
            const int blk = __builtin_ctzll(word); word &= word - 1ull;
            if ((idx++ & 3) != q4) continue;
            if (blk < 32) {
                const int phys = pt[s * 16 + (blk >> 1)];
                const float* base = KIN(2) + ((size_t)(layer * 2560 + phys) * 128 + (blk & 1) * 64) * 512 + g * 64;
                stage_wave_f32(Kt, Vt, base + 256, base + 384, 512, lane); CB();
            } else {
                stage_wave_b16(Kt, Vt, Z + (size_t)(MP + 4 * s) * LDZ + ZC_KS + g * 64, Z + (size_t)(MP + 4 * s) * LDZ + ZC_VS + g * 64, LDZ, 4, lane, true); CB();
            }
            attn_step3(Kt, Vt, qf, st, 0, qpos - 64 * blk, (mym >> blk) & 1ull, rl, quad); CB();
        }
#pragma unroll 1
        for (int jt = 0; jt < 9; ++jt) {
            if ((idx++ & 3) != q4) continue;
            if (jt < 8) { const float* base = KIN(3) + ((size_t)(layer * 128 + s) * 512 + 64 * jt) * 256 + g * 64; stage_wave_f32(Kt, Vt, base, base + 128, 256, lane); CB(); }
            else { stage_wave_b16(Kt, Vt, Z + (size_t)(MP + 4 * s) * LDZ + ZC_KW + g * 64, Z + (size_t)(MP + 4 * s) * LDZ + ZC_VW + g * 64, LDZ, 4, lane, true); CB(); }
            attn_step3(Kt, Vt, qf, sw, j + 1 - 64 * jt, 512 + j - 64 * jt, true, rl, quad); CB();
        }
    }
    int lane2 = lane; asm volatile("" : "+v"(lane2));
    LAS float* X = (LAS float*)(F.lds + wave * 18432);
    {
        const float ls = attn_rowsum(st, lane), lw = attn_rowsum(sw, lane);
        X[0 * 64 + lane2] = st.m; X[1 * 64 + lane2] = ls; X[18 * 64 + lane2] = sw.m; X[19 * 64 + lane2] = lw;
#pragma unroll
        for (int dt = 0; dt < 4; ++dt)
#pragma unroll
            for (int e = 0; e < 4; ++e) { X[(2 + 4 * dt + e) * 64 + lane2] = st.O[dt][e]; X[(20 + 4 * dt + e) * 64 + lane2] = sw.O[dt][e]; }
    }
    __syncthreads();
    if (q4 == 0) {
#pragma unroll
        for (int br = 0; br < 2; ++br) {
            float m[4], l[4];
#pragma unroll
            for (int q = 0; q < 4; ++q) { const LAS float* Y = (const LAS float*)(F.lds + (2 * q + g) * 18432) + br * 18 * 64; m[q] = Y[lane2]; l[q] = Y[64 + lane2]; }
            const float mm = fmaxf(fmaxf(m[0], m[1]), fmaxf(m[2], m[3]));
            float w[4], lt = 0.f;
#pragma unroll
            for (int q = 0; q < 4; ++q) { w[q] = __builtin_amdgcn_exp2f((m[q] - mm) * SM_C); lt += l[q] * w[q]; }
            const float gate = br == 0 ? gs : gw;
            const float sc = lt > 0.f ? gate / lt : 0.f;
#pragma unroll
            for (int q = 0; q < 4; ++q) { const LAS float* Y = (const LAS float*)(F.lds + (2 * q + g) * 18432) + br * 18 * 64; const float wq = w[q] * sc;
#pragma unroll
                for (int dt = 0; dt < 4; ++dt)
#pragma unroll
                    for (int e = 0; e < 4; ++e) Of[dt][e] += Y[(2 + 4 * dt + e) * 64 + lane2] * wq; }
        }
        bf16* MIX = (bf16*)(ws + WS_MIX) + row * 1536 + head * 64;
#pragma unroll
        for (int dt = 0; dt < 4; ++dt) { v2u w2; w2.x = pk2(Of[dt][0], Of[dt][1]); w2.y = pk2(Of[dt][2], Of[dt][3]); *(v2u*)(MIX + 16 * dt + 4 * quad) = w2; }
    }
    __syncthreads();
}
DI void ret_out_unit(Frame& F, int layer, int unit) {
    const int tid = F.tid, lane = F.lane, wave = F.wave, quad = lane >> 4, rl = lane & 15;
    const int b = unit >> 8, h = (unit >> 6) & 3, c = unit & 63;
    const int row0 = b * TP + 128 * c;
    unsigned char* ws = KWS();
    const bf16* Z = (const bf16*)(ws + WS_Z);
    const bf16* QR = (const bf16*)(ws + WS_QR); const bf16* KR = (const bf16*)(ws + WS_KR);
    const bf16* RST = (const bf16*)(ws + WS_RST) + (size_t)unit * 16384;
    LAS unsigned char* LQ = F.lds; LAS unsigned char* LK = F.lds + 34816; LAS unsigned char* LV = F.lds + 69632; LAS unsigned char* LS = F.lds + 104448;
    for (int it = tid; it < 2048; it += NTHREADS) {
        const int j = it >> 4, cc = it & 15;
        *(LAS v4u*)(LQ + j * 272 + cc * 16) = *(const v4u*)(QR + (size_t)(row0 + j) * 512 + h * 128 + cc * 8);
        *(LAS v4u*)(LK + j * 272 + cc * 16) = *(const v4u*)(KR + (size_t)(row0 + j) * 512 + h * 128 + cc * 8);
        *(LAS v4u*)(LS + j * 272 + cc * 16) = *(const v4u*)(RST + (size_t)j * 128 + cc * 8);
        const v4u w = *(const v4u*)(Z + (size_t)(row0 + j) * LDZ + ZC_RQKV + 1024 + h * 128 + cc * 8);
        LAS unsigned char* d = LV + (cc * 8) * 272 + j * 2;
        *(LAS bf16*)(d) = (bf16)(w.x & 0xffff); *(LAS bf16*)(d + 272) = (bf16)(w.x >> 16); *(LAS bf16*)(d + 2 * 272) = (bf16)(w.y & 0xffff); *(LAS bf16*)(d + 3 * 272) = (bf16)(w.y >> 16);
        *(LAS bf16*)(d + 4 * 272) = (bf16)(w.z & 0xffff); *(LAS bf16*)(d + 5 * 272) = (bf16)(w.z >> 16); *(LAS bf16*)(d + 6 * 272) = (bf16)(w.w & 0xffff); *(LAS bf16*)(d + 7 * 272) = (bf16)(w.w >> 16);
    }
    __syncthreads();
    const float lg = ret_lg(h);
    const int il = 16 * wave + rl;
    bf16x8 qb[4];
#pragma unroll
    for (int s = 0; s < 4; ++s) qb[s] = ld_frag_l(LQ + il * 272 + (32 * s + 8 * quad) * 2);
    f32x4 C[8];
    const float qdec = __expf((float)(il + 1) * lg);
#pragma unroll
    for (int dt = 0; dt < 8; ++dt) {
        f32x4 a = (f32x4){0.f, 0.f, 0.f, 0.f};
#pragma unroll
        for (int s = 0; s < 4; ++s) a = mfma16(ld_frag_l(LS + (16 * dt + rl) * 272 + (32 * s + 8 * quad) * 2), qb[s], a);
        C[dt] = a * qdec;
    }
    for (int s2 = 0; s2 <= (wave >> 1); ++s2) {
        f32x4 P[2];
#pragma unroll
        for (int e = 0; e < 2; ++e) {
            const int jt = 2 * s2 + e;
            f32x4 a = (f32x4){0.f, 0.f, 0.f, 0.f};
            if (jt <= wave) {
#pragma unroll
                for (int s = 0; s < 4; ++s) a = mfma16(ld_frag_l(LK + (16 * jt + rl) * 272 + (32 * s + 8 * quad) * 2), qb[s], a);
#pragma unroll
                for (int i = 0; i < 4; ++i) { const int jj = 16 * jt + 4 * quad + i; a[i] = (il >= jj) ? a[i] * __expf((float)(il - jj) * lg) : 0.f; }
            }
            P[e] = a;
        }
        const bf16x8 pb = pack_frag(P[0], P[1]);
#pragma unroll
        for (int dt = 0; dt < 8; ++dt) {
            const LAS unsigned char* vp = LV + (16 * dt + rl) * 272 + (32 * s2 + 4 * quad) * 2;
            C[dt] = mfma16(mk_frag(*(const LAS v2u*)vp, *(const LAS v2u*)(vp + 32)), pb, C[dt]);
        }
    }
    float ss = 0.f;
#pragma unroll
    for (int dt = 0; dt < 8; ++dt) ss += (C[dt][0] * C[dt][0] + C[dt][1] * C[dt][1]) + (C[dt][2] * C[dt][2] + C[dt][3] * C[dt][3]);
    ss += shx<16>(ss, lane); ss += shx<32>(ss, lane);
    const float scl = rsqrtf(ss * (1.f / 128.f) + EPS);
    const size_t row = (size_t)row0 + il;
#pragma unroll
    for (int dt = 0; dt < 8; ++dt) {
        const v2u gwd = *(const v2u*)(Z + row * LDZ + ZC_RG + h * 128 + 16 * dt + 4 * quad);
        v2u w; w.x = pk2(C[dt][0] * scl * siluf_(lo_bf(gwd.x)), C[dt][1] * scl * siluf_(hi_bf(gwd.x))); w.y = pk2(C[dt][2] * scl * siluf_(lo_bf(gwd.y)), C[dt][3] * scl * siluf_(hi_bf(gwd.y)));
        *(v2u*)((bf16*)(ws + WS_MIX) + row * 1536 + 1024 + h * 128 + 16 * dt + 4 * quad) = w;
    }
    __syncthreads();
}
DI void gdn_out_row(Frame& F, int layer, int row) {
    const int lane = F.lane;
    unsigned char* ws = KWS();
    const float* o = (const float*)(ws + WS_OGDN) + (size_t)row * 512 + lane * 8;
    const f32x4 a = *(const f32x4*)o, b = *(const f32x4*)(o + 4);
    float ss = (a[0] * a[0] + a[1] * a[1]) + (a[2] * a[2] + a[3] * a[3]) + (b[0] * b[0] + b[1] * b[1]) + (b[2] * b[2] + b[3] * b[3]);
    ss += shx<1>(ss, lane); ss += shx<2>(ss, lane); ss += shx<4>(ss, lane); ss += shx<8>(ss, lane);
    const float scl = rsqrtf(ss * (1.f / 128.f) + EPS);
    const float* ng = KIN(18) + layer * 128 + (lane & 15) * 8;
    const f32x4 ga = *(const f32x4*)ng, gb = *(const f32x4*)(ng + 4);
    f32x4 za, zb; unpack8(*(const v4u*)((const bf16*)(ws + WS_Z) + (size_t)row * LDZ + ZC_GZ + lane * 8), za, zb);
    f32x4 ra, rb;
#pragma unroll
    for (int e = 0; e < 4; ++e) { ra[e] = a[e] * scl * ga[e] * siluf_(za[e]); rb[e] = b[e] * scl * gb[e] * siluf_(zb[e]); }
    *(v4u*)((bf16*)(ws + WS_MIX) + (size_t)row * 1536 + 512 + lane * 8) = pack8(ra, rb);
}
DI void final_row(Frame& F, int row) {
    const int lane = F.lane;
    const float* x = (const float*)(KWS() + WS_XR) + (size_t)row * DM;
    float* y = (row < MP) ? KOUT() + O_YP + (size_t)row * DM : KOUT() + O_YS + (size_t)(row - MP) * DM;
    f32x4 v[4]; float ss = 0.f;
#pragma unroll
    for (int j = 0; j < 4; ++j) { v[j] = *(const f32x4*)(x + 256 * j + lane * 4); ss += (v[j][0] * v[j][0] + v[j][1] * v[j][1]) + (v[j][2] * v[j][2] + v[j][3] * v[j][3]); }
    const float scl = rsqrtf(wave_sum(ss, lane) * (1.f / DM) + EPS);
#pragma unroll
    for (int j = 0; j < 4; ++j) *(f32x4*)(y + 256 * j + lane * 4) = v[j] * scl * *(const f32x4*)(KIN(26) + 256 * j + lane * 4);
}
#ifndef PH_P0
#define PH_P0 1
#endif
#ifndef PH_A
#define PH_A 1
#endif
#ifndef PH_B0a
#define PH_B0a 1
#endif
#ifndef PH_B0b
#define PH_B0b 1
#endif
#ifndef PH_B0c
#define PH_B0c 1
#endif
#ifndef PH_B0d
#define PH_B0d 1
#endif
#ifndef PH_SCAN
#define PH_SCAN 1
#endif
#ifndef PH_RSCAN
#define PH_RSCAN 1
#endif
#ifndef PH_NSAP
#define PH_NSAP 1
#endif
#ifndef PH_NSAS
#define PH_NSAS 1
#endif
#ifndef PH_B2
#define PH_B2 1
#endif
#ifndef PH_C
#define PH_C 1
#endif
#ifndef PH_D
#define PH_D 1
#endif
#ifndef PH_E
#define PH_E 1
#endif
#ifndef PH_F
#define PH_F 1
#endif
#ifndef PH_G1
#define PH_G1 1
#endif
#ifndef PH_G2
#define PH_G2 1
#endif
struct Args { const void* in[27]; float* out; unsigned char* ws; };
__global__ void __launch_bounds__(NTHREADS, 2) mk_fwd(Args args) {
    extern __shared__ __attribute__((aligned(16))) unsigned char lds_raw[];
    Frame F;
    F.lds = (LAS unsigned char*)lds_raw;
    F.wave = __builtin_amdgcn_readfirstlane((int)threadIdx.x >> 6); F.lane = 0; F.tid = 0;
    F.G = gridDim.x; F.bid = blockIdx.x;
    F.ctl = (gu32*)(KWS() + WS_CTL);
    { const Frame Fp = fresh(F); for (int u = Fp.tid; u < (LDS_BYTES - LDSCTL_OFF) / 4; u += NTHREADS) ((LAS unsigned*)(F.lds + LDSCTL_OFF))[u] = 0u;
      __syncthreads();
      (void)xcd_barrier_post((unsigned*)(F.ctl + CW_BAR), (volatile LAS unsigned*)(F.lds + MISC_OFF) + 8, Fp.tid == 0); }
    const int G = F.G, bid = F.bid;

        for (int rp_ = 0; rp_ < PH_P0; ++rp_) {
    { Frame Fp = fresh(F); p0_prologue(Fp); }
        }
    GRID_BAR();

    for (int layer = 0; layer < NLAYER; ++layer) {
        for (int rp_ = 0; rp_ < PH_A; ++rp_) {
        {
            const Frame Fg = fresh(F); const int G = Fg.G, bid = Fg.bid;
            unsigned char* ws = KWS();
            pg8::Gemm g{(const bf16*)(ws + WS_XGA), (const bf16*)(ws + WS_WIN + layer * SZ_WIN), MROWS, LDZ, DM, DM, DM, 31, 0};
            pg8::StaticOrder S; S.init(MROWS, LDZ, G, bid);
            epi::EpiA E{(bf16*)(ws + WS_Z), (float*)(ws + WS_ZS), (const float*)(ws + WS_SSA), KOUT(), layer};
            pg8::gemm_phase<epi::EpiA, pg8::StaticOrder, true, true>(Fg.lds, g, S, E, Fg.tid);
        }
        }
        GRID_BAR();
        for (int rp_ = 0; rp_ < PH_B0a; ++rp_) {
        { Frame Fp = fresh(F); for (int u = Fp.bid; u < 1024; u += Fp.G) gdn_prep_unit(Fp, layer, u); }
        }
        for (int rp_ = 0; rp_ < PH_B0b; ++rp_) {
        { Frame Fp = fresh(F); for (int u = Fp.bid; u < 512; u += Fp.G) ret_prep_unit(Fp, layer, u); }
        }
        for (int rp_ = 0; rp_ < PH_B0c; ++rp_) {
        { Frame Fp = fresh(F); for (int u = Fp.bid; u < 1024; u += Fp.G) sample_rec_unit(Fp, layer, u); }
        }
        for (int rp_ = 0; rp_ < PH_B0d; ++rp_) {
        { Frame Fp = fresh(F); for (int t = Fp.bid; t < 256 + 16; t += Fp.G) compress_job(Fp, layer, t); }
        }
        GRID_BAR();
        {
            Frame Fp = fresh(F);
            gu32* qhead = F.ctl + CW_QUEUE + 64 * layer;
            volatile LAS int* qslot = (volatile LAS int*)(F.lds + MISC_OFF) + 16;
            constexpr int NQ = (PH_SCAN ? 8 : 0), NP = (PH_NSAP ? 1024 : 0), NS = (PH_NSAS ? 128 : 0), NR = (PH_RSCAN ? 32 : 0);
            for (;;) {
                if (Fp.tid == 0) *qslot = (int)__hip_atomic_fetch_add(qhead, 1u, __ATOMIC_RELAXED, __HIP_MEMORY_SCOPE_AGENT);
                __syncthreads();
                int it = *qslot;
                __syncthreads();
                it = __builtin_amdgcn_readfirstlane(it);
                if (it >= NQ + NP + NS + NR) break;
                if (it < NQ) gdn_scan_chain(Fp, layer, it);
                else if (it < NQ + NP) { const int r = it - NQ; nsa_prompt_unit(Fp, layer, ((r & 3) << 8) | (255 - (r >> 2))); }
                else if (it < NQ + NP + NS) nsa_sample_unit(Fp, layer, it - NQ - NP);
                else ret_scan_part(Fp, layer, it - NQ - NP - NS);
            }
        }
        GRID_BAR();
        for (int rp_ = 0; rp_ < PH_B2; ++rp_) {
        { Frame Fp = fresh(F); for (int u = Fp.bid; u < 512; u += Fp.G) ret_out_unit(Fp, layer, u); }
        { Frame Fp = fresh(F); for (int r = Fp.bid * NWAVES + Fp.wave; r < MROWS; r += Fp.G * NWAVES) gdn_out_row(Fp, layer, r); }
        }
        GRID_BAR();
        for (int rp_ = 0; rp_ < PH_C; ++rp_) {
        {
            const Frame Fg = fresh(F); const int G = Fg.G, bid = Fg.bid;
            unsigned char* ws = KWS();
            pg8::Gemm g{(const bf16*)(ws + WS_MIX), (const bf16*)(ws + WS_WBR + layer * SZ_WBR), MROWS, 3072, 512, 1536, 512, 2, 1024};
            pg8::StaticOrder S; S.init(MROWS, 3072, G, bid);
            epi::EpiC E{(const bf16*)(ws + WS_Z), (bf16*)(ws + WS_GATED)};
            pg8::gemm_phase<epi::EpiC, pg8::StaticOrder, true, true>(Fg.lds, g, S, E, Fg.tid);
        }
        }
        GRID_BAR();
#if PH_D
        {
            const Frame Fg = fresh(F); const int G = Fg.G, bid = Fg.bid;
            unsigned char* ws = KWS();
            pg8::Gemm g{(const bf16*)(ws + WS_GATED), (const bf16*)(ws + WS_WO3 + layer * SZ_WO3), MROWS, DM, 3072, 3072, 3072, 31, 0};
            pg8::StaticOrder S; S.init(MROWS, DM, G, bid);
            epi::EpiRes E{(float*)(ws + WS_XR), (bf16*)(ws + WS_XGB), KIN(21) + layer * DM, (float*)(ws + WS_SSB), nullptr, 0};
            pg8::gemm_phase<epi::EpiRes, pg8::StaticOrder, true, true>(Fg.lds, g, S, E, Fg.tid);
        }
#endif
        GRID_BAR();
        for (int rp_ = 0; rp_ < PH_E; ++rp_) {
        {
            const Frame Fg = fresh(F); const int G = Fg.G, bid = Fg.bid;
            unsigned char* ws = KWS();
            pg8::Gemm g{(const bf16*)(ws + WS_XGB), (const bf16*)(ws + WS_WUP + layer * SZ_WUP), MROWS, DFF, DM, DM, DM, 31, 0};
            pg8::StaticOrder S; S.init(MROWS, DFF, G, bid);
            epi::EpiUp E{(bf16*)(ws + WS_HMID), (const float*)(ws + WS_SSB)};
            pg8::gemm_phase<epi::EpiUp, pg8::StaticOrder, true, true>(Fg.lds, g, S, E, Fg.tid);
        }
        }
        GRID_BAR();
#if PH_F
        {
            const Frame Fg = fresh(F); const int G = Fg.G, bid = Fg.bid;
            unsigned char* ws = KWS();
            pg8::Gemm g{(const bf16*)(ws + WS_HMID), (const bf16*)(ws + WS_WDN + layer * SZ_WDN), MROWS, DM, DFF, DFF, DFF, 31, 0};
            pg8::StaticOrder S; S.init(MROWS, DM, G, bid);
            epi::EpiRes E{(float*)(ws + WS_XR), (bf16*)(ws + WS_XGC), nullptr, nullptr, nullptr, 0};
            pg8::gemm_phase<epi::EpiRes, pg8::StaticOrder, true, true>(Fg.lds, g, S, E, Fg.tid);
        }
#endif
        GRID_BAR();
        for (int rp_ = 0; rp_ < PH_G1; ++rp_) {
        {
            const Frame Fg = fresh(F); const int G = Fg.G, bid = Fg.bid;
            unsigned char* ws = KWS();
            int kple = PLE; asm volatile("" : "+s"(kple));
            pg8::Gemm g{(const bf16*)(ws + WS_P16) + (size_t)layer * MROWS * PLE, (const bf16*)(ws + WS_WPL + layer * SZ_WPL), MROWS, DM, kple, PLE, PLE, 31, 0};
            pg8::StaticOrder S; S.init(MROWS, DM, G, bid);
            epi::EpiRes E{nullptr, nullptr, nullptr, nullptr, (float*)(ws + WS_TPLE), 1};
            pg8::gemm_phase<epi::EpiRes, pg8::StaticOrder, true, true>(Fg.lds, g, S, E, Fg.tid);
        }
        }
#if PH_G2
        {
            const Frame Fg = fresh(F); const int G = Fg.G, bid = Fg.bid;
            unsigned char* ws = KWS();
            const bool more = layer + 1 < NLAYER;
            pg8::Gemm g{(const bf16*)(ws + WS_XGC), (const bf16*)(ws + WS_WPG + layer * SZ_WPG), MROWS, DM, DM, DM, DM, 31, 0};
            pg8::StaticOrder S; S.init(MROWS, DM, G, bid);
            epi::EpiRes E{(float*)(ws + WS_XR), more ? (bf16*)(ws + WS_XGA) : nullptr, more ? KIN(10) + (layer + 1) * DM : nullptr, more ? (float*)(ws + WS_SSA) : nullptr, (float*)(ws + WS_TPLE), 2};
            pg8::gemm_phase<epi::EpiRes, pg8::StaticOrder, true, true>(Fg.lds, g, S, E, Fg.tid);
        }
#endif
        GRID_BAR();
    }
    { Frame Fp = fresh(F); for (int r = Fp.bid * NWAVES + Fp.wave; r < MROWS; r += Fp.G * NWAVES) final_row(Fp, r); }
}

extern "C" void kernel_launch(void* const* d_in, const int* in_sizes, int n_in, void* d_out, int out_size, void* d_ws, size_t ws_size, hipStream_t stream) {
    static int grid = 0;
    if (grid == 0) {
        if (n_in != 27 || ws_size < WS_END) { fprintf(stderr, "kernel_launch: unexpected shapes (n_in %d out %d ws %zu, need %zu)\n", n_in, out_size, ws_size, (size_t)WS_END); grid = -1; return; }
        int dev = 0, cus = 0;
        if (hipGetDevice(&dev) != hipSuccess || hipDeviceGetAttribute(&cus, hipDeviceAttributeMultiprocessorCount, dev) != hipSuccess) { grid = -1; return; }
        if (hipFuncSetAttribute((const void*)mk_fwd, hipFuncAttributeMaxDynamicSharedMemorySize, LDS_BYTES) != hipSuccess) { fprintf(stderr, "kernel_launch: hipFuncSetAttribute failed\n"); grid = -1; return; }
        int per_cu = 0;
        if (hipOccupancyMaxActiveBlocksPerMultiprocessor(&per_cu, (const void*)mk_fwd, NTHREADS, LDS_BYTES) != hipSuccess || per_cu < 1) fprintf(stderr, "kernel_launch: occupancy query reports %d\n", per_cu);
        (void)hipGetLastError();
        grid = cus;
    }
    if (grid < 0) return;
    if (hipMemsetAsync((char*)d_ws + WS_CTL, 0, CTL_ZERO_BYTES, stream) != hipSuccess) return;
    Args a{};
    for (int i = 0; i < 27; ++i) a.in[i] = d_in[i];
    a.out = (float*)d_out; a.ws = (unsigned char*)d_ws;
    hipLaunchKernelGGL(mk_fwd, dim3(grid), dim3(NTHREADS), LDS_BYTES, stream, a);
}
```

```cpp
#include <hip/hip_runtime.h>
#include <cstdio>
#include <cstdint>
namespace pg8 {
#define PG8_LAS __attribute__((address_space(3)))
typedef unsigned short bf16_t;
typedef short bf16x8 __attribute__((ext_vector_type(8)));
typedef float f32x4 __attribute__((ext_vector_type(4)));
typedef unsigned u32x4 __attribute__((ext_vector_type(4)));
constexpr int BM = 256, BK = 64, HALF = 128, HTB = HALF * BK * 2  , STAGE_BYTES = 8 * HTB, NXCD = 8, WGM = 8;

__host__ __device__ __forceinline__ int lds_byte(int r, int c) { const int st = (r >> 4) * 2 + (c >> 5), rr = r & 15, cc = c & 31, ob = rr * 64 + cc * 2; return st * 1024 + (ob ^ (((ob >> 9) & 1) << 5)); }
__host__ __device__ __forceinline__ void stage_rc(int b, int& R, int& C) { const int st = b / 1024, sb = b % 1024, swz = sb ^ (((sb >> 9) & 1) << 5); R = (st >> 1) * 16 + swz / 64; C = (st & 1) * 32 + (swz % 64) / 2; }
__host__ __device__ __forceinline__ int perm32(int rho) { const int n = rho >> 4, i = rho & 15; return 8 * (i >> 2) + 4 * n + (i & 3); }

struct Unit { int pm, pn; };
struct Gemm { const bf16_t* A; const bf16_t* Bt; int M, N, K; int lda, ldb; int a_shift, a_off; };

struct StaticOrder {
    int nM, nN, nwg, G, c;
    __host__ __device__ void init(int M, int N, int G_, int c_) { nM = M / BM; nN = N / BM; nwg = nM * nN; G = G_; c = c_; }
    __host__ __device__ bool next(int i, Unit& u) const {
        const long L = (long)i * G + c; if (L >= nwg) return false;
        int wgid = (int)L; { const int q = nwg / NXCD, r = nwg % NXCD, xcd = wgid % NXCD, off = wgid / NXCD; wgid = (xcd < r ? xcd * (q + 1) : r * (q + 1) + (xcd - r) * q) + off; }
        const int nig = WGM * nN, gid = wgid / nig, fm = gid * WGM, gsz = (nM - fm) < WGM ? (nM - fm) : WGM;
        u.pm = fm + ((wgid % nig) % gsz); u.pn = (wgid % nig) / gsz; return true;
    }
    __device__ __forceinline__ void a_ready(const Unit&) const {}
    __device__ __forceinline__ void done(const Unit&) const {}
};

__device__ __forceinline__ unsigned cvt_pk_bf16(float lo, float hi) { unsigned r; asm volatile("v_cvt_pk_bf16_f32 %0, %1, %2" : "=v"(r) : "v"(lo), "v"(hi)); return r; }
typedef float f32x2 __attribute__((ext_vector_type(2)));
template <class Epi, class Sched, bool ALIGN_EPI = false, bool SP2 = false>
__device__ __forceinline__ void gemm_phase(PG8_LAS unsigned char* lds, const Gemm g, const Sched& S, const Epi& E, const int tid) {
    const int wid = __builtin_amdgcn_readfirstlane(tid >> 6), lane = tid & 63, wr = wid >> 2, wc = wid & 3, fr = lane & 15, fq = lane >> 4;
    const int K = g.K, nt = K / BK;
    unsigned voffA[2], voffB[2];
#pragma unroll
    for (int i = 0; i < 2; ++i) { int R, C; stage_rc(tid * 16 + i * 8192, R, C); const int Rb = Epi::PERM ? ((R & ~31) + perm32(R & 31)) : R;
        voffA[i] = (unsigned)(R * g.lda + C) * 2u; voffB[i] = (unsigned)(Rb * g.ldb + C) * 2u; }
    const size_t kstep = (size_t)(BK * 2);
    const size_t hstepA = (size_t)HALF * g.lda * 2, hstepB = (size_t)HALF * g.ldb * 2;
    const size_t tstepA = 2 * hstepA, tstepB = 2 * hstepB;
    const unsigned ldsw = (unsigned)wid * 1024u;
    const int aoff = lds_byte(wr * 64 + fr, fq * 8), boff = lds_byte(wc * 32 + fr, fq * 8);
#define PG8_SA(b, h) (((b) * 2 + (h)) * HTB)
#define PG8_SB(b, h) ((4 + (b) * 2 + (h)) * HTB)
#define PG8_STAGE(bufoff, gbase, voff) do { _Pragma("unroll") for (int _i = 0; _i < 2; ++_i) \
        __builtin_amdgcn_global_load_lds((const unsigned*)((const char*)(gbase) + (voff)[_i]), (PG8_LAS unsigned*)(lds + (bufoff) + ldsw + _i * 8192), 16, 0, 0); } while (0)
#define PG8_LDA(dst, b, h) do { _Pragma("unroll") for (int m = 0; m < 4; ++m) _Pragma("unroll") for (int k = 0; k < 2; ++k) dst[m][k] = *(const PG8_LAS bf16x8*)(lds + PG8_SA(b, h) + aoff + m * 2048 + k * 1024); } while (0)
#define PG8_LDB(dst, b, h) do { _Pragma("unroll") for (int n = 0; n < 2; ++n) _Pragma("unroll") for (int k = 0; k < 2; ++k) dst[n][k] = *(const PG8_LAS bf16x8*)(lds + PG8_SB(b, h) + boff + n * 2048 + k * 1024); } while (0)
#define PG8_MMA(ai, bj, At, Bt) do { __builtin_amdgcn_s_setprio(1); _Pragma("unroll") for (int m = 0; m < 4; ++m) _Pragma("unroll") for (int n = 0; n < 2; ++n) _Pragma("unroll") for (int k = 0; k < 2; ++k) \
        acc[ai][bj][m][n] = __builtin_amdgcn_mfma_f32_16x16x32_bf16(Bt[n][k], At[m][k], acc[ai][bj][m][n], 0, 0, 0); __builtin_amdgcn_s_setprio(0); } while (0)
#define PG8_WAIT_V(n) asm volatile("s_waitcnt vmcnt(" #n ")" ::: "memory")
#define PG8_WAIT_L(n) asm volatile("s_waitcnt lgkmcnt(" #n ")" ::: "memory")
#define PG8_BAR __builtin_amdgcn_s_barrier()
#define PG8_SCHED __builtin_amdgcn_sched_barrier(0)
    Unit cur, nxt; int ui = 0;
    if (!S.next(0, cur)) return;
    f32x4 acc[2][2][4][2];
#pragma unroll
    for (int a = 0; a < 2; ++a)
#pragma unroll
        for (int b = 0; b < 2; ++b)
#pragma unroll
            for (int m = 0; m < 4; ++m)
#pragma unroll
                for (int n = 0; n < 2; ++n) acc[a][b][m][n] = (f32x4){0.f, 0.f, 0.f, 0.f};
    bf16x8 At[4][2], B0[2][2], B1[2][2];
    const char* cA = (const char*)g.A + (size_t)cur.pm * tstepA + (size_t)(cur.pn >> g.a_shift) * (size_t)g.a_off; const char* cB = (const char*)g.Bt + (size_t)cur.pn * tstepB;
    S.a_ready(cur);
    if constexpr (SP2) {
        PG8_STAGE(PG8_SB(0, 0), cB, voffB); PG8_STAGE(PG8_SB(0, 1), cB + hstepB, voffB); PG8_STAGE(PG8_SA(0, 0), cA, voffA); PG8_STAGE(PG8_SA(0, 1), cA + hstepA, voffA);
        if (wr == 1) PG8_BAR;
        PG8_WAIT_V(2); PG8_BAR;
        PG8_STAGE(PG8_SB(1, 0), cB + kstep, voffB); PG8_STAGE(PG8_SA(1, 0), cA + kstep, voffA); PG8_STAGE(PG8_SB(1, 1), cB + hstepB + kstep, voffB);
        PG8_WAIT_V(6); PG8_BAR;
    } else {
        PG8_STAGE(PG8_SB(0, 0), cB, voffB); PG8_STAGE(PG8_SA(0, 0), cA, voffA); PG8_STAGE(PG8_SB(0, 1), cB + hstepB, voffB); PG8_STAGE(PG8_SA(0, 1), cA + hstepA, voffA);
        if (wr == 1) PG8_BAR;
        PG8_WAIT_V(4); PG8_BAR;
        PG8_STAGE(PG8_SB(1, 0), cB + kstep, voffB); PG8_STAGE(PG8_SA(1, 0), cA + kstep, voffA); PG8_STAGE(PG8_SB(1, 1), cB + hstepB + kstep, voffB);
        PG8_WAIT_V(6); PG8_BAR;
    }
    for (;;) {
        const bool has_next = S.next(ui + 1, nxt);
        const char* nA = has_next ? (const char*)g.A + (size_t)nxt.pm * tstepA + (size_t)(nxt.pn >> g.a_shift) * (size_t)g.a_off : cA; const char* nB = has_next ? (const char*)g.Bt + (size_t)nxt.pn * tstepB : cB;
        for (int t = 0; t < nt; t += 2) {
            const bool last = (t == nt - 2);
            const char* a1 = cA + (size_t)(t + 1) * kstep;
            const char* a2 = last ? nA : cA + (size_t)(t + 2) * kstep; const char* b2 = last ? nB : cB + (size_t)(t + 2) * kstep;
            const char* a3 = a2 + kstep; const char* b3 = b2 + kstep;
            if (last && has_next) S.a_ready(nxt);
            if constexpr (SP2) {
            PG8_LDB(B0, 0, 0); PG8_LDB(B1, 0, 1); PG8_SCHED; PG8_LDA(At, 0, 0); PG8_STAGE(PG8_SA(1, 1), a1 + hstepA, voffA);
            PG8_WAIT_V(8); PG8_WAIT_L(0); PG8_BAR; PG8_MMA(0, 0, At, B0); PG8_MMA(0, 1, At, B1); PG8_BAR; PG8_SCHED;
            PG8_LDA(At, 0, 1); PG8_STAGE(PG8_SB(0, 0), b2, voffB); PG8_STAGE(PG8_SB(0, 1), b2 + hstepB, voffB); PG8_STAGE(PG8_SA(0, 0), a2, voffA);
            PG8_WAIT_V(8); PG8_WAIT_L(0); PG8_BAR; PG8_MMA(1, 0, At, B0); PG8_MMA(1, 1, At, B1); PG8_BAR; PG8_SCHED;
            PG8_LDB(B0, 1, 0); PG8_LDB(B1, 1, 1); PG8_SCHED; PG8_LDA(At, 1, 0); PG8_STAGE(PG8_SA(0, 1), a2 + hstepA, voffA);
            PG8_WAIT_V(8); PG8_WAIT_L(0); PG8_BAR; PG8_MMA(0, 0, At, B0); PG8_MMA(0, 1, At, B1); PG8_BAR; PG8_SCHED;
            PG8_LDA(At, 1, 1); PG8_STAGE(PG8_SB(1, 0), b3, voffB); PG8_STAGE(PG8_SB(1, 1), b3 + hstepB, voffB); PG8_STAGE(PG8_SA(1, 0), a3, voffA);
            PG8_WAIT_V(8); PG8_WAIT_L(0); PG8_BAR; PG8_MMA(1, 0, At, B0); PG8_MMA(1, 1, At, B1); PG8_BAR; PG8_SCHED;
            } else {
            PG8_LDB(B0, 0, 0); PG8_SCHED; PG8_LDA(At, 0, 0); PG8_STAGE(PG8_SA(1, 1), a1 + hstepA, voffA);
            PG8_WAIT_L(8); PG8_BAR; PG8_WAIT_L(0); PG8_MMA(0, 0, At, B0); PG8_BAR; PG8_SCHED;
            PG8_LDB(B1, 0, 1); PG8_STAGE(PG8_SB(0, 0), b2, voffB);
            PG8_BAR; PG8_WAIT_L(0); PG8_MMA(0, 1, At, B1); PG8_BAR;
            PG8_LDA(At, 0, 1); PG8_STAGE(PG8_SA(0, 0), a2, voffA);
            PG8_BAR; PG8_WAIT_L(0); PG8_MMA(1, 0, At, B0); PG8_BAR; PG8_SCHED;
            PG8_STAGE(PG8_SB(0, 1), b2 + hstepB, voffB);
            PG8_WAIT_V(6); PG8_BAR; PG8_MMA(1, 1, At, B1); PG8_BAR;
            PG8_LDB(B0, 1, 0); PG8_SCHED; PG8_LDA(At, 1, 0); PG8_STAGE(PG8_SA(0, 1), a2 + hstepA, voffA);
            PG8_WAIT_L(8); PG8_BAR; PG8_WAIT_L(0); PG8_MMA(0, 0, At, B0); PG8_BAR; PG8_SCHED;
            PG8_LDB(B1, 1, 1); PG8_STAGE(PG8_SB(1, 0), b3, voffB);
            PG8_BAR; PG8_WAIT_L(0); PG8_MMA(0, 1, At, B1); PG8_BAR;
            PG8_LDA(At, 1, 1); PG8_STAGE(PG8_SA(1, 0), a3, voffA);
            PG8_BAR; PG8_WAIT_L(0); PG8_MMA(1, 0, At, B0); PG8_BAR; PG8_SCHED;
            PG8_STAGE(PG8_SB(1, 1), b3 + hstepB, voffB);
            PG8_WAIT_V(6); PG8_BAR; PG8_MMA(1, 1, At, B1); PG8_BAR;
            }
        }
        if constexpr (ALIGN_EPI) { if (wr == 0) PG8_BAR; }
        if constexpr (!Epi::AFTER_DRAIN) { E(acc, cur, wr, wc, fr, fq); S.done(cur); }
        if (!has_next) break;
#pragma unroll
        for (int a = 0; a < 2; ++a)
#pragma unroll
            for (int b = 0; b < 2; ++b)
#pragma unroll
                for (int m = 0; m < 4; ++m)
#pragma unroll
                    for (int n = 0; n < 2; ++n) acc[a][b][m][n] = (f32x4){0.f, 0.f, 0.f, 0.f};
        cur = nxt; cA = nA; cB = nB; ++ui;
        if constexpr (ALIGN_EPI) { if (wr == 1) PG8_BAR; }
    }
    PG8_WAIT_V(0);
    if constexpr (!ALIGN_EPI) { if (wr == 0) PG8_BAR; }
    PG8_BAR;
    if constexpr (Epi::AFTER_DRAIN) { E.fused(acc, cur, wr, wc, fr, fq, lds, wid, lane); S.done(cur); }
#undef PG8_SA
#undef PG8_SB
#undef PG8_STAGE
#undef PG8_LDA
#undef PG8_LDB
#undef PG8_MMA
#undef PG8_WAIT_V
#undef PG8_WAIT_L
#undef PG8_BAR
#undef PG8_SCHED
}
}
#define DI __device__ __forceinline__
#define GAS __attribute__((address_space(1)))
#define LAS __attribute__((address_space(3)))
typedef unsigned short bf16;
typedef unsigned v4u __attribute__((ext_vector_type(4)));
typedef unsigned v2u __attribute__((ext_vector_type(2)));
typedef float f32x4 __attribute__((ext_vector_type(4)));
typedef float f32x2 __attribute__((ext_vector_type(2)));
typedef short bf16x8 __attribute__((ext_vector_type(8)));
typedef short s16x4 __attribute__((ext_vector_type(4)));
typedef GAS unsigned gu32;

constexpr int DM = 1024, TP = 8192, MP = 16384, MS = 512, MROWS = 16896, LDZ = 8704, DFF = 4096, PLE = 256, NLAYER = 2;
constexpr int ZC_Q = 0, ZC_KC = 512, ZC_VC = 640, ZC_KS = 768, ZC_VS = 896, ZC_KW = 1024, ZC_VW = 1152, ZC_GQKV = 1280, ZC_GZ = 2816, ZC_RQKV = 3328, ZC_RG = 4864, ZC_MG = 5376, ZC_SM = 8448;
constexpr float EPS = 1e-6f;
constexpr size_t O_YP = 0, O_YS = O_YP + (size_t)MP * DM, O_KVP = O_YS + (size_t)MS * DM, O_KVS = O_KVP + (size_t)2 * MP * 512, O_WINP = O_KVS + (size_t)2 * MS * 512,
                 O_WINS = O_WINP + (size_t)2 * 2 * 512 * 256, O_CVP = O_WINS + (size_t)2 * 128 * 512 * 256, O_CVS = O_CVP + (size_t)2 * 2 * 3 * 1536, O_GSP = O_CVS + (size_t)2 * 128 * 3 * 1536,
                 O_GSS = O_GSP + (size_t)2 * 2 * 4 * 16384, O_RSP = O_GSS + (size_t)2 * 128 * 4 * 16384, O_RSS = O_RSP + (size_t)2 * 2 * 4 * 16384, O_END = O_RSS + (size_t)2 * 128 * 4 * 16384;

DI float bf2f(unsigned short b) { return __uint_as_float((unsigned)b << 16); }
DI unsigned f2bf(float f) { unsigned u = __float_as_uint(f); return (u + 0x7fffu + ((u >> 16) & 1u)) >> 16; }
typedef __bf16 bf16x2_t __attribute__((ext_vector_type(2)));
DI unsigned pk2(float lo, float hi) { const f32x2 v = {lo, hi}; return __builtin_bit_cast(unsigned, __builtin_convertvector(v, bf16x2_t)); }
DI float lo_bf(unsigned w) { return __uint_as_float(w << 16); }
DI float hi_bf(unsigned w) { return __uint_as_float(w & 0xffff0000u); }
DI float sigmoidf_(float x) { return 1.f / (1.f + __expf(-x)); }
DI float siluf_(float x) { return x / (1.f + __expf(-x)); }
DI v4u pack8(const f32x4 a, const f32x4 b) { v4u w; w.x = pk2(a[0], a[1]); w.y = pk2(a[2], a[3]); w.z = pk2(b[0], b[1]); w.w = pk2(b[2], b[3]); return w; }
DI void unpack8(const v4u w, f32x4& a, f32x4& b) { a[0] = lo_bf(w.x); a[1] = hi_bf(w.x); a[2] = lo_bf(w.y); a[3] = hi_bf(w.y); b[0] = lo_bf(w.z); b[1] = hi_bf(w.z); b[2] = lo_bf(w.w); b[3] = hi_bf(w.w); }

template <int M> DI int shxi(int v, int lane) {
    if constexpr (M < 32) return __builtin_amdgcn_ds_swizzle(v, (M << 10) | 0x1f);
    else return __builtin_amdgcn_ds_bpermute((lane ^ 32) << 2, v);
}
template <int M> DI float shx(float v, int lane) { return __int_as_float(shxi<M>(__float_as_int(v), lane)); }
DI float wave_sum(float v, int lane) { v += shx<1>(v, lane); v += shx<2>(v, lane); v += shx<4>(v, lane); v += shx<8>(v, lane); v += shx<16>(v, lane); v += shx<32>(v, lane); return v; }

namespace epi {
using pg8::Unit; using pg8::bf16_t;
DI float row_rstd(const float* SS, int row, int fq, int lane) {
    const f32x4 p = *(const f32x4*)(SS + (size_t)row * 16 + 4 * fq);
    float s = (p[0] + p[1]) + (p[2] + p[3]); s += shx<16>(s, lane); s += shx<32>(s, lane);
    return rsqrtf(s * (1.f / DM) + EPS);
}
struct EpiA {
    static constexpr bool PERM = true, AFTER_DRAIN = false;
    bf16* Z; float* ZS; const float* SS; float* out; int layer;
    DI void operator()(const f32x4 (&acc)[2][2][4][2], const Unit& u, int wr, int wc, int fr, int fq) const {
        asm volatile("" : "+v"(fr), "+v"(fq), "+s"(wr), "+s"(wc));
        const int pn = u.pn;
#pragma unroll
        for (int ai = 0; ai < 2; ++ai)
#pragma unroll
            for (int m = 0; m < 4; ++m) {
                const int row = u.pm * 256 + ai * 128 + wr * 64 + m * 16 + fr;
                const float rstd = row_rstd(SS, row, fq, fr + 16 * fq);
#pragma unroll
                for (int bj = 0; bj < 2; ++bj) {
                    const int col = pn * 256 + bj * 128 + wc * 32 + 8 * fq;
                    const f32x4 v0 = acc[ai][bj][m][0] * rstd, v1 = acc[ai][bj][m][1] * rstd;
                    *(v4u*)(Z + (size_t)row * LDZ + col) = pack8(v0, v1);
                    float* dst = nullptr;
                    if (pn == 2 || pn == 3) {
                        dst = (row < MP) ? out + O_KVP + ((size_t)layer * MP + row) * 512 + (col - 512) : out + O_KVS + ((size_t)layer * MS + (row - MP)) * 512 + (col - 512);
                    } else if (pn == 4) {
                        const int c2 = col - 1024;
                        if (row < MP) { const int t = row & (TP - 1), b = row >> 13; if (t >= TP - 512) dst = out + O_WINP + ((size_t)(layer * 2 + b) * 512 + (t - (TP - 512))) * 256 + c2; }
                        else { const int r2 = row - MP, s = r2 >> 2, j = r2 & 3; dst = out + O_WINS + ((size_t)(layer * 128 + s) * 512 + 508 + j) * 256 + c2; }
                    } else if (pn >= 5 && pn < 11) {
                        const int c2 = col - 1280;
                        if (row < MP) { const int t = row & (TP - 1), b = row >> 13; if (t >= TP - 3) dst = out + O_CVP + ((size_t)(layer * 2 + b) * 3 + (t - (TP - 3))) * 1536 + c2; }
                        else { const int r2 = row - MP, s = r2 >> 2, j = r2 & 3; if (j >= 1) dst = out + O_CVS + ((size_t)(layer * 128 + s) * 3 + (j - 1)) * 1536 + c2; }
                    } else if (pn == 33) {
                        if (bj == 0 && wc == 0) dst = ZS + (size_t)row * 32 + 8 * fq;
                    }
                    if (dst) { *(f32x4*)dst = v0; *(f32x4*)(dst + 4) = v1; }
                }
                asm volatile("" ::: "memory");
            }
    }
};
struct EpiC {
    static constexpr bool PERM = true, AFTER_DRAIN = false;
    const bf16* Z; bf16* G;
    DI void operator()(const f32x4 (&acc)[2][2][4][2], const Unit& u, int wr, int wc, int fr, int fq) const {
        asm volatile("" : "+v"(fr), "+v"(fq), "+s"(wr), "+s"(wc));
#pragma unroll
        for (int ai = 0; ai < 2; ++ai)
#pragma unroll
            for (int m = 0; m < 4; ++m) {
                const int row = u.pm * 256 + ai * 128 + wr * 64 + m * 16 + fr;
#pragma unroll
                for (int bj = 0; bj < 2; ++bj) {
                    const int col = u.pn * 256 + bj * 128 + wc * 32 + 8 * fq;
                    const v4u gw = *(const v4u*)(Z + (size_t)row * LDZ + ZC_MG + col);
                    f32x4 g0, g1; unpack8(gw, g0, g1);
                    f32x4 v0 = acc[ai][bj][m][0], v1 = acc[ai][bj][m][1];
#pragma unroll
                    for (int e = 0; e < 4; ++e) { v0[e] *= sigmoidf_(g0[e]); v1[e] *= sigmoidf_(g1[e]); }
                    *(v4u*)(G + (size_t)row * 3072 + col) = pack8(v0, v1);
                }
                asm volatile("" ::: "memory");
            }
    }
};
struct EpiRes {
    static constexpr bool PERM = true, AFTER_DRAIN = false;
    float* XR; bf16* XG; const float* gvec; float* SS; float* T; int mode;
    DI void operator()(const f32x4 (&acc)[2][2][4][2], const Unit& u, int wr, int wc, int fr, int fq) const {
        asm volatile("" : "+v"(fr), "+v"(fq), "+s"(wr), "+s"(wc));
#pragma unroll
        for (int ai = 0; ai < 2; ++ai)
#pragma unroll
            for (int m = 0; m < 4; ++m) {
                const int row = u.pm * 256 + ai * 128 + wr * 64 + m * 16 + fr;
                float ssq = 0.f;
#pragma unroll
                for (int bj = 0; bj < 2; ++bj) {
                    const int col = u.pn * 256 + bj * 128 + wc * 32 + 8 * fq;
                    const size_t o = (size_t)row * DM + col;
                    f32x4 a0 = acc[ai][bj][m][0], a1 = acc[ai][bj][m][1];
                    if (mode == 1) { *(f32x4*)(T + o) = a0; *(f32x4*)(T + o + 4) = a1; continue; }
                    f32x4 x0 = *(const f32x4*)(XR + o), x1 = *(const f32x4*)(XR + o + 4);
                    if (mode == 2) { const f32x4 t0 = *(const f32x4*)(T + o), t1 = *(const f32x4*)(T + o + 4);
#pragma unroll
                        for (int e = 0; e < 4; ++e) { a0[e] = t0[e] * sigmoidf_(a0[e]); a1[e] = t1[e] * sigmoidf_(a1[e]); } }
                    x0 += a0; x1 += a1;
                    *(f32x4*)(XR + o) = x0; *(f32x4*)(XR + o + 4) = x1;
                    ssq += (x0[0] * x0[0] + x0[1] * x0[1]) + (x0[2] * x0[2] + x0[3] * x0[3]) + (x1[0] * x1[0] + x1[1] * x1[1]) + (x1[2] * x1[2] + x1[3] * x1[3]);
                    if (XG) { if (gvec) { const f32x4 g0 = *(const f32x4*)(gvec + col), g1 = *(const f32x4*)(gvec + col + 4); x0 *= g0; x1 *= g1; }
                        *(v4u*)(XG + o) = pack8(x0, x1); }
                }
                if (SS) { ssq += shx<16>(ssq, fr + 16 * fq); ssq += shx<32>(ssq, fr + 16 * fq); if (fq == 0) SS[(size_t)row * 16 + u.pn * 4 + wc] = ssq; }
                asm volatile("" ::: "memory");
            }
    }
};
struct EpiUp {
    static constexpr bool PERM = true, AFTER_DRAIN = false;
    bf16* H; const float* SS;
    DI void operator()(const f32x4 (&acc)[2][2][4][2], const Unit& u, int wr, int wc, int fr, int fq) const {
        asm volatile("" : "+v"(fr), "+v"(fq), "+s"(wr), "+s"(wc));
#pragma unroll
        for (int ai = 0; ai < 2; ++ai)
#pragma unroll
            for (int m = 0; m < 4; ++m) {
                const int row = u.pm * 256 + ai * 128 + wr * 64 + m * 16 + fr;
                const float rstd = row_rstd(SS, row, fq, fr + 16 * fq);
#pragma unroll
                for (int bj = 0; bj < 2; ++bj) {
                    const int col = u.pn * 256 + bj * 128 + wc * 32 + 8 * fq;
                    f32x4 v0 = acc[ai][bj][m][0] * rstd, v1 = acc[ai][bj][m][1] * rstd;
#pragma unroll
                    for (int e = 0; e < 4; ++e) { const float a = fmaxf(v0[e], 0.f), b = fmaxf(v1[e], 0.f); v0[e] = a * a; v1[e] = b * b; }
                    *(v4u*)(H + (size_t)row * DFF + col) = pack8(v0, v1);
                }
                asm volatile("" ::: "memory");
            }
    }
};
}
constexpr size_t al256(size_t x) { return (x + 255) & ~(size_t)255; }
constexpr size_t WS_CTL = 0, CTL_ZERO_BYTES = 1u << 20;
constexpr size_t SZ_WIN = (size_t)LDZ * DM * 2, SZ_WBR = (size_t)3072 * 512 * 2, SZ_WO3 = (size_t)DM * 3072 * 2, SZ_WUP = (size_t)DFF * DM * 2, SZ_WDN = (size_t)DM * DFF * 2,
                 SZ_WPL = (size_t)DM * PLE * 2, SZ_WPG = (size_t)DM * DM * 2, SZ_W1T = (size_t)2 * 64 * 2048 * 2, SZ_W2T = (size_t)2 * 64 * 64 * 2;
constexpr size_t WS_WIN = CTL_ZERO_BYTES, WS_WBR = WS_WIN + 2 * SZ_WIN, WS_WO3 = WS_WBR + 2 * SZ_WBR, WS_WUP = WS_WO3 + 2 * SZ_WO3, WS_WDN = WS_WUP + 2 * SZ_WUP,
                 WS_WPL = WS_WDN + 2 * SZ_WDN, WS_WPG = WS_WPL + 2 * SZ_WPL, WS_W1T = WS_WPG + 2 * SZ_WPG, WS_W2T = WS_W1T + 2 * SZ_W1T, WS_ROT = al256(WS_W2T + 2 * SZ_W2T);
constexpr size_t WS_P16 = WS_ROT + (size_t)TP * 64 * 8;
constexpr size_t WS_XR = WS_P16 + (size_t)2 * MROWS * PLE * 2;
constexpr size_t WS_XGA = WS_XR + (size_t)MROWS * DM * 4, WS_XGB = WS_XGA + (size_t)MROWS * DM * 2, WS_XGC = WS_XGB + (size_t)MROWS * DM * 2;
constexpr size_t WS_SSA = WS_XGC + (size_t)MROWS * DM * 2, WS_SSB = WS_SSA + (size_t)MROWS * 64;
constexpr size_t WS_Z = WS_SSB + (size_t)MROWS * 64, WS_ZS = WS_Z + (size_t)MROWS * LDZ * 2;
constexpr size_t WS_MIX = WS_ZS + (size_t)MROWS * 128, WS_GATED = WS_MIX + (size_t)MROWS * 1536 * 2, WS_HMID = WS_GATED + (size_t)MROWS * 3072 * 2;
constexpr size_t WS_TPLE = WS_HMID + (size_t)MROWS * DFF * 2;
constexpr size_t WS_KC = WS_TPLE + (size_t)MROWS * DM * 4;
constexpr size_t WS_KCS = WS_KC + (size_t)2 * 2 * 512 * 2 * 64 * 2;
constexpr int GREC = 73984;
constexpr size_t WS_GREC = WS_KCS + (size_t)2 * 128 * 128 * 2 * 64 * 2;
constexpr size_t WS_OGDN = WS_GREC + (size_t)1024 * GREC;
constexpr size_t WS_RKV = WS_OGDN + (size_t)MROWS * 512 * 4;
constexpr size_t WS_RST = WS_RKV + (size_t)512 * 16384 * 4;
constexpr size_t WS_QR = WS_RST + (size_t)512 * 16384 * 2, WS_KR = WS_QR + (size_t)MP * 512 * 2;
constexpr size_t WS_END = WS_KR + (size_t)MP * 512 * 2;
static_assert(WS_W1T % 256 == 0 && WS_Z % 256 == 0 && WS_GREC % 256 == 0 && WS_RKV % 256 == 0 && WS_KC % 256 == 0 && WS_XR % 256 == 0, "ws alignment");

constexpr int CW_TMO = 0, CW_BAR = 4096, CW_QUEUE = 8192;
constexpr int NWAVES = 8, NTHREADS = 512;
constexpr int RING_BYTES = 147456, LDSCTL_OFF = RING_BYTES, MISC_OFF = LDSCTL_OFF + 320, LDS_BYTES = RING_BYTES + 1024;

#define RLX_AGENT __ATOMIC_RELAXED, __HIP_MEMORY_SCOPE_AGENT
#define LDS_WAIT() asm volatile("s_waitcnt lgkmcnt(0)" ::: "memory")
#define VM_WAIT() asm volatile("s_waitcnt vmcnt(0)" ::: "memory")
#define XB_TMO      128
#define XB_XCNT(j)  (256  + 64 * (j))
#define XB_XSUB(j)  (1280 + 64 * (j))
#define XB_XGEN(j)  (2304 + 64 * (j))
#define XB_TOP      3328
#define XB_TOPGEN   3392
#define XCD_BAR_WORDS 3456
#define XB_SPIN_CAP (1u << 18)

__device__ __forceinline__ unsigned xb_ld(unsigned* p)              { return __hip_atomic_load(p, __ATOMIC_RELAXED, __HIP_MEMORY_SCOPE_AGENT); }
__device__ __forceinline__ unsigned xb_add(unsigned* p, unsigned v) { return __hip_atomic_fetch_add(p, v, __ATOMIC_RELAXED, __HIP_MEMORY_SCOPE_AGENT); }
__device__ __forceinline__ unsigned xb_xcc_id() { return (unsigned)__builtin_amdgcn_s_getreg((3 << 11) | 20) & 0xFu; }
#define XB_SPIN(cond, bar) do { unsigned _sp = 0; while (cond) { __builtin_amdgcn_s_sleep(1); \
    if ((++_sp & 255u) == 0u) { if (xb_ld(&(bar)[XB_TMO])) break; if (_sp > XB_SPIN_CAP) { atomicAdd(&(bar)[XB_TMO], 1u); break; } } } } while (0)

struct XcdBarrier {
    unsigned* bar; unsigned x;
    volatile LAS unsigned* st;
};

__device__ __forceinline__ XcdBarrier xcd_barrier_post(unsigned* bar, volatile LAS unsigned* st, bool t0) {
    XcdBarrier b; b.bar = bar; b.x = xb_xcc_id(); b.st = st;
    if (t0) (void)xb_add(&bar[XB_XCNT(b.x)], 1u);
    return b;
}
__device__ __forceinline__ void xcd_barrier_complete(unsigned* bar, unsigned x, unsigned& nloc, unsigned& nx) {
    const unsigned G = gridDim.x * gridDim.y * gridDim.z;
    unsigned sum, cnt, mine, sp = 0u;
    for (;;) {
        sum = 0u; cnt = 0u; mine = 0u;
#pragma unroll
        for (unsigned j = 0; j < 16; ++j) { const unsigned c = xb_ld(&bar[XB_XCNT(j)]); sum += c; cnt += (c > 0u) ? 1u : 0u; mine = (j == x) ? c : mine; }
        if (sum == G) break;
        __builtin_amdgcn_s_sleep(1);
        if ((++sp & 255u) == 0u) { if (xb_ld(&bar[XB_TMO])) break; if (sp > XB_SPIN_CAP) { atomicAdd(&bar[XB_TMO], 1u); break; } }
    }
    nloc = mine > 0u ? mine : 1u; nx = cnt > 0u ? cnt : 1u;
}

__device__ __forceinline__ void xcd_barrier(const XcdBarrier& b, bool t0) {
    asm volatile("s_waitcnt vmcnt(0)" ::: "memory");
    __syncthreads();
    if (t0) {
        unsigned* bar = b.bar;
        __builtin_amdgcn_s_waitcnt(0);
        unsigned nloc = b.st[0], nx = b.st[1];
        if (nloc == 0u) { xcd_barrier_complete(bar, b.x, nloc, nx); b.st[0] = nloc; b.st[1] = nx; }
        const unsigned old = xb_add(&bar[XB_XSUB(b.x)], 1u);
        const unsigned gen = old / nloc;
        if (old + 1u == (gen + 1u) * nloc) {
            __builtin_amdgcn_fence(__ATOMIC_RELEASE, "agent");
            asm volatile("s_waitcnt vmcnt(0)" ::: "memory");
            const unsigned og = xb_add(&bar[XB_TOP], 1u);
            const unsigned tg = og / nx;
            if (og + 1u == (tg + 1u) * nx) xb_add(&bar[XB_TOPGEN], 1u);
            else XB_SPIN(xb_ld(&bar[XB_TOPGEN]) == tg, bar);
            __builtin_amdgcn_fence(__ATOMIC_ACQUIRE, "agent");
            xb_add(&bar[XB_XGEN(b.x)], 1u);
            asm volatile("s_waitcnt vmcnt(0)" ::: "memory");
        } else {
            XB_SPIN(xb_ld(&bar[XB_XGEN(b.x)]) == gen, bar);
            __builtin_amdgcn_fence(__ATOMIC_ACQUIRE, "agent");
            asm volatile("s_waitcnt vmcnt(0)" ::: "memory");
        }
    }
    __syncthreads();
}
typedef const void* const __attribute__((address_space(4)))* kargp_t;
DI const float* KIN(int i) { const float* p = (const float*)((kargp_t)__builtin_amdgcn_kernarg_segment_ptr())[i]; asm volatile("" : "+s"(p)); return p; }
DI float* KOUT() { float* p = (float*)((kargp_t)__builtin_amdgcn_kernarg_segment_ptr())[27]; asm volatile("" : "+s"(p)); return p; }
DI unsigned char* KWS() { unsigned char* p = (unsigned char*)((kargp_t)__builtin_amdgcn_kernarg_segment_ptr())[28]; asm volatile("" : "+s"(p)); return p; }
struct Frame {
    LAS unsigned char* lds;
    gu32* ctl;
    int tid, lane, wave, G, bid;
};
DI bf16x8 ld_frag_g(const bf16* p) { return __builtin_bit_cast(bf16x8, *(const v4u*)p); }
DI bf16x8 ld_frag_l(const LAS unsigned char* p) { return *(const LAS bf16x8*)p; }
DI f32x4 mfma16(bf16x8 a, bf16x8 b, f32x4 c) { return __builtin_amdgcn_mfma_f32_16x16x32_bf16(a, b, c, 0, 0, 0); }
DI bf16x8 pack_frag(const f32x4 a, const f32x4 b) { return __builtin_bit_cast(bf16x8, pack8(a, b)); }
DI int lane_id() { int l; asm volatile("v_mbcnt_lo_u32_b32 %0, -1, 0\n\tv_mbcnt_hi_u32_b32 %0, -1, %0" : "=v"(l)); return l; }
DI Frame fresh(const Frame& F0) {
    Frame F = F0; int w = F0.wave, g = F0.G, b = F0.bid; asm volatile("" : "+s"(w), "+s"(g), "+s"(b));
    int l = lane_id(); asm volatile("" : "+v"(l));
    unsigned lb = (unsigned)(uintptr_t)F0.lds; asm volatile("" : "+s"(lb)); F.lds = (LAS unsigned char*)(uintptr_t)lb;
    F.wave = w; F.lane = l; F.tid = w * 64 + l; F.G = g; F.bid = b; return F;
}
#define GRID_BAR() do { XcdBarrier b_; b_.bar = (unsigned*)((gu32*)(KWS() + WS_CTL) + CW_BAR); b_.x = xb_xcc_id(); b_.st = (volatile LAS unsigned*)(F.lds + MISC_OFF) + 8; \
    const Frame Fb_ = fresh(F); xcd_barrier(b_, Fb_.tid == 0); } while (0)
DI int win_colmap(int j) {
    if (j < 1280) return j; if (j < 2816) return j + 24; if (j < 8448) return j + 32; if (j < 8472) return j - 8448 + 1280; if (j < 8480) return j - 8472 + 2840; return -1;
}
DI void tr_item(const float* W, int ldw, int k0, int srccol, bf16* WT, size_t dst_row0, int ldt, int kdst0, int nrep, int krep, LAS float* scr, int lane) {
#pragma unroll 8
    for (int i = 0; i < 32; ++i) { const int kk = 2 * i + (lane >> 5); scr[kk * 33 + (lane & 31)] = (srccol >= 0) ? W[(size_t)(k0 + kk) * ldw + srccol] : 0.f; }
    LDS_WAIT(); asm volatile("" ::: "memory");
    const int c = lane & 7;
#pragma unroll
    for (int j = 0; j < 4; ++j) { const int n = (lane >> 3) + 8 * j; const LAS float* s = scr + (8 * c) * 33 + n;
        v4u o; o.x = pk2(s[0 * 33], s[1 * 33]); o.y = pk2(s[2 * 33], s[3 * 33]); o.z = pk2(s[4 * 33], s[5 * 33]); o.w = pk2(s[6 * 33], s[7 * 33]);
        for (int r = 0; r < nrep; ++r) *(v4u*)(WT + (dst_row0 + n) * (size_t)ldt + kdst0 + r * krep + 8 * c) = o; }
    LDS_WAIT(); asm volatile("" ::: "memory");
}
DI void p0_prologue(Frame& F) {
    LAS float* scr = (LAS float*)(F.lds + F.wave * 16384);
    const int gw = F.bid * NWAVES + F.wave, NGW = F.G * NWAVES, lane = F.lane;
    unsigned char* ws = KWS();
    constexpr int I_A = 16 * 272, I_B = 3 * 8 * 32, I_C = 16 * 32, I_D = 16 * 128, I_E = 64 * 32, I_F = 4 * 32, I_G = 16 * 32, I_H = 2 * 32 * 2, I_I = 2 * 2;
    constexpr int I_L = I_A + I_B + I_C + I_D + I_E + I_F + I_G + I_H + I_I;
    for (int it = gw; it < 2 * I_L; it += NGW) {
        const int l = it / I_L; int r = it % I_L;
        if (r < I_A) { const int kb = r / 272, nb = r % 272; tr_item(KIN(11) + (size_t)l * DM * 8480, 8480, 64 * kb, win_colmap(32 * nb + (lane & 31)), (bf16*)(ws + WS_WIN + l * SZ_WIN), 32 * nb, DM, 64 * kb, 1, 0, scr, lane); continue; } r -= I_A;
        if (r < I_B) { const int b = r / 256, kb = (r % 256) / 32, nb = r % 32; tr_item(KIN(19) + (size_t)(l * 3 + b) * 512 * DM, DM, 64 * kb, 32 * nb + (lane & 31), (bf16*)(ws + WS_WBR + l * SZ_WBR), b * 1024 + 32 * nb, 512, 64 * kb, 1, 0, scr, lane); continue; } r -= I_B;
        if (r < I_C) { const int kb = r / 32, nb = r % 32; tr_item(KIN(20) + (size_t)l * DM * DM, DM, 64 * kb, 32 * nb + (lane & 31), (bf16*)(ws + WS_WO3 + l * SZ_WO3), 32 * nb, 3072, 64 * kb, 3, 1024, scr, lane); continue; } r -= I_C;
        if (r < I_D) { const int kb = r / 128, nb = r % 128; tr_item(KIN(22) + (size_t)l * DM * DFF, DFF, 64 * kb, 32 * nb + (lane & 31), (bf16*)(ws + WS_WUP + l * SZ_WUP), 32 * nb, DM, 64 * kb, 1, 0, scr, lane); continue; } r -= I_D;
        if (r < I_E) { const int kb = r / 32, nb = r % 32; tr_item(KIN(23) + (size_t)l * DFF * DM, DM, 64 * kb, 32 * nb + (lane & 31), (bf16*)(ws + WS_WDN + l * SZ_WDN), 32 * nb, DFF, 64 * kb, 1, 0, scr, lane); continue; } r -= I_E;
        if (r < I_F) { const int kb = r / 32, nb = r % 32; tr_item(KIN(24) + (size_t)l * PLE * DM, DM, 64 * kb, 32 * nb + (lane & 31), (bf16*)(ws + WS_WPL + l * SZ_WPL), 32 * nb, PLE, 64 * kb, 1, 0, scr, lane); continue; } r -= I_F;
        if (r < I_G) { const int kb = r / 32, nb = r % 32; tr_item(KIN(25) + (size_t)l * DM * DM, DM, 64 * kb, 32 * nb + (lane & 31), (bf16*)(ws + WS_WPG + l * SZ_WPG), 32 * nb, DM, 64 * kb, 1, 0, scr, lane); continue; } r -= I_G;
        if (r < I_H) { const int kv = r / 64, kb = (r % 64) / 2, nb = r % 2; tr_item(KIN(13) + (size_t)(l * 2 + kv) * 2048 * 64, 64, 64 * kb, 32 * nb + (lane & 31), (bf16*)(ws + WS_W1T + l * SZ_W1T) + (size_t)kv * 64 * 2048, 32 * nb, 2048, 64 * kb, 1, 0, scr, lane); continue; } r -= I_H;
        { const int kv = r / 2, nb = r % 2; tr_item(KIN(14) + (size_t)(l * 2 + kv) * 64 * 64, 64, 0, 32 * nb + (lane & 31), (bf16*)(ws + WS_W2T + l * SZ_W2T) + (size_t)kv * 64 * 64, 32 * nb, 64, 0, 1, 0, scr, lane); }
    }
    float* XR = (float*)(ws + WS_XR); bf16* XGA = (bf16*)(ws + WS_XGA); float* SSA = (float*)(ws + WS_SSA); bf16* P16 = (bf16*)(ws + WS_P16);
    const float* g0 = KIN(10);
    for (int row = gw; row < MROWS; row += NGW) {
        const float* xs = (row < MP) ? KIN(0) + (size_t)row * DM : KIN(1) + (size_t)(row - MP) * DM;
        float ss = 0.f;
#pragma unroll
        for (int j = 0; j < 2; ++j) {
            const int c = j * 512 + lane * 8;
            f32x4 a = *(const f32x4*)(xs + c), b = *(const f32x4*)(xs + c + 4);
            *(f32x4*)(XR + (size_t)row * DM + c) = a; *(f32x4*)(XR + (size_t)row * DM + c + 4) = b;
            ss += (a[0] * a[0] + a[1] * a[1]) + (a[2] * a[2] + a[3] * a[3]) + (b[0] * b[0] + b[1] * b[1]) + (b[2] * b[2] + b[3] * b[3]);
            const f32x4 ga = *(const f32x4*)(g0 + c), gb = *(const f32x4*)(g0 + c + 4);
            *(v4u*)(XGA + (size_t)row * DM + c) = pack8(a * ga, b * gb);
        }
        ss = wave_sum(ss, lane);
        if (lane < 16) SSA[(size_t)row * 16 + lane] = (lane == 0) ? ss : 0.f;
#pragma unroll
        for (int l = 0; l < 2; ++l) {
            const float* ps = (row < MP) ? KIN(8) + ((size_t)l * MP + row) * PLE : KIN(9) + ((size_t)l * MS + (row - MP)) * PLE;
            const f32x4 a = *(const f32x4*)(ps + lane * 4);
            v2u o; o.x = pk2(a[0], a[1]); o.y = pk2(a[2], a[3]);
            *(v2u*)(P16 + ((size_t)l * MROWS + row) * PLE + lane * 4) = o;
        }
    }
    const int gt = F.bid * NTHREADS + F.tid, NGT = F.G * NTHREADS;
    f32x2* ROT = (f32x2*)(ws + WS_ROT);
    for (int e = gt; e < TP * 64; e += NGT) {
        const int pos = e >> 6, i = e & 63;
        const float x = (float)i * (1.0f / 63.0f);
        const float inv = exp2f(-x * 13.287712379549449f);
        const float ang = (float)pos * inv;
        const double rev = (double)ang * 0.15915494309189535;
        const float fr = (float)(rev - floor(rev));
        ROT[e] = (f32x2){__builtin_amdgcn_cosf(fr), __builtin_amdgcn_sinf(fr)};
    }
    for (int e = gt; e < 2 * 128 * 508 * 64; e += NGT) {
        const int ls = e / (508 * 64), r = e % (508 * 64);
        const f32x4 v = *(const f32x4*)(KIN(3) + (size_t)ls * 512 * 256 + 4 * 256 + (size_t)r * 4);
        *(f32x4*)(KOUT() + O_WINS + (size_t)ls * 512 * 256 + (size_t)r * 4) = v;
    }
}
DI float gelu_tanh(float x) { const float u = 0.7978845608028654f * (x + 0.044715f * x * x * x); const float e = __expf(2.f * u); return 0.5f * x * (1.f + (1.f - 2.f / (e + 1.f))); }
DI bf16x8 mk_frag(v2u a, v2u b) { v4u w; w.x = a.x; w.y = a.y; w.z = b.x; w.w = b.y; return __builtin_bit_cast(bf16x8, w); }

DI void compress_job(Frame& F, int layer, int job) {
    int lane = F.lane, wave = F.wave; asm volatile("" : "+v"(lane), "+s"(wave));
    const int tid = wave * 64 + lane, quad = lane >> 4, rl = lane & 15;
    unsigned char* ws = KWS();
    const bool sample = job < 256;
    int kv, bs, g0, nbase;
    if (sample) { kv = job >> 7; bs = job & 127; g0 = 0; nbase = 0; }
    else { const int j2 = job - 256; kv = j2 >> 3; bs = (j2 >> 2) & 1; g0 = (j2 >> 1) & 1; nbase = (j2 & 1) * 256; }
    const bf16* W1T = (const bf16*)(ws + WS_W1T + layer * SZ_W1T) + (size_t)kv * 64 * 2048;
    const bf16* W2T = (const bf16*)(ws + WS_W2T + layer * SZ_W2T) + (size_t)kv * 64 * 64;
    const float* pe = KIN(12) + (size_t)(layer * 2 + kv) * 32 * 64;
    const bf16* Z = (const bf16*)(ws + WS_Z);
    const int* pt = (const int*)KIN(7);
    const float* cache = KIN(2);
    LAS unsigned char* LW = F.lds;
    int gg[2], nn[2];
#pragma unroll
    for (int tl = 0; tl < 2; ++tl) { const int T = 2 * wave + tl; if (sample) { gg[tl] = T >> 3; nn[tl] = 16 * (T & 7) + rl; } else { gg[tl] = g0; nn[tl] = nbase + 16 * T + rl; } }
    f32x4 h[2][4];
#pragma unroll
    for (int tl = 0; tl < 2; ++tl)
#pragma unroll
        for (int i = 0; i < 4; ++i) h[tl][i] = (f32x4){0.f, 0.f, 0.f, 0.f};
#pragma unroll 1
    for (int c = 0; c < 4; ++c) {
        __syncthreads();
#pragma unroll
        for (int k = 0; k < 8; ++k) { const int pc = tid + 512 * k, r = pc >> 6, c16 = pc & 63;
            *(LAS v4u*)(LW + r * 1040 + c16 * 16) = *(const v4u*)(W1T + (size_t)r * 2048 + c * 512 + c16 * 8); }
        __syncthreads();
#pragma unroll 4
        for (int kk = 0; kk < 16; ++kk) {
            const int j = 8 * c + (kk >> 1), dim0 = (kk & 1) * 32 + quad * 8;
            const f32x4 pe0 = *(const f32x4*)(pe + j * 64 + dim0), pe1 = *(const f32x4*)(pe + j * 64 + dim0 + 4);
            bf16x8 xb[2];
#pragma unroll
            for (int tl = 0; tl < 2; ++tl) {
                f32x4 x0, x1;
                if (!sample) { const size_t row = (size_t)bs * TP + 16 * nn[tl] + j; unpack8(*(const v4u*)(Z + row * LDZ + ZC_KC + kv * 128 + gg[tl] * 64 + dim0), x0, x1); }
                else { int pos = 16 * nn[tl] + j; pos = pos > 2047 ? 2047 : pos; const int phys = pt[bs * 16 + (pos >> 7)];
                    const float* p = cache + ((size_t)(layer * 2560 + phys) * 128 + (pos & 127)) * 512 + kv * 128 + gg[tl] * 64 + dim0; x0 = *(const f32x4*)p; x1 = *(const f32x4*)(p + 4); }
                xb[tl] = pack_frag(x0 + pe0, x1 + pe1);
            }
#pragma unroll
            for (int ht = 0; ht < 4; ++ht) {
                const bf16x8 a = ld_frag_l(LW + (16 * ht + rl) * 1040 + (kk * 32 + quad * 8) * 2);
                h[0][ht] = mfma16(a, xb[0], h[0][ht]); h[1][ht] = mfma16(a, xb[1], h[1][ht]);
            }
        }
    }
#pragma unroll
    for (int tl = 0; tl < 2; ++tl) {
#pragma unroll
        for (int ht = 0; ht < 4; ++ht)
#pragma unroll
            for (int i = 0; i < 4; ++i) h[tl][ht][i] = gelu_tanh(h[tl][ht][i]);
        bf16x8 gb[2]; gb[0] = pack_frag(h[tl][0], h[tl][1]); gb[1] = pack_frag(h[tl][2], h[tl][3]);
        const int n = nn[tl], g = gg[tl];
        bf16* dst = sample ? (bf16*)(ws + WS_KCS) + ((((size_t)kv * 128 + bs) * 128 + n) * 2 + g) * 64 : (bf16*)(ws + WS_KC) + ((((size_t)kv * 2 + bs) * 512 + n) * 2 + g) * 64;
        const bool zero = sample && n == 127;
#pragma unroll
        for (int ot = 0; ot < 4; ++ot) {
            f32x4 o = (f32x4){0.f, 0.f, 0.f, 0.f};
#pragma unroll
            for (int s = 0; s < 2; ++s) {
                const bf16* wp = W2T + (16 * ot + rl) * 64 + 32 * s + 4 * quad;
                o = mfma16(mk_frag(*(const v2u*)wp, *(const v2u*)(wp + 16)), gb[s], o);
            }
            v2u w; w.x = zero ? 0u : pk2(o[0], o[1]); w.y = zero ? 0u : pk2(o[2], o[3]);
            *(v2u*)(dst + 16 * ot + 4 * quad) = w;
        }
    }
    __syncthreads();
}

DI int kperm(int idx) { const int s = idx >> 5, r = idx & 31; return 32 * s + 8 * ((r >> 2) & 3) + 4 * (r >> 4) + (r & 3); }
DI float softplusf_(float x) { return x > 20.f ? x : __logf(1.f + __expf(x)); }
DI float ret_lg(int h) { return h == 0 ? -0.031748697f : h == 1 ? -0.015748357f : h == 2 ? -0.007843178f : -0.0039138994f; }

DI void gdn_prep_unit(Frame& F, int layer, int unit) {
    const int tid = F.tid, lane = F.lane, wave = F.wave;
    const int b = unit >> 9, h = (unit >> 7) & 3, c = unit & 127;
    const int row0 = b * TP + 64 * c, t0 = 64 * c;
    unsigned char* ws = KWS();
    const bf16* Z = (const bf16*)(ws + WS_Z);
    const float* ZS = (const float*)(ws + WS_ZS);
    LAS float* Lq = (LAS float*)(F.lds); LAS float* Lk = (LAS float*)(F.lds + 33792); LAS float* Lv = (LAS float*)(F.lds + 67584);
    LAS float* LA = (LAS float*)(F.lds + 101376); LAS float* LQK = (LAS float*)(F.lds + 117760);
    LAS float* Lg = (LAS float*)(F.lds + 134144); LAS float* Lb = Lg + 64; LAS float* Le = Lg + 128;
    const float* cw = KIN(15) + (size_t)layer * 4 * 1536;
#pragma unroll
    for (int it0 = 0; it0 < 6; ++it0) {
        const int it = tid + it0 * NTHREADS;
        const int i = it / 48, ch = it % 48, part = ch >> 4, cc = ch & 15;
        const int col = part * 512 + h * 128 + cc * 8;
        f32x4 y0 = (f32x4){0.f, 0.f, 0.f, 0.f}, y1 = y0;
#pragma unroll
        for (int j = 0; j < 4; ++j) {
            const int t = t0 + i - 3 + j;
            if (t >= 0) { f32x4 x0, x1; unpack8(*(const v4u*)(Z + (size_t)(row0 + i - 3 + j) * LDZ + ZC_GQKV + col), x0, x1);
                y0 += x0 * *(const f32x4*)(cw + j * 1536 + col); y1 += x1 * *(const f32x4*)(cw + j * 1536 + col + 4); }
        }
#pragma unroll
        for (int e = 0; e < 4; ++e) { y0[e] = siluf_(y0[e]); y1[e] = siluf_(y1[e]); }
        LAS float* dst = (part == 0 ? Lq : part == 1 ? Lk : Lv) + i * 132 + cc * 8;
        *(LAS f32x4*)dst = y0; *(LAS f32x4*)(dst + 4) = y1;
    }
    __syncthreads();
    {
        float va[16], vb[16], ps[16];
#pragma unroll
        for (int q = 0; q < 16; ++q) { LAS float* vp = ((q < 8) ? Lq : Lk) + (wave * 8 + (q & 7)) * 132 + lane * 2; va[q] = vp[0]; vb[q] = vp[1]; ps[q] = va[q] * va[q] + vb[q] * vb[q]; }
#pragma unroll
        for (int q = 0; q < 16; ++q) ps[q] += shx<1>(ps[q], lane);
#pragma unroll
        for (int q = 0; q < 16; ++q) ps[q] += shx<2>(ps[q], lane);
#pragma unroll
        for (int q = 0; q < 16; ++q) ps[q] += shx<4>(ps[q], lane);
#pragma unroll
        for (int q = 0; q < 16; ++q) ps[q] += shx<8>(ps[q], lane);
#pragma unroll
        for (int q = 0; q < 16; ++q) ps[q] += shx<16>(ps[q], lane);
#pragma unroll
        for (int q = 0; q < 16; ++q) ps[q] += shx<32>(ps[q], lane);
#pragma unroll
        for (int q = 0; q < 16; ++q) { LAS float* vp = ((q < 8) ? Lq : Lk) + (wave * 8 + (q & 7)) * 132 + lane * 2; const float sc = rsqrtf(ps[q] + EPS) * ((q < 8) ? 0.08838834764831845f : 1.f); vp[0] = va[q] * sc; vp[1] = vb[q] * sc; }
    }
    if (wave == 0) {
        const float ga = ZS[(size_t)(row0 + lane) * 32 + 24 + h], gbv = ZS[(size_t)(row0 + lane) * 32 + 28 + h];
        float g = -__expf(KIN(16)[layer * 4 + h]) * softplusf_(ga + KIN(17)[layer * 4 + h]);
#pragma unroll
        for (int o = 1; o < 64; o <<= 1) { const float t = __int_as_float(__builtin_amdgcn_ds_bpermute(((lane - o) & 63) << 2, __float_as_int(g))); if (lane >= o) g += t; }
        Lg[lane] = g; Lb[lane] = sigmoidf_(gbv); Le[lane] = __expf(g);
    }
    __syncthreads();
    {
        const int it = wave >> 1, quad = lane >> 4, rl = lane & 15;
        f32x4 ckk[2], cqk[2];
#pragma unroll
        for (int jj = 0; jj < 2; ++jj) { ckk[jj] = (f32x4){0.f, 0.f, 0.f, 0.f}; cqk[jj] = ckk[jj]; }
#pragma unroll
        for (int s = 0; s < 4; ++s) {
            const LAS float* kp = Lk + (16 * it + rl) * 132 + 32 * s + 8 * quad; const LAS float* qp = Lq + (16 * it + rl) * 132 + 32 * s + 8 * quad;
            const f32x4 ka0 = *(const LAS f32x4*)kp, ka1 = *(const LAS f32x4*)(kp + 4), qa0 = *(const LAS f32x4*)qp, qa1 = *(const LAS f32x4*)(qp + 4);
            const bf16x8 kah = pack_frag(ka0, ka1), qah = pack_frag(qa0, qa1);
            f32x4 h0, h1; unpack8(__builtin_bit_cast(v4u, kah), h0, h1); const bf16x8 kal = pack_frag(ka0 - h0, ka1 - h1);
            unpack8(__builtin_bit_cast(v4u, qah), h0, h1); const bf16x8 qal = pack_frag(qa0 - h0, qa1 - h1);
#pragma unroll
            for (int jj = 0; jj < 2; ++jj) {
                const int jt = (wave & 1) * 2 + jj;
                if (jt <= it) {
                    const LAS float* bp = Lk + (16 * jt + rl) * 132 + 32 * s + 8 * quad;
                    const f32x4 kb0 = *(const LAS f32x4*)bp, kb1 = *(const LAS f32x4*)(bp + 4);
                    const bf16x8 kbh = pack_frag(kb0, kb1); unpack8(__builtin_bit_cast(v4u, kbh), h0, h1); const bf16x8 kbl = pack_frag(kb0 - h0, kb1 - h1);
                    ckk[jj] = mfma16(kah, kbh, ckk[jj]); ckk[jj] = mfma16(kah, kbl, ckk[jj]); ckk[jj] = mfma16(kal, kbh, ckk[jj]);
                    cqk[jj] = mfma16(qah, kbh, cqk[jj]); cqk[jj] = mfma16(qah, kbl, cqk[jj]); cqk[jj] = mfma16(qal, kbh, cqk[jj]);
                }
            }
        }
#pragma unroll
        for (int jj = 0; jj < 2; ++jj) {
            const int j = 16 * ((wave & 1) * 2 + jj) + rl; const float gj = Lg[j];
#pragma unroll
            for (int e = 0; e < 4; ++e) { const int i = 16 * it + 4 * quad + e; const float dec = (i >= j) ? __expf(Lg[i] - gj) : 0.f;
                LA[i * 64 + j] = (i > j) ? Lb[i] * ckk[jj][e] * dec : 0.f; LQK[i * 64 + j] = cqk[jj][e] * dec; }
        }
    }
    __syncthreads();
    unsigned char* rec = ws + WS_GREC + (size_t)unit * GREC;
    {
        const float gl = Lg[63];
        for (int it = tid; it < 2560; it += NTHREADS) {
            if (it < 1024) {
                const int i = it >> 4, s = (it >> 2) & 3, quad = it & 3; const float e = Le[i];
                const f32x4 a = *(const LAS f32x4*)(Lq + i * 132 + 32 * s + 4 * quad) * e, bq = *(const LAS f32x4*)(Lq + i * 132 + 32 * s + 16 + 4 * quad) * e;
                *(v4u*)(rec + 16384 + i * 256 + (32 * s + 8 * quad) * 2) = pack8(a, bq);
            } else if (it < 2048) {
                const int r = it - 1024, dk = r >> 3, s2 = (r >> 2) & 1, quad = r & 3;
                f32x4 a, bq;
#pragma unroll
                for (int e = 0; e < 4; ++e) { const int ta = 32 * s2 + 4 * quad + e, tb = ta + 16; a[e] = Lk[ta * 132 + dk] * __expf(gl - Lg[ta]); bq[e] = Lk[tb * 132 + dk] * __expf(gl - Lg[tb]); }
                *(v4u*)(rec + 32768 + dk * 128 + (32 * s2 + 8 * quad) * 2) = pack8(a, bq);
            } else {
                const int r = it - 2048, i = r >> 3, s2 = (r >> 2) & 1, quad = r & 3;
                const f32x4 a = *(const LAS f32x4*)(LQK + i * 64 + 32 * s2 + 4 * quad), bq = *(const LAS f32x4*)(LQK + i * 64 + 32 * s2 + 16 + 4 * quad);
                *(v4u*)(rec + 65536 + i * 128 + (32 * s2 + 8 * quad) * 2) = pack8(a, bq);
            }
        }
        if (tid == 0) *(float*)(rec + 73728) = __expf(gl);
    }
    __syncthreads();
    if (tid < 256) {
        LAS float* X = (tid < 128) ? (Lv + tid) : (Lk + (tid - 128));
        const bool isw = tid >= 128;
#pragma unroll 1
        for (int B = 0; B < 4; ++B) {
            float xb[16];
#pragma unroll
            for (int i = 0; i < 16; ++i) { const int r = 16 * B + i; xb[i] = (isw ? Lb[r] * Le[r] : Lb[r]) * X[r * 132]; }
#pragma unroll 1
            for (int j4 = 0; j4 < 4 * B; ++j4) {
                const float x0 = X[(4 * j4) * 132], x1 = X[(4 * j4 + 1) * 132], x2 = X[(4 * j4 + 2) * 132], x3 = X[(4 * j4 + 3) * 132];
#pragma unroll
                for (int i = 0; i < 16; ++i) { const f32x4 a = *(const LAS f32x4*)(LA + (16 * B + i) * 64 + 4 * j4); xb[i] -= (a[0] * x0 + a[1] * x1) + (a[2] * x2 + a[3] * x3); }
            }
#pragma unroll
            for (int i = 1; i < 16; ++i) {
                float acc0 = 0.f, acc1 = 0.f;
#pragma unroll
                for (int j4 = 0; j4 < (i + 3) / 4; ++j4) { const f32x4 a = *(const LAS f32x4*)(LA + (16 * B + i) * 64 + 16 * B + 4 * j4);
                    if (4 * j4 + 0 < i) acc0 += a[0] * xb[4 * j4 + 0]; if (4 * j4 + 1 < i) acc1 += a[1] * xb[4 * j4 + 1]; if (4 * j4 + 2 < i) acc0 += a[2] * xb[4 * j4 + 2]; if (4 * j4 + 3 < i) acc1 += a[3] * xb[4 * j4 + 3]; }
                xb[i] -= acc0 + acc1;
            }
#pragma unroll
            for (int i = 0; i < 16; ++i) X[(16 * B + i) * 132] = xb[i];
        }
    }
    __syncthreads();
    for (int it = tid; it < 2048; it += NTHREADS) {
        if (it < 1024) {
            const int dv = it >> 3, q = it & 7;
            v4u w; w.x = pk2(Lv[(8 * q) * 132 + dv], Lv[(8 * q + 1) * 132 + dv]); w.y = pk2(Lv[(8 * q + 2) * 132 + dv], Lv[(8 * q + 3) * 132 + dv]);
            w.z = pk2(Lv[(8 * q + 4) * 132 + dv], Lv[(8 * q + 5) * 132 + dv]); w.w = pk2(Lv[(8 * q + 6) * 132 + dv], Lv[(8 * q + 7) * 132 + dv]);
            *(v4u*)(rec + 49152 + dv * 128 + q * 16) = w;
        } else {
            const int r = it - 1024, i = r >> 4, s = (r >> 2) & 3, quad = r & 3;
            const f32x4 a = *(const LAS f32x4*)(Lk + i * 132 + 32 * s + 4 * quad), bq = *(const LAS f32x4*)(Lk + i * 132 + 32 * s + 16 + 4 * quad);
            *(v4u*)(rec + i * 256 + (32 * s + 8 * quad) * 2) = pack8(a, bq);
        }
    }
    __syncthreads();
}

DI void ret_prep_unit(Frame& F, int layer, int unit) {
    const int tid = F.tid, lane = F.lane, wave = F.wave, quad = lane >> 4, rl = lane & 15;
    const int b = unit >> 8, h = (unit >> 6) & 3, c = unit & 63;
    const int row0 = b * TP + 128 * c;
    unsigned char* ws = KWS();
    const bf16* Z = (const bf16*)(ws + WS_Z);
    const f32x2* ROT = (const f32x2*)(ws + WS_ROT);
    bf16* QR = (bf16*)(ws + WS_QR); bf16* KR = (bf16*)(ws + WS_KR);
    LAS unsigned char* LK = F.lds; LAS unsigned char* LV = F.lds + 34816;
    const float lg = ret_lg(h);
    for (int it = tid; it < 1024; it += NTHREADS) {
        const int j = it >> 3, cc = it & 7, d0 = cc * 8;
        const size_t zr = (size_t)(row0 + j) * LDZ + ZC_RQKV + h * 128 + d0;
        f32x4 q1a, q1b, q2a, q2b, k1a, k1b, k2a, k2b;
        unpack8(*(const v4u*)(Z + zr), q1a, q1b); unpack8(*(const v4u*)(Z + zr + 64), q2a, q2b);
        unpack8(*(const v4u*)(Z + zr + 512), k1a, k1b); unpack8(*(const v4u*)(Z + zr + 512 + 64), k2a, k2b);
        const f32x2* rp = ROT + (size_t)(128 * c + j) * 64 + d0;
        const float kd = __expf((float)(127 - j) * lg);
        f32x4 oq1a, oq1b, oq2a, oq2b, ok1a, ok1b, ok2a, ok2b;
#pragma unroll
        for (int e = 0; e < 8; ++e) {
            const f32x2 cs = rp[e];
            const float q1 = e < 4 ? q1a[e & 3] : q1b[e & 3], q2 = e < 4 ? q2a[e & 3] : q2b[e & 3], k1 = e < 4 ? k1a[e & 3] : k1b[e & 3], k2 = e < 4 ? k2a[e & 3] : k2b[e & 3];
            const float rq1 = q1 * cs.x - q2 * cs.y, rq2 = q2 * cs.x + q1 * cs.y, rk1 = (k1 * cs.x - k2 * cs.y) * 0.08838834764831845f, rk2 = (k2 * cs.x + k1 * cs.y) * 0.08838834764831845f;
            if (e < 4) { oq1a[e & 3] = rq1; oq2a[e & 3] = rq2; ok1a[e & 3] = rk1; ok2a[e & 3] = rk2; } else { oq1b[e & 3] = rq1; oq2b[e & 3] = rq2; ok1b[e & 3] = rk1; ok2b[e & 3] = rk2; }
            *(LAS bf16*)(LK + (d0 + e) * 272 + j * 2) = (bf16)f2bf(rk1 * kd); *(LAS bf16*)(LK + (d0 + 64 + e) * 272 + j * 2) = (bf16)f2bf(rk2 * kd);
        }
        const size_t orow = (size_t)(row0 + j) * 512 + h * 128 + d0;
        *(v4u*)(QR + orow) = pack8(oq1a, oq1b); *(v4u*)(QR + orow + 64) = pack8(oq2a, oq2b);
        *(v4u*)(KR + orow) = pack8(ok1a, ok1b); *(v4u*)(KR + orow + 64) = pack8(ok2a, ok2b);
    }
    for (int it = tid; it < 2048; it += NTHREADS) {
        const int j = it >> 4, cc = it & 15;
        const v4u w = *(const v4u*)(Z + (size_t)(row0 + j) * LDZ + ZC_RQKV + 1024 + h * 128 + cc * 8);
        LAS unsigned char* d = LV + (cc * 8) * 272 + j * 2;
        *(LAS bf16*)(d) = (bf16)(w.x & 0xffff); *(LAS bf16*)(d + 272) = (bf16)(w.x >> 16); *(LAS bf16*)(d + 2 * 272) = (bf16)(w.y & 0xffff); *(LAS bf16*)(d + 3 * 272) = (bf16)(w.y >> 16);
        *(LAS bf16*)(d + 4 * 272) = (bf16)(w.z & 0xffff); *(LAS bf16*)(d + 5 * 272) = (bf16)(w.z >> 16); *(LAS bf16*)(d + 6 * 272) = (bf16)(w.w & 0xffff); *(LAS bf16*)(d + 7 * 272) = (bf16)(w.w >> 16);
    }
    __syncthreads();
    float* RKV = (float*)(ws + WS_RKV) + (size_t)unit * 16384;
#pragma unroll
    for (int nt = 0; nt < 8; ++nt) {
        f32x4 acc = (f32x4){0.f, 0.f, 0.f, 0.f};
#pragma unroll
        for (int s = 0; s < 4; ++s) acc = mfma16(ld_frag_l(LK + (16 * wave + rl) * 272 + (32 * s + 8 * quad) * 2), ld_frag_l(LV + (16 * nt + rl) * 272 + (32 * s + 8 * quad) * 2), acc);
#pragma unroll
        for (int i = 0; i < 4; ++i) RKV[(size_t)(16 * wave + 4 * quad + i) * 128 + 16 * nt + rl] = acc[i];
    }
    __syncthreads();
}
DI void sample_rec_unit(Frame& F, int layer, int unit) {
    const int tid = F.tid, lane = F.lane, wave = F.wave;
    const int kind = unit >> 9, s = (unit >> 2) & 127, h = unit & 3;
    const int dv = tid & 127, part = tid >> 7, r0 = MP + 4 * s;
    unsigned char* ws = KWS();
    const bf16* Z = (const bf16*)(ws + WS_Z);
    const float* ZS = (const float*)(ws + WS_ZS);
    LAS float* Lq = (LAS float*)(F.lds); LAS float* Lk = Lq + 512; LAS float* Lv = Lq + 1024; LAS float* red = Lq + 1536; LAS float* Lo = Lq + 2048; LAS float* sc = Lq + 2560;
    float S[32];
    if (kind == 0) {
        if (tid < 384) {
            const int pr = tid >> 7, d = tid & 127, col = pr * 512 + h * 128 + d;
            float xp[7], w[4];
#pragma unroll
            for (int i = 0; i < 3; ++i) xp[i] = KIN(4)[((size_t)(layer * 128 + s) * 3 + i) * 1536 + col];
#pragma unroll
            for (int j = 0; j < 4; ++j) xp[3 + j] = bf2f(Z[(size_t)(r0 + j) * LDZ + ZC_GQKV + col]);
#pragma unroll
            for (int i = 0; i < 4; ++i) w[i] = KIN(15)[(size_t)(layer * 4 + i) * 1536 + col];
            LAS float* dst = pr == 0 ? Lq : pr == 1 ? Lk : Lv;
#pragma unroll
            for (int j = 0; j < 4; ++j) dst[j * 128 + d] = siluf_(w[0] * xp[j] + w[1] * xp[j + 1] + w[2] * xp[j + 2] + w[3] * xp[j + 3]);
        }
        __syncthreads();
        {
            LAS float* vp = (wave < 4 ? Lq : Lk) + (wave & 3) * 128;
            const float a = vp[2 * lane], b = vp[2 * lane + 1];
            const float scl = rsqrtf(wave_sum(a * a + b * b, lane) + EPS) * (wave < 4 ? 0.08838834764831845f : 1.f);
            vp[2 * lane] = a * scl; vp[2 * lane + 1] = b * scl;
        }
        if (tid < 4) {
            const float ga = ZS[(size_t)(r0 + tid) * 32 + 24 + h], gb = ZS[(size_t)(r0 + tid) * 32 + 28 + h];
            sc[tid] = __expf(-__expf(KIN(16)[layer * 4 + h]) * softplusf_(ga + KIN(17)[layer * 4 + h])); sc[4 + tid] = sigmoidf_(gb);
        }
        __syncthreads();
        const float* Sin = KIN(5) + ((size_t)((layer * 128 + s) * 4 + h) * 128 + 32 * part) * 128 + dv;
#pragma unroll
        for (int i = 0; i < 32; ++i) S[i] = Sin[(size_t)i * 128];
#pragma unroll
        for (int j = 0; j < 4; ++j) {
            const float a = sc[j], beta = sc[4 + j];
            float p = 0.f;
#pragma unroll
            for (int i = 0; i < 32; ++i) { S[i] *= a; p += Lk[j * 128 + 32 * part + i] * S[i]; }
            red[part * 128 + dv] = p;
            __syncthreads();
            const float delta = beta * (Lv[j * 128 + dv] - ((red[dv] + red[128 + dv]) + (red[256 + dv] + red[384 + dv])));
            __syncthreads();
            float o = 0.f;
#pragma unroll
            for (int i = 0; i < 32; ++i) { S[i] += Lk[j * 128 + 32 * part + i] * delta; o += Lq[j * 128 + 32 * part + i] * S[i]; }
            red[part * 128 + dv] = o;
            __syncthreads();
            if (part == 0) Lo[j * 128 + dv] = (red[dv] + red[128 + dv]) + (red[256 + dv] + red[384 + dv]);
            __syncthreads();
        }
        float* Sout = KOUT() + O_GSS + ((size_t)((layer * 128 + s) * 4 + h) * 128 + 32 * part) * 128 + dv;
#pragma unroll
        for (int i = 0; i < 32; ++i) Sout[(size_t)i * 128] = S[i];
        ((float*)(ws + WS_OGDN))[(size_t)(r0 + part) * 512 + h * 128 + dv] = Lo[part * 128 + dv];
    } else {
        const f32x2* ROT = (const f32x2*)(ws + WS_ROT);
        if (tid < 384) {
            const int pr = tid >> 7, d = tid & 127;
#pragma unroll
            for (int j = 0; j < 4; ++j) {
                const bf16* zp = Z + (size_t)(r0 + j) * LDZ + ZC_RQKV + pr * 512 + h * 128;
                float v = bf2f(zp[d]);
                if (pr < 2) { const f32x2 cs = ROT[(size_t)(2048 + j) * 64 + (d & 63)]; const float o = bf2f(zp[d ^ 64]);
                    v = (d < 64) ? v * cs.x - o * cs.y : v * cs.x + o * cs.y; if (pr == 1) v *= 0.08838834764831845f; }
                (pr == 0 ? Lq : pr == 1 ? Lk : Lv)[j * 128 + d] = v;
            }
        }
        __syncthreads();
        const float gam = __expf(ret_lg(h));
        const float* Sin = KIN(6) + ((size_t)((layer * 128 + s) * 4 + h) * 128 + 32 * part) * 128 + dv;
#pragma unroll
        for (int i = 0; i < 32; ++i) S[i] = Sin[(size_t)i * 128];
#pragma unroll
        for (int j = 0; j < 4; ++j) {
            const float vv = Lv[j * 128 + dv];
            float o = 0.f;
#pragma unroll
            for (int i = 0; i < 32; ++i) { S[i] = S[i] * gam + Lk[j * 128 + 32 * part + i] * vv; o += Lq[j * 128 + 32 * part + i] * S[i]; }
            red[part * 128 + dv] = o;
            __syncthreads();
            if (part == 0) Lo[j * 128 + dv] = (red[dv] + red[128 + dv]) + (red[256 + dv] + red[384 + dv]);
            __syncthreads();
        }
        float* Sout = KOUT() + O_RSS + ((size_t)((layer * 128 + s) * 4 + h) * 128 + 32 * part) * 128 + dv;
#pragma unroll
        for (int i = 0; i < 32; ++i) Sout[(size_t)i * 128] = S[i];
        if (wave < 4) {
            const int j = wave; const float a = Lo[j * 128 + 2 * lane], b = Lo[j * 128 + 2 * lane + 1];
            const float scl = rsqrtf(wave_sum(a * a + b * b, lane) * (1.f / 128.f) + EPS);
            const bf16* gp = Z + (size_t)(r0 + j) * LDZ + ZC_RG + h * 128 + 2 * lane;
            *(unsigned*)((bf16*)(ws + WS_MIX) + (size_t)(r0 + j) * 1536 + 1024 + h * 128 + 2 * lane) = pk2(a * scl * siluf_(bf2f(gp[0])), b * scl * siluf_(bf2f(gp[1])));
        }
    }
    __syncthreads();
}

DI void gdn_scan_chain(Frame& F, int layer, int bh) {
    int lane = F.lane, wave = F.wave; asm volatile("" : "+v"(lane), "+s"(wave));
    const int tid = wave * 64 + lane, quad = lane >> 4, rl = lane & 15;
    unsigned char* ws = KWS();
    const unsigned char* recb = ws + WS_GREC + (size_t)bh * 128 * GREC;
    LAS unsigned char* L = F.lds;
    constexpr int L_WP = 0, L_QP = 17408, L_KT = 34816, L_UT = 53248, L_QK = 71680;
    f32x4 S[8];
#pragma unroll
    for (int i = 0; i < 8; ++i) S[i] = (f32x4){0.f, 0.f, 0.f, 0.f};
    v4u pf[9]; float egl;
#pragma unroll
    for (int k = 0; k < 9; ++k) pf[k] = *(const v4u*)(recb + (size_t)(tid + 512 * k) * 16);
    egl = *(const float*)(recb + 73728);
    float* OG = (float*)(ws + WS_OGDN);
    const int b = bh >> 2, h = bh & 3;
    for (int c = 0; c < 128; ++c) {
        __syncthreads();
#pragma unroll
        for (int k = 0; k < 9; ++k) {
            const int o = tid * 16 + (k & 1) * 8192;
            const int reg = k >> 1;
            int dst;
            if (reg < 2) dst = (reg == 0 ? L_WP : L_QP) + (o >> 8) * 272 + (o & 255);
            else dst = (reg == 2 ? L_KT : reg == 3 ? L_UT : L_QK) + (o >> 7) * 144 + (o & 127);
            *(LAS v4u*)(L + dst) = pf[k];
        }
        const float eg = egl;
        __syncthreads();
        if (c + 1 < 128) {
            const unsigned char* rn = recb + (size_t)(c + 1) * GREC;
#pragma unroll
            for (int k = 0; k < 9; ++k) pf[k] = *(const v4u*)(rn + (size_t)(tid + 512 * k) * 16);
            egl = *(const float*)(rn + 73728);
        }
        bf16x8 Sb[4];
#pragma unroll
        for (int s = 0; s < 4; ++s) Sb[s] = pack_frag(S[2 * s], S[2 * s + 1]);
        f32x4 vn[4], O[4];
#pragma unroll
        for (int rt = 0; rt < 4; ++rt) {
            f32x4 wsacc = (f32x4){0.f, 0.f, 0.f, 0.f}, o = wsacc;
#pragma unroll
            for (int s = 0; s < 4; ++s) {
                wsacc = mfma16(ld_frag_l(L + L_WP + (16 * rt + rl) * 272 + (32 * s + 8 * quad) * 2), Sb[s], wsacc);
                o = mfma16(ld_frag_l(L + L_QP + (16 * rt + rl) * 272 + (32 * s + 8 * quad) * 2), Sb[s], o);
            }
            const v2u uw = *(const LAS v2u*)(L + L_UT + (16 * wave + rl) * 144 + (16 * rt + 4 * quad) * 2);
            vn[rt][0] = lo_bf(uw.x) - wsacc[0]; vn[rt][1] = hi_bf(uw.x) - wsacc[1]; vn[rt][2] = lo_bf(uw.y) - wsacc[2]; vn[rt][3] = hi_bf(uw.y) - wsacc[3];
            O[rt] = o;
        }
        bf16x8 Vb[2]; Vb[0] = pack_frag(vn[0], vn[1]); Vb[1] = pack_frag(vn[2], vn[3]);
#pragma unroll
        for (int rt = 0; rt < 4; ++rt) {
#pragma unroll
            for (int s2 = 0; s2 < 2; ++s2) O[rt] = mfma16(ld_frag_l(L + L_QK + (16 * rt + rl) * 144 + (32 * s2 + 8 * quad) * 2), Vb[s2], O[rt]);
            const size_t row = (size_t)b * TP + 64 * c + 16 * rt + 4 * quad;
#pragma unroll
            for (int i = 0; i < 4; ++i) OG[(row + i) * 512 + h * 128 + 16 * wave + rl] = O[rt][i];
        }
#pragma unroll
        for (int kt = 0; kt < 8; ++kt) {
            f32x4 a = S[kt] * eg;
#pragma unroll
            for (int s2 = 0; s2 < 2; ++s2) a = mfma16(ld_frag_l(L + L_KT + (16 * kt + rl) * 144 + (32 * s2 + 8 * quad) * 2), Vb[s2], a);
            S[kt] = a;
        }
    }
    float* So = KOUT() + O_GSP + (size_t)(layer * 8 + bh) * 16384;
#pragma unroll
    for (int kt = 0; kt < 8; ++kt)
#pragma unroll
        for (int i = 0; i < 4; ++i) So[(size_t)(16 * kt + 4 * quad + i) * 128 + 16 * wave + rl] = S[kt][i];
    __syncthreads();
}
DI void ret_scan_part(Frame& F, int layer, int r) {
    int tid = F.tid; asm volatile("" : "+v"(tid));
    const int bh = r >> 2, dv = tid & 127, dk0 = ((r & 3) * 4 + (tid >> 7)) * 8, h = bh & 3;
    unsigned char* ws = KWS();
    const float* RKV = (const float*)(ws + WS_RKV) + (size_t)bh * 64 * 16384;
    bf16* RST = (bf16*)(ws + WS_RST) + (size_t)bh * 64 * 16384;
    const float cdec = __expf(128.f * ret_lg(h));
    float S[8];
#pragma unroll
    for (int i = 0; i < 8; ++i) S[i] = 0.f;
#pragma unroll 4
    for (int c = 0; c < 64; ++c) {
        v4u w; w.x = pk2(S[0], S[1]); w.y = pk2(S[2], S[3]); w.z = pk2(S[4], S[5]); w.w = pk2(S[6], S[7]);
        *(v4u*)(RST + (size_t)c * 16384 + dv * 128 + dk0) = w;
#pragma unroll
        for (int i = 0; i < 8; ++i) S[i] = S[i] * cdec + RKV[(size_t)c * 16384 + (dk0 + i) * 128 + dv];
    }
    float* So = KOUT() + O_RSP + (size_t)(layer * 8 + bh) * 16384;
#pragma unroll
    for (int i = 0; i < 8; ++i) So[(size_t)(dk0 + i) * 128 + dv] = S[i];
}
constexpr float SM_C = 0.125f * 1.4426950408889634f;
struct AttnState { float m, l; f32x4 O[4]; };
DI void attn_reset(AttnState& st) { st.m = -1e30f; st.l = 0.f;
#pragma unroll
    for (int i = 0; i < 4; ++i) st.O[i] = (f32x4){0.f, 0.f, 0.f, 0.f}; }
DI void qk_tile(const LAS unsigned char* Kt, const bf16x8 (&qf)[2], f32x4 (&s)[4], int rl, int quad) {
#pragma unroll
    for (int kt = 0; kt < 4; ++kt) { f32x4 a = (f32x4){0.f, 0.f, 0.f, 0.f};
#pragma unroll
        for (int kk = 0; kk < 2; ++kk) a = mfma16(ld_frag_l(Kt + (16 * kt + rl) * 144 + kk * 64 + quad * 16), qf[kk], a);
        s[kt] = a; }
}
template <class Mask> DI void attn_step(const LAS unsigned char* Kt, const LAS unsigned char* VT, const bf16x8 (&qf)[2], AttnState& st, const Mask& ok, int rl, int quad) {
    f32x4 s[4]; qk_tile(Kt, qf, s, rl, quad);
    float mx = -3e38f;
#pragma unroll
    for (int kt = 0; kt < 4; ++kt)
#pragma unroll
        for (int i = 0; i < 4; ++i) if (ok(16 * kt + 4 * quad + i)) mx = fmaxf(mx, s[kt][i]);
    const int lane = rl + 16 * quad;
    mx = fmaxf(mx, shx<16>(mx, lane)); mx = fmaxf(mx, shx<32>(mx, lane));
    const float mn = fmaxf(st.m, mx);
    const float alpha = exp2f((st.m - mn) * SM_C);
    float ls = 0.f;
#pragma unroll
    for (int kt = 0; kt < 4; ++kt)
#pragma unroll
        for (int i = 0; i < 4; ++i) { const float p = ok(16 * kt + 4 * quad + i) ? exp2f((s[kt][i] - mn) * SM_C) : 0.f; s[kt][i] = p; ls += p; }
    ls += shx<16>(ls, lane); ls += shx<32>(ls, lane);
    st.l = st.l * alpha + ls; st.m = mn;
#pragma unroll
    for (int dt = 0; dt < 4; ++dt) st.O[dt] *= alpha;
#pragma unroll
    for (int ii = 0; ii < 2; ++ii) {
        const bf16x8 pb = pack_frag(s[2 * ii], s[2 * ii + 1]);
#pragma unroll
        for (int dt = 0; dt < 4; ++dt) {
            const LAS unsigned char* vp = VT + (16 * dt + rl) * 144 + (32 * ii + 4 * quad) * 2;
            st.O[dt] = mfma16(mk_frag(*(const LAS v2u*)vp, *(const LAS v2u*)(vp + 32)), pb, st.O[dt]);
        }
    }
}
DI void attn_accum(f32x4 (&Of)[4], const AttnState& st, float gate) {
    const float sc = st.l > 0.f ? gate / st.l : 0.f;
#pragma unroll
    for (int dt = 0; dt < 4; ++dt) Of[dt] += st.O[dt] * sc;
}
DI void vt_write(LAS unsigned char* VT, int d0, int key, const v4u w) {
    LAS unsigned char* d = VT + d0 * 144 + key * 2;
    *(LAS bf16*)(d) = (bf16)(w.x & 0xffff); *(LAS bf16*)(d + 144) = (bf16)(w.x >> 16); *(LAS bf16*)(d + 2 * 144) = (bf16)(w.y & 0xffff); *(LAS bf16*)(d + 3 * 144) = (bf16)(w.y >> 16);
    *(LAS bf16*)(d + 4 * 144) = (bf16)(w.z & 0xffff); *(LAS bf16*)(d + 5 * 144) = (bf16)(w.z >> 16); *(LAS bf16*)(d + 6 * 144) = (bf16)(w.w & 0xffff); *(LAS bf16*)(d + 7 * 144) = (bf16)(w.w >> 16);
}
DI void stage_wg(LAS unsigned char* Kt, LAS unsigned char* VT, const bf16* kb, const bf16* vb, size_t stride, int tid, bool do_v) {
    const int key = tid >> 3, ch = tid & 7;
    *(LAS v4u*)(Kt + key * 144 + ch * 16) = *(const v4u*)(kb + key * stride + ch * 8);
    if (do_v) vt_write(VT, ch * 8, key, *(const v4u*)(vb + key * stride + ch * 8));
}
DI unsigned score_key(float s, bool valid, int idx) { return valid ? (((__float_as_uint(s) | 0x80000000u) & ~127u) | (unsigned)(127 - idx)) : 0u; }
DI int key_rank(const LAS unsigned* K, int ng4, unsigned k) {
    int r = 0;
    for (int g = 0; g < ng4; ++g) { const v4u v = *(const LAS v4u*)(K + 4 * g); r += (v.x > k) + (v.y > k) + (v.z > k) + (v.w > k); }
    return r;
}
DI int top16(float v0, float v1, int lane) {
    int sel = 0;
#pragma unroll 1
    for (int r = 0; r < 16; ++r) {
        float bv; int bi;
        if (v0 >= v1) { bv = v0; bi = lane; } else { bv = v1; bi = lane + 64; }
#define T16_STEP(M) { const float ov = shx<M>(bv, lane); const int oi = shxi<M>(bi, lane); const bool take = (ov > bv) || (ov == bv && oi < bi); bv = take ? ov : bv; bi = take ? oi : bi; }
        T16_STEP(32) T16_STEP(16) T16_STEP(8) T16_STEP(4) T16_STEP(2) T16_STEP(1)
#undef T16_STEP
        const bool h0 = (bi == lane), h1 = (bi == lane + 64);
        v0 = h0 ? -3e38f : v0; v1 = h1 ? -3e38f : v1; sel |= (h0 ? 1 : 0) | (h1 ? 2 : 0);
    }
    return sel;
}

typedef short v4i16_t __attribute__((ext_vector_type(4)));
DI s16x4 vtr(const LAS unsigned char* p) { return __builtin_bit_cast(s16x4, __builtin_amdgcn_ds_read_tr16_b64_v4i16((LAS v4i16_t*)p)); }
DI bf16x8 cat4(s16x4 a, s16x4 b) { bf16x8 r; r[0] = a[0]; r[1] = a[1]; r[2] = a[2]; r[3] = a[3]; r[4] = b[0]; r[5] = b[1]; r[6] = b[2]; r[7] = b[3]; return r; }
DI void attn_step3(const LAS unsigned char* Kt, const LAS unsigned char* Vt, const bf16x8 (&qf)[2], AttnState& st, int lo, int hi, bool active, int rl, int quad) {
    active = active && (hi >= lo);
    if (!__any(active)) return;
    f32x4 s[4]; qk_tile(Kt, qf, s, rl, quad);
    const int lane = rl + 16 * quad;
    const bool full = __all((lo <= 0 && hi >= 63) || !active);
    const int kq = 4 * quad - lo; const unsigned rng = (unsigned)(hi - lo);
    float lm;
    if (full) {
        const float a0 = fmaxf(fmaxf(s[0][0], s[0][1]), fmaxf(s[0][2], s[0][3])), a1 = fmaxf(fmaxf(s[1][0], s[1][1]), fmaxf(s[1][2], s[1][3]));
        const float a2 = fmaxf(fmaxf(s[2][0], s[2][1]), fmaxf(s[2][2], s[2][3])), a3 = fmaxf(fmaxf(s[3][0], s[3][1]), fmaxf(s[3][2], s[3][3]));
        lm = fmaxf(fmaxf(a0, a1), fmaxf(a2, a3));
    } else {
        lm = -3e38f;
#pragma unroll
        for (int kt = 0; kt < 4; ++kt)
#pragma unroll
            for (int i = 0; i < 4; ++i) lm = ((unsigned)(kq + 16 * kt + i) <= rng) ? fmaxf(lm, s[kt][i]) : lm;
    }
    lm = active ? lm : -3e38f;
    if (__any(lm > st.m + 320.f)) {
        float mx = fmaxf(lm, shx<16>(lm, lane)); mx = fmaxf(mx, shx<32>(mx, lane));
        const float mn = fmaxf(st.m, mx);
        const float alpha = __builtin_amdgcn_exp2f((st.m - mn) * SM_C);
        st.l *= alpha; st.m = mn;
#pragma unroll
        for (int dt = 0; dt < 4; ++dt) st.O[dt] *= alpha;
    }
    const float mc = active ? st.m * SM_C : __builtin_inff();
    float ls = 0.f;
    if (full) {
#pragma unroll
        for (int kt = 0; kt < 4; ++kt)
#pragma unroll
            for (int i = 0; i < 4; ++i) { const float p = __builtin_amdgcn_exp2f(s[kt][i] * SM_C - mc); s[kt][i] = p; ls += p; }
    } else {
#pragma unroll
        for (int kt = 0; kt < 4; ++kt)
#pragma unroll
            for (int i = 0; i < 4; ++i) { const float p = ((unsigned)(kq + 16 * kt + i) <= rng) ? __builtin_amdgcn_exp2f(s[kt][i] * SM_C - mc) : 0.f; s[kt][i] = p; ls += p; }
    }
    st.l += ls;
#pragma unroll
    for (int ii = 0; ii < 2; ++ii) {
        const bf16x8 pb = pack_frag(s[2 * ii], s[2 * ii + 1]);
#pragma unroll
        for (int dt = 0; dt < 4; ++dt) {
            const LAS unsigned char* vp = Vt + (32 * ii + 4 * quad + (rl >> 2)) * 144 + (16 * dt + 4 * (rl & 3)) * 2;
            st.O[dt] = mfma16(cat4(vtr(vp), vtr(vp + 16 * 144)), pb, st.O[dt]);
        }
    }
}
DI float attn_rowsum(const AttnState& st, int lane) { float l = st.l; l += shx<16>(l, lane); l += shx<32>(l, lane); return l; }
DI void attn_accum3(f32x4 (&Of)[4], const AttnState& st, float gate, int lane) {
    const float l = attn_rowsum(st, lane);
    const float sc = l > 0.f ? gate / l : 0.f;
#pragma unroll
    for (int dt = 0; dt < 4; ++dt) Of[dt] += st.O[dt] * sc;
}
DI float tile_max(const f32x4 (&s)[4], bool full, int kq, unsigned rng) {
    float lm;
    if (full) {
        const float a0 = fmaxf(fmaxf(s[0][0], s[0][1]), fmaxf(s[0][2], s[0][3])), a1 = fmaxf(fmaxf(s[1][0], s[1][1]), fmaxf(s[1][2], s[1][3]));
        const float a2 = fmaxf(fmaxf(s[2][0], s[2][1]), fmaxf(s[2][2], s[2][3])), a3 = fmaxf(fmaxf(s[3][0], s[3][1]), fmaxf(s[3][2], s[3][3]));
        lm = fmaxf(fmaxf(a0, a1), fmaxf(a2, a3));
    } else {
        lm = -3e38f;
#pragma unroll
        for (int kt = 0; kt < 4; ++kt)
#pragma unroll
            for (int i = 0; i < 4; ++i) lm = ((unsigned)(kq + 16 * kt + i) <= rng) ? fmaxf(lm, s[kt][i]) : lm;
    }
    return lm;
}
DI float tile_exp(f32x4 (&s)[4], bool full, int kq, unsigned rng, float mc) {
    float ls = 0.f;
    if (full) {
#pragma unroll
        for (int kt = 0; kt < 4; ++kt)
#pragma unroll
            for (int i = 0; i < 4; ++i) { const float p = __builtin_amdgcn_exp2f(s[kt][i] * SM_C - mc); s[kt][i] = p; ls += p; }
    } else {
#pragma unroll
        for (int kt = 0; kt < 4; ++kt)
#pragma unroll
            for (int i = 0; i < 4; ++i) { const float p = ((unsigned)(kq + 16 * kt + i) <= rng) ? __builtin_amdgcn_exp2f(s[kt][i] * SM_C - mc) : 0.f; s[kt][i] = p; ls += p; }
    }
    return ls;
}
DI void tile_pv(const LAS unsigned char* Vt, const f32x4 (&s)[4], f32x4 (&O)[4], int rl, int quad) {
#pragma unroll
    for (int ii = 0; ii < 2; ++ii) {
        const bf16x8 pb = pack_frag(s[2 * ii], s[2 * ii + 1]);
#pragma unroll
        for (int dt = 0; dt < 4; ++dt) {
            const LAS unsigned char* vp = Vt + (32 * ii + 4 * quad + (rl >> 2)) * 144 + (16 * dt + 4 * (rl & 3)) * 2;
            O[dt] = mfma16(cat4(vtr(vp), vtr(vp + 16 * 144)), pb, O[dt]);
        }
    }
}
DI void attn_step_pair(const LAS unsigned char* K0, const LAS unsigned char* V0, int lo0, int hi0, bool act0,
                       const LAS unsigned char* K1, const LAS unsigned char* V1, int lo1, int hi1, bool act1,
                       const bf16x8 (&qf)[2], AttnState& st, int rl, int quad) {
    act0 = act0 && (hi0 >= lo0); act1 = act1 && (hi1 >= lo1);
    const bool any0 = __any(act0), any1 = __any(act1);
    if (!any0 && !any1) return;
    const int lane = rl + 16 * quad;
    f32x4 s0[4], s1[4];
    if (any0) qk_tile(K0, qf, s0, rl, quad);
    if (any1) qk_tile(K1, qf, s1, rl, quad);
    const bool full0 = __all((lo0 <= 0 && hi0 >= 63) || !act0), full1 = __all((lo1 <= 0 && hi1 >= 63) || !act1);
    const int kq0 = 4 * quad - lo0, kq1 = 4 * quad - lo1; const unsigned rng0 = (unsigned)(hi0 - lo0), rng1 = (unsigned)(hi1 - lo1);
    float lm = -3e38f;
    if (any0) { const float a = tile_max(s0, full0, kq0, rng0); lm = act0 ? a : lm; }
    if (any1) { const float a = tile_max(s1, full1, kq1, rng1); lm = act1 ? fmaxf(lm, a) : lm; }
    if (__any(lm > st.m + 320.f)) {
        float mx = fmaxf(lm, shx<16>(lm, lane)); mx = fmaxf(mx, shx<32>(mx, lane));
        const float mn = fmaxf(st.m, mx);
        const float alpha = __builtin_amdgcn_exp2f((st.m - mn) * SM_C);
        st.l *= alpha; st.m = mn;
#pragma unroll
        for (int dt = 0; dt < 4; ++dt) st.O[dt] *= alpha;
    }
    const float mcb = st.m * SM_C;
    if (any0) st.l += tile_exp(s0, full0, kq0, rng0, act0 ? mcb : __builtin_inff());
    if (any1) st.l += tile_exp(s1, full1, kq1, rng1, act1 ? mcb : __builtin_inff());
    if (any0) tile_pv(V0, s0, st.O, rl, quad);
    if (any1) tile_pv(V1, s1, st.O, rl, quad);
}
DI void nsa_prompt_unit(Frame& F, int layer, int unit) {
    int lane = F.lane, wave = F.wave; asm volatile("" : "+v"(lane), "+s"(wave));
    const int tid = wave * 64 + lane, quad = lane >> 4, rl = lane & 15;
    const int b = unit >> 9, g = (unit >> 8) & 1, tt = unit & 255, t0 = 32 * tt;
    unsigned char* ws = KWS();
    const bf16* Z = (const bf16*)(ws + WS_Z);
    const float* ZS = (const float*)(ws + WS_ZS);
    LAS unsigned char* TB = F.lds;
    LAS float* AIMP = (LAS float*)(F.lds + 73728);
    LAS unsigned* SEL = (LAS unsigned*)(F.lds + 139264);
    const int tk = 4 * wave + (rl >> 2), t = t0 + tk, head = 4 * g + (rl & 3);
    const size_t row = (size_t)b * TP + t;
    bf16x8 qf[2];
    qf[0] = ld_frag_g(Z + row * LDZ + ZC_Q + head * 64 + quad * 8); qf[1] = ld_frag_g(Z + row * LDZ + ZC_Q + head * 64 + 32 + quad * 8);
    const float gc = sigmoidf_(ZS[row * 32 + head * 3]), gs = sigmoidf_(ZS[row * 32 + head * 3 + 1]), gw = sigmoidf_(ZS[row * 32 + head * 3 + 2]);
    f32x4 Of[4];
#pragma unroll
    for (int i = 0; i < 4; ++i) Of[i] = (f32x4){0.f, 0.f, 0.f, 0.f};
    AttnState st;
    const int nct = (t0 >> 10) + 1;
    const bf16* KC = (const bf16*)(ws + WS_KC) + ((size_t)(0 * 2 + b) * 512 * 2 + g) * 64;
    const bf16* VC = (const bf16*)(ws + WS_KC) + ((size_t)(1 * 2 + b) * 512 * 2 + g) * 64;
    const bf16* Zb = Z + (size_t)b * TP * LDZ + g * 64;
    const int skey = tid >> 3, sch = tid & 7;
    const int wlo = (t0 - 511 > 0 ? t0 - 511 : 0) >> 6, nwin = ((t0 + 31) >> 6) - wlo + 1;
    const int nwe = (nwin + 1) & ~1, nce = (nct + 1) & ~1;
    v4u rkA, rvA, rkB, rvB;
#define COMMIT(slot, rk, rv) do { LAS unsigned char* d_ = TB + (slot) * 18432 + skey * 144 + sch * 16; *(LAS v4u*)d_ = rk; *(LAS v4u*)(d_ + 9216) = rv; } while (0)
    const int n1 = nwe + 2 * nce;
#define SEG1_VALID(i) ((i) < nwe ? (i) < nwin : (((i) - nwe) < nce ? ((i) - nwe) < nct : ((i) - nwe - nce) < nct))
#define SEG1_ISSUE(i, rk, rv) do { const int i_ = (i); if (i_ < n1 && SEG1_VALID(i_)) { if (i_ < nwe) { const bf16* p_ = Zb + (size_t)(64 * (wlo + i_) + skey) * LDZ + sch * 8; rk = *(const v4u*)(p_ + ZC_KW); rv = *(const v4u*)(p_ + ZC_VW); } \
        else { const int jt_ = (i_ - nwe) % nce; const size_t o_ = (size_t)(64 * jt_ + skey) * 128 + sch * 8; rk = *(const v4u*)(KC + o_); rv = *(const v4u*)(VC + o_); } } } while (0)
    attn_reset(st);
    float mfin = 0.f, il = 0.f;
    SEG1_ISSUE(0, rkA, rvA); SEG1_ISSUE(1, rkB, rvB);
    COMMIT(0, rkA, rvA); COMMIT(1, rkB, rvB);
    SEG1_ISSUE(2, rkA, rvA); SEG1_ISSUE(3, rkB, rvB);
    __syncthreads();
    for (int i = 0; i < n1; i += 2) {
        const LAS unsigned char* K0 = TB + (i & 3) * 18432; const LAS unsigned char* K1 = TB + ((i + 1) & 3) * 18432;
        if (i < nwe) {
            const int kb0 = 64 * (wlo + i), kb1 = kb0 + 64;
            attn_step_pair(K0, K0 + 9216, t - 511 - kb0, t - kb0, true, K1, K1 + 9216, t - 511 - kb1, t - kb1, (i + 1) < nwin, qf, st, rl, quad);
            if (i + 2 == nwe) { attn_accum3(Of, st, gw, lane); attn_reset(st); }
        } else if (i < nwe + nce) {
            const int nb0 = 64 * (i - nwe), nb1 = nb0 + 64;
            attn_step_pair(K0, K0 + 9216, 0, ((t - 31) >> 4) - nb0, true, K1, K1 + 9216, 0, ((t - 31) >> 4) - nb1, (i + 1 - nwe) < nct, qf, st, rl, quad);
            if (i + 2 == nwe + nce) { attn_accum3(Of, st, gc, lane); mfin = st.m * SM_C; const float lt_ = attn_rowsum(st, lane); il = lt_ > 0.f ? 1.f / lt_ : 0.f; }
        } else {
#pragma unroll
            for (int e2 = 0; e2 < 2; ++e2) {
                const int jt = i + e2 - nwe - nce;
                if (jt < nct) {
                    f32x4 s[4]; qk_tile(e2 ? K1 : K0, qf, s, rl, quad);
#pragma unroll
                    for (int kt = 0; kt < 4; ++kt)
#pragma unroll
                        for (int e = 0; e < 4; ++e) {
                            const int n = 64 * jt + 16 * kt + 4 * quad + e;
                            float p = (16 * n + 31 <= t) ? __builtin_amdgcn_exp2f(s[kt][e] * SM_C - mfin) * il : 0.f;
                            p += shx<1>(p, lane); p += shx<2>(p, lane);
                            if ((rl & 3) == 0) AIMP[tk * 512 + n] = p;
                        }
                }
            }
        }
        if (i + 2 < n1) { if (SEG1_VALID(i + 2)) COMMIT((i + 2) & 3, rkA, rvA); if (SEG1_VALID(i + 3)) COMMIT((i + 3) & 3, rkB, rvB); }
        __syncthreads();
        SEG1_ISSUE(i + 4, rkA, rvA); SEG1_ISSUE(i + 5, rkB, rvB);
    }
    {
        const int nav = nct * 64;
        LAS unsigned* KS = (LAS unsigned*)(TB + wave * 2048);
#pragma unroll
        for (int q = 0; q < 4; ++q) {
            const int tq = 4 * wave + q, cur = (t0 + tq) >> 6;
#pragma unroll
            for (int e = 0; e < 2; ++e) {
                const int sblk = lane + 64 * e;
                float imp = 0.f;
#pragma unroll
                for (int d = -1; d <= 3; ++d) { const int n = 4 * sblk + d; if (n >= 0 && n < nav) imp += AIMP[tq * 512 + n]; }
                const bool valid = sblk <= cur, forced = (sblk == 0) || (sblk == cur) || (sblk == cur - 1);
                KS[q * 128 + sblk] = score_key(imp + (forced ? 1000.f : 0.f), valid, sblk);
            }
        }
        asm volatile("" ::: "memory");
#pragma unroll
        for (int q = 0; q < 4; ++q) {
            const int tq = 4 * wave + q, cur = (t0 + tq) >> 6, ng4 = (cur >> 2) + 1;
            const unsigned k0 = KS[q * 128 + lane], k1 = KS[q * 128 + 64 + lane];
            const bool s0 = (lane <= cur) && key_rank(KS + q * 128, ng4, k0) < 16, s1 = (lane + 64 <= cur) && key_rank(KS + q * 128, ng4, k1) < 16;
            const unsigned long long m0 = __ballot(s0), m1 = __ballot(s1);
            if (lane == 0) { SEL[tq * 4 + 0] = (unsigned)m0; SEL[tq * 4 + 1] = (unsigned)(m0 >> 32); SEL[tq * 4 + 2] = (unsigned)m1; SEL[tq * 4 + 3] = (unsigned)(m1 >> 32); }
        }
    }
    __syncthreads();
    unsigned un[4], my[4], wv[4];
#pragma unroll
    for (int w = 0; w < 4; ++w) { unsigned v = (lane < 32) ? SEL[lane * 4 + w] : 0u;
        v |= (unsigned)shxi<1>((int)v, lane); v |= (unsigned)shxi<2>((int)v, lane); v |= (unsigned)shxi<4>((int)v, lane); v |= (unsigned)shxi<8>((int)v, lane); v |= (unsigned)shxi<16>((int)v, lane); v |= (unsigned)shxi<32>((int)v, lane);
        un[w] = __builtin_amdgcn_readfirstlane(v); my[w] = SEL[tk * 4 + w];
        wv[w] = SEL[(4 * wave) * 4 + w] | SEL[(4 * wave + 1) * 4 + w] | SEL[(4 * wave + 2) * 4 + w] | SEL[(4 * wave + 3) * 4 + w]; wv[w] = __builtin_amdgcn_readfirstlane(wv[w]); }
    attn_reset(st);
    {
        unsigned w0 = un[0], w1 = un[1], w2 = un[2], w3 = un[3];
#define NEXT_BLK(dst) do { if (w0) { dst = __builtin_ctz(w0); w0 &= w0 - 1u; } else if (w1) { dst = 32 + __builtin_ctz(w1); w1 &= w1 - 1u; } else if (w2) { dst = 64 + __builtin_ctz(w2); w2 &= w2 - 1u; } \
        else if (w3) { dst = 96 + __builtin_ctz(w3); w3 &= w3 - 1u; } else dst = -1; } while (0)
#define SEG2_ISSUE(blk_, rk, rv) do { if ((blk_) >= 0) { const bf16* p_ = Zb + (size_t)(64 * (blk_) + skey) * LDZ + sch * 8; rk = *(const v4u*)(p_ + ZC_KS); rv = *(const v4u*)(p_ + ZC_VS); } } while (0)
#define BLK_WORD(arr, blk_) (((blk_) >> 5) == 0 ? arr[0] : ((blk_) >> 5) == 1 ? arr[1] : ((blk_) >> 5) == 2 ? arr[2] : arr[3])
        int c0, c1, n0, n1b, m0, m1;
        NEXT_BLK(c0); NEXT_BLK(c1); NEXT_BLK(n0); NEXT_BLK(n1b);
        SEG2_ISSUE(c0, rkA, rvA); SEG2_ISSUE(c1, rkB, rvB);
        COMMIT(0, rkA, rvA); if (c1 >= 0) COMMIT(1, rkB, rvB);
        SEG2_ISSUE(n0, rkA, rvA); SEG2_ISSUE(n1b, rkB, rvB);
        __syncthreads();
        int i = 0;
        while (c0 >= 0) {
            NEXT_BLK(m0); NEXT_BLK(m1);
            const LAS unsigned char* K0 = TB + (i & 3) * 18432; const LAS unsigned char* K1 = TB + ((i + 1) & 3) * 18432;
            const int cc1 = c1 >= 0 ? c1 : 0;
            const bool need0 = (BLK_WORD(wv, c0) >> (c0 & 31)) & 1u, need1 = (c1 >= 0) && ((BLK_WORD(wv, cc1) >> (cc1 & 31)) & 1u);
            const bool mine0 = need0 && ((BLK_WORD(my, c0) >> (c0 & 31)) & 1u), mine1 = need1 && ((BLK_WORD(my, cc1) >> (cc1 & 31)) & 1u);
            attn_step_pair(K0, K0 + 9216, 0, t - 64 * c0, mine0, K1, K1 + 9216, 0, t - 64 * cc1, mine1, qf, st, rl, quad);
            if (n0 >= 0) COMMIT((i + 2) & 3, rkA, rvA); if (n1b >= 0) COMMIT((i + 3) & 3, rkB, rvB);
            __syncthreads();
            SEG2_ISSUE(m0, rkA, rvA); SEG2_ISSUE(m1, rkB, rvB);
            c0 = n0; c1 = n1b; n0 = m0; n1b = m1; i += 2;
        }
    }
    attn_accum3(Of, st, gs, lane);
#undef SEG1_ISSUE
#undef SEG1_VALID
#undef SEG2_ISSUE
#undef BLK_WORD
#undef COMMIT
#undef NEXT_BLK
    bf16* MIX = (bf16*)(ws + WS_MIX) + row * 1536 + head * 64;
#pragma unroll
    for (int dt = 0; dt < 4; ++dt) { v2u w; w.x = pk2(Of[dt][0], Of[dt][1]); w.y = pk2(Of[dt][2], Of[dt][3]); *(v2u*)(MIX + 16 * dt + 4 * quad) = w; }
    __syncthreads();
}

#define CB() asm volatile("" ::: "memory")
DI void stage_wave_f32(LAS unsigned char* Kt, LAS unsigned char* Vt, const float* kb, const float* vb, size_t stride, int lane) {
    const int k0 = lane >> 3, ch = lane & 7;
#pragma unroll
    for (int h = 0; h < 4; ++h) {
        const float* src = (h < 2 ? kb : vb); LAS unsigned char* dst = (h < 2 ? Kt : Vt); const int r0 = (h & 1) * 32;
        f32x4 a[4][2];
#pragma unroll
        for (int it = 0; it < 4; ++it) { const float* kp = src + (size_t)(r0 + it * 8 + k0) * stride + ch * 8; a[it][0] = *(const f32x4*)kp; a[it][1] = *(const f32x4*)(kp + 4); }
#pragma unroll
        for (int it = 0; it < 4; ++it) *(LAS v4u*)(dst + (r0 + it * 8 + k0) * 144 + ch * 16) = pack8(a[it][0], a[it][1]);
        asm volatile("" ::: "memory");
    }
}
DI void stage_wave_b16(LAS unsigned char* Kt, LAS unsigned char* Vt, const bf16* kb, const bf16* vb, size_t stride, int nvalid, int lane, bool do_v) {
    const int k0 = lane >> 3, ch = lane & 7;
    const v4u z = (v4u){0u, 0u, 0u, 0u};
#pragma unroll
    for (int it = 0; it < 8; ++it) {
        const int key = it * 8 + k0; const bool v = key < nvalid;
        *(LAS v4u*)(Kt + key * 144 + ch * 16) = v ? *(const v4u*)(kb + key * stride + ch * 8) : z;
        if (do_v) *(LAS v4u*)(Vt + key * 144 + ch * 16) = v ? *(const v4u*)(vb + key * stride + ch * 8) : z;
    }
}
DI void nsa_sample_unit(Frame& F, int layer, int s) {
    int lane = F.lane, wave = F.wave; asm volatile("" : "+v"(lane), "+s"(wave));
    const int quad = lane >> 4, rl = lane & 15;
    const int g = wave & 1, q4 = wave >> 1;
    unsigned char* ws = KWS();
    const bf16* Z = (const bf16*)(ws + WS_Z);
    const float* ZS = (const float*)(ws + WS_ZS);
    LAS unsigned char* Kt = F.lds + wave * 18432; LAS unsigned char* Vt = Kt + 9216;
    LAS float* AIMP = (LAS float*)Vt;
    const int j = rl >> 2, head = 4 * g + (rl & 3), qpos = 2048 + j;
    const size_t row = (size_t)MP + 4 * s + j;
    bf16x8 qf[2];
    qf[0] = ld_frag_g(Z + row * LDZ + ZC_Q + head * 64 + quad * 8); qf[1] = ld_frag_g(Z + row * LDZ + ZC_Q + head * 64 + 32 + quad * 8);
    const float gc = sigmoidf_(ZS[row * 32 + head * 3]), gs = sigmoidf_(ZS[row * 32 + head * 3 + 1]), gw = sigmoidf_(ZS[row * 32 + head * 3 + 2]);
    f32x4 Of[4];
#pragma unroll
    for (int i = 0; i < 4; ++i) Of[i] = (f32x4){0.f, 0.f, 0.f, 0.f};
    AttnState st;
    const bf16* KC = (const bf16*)(ws + WS_KCS) + ((size_t)(0 * 128 + s) * 128 * 2 + g) * 64;
    const bf16* VC = (const bf16*)(ws + WS_KCS) + ((size_t)(1 * 128 + s) * 128 * 2 + g) * 64;
    attn_reset(st);
#pragma unroll 1
    for (int jt = 0; jt < 2; ++jt) {
        stage_wave_b16(Kt, Vt, KC + (size_t)64 * jt * 128, VC + (size_t)64 * jt * 128, 128, 64, lane, true); CB();
        attn_step3(Kt, Vt, qf, st, 0, 126 - 64 * jt, true, rl, quad); CB();
    }
    attn_accum3(Of, st, q4 == 0 ? gc : 0.f, lane);
    {
        const float mfin = st.m * SM_C, lt = attn_rowsum(st, lane), il = lt > 0.f ? 1.f / lt : 0.f;
#pragma unroll 1
        for (int jt = 0; jt < 2; ++jt) {
            stage_wave_b16(Kt, Vt, KC + (size_t)64 * jt * 128, VC, 128, 64, lane, false); CB();
            f32x4 sv[4]; qk_tile(Kt, qf, sv, rl, quad); CB();
#pragma unroll
            for (int kt = 0; kt < 4; ++kt)
#pragma unroll
                for (int i = 0; i < 4; ++i) {
                    const int n = 64 * jt + 16 * kt + 4 * quad + i;
                    float p = (n <= 126) ? __builtin_amdgcn_exp2f(sv[kt][i] * SM_C - mfin) * il : 0.f;
                    p += shx<1>(p, lane); p += shx<2>(p, lane);
                    if ((rl & 3) == 0) AIMP[j * 128 + n] = p;
                }
        }
    }
    CB();
    unsigned long long msk[4];
    {
        unsigned keys[4];
#pragma unroll
        for (int q = 0; q < 4; ++q) {
            float imp = 0.f;
#pragma unroll
            for (int d = -1; d <= 3; ++d) { const int n = 4 * lane + d; if (n >= 0 && n <= 126 && lane < 33) imp += AIMP[q * 128 + n]; }
            const bool forced = (lane == 0) || (lane == 32) || (lane == 31);
            keys[q] = score_key(imp + (forced ? 1000.f : 0.f), lane < 33, lane);
        }
        CB();
        LAS unsigned* KS = (LAS unsigned*)Kt;
#pragma unroll
        for (int q = 0; q < 4; ++q) KS[q * 64 + lane] = keys[q];
        CB();
#pragma unroll
        for (int q = 0; q < 4; ++q) msk[q] = __ballot(lane < 33 && key_rank(KS + q * 64, 9, keys[q]) < 16);
    }
    CB();
    const unsigned long long un = msk[0] | msk[1] | msk[2] | msk[3];
    const unsigned long long mym = j == 0 ? msk[0] : j == 1 ? msk[1] : j == 2 ? msk[2] : msk[3];
    const int* pt = (const int*)KIN(7);
    AttnState sw;
    attn_reset(st); attn_reset(sw);
    {
        unsigned long long word = un; int idx = 0;
        while (word) {
            const int blk = __builtin_ctzll(word); word &= word - 1ull;
            if ((idx++ & 3) != q4) continue;
            if (blk < 32) {
                const int phys = pt[s * 16 + (blk >> 1)];
                const float* base = KIN(2) + ((size_t)(layer * 2560 + phys) * 128 + (blk & 1) * 64) * 512 + g * 64;
                stage_wave_f32(Kt, Vt, base + 256, base + 384, 512, lane); CB();
            } else {
                stage_wave_b16(Kt, Vt, Z + (size_t)(MP + 4 * s) * LDZ + ZC_KS + g * 64, Z + (size_t)(MP + 4 * s) * LDZ + ZC_VS + g * 64, LDZ, 4, lane, true); CB();
            }
            attn_step3(Kt, Vt, qf, st, 0, qpos - 64 * blk, (mym >> blk) & 1ull, rl, quad); CB();
        }
#pragma unroll 1
        for (int jt = 0; jt < 9; ++jt) {
            if ((idx++ & 3) != q4) continue;
            if (jt < 8) { const float* base = KIN(3) + ((size_t)(layer * 128 + s) * 512 + 64 * jt) * 256 + g * 64; stage_wave_f32(Kt, Vt, base, base + 128, 256, lane); CB(); }
            else { stage_wave_b16(Kt, Vt, Z + (size_t)(MP + 4 * s) * LDZ + ZC_KW + g * 64, Z + (size_t)(MP + 4 * s) * LDZ + ZC_VW + g * 64, LDZ, 4, lane, true); CB(); }
            attn_step3(Kt, Vt, qf, sw, j + 1 - 64 * jt, 512 + j - 64 * jt, true, rl, quad); CB();
        }
    }
    int lane2 = lane; asm volatile("" : "+v"(lane2));
    LAS float* X = (LAS float*)(F.lds + wave * 18432);
    {
        const float ls = attn_rowsum(st, lane), lw = attn_rowsum(sw, lane);
        X[0 * 64 + lane2] = st.m; X[1 * 64 + lane2] = ls; X[18 * 64 + lane2] = sw.m; X[19 * 64 + lane2] = lw;
#pragma unroll
        for (int dt = 0; dt < 4; ++dt)
#pragma unroll
            for (int e = 0; e < 4; ++e) { X[(2 + 4 * dt + e) * 64 + lane2] = st.O[dt][e]; X[(20 + 4 * dt + e) * 64 + lane2] = sw.O[dt][e]; }
    }
    __syncthreads();
    if (q4 == 0) {
#pragma unroll
        for (int br = 0; br < 2; ++br) {
            float m[4], l[4];
#pragma unroll
            for (int q = 0; q < 4; ++q) { const LAS float* Y = (const LAS float*)(F.lds + (2 * q + g) * 18432) + br * 18 * 64; m[q] = Y[lane2]; l[q] = Y[64 + lane2]; }
            const float mm = fmaxf(fmaxf(m[0], m[1]), fmaxf(m[2], m[3]));
            float w[4], lt = 0.f;
#pragma unroll
            for (int q = 0; q < 4; ++q) { w[q] = __builtin_amdgcn_exp2f((m[q] - mm) * SM_C); lt += l[q] * w[q]; }
            const float gate = br == 0 ? gs : gw;
            const float sc = lt > 0.f ? gate / lt : 0.f;
#pragma unroll
            for (int q = 0; q < 4; ++q) { const LAS float* Y = (const LAS float*)(F.lds + (2 * q + g) * 18432) + br * 18 * 64; const float wq = w[q] * sc;
#pragma unroll
                for (int dt = 0; dt < 4; ++dt)
#pragma unroll
                    for (int e = 0; e < 4; ++e) Of[dt][e] += Y[(2 + 4 * dt + e) * 64 + lane2] * wq; }
        }
        bf16* MIX = (bf16*)(ws + WS_MIX) + row * 1536 + head * 64;
#pragma unroll
        for (int dt = 0; dt < 4; ++dt) { v2u w2; w2.x = pk2(Of[dt][0], Of[dt][1]); w2.y = pk2(Of[dt][2], Of[dt][3]); *(v2u*)(MIX + 16 * dt + 4 * quad) = w2; }
    }
    __syncthreads();
}
DI void ret_out_unit(Frame& F, int layer, int unit) {
    const int tid = F.tid, lane = F.lane, wave = F.wave, quad = lane >> 4, rl = lane & 15;
    const int b = unit >> 8, h = (unit >> 6) & 3, c = unit & 63;
    const int row0 = b * TP + 128 * c;
    unsigned char* ws = KWS();
    const bf16* Z = (const bf16*)(ws + WS_Z);
    const bf16* QR = (const bf16*)(ws + WS_QR); const bf16* KR = (const bf16*)(ws + WS_KR);
    const bf16* RST = (const bf16*)(ws + WS_RST) + (size_t)unit * 16384;
    LAS unsigned char* LQ = F.lds; LAS unsigned char* LK = F.lds + 34816; LAS unsigned char* LV = F.lds + 69632; LAS unsigned char* LS = F.lds + 104448;
    for (int it = tid; it < 2048; it += NTHREADS) {
        const int j = it >> 4, cc = it & 15;
        *(LAS v4u*)(LQ + j * 272 + cc * 16) = *(const v4u*)(QR + (size_t)(row0 + j) * 512 + h * 128 + cc * 8);
        *(LAS v4u*)(LK + j * 272 + cc * 16) = *(const v4u*)(KR + (size_t)(row0 + j) * 512 + h * 128 + cc * 8);
        *(LAS v4u*)(LS + j * 272 + cc * 16) = *(const v4u*)(RST + (size_t)j * 128 + cc * 8);
        const v4u w = *(const v4u*)(Z + (size_t)(row0 + j) * LDZ + ZC_RQKV + 1024 + h * 128 + cc * 8);
        LAS unsigned char* d = LV + (cc * 8) * 272 + j * 2;
        *(LAS bf16*)(d) = (bf16)(w.x & 0xffff); *(LAS bf16*)(d + 272) = (bf16)(w.x >> 16); *(LAS bf16*)(d + 2 * 272) = (bf16)(w.y & 0xffff); *(LAS bf16*)(d + 3 * 272) = (bf16)(w.y >> 16);
        *(LAS bf16*)(d + 4 * 272) = (bf16)(w.z & 0xffff); *(LAS bf16*)(d + 5 * 272) = (bf16)(w.z >> 16); *(LAS bf16*)(d + 6 * 272) = (bf16)(w.w & 0xffff); *(LAS bf16*)(d + 7 * 272) = (bf16)(w.w >> 16);
    }
    __syncthreads();
    const float lg = ret_lg(h);
    const int il = 16 * wave + rl;
    bf16x8 qb[4];
#pragma unroll
    for (int s = 0; s < 4; ++s) qb[s] = ld_frag_l(LQ + il * 272 + (32 * s + 8 * quad) * 2);
    f32x4 C[8];
    const float qdec = __expf((float)(il + 1) * lg);
#pragma unroll
    for (int dt = 0; dt < 8; ++dt) {
        f32x4 a = (f32x4){0.f, 0.f, 0.f, 0.f};
#pragma unroll
        for (int s = 0; s < 4; ++s) a = mfma16(ld_frag_l(LS + (16 * dt + rl) * 272 + (32 * s + 8 * quad) * 2), qb[s], a);
        C[dt] = a * qdec;
    }
    for (int s2 = 0; s2 <= (wave >> 1); ++s2) {
        f32x4 P[2];
#pragma unroll
        for (int e = 0; e < 2; ++e) {
            const int jt = 2 * s2 + e;
            f32x4 a = (f32x4){0.f, 0.f, 0.f, 0.f};
            if (jt <= wave) {
#pragma unroll
                for (int s = 0; s < 4; ++s) a = mfma16(ld_frag_l(LK + (16 * jt + rl) * 272 + (32 * s + 8 * quad) * 2), qb[s], a);
#pragma unroll
                for (int i = 0; i < 4; ++i) { const int jj = 16 * jt + 4 * quad + i; a[i] = (il >= jj) ? a[i] * __expf((float)(il - jj) * lg) : 0.f; }
            }
            P[e] = a;
        }
        const bf16x8 pb = pack_frag(P[0], P[1]);
#pragma unroll
        for (int dt = 0; dt < 8; ++dt) {
            const LAS unsigned char* vp = LV + (16 * dt + rl) * 272 + (32 * s2 + 4 * quad) * 2;
            C[dt] = mfma16(mk_frag(*(const LAS v2u*)vp, *(const LAS v2u*)(vp + 32)), pb, C[dt]);
        }
    }
    float ss = 0.f;
#pragma unroll
    for (int dt = 0; dt < 8; ++dt) ss += (C[dt][0] * C[dt][0] + C[dt][1] * C[dt][1]) + (C[dt][2] * C[dt][2] + C[dt][3] * C[dt][3]);
    ss += shx<16>(ss, lane); ss += shx<32>(ss, lane);
    const float scl = rsqrtf(ss * (1.f / 128.f) + EPS);
    const size_t row = (size_t)row0 + il;
#pragma unroll
    for (int dt = 0; dt < 8; ++dt) {
        const v2u gwd = *(const v2u*)(Z + row * LDZ + ZC_RG + h * 128 + 16 * dt + 4 * quad);
        v2u w; w.x = pk2(C[dt][0] * scl * siluf_(lo_bf(gwd.x)), C[dt][1] * scl * siluf_(hi_bf(gwd.x))); w.y = pk2(C[dt][2] * scl * siluf_(lo_bf(gwd.y)), C[dt][3] * scl * siluf_(hi_bf(gwd.y)));
        *(v2u*)((bf16*)(ws + WS_MIX) + row * 1536 + 1024 + h * 128 + 16 * dt + 4 * quad) = w;
    }
    __syncthreads();
}
DI void gdn_out_row(Frame& F, int layer, int row) {
    const int lane = F.lane;
    unsigned char* ws = KWS();
    const float* o = (const float*)(ws + WS_OGDN) + (size_t)row * 512 + lane * 8;
    const f32x4 a = *(const f32x4*)o, b = *(const f32x4*)(o + 4);
    float ss = (a[0] * a[0] + a[1] * a[1]) + (a[2] * a[2] + a[3] * a[3]) + (b[0] * b[0] + b[1] * b[1]) + (b[2] * b[2] + b[3] * b[3]);
    ss += shx<1>(ss, lane); ss += shx<2>(ss, lane); ss += shx<4>(ss, lane); ss += shx<8>(ss, lane);
    const float scl = rsqrtf(ss * (1.f / 128.f) + EPS);
    const float* ng = KIN(18) + layer * 128 + (lane & 15) * 8;
    const f32x4 ga = *(const f32x4*)ng, gb = *(const f32x4*)(ng + 4);
    f32x4 za, zb; unpack8(*(const v4u*)((const bf16*)(ws + WS_Z) + (size_t)row * LDZ + ZC_GZ + lane * 8), za, zb);
    f32x4 ra, rb;
#pragma unroll
    for (int e = 0; e < 4; ++e) { ra[e] = a[e] * scl * ga[e] * siluf_(za[e]); rb[e] = b[e] * scl * gb[e] * siluf_(zb[e]); }
    *(v4u*)((bf16*)(ws + WS_MIX) + (size_t)row * 1536 + 512 + lane * 8) = pack8(ra, rb);
}
DI void final_row(Frame& F, int row) {
    const int lane = F.lane;
    const float* x = (const float*)(KWS() + WS_XR) + (size_t)row * DM;
    float* y = (row < MP) ? KOUT() + O_YP + (size_t)row * DM : KOUT() + O_YS + (size_t)(row - MP) * DM;
    f32x4 v[4]; float ss = 0.f;
#pragma unroll
    for (int j = 0; j < 4; ++j) { v[j] = *(const f32x4*)(x + 256 * j + lane * 4); ss += (v[j][0] * v[j][0] + v[j][1] * v[j][1]) + (v[j][2] * v[j][2] + v[j][3] * v[j][3]); }
    const float scl = rsqrtf(wave_sum(ss, lane) * (1.f / DM) + EPS);
#pragma unroll
    for (int j = 0; j < 4; ++j) *(f32x4*)(y + 256 * j + lane * 4) = v[j] * scl * *(const f32x4*)(KIN(26) + 256 * j + lane * 4);
}
#ifndef PH_P0
#define PH_P0 1
#endif
#ifndef PH_A
#define PH_A 1
#endif
#ifndef PH_B0a
#define PH_B0a 1
#endif
#ifndef PH_B0b
#define PH_B0b 1
#endif
#ifndef PH_B0c
#define PH_B0c 1
#endif
#ifndef PH_B0d
#define PH_B0d 1
#endif
#ifndef PH_SCAN
#define PH_SCAN 1
#endif
#ifndef PH_RSCAN
#define PH_RSCAN 1
#endif
#ifndef PH_NSAP
#define PH_NSAP 1
#endif
#ifndef PH_NSAS
#define PH_NSAS 1
#endif
#ifndef PH_B2
#define PH_B2 1
#endif
#ifndef PH_C
#define PH_C 1
#endif
#ifndef PH_D
#define PH_D 1
#endif
#ifndef PH_E
#define PH_E 1
#endif
#ifndef PH_F
#define PH_F 1
#endif
#ifndef PH_G1
#define PH_G1 1
#endif
#ifndef PH_G2
#define PH_G2 1
#endif
struct Args { const void* in[27]; float* out; unsigned char* ws; };
__global__ void __launch_bounds__(NTHREADS, 2) mk_fwd(Args args) {
    extern __shared__ __attribute__((aligned(16))) unsigned char lds_raw[];
    Frame F;
    F.lds = (LAS unsigned char*)lds_raw;
    F.wave = __builtin_amdgcn_readfirstlane((int)threadIdx.x >> 6); F.lane = 0; F.tid = 0;
    F.G = gridDim.x; F.bid = blockIdx.x;
    F.ctl = (gu32*)(KWS() + WS_CTL);
    { const Frame Fp = fresh(F); for (int u = Fp.tid; u < (LDS_BYTES - LDSCTL_OFF) / 4; u += NTHREADS) ((LAS unsigned*)(F.lds + LDSCTL_OFF))[u] = 0u;
      __syncthreads();
      (void)xcd_barrier_post((unsigned*)(F.ctl + CW_BAR), (volatile LAS unsigned*)(F.lds + MISC_OFF) + 8, Fp.tid == 0); }
    const int G = F.G, bid = F.bid;

        for (int rp_ = 0; rp_ < PH_P0; ++rp_) {
    { Frame Fp = fresh(F); p0_prologue(Fp); }
        }
    GRID_BAR();

    for (int layer = 0; layer < NLAYER; ++layer) {
        for (int rp_ = 0; rp_ < PH_A; ++rp_) {
        {
            const Frame Fg = fresh(F); const int G = Fg.G, bid = Fg.bid;
            unsigned char* ws = KWS();
            pg8::Gemm g{(const bf16*)(ws + WS_XGA), (const bf16*)(ws + WS_WIN + layer * SZ_WIN), MROWS, LDZ, DM, DM, DM, 31, 0};
            pg8::StaticOrder S; S.init(MROWS, LDZ, G, bid);
            epi::EpiA E{(bf16*)(ws + WS_Z), (float*)(ws + WS_ZS), (const float*)(ws + WS_SSA), KOUT(), layer};
            pg8::gemm_phase<epi::EpiA, pg8::StaticOrder, true, true>(Fg.lds, g, S, E, Fg.tid);
        }
        }
        GRID_BAR();
        for (int rp_ = 0; rp_ < PH_B0a; ++rp_) {
        { Frame Fp = fresh(F); for (int u = Fp.bid; u < 1024; u += Fp.G) gdn_prep_unit(Fp, layer, u); }
        }
        for (int rp_ = 0; rp_ < PH_B0b; ++rp_) {
        { Frame Fp = fresh(F); for (int u = Fp.bid; u < 512; u += Fp.G) ret_prep_unit(Fp, layer, u); }
        }
        for (int rp_ = 0; rp_ < PH_B0c; ++rp_) {
        { Frame Fp = fresh(F); for (int u = Fp.bid; u < 1024; u += Fp.G) sample_rec_unit(Fp, layer, u); }
        }
        for (int rp_ = 0; rp_ < PH_B0d; ++rp_) {
        { Frame Fp = fresh(F); for (int t = Fp.bid; t < 256 + 16; t += Fp.G) compress_job(Fp, layer, t); }
        }
        GRID_BAR();
        {
            Frame Fp = fresh(F);
            gu32* qhead = F.ctl + CW_QUEUE + 64 * layer;
            volatile LAS int* qslot = (volatile LAS int*)(F.lds + MISC_OFF) + 16;
            constexpr int NQ = (PH_SCAN ? 8 : 0), NP = (PH_NSAP ? 1024 : 0), NS = (PH_NSAS ? 128 : 0), NR = (PH_RSCAN ? 32 : 0);
            for (;;) {
                if (Fp.tid == 0) *qslot = (int)__hip_atomic_fetch_add(qhead, 1u, __ATOMIC_RELAXED, __HIP_MEMORY_SCOPE_AGENT);
                __syncthreads();
                int it = *qslot;
                __syncthreads();
                it = __builtin_amdgcn_readfirstlane(it);
                if (it >= NQ + NP + NS + NR) break;
                if (it < NQ) gdn_scan_chain(Fp, layer, it);
                else if (it < NQ + NP) { const int r = it - NQ; nsa_prompt_unit(Fp, layer, ((r & 3) << 8) | (255 - (r >> 2))); }
                else if (it < NQ + NP + NS) nsa_sample_unit(Fp, layer, it - NQ - NP);
                else ret_scan_part(Fp, layer, it - NQ - NP - NS);
            }
        }
        GRID_BAR();
        for (int rp_ = 0; rp_ < PH_B2; ++rp_) {
        { Frame Fp = fresh(F); for (int u = Fp.bid; u < 512; u += Fp.G) ret_out_unit(Fp, layer, u); }
        { Frame Fp = fresh(F); for (int r = Fp.bid * NWAVES + Fp.wave; r < MROWS; r += Fp.G * NWAVES) gdn_out_row(Fp, layer, r); }
        }
        GRID_BAR();
        for (int rp_ = 0; rp_ < PH_C; ++rp_) {
        {
            const Frame Fg = fresh(F); const int G = Fg.G, bid = Fg.bid;
            unsigned char* ws = KWS();
            pg8::Gemm g{(const bf16*)(ws + WS_MIX), (const bf16*)(ws + WS_WBR + layer * SZ_WBR), MROWS, 3072, 512, 1536, 512, 2, 1024};
            pg8::StaticOrder S; S.init(MROWS, 3072, G, bid);
            epi::EpiC E{(const bf16*)(ws + WS_Z), (bf16*)(ws + WS_GATED)};
            pg8::gemm_phase<epi::EpiC, pg8::StaticOrder, true, true>(Fg.lds, g, S, E, Fg.tid);
        }
        }
        GRID_BAR();
#if PH_D
        {
            const Frame Fg = fresh(F); const int G = Fg.G, bid = Fg.bid;
            unsigned char* ws = KWS();
            pg8::Gemm g{(const bf16*)(ws + WS_GATED), (const bf16*)(ws + WS_WO3 + layer * SZ_WO3), MROWS, DM, 3072, 3072, 3072, 31, 0};
            pg8::StaticOrder S; S.init(MROWS, DM, G, bid);
            epi::EpiRes E{(float*)(ws + WS_XR), (bf16*)(ws + WS_XGB), KIN(21) + layer * DM, (float*)(ws + WS_SSB), nullptr, 0};
            pg8::gemm_phase<epi::EpiRes, pg8::StaticOrder, true, true>(Fg.lds, g, S, E, Fg.tid);
        }
#endif
        GRID_BAR();
        for (int rp_ = 0; rp_ < PH_E; ++rp_) {
        {
            const Frame Fg = fresh(F); const int G = Fg.G, bid = Fg.bid;
            unsigned char* ws = KWS();
            pg8::Gemm g{(const bf16*)(ws + WS_XGB), (const bf16*)(ws + WS_WUP + layer * SZ_WUP), MROWS, DFF, DM, DM, DM, 31, 0};
            pg8::StaticOrder S; S.init(MROWS, DFF, G, bid);
            epi::EpiUp E{(bf16*)(ws + WS_HMID), (const float*)(ws + WS_SSB)};
            pg8::gemm_phase<epi::EpiUp, pg8::StaticOrder, true, true>(Fg.lds, g, S, E, Fg.tid);
        }
        }
        GRID_BAR();
#if PH_F
        {
            const Frame Fg = fresh(F); const int G = Fg.G, bid = Fg.bid;
            unsigned char* ws = KWS();
            pg8::Gemm g{(const bf16*)(ws + WS_HMID), (const bf16*)(ws + WS_WDN + layer * SZ_WDN), MROWS, DM, DFF, DFF, DFF, 31, 0};
            pg8::StaticOrder S; S.init(MROWS, DM, G, bid);
            epi::EpiRes E{(float*)(ws + WS_XR), (bf16*)(ws + WS_XGC), nullptr, nullptr, nullptr, 0};
            pg8::gemm_phase<epi::EpiRes, pg8::StaticOrder, true, true>(Fg.lds, g, S, E, Fg.tid);
        }
#endif
        GRID_BAR();
        for (int rp_ = 0; rp_ < PH_G1; ++rp_) {
        {
            const Frame Fg = fresh(F); const int G = Fg.G, bid = Fg.bid;
            unsigned char* ws = KWS();
            int kple = PLE; asm volatile("" : "+s"(kple));
            pg8::Gemm g{(const bf16*)(ws + WS_P16) + (size_t)layer * MROWS * PLE, (const bf16*)(ws + WS_WPL + layer * SZ_WPL), MROWS, DM, kple, PLE, PLE, 31, 0};
            pg8::StaticOrder S; S.init(MROWS, DM, G, bid);
            epi::EpiRes E{nullptr, nullptr, nullptr, nullptr, (float*)(ws + WS_TPLE), 1};
            pg8::gemm_phase<epi::EpiRes, pg8::StaticOrder, true, true>(Fg.lds, g, S, E, Fg.tid);
        }
        }
#if PH_G2
        {
            const Frame Fg = fresh(F); const int G = Fg.G, bid = Fg.bid;
            unsigned char* ws = KWS();
            const bool more = layer + 1 < NLAYER;
            pg8::Gemm g{(const bf16*)(ws + WS_XGC), (const bf16*)(ws + WS_WPG + layer * SZ_WPG), MROWS, DM, DM, DM, DM, 31, 0};
            pg8::StaticOrder S; S.init(MROWS, DM, G, bid);
            epi::EpiRes E{(float*)(ws + WS_XR), more ? (bf16*)(ws + WS_XGA) : nullptr, more ? KIN(10) + (layer + 1) * DM : nullptr, more ? (float*)(ws + WS_SSA) : nullptr, (float*)(ws + WS_TPLE), 2};
            pg8::gemm_phase<epi::EpiRes, pg8::StaticOrder, true, true>(Fg.lds, g, S, E, Fg.tid);
        }
#endif
        GRID_BAR();
    }
    { Frame Fp = fresh(F); for (int r = Fp.bid * NWAVES + Fp.wave; r < MROWS; r += Fp.G * NWAVES) final_row(Fp, r); }
}

extern "C" void kernel_launch(void* const* d_in, const int* in_sizes, int n_in, void* d_out, int out_size, void* d_ws, size_t ws_size, hipStream_t stream) {
    static int grid = 0;
    if (grid == 0) {
        if (n_in != 27 || ws_size < WS_END) { fprintf(stderr, "kernel_launch: unexpected shapes (n_in %d out %d ws %zu, need %zu)\n", n_in, out_size, ws_size, (size_t)WS_END); grid = -1; return; }
        int dev = 0, cus = 0;
        if (hipGetDevice(&dev) != hipSuccess || hipDeviceGetAttribute(&cus, hipDeviceAttributeMultiprocessorCount, dev) != hipSuccess) { grid = -1; return; }
        if (hipFuncSetAttribute((const void*)mk_fwd, hipFuncAttributeMaxDynamicSharedMemorySize, LDS_BYTES) != hipSuccess) { fprintf(stderr, "kernel_launch: hipFuncSetAttribute failed\n"); grid = -1; return; }
        int per_cu = 0;
        if (hipOccupancyMaxActiveBlocksPerMultiprocessor(&per_cu, (const void*)mk_fwd, NTHREADS, LDS_BYTES) != hipSuccess || per_cu < 1) fprintf(stderr, "kernel_launch: occupancy query reports %d\n", per_cu);
        (void)hipGetLastError();
        grid = cus;
    }
    if (grid < 0) return;
    if (hipMemsetAsync((char*)d_ws + WS_CTL, 0, CTL_ZERO_BYTES, stream) != hipSuccess) return;
    Args a{};
    for (int i = 0; i < 27; ++i) a.in[i] = d_in[i];
    a.out = (float*)d_out; a.ws = (unsigned char*)d_ws;
    hipLaunchKernelGGL(mk_fwd, dim3(grid), dim3(NTHREADS), LDS_BYTES, stream, a);
}
```

```cpp
#include <hip/hip_runtime.h>
#include <cstdio>
#include <cstdint>
namespace pg8 {
#define PG8_LAS __attribute__((address_space(3)))
typedef unsigned short bf16_t;
typedef short bf16x8 __attribute__((ext_vector_type(8)));
typedef float f32x4 __attribute__((ext_vector_type(4)));
typedef unsigned u32x4 __attribute__((ext_vector_type(4)));
constexpr int BM = 256, BK = 64, HALF = 128, HTB = HALF * BK * 2  , STAGE_BYTES = 8 * HTB, NXCD = 8, WGM = 8;

__host__ __device__ __forceinline__ int lds_byte(int r, int c) { const int st = (r >> 4) * 2 + (c >> 5), rr = r & 15, cc = c & 31, ob = rr * 64 + cc * 2; return st * 1024 + (ob ^ (((ob >> 9) & 1) << 5)); }
__host__ __device__ __forceinline__ void stage_rc(int b, int& R, int& C) { const int st = b / 1024, sb = b % 1024, swz = sb ^ (((sb >> 9) & 1) << 5); R = (st >> 1) * 16 + swz / 64; C = (st & 1) * 32 + (swz % 64) / 2; }
__host__ __device__ __forceinline__ int perm32(int rho) { const int n = rho >> 4, i = rho & 15; return 8 * (i >> 2) + 4 * n + (i & 3); }

struct Unit { int pm, pn; };
struct Gemm { const bf16_t* A; const bf16_t* Bt; int M, N, K; int lda, ldb; int a_shift, a_off; };

struct StaticOrder {
    int nM, nN, nwg, G, c;
    __host__ __device__ void init(int M, int N, int G_, int c_) { nM = M / BM; nN = N / BM; nwg = nM * nN; G = G_; c = c_; }
    __host__ __device__ bool next(int i, Unit& u) const {
        const long L = (long)i * G + c; if (L >= nwg) return false;
        int wgid = (int)L; { const int q = nwg / NXCD, r = nwg % NXCD, xcd = wgid % NXCD, off = wgid / NXCD; wgid = (xcd < r ? xcd * (q + 1) : r * (q + 1) + (xcd - r) * q) + off; }
        const int nig = WGM * nN, gid = wgid / nig, fm = gid * WGM, gsz = (nM - fm) < WGM ? (nM - fm) : WGM;
        u.pm = fm + ((wgid % nig) % gsz); u.pn = (wgid % nig) / gsz; return true;
    }
    __device__ __forceinline__ void a_ready(const Unit&) const {}
    __device__ __forceinline__ void done(const Unit&) const {}
};

__device__ __forceinline__ unsigned cvt_pk_bf16(float lo, float hi) { unsigned r; asm volatile("v_cvt_pk_bf16_f32 %0, %1, %2" : "=v"(r) : "v"(lo), "v"(hi)); return r; }
typedef float f32x2 __attribute__((ext_vector_type(2)));
template <class Epi, class Sched, bool ALIGN_EPI = false, bool SP2 = false>
__device__ __forceinline__ void gemm_phase(PG8_LAS unsigned char* lds, const Gemm g, const Sched& S, const Epi& E, const int tid) {
    const int wid = __builtin_amdgcn_readfirstlane(tid >> 6), lane = tid & 63, wr = wid >> 2, wc = wid & 3, fr = lane & 15, fq = lane >> 4;
    const int K = g.K, nt = K / BK;
    unsigned voffA[2], voffB[2];
#pragma unroll
    for (int i = 0; i < 2; ++i) { int R, C; stage_rc(tid * 16 + i * 8192, R, C); const int Rb = Epi::PERM ? ((R & ~31) + perm32(R & 31)) : R;
        voffA[i] = (unsigned)(R * g.lda + C) * 2u; voffB[i] = (unsigned)(Rb * g.ldb + C) * 2u; }
    const size_t kstep = (size_t)(BK * 2);
    const size_t hstepA = (size_t)HALF * g.lda * 2, hstepB = (size_t)HALF * g.ldb * 2;
    const size_t tstepA = 2 * hstepA, tstepB = 2 * hstepB;
    const unsigned ldsw = (unsigned)wid * 1024u;
    const int aoff = lds_byte(wr * 64 + fr, fq * 8), boff = lds_byte(wc * 32 + fr, fq * 8);
#define PG8_SA(b, h) (((b) * 2 + (h)) * HTB)
#define PG8_SB(b, h) ((4 + (b) * 2 + (h)) * HTB)
#define PG8_STAGE(bufoff, gbase, voff) do { _Pragma("unroll") for (int _i = 0; _i < 2; ++_i) \
        __builtin_amdgcn_global_load_lds((const unsigned*)((const char*)(gbase) + (voff)[_i]), (PG8_LAS unsigned*)(lds + (bufoff) + ldsw + _i * 8192), 16, 0, 0); } while (0)
#define PG8_LDA(dst, b, h) do { _Pragma("unroll") for (int m = 0; m < 4; ++m) _Pragma("unroll") for (int k = 0; k < 2; ++k) dst[m][k] = *(const PG8_LAS bf16x8*)(lds + PG8_SA(b, h) + aoff + m * 2048 + k * 1024); } while (0)
#define PG8_LDB(dst, b, h) do { _Pragma("unroll") for (int n = 0; n < 2; ++n) _Pragma("unroll") for (int k = 0; k < 2; ++k) dst[n][k] = *(const PG8_LAS bf16x8*)(lds + PG8_SB(b, h) + boff + n * 2048 + k * 1024); } while (0)
#define PG8_MMA(ai, bj, At, Bt) do { __builtin_amdgcn_s_setprio(1); _Pragma("unroll") for (int m = 0; m < 4; ++m) _Pragma("unroll") for (int n = 0; n < 2; ++n) _Pragma("unroll") for (int k = 0; k < 2; ++k) \
        acc[ai][bj][m][n] = __builtin_amdgcn_mfma_f32_16x16x32_bf16(Bt[n][k], At[m][k], acc[ai][bj][m][n], 0, 0, 0); __builtin_amdgcn_s_setprio(0); } while (0)
#define PG8_WAIT_V(n) asm volatile("s_waitcnt vmcnt(" #n ")" ::: "memory")
#define PG8_WAIT_L(n) asm volatile("s_waitcnt lgkmcnt(" #n ")" ::: "memory")
#define PG8_BAR __builtin_amdgcn_s_barrier()
#define PG8_SCHED __builtin_amdgcn_sched_barrier(0)
    Unit cur, nxt; int ui = 0;
    if (!S.next(0, cur)) return;
    f32x4 acc[2][2][4][2];
#pragma unroll
    for (int a = 0; a < 2; ++a)
#pragma unroll
        for (int b = 0; b < 2; ++b)
#pragma unroll
            for (int m = 0; m < 4; ++m)
#pragma unroll
                for (int n = 0; n < 2; ++n) acc[a][b][m][n] = (f32x4){0.f, 0.f, 0.f, 0.f};
    bf16x8 At[4][2], B0[2][2], B1[2][2];
    const char* cA = (const char*)g.A + (size_t)cur.pm * tstepA + (size_t)(cur.pn >> g.a_shift) * (size_t)g.a_off; const char* cB = (const char*)g.Bt + (size_t)cur.pn * tstepB;
    S.a_ready(cur);
    if constexpr (SP2) {
        PG8_STAGE(PG8_SB(0, 0), cB, voffB); PG8_STAGE(PG8_SB(0, 1), cB + hstepB, voffB); PG8_STAGE(PG8_SA(0, 0), cA, voffA); PG8_STAGE(PG8_SA(0, 1), cA + hstepA, voffA);
        if (wr == 1) PG8_BAR;
        PG8_WAIT_V(2); PG8_BAR;
        PG8_STAGE(PG8_SB(1, 0), cB + kstep, voffB); PG8_STAGE(PG8_SA(1, 0), cA + kstep, voffA); PG8_STAGE(PG8_SB(1, 1), cB + hstepB + kstep, voffB);
        PG8_WAIT_V(6); PG8_BAR;
    } else {
        PG8_STAGE(PG8_SB(0, 0), cB, voffB); PG8_STAGE(PG8_SA(0, 0), cA, voffA); PG8_STAGE(PG8_SB(0, 1), cB + hstepB, voffB); PG8_STAGE(PG8_SA(0, 1), cA + hstepA, voffA);
        if (wr == 1) PG8_BAR;
        PG8_WAIT_V(4); PG8_BAR;
        PG8_STAGE(PG8_SB(1, 0), cB + kstep, voffB); PG8_STAGE(PG8_SA(1, 0), cA + kstep, voffA); PG8_STAGE(PG8_SB(1, 1), cB + hstepB + kstep, voffB);
        PG8_WAIT_V(6); PG8_BAR;
    }
    for (;;) {
        const bool has_next = S.next(ui + 1, nxt);
        const char* nA = has_next ? (const char*)g.A + (size_t)nxt.pm * tstepA + (size_t)(nxt.pn >> g.a_shift) * (size_t)g.a_off : cA; const char* nB = has_next ? (const char*)g.Bt + (size_t)nxt.pn * tstepB : cB;
        for (int t = 0; t < nt; t += 2) {
            const bool last = (t == nt - 2);
            const char* a1 = cA + (size_t)(t + 1) * kstep;
            const char* a2 = last ? nA : cA + (size_t)(t + 2) * kstep; const char* b2 = last ? nB : cB + (size_t)(t + 2) * kstep;
            const char* a3 = a2 + kstep; const char* b3 = b2 + kstep;
            if (last && has_next) S.a_ready(nxt);
            if constexpr (SP2) {
            PG8_LDB(B0, 0, 0); PG8_LDB(B1, 0, 1); PG8_SCHED; PG8_LDA(At, 0, 0); PG8_STAGE(PG8_SA(1, 1), a1 + hstepA, voffA);
            PG8_WAIT_V(8); PG8_WAIT_L(0); PG8_BAR; PG8_MMA(0, 0, At, B0); PG8_MMA(0, 1, At, B1); PG8_BAR; PG8_SCHED;
            PG8_LDA(At, 0, 1); PG8_STAGE(PG8_SB(0, 0), b2, voffB); PG8_STAGE(PG8_SB(0, 1), b2 + hstepB, voffB); PG8_STAGE(PG8_SA(0, 0), a2, voffA);
            PG8_WAIT_V(8); PG8_WAIT_L(0); PG8_BAR; PG8_MMA(1, 0, At, B0); PG8_MMA(1, 1, At, B1); PG8_BAR; PG8_SCHED;
            PG8_LDB(B0, 1, 0); PG8_LDB(B1, 1, 1); PG8_SCHED; PG8_LDA(At, 1, 0); PG8_STAGE(PG8_SA(0, 1), a2 + hstepA, voffA);
            PG8_WAIT_V(8); PG8_WAIT_L(0); PG8_BAR; PG8_MMA(0, 0, At, B0); PG8_MMA(0, 1, At, B1); PG8_BAR; PG8_SCHED;
            PG8_LDA(At, 1, 1); PG8_STAGE(PG8_SB(1, 0), b3, voffB); PG8_STAGE(PG8_SB(1, 1), b3 + hstepB, voffB); PG8_STAGE(PG8_SA(1, 0), a3, voffA);
            PG8_WAIT_V(8); PG8_WAIT_L(0); PG8_BAR; PG8_MMA(1, 0, At, B0); PG8_MMA(1, 1, At, B1); PG8_BAR; PG8_SCHED;
            } else {
            PG8_LDB(B0, 0, 0); PG8_SCHED; PG8_LDA(At, 0, 0); PG8_STAGE(PG8_SA(1, 1), a1 + hstepA, voffA);
            PG8_WAIT_L(8); PG8_BAR; PG8_WAIT_L(0); PG8_MMA(0, 0, At, B0); PG8_BAR; PG8_SCHED;
            PG8_LDB(B1, 0, 1); PG8_STAGE(PG8_SB(0, 0), b2, voffB);
            PG8_BAR; PG8_WAIT_L(0); PG8_MMA(0, 1, At, B1); PG8_BAR;
            PG8_LDA(At, 0, 1); PG8_STAGE(PG8_SA(0, 0), a2, voffA);
            PG8_BAR; PG8_WAIT_L(0); PG8_MMA(1, 0, At, B0); PG8_BAR; PG8_SCHED;
            PG8_STAGE(PG8_SB(0, 1), b2 + hstepB, voffB);
            PG8_WAIT_V(6); PG8_BAR; PG8_MMA(1, 1, At, B1); PG8_BAR;
            PG8_LDB(B0, 1, 0); PG8_SCHED; PG8_LDA(At, 1, 0); PG8_STAGE(PG8_SA(0, 1), a2 + hstepA, voffA);
            PG8_WAIT_L(8); PG8_BAR; PG8_WAIT_L(0); PG8_MMA(0, 0, At, B0); PG8_BAR; PG8_SCHED;
            PG8_LDB(B1, 1, 1); PG8_STAGE(PG8_SB(1, 0), b3, voffB);
            PG8_BAR; PG8_WAIT_L(0); PG8_MMA(0, 1, At, B1); PG8_BAR;
            PG8_LDA(At, 1, 1); PG8_STAGE(PG8_SA(1, 0), a3, voffA);
            PG8_BAR; PG8_WAIT_L(0); PG8_MMA(1, 0, At, B0); PG8_BAR; PG8_SCHED;
            PG8_STAGE(PG8_SB(1, 1), b3 + hstepB, voffB);
            PG8_WAIT_V(6); PG8_BAR; PG8_MMA(1, 1, At, B1); PG8_BAR;
            }
        }
        if constexpr (ALIGN_EPI) { if (wr == 0) PG8_BAR; }
        if constexpr (!Epi::AFTER_DRAIN) { E(acc, cur, wr, wc, fr, fq); S.done(cur); }
        if (!has_next) break;
#pragma unroll
        for (int a = 0; a < 2; ++a)
#pragma unroll
            for (int b = 0; b < 2; ++b)
#pragma unroll
                for (int m = 0; m < 4; ++m)
#pragma unroll
                    for (int n = 0; n < 2; ++n) acc[a][b][m][n] = (f32x4){0.f, 0.f, 0.f, 0.f};
        cur = nxt; cA = nA; cB = nB; ++ui;
        if constexpr (ALIGN_EPI) { if (wr == 1) PG8_BAR; }
    }
    PG8_WAIT_V(0);
    if constexpr (!ALIGN_EPI) { if (wr == 0) PG8_BAR; }
    PG8_BAR;
    if constexpr (Epi::AFTER_DRAIN) { E.fused(acc, cur, wr, wc, fr, fq, lds, wid, lane); S.done(cur); }
#undef PG8_SA
#undef PG8_SB
#undef PG8_STAGE
#undef PG8_LDA
#undef PG8_LDB
#undef PG8_MMA
#undef PG8_WAIT_V
#undef PG8_WAIT_L
#undef PG8_BAR
#undef PG8_SCHED
}
}
#define DI __device__ __forceinline__
#define GAS __attribute__((address_space(1)))
#define LAS __attribute__((address_space(3)))
typedef unsigned short bf16;
typedef unsigned v4u __attribute__((ext_vector_type(4)));
typedef unsigned v2u __attribute__((ext_vector_type(2)));
typedef float f32x4 __attribute__((ext_vector_type(4)));
typedef float f32x2 __attribute__((ext_vector_type(2)));
typedef short bf16x8 __attribute__((ext_vector_type(8)));
typedef short s16x4 __attribute__((ext_vector_type(4)));
typedef GAS unsigned gu32;

constexpr int DM = 1024, TP = 8192, MP = 16384, MS = 512, MROWS = 16896, LDZ = 8704, DFF = 4096, PLE = 256, NLAYER = 2;
constexpr int ZC_Q = 0, ZC_KC = 512, ZC_VC = 640, ZC_KS = 768, ZC_VS = 896, ZC_KW = 1024, ZC_VW = 1152, ZC_GQKV = 1280, ZC_GZ = 2816, ZC_RQKV = 3328, ZC_RG = 4864, ZC_MG = 5376, ZC_SM = 8448;
constexpr float EPS = 1e-6f;
constexpr size_t O_YP = 0, O_YS = O_YP + (size_t)MP * DM, O_KVP = O_YS + (size_t)MS * DM, O_KVS = O_KVP + (size_t)2 * MP * 512, O_WINP = O_KVS + (size_t)2 * MS * 512,
                 O_WINS = O_WINP + (size_t)2 * 2 * 512 * 256, O_CVP = O_WINS + (size_t)2 * 128 * 512 * 256, O_CVS = O_CVP + (size_t)2 * 2 * 3 * 1536, O_GSP = O_CVS + (size_t)2 * 128 * 3 * 1536,
                 O_GSS = O_GSP + (size_t)2 * 2 * 4 * 16384, O_RSP = O_GSS + (size_t)2 * 128 * 4 * 16384, O_RSS = O_RSP + (size_t)2 * 2 * 4 * 16384, O_END = O_RSS + (size_t)2 * 128 * 4 * 16384;

DI float bf2f(unsigned short b) { return __uint_as_float((unsigned)b << 16); }
DI unsigned f2bf(float f) { unsigned u = __float_as_uint(f); return (u + 0x7fffu + ((u >> 16) & 1u)) >> 16; }
typedef __bf16 bf16x2_t __attribute__((ext_vector_type(2)));
DI unsigned pk2(float lo, float hi) { const f32x2 v = {lo, hi}; return __builtin_bit_cast(unsigned, __builtin_convertvector(v, bf16x2_t)); }
DI float lo_bf(unsigned w) { return __uint_as_float(w << 16); }
DI float hi_bf(unsigned w) { return __uint_as_float(w & 0xffff0000u); }
DI float sigmoidf_(float x) { return 1.f / (1.f + __expf(-x)); }
DI float siluf_(float x) { return x / (1.f + __expf(-x)); }
DI v4u pack8(const f32x4 a, const f32x4 b) { v4u w; w.x = pk2(a[0], a[1]); w.y = pk2(a[2], a[3]); w.z = pk2(b[0], b[1]); w.w = pk2(b[2], b[3]); return w; }
DI void unpack8(const v4u w, f32x4& a, f32x4& b) { a[0] = lo_bf(w.x); a[1] = hi_bf(w.x); a[2] = lo_bf(w.y); a[3] = hi_bf(w.y); b[0] = lo_bf(w.z); b[1] = hi_bf(w.z); b[2] = lo_bf(w.w); b[3] = hi_bf(w.w); }

template <int M> DI int shxi(int v, int lane) {
    if constexpr (M < 32) return __builtin_amdgcn_ds_swizzle(v, (M << 10) | 0x1f);
    else return __builtin_amdgcn_ds_bpermute((lane ^ 32) << 2, v);
}
template <int M> DI float shx(float v, int lane) { return __int_as_float(shxi<M>(__float_as_int(v), lane)); }
DI float wave_sum(float v, int lane) { v += shx<1>(v, lane); v += shx<2>(v, lane); v += shx<4>(v, lane); v += shx<8>(v, lane); v += shx<16>(v, lane); v += shx<32>(v, lane); return v; }

namespace epi {
using pg8::Unit; using pg8::bf16_t;
DI float row_rstd(const float* SS, int row, int fq, int lane) {
    const f32x4 p = *(const f32x4*)(SS + (size_t)row * 16 + 4 * fq);
    float s = (p[0] + p[1]) + (p[2] + p[3]); s += shx<16>(s, lane); s += shx<32>(s, lane);
    return rsqrtf(s * (1.f / DM) + EPS);
}
struct EpiA {
    static constexpr bool PERM = true, AFTER_DRAIN = false;
    bf16* Z; float* ZS; const float* SS; float* out; int layer;
    DI void operator()(const f32x4 (&acc)[2][2][4][2], const Unit& u, int wr, int wc, int fr, int fq) const {
        asm volatile("" : "+v"(fr), "+v"(fq), "+s"(wr), "+s"(wc));
        const int pn = u.pn;
#pragma unroll
        for (int ai = 0; ai < 2; ++ai)
#pragma unroll
            for (int m = 0; m < 4; ++m) {
                const int row = u.pm * 256 + ai * 128 + wr * 64 + m * 16 + fr;
                const float rstd = row_rstd(SS, row, fq, fr + 16 * fq);
#pragma unroll
                for (int bj = 0; bj < 2; ++bj) {
                    const int col = pn * 256 + bj * 128 + wc * 32 + 8 * fq;
                    const f32x4 v0 = acc[ai][bj][m][0] * rstd, v1 = acc[ai][bj][m][1] * rstd;
                    *(v4u*)(Z + (size_t)row * LDZ + col) = pack8(v0, v1);
                    float* dst = nullptr;
                    if (pn == 2 || pn == 3) {
                        dst = (row < MP) ? out + O_KVP + ((size_t)layer * MP + row) * 512 + (col - 512) : out + O_KVS + ((size_t)layer * MS + (row - MP)) * 512 + (col - 512);
                    } else if (pn == 4) {
                        const int c2 = col - 1024;
                        if (row < MP) { const int t = row & (TP - 1), b = row >> 13; if (t >= TP - 512) dst = out + O_WINP + ((size_t)(layer * 2 + b) * 512 + (t - (TP - 512))) * 256 + c2; }
                        else { const int r2 = row - MP, s = r2 >> 2, j = r2 & 3; dst = out + O_WINS + ((size_t)(layer * 128 + s) * 512 + 508 + j) * 256 + c2; }
                    } else if (pn >= 5 && pn < 11) {
                        const int c2 = col - 1280;
                        if (row < MP) { const int t = row & (TP - 1), b = row >> 13; if (t >= TP - 3) dst = out + O_CVP + ((size_t)(layer * 2 + b) * 3 + (t - (TP - 3))) * 1536 + c2; }
                        else { const int r2 = row - MP, s = r2 >> 2, j = r2 & 3; if (j >= 1) dst = out + O_CVS + ((size_t)(layer * 128 + s) * 3 + (j - 1)) * 1536 + c2; }
                    } else if (pn == 33) {
                        if (bj == 0 && wc == 0) dst = ZS + (size_t)row * 32 + 8 * fq;
                    }
                    if (dst) { *(f32x4*)dst = v0; *(f32x4*)(dst + 4) = v1; }
                }
                asm volatile("" ::: "memory");
            }
    }
};
struct EpiC {
    static constexpr bool PERM = true, AFTER_DRAIN = false;
    const bf16* Z; bf16* G;
    DI void operator()(const f32x4 (&acc)[2][2][4][2], const Unit& u, int wr, int wc, int fr, int fq) const {
        asm volatile("" : "+v"(fr), "+v"(fq), "+s"(wr), "+s"(wc));
#pragma unroll
        for (int ai = 0; ai < 2; ++ai)
#pragma unroll
            for (int m = 0; m < 4; ++m) {
                const int row = u.pm * 256 + ai * 128 + wr * 64 + m * 16 + fr;
#pragma unroll
                for (int bj = 0; bj < 2; ++bj) {
                    const int col = u.pn * 256 + bj * 128 + wc * 32 + 8 * fq;
                    const v4u gw = *(const v4u*)(Z + (size_t)row * LDZ + ZC_MG + col);
                    f32x4 g0, g1; unpack8(gw, g0, g1);
                    f32x4 v0 = acc[ai][bj][m][0], v1 = acc[ai][bj][m][1];
#pragma unroll
                    for (int e = 0; e < 4; ++e) { v0[e] *= sigmoidf_(g0[e]); v1[e] *= sigmoidf_(g1[e]); }
                    *(v4u*)(G + (size_t)row * 3072 + col) = pack8(v0, v1);
                }
                asm volatile("" ::: "memory");
            }
    }
};
struct EpiRes {
    static constexpr bool PERM = true, AFTER_DRAIN = false;
    float* XR; bf16* XG; const float* gvec; float* SS; float* T; int mode;
    DI void operator()(const f32x4 (&acc)[2][2][4][2], const Unit& u, int wr, int wc, int fr, int fq) const {
        asm volatile("" : "+v"(fr), "+v"(fq), "+s"(wr), "+s"(wc));
        if (mode == 3) return;
#pragma unroll
        for (int ai = 0; ai < 2; ++ai)
#pragma unroll
            for (int m = 0; m < 4; ++m) {
                const int row = u.pm * 256 + ai * 128 + wr * 64 + m * 16 + fr;
                float ssq = 0.f;
#pragma unroll
                for (int bj = 0; bj < 2; ++bj) {
                    const int col = u.pn * 256 + bj * 128 + wc * 32 + 8 * fq;
                    const size_t o = (size_t)row * DM + col;
                    f32x4 a0 = acc[ai][bj][m][0], a1 = acc[ai][bj][m][1];
                    if (mode == 1) { *(f32x4*)(T + o) = a0; *(f32x4*)(T + o + 4) = a1; continue; }
                    f32x4 x0 = *(const f32x4*)(XR + o), x1 = *(const f32x4*)(XR + o + 4);
                    if (mode == 2) { const f32x4 t0 = *(const f32x4*)(T + o), t1 = *(const f32x4*)(T + o + 4);
#pragma unroll
                        for (int e = 0; e < 4; ++e) { a0[e] = t0[e] * sigmoidf_(a0[e]); a1[e] = t1[e] * sigmoidf_(a1[e]); } }
                    x0 += a0; x1 += a1;
                    *(f32x4*)(XR + o) = x0; *(f32x4*)(XR + o + 4) = x1;
                    ssq += (x0[0] * x0[0] + x0[1] * x0[1]) + (x0[2] * x0[2] + x0[3] * x0[3]) + (x1[0] * x1[0] + x1[1] * x1[1]) + (x1[2] * x1[2] + x1[3] * x1[3]);
                    if (XG) { if (gvec) { const f32x4 g0 = *(const f32x4*)(gvec + col), g1 = *(const f32x4*)(gvec + col + 4); x0 *= g0; x1 *= g1; }
                        *(v4u*)(XG + o) = pack8(x0, x1); }
                }
                if (SS) { ssq += shx<16>(ssq, fr + 16 * fq); ssq += shx<32>(ssq, fr + 16 * fq); if (fq == 0) SS[(size_t)row * 16 + u.pn * 4 + wc] = ssq; }
                asm volatile("" ::: "memory");
            }
    }
};
struct EpiUp {
    static constexpr bool PERM = true, AFTER_DRAIN = false;
    bf16* H; const float* SS;
    DI void operator()(const f32x4 (&acc)[2][2][4][2], const Unit& u, int wr, int wc, int fr, int fq) const {
        asm volatile("" : "+v"(fr), "+v"(fq), "+s"(wr), "+s"(wc));
#pragma unroll
        for (int ai = 0; ai < 2; ++ai)
#pragma unroll
            for (int m = 0; m < 4; ++m) {
                const int row = u.pm * 256 + ai * 128 + wr * 64 + m * 16 + fr;
                const float rstd = row_rstd(SS, row, fq, fr + 16 * fq);
#pragma unroll
                for (int bj = 0; bj < 2; ++bj) {
                    const int col = u.pn * 256 + bj * 128 + wc * 32 + 8 * fq;
                    f32x4 v0 = acc[ai][bj][m][0] * rstd, v1 = acc[ai][bj][m][1] * rstd;
#pragma unroll
                    for (int e = 0; e < 4; ++e) { const float a = fmaxf(v0[e], 0.f), b = fmaxf(v1[e], 0.f); v0[e] = a * a; v1[e] = b * b; }
                    *(v4u*)(H + (size_t)row * DFF + col) = pack8(v0, v1);
                }
                asm volatile("" ::: "memory");
            }
    }
};
}
constexpr size_t al256(size_t x) { return (x + 255) & ~(size_t)255; }
constexpr size_t WS_CTL = 0, CTL_ZERO_BYTES = 1u << 20;
constexpr size_t SZ_WIN = (size_t)LDZ * DM * 2, SZ_WBR = (size_t)3072 * 512 * 2, SZ_WO3 = (size_t)DM * 3072 * 2, SZ_WUP = (size_t)DFF * DM * 2, SZ_WDN = (size_t)DM * DFF * 2,
                 SZ_WPL = (size_t)DM * PLE * 2, SZ_WPG = (size_t)DM * DM * 2, SZ_W1T = (size_t)2 * 64 * 2048 * 2, SZ_W2T = (size_t)2 * 64 * 64 * 2;
constexpr size_t WS_WIN = CTL_ZERO_BYTES, WS_WBR = WS_WIN + 2 * SZ_WIN, WS_WO3 = WS_WBR + 2 * SZ_WBR, WS_WUP = WS_WO3 + 2 * SZ_WO3, WS_WDN = WS_WUP + 2 * SZ_WUP,
                 WS_WPL = WS_WDN + 2 * SZ_WDN, WS_WPG = WS_WPL + 2 * SZ_WPL, WS_W1T = WS_WPG + 2 * SZ_WPG, WS_W2T = WS_W1T + 2 * SZ_W1T, WS_ROT = al256(WS_W2T + 2 * SZ_W2T);
constexpr size_t WS_P16 = WS_ROT + (size_t)TP * 64 * 8;
constexpr size_t WS_XR = WS_P16 + (size_t)2 * MROWS * PLE * 2;
constexpr size_t WS_XGA = WS_XR + (size_t)MROWS * DM * 4, WS_XGB = WS_XGA + (size_t)MROWS * DM * 2, WS_XGC = WS_XGB + (size_t)MROWS * DM * 2;
constexpr size_t WS_SSA = WS_XGC + (size_t)MROWS * DM * 2, WS_SSB = WS_SSA + (size_t)MROWS * 64;
constexpr size_t WS_Z = WS_SSB + (size_t)MROWS * 64, WS_ZS = WS_Z + (size_t)MROWS * LDZ * 2;
constexpr size_t WS_MIX = WS_ZS + (size_t)MROWS * 128, WS_GATED = WS_MIX + (size_t)MROWS * 1536 * 2, WS_HMID = WS_GATED + (size_t)MROWS * 3072 * 2;
constexpr size_t WS_TPLE = WS_HMID + (size_t)MROWS * DFF * 2;
constexpr size_t WS_KC = WS_TPLE + (size_t)MROWS * DM * 4;
constexpr size_t WS_KCS = WS_KC + (size_t)2 * 2 * 512 * 2 * 64 * 2;
constexpr int GREC = 73984;
constexpr size_t WS_GREC = WS_KCS + (size_t)2 * 128 * 128 * 2 * 64 * 2;
constexpr size_t WS_OGDN = WS_GREC + (size_t)1024 * GREC;
constexpr size_t WS_RKV = WS_OGDN + (size_t)MROWS * 512 * 4;
constexpr size_t WS_RST = WS_RKV + (size_t)512 * 16384 * 4;
constexpr size_t WS_QR = WS_RST + (size_t)512 * 16384 * 2, WS_KR = WS_QR + (size_t)MP * 512 * 2;
constexpr size_t WS_END = WS_KR + (size_t)MP * 512 * 2;
static_assert(WS_W1T % 256 == 0 && WS_Z % 256 == 0 && WS_GREC % 256 == 0 && WS_RKV % 256 == 0 && WS_KC % 256 == 0 && WS_XR % 256 == 0, "ws alignment");

constexpr int CW_TMO = 0, CW_BAR = 4096, CW_QUEUE = 8192;
constexpr int NWAVES = 8, NTHREADS = 512;
constexpr int RING_BYTES = 147456, LDSCTL_OFF = RING_BYTES, MISC_OFF = LDSCTL_OFF + 320, LDS_BYTES = RING_BYTES + 1024;

#define RLX_AGENT __ATOMIC_RELAXED, __HIP_MEMORY_SCOPE_AGENT
#define LDS_WAIT() asm volatile("s_waitcnt lgkmcnt(0)" ::: "memory")
#define VM_WAIT() asm volatile("s_waitcnt vmcnt(0)" ::: "memory")
#define XB_TMO      128
#define XB_XCNT(j)  (256  + 64 * (j))
#define XB_XSUB(j)  (1280 + 64 * (j))
#define XB_XGEN(j)  (2304 + 64 * (j))
#define XB_TOP      3328
#define XB_TOPGEN   3392
#define XCD_BAR_WORDS 3456
#define XB_SPIN_CAP (1u << 18)

__device__ __forceinline__ unsigned xb_ld(unsigned* p)              { return __hip_atomic_load(p, __ATOMIC_RELAXED, __HIP_MEMORY_SCOPE_AGENT); }
__device__ __forceinline__ unsigned xb_add(unsigned* p, unsigned v) { return __hip_atomic_fetch_add(p, v, __ATOMIC_RELAXED, __HIP_MEMORY_SCOPE_AGENT); }
__device__ __forceinline__ unsigned xb_xcc_id() { return (unsigned)__builtin_amdgcn_s_getreg((3 << 11) | 20) & 0xFu; }
#define XB_SPIN(cond, bar) do { unsigned _sp = 0; while (cond) { __builtin_amdgcn_s_sleep(1); \
    if ((++_sp & 255u) == 0u) { if (xb_ld(&(bar)[XB_TMO])) break; if (_sp > XB_SPIN_CAP) { atomicAdd(&(bar)[XB_TMO], 1u); break; } } } } while (0)

struct XcdBarrier {
    unsigned* bar; unsigned x;
    volatile LAS unsigned* st;
};

__device__ __forceinline__ XcdBarrier xcd_barrier_post(unsigned* bar, volatile LAS unsigned* st, bool t0) {
    XcdBarrier b; b.bar = bar; b.x = xb_xcc_id(); b.st = st;
    if (t0) (void)xb_add(&bar[XB_XCNT(b.x)], 1u);
    return b;
}
__device__ __forceinline__ void xcd_barrier_complete(unsigned* bar, unsigned x, unsigned& nloc, unsigned& nx) {
    const unsigned G = gridDim.x * gridDim.y * gridDim.z;
    unsigned sum, cnt, mine, sp = 0u;
    for (;;) {
        sum = 0u; cnt = 0u; mine = 0u;
#pragma unroll
        for (unsigned j = 0; j < 16; ++j) { const unsigned c = xb_ld(&bar[XB_XCNT(j)]); sum += c; cnt += (c > 0u) ? 1u : 0u; mine = (j == x) ? c : mine; }
        if (sum == G) break;
        __builtin_amdgcn_s_sleep(1);
        if ((++sp & 255u) == 0u) { if (xb_ld(&bar[XB_TMO])) break; if (sp > XB_SPIN_CAP) { atomicAdd(&bar[XB_TMO], 1u); break; } }
    }
    nloc = mine > 0u ? mine : 1u; nx = cnt > 0u ? cnt : 1u;
}

__device__ __forceinline__ void xcd_barrier(const XcdBarrier& b, bool t0) {
    asm volatile("s_waitcnt vmcnt(0)" ::: "memory");
    __syncthreads();
    if (t0) {
        unsigned* bar = b.bar;
        __builtin_amdgcn_s_waitcnt(0);
        unsigned nloc = b.st[0], nx = b.st[1];
        if (nloc == 0u) { xcd_barrier_complete(bar, b.x, nloc, nx); b.st[0] = nloc; b.st[1] = nx; }
        const unsigned old = xb_add(&bar[XB_XSUB(b.x)], 1u);
        const unsigned gen = old / nloc;
        if (old + 1u == (gen + 1u) * nloc) {
            __builtin_amdgcn_fence(__ATOMIC_RELEASE, "agent");
            asm volatile("s_waitcnt vmcnt(0)" ::: "memory");
            const unsigned og = xb_add(&bar[XB_TOP], 1u);
            const unsigned tg = og / nx;
            if (og + 1u == (tg + 1u) * nx) xb_add(&bar[XB_TOPGEN], 1u);
            else XB_SPIN(xb_ld(&bar[XB_TOPGEN]) == tg, bar);
            __builtin_amdgcn_fence(__ATOMIC_ACQUIRE, "agent");
            xb_add(&bar[XB_XGEN(b.x)], 1u);
            asm volatile("s_waitcnt vmcnt(0)" ::: "memory");
        } else {
            XB_SPIN(xb_ld(&bar[XB_XGEN(b.x)]) == gen, bar);
            __builtin_amdgcn_fence(__ATOMIC_ACQUIRE, "agent");
            asm volatile("s_waitcnt vmcnt(0)" ::: "memory");
        }
    }
    __syncthreads();
}
typedef const void* const __attribute__((address_space(4)))* kargp_t;
DI const float* KIN(int i) { const float* p = (const float*)((kargp_t)__builtin_amdgcn_kernarg_segment_ptr())[i]; asm volatile("" : "+s"(p)); return p; }
DI float* KOUT() { float* p = (float*)((kargp_t)__builtin_amdgcn_kernarg_segment_ptr())[27]; asm volatile("" : "+s"(p)); return p; }
DI unsigned char* KWS() { unsigned char* p = (unsigned char*)((kargp_t)__builtin_amdgcn_kernarg_segment_ptr())[28]; asm volatile("" : "+s"(p)); return p; }
struct Frame {
    LAS unsigned char* lds;
    gu32* ctl;
    int tid, lane, wave, G, bid;
};
DI bf16x8 ld_frag_g(const bf16* p) { return __builtin_bit_cast(bf16x8, *(const v4u*)p); }
DI bf16x8 ld_frag_l(const LAS unsigned char* p) { return *(const LAS bf16x8*)p; }
DI f32x4 mfma16(bf16x8 a, bf16x8 b, f32x4 c) { return __builtin_amdgcn_mfma_f32_16x16x32_bf16(a, b, c, 0, 0, 0); }
DI bf16x8 pack_frag(const f32x4 a, const f32x4 b) { return __builtin_bit_cast(bf16x8, pack8(a, b)); }
DI int lane_id() { int l; asm volatile("v_mbcnt_lo_u32_b32 %0, -1, 0\n\tv_mbcnt_hi_u32_b32 %0, -1, %0" : "=v"(l)); return l; }
DI Frame fresh(const Frame& F0) {
    Frame F = F0; int w = F0.wave, g = F0.G, b = F0.bid; asm volatile("" : "+s"(w), "+s"(g), "+s"(b));
    int l = lane_id(); asm volatile("" : "+v"(l));
    unsigned lb = (unsigned)(uintptr_t)F0.lds; asm volatile("" : "+s"(lb)); F.lds = (LAS unsigned char*)(uintptr_t)lb;
    F.wave = w; F.lane = l; F.tid = w * 64 + l; F.G = g; F.bid = b; return F;
}
#define GRID_BAR() do { XcdBarrier b_; b_.bar = (unsigned*)((gu32*)(KWS() + WS_CTL) + CW_BAR); b_.x = xb_xcc_id(); b_.st = (volatile LAS unsigned*)(F.lds + MISC_OFF) + 8; \
    const Frame Fb_ = fresh(F); xcd_barrier(b_, Fb_.tid == 0); } while (0)
DI int win_colmap(int j) {
    if (j < 1280) return j; if (j < 2816) return j + 24; if (j < 8448) return j + 32; if (j < 8472) return j - 8448 + 1280; if (j < 8480) return j - 8472 + 2840; return -1;
}
DI void tr_item(const float* W, int ldw, int k0, int srccol, bf16* WT, size_t dst_row0, int ldt, int kdst0, int nrep, int krep, LAS float* scr, int lane) {
#pragma unroll 8
    for (int i = 0; i < 32; ++i) { const int kk = 2 * i + (lane >> 5); scr[kk * 33 + (lane & 31)] = (srccol >= 0) ? W[(size_t)(k0 + kk) * ldw + srccol] : 0.f; }
    LDS_WAIT(); asm volatile("" ::: "memory");
    const int c = lane & 7;
#pragma unroll
    for (int j = 0; j < 4; ++j) { const int n = (lane >> 3) + 8 * j; const LAS float* s = scr + (8 * c) * 33 + n;
        v4u o; o.x = pk2(s[0 * 33], s[1 * 33]); o.y = pk2(s[2 * 33], s[3 * 33]); o.z = pk2(s[4 * 33], s[5 * 33]); o.w = pk2(s[6 * 33], s[7 * 33]);
        for (int r = 0; r < nrep; ++r) *(v4u*)(WT + (dst_row0 + n) * (size_t)ldt + kdst0 + r * krep + 8 * c) = o; }
    LDS_WAIT(); asm volatile("" ::: "memory");
}
DI void p0_prologue(Frame& F) {
    LAS float* scr = (LAS float*)(F.lds + F.wave * 16384);
    const int gw = F.bid * NWAVES + F.wave, NGW = F.G * NWAVES, lane = F.lane;
    unsigned char* ws = KWS();
    constexpr int I_A = 16 * 272, I_B = 3 * 8 * 32, I_C = 16 * 32, I_D = 16 * 128, I_E = 64 * 32, I_F = 4 * 32, I_G = 16 * 32, I_H = 2 * 32 * 2, I_I = 2 * 2;
    constexpr int I_L = I_A + I_B + I_C + I_D + I_E + I_F + I_G + I_H + I_I;
    for (int it = gw; it < 2 * I_L; it += NGW) {
        const int l = it / I_L; int r = it % I_L;
        if (r < I_A) { const int kb = r / 272, nb = r % 272; tr_item(KIN(11) + (size_t)l * DM * 8480, 8480, 64 * kb, win_colmap(32 * nb + (lane & 31)), (bf16*)(ws + WS_WIN + l * SZ_WIN), 32 * nb, DM, 64 * kb, 1, 0, scr, lane); continue; } r -= I_A;
        if (r < I_B) { const int b = r / 256, kb = (r % 256) / 32, nb = r % 32; tr_item(KIN(19) + (size_t)(l * 3 + b) * 512 * DM, DM, 64 * kb, 32 * nb + (lane & 31), (bf16*)(ws + WS_WBR + l * SZ_WBR), b * 1024 + 32 * nb, 512, 64 * kb, 1, 0, scr, lane); continue; } r -= I_B;
        if (r < I_C) { const int kb = r / 32, nb = r % 32; tr_item(KIN(20) + (size_t)l * DM * DM, DM, 64 * kb, 32 * nb + (lane & 31), (bf16*)(ws + WS_WO3 + l * SZ_WO3), 32 * nb, 3072, 64 * kb, 3, 1024, scr, lane); continue; } r -= I_C;
        if (r < I_D) { const int kb = r / 128, nb = r % 128; tr_item(KIN(22) + (size_t)l * DM * DFF, DFF, 64 * kb, 32 * nb + (lane & 31), (bf16*)(ws + WS_WUP + l * SZ_WUP), 32 * nb, DM, 64 * kb, 1, 0, scr, lane); continue; } r -= I_D;
        if (r < I_E) { const int kb = r / 32, nb = r % 32; tr_item(KIN(23) + (size_t)l * DFF * DM, DM, 64 * kb, 32 * nb + (lane & 31), (bf16*)(ws + WS_WDN + l * SZ_WDN), 32 * nb, DFF, 64 * kb, 1, 0, scr, lane); continue; } r -= I_E;
        if (r < I_F) { const int kb = r / 32, nb = r % 32; tr_item(KIN(24) + (size_t)l * PLE * DM, DM, 64 * kb, 32 * nb + (lane & 31), (bf16*)(ws + WS_WPL + l * SZ_WPL), 32 * nb, PLE, 64 * kb, 1, 0, scr, lane); continue; } r -= I_F;
        if (r < I_G) { const int kb = r / 32, nb = r % 32; tr_item(KIN(25) + (size_t)l * DM * DM, DM, 64 * kb, 32 * nb + (lane & 31), (bf16*)(ws + WS_WPG + l * SZ_WPG), 32 * nb, DM, 64 * kb, 1, 0, scr, lane); continue; } r -= I_G;
        if (r < I_H) { const int kv = r / 64, kb = (r % 64) / 2, nb = r % 2; tr_item(KIN(13) + (size_t)(l * 2 + kv) * 2048 * 64, 64, 64 * kb, 32 * nb + (lane & 31), (bf16*)(ws + WS_W1T + l * SZ_W1T) + (size_t)kv * 64 * 2048, 32 * nb, 2048, 64 * kb, 1, 0, scr, lane); continue; } r -= I_H;
        { const int kv = r / 2, nb = r % 2; tr_item(KIN(14) + (size_t)(l * 2 + kv) * 64 * 64, 64, 0, 32 * nb + (lane & 31), (bf16*)(ws + WS_W2T + l * SZ_W2T) + (size_t)kv * 64 * 64, 32 * nb, 64, 0, 1, 0, scr, lane); }
    }
    float* XR = (float*)(ws + WS_XR); bf16* XGA = (bf16*)(ws + WS_XGA); float* SSA = (float*)(ws + WS_SSA); bf16* P16 = (bf16*)(ws + WS_P16);
    const float* g0 = KIN(10);
    for (int row = gw; row < MROWS; row += NGW) {
        const float* xs = (row < MP) ? KIN(0) + (size_t)row * DM : KIN(1) + (size_t)(row - MP) * DM;
        float ss = 0.f;
#pragma unroll
        for (int j = 0; j < 2; ++j) {
            const int c = j * 512 + lane * 8;
            f32x4 a = *(const f32x4*)(xs + c), b = *(const f32x4*)(xs + c + 4);
            *(f32x4*)(XR + (size_t)row * DM + c) = a; *(f32x4*)(XR + (size_t)row * DM + c + 4) = b;
            ss += (a[0] * a[0] + a[1] * a[1]) + (a[2] * a[2] + a[3] * a[3]) + (b[0] * b[0] + b[1] * b[1]) + (b[2] * b[2] + b[3] * b[3]);
            const f32x4 ga = *(const f32x4*)(g0 + c), gb = *(const f32x4*)(g0 + c + 4);
            *(v4u*)(XGA + (size_t)row * DM + c) = pack8(a * ga, b * gb);
        }
        ss = wave_sum(ss, lane);
        if (lane < 16) SSA[(size_t)row * 16 + lane] = (lane == 0) ? ss : 0.f;
#pragma unroll
        for (int l = 0; l < 2; ++l) {
            const float* ps = (row < MP) ? KIN(8) + ((size_t)l * MP + row) * PLE : KIN(9) + ((size_t)l * MS + (row - MP)) * PLE;
            const f32x4 a = *(const f32x4*)(ps + lane * 4);
            v2u o; o.x = pk2(a[0], a[1]); o.y = pk2(a[2], a[3]);
            *(v2u*)(P16 + ((size_t)l * MROWS + row) * PLE + lane * 4) = o;
        }
    }
    const int gt = F.bid * NTHREADS + F.tid, NGT = F.G * NTHREADS;
    f32x2* ROT = (f32x2*)(ws + WS_ROT);
    for (int e = gt; e < TP * 64; e += NGT) {
        const int pos = e >> 6, i = e & 63;
        const float x = (float)i * (1.0f / 63.0f);
        const float inv = exp2f(-x * 13.287712379549449f);
        const float ang = (float)pos * inv;
        const double rev = (double)ang * 0.15915494309189535;
        const float fr = (float)(rev - floor(rev));
        ROT[e] = (f32x2){__builtin_amdgcn_cosf(fr), __builtin_amdgcn_sinf(fr)};
    }
    for (int e = gt; e < 2 * 128 * 508 * 64; e += NGT) {
        const int ls = e / (508 * 64), r = e % (508 * 64);
        const f32x4 v = *(const f32x4*)(KIN(3) + (size_t)ls * 512 * 256 + 4 * 256 + (size_t)r * 4);
        *(f32x4*)(KOUT() + O_WINS + (size_t)ls * 512 * 256 + (size_t)r * 4) = v;
    }
}
DI float gelu_tanh(float x) { const float u = 0.7978845608028654f * (x + 0.044715f * x * x * x); const float e = __expf(2.f * u); return 0.5f * x * (1.f + (1.f - 2.f / (e + 1.f))); }
DI bf16x8 mk_frag(v2u a, v2u b) { v4u w; w.x = a.x; w.y = a.y; w.z = b.x; w.w = b.y; return __builtin_bit_cast(bf16x8, w); }

DI void compress_job(Frame& F, int layer, int job) {
    int lane = F.lane, wave = F.wave; asm volatile("" : "+v"(lane), "+s"(wave));
    const int tid = wave * 64 + lane, quad = lane >> 4, rl = lane & 15;
    unsigned char* ws = KWS();
    const bool sample = job < 256;
    int kv, bs, g0, nbase;
    if (sample) { kv = job >> 7; bs = job & 127; g0 = 0; nbase = 0; }
    else { const int j2 = job - 256; kv = j2 >> 3; bs = (j2 >> 2) & 1; g0 = (j2 >> 1) & 1; nbase = (j2 & 1) * 256; }
    const bf16* W1T = (const bf16*)(ws + WS_W1T + layer * SZ_W1T) + (size_t)kv * 64 * 2048;
    const bf16* W2T = (const bf16*)(ws + WS_W2T + layer * SZ_W2T) + (size_t)kv * 64 * 64;
    const float* pe = KIN(12) + (size_t)(layer * 2 + kv) * 32 * 64;
    const bf16* Z = (const bf16*)(ws + WS_Z);
    const int* pt = (const int*)KIN(7);
    const float* cache = KIN(2);
    LAS unsigned char* LW = F.lds;
    int gg[2], nn[2];
#pragma unroll
    for (int tl = 0; tl < 2; ++tl) { const int T = 2 * wave + tl; if (sample) { gg[tl] = T >> 3; nn[tl] = 16 * (T & 7) + rl; } else { gg[tl] = g0; nn[tl] = nbase + 16 * T + rl; } }
    f32x4 h[2][4];
#pragma unroll
    for (int tl = 0; tl < 2; ++tl)
#pragma unroll
        for (int i = 0; i < 4; ++i) h[tl][i] = (f32x4){0.f, 0.f, 0.f, 0.f};
#pragma unroll 1
    for (int c = 0; c < 4; ++c) {
        __syncthreads();
#pragma unroll
        for (int k = 0; k < 8; ++k) { const int pc = tid + 512 * k, r = pc >> 6, c16 = pc & 63;
            *(LAS v4u*)(LW + r * 1040 + c16 * 16) = *(const v4u*)(W1T + (size_t)r * 2048 + c * 512 + c16 * 8); }
        __syncthreads();
#pragma unroll 4
        for (int kk = 0; kk < 16; ++kk) {
            const int j = 8 * c + (kk >> 1), dim0 = (kk & 1) * 32 + quad * 8;
            const f32x4 pe0 = *(const f32x4*)(pe + j * 64 + dim0), pe1 = *(const f32x4*)(pe + j * 64 + dim0 + 4);
            bf16x8 xb[2];
#pragma unroll
            for (int tl = 0; tl < 2; ++tl) {
                f32x4 x0, x1;
                if (!sample) { const size_t row = (size_t)bs * TP + 16 * nn[tl] + j; unpack8(*(const v4u*)(Z + row * LDZ + ZC_KC + kv * 128 + gg[tl] * 64 + dim0), x0, x1); }
                else { int pos = 16 * nn[tl] + j; pos = pos > 2047 ? 2047 : pos; const int phys = pt[bs * 16 + (pos >> 7)];
                    const float* p = cache + ((size_t)(layer * 2560 + phys) * 128 + (pos & 127)) * 512 + kv * 128 + gg[tl] * 64 + dim0; x0 = *(const f32x4*)p; x1 = *(const f32x4*)(p + 4); }
                xb[tl] = pack_frag(x0 + pe0, x1 + pe1);
            }
#pragma unroll
            for (int ht = 0; ht < 4; ++ht) {
                const bf16x8 a = ld_frag_l(LW + (16 * ht + rl) * 1040 + (kk * 32 + quad * 8) * 2);
                h[0][ht] = mfma16(a, xb[0], h[0][ht]); h[1][ht] = mfma16(a, xb[1], h[1][ht]);
            }
        }
    }
#pragma unroll
    for (int tl = 0; tl < 2; ++tl) {
#pragma unroll
        for (int ht = 0; ht < 4; ++ht)
#pragma unroll
            for (int i = 0; i < 4; ++i) h[tl][ht][i] = gelu_tanh(h[tl][ht][i]);
        bf16x8 gb[2]; gb[0] = pack_frag(h[tl][0], h[tl][1]); gb[1] = pack_frag(h[tl][2], h[tl][3]);
        const int n = nn[tl], g = gg[tl];
        bf16* dst = sample ? (bf16*)(ws + WS_KCS) + ((((size_t)kv * 128 + bs) * 128 + n) * 2 + g) * 64 : (bf16*)(ws + WS_KC) + ((((size_t)kv * 2 + bs) * 512 + n) * 2 + g) * 64;
        const bool zero = sample && n == 127;
#pragma unroll
        for (int ot = 0; ot < 4; ++ot) {
            f32x4 o = (f32x4){0.f, 0.f, 0.f, 0.f};
#pragma unroll
            for (int s = 0; s < 2; ++s) {
                const bf16* wp = W2T + (16 * ot + rl) * 64 + 32 * s + 4 * quad;
                o = mfma16(mk_frag(*(const v2u*)wp, *(const v2u*)(wp + 16)), gb[s], o);
            }
            v2u w; w.x = zero ? 0u : pk2(o[0], o[1]); w.y = zero ? 0u : pk2(o[2], o[3]);
            *(v2u*)(dst + 16 * ot + 4 * quad) = w;
        }
    }
    __syncthreads();
}

DI int kperm(int idx) { const int s = idx >> 5, r = idx & 31; return 32 * s + 8 * ((r >> 2) & 3) + 4 * (r >> 4) + (r & 3); }
DI float softplusf_(float x) { return x > 20.f ? x : __logf(1.f + __expf(x)); }
DI float ret_lg(int h) { return h == 0 ? -0.031748697f : h == 1 ? -0.015748357f : h == 2 ? -0.007843178f : -0.0039138994f; }

DI void gdn_prep_unit(Frame& F, int layer, int unit) {
    const int tid = F.tid, lane = F.lane, wave = F.wave;
    const int b = unit >> 9, h = (unit >> 7) & 3, c = unit & 127;
    const int row0 = b * TP + 64 * c, t0 = 64 * c;
    unsigned char* ws = KWS();
    const bf16* Z = (const bf16*)(ws + WS_Z);
    const float* ZS = (const float*)(ws + WS_ZS);
    LAS float* Lq = (LAS float*)(F.lds); LAS float* Lk = (LAS float*)(F.lds + 33792); LAS float* Lv = (LAS float*)(F.lds + 67584);
    LAS float* LA = (LAS float*)(F.lds + 101376); LAS float* LQK = (LAS float*)(F.lds + 117760);
    LAS float* Lg = (LAS float*)(F.lds + 134144); LAS float* Lb = Lg + 64; LAS float* Le = Lg + 128;
    const float* cw = KIN(15) + (size_t)layer * 4 * 1536;
#pragma unroll
    for (int it0 = 0; it0 < 6; ++it0) {
        const int it = tid + it0 * NTHREADS;
        const int i = it / 48, ch = it % 48, part = ch >> 4, cc = ch & 15;
        const int col = part * 512 + h * 128 + cc * 8;
        f32x4 y0 = (f32x4){0.f, 0.f, 0.f, 0.f}, y1 = y0;
#pragma unroll
        for (int j = 0; j < 4; ++j) {
            const int t = t0 + i - 3 + j;
            if (t >= 0) { f32x4 x0, x1; unpack8(*(const v4u*)(Z + (size_t)(row0 + i - 3 + j) * LDZ + ZC_GQKV + col), x0, x1);
                y0 += x0 * *(const f32x4*)(cw + j * 1536 + col); y1 += x1 * *(const f32x4*)(cw + j * 1536 + col + 4); }
        }
#pragma unroll
        for (int e = 0; e < 4; ++e) { y0[e] = siluf_(y0[e]); y1[e] = siluf_(y1[e]); }
        LAS float* dst = (part == 0 ? Lq : part == 1 ? Lk : Lv) + i * 132 + cc * 8;
        *(LAS f32x4*)dst = y0; *(LAS f32x4*)(dst + 4) = y1;
    }
    __syncthreads();
    {
        float va[16], vb[16], ps[16];
#pragma unroll
        for (int q = 0; q < 16; ++q) { LAS float* vp = ((q < 8) ? Lq : Lk) + (wave * 8 + (q & 7)) * 132 + lane * 2; va[q] = vp[0]; vb[q] = vp[1]; ps[q] = va[q] * va[q] + vb[q] * vb[q]; }
#pragma unroll
        for (int q = 0; q < 16; ++q) ps[q] += shx<1>(ps[q], lane);
#pragma unroll
        for (int q = 0; q < 16; ++q) ps[q] += shx<2>(ps[q], lane);
#pragma unroll
        for (int q = 0; q < 16; ++q) ps[q] += shx<4>(ps[q], lane);
#pragma unroll
        for (int q = 0; q < 16; ++q) ps[q] += shx<8>(ps[q], lane);
#pragma unroll
        for (int q = 0; q < 16; ++q) ps[q] += shx<16>(ps[q], lane);
#pragma unroll
        for (int q = 0; q < 16; ++q) ps[q] += shx<32>(ps[q], lane);
#pragma unroll
        for (int q = 0; q < 16; ++q) { LAS float* vp = ((q < 8) ? Lq : Lk) + (wave * 8 + (q & 7)) * 132 + lane * 2; const float sc = rsqrtf(ps[q] + EPS) * ((q < 8) ? 0.08838834764831845f : 1.f); vp[0] = va[q] * sc; vp[1] = vb[q] * sc; }
    }
    if (wave == 0) {
        const float ga = ZS[(size_t)(row0 + lane) * 32 + 24 + h], gbv = ZS[(size_t)(row0 + lane) * 32 + 28 + h];
        float g = -__expf(KIN(16)[layer * 4 + h]) * softplusf_(ga + KIN(17)[layer * 4 + h]);
#pragma unroll
        for (int o = 1; o < 64; o <<= 1) { const float t = __int_as_float(__builtin_amdgcn_ds_bpermute(((lane - o) & 63) << 2, __float_as_int(g))); if (lane >= o) g += t; }
        Lg[lane] = g; Lb[lane] = sigmoidf_(gbv); Le[lane] = __expf(g);
    }
    __syncthreads();
    {
        const int it = wave >> 1, quad = lane >> 4, rl = lane & 15;
        f32x4 ckk[2], cqk[2];
#pragma unroll
        for (int jj = 0; jj < 2; ++jj) { ckk[jj] = (f32x4){0.f, 0.f, 0.f, 0.f}; cqk[jj] = ckk[jj]; }
#pragma unroll
        for (int s = 0; s < 4; ++s) {
            const LAS float* kp = Lk + (16 * it + rl) * 132 + 32 * s + 8 * quad; const LAS float* qp = Lq + (16 * it + rl) * 132 + 32 * s + 8 * quad;
            const f32x4 ka0 = *(const LAS f32x4*)kp, ka1 = *(const LAS f32x4*)(kp + 4), qa0 = *(const LAS f32x4*)qp, qa1 = *(const LAS f32x4*)(qp + 4);
            const bf16x8 kah = pack_frag(ka0, ka1), qah = pack_frag(qa0, qa1);
            f32x4 h0, h1; unpack8(__builtin_bit_cast(v4u, kah), h0, h1); const bf16x8 kal = pack_frag(ka0 - h0, ka1 - h1);
            unpack8(__builtin_bit_cast(v4u, qah), h0, h1); const bf16x8 qal = pack_frag(qa0 - h0, qa1 - h1);
#pragma unroll
            for (int jj = 0; jj < 2; ++jj) {
                const int jt = (wave & 1) * 2 + jj;
                if (jt <= it) {
                    const LAS float* bp = Lk + (16 * jt + rl) * 132 + 32 * s + 8 * quad;
                    const f32x4 kb0 = *(const LAS f32x4*)bp, kb1 = *(const LAS f32x4*)(bp + 4);
                    const bf16x8 kbh = pack_frag(kb0, kb1); unpack8(__builtin_bit_cast(v4u, kbh), h0, h1); const bf16x8 kbl = pack_frag(kb0 - h0, kb1 - h1);
                    ckk[jj] = mfma16(kah, kbh, ckk[jj]); ckk[jj] = mfma16(kah, kbl, ckk[jj]); ckk[jj] = mfma16(kal, kbh, ckk[jj]);
                    cqk[jj] = mfma16(qah, kbh, cqk[jj]); cqk[jj] = mfma16(qah, kbl, cqk[jj]); cqk[jj] = mfma16(qal, kbh, cqk[jj]);
                }
            }
        }
#pragma unroll
        for (int jj = 0; jj < 2; ++jj) {
            const int j = 16 * ((wave & 1) * 2 + jj) + rl; const float gj = Lg[j];
#pragma unroll
            for (int e = 0; e < 4; ++e) { const int i = 16 * it + 4 * quad + e; const float dec = (i >= j) ? __expf(Lg[i] - gj) : 0.f;
                LA[i * 64 + j] = (i > j) ? Lb[i] * ckk[jj][e] * dec : 0.f; LQK[i * 64 + j] = cqk[jj][e] * dec; }
        }
    }
    __syncthreads();
    unsigned char* rec = ws + WS_GREC + (size_t)unit * GREC;
    {
        const float gl = Lg[63];
        for (int it = tid; it < 2560; it += NTHREADS) {
            if (it < 1024) {
                const int i = it >> 4, s = (it >> 2) & 3, quad = it & 3; const float e = Le[i];
                const f32x4 a = *(const LAS f32x4*)(Lq + i * 132 + 32 * s + 4 * quad) * e, bq = *(const LAS f32x4*)(Lq + i * 132 + 32 * s + 16 + 4 * quad) * e;
                *(v4u*)(rec + 16384 + i * 256 + (32 * s + 8 * quad) * 2) = pack8(a, bq);
            } else if (it < 2048) {
                const int r = it - 1024, dk = r >> 3, s2 = (r >> 2) & 1, quad = r & 3;
                f32x4 a, bq;
#pragma unroll
                for (int e = 0; e < 4; ++e) { const int ta = 32 * s2 + 4 * quad + e, tb = ta + 16; a[e] = Lk[ta * 132 + dk] * __expf(gl - Lg[ta]); bq[e] = Lk[tb * 132 + dk] * __expf(gl - Lg[tb]); }
                *(v4u*)(rec + 32768 + dk * 128 + (32 * s2 + 8 * quad) * 2) = pack8(a, bq);
            } else {
                const int r = it - 2048, i = r >> 3, s2 = (r >> 2) & 1, quad = r & 3;
                const f32x4 a = *(const LAS f32x4*)(LQK + i * 64 + 32 * s2 + 4 * quad), bq = *(const LAS f32x4*)(LQK + i * 64 + 32 * s2 + 16 + 4 * quad);
                *(v4u*)(rec + 65536 + i * 128 + (32 * s2 + 8 * quad) * 2) = pack8(a, bq);
            }
        }
        if (tid == 0) *(float*)(rec + 73728) = __expf(gl);
    }
    __syncthreads();
    if (tid < 256) {
        LAS float* X = (tid < 128) ? (Lv + tid) : (Lk + (tid - 128));
        const bool isw = tid >= 128;
#pragma unroll 1
        for (int B = 0; B < 4; ++B) {
            float xb[16];
#pragma unroll
            for (int i = 0; i < 16; ++i) { const int r = 16 * B + i; xb[i] = (isw ? Lb[r] * Le[r] : Lb[r]) * X[r * 132]; }
#pragma unroll 1
            for (int j4 = 0; j4 < 4 * B; ++j4) {
                const float x0 = X[(4 * j4) * 132], x1 = X[(4 * j4 + 1) * 132], x2 = X[(4 * j4 + 2) * 132], x3 = X[(4 * j4 + 3) * 132];
#pragma unroll
                for (int i = 0; i < 16; ++i) { const f32x4 a = *(const LAS f32x4*)(LA + (16 * B + i) * 64 + 4 * j4); xb[i] -= (a[0] * x0 + a[1] * x1) + (a[2] * x2 + a[3] * x3); }
            }
#pragma unroll
            for (int i = 1; i < 16; ++i) {
                float acc0 = 0.f, acc1 = 0.f;
#pragma unroll
                for (int j4 = 0; j4 < (i + 3) / 4; ++j4) { const f32x4 a = *(const LAS f32x4*)(LA + (16 * B + i) * 64 + 16 * B + 4 * j4);
                    if (4 * j4 + 0 < i) acc0 += a[0] * xb[4 * j4 + 0]; if (4 * j4 + 1 < i) acc1 += a[1] * xb[4 * j4 + 1]; if (4 * j4 + 2 < i) acc0 += a[2] * xb[4 * j4 + 2]; if (4 * j4 + 3 < i) acc1 += a[3] * xb[4 * j4 + 3]; }
                xb[i] -= acc0 + acc1;
            }
#pragma unroll
            for (int i = 0; i < 16; ++i) X[(16 * B + i) * 132] = xb[i];
        }
    }
    __syncthreads();
    for (int it = tid; it < 2048; it += NTHREADS) {
        if (it < 1024) {
            const int dv = it >> 3, q = it & 7;
            v4u w; w.x = pk2(Lv[(8 * q) * 132 + dv], Lv[(8 * q + 1) * 132 + dv]); w.y = pk2(Lv[(8 * q + 2) * 132 + dv], Lv[(8 * q + 3) * 132 + dv]);
            w.z = pk2(Lv[(8 * q + 4) * 132 + dv], Lv[(8 * q + 5) * 132 + dv]); w.w = pk2(Lv[(8 * q + 6) * 132 + dv], Lv[(8 * q + 7) * 132 + dv]);
            *(v4u*)(rec + 49152 + dv * 128 + q * 16) = w;
        } else {
            const int r = it - 1024, i = r >> 4, s = (r >> 2) & 3, quad = r & 3;
            const f32x4 a = *(const LAS f32x4*)(Lk + i * 132 + 32 * s + 4 * quad), bq = *(const LAS f32x4*)(Lk + i * 132 + 32 * s + 16 + 4 * quad);
            *(v4u*)(rec + i * 256 + (32 * s + 8 * quad) * 2) = pack8(a, bq);
        }
    }
    __syncthreads();
}

DI void ret_prep_unit(Frame& F, int layer, int unit) {
    const int tid = F.tid, lane = F.lane, wave = F.wave, quad = lane >> 4, rl = lane & 15;
    const int b = unit >> 8, h = (unit >> 6) & 3, c = unit & 63;
    const int row0 = b * TP + 128 * c;
    unsigned char* ws = KWS();
    const bf16* Z = (const bf16*)(ws + WS_Z);
    const f32x2* ROT = (const f32x2*)(ws + WS_ROT);
    bf16* QR = (bf16*)(ws + WS_QR); bf16* KR = (bf16*)(ws + WS_KR);
    LAS unsigned char* LK = F.lds; LAS unsigned char* LV = F.lds + 34816;
    const float lg = ret_lg(h);
    for (int it = tid; it < 1024; it += NTHREADS) {
        const int j = it >> 3, cc = it & 7, d0 = cc * 8;
        const size_t zr = (size_t)(row0 + j) * LDZ + ZC_RQKV + h * 128 + d0;
        f32x4 q1a, q1b, q2a, q2b, k1a, k1b, k2a, k2b;
        unpack8(*(const v4u*)(Z + zr), q1a, q1b); unpack8(*(const v4u*)(Z + zr + 64), q2a, q2b);
        unpack8(*(const v4u*)(Z + zr + 512), k1a, k1b); unpack8(*(const v4u*)(Z + zr + 512 + 64), k2a, k2b);
        const f32x2* rp = ROT + (size_t)(128 * c + j) * 64 + d0;
        const float kd = __expf((float)(127 - j) * lg);
        f32x4 oq1a, oq1b, oq2a, oq2b, ok1a, ok1b, ok2a, ok2b;
#pragma unroll
        for (int e = 0; e < 8; ++e) {
            const f32x2 cs = rp[e];
            const float q1 = e < 4 ? q1a[e & 3] : q1b[e & 3], q2 = e < 4 ? q2a[e & 3] : q2b[e & 3], k1 = e < 4 ? k1a[e & 3] : k1b[e & 3], k2 = e < 4 ? k2a[e & 3] : k2b[e & 3];
            const float rq1 = q1 * cs.x - q2 * cs.y, rq2 = q2 * cs.x + q1 * cs.y, rk1 = (k1 * cs.x - k2 * cs.y) * 0.08838834764831845f, rk2 = (k2 * cs.x + k1 * cs.y) * 0.08838834764831845f;
            if (e < 4) { oq1a[e & 3] = rq1; oq2a[e & 3] = rq2; ok1a[e & 3] = rk1; ok2a[e & 3] = rk2; } else { oq1b[e & 3] = rq1; oq2b[e & 3] = rq2; ok1b[e & 3] = rk1; ok2b[e & 3] = rk2; }
            *(LAS bf16*)(LK + (d0 + e) * 272 + j * 2) = (bf16)f2bf(rk1 * kd); *(LAS bf16*)(LK + (d0 + 64 + e) * 272 + j * 2) = (bf16)f2bf(rk2 * kd);
        }
        const size_t orow = (size_t)(row0 + j) * 512 + h * 128 + d0;
        *(v4u*)(QR + orow) = pack8(oq1a, oq1b); *(v4u*)(QR + orow + 64) = pack8(oq2a, oq2b);
        *(v4u*)(KR + orow) = pack8(ok1a, ok1b); *(v4u*)(KR + orow + 64) = pack8(ok2a, ok2b);
    }
    for (int it = tid; it < 2048; it += NTHREADS) {
        const int j = it >> 4, cc = it & 15;
        const v4u w = *(const v4u*)(Z + (size_t)(row0 + j) * LDZ + ZC_RQKV + 1024 + h * 128 + cc * 8);
        LAS unsigned char* d = LV + (cc * 8) * 272 + j * 2;
        *(LAS bf16*)(d) = (bf16)(w.x & 0xffff); *(LAS bf16*)(d + 272) = (bf16)(w.x >> 16); *(LAS bf16*)(d + 2 * 272) = (bf16)(w.y & 0xffff); *(LAS bf16*)(d + 3 * 272) = (bf16)(w.y >> 16);
        *(LAS bf16*)(d + 4 * 272) = (bf16)(w.z & 0xffff); *(LAS bf16*)(d + 5 * 272) = (bf16)(w.z >> 16); *(LAS bf16*)(d + 6 * 272) = (bf16)(w.w & 0xffff); *(LAS bf16*)(d + 7 * 272) = (bf16)(w.w >> 16);
    }
    __syncthreads();
    float* RKV = (float*)(ws + WS_RKV) + (size_t)unit * 16384;
#pragma unroll
    for (int nt = 0; nt < 8; ++nt) {
        f32x4 acc = (f32x4){0.f, 0.f, 0.f, 0.f};
#pragma unroll
        for (int s = 0; s < 4; ++s) acc = mfma16(ld_frag_l(LK + (16 * wave + rl) * 272 + (32 * s + 8 * quad) * 2), ld_frag_l(LV + (16 * nt + rl) * 272 + (32 * s + 8 * quad) * 2), acc);
#pragma unroll
        for (int i = 0; i < 4; ++i) RKV[(size_t)(16 * wave + 4 * quad + i) * 128 + 16 * nt + rl] = acc[i];
    }
    __syncthreads();
}
DI void sample_rec_unit(Frame& F, int layer, int unit) {
    const int tid = F.tid, lane = F.lane, wave = F.wave;
    const int kind = unit >> 9, s = (unit >> 2) & 127, h = unit & 3;
    const int dv = tid & 127, part = tid >> 7, r0 = MP + 4 * s;
    unsigned char* ws = KWS();
    const bf16* Z = (const bf16*)(ws + WS_Z);
    const float* ZS = (const float*)(ws + WS_ZS);
    LAS float* Lq = (LAS float*)(F.lds); LAS float* Lk = Lq + 512; LAS float* Lv = Lq + 1024; LAS float* red = Lq + 1536; LAS float* Lo = Lq + 2048; LAS float* sc = Lq + 2560;
    float S[32];
    if (kind == 0) {
        if (tid < 384) {
            const int pr = tid >> 7, d = tid & 127, col = pr * 512 + h * 128 + d;
            float xp[7], w[4];
#pragma unroll
            for (int i = 0; i < 3; ++i) xp[i] = KIN(4)[((size_t)(layer * 128 + s) * 3 + i) * 1536 + col];
#pragma unroll
            for (int j = 0; j < 4; ++j) xp[3 + j] = bf2f(Z[(size_t)(r0 + j) * LDZ + ZC_GQKV + col]);
#pragma unroll
            for (int i = 0; i < 4; ++i) w[i] = KIN(15)[(size_t)(layer * 4 + i) * 1536 + col];
            LAS float* dst = pr == 0 ? Lq : pr == 1 ? Lk : Lv;
#pragma unroll
            for (int j = 0; j < 4; ++j) dst[j * 128 + d] = siluf_(w[0] * xp[j] + w[1] * xp[j + 1] + w[2] * xp[j + 2] + w[3] * xp[j + 3]);
        }
        __syncthreads();
        {
            LAS float* vp = (wave < 4 ? Lq : Lk) + (wave & 3) * 128;
            const float a = vp[2 * lane], b = vp[2 * lane + 1];
            const float scl = rsqrtf(wave_sum(a * a + b * b, lane) + EPS) * (wave < 4 ? 0.08838834764831845f : 1.f);
            vp[2 * lane] = a * scl; vp[2 * lane + 1] = b * scl;
        }
        if (tid < 4) {
            const float ga = ZS[(size_t)(r0 + tid) * 32 + 24 + h], gb = ZS[(size_t)(r0 + tid) * 32 + 28 + h];
            sc[tid] = __expf(-__expf(KIN(16)[layer * 4 + h]) * softplusf_(ga + KIN(17)[layer * 4 + h])); sc[4 + tid] = sigmoidf_(gb);
        }
        __syncthreads();
        const float* Sin = KIN(5) + ((size_t)((layer * 128 + s) * 4 + h) * 128 + 32 * part) * 128 + dv;
#pragma unroll
        for (int i = 0; i < 32; ++i) S[i] = Sin[(size_t)i * 128];
#pragma unroll
        for (int j = 0; j < 4; ++j) {
            const float a = sc[j], beta = sc[4 + j];
            float p = 0.f;
#pragma unroll
            for (int i = 0; i < 32; ++i) { S[i] *= a; p += Lk[j * 128 + 32 * part + i] * S[i]; }
            red[part * 128 + dv] = p;
            __syncthreads();
            const float delta = beta * (Lv[j * 128 + dv] - ((red[dv] + red[128 + dv]) + (red[256 + dv] + red[384 + dv])));
            __syncthreads();
            float o = 0.f;
#pragma unroll
            for (int i = 0; i < 32; ++i) { S[i] += Lk[j * 128 + 32 * part + i] * delta; o += Lq[j * 128 + 32 * part + i] * S[i]; }
            red[part * 128 + dv] = o;
            __syncthreads();
            if (part == 0) Lo[j * 128 + dv] = (red[dv] + red[128 + dv]) + (red[256 + dv] + red[384 + dv]);
            __syncthreads();
        }
        float* Sout = KOUT() + O_GSS + ((size_t)((layer * 128 + s) * 4 + h) * 128 + 32 * part) * 128 + dv;
#pragma unroll
        for (int i = 0; i < 32; ++i) Sout[(size_t)i * 128] = S[i];
        ((float*)(ws + WS_OGDN))[(size_t)(r0 + part) * 512 + h * 128 + dv] = Lo[part * 128 + dv];
    } else {
        const f32x2* ROT = (const f32x2*)(ws + WS_ROT);
        if (tid < 384) {
            const int pr = tid >> 7, d = tid & 127;
#pragma unroll
            for (int j = 0; j < 4; ++j) {
                const bf16* zp = Z + (size_t)(r0 + j) * LDZ + ZC_RQKV + pr * 512 + h * 128;
                float v = bf2f(zp[d]);
                if (pr < 2) { const f32x2 cs = ROT[(size_t)(2048 + j) * 64 + (d & 63)]; const float o = bf2f(zp[d ^ 64]);
                    v = (d < 64) ? v * cs.x - o * cs.y : v * cs.x + o * cs.y; if (pr == 1) v *= 0.08838834764831845f; }
                (pr == 0 ? Lq : pr == 1 ? Lk : Lv)[j * 128 + d] = v;
            }
        }
        __syncthreads();
        const float gam = __expf(ret_lg(h));
        const float* Sin = KIN(6) + ((size_t)((layer * 128 + s) * 4 + h) * 128 + 32 * part) * 128 + dv;
#pragma unroll
        for (int i = 0; i < 32; ++i) S[i] = Sin[(size_t)i * 128];
#pragma unroll
        for (int j = 0; j < 4; ++j) {
            const float vv = Lv[j * 128 + dv];
            float o = 0.f;
#pragma unroll
            for (int i = 0; i < 32; ++i) { S[i] = S[i] * gam + Lk[j * 128 + 32 * part + i] * vv; o += Lq[j * 128 + 32 * part + i] * S[i]; }
            red[part * 128 + dv] = o;
            __syncthreads();
            if (part == 0) Lo[j * 128 + dv] = (red[dv] + red[128 + dv]) + (red[256 + dv] + red[384 + dv]);
            __syncthreads();
        }
        float* Sout = KOUT() + O_RSS + ((size_t)((layer * 128 + s) * 4 + h) * 128 + 32 * part) * 128 + dv;
#pragma unroll
        for (int i = 0; i < 32; ++i) Sout[(size_t)i * 128] = S[i];
        if (wave < 4) {
            const int j = wave; const float a = Lo[j * 128 + 2 * lane], b = Lo[j * 128 + 2 * lane + 1];
            const float scl = rsqrtf(wave_sum(a * a + b * b, lane) * (1.f / 128.f) + EPS);
            const bf16* gp = Z + (size_t)(r0 + j) * LDZ + ZC_RG + h * 128 + 2 * lane;
            *(unsigned*)((bf16*)(ws + WS_MIX) + (size_t)(r0 + j) * 1536 + 1024 + h * 128 + 2 * lane) = pk2(a * scl * siluf_(bf2f(gp[0])), b * scl * siluf_(bf2f(gp[1])));
        }
    }
    __syncthreads();
}

DI void gdn_scan_chain(Frame& F, int layer, int bh) {
    int lane = F.lane, wave = F.wave; asm volatile("" : "+v"(lane), "+s"(wave));
    const int tid = wave * 64 + lane, quad = lane >> 4, rl = lane & 15;
    unsigned char* ws = KWS();
    const unsigned char* recb = ws + WS_GREC + (size_t)bh * 128 * GREC;
    LAS unsigned char* L = F.lds;
    constexpr int L_WP = 0, L_QP = 17408, L_KT = 34816, L_UT = 53248, L_QK = 71680;
    f32x4 S[8];
#pragma unroll
    for (int i = 0; i < 8; ++i) S[i] = (f32x4){0.f, 0.f, 0.f, 0.f};
    v4u pf[9]; float egl;
#pragma unroll
    for (int k = 0; k < 9; ++k) pf[k] = *(const v4u*)(recb + (size_t)(tid + 512 * k) * 16);
    egl = *(const float*)(recb + 73728);
    float* OG = (float*)(ws + WS_OGDN);
    const int b = bh >> 2, h = bh & 3;
    for (int c = 0; c < 128; ++c) {
        __syncthreads();
#pragma unroll
        for (int k = 0; k < 9; ++k) {
            const int o = tid * 16 + (k & 1) * 8192;
            const int reg = k >> 1;
            int dst;
            if (reg < 2) dst = (reg == 0 ? L_WP : L_QP) + (o >> 8) * 272 + (o & 255);
            else dst = (reg == 2 ? L_KT : reg == 3 ? L_UT : L_QK) + (o >> 7) * 144 + (o & 127);
            *(LAS v4u*)(L + dst) = pf[k];
        }
        const float eg = egl;
        __syncthreads();
        {
            const unsigned char* rn = recb + (size_t)(c + 1 < 128 ? c + 1 : 127) * GREC;
#pragma unroll
            for (int k = 0; k < 9; ++k) pf[k] = *(const v4u*)(rn + (size_t)(tid + 512 * k) * 16);
            egl = *(const float*)(rn + 73728);
        }
        bf16x8 Sb[4];
#pragma unroll
        for (int s = 0; s < 4; ++s) Sb[s] = pack_frag(S[2 * s], S[2 * s + 1]);
        f32x4 vn[4], O[4];
#pragma unroll
        for (int rt = 0; rt < 4; ++rt) {
            f32x4 wsacc = (f32x4){0.f, 0.f, 0.f, 0.f}, o = wsacc;
#pragma unroll
            for (int s = 0; s < 4; ++s) {
                wsacc = mfma16(ld_frag_l(L + L_WP + (16 * rt + rl) * 272 + (32 * s + 8 * quad) * 2), Sb[s], wsacc);
                o = mfma16(ld_frag_l(L + L_QP + (16 * rt + rl) * 272 + (32 * s + 8 * quad) * 2), Sb[s], o);
            }
            const v2u uw = *(const LAS v2u*)(L + L_UT + (16 * wave + rl) * 144 + (16 * rt + 4 * quad) * 2);
            vn[rt][0] = lo_bf(uw.x) - wsacc[0]; vn[rt][1] = hi_bf(uw.x) - wsacc[1]; vn[rt][2] = lo_bf(uw.y) - wsacc[2]; vn[rt][3] = hi_bf(uw.y) - wsacc[3];
            O[rt] = o;
        }
        bf16x8 Vb[2]; Vb[0] = pack_frag(vn[0], vn[1]); Vb[1] = pack_frag(vn[2], vn[3]);
#pragma unroll
        for (int rt = 0; rt < 4; ++rt) {
#pragma unroll
            for (int s2 = 0; s2 < 2; ++s2) O[rt] = mfma16(ld_frag_l(L + L_QK + (16 * rt + rl) * 144 + (32 * s2 + 8 * quad) * 2), Vb[s2], O[rt]);
            const size_t row = (size_t)b * TP + 64 * c + 16 * rt + 4 * quad;
#pragma unroll
            for (int i = 0; i < 4; ++i) OG[(row + i) * 512 + h * 128 + 16 * wave + rl] = O[rt][i];
        }
#pragma unroll
        for (int kt = 0; kt < 8; ++kt) {
            f32x4 a = S[kt] * eg;
#pragma unroll
            for (int s2 = 0; s2 < 2; ++s2) a = mfma16(ld_frag_l(L + L_KT + (16 * kt + rl) * 144 + (32 * s2 + 8 * quad) * 2), Vb[s2], a);
            S[kt] = a;
        }
    }
    float* So = KOUT() + O_GSP + (size_t)(layer * 8 + bh) * 16384;
#pragma unroll
    for (int kt = 0; kt < 8; ++kt)
#pragma unroll
        for (int i = 0; i < 4; ++i) So[(size_t)(16 * kt + 4 * quad + i) * 128 + 16 * wave + rl] = S[kt][i];
    __syncthreads();
}
DI void ret_scan_part(Frame& F, int layer, int r) {
    int tid = F.tid; asm volatile("" : "+v"(tid));
    const int bh = r >> 2, dv = tid & 127, dk0 = ((r & 3) * 4 + (tid >> 7)) * 8, h = bh & 3;
    unsigned char* ws = KWS();
    const float* RKV = (const float*)(ws + WS_RKV) + (size_t)bh * 64 * 16384;
    bf16* RST = (bf16*)(ws + WS_RST) + (size_t)bh * 64 * 16384;
    const float cdec = __expf(128.f * ret_lg(h));
    float S[8];
#pragma unroll
    for (int i = 0; i < 8; ++i) S[i] = 0.f;
#pragma unroll 4
    for (int c = 0; c < 64; ++c) {
        v4u w; w.x = pk2(S[0], S[1]); w.y = pk2(S[2], S[3]); w.z = pk2(S[4], S[5]); w.w = pk2(S[6], S[7]);
        *(v4u*)(RST + (size_t)c * 16384 + dv * 128 + dk0) = w;
#pragma unroll
        for (int i = 0; i < 8; ++i) S[i] = S[i] * cdec + RKV[(size_t)c * 16384 + (dk0 + i) * 128 + dv];
    }
    float* So = KOUT() + O_RSP + (size_t)(layer * 8 + bh) * 16384;
#pragma unroll
    for (int i = 0; i < 8; ++i) So[(size_t)(dk0 + i) * 128 + dv] = S[i];
}
constexpr float SM_C = 0.125f * 1.4426950408889634f;
struct AttnState { float m, l; f32x4 O[4]; };
DI void attn_reset(AttnState& st) { st.m = -1e30f; st.l = 0.f;
#pragma unroll
    for (int i = 0; i < 4; ++i) st.O[i] = (f32x4){0.f, 0.f, 0.f, 0.f}; }
DI void qk_tile(const LAS unsigned char* Kt, const bf16x8 (&qf)[2], f32x4 (&s)[4], int rl, int quad) {
#pragma unroll
    for (int kt = 0; kt < 4; ++kt) { f32x4 a = (f32x4){0.f, 0.f, 0.f, 0.f};
#pragma unroll
        for (int kk = 0; kk < 2; ++kk) a = mfma16(ld_frag_l(Kt + (16 * kt + rl) * 144 + kk * 64 + quad * 16), qf[kk], a);
        s[kt] = a; }
}
template <class Mask> DI void attn_step(const LAS unsigned char* Kt, const LAS unsigned char* VT, const bf16x8 (&qf)[2], AttnState& st, const Mask& ok, int rl, int quad) {
    f32x4 s[4]; qk_tile(Kt, qf, s, rl, quad);
    float mx = -3e38f;
#pragma unroll
    for (int kt = 0; kt < 4; ++kt)
#pragma unroll
        for (int i = 0; i < 4; ++i) if (ok(16 * kt + 4 * quad + i)) mx = fmaxf(mx, s[kt][i]);
    const int lane = rl + 16 * quad;
    mx = fmaxf(mx, shx<16>(mx, lane)); mx = fmaxf(mx, shx<32>(mx, lane));
    const float mn = fmaxf(st.m, mx);
    const float alpha = exp2f((st.m - mn) * SM_C);
    float ls = 0.f;
#pragma unroll
    for (int kt = 0; kt < 4; ++kt)
#pragma unroll
        for (int i = 0; i < 4; ++i) { const float p = ok(16 * kt + 4 * quad + i) ? exp2f((s[kt][i] - mn) * SM_C) : 0.f; s[kt][i] = p; ls += p; }
    ls += shx<16>(ls, lane); ls += shx<32>(ls, lane);
    st.l = st.l * alpha + ls; st.m = mn;
#pragma unroll
    for (int dt = 0; dt < 4; ++dt) st.O[dt] *= alpha;
#pragma unroll
    for (int ii = 0; ii < 2; ++ii) {
        const bf16x8 pb = pack_frag(s[2 * ii], s[2 * ii + 1]);
#pragma unroll
        for (int dt = 0; dt < 4; ++dt) {
            const LAS unsigned char* vp = VT + (16 * dt + rl) * 144 + (32 * ii + 4 * quad) * 2;
            st.O[dt] = mfma16(mk_frag(*(const LAS v2u*)vp, *(const LAS v2u*)(vp + 32)), pb, st.O[dt]);
        }
    }
}
DI void attn_accum(f32x4 (&Of)[4], const AttnState& st, float gate) {
    const float sc = st.l > 0.f ? gate / st.l : 0.f;
#pragma unroll
    for (int dt = 0; dt < 4; ++dt) Of[dt] += st.O[dt] * sc;
}
DI void vt_write(LAS unsigned char* VT, int d0, int key, const v4u w) {
    LAS unsigned char* d = VT + d0 * 144 + key * 2;
    *(LAS bf16*)(d) = (bf16)(w.x & 0xffff); *(LAS bf16*)(d + 144) = (bf16)(w.x >> 16); *(LAS bf16*)(d + 2 * 144) = (bf16)(w.y & 0xffff); *(LAS bf16*)(d + 3 * 144) = (bf16)(w.y >> 16);
    *(LAS bf16*)(d + 4 * 144) = (bf16)(w.z & 0xffff); *(LAS bf16*)(d + 5 * 144) = (bf16)(w.z >> 16); *(LAS bf16*)(d + 6 * 144) = (bf16)(w.w & 0xffff); *(LAS bf16*)(d + 7 * 144) = (bf16)(w.w >> 16);
}
DI void stage_wg(LAS unsigned char* Kt, LAS unsigned char* VT, const bf16* kb, const bf16* vb, size_t stride, int tid, bool do_v) {
    const int key = tid >> 3, ch = tid & 7;
    *(LAS v4u*)(Kt + key * 144 + ch * 16) = *(const v4u*)(kb + key * stride + ch * 8);
    if (do_v) vt_write(VT, ch * 8, key, *(const v4u*)(vb + key * stride + ch * 8));
}
DI unsigned score_key(float s, bool valid, int idx) { return valid ? (((__float_as_uint(s) | 0x80000000u) & ~127u) | (unsigned)(127 - idx)) : 0u; }
DI int key_rank(const LAS unsigned* K, int ng4, unsigned k) {
    int r = 0;
    for (int g = 0; g < ng4; ++g) { const v4u v = *(const LAS v4u*)(K + 4 * g); r += (v.x > k) + (v.y > k) + (v.z > k) + (v.w > k); }
    return r;
}
DI int top16(float v0, float v1, int lane) {
    int sel = 0;
#pragma unroll 1
    for (int r = 0; r < 16; ++r) {
        float bv; int bi;
        if (v0 >= v1) { bv = v0; bi = lane; } else { bv = v1; bi = lane + 64; }
#define T16_STEP(M) { const float ov = shx<M>(bv, lane); const int oi = shxi<M>(bi, lane); const bool take = (ov > bv) || (ov == bv && oi < bi); bv = take ? ov : bv; bi = take ? oi : bi; }
        T16_STEP(32) T16_STEP(16) T16_STEP(8) T16_STEP(4) T16_STEP(2) T16_STEP(1)
#undef T16_STEP
        const bool h0 = (bi == lane), h1 = (bi == lane + 64);
        v0 = h0 ? -3e38f : v0; v1 = h1 ? -3e38f : v1; sel |= (h0 ? 1 : 0) | (h1 ? 2 : 0);
    }
    return sel;
}

typedef short v4i16_t __attribute__((ext_vector_type(4)));
DI s16x4 vtr(const LAS unsigned char* p) { return __builtin_bit_cast(s16x4, __builtin_amdgcn_ds_read_tr16_b64_v4i16((LAS v4i16_t*)p)); }
DI bf16x8 cat4(s16x4 a, s16x4 b) { bf16x8 r; r[0] = a[0]; r[1] = a[1]; r[2] = a[2]; r[3] = a[3]; r[4] = b[0]; r[5] = b[1]; r[6] = b[2]; r[7] = b[3]; return r; }
DI void attn_step3(const LAS unsigned char* Kt, const LAS unsigned char* Vt, const bf16x8 (&qf)[2], AttnState& st, int lo, int hi, bool active, int rl, int quad) {
    active = active && (hi >= lo);
    if (!__any(active)) return;
    f32x4 s[4]; qk_tile(Kt, qf, s, rl, quad);
    const int lane = rl + 16 * quad;
    const bool full = __all((lo <= 0 && hi >= 63) || !active);
    const int kq = 4 * quad - lo; const unsigned rng = (unsigned)(hi - lo);
    float lm;
    if (full) {
        const float a0 = fmaxf(fmaxf(s[0][0], s[0][1]), fmaxf(s[0][2], s[0][3])), a1 = fmaxf(fmaxf(s[1][0], s[1][1]), fmaxf(s[1][2], s[1][3]));
        const float a2 = fmaxf(fmaxf(s[2][0], s[2][1]), fmaxf(s[2][2], s[2][3])), a3 = fmaxf(fmaxf(s[3][0], s[3][1]), fmaxf(s[3][2], s[3][3]));
        lm = fmaxf(fmaxf(a0, a1), fmaxf(a2, a3));
    } else {
        lm = -3e38f;
#pragma unroll
        for (int kt = 0; kt < 4; ++kt)
#pragma unroll
            for (int i = 0; i < 4; ++i) lm = ((unsigned)(kq + 16 * kt + i) <= rng) ? fmaxf(lm, s[kt][i]) : lm;
    }
    lm = active ? lm : -3e38f;
    if (__any(lm > st.m + 320.f)) {
        float mx = fmaxf(lm, shx<16>(lm, lane)); mx = fmaxf(mx, shx<32>(mx, lane));
        const float mn = fmaxf(st.m, mx);
        const float alpha = __builtin_amdgcn_exp2f((st.m - mn) * SM_C);
        st.l *= alpha; st.m = mn;
#pragma unroll
        for (int dt = 0; dt < 4; ++dt) st.O[dt] *= alpha;
    }
    const float mc = active ? st.m * SM_C : __builtin_inff();
    float ls = 0.f;
    if (full) {
#pragma unroll
        for (int kt = 0; kt < 4; ++kt)
#pragma unroll
            for (int i = 0; i < 4; ++i) { const float p = __builtin_amdgcn_exp2f(s[kt][i] * SM_C - mc); s[kt][i] = p; ls += p; }
    } else {
#pragma unroll
        for (int kt = 0; kt < 4; ++kt)
#pragma unroll
            for (int i = 0; i < 4; ++i) { const float p = ((unsigned)(kq + 16 * kt + i) <= rng) ? __builtin_amdgcn_exp2f(s[kt][i] * SM_C - mc) : 0.f; s[kt][i] = p; ls += p; }
    }
    st.l += ls;
#pragma unroll
    for (int ii = 0; ii < 2; ++ii) {
        const bf16x8 pb = pack_frag(s[2 * ii], s[2 * ii + 1]);
#pragma unroll
        for (int dt = 0; dt < 4; ++dt) {
            const LAS unsigned char* vp = Vt + (32 * ii + 4 * quad + (rl >> 2)) * 144 + (16 * dt + 4 * (rl & 3)) * 2;
            st.O[dt] = mfma16(cat4(vtr(vp), vtr(vp + 16 * 144)), pb, st.O[dt]);
        }
    }
}
DI float attn_rowsum(const AttnState& st, int lane) { float l = st.l; l += shx<16>(l, lane); l += shx<32>(l, lane); return l; }
DI void attn_accum3(f32x4 (&Of)[4], const AttnState& st, float gate, int lane) {
    const float l = attn_rowsum(st, lane);
    const float sc = l > 0.f ? gate / l : 0.f;
#pragma unroll
    for (int dt = 0; dt < 4; ++dt) Of[dt] += st.O[dt] * sc;
}
DI float tile_max(const f32x4 (&s)[4], bool full, int kq, unsigned rng) {
    float lm;
    if (full) {
        const float a0 = fmaxf(fmaxf(s[0][0], s[0][1]), fmaxf(s[0][2], s[0][3])), a1 = fmaxf(fmaxf(s[1][0], s[1][1]), fmaxf(s[1][2], s[1][3]));
        const float a2 = fmaxf(fmaxf(s[2][0], s[2][1]), fmaxf(s[2][2], s[2][3])), a3 = fmaxf(fmaxf(s[3][0], s[3][1]), fmaxf(s[3][2], s[3][3]));
        lm = fmaxf(fmaxf(a0, a1), fmaxf(a2, a3));
    } else {
        lm = -3e38f;
#pragma unroll
        for (int kt = 0; kt < 4; ++kt)
#pragma unroll
            for (int i = 0; i < 4; ++i) lm = ((unsigned)(kq + 16 * kt + i) <= rng) ? fmaxf(lm, s[kt][i]) : lm;
    }
    return lm;
}
DI float tile_exp(f32x4 (&s)[4], bool full, int kq, unsigned rng, float mc) {
    float ls = 0.f;
    if (full) {
#pragma unroll
        for (int kt = 0; kt < 4; ++kt)
#pragma unroll
            for (int i = 0; i < 4; ++i) { const float p = __builtin_amdgcn_exp2f(s[kt][i] * SM_C - mc); s[kt][i] = p; ls += p; }
    } else {
#pragma unroll
        for (int kt = 0; kt < 4; ++kt)
#pragma unroll
            for (int i = 0; i < 4; ++i) { const float p = ((unsigned)(kq + 16 * kt + i) <= rng) ? __builtin_amdgcn_exp2f(s[kt][i] * SM_C - mc) : 0.f; s[kt][i] = p; ls += p; }
    }
    return ls;
}
DI void tile_pv(const LAS unsigned char* Vt, const f32x4 (&s)[4], f32x4 (&O)[4], int rl, int quad) {
#pragma unroll
    for (int ii = 0; ii < 2; ++ii) {
        const bf16x8 pb = pack_frag(s[2 * ii], s[2 * ii + 1]);
#pragma unroll
        for (int dt = 0; dt < 4; ++dt) {
            const LAS unsigned char* vp = Vt + (32 * ii + 4 * quad + (rl >> 2)) * 144 + (16 * dt + 4 * (rl & 3)) * 2;
            O[dt] = mfma16(cat4(vtr(vp), vtr(vp + 16 * 144)), pb, O[dt]);
        }
    }
}
DI void attn_step_pair(const LAS unsigned char* K0, const LAS unsigned char* V0, int lo0, int hi0, bool act0,
                       const LAS unsigned char* K1, const LAS unsigned char* V1, int lo1, int hi1, bool act1,
                       const bf16x8 (&qf)[2], AttnState& st, int rl, int quad) {
    act0 = act0 && (hi0 >= lo0); act1 = act1 && (hi1 >= lo1);
    const bool any0 = __any(act0), any1 = __any(act1);
    if (!any0 && !any1) return;
    const int lane = rl + 16 * quad;
    f32x4 s0[4], s1[4];
    if (any0) qk_tile(K0, qf, s0, rl, quad);
    if (any1) qk_tile(K1, qf, s1, rl, quad);
    const bool full0 = __all((lo0 <= 0 && hi0 >= 63) || !act0), full1 = __all((lo1 <= 0 && hi1 >= 63) || !act1);
    const int kq0 = 4 * quad - lo0, kq1 = 4 * quad - lo1; const unsigned rng0 = (unsigned)(hi0 - lo0), rng1 = (unsigned)(hi1 - lo1);
    float lm = -3e38f;
    if (any0) { const float a = tile_max(s0, full0, kq0, rng0); lm = act0 ? a : lm; }
    if (any1) { const float a = tile_max(s1, full1, kq1, rng1); lm = act1 ? fmaxf(lm, a) : lm; }
    if (__any(lm > st.m + 320.f)) {
        float mx = fmaxf(lm, shx<16>(lm, lane)); mx = fmaxf(mx, shx<32>(mx, lane));
        const float mn = fmaxf(st.m, mx);
        const float alpha = __builtin_amdgcn_exp2f((st.m - mn) * SM_C);
        st.l *= alpha; st.m = mn;
#pragma unroll
        for (int dt = 0; dt < 4; ++dt) st.O[dt] *= alpha;
    }
    const float mcb = st.m * SM_C;
    if (any0) st.l += tile_exp(s0, full0, kq0, rng0, act0 ? mcb : __builtin_inff());
    if (any1) st.l += tile_exp(s1, full1, kq1, rng1, act1 ? mcb : __builtin_inff());
    if (any0) tile_pv(V0, s0, st.O, rl, quad);
    if (any1) tile_pv(V1, s1, st.O, rl, quad);
}
DI void nsa_prompt_unit(Frame& F, int layer, int unit) {
    int lane = F.lane, wave = F.wave; asm volatile("" : "+v"(lane), "+s"(wave));
    const int tid = wave * 64 + lane, quad = lane >> 4, rl = lane & 15;
    const int b = unit >> 9, g = (unit >> 8) & 1, tt = unit & 255, t0 = 32 * tt;
    unsigned char* ws = KWS();
    const bf16* Z = (const bf16*)(ws + WS_Z);
    const float* ZS = (const float*)(ws + WS_ZS);
    LAS unsigned char* TB = F.lds;
    LAS float* AIMP = (LAS float*)(F.lds + 73728);
    LAS unsigned* SEL = (LAS unsigned*)(F.lds + 139264);
    const int tk = 4 * wave + (rl >> 2), t = t0 + tk, head = 4 * g + (rl & 3);
    const size_t row = (size_t)b * TP + t;
    bf16x8 qf[2];
    qf[0] = ld_frag_g(Z + row * LDZ + ZC_Q + head * 64 + quad * 8); qf[1] = ld_frag_g(Z + row * LDZ + ZC_Q + head * 64 + 32 + quad * 8);
    const float gc = sigmoidf_(ZS[row * 32 + head * 3]), gs = sigmoidf_(ZS[row * 32 + head * 3 + 1]), gw = sigmoidf_(ZS[row * 32 + head * 3 + 2]);
    f32x4 Of[4];
#pragma unroll
    for (int i = 0; i < 4; ++i) Of[i] = (f32x4){0.f, 0.f, 0.f, 0.f};
    AttnState st;
    const int nct = (t0 >> 10) + 1;
    const bf16* KC = (const bf16*)(ws + WS_KC) + ((size_t)(0 * 2 + b) * 512 * 2 + g) * 64;
    const bf16* VC = (const bf16*)(ws + WS_KC) + ((size_t)(1 * 2 + b) * 512 * 2 + g) * 64;
    const bf16* Zb = Z + (size_t)b * TP * LDZ + g * 64;
    const int skey = tid >> 3, sch = tid & 7;
    const int wlo = (t0 - 511 > 0 ? t0 - 511 : 0) >> 6, nwin = ((t0 + 31) >> 6) - wlo + 1;
    const int nwe = (nwin + 1) & ~1, nce = (nct + 1) & ~1;
    v4u rkA, rvA, rkB, rvB;
#define COMMIT(slot, rk, rv) do { LAS unsigned char* d_ = TB + (slot) * 18432 + skey * 144 + sch * 16; *(LAS v4u*)d_ = rk; *(LAS v4u*)(d_ + 9216) = rv; } while (0)
    const int n1 = nwe + 2 * nce;
#define SEG1_VALID(i) ((i) < nwe ? (i) < nwin : (((i) - nwe) < nce ? ((i) - nwe) < nct : ((i) - nwe - nce) < nct))
#define SEG1_ISSUE(i, rk, rv) do { int i_ = (i); i_ = i_ < n1 ? i_ : n1 - 1; const bool win_ = i_ < nwe; int wt_ = wlo + (i_ < nwin ? i_ : nwin - 1); int jt_ = (i_ - nwe) % nce; jt_ = jt_ < nct ? jt_ : nct - 1; jt_ = jt_ < 0 ? 0 : jt_; \
        const bf16* pk_ = win_ ? Zb + (size_t)(64 * wt_ + skey) * LDZ + sch * 8 + ZC_KW : KC + (size_t)(64 * jt_ + skey) * 128 + sch * 8; \
        const bf16* pv_ = win_ ? Zb + (size_t)(64 * wt_ + skey) * LDZ + sch * 8 + ZC_VW : VC + (size_t)(64 * jt_ + skey) * 128 + sch * 8; \
        rk = *(const v4u*)pk_; rv = *(const v4u*)pv_; } while (0)
    attn_reset(st);
    float mfin = 0.f, il = 0.f;
    SEG1_ISSUE(0, rkA, rvA); SEG1_ISSUE(1, rkB, rvB);
    COMMIT(0, rkA, rvA); COMMIT(1, rkB, rvB);
    SEG1_ISSUE(2, rkA, rvA); SEG1_ISSUE(3, rkB, rvB);
    __syncthreads();
    for (int i = 0; i < n1; i += 2) {
        const LAS unsigned char* K0 = TB + (i & 3) * 18432; const LAS unsigned char* K1 = TB + ((i + 1) & 3) * 18432;
        if (i < nwe) {
            const int kb0 = 64 * (wlo + i), kb1 = kb0 + 64;
            attn_step_pair(K0, K0 + 9216, t - 511 - kb0, t - kb0, true, K1, K1 + 9216, t - 511 - kb1, t - kb1, (i + 1) < nwin, qf, st, rl, quad);
            if (i + 2 == nwe) { attn_accum3(Of, st, gw, lane); attn_reset(st); }
        } else if (i < nwe + nce) {
            const int nb0 = 64 * (i - nwe), nb1 = nb0 + 64;
            attn_step_pair(K0, K0 + 9216, 0, ((t - 31) >> 4) - nb0, true, K1, K1 + 9216, 0, ((t - 31) >> 4) - nb1, (i + 1 - nwe) < nct, qf, st, rl, quad);
            if (i + 2 == nwe + nce) { attn_accum3(Of, st, gc, lane); mfin = st.m * SM_C; const float lt_ = attn_rowsum(st, lane); il = lt_ > 0.f ? 1.f / lt_ : 0.f; }
        } else {
#pragma unroll
            for (int e2 = 0; e2 < 2; ++e2) {
                const int jt = i + e2 - nwe - nce;
                if (jt < nct) {
                    f32x4 s[4]; qk_tile(e2 ? K1 : K0, qf, s, rl, quad);
#pragma unroll
                    for (int kt = 0; kt < 4; ++kt)
#pragma unroll
                        for (int e = 0; e < 4; ++e) {
                            const int n = 64 * jt + 16 * kt + 4 * quad + e;
                            float p = (16 * n + 31 <= t) ? __builtin_amdgcn_exp2f(s[kt][e] * SM_C - mfin) * il : 0.f;
                            p += shx<1>(p, lane); p += shx<2>(p, lane);
                            if ((rl & 3) == 0) AIMP[tk * 512 + n] = p;
                        }
                }
            }
        }
        if (i + 2 < n1) { if (SEG1_VALID(i + 2)) COMMIT((i + 2) & 3, rkA, rvA); if (SEG1_VALID(i + 3)) COMMIT((i + 3) & 3, rkB, rvB); }
        __syncthreads();
        SEG1_ISSUE(i + 4, rkA, rvA); SEG1_ISSUE(i + 5, rkB, rvB);
    }
    {
        const int nav = nct * 64;
        LAS unsigned* KS = (LAS unsigned*)(TB + wave * 2048);
#pragma unroll
        for (int q = 0; q < 4; ++q) {
            const int tq = 4 * wave + q, cur = (t0 + tq) >> 6;
#pragma unroll
            for (int e = 0; e < 2; ++e) {
                const int sblk = lane + 64 * e;
                float imp = 0.f;
#pragma unroll
                for (int d = -1; d <= 3; ++d) { const int n = 4 * sblk + d; if (n >= 0 && n < nav) imp += AIMP[tq * 512 + n]; }
                const bool valid = sblk <= cur, forced = (sblk == 0) || (sblk == cur) || (sblk == cur - 1);
                KS[q * 128 + sblk] = score_key(imp + (forced ? 1000.f : 0.f), valid, sblk);
            }
        }
        asm volatile("" ::: "memory");
#pragma unroll
        for (int q = 0; q < 4; ++q) {
            const int tq = 4 * wave + q, cur = (t0 + tq) >> 6, ng4 = (cur >> 2) + 1;
            const unsigned k0 = KS[q * 128 + lane], k1 = KS[q * 128 + 64 + lane];
            const bool s0 = (lane <= cur) && key_rank(KS + q * 128, ng4, k0) < 16, s1 = (lane + 64 <= cur) && key_rank(KS + q * 128, ng4, k1) < 16;
            const unsigned long long m0 = __ballot(s0), m1 = __ballot(s1);
            if (lane == 0) { SEL[tq * 4 + 0] = (unsigned)m0; SEL[tq * 4 + 1] = (unsigned)(m0 >> 32); SEL[tq * 4 + 2] = (unsigned)m1; SEL[tq * 4 + 3] = (unsigned)(m1 >> 32); }
        }
    }
    __syncthreads();
    unsigned un[4], my[4], wv[4];
#pragma unroll
    for (int w = 0; w < 4; ++w) { unsigned v = (lane < 32) ? SEL[lane * 4 + w] : 0u;
        v |= (unsigned)shxi<1>((int)v, lane); v |= (unsigned)shxi<2>((int)v, lane); v |= (unsigned)shxi<4>((int)v, lane); v |= (unsigned)shxi<8>((int)v, lane); v |= (unsigned)shxi<16>((int)v, lane); v |= (unsigned)shxi<32>((int)v, lane);
        un[w] = __builtin_amdgcn_readfirstlane(v); my[w] = SEL[tk * 4 + w];
        wv[w] = SEL[(4 * wave) * 4 + w] | SEL[(4 * wave + 1) * 4 + w] | SEL[(4 * wave + 2) * 4 + w] | SEL[(4 * wave + 3) * 4 + w]; wv[w] = __builtin_amdgcn_readfirstlane(wv[w]); }
    attn_reset(st);
    {
        unsigned w0 = un[0], w1 = un[1], w2 = un[2], w3 = un[3];
#define NEXT_BLK(dst) do { if (w0) { dst = __builtin_ctz(w0); w0 &= w0 - 1u; } else if (w1) { dst = 32 + __builtin_ctz(w1); w1 &= w1 - 1u; } else if (w2) { dst = 64 + __builtin_ctz(w2); w2 &= w2 - 1u; } \
        else if (w3) { dst = 96 + __builtin_ctz(w3); w3 &= w3 - 1u; } else dst = -1; } while (0)
#define SEG2_ISSUE(blk_, rk, rv) do { const int b_ = (blk_) >= 0 ? (blk_) : 0; const bf16* p_ = Zb + (size_t)(64 * b_ + skey) * LDZ + sch * 8; rk = *(const v4u*)(p_ + ZC_KS); rv = *(const v4u*)(p_ + ZC_VS); } while (0)
#define BLK_WORD(arr, blk_) (((blk_) >> 5) == 0 ? arr[0] : ((blk_) >> 5) == 1 ? arr[1] : ((blk_) >> 5) == 2 ? arr[2] : arr[3])
        int c0, c1, n0, n1b, m0, m1;
        NEXT_BLK(c0); NEXT_BLK(c1); NEXT_BLK(n0); NEXT_BLK(n1b);
        SEG2_ISSUE(c0, rkA, rvA); SEG2_ISSUE(c1, rkB, rvB);
        COMMIT(0, rkA, rvA); if (c1 >= 0) COMMIT(1, rkB, rvB);
        SEG2_ISSUE(n0, rkA, rvA); SEG2_ISSUE(n1b, rkB, rvB);
        __syncthreads();
        int i = 0;
        while (c0 >= 0) {
            NEXT_BLK(m0); NEXT_BLK(m1);
            const LAS unsigned char* K0 = TB + (i & 3) * 18432; const LAS unsigned char* K1 = TB + ((i + 1) & 3) * 18432;
            const int cc1 = c1 >= 0 ? c1 : 0;
            const bool need0 = (BLK_WORD(wv, c0) >> (c0 & 31)) & 1u, need1 = (c1 >= 0) && ((BLK_WORD(wv, cc1) >> (cc1 & 31)) & 1u);
            const bool mine0 = need0 && ((BLK_WORD(my, c0) >> (c0 & 31)) & 1u), mine1 = need1 && ((BLK_WORD(my, cc1) >> (cc1 & 31)) & 1u);
            attn_step_pair(K0, K0 + 9216, 0, t - 64 * c0, mine0, K1, K1 + 9216, 0, t - 64 * cc1, mine1, qf, st, rl, quad);
            if (n0 >= 0) COMMIT((i + 2) & 3, rkA, rvA); if (n1b >= 0) COMMIT((i + 3) & 3, rkB, rvB);
            __syncthreads();
            SEG2_ISSUE(m0, rkA, rvA); SEG2_ISSUE(m1, rkB, rvB);
            c0 = n0; c1 = n1b; n0 = m0; n1b = m1; i += 2;
        }
    }
    attn_accum3(Of, st, gs, lane);
#undef SEG1_ISSUE
#undef SEG1_VALID
#undef SEG2_ISSUE
#undef BLK_WORD
#undef COMMIT
#undef NEXT_BLK
    bf16* MIX = (bf16*)(ws + WS_MIX) + row * 1536 + head * 64;
#pragma unroll
    for (int dt = 0; dt < 4; ++dt) { v2u w; w.x = pk2(Of[dt][0], Of[dt][1]); w.y = pk2(Of[dt][2], Of[dt][3]); *(v2u*)(MIX + 16 * dt + 4 * quad) = w; }
    __syncthreads();
}

#define CB() asm volatile("" ::: "memory")
DI void stage_wave_f32(LAS unsigned char* Kt, LAS unsigned char* Vt, const float* kb, const float* vb, size_t stride, int lane) {
    const int k0 = lane >> 3, ch = lane & 7;
#pragma unroll
    for (int h = 0; h < 4; ++h) {
        const float* src = (h < 2 ? kb : vb); LAS unsigned char* dst = (h < 2 ? Kt : Vt); const int r0 = (h & 1) * 32;
        f32x4 a[4][2];
#pragma unroll
        for (int it = 0; it < 4; ++it) { const float* kp = src + (size_t)(r0 + it * 8 + k0) * stride + ch * 8; a[it][0] = *(const f32x4*)kp; a[it][1] = *(const f32x4*)(kp + 4); }
#pragma unroll
        for (int it = 0; it < 4; ++it) *(LAS v4u*)(dst + (r0 + it * 8 + k0) * 144 + ch * 16) = pack8(a[it][0], a[it][1]);
        asm volatile("" ::: "memory");
    }
}
DI void stage_wave_b16(LAS unsigned char* Kt, LAS unsigned char* Vt, const bf16* kb, const bf16* vb, size_t stride, int nvalid, int lane, bool do_v) {
    const int k0 = lane >> 3, ch = lane & 7;
    const v4u z = (v4u){0u, 0u, 0u, 0u};
#pragma unroll
    for (int it = 0; it < 8; ++it) {
        const int key = it * 8 + k0; const bool v = key < nvalid;
        *(LAS v4u*)(Kt + key * 144 + ch * 16) = v ? *(const v4u*)(kb + key * stride + ch * 8) : z;
        if (do_v) *(LAS v4u*)(Vt + key * 144 + ch * 16) = v ? *(const v4u*)(vb + key * stride + ch * 8) : z;
    }
}
DI void nsa_sample_unit(Frame& F, int layer, int s) {
    int lane = F.lane, wave = F.wave; asm volatile("" : "+v"(lane), "+s"(wave));
    const int quad = lane >> 4, rl = lane & 15;
    const int g = wave & 1, q4 = wave >> 1;
    unsigned char* ws = KWS();
    const bf16* Z = (const bf16*)(ws + WS_Z);
    const float* ZS = (const float*)(ws + WS_ZS);
    LAS unsigned char* Kt = F.lds + wave * 18432; LAS unsigned char* Vt = Kt + 9216;
    LAS float* AIMP = (LAS float*)Vt;
    const int j = rl >> 2, head = 4 * g + (rl & 3), qpos = 2048 + j;
    const size_t row = (size_t)MP + 4 * s + j;
    bf16x8 qf[2];
    qf[0] = ld_frag_g(Z + row * LDZ + ZC_Q + head * 64 + quad * 8); qf[1] = ld_frag_g(Z + row * LDZ + ZC_Q + head * 64 + 32 + quad * 8);
    const float gc = sigmoidf_(ZS[row * 32 + head * 3]), gs = sigmoidf_(ZS[row * 32 + head * 3 + 1]), gw = sigmoidf_(ZS[row * 32 + head * 3 + 2]);
    f32x4 Of[4];
#pragma unroll
    for (int i = 0; i < 4; ++i) Of[i] = (f32x4){0.f, 0.f, 0.f, 0.f};
    AttnState st;
    const bf16* KC = (const bf16*)(ws + WS_KCS) + ((size_t)(0 * 128 + s) * 128 * 2 + g) * 64;
    const bf16* VC = (const bf16*)(ws + WS_KCS) + ((size_t)(1 * 128 + s) * 128 * 2 + g) * 64;
    attn_reset(st);
#pragma unroll 1
    for (int jt = 0; jt < 2; ++jt) {
        stage_wave_b16(Kt, Vt, KC + (size_t)64 * jt * 128, VC + (size_t)64 * jt * 128, 128, 64, lane, true); CB();
        attn_step3(Kt, Vt, qf, st, 0, 126 - 64 * jt, true, rl, quad); CB();
    }
    attn_accum3(Of, st, q4 == 0 ? gc : 0.f, lane);
    {
        const float mfin = st.m * SM_C, lt = attn_rowsum(st, lane), il = lt > 0.f ? 1.f / lt : 0.f;
#pragma unroll 1
        for (int jt = 0; jt < 2; ++jt) {
            stage_wave_b16(Kt, Vt, KC + (size_t)64 * jt * 128, VC, 128, 64, lane, false); CB();
            f32x4 sv[4]; qk_tile(Kt, qf, sv, rl, quad); CB();
#pragma unroll
            for (int kt = 0; kt < 4; ++kt)
#pragma unroll
                for (int i = 0; i < 4; ++i) {
                    const int n = 64 * jt + 16 * kt + 4 * quad + i;
                    float p = (n <= 126) ? __builtin_amdgcn_exp2f(sv[kt][i] * SM_C - mfin) * il : 0.f;
                    p += shx<1>(p, lane); p += shx<2>(p, lane);
                    if ((rl & 3) == 0) AIMP[j * 128 + n] = p;
                }
        }
    }
    CB();
    unsigned long long msk[4];
    {
        unsigned keys[4];
#pragma unroll
        for (int q = 0; q < 4; ++q) {
            float imp = 0.f;
#pragma unroll
            for (int d = -1; d <= 3; ++d) { const int n = 4 * lane + d; if (n >= 0 && n <= 126 && lane < 33) imp += AIMP[q * 128 + n]; }
            const bool forced = (lane == 0) || (lane == 32) || (lane == 31);
            keys[q] = score_key(imp + (forced ? 1000.f : 0.f), lane < 33, lane);
        }
        CB();
        LAS unsigned* KS = (LAS unsigned*)Kt;
#pragma unroll
        for (int q = 0; q < 4; ++q) KS[q * 64 + lane] = keys[q];
        CB();
#pragma unroll
        for (int q = 0; q < 4; ++q) msk[q] = __ballot(lane < 33 && key_rank(KS + q * 64, 9, keys[q]) < 16);
    }
    CB();
    const unsigned long long un = msk[0] | msk[1] | msk[2] | msk[3];
    const unsigned long long mym = j == 0 ? msk[0] : j == 1 ? msk[1] : j == 2 ? msk[2] : msk[3];
    const int* pt = (const int*)KIN(7);
    AttnState sw;
    attn_reset(st); attn_reset(sw);
    {
        unsigned long long word = un; int idx = 0;
        while (word) {
            const int blk = __builtin_ctzll(word); word &= word - 1ull;
            if ((idx++ & 3) != q4) continue;
            if (blk < 32) {
                const int phys = pt[s * 16 + (blk >> 1)];
                const float* base = KIN(2) + ((size_t)(layer * 2560 + phys) * 128 + (blk & 1) * 64) * 512 + g * 64;
                stage_wave_f32(Kt, Vt, base + 256, base + 384, 512, lane); CB();
            } else {
                stage_wave_b16(Kt, Vt, Z + (size_t)(MP + 4 * s) * LDZ + ZC_KS + g * 64, Z + (size_t)(MP + 4 * s) * LDZ + ZC_VS + g * 64, LDZ, 4, lane, true); CB();
            }
            attn_step3(Kt, Vt, qf, st, 0, qpos - 64 * blk, (mym >> blk) & 1ull, rl, quad); CB();
        }
#pragma unroll 1
        for (int jt = 0; jt < 9; ++jt) {
            if ((idx++ & 3) != q4) continue;
            if (jt < 8) { const float* base = KIN(3) + ((size_t)(layer * 128 + s) * 512 + 64 * jt) * 256 + g * 64; stage_wave_f32(Kt, Vt, base, base + 128, 256, lane); CB(); }
            else { stage_wave_b16(Kt, Vt, Z + (size_t)(MP + 4 * s) * LDZ + ZC_KW + g * 64, Z + (size_t)(MP + 4 * s) * LDZ + ZC_VW + g * 64, LDZ, 4, lane, true); CB(); }
            attn_step3(Kt, Vt, qf, sw, j + 1 - 64 * jt, 512 + j - 64 * jt, true, rl, quad); CB();
        }
    }
    int lane2 = lane; asm volatile("" : "+v"(lane2));
    LAS float* X = (LAS float*)(F.lds + wave * 18432);
    {
        const float ls = attn_rowsum(st, lane), lw = attn_rowsum(sw, lane);
        X[0 * 64 + lane2] = st.m; X[1 * 64 + lane2] = ls; X[18 * 64 + lane2] = sw.m; X[19 * 64 + lane2] = lw;
#pragma unroll
        for (int dt = 0; dt < 4; ++dt)
#pragma unroll
            for (int e = 0; e < 4; ++e) { X[(2 + 4 * dt + e) * 64 + lane2] = st.O[dt][e]; X[(20 + 4 * dt + e) * 64 + lane2] = sw.O[dt][e]; }
    }
    __syncthreads();
    if (q4 == 0) {
#pragma unroll
        for (int br = 0; br < 2; ++br) {
            float m[4], l[4];
#pragma unroll
            for (int q = 0; q < 4; ++q) { const LAS float* Y = (const LAS float*)(F.lds + (2 * q + g) * 18432) + br * 18 * 64; m[q] = Y[lane2]; l[q] = Y[64 + lane2]; }
            const float mm = fmaxf(fmaxf(m[0], m[1]), fmaxf(m[2], m[3]));
            float w[4], lt = 0.f;
#pragma unroll
            for (int q = 0; q < 4; ++q) { w[q] = __builtin_amdgcn_exp2f((m[q] - mm) * SM_C); lt += l[q] * w[q]; }
            const float gate = br == 0 ? gs : gw;
            const float sc = lt > 0.f ? gate / lt : 0.f;
#pragma unroll
            for (int q = 0; q < 4; ++q) { const LAS float* Y = (const LAS float*)(F.lds + (2 * q + g) * 18432) + br * 18 * 64; const float wq = w[q] * sc;
#pragma unroll
                for (int dt = 0; dt < 4; ++dt)
#pragma unroll
                    for (int e = 0; e < 4; ++e) Of[dt][e] += Y[(2 + 4 * dt + e) * 64 + lane2] * wq; }
        }
        bf16* MIX = (bf16*)(ws + WS_MIX) + row * 1536 + head * 64;
#pragma unroll
        for (int dt = 0; dt < 4; ++dt) { v2u w2; w2.x = pk2(Of[dt][0], Of[dt][1]); w2.y = pk2(Of[dt][2], Of[dt][3]); *(v2u*)(MIX + 16 * dt + 4 * quad) = w2; }
    }
    __syncthreads();
}
DI void ret_out_unit(Frame& F, int layer, int unit) {
    const int tid = F.tid, lane = F.lane, wave = F.wave, quad = lane >> 4, rl = lane & 15;
    const int b = unit >> 8, h = (unit >> 6) & 3, c = unit & 63;
    const int row0 = b * TP + 128 * c;
    unsigned char* ws = KWS();
    const bf16* Z = (const bf16*)(ws + WS_Z);
    const bf16* QR = (const bf16*)(ws + WS_QR); const bf16* KR = (const bf16*)(ws + WS_KR);
    const bf16* RST = (const bf16*)(ws + WS_RST) + (size_t)unit * 16384;
    LAS unsigned char* LQ = F.lds; LAS unsigned char* LK = F.lds + 34816; LAS unsigned char* LV = F.lds + 69632; LAS unsigned char* LS = F.lds + 104448;
    for (int it = tid; it < 2048; it += NTHREADS) {
        const int j = it >> 4, cc = it & 15;
        *(LAS v4u*)(LQ + j * 272 + cc * 16) = *(const v4u*)(QR + (size_t)(row0 + j) * 512 + h * 128 + cc * 8);
        *(LAS v4u*)(LK + j * 272 + cc * 16) = *(const v4u*)(KR + (size_t)(row0 + j) * 512 + h * 128 + cc * 8);
        *(LAS v4u*)(LS + j * 272 + cc * 16) = *(const v4u*)(RST + (size_t)j * 128 + cc * 8);
        const v4u w = *(const v4u*)(Z + (size_t)(row0 + j) * LDZ + ZC_RQKV + 1024 + h * 128 + cc * 8);
        LAS unsigned char* d = LV + (cc * 8) * 272 + j * 2;
        *(LAS bf16*)(d) = (bf16)(w.x & 0xffff); *(LAS bf16*)(d + 272) = (bf16)(w.x >> 16); *(LAS bf16*)(d + 2 * 272) = (bf16)(w.y & 0xffff); *(LAS bf16*)(d + 3 * 272) = (bf16)(w.y >> 16);
        *(LAS bf16*)(d + 4 * 272) = (bf16)(w.z & 0xffff); *(LAS bf16*)(d + 5 * 272) = (bf16)(w.z >> 16); *(LAS bf16*)(d + 6 * 272) = (bf16)(w.w & 0xffff); *(LAS bf16*)(d + 7 * 272) = (bf16)(w.w >> 16);
    }
    __syncthreads();
    const float lg = ret_lg(h);
    const int il = 16 * wave + rl;
    bf16x8 qb[4];
#pragma unroll
    for (int s = 0; s < 4; ++s) qb[s] = ld_frag_l(LQ + il * 272 + (32 * s + 8 * quad) * 2);
    f32x4 C[8];
    const float qdec = __expf((float)(il + 1) * lg);
#pragma unroll
    for (int dt = 0; dt < 8; ++dt) {
        f32x4 a = (f32x4){0.f, 0.f, 0.f, 0.f};
#pragma unroll
        for (int s = 0; s < 4; ++s) a = mfma16(ld_frag_l(LS + (16 * dt + rl) * 272 + (32 * s + 8 * quad) * 2), qb[s], a);
        C[dt] = a * qdec;
    }
    for (int s2 = 0; s2 <= (wave >> 1); ++s2) {
        f32x4 P[2];
#pragma unroll
        for (int e = 0; e < 2; ++e) {
            const int jt = 2 * s2 + e;
            f32x4 a = (f32x4){0.f, 0.f, 0.f, 0.f};
            if (jt <= wave) {
#pragma unroll
                for (int s = 0; s < 4; ++s) a = mfma16(ld_frag_l(LK + (16 * jt + rl) * 272 + (32 * s + 8 * quad) * 2), qb[s], a);
#pragma unroll
                for (int i = 0; i < 4; ++i) { const int jj = 16 * jt + 4 * quad + i; a[i] = (il >= jj) ? a[i] * __expf((float)(il - jj) * lg) : 0.f; }
            }
            P[e] = a;
        }
        const bf16x8 pb = pack_frag(P[0], P[1]);
#pragma unroll
        for (int dt = 0; dt < 8; ++dt) {
            const LAS unsigned char* vp = LV + (16 * dt + rl) * 272 + (32 * s2 + 4 * quad) * 2;
            C[dt] = mfma16(mk_frag(*(const LAS v2u*)vp, *(const LAS v2u*)(vp + 32)), pb, C[dt]);
        }
    }
    float ss = 0.f;
#pragma unroll
    for (int dt = 0; dt < 8; ++dt) ss += (C[dt][0] * C[dt][0] + C[dt][1] * C[dt][1]) + (C[dt][2] * C[dt][2] + C[dt][3] * C[dt][3]);
    ss += shx<16>(ss, lane); ss += shx<32>(ss, lane);
    const float scl = rsqrtf(ss * (1.f / 128.f) + EPS);
    const size_t row = (size_t)row0 + il;
#pragma unroll
    for (int dt = 0; dt < 8; ++dt) {
        const v2u gwd = *(const v2u*)(Z + row * LDZ + ZC_RG + h * 128 + 16 * dt + 4 * quad);
        v2u w; w.x = pk2(C[dt][0] * scl * siluf_(lo_bf(gwd.x)), C[dt][1] * scl * siluf_(hi_bf(gwd.x))); w.y = pk2(C[dt][2] * scl * siluf_(lo_bf(gwd.y)), C[dt][3] * scl * siluf_(hi_bf(gwd.y)));
        *(v2u*)((bf16*)(ws + WS_MIX) + row * 1536 + 1024 + h * 128 + 16 * dt + 4 * quad) = w;
    }
    __syncthreads();
}
DI void gdn_out_row(Frame& F, int layer, int row) {
    const int lane = F.lane;
    unsigned char* ws = KWS();
    const float* o = (const float*)(ws + WS_OGDN) + (size_t)row * 512 + lane * 8;
    const f32x4 a = *(const f32x4*)o, b = *(const f32x4*)(o + 4);
    float ss = (a[0] * a[0] + a[1] * a[1]) + (a[2] * a[2] + a[3] * a[3]) + (b[0] * b[0] + b[1] * b[1]) + (b[2] * b[2] + b[3] * b[3]);
    ss += shx<1>(ss, lane); ss += shx<2>(ss, lane); ss += shx<4>(ss, lane); ss += shx<8>(ss, lane);
    const float scl = rsqrtf(ss * (1.f / 128.f) + EPS);
    const float* ng = KIN(18) + layer * 128 + (lane & 15) * 8;
    const f32x4 ga = *(const f32x4*)ng, gb = *(const f32x4*)(ng + 4);
    f32x4 za, zb; unpack8(*(const v4u*)((const bf16*)(ws + WS_Z) + (size_t)row * LDZ + ZC_GZ + lane * 8), za, zb);
    f32x4 ra, rb;
#pragma unroll
    for (int e = 0; e < 4; ++e) { ra[e] = a[e] * scl * ga[e] * siluf_(za[e]); rb[e] = b[e] * scl * gb[e] * siluf_(zb[e]); }
    *(v4u*)((bf16*)(ws + WS_MIX) + (size_t)row * 1536 + 512 + lane * 8) = pack8(ra, rb);
}
DI void final_row(Frame& F, int row) {
    const int lane = F.lane;
    const float* x = (const float*)(KWS() + WS_XR) + (size_t)row * DM;
    float* y = (row < MP) ? KOUT() + O_YP + (size_t)row * DM : KOUT() + O_YS + (size_t)(row - MP) * DM;
    f32x4 v[4]; float ss = 0.f;
#pragma unroll
    for (int j = 0; j < 4; ++j) { v[j] = *(const f32x4*)(x + 256 * j + lane * 4); ss += (v[j][0] * v[j][0] + v[j][1] * v[j][1]) + (v[j][2] * v[j][2] + v[j][3] * v[j][3]); }
    const float scl = rsqrtf(wave_sum(ss, lane) * (1.f / DM) + EPS);
#pragma unroll
    for (int j = 0; j < 4; ++j) *(f32x4*)(y + 256 * j + lane * 4) = v[j] * scl * *(const f32x4*)(KIN(26) + 256 * j + lane * 4);
}
#ifndef PH_P0
#define PH_P0 1
#endif
#ifndef PH_A
#define PH_A 1
#endif
#ifndef PH_B0a
#define PH_B0a 1
#endif
#ifndef PH_B0b
#define PH_B0b 1
#endif
#ifndef PH_B0c
#define PH_B0c 1
#endif
#ifndef PH_B0d
#define PH_B0d 1
#endif
#ifndef PH_SCAN
#define PH_SCAN 1
#endif
#ifndef PH_RSCAN
#define PH_RSCAN 1
#endif
#ifndef PH_NSAP
#define PH_NSAP 1
#endif
#ifndef PH_NSAS
#define PH_NSAS 1
#endif
#ifndef PH_B2
#define PH_B2 1
#endif
#ifndef PH_C
#define PH_C 1
#endif
#ifndef PH_XBAR
#define PH_XBAR 0
#endif
#ifndef PH_D
#define PH_D 1
#endif
#ifndef PH_E
#define PH_E 1
#endif
#ifndef PH_F
#define PH_F 1
#endif
#ifndef PH_G1
#define PH_G1 1
#endif
#ifndef PH_G2
#define PH_G2 1
#endif
struct Args { const void* in[27]; float* out; unsigned char* ws; };
__global__ void __launch_bounds__(NTHREADS, 2) mk_fwd(Args args) {
    extern __shared__ __attribute__((aligned(16))) unsigned char lds_raw[];
    Frame F;
    F.lds = (LAS unsigned char*)lds_raw;
    F.wave = __builtin_amdgcn_readfirstlane((int)threadIdx.x >> 6); F.lane = 0; F.tid = 0;
    F.G = gridDim.x; F.bid = blockIdx.x;
    F.ctl = (gu32*)(KWS() + WS_CTL);
    { const Frame Fp = fresh(F); for (int u = Fp.tid; u < (LDS_BYTES - LDSCTL_OFF) / 4; u += NTHREADS) ((LAS unsigned*)(F.lds + LDSCTL_OFF))[u] = 0u;
      __syncthreads();
      (void)xcd_barrier_post((unsigned*)(F.ctl + CW_BAR), (volatile LAS unsigned*)(F.lds + MISC_OFF) + 8, Fp.tid == 0); }
    const int G = F.G, bid = F.bid;

        for (int rp_ = 0; rp_ < PH_P0; ++rp_) {
    { Frame Fp = fresh(F); p0_prologue(Fp); }
        }
    GRID_BAR();

    for (int layer = 0; layer < NLAYER; ++layer) {
        for (int rp_ = 0; rp_ < PH_A; ++rp_) {
        {
            const Frame Fg = fresh(F); const int G = Fg.G, bid = Fg.bid;
            unsigned char* ws = KWS();
            pg8::Gemm g{(const bf16*)(ws + WS_XGA), (const bf16*)(ws + WS_WIN + layer * SZ_WIN), MROWS, LDZ, DM, DM, DM, 31, 0};
            pg8::StaticOrder S; S.init(MROWS, LDZ, G, bid);
            epi::EpiA E{(bf16*)(ws + WS_Z), (float*)(ws + WS_ZS), (const float*)(ws + WS_SSA), KOUT(), layer};
            pg8::gemm_phase<epi::EpiA, pg8::StaticOrder, true, true>(Fg.lds, g, S, E, Fg.tid);
        }
        }
        GRID_BAR();
        for (int rp_ = 0; rp_ < PH_B0a; ++rp_) {
        { Frame Fp = fresh(F); for (int u = Fp.bid; u < 1024; u += Fp.G) gdn_prep_unit(Fp, layer, u); }
        }
        for (int rp_ = 0; rp_ < PH_B0b; ++rp_) {
        { Frame Fp = fresh(F); for (int u = Fp.bid; u < 512; u += Fp.G) ret_prep_unit(Fp, layer, u); }
        }
        for (int rp_ = 0; rp_ < PH_B0c; ++rp_) {
        { Frame Fp = fresh(F); for (int u = Fp.bid; u < 1024; u += Fp.G) sample_rec_unit(Fp, layer, u); }
        }
        for (int rp_ = 0; rp_ < PH_B0d; ++rp_) {
        { Frame Fp = fresh(F); for (int t = Fp.bid; t < 256 + 16; t += Fp.G) compress_job(Fp, layer, t); }
        }
        GRID_BAR();
        {
            Frame Fp = fresh(F);
            gu32* qbase = F.ctl + CW_QUEUE + 512 * layer;
            volatile LAS int* qslot = (volatile LAS int*)(F.lds + MISC_OFF) + 16;
            constexpr int NQ = 8 * PH_SCAN, NS = 128 * PH_NSAS, NR = 32 * PH_RSCAN, NP = 256 * PH_NSAP;
            const int pref = (int)(xb_xcc_id() & 3u);
            for (;;) {
                if (Fp.tid == 0) {
                    int kind = -1, idx = 0;
                    const int a = (int)__hip_atomic_fetch_add(qbase, 1u, __ATOMIC_RELAXED, __HIP_MEMORY_SCOPE_AGENT);
                    if (a < NQ + NS + NR) { kind = 4; idx = a; }
                    else {
                        for (int k = 0; k < 4 && kind < 0; ++k) { const int s = (pref + k) & 3;
                            if ((int)__hip_atomic_load(qbase + 64 * (1 + s), __ATOMIC_RELAXED, __HIP_MEMORY_SCOPE_AGENT) < NP) {
                                const int r = (int)__hip_atomic_fetch_add(qbase + 64 * (1 + s), 1u, __ATOMIC_RELAXED, __HIP_MEMORY_SCOPE_AGENT);
                                if (r < NP) { kind = s; idx = r; } } }
                    }
                    qslot[0] = kind; qslot[1] = idx;
                }
                __syncthreads();
                int kind = qslot[0], it = qslot[1];
                __syncthreads();
                kind = __builtin_amdgcn_readfirstlane(kind); it = __builtin_amdgcn_readfirstlane(it);
                if (kind < 0) break;
                if (kind < 4) nsa_prompt_unit(Fp, layer, (kind << 8) | (255 - (it & 255)));
                else if (it < NQ) gdn_scan_chain(Fp, layer, it & 7);
                else if (it < NQ + NS) nsa_sample_unit(Fp, layer, (it - NQ) & 127);
                else ret_scan_part(Fp, layer, (it - NQ - NS) & 31);
            }
        }
        GRID_BAR();
        for (int rp_ = 0; rp_ < PH_B2; ++rp_) {
        { Frame Fp = fresh(F); for (int u = Fp.bid; u < 512; u += Fp.G) ret_out_unit(Fp, layer, u); }
        { Frame Fp = fresh(F); for (int r = Fp.bid * NWAVES + Fp.wave; r < MROWS; r += Fp.G * NWAVES) gdn_out_row(Fp, layer, r); }
        }
        GRID_BAR();
        for (int rp_ = 0; rp_ < PH_C; ++rp_) {
        {
            const Frame Fg = fresh(F); const int G = Fg.G, bid = Fg.bid;
            unsigned char* ws = KWS();
            pg8::Gemm g{(const bf16*)(ws + WS_MIX), (const bf16*)(ws + WS_WBR + layer * SZ_WBR), MROWS, 3072, 512, 1536, 512, 2, 1024};
            pg8::StaticOrder S; S.init(MROWS, 3072, G, bid);
            epi::EpiC E{(const bf16*)(ws + WS_Z), (bf16*)(ws + WS_GATED)};
            pg8::gemm_phase<epi::EpiC, pg8::StaticOrder, true, true>(Fg.lds, g, S, E, Fg.tid);
        }
        }
        GRID_BAR();
        for (int rp_ = 0; rp_ < PH_D; ++rp_) {
        {
            const Frame Fg = fresh(F); const int G = Fg.G, bid = Fg.bid;
            unsigned char* ws = KWS();
            pg8::Gemm g{(const bf16*)(ws + WS_GATED), (const bf16*)(ws + WS_WO3 + layer * SZ_WO3), MROWS, DM, 3072, 3072, 3072, 31, 0};
            pg8::StaticOrder S; S.init(MROWS, DM, G, bid);
            epi::EpiRes E{(float*)(ws + WS_XR), (bf16*)(ws + WS_XGB), KIN(21) + layer * DM, (float*)(ws + WS_SSB), nullptr, (rp_ + 1 < PH_D) ? 3 : 0};
            pg8::gemm_phase<epi::EpiRes, pg8::StaticOrder, true, true>(Fg.lds, g, S, E, Fg.tid);
        }
        }
        GRID_BAR();
        for (int rp_ = 0; rp_ < PH_E; ++rp_) {
        {
            const Frame Fg = fresh(F); const int G = Fg.G, bid = Fg.bid;
            unsigned char* ws = KWS();
            pg8::Gemm g{(const bf16*)(ws + WS_XGB), (const bf16*)(ws + WS_WUP + layer * SZ_WUP), MROWS, DFF, DM, DM, DM, 31, 0};
            pg8::StaticOrder S; S.init(MROWS, DFF, G, bid);
            epi::EpiUp E{(bf16*)(ws + WS_HMID), (const float*)(ws + WS_SSB)};
            pg8::gemm_phase<epi::EpiUp, pg8::StaticOrder, true, true>(Fg.lds, g, S, E, Fg.tid);
        }
        }
        GRID_BAR();
        for (int rp_ = 0; rp_ < PH_F; ++rp_) {
        {
            const Frame Fg = fresh(F); const int G = Fg.G, bid = Fg.bid;
            unsigned char* ws = KWS();
            pg8::Gemm g{(const bf16*)(ws + WS_HMID), (const bf16*)(ws + WS_WDN + layer * SZ_WDN), MROWS, DM, DFF, DFF, DFF, 31, 0};
            pg8::StaticOrder S; S.init(MROWS, DM, G, bid);
            epi::EpiRes E{(float*)(ws + WS_XR), (bf16*)(ws + WS_XGC), nullptr, nullptr, nullptr, (rp_ + 1 < PH_F) ? 3 : 0};
            pg8::gemm_phase<epi::EpiRes, pg8::StaticOrder, true, true>(Fg.lds, g, S, E, Fg.tid);
        }
        }
        GRID_BAR();
        for (int rp_ = 0; rp_ < PH_G1; ++rp_) {
        {
            const Frame Fg = fresh(F); const int G = Fg.G, bid = Fg.bid;
            unsigned char* ws = KWS();
            int kple = PLE; asm volatile("" : "+s"(kple));
            pg8::Gemm g{(const bf16*)(ws + WS_P16) + (size_t)layer * MROWS * PLE, (const bf16*)(ws + WS_WPL + layer * SZ_WPL), MROWS, DM, kple, PLE, PLE, 31, 0};
            pg8::StaticOrder S; S.init(MROWS, DM, G, bid);
            epi::EpiRes E{nullptr, nullptr, nullptr, nullptr, (float*)(ws + WS_TPLE), 1};
            pg8::gemm_phase<epi::EpiRes, pg8::StaticOrder, true, true>(Fg.lds, g, S, E, Fg.tid);
        }
        }
        for (int rp_ = 0; rp_ < PH_G2; ++rp_) {
        {
            const Frame Fg = fresh(F); const int G = Fg.G, bid = Fg.bid;
            unsigned char* ws = KWS();
            const bool more = layer + 1 < NLAYER;
            pg8::Gemm g{(const bf16*)(ws + WS_XGC), (const bf16*)(ws + WS_WPG + layer * SZ_WPG), MROWS, DM, DM, DM, DM, 31, 0};
            pg8::StaticOrder S; S.init(MROWS, DM, G, bid);
            epi::EpiRes E{(float*)(ws + WS_XR), more ? (bf16*)(ws + WS_XGA) : nullptr, more ? KIN(10) + (layer + 1) * DM : nullptr, more ? (float*)(ws + WS_SSA) : nullptr, (float*)(ws + WS_TPLE), (rp_ + 1 < PH_G2) ? 3 : 2};
            pg8::gemm_phase<epi::EpiRes, pg8::StaticOrder, true, true>(Fg.lds, g, S, E, Fg.tid);
        }
        }
        GRID_BAR();
    }
    for (int xb_ = 0; xb_ < PH_XBAR; ++xb_) GRID_BAR();
    { Frame Fp = fresh(F); for (int r = Fp.bid * NWAVES + Fp.wave; r < MROWS; r += Fp.G * NWAVES) final_row(Fp, r); }
}

extern "C" void kernel_launch(void* const* d_in, const int* in_sizes, int n_in, void* d_out, int out_size, void* d_ws, size_t ws_size, hipStream_t stream) {
    static int grid = 0;
    if (grid == 0) {
        if (n_in != 27 || ws_size < WS_END) { fprintf(stderr, "kernel_launch: unexpected shapes (n_in %d out %d ws %zu, need %zu)\n", n_in, out_size, ws_size, (size_t)WS_END); grid = -1; return; }
        int dev = 0, cus = 0;
        if (hipGetDevice(&dev) != hipSuccess || hipDeviceGetAttribute(&cus, hipDeviceAttributeMultiprocessorCount, dev) != hipSuccess) { grid = -1; return; }
        if (hipFuncSetAttribute((const void*)mk_fwd, hipFuncAttributeMaxDynamicSharedMemorySize, LDS_BYTES) != hipSuccess) { fprintf(stderr, "kernel_launch: hipFuncSetAttribute failed\n"); grid = -1; return; }
        int per_cu = 0;
        if (hipOccupancyMaxActiveBlocksPerMultiprocessor(&per_cu, (const void*)mk_fwd, NTHREADS, LDS_BYTES) != hipSuccess || per_cu < 1) fprintf(stderr, "kernel_launch: occupancy query reports %d\n", per_cu);
        (void)hipGetLastError();
        grid = cus;
    }
    if (grid < 0) return;
    if (hipMemsetAsync((char*)d_ws + WS_CTL, 0, CTL_ZERO_BYTES, stream) != hipSuccess) return;
    Args a{};
    for (int i = 0; i < 27; ++i) a.in[i] = d_in[i];
    a.out = (float*)d_out; a.ws = (unsigned char*)d_ws;
    hipLaunchKernelGGL(mk_fwd, dim3(grid), dim3(NTHREADS), LDS_BYTES, stream, a);
}
```

```cpp
#include <hip/hip_runtime.h>
#include <cstdio>
#include <cstdint>
namespace pg8 {
#define PG8_LAS __attribute__((address_space(3)))
typedef unsigned short bf16_t;
typedef short bf16x8 __attribute__((ext_vector_type(8)));
typedef float f32x4 __attribute__((ext_vector_type(4)));
typedef unsigned u32x4 __attribute__((ext_vector_type(4)));
constexpr int BM = 256, BK = 64, HALF = 128, HTB = HALF * BK * 2  , STAGE_BYTES = 8 * HTB, NXCD = 8, WGM = 8;

__host__ __device__ __forceinline__ int lds_byte(int r, int c) { const int st = (r >> 4) * 2 + (c >> 5), rr = r & 15, cc = c & 31, ob = rr * 64 + cc * 2; return st * 1024 + (ob ^ (((ob >> 9) & 1) << 5)); }
__host__ __device__ __forceinline__ void stage_rc(int b, int& R, int& C) { const int st = b / 1024, sb = b % 1024, swz = sb ^ (((sb >> 9) & 1) << 5); R = (st >> 1) * 16 + swz / 64; C = (st & 1) * 32 + (swz % 64) / 2; }
__host__ __device__ __forceinline__ int perm32(int rho) { const int n = rho >> 4, i = rho & 15; return 8 * (i >> 2) + 4 * n + (i & 3); }

struct Unit { int pm, pn; };
struct Gemm { const bf16_t* A; const bf16_t* Bt; int M, N, K; int lda, ldb; int a_shift, a_off; };

struct StaticOrder {
    int nM, nN, nwg, G, c;
    __host__ __device__ void init(int M, int N, int G_, int c_) { nM = M / BM; nN = N / BM; nwg = nM * nN; G = G_; c = c_; }
    __host__ __device__ bool next(int i, Unit& u) const {
        const long L = (long)i * G + c; if (L >= nwg) return false;
        int wgid = (int)L; { const int q = nwg / NXCD, r = nwg % NXCD, xcd = wgid % NXCD, off = wgid / NXCD; wgid = (xcd < r ? xcd * (q + 1) : r * (q + 1) + (xcd - r) * q) + off; }
        const int nig = WGM * nN, gid = wgid / nig, fm = gid * WGM, gsz = (nM - fm) < WGM ? (nM - fm) : WGM;
        u.pm = fm + ((wgid % nig) % gsz); u.pn = (wgid % nig) / gsz; return true;
    }
    __device__ __forceinline__ void a_ready(const Unit&) const {}
    __device__ __forceinline__ void done(const Unit&) const {}
};

__device__ __forceinline__ unsigned cvt_pk_bf16(float lo, float hi) { unsigned r; asm volatile("v_cvt_pk_bf16_f32 %0, %1, %2" : "=v"(r) : "v"(lo), "v"(hi)); return r; }
typedef float f32x2 __attribute__((ext_vector_type(2)));
template <class Epi, class Sched, bool ALIGN_EPI = false, bool SP2 = false>
__device__ __forceinline__ void gemm_phase(PG8_LAS unsigned char* lds, const Gemm g, const Sched& S, const Epi& E, const int tid) {
    const int wid = __builtin_amdgcn_readfirstlane(tid >> 6), lane = tid & 63, wr = wid >> 2, wc = wid & 3, fr = lane & 15, fq = lane >> 4;
    const int K = g.K, nt = K / BK;
    unsigned voffA[2], voffB[2];
#pragma unroll
    for (int i = 0; i < 2; ++i) { int R, C; stage_rc(tid * 16 + i * 8192, R, C); const int Rb = Epi::PERM ? ((R & ~31) + perm32(R & 31)) : R;
        voffA[i] = (unsigned)(R * g.lda + C) * 2u; voffB[i] = (unsigned)(Rb * g.ldb + C) * 2u; }
    const size_t kstep = (size_t)(BK * 2);
    const size_t hstepA = (size_t)HALF * g.lda * 2, hstepB = (size_t)HALF * g.ldb * 2;
    const size_t tstepA = 2 * hstepA, tstepB = 2 * hstepB;
    const unsigned ldsw = (unsigned)wid * 1024u;
    const int aoff = lds_byte(wr * 64 + fr, fq * 8), boff = lds_byte(wc * 32 + fr, fq * 8);
#define PG8_SA(b, h) (((b) * 2 + (h)) * HTB)
#define PG8_SB(b, h) ((4 + (b) * 2 + (h)) * HTB)
#define PG8_STAGE(bufoff, gbase, voff) do { _Pragma("unroll") for (int _i = 0; _i < 2; ++_i) \
        __builtin_amdgcn_global_load_lds((const unsigned*)((const char*)(gbase) + (voff)[_i]), (PG8_LAS unsigned*)(lds + (bufoff) + ldsw + _i * 8192), 16, 0, 0); } while (0)
#define PG8_LDA(dst, b, h) do { _Pragma("unroll") for (int m = 0; m < 4; ++m) _Pragma("unroll") for (int k = 0; k < 2; ++k) dst[m][k] = *(const PG8_LAS bf16x8*)(lds + PG8_SA(b, h) + aoff + m * 2048 + k * 1024); } while (0)
#define PG8_LDB(dst, b, h) do { _Pragma("unroll") for (int n = 0; n < 2; ++n) _Pragma("unroll") for (int k = 0; k < 2; ++k) dst[n][k] = *(const PG8_LAS bf16x8*)(lds + PG8_SB(b, h) + boff + n * 2048 + k * 1024); } while (0)
#define PG8_MMA(ai, bj, At, Bt) do { __builtin_amdgcn_s_setprio(1); _Pragma("unroll") for (int m = 0; m < 4; ++m) _Pragma("unroll") for (int n = 0; n < 2; ++n) _Pragma("unroll") for (int k = 0; k < 2; ++k) \
        acc[ai][bj][m][n] = __builtin_amdgcn_mfma_f32_16x16x32_bf16(Bt[n][k], At[m][k], acc[ai][bj][m][n], 0, 0, 0); __builtin_amdgcn_s_setprio(0); } while (0)
#define PG8_WAIT_V(n) asm volatile("s_waitcnt vmcnt(" #n ")" ::: "memory")
#define PG8_WAIT_L(n) asm volatile("s_waitcnt lgkmcnt(" #n ")" ::: "memory")
#define PG8_BAR __builtin_amdgcn_s_barrier()
#define PG8_SCHED __builtin_amdgcn_sched_barrier(0)
    Unit cur, nxt; int ui = 0;
    if (!S.next(0, cur)) return;
    f32x4 acc[2][2][4][2];
#pragma unroll
    for (int a = 0; a < 2; ++a)
#pragma unroll
        for (int b = 0; b < 2; ++b)
#pragma unroll
            for (int m = 0; m < 4; ++m)
#pragma unroll
                for (int n = 0; n < 2; ++n) acc[a][b][m][n] = (f32x4){0.f, 0.f, 0.f, 0.f};
    bf16x8 At[4][2], B0[2][2], B1[2][2];
    const char* cA = (const char*)g.A + (size_t)cur.pm * tstepA + (size_t)(cur.pn >> g.a_shift) * (size_t)g.a_off; const char* cB = (const char*)g.Bt + (size_t)cur.pn * tstepB;
    S.a_ready(cur);
    if constexpr (SP2) {
        PG8_STAGE(PG8_SB(0, 0), cB, voffB); PG8_STAGE(PG8_SB(0, 1), cB + hstepB, voffB); PG8_STAGE(PG8_SA(0, 0), cA, voffA); PG8_STAGE(PG8_SA(0, 1), cA + hstepA, voffA);
        if (wr == 1) PG8_BAR;
        PG8_WAIT_V(2); PG8_BAR;
        PG8_STAGE(PG8_SB(1, 0), cB + kstep, voffB); PG8_STAGE(PG8_SA(1, 0), cA + kstep, voffA); PG8_STAGE(PG8_SB(1, 1), cB + hstepB + kstep, voffB);
        PG8_WAIT_V(6); PG8_BAR;
    } else {
        PG8_STAGE(PG8_SB(0, 0), cB, voffB); PG8_STAGE(PG8_SA(0, 0), cA, voffA); PG8_STAGE(PG8_SB(0, 1), cB + hstepB, voffB); PG8_STAGE(PG8_SA(0, 1), cA + hstepA, voffA);
        if (wr == 1) PG8_BAR;
        PG8_WAIT_V(4); PG8_BAR;
        PG8_STAGE(PG8_SB(1, 0), cB + kstep, voffB); PG8_STAGE(PG8_SA(1, 0), cA + kstep, voffA); PG8_STAGE(PG8_SB(1, 1), cB + hstepB + kstep, voffB);
        PG8_WAIT_V(6); PG8_BAR;
    }
    for (;;) {
        const bool has_next = S.next(ui + 1, nxt);
        const char* nA = has_next ? (const char*)g.A + (size_t)nxt.pm * tstepA + (size_t)(nxt.pn >> g.a_shift) * (size_t)g.a_off : cA; const char* nB = has_next ? (const char*)g.Bt + (size_t)nxt.pn * tstepB : cB;
        for (int t = 0; t < nt; t += 2) {
            const bool last = (t == nt - 2);
            const char* a1 = cA + (size_t)(t + 1) * kstep;
            const char* a2 = last ? nA : cA + (size_t)(t + 2) * kstep; const char* b2 = last ? nB : cB + (size_t)(t + 2) * kstep;
            const char* a3 = a2 + kstep; const char* b3 = b2 + kstep;
            if (last && has_next) S.a_ready(nxt);
            if constexpr (SP2) {
            PG8_LDB(B0, 0, 0); PG8_LDB(B1, 0, 1); PG8_SCHED; PG8_LDA(At, 0, 0); PG8_STAGE(PG8_SA(1, 1), a1 + hstepA, voffA);
            PG8_WAIT_V(8); PG8_WAIT_L(0); PG8_BAR; PG8_MMA(0, 0, At, B0); PG8_MMA(0, 1, At, B1); PG8_BAR; PG8_SCHED;
            PG8_LDA(At, 0, 1); PG8_STAGE(PG8_SB(0, 0), b2, voffB); PG8_STAGE(PG8_SB(0, 1), b2 + hstepB, voffB); PG8_STAGE(PG8_SA(0, 0), a2, voffA);
            PG8_WAIT_V(8); PG8_WAIT_L(0); PG8_BAR; PG8_MMA(1, 0, At, B0); PG8_MMA(1, 1, At, B1); PG8_BAR; PG8_SCHED;
            PG8_LDB(B0, 1, 0); PG8_LDB(B1, 1, 1); PG8_SCHED; PG8_LDA(At, 1, 0); PG8_STAGE(PG8_SA(0, 1), a2 + hstepA, voffA);
            PG8_WAIT_V(8); PG8_WAIT_L(0); PG8_BAR; PG8_MMA(0, 0, At, B0); PG8_MMA(0, 1, At, B1); PG8_BAR; PG8_SCHED;
            PG8_LDA(At, 1, 1); PG8_STAGE(PG8_SB(1, 0), b3, voffB); PG8_STAGE(PG8_SB(1, 1), b3 + hstepB, voffB); PG8_STAGE(PG8_SA(1, 0), a3, voffA);
            PG8_WAIT_V(8); PG8_WAIT_L(0); PG8_BAR; PG8_MMA(1, 0, At, B0); PG8_MMA(1, 1, At, B1); PG8_BAR; PG8_SCHED;
            } else {
            PG8_LDB(B0, 0, 0); PG8_SCHED; PG8_LDA(At, 0, 0); PG8_STAGE(PG8_SA(1, 1), a1 + hstepA, voffA);
            PG8_WAIT_L(8); PG8_BAR; PG8_WAIT_L(0); PG8_MMA(0, 0, At, B0); PG8_BAR; PG8_SCHED;
            PG8_LDB(B1, 0, 1); PG8_STAGE(PG8_SB(0, 0), b2, voffB);
            PG8_BAR; PG8_WAIT_L(0); PG8_MMA(0, 1, At, B1); PG8_BAR;
            PG8_LDA(At, 0, 1); PG8_STAGE(PG8_SA(0, 0), a2, voffA);
            PG8_BAR; PG8_WAIT_L(0); PG8_MMA(1, 0, At, B0); PG8_BAR; PG8_SCHED;
            PG8_STAGE(PG8_SB(0, 1), b2 + hstepB, voffB);
            PG8_WAIT_V(6); PG8_BAR; PG8_MMA(1, 1, At, B1); PG8_BAR;
            PG8_LDB(B0, 1, 0); PG8_SCHED; PG8_LDA(At, 1, 0); PG8_STAGE(PG8_SA(0, 1), a2 + hstepA, voffA);
            PG8_WAIT_L(8); PG8_BAR; PG8_WAIT_L(0); PG8_MMA(0, 0, At, B0); PG8_BAR; PG8_SCHED;
            PG8_LDB(B1, 1, 1); PG8_STAGE(PG8_SB(1, 0), b3, voffB);
            PG8_BAR; PG8_WAIT_L(0); PG8_MMA(0, 1, At, B1); PG8_BAR;
            PG8_LDA(At, 1, 1); PG8_STAGE(PG8_SA(1, 0), a3, voffA);
            PG8_BAR; PG8_WAIT_L(0); PG8_MMA(1, 0, At, B0); PG8_BAR; PG8_SCHED;
            PG8_STAGE(PG8_SB(1, 1), b3 + hstepB, voffB);
            PG8_WAIT_V(6); PG8_BAR; PG8_MMA(1, 1, At, B1); PG8_BAR;
            }
        }
        if constexpr (ALIGN_EPI) { if (wr == 0) PG8_BAR; }
        if constexpr (!Epi::AFTER_DRAIN) { E(acc, cur, wr, wc, fr, fq); S.done(cur); }
        if (!has_next) break;
#pragma unroll
        for (int a = 0; a < 2; ++a)
#pragma unroll
            for (int b = 0; b < 2; ++b)
#pragma unroll
                for (int m = 0; m < 4; ++m)
#pragma unroll
                    for (int n = 0; n < 2; ++n) acc[a][b][m][n] = (f32x4){0.f, 0.f, 0.f, 0.f};
        cur = nxt; cA = nA; cB = nB; ++ui;
        if constexpr (ALIGN_EPI) { if (wr == 1) PG8_BAR; }
    }
    PG8_WAIT_V(0);
    if constexpr (!ALIGN_EPI) { if (wr == 0) PG8_BAR; }
    PG8_BAR;
    if constexpr (Epi::AFTER_DRAIN) { E.fused(acc, cur, wr, wc, fr, fq, lds, wid, lane); S.done(cur); }
#undef PG8_SA
#undef PG8_SB
#undef PG8_STAGE
#undef PG8_LDA
#undef PG8_LDB
#undef PG8_MMA
#undef PG8_WAIT_V
#undef PG8_WAIT_L
#undef PG8_BAR
#undef PG8_SCHED
}
}
#define DI __device__ __forceinline__
#define GAS __attribute__((address_space(1)))
#define LAS __attribute__((address_space(3)))
typedef unsigned short bf16;
typedef unsigned v4u __attribute__((ext_vector_type(4)));
typedef unsigned v2u __attribute__((ext_vector_type(2)));
typedef float f32x4 __attribute__((ext_vector_type(4)));
typedef float f32x2 __attribute__((ext_vector_type(2)));
typedef short bf16x8 __attribute__((ext_vector_type(8)));
typedef short s16x4 __attribute__((ext_vector_type(4)));
typedef GAS unsigned gu32;

constexpr int DM = 1024, TP = 8192, MP = 16384, MS = 512, MROWS = 16896, LDZ = 8704, DFF = 4096, PLE = 256, NLAYER = 2;
constexpr int ZC_Q = 0, ZC_KC = 512, ZC_VC = 640, ZC_KS = 768, ZC_VS = 896, ZC_KW = 1024, ZC_VW = 1152, ZC_GQKV = 1280, ZC_GZ = 2816, ZC_RQKV = 3328, ZC_RG = 4864, ZC_MG = 5376, ZC_SM = 8448;
constexpr float EPS = 1e-6f;
constexpr size_t O_YP = 0, O_YS = O_YP + (size_t)MP * DM, O_KVP = O_YS + (size_t)MS * DM, O_KVS = O_KVP + (size_t)2 * MP * 512, O_WINP = O_KVS + (size_t)2 * MS * 512,
                 O_WINS = O_WINP + (size_t)2 * 2 * 512 * 256, O_CVP = O_WINS + (size_t)2 * 128 * 512 * 256, O_CVS = O_CVP + (size_t)2 * 2 * 3 * 1536, O_GSP = O_CVS + (size_t)2 * 128 * 3 * 1536,
                 O_GSS = O_GSP + (size_t)2 * 2 * 4 * 16384, O_RSP = O_GSS + (size_t)2 * 128 * 4 * 16384, O_RSS = O_RSP + (size_t)2 * 2 * 4 * 16384, O_END = O_RSS + (size_t)2 * 128 * 4 * 16384;

DI float bf2f(unsigned short b) { return __uint_as_float((unsigned)b << 16); }
DI unsigned f2bf(float f) { unsigned u = __float_as_uint(f); return (u + 0x7fffu + ((u >> 16) & 1u)) >> 16; }
typedef __bf16 bf16x2_t __attribute__((ext_vector_type(2)));
DI unsigned pk2(float lo, float hi) { const f32x2 v = {lo, hi}; return __builtin_bit_cast(unsigned, __builtin_convertvector(v, bf16x2_t)); }
DI float lo_bf(unsigned w) { return __uint_as_float(w << 16); }
DI float hi_bf(unsigned w) { return __uint_as_float(w & 0xffff0000u); }
DI float sigmoidf_(float x) { return 1.f / (1.f + __expf(-x)); }
DI float siluf_(float x) { return x / (1.f + __expf(-x)); }
DI v4u pack8(const f32x4 a, const f32x4 b) { v4u w; w.x = pk2(a[0], a[1]); w.y = pk2(a[2], a[3]); w.z = pk2(b[0], b[1]); w.w = pk2(b[2], b[3]); return w; }
DI void unpack8(const v4u w, f32x4& a, f32x4& b) { a[0] = lo_bf(w.x); a[1] = hi_bf(w.x); a[2] = lo_bf(w.y); a[3] = hi_bf(w.y); b[0] = lo_bf(w.z); b[1] = hi_bf(w.z); b[2] = lo_bf(w.w); b[3] = hi_bf(w.w); }

template <int M> DI int shxi(int v, int lane) {
    if constexpr (M < 32) return __builtin_amdgcn_ds_swizzle(v, (M << 10) | 0x1f);
    else return __builtin_amdgcn_ds_bpermute((lane ^ 32) << 2, v);
}
template <int M> DI float shx(float v, int lane) { return __int_as_float(shxi<M>(__float_as_int(v), lane)); }
DI float wave_sum(float v, int lane) { v += shx<1>(v, lane); v += shx<2>(v, lane); v += shx<4>(v, lane); v += shx<8>(v, lane); v += shx<16>(v, lane); v += shx<32>(v, lane); return v; }

namespace epi {
using pg8::Unit; using pg8::bf16_t;
DI float row_rstd(const float* SS, int row, int fq, int lane) {
    const f32x4 p = *(const f32x4*)(SS + (size_t)row * 16 + 4 * fq);
    float s = (p[0] + p[1]) + (p[2] + p[3]); s += shx<16>(s, lane); s += shx<32>(s, lane);
    return rsqrtf(s * (1.f / DM) + EPS);
}
struct EpiA {
    static constexpr bool PERM = true, AFTER_DRAIN = false;
    bf16* Z; float* ZS; const float* SS; float* out; int layer;
    DI void operator()(const f32x4 (&acc)[2][2][4][2], const Unit& u, int wr, int wc, int fr, int fq) const {
        asm volatile("" : "+v"(fr), "+v"(fq), "+s"(wr), "+s"(wc));
        const int pn = u.pn;
#pragma unroll
        for (int ai = 0; ai < 2; ++ai)
#pragma unroll
            for (int m = 0; m < 4; ++m) {
                const int row = u.pm * 256 + ai * 128 + wr * 64 + m * 16 + fr;
                const float rstd = row_rstd(SS, row, fq, fr + 16 * fq);
#pragma unroll
                for (int bj = 0; bj < 2; ++bj) {
                    const int col = pn * 256 + bj * 128 + wc * 32 + 8 * fq;
                    const f32x4 v0 = acc[ai][bj][m][0] * rstd, v1 = acc[ai][bj][m][1] * rstd;
                    *(v4u*)(Z + (size_t)row * LDZ + col) = pack8(v0, v1);
                    float* dst = nullptr;
                    if (pn == 2 || pn == 3) {
                        dst = (row < MP) ? out + O_KVP + ((size_t)layer * MP + row) * 512 + (col - 512) : out + O_KVS + ((size_t)layer * MS + (row - MP)) * 512 + (col - 512);
                    } else if (pn == 4) {
                        const int c2 = col - 1024;
                        if (row < MP) { const int t = row & (TP - 1), b = row >> 13; if (t >= TP - 512) dst = out + O_WINP + ((size_t)(layer * 2 + b) * 512 + (t - (TP - 512))) * 256 + c2; }
                        else { const int r2 = row - MP, s = r2 >> 2, j = r2 & 3; dst = out + O_WINS + ((size_t)(layer * 128 + s) * 512 + 508 + j) * 256 + c2; }
                    } else if (pn >= 5 && pn < 11) {
                        const int c2 = col - 1280;
                        if (row < MP) { const int t = row & (TP - 1), b = row >> 13; if (t >= TP - 3) dst = out + O_CVP + ((size_t)(layer * 2 + b) * 3 + (t - (TP - 3))) * 1536 + c2; }
                        else { const int r2 = row - MP, s = r2 >> 2, j = r2 & 3; if (j >= 1) dst = out + O_CVS + ((size_t)(layer * 128 + s) * 3 + (j - 1)) * 1536 + c2; }
                    } else if (pn == 33) {
                        if (bj == 0 && wc == 0) dst = ZS + (size_t)row * 32 + 8 * fq;
                    }
                    if (dst) { *(f32x4*)dst = v0; *(f32x4*)(dst + 4) = v1; }
                }
                asm volatile("" ::: "memory");
            }
    }
};
struct EpiC {
    static constexpr bool PERM = true, AFTER_DRAIN = false;
    const bf16* Z; bf16* G;
    DI void operator()(const f32x4 (&acc)[2][2][4][2], const Unit& u, int wr, int wc, int fr, int fq) const {
        asm volatile("" : "+v"(fr), "+v"(fq), "+s"(wr), "+s"(wc));
#pragma unroll
        for (int ai = 0; ai < 2; ++ai)
#pragma unroll
            for (int m = 0; m < 4; ++m) {
                const int row = u.pm * 256 + ai * 128 + wr * 64 + m * 16 + fr;
#pragma unroll
                for (int bj = 0; bj < 2; ++bj) {
                    const int col = u.pn * 256 + bj * 128 + wc * 32 + 8 * fq;
                    const v4u gw = *(const v4u*)(Z + (size_t)row * LDZ + ZC_MG + col);
                    f32x4 g0, g1; unpack8(gw, g0, g1);
                    f32x4 v0 = acc[ai][bj][m][0], v1 = acc[ai][bj][m][1];
#pragma unroll
                    for (int e = 0; e < 4; ++e) { v0[e] *= sigmoidf_(g0[e]); v1[e] *= sigmoidf_(g1[e]); }
                    *(v4u*)(G + (size_t)row * 3072 + col) = pack8(v0, v1);
                }
                asm volatile("" ::: "memory");
            }
    }
};
struct EpiRes {
    static constexpr bool PERM = true, AFTER_DRAIN = false;
    float* XR; bf16* XG; const float* gvec; float* SS; float* T; int mode;
    DI void operator()(const f32x4 (&acc)[2][2][4][2], const Unit& u, int wr, int wc, int fr, int fq) const {
        asm volatile("" : "+v"(fr), "+v"(fq), "+s"(wr), "+s"(wc));
        if (mode == 3) return;
#pragma unroll
        for (int ai = 0; ai < 2; ++ai)
#pragma unroll
            for (int m = 0; m < 4; ++m) {
                const int row = u.pm * 256 + ai * 128 + wr * 64 + m * 16 + fr;
                float ssq = 0.f;
#pragma unroll
                for (int bj = 0; bj < 2; ++bj) {
                    const int col = u.pn * 256 + bj * 128 + wc * 32 + 8 * fq;
                    const size_t o = (size_t)row * DM + col;
                    f32x4 a0 = acc[ai][bj][m][0], a1 = acc[ai][bj][m][1];
                    if (mode == 1) { *(f32x4*)(T + o) = a0; *(f32x4*)(T + o + 4) = a1; continue; }
                    f32x4 x0 = *(const f32x4*)(XR + o), x1 = *(const f32x4*)(XR + o + 4);
                    if (mode == 2) { const f32x4 t0 = *(const f32x4*)(T + o), t1 = *(const f32x4*)(T + o + 4);
#pragma unroll
                        for (int e = 0; e < 4; ++e) { a0[e] = t0[e] * sigmoidf_(a0[e]); a1[e] = t1[e] * sigmoidf_(a1[e]); } }
                    x0 += a0; x1 += a1;
                    *(f32x4*)(XR + o) = x0; *(f32x4*)(XR + o + 4) = x1;
                    ssq += (x0[0] * x0[0] + x0[1] * x0[1]) + (x0[2] * x0[2] + x0[3] * x0[3]) + (x1[0] * x1[0] + x1[1] * x1[1]) + (x1[2] * x1[2] + x1[3] * x1[3]);
                    if (XG) { if (gvec) { const f32x4 g0 = *(const f32x4*)(gvec + col), g1 = *(const f32x4*)(gvec + col + 4); x0 *= g0; x1 *= g1; }
                        *(v4u*)(XG + o) = pack8(x0, x1); }
                }
                if (SS) { ssq += shx<16>(ssq, fr + 16 * fq); ssq += shx<32>(ssq, fr + 16 * fq); if (fq == 0) SS[(size_t)row * 16 + u.pn * 4 + wc] = ssq; }
                asm volatile("" ::: "memory");
            }
    }
};
struct EpiUp {
    static constexpr bool PERM = true, AFTER_DRAIN = false;
    bf16* H; const float* SS;
    DI void operator()(const f32x4 (&acc)[2][2][4][2], const Unit& u, int wr, int wc, int fr, int fq) const {
        asm volatile("" : "+v"(fr), "+v"(fq), "+s"(wr), "+s"(wc));
#pragma unroll
        for (int ai = 0; ai < 2; ++ai)
#pragma unroll
            for (int m = 0; m < 4; ++m) {
                const int row = u.pm * 256 + ai * 128 + wr * 64 + m * 16 + fr;
                const float rstd = row_rstd(SS, row, fq, fr + 16 * fq);
#pragma unroll
                for (int bj = 0; bj < 2; ++bj) {
                    const int col = u.pn * 256 + bj * 128 + wc * 32 + 8 * fq;
                    f32x4 v0 = acc[ai][bj][m][0] * rstd, v1 = acc[ai][bj][m][1] * rstd;
#pragma unroll
                    for (int e = 0; e < 4; ++e) { const float a = fmaxf(v0[e], 0.f), b = fmaxf(v1[e], 0.f); v0[e] = a * a; v1[e] = b * b; }
                    *(v4u*)(H + (size_t)row * DFF + col) = pack8(v0, v1);
                }
                asm volatile("" ::: "memory");
            }
    }
};
}
constexpr size_t al256(size_t x) { return (x + 255) & ~(size_t)255; }
constexpr size_t WS_CTL = 0, CTL_ZERO_BYTES = 1u << 20;
constexpr size_t SZ_WIN = (size_t)LDZ * DM * 2, SZ_WBR = (size_t)3072 * 512 * 2, SZ_WO3 = (size_t)DM * 3072 * 2, SZ_WUP = (size_t)DFF * DM * 2, SZ_WDN = (size_t)DM * DFF * 2,
                 SZ_WPL = (size_t)DM * PLE * 2, SZ_WPG = (size_t)DM * DM * 2, SZ_W1T = (size_t)2 * 64 * 2048 * 2, SZ_W2T = (size_t)2 * 64 * 64 * 2;
constexpr size_t WS_WIN = CTL_ZERO_BYTES, WS_WBR = WS_WIN + 2 * SZ_WIN, WS_WO3 = WS_WBR + 2 * SZ_WBR, WS_WUP = WS_WO3 + 2 * SZ_WO3, WS_WDN = WS_WUP + 2 * SZ_WUP,
                 WS_WPL = WS_WDN + 2 * SZ_WDN, WS_WPG = WS_WPL + 2 * SZ_WPL, WS_W1T = WS_WPG + 2 * SZ_WPG, WS_W2T = WS_W1T + 2 * SZ_W1T, WS_ROT = al256(WS_W2T + 2 * SZ_W2T);
constexpr size_t WS_P16 = WS_ROT + (size_t)TP * 64 * 8;
constexpr size_t WS_XR = WS_P16 + (size_t)2 * MROWS * PLE * 2;
constexpr size_t WS_XGA = WS_XR + (size_t)MROWS * DM * 4, WS_XGB = WS_XGA + (size_t)MROWS * DM * 2, WS_XGC = WS_XGB + (size_t)MROWS * DM * 2;
constexpr size_t WS_SSA = WS_XGC + (size_t)MROWS * DM * 2, WS_SSB = WS_SSA + (size_t)MROWS * 64;
constexpr size_t WS_Z = WS_SSB + (size_t)MROWS * 64, WS_ZS = WS_Z + (size_t)MROWS * LDZ * 2;
constexpr size_t WS_MIX = WS_ZS + (size_t)MROWS * 128, WS_GATED = WS_MIX + (size_t)MROWS * 1536 * 2, WS_HMID = WS_GATED + (size_t)MROWS * 3072 * 2;
constexpr size_t WS_TPLE = WS_HMID + (size_t)MROWS * DFF * 2;
constexpr size_t WS_KC = WS_TPLE + (size_t)MROWS * DM * 4;
constexpr size_t WS_KCS = WS_KC + (size_t)2 * 2 * 512 * 2 * 64 * 2;
constexpr int GREC = 73984;
constexpr size_t WS_GREC = WS_KCS + (size_t)2 * 128 * 128 * 2 * 64 * 2;
constexpr size_t WS_OGDN = WS_GREC + (size_t)1024 * GREC;
constexpr size_t WS_RKV = WS_OGDN + (size_t)MROWS * 512 * 4;
constexpr size_t WS_RST = WS_RKV + (size_t)512 * 16384 * 4;
constexpr size_t WS_QR = WS_RST + (size_t)512 * 16384 * 2, WS_KR = WS_QR + (size_t)MP * 512 * 2;
constexpr size_t WS_END = WS_KR + (size_t)MP * 512 * 2;
static_assert(WS_W1T % 256 == 0 && WS_Z % 256 == 0 && WS_GREC % 256 == 0 && WS_RKV % 256 == 0 && WS_KC % 256 == 0 && WS_XR % 256 == 0, "ws alignment");

constexpr int CW_TMO = 0, CW_BAR = 4096, CW_QUEUE = 8192;
constexpr int NWAVES = 8, NTHREADS = 512;
constexpr int RING_BYTES = 147456, LDSCTL_OFF = RING_BYTES, MISC_OFF = LDSCTL_OFF + 320, LDS_BYTES = RING_BYTES + 1024;

#define RLX_AGENT __ATOMIC_RELAXED, __HIP_MEMORY_SCOPE_AGENT
#define LDS_WAIT() asm volatile("s_waitcnt lgkmcnt(0)" ::: "memory")
#define VM_WAIT() asm volatile("s_waitcnt vmcnt(0)" ::: "memory")
#define XB_TMO      128
#define XB_XCNT(j)  (256  + 64 * (j))
#define XB_XSUB(j)  (1280 + 64 * (j))
#define XB_XGEN(j)  (2304 + 64 * (j))
#define XB_TOP      3328
#define XB_TOPGEN   3392
#define XCD_BAR_WORDS 3456
#define XB_SPIN_CAP (1u << 18)

__device__ __forceinline__ unsigned xb_ld(unsigned* p)              { return __hip_atomic_load(p, __ATOMIC_RELAXED, __HIP_MEMORY_SCOPE_AGENT); }
__device__ __forceinline__ unsigned xb_add(unsigned* p, unsigned v) { return __hip_atomic_fetch_add(p, v, __ATOMIC_RELAXED, __HIP_MEMORY_SCOPE_AGENT); }
__device__ __forceinline__ unsigned xb_xcc_id() { return (unsigned)__builtin_amdgcn_s_getreg((3 << 11) | 20) & 0xFu; }
#define XB_SPIN(cond, bar) do { unsigned _sp = 0; while (cond) { __builtin_amdgcn_s_sleep(1); \
    if ((++_sp & 255u) == 0u) { if (xb_ld(&(bar)[XB_TMO])) break; if (_sp > XB_SPIN_CAP) { atomicAdd(&(bar)[XB_TMO], 1u); break; } } } } while (0)

struct XcdBarrier {
    unsigned* bar; unsigned x;
    volatile LAS unsigned* st;
};

__device__ __forceinline__ XcdBarrier xcd_barrier_post(unsigned* bar, volatile LAS unsigned* st, bool t0) {
    XcdBarrier b; b.bar = bar; b.x = xb_xcc_id(); b.st = st;
    if (t0) (void)xb_add(&bar[XB_XCNT(b.x)], 1u);
    return b;
}
__device__ __forceinline__ void xcd_barrier_complete(unsigned* bar, unsigned x, unsigned& nloc, unsigned& nx) {
    const unsigned G = gridDim.x * gridDim.y * gridDim.z;
    unsigned sum, cnt, mine, sp = 0u;
    for (;;) {
        sum = 0u; cnt = 0u; mine = 0u;
#pragma unroll
        for (unsigned j = 0; j < 16; ++j) { const unsigned c = xb_ld(&bar[XB_XCNT(j)]); sum += c; cnt += (c > 0u) ? 1u : 0u; mine = (j == x) ? c : mine; }
        if (sum == G) break;
        __builtin_amdgcn_s_sleep(1);
        if ((++sp & 255u) == 0u) { if (xb_ld(&bar[XB_TMO])) break; if (sp > XB_SPIN_CAP) { atomicAdd(&bar[XB_TMO], 1u); break; } }
    }
    nloc = mine > 0u ? mine : 1u; nx = cnt > 0u ? cnt : 1u;
}

__device__ __forceinline__ void xcd_barrier(const XcdBarrier& b, bool t0) {
    asm volatile("s_waitcnt vmcnt(0)" ::: "memory");
    __syncthreads();
    if (t0) {
        unsigned* bar = b.bar;
        __builtin_amdgcn_s_waitcnt(0);
        unsigned nloc = b.st[0], nx = b.st[1];
        if (nloc == 0u) { xcd_barrier_complete(bar, b.x, nloc, nx); b.st[0] = nloc; b.st[1] = nx; }
        const unsigned old = xb_add(&bar[XB_XSUB(b.x)], 1u);
        const unsigned gen = old / nloc;
        if (old + 1u == (gen + 1u) * nloc) {
            __builtin_amdgcn_fence(__ATOMIC_RELEASE, "agent");
            asm volatile("s_waitcnt vmcnt(0)" ::: "memory");
            const unsigned og = xb_add(&bar[XB_TOP], 1u);
            const unsigned tg = og / nx;
            if (og + 1u == (tg + 1u) * nx) xb_add(&bar[XB_TOPGEN], 1u);
            else XB_SPIN(xb_ld(&bar[XB_TOPGEN]) == tg, bar);
            __builtin_amdgcn_fence(__ATOMIC_ACQUIRE, "agent");
            xb_add(&bar[XB_XGEN(b.x)], 1u);
            asm volatile("s_waitcnt vmcnt(0)" ::: "memory");
        } else {
            XB_SPIN(xb_ld(&bar[XB_XGEN(b.x)]) == gen, bar);
            __builtin_amdgcn_fence(__ATOMIC_ACQUIRE, "agent");
            asm volatile("s_waitcnt vmcnt(0)" ::: "memory");
        }
    }
    __syncthreads();
}
typedef const void* const __attribute__((address_space(4)))* kargp_t;
DI const float* KIN(int i) { const float* p = (const float*)((kargp_t)__builtin_amdgcn_kernarg_segment_ptr())[i]; asm volatile("" : "+s"(p)); return p; }
DI float* KOUT() { float* p = (float*)((kargp_t)__builtin_amdgcn_kernarg_segment_ptr())[27]; asm volatile("" : "+s"(p)); return p; }
DI unsigned char* KWS() { unsigned char* p = (unsigned char*)((kargp_t)__builtin_amdgcn_kernarg_segment_ptr())[28]; asm volatile("" : "+s"(p)); return p; }
struct Frame {
    LAS unsigned char* lds;
    gu32* ctl;
    int tid, lane, wave, G, bid;
};
DI bf16x8 ld_frag_g(const bf16* p) { return __builtin_bit_cast(bf16x8, *(const v4u*)p); }
DI bf16x8 ld_frag_l(const LAS unsigned char* p) { return *(const LAS bf16x8*)p; }
DI f32x4 mfma16(bf16x8 a, bf16x8 b, f32x4 c) { return __builtin_amdgcn_mfma_f32_16x16x32_bf16(a, b, c, 0, 0, 0); }
DI bf16x8 pack_frag(const f32x4 a, const f32x4 b) { return __builtin_bit_cast(bf16x8, pack8(a, b)); }
DI int lane_id() { int l; asm volatile("v_mbcnt_lo_u32_b32 %0, -1, 0\n\tv_mbcnt_hi_u32_b32 %0, -1, %0" : "=v"(l)); return l; }
DI Frame fresh(const Frame& F0) {
    Frame F = F0; int w = F0.wave, g = F0.G, b = F0.bid; asm volatile("" : "+s"(w), "+s"(g), "+s"(b));
    int l = lane_id(); asm volatile("" : "+v"(l));
    unsigned lb = (unsigned)(uintptr_t)F0.lds; asm volatile("" : "+s"(lb)); F.lds = (LAS unsigned char*)(uintptr_t)lb;
    F.wave = w; F.lane = l; F.tid = w * 64 + l; F.G = g; F.bid = b; return F;
}
#define GRID_BAR() do { XcdBarrier b_; b_.bar = (unsigned*)((gu32*)(KWS() + WS_CTL) + CW_BAR); b_.x = xb_xcc_id(); b_.st = (volatile LAS unsigned*)(F.lds + MISC_OFF) + 8; \
    const Frame Fb_ = fresh(F); xcd_barrier(b_, Fb_.tid == 0); } while (0)
DI int win_colmap(int j) {
    if (j < 1280) return j; if (j < 2816) return j + 24; if (j < 8448) return j + 32; if (j < 8472) return j - 8448 + 1280; if (j < 8480) return j - 8472 + 2840; return -1;
}
DI void tr_item(const float* W, int ldw, int k0, int srccol, bf16* WT, size_t dst_row0, int ldt, int kdst0, int nrep, int krep, LAS float* scr, int lane) {
#pragma unroll 8
    for (int i = 0; i < 32; ++i) { const int kk = 2 * i + (lane >> 5); scr[kk * 33 + (lane & 31)] = (srccol >= 0) ? W[(size_t)(k0 + kk) * ldw + srccol] : 0.f; }
    LDS_WAIT(); asm volatile("" ::: "memory");
    const int c = lane & 7;
#pragma unroll
    for (int j = 0; j < 4; ++j) { const int n = (lane >> 3) + 8 * j; const LAS float* s = scr + (8 * c) * 33 + n;
        v4u o; o.x = pk2(s[0 * 33], s[1 * 33]); o.y = pk2(s[2 * 33], s[3 * 33]); o.z = pk2(s[4 * 33], s[5 * 33]); o.w = pk2(s[6 * 33], s[7 * 33]);
        for (int r = 0; r < nrep; ++r) *(v4u*)(WT + (dst_row0 + n) * (size_t)ldt + kdst0 + r * krep + 8 * c) = o; }
    LDS_WAIT(); asm volatile("" ::: "memory");
}
DI void p0_prologue(Frame& F) {
    LAS float* scr = (LAS float*)(F.lds + F.wave * 16384);
    const int gw = F.bid * NWAVES + F.wave, NGW = F.G * NWAVES, lane = F.lane;
    unsigned char* ws = KWS();
    constexpr int I_A = 16 * 272, I_B = 3 * 8 * 32, I_C = 16 * 32, I_D = 16 * 128, I_E = 64 * 32, I_F = 4 * 32, I_G = 16 * 32, I_H = 2 * 32 * 2, I_I = 2 * 2;
    constexpr int I_L = I_A + I_B + I_C + I_D + I_E + I_F + I_G + I_H + I_I;
    for (int it = gw; it < 2 * I_L; it += NGW) {
        const int l = it / I_L; int r = it % I_L;
        if (r < I_A) { const int kb = r / 272, nb = r % 272; tr_item(KIN(11) + (size_t)l * DM * 8480, 8480, 64 * kb, win_colmap(32 * nb + (lane & 31)), (bf16*)(ws + WS_WIN + l * SZ_WIN), 32 * nb, DM, 64 * kb, 1, 0, scr, lane); continue; } r -= I_A;
        if (r < I_B) { const int b = r / 256, kb = (r % 256) / 32, nb = r % 32; tr_item(KIN(19) + (size_t)(l * 3 + b) * 512 * DM, DM, 64 * kb, 32 * nb + (lane & 31), (bf16*)(ws + WS_WBR + l * SZ_WBR), b * 1024 + 32 * nb, 512, 64 * kb, 1, 0, scr, lane); continue; } r -= I_B;
        if (r < I_C) { const int kb = r / 32, nb = r % 32; tr_item(KIN(20) + (size_t)l * DM * DM, DM, 64 * kb, 32 * nb + (lane & 31), (bf16*)(ws + WS_WO3 + l * SZ_WO3), 32 * nb, 3072, 64 * kb, 3, 1024, scr, lane); continue; } r -= I_C;
        if (r < I_D) { const int kb = r / 128, nb = r % 128; tr_item(KIN(22) + (size_t)l * DM * DFF, DFF, 64 * kb, 32 * nb + (lane & 31), (bf16*)(ws + WS_WUP + l * SZ_WUP), 32 * nb, DM, 64 * kb, 1, 0, scr, lane); continue; } r -= I_D;
        if (r < I_E) { const int kb = r / 32, nb = r % 32; tr_item(KIN(23) + (size_t)l * DFF * DM, DM, 64 * kb, 32 * nb + (lane & 31), (bf16*)(ws + WS_WDN + l * SZ_WDN), 32 * nb, DFF, 64 * kb, 1, 0, scr, lane); continue; } r -= I_E;
        if (r < I_F) { const int kb = r / 32, nb = r % 32; tr_item(KIN(24) + (size_t)l * PLE * DM, DM, 64 * kb, 32 * nb + (lane & 31), (bf16*)(ws + WS_WPL + l * SZ_WPL), 32 * nb, PLE, 64 * kb, 1, 0, scr, lane); continue; } r -= I_F;
        if (r < I_G) { const int kb = r / 32, nb = r % 32; tr_item(KIN(25) + (size_t)l * DM * DM, DM, 64 * kb, 32 * nb + (lane & 31), (bf16*)(ws + WS_WPG + l * SZ_WPG), 32 * nb, DM, 64 * kb, 1, 0, scr, lane); continue; } r -= I_G;
        if (r < I_H) { const int kv = r / 64, kb = (r % 64) / 2, nb = r % 2; tr_item(KIN(13) + (size_t)(l * 2 + kv) * 2048 * 64, 64, 64 * kb, 32 * nb + (lane & 31), (bf16*)(ws + WS_W1T + l * SZ_W1T) + (size_t)kv * 64 * 2048, 32 * nb, 2048, 64 * kb, 1, 0, scr, lane); continue; } r -= I_H;
        { const int kv = r / 2, nb = r % 2; tr_item(KIN(14) + (size_t)(l * 2 + kv) * 64 * 64, 64, 0, 32 * nb + (lane & 31), (bf16*)(ws + WS_W2T + l * SZ_W2T) + (size_t)kv * 64 * 64, 32 * nb, 64, 0, 1, 0, scr, lane); }
    }
    float* XR = (float*)(ws + WS_XR); bf16* XGA = (bf16*)(ws + WS_XGA); float* SSA = (float*)(ws + WS_SSA); bf16* P16 = (bf16*)(ws + WS_P16);
    const float* g0 = KIN(10);
    for (int row = gw; row < MROWS; row += NGW) {
        const float* xs = (row < MP) ? KIN(0) + (size_t)row * DM : KIN(1) + (size_t)(row - MP) * DM;
        float ss = 0.f;
#pragma unroll
        for (int j = 0; j < 2; ++j) {
            const int c = j * 512 + lane * 8;
            f32x4 a = *(const f32x4*)(xs + c), b = *(const f32x4*)(xs + c + 4);
            *(f32x4*)(XR + (size_t)row * DM + c) = a; *(f32x4*)(XR + (size_t)row * DM + c + 4) = b;
            ss += (a[0] * a[0] + a[1] * a[1]) + (a[2] * a[2] + a[3] * a[3]) + (b[0] * b[0] + b[1] * b[1]) + (b[2] * b[2] + b[3] * b[3]);
            const f32x4 ga = *(const f32x4*)(g0 + c), gb = *(const f32x4*)(g0 + c + 4);
            *(v4u*)(XGA + (size_t)row * DM + c) = pack8(a * ga, b * gb);
        }
        ss = wave_sum(ss, lane);
        if (lane < 16) SSA[(size_t)row * 16 + lane] = (lane == 0) ? ss : 0.f;
#pragma unroll
        for (int l = 0; l < 2; ++l) {
            const float* ps = (row < MP) ? KIN(8) + ((size_t)l * MP + row) * PLE : KIN(9) + ((size_t)l * MS + (row - MP)) * PLE;
            const f32x4 a = *(const f32x4*)(ps + lane * 4);
            v2u o; o.x = pk2(a[0], a[1]); o.y = pk2(a[2], a[3]);
            *(v2u*)(P16 + ((size_t)l * MROWS + row) * PLE + lane * 4) = o;
        }
    }
    const int gt = F.bid * NTHREADS + F.tid, NGT = F.G * NTHREADS;
    f32x2* ROT = (f32x2*)(ws + WS_ROT);
    for (int e = gt; e < TP * 64; e += NGT) {
        const int pos = e >> 6, i = e & 63;
        const float x = (float)i * (1.0f / 63.0f);
        const float inv = exp2f(-x * 13.287712379549449f);
        const float ang = (float)pos * inv;
        const double rev = (double)ang * 0.15915494309189535;
        const float fr = (float)(rev - floor(rev));
        ROT[e] = (f32x2){__builtin_amdgcn_cosf(fr), __builtin_amdgcn_sinf(fr)};
    }
    {
        const float* src = KIN(3); float* dst = KOUT() + O_WINS;
        constexpr int NE = 2 * 128 * 508 * 64;
        for (int e0 = gt; e0 < NE; e0 += 8 * NGT) {
            f32x4 v[8];
#pragma unroll
            for (int u = 0; u < 8; ++u) { const int e = e0 + u * NGT; const int ec = e < NE ? e : NE - 1; const int ls = ec / (508 * 64), r = ec % (508 * 64);
                v[u] = *(const f32x4*)(src + (size_t)ls * 512 * 256 + 4 * 256 + (size_t)r * 4); }
#pragma unroll
            for (int u = 0; u < 8; ++u) { const int e = e0 + u * NGT; if (e < NE) { const int ls = e / (508 * 64), r = e % (508 * 64); *(f32x4*)(dst + (size_t)ls * 512 * 256 + (size_t)r * 4) = v[u]; } }
        }
    }
}
DI float gelu_tanh(float x) { const float u = 0.7978845608028654f * (x + 0.044715f * x * x * x); const float e = __expf(2.f * u); return 0.5f * x * (1.f + (1.f - 2.f / (e + 1.f))); }
DI bf16x8 mk_frag(v2u a, v2u b) { v4u w; w.x = a.x; w.y = a.y; w.z = b.x; w.w = b.y; return __builtin_bit_cast(bf16x8, w); }

DI void compress_job(Frame& F, int layer, int job) {
    int lane = F.lane, wave = F.wave; asm volatile("" : "+v"(lane), "+s"(wave));
    const int tid = wave * 64 + lane, quad = lane >> 4, rl = lane & 15;
    unsigned char* ws = KWS();
    const bool sample = job < 256;
    int kv, bs, g0, nbase;
    if (sample) { kv = job >> 7; bs = job & 127; g0 = 0; nbase = 0; }
    else { const int j2 = job - 256; kv = j2 >> 3; bs = (j2 >> 2) & 1; g0 = (j2 >> 1) & 1; nbase = (j2 & 1) * 256; }
    const bf16* W1T = (const bf16*)(ws + WS_W1T + layer * SZ_W1T) + (size_t)kv * 64 * 2048;
    const bf16* W2T = (const bf16*)(ws + WS_W2T + layer * SZ_W2T) + (size_t)kv * 64 * 64;
    const float* pe = KIN(12) + (size_t)(layer * 2 + kv) * 32 * 64;
    const bf16* Z = (const bf16*)(ws + WS_Z);
    const int* pt = (const int*)KIN(7);
    const float* cache = KIN(2);
    LAS unsigned char* LW = F.lds;
    int gg[2], nn[2];
#pragma unroll
    for (int tl = 0; tl < 2; ++tl) { const int T = 2 * wave + tl; if (sample) { gg[tl] = T >> 3; nn[tl] = 16 * (T & 7) + rl; } else { gg[tl] = g0; nn[tl] = nbase + 16 * T + rl; } }
    f32x4 h[2][4];
#pragma unroll
    for (int tl = 0; tl < 2; ++tl)
#pragma unroll
        for (int i = 0; i < 4; ++i) h[tl][i] = (f32x4){0.f, 0.f, 0.f, 0.f};
#pragma unroll 1
    for (int c = 0; c < 4; ++c) {
        __syncthreads();
#pragma unroll
        for (int k = 0; k < 8; ++k) { const int pc = tid + 512 * k, r = pc >> 6, c16 = pc & 63;
            *(LAS v4u*)(LW + r * 1040 + c16 * 16) = *(const v4u*)(W1T + (size_t)r * 2048 + c * 512 + c16 * 8); }
        __syncthreads();
#pragma unroll 4
        for (int kk = 0; kk < 16; ++kk) {
            const int j = 8 * c + (kk >> 1), dim0 = (kk & 1) * 32 + quad * 8;
            const f32x4 pe0 = *(const f32x4*)(pe + j * 64 + dim0), pe1 = *(const f32x4*)(pe + j * 64 + dim0 + 4);
            bf16x8 xb[2];
#pragma unroll
            for (int tl = 0; tl < 2; ++tl) {
                f32x4 x0, x1;
                if (!sample) { const size_t row = (size_t)bs * TP + 16 * nn[tl] + j; unpack8(*(const v4u*)(Z + row * LDZ + ZC_KC + kv * 128 + gg[tl] * 64 + dim0), x0, x1); }
                else { int pos = 16 * nn[tl] + j; pos = pos > 2047 ? 2047 : pos; const int phys = pt[bs * 16 + (pos >> 7)];
                    const float* p = cache + ((size_t)(layer * 2560 + phys) * 128 + (pos & 127)) * 512 + kv * 128 + gg[tl] * 64 + dim0; x0 = *(const f32x4*)p; x1 = *(const f32x4*)(p + 4); }
                xb[tl] = pack_frag(x0 + pe0, x1 + pe1);
            }
#pragma unroll
            for (int ht = 0; ht < 4; ++ht) {
                const bf16x8 a = ld_frag_l(LW + (16 * ht + rl) * 1040 + (kk * 32 + quad * 8) * 2);
                h[0][ht] = mfma16(a, xb[0], h[0][ht]); h[1][ht] = mfma16(a, xb[1], h[1][ht]);
            }
        }
    }
#pragma unroll
    for (int tl = 0; tl < 2; ++tl) {
#pragma unroll
        for (int ht = 0; ht < 4; ++ht)
#pragma unroll
            for (int i = 0; i < 4; ++i) h[tl][ht][i] = gelu_tanh(h[tl][ht][i]);
        bf16x8 gb[2]; gb[0] = pack_frag(h[tl][0], h[tl][1]); gb[1] = pack_frag(h[tl][2], h[tl][3]);
        const int n = nn[tl], g = gg[tl];
        bf16* dst = sample ? (bf16*)(ws + WS_KCS) + ((((size_t)kv * 128 + bs) * 128 + n) * 2 + g) * 64 : (bf16*)(ws + WS_KC) + ((((size_t)kv * 2 + bs) * 512 + n) * 2 + g) * 64;
        const bool zero = sample && n == 127;
#pragma unroll
        for (int ot = 0; ot < 4; ++ot) {
            f32x4 o = (f32x4){0.f, 0.f, 0.f, 0.f};
#pragma unroll
            for (int s = 0; s < 2; ++s) {
                const bf16* wp = W2T + (16 * ot + rl) * 64 + 32 * s + 4 * quad;
                o = mfma16(mk_frag(*(const v2u*)wp, *(const v2u*)(wp + 16)), gb[s], o);
            }
            v2u w; w.x = zero ? 0u : pk2(o[0], o[1]); w.y = zero ? 0u : pk2(o[2], o[3]);
            *(v2u*)(dst + 16 * ot + 4 * quad) = w;
        }
    }
    __syncthreads();
}

DI int kperm(int idx) { const int s = idx >> 5, r = idx & 31; return 32 * s + 8 * ((r >> 2) & 3) + 4 * (r >> 4) + (r & 3); }
DI float softplusf_(float x) { return x > 20.f ? x : __logf(1.f + __expf(x)); }
DI float ret_lg(int h) { return h == 0 ? -0.031748697f : h == 1 ? -0.015748357f : h == 2 ? -0.007843178f : -0.0039138994f; }

DI void gdn_prep_unit(Frame& F, int layer, int unit) {
    const int tid = F.tid, lane = F.lane, wave = F.wave;
    const int b = unit >> 9, h = (unit >> 7) & 3, c = unit & 127;
    const int row0 = b * TP + 64 * c, t0 = 64 * c;
    unsigned char* ws = KWS();
    const bf16* Z = (const bf16*)(ws + WS_Z);
    const float* ZS = (const float*)(ws + WS_ZS);
    LAS float* Lq = (LAS float*)(F.lds); LAS float* Lk = (LAS float*)(F.lds + 33792); LAS float* Lv = (LAS float*)(F.lds + 67584);
    LAS float* LA = (LAS float*)(F.lds + 101376); LAS float* LQK = (LAS float*)(F.lds + 117760);
    LAS float* Lg = (LAS float*)(F.lds + 134144); LAS float* Lb = Lg + 64; LAS float* Le = Lg + 128;
    const float* cw = KIN(15) + (size_t)layer * 4 * 1536;
#pragma unroll
    for (int it0 = 0; it0 < 6; ++it0) {
        const int it = tid + it0 * NTHREADS;
        const int i = it / 48, ch = it % 48, part = ch >> 4, cc = ch & 15;
        const int col = part * 512 + h * 128 + cc * 8;
        f32x4 y0 = (f32x4){0.f, 0.f, 0.f, 0.f}, y1 = y0;
#pragma unroll
        for (int j = 0; j < 4; ++j) {
            const int t = t0 + i - 3 + j;
            if (t >= 0) { f32x4 x0, x1; unpack8(*(const v4u*)(Z + (size_t)(row0 + i - 3 + j) * LDZ + ZC_GQKV + col), x0, x1);
                y0 += x0 * *(const f32x4*)(cw + j * 1536 + col); y1 += x1 * *(const f32x4*)(cw + j * 1536 + col + 4); }
        }
#pragma unroll
        for (int e = 0; e < 4; ++e) { y0[e] = siluf_(y0[e]); y1[e] = siluf_(y1[e]); }
        LAS float* dst = (part == 0 ? Lq : part == 1 ? Lk : Lv) + i * 132 + cc * 8;
        *(LAS f32x4*)dst = y0; *(LAS f32x4*)(dst + 4) = y1;
    }
    __syncthreads();
    {
        float va[16], vb[16], ps[16];
#pragma unroll
        for (int q = 0; q < 16; ++q) { LAS float* vp = ((q < 8) ? Lq : Lk) + (wave * 8 + (q & 7)) * 132 + lane * 2; va[q] = vp[0]; vb[q] = vp[1]; ps[q] = va[q] * va[q] + vb[q] * vb[q]; }
#pragma unroll
        for (int q = 0; q < 16; ++q) ps[q] += shx<1>(ps[q], lane);
#pragma unroll
        for (int q = 0; q < 16; ++q) ps[q] += shx<2>(ps[q], lane);
#pragma unroll
        for (int q = 0; q < 16; ++q) ps[q] += shx<4>(ps[q], lane);
#pragma unroll
        for (int q = 0; q < 16; ++q) ps[q] += shx<8>(ps[q], lane);
#pragma unroll
        for (int q = 0; q < 16; ++q) ps[q] += shx<16>(ps[q], lane);
#pragma unroll
        for (int q = 0; q < 16; ++q) ps[q] += shx<32>(ps[q], lane);
#pragma unroll
        for (int q = 0; q < 16; ++q) { LAS float* vp = ((q < 8) ? Lq : Lk) + (wave * 8 + (q & 7)) * 132 + lane * 2; const float sc = rsqrtf(ps[q] + EPS) * ((q < 8) ? 0.08838834764831845f : 1.f); vp[0] = va[q] * sc; vp[1] = vb[q] * sc; }
    }
    if (wave == 0) {
        const float ga = ZS[(size_t)(row0 + lane) * 32 + 24 + h], gbv = ZS[(size_t)(row0 + lane) * 32 + 28 + h];
        float g = -__expf(KIN(16)[layer * 4 + h]) * softplusf_(ga + KIN(17)[layer * 4 + h]);
#pragma unroll
        for (int o = 1; o < 64; o <<= 1) { const float t = __int_as_float(__builtin_amdgcn_ds_bpermute(((lane - o) & 63) << 2, __float_as_int(g))); if (lane >= o) g += t; }
        Lg[lane] = g; Lb[lane] = sigmoidf_(gbv); Le[lane] = __expf(g);
    }
    __syncthreads();
    {
        const int it = wave >> 1, quad = lane >> 4, rl = lane & 15;
        f32x4 ckk[2], cqk[2];
#pragma unroll
        for (int jj = 0; jj < 2; ++jj) { ckk[jj] = (f32x4){0.f, 0.f, 0.f, 0.f}; cqk[jj] = ckk[jj]; }
#pragma unroll
        for (int s = 0; s < 4; ++s) {
            const LAS float* kp = Lk + (16 * it + rl) * 132 + 32 * s + 8 * quad; const LAS float* qp = Lq + (16 * it + rl) * 132 + 32 * s + 8 * quad;
            const f32x4 ka0 = *(const LAS f32x4*)kp, ka1 = *(const LAS f32x4*)(kp + 4), qa0 = *(const LAS f32x4*)qp, qa1 = *(const LAS f32x4*)(qp + 4);
            const bf16x8 kah = pack_frag(ka0, ka1), qah = pack_frag(qa0, qa1);
            f32x4 h0, h1; unpack8(__builtin_bit_cast(v4u, kah), h0, h1); const bf16x8 kal = pack_frag(ka0 - h0, ka1 - h1);
            unpack8(__builtin_bit_cast(v4u, qah), h0, h1); const bf16x8 qal = pack_frag(qa0 - h0, qa1 - h1);
#pragma unroll
            for (int jj = 0; jj < 2; ++jj) {
                const int jt = (wave & 1) * 2 + jj;
                if (jt <= it) {
                    const LAS float* bp = Lk + (16 * jt + rl) * 132 + 32 * s + 8 * quad;
                    const f32x4 kb0 = *(const LAS f32x4*)bp, kb1 = *(const LAS f32x4*)(bp + 4);
                    const bf16x8 kbh = pack_frag(kb0, kb1); unpack8(__builtin_bit_cast(v4u, kbh), h0, h1); const bf16x8 kbl = pack_frag(kb0 - h0, kb1 - h1);
                    ckk[jj] = mfma16(kah, kbh, ckk[jj]); ckk[jj] = mfma16(kah, kbl, ckk[jj]); ckk[jj] = mfma16(kal, kbh, ckk[jj]);
                    cqk[jj] = mfma16(qah, kbh, cqk[jj]); cqk[jj] = mfma16(qah, kbl, cqk[jj]); cqk[jj] = mfma16(qal, kbh, cqk[jj]);
                }
            }
        }
#pragma unroll
        for (int jj = 0; jj < 2; ++jj) {
            const int j = 16 * ((wave & 1) * 2 + jj) + rl; const float gj = Lg[j];
#pragma unroll
            for (int e = 0; e < 4; ++e) { const int i = 16 * it + 4 * quad + e; const float dec = (i >= j) ? __expf(Lg[i] - gj) : 0.f;
                LA[i * 64 + j] = (i > j) ? Lb[i] * ckk[jj][e] * dec : 0.f; LQK[i * 64 + j] = cqk[jj][e] * dec; }
        }
    }
    __syncthreads();
    unsigned char* rec = ws + WS_GREC + (size_t)unit * GREC;
    {
        const float gl = Lg[63];
        for (int it = tid; it < 2560; it += NTHREADS) {
            if (it < 1024) {
                const int i = it >> 4, s = (it >> 2) & 3, quad = it & 3; const float e = Le[i];
                const f32x4 a = *(const LAS f32x4*)(Lq + i * 132 + 32 * s + 4 * quad) * e, bq = *(const LAS f32x4*)(Lq + i * 132 + 32 * s + 16 + 4 * quad) * e;
                *(v4u*)(rec + 16384 + i * 256 + (32 * s + 8 * quad) * 2) = pack8(a, bq);
            } else if (it < 2048) {
                const int r = it - 1024, dk = r >> 3, s2 = (r >> 2) & 1, quad = r & 3;
                f32x4 a, bq;
#pragma unroll
                for (int e = 0; e < 4; ++e) { const int ta = 32 * s2 + 4 * quad + e, tb = ta + 16; a[e] = Lk[ta * 132 + dk] * __expf(gl - Lg[ta]); bq[e] = Lk[tb * 132 + dk] * __expf(gl - Lg[tb]); }
                *(v4u*)(rec + 32768 + dk * 128 + (32 * s2 + 8 * quad) * 2) = pack8(a, bq);
            } else {
                const int r = it - 2048, i = r >> 3, s2 = (r >> 2) & 1, quad = r & 3;
                const f32x4 a = *(const LAS f32x4*)(LQK + i * 64 + 32 * s2 + 4 * quad), bq = *(const LAS f32x4*)(LQK + i * 64 + 32 * s2 + 16 + 4 * quad);
                *(v4u*)(rec + 65536 + i * 128 + (32 * s2 + 8 * quad) * 2) = pack8(a, bq);
            }
        }
        if (tid == 0) *(float*)(rec + 73728) = __expf(gl);
    }
    __syncthreads();
    if (tid < 256) {
        LAS float* X = (tid < 128) ? (Lv + tid) : (Lk + (tid - 128));
        const bool isw = tid >= 128;
#pragma unroll 1
        for (int B = 0; B < 4; ++B) {
            float xb[16];
#pragma unroll
            for (int i = 0; i < 16; ++i) { const int r = 16 * B + i; xb[i] = (isw ? Lb[r] * Le[r] : Lb[r]) * X[r * 132]; }
#pragma unroll 1
            for (int j4 = 0; j4 < 4 * B; ++j4) {
                const float x0 = X[(4 * j4) * 132], x1 = X[(4 * j4 + 1) * 132], x2 = X[(4 * j4 + 2) * 132], x3 = X[(4 * j4 + 3) * 132];
#pragma unroll
                for (int i = 0; i < 16; ++i) { const f32x4 a = *(const LAS f32x4*)(LA + (16 * B + i) * 64 + 4 * j4); xb[i] -= (a[0] * x0 + a[1] * x1) + (a[2] * x2 + a[3] * x3); }
            }
#pragma unroll
            for (int i = 1; i < 16; ++i) {
                float acc0 = 0.f, acc1 = 0.f;
#pragma unroll
                for (int j4 = 0; j4 < (i + 3) / 4; ++j4) { const f32x4 a = *(const LAS f32x4*)(LA + (16 * B + i) * 64 + 16 * B + 4 * j4);
                    if (4 * j4 + 0 < i) acc0 += a[0] * xb[4 * j4 + 0]; if (4 * j4 + 1 < i) acc1 += a[1] * xb[4 * j4 + 1]; if (4 * j4 + 2 < i) acc0 += a[2] * xb[4 * j4 + 2]; if (4 * j4 + 3 < i) acc1 += a[3] * xb[4 * j4 + 3]; }
                xb[i] -= acc0 + acc1;
            }
#pragma unroll
            for (int i = 0; i < 16; ++i) X[(16 * B + i) * 132] = xb[i];
        }
    }
    __syncthreads();
    for (int it = tid; it < 2048; it += NTHREADS) {
        if (it < 1024) {
            const int dv = it >> 3, q = it & 7;
            v4u w; w.x = pk2(Lv[(8 * q) * 132 + dv], Lv[(8 * q + 1) * 132 + dv]); w.y = pk2(Lv[(8 * q + 2) * 132 + dv], Lv[(8 * q + 3) * 132 + dv]);
            w.z = pk2(Lv[(8 * q + 4) * 132 + dv], Lv[(8 * q + 5) * 132 + dv]); w.w = pk2(Lv[(8 * q + 6) * 132 + dv], Lv[(8 * q + 7) * 132 + dv]);
            *(v4u*)(rec + 49152 + dv * 128 + q * 16) = w;
        } else {
            const int r = it - 1024, i = r >> 4, s = (r >> 2) & 3, quad = r & 3;
            const f32x4 a = *(const LAS f32x4*)(Lk + i * 132 + 32 * s + 4 * quad), bq = *(const LAS f32x4*)(Lk + i * 132 + 32 * s + 16 + 4 * quad);
            *(v4u*)(rec + i * 256 + (32 * s + 8 * quad) * 2) = pack8(a, bq);
        }
    }
    __syncthreads();
}

DI void ret_prep_unit(Frame& F, int layer, int unit) {
    const int tid = F.tid, lane = F.lane, wave = F.wave, quad = lane >> 4, rl = lane & 15;
    const int b = unit >> 8, h = (unit >> 6) & 3, c = unit & 63;
    const int row0 = b * TP + 128 * c;
    unsigned char* ws = KWS();
    const bf16* Z = (const bf16*)(ws + WS_Z);
    const f32x2* ROT = (const f32x2*)(ws + WS_ROT);
    bf16* QR = (bf16*)(ws + WS_QR); bf16* KR = (bf16*)(ws + WS_KR);
    LAS unsigned char* LK = F.lds; LAS unsigned char* LV = F.lds + 34816;
    const float lg = ret_lg(h);
    for (int it = tid; it < 1024; it += NTHREADS) {
        const int j = it >> 3, cc = it & 7, d0 = cc * 8;
        const size_t zr = (size_t)(row0 + j) * LDZ + ZC_RQKV + h * 128 + d0;
        f32x4 q1a, q1b, q2a, q2b, k1a, k1b, k2a, k2b;
        unpack8(*(const v4u*)(Z + zr), q1a, q1b); unpack8(*(const v4u*)(Z + zr + 64), q2a, q2b);
        unpack8(*(const v4u*)(Z + zr + 512), k1a, k1b); unpack8(*(const v4u*)(Z + zr + 512 + 64), k2a, k2b);
        const f32x2* rp = ROT + (size_t)(128 * c + j) * 64 + d0;
        const float kd = __expf((float)(127 - j) * lg);
        f32x4 oq1a, oq1b, oq2a, oq2b, ok1a, ok1b, ok2a, ok2b;
#pragma unroll
        for (int e = 0; e < 8; ++e) {
            const f32x2 cs = rp[e];
            const float q1 = e < 4 ? q1a[e & 3] : q1b[e & 3], q2 = e < 4 ? q2a[e & 3] : q2b[e & 3], k1 = e < 4 ? k1a[e & 3] : k1b[e & 3], k2 = e < 4 ? k2a[e & 3] : k2b[e & 3];
            const float rq1 = q1 * cs.x - q2 * cs.y, rq2 = q2 * cs.x + q1 * cs.y, rk1 = (k1 * cs.x - k2 * cs.y) * 0.08838834764831845f, rk2 = (k2 * cs.x + k1 * cs.y) * 0.08838834764831845f;
            if (e < 4) { oq1a[e & 3] = rq1; oq2a[e & 3] = rq2; ok1a[e & 3] = rk1; ok2a[e & 3] = rk2; } else { oq1b[e & 3] = rq1; oq2b[e & 3] = rq2; ok1b[e & 3] = rk1; ok2b[e & 3] = rk2; }
            *(LAS bf16*)(LK + (d0 + e) * 272 + j * 2) = (bf16)f2bf(rk1 * kd); *(LAS bf16*)(LK + (d0 + 64 + e) * 272 + j * 2) = (bf16)f2bf(rk2 * kd);
        }
        const size_t orow = (size_t)(row0 + j) * 512 + h * 128 + d0;
        *(v4u*)(QR + orow) = pack8(oq1a, oq1b); *(v4u*)(QR + orow + 64) = pack8(oq2a, oq2b);
        *(v4u*)(KR + orow) = pack8(ok1a, ok1b); *(v4u*)(KR + orow + 64) = pack8(ok2a, ok2b);
    }
    for (int it = tid; it < 2048; it += NTHREADS) {
        const int j = it >> 4, cc = it & 15;
        const v4u w = *(const v4u*)(Z + (size_t)(row0 + j) * LDZ + ZC_RQKV + 1024 + h * 128 + cc * 8);
        LAS unsigned char* d = LV + (cc * 8) * 272 + j * 2;
        *(LAS bf16*)(d) = (bf16)(w.x & 0xffff); *(LAS bf16*)(d + 272) = (bf16)(w.x >> 16); *(LAS bf16*)(d + 2 * 272) = (bf16)(w.y & 0xffff); *(LAS bf16*)(d + 3 * 272) = (bf16)(w.y >> 16);
        *(LAS bf16*)(d + 4 * 272) = (bf16)(w.z & 0xffff); *(LAS bf16*)(d + 5 * 272) = (bf16)(w.z >> 16); *(LAS bf16*)(d + 6 * 272) = (bf16)(w.w & 0xffff); *(LAS bf16*)(d + 7 * 272) = (bf16)(w.w >> 16);
    }
    __syncthreads();
    float* RKV = (float*)(ws + WS_RKV) + (size_t)unit * 16384;
#pragma unroll
    for (int nt = 0; nt < 8; ++nt) {
        f32x4 acc = (f32x4){0.f, 0.f, 0.f, 0.f};
#pragma unroll
        for (int s = 0; s < 4; ++s) acc = mfma16(ld_frag_l(LK + (16 * wave + rl) * 272 + (32 * s + 8 * quad) * 2), ld_frag_l(LV + (16 * nt + rl) * 272 + (32 * s + 8 * quad) * 2), acc);
#pragma unroll
        for (int i = 0; i < 4; ++i) RKV[(size_t)(16 * wave + 4 * quad + i) * 128 + 16 * nt + rl] = acc[i];
    }
    __syncthreads();
}
DI void sample_rec_unit(Frame& F, int layer, int unit) {
    const int tid = F.tid, lane = F.lane, wave = F.wave;
    const int kind = unit >> 9, s = (unit >> 2) & 127, h = unit & 3;
    const int dv = tid & 127, part = tid >> 7, r0 = MP + 4 * s;
    unsigned char* ws = KWS();
    const bf16* Z = (const bf16*)(ws + WS_Z);
    const float* ZS = (const float*)(ws + WS_ZS);
    LAS float* Lq = (LAS float*)(F.lds); LAS float* Lk = Lq + 512; LAS float* Lv = Lq + 1024; LAS float* red = Lq + 1536; LAS float* Lo = Lq + 2048; LAS float* sc = Lq + 2560;
    float S[32];
    if (kind == 0) {
        if (tid < 384) {
            const int pr = tid >> 7, d = tid & 127, col = pr * 512 + h * 128 + d;
            float xp[7], w[4];
#pragma unroll
            for (int i = 0; i < 3; ++i) xp[i] = KIN(4)[((size_t)(layer * 128 + s) * 3 + i) * 1536 + col];
#pragma unroll
            for (int j = 0; j < 4; ++j) xp[3 + j] = bf2f(Z[(size_t)(r0 + j) * LDZ + ZC_GQKV + col]);
#pragma unroll
            for (int i = 0; i < 4; ++i) w[i] = KIN(15)[(size_t)(layer * 4 + i) * 1536 + col];
            LAS float* dst = pr == 0 ? Lq : pr == 1 ? Lk : Lv;
#pragma unroll
            for (int j = 0; j < 4; ++j) dst[j * 128 + d] = siluf_(w[0] * xp[j] + w[1] * xp[j + 1] + w[2] * xp[j + 2] + w[3] * xp[j + 3]);
        }
        __syncthreads();
        {
            LAS float* vp = (wave < 4 ? Lq : Lk) + (wave & 3) * 128;
            const float a = vp[2 * lane], b = vp[2 * lane + 1];
            const float scl = rsqrtf(wave_sum(a * a + b * b, lane) + EPS) * (wave < 4 ? 0.08838834764831845f : 1.f);
            vp[2 * lane] = a * scl; vp[2 * lane + 1] = b * scl;
        }
        if (tid < 4) {
            const float ga = ZS[(size_t)(r0 + tid) * 32 + 24 + h], gb = ZS[(size_t)(r0 + tid) * 32 + 28 + h];
            sc[tid] = __expf(-__expf(KIN(16)[layer * 4 + h]) * softplusf_(ga + KIN(17)[layer * 4 + h])); sc[4 + tid] = sigmoidf_(gb);
        }
        __syncthreads();
        const float* Sin = KIN(5) + ((size_t)((layer * 128 + s) * 4 + h) * 128 + 32 * part) * 128 + dv;
#pragma unroll
        for (int i = 0; i < 32; ++i) S[i] = Sin[(size_t)i * 128];
#pragma unroll
        for (int j = 0; j < 4; ++j) {
            const float a = sc[j], beta = sc[4 + j];
            float p = 0.f;
#pragma unroll
            for (int i = 0; i < 32; ++i) { S[i] *= a; p += Lk[j * 128 + 32 * part + i] * S[i]; }
            red[part * 128 + dv] = p;
            __syncthreads();
            const float delta = beta * (Lv[j * 128 + dv] - ((red[dv] + red[128 + dv]) + (red[256 + dv] + red[384 + dv])));
            __syncthreads();
            float o = 0.f;
#pragma unroll
            for (int i = 0; i < 32; ++i) { S[i] += Lk[j * 128 + 32 * part + i] * delta; o += Lq[j * 128 + 32 * part + i] * S[i]; }
            red[part * 128 + dv] = o;
            __syncthreads();
            if (part == 0) Lo[j * 128 + dv] = (red[dv] + red[128 + dv]) + (red[256 + dv] + red[384 + dv]);
            __syncthreads();
        }
        float* Sout = KOUT() + O_GSS + ((size_t)((layer * 128 + s) * 4 + h) * 128 + 32 * part) * 128 + dv;
#pragma unroll
        for (int i = 0; i < 32; ++i) Sout[(size_t)i * 128] = S[i];
        ((float*)(ws + WS_OGDN))[(size_t)(r0 + part) * 512 + h * 128 + dv] = Lo[part * 128 + dv];
    } else {
        const f32x2* ROT = (const f32x2*)(ws + WS_ROT);
        if (tid < 384) {
            const int pr = tid >> 7, d = tid & 127;
#pragma unroll
            for (int j = 0; j < 4; ++j) {
                const bf16* zp = Z + (size_t)(r0 + j) * LDZ + ZC_RQKV + pr * 512 + h * 128;
                float v = bf2f(zp[d]);
                if (pr < 2) { const f32x2 cs = ROT[(size_t)(2048 + j) * 64 + (d & 63)]; const float o = bf2f(zp[d ^ 64]);
                    v = (d < 64) ? v * cs.x - o * cs.y : v * cs.x + o * cs.y; if (pr == 1) v *= 0.08838834764831845f; }
                (pr == 0 ? Lq : pr == 1 ? Lk : Lv)[j * 128 + d] = v;
            }
        }
        __syncthreads();
        const float gam = __expf(ret_lg(h));
        const float* Sin = KIN(6) + ((size_t)((layer * 128 + s) * 4 + h) * 128 + 32 * part) * 128 + dv;
#pragma unroll
        for (int i = 0; i < 32; ++i) S[i] = Sin[(size_t)i * 128];
#pragma unroll
        for (int j = 0; j < 4; ++j) {
            const float vv = Lv[j * 128 + dv];
            float o = 0.f;
#pragma unroll
            for (int i = 0; i < 32; ++i) { S[i] = S[i] * gam + Lk[j * 128 + 32 * part + i] * vv; o += Lq[j * 128 + 32 * part + i] * S[i]; }
            red[part * 128 + dv] = o;
            __syncthreads();
            if (part == 0) Lo[j * 128 + dv] = (red[dv] + red[128 + dv]) + (red[256 + dv] + red[384 + dv]);
            __syncthreads();
        }
        float* Sout = KOUT() + O_RSS + ((size_t)((layer * 128 + s) * 4 + h) * 128 + 32 * part) * 128 + dv;
#pragma unroll
        for (int i = 0; i < 32; ++i) Sout[(size_t)i * 128] = S[i];
        if (wave < 4) {
            const int j = wave; const float a = Lo[j * 128 + 2 * lane], b = Lo[j * 128 + 2 * lane + 1];
            const float scl = rsqrtf(wave_sum(a * a + b * b, lane) * (1.f / 128.f) + EPS);
            const bf16* gp = Z + (size_t)(r0 + j) * LDZ + ZC_RG + h * 128 + 2 * lane;
            *(unsigned*)((bf16*)(ws + WS_MIX) + (size_t)(r0 + j) * 1536 + 1024 + h * 128 + 2 * lane) = pk2(a * scl * siluf_(bf2f(gp[0])), b * scl * siluf_(bf2f(gp[1])));
        }
    }
    __syncthreads();
}

DI void gdn_scan_chain(Frame& F, int layer, int bh) {
    int lane = F.lane, wave = F.wave; asm volatile("" : "+v"(lane), "+s"(wave));
    const int tid = wave * 64 + lane, quad = lane >> 4, rl = lane & 15;
    unsigned char* ws = KWS();
    const unsigned char* recb = ws + WS_GREC + (size_t)bh * 128 * GREC;
    LAS unsigned char* L = F.lds;
    constexpr int L_WP = 0, L_QP = 17408, L_KT = 34816, L_UT = 53248, L_QK = 71680;
    f32x4 S[8];
#pragma unroll
    for (int i = 0; i < 8; ++i) S[i] = (f32x4){0.f, 0.f, 0.f, 0.f};
    v4u pf[9]; float egl;
#pragma unroll
    for (int k = 0; k < 9; ++k) pf[k] = *(const v4u*)(recb + (size_t)(tid + 512 * k) * 16);
    egl = *(const float*)(recb + 73728);
    float* OG = (float*)(ws + WS_OGDN);
    const int b = bh >> 2, h = bh & 3;
    for (int c = 0; c < 128; ++c) {
        __syncthreads();
#pragma unroll
        for (int k = 0; k < 9; ++k) {
            const int o = tid * 16 + (k & 1) * 8192;
            const int reg = k >> 1;
            int dst;
            if (reg < 2) dst = (reg == 0 ? L_WP : L_QP) + (o >> 8) * 272 + (o & 255);
            else dst = (reg == 2 ? L_KT : reg == 3 ? L_UT : L_QK) + (o >> 7) * 144 + (o & 127);
            *(LAS v4u*)(L + dst) = pf[k];
        }
        const float eg = egl;
        __syncthreads();
        {
            const unsigned char* rn = recb + (size_t)(c + 1 < 128 ? c + 1 : 127) * GREC;
#pragma unroll
            for (int k = 0; k < 9; ++k) pf[k] = *(const v4u*)(rn + (size_t)(tid + 512 * k) * 16);
            egl = *(const float*)(rn + 73728);
        }
        bf16x8 Sb[4];
#pragma unroll
        for (int s = 0; s < 4; ++s) Sb[s] = pack_frag(S[2 * s], S[2 * s + 1]);
        f32x4 vn[4], O[4];
#pragma unroll
        for (int rt = 0; rt < 4; ++rt) {
            f32x4 wsacc = (f32x4){0.f, 0.f, 0.f, 0.f}, o = wsacc;
#pragma unroll
            for (int s = 0; s < 4; ++s) {
                wsacc = mfma16(ld_frag_l(L + L_WP + (16 * rt + rl) * 272 + (32 * s + 8 * quad) * 2), Sb[s], wsacc);
                o = mfma16(ld_frag_l(L + L_QP + (16 * rt + rl) * 272 + (32 * s + 8 * quad) * 2), Sb[s], o);
            }
            const v2u uw = *(const LAS v2u*)(L + L_UT + (16 * wave + rl) * 144 + (16 * rt + 4 * quad) * 2);
            vn[rt][0] = lo_bf(uw.x) - wsacc[0]; vn[rt][1] = hi_bf(uw.x) - wsacc[1]; vn[rt][2] = lo_bf(uw.y) - wsacc[2]; vn[rt][3] = hi_bf(uw.y) - wsacc[3];
            O[rt] = o;
        }
        bf16x8 Vb[2]; Vb[0] = pack_frag(vn[0], vn[1]); Vb[1] = pack_frag(vn[2], vn[3]);
#pragma unroll
        for (int rt = 0; rt < 4; ++rt) {
#pragma unroll
            for (int s2 = 0; s2 < 2; ++s2) O[rt] = mfma16(ld_frag_l(L + L_QK + (16 * rt + rl) * 144 + (32 * s2 + 8 * quad) * 2), Vb[s2], O[rt]);
            const size_t row = (size_t)b * TP + 64 * c + 16 * rt + 4 * quad;
#pragma unroll
            for (int i = 0; i < 4; ++i) OG[(row + i) * 512 + h * 128 + 16 * wave + rl] = O[rt][i];
        }
#pragma unroll
        for (int kt = 0; kt < 8; ++kt) {
            f32x4 a = S[kt] * eg;
#pragma unroll
            for (int s2 = 0; s2 < 2; ++s2) a = mfma16(ld_frag_l(L + L_KT + (16 * kt + rl) * 144 + (32 * s2 + 8 * quad) * 2), Vb[s2], a);
            S[kt] = a;
        }
    }
    float* So = KOUT() + O_GSP + (size_t)(layer * 8 + bh) * 16384;
#pragma unroll
    for (int kt = 0; kt < 8; ++kt)
#pragma unroll
        for (int i = 0; i < 4; ++i) So[(size_t)(16 * kt + 4 * quad + i) * 128 + 16 * wave + rl] = S[kt][i];
    __syncthreads();
}
DI void ret_scan_part(Frame& F, int layer, int r) {
    int tid = F.tid; asm volatile("" : "+v"(tid));
    const int bh = r >> 2, dv = tid & 127, dk0 = ((r & 3) * 4 + (tid >> 7)) * 8, h = bh & 3;
    unsigned char* ws = KWS();
    const float* RKV = (const float*)(ws + WS_RKV) + (size_t)bh * 64 * 16384;
    bf16* RST = (bf16*)(ws + WS_RST) + (size_t)bh * 64 * 16384;
    const float cdec = __expf(128.f * ret_lg(h));
    float S[8];
#pragma unroll
    for (int i = 0; i < 8; ++i) S[i] = 0.f;
#pragma unroll 4
    for (int c = 0; c < 64; ++c) {
        v4u w; w.x = pk2(S[0], S[1]); w.y = pk2(S[2], S[3]); w.z = pk2(S[4], S[5]); w.w = pk2(S[6], S[7]);
        *(v4u*)(RST + (size_t)c * 16384 + dv * 128 + dk0) = w;
#pragma unroll
        for (int i = 0; i < 8; ++i) S[i] = S[i] * cdec + RKV[(size_t)c * 16384 + (dk0 + i) * 128 + dv];
    }
    float* So = KOUT() + O_RSP + (size_t)(layer * 8 + bh) * 16384;
#pragma unroll
    for (int i = 0; i < 8; ++i) So[(size_t)(dk0 + i) * 128 + dv] = S[i];
}
constexpr float SM_C = 0.125f * 1.4426950408889634f;
struct AttnState { float m, l; f32x4 O[4]; };
DI void attn_reset(AttnState& st) { st.m = -1e30f; st.l = 0.f;
#pragma unroll
    for (int i = 0; i < 4; ++i) st.O[i] = (f32x4){0.f, 0.f, 0.f, 0.f}; }
DI void qk_tile(const LAS unsigned char* Kt, const bf16x8 (&qf)[2], f32x4 (&s)[4], int rl, int quad) {
#pragma unroll
    for (int kt = 0; kt < 4; ++kt) { f32x4 a = (f32x4){0.f, 0.f, 0.f, 0.f};
#pragma unroll
        for (int kk = 0; kk < 2; ++kk) a = mfma16(ld_frag_l(Kt + (16 * kt + rl) * 144 + kk * 64 + quad * 16), qf[kk], a);
        s[kt] = a; }
}
template <class Mask> DI void attn_step(const LAS unsigned char* Kt, const LAS unsigned char* VT, const bf16x8 (&qf)[2], AttnState& st, const Mask& ok, int rl, int quad) {
    f32x4 s[4]; qk_tile(Kt, qf, s, rl, quad);
    float mx = -3e38f;
#pragma unroll
    for (int kt = 0; kt < 4; ++kt)
#pragma unroll
        for (int i = 0; i < 4; ++i) if (ok(16 * kt + 4 * quad + i)) mx = fmaxf(mx, s[kt][i]);
    const int lane = rl + 16 * quad;
    mx = fmaxf(mx, shx<16>(mx, lane)); mx = fmaxf(mx, shx<32>(mx, lane));
    const float mn = fmaxf(st.m, mx);
    const float alpha = exp2f((st.m - mn) * SM_C);
    float ls = 0.f;
#pragma unroll
    for (int kt = 0; kt < 4; ++kt)
#pragma unroll
        for (int i = 0; i < 4; ++i) { const float p = ok(16 * kt + 4 * quad + i) ? exp2f((s[kt][i] - mn) * SM_C) : 0.f; s[kt][i] = p; ls += p; }
    ls += shx<16>(ls, lane); ls += shx<32>(ls, lane);
    st.l = st.l * alpha + ls; st.m = mn;
#pragma unroll
    for (int dt = 0; dt < 4; ++dt) st.O[dt] *= alpha;
#pragma unroll
    for (int ii = 0; ii < 2; ++ii) {
        const bf16x8 pb = pack_frag(s[2 * ii], s[2 * ii + 1]);
#pragma unroll
        for (int dt = 0; dt < 4; ++dt) {
            const LAS unsigned char* vp = VT + (16 * dt + rl) * 144 + (32 * ii + 4 * quad) * 2;
            st.O[dt] = mfma16(mk_frag(*(const LAS v2u*)vp, *(const LAS v2u*)(vp + 32)), pb, st.O[dt]);
        }
    }
}
DI void attn_accum(f32x4 (&Of)[4], const AttnState& st, float gate) {
    const float sc = st.l > 0.f ? gate / st.l : 0.f;
#pragma unroll
    for (int dt = 0; dt < 4; ++dt) Of[dt] += st.O[dt] * sc;
}
DI void vt_write(LAS unsigned char* VT, int d0, int key, const v4u w) {
    LAS unsigned char* d = VT + d0 * 144 + key * 2;
    *(LAS bf16*)(d) = (bf16)(w.x & 0xffff); *(LAS bf16*)(d + 144) = (bf16)(w.x >> 16); *(LAS bf16*)(d + 2 * 144) = (bf16)(w.y & 0xffff); *(LAS bf16*)(d + 3 * 144) = (bf16)(w.y >> 16);
    *(LAS bf16*)(d + 4 * 144) = (bf16)(w.z & 0xffff); *(LAS bf16*)(d + 5 * 144) = (bf16)(w.z >> 16); *(LAS bf16*)(d + 6 * 144) = (bf16)(w.w & 0xffff); *(LAS bf16*)(d + 7 * 144) = (bf16)(w.w >> 16);
}
DI void stage_wg(LAS unsigned char* Kt, LAS unsigned char* VT, const bf16* kb, const bf16* vb, size_t stride, int tid, bool do_v) {
    const int key = tid >> 3, ch = tid & 7;
    *(LAS v4u*)(Kt + key * 144 + ch * 16) = *(const v4u*)(kb + key * stride + ch * 8);
    if (do_v) vt_write(VT, ch * 8, key, *(const v4u*)(vb + key * stride + ch * 8));
}
DI unsigned score_key(float s, bool valid, int idx) { return valid ? (((__float_as_uint(s) | 0x80000000u) & ~127u) | (unsigned)(127 - idx)) : 0u; }
DI int key_rank(const LAS unsigned* K, int ng4, unsigned k) {
    int r = 0;
    for (int g = 0; g < ng4; ++g) { const v4u v = *(const LAS v4u*)(K + 4 * g); r += (v.x > k) + (v.y > k) + (v.z > k) + (v.w > k); }
    return r;
}
DI int top16(float v0, float v1, int lane) {
    int sel = 0;
#pragma unroll 1
    for (int r = 0; r < 16; ++r) {
        float bv; int bi;
        if (v0 >= v1) { bv = v0; bi = lane; } else { bv = v1; bi = lane + 64; }
#define T16_STEP(M) { const float ov = shx<M>(bv, lane); const int oi = shxi<M>(bi, lane); const bool take = (ov > bv) || (ov == bv && oi < bi); bv = take ? ov : bv; bi = take ? oi : bi; }
        T16_STEP(32) T16_STEP(16) T16_STEP(8) T16_STEP(4) T16_STEP(2) T16_STEP(1)
#undef T16_STEP
        const bool h0 = (bi == lane), h1 = (bi == lane + 64);
        v0 = h0 ? -3e38f : v0; v1 = h1 ? -3e38f : v1; sel |= (h0 ? 1 : 0) | (h1 ? 2 : 0);
    }
    return sel;
}

typedef short v4i16_t __attribute__((ext_vector_type(4)));
DI s16x4 vtr(const LAS unsigned char* p) { return __builtin_bit_cast(s16x4, __builtin_amdgcn_ds_read_tr16_b64_v4i16((LAS v4i16_t*)p)); }
DI bf16x8 cat4(s16x4 a, s16x4 b) { bf16x8 r; r[0] = a[0]; r[1] = a[1]; r[2] = a[2]; r[3] = a[3]; r[4] = b[0]; r[5] = b[1]; r[6] = b[2]; r[7] = b[3]; return r; }
DI void attn_step3(const LAS unsigned char* Kt, const LAS unsigned char* Vt, const bf16x8 (&qf)[2], AttnState& st, int lo, int hi, bool active, int rl, int quad) {
    active = active && (hi >= lo);
    if (!__any(active)) return;
    f32x4 s[4]; qk_tile(Kt, qf, s, rl, quad);
    const int lane = rl + 16 * quad;
    const bool full = __all((lo <= 0 && hi >= 63) || !active);
    const int kq = 4 * quad - lo; const unsigned rng = (unsigned)(hi - lo);
    float lm;
    if (full) {
        const float a0 = fmaxf(fmaxf(s[0][0], s[0][1]), fmaxf(s[0][2], s[0][3])), a1 = fmaxf(fmaxf(s[1][0], s[1][1]), fmaxf(s[1][2], s[1][3]));
        const float a2 = fmaxf(fmaxf(s[2][0], s[2][1]), fmaxf(s[2][2], s[2][3])), a3 = fmaxf(fmaxf(s[3][0], s[3][1]), fmaxf(s[3][2], s[3][3]));
        lm = fmaxf(fmaxf(a0, a1), fmaxf(a2, a3));
    } else {
        lm = -3e38f;
#pragma unroll
        for (int kt = 0; kt < 4; ++kt)
#pragma unroll
            for (int i = 0; i < 4; ++i) lm = ((unsigned)(kq + 16 * kt + i) <= rng) ? fmaxf(lm, s[kt][i]) : lm;
    }
    lm = active ? lm : -3e38f;
    if (__any(lm > st.m + 320.f)) {
        float mx = fmaxf(lm, shx<16>(lm, lane)); mx = fmaxf(mx, shx<32>(mx, lane));
        const float mn = fmaxf(st.m, mx);
        const float alpha = __builtin_amdgcn_exp2f((st.m - mn) * SM_C);
        st.l *= alpha; st.m = mn;
#pragma unroll
        for (int dt = 0; dt < 4; ++dt) st.O[dt] *= alpha;
    }
    const float mc = active ? st.m * SM_C : __builtin_inff();
    float ls = 0.f;
    if (full) {
#pragma unroll
        for (int kt = 0; kt < 4; ++kt)
#pragma unroll
            for (int i = 0; i < 4; ++i) { const float p = __builtin_amdgcn_exp2f(s[kt][i] * SM_C - mc); s[kt][i] = p; ls += p; }
    } else {
#pragma unroll
        for (int kt = 0; kt < 4; ++kt)
#pragma unroll
            for (int i = 0; i < 4; ++i) { const float p = ((unsigned)(kq + 16 * kt + i) <= rng) ? __builtin_amdgcn_exp2f(s[kt][i] * SM_C - mc) : 0.f; s[kt][i] = p; ls += p; }
    }
    st.l += ls;
#pragma unroll
    for (int ii = 0; ii < 2; ++ii) {
        const bf16x8 pb = pack_frag(s[2 * ii], s[2 * ii + 1]);
#pragma unroll
        for (int dt = 0; dt < 4; ++dt) {
            const LAS unsigned char* vp = Vt + (32 * ii + 4 * quad + (rl >> 2)) * 144 + (16 * dt + 4 * (rl & 3)) * 2;
            st.O[dt] = mfma16(cat4(vtr(vp), vtr(vp + 16 * 144)), pb, st.O[dt]);
        }
    }
}
DI float attn_rowsum(const AttnState& st, int lane) { float l = st.l; l += shx<16>(l, lane); l += shx<32>(l, lane); return l; }
DI void attn_accum3(f32x4 (&Of)[4], const AttnState& st, float gate, int lane) {
    const float l = attn_rowsum(st, lane);
    const float sc = l > 0.f ? gate / l : 0.f;
#pragma unroll
    for (int dt = 0; dt < 4; ++dt) Of[dt] += st.O[dt] * sc;
}
DI float tile_max(const f32x4 (&s)[4], bool full, int kq, unsigned rng) {
    float lm;
    if (full) {
        const float a0 = fmaxf(fmaxf(s[0][0], s[0][1]), fmaxf(s[0][2], s[0][3])), a1 = fmaxf(fmaxf(s[1][0], s[1][1]), fmaxf(s[1][2], s[1][3]));
        const float a2 = fmaxf(fmaxf(s[2][0], s[2][1]), fmaxf(s[2][2], s[2][3])), a3 = fmaxf(fmaxf(s[3][0], s[3][1]), fmaxf(s[3][2], s[3][3]));
        lm = fmaxf(fmaxf(a0, a1), fmaxf(a2, a3));
    } else {
        lm = -3e38f;
#pragma unroll
        for (int kt = 0; kt < 4; ++kt)
#pragma unroll
            for (int i = 0; i < 4; ++i) lm = ((unsigned)(kq + 16 * kt + i) <= rng) ? fmaxf(lm, s[kt][i]) : lm;
    }
    return lm;
}
DI float tile_exp(f32x4 (&s)[4], bool full, int kq, unsigned rng, float mc) {
    float ls = 0.f;
    if (full) {
#pragma unroll
        for (int kt = 0; kt < 4; ++kt)
#pragma unroll
            for (int i = 0; i < 4; ++i) { const float p = __builtin_amdgcn_exp2f(s[kt][i] * SM_C - mc); s[kt][i] = p; ls += p; }
    } else {
#pragma unroll
        for (int kt = 0; kt < 4; ++kt)
#pragma unroll
            for (int i = 0; i < 4; ++i) { const float p = ((unsigned)(kq + 16 * kt + i) <= rng) ? __builtin_amdgcn_exp2f(s[kt][i] * SM_C - mc) : 0.f; s[kt][i] = p; ls += p; }
    }
    return ls;
}
DI void tile_pv(const LAS unsigned char* Vt, const f32x4 (&s)[4], f32x4 (&O)[4], int rl, int quad) {
#pragma unroll
    for (int ii = 0; ii < 2; ++ii) {
        const bf16x8 pb = pack_frag(s[2 * ii], s[2 * ii + 1]);
#pragma unroll
        for (int dt = 0; dt < 4; ++dt) {
            const LAS unsigned char* vp = Vt + (32 * ii + 4 * quad + (rl >> 2)) * 144 + (16 * dt + 4 * (rl & 3)) * 2;
            O[dt] = mfma16(cat4(vtr(vp), vtr(vp + 16 * 144)), pb, O[dt]);
        }
    }
}
DI void attn_step_pair(const LAS unsigned char* K0, const LAS unsigned char* V0, int lo0, int hi0, bool act0,
                       const LAS unsigned char* K1, const LAS unsigned char* V1, int lo1, int hi1, bool act1,
                       const bf16x8 (&qf)[2], AttnState& st, int rl, int quad) {
    act0 = act0 && (hi0 >= lo0); act1 = act1 && (hi1 >= lo1);
    const bool any0 = __any(act0), any1 = __any(act1);
    if (!any0 && !any1) return;
    const int lane = rl + 16 * quad;
    f32x4 s0[4], s1[4];
    if (any0) qk_tile(K0, qf, s0, rl, quad);
    if (any1) qk_tile(K1, qf, s1, rl, quad);
    const bool full0 = __all((lo0 <= 0 && hi0 >= 63) || !act0), full1 = __all((lo1 <= 0 && hi1 >= 63) || !act1);
    const int kq0 = 4 * quad - lo0, kq1 = 4 * quad - lo1; const unsigned rng0 = (unsigned)(hi0 - lo0), rng1 = (unsigned)(hi1 - lo1);
    float lm = -3e38f;
    if (any0) { const float a = tile_max(s0, full0, kq0, rng0); lm = act0 ? a : lm; }
    if (any1) { const float a = tile_max(s1, full1, kq1, rng1); lm = act1 ? fmaxf(lm, a) : lm; }
    if (__any(lm > st.m + 320.f)) {
        float mx = fmaxf(lm, shx<16>(lm, lane)); mx = fmaxf(mx, shx<32>(mx, lane));
        const float mn = fmaxf(st.m, mx);
        const float alpha = __builtin_amdgcn_exp2f((st.m - mn) * SM_C);
        st.l *= alpha; st.m = mn;
#pragma unroll
        for (int dt = 0; dt < 4; ++dt) st.O[dt] *= alpha;
    }
    const float mcb = st.m * SM_C;
    if (any0) st.l += tile_exp(s0, full0, kq0, rng0, act0 ? mcb : __builtin_inff());
    if (any1) st.l += tile_exp(s1, full1, kq1, rng1, act1 ? mcb : __builtin_inff());
    if (any0) tile_pv(V0, s0, st.O, rl, quad);
    if (any1) tile_pv(V1, s1, st.O, rl, quad);
}
DI void nsa_prompt_unit(Frame& F, int layer, int unit) {
    int lane = F.lane, wave = F.wave; asm volatile("" : "+v"(lane), "+s"(wave));
    const int tid = wave * 64 + lane, quad = lane >> 4, rl = lane & 15;
    const int b = unit >> 9, g = (unit >> 8) & 1, tt = unit & 255, t0 = 32 * tt;
    unsigned char* ws = KWS();
    const bf16* Z = (const bf16*)(ws + WS_Z);
    const float* ZS = (const float*)(ws + WS_ZS);
    LAS unsigned char* TB = F.lds;
    LAS float* AIMP = (LAS float*)(F.lds + 73728);
    LAS unsigned* SEL = (LAS unsigned*)(F.lds + 139264);
    const int tk = 4 * wave + (rl >> 2), t = t0 + tk, head = 4 * g + (rl & 3);
    const size_t row = (size_t)b * TP + t;
    bf16x8 qf[2];
    qf[0] = ld_frag_g(Z + row * LDZ + ZC_Q + head * 64 + quad * 8); qf[1] = ld_frag_g(Z + row * LDZ + ZC_Q + head * 64 + 32 + quad * 8);
    const float gc = sigmoidf_(ZS[row * 32 + head * 3]), gs = sigmoidf_(ZS[row * 32 + head * 3 + 1]), gw = sigmoidf_(ZS[row * 32 + head * 3 + 2]);
    f32x4 Of[4];
#pragma unroll
    for (int i = 0; i < 4; ++i) Of[i] = (f32x4){0.f, 0.f, 0.f, 0.f};
    AttnState st;
    const int nct = (t0 >> 10) + 1;
    const bf16* KC = (const bf16*)(ws + WS_KC) + ((size_t)(0 * 2 + b) * 512 * 2 + g) * 64;
    const bf16* VC = (const bf16*)(ws + WS_KC) + ((size_t)(1 * 2 + b) * 512 * 2 + g) * 64;
    const bf16* Zb = Z + (size_t)b * TP * LDZ + g * 64;
    const int skey = tid >> 3, sch = tid & 7;
    const int wlo = (t0 - 511 > 0 ? t0 - 511 : 0) >> 6, nwin = ((t0 + 31) >> 6) - wlo + 1;
    const int nwe = (nwin + 1) & ~1, nce = (nct + 1) & ~1;
    v4u rkA, rvA, rkB, rvB;
#define COMMIT(slot, rk, rv) do { LAS unsigned char* d_ = TB + (slot) * 18432 + skey * 144 + sch * 16; *(LAS v4u*)d_ = rk; *(LAS v4u*)(d_ + 9216) = rv; } while (0)
    const int n1 = nwe + 2 * nce;
#define SEG1_VALID(i) ((i) < nwe ? (i) < nwin : (((i) - nwe) < nce ? ((i) - nwe) < nct : ((i) - nwe - nce) < nct))
#define SEG1_ISSUE(i, rk, rv) do { int i_ = (i); i_ = i_ < n1 ? i_ : n1 - 1; const bool win_ = i_ < nwe; int wt_ = wlo + (i_ < nwin ? i_ : nwin - 1); int jt_ = (i_ - nwe) % nce; jt_ = jt_ < nct ? jt_ : nct - 1; jt_ = jt_ < 0 ? 0 : jt_; \
        const bf16* pk_ = win_ ? Zb + (size_t)(64 * wt_ + skey) * LDZ + sch * 8 + ZC_KW : KC + (size_t)(64 * jt_ + skey) * 128 + sch * 8; \
        const bf16* pv_ = win_ ? Zb + (size_t)(64 * wt_ + skey) * LDZ + sch * 8 + ZC_VW : VC + (size_t)(64 * jt_ + skey) * 128 + sch * 8; \
        rk = *(const v4u*)pk_; rv = *(const v4u*)pv_; } while (0)
    attn_reset(st);
    float mfin = 0.f, il = 0.f;
    SEG1_ISSUE(0, rkA, rvA); SEG1_ISSUE(1, rkB, rvB);
    COMMIT(0, rkA, rvA); COMMIT(1, rkB, rvB);
    SEG1_ISSUE(2, rkA, rvA); SEG1_ISSUE(3, rkB, rvB);
    __syncthreads();
    for (int i = 0; i < n1; i += 2) {
        const LAS unsigned char* K0 = TB + (i & 3) * 18432; const LAS unsigned char* K1 = TB + ((i + 1) & 3) * 18432;
        if (i < nwe) {
            const int kb0 = 64 * (wlo + i), kb1 = kb0 + 64;
            attn_step_pair(K0, K0 + 9216, t - 511 - kb0, t - kb0, true, K1, K1 + 9216, t - 511 - kb1, t - kb1, (i + 1) < nwin, qf, st, rl, quad);
            if (i + 2 == nwe) { attn_accum3(Of, st, gw, lane); attn_reset(st); }
        } else if (i < nwe + nce) {
            const int nb0 = 64 * (i - nwe), nb1 = nb0 + 64;
            attn_step_pair(K0, K0 + 9216, 0, ((t - 31) >> 4) - nb0, true, K1, K1 + 9216, 0, ((t - 31) >> 4) - nb1, (i + 1 - nwe) < nct, qf, st, rl, quad);
            if (i + 2 == nwe + nce) { attn_accum3(Of, st, gc, lane); mfin = st.m * SM_C; const float lt_ = attn_rowsum(st, lane); il = lt_ > 0.f ? 1.f / lt_ : 0.f; }
        } else {
#pragma unroll
            for (int e2 = 0; e2 < 2; ++e2) {
                const int jt = i + e2 - nwe - nce;
                if (jt < nct) {
                    f32x4 s[4]; qk_tile(e2 ? K1 : K0, qf, s, rl, quad);
#pragma unroll
                    for (int kt = 0; kt < 4; ++kt)
#pragma unroll
                        for (int e = 0; e < 4; ++e) {
                            const int n = 64 * jt + 16 * kt + 4 * quad + e;
                            float p = (16 * n + 31 <= t) ? __builtin_amdgcn_exp2f(s[kt][e] * SM_C - mfin) * il : 0.f;
                            p += shx<1>(p, lane); p += shx<2>(p, lane);
                            if ((rl & 3) == 0) AIMP[tk * 512 + n] = p;
                        }
                }
            }
        }
        if (i + 2 < n1) { if (SEG1_VALID(i + 2)) COMMIT((i + 2) & 3, rkA, rvA); if (SEG1_VALID(i + 3)) COMMIT((i + 3) & 3, rkB, rvB); }
        __syncthreads();
        SEG1_ISSUE(i + 4, rkA, rvA); SEG1_ISSUE(i + 5, rkB, rvB);
    }
    {
        const int nav = nct * 64;
        LAS unsigned* KS = (LAS unsigned*)(TB + wave * 2048);
#pragma unroll
        for (int q = 0; q < 4; ++q) {
            const int tq = 4 * wave + q, cur = (t0 + tq) >> 6;
#pragma unroll
            for (int e = 0; e < 2; ++e) {
                const int sblk = lane + 64 * e;
                float imp = 0.f;
#pragma unroll
                for (int d = -1; d <= 3; ++d) { const int n = 4 * sblk + d; if (n >= 0 && n < nav) imp += AIMP[tq * 512 + n]; }
                const bool valid = sblk <= cur, forced = (sblk == 0) || (sblk == cur) || (sblk == cur - 1);
                KS[q * 128 + sblk] = score_key(imp + (forced ? 1000.f : 0.f), valid, sblk);
            }
        }
        asm volatile("" ::: "memory");
#pragma unroll
        for (int q = 0; q < 4; ++q) {
            const int tq = 4 * wave + q, cur = (t0 + tq) >> 6, ng4 = (cur >> 2) + 1;
            const unsigned k0 = KS[q * 128 + lane], k1 = KS[q * 128 + 64 + lane];
            const bool s0 = (lane <= cur) && key_rank(KS + q * 128, ng4, k0) < 16, s1 = (lane + 64 <= cur) && key_rank(KS + q * 128, ng4, k1) < 16;
            const unsigned long long m0 = __ballot(s0), m1 = __ballot(s1);
            if (lane == 0) { SEL[tq * 4 + 0] = (unsigned)m0; SEL[tq * 4 + 1] = (unsigned)(m0 >> 32); SEL[tq * 4 + 2] = (unsigned)m1; SEL[tq * 4 + 3] = (unsigned)(m1 >> 32); }
        }
    }
    __syncthreads();
    unsigned un[4], my[4], wv[4];
#pragma unroll
    for (int w = 0; w < 4; ++w) { unsigned v = (lane < 32) ? SEL[lane * 4 + w] : 0u;
        v |= (unsigned)shxi<1>((int)v, lane); v |= (unsigned)shxi<2>((int)v, lane); v |= (unsigned)shxi<4>((int)v, lane); v |= (unsigned)shxi<8>((int)v, lane); v |= (unsigned)shxi<16>((int)v, lane); v |= (unsigned)shxi<32>((int)v, lane);
        un[w] = __builtin_amdgcn_readfirstlane(v); my[w] = SEL[tk * 4 + w];
        wv[w] = SEL[(4 * wave) * 4 + w] | SEL[(4 * wave + 1) * 4 + w] | SEL[(4 * wave + 2) * 4 + w] | SEL[(4 * wave + 3) * 4 + w]; wv[w] = __builtin_amdgcn_readfirstlane(wv[w]); }
    attn_reset(st);
    {
        unsigned w0 = un[0], w1 = un[1], w2 = un[2], w3 = un[3];
#define NEXT_BLK(dst) do { if (w0) { dst = __builtin_ctz(w0); w0 &= w0 - 1u; } else if (w1) { dst = 32 + __builtin_ctz(w1); w1 &= w1 - 1u; } else if (w2) { dst = 64 + __builtin_ctz(w2); w2 &= w2 - 1u; } \
        else if (w3) { dst = 96 + __builtin_ctz(w3); w3 &= w3 - 1u; } else dst = -1; } while (0)
#define SEG2_ISSUE(blk_, rk, rv) do { const int b_ = (blk_) >= 0 ? (blk_) : 0; const bf16* p_ = Zb + (size_t)(64 * b_ + skey) * LDZ + sch * 8; rk = *(const v4u*)(p_ + ZC_KS); rv = *(const v4u*)(p_ + ZC_VS); } while (0)
#define BLK_WORD(arr, blk_) (((blk_) >> 5) == 0 ? arr[0] : ((blk_) >> 5) == 1 ? arr[1] : ((blk_) >> 5) == 2 ? arr[2] : arr[3])
        int c0, c1, n0, n1b, m0, m1;
        NEXT_BLK(c0); NEXT_BLK(c1); NEXT_BLK(n0); NEXT_BLK(n1b);
        SEG2_ISSUE(c0, rkA, rvA); SEG2_ISSUE(c1, rkB, rvB);
        COMMIT(0, rkA, rvA); if (c1 >= 0) COMMIT(1, rkB, rvB);
        SEG2_ISSUE(n0, rkA, rvA); SEG2_ISSUE(n1b, rkB, rvB);
        __syncthreads();
        int i = 0;
        while (c0 >= 0) {
            NEXT_BLK(m0); NEXT_BLK(m1);
            const LAS unsigned char* K0 = TB + (i & 3) * 18432; const LAS unsigned char* K1 = TB + ((i + 1) & 3) * 18432;
            const int cc1 = c1 >= 0 ? c1 : 0;
            const bool need0 = (BLK_WORD(wv, c0) >> (c0 & 31)) & 1u, need1 = (c1 >= 0) && ((BLK_WORD(wv, cc1) >> (cc1 & 31)) & 1u);
            const bool mine0 = need0 && ((BLK_WORD(my, c0) >> (c0 & 31)) & 1u), mine1 = need1 && ((BLK_WORD(my, cc1) >> (cc1 & 31)) & 1u);
            attn_step_pair(K0, K0 + 9216, 0, t - 64 * c0, mine0, K1, K1 + 9216, 0, t - 64 * cc1, mine1, qf, st, rl, quad);
            if (n0 >= 0) COMMIT((i + 2) & 3, rkA, rvA); if (n1b >= 0) COMMIT((i + 3) & 3, rkB, rvB);
            __syncthreads();
            SEG2_ISSUE(m0, rkA, rvA); SEG2_ISSUE(m1, rkB, rvB);
            c0 = n0; c1 = n1b; n0 = m0; n1b = m1; i += 2;
        }
    }
    attn_accum3(Of, st, gs, lane);
#undef SEG1_ISSUE
#undef SEG1_VALID
#undef SEG2_ISSUE
#undef BLK_WORD
#undef COMMIT
#undef NEXT_BLK
    bf16* MIX = (bf16*)(ws + WS_MIX) + row * 1536 + head * 64;
#pragma unroll
    for (int dt = 0; dt < 4; ++dt) { v2u w; w.x = pk2(Of[dt][0], Of[dt][1]); w.y = pk2(Of[dt][2], Of[dt][3]); *(v2u*)(MIX + 16 * dt + 4 * quad) = w; }
    __syncthreads();
}

#define CB() asm volatile("" ::: "memory")
DI void stage_wave_f32(LAS unsigned char* Kt, LAS unsigned char* Vt, const float* kb, const float* vb, size_t stride, int lane) {
    const int k0 = lane >> 3, ch = lane & 7;
#pragma unroll
    for (int h = 0; h < 4; ++h) {
        const float* src = (h < 2 ? kb : vb); LAS unsigned char* dst = (h < 2 ? Kt : Vt); const int r0 = (h & 1) * 32;
        f32x4 a[4][2];
#pragma unroll
        for (int it = 0; it < 4; ++it) { const float* kp = src + (size_t)(r0 + it * 8 + k0) * stride + ch * 8; a[it][0] = *(const f32x4*)kp; a[it][1] = *(const f32x4*)(kp + 4); }
#pragma unroll
        for (int it = 0; it < 4; ++it) *(LAS v4u*)(dst + (r0 + it * 8 + k0) * 144 + ch * 16) = pack8(a[it][0], a[it][1]);
        asm volatile("" ::: "memory");
    }
}
DI void stage_wave_b16(LAS unsigned char* Kt, LAS unsigned char* Vt, const bf16* kb, const bf16* vb, size_t stride, int nvalid, int lane, bool do_v) {
    const int k0 = lane >> 3, ch = lane & 7;
    const v4u z = (v4u){0u, 0u, 0u, 0u};
#pragma unroll
    for (int it = 0; it < 8; ++it) {
        const int key = it * 8 + k0; const bool v = key < nvalid;
        *(LAS v4u*)(Kt + key * 144 + ch * 16) = v ? *(const v4u*)(kb + key * stride + ch * 8) : z;
        if (do_v) *(LAS v4u*)(Vt + key * 144 + ch * 16) = v ? *(const v4u*)(vb + key * stride + ch * 8) : z;
    }
}
DI void nsa_sample_unit(Frame& F, int layer, int s) {
    int lane = F.lane, wave = F.wave; asm volatile("" : "+v"(lane), "+s"(wave));
    const int quad = lane >> 4, rl = lane & 15;
    const int g = wave & 1, q4 = wave >> 1;
    unsigned char* ws = KWS();
    const bf16* Z = (const bf16*)(ws + WS_Z);
    const float* ZS = (const float*)(ws + WS_ZS);
    LAS unsigned char* Kt = F.lds + wave * 18432; LAS unsigned char* Vt = Kt + 9216;
    LAS float* AIMP = (LAS float*)Vt;
    const int j = rl >> 2, head = 4 * g + (rl & 3), qpos = 2048 + j;
    const size_t row = (size_t)MP + 4 * s + j;
    bf16x8 qf[2];
    qf[0] = ld_frag_g(Z + row * LDZ + ZC_Q + head * 64 + quad * 8); qf[1] = ld_frag_g(Z + row * LDZ + ZC_Q + head * 64 + 32 + quad * 8);
    const float gc = sigmoidf_(ZS[row * 32 + head * 3]), gs = sigmoidf_(ZS[row * 32 + head * 3 + 1]), gw = sigmoidf_(ZS[row * 32 + head * 3 + 2]);
    f32x4 Of[4];
#pragma unroll
    for (int i = 0; i < 4; ++i) Of[i] = (f32x4){0.f, 0.f, 0.f, 0.f};
    AttnState st;
    const bf16* KC = (const bf16*)(ws + WS_KCS) + ((size_t)(0 * 128 + s) * 128 * 2 + g) * 64;
    const bf16* VC = (const bf16*)(ws + WS_KCS) + ((size_t)(1 * 128 + s) * 128 * 2 + g) * 64;
    attn_reset(st);
#pragma unroll 1
    for (int jt = 0; jt < 2; ++jt) {
        stage_wave_b16(Kt, Vt, KC + (size_t)64 * jt * 128, VC + (size_t)64 * jt * 128, 128, 64, lane, true); CB();
        attn_step3(Kt, Vt, qf, st, 0, 126 - 64 * jt, true, rl, quad); CB();
    }
    attn_accum3(Of, st, q4 == 0 ? gc : 0.f, lane);
    {
        const float mfin = st.m * SM_C, lt = attn_rowsum(st, lane), il = lt > 0.f ? 1.f / lt : 0.f;
#pragma unroll 1
        for (int jt = 0; jt < 2; ++jt) {
            stage_wave_b16(Kt, Vt, KC + (size_t)64 * jt * 128, VC, 128, 64, lane, false); CB();
            f32x4 sv[4]; qk_tile(Kt, qf, sv, rl, quad); CB();
#pragma unroll
            for (int kt = 0; kt < 4; ++kt)
#pragma unroll
                for (int i = 0; i < 4; ++i) {
                    const int n = 64 * jt + 16 * kt + 4 * quad + i;
                    float p = (n <= 126) ? __builtin_amdgcn_exp2f(sv[kt][i] * SM_C - mfin) * il : 0.f;
                    p += shx<1>(p, lane); p += shx<2>(p, lane);
                    if ((rl & 3) == 0) AIMP[j * 128 + n] = p;
                }
        }
    }
    CB();
    unsigned long long msk[4];
    {
        unsigned keys[4];
#pragma unroll
        for (int q = 0; q < 4; ++q) {
            float imp = 0.f;
#pragma unroll
            for (int d = -1; d <= 3; ++d) { const int n = 4 * lane + d; if (n >= 0 && n <= 126 && lane < 33) imp += AIMP[q * 128 + n]; }
            const bool forced = (lane == 0) || (lane == 32) || (lane == 31);
            keys[q] = score_key(imp + (forced ? 1000.f : 0.f), lane < 33, lane);
        }
        CB();
        LAS unsigned* KS = (LAS unsigned*)Kt;
#pragma unroll
        for (int q = 0; q < 4; ++q) KS[q * 64 + lane] = keys[q];
        CB();
#pragma unroll
        for (int q = 0; q < 4; ++q) msk[q] = __ballot(lane < 33 && key_rank(KS + q * 64, 9, keys[q]) < 16);
    }
    CB();
    const unsigned long long un = msk[0] | msk[1] | msk[2] | msk[3];
    const unsigned long long mym = j == 0 ? msk[0] : j == 1 ? msk[1] : j == 2 ? msk[2] : msk[3];
    const int* pt = (const int*)KIN(7);
    AttnState sw;
    attn_reset(st); attn_reset(sw);
    {
        unsigned long long word = un; int idx = 0;
        while (word) {
            const int blk = __builtin_ctzll(word); word &= word - 1ull;
            if ((idx++ & 3) != q4) continue;
            if (blk < 32) {
                const int phys = pt[s * 16 + (blk >> 1)];
                const float* base = KIN(2) + ((size_t)(layer * 2560 + phys) * 128 + (blk & 1) * 64) * 512 + g * 64;
                stage_wave_f32(Kt, Vt, base + 256, base + 384, 512, lane); CB();
            } else {
                stage_wave_b16(Kt, Vt, Z + (size_t)(MP + 4 * s) * LDZ + ZC_KS + g * 64, Z + (size_t)(MP + 4 * s) * LDZ + ZC_VS + g * 64, LDZ, 4, lane, true); CB();
            }
            attn_step3(Kt, Vt, qf, st, 0, qpos - 64 * blk, (mym >> blk) & 1ull, rl, quad); CB();
        }
#pragma unroll 1
        for (int jt = 0; jt < 9; ++jt) {
            if ((idx++ & 3) != q4) continue;
            if (jt < 8) { const float* base = KIN(3) + ((size_t)(layer * 128 + s) * 512 + 64 * jt) * 256 + g * 64; stage_wave_f32(Kt, Vt, base, base + 128, 256, lane); CB(); }
            else { stage_wave_b16(Kt, Vt, Z + (size_t)(MP + 4 * s) * LDZ + ZC_KW + g * 64, Z + (size_t)(MP + 4 * s) * LDZ + ZC_VW + g * 64, LDZ, 4, lane, true); CB(); }
            attn_step3(Kt, Vt, qf, sw, j + 1 - 64 * jt, 512 + j - 64 * jt, true, rl, quad); CB();
        }
    }
    int lane2 = lane; asm volatile("" : "+v"(lane2));
    LAS float* X = (LAS float*)(F.lds + wave * 18432);
    {
        const float ls = attn_rowsum(st, lane), lw = attn_rowsum(sw, lane);
        X[0 * 64 + lane2] = st.m; X[1 * 64 + lane2] = ls; X[18 * 64 + lane2] = sw.m; X[19 * 64 + lane2] = lw;
#pragma unroll
        for (int dt = 0; dt < 4; ++dt)
#pragma unroll
            for (int e = 0; e < 4; ++e) { X[(2 + 4 * dt + e) * 64 + lane2] = st.O[dt][e]; X[(20 + 4 * dt + e) * 64 + lane2] = sw.O[dt][e]; }
    }
    __syncthreads();
    if (q4 == 0) {
#pragma unroll
        for (int br = 0; br < 2; ++br) {
            float m[4], l[4];
#pragma unroll
            for (int q = 0; q < 4; ++q) { const LAS float* Y = (const LAS float*)(F.lds + (2 * q + g) * 18432) + br * 18 * 64; m[q] = Y[lane2]; l[q] = Y[64 + lane2]; }
            const float mm = fmaxf(fmaxf(m[0], m[1]), fmaxf(m[2], m[3]));
            float w[4], lt = 0.f;
#pragma unroll
            for (int q = 0; q < 4; ++q) { w[q] = __builtin_amdgcn_exp2f((m[q] - mm) * SM_C); lt += l[q] * w[q]; }
            const float gate = br == 0 ? gs : gw;
            const float sc = lt > 0.f ? gate / lt : 0.f;
#pragma unroll
            for (int q = 0; q < 4; ++q) { const LAS float* Y = (const LAS float*)(F.lds + (2 * q + g) * 18432) + br * 18 * 64; const float wq = w[q] * sc;
#pragma unroll
                for (int dt = 0; dt < 4; ++dt)
#pragma unroll
                    for (int e = 0; e < 4; ++e) Of[dt][e] += Y[(2 + 4 * dt + e) * 64 + lane2] * wq; }
        }
        bf16* MIX = (bf16*)(ws + WS_MIX) + row * 1536 + head * 64;
#pragma unroll
        for (int dt = 0; dt < 4; ++dt) { v2u w2; w2.x = pk2(Of[dt][0], Of[dt][1]); w2.y = pk2(Of[dt][2], Of[dt][3]); *(v2u*)(MIX + 16 * dt + 4 * quad) = w2; }
    }
    __syncthreads();
}
DI void ret_out_unit(Frame& F, int layer, int unit) {
    const int tid = F.tid, lane = F.lane, wave = F.wave, quad = lane >> 4, rl = lane & 15;
    const int b = unit >> 8, h = (unit >> 6) & 3, c = unit & 63;
    const int row0 = b * TP + 128 * c;
    unsigned char* ws = KWS();
    const bf16* Z = (const bf16*)(ws + WS_Z);
    const bf16* QR = (const bf16*)(ws + WS_QR); const bf16* KR = (const bf16*)(ws + WS_KR);
    const bf16* RST = (const bf16*)(ws + WS_RST) + (size_t)unit * 16384;
    LAS unsigned char* LQ = F.lds; LAS unsigned char* LK = F.lds + 34816; LAS unsigned char* LV = F.lds + 69632; LAS unsigned char* LS = F.lds + 104448;
    for (int it = tid; it < 2048; it += NTHREADS) {
        const int j = it >> 4, cc = it & 15;
        *(LAS v4u*)(LQ + j * 272 + cc * 16) = *(const v4u*)(QR + (size_t)(row0 + j) * 512 + h * 128 + cc * 8);
        *(LAS v4u*)(LK + j * 272 + cc * 16) = *(const v4u*)(KR + (size_t)(row0 + j) * 512 + h * 128 + cc * 8);
        *(LAS v4u*)(LS + j * 272 + cc * 16) = *(const v4u*)(RST + (size_t)j * 128 + cc * 8);
        const v4u w = *(const v4u*)(Z + (size_t)(row0 + j) * LDZ + ZC_RQKV + 1024 + h * 128 + cc * 8);
        LAS unsigned char* d = LV + (cc * 8) * 272 + j * 2;
        *(LAS bf16*)(d) = (bf16)(w.x & 0xffff); *(LAS bf16*)(d + 272) = (bf16)(w.x >> 16); *(LAS bf16*)(d + 2 * 272) = (bf16)(w.y & 0xffff); *(LAS bf16*)(d + 3 * 272) = (bf16)(w.y >> 16);
        *(LAS bf16*)(d + 4 * 272) = (bf16)(w.z & 0xffff); *(LAS bf16*)(d + 5 * 272) = (bf16)(w.z >> 16); *(LAS bf16*)(d + 6 * 272) = (bf16)(w.w & 0xffff); *(LAS bf16*)(d + 7 * 272) = (bf16)(w.w >> 16);
    }
    __syncthreads();
    const float lg = ret_lg(h);
    const int il = 16 * wave + rl;
    bf16x8 qb[4];
#pragma unroll
    for (int s = 0; s < 4; ++s) qb[s] = ld_frag_l(LQ + il * 272 + (32 * s + 8 * quad) * 2);
    f32x4 C[8];
    const float qdec = __expf((float)(il + 1) * lg);
#pragma unroll
    for (int dt = 0; dt < 8; ++dt) {
        f32x4 a = (f32x4){0.f, 0.f, 0.f, 0.f};
#pragma unroll
        for (int s = 0; s < 4; ++s) a = mfma16(ld_frag_l(LS + (16 * dt + rl) * 272 + (32 * s + 8 * quad) * 2), qb[s], a);
        C[dt] = a * qdec;
    }
    for (int s2 = 0; s2 <= (wave >> 1); ++s2) {
        f32x4 P[2];
#pragma unroll
        for (int e = 0; e < 2; ++e) {
            const int jt = 2 * s2 + e;
            f32x4 a = (f32x4){0.f, 0.f, 0.f, 0.f};
            if (jt <= wave) {
#pragma unroll
                for (int s = 0; s < 4; ++s) a = mfma16(ld_frag_l(LK + (16 * jt + rl) * 272 + (32 * s + 8 * quad) * 2), qb[s], a);
#pragma unroll
                for (int i = 0; i < 4; ++i) { const int jj = 16 * jt + 4 * quad + i; a[i] = (il >= jj) ? a[i] * __expf((float)(il - jj) * lg) : 0.f; }
            }
            P[e] = a;
        }
        const bf16x8 pb = pack_frag(P[0], P[1]);
#pragma unroll
        for (int dt = 0; dt < 8; ++dt) {
            const LAS unsigned char* vp = LV + (16 * dt + rl) * 272 + (32 * s2 + 4 * quad) * 2;
            C[dt] = mfma16(mk_frag(*(const LAS v2u*)vp, *(const LAS v2u*)(vp + 32)), pb, C[dt]);
        }
    }
    float ss = 0.f;
#pragma unroll
    for (int dt = 0; dt < 8; ++dt) ss += (C[dt][0] * C[dt][0] + C[dt][1] * C[dt][1]) + (C[dt][2] * C[dt][2] + C[dt][3] * C[dt][3]);
    ss += shx<16>(ss, lane); ss += shx<32>(ss, lane);
    const float scl = rsqrtf(ss * (1.f / 128.f) + EPS);
    const size_t row = (size_t)row0 + il;
#pragma unroll
    for (int dt = 0; dt < 8; ++dt) {
        const v2u gwd = *(const v2u*)(Z + row * LDZ + ZC_RG + h * 128 + 16 * dt + 4 * quad);
        v2u w; w.x = pk2(C[dt][0] * scl * siluf_(lo_bf(gwd.x)), C[dt][1] * scl * siluf_(hi_bf(gwd.x))); w.y = pk2(C[dt][2] * scl * siluf_(lo_bf(gwd.y)), C[dt][3] * scl * siluf_(hi_bf(gwd.y)));
        *(v2u*)((bf16*)(ws + WS_MIX) + row * 1536 + 1024 + h * 128 + 16 * dt + 4 * quad) = w;
    }
    __syncthreads();
}
DI void gdn_out_row(Frame& F, int layer, int row) {
    const int lane = F.lane;
    unsigned char* ws = KWS();
    const float* o = (const float*)(ws + WS_OGDN) + (size_t)row * 512 + lane * 8;
    const f32x4 a = *(const f32x4*)o, b = *(const f32x4*)(o + 4);
    float ss = (a[0] * a[0] + a[1] * a[1]) + (a[2] * a[2] + a[3] * a[3]) + (b[0] * b[0] + b[1] * b[1]) + (b[2] * b[2] + b[3] * b[3]);
    ss += shx<1>(ss, lane); ss += shx<2>(ss, lane); ss += shx<4>(ss, lane); ss += shx<8>(ss, lane);
    const float scl = rsqrtf(ss * (1.f / 128.f) + EPS);
    const float* ng = KIN(18) + layer * 128 + (lane & 15) * 8;
    const f32x4 ga = *(const f32x4*)ng, gb = *(const f32x4*)(ng + 4);
    f32x4 za, zb; unpack8(*(const v4u*)((const bf16*)(ws + WS_Z) + (size_t)row * LDZ + ZC_GZ + lane * 8), za, zb);
    f32x4 ra, rb;
#pragma unroll
    for (int e = 0; e < 4; ++e) { ra[e] = a[e] * scl * ga[e] * siluf_(za[e]); rb[e] = b[e] * scl * gb[e] * siluf_(zb[e]); }
    *(v4u*)((bf16*)(ws + WS_MIX) + (size_t)row * 1536 + 512 + lane * 8) = pack8(ra, rb);
}
DI void final_row(Frame& F, int row) {
    const int lane = F.lane;
    const float* x = (const float*)(KWS() + WS_XR) + (size_t)row * DM;
    float* y = (row < MP) ? KOUT() + O_YP + (size_t)row * DM : KOUT() + O_YS + (size_t)(row - MP) * DM;
    f32x4 v[4]; float ss = 0.f;
#pragma unroll
    for (int j = 0; j < 4; ++j) { v[j] = *(const f32x4*)(x + 256 * j + lane * 4); ss += (v[j][0] * v[j][0] + v[j][1] * v[j][1]) + (v[j][2] * v[j][2] + v[j][3] * v[j][3]); }
    const float scl = rsqrtf(wave_sum(ss, lane) * (1.f / DM) + EPS);
#pragma unroll
    for (int j = 0; j < 4; ++j) *(f32x4*)(y + 256 * j + lane * 4) = v[j] * scl * *(const f32x4*)(KIN(26) + 256 * j + lane * 4);
}
template <class Epi>
DI void sgemm_tile(Frame& F, const bf16* A, int lda, const bf16* Bt, int ldb, int K, int row0, int col0, const Epi& E) {
    int lane = F.lane, wave = F.wave; asm volatile("" : "+v"(lane), "+s"(wave));
    const int tid = wave * 64 + lane, quad = lane >> 4, rl = lane & 15;
    const int kper = K >> 3, nks = kper >> 5;
    f32x4 acc[2][4];
#pragma unroll
    for (int rt = 0; rt < 2; ++rt)
#pragma unroll
        for (int ct = 0; ct < 4; ++ct) acc[rt][ct] = (f32x4){0.f, 0.f, 0.f, 0.f};
    const bf16* ap = A + (size_t)(row0 + rl) * lda + wave * kper + quad * 8;
    const bf16* bp = Bt + (size_t)(col0 + rl) * ldb + wave * kper + quad * 8;
#pragma unroll 4
    for (int ks = 0; ks < nks; ++ks) {
        bf16x8 a[2], b[4];
#pragma unroll
        for (int rt = 0; rt < 2; ++rt) a[rt] = ld_frag_g(ap + (size_t)(16 * rt) * lda + ks * 32);
#pragma unroll
        for (int ct = 0; ct < 4; ++ct) b[ct] = ld_frag_g(bp + (size_t)(16 * ct) * ldb + ks * 32);
#pragma unroll
        for (int rt = 0; rt < 2; ++rt)
#pragma unroll
            for (int ct = 0; ct < 4; ++ct) acc[rt][ct] = mfma16(a[rt], b[ct], acc[rt][ct]);
    }
    LAS float* RED = (LAS float*)F.lds;
#pragma unroll
    for (int rt = 0; rt < 2; ++rt)
#pragma unroll
        for (int ct = 0; ct < 4; ++ct)
#pragma unroll
            for (int i = 0; i < 4; ++i) RED[wave * 2176 + (16 * rt + 4 * quad + i) * 68 + 16 * ct + rl] = acc[rt][ct][i];
    __syncthreads();
    const int r = tid >> 4, c4 = (tid & 15) * 4;
    f32x4 v = *(const LAS f32x4*)(RED + r * 68 + c4);
#pragma unroll
    for (int w = 1; w < 8; ++w) v += *(const LAS f32x4*)(RED + w * 2176 + r * 68 + c4);
    E(row0 + r, col0 + c4, v, lane);
    __syncthreads();
}
DI v2u pack4(const f32x4 v) { v2u w; w.x = pk2(v[0], v[1]); w.y = pk2(v[2], v[3]); return w; }
struct SEpiC {
    const bf16* Z; bf16* G;
    DI void operator()(int row, int col, f32x4 v, int lane) const {
        const v2u gw = *(const v2u*)(Z + (size_t)row * LDZ + ZC_MG + col);
        v[0] *= sigmoidf_(lo_bf(gw.x)); v[1] *= sigmoidf_(hi_bf(gw.x)); v[2] *= sigmoidf_(lo_bf(gw.y)); v[3] *= sigmoidf_(hi_bf(gw.y));
        *(v2u*)(G + (size_t)row * 3072 + col) = pack4(v);
    }
};
struct SEpiRes {
    float* XR; bf16* XG; const float* gvec; float* SS; float* T; int mode;
    DI void operator()(int row, int col, f32x4 v, int lane) const {
        const size_t o = (size_t)row * DM + col;
        if (mode == 1) { *(f32x4*)(T + o) = v; return; }
        f32x4 x = *(const f32x4*)(XR + o);
        if (mode == 2) { const f32x4 t = *(const f32x4*)(T + o);
#pragma unroll
            for (int e = 0; e < 4; ++e) v[e] = t[e] * sigmoidf_(v[e]); }
        x += v;
        *(f32x4*)(XR + o) = x;
        if (XG) { f32x4 y = x; if (gvec) y *= *(const f32x4*)(gvec + col); *(v2u*)(XG + o) = pack4(y); }
        if (SS) { float ssq = (x[0] * x[0] + x[1] * x[1]) + (x[2] * x[2] + x[3] * x[3]);
            ssq += shx<1>(ssq, lane); ssq += shx<2>(ssq, lane); ssq += shx<4>(ssq, lane); ssq += shx<8>(ssq, lane);
            if ((lane & 15) == 0) SS[(size_t)row * 16 + (col >> 6)] = ssq; }
    }
};
struct SEpiUp {
    bf16* H; const float* SS;
    DI void operator()(int row, int col, f32x4 v, int lane) const {
        const f32x4 p0 = *(const f32x4*)(SS + (size_t)row * 16), p1 = *(const f32x4*)(SS + (size_t)row * 16 + 4), p2 = *(const f32x4*)(SS + (size_t)row * 16 + 8), p3 = *(const f32x4*)(SS + (size_t)row * 16 + 12);
        const f32x4 ps = (p0 + p1) + (p2 + p3);
        const float rstd = rsqrtf(((ps[0] + ps[1]) + (ps[2] + ps[3])) * (1.f / DM) + EPS);
#pragma unroll
        for (int e = 0; e < 4; ++e) { const float a = fmaxf(v[e] * rstd, 0.f); v[e] = a * a; }
        *(v2u*)(H + (size_t)row * DFF + col) = pack4(v);
    }
};
#ifndef PH_P0
#define PH_P0 1
#endif
#ifndef PH_A
#define PH_A 1
#endif
#ifndef PH_B0a
#define PH_B0a 1
#endif
#ifndef PH_B0b
#define PH_B0b 1
#endif
#ifndef PH_B0c
#define PH_B0c 1
#endif
#ifndef PH_B0d
#define PH_B0d 1
#endif
#ifndef PH_SCAN
#define PH_SCAN 1
#endif
#ifndef PH_RSCAN
#define PH_RSCAN 1
#endif
#ifndef PH_NSAP
#define PH_NSAP 1
#endif
#ifndef PH_NSAS
#define PH_NSAS 1
#endif
#ifndef PH_B2
#define PH_B2 1
#endif
#ifndef PH_C
#define PH_C 1
#endif
#ifndef PH_XBAR
#define PH_XBAR 0
#endif
#ifndef PH_D
#define PH_D 1
#endif
#ifndef PH_E
#define PH_E 1
#endif
#ifndef PH_F
#define PH_F 1
#endif
#ifndef PH_G1
#define PH_G1 1
#endif
#ifndef PH_G2
#define PH_G2 1
#endif
struct Args { const void* in[27]; float* out; unsigned char* ws; };
__global__ void __launch_bounds__(NTHREADS, 2) mk_fwd(Args args) {
    extern __shared__ __attribute__((aligned(16))) unsigned char lds_raw[];
    Frame F;
    F.lds = (LAS unsigned char*)lds_raw;
    F.wave = __builtin_amdgcn_readfirstlane((int)threadIdx.x >> 6); F.lane = 0; F.tid = 0;
    F.G = gridDim.x; F.bid = blockIdx.x;
    F.ctl = (gu32*)(KWS() + WS_CTL);
    { const Frame Fp = fresh(F); for (int u = Fp.tid; u < (LDS_BYTES - LDSCTL_OFF) / 4; u += NTHREADS) ((LAS unsigned*)(F.lds + LDSCTL_OFF))[u] = 0u;
      __syncthreads();
      (void)xcd_barrier_post((unsigned*)(F.ctl + CW_BAR), (volatile LAS unsigned*)(F.lds + MISC_OFF) + 8, Fp.tid == 0); }
    const int G = F.G, bid = F.bid;

        for (int rp_ = 0; rp_ < PH_P0; ++rp_) {
    { Frame Fp = fresh(F); p0_prologue(Fp); }
        }
    GRID_BAR();

    for (int layer = 0; layer < NLAYER; ++layer) {
        for (int rp_ = 0; rp_ < PH_A; ++rp_) {
        {
            const Frame Fg = fresh(F); const int G = Fg.G, bid = Fg.bid;
            unsigned char* ws = KWS();
            pg8::Gemm g{(const bf16*)(ws + WS_XGA), (const bf16*)(ws + WS_WIN + layer * SZ_WIN), MROWS, LDZ, DM, DM, DM, 31, 0};
            pg8::StaticOrder S; S.init(MROWS, LDZ, G, bid);
            epi::EpiA E{(bf16*)(ws + WS_Z), (float*)(ws + WS_ZS), (const float*)(ws + WS_SSA), KOUT(), layer};
            pg8::gemm_phase<epi::EpiA, pg8::StaticOrder, true, true>(Fg.lds, g, S, E, Fg.tid);
        }
        }
        GRID_BAR();
        for (int rp_ = 0; rp_ < PH_B0a; ++rp_) {
        { Frame Fp = fresh(F); for (int u = Fp.bid; u < 1024; u += Fp.G) gdn_prep_unit(Fp, layer, u); }
        }
        for (int rp_ = 0; rp_ < PH_B0b; ++rp_) {
        { Frame Fp = fresh(F); for (int u = Fp.bid; u < 512; u += Fp.G) ret_prep_unit(Fp, layer, u); }
        }
        for (int rp_ = 0; rp_ < PH_B0c; ++rp_) {
        { Frame Fp = fresh(F); for (int u = Fp.bid; u < 1024; u += Fp.G) sample_rec_unit(Fp, layer, u); }
        }
        for (int rp_ = 0; rp_ < PH_B0d; ++rp_) {
        { Frame Fp = fresh(F); for (int t = Fp.bid; t < 256 + 16; t += Fp.G) compress_job(Fp, layer, t); }
        }
        GRID_BAR();
        {
            Frame Fp = fresh(F);
            gu32* qbase = F.ctl + CW_QUEUE + 512 * layer;
            volatile LAS int* qslot = (volatile LAS int*)(F.lds + MISC_OFF) + 16;
            constexpr int NQ = 8 * PH_SCAN, NS = 128 * PH_NSAS, NR = 32 * PH_RSCAN, NP = 256 * PH_NSAP;
            const int pref = (int)(xb_xcc_id() & 3u);
            for (;;) {
                if (Fp.tid == 0) {
                    int kind = -1, idx = 0;
                    const int a = (int)__hip_atomic_fetch_add(qbase, 1u, __ATOMIC_RELAXED, __HIP_MEMORY_SCOPE_AGENT);
                    if (a < NQ + NS + NR) { kind = 4; idx = a; }
                    else {
                        for (int k = 0; k < 4 && kind < 0; ++k) { const int s = (pref + k) & 3;
                            if ((int)__hip_atomic_load(qbase + 64 * (1 + s), __ATOMIC_RELAXED, __HIP_MEMORY_SCOPE_AGENT) < NP) {
                                const int r = (int)__hip_atomic_fetch_add(qbase + 64 * (1 + s), 1u, __ATOMIC_RELAXED, __HIP_MEMORY_SCOPE_AGENT);
                                if (r < NP) { kind = s; idx = r; } } }
                    }
                    qslot[0] = kind; qslot[1] = idx;
                }
                __syncthreads();
                int kind = qslot[0], it = qslot[1];
                __syncthreads();
                kind = __builtin_amdgcn_readfirstlane(kind); it = __builtin_amdgcn_readfirstlane(it);
                if (kind < 0) break;
                if (kind < 4) nsa_prompt_unit(Fp, layer, (kind << 8) | (255 - (it & 255)));
                else if (it < NQ) gdn_scan_chain(Fp, layer, it & 7);
                else if (it < NQ + NS) nsa_sample_unit(Fp, layer, (it - NQ) & 127);
                else ret_scan_part(Fp, layer, (it - NQ - NS) & 31);
            }
        }
        GRID_BAR();
        for (int rp_ = 0; rp_ < PH_B2; ++rp_) {
        { Frame Fp = fresh(F); for (int u = Fp.bid; u < 512; u += Fp.G) ret_out_unit(Fp, layer, u); }
        { Frame Fp = fresh(F); for (int r = Fp.bid * NWAVES + Fp.wave; r < MROWS; r += Fp.G * NWAVES) gdn_out_row(Fp, layer, r); }
        }
        GRID_BAR();
        for (int rp_ = 0; rp_ < PH_C; ++rp_) {
        {
            const Frame Fg = fresh(F); const int G = Fg.G, bid = Fg.bid;
            unsigned char* ws = KWS();
            pg8::Gemm g{(const bf16*)(ws + WS_MIX), (const bf16*)(ws + WS_WBR + layer * SZ_WBR), MP, 3072, 512, 1536, 512, 2, 1024};
            pg8::StaticOrder S; S.init(MP, 3072, G, bid);
            epi::EpiC E{(const bf16*)(ws + WS_Z), (bf16*)(ws + WS_GATED)};
            pg8::gemm_phase<epi::EpiC, pg8::StaticOrder, true, true>(Fg.lds, g, S, E, Fg.tid);
            {
                Frame Fs = fresh(F); const SEpiC Es{(const bf16*)(ws + WS_Z), (bf16*)(ws + WS_GATED)};
                for (int tl = Fs.bid; tl < 16 * 48; tl += Fs.G) { const int rt = tl & 15, ct = tl >> 4, b = ct >> 4;
                    sgemm_tile(Fs, (const bf16*)(ws + WS_MIX) + b * 512, 1536, (const bf16*)(ws + WS_WBR + layer * SZ_WBR), 512, 512, MP + 32 * rt, 64 * ct, Es); }
            }
        }
        }
        GRID_BAR();
        for (int rp_ = 0; rp_ < PH_D; ++rp_) {
        {
            const Frame Fg = fresh(F); const int G = Fg.G, bid = Fg.bid;
            unsigned char* ws = KWS();
            pg8::Gemm g{(const bf16*)(ws + WS_GATED), (const bf16*)(ws + WS_WO3 + layer * SZ_WO3), MP, DM, 3072, 3072, 3072, 31, 0};
            pg8::StaticOrder S; S.init(MP, DM, G, bid);
            epi::EpiRes E{(float*)(ws + WS_XR), (bf16*)(ws + WS_XGB), KIN(21) + layer * DM, (float*)(ws + WS_SSB), nullptr, (rp_ + 1 < PH_D) ? 3 : 0};
            pg8::gemm_phase<epi::EpiRes, pg8::StaticOrder, true, true>(Fg.lds, g, S, E, Fg.tid);
            if (rp_ + 1 == PH_D) {
                Frame Fs = fresh(F); const SEpiRes Es{(float*)(ws + WS_XR), (bf16*)(ws + WS_XGB), KIN(21) + layer * DM, (float*)(ws + WS_SSB), nullptr, 0};
                for (int tl = Fs.bid; tl < 256; tl += Fs.G) sgemm_tile(Fs, (const bf16*)(ws + WS_GATED), 3072, (const bf16*)(ws + WS_WO3 + layer * SZ_WO3), 3072, 3072, MP + 32 * (tl & 15), 64 * (tl >> 4), Es);
            }
        }
        }
        GRID_BAR();
        for (int rp_ = 0; rp_ < PH_E; ++rp_) {
        {
            const Frame Fg = fresh(F); const int G = Fg.G, bid = Fg.bid;
            unsigned char* ws = KWS();
            pg8::Gemm g{(const bf16*)(ws + WS_XGB), (const bf16*)(ws + WS_WUP + layer * SZ_WUP), MP, DFF, DM, DM, DM, 31, 0};
            pg8::StaticOrder S; S.init(MP, DFF, G, bid);
            epi::EpiUp E{(bf16*)(ws + WS_HMID), (const float*)(ws + WS_SSB)};
            pg8::gemm_phase<epi::EpiUp, pg8::StaticOrder, true, true>(Fg.lds, g, S, E, Fg.tid);
            {
                Frame Fs = fresh(F); const SEpiUp Es{(bf16*)(ws + WS_HMID), (const float*)(ws + WS_SSB)};
                for (int tl = Fs.bid; tl < 16 * 64; tl += Fs.G) sgemm_tile(Fs, (const bf16*)(ws + WS_XGB), DM, (const bf16*)(ws + WS_WUP + layer * SZ_WUP), DM, DM, MP + 32 * (tl & 15), 64 * (tl >> 4), Es);
            }
        }
        }
        GRID_BAR();
        for (int rp_ = 0; rp_ < PH_F; ++rp_) {
        {
            const Frame Fg = fresh(F); const int G = Fg.G, bid = Fg.bid;
            unsigned char* ws = KWS();
            pg8::Gemm g{(const bf16*)(ws + WS_HMID), (const bf16*)(ws + WS_WDN + layer * SZ_WDN), MP, DM, DFF, DFF, DFF, 31, 0};
            pg8::StaticOrder S; S.init(MP, DM, G, bid);
            epi::EpiRes E{(float*)(ws + WS_XR), (bf16*)(ws + WS_XGC), nullptr, nullptr, nullptr, (rp_ + 1 < PH_F) ? 3 : 0};
            pg8::gemm_phase<epi::EpiRes, pg8::StaticOrder, true, true>(Fg.lds, g, S, E, Fg.tid);
            if (rp_ + 1 == PH_F) {
                Frame Fs = fresh(F); const SEpiRes Es{(float*)(ws + WS_XR), (bf16*)(ws + WS_XGC), nullptr, nullptr, nullptr, 0};
                for (int tl = Fs.bid; tl < 256; tl += Fs.G) sgemm_tile(Fs, (const bf16*)(ws + WS_HMID), DFF, (const bf16*)(ws + WS_WDN + layer * SZ_WDN), DFF, DFF, MP + 32 * (tl & 15), 64 * (tl >> 4), Es);
            }
        }
        }
        GRID_BAR();
        for (int rp_ = 0; rp_ < PH_G1; ++rp_) {
        {
            const Frame Fg = fresh(F); const int G = Fg.G, bid = Fg.bid;
            unsigned char* ws = KWS();
            int kple = PLE; asm volatile("" : "+s"(kple));
            pg8::Gemm g{(const bf16*)(ws + WS_P16) + (size_t)layer * MROWS * PLE, (const bf16*)(ws + WS_WPL + layer * SZ_WPL), MP, DM, kple, PLE, PLE, 31, 0};
            pg8::StaticOrder S; S.init(MP, DM, G, bid);
            epi::EpiRes E{nullptr, nullptr, nullptr, nullptr, (float*)(ws + WS_TPLE), 1};
            pg8::gemm_phase<epi::EpiRes, pg8::StaticOrder, true, true>(Fg.lds, g, S, E, Fg.tid);
            {
                Frame Fs = fresh(F); const SEpiRes Es{nullptr, nullptr, nullptr, nullptr, (float*)(ws + WS_TPLE), 1};
                for (int tl = Fs.bid; tl < 256; tl += Fs.G) sgemm_tile(Fs, (const bf16*)(ws + WS_P16) + (size_t)layer * MROWS * PLE, PLE, (const bf16*)(ws + WS_WPL + layer * SZ_WPL), PLE, PLE, MP + 32 * (tl & 15), 64 * (tl >> 4), Es);
            }
        }
        }
        for (int rp_ = 0; rp_ < PH_G2; ++rp_) {
        {
            const Frame Fg = fresh(F); const int G = Fg.G, bid = Fg.bid;
            unsigned char* ws = KWS();
            const bool more = layer + 1 < NLAYER;
            pg8::Gemm g{(const bf16*)(ws + WS_XGC), (const bf16*)(ws + WS_WPG + layer * SZ_WPG), MP, DM, DM, DM, DM, 31, 0};
            pg8::StaticOrder S; S.init(MP, DM, G, bid);
            epi::EpiRes E{(float*)(ws + WS_XR), more ? (bf16*)(ws + WS_XGA) : nullptr, more ? KIN(10) + (layer + 1) * DM : nullptr, more ? (float*)(ws + WS_SSA) : nullptr, (float*)(ws + WS_TPLE), (rp_ + 1 < PH_G2) ? 3 : 2};
            pg8::gemm_phase<epi::EpiRes, pg8::StaticOrder, true, true>(Fg.lds, g, S, E, Fg.tid);
            if (rp_ + 1 == PH_G2) {
                Frame Fs = fresh(F); const SEpiRes Es{(float*)(ws + WS_XR), more ? (bf16*)(ws + WS_XGA) : nullptr, more ? KIN(10) + (layer + 1) * DM : nullptr, more ? (float*)(ws + WS_SSA) : nullptr, (float*)(ws + WS_TPLE), 2};
                for (int tl = Fs.bid; tl < 256; tl += Fs.G) sgemm_tile(Fs, (const bf16*)(ws + WS_XGC), DM, (const bf16*)(ws + WS_WPG + layer * SZ_WPG), DM, DM, MP + 32 * (tl & 15), 64 * (tl >> 4), Es);
            }
        }
        }
        GRID_BAR();
    }
    for (int xb_ = 0; xb_ < PH_XBAR; ++xb_) GRID_BAR();
    { Frame Fp = fresh(F); for (int r = Fp.bid * NWAVES + Fp.wave; r < MROWS; r += Fp.G * NWAVES) final_row(Fp, r); }
}

extern "C" void kernel_launch(void* const* d_in, const int* in_sizes, int n_in, void* d_out, int out_size, void* d_ws, size_t ws_size, hipStream_t stream) {
    static int grid = 0;
    if (grid == 0) {
        if (n_in != 27 || ws_size < WS_END) { fprintf(stderr, "kernel_launch: unexpected shapes (n_in %d out %d ws %zu, need %zu)\n", n_in, out_size, ws_size, (size_t)WS_END); grid = -1; return; }
        int dev = 0, cus = 0;
        if (hipGetDevice(&dev) != hipSuccess || hipDeviceGetAttribute(&cus, hipDeviceAttributeMultiprocessorCount, dev) != hipSuccess) { grid = -1; return; }
        if (hipFuncSetAttribute((const void*)mk_fwd, hipFuncAttributeMaxDynamicSharedMemorySize, LDS_BYTES) != hipSuccess) { fprintf(stderr, "kernel_launch: hipFuncSetAttribute failed\n"); grid = -1; return; }
        int per_cu = 0;
        if (hipOccupancyMaxActiveBlocksPerMultiprocessor(&per_cu, (const void*)mk_fwd, NTHREADS, LDS_BYTES) != hipSuccess || per_cu < 1) fprintf(stderr, "kernel_launch: occupancy query reports %d\n", per_cu);
        (void)hipGetLastError();
        grid = cus;
    }
    if (grid < 0) return;
    if (hipMemsetAsync((char*)d_ws + WS_CTL, 0, CTL_ZERO_BYTES, stream) != hipSuccess) return;
    Args a{};
    for (int i = 0; i < 27; ++i) a.in[i] = d_in[i];
    a.out = (float*)d_out; a.ws = (unsigned char*)d_ws;
    hipLaunchKernelGGL(mk_fwd, dim3(grid), dim3(NTHREADS), LDS_BYTES, stream, a);
}
```

```cpp
#include <hip/hip_runtime.h>
#include <cstdio>
#include <cstdint>
namespace pg8 {
#define PG8_LAS __attribute__((address_space(3)))
typedef unsigned short bf16_t;
typedef short bf16x8 __attribute__((ext_vector_type(8)));
typedef float f32x4 __attribute__((ext_vector_type(4)));
typedef unsigned u32x4 __attribute__((ext_vector_type(4)));
constexpr int BM = 256, BK = 64, HALF = 128, HTB = HALF * BK * 2  , STAGE_BYTES = 8 * HTB, NXCD = 8, WGM = 8;

__host__ __device__ __forceinline__ int lds_byte(int r, int c) { const int st = (r >> 4) * 2 + (c >> 5), rr = r & 15, cc = c & 31, ob = rr * 64 + cc * 2; return st * 1024 + (ob ^ (((ob >> 9) & 1) << 5)); }
__host__ __device__ __forceinline__ void stage_rc(int b, int& R, int& C) { const int st = b / 1024, sb = b % 1024, swz = sb ^ (((sb >> 9) & 1) << 5); R = (st >> 1) * 16 + swz / 64; C = (st & 1) * 32 + (swz % 64) / 2; }
__host__ __device__ __forceinline__ int perm32(int rho) { const int n = rho >> 4, i = rho & 15; return 8 * (i >> 2) + 4 * n + (i & 3); }

struct Unit { int pm, pn; };
struct Gemm { const bf16_t* A; const bf16_t* Bt; int M, N, K; int lda, ldb; int a_shift, a_off; };

struct StaticOrder {
    int nM, nN, nwg, G, c;
    __host__ __device__ void init(int M, int N, int G_, int c_) { nM = M / BM; nN = N / BM; nwg = nM * nN; G = G_; c = c_; }
    __host__ __device__ bool next(int i, Unit& u) const {
        const long L = (long)i * G + c; if (L >= nwg) return false;
        int wgid = (int)L; { const int q = nwg / NXCD, r = nwg % NXCD, xcd = wgid % NXCD, off = wgid / NXCD; wgid = (xcd < r ? xcd * (q + 1) : r * (q + 1) + (xcd - r) * q) + off; }
        const int nig = WGM * nN, gid = wgid / nig, fm = gid * WGM, gsz = (nM - fm) < WGM ? (nM - fm) : WGM;
        u.pm = fm + ((wgid % nig) % gsz); u.pn = (wgid % nig) / gsz; return true;
    }
    __device__ __forceinline__ void a_ready(const Unit&) const {}
    __device__ __forceinline__ void done(const Unit&) const {}
};

__device__ __forceinline__ unsigned cvt_pk_bf16(float lo, float hi) { unsigned r; asm volatile("v_cvt_pk_bf16_f32 %0, %1, %2" : "=v"(r) : "v"(lo), "v"(hi)); return r; }
typedef float f32x2 __attribute__((ext_vector_type(2)));
template <class Epi, class Sched, bool ALIGN_EPI = false, bool SP2 = false>
__device__ __forceinline__ void gemm_phase(PG8_LAS unsigned char* lds, const Gemm g, const Sched& S, const Epi& E, const int tid) {
    const int wid = __builtin_amdgcn_readfirstlane(tid >> 6), lane = tid & 63, wr = wid >> 2, wc = wid & 3, fr = lane & 15, fq = lane >> 4;
    const int K = g.K, nt = K / BK;
    unsigned voffA[2], voffB[2];
#pragma unroll
    for (int i = 0; i < 2; ++i) { int R, C; stage_rc(tid * 16 + i * 8192, R, C); const int Rb = Epi::PERM ? ((R & ~31) + perm32(R & 31)) : R;
        voffA[i] = (unsigned)(R * g.lda + C) * 2u; voffB[i] = (unsigned)(Rb * g.ldb + C) * 2u; }
    const size_t kstep = (size_t)(BK * 2);
    const size_t hstepA = (size_t)HALF * g.lda * 2, hstepB = (size_t)HALF * g.ldb * 2;
    const size_t tstepA = 2 * hstepA, tstepB = 2 * hstepB;
    const unsigned ldsw = (unsigned)wid * 1024u;
    const int aoff = lds_byte(wr * 64 + fr, fq * 8), boff = lds_byte(wc * 32 + fr, fq * 8);
#define PG8_SA(b, h) (((b) * 2 + (h)) * HTB)
#define PG8_SB(b, h) ((4 + (b) * 2 + (h)) * HTB)
#define PG8_STAGE(bufoff, gbase, voff) do { _Pragma("unroll") for (int _i = 0; _i < 2; ++_i) \
        __builtin_amdgcn_global_load_lds((const unsigned*)((const char*)(gbase) + (voff)[_i]), (PG8_LAS unsigned*)(lds + (bufoff) + ldsw + _i * 8192), 16, 0, 0); } while (0)
#define PG8_LDA(dst, b, h) do { _Pragma("unroll") for (int m = 0; m < 4; ++m) _Pragma("unroll") for (int k = 0; k < 2; ++k) dst[m][k] = *(const PG8_LAS bf16x8*)(lds + PG8_SA(b, h) + aoff + m * 2048 + k * 1024); } while (0)
#define PG8_LDB(dst, b, h) do { _Pragma("unroll") for (int n = 0; n < 2; ++n) _Pragma("unroll") for (int k = 0; k < 2; ++k) dst[n][k] = *(const PG8_LAS bf16x8*)(lds + PG8_SB(b, h) + boff + n * 2048 + k * 1024); } while (0)
#define PG8_MMA(ai, bj, At, Bt) do { __builtin_amdgcn_s_setprio(1); _Pragma("unroll") for (int m = 0; m < 4; ++m) _Pragma("unroll") for (int n = 0; n < 2; ++n) _Pragma("unroll") for (int k = 0; k < 2; ++k) \
        acc[ai][bj][m][n] = __builtin_amdgcn_mfma_f32_16x16x32_bf16(Bt[n][k], At[m][k], acc[ai][bj][m][n], 0, 0, 0); __builtin_amdgcn_s_setprio(0); } while (0)
#define PG8_WAIT_V(n) asm volatile("s_waitcnt vmcnt(" #n ")" ::: "memory")
#define PG8_WAIT_L(n) asm volatile("s_waitcnt lgkmcnt(" #n ")" ::: "memory")
#define PG8_BAR __builtin_amdgcn_s_barrier()
#define PG8_SCHED __builtin_amdgcn_sched_barrier(0)
    Unit cur, nxt; int ui = 0;
    if (!S.next(0, cur)) return;
    f32x4 acc[2][2][4][2];
#pragma unroll
    for (int a = 0; a < 2; ++a)
#pragma unroll
        for (int b = 0; b < 2; ++b)
#pragma unroll
            for (int m = 0; m < 4; ++m)
#pragma unroll
                for (int n = 0; n < 2; ++n) acc[a][b][m][n] = (f32x4){0.f, 0.f, 0.f, 0.f};
    bf16x8 At[4][2], B0[2][2], B1[2][2];
    const char* cA = (const char*)g.A + (size_t)cur.pm * tstepA + (size_t)(cur.pn >> g.a_shift) * (size_t)g.a_off; const char* cB = (const char*)g.Bt + (size_t)cur.pn * tstepB;
    S.a_ready(cur);
    if constexpr (SP2) {
        PG8_STAGE(PG8_SB(0, 0), cB, voffB); PG8_STAGE(PG8_SB(0, 1), cB + hstepB, voffB); PG8_STAGE(PG8_SA(0, 0), cA, voffA); PG8_STAGE(PG8_SA(0, 1), cA + hstepA, voffA);
        if (wr == 1) PG8_BAR;
        PG8_WAIT_V(2); PG8_BAR;
        PG8_STAGE(PG8_SB(1, 0), cB + kstep, voffB); PG8_STAGE(PG8_SA(1, 0), cA + kstep, voffA); PG8_STAGE(PG8_SB(1, 1), cB + hstepB + kstep, voffB);
        PG8_WAIT_V(6); PG8_BAR;
    } else {
        PG8_STAGE(PG8_SB(0, 0), cB, voffB); PG8_STAGE(PG8_SA(0, 0), cA, voffA); PG8_STAGE(PG8_SB(0, 1), cB + hstepB, voffB); PG8_STAGE(PG8_SA(0, 1), cA + hstepA, voffA);
        if (wr == 1) PG8_BAR;
        PG8_WAIT_V(4); PG8_BAR;
        PG8_STAGE(PG8_SB(1, 0), cB + kstep, voffB); PG8_STAGE(PG8_SA(1, 0), cA + kstep, voffA); PG8_STAGE(PG8_SB(1, 1), cB + hstepB + kstep, voffB);
        PG8_WAIT_V(6); PG8_BAR;
    }
    for (;;) {
        const bool has_next = S.next(ui + 1, nxt);
        const char* nA = has_next ? (const char*)g.A + (size_t)nxt.pm * tstepA + (size_t)(nxt.pn >> g.a_shift) * (size_t)g.a_off : cA; const char* nB = has_next ? (const char*)g.Bt + (size_t)nxt.pn * tstepB : cB;
        for (int t = 0; t < nt; t += 2) {
            const bool last = (t == nt - 2);
            const char* a1 = cA + (size_t)(t + 1) * kstep;
            const char* a2 = last ? nA : cA + (size_t)(t + 2) * kstep; const char* b2 = last ? nB : cB + (size_t)(t + 2) * kstep;
            const char* a3 = a2 + kstep; const char* b3 = b2 + kstep;
            if (last && has_next) S.a_ready(nxt);
            if constexpr (SP2) {
            PG8_LDB(B0, 0, 0); PG8_LDB(B1, 0, 1); PG8_SCHED; PG8_LDA(At, 0, 0); PG8_STAGE(PG8_SA(1, 1), a1 + hstepA, voffA);
            PG8_WAIT_V(8); PG8_WAIT_L(0); PG8_BAR; PG8_MMA(0, 0, At, B0); PG8_MMA(0, 1, At, B1); PG8_BAR; PG8_SCHED;
            PG8_LDA(At, 0, 1); PG8_STAGE(PG8_SB(0, 0), b2, voffB); PG8_STAGE(PG8_SB(0, 1), b2 + hstepB, voffB); PG8_STAGE(PG8_SA(0, 0), a2, voffA);
            PG8_WAIT_V(8); PG8_WAIT_L(0); PG8_BAR; PG8_MMA(1, 0, At, B0); PG8_MMA(1, 1, At, B1); PG8_BAR; PG8_SCHED;
            PG8_LDB(B0, 1, 0); PG8_LDB(B1, 1, 1); PG8_SCHED; PG8_LDA(At, 1, 0); PG8_STAGE(PG8_SA(0, 1), a2 + hstepA, voffA);
            PG8_WAIT_V(8); PG8_WAIT_L(0); PG8_BAR; PG8_MMA(0, 0, At, B0); PG8_MMA(0, 1, At, B1); PG8_BAR; PG8_SCHED;
            PG8_LDA(At, 1, 1); PG8_STAGE(PG8_SB(1, 0), b3, voffB); PG8_STAGE(PG8_SB(1, 1), b3 + hstepB, voffB); PG8_STAGE(PG8_SA(1, 0), a3, voffA);
            PG8_WAIT_V(8); PG8_WAIT_L(0); PG8_BAR; PG8_MMA(1, 0, At, B0); PG8_MMA(1, 1, At, B1); PG8_BAR; PG8_SCHED;
            } else {
            PG8_LDB(B0, 0, 0); PG8_SCHED; PG8_LDA(At, 0, 0); PG8_STAGE(PG8_SA(1, 1), a1 + hstepA, voffA);
            PG8_WAIT_L(8); PG8_BAR; PG8_WAIT_L(0); PG8_MMA(0, 0, At, B0); PG8_BAR; PG8_SCHED;
            PG8_LDB(B1, 0, 1); PG8_STAGE(PG8_SB(0, 0), b2, voffB);
            PG8_BAR; PG8_WAIT_L(0); PG8_MMA(0, 1, At, B1); PG8_BAR;
            PG8_LDA(At, 0, 1); PG8_STAGE(PG8_SA(0, 0), a2, voffA);
            PG8_BAR; PG8_WAIT_L(0); PG8_MMA(1, 0, At, B0); PG8_BAR; PG8_SCHED;
            PG8_STAGE(PG8_SB(0, 1), b2 + hstepB, voffB);
            PG8_WAIT_V(6); PG8_BAR; PG8_MMA(1, 1, At, B1); PG8_BAR;
            PG8_LDB(B0, 1, 0); PG8_SCHED; PG8_LDA(At, 1, 0); PG8_STAGE(PG8_SA(0, 1), a2 + hstepA, voffA);
            PG8_WAIT_L(8); PG8_BAR; PG8_WAIT_L(0); PG8_MMA(0, 0, At, B0); PG8_BAR; PG8_SCHED;
            PG8_LDB(B1, 1, 1); PG8_STAGE(PG8_SB(1, 0), b3, voffB);
            PG8_BAR; PG8_WAIT_L(0); PG8_MMA(0, 1, At, B1); PG8_BAR;
            PG8_LDA(At, 1, 1); PG8_STAGE(PG8_SA(1, 0), a3, voffA);
            PG8_BAR; PG8_WAIT_L(0); PG8_MMA(1, 0, At, B0); PG8_BAR; PG8_SCHED;
            PG8_STAGE(PG8_SB(1, 1), b3 + hstepB, voffB);
            PG8_WAIT_V(6); PG8_BAR; PG8_MMA(1, 1, At, B1); PG8_BAR;
            }
        }
        if constexpr (ALIGN_EPI) { if (wr == 0) PG8_BAR; }
        if constexpr (!Epi::AFTER_DRAIN) { E(acc, cur, wr, wc, fr, fq); S.done(cur); }
        if (!has_next) break;
#pragma unroll
        for (int a = 0; a < 2; ++a)
#pragma unroll
            for (int b = 0; b < 2; ++b)
#pragma unroll
                for (int m = 0; m < 4; ++m)
#pragma unroll
                    for (int n = 0; n < 2; ++n) acc[a][b][m][n] = (f32x4){0.f, 0.f, 0.f, 0.f};
        cur = nxt; cA = nA; cB = nB; ++ui;
        if constexpr (ALIGN_EPI) { if (wr == 1) PG8_BAR; }
    }
    PG8_WAIT_V(0);
    if constexpr (!ALIGN_EPI) { if (wr == 0) PG8_BAR; }
    PG8_BAR;
    if constexpr (Epi::AFTER_DRAIN) { E.fused(acc, cur, wr, wc, fr, fq, lds, wid, lane); S.done(cur); }
#undef PG8_SA
#undef PG8_SB
#undef PG8_STAGE
#undef PG8_LDA
#undef PG8_LDB
#undef PG8_MMA
#undef PG8_WAIT_V
#undef PG8_WAIT_L
#undef PG8_BAR
#undef PG8_SCHED
}
}
#define DI __device__ __forceinline__
#define GAS __attribute__((address_space(1)))
#define LAS __attribute__((address_space(3)))
typedef unsigned short bf16;
typedef unsigned v4u __attribute__((ext_vector_type(4)));
typedef unsigned v2u __attribute__((ext_vector_type(2)));
typedef float f32x4 __attribute__((ext_vector_type(4)));
typedef float f32x2 __attribute__((ext_vector_type(2)));
typedef short bf16x8 __attribute__((ext_vector_type(8)));
typedef short s16x4 __attribute__((ext_vector_type(4)));
typedef GAS unsigned gu32;

constexpr int DM = 1024, TP = 8192, MP = 16384, MS = 512, MROWS = 16896, LDZ = 8704, DFF = 4096, PLE = 256, NLAYER = 2;
constexpr int ZC_Q = 0, ZC_KC = 512, ZC_VC = 640, ZC_KS = 768, ZC_VS = 896, ZC_KW = 1024, ZC_VW = 1152, ZC_GQKV = 1280, ZC_GZ = 2816, ZC_RQKV = 3328, ZC_RG = 4864, ZC_MG = 5376, ZC_SM = 8448;
constexpr float EPS = 1e-6f;
constexpr size_t O_YP = 0, O_YS = O_YP + (size_t)MP * DM, O_KVP = O_YS + (size_t)MS * DM, O_KVS = O_KVP + (size_t)2 * MP * 512, O_WINP = O_KVS + (size_t)2 * MS * 512,
                 O_WINS = O_WINP + (size_t)2 * 2 * 512 * 256, O_CVP = O_WINS + (size_t)2 * 128 * 512 * 256, O_CVS = O_CVP + (size_t)2 * 2 * 3 * 1536, O_GSP = O_CVS + (size_t)2 * 128 * 3 * 1536,
                 O_GSS = O_GSP + (size_t)2 * 2 * 4 * 16384, O_RSP = O_GSS + (size_t)2 * 128 * 4 * 16384, O_RSS = O_RSP + (size_t)2 * 2 * 4 * 16384, O_END = O_RSS + (size_t)2 * 128 * 4 * 16384;

DI float bf2f(unsigned short b) { return __uint_as_float((unsigned)b << 16); }
DI unsigned f2bf(float f) { unsigned u = __float_as_uint(f); return (u + 0x7fffu + ((u >> 16) & 1u)) >> 16; }
typedef __bf16 bf16x2_t __attribute__((ext_vector_type(2)));
DI unsigned pk2(float lo, float hi) { const f32x2 v = {lo, hi}; return __builtin_bit_cast(unsigned, __builtin_convertvector(v, bf16x2_t)); }
DI float lo_bf(unsigned w) { return __uint_as_float(w << 16); }
DI float hi_bf(unsigned w) { return __uint_as_float(w & 0xffff0000u); }
DI float sigmoidf_(float x) { return 1.f / (1.f + __expf(-x)); }
DI float siluf_(float x) { return x / (1.f + __expf(-x)); }
DI v4u pack8(const f32x4 a, const f32x4 b) { v4u w; w.x = pk2(a[0], a[1]); w.y = pk2(a[2], a[3]); w.z = pk2(b[0], b[1]); w.w = pk2(b[2], b[3]); return w; }
DI void unpack8(const v4u w, f32x4& a, f32x4& b) { a[0] = lo_bf(w.x); a[1] = hi_bf(w.x); a[2] = lo_bf(w.y); a[3] = hi_bf(w.y); b[0] = lo_bf(w.z); b[1] = hi_bf(w.z); b[2] = lo_bf(w.w); b[3] = hi_bf(w.w); }

template <int M> DI int shxi(int v, int lane) {
    if constexpr (M < 32) return __builtin_amdgcn_ds_swizzle(v, (M << 10) | 0x1f);
    else return __builtin_amdgcn_ds_bpermute((lane ^ 32) << 2, v);
}
template <int M> DI float shx(float v, int lane) { return __int_as_float(shxi<M>(__float_as_int(v), lane)); }
DI float wave_sum(float v, int lane) { v += shx<1>(v, lane); v += shx<2>(v, lane); v += shx<4>(v, lane); v += shx<8>(v, lane); v += shx<16>(v, lane); v += shx<32>(v, lane); return v; }

namespace epi {
using pg8::Unit; using pg8::bf16_t;
DI float row_rstd(const float* SS, int row, int fq, int lane) {
    const f32x4 p = *(const f32x4*)(SS + (size_t)row * 16 + 4 * fq);
    float s = (p[0] + p[1]) + (p[2] + p[3]); s += shx<16>(s, lane); s += shx<32>(s, lane);
    return rsqrtf(s * (1.f / DM) + EPS);
}
struct EpiA {
    static constexpr bool PERM = true, AFTER_DRAIN = false;
    bf16* Z; float* ZS; const float* SS; float* out; int layer;
    DI void operator()(const f32x4 (&acc)[2][2][4][2], const Unit& u, int wr, int wc, int fr, int fq) const {
        asm volatile("" : "+v"(fr), "+v"(fq), "+s"(wr), "+s"(wc));
        const int pn = u.pn;
        float rs[2][4];
#pragma unroll
        for (int ai = 0; ai < 2; ++ai)
#pragma unroll
            for (int m = 0; m < 4; ++m) rs[ai][m] = row_rstd(SS, u.pm * 256 + ai * 128 + wr * 64 + m * 16 + fr, fq, fr + 16 * fq);
#pragma unroll
        for (int ai = 0; ai < 2; ++ai)
#pragma unroll
            for (int m = 0; m < 4; ++m) {
                const int row = u.pm * 256 + ai * 128 + wr * 64 + m * 16 + fr;
                const float rstd = rs[ai][m];
#pragma unroll
                for (int bj = 0; bj < 2; ++bj) {
                    const int col = pn * 256 + bj * 128 + wc * 32 + 8 * fq;
                    const f32x4 v0 = acc[ai][bj][m][0] * rstd, v1 = acc[ai][bj][m][1] * rstd;
                    *(v4u*)(Z + (size_t)row * LDZ + col) = pack8(v0, v1);
                    float* dst = nullptr;
                    if (pn == 2 || pn == 3) {
                        dst = (row < MP) ? out + O_KVP + ((size_t)layer * MP + row) * 512 + (col - 512) : out + O_KVS + ((size_t)layer * MS + (row - MP)) * 512 + (col - 512);
                    } else if (pn == 4) {
                        const int c2 = col - 1024;
                        if (row < MP) { const int t = row & (TP - 1), b = row >> 13; if (t >= TP - 512) dst = out + O_WINP + ((size_t)(layer * 2 + b) * 512 + (t - (TP - 512))) * 256 + c2; }
                        else { const int r2 = row - MP, s = r2 >> 2, j = r2 & 3; dst = out + O_WINS + ((size_t)(layer * 128 + s) * 512 + 508 + j) * 256 + c2; }
                    } else if (pn >= 5 && pn < 11) {
                        const int c2 = col - 1280;
                        if (row < MP) { const int t = row & (TP - 1), b = row >> 13; if (t >= TP - 3) dst = out + O_CVP + ((size_t)(layer * 2 + b) * 3 + (t - (TP - 3))) * 1536 + c2; }
                        else { const int r2 = row - MP, s = r2 >> 2, j = r2 & 3; if (j >= 1) dst = out + O_CVS + ((size_t)(layer * 128 + s) * 3 + (j - 1)) * 1536 + c2; }
                    } else if (pn == 33) {
                        if (bj == 0 && wc == 0) dst = ZS + (size_t)row * 32 + 8 * fq;
                    }
                    if (dst) { *(f32x4*)dst = v0; *(f32x4*)(dst + 4) = v1; }
                }
                asm volatile("" ::: "memory");
            }
    }
};
struct EpiC {
    static constexpr bool PERM = true, AFTER_DRAIN = false;
    const bf16* Z; bf16* G;
    DI void operator()(const f32x4 (&acc)[2][2][4][2], const Unit& u, int wr, int wc, int fr, int fq) const {
        asm volatile("" : "+v"(fr), "+v"(fq), "+s"(wr), "+s"(wc));
#pragma unroll
        for (int ai = 0; ai < 2; ++ai) {
            v4u gw[4][2];
#pragma unroll
            for (int m = 0; m < 4; ++m)
#pragma unroll
                for (int bj = 0; bj < 2; ++bj) gw[m][bj] = *(const v4u*)(Z + (size_t)(u.pm * 256 + ai * 128 + wr * 64 + m * 16 + fr) * LDZ + ZC_MG + u.pn * 256 + bj * 128 + wc * 32 + 8 * fq);
#pragma unroll
            for (int m = 0; m < 4; ++m) {
                const int row = u.pm * 256 + ai * 128 + wr * 64 + m * 16 + fr;
#pragma unroll
                for (int bj = 0; bj < 2; ++bj) {
                    const int col = u.pn * 256 + bj * 128 + wc * 32 + 8 * fq;
                    f32x4 g0, g1; unpack8(gw[m][bj], g0, g1);
                    f32x4 v0 = acc[ai][bj][m][0], v1 = acc[ai][bj][m][1];
#pragma unroll
                    for (int e = 0; e < 4; ++e) { v0[e] *= sigmoidf_(g0[e]); v1[e] *= sigmoidf_(g1[e]); }
                    *(v4u*)(G + (size_t)row * 3072 + col) = pack8(v0, v1);
                }
            }
            asm volatile("" ::: "memory");
        }
    }
};
struct EpiRes {
    static constexpr bool PERM = true, AFTER_DRAIN = false;
    float* XR; bf16* XG; const float* gvec; float* SS; float* T; int mode;
    DI void operator()(const f32x4 (&acc)[2][2][4][2], const Unit& u, int wr, int wc, int fr, int fq) const {
        asm volatile("" : "+v"(fr), "+v"(fq), "+s"(wr), "+s"(wc));
        if (mode == 3) return;
        if (mode == 1) {
#pragma unroll
            for (int ai = 0; ai < 2; ++ai)
#pragma unroll
                for (int m = 0; m < 4; ++m)
#pragma unroll
                    for (int bj = 0; bj < 2; ++bj) { const size_t o = (size_t)(u.pm * 256 + ai * 128 + wr * 64 + m * 16 + fr) * DM + u.pn * 256 + bj * 128 + wc * 32 + 8 * fq;
                        *(f32x4*)(T + o) = acc[ai][bj][m][0]; *(f32x4*)(T + o + 4) = acc[ai][bj][m][1]; }
            return;
        }
#pragma unroll
        for (int ai = 0; ai < 2; ++ai)
#pragma unroll
            for (int mp = 0; mp < 2; ++mp) {
                f32x4 xr[2][2][2], tt[2][2][2];
#pragma unroll
                for (int mm = 0; mm < 2; ++mm)
#pragma unroll
                    for (int bj = 0; bj < 2; ++bj) { const size_t o = (size_t)(u.pm * 256 + ai * 128 + wr * 64 + (2 * mp + mm) * 16 + fr) * DM + u.pn * 256 + bj * 128 + wc * 32 + 8 * fq;
                        xr[mm][bj][0] = *(const f32x4*)(XR + o); xr[mm][bj][1] = *(const f32x4*)(XR + o + 4);
                        if (mode == 2) { tt[mm][bj][0] = *(const f32x4*)(T + o); tt[mm][bj][1] = *(const f32x4*)(T + o + 4); } }
#pragma unroll
                for (int mm = 0; mm < 2; ++mm) {
                    const int m = 2 * mp + mm;
                    const int row = u.pm * 256 + ai * 128 + wr * 64 + m * 16 + fr;
                    float ssq = 0.f;
#pragma unroll
                    for (int bj = 0; bj < 2; ++bj) {
                        const int col = u.pn * 256 + bj * 128 + wc * 32 + 8 * fq;
                        const size_t o = (size_t)row * DM + col;
                        f32x4 a0 = acc[ai][bj][m][0], a1 = acc[ai][bj][m][1];
                        f32x4 x0 = xr[mm][bj][0], x1 = xr[mm][bj][1];
                        if (mode == 2) {
#pragma unroll
                            for (int e = 0; e < 4; ++e) { a0[e] = tt[mm][bj][0][e] * sigmoidf_(a0[e]); a1[e] = tt[mm][bj][1][e] * sigmoidf_(a1[e]); } }
                        x0 += a0; x1 += a1;
                        *(f32x4*)(XR + o) = x0; *(f32x4*)(XR + o + 4) = x1;
                        ssq += (x0[0] * x0[0] + x0[1] * x0[1]) + (x0[2] * x0[2] + x0[3] * x0[3]) + (x1[0] * x1[0] + x1[1] * x1[1]) + (x1[2] * x1[2] + x1[3] * x1[3]);
                        if (XG) { if (gvec) { const f32x4 g0 = *(const f32x4*)(gvec + col), g1 = *(const f32x4*)(gvec + col + 4); x0 *= g0; x1 *= g1; }
                            *(v4u*)(XG + o) = pack8(x0, x1); }
                    }
                    if (SS) { ssq += shx<16>(ssq, fr + 16 * fq); ssq += shx<32>(ssq, fr + 16 * fq); if (fq == 0) SS[(size_t)row * 16 + u.pn * 4 + wc] = ssq; }
                }
                asm volatile("" ::: "memory");
            }
    }
};
struct EpiUp {
    static constexpr bool PERM = true, AFTER_DRAIN = false;
    bf16* H; const float* SS;
    DI void operator()(const f32x4 (&acc)[2][2][4][2], const Unit& u, int wr, int wc, int fr, int fq) const {
        asm volatile("" : "+v"(fr), "+v"(fq), "+s"(wr), "+s"(wc));
        float rs[2][4];
#pragma unroll
        for (int ai = 0; ai < 2; ++ai)
#pragma unroll
            for (int m = 0; m < 4; ++m) rs[ai][m] = row_rstd(SS, u.pm * 256 + ai * 128 + wr * 64 + m * 16 + fr, fq, fr + 16 * fq);
#pragma unroll
        for (int ai = 0; ai < 2; ++ai)
#pragma unroll
            for (int m = 0; m < 4; ++m) {
                const int row = u.pm * 256 + ai * 128 + wr * 64 + m * 16 + fr;
                const float rstd = rs[ai][m];
#pragma unroll
                for (int bj = 0; bj < 2; ++bj) {
                    const int col = u.pn * 256 + bj * 128 + wc * 32 + 8 * fq;
                    f32x4 v0 = acc[ai][bj][m][0] * rstd, v1 = acc[ai][bj][m][1] * rstd;
#pragma unroll
                    for (int e = 0; e < 4; ++e) { const float a = fmaxf(v0[e], 0.f), b = fmaxf(v1[e], 0.f); v0[e] = a * a; v1[e] = b * b; }
                    *(v4u*)(H + (size_t)row * DFF + col) = pack8(v0, v1);
                }
                asm volatile("" ::: "memory");
            }
    }
};
}
constexpr size_t al256(size_t x) { return (x + 255) & ~(size_t)255; }
constexpr size_t WS_CTL = 0, CTL_ZERO_BYTES = 1u << 20;
constexpr size_t SZ_WIN = (size_t)LDZ * DM * 2, SZ_WBR = (size_t)3072 * 512 * 2, SZ_WO3 = (size_t)DM * 3072 * 2, SZ_WUP = (size_t)DFF * DM * 2, SZ_WDN = (size_t)DM * DFF * 2,
                 SZ_WPL = (size_t)DM * PLE * 2, SZ_WPG = (size_t)DM * DM * 2, SZ_W1T = (size_t)2 * 64 * 2048 * 2, SZ_W2T = (size_t)2 * 64 * 64 * 2;
constexpr size_t WS_WIN = CTL_ZERO_BYTES, WS_WBR = WS_WIN + 2 * SZ_WIN, WS_WO3 = WS_WBR + 2 * SZ_WBR, WS_WUP = WS_WO3 + 2 * SZ_WO3, WS_WDN = WS_WUP + 2 * SZ_WUP,
                 WS_WPL = WS_WDN + 2 * SZ_WDN, WS_WPG = WS_WPL + 2 * SZ_WPL, WS_W1T = WS_WPG + 2 * SZ_WPG, WS_W2T = WS_W1T + 2 * SZ_W1T, WS_ROT = al256(WS_W2T + 2 * SZ_W2T);
constexpr size_t WS_P16 = WS_ROT + (size_t)TP * 64 * 8;
constexpr size_t WS_XR = WS_P16 + (size_t)2 * MROWS * PLE * 2;
constexpr size_t WS_XGA = WS_XR + (size_t)MROWS * DM * 4, WS_XGB = WS_XGA + (size_t)MROWS * DM * 2, WS_XGC = WS_XGB + (size_t)MROWS * DM * 2;
constexpr size_t WS_SSA = WS_XGC + (size_t)MROWS * DM * 2, WS_SSB = WS_SSA + (size_t)MROWS * 64;
constexpr size_t WS_Z = WS_SSB + (size_t)MROWS * 64, WS_ZS = WS_Z + (size_t)MROWS * LDZ * 2;
constexpr size_t WS_MIX = WS_ZS + (size_t)MROWS * 128, WS_GATED = WS_MIX + (size_t)MROWS * 1536 * 2, WS_HMID = WS_GATED + (size_t)MROWS * 3072 * 2;
constexpr size_t WS_TPLE = WS_HMID + (size_t)MROWS * DFF * 2;
constexpr size_t WS_KC = WS_TPLE + (size_t)MROWS * DM * 4;
constexpr size_t WS_KCS = WS_KC + (size_t)2 * 2 * 512 * 2 * 64 * 2;
constexpr int GREC = 73984;
constexpr size_t WS_GREC = WS_KCS + (size_t)2 * 128 * 128 * 2 * 64 * 2;
constexpr size_t WS_OGDN = WS_GREC + (size_t)1024 * GREC;
constexpr size_t WS_RKV = WS_OGDN + (size_t)MROWS * 512 * 4;
constexpr size_t WS_RST = WS_RKV + (size_t)512 * 16384 * 4;
constexpr size_t WS_QR = WS_RST + (size_t)512 * 16384 * 2, WS_KR = WS_QR + (size_t)MP * 512 * 2;
constexpr size_t WS_END = WS_KR + (size_t)MP * 512 * 2;
static_assert(WS_W1T % 256 == 0 && WS_Z % 256 == 0 && WS_GREC % 256 == 0 && WS_RKV % 256 == 0 && WS_KC % 256 == 0 && WS_XR % 256 == 0, "ws alignment");

constexpr int CW_TMO = 0, CW_BAR = 4096, CW_QUEUE = 8192;
constexpr int NWAVES = 8, NTHREADS = 512;
constexpr int RING_BYTES = 147456, LDSCTL_OFF = RING_BYTES, MISC_OFF = LDSCTL_OFF + 320, LDS_BYTES = RING_BYTES + 1024;

#define RLX_AGENT __ATOMIC_RELAXED, __HIP_MEMORY_SCOPE_AGENT
#define LDS_WAIT() asm volatile("s_waitcnt lgkmcnt(0)" ::: "memory")
#define VM_WAIT() asm volatile("s_waitcnt vmcnt(0)" ::: "memory")
#define XB_TMO      128
#define XB_XCNT(j)  (256  + 64 * (j))
#define XB_XSUB(j)  (1280 + 64 * (j))
#define XB_XGEN(j)  (2304 + 64 * (j))
#define XB_TOP      3328
#define XB_TOPGEN   3392
#define XCD_BAR_WORDS 3456
#define XB_SPIN_CAP (1u << 18)

__device__ __forceinline__ unsigned xb_ld(unsigned* p)              { return __hip_atomic_load(p, __ATOMIC_RELAXED, __HIP_MEMORY_SCOPE_AGENT); }
__device__ __forceinline__ unsigned xb_add(unsigned* p, unsigned v) { return __hip_atomic_fetch_add(p, v, __ATOMIC_RELAXED, __HIP_MEMORY_SCOPE_AGENT); }
__device__ __forceinline__ unsigned xb_xcc_id() { return (unsigned)__builtin_amdgcn_s_getreg((3 << 11) | 20) & 0xFu; }
#define XB_SPIN(cond, bar) do { unsigned _sp = 0; while (cond) { __builtin_amdgcn_s_sleep(1); \
    if ((++_sp & 255u) == 0u) { if (xb_ld(&(bar)[XB_TMO])) break; if (_sp > XB_SPIN_CAP) { atomicAdd(&(bar)[XB_TMO], 1u); break; } } } } while (0)

struct XcdBarrier {
    unsigned* bar; unsigned x;
    volatile LAS unsigned* st;
};

__device__ __forceinline__ XcdBarrier xcd_barrier_post(unsigned* bar, volatile LAS unsigned* st, bool t0) {
    XcdBarrier b; b.bar = bar; b.x = xb_xcc_id(); b.st = st;
    if (t0) (void)xb_add(&bar[XB_XCNT(b.x)], 1u);
    return b;
}
__device__ __forceinline__ void xcd_barrier_complete(unsigned* bar, unsigned x, unsigned& nloc, unsigned& nx) {
    const unsigned G = gridDim.x * gridDim.y * gridDim.z;
    unsigned sum, cnt, mine, sp = 0u;
    for (;;) {
        sum = 0u; cnt = 0u; mine = 0u;
#pragma unroll
        for (unsigned j = 0; j < 16; ++j) { const unsigned c = xb_ld(&bar[XB_XCNT(j)]); sum += c; cnt += (c > 0u) ? 1u : 0u; mine = (j == x) ? c : mine; }
        if (sum == G) break;
        __builtin_amdgcn_s_sleep(1);
        if ((++sp & 255u) == 0u) { if (xb_ld(&bar[XB_TMO])) break; if (sp > XB_SPIN_CAP) { atomicAdd(&bar[XB_TMO], 1u); break; } }
    }
    nloc = mine > 0u ? mine : 1u; nx = cnt > 0u ? cnt : 1u;
}

__device__ __forceinline__ void xcd_barrier(const XcdBarrier& b, bool t0) {
    asm volatile("s_waitcnt vmcnt(0)" ::: "memory");
    __syncthreads();
    if (t0) {
        unsigned* bar = b.bar;
        __builtin_amdgcn_s_waitcnt(0);
        unsigned nloc = b.st[0], nx = b.st[1];
        if (nloc == 0u) { xcd_barrier_complete(bar, b.x, nloc, nx); b.st[0] = nloc; b.st[1] = nx; }
        const unsigned old = xb_add(&bar[XB_XSUB(b.x)], 1u);
        const unsigned gen = old / nloc;
        if (old + 1u == (gen + 1u) * nloc) {
            __builtin_amdgcn_fence(__ATOMIC_RELEASE, "agent");
            asm volatile("s_waitcnt vmcnt(0)" ::: "memory");
            const unsigned og = xb_add(&bar[XB_TOP], 1u);
            const unsigned tg = og / nx;
            if (og + 1u == (tg + 1u) * nx) xb_add(&bar[XB_TOPGEN], 1u);
            else XB_SPIN(xb_ld(&bar[XB_TOPGEN]) == tg, bar);
            __builtin_amdgcn_fence(__ATOMIC_ACQUIRE, "agent");
            xb_add(&bar[XB_XGEN(b.x)], 1u);
            asm volatile("s_waitcnt vmcnt(0)" ::: "memory");
        } else {
            XB_SPIN(xb_ld(&bar[XB_XGEN(b.x)]) == gen, bar);
            __builtin_amdgcn_fence(__ATOMIC_ACQUIRE, "agent");
            asm volatile("s_waitcnt vmcnt(0)" ::: "memory");
        }
    }
    __syncthreads();
}
typedef const void* const __attribute__((address_space(4)))* kargp_t;
DI const float* KIN(int i) { const GAS float* p = (const GAS float*)((kargp_t)__builtin_amdgcn_kernarg_segment_ptr())[i]; asm volatile("" : "+s"(p)); return (const float*)p; }
DI float* KOUT() { GAS float* p = (GAS float*)((kargp_t)__builtin_amdgcn_kernarg_segment_ptr())[27]; asm volatile("" : "+s"(p)); return (float*)p; }
DI unsigned char* KWS() { GAS unsigned char* p = (GAS unsigned char*)((kargp_t)__builtin_amdgcn_kernarg_segment_ptr())[28]; asm volatile("" : "+s"(p)); return (unsigned char*)p; }
struct Frame {
    LAS unsigned char* lds;
    gu32* ctl;
    int tid, lane, wave, G, bid;
};
DI bf16x8 ld_frag_g(const bf16* p) { return __builtin_bit_cast(bf16x8, *(const v4u*)p); }
DI bf16x8 ld_frag_l(const LAS unsigned char* p) { return *(const LAS bf16x8*)p; }
DI f32x4 mfma16(bf16x8 a, bf16x8 b, f32x4 c) { return __builtin_amdgcn_mfma_f32_16x16x32_bf16(a, b, c, 0, 0, 0); }
DI bf16x8 pack_frag(const f32x4 a, const f32x4 b) { return __builtin_bit_cast(bf16x8, pack8(a, b)); }
DI int lane_id() { int l; asm volatile("v_mbcnt_lo_u32_b32 %0, -1, 0\n\tv_mbcnt_hi_u32_b32 %0, -1, %0" : "=v"(l)); return l; }
DI Frame fresh(const Frame& F0) {
    Frame F = F0; int w = F0.wave, g = F0.G, b = F0.bid; asm volatile("" : "+s"(w), "+s"(g), "+s"(b));
    int l = lane_id(); asm volatile("" : "+v"(l));
    unsigned lb = (unsigned)(uintptr_t)F0.lds; asm volatile("" : "+s"(lb)); F.lds = (LAS unsigned char*)(uintptr_t)lb;
    F.wave = w; F.lane = l; F.tid = w * 64 + l; F.G = g; F.bid = b; return F;
}
#define GRID_BAR() do { XcdBarrier b_; b_.bar = (unsigned*)((gu32*)(KWS() + WS_CTL) + CW_BAR); b_.x = xb_xcc_id(); b_.st = (volatile LAS unsigned*)(F.lds + MISC_OFF) + 8; \
    const Frame Fb_ = fresh(F); xcd_barrier(b_, Fb_.tid == 0); } while (0)
DI int win_colmap(int j) {
    if (j < 1280) return j; if (j < 2816) return j + 24; if (j < 8448) return j + 32; if (j < 8472) return j - 8448 + 1280; if (j < 8480) return j - 8472 + 2840; return -1;
}
DI void tr_item(const float* W, int ldw, int k0, int srccol, bf16* WT, size_t dst_row0, int ldt, int kdst0, int nrep, int krep, LAS float* scr, int lane) {
#pragma unroll 8
    for (int i = 0; i < 32; ++i) { const int kk = 2 * i + (lane >> 5); const float v_ = W[(size_t)(k0 + kk) * ldw + (srccol >= 0 ? srccol : 0)]; scr[kk * 33 + (lane & 31)] = (srccol >= 0) ? v_ : 0.f; }
    LDS_WAIT(); asm volatile("" ::: "memory");
    const int c = lane & 7;
#pragma unroll
    for (int j = 0; j < 4; ++j) { const int n = (lane >> 3) + 8 * j; const LAS float* s = scr + (8 * c) * 33 + n;
        v4u o; o.x = pk2(s[0 * 33], s[1 * 33]); o.y = pk2(s[2 * 33], s[3 * 33]); o.z = pk2(s[4 * 33], s[5 * 33]); o.w = pk2(s[6 * 33], s[7 * 33]);
        for (int r = 0; r < nrep; ++r) *(v4u*)(WT + (dst_row0 + n) * (size_t)ldt + kdst0 + r * krep + 8 * c) = o; }
    LDS_WAIT(); asm volatile("" ::: "memory");
}
DI void p0_prologue(Frame& F) {
    LAS float* scr = (LAS float*)(F.lds + F.wave * 16384);
    const int gw = F.bid * NWAVES + F.wave, NGW = F.G * NWAVES, lane = F.lane;
    unsigned char* ws = KWS();
    constexpr int I_A = 16 * 272, I_B = 3 * 8 * 32, I_C = 16 * 32, I_D = 16 * 128, I_E = 64 * 32, I_F = 4 * 32, I_G = 16 * 32, I_H = 2 * 32 * 2, I_I = 2 * 2;
    constexpr int I_L = I_A + I_B + I_C + I_D + I_E + I_F + I_G + I_H + I_I;
    for (int it = gw; it < 2 * I_L; it += NGW) {
        const int l = it / I_L; int r = it % I_L;
        if (r < I_A) { const int kb = r / 272, nb = r % 272; tr_item(KIN(11) + (size_t)l * DM * 8480, 8480, 64 * kb, win_colmap(32 * nb + (lane & 31)), (bf16*)(ws + WS_WIN + l * SZ_WIN), 32 * nb, DM, 64 * kb, 1, 0, scr, lane); continue; } r -= I_A;
        if (r < I_B) { const int b = r / 256, kb = (r % 256) / 32, nb = r % 32; tr_item(KIN(19) + (size_t)(l * 3 + b) * 512 * DM, DM, 64 * kb, 32 * nb + (lane & 31), (bf16*)(ws + WS_WBR + l * SZ_WBR), b * 1024 + 32 * nb, 512, 64 * kb, 1, 0, scr, lane); continue; } r -= I_B;
        if (r < I_C) { const int kb = r / 32, nb = r % 32; tr_item(KIN(20) + (size_t)l * DM * DM, DM, 64 * kb, 32 * nb + (lane & 31), (bf16*)(ws + WS_WO3 + l * SZ_WO3), 32 * nb, 3072, 64 * kb, 3, 1024, scr, lane); continue; } r -= I_C;
        if (r < I_D) { const int kb = r / 128, nb = r % 128; tr_item(KIN(22) + (size_t)l * DM * DFF, DFF, 64 * kb, 32 * nb + (lane & 31), (bf16*)(ws + WS_WUP + l * SZ_WUP), 32 * nb, DM, 64 * kb, 1, 0, scr, lane); continue; } r -= I_D;
        if (r < I_E) { const int kb = r / 32, nb = r % 32; tr_item(KIN(23) + (size_t)l * DFF * DM, DM, 64 * kb, 32 * nb + (lane & 31), (bf16*)(ws + WS_WDN + l * SZ_WDN), 32 * nb, DFF, 64 * kb, 1, 0, scr, lane); continue; } r -= I_E;
        if (r < I_F) { const int kb = r / 32, nb = r % 32; tr_item(KIN(24) + (size_t)l * PLE * DM, DM, 64 * kb, 32 * nb + (lane & 31), (bf16*)(ws + WS_WPL + l * SZ_WPL), 32 * nb, PLE, 64 * kb, 1, 0, scr, lane); continue; } r -= I_F;
        if (r < I_G) { const int kb = r / 32, nb = r % 32; tr_item(KIN(25) + (size_t)l * DM * DM, DM, 64 * kb, 32 * nb + (lane & 31), (bf16*)(ws + WS_WPG + l * SZ_WPG), 32 * nb, DM, 64 * kb, 1, 0, scr, lane); continue; } r -= I_G;
        if (r < I_H) { const int kv = r / 64, kb = (r % 64) / 2, nb = r % 2; tr_item(KIN(13) + (size_t)(l * 2 + kv) * 2048 * 64, 64, 64 * kb, 32 * nb + (lane & 31), (bf16*)(ws + WS_W1T + l * SZ_W1T) + (size_t)kv * 64 * 2048, 32 * nb, 2048, 64 * kb, 1, 0, scr, lane); continue; } r -= I_H;
        { const int kv = r / 2, nb = r % 2; tr_item(KIN(14) + (size_t)(l * 2 + kv) * 64 * 64, 64, 0, 32 * nb + (lane & 31), (bf16*)(ws + WS_W2T + l * SZ_W2T) + (size_t)kv * 64 * 64, 32 * nb, 64, 0, 1, 0, scr, lane); }
    }
    float* XR = (float*)(ws + WS_XR); bf16* XGA = (bf16*)(ws + WS_XGA); float* SSA = (float*)(ws + WS_SSA); bf16* P16 = (bf16*)(ws + WS_P16);
    const float* g0 = KIN(10);
    for (int row = gw; row < MROWS; row += NGW) {
        const float* xs = (row < MP) ? KIN(0) + (size_t)row * DM : KIN(1) + (size_t)(row - MP) * DM;
        float ss = 0.f;
#pragma unroll
        for (int j = 0; j < 2; ++j) {
            const int c = j * 512 + lane * 8;
            f32x4 a = *(const f32x4*)(xs + c), b = *(const f32x4*)(xs + c + 4);
            *(f32x4*)(XR + (size_t)row * DM + c) = a; *(f32x4*)(XR + (size_t)row * DM + c + 4) = b;
            ss += (a[0] * a[0] + a[1] * a[1]) + (a[2] * a[2] + a[3] * a[3]) + (b[0] * b[0] + b[1] * b[1]) + (b[2] * b[2] + b[3] * b[3]);
            const f32x4 ga = *(const f32x4*)(g0 + c), gb = *(const f32x4*)(g0 + c + 4);
            *(v4u*)(XGA + (size_t)row * DM + c) = pack8(a * ga, b * gb);
        }
        ss = wave_sum(ss, lane);
        if (lane < 16) SSA[(size_t)row * 16 + lane] = (lane == 0) ? ss : 0.f;
#pragma unroll
        for (int l = 0; l < 2; ++l) {
            const float* ps = (row < MP) ? KIN(8) + ((size_t)l * MP + row) * PLE : KIN(9) + ((size_t)l * MS + (row - MP)) * PLE;
            const f32x4 a = *(const f32x4*)(ps + lane * 4);
            v2u o; o.x = pk2(a[0], a[1]); o.y = pk2(a[2], a[3]);
            *(v2u*)(P16 + ((size_t)l * MROWS + row) * PLE + lane * 4) = o;
        }
    }
    const int gt = F.bid * NTHREADS + F.tid, NGT = F.G * NTHREADS;
    f32x2* ROT = (f32x2*)(ws + WS_ROT);
    for (int e = gt; e < TP * 64; e += NGT) {
        const int pos = e >> 6, i = e & 63;
        const float x = (float)i * (1.0f / 63.0f);
        const float inv = exp2f(-x * 13.287712379549449f);
        const float ang = (float)pos * inv;
        const double rev = (double)ang * 0.15915494309189535;
        const float fr = (float)(rev - floor(rev));
        ROT[e] = (f32x2){__builtin_amdgcn_cosf(fr), __builtin_amdgcn_sinf(fr)};
    }
    {
        const float* src = KIN(3); float* dst = KOUT() + O_WINS;
        constexpr int NE = 2 * 128 * 508 * 64;
        for (int e0 = gt; e0 < NE; e0 += 8 * NGT) {
            f32x4 v[8];
#pragma unroll
            for (int u = 0; u < 8; ++u) { const int e = e0 + u * NGT; const int ec = e < NE ? e : NE - 1; const int ls = ec / (508 * 64), r = ec % (508 * 64);
                v[u] = *(const f32x4*)(src + (size_t)ls * 512 * 256 + 4 * 256 + (size_t)r * 4); }
#pragma unroll
            for (int u = 0; u < 8; ++u) { const int e = e0 + u * NGT; if (e < NE) { const int ls = e / (508 * 64), r = e % (508 * 64); *(f32x4*)(dst + (size_t)ls * 512 * 256 + (size_t)r * 4) = v[u]; } }
        }
    }
}
DI float gelu_tanh(float x) { const float u = 0.7978845608028654f * (x + 0.044715f * x * x * x); const float e = __expf(2.f * u); return 0.5f * x * (1.f + (1.f - 2.f / (e + 1.f))); }
DI bf16x8 mk_frag(v2u a, v2u b) { v4u w; w.x = a.x; w.y = a.y; w.z = b.x; w.w = b.y; return __builtin_bit_cast(bf16x8, w); }

template <bool sample> DI void compress_job_t(Frame& F, int layer, int job) {
    int lane = F.lane, wave = F.wave; asm volatile("" : "+v"(lane), "+s"(wave));
    const int tid = wave * 64 + lane, quad = lane >> 4, rl = lane & 15;
    unsigned char* ws = KWS();
    int kv, bs, g0, nbase;
    if (sample) { kv = job >> 7; bs = job & 127; g0 = 0; nbase = 0; }
    else { const int j2 = job - 256; kv = j2 >> 3; bs = (j2 >> 2) & 1; g0 = (j2 >> 1) & 1; nbase = (j2 & 1) * 256; }
    const bf16* W1T = (const bf16*)(ws + WS_W1T + layer * SZ_W1T) + (size_t)kv * 64 * 2048;
    const bf16* W2T = (const bf16*)(ws + WS_W2T + layer * SZ_W2T) + (size_t)kv * 64 * 64;
    const float* pe = KIN(12) + (size_t)(layer * 2 + kv) * 32 * 64;
    const bf16* Z = (const bf16*)(ws + WS_Z);
    const int* pt = (const int*)KIN(7);
    const float* cache = KIN(2);
    LAS unsigned char* LW = F.lds;
    int gg[2], nn[2];
    size_t pb0[2], pb1[2];
#pragma unroll
    for (int tl = 0; tl < 2; ++tl) { const int T = 2 * wave + tl; if (sample) { gg[tl] = T >> 3; nn[tl] = 16 * (T & 7) + rl; } else { gg[tl] = g0; nn[tl] = nbase + 16 * T + rl; }
        pb0[tl] = 0; pb1[tl] = 0;
        if (sample) { const int p0 = (16 * nn[tl]) >> 7; const int p1 = p0 + 1 > 15 ? 15 : p0 + 1;
            pb0[tl] = (size_t)(layer * 2560 + pt[bs * 16 + p0]) * 128 * 512; pb1[tl] = (size_t)(layer * 2560 + pt[bs * 16 + p1]) * 128 * 512; } }
    f32x4 h[2][4];
#pragma unroll
    for (int tl = 0; tl < 2; ++tl)
#pragma unroll
        for (int i = 0; i < 4; ++i) h[tl][i] = (f32x4){0.f, 0.f, 0.f, 0.f};
#pragma unroll 1
    for (int c = 0; c < 4; ++c) {
        __syncthreads();
#pragma unroll
        for (int k = 0; k < 8; ++k) { const int pc = tid + 512 * k, r = pc >> 6, c16 = pc & 63;
            *(LAS v4u*)(LW + r * 1040 + c16 * 16) = *(const v4u*)(W1T + (size_t)r * 2048 + c * 512 + c16 * 8); }
        __syncthreads();
#pragma unroll 8
        for (int kk = 0; kk < 16; ++kk) {
            const int j = 8 * c + (kk >> 1), dim0 = (kk & 1) * 32 + quad * 8;
            const f32x4 pe0 = *(const f32x4*)(pe + j * 64 + dim0), pe1 = *(const f32x4*)(pe + j * 64 + dim0 + 4);
            bf16x8 xb[2];
#pragma unroll
            for (int tl = 0; tl < 2; ++tl) {
                f32x4 x0, x1;
                if (!sample) { const size_t row = (size_t)bs * TP + 16 * nn[tl] + j; unpack8(*(const v4u*)(Z + row * LDZ + ZC_KC + kv * 128 + gg[tl] * 64 + dim0), x0, x1); }
                else { int pos = 16 * nn[tl] + j; pos = pos > 2047 ? 2047 : pos;
                    const float* p = cache + (((pos >> 7) == ((16 * nn[tl]) >> 7)) ? pb0[tl] : pb1[tl]) + (size_t)(pos & 127) * 512 + kv * 128 + gg[tl] * 64 + dim0; x0 = *(const f32x4*)p; x1 = *(const f32x4*)(p + 4); }
                xb[tl] = pack_frag(x0 + pe0, x1 + pe1);
            }
#pragma unroll
            for (int ht = 0; ht < 4; ++ht) {
                const bf16x8 a = ld_frag_l(LW + (16 * ht + rl) * 1040 + (kk * 32 + quad * 8) * 2);
                h[0][ht] = mfma16(a, xb[0], h[0][ht]); h[1][ht] = mfma16(a, xb[1], h[1][ht]);
            }
        }
    }
#pragma unroll
    for (int tl = 0; tl < 2; ++tl) {
#pragma unroll
        for (int ht = 0; ht < 4; ++ht)
#pragma unroll
            for (int i = 0; i < 4; ++i) h[tl][ht][i] = gelu_tanh(h[tl][ht][i]);
        bf16x8 gb[2]; gb[0] = pack_frag(h[tl][0], h[tl][1]); gb[1] = pack_frag(h[tl][2], h[tl][3]);
        const int n = nn[tl], g = gg[tl];
        bf16* dst = sample ? (bf16*)(ws + WS_KCS) + ((((size_t)kv * 128 + bs) * 128 + n) * 2 + g) * 64 : (bf16*)(ws + WS_KC) + ((((size_t)kv * 2 + bs) * 512 + n) * 2 + g) * 64;
        const bool zero = sample && n == 127;
#pragma unroll
        for (int ot = 0; ot < 4; ++ot) {
            f32x4 o = (f32x4){0.f, 0.f, 0.f, 0.f};
#pragma unroll
            for (int s = 0; s < 2; ++s) {
                const bf16* wp = W2T + (16 * ot + rl) * 64 + 32 * s + 4 * quad;
                o = mfma16(mk_frag(*(const v2u*)wp, *(const v2u*)(wp + 16)), gb[s], o);
            }
            v2u w; w.x = zero ? 0u : pk2(o[0], o[1]); w.y = zero ? 0u : pk2(o[2], o[3]);
            *(v2u*)(dst + 16 * ot + 4 * quad) = w;
        }
    }
    __syncthreads();
}

DI v2u pack4(const f32x4 v) { v2u w; w.x = pk2(v[0], v[1]); w.y = pk2(v[2], v[3]); return w; }
DI void compress_sample_job(Frame& F, int layer, int job) {
    int lane = F.lane, wave = F.wave; asm volatile("" : "+v"(lane), "+s"(wave));
    const int tid = wave * 64 + lane, quad = lane >> 4, rl = lane & 15;
    unsigned char* ws = KWS();
    const int kv = job >> 7, bs = job & 127;
    const bf16* W1T = (const bf16*)(ws + WS_W1T + layer * SZ_W1T) + (size_t)kv * 64 * 2048;
    const bf16* W2T = (const bf16*)(ws + WS_W2T + layer * SZ_W2T) + (size_t)kv * 64 * 64;
    const float* pe = KIN(12) + (size_t)(layer * 2 + kv) * 32 * 64;
    const int* pt = (const int*)KIN(7);
    const float* cache = KIN(2);
    LAS unsigned char* XS = F.lds;
    LAS unsigned char* WS1 = F.lds + 69632;
    size_t toff[8];
#pragma unroll
    for (int k = 0; k < 8; ++k) { const int q = tid + 512 * k, m = q >> 5; const int pos = 16 * m; const int phys = pt[bs * 16 + (pos >> 7)];
        toff[k] = ((size_t)(layer * 2560 + phys) * 128 + (pos & 127)) * 512 + kv * 128 + 4 * (q & 31); }
    const int wr_ = tid >> 3, wc_ = tid & 7;
    int gg[2], nn[2];
#pragma unroll
    for (int tl = 0; tl < 2; ++tl) { const int T = 2 * wave + tl; gg[tl] = T >> 3; nn[tl] = 16 * (T & 7) + rl; }
    f32x4 h[2][4];
#pragma unroll
    for (int tl = 0; tl < 2; ++tl)
#pragma unroll
        for (int i = 0; i < 4; ++i) h[tl][i] = (f32x4){0.f, 0.f, 0.f, 0.f};
    f32x4 xr[8]; v4u wr2[2];
#define CS_ISSUE(r_) do { _Pragma("unroll") for (int k = 0; k < 8; ++k) xr[k] = *(const f32x4*)(cache + toff[k] + (size_t)(r_) * 512); \
        _Pragma("unroll") for (int u = 0; u < 2; ++u) wr2[u] = *(const v4u*)(W1T + (size_t)wr_ * 2048 + ((r_) + 16 * u) * 64 + wc_ * 8); } while (0)
    CS_ISSUE(0);
#pragma unroll 1
    for (int r = 0; r < 16; ++r) {
        __syncthreads();
#pragma unroll
        for (int k = 0; k < 8; ++k) { const int q = tid + 512 * k, m = q >> 5, c = q & 31, d = 4 * (c & 15);
#pragma unroll
            for (int u = 0; u < 2; ++u) { const f32x4 v = xr[k] + *(const f32x4*)(pe + (r + 16 * u) * 64 + d);
                *(LAS v2u*)(XS + u * 34816 + m * 272 + c * 8) = pack4(v); } }
#pragma unroll
        for (int u = 0; u < 2; ++u) *(LAS v4u*)(WS1 + u * 9216 + wr_ * 144 + wc_ * 16) = wr2[u];
        __syncthreads();
        { const int rn = r + 1 < 16 ? r + 1 : 15; CS_ISSUE(rn); }
#pragma unroll
        for (int u = 0; u < 2; ++u)
#pragma unroll
            for (int ks = 0; ks < 2; ++ks) {
                bf16x8 xb[2];
#pragma unroll
                for (int tl = 0; tl < 2; ++tl) { int m = nn[tl] + u; m = m > 127 ? 127 : m; xb[tl] = ld_frag_l(XS + u * 34816 + m * 272 + gg[tl] * 128 + ks * 64 + quad * 16); }
#pragma unroll
                for (int ht = 0; ht < 4; ++ht) { const bf16x8 a = ld_frag_l(WS1 + u * 9216 + (16 * ht + rl) * 144 + ks * 64 + quad * 16);
                    h[0][ht] = mfma16(a, xb[0], h[0][ht]); h[1][ht] = mfma16(a, xb[1], h[1][ht]); }
            }
    }
#undef CS_ISSUE
#pragma unroll
    for (int tl = 0; tl < 2; ++tl) {
#pragma unroll
        for (int ht = 0; ht < 4; ++ht)
#pragma unroll
            for (int i = 0; i < 4; ++i) h[tl][ht][i] = gelu_tanh(h[tl][ht][i]);
        bf16x8 gb[2]; gb[0] = pack_frag(h[tl][0], h[tl][1]); gb[1] = pack_frag(h[tl][2], h[tl][3]);
        const int n = nn[tl], g = gg[tl];
        bf16* dst = (bf16*)(ws + WS_KCS) + ((((size_t)kv * 128 + bs) * 128 + n) * 2 + g) * 64;
        const bool zero = n == 127;
#pragma unroll
        for (int ot = 0; ot < 4; ++ot) {
            f32x4 o = (f32x4){0.f, 0.f, 0.f, 0.f};
#pragma unroll
            for (int s = 0; s < 2; ++s) {
                const bf16* wp = W2T + (16 * ot + rl) * 64 + 32 * s + 4 * quad;
                o = mfma16(mk_frag(*(const v2u*)wp, *(const v2u*)(wp + 16)), gb[s], o);
            }
            v2u w; w.x = zero ? 0u : pk2(o[0], o[1]); w.y = zero ? 0u : pk2(o[2], o[3]);
            *(v2u*)(dst + 16 * ot + 4 * quad) = w;
        }
    }
    __syncthreads();
}
DI void compress_job(Frame& F, int layer, int job) { if (job < 256) compress_sample_job(F, layer, job); else compress_job_t<false>(F, layer, job); }
#ifndef PH_GPT
#define PH_GPT (-1)
#endif
#if PH_GPT >= 0
#define GP_T(k) do { if (tid == 0) { volatile LAS unsigned long long* gp_ = (volatile LAS unsigned long long*)(F.lds + LDSCTL_OFF + 448); const unsigned long long now_ = __builtin_amdgcn_s_memrealtime(); \
    if ((k) == PH_GPT) gp_[0] += now_ - gp_[1]; gp_[1] = now_; } } while (0)
#else
#define GP_T(k) do { } while (0)
#endif
DI int kperm(int idx) { const int s = idx >> 5, r = idx & 31; return 32 * s + 8 * ((r >> 2) & 3) + 4 * (r >> 4) + (r & 3); }
DI float softplusf_(float x) { return x > 20.f ? x : __logf(1.f + __expf(x)); }
DI float ret_lg(int h) { return h == 0 ? -0.031748697f : h == 1 ? -0.015748357f : h == 2 ? -0.007843178f : -0.0039138994f; }

DI void gdn_prep_unit(Frame& F, int layer, int unit) {
    int lane = F.lane, wave = F.wave; asm volatile("" : "+v"(lane), "+s"(wave));
    const int tid = wave * 64 + lane;
    const int b = unit >> 9, h = (unit >> 7) & 3, c = unit & 127;
    const int row0 = b * TP + 64 * c, t0 = 64 * c;
    GP_T(0);
    unsigned char* ws = KWS();
    const bf16* Z = (const bf16*)(ws + WS_Z);
    const float* ZS = (const float*)(ws + WS_ZS);
    LAS float* Lq = (LAS float*)(F.lds); LAS float* Lk = (LAS float*)(F.lds + 33792); LAS float* Lv = (LAS float*)(F.lds + 67584);
    LAS float* LA = (LAS float*)(F.lds + 101376); LAS float* LQK = (LAS float*)(F.lds + 117760);
    LAS float* Lg = (LAS float*)(F.lds + 134144); LAS float* Lb = Lg + 64; LAS float* Le = Lg + 128;
    const float* cw = KIN(15) + (size_t)layer * 4 * 1536;
    {
        v4u xs[6][4];
#pragma unroll
        for (int it0 = 0; it0 < 6; ++it0) {
            const int it = tid + it0 * NTHREADS, i = it / 48, ch = it % 48, col = (ch >> 4) * 512 + h * 128 + (ch & 15) * 8;
#pragma unroll
            for (int j = 0; j < 4; ++j) { const bool ok = (t0 + i - 3 + j) >= 0; xs[it0][j] = *(const v4u*)(Z + (size_t)(ok ? row0 + i - 3 + j : row0) * LDZ + ZC_GQKV + col); }
        }
        asm volatile("" ::: "memory");
#pragma unroll
        for (int it0 = 0; it0 < 6; ++it0) {
            const int it = tid + it0 * NTHREADS, i = it / 48, ch = it % 48, part = ch >> 4, cc = ch & 15;
            const int col = part * 512 + h * 128 + cc * 8;
            f32x4 y0 = (f32x4){0.f, 0.f, 0.f, 0.f}, y1 = y0;
#pragma unroll
            for (int j = 0; j < 4; ++j) {
                const float zf = ((t0 + i - 3 + j) >= 0) ? 1.f : 0.f;
                f32x4 x0, x1; unpack8(xs[it0][j], x0, x1);
                y0 += x0 * (*(const f32x4*)(cw + j * 1536 + col) * zf); y1 += x1 * (*(const f32x4*)(cw + j * 1536 + col + 4) * zf);
            }
#pragma unroll
            for (int e = 0; e < 4; ++e) { y0[e] = siluf_(y0[e]); y1[e] = siluf_(y1[e]); }
            LAS float* dst = (part == 0 ? Lq : part == 1 ? Lk : Lv) + i * 132 + cc * 8;
            *(LAS f32x4*)dst = y0; *(LAS f32x4*)(dst + 4) = y1;
        }
    }
    __syncthreads();
    GP_T(1);
    {
        float va[16], vb[16], ps[16];
#pragma unroll
        for (int q = 0; q < 16; ++q) { LAS float* vp = ((q < 8) ? Lq : Lk) + (wave * 8 + (q & 7)) * 132 + lane * 2; va[q] = vp[0]; vb[q] = vp[1]; ps[q] = va[q] * va[q] + vb[q] * vb[q]; }
#pragma unroll
        for (int q = 0; q < 16; ++q) ps[q] += shx<1>(ps[q], lane);
#pragma unroll
        for (int q = 0; q < 16; ++q) ps[q] += shx<2>(ps[q], lane);
#pragma unroll
        for (int q = 0; q < 16; ++q) ps[q] += shx<4>(ps[q], lane);
#pragma unroll
        for (int q = 0; q < 16; ++q) ps[q] += shx<8>(ps[q], lane);
#pragma unroll
        for (int q = 0; q < 16; ++q) ps[q] += shx<16>(ps[q], lane);
#pragma unroll
        for (int q = 0; q < 16; ++q) ps[q] += shx<32>(ps[q], lane);
#pragma unroll
        for (int q = 0; q < 16; ++q) { LAS float* vp = ((q < 8) ? Lq : Lk) + (wave * 8 + (q & 7)) * 132 + lane * 2; const float sc = rsqrtf(ps[q] + EPS) * ((q < 8) ? 0.08838834764831845f : 1.f); vp[0] = va[q] * sc; vp[1] = vb[q] * sc; }
    }
    if (wave == 0) {
        const float ga = ZS[(size_t)(row0 + lane) * 32 + 24 + h], gbv = ZS[(size_t)(row0 + lane) * 32 + 28 + h];
        float g = -__expf(KIN(16)[layer * 4 + h]) * softplusf_(ga + KIN(17)[layer * 4 + h]);
#pragma unroll
        for (int o = 1; o < 64; o <<= 1) { const float t = __int_as_float(__builtin_amdgcn_ds_bpermute(((lane - o) & 63) << 2, __float_as_int(g))); if (lane >= o) g += t; }
        Lg[lane] = g; Lb[lane] = sigmoidf_(gbv); Le[lane] = __expf(g);
    }
    __syncthreads();
    GP_T(2);
    {
        const int it = wave >> 1, quad = lane >> 4, rl = lane & 15;
        f32x4 ckk[2], cqk[2];
#pragma unroll
        for (int jj = 0; jj < 2; ++jj) { ckk[jj] = (f32x4){0.f, 0.f, 0.f, 0.f}; cqk[jj] = ckk[jj]; }
#pragma unroll
        for (int s = 0; s < 4; ++s) {
            const LAS float* kp = Lk + (16 * it + rl) * 132 + 32 * s + 8 * quad; const LAS float* qp = Lq + (16 * it + rl) * 132 + 32 * s + 8 * quad;
            const f32x4 ka0 = *(const LAS f32x4*)kp, ka1 = *(const LAS f32x4*)(kp + 4), qa0 = *(const LAS f32x4*)qp, qa1 = *(const LAS f32x4*)(qp + 4);
            const bf16x8 kah = pack_frag(ka0, ka1), qah = pack_frag(qa0, qa1);
            f32x4 h0, h1; unpack8(__builtin_bit_cast(v4u, kah), h0, h1); const bf16x8 kal = pack_frag(ka0 - h0, ka1 - h1);
            unpack8(__builtin_bit_cast(v4u, qah), h0, h1); const bf16x8 qal = pack_frag(qa0 - h0, qa1 - h1);
#pragma unroll
            for (int jj = 0; jj < 2; ++jj) {
                const int jt = (wave & 1) * 2 + jj;
                if (jt <= it) {
                    const LAS float* bp = Lk + (16 * jt + rl) * 132 + 32 * s + 8 * quad;
                    const f32x4 kb0 = *(const LAS f32x4*)bp, kb1 = *(const LAS f32x4*)(bp + 4);
                    const bf16x8 kbh = pack_frag(kb0, kb1); unpack8(__builtin_bit_cast(v4u, kbh), h0, h1); const bf16x8 kbl = pack_frag(kb0 - h0, kb1 - h1);
                    ckk[jj] = mfma16(kah, kbh, ckk[jj]); ckk[jj] = mfma16(kah, kbl, ckk[jj]); ckk[jj] = mfma16(kal, kbh, ckk[jj]);
                    cqk[jj] = mfma16(qah, kbh, cqk[jj]); cqk[jj] = mfma16(qah, kbl, cqk[jj]); cqk[jj] = mfma16(qal, kbh, cqk[jj]);
                }
            }
        }
#pragma unroll
        for (int jj = 0; jj < 2; ++jj) {
            const int j = 16 * ((wave & 1) * 2 + jj) + rl; const float gj = Lg[j];
#pragma unroll
            for (int e = 0; e < 4; ++e) { const int i = 16 * it + 4 * quad + e; const float dec = (i >= j) ? __expf(Lg[i] - gj) : 0.f;
                LA[i * 64 + j] = (i > j) ? Lb[i] * ckk[jj][e] * dec : 0.f; LQK[i * 64 + j] = cqk[jj][e] * dec; }
        }
    }
    __syncthreads();
    GP_T(3);
    unsigned char* rec = ws + WS_GREC + (size_t)unit * GREC;
    LAS float* TI = (LAS float*)(F.lds + 135168);
    if (tid < 64) {
        const int B = tid >> 4, c = tid & 15;
        float tc[16];
#pragma unroll
        for (int i = 0; i < 16; ++i) {
            float s0 = (i == c) ? 1.f : 0.f;
#pragma unroll
            for (int j = 0; j < i; ++j) s0 -= LA[(16 * B + i) * 64 + 16 * B + j] * tc[j];
            tc[i] = s0;
        }
#pragma unroll
        for (int i = 0; i < 16; ++i) TI[B * 256 + i * 16 + c] = tc[i];
    }
    {
        const float gl = Lg[63];
        for (int it = tid; it < 2560; it += NTHREADS) {
            if (it < 1024) {
                const int i = it >> 4, s = (it >> 2) & 3, quad = it & 3; const float e = Le[i];
                const f32x4 a = *(const LAS f32x4*)(Lq + i * 132 + 32 * s + 4 * quad) * e, bq = *(const LAS f32x4*)(Lq + i * 132 + 32 * s + 16 + 4 * quad) * e;
                *(v4u*)(rec + 16384 + i * 256 + (32 * s + 8 * quad) * 2) = pack8(a, bq);
            } else if (it < 2048) {
                const int r = it - 1024, dk = r >> 3, s2 = (r >> 2) & 1, quad = r & 3;
                f32x4 a, bq;
#pragma unroll
                for (int e = 0; e < 4; ++e) { const int ta = 32 * s2 + 4 * quad + e, tb = ta + 16; a[e] = Lk[ta * 132 + dk] * __expf(gl - Lg[ta]); bq[e] = Lk[tb * 132 + dk] * __expf(gl - Lg[tb]); }
                *(v4u*)(rec + 32768 + dk * 128 + (32 * s2 + 8 * quad) * 2) = pack8(a, bq);
            } else {
                const int r = it - 2048, i = r >> 3, s2 = (r >> 2) & 1, quad = r & 3;
                const f32x4 a = *(const LAS f32x4*)(LQK + i * 64 + 32 * s2 + 4 * quad), bq = *(const LAS f32x4*)(LQK + i * 64 + 32 * s2 + 16 + 4 * quad);
                *(v4u*)(rec + 65536 + i * 128 + (32 * s2 + 8 * quad) * 2) = pack8(a, bq);
            }
        }
        if (tid == 0) *(float*)(rec + 73728) = __expf(gl);
    }
    __syncthreads();
    GP_T(4);
    {
        const int col = tid & 255, hb = tid >> 8;
        LAS float* X = (col < 128) ? (Lv + col) : (Lk + (col - 128));
        const bool isw = col >= 128;
#pragma unroll 1
        for (int B = 0; B < 4; ++B) {
            float xb[8];
#pragma unroll
            for (int i = 0; i < 8; ++i) { const int r = 16 * B + 8 * hb + i; xb[i] = (isw ? Lb[r] * Le[r] : Lb[r]) * X[r * 132]; }
#pragma unroll 2
            for (int j4 = 0; j4 < 4 * B; ++j4) {
                const float x0 = X[(4 * j4) * 132], x1 = X[(4 * j4 + 1) * 132], x2 = X[(4 * j4 + 2) * 132], x3 = X[(4 * j4 + 3) * 132];
#pragma unroll
                for (int i = 0; i < 8; ++i) { const f32x4 a = *(const LAS f32x4*)(LA + (16 * B + 8 * hb + i) * 64 + 4 * j4); xb[i] -= (a[0] * x0 + a[1] * x1) + (a[2] * x2 + a[3] * x3); }
            }
#pragma unroll
            for (int i = 0; i < 8; ++i) X[(16 * B + 8 * hb + i) * 132] = xb[i];
            __syncthreads();
            float r[16];
#pragma unroll
            for (int jj = 0; jj < 16; ++jj) r[jj] = X[(16 * B + jj) * 132];
            __syncthreads();
#pragma unroll
            for (int i = 0; i < 8; ++i) {
                float s0 = 0.f, s1 = 0.f;
#pragma unroll
                for (int j4 = 0; j4 < 4; ++j4) { const f32x4 a = *(const LAS f32x4*)(TI + B * 256 + (8 * hb + i) * 16 + 4 * j4);
                    s0 += a[0] * r[4 * j4] + a[2] * r[4 * j4 + 2]; s1 += a[1] * r[4 * j4 + 1] + a[3] * r[4 * j4 + 3]; }
                X[(16 * B + 8 * hb + i) * 132] = s0 + s1;
            }
            __syncthreads();
        }
    }
    __syncthreads();
    GP_T(5);
    for (int it = tid; it < 2048; it += NTHREADS) {
        if (it < 1024) {
            const int dv = it >> 3, q = it & 7;
            v4u w; w.x = pk2(Lv[(8 * q) * 132 + dv], Lv[(8 * q + 1) * 132 + dv]); w.y = pk2(Lv[(8 * q + 2) * 132 + dv], Lv[(8 * q + 3) * 132 + dv]);
            w.z = pk2(Lv[(8 * q + 4) * 132 + dv], Lv[(8 * q + 5) * 132 + dv]); w.w = pk2(Lv[(8 * q + 6) * 132 + dv], Lv[(8 * q + 7) * 132 + dv]);
            *(v4u*)(rec + 49152 + dv * 128 + q * 16) = w;
        } else {
            const int r = it - 1024, i = r >> 4, s = (r >> 2) & 3, quad = r & 3;
            const f32x4 a = *(const LAS f32x4*)(Lk + i * 132 + 32 * s + 4 * quad), bq = *(const LAS f32x4*)(Lk + i * 132 + 32 * s + 16 + 4 * quad);
            *(v4u*)(rec + i * 256 + (32 * s + 8 * quad) * 2) = pack8(a, bq);
        }
    }
    __syncthreads();
    GP_T(6);
}

DI void ret_prep_unit(Frame& F, int layer, int unit) {
    int lane = F.lane, wave = F.wave; asm volatile("" : "+v"(lane), "+s"(wave));
    const int tid = wave * 64 + lane, quad = lane >> 4, rl = lane & 15;
    const int b = unit >> 8, h = (unit >> 6) & 3, c = unit & 63;
    const int row0 = b * TP + 128 * c;
    unsigned char* ws = KWS();
    const bf16* Z = (const bf16*)(ws + WS_Z);
    const f32x2* ROT = (const f32x2*)(ws + WS_ROT);
    bf16* QR = (bf16*)(ws + WS_QR); bf16* KR = (bf16*)(ws + WS_KR);
    LAS unsigned char* LK = F.lds; LAS unsigned char* LV = F.lds + 34816;
    const float lg = ret_lg(h);
    for (int it = tid; it < 1024; it += NTHREADS) {
        const int j = it >> 3, cc = it & 7, d0 = cc * 8;
        const size_t zr = (size_t)(row0 + j) * LDZ + ZC_RQKV + h * 128 + d0;
        f32x4 q1a, q1b, q2a, q2b, k1a, k1b, k2a, k2b;
        unpack8(*(const v4u*)(Z + zr), q1a, q1b); unpack8(*(const v4u*)(Z + zr + 64), q2a, q2b);
        unpack8(*(const v4u*)(Z + zr + 512), k1a, k1b); unpack8(*(const v4u*)(Z + zr + 512 + 64), k2a, k2b);
        const f32x2* rp = ROT + (size_t)(128 * c + j) * 64 + d0;
        const float kd = __expf((float)(127 - j) * lg);
        f32x4 oq1a, oq1b, oq2a, oq2b, ok1a, ok1b, ok2a, ok2b;
#pragma unroll
        for (int e = 0; e < 8; ++e) {
            const f32x2 cs = rp[e];
            const float q1 = e < 4 ? q1a[e & 3] : q1b[e & 3], q2 = e < 4 ? q2a[e & 3] : q2b[e & 3], k1 = e < 4 ? k1a[e & 3] : k1b[e & 3], k2 = e < 4 ? k2a[e & 3] : k2b[e & 3];
            const float rq1 = q1 * cs.x - q2 * cs.y, rq2 = q2 * cs.x + q1 * cs.y, rk1 = (k1 * cs.x - k2 * cs.y) * 0.08838834764831845f, rk2 = (k2 * cs.x + k1 * cs.y) * 0.08838834764831845f;
            if (e < 4) { oq1a[e & 3] = rq1; oq2a[e & 3] = rq2; ok1a[e & 3] = rk1; ok2a[e & 3] = rk2; } else { oq1b[e & 3] = rq1; oq2b[e & 3] = rq2; ok1b[e & 3] = rk1; ok2b[e & 3] = rk2; }
            *(LAS bf16*)(LK + (d0 + e) * 272 + j * 2) = (bf16)f2bf(rk1 * kd); *(LAS bf16*)(LK + (d0 + 64 + e) * 272 + j * 2) = (bf16)f2bf(rk2 * kd);
        }
        const size_t orow = (size_t)(row0 + j) * 512 + h * 128 + d0;
        *(v4u*)(QR + orow) = pack8(oq1a, oq1b); *(v4u*)(QR + orow + 64) = pack8(oq2a, oq2b);
        *(v4u*)(KR + orow) = pack8(ok1a, ok1b); *(v4u*)(KR + orow + 64) = pack8(ok2a, ok2b);
    }
    for (int it = tid; it < 2048; it += NTHREADS) {
        const int j = it >> 4, cc = it & 15;
        const v4u w = *(const v4u*)(Z + (size_t)(row0 + j) * LDZ + ZC_RQKV + 1024 + h * 128 + cc * 8);
        LAS unsigned char* d = LV + (cc * 8) * 272 + j * 2;
        *(LAS bf16*)(d) = (bf16)(w.x & 0xffff); *(LAS bf16*)(d + 272) = (bf16)(w.x >> 16); *(LAS bf16*)(d + 2 * 272) = (bf16)(w.y & 0xffff); *(LAS bf16*)(d + 3 * 272) = (bf16)(w.y >> 16);
        *(LAS bf16*)(d + 4 * 272) = (bf16)(w.z & 0xffff); *(LAS bf16*)(d + 5 * 272) = (bf16)(w.z >> 16); *(LAS bf16*)(d + 6 * 272) = (bf16)(w.w & 0xffff); *(LAS bf16*)(d + 7 * 272) = (bf16)(w.w >> 16);
    }
    __syncthreads();
    float* RKV = (float*)(ws + WS_RKV) + (size_t)unit * 16384;
#pragma unroll
    for (int nt = 0; nt < 8; ++nt) {
        f32x4 acc = (f32x4){0.f, 0.f, 0.f, 0.f};
#pragma unroll
        for (int s = 0; s < 4; ++s) acc = mfma16(ld_frag_l(LK + (16 * wave + rl) * 272 + (32 * s + 8 * quad) * 2), ld_frag_l(LV + (16 * nt + rl) * 272 + (32 * s + 8 * quad) * 2), acc);
#pragma unroll
        for (int i = 0; i < 4; ++i) RKV[(size_t)(16 * wave + 4 * quad + i) * 128 + 16 * nt + rl] = acc[i];
    }
    __syncthreads();
}
DI void sample_rec_unit(Frame& F, int layer, int unit) {
    int lane = F.lane, wave = F.wave; asm volatile("" : "+v"(lane), "+s"(wave));
    const int tid = wave * 64 + lane;
    const int kind = unit >> 9, s = (unit >> 2) & 127, h = unit & 3;
    const int dv = tid & 127, part = tid >> 7, r0 = MP + 4 * s;
    unsigned char* ws = KWS();
    const bf16* Z = (const bf16*)(ws + WS_Z);
    const float* ZS = (const float*)(ws + WS_ZS);
    LAS float* Lq = (LAS float*)(F.lds); LAS float* Lk = Lq + 512; LAS float* Lv = Lq + 1024; LAS float* red = Lq + 1536; LAS float* Lo = Lq + 2048; LAS float* sc = Lq + 2560;
    float S[32];
    if (kind == 0) {
        if (tid < 384) {
            const int pr = tid >> 7, d = tid & 127, col = pr * 512 + h * 128 + d;
            float xp[7], w[4];
#pragma unroll
            for (int i = 0; i < 3; ++i) xp[i] = KIN(4)[((size_t)(layer * 128 + s) * 3 + i) * 1536 + col];
#pragma unroll
            for (int j = 0; j < 4; ++j) xp[3 + j] = bf2f(Z[(size_t)(r0 + j) * LDZ + ZC_GQKV + col]);
#pragma unroll
            for (int i = 0; i < 4; ++i) w[i] = KIN(15)[(size_t)(layer * 4 + i) * 1536 + col];
            LAS float* dst = pr == 0 ? Lq : pr == 1 ? Lk : Lv;
#pragma unroll
            for (int j = 0; j < 4; ++j) dst[j * 128 + d] = siluf_(w[0] * xp[j] + w[1] * xp[j + 1] + w[2] * xp[j + 2] + w[3] * xp[j + 3]);
        }
        __syncthreads();
        {
            LAS float* vp = (wave < 4 ? Lq : Lk) + (wave & 3) * 128;
            const float a = vp[2 * lane], b = vp[2 * lane + 1];
            const float scl = rsqrtf(wave_sum(a * a + b * b, lane) + EPS) * (wave < 4 ? 0.08838834764831845f : 1.f);
            vp[2 * lane] = a * scl; vp[2 * lane + 1] = b * scl;
        }
        if (tid < 4) {
            const float ga = ZS[(size_t)(r0 + tid) * 32 + 24 + h], gb = ZS[(size_t)(r0 + tid) * 32 + 28 + h];
            sc[tid] = __expf(-__expf(KIN(16)[layer * 4 + h]) * softplusf_(ga + KIN(17)[layer * 4 + h])); sc[4 + tid] = sigmoidf_(gb);
        }
        __syncthreads();
        const float* Sin = KIN(5) + ((size_t)((layer * 128 + s) * 4 + h) * 128 + 32 * part) * 128 + dv;
#pragma unroll
        for (int i = 0; i < 32; ++i) S[i] = Sin[(size_t)i * 128];
#pragma unroll
        for (int j = 0; j < 4; ++j) {
            const float a = sc[j], beta = sc[4 + j];
            float p = 0.f;
#pragma unroll
            for (int i = 0; i < 32; ++i) { S[i] *= a; p += Lk[j * 128 + 32 * part + i] * S[i]; }
            red[part * 128 + dv] = p;
            __syncthreads();
            const float delta = beta * (Lv[j * 128 + dv] - ((red[dv] + red[128 + dv]) + (red[256 + dv] + red[384 + dv])));
            __syncthreads();
            float o = 0.f;
#pragma unroll
            for (int i = 0; i < 32; ++i) { S[i] += Lk[j * 128 + 32 * part + i] * delta; o += Lq[j * 128 + 32 * part + i] * S[i]; }
            red[part * 128 + dv] = o;
            __syncthreads();
            if (part == 0) Lo[j * 128 + dv] = (red[dv] + red[128 + dv]) + (red[256 + dv] + red[384 + dv]);
            __syncthreads();
        }
        float* Sout = KOUT() + O_GSS + ((size_t)((layer * 128 + s) * 4 + h) * 128 + 32 * part) * 128 + dv;
#pragma unroll
        for (int i = 0; i < 32; ++i) Sout[(size_t)i * 128] = S[i];
        ((float*)(ws + WS_OGDN))[(size_t)(r0 + part) * 512 + h * 128 + dv] = Lo[part * 128 + dv];
    } else {
        const f32x2* ROT = (const f32x2*)(ws + WS_ROT);
        if (tid < 384) {
            const int pr = tid >> 7, d = tid & 127;
#pragma unroll
            for (int j = 0; j < 4; ++j) {
                const bf16* zp = Z + (size_t)(r0 + j) * LDZ + ZC_RQKV + pr * 512 + h * 128;
                float v = bf2f(zp[d]);
                if (pr < 2) { const f32x2 cs = ROT[(size_t)(2048 + j) * 64 + (d & 63)]; const float o = bf2f(zp[d ^ 64]);
                    v = (d < 64) ? v * cs.x - o * cs.y : v * cs.x + o * cs.y; if (pr == 1) v *= 0.08838834764831845f; }
                (pr == 0 ? Lq : pr == 1 ? Lk : Lv)[j * 128 + d] = v;
            }
        }
        __syncthreads();
        const float gam = __expf(ret_lg(h));
        const float* Sin = KIN(6) + ((size_t)((layer * 128 + s) * 4 + h) * 128 + 32 * part) * 128 + dv;
#pragma unroll
        for (int i = 0; i < 32; ++i) S[i] = Sin[(size_t)i * 128];
#pragma unroll
        for (int j = 0; j < 4; ++j) {
            const float vv = Lv[j * 128 + dv];
            float o = 0.f;
#pragma unroll
            for (int i = 0; i < 32; ++i) { S[i] = S[i] * gam + Lk[j * 128 + 32 * part + i] * vv; o += Lq[j * 128 + 32 * part + i] * S[i]; }
            red[part * 128 + dv] = o;
            __syncthreads();
            if (part == 0) Lo[j * 128 + dv] = (red[dv] + red[128 + dv]) + (red[256 + dv] + red[384 + dv]);
            __syncthreads();
        }
        float* Sout = KOUT() + O_RSS + ((size_t)((layer * 128 + s) * 4 + h) * 128 + 32 * part) * 128 + dv;
#pragma unroll
        for (int i = 0; i < 32; ++i) Sout[(size_t)i * 128] = S[i];
        if (wave < 4) {
            const int j = wave; const float a = Lo[j * 128 + 2 * lane], b = Lo[j * 128 + 2 * lane + 1];
            const float scl = rsqrtf(wave_sum(a * a + b * b, lane) * (1.f / 128.f) + EPS);
            const bf16* gp = Z + (size_t)(r0 + j) * LDZ + ZC_RG + h * 128 + 2 * lane;
            *(unsigned*)((bf16*)(ws + WS_MIX) + (size_t)(r0 + j) * 1536 + 1024 + h * 128 + 2 * lane) = pk2(a * scl * siluf_(bf2f(gp[0])), b * scl * siluf_(bf2f(gp[1])));
        }
    }
    __syncthreads();
}

DI void gdn_scan_chain(Frame& F, int layer, int bh) {
    int lane = F.lane, wave = F.wave; asm volatile("" : "+v"(lane), "+s"(wave));
    const int tid = wave * 64 + lane, quad = lane >> 4, rl = lane & 15;
    unsigned char* ws = KWS();
    const unsigned char* recb = ws + WS_GREC + (size_t)bh * 128 * GREC;
    LAS unsigned char* L = F.lds;
    constexpr int L_WP = 0, L_QP = 17408, L_KT = 34816, L_UT = 53248, L_QK = 71680;
    f32x4 S[8];
#pragma unroll
    for (int i = 0; i < 8; ++i) S[i] = (f32x4){0.f, 0.f, 0.f, 0.f};
    v4u pf[9]; float egl;
#pragma unroll
    for (int k = 0; k < 9; ++k) pf[k] = *(const v4u*)(recb + (size_t)(tid + 512 * k) * 16);
    egl = *(const float*)(recb + 73728);
    float* OG = (float*)(ws + WS_OGDN);
    const int b = bh >> 2, h = bh & 3;
    for (int c = 0; c < 128; ++c) {
        __syncthreads();
#pragma unroll
        for (int k = 0; k < 9; ++k) {
            const int o = tid * 16 + (k & 1) * 8192;
            const int reg = k >> 1;
            int dst;
            if (reg < 2) dst = (reg == 0 ? L_WP : L_QP) + (o >> 8) * 272 + (o & 255);
            else dst = (reg == 2 ? L_KT : reg == 3 ? L_UT : L_QK) + (o >> 7) * 144 + (o & 127);
            *(LAS v4u*)(L + dst) = pf[k];
        }
        const float eg = egl;
        __syncthreads();
        {
            const unsigned char* rn = recb + (size_t)(c + 1 < 128 ? c + 1 : 127) * GREC;
#pragma unroll
            for (int k = 0; k < 9; ++k) pf[k] = *(const v4u*)(rn + (size_t)(tid + 512 * k) * 16);
            egl = *(const float*)(rn + 73728);
        }
        bf16x8 Sb[4];
#pragma unroll
        for (int s = 0; s < 4; ++s) Sb[s] = pack_frag(S[2 * s], S[2 * s + 1]);
        f32x4 vn[4], O[4];
#pragma unroll
        for (int rt = 0; rt < 4; ++rt) {
            f32x4 wsacc = (f32x4){0.f, 0.f, 0.f, 0.f}, o = wsacc;
#pragma unroll
            for (int s = 0; s < 4; ++s) {
                wsacc = mfma16(ld_frag_l(L + L_WP + (16 * rt + rl) * 272 + (32 * s + 8 * quad) * 2), Sb[s], wsacc);
                o = mfma16(ld_frag_l(L + L_QP + (16 * rt + rl) * 272 + (32 * s + 8 * quad) * 2), Sb[s], o);
            }
            const v2u uw = *(const LAS v2u*)(L + L_UT + (16 * wave + rl) * 144 + (16 * rt + 4 * quad) * 2);
            vn[rt][0] = lo_bf(uw.x) - wsacc[0]; vn[rt][1] = hi_bf(uw.x) - wsacc[1]; vn[rt][2] = lo_bf(uw.y) - wsacc[2]; vn[rt][3] = hi_bf(uw.y) - wsacc[3];
            O[rt] = o;
        }
        bf16x8 Vb[2]; Vb[0] = pack_frag(vn[0], vn[1]); Vb[1] = pack_frag(vn[2], vn[3]);
#pragma unroll
        for (int rt = 0; rt < 4; ++rt) {
#pragma unroll
            for (int s2 = 0; s2 < 2; ++s2) O[rt] = mfma16(ld_frag_l(L + L_QK + (16 * rt + rl) * 144 + (32 * s2 + 8 * quad) * 2), Vb[s2], O[rt]);
            const size_t row = (size_t)b * TP + 64 * c + 16 * rt + 4 * quad;
#pragma unroll
            for (int i = 0; i < 4; ++i) OG[(row + i) * 512 + h * 128 + 16 * wave + rl] = O[rt][i];
        }
#pragma unroll
        for (int kt = 0; kt < 8; ++kt) {
            f32x4 a = S[kt] * eg;
#pragma unroll
            for (int s2 = 0; s2 < 2; ++s2) a = mfma16(ld_frag_l(L + L_KT + (16 * kt + rl) * 144 + (32 * s2 + 8 * quad) * 2), Vb[s2], a);
            S[kt] = a;
        }
    }
    float* So = KOUT() + O_GSP + (size_t)(layer * 8 + bh) * 16384;
#pragma unroll
    for (int kt = 0; kt < 8; ++kt)
#pragma unroll
        for (int i = 0; i < 4; ++i) So[(size_t)(16 * kt + 4 * quad + i) * 128 + 16 * wave + rl] = S[kt][i];
    __syncthreads();
}
DI void ret_scan_part(Frame& F, int layer, int r) {
    int tid = F.tid; asm volatile("" : "+v"(tid));
    const int bh = r >> 2, dv = tid & 127, dk0 = ((r & 3) * 4 + (tid >> 7)) * 8, h = bh & 3;
    unsigned char* ws = KWS();
    const float* RKV = (const float*)(ws + WS_RKV) + (size_t)bh * 64 * 16384;
    bf16* RST = (bf16*)(ws + WS_RST) + (size_t)bh * 64 * 16384;
    const float cdec = __expf(128.f * ret_lg(h));
    float S[8];
#pragma unroll
    for (int i = 0; i < 8; ++i) S[i] = 0.f;
#pragma unroll 4
    for (int c = 0; c < 64; ++c) {
        v4u w; w.x = pk2(S[0], S[1]); w.y = pk2(S[2], S[3]); w.z = pk2(S[4], S[5]); w.w = pk2(S[6], S[7]);
        *(v4u*)(RST + (size_t)c * 16384 + dv * 128 + dk0) = w;
#pragma unroll
        for (int i = 0; i < 8; ++i) S[i] = S[i] * cdec + RKV[(size_t)c * 16384 + (dk0 + i) * 128 + dv];
    }
    float* So = KOUT() + O_RSP + (size_t)(layer * 8 + bh) * 16384;
#pragma unroll
    for (int i = 0; i < 8; ++i) So[(size_t)(dk0 + i) * 128 + dv] = S[i];
}
constexpr float SM_C = 0.125f * 1.4426950408889634f;
struct AttnState { float m, l; f32x4 O[4]; };
DI void attn_reset(AttnState& st) { st.m = -1e30f; st.l = 0.f;
#pragma unroll
    for (int i = 0; i < 4; ++i) st.O[i] = (f32x4){0.f, 0.f, 0.f, 0.f}; }
DI void qk_tile(const LAS unsigned char* Kt, const bf16x8 (&qf)[2], f32x4 (&s)[4], int rl, int quad) {
    bf16x8 kf[4][2];
#pragma unroll
    for (int kt = 0; kt < 4; ++kt)
#pragma unroll
        for (int kk = 0; kk < 2; ++kk) kf[kt][kk] = ld_frag_l(Kt + (16 * kt + rl) * 144 + kk * 64 + quad * 16);
    __builtin_amdgcn_s_setprio(1);
#pragma unroll
    for (int kt = 0; kt < 4; ++kt) s[kt] = mfma16(kf[kt][0], qf[0], (f32x4){0.f, 0.f, 0.f, 0.f});
#pragma unroll
    for (int kt = 0; kt < 4; ++kt) s[kt] = mfma16(kf[kt][1], qf[1], s[kt]);
    __builtin_amdgcn_s_setprio(0);
}
template <class Mask> DI void attn_step(const LAS unsigned char* Kt, const LAS unsigned char* VT, const bf16x8 (&qf)[2], AttnState& st, const Mask& ok, int rl, int quad) {
    f32x4 s[4]; qk_tile(Kt, qf, s, rl, quad);
    float mx = -3e38f;
#pragma unroll
    for (int kt = 0; kt < 4; ++kt)
#pragma unroll
        for (int i = 0; i < 4; ++i) if (ok(16 * kt + 4 * quad + i)) mx = fmaxf(mx, s[kt][i]);
    const int lane = rl + 16 * quad;
    mx = fmaxf(mx, shx<16>(mx, lane)); mx = fmaxf(mx, shx<32>(mx, lane));
    const float mn = fmaxf(st.m, mx);
    const float alpha = exp2f((st.m - mn) * SM_C);
    float ls = 0.f;
#pragma unroll
    for (int kt = 0; kt < 4; ++kt)
#pragma unroll
        for (int i = 0; i < 4; ++i) { const float p = ok(16 * kt + 4 * quad + i) ? exp2f((s[kt][i] - mn) * SM_C) : 0.f; s[kt][i] = p; ls += p; }
    ls += shx<16>(ls, lane); ls += shx<32>(ls, lane);
    st.l = st.l * alpha + ls; st.m = mn;
#pragma unroll
    for (int dt = 0; dt < 4; ++dt) st.O[dt] *= alpha;
#pragma unroll
    for (int ii = 0; ii < 2; ++ii) {
        const bf16x8 pb = pack_frag(s[2 * ii], s[2 * ii + 1]);
#pragma unroll
        for (int dt = 0; dt < 4; ++dt) {
            const LAS unsigned char* vp = VT + (16 * dt + rl) * 144 + (32 * ii + 4 * quad) * 2;
            st.O[dt] = mfma16(mk_frag(*(const LAS v2u*)vp, *(const LAS v2u*)(vp + 32)), pb, st.O[dt]);
        }
    }
}
DI void attn_accum(f32x4 (&Of)[4], const AttnState& st, float gate) {
    const float sc = st.l > 0.f ? gate / st.l : 0.f;
#pragma unroll
    for (int dt = 0; dt < 4; ++dt) Of[dt] += st.O[dt] * sc;
}
DI void vt_write(LAS unsigned char* VT, int d0, int key, const v4u w) {
    LAS unsigned char* d = VT + d0 * 144 + key * 2;
    *(LAS bf16*)(d) = (bf16)(w.x & 0xffff); *(LAS bf16*)(d + 144) = (bf16)(w.x >> 16); *(LAS bf16*)(d + 2 * 144) = (bf16)(w.y & 0xffff); *(LAS bf16*)(d + 3 * 144) = (bf16)(w.y >> 16);
    *(LAS bf16*)(d + 4 * 144) = (bf16)(w.z & 0xffff); *(LAS bf16*)(d + 5 * 144) = (bf16)(w.z >> 16); *(LAS bf16*)(d + 6 * 144) = (bf16)(w.w & 0xffff); *(LAS bf16*)(d + 7 * 144) = (bf16)(w.w >> 16);
}
DI void stage_wg(LAS unsigned char* Kt, LAS unsigned char* VT, const bf16* kb, const bf16* vb, size_t stride, int tid, bool do_v) {
    const int key = tid >> 3, ch = tid & 7;
    *(LAS v4u*)(Kt + key * 144 + ch * 16) = *(const v4u*)(kb + key * stride + ch * 8);
    if (do_v) vt_write(VT, ch * 8, key, *(const v4u*)(vb + key * stride + ch * 8));
}
DI unsigned score_key(float s, bool valid, int idx) { return valid ? (((__float_as_uint(s) | 0x80000000u) & ~127u) | (unsigned)(127 - idx)) : 0u; }
DI int key_rank(const LAS unsigned* K, int ng4, unsigned k) {
    int r = 0;
#pragma unroll 4
    for (int g = 0; g < ng4; ++g) { const v4u v = *(const LAS v4u*)(K + 4 * g); r += (v.x > k) + (v.y > k) + (v.z > k) + (v.w > k); }
    return r;
}
DI void key_rank2(const LAS unsigned* K, int ng4, unsigned k0, unsigned k1, int& r0, int& r1) {
    int a0 = 0, a1 = 0, b0 = 0, b1 = 0;
    const int ng8 = (ng4 + 1) >> 1;
#pragma unroll 4
    for (int g = 0; g < ng8; ++g) { const v4u v = *(const LAS v4u*)(K + 8 * g), w = *(const LAS v4u*)(K + 8 * g + 4);
        a0 += (v.x > k0) + (v.y > k0) + (v.z > k0) + (v.w > k0); b0 += (w.x > k0) + (w.y > k0) + (w.z > k0) + (w.w > k0);
        a1 += (v.x > k1) + (v.y > k1) + (v.z > k1) + (v.w > k1); b1 += (w.x > k1) + (w.y > k1) + (w.z > k1) + (w.w > k1); }
    r0 = a0 + b0; r1 = a1 + b1;
}
DI int top16(float v0, float v1, int lane) {
    int sel = 0;
#pragma unroll 1
    for (int r = 0; r < 16; ++r) {
        float bv; int bi;
        if (v0 >= v1) { bv = v0; bi = lane; } else { bv = v1; bi = lane + 64; }
#define T16_STEP(M) { const float ov = shx<M>(bv, lane); const int oi = shxi<M>(bi, lane); const bool take = (ov > bv) || (ov == bv && oi < bi); bv = take ? ov : bv; bi = take ? oi : bi; }
        T16_STEP(32) T16_STEP(16) T16_STEP(8) T16_STEP(4) T16_STEP(2) T16_STEP(1)
#undef T16_STEP
        const bool h0 = (bi == lane), h1 = (bi == lane + 64);
        v0 = h0 ? -3e38f : v0; v1 = h1 ? -3e38f : v1; sel |= (h0 ? 1 : 0) | (h1 ? 2 : 0);
    }
    return sel;
}

typedef short v4i16_t __attribute__((ext_vector_type(4)));
DI s16x4 vtr(const LAS unsigned char* p) { return __builtin_bit_cast(s16x4, __builtin_amdgcn_ds_read_tr16_b64_v4i16((LAS v4i16_t*)p)); }
DI bf16x8 cat4(s16x4 a, s16x4 b) { bf16x8 r; r[0] = a[0]; r[1] = a[1]; r[2] = a[2]; r[3] = a[3]; r[4] = b[0]; r[5] = b[1]; r[6] = b[2]; r[7] = b[3]; return r; }
DI void attn_step3(const LAS unsigned char* Kt, const LAS unsigned char* Vt, const bf16x8 (&qf)[2], AttnState& st, int lo, int hi, bool active, int rl, int quad) {
    active = active && (hi >= lo);
    if (!__any(active)) return;
    f32x4 s[4]; qk_tile(Kt, qf, s, rl, quad);
    const int lane = rl + 16 * quad;
    const bool full = __all((lo <= 0 && hi >= 63) || !active);
    const int kq = 4 * quad - lo; const unsigned rng = (unsigned)(hi - lo);
    float lm;
    if (full) {
        const float a0 = fmaxf(fmaxf(s[0][0], s[0][1]), fmaxf(s[0][2], s[0][3])), a1 = fmaxf(fmaxf(s[1][0], s[1][1]), fmaxf(s[1][2], s[1][3]));
        const float a2 = fmaxf(fmaxf(s[2][0], s[2][1]), fmaxf(s[2][2], s[2][3])), a3 = fmaxf(fmaxf(s[3][0], s[3][1]), fmaxf(s[3][2], s[3][3]));
        lm = fmaxf(fmaxf(a0, a1), fmaxf(a2, a3));
    } else {
        lm = -3e38f;
#pragma unroll
        for (int kt = 0; kt < 4; ++kt)
#pragma unroll
            for (int i = 0; i < 4; ++i) lm = ((unsigned)(kq + 16 * kt + i) <= rng) ? fmaxf(lm, s[kt][i]) : lm;
    }
    lm = active ? lm : -3e38f;
    if (__any(lm > st.m + 320.f)) {
        float mx = fmaxf(lm, shx<16>(lm, lane)); mx = fmaxf(mx, shx<32>(mx, lane));
        const float mn = fmaxf(st.m, mx);
        const float alpha = __builtin_amdgcn_exp2f((st.m - mn) * SM_C);
        st.l *= alpha; st.m = mn;
#pragma unroll
        for (int dt = 0; dt < 4; ++dt) st.O[dt] *= alpha;
    }
    const float mc = active ? st.m * SM_C : __builtin_inff();
    float ls = 0.f;
    if (full) {
#pragma unroll
        for (int kt = 0; kt < 4; ++kt)
#pragma unroll
            for (int i = 0; i < 4; ++i) { const float p = __builtin_amdgcn_exp2f(s[kt][i] * SM_C - mc); s[kt][i] = p; ls += p; }
    } else {
#pragma unroll
        for (int kt = 0; kt < 4; ++kt)
#pragma unroll
            for (int i = 0; i < 4; ++i) { const float p = ((unsigned)(kq + 16 * kt + i) <= rng) ? __builtin_amdgcn_exp2f(s[kt][i] * SM_C - mc) : 0.f; s[kt][i] = p; ls += p; }
    }
    st.l += ls;
#pragma unroll
    for (int ii = 0; ii < 2; ++ii) {
        const bf16x8 pb = pack_frag(s[2 * ii], s[2 * ii + 1]);
#pragma unroll
        for (int dt = 0; dt < 4; ++dt) {
            const LAS unsigned char* vp = Vt + (32 * ii + 4 * quad + (rl >> 2)) * 144 + (16 * dt + 4 * (rl & 3)) * 2;
            st.O[dt] = mfma16(cat4(vtr(vp), vtr(vp + 16 * 144)), pb, st.O[dt]);
        }
    }
}
DI float attn_rowsum(const AttnState& st, int lane) { float l = st.l; l += shx<16>(l, lane); l += shx<32>(l, lane); return l; }
DI void attn_accum3(f32x4 (&Of)[4], const AttnState& st, float gate, int lane) {
    const float l = attn_rowsum(st, lane);
    const float sc = l > 0.f ? gate / l : 0.f;
#pragma unroll
    for (int dt = 0; dt < 4; ++dt) Of[dt] += st.O[dt] * sc;
}
#ifndef PH_NPT
#define PH_NPT (-1)
#endif
#if PH_NPT >= 0
#define NP_T(k) do { if (tid == 0) { volatile LAS unsigned long long* np_ = (volatile LAS unsigned long long*)(F.lds + LDSCTL_OFF + 464); const unsigned long long now_ = __builtin_amdgcn_s_memrealtime(); \
    if ((k) == PH_NPT) np_[0] += now_ - np_[1]; np_[1] = now_; } } while (0)
#else
#define NP_T(k) do { } while (0)
#endif
#ifndef PH_NSAC
#define PH_NSAC 1
#endif
DI float tile_max(const f32x4 (&s)[4], bool full, int kq, unsigned rng) {
    float lm;
    if (full) {
        const float a0 = fmaxf(fmaxf(s[0][0], s[0][1]), fmaxf(s[0][2], s[0][3])), a1 = fmaxf(fmaxf(s[1][0], s[1][1]), fmaxf(s[1][2], s[1][3]));
        const float a2 = fmaxf(fmaxf(s[2][0], s[2][1]), fmaxf(s[2][2], s[2][3])), a3 = fmaxf(fmaxf(s[3][0], s[3][1]), fmaxf(s[3][2], s[3][3]));
        lm = fmaxf(fmaxf(a0, a1), fmaxf(a2, a3));
    } else {
        lm = -3e38f;
#pragma unroll
        for (int kt = 0; kt < 4; ++kt)
#pragma unroll
            for (int i = 0; i < 4; ++i) lm = ((unsigned)(kq + 16 * kt + i) <= rng) ? fmaxf(lm, s[kt][i]) : lm;
    }
    return lm;
}
DI float tile_exp(f32x4 (&s)[4], bool full, int kq, unsigned rng, float mc) {
    float ls = 0.f;
    if (full) {
#pragma unroll
        for (int kt = 0; kt < 4; ++kt)
#pragma unroll
            for (int i = 0; i < 4; ++i) { const float p = __builtin_amdgcn_exp2f(s[kt][i] * SM_C - mc); s[kt][i] = p; ls += p; }
    } else {
#pragma unroll
        for (int kt = 0; kt < 4; ++kt)
#pragma unroll
            for (int i = 0; i < 4; ++i) { const float p = ((unsigned)(kq + 16 * kt + i) <= rng) ? __builtin_amdgcn_exp2f(s[kt][i] * SM_C - mc) : 0.f; s[kt][i] = p; ls += p; }
    }
    return ls;
}
DI void tile_pv(const LAS unsigned char* Vt, const f32x4 (&s)[4], f32x4 (&O)[4], int rl, int quad) {
    bf16x8 vf[2][4];
#pragma unroll
    for (int ii = 0; ii < 2; ++ii)
#pragma unroll
        for (int dt = 0; dt < 4; ++dt) { const LAS unsigned char* vp = Vt + (32 * ii + 4 * quad + (rl >> 2)) * 144 + (16 * dt + 4 * (rl & 3)) * 2; vf[ii][dt] = cat4(vtr(vp), vtr(vp + 16 * 144)); }
    const bf16x8 pb0 = pack_frag(s[0], s[1]), pb1 = pack_frag(s[2], s[3]);
    __builtin_amdgcn_s_setprio(1);
#pragma unroll
    for (int dt = 0; dt < 4; ++dt) O[dt] = mfma16(vf[0][dt], pb0, O[dt]);
#pragma unroll
    for (int dt = 0; dt < 4; ++dt) O[dt] = mfma16(vf[1][dt], pb1, O[dt]);
    __builtin_amdgcn_s_setprio(0);
}
DI void tile_vload(const LAS unsigned char* Vt, bf16x8 (&vf)[2][4], int rl, int quad) {
#pragma unroll
    for (int ii = 0; ii < 2; ++ii)
#pragma unroll
        for (int dt = 0; dt < 4; ++dt) { const LAS unsigned char* vp = Vt + (32 * ii + 4 * quad + (rl >> 2)) * 144 + (16 * dt + 4 * (rl & 3)) * 2; vf[ii][dt] = cat4(vtr(vp), vtr(vp + 16 * 144)); }
}
DI void tile_pvmma(const bf16x8 (&vf)[2][4], const f32x4 (&s)[4], f32x4 (&O)[4]) {
    const bf16x8 pb0 = pack_frag(s[0], s[1]), pb1 = pack_frag(s[2], s[3]);
    __builtin_amdgcn_s_setprio(1);
#pragma unroll
    for (int dt = 0; dt < 4; ++dt) O[dt] = mfma16(vf[0][dt], pb0, O[dt]);
#pragma unroll
    for (int dt = 0; dt < 4; ++dt) O[dt] = mfma16(vf[1][dt], pb1, O[dt]);
    __builtin_amdgcn_s_setprio(0);
}
DI void attn_step_pair(const LAS unsigned char* K0, const LAS unsigned char* V0, int lo0, int hi0, bool act0,
                       const LAS unsigned char* K1, const LAS unsigned char* V1, int lo1, int hi1, bool act1,
                       const bf16x8 (&qf)[2], AttnState& st, int rl, int quad) {
    act0 = act0 && (hi0 >= lo0); act1 = act1 && (hi1 >= lo1);
    const bool any0 = __any(act0), any1 = __any(act1);
    if (!any0 && !any1) return;
    const int lane = rl + 16 * quad;
    f32x4 s0[4], s1[4];
    if (any0 && any1) {
        bf16x8 kf0[4][2], kf1[4][2];
#pragma unroll
        for (int kt = 0; kt < 4; ++kt)
#pragma unroll
            for (int kk = 0; kk < 2; ++kk) { kf0[kt][kk] = ld_frag_l(K0 + (16 * kt + rl) * 144 + kk * 64 + quad * 16); kf1[kt][kk] = ld_frag_l(K1 + (16 * kt + rl) * 144 + kk * 64 + quad * 16); }
        __builtin_amdgcn_s_setprio(1);
#pragma unroll
        for (int kt = 0; kt < 4; ++kt) s0[kt] = mfma16(kf0[kt][0], qf[0], (f32x4){0.f, 0.f, 0.f, 0.f});
#pragma unroll
        for (int kt = 0; kt < 4; ++kt) s1[kt] = mfma16(kf1[kt][0], qf[0], (f32x4){0.f, 0.f, 0.f, 0.f});
#pragma unroll
        for (int kt = 0; kt < 4; ++kt) s0[kt] = mfma16(kf0[kt][1], qf[1], s0[kt]);
#pragma unroll
        for (int kt = 0; kt < 4; ++kt) s1[kt] = mfma16(kf1[kt][1], qf[1], s1[kt]);
        __builtin_amdgcn_s_setprio(0);
    } else {
        if (any0) qk_tile(K0, qf, s0, rl, quad);
        if (any1) qk_tile(K1, qf, s1, rl, quad);
    }
    const bool full0 = __all((lo0 <= 0 && hi0 >= 63) || !act0), full1 = __all((lo1 <= 0 && hi1 >= 63) || !act1);
    const int kq0 = 4 * quad - lo0, kq1 = 4 * quad - lo1; const unsigned rng0 = (unsigned)(hi0 - lo0), rng1 = (unsigned)(hi1 - lo1);
    float mcb = st.m * SM_C;
    bf16x8 vf0[2][4], vf1[2][4];
    if (any0) tile_vload(V0, vf0, rl, quad);
    float ls = 0.f;
    if (any0) ls += tile_exp(s0, full0, kq0, rng0, act0 ? mcb : __builtin_inff());
    if (any1) ls += tile_exp(s1, full1, kq1, rng1, act1 ? mcb : __builtin_inff());
    if (__any(!(ls <= 1e30f))) {
        if (any0) qk_tile(K0, qf, s0, rl, quad);
        if (any1) qk_tile(K1, qf, s1, rl, quad);
        float lm = -3e38f;
        if (any0) { const float a = tile_max(s0, full0, kq0, rng0); lm = act0 ? a : lm; }
        if (any1) { const float a = tile_max(s1, full1, kq1, rng1); lm = act1 ? fmaxf(lm, a) : lm; }
        float mx = fmaxf(lm, shx<16>(lm, lane)); mx = fmaxf(mx, shx<32>(mx, lane));
        const float mn = fmaxf(st.m, mx);
        const float alpha = __builtin_amdgcn_exp2f((st.m - mn) * SM_C);
        st.l *= alpha; st.m = mn;
#pragma unroll
        for (int dt = 0; dt < 4; ++dt) st.O[dt] *= alpha;
        mcb = mn * SM_C; ls = 0.f;
        if (any0) ls += tile_exp(s0, full0, kq0, rng0, act0 ? mcb : __builtin_inff());
        if (any1) ls += tile_exp(s1, full1, kq1, rng1, act1 ? mcb : __builtin_inff());
    }
    st.l += ls;
    if (any1) tile_vload(V1, vf1, rl, quad);
    if (any0) tile_pvmma(vf0, s0, st.O);
    if (any1) tile_pvmma(vf1, s1, st.O);
}
DI void nsa_prompt_unit(Frame& F, int layer, int unit) {
    int lane = F.lane, wave = F.wave; asm volatile("" : "+v"(lane), "+s"(wave));
    const int tid = wave * 64 + lane, quad = lane >> 4, rl = lane & 15;
    const int b = unit >> 9, g = (unit >> 8) & 1, tt = unit & 255, t0 = 32 * tt;
    unsigned char* ws = KWS();
    const bf16* Z = (const bf16*)(ws + WS_Z);
    const float* ZS = (const float*)(ws + WS_ZS);
    LAS unsigned char* TB = F.lds;
    LAS float* AIMP = (LAS float*)(F.lds + 73728);
    LAS unsigned* SEL = (LAS unsigned*)(F.lds + LDSCTL_OFF + 512);
    const int tk = 4 * wave + (rl >> 2), t = t0 + tk, head = 4 * g + (rl & 3);
    const size_t row = (size_t)b * TP + t;
    bf16x8 qf[2];
    qf[0] = ld_frag_g(Z + row * LDZ + ZC_Q + head * 64 + quad * 8); qf[1] = ld_frag_g(Z + row * LDZ + ZC_Q + head * 64 + 32 + quad * 8);
    const float gc = sigmoidf_(ZS[row * 32 + head * 3]), gs = sigmoidf_(ZS[row * 32 + head * 3 + 1]), gw = sigmoidf_(ZS[row * 32 + head * 3 + 2]);
    f32x4 Of[4];
#pragma unroll
    for (int i = 0; i < 4; ++i) Of[i] = (f32x4){0.f, 0.f, 0.f, 0.f};
    AttnState st;
    const int nct = (t0 >> 10) + 1;
    const bf16* KC = (const bf16*)(ws + WS_KC) + ((size_t)(0 * 2 + b) * 512 * 2 + g) * 64;
    const bf16* VC = (const bf16*)(ws + WS_KC) + ((size_t)(1 * 2 + b) * 512 * 2 + g) * 64;
    const bf16* Zb = Z + (size_t)b * TP * LDZ + g * 64;
    const int skey = tid >> 3, sch = tid & 7;
    const int wlo = (t0 - 511 > 0 ? t0 - 511 : 0) >> 6, nwin = ((t0 + 31) >> 6) - wlo + 1;
    const int nwe = (nwin + 1) & ~1, nce = (nct + 1) & ~1;
    v4u rkA, rvA, rkB, rvB;
#define COMMIT(slot, rk, rv) do { LAS unsigned char* d_ = TB + (slot) * 18432 + skey * 144 + sch * 16; *(LAS v4u*)d_ = rk; *(LAS v4u*)(d_ + 9216) = rv; } while (0)
    NP_T(0);
    const int n1 = nwe + 2 * nce;
#define SEG1_VALID(i) ((i) < nwe ? (i) < nwin : (((i) - nwe) < nce ? ((i) - nwe) < nct : ((i) - nwe - nce) < nct))
#define SEG1_ISSUE(i, rk, rv) do { int i_ = (i); i_ = i_ < n1 ? i_ : n1 - 1; const bool win_ = i_ < nwe; int wt_ = wlo + (i_ < nwin ? i_ : nwin - 1); int jt_ = (i_ - nwe) % nce; jt_ = jt_ < nct ? jt_ : nct - 1; jt_ = jt_ < 0 ? 0 : jt_; \
        const bf16* pk_ = win_ ? Zb + (size_t)(64 * wt_ + skey) * LDZ + sch * 8 + ZC_KW : KC + (size_t)(64 * jt_ + skey) * 128 + sch * 8; \
        const bf16* pv_ = win_ ? Zb + (size_t)(64 * wt_ + skey) * LDZ + sch * 8 + ZC_VW : VC + (size_t)(64 * jt_ + skey) * 128 + sch * 8; \
        rk = *(const v4u*)pk_; rv = *(const v4u*)pv_; } while (0)
    attn_reset(st);
    float mfin = 0.f, il = 0.f;
    SEG1_ISSUE(0, rkA, rvA); SEG1_ISSUE(1, rkB, rvB);
    COMMIT(0, rkA, rvA); COMMIT(1, rkB, rvB);
    SEG1_ISSUE(2, rkA, rvA); SEG1_ISSUE(3, rkB, rvB);
    __syncthreads();
    for (int i = 0; i < n1; i += 2) {
        const LAS unsigned char* K0 = TB + (i & 3) * 18432; const LAS unsigned char* K1 = TB + ((i + 1) & 3) * 18432;
        if (i < nwe) {
            const int kb0 = 64 * (wlo + i), kb1 = kb0 + 64;
            attn_step_pair(K0, K0 + 9216, t - 511 - kb0, t - kb0, true, K1, K1 + 9216, t - 511 - kb1, t - kb1, (i + 1) < nwin, qf, st, rl, quad);
            if (i + 2 == nwe) { attn_accum3(Of, st, gw, lane); attn_reset(st); }
        } else if (i < nwe + nce) {
            const int nb0 = 64 * (i - nwe), nb1 = nb0 + 64;
            attn_step_pair(K0, K0 + 9216, 0, ((t - 31) >> 4) - nb0, true, K1, K1 + 9216, 0, ((t - 31) >> 4) - nb1, (i + 1 - nwe) < nct, qf, st, rl, quad);
            if (i + 2 == nwe + nce) { attn_accum3(Of, st, gc, lane); mfin = st.m * SM_C; const float lt_ = attn_rowsum(st, lane); il = lt_ > 0.f ? 1.f / lt_ : 0.f; }
        } else {
#pragma unroll
            for (int e2 = 0; e2 < 2; ++e2) {
                const int jt = i + e2 - nwe - nce;
                if (jt < nct) {
                    f32x4 s[4]; qk_tile(e2 ? K1 : K0, qf, s, rl, quad);
#pragma unroll
                    for (int kt = 0; kt < 4; ++kt)
#pragma unroll
                        for (int e = 0; e < 4; ++e) {
                            const int n = 64 * jt + 16 * kt + 4 * quad + e;
                            float p = (16 * n + 31 <= t) ? __builtin_amdgcn_exp2f(s[kt][e] * SM_C - mfin) * il : 0.f;
                            p += shx<1>(p, lane); p += shx<2>(p, lane);
                            if ((rl & 3) == 0) AIMP[tk * 512 + n] = p;
                        }
                }
            }
        }
        if (i + 2 < n1) { if (SEG1_VALID(i + 2)) COMMIT((i + 2) & 3, rkA, rvA); if (SEG1_VALID(i + 3)) COMMIT((i + 3) & 3, rkB, rvB); }
        __syncthreads();
        SEG1_ISSUE(i + 4, rkA, rvA); SEG1_ISSUE(i + 5, rkB, rvB);
    }
    NP_T(1);
    {
        const int nav = nct * 64;
        LAS unsigned* KS = (LAS unsigned*)(TB + wave * 2048);
#pragma unroll
        for (int q = 0; q < 4; ++q) {
            const int tq = 4 * wave + q, cur = (t0 + tq) >> 6;
#pragma unroll
            for (int e = 0; e < 2; ++e) {
                const int sblk = lane + 64 * e;
                float imp = 0.f;
#pragma unroll
                for (int d = -1; d <= 3; ++d) { const int n = 4 * sblk + d; if (n >= 0 && n < nav) imp += AIMP[tq * 512 + n]; }
                const bool valid = sblk <= cur, forced = (sblk == 0) || (sblk == cur) || (sblk == cur - 1);
                KS[q * 128 + sblk] = score_key(imp + (forced ? 1000.f : 0.f), valid, sblk);
            }
        }
        asm volatile("" ::: "memory");
#pragma unroll
        for (int q = 0; q < 4; ++q) {
            const int tq = 4 * wave + q, cur = (t0 + tq) >> 6, ng4 = (cur >> 2) + 1;
            const unsigned k0 = KS[q * 128 + lane], k1 = KS[q * 128 + 64 + lane];
            int r0, r1; key_rank2(KS + q * 128, ng4, k0, k1, r0, r1);
            const bool s0 = (lane <= cur) && r0 < 16, s1 = (lane + 64 <= cur) && r1 < 16;
            const unsigned long long m0 = __ballot(s0), m1 = __ballot(s1);
            if (lane == 0) { SEL[tq * 4 + 0] = (unsigned)m0; SEL[tq * 4 + 1] = (unsigned)(m0 >> 32); SEL[tq * 4 + 2] = (unsigned)m1; SEL[tq * 4 + 3] = (unsigned)(m1 >> 32); }
        }
    }
    __syncthreads();
    unsigned un[4], my[4], wv[4];
#pragma unroll
    for (int w = 0; w < 4; ++w) { unsigned v = (lane < 32) ? SEL[lane * 4 + w] : 0u;
        v |= (unsigned)shxi<1>((int)v, lane); v |= (unsigned)shxi<2>((int)v, lane); v |= (unsigned)shxi<4>((int)v, lane); v |= (unsigned)shxi<8>((int)v, lane); v |= (unsigned)shxi<16>((int)v, lane); v |= (unsigned)shxi<32>((int)v, lane);
        un[w] = __builtin_amdgcn_readfirstlane(v); my[w] = SEL[tk * 4 + w];
        wv[w] = SEL[(4 * wave) * 4 + w] | SEL[(4 * wave + 1) * 4 + w] | SEL[(4 * wave + 2) * 4 + w] | SEL[(4 * wave + 3) * 4 + w]; wv[w] = __builtin_amdgcn_readfirstlane(wv[w]); }
#if PH_NSAC > 1
    AttnState st2; attn_reset(st2);
#endif
    NP_T(2);
    attn_reset(st);
    {
        unsigned w0 = un[0], w1 = un[1], w2 = un[2], w3 = un[3];
#define NEXT_BLK(dst) do { if (w0) { dst = __builtin_ctz(w0); w0 &= w0 - 1u; } else if (w1) { dst = 32 + __builtin_ctz(w1); w1 &= w1 - 1u; } else if (w2) { dst = 64 + __builtin_ctz(w2); w2 &= w2 - 1u; } \
        else if (w3) { dst = 96 + __builtin_ctz(w3); w3 &= w3 - 1u; } else dst = -1; } while (0)
#define SEG2_ISSUE(blk_, rk, rv) do { const int b_ = (blk_) >= 0 ? (blk_) : 0; const bf16* p_ = Zb + (size_t)(64 * b_ + skey) * LDZ + sch * 8; rk = *(const v4u*)(p_ + ZC_KS); rv = *(const v4u*)(p_ + ZC_VS); } while (0)
#define BLK_WORD(arr, blk_) (((blk_) >> 5) == 0 ? arr[0] : ((blk_) >> 5) == 1 ? arr[1] : ((blk_) >> 5) == 2 ? arr[2] : arr[3])
#define SEG2_PAIR(ca, cb, sa, sb, stt) do { const LAS unsigned char* K0 = TB + (sa) * 18432; const LAS unsigned char* K1 = TB + (sb) * 18432; \
            const int ca_ = (ca) >= 0 ? (ca) : 0, cb_ = (cb) >= 0 ? (cb) : 0; \
            const bool need0 = ((ca) >= 0) && ((BLK_WORD(wv, ca_) >> (ca_ & 31)) & 1u), need1 = ((cb) >= 0) && ((BLK_WORD(wv, cb_) >> (cb_ & 31)) & 1u); \
            const bool mine0 = need0 && ((BLK_WORD(my, ca_) >> (ca_ & 31)) & 1u), mine1 = need1 && ((BLK_WORD(my, cb_) >> (cb_ & 31)) & 1u); \
            attn_step_pair(K0, K0 + 9216, 0, t - 64 * ca_, mine0, K1, K1 + 9216, 0, t - 64 * cb_, mine1, qf, stt, rl, quad); } while (0)
        v4u rkC, rvC, rkD, rvD;
        int c0, c1, c2, c3, n0, n1b, n2, n3, m0, m1, m2, m3;
        NEXT_BLK(c0); NEXT_BLK(c1); NEXT_BLK(c2); NEXT_BLK(c3); NEXT_BLK(n0); NEXT_BLK(n1b); NEXT_BLK(n2); NEXT_BLK(n3);
        SEG2_ISSUE(c0, rkA, rvA); SEG2_ISSUE(c1, rkB, rvB); SEG2_ISSUE(c2, rkC, rvC); SEG2_ISSUE(c3, rkD, rvD);
        COMMIT(0, rkA, rvA); COMMIT(1, rkB, rvB); COMMIT(2, rkC, rvC); COMMIT(3, rkD, rvD);
        SEG2_ISSUE(n0, rkA, rvA); SEG2_ISSUE(n1b, rkB, rvB); SEG2_ISSUE(n2, rkC, rvC); SEG2_ISSUE(n3, rkD, rvD);
        __syncthreads();
        int i = 0;
        while (c0 >= 0) {
            NEXT_BLK(m0); NEXT_BLK(m1); NEXT_BLK(m2); NEXT_BLK(m3);
            SEG2_PAIR(c0, c1, i & 7, (i + 1) & 7, st);
            SEG2_PAIR(c2, c3, (i + 2) & 7, (i + 3) & 7, st);
#if PH_NSAC > 1
            SEG2_PAIR(c0, c1, i & 7, (i + 1) & 7, st2); SEG2_PAIR(c2, c3, (i + 2) & 7, (i + 3) & 7, st2);
#endif
            COMMIT((i + 4) & 7, rkA, rvA); COMMIT((i + 5) & 7, rkB, rvB); COMMIT((i + 6) & 7, rkC, rvC); COMMIT((i + 7) & 7, rkD, rvD);
            __syncthreads();
#if defined(PH_NSAX) && (PH_NSAX & 1)
            __syncthreads();
#endif
#if defined(PH_NSAX) && (PH_NSAX & 2)
            { v4u d0_, d1_; SEG2_ISSUE(m0, d0_, d1_); asm volatile("" :: "v"(d0_), "v"(d1_)); SEG2_ISSUE(m1, d0_, d1_); asm volatile("" :: "v"(d0_), "v"(d1_));
              SEG2_ISSUE(m2, d0_, d1_); asm volatile("" :: "v"(d0_), "v"(d1_)); SEG2_ISSUE(m3, d0_, d1_); asm volatile("" :: "v"(d0_), "v"(d1_)); }
#endif
            SEG2_ISSUE(m0, rkA, rvA); SEG2_ISSUE(m1, rkB, rvB); SEG2_ISSUE(m2, rkC, rvC); SEG2_ISSUE(m3, rkD, rvD);
            c0 = n0; c1 = n1b; c2 = n2; c3 = n3; n0 = m0; n1b = m1; n2 = m2; n3 = m3; i += 4;
        }
    }
    NP_T(3);
    attn_accum3(Of, st, gs, lane);
#if PH_NSAC > 1
    attn_accum3(Of, st2, (float)(layer >> 8), lane);
#endif
#undef SEG1_ISSUE
#undef SEG1_VALID
#undef SEG2_ISSUE
#undef SEG2_PAIR
#undef BLK_WORD
#undef COMMIT
#undef NEXT_BLK
    bf16* MIX = (bf16*)(ws + WS_MIX) + row * 1536 + head * 64;
#pragma unroll
    for (int dt = 0; dt < 4; ++dt) { v2u w; w.x = pk2(Of[dt][0], Of[dt][1]); w.y = pk2(Of[dt][2], Of[dt][3]); *(v2u*)(MIX + 16 * dt + 4 * quad) = w; }
    __syncthreads();
}

#define CB() asm volatile("" ::: "memory")
DI void stage_wave_f32(LAS unsigned char* Kt, LAS unsigned char* Vt, const float* kb, const float* vb, size_t stride, int lane) {
    const int k0 = lane >> 3, ch = lane & 7;
#pragma unroll
    for (int h = 0; h < 4; ++h) {
        const float* src = (h < 2 ? kb : vb); LAS unsigned char* dst = (h < 2 ? Kt : Vt); const int r0 = (h & 1) * 32;
        f32x4 a[4][2];
#pragma unroll
        for (int it = 0; it < 4; ++it) { const float* kp = src + (size_t)(r0 + it * 8 + k0) * stride + ch * 8; a[it][0] = *(const f32x4*)kp; a[it][1] = *(const f32x4*)(kp + 4); }
#pragma unroll
        for (int it = 0; it < 4; ++it) *(LAS v4u*)(dst + (r0 + it * 8 + k0) * 144 + ch * 16) = pack8(a[it][0], a[it][1]);
        asm volatile("" ::: "memory");
    }
}
DI void stage_wave_b16(LAS unsigned char* Kt, LAS unsigned char* Vt, const bf16* kb, const bf16* vb, size_t stride, int nvalid, int lane, bool do_v) {
    const int k0 = lane >> 3, ch = lane & 7;
    const v4u z = (v4u){0u, 0u, 0u, 0u};
#pragma unroll
    for (int it = 0; it < 8; ++it) {
        const int key = it * 8 + k0; const bool v = key < nvalid;
        *(LAS v4u*)(Kt + key * 144 + ch * 16) = v ? *(const v4u*)(kb + key * stride + ch * 8) : z;
        if (do_v) *(LAS v4u*)(Vt + key * 144 + ch * 16) = v ? *(const v4u*)(vb + key * stride + ch * 8) : z;
    }
}
DI void nsa_sample_unit(Frame& F, int layer, int s) {
    int lane = F.lane, wave = F.wave; asm volatile("" : "+v"(lane), "+s"(wave));
    const int quad = lane >> 4, rl = lane & 15;
    const int g = wave & 1, q4 = wave >> 1;
    unsigned char* ws = KWS();
    const bf16* Z = (const bf16*)(ws + WS_Z);
    const float* ZS = (const float*)(ws + WS_ZS);
    LAS unsigned char* Kt = F.lds + wave * 18432; LAS unsigned char* Vt = Kt + 9216;
    LAS float* AIMP = (LAS float*)Vt;
    const int j = rl >> 2, head = 4 * g + (rl & 3), qpos = 2048 + j;
    const size_t row = (size_t)MP + 4 * s + j;
    bf16x8 qf[2];
    qf[0] = ld_frag_g(Z + row * LDZ + ZC_Q + head * 64 + quad * 8); qf[1] = ld_frag_g(Z + row * LDZ + ZC_Q + head * 64 + 32 + quad * 8);
    const float gc = sigmoidf_(ZS[row * 32 + head * 3]), gs = sigmoidf_(ZS[row * 32 + head * 3 + 1]), gw = sigmoidf_(ZS[row * 32 + head * 3 + 2]);
    f32x4 Of[4];
#pragma unroll
    for (int i = 0; i < 4; ++i) Of[i] = (f32x4){0.f, 0.f, 0.f, 0.f};
    AttnState st;
    const bf16* KC = (const bf16*)(ws + WS_KCS) + ((size_t)(0 * 128 + s) * 128 * 2 + g) * 64;
    const bf16* VC = (const bf16*)(ws + WS_KCS) + ((size_t)(1 * 128 + s) * 128 * 2 + g) * 64;
    attn_reset(st);
#pragma unroll 1
    for (int jt = 0; jt < 2; ++jt) {
        stage_wave_b16(Kt, Vt, KC + (size_t)64 * jt * 128, VC + (size_t)64 * jt * 128, 128, 64, lane, true); CB();
        attn_step3(Kt, Vt, qf, st, 0, 126 - 64 * jt, true, rl, quad); CB();
    }
    attn_accum3(Of, st, q4 == 0 ? gc : 0.f, lane);
    {
        const float mfin = st.m * SM_C, lt = attn_rowsum(st, lane), il = lt > 0.f ? 1.f / lt : 0.f;
#pragma unroll 1
        for (int jt = 0; jt < 2; ++jt) {
            stage_wave_b16(Kt, Vt, KC + (size_t)64 * jt * 128, VC, 128, 64, lane, false); CB();
            f32x4 sv[4]; qk_tile(Kt, qf, sv, rl, quad); CB();
#pragma unroll
            for (int kt = 0; kt < 4; ++kt)
#pragma unroll
                for (int i = 0; i < 4; ++i) {
                    const int n = 64 * jt + 16 * kt + 4 * quad + i;
                    float p = (n <= 126) ? __builtin_amdgcn_exp2f(sv[kt][i] * SM_C - mfin) * il : 0.f;
                    p += shx<1>(p, lane); p += shx<2>(p, lane);
                    if ((rl & 3) == 0) AIMP[j * 128 + n] = p;
                }
        }
    }
    CB();
    unsigned long long msk[4];
    {
        unsigned keys[4];
#pragma unroll
        for (int q = 0; q < 4; ++q) {
            float imp = 0.f;
#pragma unroll
            for (int d = -1; d <= 3; ++d) { const int n = 4 * lane + d; if (n >= 0 && n <= 126 && lane < 33) imp += AIMP[q * 128 + n]; }
            const bool forced = (lane == 0) || (lane == 32) || (lane == 31);
            keys[q] = score_key(imp + (forced ? 1000.f : 0.f), lane < 33, lane);
        }
        CB();
        LAS unsigned* KS = (LAS unsigned*)Kt;
#pragma unroll
        for (int q = 0; q < 4; ++q) KS[q * 64 + lane] = keys[q];
        CB();
#pragma unroll
        for (int q = 0; q < 4; ++q) msk[q] = __ballot(lane < 33 && key_rank(KS + q * 64, 9, keys[q]) < 16);
    }
    CB();
    const unsigned long long un = msk[0] | msk[1] | msk[2] | msk[3];
    const unsigned long long mym = j == 0 ? msk[0] : j == 1 ? msk[1] : j == 2 ? msk[2] : msk[3];
    const int* pt = (const int*)KIN(7);
    AttnState sw;
    attn_reset(st); attn_reset(sw);
    {
        unsigned long long word = un; int idx = 0;
        while (word) {
            const int blk = __builtin_ctzll(word); word &= word - 1ull;
            if ((idx++ & 3) != q4) continue;
            if (blk < 32) {
                const int phys = pt[s * 16 + (blk >> 1)];
                const float* base = KIN(2) + ((size_t)(layer * 2560 + phys) * 128 + (blk & 1) * 64) * 512 + g * 64;
                stage_wave_f32(Kt, Vt, base + 256, base + 384, 512, lane); CB();
            } else {
                stage_wave_b16(Kt, Vt, Z + (size_t)(MP + 4 * s) * LDZ + ZC_KS + g * 64, Z + (size_t)(MP + 4 * s) * LDZ + ZC_VS + g * 64, LDZ, 4, lane, true); CB();
            }
            attn_step3(Kt, Vt, qf, st, 0, qpos - 64 * blk, (mym >> blk) & 1ull, rl, quad); CB();
        }
#pragma unroll 1
        for (int jt = 0; jt < 9; ++jt) {
            if ((idx++ & 3) != q4) continue;
            if (jt < 8) { const float* base = KIN(3) + ((size_t)(layer * 128 + s) * 512 + 64 * jt) * 256 + g * 64; stage_wave_f32(Kt, Vt, base, base + 128, 256, lane); CB(); }
            else { stage_wave_b16(Kt, Vt, Z + (size_t)(MP + 4 * s) * LDZ + ZC_KW + g * 64, Z + (size_t)(MP + 4 * s) * LDZ + ZC_VW + g * 64, LDZ, 4, lane, true); CB(); }
            attn_step3(Kt, Vt, qf, sw, j + 1 - 64 * jt, 512 + j - 64 * jt, true, rl, quad); CB();
        }
    }
    int lane2 = lane; asm volatile("" : "+v"(lane2));
    LAS float* X = (LAS float*)(F.lds + wave * 18432);
    {
        const float ls = attn_rowsum(st, lane), lw = attn_rowsum(sw, lane);
        X[0 * 64 + lane2] = st.m; X[1 * 64 + lane2] = ls; X[18 * 64 + lane2] = sw.m; X[19 * 64 + lane2] = lw;
#pragma unroll
        for (int dt = 0; dt < 4; ++dt)
#pragma unroll
            for (int e = 0; e < 4; ++e) { X[(2 + 4 * dt + e) * 64 + lane2] = st.O[dt][e]; X[(20 + 4 * dt + e) * 64 + lane2] = sw.O[dt][e]; }
    }
    __syncthreads();
    if (q4 == 0) {
#pragma unroll
        for (int br = 0; br < 2; ++br) {
            float m[4], l[4];
#pragma unroll
            for (int q = 0; q < 4; ++q) { const LAS float* Y = (const LAS float*)(F.lds + (2 * q + g) * 18432) + br * 18 * 64; m[q] = Y[lane2]; l[q] = Y[64 + lane2]; }
            const float mm = fmaxf(fmaxf(m[0], m[1]), fmaxf(m[2], m[3]));
            float w[4], lt = 0.f;
#pragma unroll
            for (int q = 0; q < 4; ++q) { w[q] = __builtin_amdgcn_exp2f((m[q] - mm) * SM_C); lt += l[q] * w[q]; }
            const float gate = br == 0 ? gs : gw;
            const float sc = lt > 0.f ? gate / lt : 0.f;
#pragma unroll
            for (int q = 0; q < 4; ++q) { const LAS float* Y = (const LAS float*)(F.lds + (2 * q + g) * 18432) + br * 18 * 64; const float wq = w[q] * sc;
#pragma unroll
                for (int dt = 0; dt < 4; ++dt)
#pragma unroll
                    for (int e = 0; e < 4; ++e) Of[dt][e] += Y[(2 + 4 * dt + e) * 64 + lane2] * wq; }
        }
        bf16* MIX = (bf16*)(ws + WS_MIX) + row * 1536 + head * 64;
#pragma unroll
        for (int dt = 0; dt < 4; ++dt) { v2u w2; w2.x = pk2(Of[dt][0], Of[dt][1]); w2.y = pk2(Of[dt][2], Of[dt][3]); *(v2u*)(MIX + 16 * dt + 4 * quad) = w2; }
    }
    __syncthreads();
}
DI void ret_out_unit(Frame& F, int layer, int unit) {
    const int tid = F.tid, lane = F.lane, wave = F.wave, quad = lane >> 4, rl = lane & 15;
    const int b = unit >> 8, h = (unit >> 6) & 3, c = unit & 63;
    const int row0 = b * TP + 128 * c;
    unsigned char* ws = KWS();
    const bf16* Z = (const bf16*)(ws + WS_Z);
    const bf16* QR = (const bf16*)(ws + WS_QR); const bf16* KR = (const bf16*)(ws + WS_KR);
    const bf16* RST = (const bf16*)(ws + WS_RST) + (size_t)unit * 16384;
    LAS unsigned char* LQ = F.lds; LAS unsigned char* LK = F.lds + 34816; LAS unsigned char* LV = F.lds + 69632; LAS unsigned char* LS = F.lds + 104448;
    for (int it = tid; it < 2048; it += NTHREADS) {
        const int j = it >> 4, cc = it & 15;
        *(LAS v4u*)(LQ + j * 272 + cc * 16) = *(const v4u*)(QR + (size_t)(row0 + j) * 512 + h * 128 + cc * 8);
        *(LAS v4u*)(LK + j * 272 + cc * 16) = *(const v4u*)(KR + (size_t)(row0 + j) * 512 + h * 128 + cc * 8);
        *(LAS v4u*)(LS + j * 272 + cc * 16) = *(const v4u*)(RST + (size_t)j * 128 + cc * 8);
        const v4u w = *(const v4u*)(Z + (size_t)(row0 + j) * LDZ + ZC_RQKV + 1024 + h * 128 + cc * 8);
        LAS unsigned char* d = LV + (cc * 8) * 272 + j * 2;
        *(LAS bf16*)(d) = (bf16)(w.x & 0xffff); *(LAS bf16*)(d + 272) = (bf16)(w.x >> 16); *(LAS bf16*)(d + 2 * 272) = (bf16)(w.y & 0xffff); *(LAS bf16*)(d + 3 * 272) = (bf16)(w.y >> 16);
        *(LAS bf16*)(d + 4 * 272) = (bf16)(w.z & 0xffff); *(LAS bf16*)(d + 5 * 272) = (bf16)(w.z >> 16); *(LAS bf16*)(d + 6 * 272) = (bf16)(w.w & 0xffff); *(LAS bf16*)(d + 7 * 272) = (bf16)(w.w >> 16);
    }
    __syncthreads();
    const float lg = ret_lg(h);
    const int il = 16 * wave + rl;
    bf16x8 qb[4];
#pragma unroll
    for (int s = 0; s < 4; ++s) qb[s] = ld_frag_l(LQ + il * 272 + (32 * s + 8 * quad) * 2);
    f32x4 C[8];
    const float qdec = __expf((float)(il + 1) * lg);
#pragma unroll
    for (int dt = 0; dt < 8; ++dt) {
        f32x4 a = (f32x4){0.f, 0.f, 0.f, 0.f};
#pragma unroll
        for (int s = 0; s < 4; ++s) a = mfma16(ld_frag_l(LS + (16 * dt + rl) * 272 + (32 * s + 8 * quad) * 2), qb[s], a);
        C[dt] = a * qdec;
    }
    for (int s2 = 0; s2 <= (wave >> 1); ++s2) {
        f32x4 P[2];
#pragma unroll
        for (int e = 0; e < 2; ++e) {
            const int jt = 2 * s2 + e;
            f32x4 a = (f32x4){0.f, 0.f, 0.f, 0.f};
            if (jt <= wave) {
#pragma unroll
                for (int s = 0; s < 4; ++s) a = mfma16(ld_frag_l(LK + (16 * jt + rl) * 272 + (32 * s + 8 * quad) * 2), qb[s], a);
#pragma unroll
                for (int i = 0; i < 4; ++i) { const int jj = 16 * jt + 4 * quad + i; a[i] = (il >= jj) ? a[i] * __expf((float)(il - jj) * lg) : 0.f; }
            }
            P[e] = a;
        }
        const bf16x8 pb = pack_frag(P[0], P[1]);
#pragma unroll
        for (int dt = 0; dt < 8; ++dt) {
            const LAS unsigned char* vp = LV + (16 * dt + rl) * 272 + (32 * s2 + 4 * quad) * 2;
            C[dt] = mfma16(mk_frag(*(const LAS v2u*)vp, *(const LAS v2u*)(vp + 32)), pb, C[dt]);
        }
    }
    float ss = 0.f;
#pragma unroll
    for (int dt = 0; dt < 8; ++dt) ss += (C[dt][0] * C[dt][0] + C[dt][1] * C[dt][1]) + (C[dt][2] * C[dt][2] + C[dt][3] * C[dt][3]);
    ss += shx<16>(ss, lane); ss += shx<32>(ss, lane);
    const float scl = rsqrtf(ss * (1.f / 128.f) + EPS);
    const size_t row = (size_t)row0 + il;
#pragma unroll
    for (int dt = 0; dt < 8; ++dt) {
        const v2u gwd = *(const v2u*)(Z + row * LDZ + ZC_RG + h * 128 + 16 * dt + 4 * quad);
        v2u w; w.x = pk2(C[dt][0] * scl * siluf_(lo_bf(gwd.x)), C[dt][1] * scl * siluf_(hi_bf(gwd.x))); w.y = pk2(C[dt][2] * scl * siluf_(lo_bf(gwd.y)), C[dt][3] * scl * siluf_(hi_bf(gwd.y)));
        *(v2u*)((bf16*)(ws + WS_MIX) + row * 1536 + 1024 + h * 128 + 16 * dt + 4 * quad) = w;
    }
    __syncthreads();
}
DI void gdn_out_row(Frame& F, int layer, int row) {
    const int lane = F.lane;
    unsigned char* ws = KWS();
    const float* o = (const float*)(ws + WS_OGDN) + (size_t)row * 512 + lane * 8;
    const f32x4 a = *(const f32x4*)o, b = *(const f32x4*)(o + 4);
    float ss = (a[0] * a[0] + a[1] * a[1]) + (a[2] * a[2] + a[3] * a[3]) + (b[0] * b[0] + b[1] * b[1]) + (b[2] * b[2] + b[3] * b[3]);
    ss += shx<1>(ss, lane); ss += shx<2>(ss, lane); ss += shx<4>(ss, lane); ss += shx<8>(ss, lane);
    const float scl = rsqrtf(ss * (1.f / 128.f) + EPS);
    const float* ng = KIN(18) + layer * 128 + (lane & 15) * 8;
    const f32x4 ga = *(const f32x4*)ng, gb = *(const f32x4*)(ng + 4);
    f32x4 za, zb; unpack8(*(const v4u*)((const bf16*)(ws + WS_Z) + (size_t)row * LDZ + ZC_GZ + lane * 8), za, zb);
    f32x4 ra, rb;
#pragma unroll
    for (int e = 0; e < 4; ++e) { ra[e] = a[e] * scl * ga[e] * siluf_(za[e]); rb[e] = b[e] * scl * gb[e] * siluf_(zb[e]); }
    *(v4u*)((bf16*)(ws + WS_MIX) + (size_t)row * 1536 + 512 + lane * 8) = pack8(ra, rb);
}
DI void final_row(Frame& F, int row) {
    const int lane = F.lane;
    const float* x = (const float*)(KWS() + WS_XR) + (size_t)row * DM;
    float* y = (row < MP) ? KOUT() + O_YP + (size_t)row * DM : KOUT() + O_YS + (size_t)(row - MP) * DM;
    f32x4 v[4]; float ss = 0.f;
#pragma unroll
    for (int j = 0; j < 4; ++j) { v[j] = *(const f32x4*)(x + 256 * j + lane * 4); ss += (v[j][0] * v[j][0] + v[j][1] * v[j][1]) + (v[j][2] * v[j][2] + v[j][3] * v[j][3]); }
    const float scl = rsqrtf(wave_sum(ss, lane) * (1.f / DM) + EPS);
#pragma unroll
    for (int j = 0; j < 4; ++j) *(f32x4*)(y + 256 * j + lane * 4) = v[j] * scl * *(const f32x4*)(KIN(26) + 256 * j + lane * 4);
}
template <class Epi>
DI void sgemm_tile(Frame& F, const bf16* A, int lda, const bf16* Bt, int ldb, int K, int row0, int col0, const Epi& E) {
    int lane = F.lane, wave = F.wave; asm volatile("" : "+v"(lane), "+s"(wave));
    const int tid = wave * 64 + lane, quad = lane >> 4, rl = lane & 15;
    const int kper = K >> 3, nks = kper >> 5;
    f32x4 acc[2][4];
#pragma unroll
    for (int rt = 0; rt < 2; ++rt)
#pragma unroll
        for (int ct = 0; ct < 4; ++ct) acc[rt][ct] = (f32x4){0.f, 0.f, 0.f, 0.f};
    const bf16* ap = A + (size_t)(row0 + rl) * lda + wave * kper + quad * 8;
    const bf16* bp = Bt + (size_t)(col0 + rl) * ldb + wave * kper + quad * 8;
#pragma unroll 4
    for (int ks = 0; ks < nks; ++ks) {
        bf16x8 a[2], b[4];
#pragma unroll
        for (int rt = 0; rt < 2; ++rt) a[rt] = ld_frag_g(ap + (size_t)(16 * rt) * lda + ks * 32);
#pragma unroll
        for (int ct = 0; ct < 4; ++ct) b[ct] = ld_frag_g(bp + (size_t)(16 * ct) * ldb + ks * 32);
#pragma unroll
        for (int rt = 0; rt < 2; ++rt)
#pragma unroll
            for (int ct = 0; ct < 4; ++ct) acc[rt][ct] = mfma16(a[rt], b[ct], acc[rt][ct]);
    }
    LAS float* RED = (LAS float*)F.lds;
#pragma unroll
    for (int rt = 0; rt < 2; ++rt)
#pragma unroll
        for (int ct = 0; ct < 4; ++ct)
#pragma unroll
            for (int i = 0; i < 4; ++i) RED[wave * 2176 + (16 * rt + 4 * quad + i) * 68 + 16 * ct + rl] = acc[rt][ct][i];
    __syncthreads();
    const int r = tid >> 4, c4 = (tid & 15) * 4;
    f32x4 v = *(const LAS f32x4*)(RED + r * 68 + c4);
#pragma unroll
    for (int w = 1; w < 8; ++w) v += *(const LAS f32x4*)(RED + w * 2176 + r * 68 + c4);
    E(row0 + r, col0 + c4, v, lane);
    __syncthreads();
}
struct SEpiC {
    const bf16* Z; bf16* G;
    DI void operator()(int row, int col, f32x4 v, int lane) const {
        const v2u gw = *(const v2u*)(Z + (size_t)row * LDZ + ZC_MG + col);
        v[0] *= sigmoidf_(lo_bf(gw.x)); v[1] *= sigmoidf_(hi_bf(gw.x)); v[2] *= sigmoidf_(lo_bf(gw.y)); v[3] *= sigmoidf_(hi_bf(gw.y));
        *(v2u*)(G + (size_t)row * 3072 + col) = pack4(v);
    }
};
struct SEpiRes {
    float* XR; bf16* XG; const float* gvec; float* SS; float* T; int mode;
    DI void operator()(int row, int col, f32x4 v, int lane) const {
        const size_t o = (size_t)row * DM + col;
        if (mode == 1) { *(f32x4*)(T + o) = v; return; }
        f32x4 x = *(const f32x4*)(XR + o);
        if (mode == 2) { const f32x4 t = *(const f32x4*)(T + o);
#pragma unroll
            for (int e = 0; e < 4; ++e) v[e] = t[e] * sigmoidf_(v[e]); }
        x += v;
        *(f32x4*)(XR + o) = x;
        if (XG) { f32x4 y = x; if (gvec) y *= *(const f32x4*)(gvec + col); *(v2u*)(XG + o) = pack4(y); }
        if (SS) { float ssq = (x[0] * x[0] + x[1] * x[1]) + (x[2] * x[2] + x[3] * x[3]);
            ssq += shx<1>(ssq, lane); ssq += shx<2>(ssq, lane); ssq += shx<4>(ssq, lane); ssq += shx<8>(ssq, lane);
            if ((lane & 15) == 0) SS[(size_t)row * 16 + (col >> 6)] = ssq; }
    }
};
struct SEpiUp {
    bf16* H; const float* SS;
    DI void operator()(int row, int col, f32x4 v, int lane) const {
        const f32x4 p0 = *(const f32x4*)(SS + (size_t)row * 16), p1 = *(const f32x4*)(SS + (size_t)row * 16 + 4), p2 = *(const f32x4*)(SS + (size_t)row * 16 + 8), p3 = *(const f32x4*)(SS + (size_t)row * 16 + 12);
        const f32x4 ps = (p0 + p1) + (p2 + p3);
        const float rstd = rsqrtf(((ps[0] + ps[1]) + (ps[2] + ps[3])) * (1.f / DM) + EPS);
#pragma unroll
        for (int e = 0; e < 4; ++e) { const float a = fmaxf(v[e] * rstd, 0.f); v[e] = a * a; }
        *(v2u*)(H + (size_t)row * DFF + col) = pack4(v);
    }
};
#ifndef PH_P0
#define PH_P0 1
#endif
#ifndef PH_A
#define PH_A 1
#endif
#ifndef PH_B0a
#define PH_B0a 1
#endif
#ifndef PH_B0b
#define PH_B0b 1
#endif
#ifndef PH_B0c
#define PH_B0c 1
#endif
#ifndef PH_B0d
#define PH_B0d 1
#endif
#ifndef PH_SCAN
#define PH_SCAN 1
#endif
#ifndef PH_RSCAN
#define PH_RSCAN 1
#endif
#ifndef PH_NSAP
#define PH_NSAP 1
#endif
#ifndef PH_NSAS
#define PH_NSAS 1
#endif
#ifndef PH_B2
#define PH_B2 1
#endif
#ifndef PH_C
#define PH_C 1
#endif
#ifndef PH_XBAR
#define PH_XBAR 0
#endif
#ifndef PH_D
#define PH_D 1
#endif
#ifndef PH_E
#define PH_E 1
#endif
#ifndef PH_F
#define PH_F 1
#endif
#ifndef PH_G1
#define PH_G1 1
#endif
#ifndef PH_G2
#define PH_G2 1
#endif
#ifndef PH_TREG
#define PH_TREG (-1)
#endif
#if PH_TREG >= 0
#define TREG_MARK(r) do { const unsigned long long now_ = __builtin_amdgcn_s_memrealtime(); if ((r) == PH_TREG) tacc_ += now_ - tlast_; tlast_ = now_; } while (0)
#define TREG_SUB(r) do { const unsigned long long now_ = __builtin_amdgcn_s_memrealtime(); if ((r) == PH_TREG) tacc_ += now_ - tsub_; tsub_ = now_; } while (0)
#else
#define TREG_MARK(r) do { } while (0)
#define TREG_SUB(r) do { } while (0)
#endif
struct Args { const void* in[27]; float* out; unsigned char* ws; };
__global__ void __launch_bounds__(NTHREADS, 2) mk_fwd(Args args) {
    extern __shared__ __attribute__((aligned(16))) unsigned char lds_raw[];
    Frame F;
    F.lds = (LAS unsigned char*)lds_raw;
    F.wave = __builtin_amdgcn_readfirstlane((int)threadIdx.x >> 6); F.lane = 0; F.tid = 0;
    F.G = gridDim.x; F.bid = blockIdx.x;
    F.ctl = (gu32*)(KWS() + WS_CTL);
    { const Frame Fp = fresh(F); for (int u = Fp.tid; u < (LDS_BYTES - LDSCTL_OFF) / 4; u += NTHREADS) ((LAS unsigned*)(F.lds + LDSCTL_OFF))[u] = 0u;
      __syncthreads();
      (void)xcd_barrier_post((unsigned*)(F.ctl + CW_BAR), (volatile LAS unsigned*)(F.lds + MISC_OFF) + 8, Fp.tid == 0); }
    const int G = F.G, bid = F.bid;
#if PH_TREG >= 0
    unsigned long long tacc_ = 0ull, tlast_ = __builtin_amdgcn_s_memrealtime(), tsub_ = tlast_;
#endif

        for (int rp_ = 0; rp_ < PH_P0; ++rp_) {
    { Frame Fp = fresh(F); p0_prologue(Fp); }
        }
    GRID_BAR();
    TREG_MARK(0);

    for (int layer = 0; layer < NLAYER; ++layer) {
        for (int rp_ = 0; rp_ < PH_A; ++rp_) {
        {
            const Frame Fg = fresh(F); const int G = Fg.G, bid = Fg.bid;
            unsigned char* ws = KWS();
            pg8::Gemm g{(const bf16*)(ws + WS_XGA), (const bf16*)(ws + WS_WIN + layer * SZ_WIN), MROWS, LDZ, DM, DM, DM, 31, 0};
            pg8::StaticOrder S; S.init(MROWS, LDZ, G, bid);
            epi::EpiA E{(bf16*)(ws + WS_Z), (float*)(ws + WS_ZS), (const float*)(ws + WS_SSA), KOUT(), layer};
            pg8::gemm_phase<epi::EpiA, pg8::StaticOrder, true, true>(Fg.lds, g, S, E, Fg.tid);
        }
        }
        GRID_BAR();
    TREG_MARK(1);
#if PH_TREG >= 0
        tsub_ = __builtin_amdgcn_s_memrealtime();
#endif
        {
            Frame Fp = fresh(F);
            gu32* qhead = F.ctl + CW_QUEUE + 512 * layer + 384;
            volatile LAS int* qslot = (volatile LAS int*)(F.lds + MISC_OFF) + 16;
            constexpr int N0 = 272 * PH_B0d, N1 = 1024 * PH_B0a, N2 = 1024 * PH_B0c, N3 = 512 * PH_B0b;
            int qnext = 0;
            if (Fp.tid == 0) qnext = (int)__hip_atomic_fetch_add(qhead, 1u, __ATOMIC_RELAXED, __HIP_MEMORY_SCOPE_AGENT);
            for (;;) {
                if (Fp.tid == 0) qslot[0] = qnext;
                __syncthreads();
                int it = qslot[0];
                __syncthreads();
                it = __builtin_amdgcn_readfirstlane(it);
                if (it >= N0 + N1 + N2 + N3) break;
                if (Fp.tid == 0) qnext = (int)__hip_atomic_fetch_add(qhead, 1u, __ATOMIC_RELAXED, __HIP_MEMORY_SCOPE_AGENT);
                TREG_SUB(99);
                if (it < N0) compress_job(Fp, layer, it % 272);
                else if (it < N0 + N1) gdn_prep_unit(Fp, layer, (it - N0) & 1023);
                else if (it < N0 + N1 + N2) sample_rec_unit(Fp, layer, (it - N0 - N1) & 1023);
                else ret_prep_unit(Fp, layer, (it - N0 - N1 - N2) & 511);
                TREG_SUB(it < N0 ? 40 : (it < N0 + N1 ? 41 : (it < N0 + N1 + N2 ? 42 : 43)));
            }
        }
        GRID_BAR();
    TREG_MARK(2);
        {
            Frame Fp = fresh(F);
            gu32* qbase = F.ctl + CW_QUEUE + 512 * layer;
            volatile LAS int* qslot = (volatile LAS int*)(F.lds + MISC_OFF) + 16;
            constexpr int NQ = 8 * PH_SCAN, NS = 128 * PH_NSAS, NR = 32 * PH_RSCAN, NP = 256 * PH_NSAP;
            const int pref = (int)(xb_xcc_id() & 3u);
            for (;;) {
                if (Fp.tid == 0) qslot[1] = (int)__hip_atomic_fetch_add(qbase, 1u, __ATOMIC_RELAXED, __HIP_MEMORY_SCOPE_AGENT);
                __syncthreads();
                int it = qslot[1];
                __syncthreads();
                it = __builtin_amdgcn_readfirstlane(it);
                if (it >= NQ + NS + NR) break;
                TREG_SUB(99);
                if (it < NQ) gdn_scan_chain(Fp, layer, it & 7);
                else if (it < NQ + NS) nsa_sample_unit(Fp, layer, (it - NQ) & 127);
                else ret_scan_part(Fp, layer, (it - NQ - NS) & 31);
                TREG_SUB(it < NQ ? 21 : (it < NQ + NS ? 22 : 23));
            }
            int rnext = 0;
            if (Fp.tid == 0) rnext = (int)__hip_atomic_fetch_add(qbase + 64 * (1 + pref), 1u, __ATOMIC_RELAXED, __HIP_MEMORY_SCOPE_AGENT);
            for (;;) {
                if (Fp.tid == 0) {
                    int kind = pref, idx = rnext;
                    if (idx >= NP) {
                        kind = -1;
                        for (int k = 1; k < 4 && kind < 0; ++k) { const int s = (pref + k) & 3;
                            if ((int)__hip_atomic_load(qbase + 64 * (1 + s), __ATOMIC_RELAXED, __HIP_MEMORY_SCOPE_AGENT) < NP) {
                                const int r = (int)__hip_atomic_fetch_add(qbase + 64 * (1 + s), 1u, __ATOMIC_RELAXED, __HIP_MEMORY_SCOPE_AGENT);
                                if (r < NP) { kind = s; idx = r; } } }
                    }
                    qslot[0] = kind; qslot[1] = idx;
                }
                __syncthreads();
                int kind = qslot[0], it = qslot[1];
                __syncthreads();
                kind = __builtin_amdgcn_readfirstlane(kind); it = __builtin_amdgcn_readfirstlane(it);
                if (kind < 0) break;
                if (Fp.tid == 0) rnext = (int)__hip_atomic_fetch_add(qbase + 64 * (1 + pref), 1u, __ATOMIC_RELAXED, __HIP_MEMORY_SCOPE_AGENT);
                TREG_SUB(99);
                nsa_prompt_unit(Fp, layer, (kind << 8) | (255 - (it & 255)));
                TREG_SUB(20);
            }
        }
        GRID_BAR();
    TREG_MARK(3);
        for (int rp_ = 0; rp_ < PH_B2; ++rp_) {
        { Frame Fp = fresh(F); for (int u = Fp.bid; u < 512; u += Fp.G) ret_out_unit(Fp, layer, u); }
        { Frame Fp = fresh(F); for (int r = Fp.bid * NWAVES + Fp.wave; r < MROWS; r += Fp.G * NWAVES) gdn_out_row(Fp, layer, r); }
        }
        GRID_BAR();
    TREG_MARK(4);
        for (int rp_ = 0; rp_ < PH_C; ++rp_) {
        {
            const Frame Fg = fresh(F); const int G = Fg.G, bid = Fg.bid;
            unsigned char* ws = KWS();
            pg8::Gemm g{(const bf16*)(ws + WS_MIX), (const bf16*)(ws + WS_WBR + layer * SZ_WBR), MP, 3072, 512, 1536, 512, 2, 1024};
            pg8::StaticOrder S; S.init(MP, 3072, G, bid);
            epi::EpiC E{(const bf16*)(ws + WS_Z), (bf16*)(ws + WS_GATED)};
            pg8::gemm_phase<epi::EpiC, pg8::StaticOrder, true, true>(Fg.lds, g, S, E, Fg.tid);
            TREG_SUB(99);
            {
                Frame Fs = fresh(F); const SEpiC Es{(const bf16*)(ws + WS_Z), (bf16*)(ws + WS_GATED)};
                for (int tl = Fs.bid; tl < 16 * 48; tl += Fs.G) { const int rt = tl & 15, ct = tl >> 4, b = ct >> 4;
                    sgemm_tile(Fs, (const bf16*)(ws + WS_MIX) + b * 512, 1536, (const bf16*)(ws + WS_WBR + layer * SZ_WBR), 512, 512, MP + 32 * rt, 64 * ct, Es); }
            }
            TREG_SUB(31);
        }
        }
        GRID_BAR();
    TREG_MARK(5);
        for (int rp_ = 0; rp_ < PH_D; ++rp_) {
        {
            const Frame Fg = fresh(F); const int G = Fg.G, bid = Fg.bid;
            unsigned char* ws = KWS();
            pg8::Gemm g{(const bf16*)(ws + WS_GATED), (const bf16*)(ws + WS_WO3 + layer * SZ_WO3), MP, DM, 3072, 3072, 3072, 31, 0};
            pg8::StaticOrder S; S.init(MP, DM, G, bid);
            epi::EpiRes E{(float*)(ws + WS_XR), (bf16*)(ws + WS_XGB), KIN(21) + layer * DM, (float*)(ws + WS_SSB), nullptr, (rp_ + 1 < PH_D) ? 3 : 0};
            pg8::gemm_phase<epi::EpiRes, pg8::StaticOrder, true, true>(Fg.lds, g, S, E, Fg.tid);
            TREG_SUB(99);
            if (rp_ + 1 == PH_D) {
                Frame Fs = fresh(F); const SEpiRes Es{(float*)(ws + WS_XR), (bf16*)(ws + WS_XGB), KIN(21) + layer * DM, (float*)(ws + WS_SSB), nullptr, 0};
                for (int tl = Fs.bid; tl < 256; tl += Fs.G) sgemm_tile(Fs, (const bf16*)(ws + WS_GATED), 3072, (const bf16*)(ws + WS_WO3 + layer * SZ_WO3), 3072, 3072, MP + 32 * (tl & 15), 64 * (tl >> 4), Es);
            }
            TREG_SUB(32);
        }
        }
        GRID_BAR();
    TREG_MARK(6);
        for (int rp_ = 0; rp_ < PH_E; ++rp_) {
        {
            const Frame Fg = fresh(F); const int G = Fg.G, bid = Fg.bid;
            unsigned char* ws = KWS();
            pg8::Gemm g{(const bf16*)(ws + WS_XGB), (const bf16*)(ws + WS_WUP + layer * SZ_WUP), MP, DFF, DM, DM, DM, 31, 0};
            pg8::StaticOrder S; S.init(MP, DFF, G, bid);
            epi::EpiUp E{(bf16*)(ws + WS_HMID), (const float*)(ws + WS_SSB)};
            pg8::gemm_phase<epi::EpiUp, pg8::StaticOrder, true, true>(Fg.lds, g, S, E, Fg.tid);
            TREG_SUB(99);
            {
                Frame Fs = fresh(F); const SEpiUp Es{(bf16*)(ws + WS_HMID), (const float*)(ws + WS_SSB)};
                for (int tl = Fs.bid; tl < 16 * 64; tl += Fs.G) sgemm_tile(Fs, (const bf16*)(ws + WS_XGB), DM, (const bf16*)(ws + WS_WUP + layer * SZ_WUP), DM, DM, MP + 32 * (tl & 15), 64 * (tl >> 4), Es);
            }
            TREG_SUB(33);
        }
        }
        GRID_BAR();
    TREG_MARK(7);
        for (int rp_ = 0; rp_ < PH_F; ++rp_) {
        {
            const Frame Fg = fresh(F); const int G = Fg.G, bid = Fg.bid;
            unsigned char* ws = KWS();
            pg8::Gemm g{(const bf16*)(ws + WS_HMID), (const bf16*)(ws + WS_WDN + layer * SZ_WDN), MP, DM, DFF, DFF, DFF, 31, 0};
            pg8::StaticOrder S; S.init(MP, DM, G, bid);
            epi::EpiRes E{(float*)(ws + WS_XR), (bf16*)(ws + WS_XGC), nullptr, nullptr, nullptr, (rp_ + 1 < PH_F) ? 3 : 0};
            pg8::gemm_phase<epi::EpiRes, pg8::StaticOrder, true, true>(Fg.lds, g, S, E, Fg.tid);
            TREG_SUB(99);
            if (rp_ + 1 == PH_F) {
                Frame Fs = fresh(F); const SEpiRes Es{(float*)(ws + WS_XR), (bf16*)(ws + WS_XGC), nullptr, nullptr, nullptr, 0};
                for (int tl = Fs.bid; tl < 256; tl += Fs.G) sgemm_tile(Fs, (const bf16*)(ws + WS_HMID), DFF, (const bf16*)(ws + WS_WDN + layer * SZ_WDN), DFF, DFF, MP + 32 * (tl & 15), 64 * (tl >> 4), Es);
            }
            TREG_SUB(34);
        }
        }
        GRID_BAR();
    TREG_MARK(8);
        for (int rp_ = 0; rp_ < PH_G1; ++rp_) {
        {
            const Frame Fg = fresh(F); const int G = Fg.G, bid = Fg.bid;
            unsigned char* ws = KWS();
            int kple = PLE; asm volatile("" : "+s"(kple));
            pg8::Gemm g{(const bf16*)(ws + WS_P16) + (size_t)layer * MROWS * PLE, (const bf16*)(ws + WS_WPL + layer * SZ_WPL), MP, DM, kple, PLE, PLE, 31, 0};
            pg8::StaticOrder S; S.init(MP, DM, G, bid);
            epi::EpiRes E{nullptr, nullptr, nullptr, nullptr, (float*)(ws + WS_TPLE), 1};
            pg8::gemm_phase<epi::EpiRes, pg8::StaticOrder, true, true>(Fg.lds, g, S, E, Fg.tid);
            TREG_SUB(99);
            {
                Frame Fs = fresh(F); const SEpiRes Es{nullptr, nullptr, nullptr, nullptr, (float*)(ws + WS_TPLE), 1};
                for (int tl = Fs.bid; tl < 256; tl += Fs.G) sgemm_tile(Fs, (const bf16*)(ws + WS_P16) + (size_t)layer * MROWS * PLE, PLE, (const bf16*)(ws + WS_WPL + layer * SZ_WPL), PLE, PLE, MP + 32 * (tl & 15), 64 * (tl >> 4), Es);
            }
            TREG_SUB(35);
        }
        }
        for (int rp_ = 0; rp_ < PH_G2; ++rp_) {
        {
            const Frame Fg = fresh(F); const int G = Fg.G, bid = Fg.bid;
            unsigned char* ws = KWS();
            const bool more = layer + 1 < NLAYER;
            pg8::Gemm g{(const bf16*)(ws + WS_XGC), (const bf16*)(ws + WS_WPG + layer * SZ_WPG), MP, DM, DM, DM, DM, 31, 0};
            pg8::StaticOrder S; S.init(MP, DM, G, bid);
            epi::EpiRes E{(float*)(ws + WS_XR), more ? (bf16*)(ws + WS_XGA) : nullptr, more ? KIN(10) + (layer + 1) * DM : nullptr, more ? (float*)(ws + WS_SSA) : nullptr, (float*)(ws + WS_TPLE), (rp_ + 1 < PH_G2) ? 3 : 2};
            pg8::gemm_phase<epi::EpiRes, pg8::StaticOrder, true, true>(Fg.lds, g, S, E, Fg.tid);
            TREG_SUB(99);
            if (rp_ + 1 == PH_G2) {
                Frame Fs = fresh(F); const SEpiRes Es{(float*)(ws + WS_XR), more ? (bf16*)(ws + WS_XGA) : nullptr, more ? KIN(10) + (layer + 1) * DM : nullptr, more ? (float*)(ws + WS_SSA) : nullptr, (float*)(ws + WS_TPLE), 2};
                for (int tl = Fs.bid; tl < 256; tl += Fs.G) sgemm_tile(Fs, (const bf16*)(ws + WS_XGC), DM, (const bf16*)(ws + WS_WPG + layer * SZ_WPG), DM, DM, MP + 32 * (tl & 15), 64 * (tl >> 4), Es);
            }
            TREG_SUB(36);
        }
        }
        GRID_BAR();
    TREG_MARK(9);
    }
    for (int xb_ = 0; xb_ < PH_XBAR; ++xb_) GRID_BAR();
    { Frame Fp = fresh(F); for (int r = Fp.bid * NWAVES + Fp.wave; r < MROWS; r += Fp.G * NWAVES) final_row(Fp, r); }
    TREG_MARK(10);
#if PH_TREG >= 0
#if defined(PH_GPT) && PH_GPT >= 0
    tacc_ += *(volatile LAS unsigned long long*)(F.lds + LDSCTL_OFF + 448);
#endif
#if defined(PH_NPT) && PH_NPT >= 0
    tacc_ += *(volatile LAS unsigned long long*)(F.lds + LDSCTL_OFF + 464);
#endif
      { const unsigned long long tend_ = __builtin_amdgcn_s_memrealtime() + tacc_; while (__builtin_amdgcn_s_memrealtime() < tend_) __builtin_amdgcn_s_sleep(8); }
#endif
}

extern "C" void kernel_launch(void* const* d_in, const int* in_sizes, int n_in, void* d_out, int out_size, void* d_ws, size_t ws_size, hipStream_t stream) {
    static int grid = 0;
    if (grid == 0) {
        if (n_in != 27 || ws_size < WS_END) { fprintf(stderr, "kernel_launch: unexpected shapes (n_in %d out %d ws %zu, need %zu)\n", n_in, out_size, ws_size, (size_t)WS_END); grid = -1; return; }
        int dev = 0, cus = 0;
        if (hipGetDevice(&dev) != hipSuccess || hipDeviceGetAttribute(&cus, hipDeviceAttributeMultiprocessorCount, dev) != hipSuccess) { grid = -1; return; }
        if (hipFuncSetAttribute((const void*)mk_fwd, hipFuncAttributeMaxDynamicSharedMemorySize, LDS_BYTES) != hipSuccess) { fprintf(stderr, "kernel_launch: hipFuncSetAttribute failed\n"); grid = -1; return; }
        int per_cu = 0;
        if (hipOccupancyMaxActiveBlocksPerMultiprocessor(&per_cu, (const void*)mk_fwd, NTHREADS, LDS_BYTES) != hipSuccess || per_cu < 1) fprintf(stderr, "kernel_launch: occupancy query reports %d\n", per_cu);
        (void)hipGetLastError();
        grid = cus;
    }
    if (grid < 0) return;
    if (hipMemsetAsync((char*)d_ws + WS_CTL, 0, CTL_ZERO_BYTES, stream) != hipSuccess) return;
    Args a{};
    for (int i = 0; i < 27; ++i) a.in[i] = d_in[i];
    a.out = (float*)d_out; a.ws = (unsigned char*)d_ws;
    hipLaunchKernelGGL(mk_fwd, dim3(grid), dim3(NTHREADS), LDS_BYTES, stream, a);
}
```

```cpp
#include <hip/hip_runtime.h>
#include <cstdio>
#include <cstdint>
namespace pg8 {
#define PG8_LAS __attribute__((address_space(3)))
typedef unsigned short bf16_t;
typedef short bf16x8 __attribute__((ext_vector_type(8)));
typedef float f32x4 __attribute__((ext_vector_type(4)));
typedef unsigned u32x4 __attribute__((ext_vector_type(4)));
constexpr int BM = 256, BK = 64, HALF = 128, HTB = HALF * BK * 2  , STAGE_BYTES = 8 * HTB, NXCD = 8, WGM = 8;

__host__ __device__ __forceinline__ int lds_byte(int r, int c) { const int st = (r >> 4) * 2 + (c >> 5), rr = r & 15, cc = c & 31, ob = rr * 64 + cc * 2; return st * 1024 + (ob ^ (((ob >> 9) & 1) << 5)); }
__host__ __device__ __forceinline__ void stage_rc(int b, int& R, int& C) { const int st = b / 1024, sb = b % 1024, swz = sb ^ (((sb >> 9) & 1) << 5); R = (st >> 1) * 16 + swz / 64; C = (st & 1) * 32 + (swz % 64) / 2; }
__host__ __device__ __forceinline__ int perm32(int rho) { const int n = rho >> 4, i = rho & 15; return 8 * (i >> 2) + 4 * n + (i & 3); }

struct Unit { int pm, pn; };
struct Gemm { const bf16_t* A; const bf16_t* Bt; int M, N, K; int lda, ldb; int a_shift, a_off; };

struct StaticOrder {
    int nM, nN, nwg, G, c;
    __host__ __device__ void init(int M, int N, int G_, int c_) { nM = M / BM; nN = N / BM; nwg = nM * nN; G = G_; c = c_; }
    __host__ __device__ bool next(int i, Unit& u) const {
        const long L = (long)i * G + c; if (L >= nwg) return false;
        int wgid = (int)L; { const int q = nwg / NXCD, r = nwg % NXCD, xcd = wgid % NXCD, off = wgid / NXCD; wgid = (xcd < r ? xcd * (q + 1) : r * (q + 1) + (xcd - r) * q) + off; }
        const int nig = WGM * nN, gid = wgid / nig, fm = gid * WGM, gsz = (nM - fm) < WGM ? (nM - fm) : WGM;
        u.pm = fm + ((wgid % nig) % gsz); u.pn = (wgid % nig) / gsz; return true;
    }
    __device__ __forceinline__ void a_ready(const Unit&) const {}
    __device__ __forceinline__ void done(const Unit&) const {}
};

__device__ __forceinline__ unsigned cvt_pk_bf16(float lo, float hi) { unsigned r; asm volatile("v_cvt_pk_bf16_f32 %0, %1, %2" : "=v"(r) : "v"(lo), "v"(hi)); return r; }
typedef float f32x2 __attribute__((ext_vector_type(2)));
template <class Epi, class Sched, bool ALIGN_EPI = false, bool SP2 = false>
__device__ __forceinline__ void gemm_phase(PG8_LAS unsigned char* lds, const Gemm g, const Sched& S, const Epi& E, const int tid) {
    const int wid = __builtin_amdgcn_readfirstlane(tid >> 6), lane = tid & 63, wr = wid >> 2, wc = wid & 3, fr = lane & 15, fq = lane >> 4;
    const int K = g.K, nt = K / BK;
    unsigned voffA[2], voffB[2];
#pragma unroll
    for (int i = 0; i < 2; ++i) { int R, C; stage_rc(tid * 16 + i * 8192, R, C); const int Rb = Epi::PERM ? ((R & ~31) + perm32(R & 31)) : R;
        voffA[i] = (unsigned)(R * g.lda + C) * 2u; voffB[i] = (unsigned)(Rb * g.ldb + C) * 2u; }
    const size_t kstep = (size_t)(BK * 2);
    const size_t hstepA = (size_t)HALF * g.lda * 2, hstepB = (size_t)HALF * g.ldb * 2;
    const size_t tstepA = 2 * hstepA, tstepB = 2 * hstepB;
    const unsigned ldsw = (unsigned)wid * 1024u;
    const int aoff = lds_byte(wr * 64 + fr, fq * 8), boff = lds_byte(wc * 32 + fr, fq * 8);
#define PG8_SA(b, h) (((b) * 2 + (h)) * HTB)
#define PG8_SB(b, h) ((4 + (b) * 2 + (h)) * HTB)
#define PG8_STAGE(bufoff, gbase, voff) do { _Pragma("unroll") for (int _i = 0; _i < 2; ++_i) \
        __builtin_amdgcn_global_load_lds((const unsigned*)((const char*)(gbase) + (voff)[_i]), (PG8_LAS unsigned*)(lds + (bufoff) + ldsw + _i * 8192), 16, 0, 0); } while (0)
#define PG8_LDA(dst, b, h) do { _Pragma("unroll") for (int m = 0; m < 4; ++m) _Pragma("unroll") for (int k = 0; k < 2; ++k) dst[m][k] = *(const PG8_LAS bf16x8*)(lds + PG8_SA(b, h) + aoff + m * 2048 + k * 1024); } while (0)
#define PG8_LDB(dst, b, h) do { _Pragma("unroll") for (int n = 0; n < 2; ++n) _Pragma("unroll") for (int k = 0; k < 2; ++k) dst[n][k] = *(const PG8_LAS bf16x8*)(lds + PG8_SB(b, h) + boff + n * 2048 + k * 1024); } while (0)
#define PG8_MMA(ai, bj, At, Bt) do { __builtin_amdgcn_s_setprio(1); _Pragma("unroll") for (int m = 0; m < 4; ++m) _Pragma("unroll") for (int n = 0; n < 2; ++n) _Pragma("unroll") for (int k = 0; k < 2; ++k) \
        acc[ai][bj][m][n] = __builtin_amdgcn_mfma_f32_16x16x32_bf16(Bt[n][k], At[m][k], acc[ai][bj][m][n], 0, 0, 0); __builtin_amdgcn_s_setprio(0); } while (0)
#define PG8_WAIT_V(n) asm volatile("s_waitcnt vmcnt(" #n ")" ::: "memory")
#define PG8_WAIT_L(n) asm volatile("s_waitcnt lgkmcnt(" #n ")" ::: "memory")
#define PG8_BAR __builtin_amdgcn_s_barrier()
#define PG8_SCHED __builtin_amdgcn_sched_barrier(0)
    Unit cur, nxt; int ui = 0;
    if (!S.next(0, cur)) return;
    f32x4 acc[2][2][4][2];
#pragma unroll
    for (int a = 0; a < 2; ++a)
#pragma unroll
        for (int b = 0; b < 2; ++b)
#pragma unroll
            for (int m = 0; m < 4; ++m)
#pragma unroll
                for (int n = 0; n < 2; ++n) acc[a][b][m][n] = (f32x4){0.f, 0.f, 0.f, 0.f};
    bf16x8 At[4][2], B0[2][2], B1[2][2];
    const char* cA = (const char*)g.A + (size_t)cur.pm * tstepA + (size_t)(cur.pn >> g.a_shift) * (size_t)g.a_off; const char* cB = (const char*)g.Bt + (size_t)cur.pn * tstepB;
    S.a_ready(cur);
    if constexpr (SP2) {
        PG8_STAGE(PG8_SB(0, 0), cB, voffB); PG8_STAGE(PG8_SB(0, 1), cB + hstepB, voffB); PG8_STAGE(PG8_SA(0, 0), cA, voffA); PG8_STAGE(PG8_SA(0, 1), cA + hstepA, voffA);
        if (wr == 1) PG8_BAR;
        PG8_WAIT_V(2); PG8_BAR;
        PG8_STAGE(PG8_SB(1, 0), cB + kstep, voffB); PG8_STAGE(PG8_SA(1, 0), cA + kstep, voffA); PG8_STAGE(PG8_SB(1, 1), cB + hstepB + kstep, voffB);
        PG8_WAIT_V(6); PG8_BAR;
    } else {
        PG8_STAGE(PG8_SB(0, 0), cB, voffB); PG8_STAGE(PG8_SA(0, 0), cA, voffA); PG8_STAGE(PG8_SB(0, 1), cB + hstepB, voffB); PG8_STAGE(PG8_SA(0, 1), cA + hstepA, voffA);
        if (wr == 1) PG8_BAR;
        PG8_WAIT_V(4); PG8_BAR;
        PG8_STAGE(PG8_SB(1, 0), cB + kstep, voffB); PG8_STAGE(PG8_SA(1, 0), cA + kstep, voffA); PG8_STAGE(PG8_SB(1, 1), cB + hstepB + kstep, voffB);
        PG8_WAIT_V(6); PG8_BAR;
    }
    for (;;) {
        const bool has_next = S.next(ui + 1, nxt);
        const char* nA = has_next ? (const char*)g.A + (size_t)nxt.pm * tstepA + (size_t)(nxt.pn >> g.a_shift) * (size_t)g.a_off : cA; const char* nB = has_next ? (const char*)g.Bt + (size_t)nxt.pn * tstepB : cB;
        for (int t = 0; t < nt; t += 2) {
            const bool last = (t == nt - 2);
            const char* a1 = cA + (size_t)(t + 1) * kstep;
            const char* a2 = last ? nA : cA + (size_t)(t + 2) * kstep; const char* b2 = last ? nB : cB + (size_t)(t + 2) * kstep;
            const char* a3 = a2 + kstep; const char* b3 = b2 + kstep;
            if (last && has_next) S.a_ready(nxt);
            if constexpr (SP2) {
            PG8_LDB(B0, 0, 0); PG8_LDB(B1, 0, 1); PG8_SCHED; PG8_LDA(At, 0, 0); PG8_STAGE(PG8_SA(1, 1), a1 + hstepA, voffA);
            PG8_WAIT_V(8); PG8_WAIT_L(0); PG8_BAR; PG8_MMA(0, 0, At, B0); PG8_MMA(0, 1, At, B1); PG8_BAR; PG8_SCHED;
            PG8_LDA(At, 0, 1); PG8_STAGE(PG8_SB(0, 0), b2, voffB); PG8_STAGE(PG8_SB(0, 1), b2 + hstepB, voffB); PG8_STAGE(PG8_SA(0, 0), a2, voffA);
            PG8_WAIT_V(8); PG8_WAIT_L(0); PG8_BAR; PG8_MMA(1, 0, At, B0); PG8_MMA(1, 1, At, B1); PG8_BAR; PG8_SCHED;
            PG8_LDB(B0, 1, 0); PG8_LDB(B1, 1, 1); PG8_SCHED; PG8_LDA(At, 1, 0); PG8_STAGE(PG8_SA(0, 1), a2 + hstepA, voffA);
            PG8_WAIT_V(8); PG8_WAIT_L(0); PG8_BAR; PG8_MMA(0, 0, At, B0); PG8_MMA(0, 1, At, B1); PG8_BAR; PG8_SCHED;
            PG8_LDA(At, 1, 1); PG8_STAGE(PG8_SB(1, 0), b3, voffB); PG8_STAGE(PG8_SB(1, 1), b3 + hstepB, voffB); PG8_STAGE(PG8_SA(1, 0), a3, voffA);
            PG8_WAIT_V(8); PG8_WAIT_L(0); PG8_BAR; PG8_MMA(1, 0, At, B0); PG8_MMA(1, 1, At, B1); PG8_BAR; PG8_SCHED;
            } else {
            PG8_LDB(B0, 0, 0); PG8_SCHED; PG8_LDA(At, 0, 0); PG8_STAGE(PG8_SA(1, 1), a1 + hstepA, voffA);
            PG8_WAIT_L(8); PG8_BAR; PG8_WAIT_L(0); PG8_MMA(0, 0, At, B0); PG8_BAR; PG8_SCHED;
            PG8_LDB(B1, 0, 1); PG8_STAGE(PG8_SB(0, 0), b2, voffB);
            PG8_BAR; PG8_WAIT_L(0); PG8_MMA(0, 1, At, B1); PG8_BAR;
            PG8_LDA(At, 0, 1); PG8_STAGE(PG8_SA(0, 0), a2, voffA);
            PG8_BAR; PG8_WAIT_L(0); PG8_MMA(1, 0, At, B0); PG8_BAR; PG8_SCHED;
            PG8_STAGE(PG8_SB(0, 1), b2 + hstepB, voffB);
            PG8_WAIT_V(6); PG8_BAR; PG8_MMA(1, 1, At, B1); PG8_BAR;
            PG8_LDB(B0, 1, 0); PG8_SCHED; PG8_LDA(At, 1, 0); PG8_STAGE(PG8_SA(0, 1), a2 + hstepA, voffA);
            PG8_WAIT_L(8); PG8_BAR; PG8_WAIT_L(0); PG8_MMA(0, 0, At, B0); PG8_BAR; PG8_SCHED;
            PG8_LDB(B1, 1, 1); PG8_STAGE(PG8_SB(1, 0), b3, voffB);
            PG8_BAR; PG8_WAIT_L(0); PG8_MMA(0, 1, At, B1); PG8_BAR;
            PG8_LDA(At, 1, 1); PG8_STAGE(PG8_SA(1, 0), a3, voffA);
            PG8_BAR; PG8_WAIT_L(0); PG8_MMA(1, 0, At, B0); PG8_BAR; PG8_SCHED;
            PG8_STAGE(PG8_SB(1, 1), b3 + hstepB, voffB);
            PG8_WAIT_V(6); PG8_BAR; PG8_MMA(1, 1, At, B1); PG8_BAR;
            }
        }
        if constexpr (ALIGN_EPI) { if (wr == 0) PG8_BAR; }
        if constexpr (!Epi::AFTER_DRAIN) { E(acc, cur, wr, wc, fr, fq); S.done(cur); }
        if (!has_next) break;
#pragma unroll
        for (int a = 0; a < 2; ++a)
#pragma unroll
            for (int b = 0; b < 2; ++b)
#pragma unroll
                for (int m = 0; m < 4; ++m)
#pragma unroll
                    for (int n = 0; n < 2; ++n) acc[a][b][m][n] = (f32x4){0.f, 0.f, 0.f, 0.f};
        cur = nxt; cA = nA; cB = nB; ++ui;
        if constexpr (ALIGN_EPI) { if (wr == 1) PG8_BAR; }
    }
    PG8_WAIT_V(0);
    if constexpr (!ALIGN_EPI) { if (wr == 0) PG8_BAR; }
    PG8_BAR;
    if constexpr (Epi::AFTER_DRAIN) { E.fused(acc, cur, wr, wc, fr, fq, lds, wid, lane); S.done(cur); }
#undef PG8_SA
#undef PG8_SB
#undef PG8_STAGE
#undef PG8_LDA
#undef PG8_LDB
#undef PG8_MMA
#undef PG8_WAIT_V
#undef PG8_WAIT_L
#undef PG8_BAR
#undef PG8_SCHED
}
}
#define DI __device__ __forceinline__
#define GAS __attribute__((address_space(1)))
#define LAS __attribute__((address_space(3)))
typedef unsigned short bf16;
typedef unsigned v4u __attribute__((ext_vector_type(4)));
typedef unsigned v2u __attribute__((ext_vector_type(2)));
typedef float f32x4 __attribute__((ext_vector_type(4)));
typedef float f32x2 __attribute__((ext_vector_type(2)));
typedef short bf16x8 __attribute__((ext_vector_type(8)));
typedef short s16x4 __attribute__((ext_vector_type(4)));
typedef GAS unsigned gu32;

constexpr int DM = 1024, TP = 8192, MP = 16384, MS = 512, MROWS = 16896, LDZ = 8704, DFF = 4096, PLE = 256, NLAYER = 2;
constexpr int ZC_Q = 0, ZC_KC = 512, ZC_VC = 640, ZC_KS = 768, ZC_VS = 896, ZC_KW = 1024, ZC_VW = 1152, ZC_GQKV = 1280, ZC_GZ = 2816, ZC_RQKV = 3328, ZC_RG = 4864, ZC_MG = 5376, ZC_SM = 8448;
constexpr float EPS = 1e-6f;
constexpr size_t O_YP = 0, O_YS = O_YP + (size_t)MP * DM, O_KVP = O_YS + (size_t)MS * DM, O_KVS = O_KVP + (size_t)2 * MP * 512, O_WINP = O_KVS + (size_t)2 * MS * 512,
                 O_WINS = O_WINP + (size_t)2 * 2 * 512 * 256, O_CVP = O_WINS + (size_t)2 * 128 * 512 * 256, O_CVS = O_CVP + (size_t)2 * 2 * 3 * 1536, O_GSP = O_CVS + (size_t)2 * 128 * 3 * 1536,
                 O_GSS = O_GSP + (size_t)2 * 2 * 4 * 16384, O_RSP = O_GSS + (size_t)2 * 128 * 4 * 16384, O_RSS = O_RSP + (size_t)2 * 2 * 4 * 16384, O_END = O_RSS + (size_t)2 * 128 * 4 * 16384;

DI float bf2f(unsigned short b) { return __uint_as_float((unsigned)b << 16); }
DI unsigned f2bf(float f) { unsigned u = __float_as_uint(f); return (u + 0x7fffu + ((u >> 16) & 1u)) >> 16; }
typedef __bf16 bf16x2_t __attribute__((ext_vector_type(2)));
DI unsigned pk2(float lo, float hi) { const f32x2 v = {lo, hi}; return __builtin_bit_cast(unsigned, __builtin_convertvector(v, bf16x2_t)); }
DI float lo_bf(unsigned w) { return __uint_as_float(w << 16); }
DI float hi_bf(unsigned w) { return __uint_as_float(w & 0xffff0000u); }
DI float sigmoidf_(float x) { return 1.f / (1.f + __expf(-x)); }
DI float siluf_(float x) { return x / (1.f + __expf(-x)); }
DI v4u pack8(const f32x4 a, const f32x4 b) { v4u w; w.x = pk2(a[0], a[1]); w.y = pk2(a[2], a[3]); w.z = pk2(b[0], b[1]); w.w = pk2(b[2], b[3]); return w; }
DI void unpack8(const v4u w, f32x4& a, f32x4& b) { a[0] = lo_bf(w.x); a[1] = hi_bf(w.x); a[2] = lo_bf(w.y); a[3] = hi_bf(w.y); b[0] = lo_bf(w.z); b[1] = hi_bf(w.z); b[2] = lo_bf(w.w); b[3] = hi_bf(w.w); }

template <int M> DI int shxi(int v, int lane) {
    if constexpr (M < 32) return __builtin_amdgcn_ds_swizzle(v, (M << 10) | 0x1f);
    else return __builtin_amdgcn_ds_bpermute((lane ^ 32) << 2, v);
}
template <int M> DI float shx(float v, int lane) { return __int_as_float(shxi<M>(__float_as_int(v), lane)); }
DI float wave_sum(float v, int lane) { v += shx<1>(v, lane); v += shx<2>(v, lane); v += shx<4>(v, lane); v += shx<8>(v, lane); v += shx<16>(v, lane); v += shx<32>(v, lane); return v; }

namespace epi {
using pg8::Unit; using pg8::bf16_t;
DI float row_rstd(const float* SS, int row, int fq, int lane) {
    const f32x4 p = *(const f32x4*)(SS + (size_t)row * 16 + 4 * fq);
    float s = (p[0] + p[1]) + (p[2] + p[3]); s += shx<16>(s, lane); s += shx<32>(s, lane);
    return rsqrtf(s * (1.f / DM) + EPS);
}
struct EpiA {
    static constexpr bool PERM = true, AFTER_DRAIN = false;
    bf16* Z; float* ZS; const float* SS; float* out; int layer;
    DI void operator()(const f32x4 (&acc)[2][2][4][2], const Unit& u, int wr, int wc, int fr, int fq) const {
        asm volatile("" : "+v"(fr), "+v"(fq), "+s"(wr), "+s"(wc));
        const int pn = u.pn;
        float rs[2][4];
#pragma unroll
        for (int ai = 0; ai < 2; ++ai)
#pragma unroll
            for (int m = 0; m < 4; ++m) rs[ai][m] = row_rstd(SS, u.pm * 256 + ai * 128 + wr * 64 + m * 16 + fr, fq, fr + 16 * fq);
#pragma unroll
        for (int ai = 0; ai < 2; ++ai)
#pragma unroll
            for (int m = 0; m < 4; ++m) {
                const int row = u.pm * 256 + ai * 128 + wr * 64 + m * 16 + fr;
                const float rstd = rs[ai][m];
#pragma unroll
                for (int bj = 0; bj < 2; ++bj) {
                    const int col = pn * 256 + bj * 128 + wc * 32 + 8 * fq;
                    const f32x4 v0 = acc[ai][bj][m][0] * rstd, v1 = acc[ai][bj][m][1] * rstd;
                    *(v4u*)(Z + (size_t)row * LDZ + col) = pack8(v0, v1);
                    float* dst = nullptr;
                    if (pn == 2 || pn == 3) {
                        dst = (row < MP) ? out + O_KVP + ((size_t)layer * MP + row) * 512 + (col - 512) : out + O_KVS + ((size_t)layer * MS + (row - MP)) * 512 + (col - 512);
                    } else if (pn == 4) {
                        const int c2 = col - 1024;
                        if (row < MP) { const int t = row & (TP - 1), b = row >> 13; if (t >= TP - 512) dst = out + O_WINP + ((size_t)(layer * 2 + b) * 512 + (t - (TP - 512))) * 256 + c2; }
                        else { const int r2 = row - MP, s = r2 >> 2, j = r2 & 3; dst = out + O_WINS + ((size_t)(layer * 128 + s) * 512 + 508 + j) * 256 + c2; }
                    } else if (pn >= 5 && pn < 11) {
                        const int c2 = col - 1280;
                        if (row < MP) { const int t = row & (TP - 1), b = row >> 13; if (t >= TP - 3) dst = out + O_CVP + ((size_t)(layer * 2 + b) * 3 + (t - (TP - 3))) * 1536 + c2; }
                        else { const int r2 = row - MP, s = r2 >> 2, j = r2 & 3; if (j >= 1) dst = out + O_CVS + ((size_t)(layer * 128 + s) * 3 + (j - 1)) * 1536 + c2; }
                    } else if (pn == 33) {
                        if (bj == 0 && wc == 0) dst = ZS + (size_t)row * 32 + 8 * fq;
                    }
                    if (dst) { *(f32x4*)dst = v0; *(f32x4*)(dst + 4) = v1; }
                }
                asm volatile("" ::: "memory");
            }
    }
};
struct EpiC {
    static constexpr bool PERM = true, AFTER_DRAIN = false;
    const bf16* Z; bf16* G;
    DI void operator()(const f32x4 (&acc)[2][2][4][2], const Unit& u, int wr, int wc, int fr, int fq) const {
        asm volatile("" : "+v"(fr), "+v"(fq), "+s"(wr), "+s"(wc));
#pragma unroll
        for (int ai = 0; ai < 2; ++ai) {
            v4u gw[4][2];
#pragma unroll
            for (int m = 0; m < 4; ++m)
#pragma unroll
                for (int bj = 0; bj < 2; ++bj) gw[m][bj] = *(const v4u*)(Z + (size_t)(u.pm * 256 + ai * 128 + wr * 64 + m * 16 + fr) * LDZ + ZC_MG + u.pn * 256 + bj * 128 + wc * 32 + 8 * fq);
#pragma unroll
            for (int m = 0; m < 4; ++m) {
                const int row = u.pm * 256 + ai * 128 + wr * 64 + m * 16 + fr;
#pragma unroll
                for (int bj = 0; bj < 2; ++bj) {
                    const int col = u.pn * 256 + bj * 128 + wc * 32 + 8 * fq;
                    f32x4 g0, g1; unpack8(gw[m][bj], g0, g1);
                    f32x4 v0 = acc[ai][bj][m][0], v1 = acc[ai][bj][m][1];
#pragma unroll
                    for (int e = 0; e < 4; ++e) { v0[e] *= sigmoidf_(g0[e]); v1[e] *= sigmoidf_(g1[e]); }
                    *(v4u*)(G + (size_t)row * 3072 + col) = pack8(v0, v1);
                }
            }
            asm volatile("" ::: "memory");
        }
    }
};
struct EpiRes {
    static constexpr bool PERM = true, AFTER_DRAIN = false;
    float* XR; bf16* XG; const float* gvec; float* SS; float* T; int mode;
    DI void operator()(const f32x4 (&acc)[2][2][4][2], const Unit& u, int wr, int wc, int fr, int fq) const {
        asm volatile("" : "+v"(fr), "+v"(fq), "+s"(wr), "+s"(wc));
        if (mode == 3) return;
        if (mode == 1) {
#pragma unroll
            for (int ai = 0; ai < 2; ++ai)
#pragma unroll
                for (int m = 0; m < 4; ++m)
#pragma unroll
                    for (int bj = 0; bj < 2; ++bj) { const size_t o = (size_t)(u.pm * 256 + ai * 128 + wr * 64 + m * 16 + fr) * DM + u.pn * 256 + bj * 128 + wc * 32 + 8 * fq;
                        *(f32x4*)(T + o) = acc[ai][bj][m][0]; *(f32x4*)(T + o + 4) = acc[ai][bj][m][1]; }
            return;
        }
#pragma unroll
        for (int ai = 0; ai < 2; ++ai)
#pragma unroll
            for (int mp = 0; mp < 2; ++mp) {
                f32x4 xr[2][2][2], tt[2][2][2];
#pragma unroll
                for (int mm = 0; mm < 2; ++mm)
#pragma unroll
                    for (int bj = 0; bj < 2; ++bj) { const size_t o = (size_t)(u.pm * 256 + ai * 128 + wr * 64 + (2 * mp + mm) * 16 + fr) * DM + u.pn * 256 + bj * 128 + wc * 32 + 8 * fq;
                        xr[mm][bj][0] = *(const f32x4*)(XR + o); xr[mm][bj][1] = *(const f32x4*)(XR + o + 4);
                        if (mode == 2) { tt[mm][bj][0] = *(const f32x4*)(T + o); tt[mm][bj][1] = *(const f32x4*)(T + o + 4); } }
#pragma unroll
                for (int mm = 0; mm < 2; ++mm) {
                    const int m = 2 * mp + mm;
                    const int row = u.pm * 256 + ai * 128 + wr * 64 + m * 16 + fr;
                    float ssq = 0.f;
#pragma unroll
                    for (int bj = 0; bj < 2; ++bj) {
                        const int col = u.pn * 256 + bj * 128 + wc * 32 + 8 * fq;
                        const size_t o = (size_t)row * DM + col;
                        f32x4 a0 = acc[ai][bj][m][0], a1 = acc[ai][bj][m][1];
                        f32x4 x0 = xr[mm][bj][0], x1 = xr[mm][bj][1];
                        if (mode == 2) {
#pragma unroll
                            for (int e = 0; e < 4; ++e) { a0[e] = tt[mm][bj][0][e] * sigmoidf_(a0[e]); a1[e] = tt[mm][bj][1][e] * sigmoidf_(a1[e]); } }
                        x0 += a0; x1 += a1;
                        *(f32x4*)(XR + o) = x0; *(f32x4*)(XR + o + 4) = x1;
                        ssq += (x0[0] * x0[0] + x0[1] * x0[1]) + (x0[2] * x0[2] + x0[3] * x0[3]) + (x1[0] * x1[0] + x1[1] * x1[1]) + (x1[2] * x1[2] + x1[3] * x1[3]);
                        if (XG) { if (gvec) { const f32x4 g0 = *(const f32x4*)(gvec + col), g1 = *(const f32x4*)(gvec + col + 4); x0 *= g0; x1 *= g1; }
                            *(v4u*)(XG + o) = pack8(x0, x1); }
                    }
                    if (SS) { ssq += shx<16>(ssq, fr + 16 * fq); ssq += shx<32>(ssq, fr + 16 * fq); if (fq == 0) SS[(size_t)row * 16 + u.pn * 4 + wc] = ssq; }
                }
                asm volatile("" ::: "memory");
            }
    }
};
struct EpiUp {
    static constexpr bool PERM = true, AFTER_DRAIN = false;
    bf16* H; const float* SS;
    DI void operator()(const f32x4 (&acc)[2][2][4][2], const Unit& u, int wr, int wc, int fr, int fq) const {
        asm volatile("" : "+v"(fr), "+v"(fq), "+s"(wr), "+s"(wc));
        float rs[2][4];
#pragma unroll
        for (int ai = 0; ai < 2; ++ai)
#pragma unroll
            for (int m = 0; m < 4; ++m) rs[ai][m] = row_rstd(SS, u.pm * 256 + ai * 128 + wr * 64 + m * 16 + fr, fq, fr + 16 * fq);
#pragma unroll
        for (int ai = 0; ai < 2; ++ai)
#pragma unroll
            for (int m = 0; m < 4; ++m) {
                const int row = u.pm * 256 + ai * 128 + wr * 64 + m * 16 + fr;
                const float rstd = rs[ai][m];
#pragma unroll
                for (int bj = 0; bj < 2; ++bj) {
                    const int col = u.pn * 256 + bj * 128 + wc * 32 + 8 * fq;
                    f32x4 v0 = acc[ai][bj][m][0] * rstd, v1 = acc[ai][bj][m][1] * rstd;
#pragma unroll
                    for (int e = 0; e < 4; ++e) { const float a = fmaxf(v0[e], 0.f), b = fmaxf(v1[e], 0.f); v0[e] = a * a; v1[e] = b * b; }
                    *(v4u*)(H + (size_t)row * DFF + col) = pack8(v0, v1);
                }
                asm volatile("" ::: "memory");
            }
    }
};
}
constexpr size_t al256(size_t x) { return (x + 255) & ~(size_t)255; }
constexpr size_t WS_CTL = 0, CTL_ZERO_BYTES = 1u << 20;
constexpr size_t SZ_WIN = (size_t)LDZ * DM * 2, SZ_WBR = (size_t)3072 * 512 * 2, SZ_WO3 = (size_t)DM * 3072 * 2, SZ_WUP = (size_t)DFF * DM * 2, SZ_WDN = (size_t)DM * DFF * 2,
                 SZ_WPL = (size_t)DM * PLE * 2, SZ_WPG = (size_t)DM * DM * 2, SZ_W1T = (size_t)2 * 64 * 2048 * 2, SZ_W2T = (size_t)2 * 64 * 64 * 2;
constexpr size_t WS_WIN = CTL_ZERO_BYTES, WS_WBR = WS_WIN + 2 * SZ_WIN, WS_WO3 = WS_WBR + 2 * SZ_WBR, WS_WUP = WS_WO3 + 2 * SZ_WO3, WS_WDN = WS_WUP + 2 * SZ_WUP,
                 WS_WPL = WS_WDN + 2 * SZ_WDN, WS_WPG = WS_WPL + 2 * SZ_WPL, WS_W1T = WS_WPG + 2 * SZ_WPG, WS_W2T = WS_W1T + 2 * SZ_W1T, WS_ROT = al256(WS_W2T + 2 * SZ_W2T);
constexpr size_t WS_P16 = WS_ROT + (size_t)TP * 64 * 8;
constexpr size_t WS_XR = WS_P16 + (size_t)2 * MROWS * PLE * 2;
constexpr size_t WS_XGA = WS_XR + (size_t)MROWS * DM * 4, WS_XGB = WS_XGA + (size_t)MROWS * DM * 2, WS_XGC = WS_XGB + (size_t)MROWS * DM * 2;
constexpr size_t WS_SSA = WS_XGC + (size_t)MROWS * DM * 2, WS_SSB = WS_SSA + (size_t)MROWS * 64;
constexpr size_t WS_Z = WS_SSB + (size_t)MROWS * 64, WS_ZS = WS_Z + (size_t)MROWS * LDZ * 2;
constexpr size_t WS_MIX = WS_ZS + (size_t)MROWS * 128, WS_GATED = WS_MIX + (size_t)MROWS * 1536 * 2, WS_HMID = WS_GATED + (size_t)MROWS * 3072 * 2;
constexpr size_t WS_TPLE = WS_HMID + (size_t)MROWS * DFF * 2;
constexpr size_t WS_KC = WS_TPLE + (size_t)MROWS * DM * 4;
constexpr size_t WS_KCS = WS_KC + (size_t)2 * 2 * 512 * 2 * 64 * 2;
constexpr int GREC = 73984;
constexpr size_t WS_GREC = WS_KCS + (size_t)2 * 128 * 128 * 2 * 64 * 2;
constexpr size_t WS_OGDN = WS_GREC + (size_t)1024 * GREC;
constexpr size_t WS_RKV = WS_OGDN + (size_t)MROWS * 512 * 4;
constexpr size_t WS_RST = WS_RKV + (size_t)512 * 16384 * 4;
constexpr size_t WS_QR = WS_RST + (size_t)512 * 16384 * 2, WS_KR = WS_QR + (size_t)MP * 512 * 2;
constexpr size_t WS_END = WS_KR + (size_t)MP * 512 * 2;
static_assert(WS_W1T % 256 == 0 && WS_Z % 256 == 0 && WS_GREC % 256 == 0 && WS_RKV % 256 == 0 && WS_KC % 256 == 0 && WS_XR % 256 == 0, "ws alignment");

constexpr int CW_TMO = 0, CW_BAR = 4096, CW_QUEUE = 8192;
constexpr int NWAVES = 8, NTHREADS = 512;
constexpr int RING_BYTES = 147456, LDSCTL_OFF = RING_BYTES, MISC_OFF = LDSCTL_OFF + 320, LDS_BYTES = RING_BYTES + 1024;

#define RLX_AGENT __ATOMIC_RELAXED, __HIP_MEMORY_SCOPE_AGENT
#define LDS_WAIT() asm volatile("s_waitcnt lgkmcnt(0)" ::: "memory")
#define VM_WAIT() asm volatile("s_waitcnt vmcnt(0)" ::: "memory")
#define XB_TMO      128
#define XB_XCNT(j)  (256  + 64 * (j))
#define XB_XSUB(j)  (1280 + 64 * (j))
#define XB_XGEN(j)  (2304 + 64 * (j))
#define XB_TOP      3328
#define XB_TOPGEN   3392
#define XCD_BAR_WORDS 3456
#define XB_SPIN_CAP (1u << 18)

__device__ __forceinline__ unsigned xb_ld(unsigned* p)              { return __hip_atomic_load(p, __ATOMIC_RELAXED, __HIP_MEMORY_SCOPE_AGENT); }
__device__ __forceinline__ unsigned xb_add(unsigned* p, unsigned v) { return __hip_atomic_fetch_add(p, v, __ATOMIC_RELAXED, __HIP_MEMORY_SCOPE_AGENT); }
__device__ __forceinline__ unsigned xb_xcc_id() { return (unsigned)__builtin_amdgcn_s_getreg((3 << 11) | 20) & 0xFu; }
#define XB_SPIN(cond, bar) do { unsigned _sp = 0; while (cond) { __builtin_amdgcn_s_sleep(1); \
    if ((++_sp & 255u) == 0u) { if (xb_ld(&(bar)[XB_TMO])) break; if (_sp > XB_SPIN_CAP) { atomicAdd(&(bar)[XB_TMO], 1u); break; } } } } while (0)

struct XcdBarrier {
    unsigned* bar; unsigned x;
    volatile LAS unsigned* st;
};

__device__ __forceinline__ XcdBarrier xcd_barrier_post(unsigned* bar, volatile LAS unsigned* st, bool t0) {
    XcdBarrier b; b.bar = bar; b.x = xb_xcc_id(); b.st = st;
    if (t0) (void)xb_add(&bar[XB_XCNT(b.x)], 1u);
    return b;
}
__device__ __forceinline__ void xcd_barrier_complete(unsigned* bar, unsigned x, unsigned& nloc, unsigned& nx) {
    const unsigned G = gridDim.x * gridDim.y * gridDim.z;
    unsigned sum, cnt, mine, sp = 0u;
    for (;;) {
        sum = 0u; cnt = 0u; mine = 0u;
#pragma unroll
        for (unsigned j = 0; j < 16; ++j) { const unsigned c = xb_ld(&bar[XB_XCNT(j)]); sum += c; cnt += (c > 0u) ? 1u : 0u; mine = (j == x) ? c : mine; }
        if (sum == G) break;
        __builtin_amdgcn_s_sleep(1);
        if ((++sp & 255u) == 0u) { if (xb_ld(&bar[XB_TMO])) break; if (sp > XB_SPIN_CAP) { atomicAdd(&bar[XB_TMO], 1u); break; } }
    }
    nloc = mine > 0u ? mine : 1u; nx = cnt > 0u ? cnt : 1u;
}

__device__ __forceinline__ void xcd_barrier(const XcdBarrier& b, bool t0) {
    asm volatile("s_waitcnt vmcnt(0)" ::: "memory");
    __syncthreads();
    if (t0) {
        unsigned* bar = b.bar;
        __builtin_amdgcn_s_waitcnt(0);
        unsigned nloc = b.st[0], nx = b.st[1];
        if (nloc == 0u) { xcd_barrier_complete(bar, b.x, nloc, nx); b.st[0] = nloc; b.st[1] = nx; }
        const unsigned old = xb_add(&bar[XB_XSUB(b.x)], 1u);
        const unsigned gen = old / nloc;
        if (old + 1u == (gen + 1u) * nloc) {
            __builtin_amdgcn_fence(__ATOMIC_RELEASE, "agent");
            asm volatile("s_waitcnt vmcnt(0)" ::: "memory");
            const unsigned og = xb_add(&bar[XB_TOP], 1u);
            const unsigned tg = og / nx;
            if (og + 1u == (tg + 1u) * nx) xb_add(&bar[XB_TOPGEN], 1u);
            else XB_SPIN(xb_ld(&bar[XB_TOPGEN]) == tg, bar);
            __builtin_amdgcn_fence(__ATOMIC_ACQUIRE, "agent");
            xb_add(&bar[XB_XGEN(b.x)], 1u);
            asm volatile("s_waitcnt vmcnt(0)" ::: "memory");
        } else {
            XB_SPIN(xb_ld(&bar[XB_XGEN(b.x)]) == gen, bar);
            __builtin_amdgcn_fence(__ATOMIC_ACQUIRE, "agent");
            asm volatile("s_waitcnt vmcnt(0)" ::: "memory");
        }
    }
    __syncthreads();
}
typedef const void* const __attribute__((address_space(4)))* kargp_t;
DI const float* KIN(int i) { const GAS float* p = (const GAS float*)((kargp_t)__builtin_amdgcn_kernarg_segment_ptr())[i]; asm volatile("" : "+s"(p)); return (const float*)p; }
DI float* KOUT() { GAS float* p = (GAS float*)((kargp_t)__builtin_amdgcn_kernarg_segment_ptr())[27]; asm volatile("" : "+s"(p)); return (float*)p; }
DI unsigned char* KWS() { GAS unsigned char* p = (GAS unsigned char*)((kargp_t)__builtin_amdgcn_kernarg_segment_ptr())[28]; asm volatile("" : "+s"(p)); return (unsigned char*)p; }
struct Frame {
    LAS unsigned char* lds;
    gu32* ctl;
    int tid, lane, wave, G, bid;
};
DI bf16x8 ld_frag_g(const bf16* p) { return __builtin_bit_cast(bf16x8, *(const v4u*)p); }
DI bf16x8 ld_frag_l(const LAS unsigned char* p) { return *(const LAS bf16x8*)p; }
DI f32x4 mfma16(bf16x8 a, bf16x8 b, f32x4 c) { return __builtin_amdgcn_mfma_f32_16x16x32_bf16(a, b, c, 0, 0, 0); }
DI bf16x8 pack_frag(const f32x4 a, const f32x4 b) { return __builtin_bit_cast(bf16x8, pack8(a, b)); }
DI int lane_id() { int l; asm volatile("v_mbcnt_lo_u32_b32 %0, -1, 0\n\tv_mbcnt_hi_u32_b32 %0, -1, %0" : "=v"(l)); return l; }
DI Frame fresh(const Frame& F0) {
    Frame F = F0; int w = F0.wave, g = F0.G, b = F0.bid; asm volatile("" : "+s"(w), "+s"(g), "+s"(b));
    int l = lane_id(); asm volatile("" : "+v"(l));
    unsigned lb = (unsigned)(uintptr_t)F0.lds; asm volatile("" : "+s"(lb)); F.lds = (LAS unsigned char*)(uintptr_t)lb;
    F.wave = w; F.lane = l; F.tid = w * 64 + l; F.G = g; F.bid = b; return F;
}
#define GRID_BAR() do { XcdBarrier b_; b_.bar = (unsigned*)((gu32*)(KWS() + WS_CTL) + CW_BAR); b_.x = xb_xcc_id(); b_.st = (volatile LAS unsigned*)(F.lds + MISC_OFF) + 8; \
    const Frame Fb_ = fresh(F); xcd_barrier(b_, Fb_.tid == 0); } while (0)
DI int win_colmap(int j) {
    if (j < 1280) return j; if (j < 2816) return j + 24; if (j < 8448) return j + 32; if (j < 8472) return j - 8448 + 1280; if (j < 8480) return j - 8472 + 2840; return -1;
}
DI void tr_item(const float* W, int ldw, int k0, int srccol, bf16* WT, size_t dst_row0, int ldt, int kdst0, int nrep, int krep, LAS float* scr, int lane) {
#pragma unroll 8
    for (int i = 0; i < 32; ++i) { const int kk = 2 * i + (lane >> 5); const float v_ = W[(size_t)(k0 + kk) * ldw + (srccol >= 0 ? srccol : 0)]; scr[kk * 33 + (lane & 31)] = (srccol >= 0) ? v_ : 0.f; }
    LDS_WAIT(); asm volatile("" ::: "memory");
    const int c = lane & 7;
#pragma unroll
    for (int j = 0; j < 4; ++j) { const int n = (lane >> 3) + 8 * j; const LAS float* s = scr + (8 * c) * 33 + n;
        v4u o; o.x = pk2(s[0 * 33], s[1 * 33]); o.y = pk2(s[2 * 33], s[3 * 33]); o.z = pk2(s[4 * 33], s[5 * 33]); o.w = pk2(s[6 * 33], s[7 * 33]);
        for (int r = 0; r < nrep; ++r) *(v4u*)(WT + (dst_row0 + n) * (size_t)ldt + kdst0 + r * krep + 8 * c) = o; }
    LDS_WAIT(); asm volatile("" ::: "memory");
}
DI void p0_prologue(Frame& F) {
    LAS float* scr = (LAS float*)(F.lds + F.wave * 16384);
    const int gw = F.bid * NWAVES + F.wave, NGW = F.G * NWAVES, lane = F.lane;
    unsigned char* ws = KWS();
    constexpr int I_A = 16 * 272, I_B = 3 * 8 * 32, I_C = 16 * 32, I_D = 16 * 128, I_E = 64 * 32, I_F = 4 * 32, I_G = 16 * 32, I_H = 2 * 32 * 2, I_I = 2 * 2;
    constexpr int I_L = I_A + I_B + I_C + I_D + I_E + I_F + I_G + I_H + I_I;
    for (int it = gw; it < 2 * I_L; it += NGW) {
        const int l = it / I_L; int r = it % I_L;
        if (r < I_A) { const int kb = r / 272, nb = r % 272; tr_item(KIN(11) + (size_t)l * DM * 8480, 8480, 64 * kb, win_colmap(32 * nb + (lane & 31)), (bf16*)(ws + WS_WIN + l * SZ_WIN), 32 * nb, DM, 64 * kb, 1, 0, scr, lane); continue; } r -= I_A;
        if (r < I_B) { const int b = r / 256, kb = (r % 256) / 32, nb = r % 32; tr_item(KIN(19) + (size_t)(l * 3 + b) * 512 * DM, DM, 64 * kb, 32 * nb + (lane & 31), (bf16*)(ws + WS_WBR + l * SZ_WBR), b * 1024 + 32 * nb, 512, 64 * kb, 1, 0, scr, lane); continue; } r -= I_B;
        if (r < I_C) { const int kb = r / 32, nb = r % 32; tr_item(KIN(20) + (size_t)l * DM * DM, DM, 64 * kb, 32 * nb + (lane & 31), (bf16*)(ws + WS_WO3 + l * SZ_WO3), 32 * nb, 3072, 64 * kb, 3, 1024, scr, lane); continue; } r -= I_C;
        if (r < I_D) { const int kb = r / 128, nb = r % 128; tr_item(KIN(22) + (size_t)l * DM * DFF, DFF, 64 * kb, 32 * nb + (lane & 31), (bf16*)(ws + WS_WUP + l * SZ_WUP), 32 * nb, DM, 64 * kb, 1, 0, scr, lane); continue; } r -= I_D;
        if (r < I_E) { const int kb = r / 32, nb = r % 32; tr_item(KIN(23) + (size_t)l * DFF * DM, DM, 64 * kb, 32 * nb + (lane & 31), (bf16*)(ws + WS_WDN + l * SZ_WDN), 32 * nb, DFF, 64 * kb, 1, 0, scr, lane); continue; } r -= I_E;
        if (r < I_F) { const int kb = r / 32, nb = r % 32; tr_item(KIN(24) + (size_t)l * PLE * DM, DM, 64 * kb, 32 * nb + (lane & 31), (bf16*)(ws + WS_WPL + l * SZ_WPL), 32 * nb, PLE, 64 * kb, 1, 0, scr, lane); continue; } r -= I_F;
        if (r < I_G) { const int kb = r / 32, nb = r % 32; tr_item(KIN(25) + (size_t)l * DM * DM, DM, 64 * kb, 32 * nb + (lane & 31), (bf16*)(ws + WS_WPG + l * SZ_WPG), 32 * nb, DM, 64 * kb, 1, 0, scr, lane); continue; } r -= I_G;
        if (r < I_H) { const int kv = r / 64, kb = (r % 64) / 2, nb = r % 2; tr_item(KIN(13) + (size_t)(l * 2 + kv) * 2048 * 64, 64, 64 * kb, 32 * nb + (lane & 31), (bf16*)(ws + WS_W1T + l * SZ_W1T) + (size_t)kv * 64 * 2048, 32 * nb, 2048, 64 * kb, 1, 0, scr, lane); continue; } r -= I_H;
        { const int kv = r / 2, nb = r % 2; tr_item(KIN(14) + (size_t)(l * 2 + kv) * 64 * 64, 64, 0, 32 * nb + (lane & 31), (bf16*)(ws + WS_W2T + l * SZ_W2T) + (size_t)kv * 64 * 64, 32 * nb, 64, 0, 1, 0, scr, lane); }
    }
    float* XR = (float*)(ws + WS_XR); bf16* XGA = (bf16*)(ws + WS_XGA); float* SSA = (float*)(ws + WS_SSA); bf16* P16 = (bf16*)(ws + WS_P16);
    const float* g0 = KIN(10);
    for (int row = gw; row < MROWS; row += NGW) {
        const float* xs = (row < MP) ? KIN(0) + (size_t)row * DM : KIN(1) + (size_t)(row - MP) * DM;
        float ss = 0.f;
#pragma unroll
        for (int j = 0; j < 2; ++j) {
            const int c = j * 512 + lane * 8;
            f32x4 a = *(const f32x4*)(xs + c), b = *(const f32x4*)(xs + c + 4);
            *(f32x4*)(XR + (size_t)row * DM + c) = a; *(f32x4*)(XR + (size_t)row * DM + c + 4) = b;
            ss += (a[0] * a[0] + a[1] * a[1]) + (a[2] * a[2] + a[3] * a[3]) + (b[0] * b[0] + b[1] * b[1]) + (b[2] * b[2] + b[3] * b[3]);
            const f32x4 ga = *(const f32x4*)(g0 + c), gb = *(const f32x4*)(g0 + c + 4);
            *(v4u*)(XGA + (size_t)row * DM + c) = pack8(a * ga, b * gb);
        }
        ss = wave_sum(ss, lane);
        if (lane < 16) SSA[(size_t)row * 16 + lane] = (lane == 0) ? ss : 0.f;
#pragma unroll
        for (int l = 0; l < 2; ++l) {
            const float* ps = (row < MP) ? KIN(8) + ((size_t)l * MP + row) * PLE : KIN(9) + ((size_t)l * MS + (row - MP)) * PLE;
            const f32x4 a = *(const f32x4*)(ps + lane * 4);
            v2u o; o.x = pk2(a[0], a[1]); o.y = pk2(a[2], a[3]);
            *(v2u*)(P16 + ((size_t)l * MROWS + row) * PLE + lane * 4) = o;
        }
    }
    const int gt = F.bid * NTHREADS + F.tid, NGT = F.G * NTHREADS;
    f32x2* ROT = (f32x2*)(ws + WS_ROT);
    for (int e = gt; e < TP * 64; e += NGT) {
        const int pos = e >> 6, i = e & 63;
        const float x = (float)i * (1.0f / 63.0f);
        const float inv = exp2f(-x * 13.287712379549449f);
        const float ang = (float)pos * inv;
        const double rev = (double)ang * 0.15915494309189535;
        const float fr = (float)(rev - floor(rev));
        ROT[e] = (f32x2){__builtin_amdgcn_cosf(fr), __builtin_amdgcn_sinf(fr)};
    }
    {
        const float* src = KIN(3); float* dst = KOUT() + O_WINS;
        constexpr int NE = 2 * 128 * 508 * 64;
        for (int e0 = gt; e0 < NE; e0 += 8 * NGT) {
            f32x4 v[8];
#pragma unroll
            for (int u = 0; u < 8; ++u) { const int e = e0 + u * NGT; const int ec = e < NE ? e : NE - 1; const int ls = ec / (508 * 64), r = ec % (508 * 64);
                v[u] = *(const f32x4*)(src + (size_t)ls * 512 * 256 + 4 * 256 + (size_t)r * 4); }
#pragma unroll
            for (int u = 0; u < 8; ++u) { const int e = e0 + u * NGT; if (e < NE) { const int ls = e / (508 * 64), r = e % (508 * 64); *(f32x4*)(dst + (size_t)ls * 512 * 256 + (size_t)r * 4) = v[u]; } }
        }
    }
}
DI float gelu_tanh(float x) { const float u = 0.7978845608028654f * (x + 0.044715f * x * x * x); const float e = __expf(2.f * u); return 0.5f * x * (1.f + (1.f - 2.f / (e + 1.f))); }
DI bf16x8 mk_frag(v2u a, v2u b) { v4u w; w.x = a.x; w.y = a.y; w.z = b.x; w.w = b.y; return __builtin_bit_cast(bf16x8, w); }

template <bool sample> DI void compress_job_t(Frame& F, int layer, int job) {
    int lane = F.lane, wave = F.wave; asm volatile("" : "+v"(lane), "+s"(wave));
    const int tid = wave * 64 + lane, quad = lane >> 4, rl = lane & 15;
    unsigned char* ws = KWS();
    int kv, bs, g0, nbase;
    if (sample) { kv = job >> 7; bs = job & 127; g0 = 0; nbase = 0; }
    else { const int j2 = job - 256; kv = j2 >> 3; bs = (j2 >> 2) & 1; g0 = (j2 >> 1) & 1; nbase = (j2 & 1) * 256; }
    const bf16* W1T = (const bf16*)(ws + WS_W1T + layer * SZ_W1T) + (size_t)kv * 64 * 2048;
    const bf16* W2T = (const bf16*)(ws + WS_W2T + layer * SZ_W2T) + (size_t)kv * 64 * 64;
    const float* pe = KIN(12) + (size_t)(layer * 2 + kv) * 32 * 64;
    const bf16* Z = (const bf16*)(ws + WS_Z);
    const int* pt = (const int*)KIN(7);
    const float* cache = KIN(2);
    LAS unsigned char* LW = F.lds;
    int gg[2], nn[2];
    size_t pb0[2], pb1[2];
#pragma unroll
    for (int tl = 0; tl < 2; ++tl) { const int T = 2 * wave + tl; if (sample) { gg[tl] = T >> 3; nn[tl] = 16 * (T & 7) + rl; } else { gg[tl] = g0; nn[tl] = nbase + 16 * T + rl; }
        pb0[tl] = 0; pb1[tl] = 0;
        if (sample) { const int p0 = (16 * nn[tl]) >> 7; const int p1 = p0 + 1 > 15 ? 15 : p0 + 1;
            pb0[tl] = (size_t)(layer * 2560 + pt[bs * 16 + p0]) * 128 * 512; pb1[tl] = (size_t)(layer * 2560 + pt[bs * 16 + p1]) * 128 * 512; } }
    f32x4 h[2][4];
#pragma unroll
    for (int tl = 0; tl < 2; ++tl)
#pragma unroll
        for (int i = 0; i < 4; ++i) h[tl][i] = (f32x4){0.f, 0.f, 0.f, 0.f};
#pragma unroll 1
    for (int c = 0; c < 4; ++c) {
        __syncthreads();
#pragma unroll
        for (int k = 0; k < 8; ++k) { const int pc = tid + 512 * k, r = pc >> 6, c16 = pc & 63;
            *(LAS v4u*)(LW + r * 1040 + c16 * 16) = *(const v4u*)(W1T + (size_t)r * 2048 + c * 512 + c16 * 8); }
        __syncthreads();
#pragma unroll 8
        for (int kk = 0; kk < 16; ++kk) {
            const int j = 8 * c + (kk >> 1), dim0 = (kk & 1) * 32 + quad * 8;
            const f32x4 pe0 = *(const f32x4*)(pe + j * 64 + dim0), pe1 = *(const f32x4*)(pe + j * 64 + dim0 + 4);
            bf16x8 xb[2];
#pragma unroll
            for (int tl = 0; tl < 2; ++tl) {
                f32x4 x0, x1;
                if (!sample) { const size_t row = (size_t)bs * TP + 16 * nn[tl] + j; unpack8(*(const v4u*)(Z + row * LDZ + ZC_KC + kv * 128 + gg[tl] * 64 + dim0), x0, x1); }
                else { int pos = 16 * nn[tl] + j; pos = pos > 2047 ? 2047 : pos;
                    const float* p = cache + (((pos >> 7) == ((16 * nn[tl]) >> 7)) ? pb0[tl] : pb1[tl]) + (size_t)(pos & 127) * 512 + kv * 128 + gg[tl] * 64 + dim0; x0 = *(const f32x4*)p; x1 = *(const f32x4*)(p + 4); }
                xb[tl] = pack_frag(x0 + pe0, x1 + pe1);
            }
#pragma unroll
            for (int ht = 0; ht < 4; ++ht) {
                const bf16x8 a = ld_frag_l(LW + (16 * ht + rl) * 1040 + (kk * 32 + quad * 8) * 2);
                h[0][ht] = mfma16(a, xb[0], h[0][ht]); h[1][ht] = mfma16(a, xb[1], h[1][ht]);
            }
        }
    }
#pragma unroll
    for (int tl = 0; tl < 2; ++tl) {
#pragma unroll
        for (int ht = 0; ht < 4; ++ht)
#pragma unroll
            for (int i = 0; i < 4; ++i) h[tl][ht][i] = gelu_tanh(h[tl][ht][i]);
        bf16x8 gb[2]; gb[0] = pack_frag(h[tl][0], h[tl][1]); gb[1] = pack_frag(h[tl][2], h[tl][3]);
        const int n = nn[tl], g = gg[tl];
        bf16* dst = sample ? (bf16*)(ws + WS_KCS) + ((((size_t)kv * 128 + bs) * 128 + n) * 2 + g) * 64 : (bf16*)(ws + WS_KC) + ((((size_t)kv * 2 + bs) * 512 + n) * 2 + g) * 64;
        const bool zero = sample && n == 127;
#pragma unroll
        for (int ot = 0; ot < 4; ++ot) {
            f32x4 o = (f32x4){0.f, 0.f, 0.f, 0.f};
#pragma unroll
            for (int s = 0; s < 2; ++s) {
                const bf16* wp = W2T + (16 * ot + rl) * 64 + 32 * s + 4 * quad;
                o = mfma16(mk_frag(*(const v2u*)wp, *(const v2u*)(wp + 16)), gb[s], o);
            }
            v2u w; w.x = zero ? 0u : pk2(o[0], o[1]); w.y = zero ? 0u : pk2(o[2], o[3]);
            *(v2u*)(dst + 16 * ot + 4 * quad) = w;
        }
    }
    __syncthreads();
}

DI v2u pack4(const f32x4 v) { v2u w; w.x = pk2(v[0], v[1]); w.y = pk2(v[2], v[3]); return w; }
DI void compress_sample_job(Frame& F, int layer, int job) {
    int lane = F.lane, wave = F.wave; asm volatile("" : "+v"(lane), "+s"(wave));
    const int tid = wave * 64 + lane, quad = lane >> 4, rl = lane & 15;
    unsigned char* ws = KWS();
    const int kv = job >> 7, bs = job & 127;
    const bf16* W1T = (const bf16*)(ws + WS_W1T + layer * SZ_W1T) + (size_t)kv * 64 * 2048;
    const bf16* W2T = (const bf16*)(ws + WS_W2T + layer * SZ_W2T) + (size_t)kv * 64 * 64;
    const float* pe = KIN(12) + (size_t)(layer * 2 + kv) * 32 * 64;
    const int* pt = (const int*)KIN(7);
    const float* cache = KIN(2);
    LAS unsigned char* XS = F.lds;
    LAS unsigned char* WS1 = F.lds + 69632;
    size_t toff[8];
#pragma unroll
    for (int k = 0; k < 8; ++k) { const int q = tid + 512 * k, m = q >> 5; const int pos = 16 * m; const int phys = pt[bs * 16 + (pos >> 7)];
        toff[k] = ((size_t)(layer * 2560 + phys) * 128 + (pos & 127)) * 512 + kv * 128 + 4 * (q & 31); }
    const int wr_ = tid >> 3, wc_ = tid & 7;
    int gg[2], nn[2];
#pragma unroll
    for (int tl = 0; tl < 2; ++tl) { const int T = 2 * wave + tl; gg[tl] = T >> 3; nn[tl] = 16 * (T & 7) + rl; }
    f32x4 h[2][4];
#pragma unroll
    for (int tl = 0; tl < 2; ++tl)
#pragma unroll
        for (int i = 0; i < 4; ++i) h[tl][i] = (f32x4){0.f, 0.f, 0.f, 0.f};
    f32x4 xr[8]; v4u wr2[2];
#define CS_ISSUE(r_) do { _Pragma("unroll") for (int k = 0; k < 8; ++k) xr[k] = *(const f32x4*)(cache + toff[k] + (size_t)(r_) * 512); \
        _Pragma("unroll") for (int u = 0; u < 2; ++u) wr2[u] = *(const v4u*)(W1T + (size_t)wr_ * 2048 + ((r_) + 16 * u) * 64 + wc_ * 8); } while (0)
    CS_ISSUE(0);
#pragma unroll 1
    for (int r = 0; r < 16; ++r) {
        __syncthreads();
#pragma unroll
        for (int k = 0; k < 8; ++k) { const int q = tid + 512 * k, m = q >> 5, c = q & 31, d = 4 * (c & 15);
#pragma unroll
            for (int u = 0; u < 2; ++u) { const f32x4 v = xr[k] + *(const f32x4*)(pe + (r + 16 * u) * 64 + d);
                *(LAS v2u*)(XS + u * 34816 + m * 272 + c * 8) = pack4(v); } }
#pragma unroll
        for (int u = 0; u < 2; ++u) *(LAS v4u*)(WS1 + u * 9216 + wr_ * 144 + wc_ * 16) = wr2[u];
        __syncthreads();
        { const int rn = r + 1 < 16 ? r + 1 : 15; CS_ISSUE(rn); }
#pragma unroll
        for (int u = 0; u < 2; ++u)
#pragma unroll
            for (int ks = 0; ks < 2; ++ks) {
                bf16x8 xb[2];
#pragma unroll
                for (int tl = 0; tl < 2; ++tl) { int m = nn[tl] + u; m = m > 127 ? 127 : m; xb[tl] = ld_frag_l(XS + u * 34816 + m * 272 + gg[tl] * 128 + ks * 64 + quad * 16); }
#pragma unroll
                for (int ht = 0; ht < 4; ++ht) { const bf16x8 a = ld_frag_l(WS1 + u * 9216 + (16 * ht + rl) * 144 + ks * 64 + quad * 16);
                    h[0][ht] = mfma16(a, xb[0], h[0][ht]); h[1][ht] = mfma16(a, xb[1], h[1][ht]); }
            }
    }
#undef CS_ISSUE
#pragma unroll
    for (int tl = 0; tl < 2; ++tl) {
#pragma unroll
        for (int ht = 0; ht < 4; ++ht)
#pragma unroll
            for (int i = 0; i < 4; ++i) h[tl][ht][i] = gelu_tanh(h[tl][ht][i]);
        bf16x8 gb[2]; gb[0] = pack_frag(h[tl][0], h[tl][1]); gb[1] = pack_frag(h[tl][2], h[tl][3]);
        const int n = nn[tl], g = gg[tl];
        bf16* dst = (bf16*)(ws + WS_KCS) + ((((size_t)kv * 128 + bs) * 128 + n) * 2 + g) * 64;
        const bool zero = n == 127;
#pragma unroll
        for (int ot = 0; ot < 4; ++ot) {
            f32x4 o = (f32x4){0.f, 0.f, 0.f, 0.f};
#pragma unroll
            for (int s = 0; s < 2; ++s) {
                const bf16* wp = W2T + (16 * ot + rl) * 64 + 32 * s + 4 * quad;
                o = mfma16(mk_frag(*(const v2u*)wp, *(const v2u*)(wp + 16)), gb[s], o);
            }
            v2u w; w.x = zero ? 0u : pk2(o[0], o[1]); w.y = zero ? 0u : pk2(o[2], o[3]);
            *(v2u*)(dst + 16 * ot + 4 * quad) = w;
        }
    }
    __syncthreads();
}
DI void compress_job(Frame& F, int layer, int job) { if (job < 256) compress_sample_job(F, layer, job); else compress_job_t<false>(F, layer, job); }
#ifndef PH_GPT
#define PH_GPT (-1)
#endif
#if PH_GPT >= 0
#define GP_T(k) do { if (tid == 0) { volatile LAS unsigned long long* gp_ = (volatile LAS unsigned long long*)(F.lds + LDSCTL_OFF + 448); const unsigned long long now_ = __builtin_amdgcn_s_memrealtime(); \
    if ((k) == PH_GPT) gp_[0] += now_ - gp_[1]; gp_[1] = now_; } } while (0)
#else
#define GP_T(k) do { } while (0)
#endif
DI int kperm(int idx) { const int s = idx >> 5, r = idx & 31; return 32 * s + 8 * ((r >> 2) & 3) + 4 * (r >> 4) + (r & 3); }
DI float softplusf_(float x) { return x > 20.f ? x : __logf(1.f + __expf(x)); }
DI float ret_lg(int h) { return h == 0 ? -0.031748697f : h == 1 ? -0.015748357f : h == 2 ? -0.007843178f : -0.0039138994f; }

DI void gdn_prep_unit(Frame& F, int layer, int unit) {
    int lane = F.lane, wave = F.wave; asm volatile("" : "+v"(lane), "+s"(wave));
    const int tid = wave * 64 + lane;
    const int b = unit >> 9, h = (unit >> 7) & 3, c = unit & 127;
    const int row0 = b * TP + 64 * c, t0 = 64 * c;
    GP_T(0);
    unsigned char* ws = KWS();
    const bf16* Z = (const bf16*)(ws + WS_Z);
    const float* ZS = (const float*)(ws + WS_ZS);
    LAS float* Lq = (LAS float*)(F.lds); LAS float* Lk = (LAS float*)(F.lds + 33792); LAS float* Lv = (LAS float*)(F.lds + 67584);
    LAS float* LA = (LAS float*)(F.lds + 101376); LAS float* LQK = (LAS float*)(F.lds + 117760);
    LAS float* Lg = (LAS float*)(F.lds + 134144); LAS float* Lb = Lg + 64; LAS float* Le = Lg + 128;
    const float* cw = KIN(15) + (size_t)layer * 4 * 1536;
    {
        v4u xs[6][4];
#pragma unroll
        for (int it0 = 0; it0 < 6; ++it0) {
            const int it = tid + it0 * NTHREADS, i = it / 48, ch = it % 48, col = (ch >> 4) * 512 + h * 128 + (ch & 15) * 8;
#pragma unroll
            for (int j = 0; j < 4; ++j) { const bool ok = (t0 + i - 3 + j) >= 0; xs[it0][j] = *(const v4u*)(Z + (size_t)(ok ? row0 + i - 3 + j : row0) * LDZ + ZC_GQKV + col); }
        }
        asm volatile("" ::: "memory");
#pragma unroll
        for (int it0 = 0; it0 < 6; ++it0) {
            const int it = tid + it0 * NTHREADS, i = it / 48, ch = it % 48, part = ch >> 4, cc = ch & 15;
            const int col = part * 512 + h * 128 + cc * 8;
            f32x4 y0 = (f32x4){0.f, 0.f, 0.f, 0.f}, y1 = y0;
#pragma unroll
            for (int j = 0; j < 4; ++j) {
                const float zf = ((t0 + i - 3 + j) >= 0) ? 1.f : 0.f;
                f32x4 x0, x1; unpack8(xs[it0][j], x0, x1);
                y0 += x0 * (*(const f32x4*)(cw + j * 1536 + col) * zf); y1 += x1 * (*(const f32x4*)(cw + j * 1536 + col + 4) * zf);
            }
#pragma unroll
            for (int e = 0; e < 4; ++e) { y0[e] = siluf_(y0[e]); y1[e] = siluf_(y1[e]); }
            LAS float* dst = (part == 0 ? Lq : part == 1 ? Lk : Lv) + i * 132 + cc * 8;
            *(LAS f32x4*)dst = y0; *(LAS f32x4*)(dst + 4) = y1;
        }
    }
    __syncthreads();
    GP_T(1);
    {
        float va[16], vb[16], ps[16];
#pragma unroll
        for (int q = 0; q < 16; ++q) { LAS float* vp = ((q < 8) ? Lq : Lk) + (wave * 8 + (q & 7)) * 132 + lane * 2; va[q] = vp[0]; vb[q] = vp[1]; ps[q] = va[q] * va[q] + vb[q] * vb[q]; }
#pragma unroll
        for (int q = 0; q < 16; ++q) ps[q] += shx<1>(ps[q], lane);
#pragma unroll
        for (int q = 0; q < 16; ++q) ps[q] += shx<2>(ps[q], lane);
#pragma unroll
        for (int q = 0; q < 16; ++q) ps[q] += shx<4>(ps[q], lane);
#pragma unroll
        for (int q = 0; q < 16; ++q) ps[q] += shx<8>(ps[q], lane);
#pragma unroll
        for (int q = 0; q < 16; ++q) ps[q] += shx<16>(ps[q], lane);
#pragma unroll
        for (int q = 0; q < 16; ++q) ps[q] += shx<32>(ps[q], lane);
#pragma unroll
        for (int q = 0; q < 16; ++q) { LAS float* vp = ((q < 8) ? Lq : Lk) + (wave * 8 + (q & 7)) * 132 + lane * 2; const float sc = rsqrtf(ps[q] + EPS) * ((q < 8) ? 0.08838834764831845f : 1.f); vp[0] = va[q] * sc; vp[1] = vb[q] * sc; }
    }
    if (wave == 0) {
        const float ga = ZS[(size_t)(row0 + lane) * 32 + 24 + h], gbv = ZS[(size_t)(row0 + lane) * 32 + 28 + h];
        float g = -__expf(KIN(16)[layer * 4 + h]) * softplusf_(ga + KIN(17)[layer * 4 + h]);
#pragma unroll
        for (int o = 1; o < 64; o <<= 1) { const float t = __int_as_float(__builtin_amdgcn_ds_bpermute(((lane - o) & 63) << 2, __float_as_int(g))); if (lane >= o) g += t; }
        Lg[lane] = g; Lb[lane] = sigmoidf_(gbv); Le[lane] = __expf(g);
    }
    __syncthreads();
    GP_T(2);
    {
        const int it = wave >> 1, quad = lane >> 4, rl = lane & 15;
        f32x4 ckk[2], cqk[2];
#pragma unroll
        for (int jj = 0; jj < 2; ++jj) { ckk[jj] = (f32x4){0.f, 0.f, 0.f, 0.f}; cqk[jj] = ckk[jj]; }
#pragma unroll
        for (int s = 0; s < 4; ++s) {
            const LAS float* kp = Lk + (16 * it + rl) * 132 + 32 * s + 8 * quad; const LAS float* qp = Lq + (16 * it + rl) * 132 + 32 * s + 8 * quad;
            const f32x4 ka0 = *(const LAS f32x4*)kp, ka1 = *(const LAS f32x4*)(kp + 4), qa0 = *(const LAS f32x4*)qp, qa1 = *(const LAS f32x4*)(qp + 4);
            const bf16x8 kah = pack_frag(ka0, ka1), qah = pack_frag(qa0, qa1);
            f32x4 h0, h1; unpack8(__builtin_bit_cast(v4u, kah), h0, h1); const bf16x8 kal = pack_frag(ka0 - h0, ka1 - h1);
            unpack8(__builtin_bit_cast(v4u, qah), h0, h1); const bf16x8 qal = pack_frag(qa0 - h0, qa1 - h1);
#pragma unroll
            for (int jj = 0; jj < 2; ++jj) {
                const int jt = (wave & 1) * 2 + jj;
                if (jt <= it) {
                    const LAS float* bp = Lk + (16 * jt + rl) * 132 + 32 * s + 8 * quad;
                    const f32x4 kb0 = *(const LAS f32x4*)bp, kb1 = *(const LAS f32x4*)(bp + 4);
                    const bf16x8 kbh = pack_frag(kb0, kb1); unpack8(__builtin_bit_cast(v4u, kbh), h0, h1); const bf16x8 kbl = pack_frag(kb0 - h0, kb1 - h1);
                    ckk[jj] = mfma16(kah, kbh, ckk[jj]); ckk[jj] = mfma16(kah, kbl, ckk[jj]); ckk[jj] = mfma16(kal, kbh, ckk[jj]);
                    cqk[jj] = mfma16(qah, kbh, cqk[jj]); cqk[jj] = mfma16(qah, kbl, cqk[jj]); cqk[jj] = mfma16(qal, kbh, cqk[jj]);
                }
            }
        }
#pragma unroll
        for (int jj = 0; jj < 2; ++jj) {
            const int j = 16 * ((wave & 1) * 2 + jj) + rl; const float gj = Lg[j];
#pragma unroll
            for (int e = 0; e < 4; ++e) { const int i = 16 * it + 4 * quad + e; const float dec = (i >= j) ? __expf(Lg[i] - gj) : 0.f;
                LA[i * 64 + j] = (i > j) ? Lb[i] * ckk[jj][e] * dec : 0.f; LQK[i * 64 + j] = cqk[jj][e] * dec; }
        }
    }
    __syncthreads();
    GP_T(3);
    unsigned char* rec = ws + WS_GREC + (size_t)unit * GREC;
    LAS float* TI = (LAS float*)(F.lds + 135168);
    if (tid < 64) {
        const int B = tid >> 4, c = tid & 15;
        float tc[16];
#pragma unroll
        for (int i = 0; i < 16; ++i) {
            float s0 = (i == c) ? 1.f : 0.f;
#pragma unroll
            for (int j = 0; j < i; ++j) s0 -= LA[(16 * B + i) * 64 + 16 * B + j] * tc[j];
            tc[i] = s0;
        }
#pragma unroll
        for (int i = 0; i < 16; ++i) TI[B * 256 + i * 16 + c] = tc[i];
    }
    {
        const float gl = Lg[63];
        for (int it = tid; it < 2560; it += NTHREADS) {
            if (it < 1024) {
                const int i = it >> 4, s = (it >> 2) & 3, quad = it & 3; const float e = Le[i];
                const f32x4 a = *(const LAS f32x4*)(Lq + i * 132 + 32 * s + 4 * quad) * e, bq = *(const LAS f32x4*)(Lq + i * 132 + 32 * s + 16 + 4 * quad) * e;
                *(v4u*)(rec + 16384 + i * 256 + (32 * s + 8 * quad) * 2) = pack8(a, bq);
            } else if (it < 2048) {
                const int r = it - 1024, dk = r >> 3, s2 = (r >> 2) & 1, quad = r & 3;
                f32x4 a, bq;
#pragma unroll
                for (int e = 0; e < 4; ++e) { const int ta = 32 * s2 + 4 * quad + e, tb = ta + 16; a[e] = Lk[ta * 132 + dk] * __expf(gl - Lg[ta]); bq[e] = Lk[tb * 132 + dk] * __expf(gl - Lg[tb]); }
                *(v4u*)(rec + 32768 + dk * 128 + (32 * s2 + 8 * quad) * 2) = pack8(a, bq);
            } else {
                const int r = it - 2048, i = r >> 3, s2 = (r >> 2) & 1, quad = r & 3;
                const f32x4 a = *(const LAS f32x4*)(LQK + i * 64 + 32 * s2 + 4 * quad), bq = *(const LAS f32x4*)(LQK + i * 64 + 32 * s2 + 16 + 4 * quad);
                *(v4u*)(rec + 65536 + i * 128 + (32 * s2 + 8 * quad) * 2) = pack8(a, bq);
            }
        }
        if (tid == 0) *(float*)(rec + 73728) = __expf(gl);
    }
    __syncthreads();
    GP_T(4);
    {
        const int col = tid & 255, hb = tid >> 8;
        LAS float* X = (col < 128) ? (Lv + col) : (Lk + (col - 128));
        const bool isw = col >= 128;
#pragma unroll 1
        for (int B = 0; B < 4; ++B) {
            float xb[8];
#pragma unroll
            for (int i = 0; i < 8; ++i) { const int r = 16 * B + 8 * hb + i; xb[i] = (isw ? Lb[r] * Le[r] : Lb[r]) * X[r * 132]; }
#pragma unroll 2
            for (int j4 = 0; j4 < 4 * B; ++j4) {
                const float x0 = X[(4 * j4) * 132], x1 = X[(4 * j4 + 1) * 132], x2 = X[(4 * j4 + 2) * 132], x3 = X[(4 * j4 + 3) * 132];
#pragma unroll
                for (int i = 0; i < 8; ++i) { const f32x4 a = *(const LAS f32x4*)(LA + (16 * B + 8 * hb + i) * 64 + 4 * j4); xb[i] -= (a[0] * x0 + a[1] * x1) + (a[2] * x2 + a[3] * x3); }
            }
#pragma unroll
            for (int i = 0; i < 8; ++i) X[(16 * B + 8 * hb + i) * 132] = xb[i];
            __syncthreads();
            float r[16];
#pragma unroll
            for (int jj = 0; jj < 16; ++jj) r[jj] = X[(16 * B + jj) * 132];
            __syncthreads();
#pragma unroll
            for (int i = 0; i < 8; ++i) {
                float s0 = 0.f, s1 = 0.f;
#pragma unroll
                for (int j4 = 0; j4 < 4; ++j4) { const f32x4 a = *(const LAS f32x4*)(TI + B * 256 + (8 * hb + i) * 16 + 4 * j4);
                    s0 += a[0] * r[4 * j4] + a[2] * r[4 * j4 + 2]; s1 += a[1] * r[4 * j4 + 1] + a[3] * r[4 * j4 + 3]; }
                X[(16 * B + 8 * hb + i) * 132] = s0 + s1;
            }
            __syncthreads();
        }
    }
    __syncthreads();
    GP_T(5);
    for (int it = tid; it < 2048; it += NTHREADS) {
        if (it < 1024) {
            const int dv = it >> 3, q = it & 7;
            v4u w; w.x = pk2(Lv[(8 * q) * 132 + dv], Lv[(8 * q + 1) * 132 + dv]); w.y = pk2(Lv[(8 * q + 2) * 132 + dv], Lv[(8 * q + 3) * 132 + dv]);
            w.z = pk2(Lv[(8 * q + 4) * 132 + dv], Lv[(8 * q + 5) * 132 + dv]); w.w = pk2(Lv[(8 * q + 6) * 132 + dv], Lv[(8 * q + 7) * 132 + dv]);
            *(v4u*)(rec + 49152 + dv * 128 + q * 16) = w;
        } else {
            const int r = it - 1024, i = r >> 4, s = (r >> 2) & 3, quad = r & 3;
            const f32x4 a = *(const LAS f32x4*)(Lk + i * 132 + 32 * s + 4 * quad), bq = *(const LAS f32x4*)(Lk + i * 132 + 32 * s + 16 + 4 * quad);
            *(v4u*)(rec + i * 256 + (32 * s + 8 * quad) * 2) = pack8(a, bq);
        }
    }
    __syncthreads();
    GP_T(6);
}

DI void ret_prep_unit(Frame& F, int layer, int unit) {
    int lane = F.lane, wave = F.wave; asm volatile("" : "+v"(lane), "+s"(wave));
    const int tid = wave * 64 + lane, quad = lane >> 4, rl = lane & 15;
    const int b = unit >> 8, h = (unit >> 6) & 3, c = unit & 63;
    const int row0 = b * TP + 128 * c;
    unsigned char* ws = KWS();
    const bf16* Z = (const bf16*)(ws + WS_Z);
    const f32x2* ROT = (const f32x2*)(ws + WS_ROT);
    bf16* QR = (bf16*)(ws + WS_QR); bf16* KR = (bf16*)(ws + WS_KR);
    LAS unsigned char* LK = F.lds; LAS unsigned char* LV = F.lds + 34816;
    const float lg = ret_lg(h);
    for (int it = tid; it < 1024; it += NTHREADS) {
        const int j = it >> 3, cc = it & 7, d0 = cc * 8;
        const size_t zr = (size_t)(row0 + j) * LDZ + ZC_RQKV + h * 128 + d0;
        f32x4 q1a, q1b, q2a, q2b, k1a, k1b, k2a, k2b;
        unpack8(*(const v4u*)(Z + zr), q1a, q1b); unpack8(*(const v4u*)(Z + zr + 64), q2a, q2b);
        unpack8(*(const v4u*)(Z + zr + 512), k1a, k1b); unpack8(*(const v4u*)(Z + zr + 512 + 64), k2a, k2b);
        const f32x2* rp = ROT + (size_t)(128 * c + j) * 64 + d0;
        const float kd = __expf((float)(127 - j) * lg);
        f32x4 oq1a, oq1b, oq2a, oq2b, ok1a, ok1b, ok2a, ok2b;
#pragma unroll
        for (int e = 0; e < 8; ++e) {
            const f32x2 cs = rp[e];
            const float q1 = e < 4 ? q1a[e & 3] : q1b[e & 3], q2 = e < 4 ? q2a[e & 3] : q2b[e & 3], k1 = e < 4 ? k1a[e & 3] : k1b[e & 3], k2 = e < 4 ? k2a[e & 3] : k2b[e & 3];
            const float rq1 = q1 * cs.x - q2 * cs.y, rq2 = q2 * cs.x + q1 * cs.y, rk1 = (k1 * cs.x - k2 * cs.y) * 0.08838834764831845f, rk2 = (k2 * cs.x + k1 * cs.y) * 0.08838834764831845f;
            if (e < 4) { oq1a[e & 3] = rq1; oq2a[e & 3] = rq2; ok1a[e & 3] = rk1; ok2a[e & 3] = rk2; } else { oq1b[e & 3] = rq1; oq2b[e & 3] = rq2; ok1b[e & 3] = rk1; ok2b[e & 3] = rk2; }
            *(LAS bf16*)(LK + (d0 + e) * 272 + j * 2) = (bf16)f2bf(rk1 * kd); *(LAS bf16*)(LK + (d0 + 64 + e) * 272 + j * 2) = (bf16)f2bf(rk2 * kd);
        }
        const size_t orow = (size_t)(row0 + j) * 512 + h * 128 + d0;
        *(v4u*)(QR + orow) = pack8(oq1a, oq1b); *(v4u*)(QR + orow + 64) = pack8(oq2a, oq2b);
        *(v4u*)(KR + orow) = pack8(ok1a, ok1b); *(v4u*)(KR + orow + 64) = pack8(ok2a, ok2b);
    }
    for (int it = tid; it < 2048; it += NTHREADS) {
        const int j = it >> 4, cc = it & 15;
        const v4u w = *(const v4u*)(Z + (size_t)(row0 + j) * LDZ + ZC_RQKV + 1024 + h * 128 + cc * 8);
        LAS unsigned char* d = LV + (cc * 8) * 272 + j * 2;
        *(LAS bf16*)(d) = (bf16)(w.x & 0xffff); *(LAS bf16*)(d + 272) = (bf16)(w.x >> 16); *(LAS bf16*)(d + 2 * 272) = (bf16)(w.y & 0xffff); *(LAS bf16*)(d + 3 * 272) = (bf16)(w.y >> 16);
        *(LAS bf16*)(d + 4 * 272) = (bf16)(w.z & 0xffff); *(LAS bf16*)(d + 5 * 272) = (bf16)(w.z >> 16); *(LAS bf16*)(d + 6 * 272) = (bf16)(w.w & 0xffff); *(LAS bf16*)(d + 7 * 272) = (bf16)(w.w >> 16);
    }
    __syncthreads();
    float* RKV = (float*)(ws + WS_RKV) + (size_t)unit * 16384;
#pragma unroll
    for (int nt = 0; nt < 8; ++nt) {
        f32x4 acc = (f32x4){0.f, 0.f, 0.f, 0.f};
#pragma unroll
        for (int s = 0; s < 4; ++s) acc = mfma16(ld_frag_l(LK + (16 * wave + rl) * 272 + (32 * s + 8 * quad) * 2), ld_frag_l(LV + (16 * nt + rl) * 272 + (32 * s + 8 * quad) * 2), acc);
#pragma unroll
        for (int i = 0; i < 4; ++i) RKV[(size_t)(16 * wave + 4 * quad + i) * 128 + 16 * nt + rl] = acc[i];
    }
    __syncthreads();
}
DI void sample_rec_unit(Frame& F, int layer, int unit) {
    int lane = F.lane, wave = F.wave; asm volatile("" : "+v"(lane), "+s"(wave));
    const int tid = wave * 64 + lane;
    const int kind = unit >> 9, s = (unit >> 2) & 127, h = unit & 3;
    const int dv = tid & 127, part = tid >> 7, r0 = MP + 4 * s;
    unsigned char* ws = KWS();
    const bf16* Z = (const bf16*)(ws + WS_Z);
    const float* ZS = (const float*)(ws + WS_ZS);
    LAS float* Lq = (LAS float*)(F.lds); LAS float* Lk = Lq + 512; LAS float* Lv = Lq + 1024; LAS float* red = Lq + 1536; LAS float* Lo = Lq + 2048; LAS float* sc = Lq + 2560;
    float S[32];
    if (kind == 0) {
        if (tid < 384) {
            const int pr = tid >> 7, d = tid & 127, col = pr * 512 + h * 128 + d;
            float xp[7], w[4];
#pragma unroll
            for (int i = 0; i < 3; ++i) xp[i] = KIN(4)[((size_t)(layer * 128 + s) * 3 + i) * 1536 + col];
#pragma unroll
            for (int j = 0; j < 4; ++j) xp[3 + j] = bf2f(Z[(size_t)(r0 + j) * LDZ + ZC_GQKV + col]);
#pragma unroll
            for (int i = 0; i < 4; ++i) w[i] = KIN(15)[(size_t)(layer * 4 + i) * 1536 + col];
            LAS float* dst = pr == 0 ? Lq : pr == 1 ? Lk : Lv;
#pragma unroll
            for (int j = 0; j < 4; ++j) dst[j * 128 + d] = siluf_(w[0] * xp[j] + w[1] * xp[j + 1] + w[2] * xp[j + 2] + w[3] * xp[j + 3]);
        }
        __syncthreads();
        {
            LAS float* vp = (wave < 4 ? Lq : Lk) + (wave & 3) * 128;
            const float a = vp[2 * lane], b = vp[2 * lane + 1];
            const float scl = rsqrtf(wave_sum(a * a + b * b, lane) + EPS) * (wave < 4 ? 0.08838834764831845f : 1.f);
            vp[2 * lane] = a * scl; vp[2 * lane + 1] = b * scl;
        }
        if (tid < 4) {
            const float ga = ZS[(size_t)(r0 + tid) * 32 + 24 + h], gb = ZS[(size_t)(r0 + tid) * 32 + 28 + h];
            sc[tid] = __expf(-__expf(KIN(16)[layer * 4 + h]) * softplusf_(ga + KIN(17)[layer * 4 + h])); sc[4 + tid] = sigmoidf_(gb);
        }
        __syncthreads();
        const float* Sin = KIN(5) + ((size_t)((layer * 128 + s) * 4 + h) * 128 + 32 * part) * 128 + dv;
#pragma unroll
        for (int i = 0; i < 32; ++i) S[i] = Sin[(size_t)i * 128];
#pragma unroll
        for (int j = 0; j < 4; ++j) {
            const float a = sc[j], beta = sc[4 + j];
            float p = 0.f;
#pragma unroll
            for (int i = 0; i < 32; ++i) { S[i] *= a; p += Lk[j * 128 + 32 * part + i] * S[i]; }
            red[part * 128 + dv] = p;
            __syncthreads();
            const float delta = beta * (Lv[j * 128 + dv] - ((red[dv] + red[128 + dv]) + (red[256 + dv] + red[384 + dv])));
            __syncthreads();
            float o = 0.f;
#pragma unroll
            for (int i = 0; i < 32; ++i) { S[i] += Lk[j * 128 + 32 * part + i] * delta; o += Lq[j * 128 + 32 * part + i] * S[i]; }
            red[part * 128 + dv] = o;
            __syncthreads();
            if (part == 0) Lo[j * 128 + dv] = (red[dv] + red[128 + dv]) + (red[256 + dv] + red[384 + dv]);
            __syncthreads();
        }
        float* Sout = KOUT() + O_GSS + ((size_t)((layer * 128 + s) * 4 + h) * 128 + 32 * part) * 128 + dv;
#pragma unroll
        for (int i = 0; i < 32; ++i) Sout[(size_t)i * 128] = S[i];
        ((float*)(ws + WS_OGDN))[(size_t)(r0 + part) * 512 + h * 128 + dv] = Lo[part * 128 + dv];
    } else {
        const f32x2* ROT = (const f32x2*)(ws + WS_ROT);
        if (tid < 384) {
            const int pr = tid >> 7, d = tid & 127;
#pragma unroll
            for (int j = 0; j < 4; ++j) {
                const bf16* zp = Z + (size_t)(r0 + j) * LDZ + ZC_RQKV + pr * 512 + h * 128;
                float v = bf2f(zp[d]);
                if (pr < 2) { const f32x2 cs = ROT[(size_t)(2048 + j) * 64 + (d & 63)]; const float o = bf2f(zp[d ^ 64]);
                    v = (d < 64) ? v * cs.x - o * cs.y : v * cs.x + o * cs.y; if (pr == 1) v *= 0.08838834764831845f; }
                (pr == 0 ? Lq : pr == 1 ? Lk : Lv)[j * 128 + d] = v;
            }
        }
        __syncthreads();
        const float gam = __expf(ret_lg(h));
        const float* Sin = KIN(6) + ((size_t)((layer * 128 + s) * 4 + h) * 128 + 32 * part) * 128 + dv;
#pragma unroll
        for (int i = 0; i < 32; ++i) S[i] = Sin[(size_t)i * 128];
#pragma unroll
        for (int j = 0; j < 4; ++j) {
            const float vv = Lv[j * 128 + dv];
            float o = 0.f;
#pragma unroll
            for (int i = 0; i < 32; ++i) { S[i] = S[i] * gam + Lk[j * 128 + 32 * part + i] * vv; o += Lq[j * 128 + 32 * part + i] * S[i]; }
            red[part * 128 + dv] = o;
            __syncthreads();
            if (part == 0) Lo[j * 128 + dv] = (red[dv] + red[128 + dv]) + (red[256 + dv] + red[384 + dv]);
            __syncthreads();
        }
        float* Sout = KOUT() + O_RSS + ((size_t)((layer * 128 + s) * 4 + h) * 128 + 32 * part) * 128 + dv;
#pragma unroll
        for (int i = 0; i < 32; ++i) Sout[(size_t)i * 128] = S[i];
        if (wave < 4) {
            const int j = wave; const float a = Lo[j * 128 + 2 * lane], b = Lo[j * 128 + 2 * lane + 1];
            const float scl = rsqrtf(wave_sum(a * a + b * b, lane) * (1.f / 128.f) + EPS);
            const bf16* gp = Z + (size_t)(r0 + j) * LDZ + ZC_RG + h * 128 + 2 * lane;
            *(unsigned*)((bf16*)(ws + WS_MIX) + (size_t)(r0 + j) * 1536 + 1024 + h * 128 + 2 * lane) = pk2(a * scl * siluf_(bf2f(gp[0])), b * scl * siluf_(bf2f(gp[1])));
        }
    }
    __syncthreads();
}

DI void gdn_scan_chain(Frame& F, int layer, int bh) {
    int lane = F.lane, wave = F.wave; asm volatile("" : "+v"(lane), "+s"(wave));
    const int tid = wave * 64 + lane, quad = lane >> 4, rl = lane & 15;
    unsigned char* ws = KWS();
    const unsigned char* recb = ws + WS_GREC + (size_t)bh * 128 * GREC;
    LAS unsigned char* L = F.lds;
    constexpr int L_WP = 0, L_QP = 17408, L_KT = 34816, L_UT = 53248, L_QK = 71680;
    f32x4 S[8];
#pragma unroll
    for (int i = 0; i < 8; ++i) S[i] = (f32x4){0.f, 0.f, 0.f, 0.f};
    v4u pf[9]; float egl;
#pragma unroll
    for (int k = 0; k < 9; ++k) pf[k] = *(const v4u*)(recb + (size_t)(tid + 512 * k) * 16);
    egl = *(const float*)(recb + 73728);
    float* OG = (float*)(ws + WS_OGDN);
    const int b = bh >> 2, h = bh & 3;
    for (int c = 0; c < 128; ++c) {
        __syncthreads();
#pragma unroll
        for (int k = 0; k < 9; ++k) {
            const int o = tid * 16 + (k & 1) * 8192;
            const int reg = k >> 1;
            int dst;
            if (reg < 2) dst = (reg == 0 ? L_WP : L_QP) + (o >> 8) * 272 + (o & 255);
            else dst = (reg == 2 ? L_KT : reg == 3 ? L_UT : L_QK) + (o >> 7) * 144 + (o & 127);
            *(LAS v4u*)(L + dst) = pf[k];
        }
        const float eg = egl;
        __syncthreads();
        {
            const unsigned char* rn = recb + (size_t)(c + 1 < 128 ? c + 1 : 127) * GREC;
#pragma unroll
            for (int k = 0; k < 9; ++k) pf[k] = *(const v4u*)(rn + (size_t)(tid + 512 * k) * 16);
            egl = *(const float*)(rn + 73728);
        }
        bf16x8 Sb[4];
#pragma unroll
        for (int s = 0; s < 4; ++s) Sb[s] = pack_frag(S[2 * s], S[2 * s + 1]);
        f32x4 vn[4], O[4];
#pragma unroll
        for (int rt = 0; rt < 4; ++rt) {
            f32x4 wsacc = (f32x4){0.f, 0.f, 0.f, 0.f}, o = wsacc;
#pragma unroll
            for (int s = 0; s < 4; ++s) {
                wsacc = mfma16(ld_frag_l(L + L_WP + (16 * rt + rl) * 272 + (32 * s + 8 * quad) * 2), Sb[s], wsacc);
                o = mfma16(ld_frag_l(L + L_QP + (16 * rt + rl) * 272 + (32 * s + 8 * quad) * 2), Sb[s], o);
            }
            const v2u uw = *(const LAS v2u*)(L + L_UT + (16 * wave + rl) * 144 + (16 * rt + 4 * quad) * 2);
            vn[rt][0] = lo_bf(uw.x) - wsacc[0]; vn[rt][1] = hi_bf(uw.x) - wsacc[1]; vn[rt][2] = lo_bf(uw.y) - wsacc[2]; vn[rt][3] = hi_bf(uw.y) - wsacc[3];
            O[rt] = o;
        }
        bf16x8 Vb[2]; Vb[0] = pack_frag(vn[0], vn[1]); Vb[1] = pack_frag(vn[2], vn[3]);
#pragma unroll
        for (int rt = 0; rt < 4; ++rt) {
#pragma unroll
            for (int s2 = 0; s2 < 2; ++s2) O[rt] = mfma16(ld_frag_l(L + L_QK + (16 * rt + rl) * 144 + (32 * s2 + 8 * quad) * 2), Vb[s2], O[rt]);
            const size_t row = (size_t)b * TP + 64 * c + 16 * rt + 4 * quad;
#pragma unroll
            for (int i = 0; i < 4; ++i) OG[(row + i) * 512 + h * 128 + 16 * wave + rl] = O[rt][i];
        }
#pragma unroll
        for (int kt = 0; kt < 8; ++kt) {
            f32x4 a = S[kt] * eg;
#pragma unroll
            for (int s2 = 0; s2 < 2; ++s2) a = mfma16(ld_frag_l(L + L_KT + (16 * kt + rl) * 144 + (32 * s2 + 8 * quad) * 2), Vb[s2], a);
            S[kt] = a;
        }
    }
    float* So = KOUT() + O_GSP + (size_t)(layer * 8 + bh) * 16384;
#pragma unroll
    for (int kt = 0; kt < 8; ++kt)
#pragma unroll
        for (int i = 0; i < 4; ++i) So[(size_t)(16 * kt + 4 * quad + i) * 128 + 16 * wave + rl] = S[kt][i];
    __syncthreads();
}
DI void ret_scan_part(Frame& F, int layer, int r) {
    int tid = F.tid; asm volatile("" : "+v"(tid));
    const int bh = r >> 2, dv = tid & 127, dk0 = ((r & 3) * 4 + (tid >> 7)) * 8, h = bh & 3;
    unsigned char* ws = KWS();
    const float* RKV = (const float*)(ws + WS_RKV) + (size_t)bh * 64 * 16384;
    bf16* RST = (bf16*)(ws + WS_RST) + (size_t)bh * 64 * 16384;
    const float cdec = __expf(128.f * ret_lg(h));
    float S[8];
#pragma unroll
    for (int i = 0; i < 8; ++i) S[i] = 0.f;
#pragma unroll 4
    for (int c = 0; c < 64; ++c) {
        v4u w; w.x = pk2(S[0], S[1]); w.y = pk2(S[2], S[3]); w.z = pk2(S[4], S[5]); w.w = pk2(S[6], S[7]);
        *(v4u*)(RST + (size_t)c * 16384 + dv * 128 + dk0) = w;
#pragma unroll
        for (int i = 0; i < 8; ++i) S[i] = S[i] * cdec + RKV[(size_t)c * 16384 + (dk0 + i) * 128 + dv];
    }
    float* So = KOUT() + O_RSP + (size_t)(layer * 8 + bh) * 16384;
#pragma unroll
    for (int i = 0; i < 8; ++i) So[(size_t)(dk0 + i) * 128 + dv] = S[i];
}
constexpr float SM_C = 0.125f * 1.4426950408889634f;
struct AttnState { float m, l; f32x4 O[4]; };
DI void attn_reset(AttnState& st) { st.m = -1e30f; st.l = 0.f;
#pragma unroll
    for (int i = 0; i < 4; ++i) st.O[i] = (f32x4){0.f, 0.f, 0.f, 0.f}; }
DI void qk_tile(const LAS unsigned char* Kt, const bf16x8 (&qf)[2], f32x4 (&s)[4], int rl, int quad) {
    bf16x8 kf[4][2];
#pragma unroll
    for (int kt = 0; kt < 4; ++kt)
#pragma unroll
        for (int kk = 0; kk < 2; ++kk) kf[kt][kk] = ld_frag_l(Kt + (16 * kt + rl) * 144 + kk * 64 + quad * 16);
    __builtin_amdgcn_s_setprio(1);
#pragma unroll
    for (int kt = 0; kt < 4; ++kt) s[kt] = mfma16(kf[kt][0], qf[0], (f32x4){0.f, 0.f, 0.f, 0.f});
#pragma unroll
    for (int kt = 0; kt < 4; ++kt) s[kt] = mfma16(kf[kt][1], qf[1], s[kt]);
    __builtin_amdgcn_s_setprio(0);
}
template <class Mask> DI void attn_step(const LAS unsigned char* Kt, const LAS unsigned char* VT, const bf16x8 (&qf)[2], AttnState& st, const Mask& ok, int rl, int quad) {
    f32x4 s[4]; qk_tile(Kt, qf, s, rl, quad);
    float mx = -3e38f;
#pragma unroll
    for (int kt = 0; kt < 4; ++kt)
#pragma unroll
        for (int i = 0; i < 4; ++i) if (ok(16 * kt + 4 * quad + i)) mx = fmaxf(mx, s[kt][i]);
    const int lane = rl + 16 * quad;
    mx = fmaxf(mx, shx<16>(mx, lane)); mx = fmaxf(mx, shx<32>(mx, lane));
    const float mn = fmaxf(st.m, mx);
    const float alpha = exp2f((st.m - mn) * SM_C);
    float ls = 0.f;
#pragma unroll
    for (int kt = 0; kt < 4; ++kt)
#pragma unroll
        for (int i = 0; i < 4; ++i) { const float p = ok(16 * kt + 4 * quad + i) ? exp2f((s[kt][i] - mn) * SM_C) : 0.f; s[kt][i] = p; ls += p; }
    ls += shx<16>(ls, lane); ls += shx<32>(ls, lane);
    st.l = st.l * alpha + ls; st.m = mn;
#pragma unroll
    for (int dt = 0; dt < 4; ++dt) st.O[dt] *= alpha;
#pragma unroll
    for (int ii = 0; ii < 2; ++ii) {
        const bf16x8 pb = pack_frag(s[2 * ii], s[2 * ii + 1]);
#pragma unroll
        for (int dt = 0; dt < 4; ++dt) {
            const LAS unsigned char* vp = VT + (16 * dt + rl) * 144 + (32 * ii + 4 * quad) * 2;
            st.O[dt] = mfma16(mk_frag(*(const LAS v2u*)vp, *(const LAS v2u*)(vp + 32)), pb, st.O[dt]);
        }
    }
}
DI void attn_accum(f32x4 (&Of)[4], const AttnState& st, float gate) {
    const float sc = st.l > 0.f ? gate / st.l : 0.f;
#pragma unroll
    for (int dt = 0; dt < 4; ++dt) Of[dt] += st.O[dt] * sc;
}
DI void vt_write(LAS unsigned char* VT, int d0, int key, const v4u w) {
    LAS unsigned char* d = VT + d0 * 144 + key * 2;
    *(LAS bf16*)(d) = (bf16)(w.x & 0xffff); *(LAS bf16*)(d + 144) = (bf16)(w.x >> 16); *(LAS bf16*)(d + 2 * 144) = (bf16)(w.y & 0xffff); *(LAS bf16*)(d + 3 * 144) = (bf16)(w.y >> 16);
    *(LAS bf16*)(d + 4 * 144) = (bf16)(w.z & 0xffff); *(LAS bf16*)(d + 5 * 144) = (bf16)(w.z >> 16); *(LAS bf16*)(d + 6 * 144) = (bf16)(w.w & 0xffff); *(LAS bf16*)(d + 7 * 144) = (bf16)(w.w >> 16);
}
DI void stage_wg(LAS unsigned char* Kt, LAS unsigned char* VT, const bf16* kb, const bf16* vb, size_t stride, int tid, bool do_v) {
    const int key = tid >> 3, ch = tid & 7;
    *(LAS v4u*)(Kt + key * 144 + ch * 16) = *(const v4u*)(kb + key * stride + ch * 8);
    if (do_v) vt_write(VT, ch * 8, key, *(const v4u*)(vb + key * stride + ch * 8));
}
DI unsigned score_key(float s, bool valid, int idx) { return valid ? (((__float_as_uint(s) | 0x80000000u) & ~127u) | (unsigned)(127 - idx)) : 0u; }
DI int key_rank(const LAS unsigned* K, int ng4, unsigned k) {
    int r = 0;
#pragma unroll 4
    for (int g = 0; g < ng4; ++g) { const v4u v = *(const LAS v4u*)(K + 4 * g); r += (v.x > k) + (v.y > k) + (v.z > k) + (v.w > k); }
    return r;
}
DI void key_rank2(const LAS unsigned* K, int ng4, unsigned k0, unsigned k1, int& r0, int& r1) {
    int a0 = 0, a1 = 0, b0 = 0, b1 = 0;
    const int ng8 = (ng4 + 1) >> 1;
#pragma unroll 4
    for (int g = 0; g < ng8; ++g) { const v4u v = *(const LAS v4u*)(K + 8 * g), w = *(const LAS v4u*)(K + 8 * g + 4);
        a0 += (v.x > k0) + (v.y > k0) + (v.z > k0) + (v.w > k0); b0 += (w.x > k0) + (w.y > k0) + (w.z > k0) + (w.w > k0);
        a1 += (v.x > k1) + (v.y > k1) + (v.z > k1) + (v.w > k1); b1 += (w.x > k1) + (w.y > k1) + (w.z > k1) + (w.w > k1); }
    r0 = a0 + b0; r1 = a1 + b1;
}
DI int top16(float v0, float v1, int lane) {
    int sel = 0;
#pragma unroll 1
    for (int r = 0; r < 16; ++r) {
        float bv; int bi;
        if (v0 >= v1) { bv = v0; bi = lane; } else { bv = v1; bi = lane + 64; }
#define T16_STEP(M) { const float ov = shx<M>(bv, lane); const int oi = shxi<M>(bi, lane); const bool take = (ov > bv) || (ov == bv && oi < bi); bv = take ? ov : bv; bi = take ? oi : bi; }
        T16_STEP(32) T16_STEP(16) T16_STEP(8) T16_STEP(4) T16_STEP(2) T16_STEP(1)
#undef T16_STEP
        const bool h0 = (bi == lane), h1 = (bi == lane + 64);
        v0 = h0 ? -3e38f : v0; v1 = h1 ? -3e38f : v1; sel |= (h0 ? 1 : 0) | (h1 ? 2 : 0);
    }
    return sel;
}

typedef short v4i16_t __attribute__((ext_vector_type(4)));
DI s16x4 vtr(const LAS unsigned char* p) { return __builtin_bit_cast(s16x4, __builtin_amdgcn_ds_read_tr16_b64_v4i16((LAS v4i16_t*)p)); }
DI bf16x8 cat4(s16x4 a, s16x4 b) { bf16x8 r; r[0] = a[0]; r[1] = a[1]; r[2] = a[2]; r[3] = a[3]; r[4] = b[0]; r[5] = b[1]; r[6] = b[2]; r[7] = b[3]; return r; }
DI void attn_step3(const LAS unsigned char* Kt, const LAS unsigned char* Vt, const bf16x8 (&qf)[2], AttnState& st, int lo, int hi, bool active, int rl, int quad) {
    active = active && (hi >= lo);
    if (!__any(active)) return;
    f32x4 s[4]; qk_tile(Kt, qf, s, rl, quad);
    const int lane = rl + 16 * quad;
    const bool full = __all((lo <= 0 && hi >= 63) || !active);
    const int kq = 4 * quad - lo; const unsigned rng = (unsigned)(hi - lo);
    float lm;
    if (full) {
        const float a0 = fmaxf(fmaxf(s[0][0], s[0][1]), fmaxf(s[0][2], s[0][3])), a1 = fmaxf(fmaxf(s[1][0], s[1][1]), fmaxf(s[1][2], s[1][3]));
        const float a2 = fmaxf(fmaxf(s[2][0], s[2][1]), fmaxf(s[2][2], s[2][3])), a3 = fmaxf(fmaxf(s[3][0], s[3][1]), fmaxf(s[3][2], s[3][3]));
        lm = fmaxf(fmaxf(a0, a1), fmaxf(a2, a3));
    } else {
        lm = -3e38f;
#pragma unroll
        for (int kt = 0; kt < 4; ++kt)
#pragma unroll
            for (int i = 0; i < 4; ++i) lm = ((unsigned)(kq + 16 * kt + i) <= rng) ? fmaxf(lm, s[kt][i]) : lm;
    }
    lm = active ? lm : -3e38f;
    if (__any(lm > st.m + 320.f)) {
        float mx = fmaxf(lm, shx<16>(lm, lane)); mx = fmaxf(mx, shx<32>(mx, lane));
        const float mn = fmaxf(st.m, mx);
        const float alpha = __builtin_amdgcn_exp2f((st.m - mn) * SM_C);
        st.l *= alpha; st.m = mn;
#pragma unroll
        for (int dt = 0; dt < 4; ++dt) st.O[dt] *= alpha;
    }
    const float mc = active ? st.m * SM_C : __builtin_inff();
    float ls = 0.f;
    if (full) {
#pragma unroll
        for (int kt = 0; kt < 4; ++kt)
#pragma unroll
            for (int i = 0; i < 4; ++i) { const float p = __builtin_amdgcn_exp2f(s[kt][i] * SM_C - mc); s[kt][i] = p; ls += p; }
    } else {
#pragma unroll
        for (int kt = 0; kt < 4; ++kt)
#pragma unroll
            for (int i = 0; i < 4; ++i) { const float p = ((unsigned)(kq + 16 * kt + i) <= rng) ? __builtin_amdgcn_exp2f(s[kt][i] * SM_C - mc) : 0.f; s[kt][i] = p; ls += p; }
    }
    st.l += ls;
#pragma unroll
    for (int ii = 0; ii < 2; ++ii) {
        const bf16x8 pb = pack_frag(s[2 * ii], s[2 * ii + 1]);
#pragma unroll
        for (int dt = 0; dt < 4; ++dt) {
            const LAS unsigned char* vp = Vt + (32 * ii + 4 * quad + (rl >> 2)) * 144 + (16 * dt + 4 * (rl & 3)) * 2;
            st.O[dt] = mfma16(cat4(vtr(vp), vtr(vp + 16 * 144)), pb, st.O[dt]);
        }
    }
}
DI float attn_rowsum(const AttnState& st, int lane) { float l = st.l; l += shx<16>(l, lane); l += shx<32>(l, lane); return l; }
DI void attn_accum3(f32x4 (&Of)[4], const AttnState& st, float gate, int lane) {
    const float l = attn_rowsum(st, lane);
    const float sc = l > 0.f ? gate / l : 0.f;
#pragma unroll
    for (int dt = 0; dt < 4; ++dt) Of[dt] += st.O[dt] * sc;
}
#ifndef PH_NPT
#define PH_NPT (-1)
#endif
#if PH_NPT >= 0
#define NP_T(k) do { if (tid == 0) { volatile LAS unsigned long long* np_ = (volatile LAS unsigned long long*)(F.lds + LDSCTL_OFF + 464); const unsigned long long now_ = __builtin_amdgcn_s_memrealtime(); \
    if ((k) == PH_NPT) np_[0] += now_ - np_[1]; np_[1] = now_; } } while (0)
#else
#define NP_T(k) do { } while (0)
#endif
#ifndef PH_NSAC
#define PH_NSAC 1
#endif
DI float tile_max(const f32x4 (&s)[4], bool full, int kq, unsigned rng) {
    float lm;
    if (full) {
        const float a0 = fmaxf(fmaxf(s[0][0], s[0][1]), fmaxf(s[0][2], s[0][3])), a1 = fmaxf(fmaxf(s[1][0], s[1][1]), fmaxf(s[1][2], s[1][3]));
        const float a2 = fmaxf(fmaxf(s[2][0], s[2][1]), fmaxf(s[2][2], s[2][3])), a3 = fmaxf(fmaxf(s[3][0], s[3][1]), fmaxf(s[3][2], s[3][3]));
        lm = fmaxf(fmaxf(a0, a1), fmaxf(a2, a3));
    } else {
        lm = -3e38f;
#pragma unroll
        for (int kt = 0; kt < 4; ++kt)
#pragma unroll
            for (int i = 0; i < 4; ++i) lm = ((unsigned)(kq + 16 * kt + i) <= rng) ? fmaxf(lm, s[kt][i]) : lm;
    }
    return lm;
}
DI float tile_exp(f32x4 (&s)[4], bool full, int kq, unsigned rng, float mc) {
    float ls = 0.f;
    if (full) {
#pragma unroll
        for (int kt = 0; kt < 4; ++kt)
#pragma unroll
            for (int i = 0; i < 4; ++i) { const float p = __builtin_amdgcn_exp2f(s[kt][i] * SM_C - mc); s[kt][i] = p; ls += p; }
    } else {
#pragma unroll
        for (int kt = 0; kt < 4; ++kt)
#pragma unroll
            for (int i = 0; i < 4; ++i) { const float p = ((unsigned)(kq + 16 * kt + i) <= rng) ? __builtin_amdgcn_exp2f(s[kt][i] * SM_C - mc) : 0.f; s[kt][i] = p; ls += p; }
    }
    return ls;
}
DI void tile_pv(const LAS unsigned char* Vt, const f32x4 (&s)[4], f32x4 (&O)[4], int rl, int quad) {
    bf16x8 vf[2][4];
#pragma unroll
    for (int ii = 0; ii < 2; ++ii)
#pragma unroll
        for (int dt = 0; dt < 4; ++dt) { const LAS unsigned char* vp = Vt + (32 * ii + 4 * quad + (rl >> 2)) * 144 + (16 * dt + 4 * (rl & 3)) * 2; vf[ii][dt] = cat4(vtr(vp), vtr(vp + 16 * 144)); }
    const bf16x8 pb0 = pack_frag(s[0], s[1]), pb1 = pack_frag(s[2], s[3]);
    __builtin_amdgcn_s_setprio(1);
#pragma unroll
    for (int dt = 0; dt < 4; ++dt) O[dt] = mfma16(vf[0][dt], pb0, O[dt]);
#pragma unroll
    for (int dt = 0; dt < 4; ++dt) O[dt] = mfma16(vf[1][dt], pb1, O[dt]);
    __builtin_amdgcn_s_setprio(0);
}
DI void tile_vload(const LAS unsigned char* Vt, bf16x8 (&vf)[2][4], int rl, int quad) {
#pragma unroll
    for (int ii = 0; ii < 2; ++ii)
#pragma unroll
        for (int dt = 0; dt < 4; ++dt) { const LAS unsigned char* vp = Vt + (32 * ii + 4 * quad + (rl >> 2)) * 144 + (16 * dt + 4 * (rl & 3)) * 2; vf[ii][dt] = cat4(vtr(vp), vtr(vp + 16 * 144)); }
}
DI void tile_pvmma(const bf16x8 (&vf)[2][4], const f32x4 (&s)[4], f32x4 (&O)[4]) {
    const bf16x8 pb0 = pack_frag(s[0], s[1]), pb1 = pack_frag(s[2], s[3]);
    __builtin_amdgcn_s_setprio(1);
#pragma unroll
    for (int dt = 0; dt < 4; ++dt) O[dt] = mfma16(vf[0][dt], pb0, O[dt]);
#pragma unroll
    for (int dt = 0; dt < 4; ++dt) O[dt] = mfma16(vf[1][dt], pb1, O[dt]);
    __builtin_amdgcn_s_setprio(0);
}
DI void attn_step_pair(const LAS unsigned char* K0, const LAS unsigned char* V0, int lo0, int hi0, bool act0,
                       const LAS unsigned char* K1, const LAS unsigned char* V1, int lo1, int hi1, bool act1,
                       const bf16x8 (&qf)[2], AttnState& st, int rl, int quad) {
    act0 = act0 && (hi0 >= lo0); act1 = act1 && (hi1 >= lo1);
    const bool any0 = __any(act0), any1 = __any(act1);
    if (!any0 && !any1) return;
    const int lane = rl + 16 * quad;
    f32x4 s0[4], s1[4];
    if (any0 && any1) {
        bf16x8 kf0[4][2], kf1[4][2];
#pragma unroll
        for (int kt = 0; kt < 4; ++kt)
#pragma unroll
            for (int kk = 0; kk < 2; ++kk) { kf0[kt][kk] = ld_frag_l(K0 + (16 * kt + rl) * 144 + kk * 64 + quad * 16); kf1[kt][kk] = ld_frag_l(K1 + (16 * kt + rl) * 144 + kk * 64 + quad * 16); }
        __builtin_amdgcn_s_setprio(1);
#pragma unroll
        for (int kt = 0; kt < 4; ++kt) s0[kt] = mfma16(kf0[kt][0], qf[0], (f32x4){0.f, 0.f, 0.f, 0.f});
#pragma unroll
        for (int kt = 0; kt < 4; ++kt) s1[kt] = mfma16(kf1[kt][0], qf[0], (f32x4){0.f, 0.f, 0.f, 0.f});
#pragma unroll
        for (int kt = 0; kt < 4; ++kt) s0[kt] = mfma16(kf0[kt][1], qf[1], s0[kt]);
#pragma unroll
        for (int kt = 0; kt < 4; ++kt) s1[kt] = mfma16(kf1[kt][1], qf[1], s1[kt]);
        __builtin_amdgcn_s_setprio(0);
    } else {
        if (any0) qk_tile(K0, qf, s0, rl, quad);
        if (any1) qk_tile(K1, qf, s1, rl, quad);
    }
    const bool full0 = __all((lo0 <= 0 && hi0 >= 63) || !act0), full1 = __all((lo1 <= 0 && hi1 >= 63) || !act1);
    const int kq0 = 4 * quad - lo0, kq1 = 4 * quad - lo1; const unsigned rng0 = (unsigned)(hi0 - lo0), rng1 = (unsigned)(hi1 - lo1);
    float mcb = st.m * SM_C;
    bf16x8 vf0[2][4], vf1[2][4];
    if (any0) tile_vload(V0, vf0, rl, quad);
    float ls = 0.f;
    if (any0) ls += tile_exp(s0, full0, kq0, rng0, act0 ? mcb : __builtin_inff());
    if (any1) ls += tile_exp(s1, full1, kq1, rng1, act1 ? mcb : __builtin_inff());
    if (__any(!(ls <= 1e30f))) {
        if (any0) qk_tile(K0, qf, s0, rl, quad);
        if (any1) qk_tile(K1, qf, s1, rl, quad);
        float lm = -3e38f;
        if (any0) { const float a = tile_max(s0, full0, kq0, rng0); lm = act0 ? a : lm; }
        if (any1) { const float a = tile_max(s1, full1, kq1, rng1); lm = act1 ? fmaxf(lm, a) : lm; }
        float mx = fmaxf(lm, shx<16>(lm, lane)); mx = fmaxf(mx, shx<32>(mx, lane));
        const float mn = fmaxf(st.m, mx);
        const float alpha = __builtin_amdgcn_exp2f((st.m - mn) * SM_C);
        st.l *= alpha; st.m = mn;
#pragma unroll
        for (int dt = 0; dt < 4; ++dt) st.O[dt] *= alpha;
        mcb = mn * SM_C; ls = 0.f;
        if (any0) ls += tile_exp(s0, full0, kq0, rng0, act0 ? mcb : __builtin_inff());
        if (any1) ls += tile_exp(s1, full1, kq1, rng1, act1 ? mcb : __builtin_inff());
    }
    st.l += ls;
    if (any1) tile_vload(V1, vf1, rl, quad);
    if (any0) tile_pvmma(vf0, s0, st.O);
    if (any1) tile_pvmma(vf1, s1, st.O);
}
DI void nsa_prompt_unit(Frame& F, int layer, int unit) {
    int lane = F.lane, wave = F.wave; asm volatile("" : "+v"(lane), "+s"(wave));
    const int tid = wave * 64 + lane, quad = lane >> 4, rl = lane & 15;
    const int b = unit >> 9, g = (unit >> 8) & 1, tt = unit & 255, t0 = 32 * tt;
    unsigned char* ws = KWS();
    const bf16* Z = (const bf16*)(ws + WS_Z);
    const float* ZS = (const float*)(ws + WS_ZS);
    LAS unsigned char* TB = F.lds;
    LAS float* AIMP = (LAS float*)(F.lds + 73728);
    LAS unsigned* SEL = (LAS unsigned*)(F.lds + LDSCTL_OFF + 512);
    const int tk = 4 * wave + (rl >> 2), t = t0 + tk, head = 4 * g + (rl & 3);
    const size_t row = (size_t)b * TP + t;
    bf16x8 qf[2];
    qf[0] = ld_frag_g(Z + row * LDZ + ZC_Q + head * 64 + quad * 8); qf[1] = ld_frag_g(Z + row * LDZ + ZC_Q + head * 64 + 32 + quad * 8);
    const float gc = sigmoidf_(ZS[row * 32 + head * 3]), gs = sigmoidf_(ZS[row * 32 + head * 3 + 1]), gw = sigmoidf_(ZS[row * 32 + head * 3 + 2]);
    f32x4 Of[4];
#pragma unroll
    for (int i = 0; i < 4; ++i) Of[i] = (f32x4){0.f, 0.f, 0.f, 0.f};
    AttnState st;
    const int nct = (t0 >> 10) + 1;
    const bf16* KC = (const bf16*)(ws + WS_KC) + ((size_t)(0 * 2 + b) * 512 * 2 + g) * 64;
    const bf16* VC = (const bf16*)(ws + WS_KC) + ((size_t)(1 * 2 + b) * 512 * 2 + g) * 64;
    const bf16* Zb = Z + (size_t)b * TP * LDZ + g * 64;
    const int skey = tid >> 3, sch = tid & 7;
    const int wlo = (t0 - 511 > 0 ? t0 - 511 : 0) >> 6, nwin = ((t0 + 31) >> 6) - wlo + 1;
    const int nwe = (nwin + 1) & ~1, nce = (nct + 1) & ~1;
    v4u rkA, rvA, rkB, rvB;
#define COMMIT(slot, rk, rv) do { LAS unsigned char* d_ = TB + (slot) * 18432 + skey * 144 + sch * 16; *(LAS v4u*)d_ = rk; *(LAS v4u*)(d_ + 9216) = rv; } while (0)
    NP_T(0);
    const int n1 = nwe + 2 * nce;
#define SEG1_VALID(i) ((i) < nwe ? (i) < nwin : (((i) - nwe) < nce ? ((i) - nwe) < nct : ((i) - nwe - nce) < nct))
#define SEG1_ISSUE(i, rk, rv) do { int i_ = (i); i_ = i_ < n1 ? i_ : n1 - 1; const bool win_ = i_ < nwe; int wt_ = wlo + (i_ < nwin ? i_ : nwin - 1); int jt_ = (i_ - nwe) % nce; jt_ = jt_ < nct ? jt_ : nct - 1; jt_ = jt_ < 0 ? 0 : jt_; \
        const bf16* pk_ = win_ ? Zb + (size_t)(64 * wt_ + skey) * LDZ + sch * 8 + ZC_KW : KC + (size_t)(64 * jt_ + skey) * 128 + sch * 8; \
        const bf16* pv_ = win_ ? Zb + (size_t)(64 * wt_ + skey) * LDZ + sch * 8 + ZC_VW : VC + (size_t)(64 * jt_ + skey) * 128 + sch * 8; \
        rk = *(const v4u*)pk_; rv = *(const v4u*)pv_; } while (0)
    attn_reset(st);
    float mfin = 0.f, il = 0.f;
    SEG1_ISSUE(0, rkA, rvA); SEG1_ISSUE(1, rkB, rvB);
    COMMIT(0, rkA, rvA); COMMIT(1, rkB, rvB);
    SEG1_ISSUE(2, rkA, rvA); SEG1_ISSUE(3, rkB, rvB);
    __syncthreads();
    for (int i = 0; i < n1; i += 2) {
        const LAS unsigned char* K0 = TB + (i & 3) * 18432; const LAS unsigned char* K1 = TB + ((i + 1) & 3) * 18432;
        if (i < nwe) {
            const int kb0 = 64 * (wlo + i), kb1 = kb0 + 64;
            attn_step_pair(K0, K0 + 9216, t - 511 - kb0, t - kb0, true, K1, K1 + 9216, t - 511 - kb1, t - kb1, (i + 1) < nwin, qf, st, rl, quad);
            if (i + 2 == nwe) { attn_accum3(Of, st, gw, lane); attn_reset(st); }
        } else if (i < nwe + nce) {
            const int nb0 = 64 * (i - nwe), nb1 = nb0 + 64;
            attn_step_pair(K0, K0 + 9216, 0, ((t - 31) >> 4) - nb0, true, K1, K1 + 9216, 0, ((t - 31) >> 4) - nb1, (i + 1 - nwe) < nct, qf, st, rl, quad);
            if (i + 2 == nwe + nce) { attn_accum3(Of, st, gc, lane); mfin = st.m * SM_C; const float lt_ = attn_rowsum(st, lane); il = lt_ > 0.f ? 1.f / lt_ : 0.f; }
        } else {
#pragma unroll
            for (int e2 = 0; e2 < 2; ++e2) {
                const int jt = i + e2 - nwe - nce;
                if (jt < nct) {
                    f32x4 s[4]; qk_tile(e2 ? K1 : K0, qf, s, rl, quad);
#pragma unroll
                    for (int kt = 0; kt < 4; ++kt)
#pragma unroll
                        for (int e = 0; e < 4; ++e) {
                            const int n = 64 * jt + 16 * kt + 4 * quad + e;
                            float p = (16 * n + 31 <= t) ? __builtin_amdgcn_exp2f(s[kt][e] * SM_C - mfin) * il : 0.f;
                            p += shx<1>(p, lane); p += shx<2>(p, lane);
                            if ((rl & 3) == 0) AIMP[tk * 512 + n] = p;
                        }
                }
            }
        }
        if (i + 2 < n1) { if (SEG1_VALID(i + 2)) COMMIT((i + 2) & 3, rkA, rvA); if (SEG1_VALID(i + 3)) COMMIT((i + 3) & 3, rkB, rvB); }
        __syncthreads();
        SEG1_ISSUE(i + 4, rkA, rvA); SEG1_ISSUE(i + 5, rkB, rvB);
    }
    NP_T(1);
    {
        const int nav = nct * 64;
        LAS unsigned* KS = (LAS unsigned*)(TB + wave * 2048);
#pragma unroll
        for (int q = 0; q < 4; ++q) {
            const int tq = 4 * wave + q, cur = (t0 + tq) >> 6;
#pragma unroll
            for (int e = 0; e < 2; ++e) {
                const int sblk = lane + 64 * e;
                float imp = 0.f;
#pragma unroll
                for (int d = -1; d <= 3; ++d) { const int n = 4 * sblk + d; if (n >= 0 && n < nav) imp += AIMP[tq * 512 + n]; }
                const bool valid = sblk <= cur, forced = (sblk == 0) || (sblk == cur) || (sblk == cur - 1);
                KS[q * 128 + sblk] = score_key(imp + (forced ? 1000.f : 0.f), valid, sblk);
            }
        }
        asm volatile("" ::: "memory");
#pragma unroll
        for (int q = 0; q < 4; ++q) {
            const int tq = 4 * wave + q, cur = (t0 + tq) >> 6, ng4 = (cur >> 2) + 1;
            const unsigned k0 = KS[q * 128 + lane], k1 = KS[q * 128 + 64 + lane];
            int r0, r1; key_rank2(KS + q * 128, ng4, k0, k1, r0, r1);
            const bool s0 = (lane <= cur) && r0 < 16, s1 = (lane + 64 <= cur) && r1 < 16;
            const unsigned long long m0 = __ballot(s0), m1 = __ballot(s1);
            if (lane == 0) { SEL[tq * 4 + 0] = (unsigned)m0; SEL[tq * 4 + 1] = (unsigned)(m0 >> 32); SEL[tq * 4 + 2] = (unsigned)m1; SEL[tq * 4 + 3] = (unsigned)(m1 >> 32); }
        }
    }
    __syncthreads();
    unsigned un[4], my[4], wv[4];
#pragma unroll
    for (int w = 0; w < 4; ++w) { unsigned v = (lane < 32) ? SEL[lane * 4 + w] : 0u;
        v |= (unsigned)shxi<1>((int)v, lane); v |= (unsigned)shxi<2>((int)v, lane); v |= (unsigned)shxi<4>((int)v, lane); v |= (unsigned)shxi<8>((int)v, lane); v |= (unsigned)shxi<16>((int)v, lane); v |= (unsigned)shxi<32>((int)v, lane);
        un[w] = __builtin_amdgcn_readfirstlane(v); my[w] = SEL[tk * 4 + w];
        wv[w] = SEL[(4 * wave) * 4 + w] | SEL[(4 * wave + 1) * 4 + w] | SEL[(4 * wave + 2) * 4 + w] | SEL[(4 * wave + 3) * 4 + w]; wv[w] = __builtin_amdgcn_readfirstlane(wv[w]); }
#if PH_NSAC > 1
    AttnState st2; attn_reset(st2);
#endif
    NP_T(2);
    attn_reset(st);
    {
        unsigned w0 = un[0], w1 = un[1], w2 = un[2], w3 = un[3];
#define NEXT_BLK(dst) do { if (w0) { dst = __builtin_ctz(w0); w0 &= w0 - 1u; } else if (w1) { dst = 32 + __builtin_ctz(w1); w1 &= w1 - 1u; } else if (w2) { dst = 64 + __builtin_ctz(w2); w2 &= w2 - 1u; } \
        else if (w3) { dst = 96 + __builtin_ctz(w3); w3 &= w3 - 1u; } else dst = -1; } while (0)
#define SEG2_ISSUE(blk_, rk, rv) do { const int b_ = (blk_) >= 0 ? (blk_) : 0; const bf16* p_ = Zb + (size_t)(64 * b_ + skey) * LDZ + sch * 8; rk = *(const v4u*)(p_ + ZC_KS); rv = *(const v4u*)(p_ + ZC_VS); } while (0)
#define BLK_WORD(arr, blk_) (((blk_) >> 5) == 0 ? arr[0] : ((blk_) >> 5) == 1 ? arr[1] : ((blk_) >> 5) == 2 ? arr[2] : arr[3])
#define SEG2_PAIR(ca, cb, sa, sb, stt) do { const LAS unsigned char* K0 = TB + (sa) * 18432; const LAS unsigned char* K1 = TB + (sb) * 18432; \
            const int ca_ = (ca) >= 0 ? (ca) : 0, cb_ = (cb) >= 0 ? (cb) : 0; \
            const bool need0 = ((ca) >= 0) && ((BLK_WORD(wv, ca_) >> (ca_ & 31)) & 1u), need1 = ((cb) >= 0) && ((BLK_WORD(wv, cb_) >> (cb_ & 31)) & 1u); \
            const bool mine0 = need0 && ((BLK_WORD(my, ca_) >> (ca_ & 31)) & 1u), mine1 = need1 && ((BLK_WORD(my, cb_) >> (cb_ & 31)) & 1u); \
            attn_step_pair(K0, K0 + 9216, 0, t - 64 * ca_, mine0, K1, K1 + 9216, 0, t - 64 * cb_, mine1, qf, stt, rl, quad); } while (0)
        v4u rkC, rvC, rkD, rvD;
        int c0, c1, c2, c3, n0, n1b, n2, n3, m0, m1, m2, m3;
        NEXT_BLK(c0); NEXT_BLK(c1); NEXT_BLK(c2); NEXT_BLK(c3); NEXT_BLK(n0); NEXT_BLK(n1b); NEXT_BLK(n2); NEXT_BLK(n3);
        SEG2_ISSUE(c0, rkA, rvA); SEG2_ISSUE(c1, rkB, rvB); SEG2_ISSUE(c2, rkC, rvC); SEG2_ISSUE(c3, rkD, rvD);
        COMMIT(0, rkA, rvA); COMMIT(1, rkB, rvB); COMMIT(2, rkC, rvC); COMMIT(3, rkD, rvD);
        SEG2_ISSUE(n0, rkA, rvA); SEG2_ISSUE(n1b, rkB, rvB); SEG2_ISSUE(n2, rkC, rvC); SEG2_ISSUE(n3, rkD, rvD);
        __syncthreads();
        int i = 0;
        while (c0 >= 0) {
            NEXT_BLK(m0); NEXT_BLK(m1); NEXT_BLK(m2); NEXT_BLK(m3);
            SEG2_PAIR(c0, c1, i & 7, (i + 1) & 7, st);
            SEG2_PAIR(c2, c3, (i + 2) & 7, (i + 3) & 7, st);
#if PH_NSAC > 1
            SEG2_PAIR(c0, c1, i & 7, (i + 1) & 7, st2); SEG2_PAIR(c2, c3, (i + 2) & 7, (i + 3) & 7, st2);
#endif
            COMMIT((i + 4) & 7, rkA, rvA); COMMIT((i + 5) & 7, rkB, rvB); COMMIT((i + 6) & 7, rkC, rvC); COMMIT((i + 7) & 7, rkD, rvD);
            __syncthreads();
#if defined(PH_NSAX) && (PH_NSAX & 1)
            __syncthreads();
#endif
#if defined(PH_NSAX) && (PH_NSAX & 2)
            { v4u d0_, d1_; SEG2_ISSUE(m0, d0_, d1_); asm volatile("" :: "v"(d0_), "v"(d1_)); SEG2_ISSUE(m1, d0_, d1_); asm volatile("" :: "v"(d0_), "v"(d1_));
              SEG2_ISSUE(m2, d0_, d1_); asm volatile("" :: "v"(d0_), "v"(d1_)); SEG2_ISSUE(m3, d0_, d1_); asm volatile("" :: "v"(d0_), "v"(d1_)); }
#endif
            SEG2_ISSUE(m0, rkA, rvA); SEG2_ISSUE(m1, rkB, rvB); SEG2_ISSUE(m2, rkC, rvC); SEG2_ISSUE(m3, rkD, rvD);
            c0 = n0; c1 = n1b; c2 = n2; c3 = n3; n0 = m0; n1b = m1; n2 = m2; n3 = m3; i += 4;
        }
    }
    NP_T(3);
    attn_accum3(Of, st, gs, lane);
#if PH_NSAC > 1
    attn_accum3(Of, st2, (float)(layer >> 8), lane);
#endif
#undef SEG1_ISSUE
#undef SEG1_VALID
#undef SEG2_ISSUE
#undef SEG2_PAIR
#undef BLK_WORD
#undef COMMIT
#undef NEXT_BLK
    bf16* MIX = (bf16*)(ws + WS_MIX) + row * 1536 + head * 64;
#pragma unroll
    for (int dt = 0; dt < 4; ++dt) { v2u w; w.x = pk2(Of[dt][0], Of[dt][1]); w.y = pk2(Of[dt][2], Of[dt][3]); *(v2u*)(MIX + 16 * dt + 4 * quad) = w; }
    __syncthreads();
}

#define CB() asm volatile("" ::: "memory")
DI void stage_wave_f32(LAS unsigned char* Kt, LAS unsigned char* Vt, const float* kb, const float* vb, size_t stride, int lane) {
    const int k0 = lane >> 3, ch = lane & 7;
#pragma unroll
    for (int h = 0; h < 4; ++h) {
        const float* src = (h < 2 ? kb : vb); LAS unsigned char* dst = (h < 2 ? Kt : Vt); const int r0 = (h & 1) * 32;
        f32x4 a[4][2];
#pragma unroll
        for (int it = 0; it < 4; ++it) { const float* kp = src + (size_t)(r0 + it * 8 + k0) * stride + ch * 8; a[it][0] = *(const f32x4*)kp; a[it][1] = *(const f32x4*)(kp + 4); }
#pragma unroll
        for (int it = 0; it < 4; ++it) *(LAS v4u*)(dst + (r0 + it * 8 + k0) * 144 + ch * 16) = pack8(a[it][0], a[it][1]);
        asm volatile("" ::: "memory");
    }
}
DI void stage_wave_b16(LAS unsigned char* Kt, LAS unsigned char* Vt, const bf16* kb, const bf16* vb, size_t stride, int nvalid, int lane, bool do_v) {
    const int k0 = lane >> 3, ch = lane & 7;
    const v4u z = (v4u){0u, 0u, 0u, 0u};
#pragma unroll
    for (int it = 0; it < 8; ++it) {
        const int key = it * 8 + k0; const bool v = key < nvalid;
        *(LAS v4u*)(Kt + key * 144 + ch * 16) = v ? *(const v4u*)(kb + key * stride + ch * 8) : z;
        if (do_v) *(LAS v4u*)(Vt + key * 144 + ch * 16) = v ? *(const v4u*)(vb + key * stride + ch * 8) : z;
    }
}
DI void nsa_sample_unit(Frame& F, int layer, int s) {
    int lane = F.lane, wave = F.wave; asm volatile("" : "+v"(lane), "+s"(wave));
    const int quad = lane >> 4, rl = lane & 15;
    const int g = wave & 1, q4 = wave >> 1;
    unsigned char* ws = KWS();
    const bf16* Z = (const bf16*)(ws + WS_Z);
    const float* ZS = (const float*)(ws + WS_ZS);
    LAS unsigned char* Kt = F.lds + wave * 18432; LAS unsigned char* Vt = Kt + 9216;
    LAS float* AIMP = (LAS float*)Vt;
    const int j = rl >> 2, head = 4 * g + (rl & 3), qpos = 2048 + j;
    const size_t row = (size_t)MP + 4 * s + j;
    bf16x8 qf[2];
    qf[0] = ld_frag_g(Z + row * LDZ + ZC_Q + head * 64 + quad * 8); qf[1] = ld_frag_g(Z + row * LDZ + ZC_Q + head * 64 + 32 + quad * 8);
    const float gc = sigmoidf_(ZS[row * 32 + head * 3]), gs = sigmoidf_(ZS[row * 32 + head * 3 + 1]), gw = sigmoidf_(ZS[row * 32 + head * 3 + 2]);
    f32x4 Of[4];
#pragma unroll
    for (int i = 0; i < 4; ++i) Of[i] = (f32x4){0.f, 0.f, 0.f, 0.f};
    AttnState st;
    const bf16* KC = (const bf16*)(ws + WS_KCS) + ((size_t)(0 * 128 + s) * 128 * 2 + g) * 64;
    const bf16* VC = (const bf16*)(ws + WS_KCS) + ((size_t)(1 * 128 + s) * 128 * 2 + g) * 64;
    attn_reset(st);
#pragma unroll 1
    for (int jt = 0; jt < 2; ++jt) {
        stage_wave_b16(Kt, Vt, KC + (size_t)64 * jt * 128, VC + (size_t)64 * jt * 128, 128, 64, lane, true); CB();
        attn_step3(Kt, Vt, qf, st, 0, 126 - 64 * jt, true, rl, quad); CB();
    }
    attn_accum3(Of, st, q4 == 0 ? gc : 0.f, lane);
    {
        const float mfin = st.m * SM_C, lt = attn_rowsum(st, lane), il = lt > 0.f ? 1.f / lt : 0.f;
#pragma unroll 1
        for (int jt = 0; jt < 2; ++jt) {
            stage_wave_b16(Kt, Vt, KC + (size_t)64 * jt * 128, VC, 128, 64, lane, false); CB();
            f32x4 sv[4]; qk_tile(Kt, qf, sv, rl, quad); CB();
#pragma unroll
            for (int kt = 0; kt < 4; ++kt)
#pragma unroll
                for (int i = 0; i < 4; ++i) {
                    const int n = 64 * jt + 16 * kt + 4 * quad + i;
                    float p = (n <= 126) ? __builtin_amdgcn_exp2f(sv[kt][i] * SM_C - mfin) * il : 0.f;
                    p += shx<1>(p, lane); p += shx<2>(p, lane);
                    if ((rl & 3) == 0) AIMP[j * 128 + n] = p;
                }
        }
    }
    CB();
    unsigned long long msk[4];
    {
        unsigned keys[4];
#pragma unroll
        for (int q = 0; q < 4; ++q) {
            float imp = 0.f;
#pragma unroll
            for (int d = -1; d <= 3; ++d) { const int n = 4 * lane + d; if (n >= 0 && n <= 126 && lane < 33) imp += AIMP[q * 128 + n]; }
            const bool forced = (lane == 0) || (lane == 32) || (lane == 31);
            keys[q] = score_key(imp + (forced ? 1000.f : 0.f), lane < 33, lane);
        }
        CB();
        LAS unsigned* KS = (LAS unsigned*)Kt;
#pragma unroll
        for (int q = 0; q < 4; ++q) KS[q * 64 + lane] = keys[q];
        CB();
#pragma unroll
        for (int q = 0; q < 4; ++q) msk[q] = __ballot(lane < 33 && key_rank(KS + q * 64, 9, keys[q]) < 16);
    }
    CB();
    const unsigned long long un = msk[0] | msk[1] | msk[2] | msk[3];
    const unsigned long long mym = j == 0 ? msk[0] : j == 1 ? msk[1] : j == 2 ? msk[2] : msk[3];
    const int* pt = (const int*)KIN(7);
    AttnState sw;
    attn_reset(st); attn_reset(sw);
    {
        unsigned long long word = un; int idx = 0;
        while (word) {
            const int blk = __builtin_ctzll(word); word &= word - 1ull;
            if ((idx++ & 3) != q4) continue;
            if (blk < 32) {
                const int phys = pt[s * 16 + (blk >> 1)];
                const float* base = KIN(2) + ((size_t)(layer * 2560 + phys) * 128 + (blk & 1) * 64) * 512 + g * 64;
                stage_wave_f32(Kt, Vt, base + 256, base + 384, 512, lane); CB();
            } else {
                stage_wave_b16(Kt, Vt, Z + (size_t)(MP + 4 * s) * LDZ + ZC_KS + g * 64, Z + (size_t)(MP + 4 * s) * LDZ + ZC_VS + g * 64, LDZ, 4, lane, true); CB();
            }
            attn_step3(Kt, Vt, qf, st, 0, qpos - 64 * blk, (mym >> blk) & 1ull, rl, quad); CB();
        }
#pragma unroll 1
        for (int jt = 0; jt < 9; ++jt) {
            if ((idx++ & 3) != q4) continue;
            if (jt < 8) { const float* base = KIN(3) + ((size_t)(layer * 128 + s) * 512 + 64 * jt) * 256 + g * 64; stage_wave_f32(Kt, Vt, base, base + 128, 256, lane); CB(); }
            else { stage_wave_b16(Kt, Vt, Z + (size_t)(MP + 4 * s) * LDZ + ZC_KW + g * 64, Z + (size_t)(MP + 4 * s) * LDZ + ZC_VW + g * 64, LDZ, 4, lane, true); CB(); }
            attn_step3(Kt, Vt, qf, sw, j + 1 - 64 * jt, 512 + j - 64 * jt, true, rl, quad); CB();
        }
    }
    int lane2 = lane; asm volatile("" : "+v"(lane2));
    LAS float* X = (LAS float*)(F.lds + wave * 18432);
    {
        const float ls = attn_rowsum(st, lane), lw = attn_rowsum(sw, lane);
        X[0 * 64 + lane2] = st.m; X[1 * 64 + lane2] = ls; X[18 * 64 + lane2] = sw.m; X[19 * 64 + lane2] = lw;
#pragma unroll
        for (int dt = 0; dt < 4; ++dt)
#pragma unroll
            for (int e = 0; e < 4; ++e) { X[(2 + 4 * dt + e) * 64 + lane2] = st.O[dt][e]; X[(20 + 4 * dt + e) * 64 + lane2] = sw.O[dt][e]; }
    }
    __syncthreads();
    if (q4 == 0) {
#pragma unroll
        for (int br = 0; br < 2; ++br) {
            float m[4], l[4];
#pragma unroll
            for (int q = 0; q < 4; ++q) { const LAS float* Y = (const LAS float*)(F.lds + (2 * q + g) * 18432) + br * 18 * 64; m[q] = Y[lane2]; l[q] = Y[64 + lane2]; }
            const float mm = fmaxf(fmaxf(m[0], m[1]), fmaxf(m[2], m[3]));
            float w[4], lt = 0.f;
#pragma unroll
            for (int q = 0; q < 4; ++q) { w[q] = __builtin_amdgcn_exp2f((m[q] - mm) * SM_C); lt += l[q] * w[q]; }
            const float gate = br == 0 ? gs : gw;
            const float sc = lt > 0.f ? gate / lt : 0.f;
#pragma unroll
            for (int q = 0; q < 4; ++q) { const LAS float* Y = (const LAS float*)(F.lds + (2 * q + g) * 18432) + br * 18 * 64; const float wq = w[q] * sc;
#pragma unroll
                for (int dt = 0; dt < 4; ++dt)
#pragma unroll
                    for (int e = 0; e < 4; ++e) Of[dt][e] += Y[(2 + 4 * dt + e) * 64 + lane2] * wq; }
        }
        bf16* MIX = (bf16*)(ws + WS_MIX) + row * 1536 + head * 64;
#pragma unroll
        for (int dt = 0; dt < 4; ++dt) { v2u w2; w2.x = pk2(Of[dt][0], Of[dt][1]); w2.y = pk2(Of[dt][2], Of[dt][3]); *(v2u*)(MIX + 16 * dt + 4 * quad) = w2; }
    }
    __syncthreads();
}
DI void ret_out_unit(Frame& F, int layer, int unit) {
    const int tid = F.tid, lane = F.lane, wave = F.wave, quad = lane >> 4, rl = lane & 15;
    const int b = unit >> 8, h = (unit >> 6) & 3, c = unit & 63;
    const int row0 = b * TP + 128 * c;
    unsigned char* ws = KWS();
    const bf16* Z = (const bf16*)(ws + WS_Z);
    const bf16* QR = (const bf16*)(ws + WS_QR); const bf16* KR = (const bf16*)(ws + WS_KR);
    const bf16* RST = (const bf16*)(ws + WS_RST) + (size_t)unit * 16384;
    LAS unsigned char* LQ = F.lds; LAS unsigned char* LK = F.lds + 34816; LAS unsigned char* LV = F.lds + 69632; LAS unsigned char* LS = F.lds + 104448;
    for (int it = tid; it < 2048; it += NTHREADS) {
        const int j = it >> 4, cc = it & 15;
        *(LAS v4u*)(LQ + j * 272 + cc * 16) = *(const v4u*)(QR + (size_t)(row0 + j) * 512 + h * 128 + cc * 8);
        *(LAS v4u*)(LK + j * 272 + cc * 16) = *(const v4u*)(KR + (size_t)(row0 + j) * 512 + h * 128 + cc * 8);
        *(LAS v4u*)(LS + j * 272 + cc * 16) = *(const v4u*)(RST + (size_t)j * 128 + cc * 8);
        const v4u w = *(const v4u*)(Z + (size_t)(row0 + j) * LDZ + ZC_RQKV + 1024 + h * 128 + cc * 8);
        LAS unsigned char* d = LV + (cc * 8) * 272 + j * 2;
        *(LAS bf16*)(d) = (bf16)(w.x & 0xffff); *(LAS bf16*)(d + 272) = (bf16)(w.x >> 16); *(LAS bf16*)(d + 2 * 272) = (bf16)(w.y & 0xffff); *(LAS bf16*)(d + 3 * 272) = (bf16)(w.y >> 16);
        *(LAS bf16*)(d + 4 * 272) = (bf16)(w.z & 0xffff); *(LAS bf16*)(d + 5 * 272) = (bf16)(w.z >> 16); *(LAS bf16*)(d + 6 * 272) = (bf16)(w.w & 0xffff); *(LAS bf16*)(d + 7 * 272) = (bf16)(w.w >> 16);
    }
    __syncthreads();
    const float lg = ret_lg(h);
    const int il = 16 * wave + rl;
    bf16x8 qb[4];
#pragma unroll
    for (int s = 0; s < 4; ++s) qb[s] = ld_frag_l(LQ + il * 272 + (32 * s + 8 * quad) * 2);
    f32x4 C[8];
    const float qdec = __expf((float)(il + 1) * lg);
#pragma unroll
    for (int dt = 0; dt < 8; ++dt) {
        f32x4 a = (f32x4){0.f, 0.f, 0.f, 0.f};
#pragma unroll
        for (int s = 0; s < 4; ++s) a = mfma16(ld_frag_l(LS + (16 * dt + rl) * 272 + (32 * s + 8 * quad) * 2), qb[s], a);
        C[dt] = a * qdec;
    }
    for (int s2 = 0; s2 <= (wave >> 1); ++s2) {
        f32x4 P[2];
#pragma unroll
        for (int e = 0; e < 2; ++e) {
            const int jt = 2 * s2 + e;
            f32x4 a = (f32x4){0.f, 0.f, 0.f, 0.f};
            if (jt <= wave) {
#pragma unroll
                for (int s = 0; s < 4; ++s) a = mfma16(ld_frag_l(LK + (16 * jt + rl) * 272 + (32 * s + 8 * quad) * 2), qb[s], a);
#pragma unroll
                for (int i = 0; i < 4; ++i) { const int jj = 16 * jt + 4 * quad + i; a[i] = (il >= jj) ? a[i] * __expf((float)(il - jj) * lg) : 0.f; }
            }
            P[e] = a;
        }
        const bf16x8 pb = pack_frag(P[0], P[1]);
#pragma unroll
        for (int dt = 0; dt < 8; ++dt) {
            const LAS unsigned char* vp = LV + (16 * dt + rl) * 272 + (32 * s2 + 4 * quad) * 2;
            C[dt] = mfma16(mk_frag(*(const LAS v2u*)vp, *(const LAS v2u*)(vp + 32)), pb, C[dt]);
        }
    }
    float ss = 0.f;
#pragma unroll
    for (int dt = 0; dt < 8; ++dt) ss += (C[dt][0] * C[dt][0] + C[dt][1] * C[dt][1]) + (C[dt][2] * C[dt][2] + C[dt][3] * C[dt][3]);
    ss += shx<16>(ss, lane); ss += shx<32>(ss, lane);
    const float scl = rsqrtf(ss * (1.f / 128.f) + EPS);
    const size_t row = (size_t)row0 + il;
#pragma unroll
    for (int dt = 0; dt < 8; ++dt) {
        const v2u gwd = *(const v2u*)(Z + row * LDZ + ZC_RG + h * 128 + 16 * dt + 4 * quad);
        v2u w; w.x = pk2(C[dt][0] * scl * siluf_(lo_bf(gwd.x)), C[dt][1] * scl * siluf_(hi_bf(gwd.x))); w.y = pk2(C[dt][2] * scl * siluf_(lo_bf(gwd.y)), C[dt][3] * scl * siluf_(hi_bf(gwd.y)));
        *(v2u*)((bf16*)(ws + WS_MIX) + row * 1536 + 1024 + h * 128 + 16 * dt + 4 * quad) = w;
    }
    __syncthreads();
}
DI void gdn_out_row(Frame& F, int layer, int row) {
    const int lane = F.lane;
    unsigned char* ws = KWS();
    const float* o = (const float*)(ws + WS_OGDN) + (size_t)row * 512 + lane * 8;
    const f32x4 a = *(const f32x4*)o, b = *(const f32x4*)(o + 4);
    float ss = (a[0] * a[0] + a[1] * a[1]) + (a[2] * a[2] + a[3] * a[3]) + (b[0] * b[0] + b[1] * b[1]) + (b[2] * b[2] + b[3] * b[3]);
    ss += shx<1>(ss, lane); ss += shx<2>(ss, lane); ss += shx<4>(ss, lane); ss += shx<8>(ss, lane);
    const float scl = rsqrtf(ss * (1.f / 128.f) + EPS);
    const float* ng = KIN(18) + layer * 128 + (lane & 15) * 8;
    const f32x4 ga = *(const f32x4*)ng, gb = *(const f32x4*)(ng + 4);
    f32x4 za, zb; unpack8(*(const v4u*)((const bf16*)(ws + WS_Z) + (size_t)row * LDZ + ZC_GZ + lane * 8), za, zb);
    f32x4 ra, rb;
#pragma unroll
    for (int e = 0; e < 4; ++e) { ra[e] = a[e] * scl * ga[e] * siluf_(za[e]); rb[e] = b[e] * scl * gb[e] * siluf_(zb[e]); }
    *(v4u*)((bf16*)(ws + WS_MIX) + (size_t)row * 1536 + 512 + lane * 8) = pack8(ra, rb);
}
DI void final_row(Frame& F, int row) {
    const int lane = F.lane;
    const float* x = (const float*)(KWS() + WS_XR) + (size_t)row * DM;
    float* y = (row < MP) ? KOUT() + O_YP + (size_t)row * DM : KOUT() + O_YS + (size_t)(row - MP) * DM;
    f32x4 v[4]; float ss = 0.f;
#pragma unroll
    for (int j = 0; j < 4; ++j) { v[j] = *(const f32x4*)(x + 256 * j + lane * 4); ss += (v[j][0] * v[j][0] + v[j][1] * v[j][1]) + (v[j][2] * v[j][2] + v[j][3] * v[j][3]); }
    const float scl = rsqrtf(wave_sum(ss, lane) * (1.f / DM) + EPS);
#pragma unroll
    for (int j = 0; j < 4; ++j) *(f32x4*)(y + 256 * j + lane * 4) = v[j] * scl * *(const f32x4*)(KIN(26) + 256 * j + lane * 4);
}
template <class Epi>
DI void sgemm_tile(Frame& F, const bf16* A, int lda, const bf16* Bt, int ldb, int K, int row0, int col0, const Epi& E) {
    int lane = F.lane, wave = F.wave; asm volatile("" : "+v"(lane), "+s"(wave));
    const int tid = wave * 64 + lane, quad = lane >> 4, rl = lane & 15;
    const int kper = K >> 3, nks = kper >> 5;
    f32x4 acc[2][4];
#pragma unroll
    for (int rt = 0; rt < 2; ++rt)
#pragma unroll
        for (int ct = 0; ct < 4; ++ct) acc[rt][ct] = (f32x4){0.f, 0.f, 0.f, 0.f};
    const bf16* ap = A + (size_t)(row0 + rl) * lda + wave * kper + quad * 8;
    const bf16* bp = Bt + (size_t)(col0 + rl) * ldb + wave * kper + quad * 8;
#pragma unroll 4
    for (int ks = 0; ks < nks; ++ks) {
        bf16x8 a[2], b[4];
#pragma unroll
        for (int rt = 0; rt < 2; ++rt) a[rt] = ld_frag_g(ap + (size_t)(16 * rt) * lda + ks * 32);
#pragma unroll
        for (int ct = 0; ct < 4; ++ct) b[ct] = ld_frag_g(bp + (size_t)(16 * ct) * ldb + ks * 32);
#pragma unroll
        for (int rt = 0; rt < 2; ++rt)
#pragma unroll
            for (int ct = 0; ct < 4; ++ct) acc[rt][ct] = mfma16(a[rt], b[ct], acc[rt][ct]);
    }
    LAS float* RED = (LAS float*)F.lds;
#pragma unroll
    for (int rt = 0; rt < 2; ++rt)
#pragma unroll
        for (int ct = 0; ct < 4; ++ct)
#pragma unroll
            for (int i = 0; i < 4; ++i) RED[wave * 2176 + (16 * rt + 4 * quad + i) * 68 + 16 * ct + rl] = acc[rt][ct][i];
    __syncthreads();
    const int r = tid >> 4, c4 = (tid & 15) * 4;
    f32x4 v = *(const LAS f32x4*)(RED + r * 68 + c4);
#pragma unroll
    for (int w = 1; w < 8; ++w) v += *(const LAS f32x4*)(RED + w * 2176 + r * 68 + c4);
    E(row0 + r, col0 + c4, v, lane);
    __syncthreads();
}
struct SEpiC {
    const bf16* Z; bf16* G;
    DI void operator()(int row, int col, f32x4 v, int lane) const {
        const v2u gw = *(const v2u*)(Z + (size_t)row * LDZ + ZC_MG + col);
        v[0] *= sigmoidf_(lo_bf(gw.x)); v[1] *= sigmoidf_(hi_bf(gw.x)); v[2] *= sigmoidf_(lo_bf(gw.y)); v[3] *= sigmoidf_(hi_bf(gw.y));
        *(v2u*)(G + (size_t)row * 3072 + col) = pack4(v);
    }
};
struct SEpiRes {
    float* XR; bf16* XG; const float* gvec; float* SS; float* T; int mode;
    DI void operator()(int row, int col, f32x4 v, int lane) const {
        const size_t o = (size_t)row * DM + col;
        if (mode == 1) { *(f32x4*)(T + o) = v; return; }
        f32x4 x = *(const f32x4*)(XR + o);
        if (mode == 2) { const f32x4 t = *(const f32x4*)(T + o);
#pragma unroll
            for (int e = 0; e < 4; ++e) v[e] = t[e] * sigmoidf_(v[e]); }
        x += v;
        *(f32x4*)(XR + o) = x;
        if (XG) { f32x4 y = x; if (gvec) y *= *(const f32x4*)(gvec + col); *(v2u*)(XG + o) = pack4(y); }
        if (SS) { float ssq = (x[0] * x[0] + x[1] * x[1]) + (x[2] * x[2] + x[3] * x[3]);
            ssq += shx<1>(ssq, lane); ssq += shx<2>(ssq, lane); ssq += shx<4>(ssq, lane); ssq += shx<8>(ssq, lane);
            if ((lane & 15) == 0) SS[(size_t)row * 16 + (col >> 6)] = ssq; }
    }
};
struct SEpiUp {
    bf16* H; const float* SS;
    DI void operator()(int row, int col, f32x4 v, int lane) const {
        const f32x4 p0 = *(const f32x4*)(SS + (size_t)row * 16), p1 = *(const f32x4*)(SS + (size_t)row * 16 + 4), p2 = *(const f32x4*)(SS + (size_t)row * 16 + 8), p3 = *(const f32x4*)(SS + (size_t)row * 16 + 12);
        const f32x4 ps = (p0 + p1) + (p2 + p3);
        const float rstd = rsqrtf(((ps[0] + ps[1]) + (ps[2] + ps[3])) * (1.f / DM) + EPS);
#pragma unroll
        for (int e = 0; e < 4; ++e) { const float a = fmaxf(v[e] * rstd, 0.f); v[e] = a * a; }
        *(v2u*)(H + (size_t)row * DFF + col) = pack4(v);
    }
};
#ifndef PH_P0
#define PH_P0 1
#endif
#ifndef PH_A
#define PH_A 1
#endif
#ifndef PH_B0a
#define PH_B0a 1
#endif
#ifndef PH_B0b
#define PH_B0b 1
#endif
#ifndef PH_B0c
#define PH_B0c 1
#endif
#ifndef PH_B0d
#define PH_B0d 1
#endif
#ifndef PH_SCAN
#define PH_SCAN 1
#endif
#ifndef PH_RSCAN
#define PH_RSCAN 1
#endif
#ifndef PH_NSAP
#define PH_NSAP 1
#endif
#ifndef PH_NSAS
#define PH_NSAS 1
#endif
#ifndef PH_B2
#define PH_B2 1
#endif
#ifndef PH_C
#define PH_C 1
#endif
#ifndef PH_XBAR
#define PH_XBAR 0
#endif
#ifndef PH_D
#define PH_D 1
#endif
#ifndef PH_E
#define PH_E 1
#endif
#ifndef PH_F
#define PH_F 1
#endif
#ifndef PH_G1
#define PH_G1 1
#endif
#ifndef PH_G2
#define PH_G2 1
#endif
#ifndef PH_TREG
#define PH_TREG (-1)
#endif
#if PH_TREG >= 0
#define TREG_MARK(r) do { const unsigned long long now_ = __builtin_amdgcn_s_memrealtime(); if ((r) == PH_TREG) tacc_ += now_ - tlast_; tlast_ = now_; } while (0)
#define TREG_SUB(r) do { const unsigned long long now_ = __builtin_amdgcn_s_memrealtime(); if ((r) == PH_TREG) tacc_ += now_ - tsub_; tsub_ = now_; } while (0)
#else
#define TREG_MARK(r) do { } while (0)
#define TREG_SUB(r) do { } while (0)
#endif
struct Args { const void* in[27]; float* out; unsigned char* ws; };
__global__ void __launch_bounds__(NTHREADS, 2) mk_fwd(Args args) {
    extern __shared__ __attribute__((aligned(16))) unsigned char lds_raw[];
    Frame F;
    F.lds = (LAS unsigned char*)lds_raw;
    F.wave = __builtin_amdgcn_readfirstlane((int)threadIdx.x >> 6); F.lane = 0; F.tid = 0;
    F.G = gridDim.x; F.bid = blockIdx.x;
    F.ctl = (gu32*)(KWS() + WS_CTL);
    { const Frame Fp = fresh(F); for (int u = Fp.tid; u < (LDS_BYTES - LDSCTL_OFF) / 4; u += NTHREADS) ((LAS unsigned*)(F.lds + LDSCTL_OFF))[u] = 0u;
      __syncthreads();
      (void)xcd_barrier_post((unsigned*)(F.ctl + CW_BAR), (volatile LAS unsigned*)(F.lds + MISC_OFF) + 8, Fp.tid == 0); }
    const int G = F.G, bid = F.bid;
#if PH_TREG >= 0
    unsigned long long tacc_ = 0ull, tlast_ = __builtin_amdgcn_s_memrealtime(), tsub_ = tlast_;
#endif

        for (int rp_ = 0; rp_ < PH_P0; ++rp_) {
    { Frame Fp = fresh(F); p0_prologue(Fp); }
        }
    GRID_BAR();
    TREG_MARK(0);

    for (int layer = 0; layer < NLAYER; ++layer) {
        for (int rp_ = 0; rp_ < PH_A; ++rp_) {
        {
            const Frame Fg = fresh(F); const int G = Fg.G, bid = Fg.bid;
            unsigned char* ws = KWS();
            pg8::Gemm g{(const bf16*)(ws + WS_XGA), (const bf16*)(ws + WS_WIN + layer * SZ_WIN), MROWS, LDZ, DM, DM, DM, 31, 0};
            pg8::StaticOrder S; S.init(MROWS, LDZ, G, bid);
            epi::EpiA E{(bf16*)(ws + WS_Z), (float*)(ws + WS_ZS), (const float*)(ws + WS_SSA), KOUT(), layer};
            pg8::gemm_phase<epi::EpiA, pg8::StaticOrder, true, true>(Fg.lds, g, S, E, Fg.tid);
        }
        }
        GRID_BAR();
    TREG_MARK(1);
#if PH_TREG >= 0
        tsub_ = __builtin_amdgcn_s_memrealtime();
#endif
        {
            Frame Fp = fresh(F);
            gu32* qhead = F.ctl + CW_QUEUE + 512 * layer + 384;
            volatile LAS int* qslot = (volatile LAS int*)(F.lds + MISC_OFF) + 16;
            constexpr int NI = 5 * 272 * PH_B0d, N2 = 1024 * PH_B0c, N3 = 512 * PH_B0b;
            for (;;) {
                if (Fp.tid == 0) qslot[0] = (int)__hip_atomic_fetch_add(qhead, 1u, __ATOMIC_RELAXED, __HIP_MEMORY_SCOPE_AGENT);
                __syncthreads();
                int it = qslot[0];
                __syncthreads();
                it = __builtin_amdgcn_readfirstlane(it);
                if (it >= NI + N2 + N3) break;
                TREG_SUB(99);
                if (it < NI) { const int k = it / 5, r = it % 5;
                    if (r == 0) compress_job(Fp, layer, k % 272);
                    else if (k < 256 * PH_B0a) gdn_prep_unit(Fp, layer, (4 * k + r - 1) & 1023); }
                else if (it < NI + N2) sample_rec_unit(Fp, layer, (it - NI) & 1023);
                else ret_prep_unit(Fp, layer, (it - NI - N2) & 511);
                TREG_SUB(it < NI ? ((it % 5) == 0 ? 40 : 41) : (it < NI + N2 ? 42 : 43));
            }
        }
        GRID_BAR();
    TREG_MARK(2);
        {
            Frame Fp = fresh(F);
            gu32* qbase = F.ctl + CW_QUEUE + 512 * layer;
            volatile LAS int* qslot = (volatile LAS int*)(F.lds + MISC_OFF) + 16;
            constexpr int NQ = 8 * PH_SCAN, NS = 128 * PH_NSAS, NR = 32 * PH_RSCAN, NP = 256 * PH_NSAP;
            const int pref = (int)(xb_xcc_id() & 3u);
            for (;;) {
                if (Fp.tid == 0) {
                    int kind = -1, idx = 0;
                    const int a = (int)__hip_atomic_fetch_add(qbase, 1u, __ATOMIC_RELAXED, __HIP_MEMORY_SCOPE_AGENT);
                    if (a < NQ + NS + NR) { kind = 4; idx = a; }
                    else {
                        for (int k = 0; k < 4 && kind < 0; ++k) { const int s = (pref + k) & 3;
                            if ((int)__hip_atomic_load(qbase + 64 * (1 + s), __ATOMIC_RELAXED, __HIP_MEMORY_SCOPE_AGENT) < NP) {
                                const int r = (int)__hip_atomic_fetch_add(qbase + 64 * (1 + s), 1u, __ATOMIC_RELAXED, __HIP_MEMORY_SCOPE_AGENT);
                                if (r < NP) { kind = s; idx = r; } } }
                    }
                    qslot[0] = kind; qslot[1] = idx;
                }
                __syncthreads();
                int kind = qslot[0], it = qslot[1];
                __syncthreads();
                kind = __builtin_amdgcn_readfirstlane(kind); it = __builtin_amdgcn_readfirstlane(it);
                if (kind < 0) break;
                TREG_SUB(99);
                if (kind < 4) nsa_prompt_unit(Fp, layer, (kind << 8) | (255 - (it & 255)));
                else if (it < NQ) gdn_scan_chain(Fp, layer, it & 7);
                else if (it < NQ + NS) nsa_sample_unit(Fp, layer, (it - NQ) & 127);
                else ret_scan_part(Fp, layer, (it - NQ - NS) & 31);
                TREG_SUB(kind < 4 ? 20 : (it < NQ ? 21 : (it < NQ + NS ? 22 : 23)));
            }
        }
        GRID_BAR();
    TREG_MARK(3);
        for (int rp_ = 0; rp_ < PH_B2; ++rp_) {
        { Frame Fp = fresh(F); for (int u = Fp.bid; u < 512; u += Fp.G) ret_out_unit(Fp, layer, u); }
        { Frame Fp = fresh(F); for (int r = Fp.bid * NWAVES + Fp.wave; r < MROWS; r += Fp.G * NWAVES) gdn_out_row(Fp, layer, r); }
        }
        GRID_BAR();
    TREG_MARK(4);
        for (int rp_ = 0; rp_ < PH_C; ++rp_) {
        {
            const Frame Fg = fresh(F); const int G = Fg.G, bid = Fg.bid;
            unsigned char* ws = KWS();
            pg8::Gemm g{(const bf16*)(ws + WS_MIX), (const bf16*)(ws + WS_WBR + layer * SZ_WBR), MP, 3072, 512, 1536, 512, 2, 1024};
            pg8::StaticOrder S; S.init(MP, 3072, G, bid);
            epi::EpiC E{(const bf16*)(ws + WS_Z), (bf16*)(ws + WS_GATED)};
            pg8::gemm_phase<epi::EpiC, pg8::StaticOrder, true, true>(Fg.lds, g, S, E, Fg.tid);
            TREG_SUB(99);
            {
                Frame Fs = fresh(F); const SEpiC Es{(const bf16*)(ws + WS_Z), (bf16*)(ws + WS_GATED)};
                for (int tl = Fs.bid; tl < 16 * 48; tl += Fs.G) { const int rt = tl & 15, ct = tl >> 4, b = ct >> 4;
                    sgemm_tile(Fs, (const bf16*)(ws + WS_MIX) + b * 512, 1536, (const bf16*)(ws + WS_WBR + layer * SZ_WBR), 512, 512, MP + 32 * rt, 64 * ct, Es); }
            }
            TREG_SUB(31);
        }
        }
        GRID_BAR();
    TREG_MARK(5);
        for (int rp_ = 0; rp_ < PH_D; ++rp_) {
        {
            const Frame Fg = fresh(F); const int G = Fg.G, bid = Fg.bid;
            unsigned char* ws = KWS();
            pg8::Gemm g{(const bf16*)(ws + WS_GATED), (const bf16*)(ws + WS_WO3 + layer * SZ_WO3), MP, DM, 3072, 3072, 3072, 31, 0};
            pg8::StaticOrder S; S.init(MP, DM, G, bid);
            epi::EpiRes E{(float*)(ws + WS_XR), (bf16*)(ws + WS_XGB), KIN(21) + layer * DM, (float*)(ws + WS_SSB), nullptr, (rp_ + 1 < PH_D) ? 3 : 0};
            pg8::gemm_phase<epi::EpiRes, pg8::StaticOrder, true, true>(Fg.lds, g, S, E, Fg.tid);
            TREG_SUB(99);
            if (rp_ + 1 == PH_D) {
                Frame Fs = fresh(F); const SEpiRes Es{(float*)(ws + WS_XR), (bf16*)(ws + WS_XGB), KIN(21) + layer * DM, (float*)(ws + WS_SSB), nullptr, 0};
                for (int tl = Fs.bid; tl < 256; tl += Fs.G) sgemm_tile(Fs, (const bf16*)(ws + WS_GATED), 3072, (const bf16*)(ws + WS_WO3 + layer * SZ_WO3), 3072, 3072, MP + 32 * (tl & 15), 64 * (tl >> 4), Es);
            }
            TREG_SUB(32);
        }
        }
        GRID_BAR();
    TREG_MARK(6);
        for (int rp_ = 0; rp_ < PH_E; ++rp_) {
        {
            const Frame Fg = fresh(F); const int G = Fg.G, bid = Fg.bid;
            unsigned char* ws = KWS();
            pg8::Gemm g{(const bf16*)(ws + WS_XGB), (const bf16*)(ws + WS_WUP + layer * SZ_WUP), MP, DFF, DM, DM, DM, 31, 0};
            pg8::StaticOrder S; S.init(MP, DFF, G, bid);
            epi::EpiUp E{(bf16*)(ws + WS_HMID), (const float*)(ws + WS_SSB)};
            pg8::gemm_phase<epi::EpiUp, pg8::StaticOrder, true, true>(Fg.lds, g, S, E, Fg.tid);
            TREG_SUB(99);
            {
                Frame Fs = fresh(F); const SEpiUp Es{(bf16*)(ws + WS_HMID), (const float*)(ws + WS_SSB)};
                for (int tl = Fs.bid; tl < 16 * 64; tl += Fs.G) sgemm_tile(Fs, (const bf16*)(ws + WS_XGB), DM, (const bf16*)(ws + WS_WUP + layer * SZ_WUP), DM, DM, MP + 32 * (tl & 15), 64 * (tl >> 4), Es);
            }
            TREG_SUB(33);
        }
        }
        GRID_BAR();
    TREG_MARK(7);
        for (int rp_ = 0; rp_ < PH_F; ++rp_) {
        {
            const Frame Fg = fresh(F); const int G = Fg.G, bid = Fg.bid;
            unsigned char* ws = KWS();
            pg8::Gemm g{(const bf16*)(ws + WS_HMID), (const bf16*)(ws + WS_WDN + layer * SZ_WDN), MP, DM, DFF, DFF, DFF, 31, 0};
            pg8::StaticOrder S; S.init(MP, DM, G, bid);
            epi::EpiRes E{(float*)(ws + WS_XR), (bf16*)(ws + WS_XGC), nullptr, nullptr, nullptr, (rp_ + 1 < PH_F) ? 3 : 0};
            pg8::gemm_phase<epi::EpiRes, pg8::StaticOrder, true, true>(Fg.lds, g, S, E, Fg.tid);
            TREG_SUB(99);
            if (rp_ + 1 == PH_F) {
                Frame Fs = fresh(F); const SEpiRes Es{(float*)(ws + WS_XR), (bf16*)(ws + WS_XGC), nullptr, nullptr, nullptr, 0};
                for (int tl = Fs.bid; tl < 256; tl += Fs.G) sgemm_tile(Fs, (const bf16*)(ws + WS_HMID), DFF, (const bf16*)(ws + WS_WDN + layer * SZ_WDN), DFF, DFF, MP + 32 * (tl & 15), 64 * (tl >> 4), Es);
            }
            TREG_SUB(34);
        }
        }
        GRID_BAR();
    TREG_MARK(8);
        for (int rp_ = 0; rp_ < PH_G1; ++rp_) {
        {
            const Frame Fg = fresh(F); const int G = Fg.G, bid = Fg.bid;
            unsigned char* ws = KWS();
            int kple = PLE; asm volatile("" : "+s"(kple));
            pg8::Gemm g{(const bf16*)(ws + WS_P16) + (size_t)layer * MROWS * PLE, (const bf16*)(ws + WS_WPL + layer * SZ_WPL), MP, DM, kple, PLE, PLE, 31, 0};
            pg8::StaticOrder S; S.init(MP, DM, G, bid);
            epi::EpiRes E{nullptr, nullptr, nullptr, nullptr, (float*)(ws + WS_TPLE), 1};
            pg8::gemm_phase<epi::EpiRes, pg8::StaticOrder, true, true>(Fg.lds, g, S, E, Fg.tid);
            TREG_SUB(99);
            {
                Frame Fs = fresh(F); const SEpiRes Es{nullptr, nullptr, nullptr, nullptr, (float*)(ws + WS_TPLE), 1};
                for (int tl = Fs.bid; tl < 256; tl += Fs.G) sgemm_tile(Fs, (const bf16*)(ws + WS_P16) + (size_t)layer * MROWS * PLE, PLE, (const bf16*)(ws + WS_WPL + layer * SZ_WPL), PLE, PLE, MP + 32 * (tl & 15), 64 * (tl >> 4), Es);
            }
            TREG_SUB(35);
        }
        }
        for (int rp_ = 0; rp_ < PH_G2; ++rp_) {
        {
            const Frame Fg = fresh(F); const int G = Fg.G, bid = Fg.bid;
            unsigned char* ws = KWS();
            const bool more = layer + 1 < NLAYER;
            pg8::Gemm g{(const bf16*)(ws + WS_XGC), (const bf16*)(ws + WS_WPG + layer * SZ_WPG), MP, DM, DM, DM, DM, 31, 0};
            pg8::StaticOrder S; S.init(MP, DM, G, bid);
            epi::EpiRes E{(float*)(ws + WS_XR), more ? (bf16*)(ws + WS_XGA) : nullptr, more ? KIN(10) + (layer + 1) * DM : nullptr, more ? (float*)(ws + WS_SSA) : nullptr, (float*)(ws + WS_TPLE), (rp_ + 1 < PH_G2) ? 3 : 2};
            pg8::gemm_phase<epi::EpiRes, pg8::StaticOrder, true, true>(Fg.lds, g, S, E, Fg.tid);
            TREG_SUB(99);
            if (rp_ + 1 == PH_G2) {
                Frame Fs = fresh(F); const SEpiRes Es{(float*)(ws + WS_XR), more ? (bf16*)(ws + WS_XGA) : nullptr, more ? KIN(10) + (layer + 1) * DM : nullptr, more ? (float*)(ws + WS_SSA) : nullptr, (float*)(ws + WS_TPLE), 2};
                for (int tl = Fs.bid; tl < 256; tl += Fs.G) sgemm_tile(Fs, (const bf16*)(ws + WS_XGC), DM, (const bf16*)(ws + WS_WPG + layer * SZ_WPG), DM, DM, MP + 32 * (tl & 15), 64 * (tl >> 4), Es);
            }
            TREG_SUB(36);
        }
        }
        GRID_BAR();
    TREG_MARK(9);
    }
    for (int xb_ = 0; xb_ < PH_XBAR; ++xb_) GRID_BAR();
    { Frame Fp = fresh(F); for (int r = Fp.bid * NWAVES + Fp.wave; r < MROWS; r += Fp.G * NWAVES) final_row(Fp, r); }
    TREG_MARK(10);
#if PH_TREG >= 0
#if defined(PH_GPT) && PH_GPT >= 0
    tacc_ += *(volatile LAS unsigned long long*)(F.lds + LDSCTL_OFF + 448);
#endif
#if defined(PH_NPT) && PH_NPT >= 0
    tacc_ += *(volatile LAS unsigned long long*)(F.lds + LDSCTL_OFF + 464);
#endif
      { const unsigned long long tend_ = __builtin_amdgcn_s_memrealtime() + tacc_; while (__builtin_amdgcn_s_memrealtime() < tend_) __builtin_amdgcn_s_sleep(8); }
#endif
}

extern "C" void kernel_launch(void* const* d_in, const int* in_sizes, int n_in, void* d_out, int out_size, void* d_ws, size_t ws_size, hipStream_t stream) {
    static int grid = 0;
    if (grid == 0) {
        if (n_in != 27 || ws_size < WS_END) { fprintf(stderr, "kernel_launch: unexpected shapes (n_in %d out %d ws %zu, need %zu)\n", n_in, out_size, ws_size, (size_t)WS_END); grid = -1; return; }
        int dev = 0, cus = 0;
        if (hipGetDevice(&dev) != hipSuccess || hipDeviceGetAttribute(&cus, hipDeviceAttributeMultiprocessorCount, dev) != hipSuccess) { grid = -1; return; }
        if (hipFuncSetAttribute((const void*)mk_fwd, hipFuncAttributeMaxDynamicSharedMemorySize, LDS_BYTES) != hipSuccess) { fprintf(stderr, "kernel_launch: hipFuncSetAttribute failed\n"); grid = -1; return; }
        int per_cu = 0;
        if (hipOccupancyMaxActiveBlocksPerMultiprocessor(&per_cu, (const void*)mk_fwd, NTHREADS, LDS_BYTES) != hipSuccess || per_cu < 1) fprintf(stderr, "kernel_launch: occupancy query reports %d\n", per_cu);
        (void)hipGetLastError();
        grid = cus;
    }
    if (grid < 0) return;
    if (hipMemsetAsync((char*)d_ws + WS_CTL, 0, CTL_ZERO_BYTES, stream) != hipSuccess) return;
    Args a{};
    for (int i = 0; i < 27; ++i) a.in[i] = d_in[i];
    a.out = (float*)d_out; a.ws = (unsigned char*)d_ws;
    hipLaunchKernelGGL(mk_fwd, dim3(grid), dim3(NTHREADS), LDS_BYTES, stream, a);
}
```

```cpp
#include <hip/hip_runtime.h>
#include <cstdio>
#include <cstdint>
namespace pg8 {
#define PG8_LAS __attribute__((address_space(3)))
typedef unsigned short bf16_t;
typedef short bf16x8 __attribute__((ext_vector_type(8)));
typedef float f32x4 __attribute__((ext_vector_type(4)));
typedef unsigned u32x4 __attribute__((ext_vector_type(4)));
constexpr int BM = 256, BK = 64, HALF = 128, HTB = HALF * BK * 2  , STAGE_BYTES = 8 * HTB, NXCD = 8, WGM = 8;

__host__ __device__ __forceinline__ int lds_byte(int r, int c) { const int st = (r >> 4) * 2 + (c >> 5), rr = r & 15, cc = c & 31, ob = rr * 64 + cc * 2; return st * 1024 + (ob ^ (((ob >> 9) & 1) << 5)); }
__host__ __device__ __forceinline__ void stage_rc(int b, int& R, int& C) { const int st = b / 1024, sb = b % 1024, swz = sb ^ (((sb >> 9) & 1) << 5); R = (st >> 1) * 16 + swz / 64; C = (st & 1) * 32 + (swz % 64) / 2; }
__host__ __device__ __forceinline__ int perm32(int rho) { const int n = rho >> 4, i = rho & 15; return 8 * (i >> 2) + 4 * n + (i & 3); }

struct Unit { int pm, pn; };
struct Gemm { const bf16_t* A; const bf16_t* Bt; int M, N, K; int lda, ldb; int a_shift, a_off; };

struct StaticOrder {
    int nM, nN, nwg, G, c;
    __host__ __device__ void init(int M, int N, int G_, int c_) { nM = M / BM; nN = N / BM; nwg = nM * nN; G = G_; c = c_; }
    __host__ __device__ bool next(int i, Unit& u) const {
        const long L = (long)i * G + c; if (L >= nwg) return false;
        int wgid = (int)L; { const int q = nwg / NXCD, r = nwg % NXCD, xcd = wgid % NXCD, off = wgid / NXCD; wgid = (xcd < r ? xcd * (q + 1) : r * (q + 1) + (xcd - r) * q) + off; }
        const int nig = WGM * nN, gid = wgid / nig, fm = gid * WGM, gsz = (nM - fm) < WGM ? (nM - fm) : WGM;
        u.pm = fm + ((wgid % nig) % gsz); u.pn = (wgid % nig) / gsz; return true;
    }
    __device__ __forceinline__ void a_ready(const Unit&) const {}
    __device__ __forceinline__ void done(const Unit&) const {}
};

__device__ __forceinline__ unsigned cvt_pk_bf16(float lo, float hi) { unsigned r; asm volatile("v_cvt_pk_bf16_f32 %0, %1, %2" : "=v"(r) : "v"(lo), "v"(hi)); return r; }
typedef float f32x2 __attribute__((ext_vector_type(2)));
template <class Epi, class Sched, bool ALIGN_EPI = false, bool SP2 = false>
__device__ __forceinline__ void gemm_phase(PG8_LAS unsigned char* lds, const Gemm g, const Sched& S, const Epi& E, const int tid) {
    const int wid = __builtin_amdgcn_readfirstlane(tid >> 6), lane = tid & 63, wr = wid >> 2, wc = wid & 3, fr = lane & 15, fq = lane >> 4;
    const int K = g.K, nt = K / BK;
    unsigned voffA[2], voffB[2];
#pragma unroll
    for (int i = 0; i < 2; ++i) { int R, C; stage_rc(tid * 16 + i * 8192, R, C); const int Rb = Epi::PERM ? ((R & ~31) + perm32(R & 31)) : R;
        voffA[i] = (unsigned)(R * g.lda + C) * 2u; voffB[i] = (unsigned)(Rb * g.ldb + C) * 2u; }
    const size_t kstep = (size_t)(BK * 2);
    const size_t hstepA = (size_t)HALF * g.lda * 2, hstepB = (size_t)HALF * g.ldb * 2;
    const size_t tstepA = 2 * hstepA, tstepB = 2 * hstepB;
    const unsigned ldsw = (unsigned)wid * 1024u;
    const int aoff = lds_byte(wr * 64 + fr, fq * 8), boff = lds_byte(wc * 32 + fr, fq * 8);
#define PG8_SA(b, h) (((b) * 2 + (h)) * HTB)
#define PG8_SB(b, h) ((4 + (b) * 2 + (h)) * HTB)
#define PG8_STAGE(bufoff, gbase, voff) do { _Pragma("unroll") for (int _i = 0; _i < 2; ++_i) \
        __builtin_amdgcn_global_load_lds((const unsigned*)((const char*)(gbase) + (voff)[_i]), (PG8_LAS unsigned*)(lds + (bufoff) + ldsw + _i * 8192), 16, 0, 0); } while (0)
#define PG8_LDA(dst, b, h) do { _Pragma("unroll") for (int m = 0; m < 4; ++m) _Pragma("unroll") for (int k = 0; k < 2; ++k) dst[m][k] = *(const PG8_LAS bf16x8*)(lds + PG8_SA(b, h) + aoff + m * 2048 + k * 1024); } while (0)
#define PG8_LDB(dst, b, h) do { _Pragma("unroll") for (int n = 0; n < 2; ++n) _Pragma("unroll") for (int k = 0; k < 2; ++k) dst[n][k] = *(const PG8_LAS bf16x8*)(lds + PG8_SB(b, h) + boff + n * 2048 + k * 1024); } while (0)
#define PG8_MMA(ai, bj, At, Bt) do { __builtin_amdgcn_s_setprio(1); _Pragma("unroll") for (int m = 0; m < 4; ++m) _Pragma("unroll") for (int n = 0; n < 2; ++n) _Pragma("unroll") for (int k = 0; k < 2; ++k) \
        acc[ai][bj][m][n] = __builtin_amdgcn_mfma_f32_16x16x32_bf16(Bt[n][k], At[m][k], acc[ai][bj][m][n], 0, 0, 0); __builtin_amdgcn_s_setprio(0); } while (0)
#define PG8_WAIT_V(n) asm volatile("s_waitcnt vmcnt(" #n ")" ::: "memory")
#define PG8_WAIT_L(n) asm volatile("s_waitcnt lgkmcnt(" #n ")" ::: "memory")
#define PG8_BAR __builtin_amdgcn_s_barrier()
#define PG8_SCHED __builtin_amdgcn_sched_barrier(0)
    Unit cur, nxt; int ui = 0;
    if (!S.next(0, cur)) return;
    f32x4 acc[2][2][4][2];
#pragma unroll
    for (int a = 0; a < 2; ++a)
#pragma unroll
        for (int b = 0; b < 2; ++b)
#pragma unroll
            for (int m = 0; m < 4; ++m)
#pragma unroll
                for (int n = 0; n < 2; ++n) acc[a][b][m][n] = (f32x4){0.f, 0.f, 0.f, 0.f};
    bf16x8 At[4][2], B0[2][2], B1[2][2];
    const char* cA = (const char*)g.A + (size_t)cur.pm * tstepA + (size_t)(cur.pn >> g.a_shift) * (size_t)g.a_off; const char* cB = (const char*)g.Bt + (size_t)cur.pn * tstepB;
    S.a_ready(cur);
    if constexpr (SP2) {
        PG8_STAGE(PG8_SB(0, 0), cB, voffB); PG8_STAGE(PG8_SB(0, 1), cB + hstepB, voffB); PG8_STAGE(PG8_SA(0, 0), cA, voffA); PG8_STAGE(PG8_SA(0, 1), cA + hstepA, voffA);
        if (wr == 1) PG8_BAR;
        PG8_WAIT_V(2); PG8_BAR;
        PG8_STAGE(PG8_SB(1, 0), cB + kstep, voffB); PG8_STAGE(PG8_SA(1, 0), cA + kstep, voffA); PG8_STAGE(PG8_SB(1, 1), cB + hstepB + kstep, voffB);
        PG8_WAIT_V(6); PG8_BAR;
    } else {
        PG8_STAGE(PG8_SB(0, 0), cB, voffB); PG8_STAGE(PG8_SA(0, 0), cA, voffA); PG8_STAGE(PG8_SB(0, 1), cB + hstepB, voffB); PG8_STAGE(PG8_SA(0, 1), cA + hstepA, voffA);
        if (wr == 1) PG8_BAR;
        PG8_WAIT_V(4); PG8_BAR;
        PG8_STAGE(PG8_SB(1, 0), cB + kstep, voffB); PG8_STAGE(PG8_SA(1, 0), cA + kstep, voffA); PG8_STAGE(PG8_SB(1, 1), cB + hstepB + kstep, voffB);
        PG8_WAIT_V(6); PG8_BAR;
    }
    for (;;) {
        const bool has_next = S.next(ui + 1, nxt);
        const char* nA = has_next ? (const char*)g.A + (size_t)nxt.pm * tstepA + (size_t)(nxt.pn >> g.a_shift) * (size_t)g.a_off : cA; const char* nB = has_next ? (const char*)g.Bt + (size_t)nxt.pn * tstepB : cB;
        for (int t = 0; t < nt; t += 2) {
            const bool last = (t == nt - 2);
            const char* a1 = cA + (size_t)(t + 1) * kstep;
            const char* a2 = last ? nA : cA + (size_t)(t + 2) * kstep; const char* b2 = last ? nB : cB + (size_t)(t + 2) * kstep;
            const char* a3 = a2 + kstep; const char* b3 = b2 + kstep;
            if (last && has_next) S.a_ready(nxt);
            if constexpr (SP2) {
            PG8_LDB(B0, 0, 0); PG8_LDB(B1, 0, 1); PG8_SCHED; PG8_LDA(At, 0, 0); PG8_STAGE(PG8_SA(1, 1), a1 + hstepA, voffA);
            PG8_WAIT_V(8); PG8_WAIT_L(0); PG8_BAR; PG8_MMA(0, 0, At, B0); PG8_MMA(0, 1, At, B1); PG8_BAR; PG8_SCHED;
            PG8_LDA(At, 0, 1); PG8_STAGE(PG8_SB(0, 0), b2, voffB); PG8_STAGE(PG8_SB(0, 1), b2 + hstepB, voffB); PG8_STAGE(PG8_SA(0, 0), a2, voffA);
            PG8_WAIT_V(8); PG8_WAIT_L(0); PG8_BAR; PG8_MMA(1, 0, At, B0); PG8_MMA(1, 1, At, B1); PG8_BAR; PG8_SCHED;
            PG8_LDB(B0, 1, 0); PG8_LDB(B1, 1, 1); PG8_SCHED; PG8_LDA(At, 1, 0); PG8_STAGE(PG8_SA(0, 1), a2 + hstepA, voffA);
            PG8_WAIT_V(8); PG8_WAIT_L(0); PG8_BAR; PG8_MMA(0, 0, At, B0); PG8_MMA(0, 1, At, B1); PG8_BAR; PG8_SCHED;
            PG8_LDA(At, 1, 1); PG8_STAGE(PG8_SB(1, 0), b3, voffB); PG8_STAGE(PG8_SB(1, 1), b3 + hstepB, voffB); PG8_STAGE(PG8_SA(1, 0), a3, voffA);
            PG8_WAIT_V(8); PG8_WAIT_L(0); PG8_BAR; PG8_MMA(1, 0, At, B0); PG8_MMA(1, 1, At, B1); PG8_BAR; PG8_SCHED;
            } else {
            PG8_LDB(B0, 0, 0); PG8_SCHED; PG8_LDA(At, 0, 0); PG8_STAGE(PG8_SA(1, 1), a1 + hstepA, voffA);
            PG8_WAIT_L(8); PG8_BAR; PG8_WAIT_L(0); PG8_MMA(0, 0, At, B0); PG8_BAR; PG8_SCHED;
            PG8_LDB(B1, 0, 1); PG8_STAGE(PG8_SB(0, 0), b2, voffB);
            PG8_BAR; PG8_WAIT_L(0); PG8_MMA(0, 1, At, B1); PG8_BAR;
            PG8_LDA(At, 0, 1); PG8_STAGE(PG8_SA(0, 0), a2, voffA);
            PG8_BAR; PG8_WAIT_L(0); PG8_MMA(1, 0, At, B0); PG8_BAR; PG8_SCHED;
            PG8_STAGE(PG8_SB(0, 1), b2 + hstepB, voffB);
            PG8_WAIT_V(6); PG8_BAR; PG8_MMA(1, 1, At, B1); PG8_BAR;
            PG8_LDB(B0, 1, 0); PG8_SCHED; PG8_LDA(At, 1, 0); PG8_STAGE(PG8_SA(0, 1), a2 + hstepA, voffA);
            PG8_WAIT_L(8); PG8_BAR; PG8_WAIT_L(0); PG8_MMA(0, 0, At, B0); PG8_BAR; PG8_SCHED;
            PG8_LDB(B1, 1, 1); PG8_STAGE(PG8_SB(1, 0), b3, voffB);
            PG8_BAR; PG8_WAIT_L(0); PG8_MMA(0, 1, At, B1); PG8_BAR;
            PG8_LDA(At, 1, 1); PG8_STAGE(PG8_SA(1, 0), a3, voffA);
            PG8_BAR; PG8_WAIT_L(0); PG8_MMA(1, 0, At, B0); PG8_BAR; PG8_SCHED;
            PG8_STAGE(PG8_SB(1, 1), b3 + hstepB, voffB);
            PG8_WAIT_V(6); PG8_BAR; PG8_MMA(1, 1, At, B1); PG8_BAR;
            }
        }
        if constexpr (ALIGN_EPI) { if (wr == 0) PG8_BAR; }
        if constexpr (!Epi::AFTER_DRAIN) { E(acc, cur, wr, wc, fr, fq); S.done(cur); }
        if (!has_next) break;
#pragma unroll
        for (int a = 0; a < 2; ++a)
#pragma unroll
            for (int b = 0; b < 2; ++b)
#pragma unroll
                for (int m = 0; m < 4; ++m)
#pragma unroll
                    for (int n = 0; n < 2; ++n) acc[a][b][m][n] = (f32x4){0.f, 0.f, 0.f, 0.f};
        cur = nxt; cA = nA; cB = nB; ++ui;
        if constexpr (ALIGN_EPI) { if (wr == 1) PG8_BAR; }
    }
    PG8_WAIT_V(0);
    if constexpr (!ALIGN_EPI) { if (wr == 0) PG8_BAR; }
    PG8_BAR;
    if constexpr (Epi::AFTER_DRAIN) { E.fused(acc, cur, wr, wc, fr, fq, lds, wid, lane); S.done(cur); }
#undef PG8_SA
#undef PG8_SB
#undef PG8_STAGE
#undef PG8_LDA
#undef PG8_LDB
#undef PG8_MMA
#undef PG8_WAIT_V
#undef PG8_WAIT_L
#undef PG8_BAR
#undef PG8_SCHED
}
}
#define DI __device__ __forceinline__
#define GAS __attribute__((address_space(1)))
#define LAS __attribute__((address_space(3)))
typedef unsigned short bf16;
typedef unsigned v4u __attribute__((ext_vector_type(4)));
typedef unsigned v2u __attribute__((ext_vector_type(2)));
typedef float f32x4 __attribute__((ext_vector_type(4)));
typedef float f32x2 __attribute__((ext_vector_type(2)));
typedef short bf16x8 __attribute__((ext_vector_type(8)));
typedef short s16x4 __attribute__((ext_vector_type(4)));
typedef GAS unsigned gu32;

constexpr int DM = 1024, TP = 8192, MP = 16384, MS = 512, MROWS = 16896, LDZ = 8704, DFF = 4096, PLE = 256, NLAYER = 2;
constexpr int ZC_Q = 0, ZC_KC = 512, ZC_VC = 640, ZC_KS = 768, ZC_VS = 896, ZC_KW = 1024, ZC_VW = 1152, ZC_GQKV = 1280, ZC_GZ = 2816, ZC_RQKV = 3328, ZC_RG = 4864, ZC_MG = 5376, ZC_SM = 8448;
constexpr float EPS = 1e-6f;
constexpr size_t O_YP = 0, O_YS = O_YP + (size_t)MP * DM, O_KVP = O_YS + (size_t)MS * DM, O_KVS = O_KVP + (size_t)2 * MP * 512, O_WINP = O_KVS + (size_t)2 * MS * 512,
                 O_WINS = O_WINP + (size_t)2 * 2 * 512 * 256, O_CVP = O_WINS + (size_t)2 * 128 * 512 * 256, O_CVS = O_CVP + (size_t)2 * 2 * 3 * 1536, O_GSP = O_CVS + (size_t)2 * 128 * 3 * 1536,
                 O_GSS = O_GSP + (size_t)2 * 2 * 4 * 16384, O_RSP = O_GSS + (size_t)2 * 128 * 4 * 16384, O_RSS = O_RSP + (size_t)2 * 2 * 4 * 16384, O_END = O_RSS + (size_t)2 * 128 * 4 * 16384;

DI float bf2f(unsigned short b) { return __uint_as_float((unsigned)b << 16); }
DI unsigned f2bf(float f) { unsigned u = __float_as_uint(f); return (u + 0x7fffu + ((u >> 16) & 1u)) >> 16; }
typedef __bf16 bf16x2_t __attribute__((ext_vector_type(2)));
DI unsigned pk2(float lo, float hi) { const f32x2 v = {lo, hi}; return __builtin_bit_cast(unsigned, __builtin_convertvector(v, bf16x2_t)); }
DI float lo_bf(unsigned w) { return __uint_as_float(w << 16); }
DI float hi_bf(unsigned w) { return __uint_as_float(w & 0xffff0000u); }
DI float sigmoidf_(float x) { return 1.f / (1.f + __expf(-x)); }
DI float siluf_(float x) { return x / (1.f + __expf(-x)); }
DI v4u pack8(const f32x4 a, const f32x4 b) { v4u w; w.x = pk2(a[0], a[1]); w.y = pk2(a[2], a[3]); w.z = pk2(b[0], b[1]); w.w = pk2(b[2], b[3]); return w; }
DI void unpack8(const v4u w, f32x4& a, f32x4& b) { a[0] = lo_bf(w.x); a[1] = hi_bf(w.x); a[2] = lo_bf(w.y); a[3] = hi_bf(w.y); b[0] = lo_bf(w.z); b[1] = hi_bf(w.z); b[2] = lo_bf(w.w); b[3] = hi_bf(w.w); }

template <int M> DI int shxi(int v, int lane) {
    if constexpr (M < 32) return __builtin_amdgcn_ds_swizzle(v, (M << 10) | 0x1f);
    else return __builtin_amdgcn_ds_bpermute((lane ^ 32) << 2, v);
}
template <int M> DI float shx(float v, int lane) { return __int_as_float(shxi<M>(__float_as_int(v), lane)); }
DI float wave_sum(float v, int lane) { v += shx<1>(v, lane); v += shx<2>(v, lane); v += shx<4>(v, lane); v += shx<8>(v, lane); v += shx<16>(v, lane); v += shx<32>(v, lane); return v; }

namespace epi {
using pg8::Unit; using pg8::bf16_t;
DI float row_rstd(const float* SS, int row, int fq, int lane) {
    const f32x4 p = *(const f32x4*)(SS + (size_t)row * 16 + 4 * fq);
    float s = (p[0] + p[1]) + (p[2] + p[3]); s += shx<16>(s, lane); s += shx<32>(s, lane);
    return rsqrtf(s * (1.f / DM) + EPS);
}
struct EpiA {
    static constexpr bool PERM = true, AFTER_DRAIN = false;
    bf16* Z; float* ZS; const float* SS; float* out; int layer;
    DI void operator()(const f32x4 (&acc)[2][2][4][2], const Unit& u, int wr, int wc, int fr, int fq) const {
        asm volatile("" : "+v"(fr), "+v"(fq), "+s"(wr), "+s"(wc));
        const int pn = u.pn;
        float rs[2][4];
#pragma unroll
        for (int ai = 0; ai < 2; ++ai)
#pragma unroll
            for (int m = 0; m < 4; ++m) rs[ai][m] = row_rstd(SS, u.pm * 256 + ai * 128 + wr * 64 + m * 16 + fr, fq, fr + 16 * fq);
#pragma unroll
        for (int ai = 0; ai < 2; ++ai)
#pragma unroll
            for (int m = 0; m < 4; ++m) {
                const int row = u.pm * 256 + ai * 128 + wr * 64 + m * 16 + fr;
                const float rstd = rs[ai][m];
#pragma unroll
                for (int bj = 0; bj < 2; ++bj) {
                    const int col = pn * 256 + bj * 128 + wc * 32 + 8 * fq;
                    const f32x4 v0 = acc[ai][bj][m][0] * rstd, v1 = acc[ai][bj][m][1] * rstd;
                    *(v4u*)(Z + (size_t)row * LDZ + col) = pack8(v0, v1);
                    float* dst = nullptr;
                    if (pn == 2 || pn == 3) {
                        dst = (row < MP) ? out + O_KVP + ((size_t)layer * MP + row) * 512 + (col - 512) : out + O_KVS + ((size_t)layer * MS + (row - MP)) * 512 + (col - 512);
                    } else if (pn == 4) {
                        const int c2 = col - 1024;
                        if (row < MP) { const int t = row & (TP - 1), b = row >> 13; if (t >= TP - 512) dst = out + O_WINP + ((size_t)(layer * 2 + b) * 512 + (t - (TP - 512))) * 256 + c2; }
                        else { const int r2 = row - MP, s = r2 >> 2, j = r2 & 3; dst = out + O_WINS + ((size_t)(layer * 128 + s) * 512 + 508 + j) * 256 + c2; }
                    } else if (pn >= 5 && pn < 11) {
                        const int c2 = col - 1280;
                        if (row < MP) { const int t = row & (TP - 1), b = row >> 13; if (t >= TP - 3) dst = out + O_CVP + ((size_t)(layer * 2 + b) * 3 + (t - (TP - 3))) * 1536 + c2; }
                        else { const int r2 = row - MP, s = r2 >> 2, j = r2 & 3; if (j >= 1) dst = out + O_CVS + ((size_t)(layer * 128 + s) * 3 + (j - 1)) * 1536 + c2; }
                    } else if (pn == 33) {
                        if (bj == 0 && wc == 0) dst = ZS + (size_t)row * 32 + 8 * fq;
                    }
                    if (dst) { *(f32x4*)dst = v0; *(f32x4*)(dst + 4) = v1; }
                }
                asm volatile("" ::: "memory");
            }
    }
};
struct EpiC {
    static constexpr bool PERM = true, AFTER_DRAIN = false;
    const bf16* Z; bf16* G;
    DI void operator()(const f32x4 (&acc)[2][2][4][2], const Unit& u, int wr, int wc, int fr, int fq) const {
        asm volatile("" : "+v"(fr), "+v"(fq), "+s"(wr), "+s"(wc));
#pragma unroll
        for (int ai = 0; ai < 2; ++ai) {
            v4u gw[4][2];
#pragma unroll
            for (int m = 0; m < 4; ++m)
#pragma unroll
                for (int bj = 0; bj < 2; ++bj) gw[m][bj] = *(const v4u*)(Z + (size_t)(u.pm * 256 + ai * 128 + wr * 64 + m * 16 + fr) * LDZ + ZC_MG + u.pn * 256 + bj * 128 + wc * 32 + 8 * fq);
#pragma unroll
            for (int m = 0; m < 4; ++m) {
                const int row = u.pm * 256 + ai * 128 + wr * 64 + m * 16 + fr;
#pragma unroll
                for (int bj = 0; bj < 2; ++bj) {
                    const int col = u.pn * 256 + bj * 128 + wc * 32 + 8 * fq;
                    f32x4 g0, g1; unpack8(gw[m][bj], g0, g1);
                    f32x4 v0 = acc[ai][bj][m][0], v1 = acc[ai][bj][m][1];
#pragma unroll
                    for (int e = 0; e < 4; ++e) { v0[e] *= sigmoidf_(g0[e]); v1[e] *= sigmoidf_(g1[e]); }
                    *(v4u*)(G + (size_t)row * 3072 + col) = pack8(v0, v1);
                }
            }
            asm volatile("" ::: "memory");
        }
    }
};
struct EpiRes {
    static constexpr bool PERM = true, AFTER_DRAIN = false;
    float* XR; bf16* XG; const float* gvec; float* SS; float* T; int mode;
    DI void operator()(const f32x4 (&acc)[2][2][4][2], const Unit& u, int wr, int wc, int fr, int fq) const {
        asm volatile("" : "+v"(fr), "+v"(fq), "+s"(wr), "+s"(wc));
        if (mode == 3) return;
        if (mode == 1) {
#pragma unroll
            for (int ai = 0; ai < 2; ++ai)
#pragma unroll
                for (int m = 0; m < 4; ++m)
#pragma unroll
                    for (int bj = 0; bj < 2; ++bj) { const size_t o = (size_t)(u.pm * 256 + ai * 128 + wr * 64 + m * 16 + fr) * DM + u.pn * 256 + bj * 128 + wc * 32 + 8 * fq;
                        *(f32x4*)(T + o) = acc[ai][bj][m][0]; *(f32x4*)(T + o + 4) = acc[ai][bj][m][1]; }
            return;
        }
#pragma unroll
        for (int ai = 0; ai < 2; ++ai)
#pragma unroll
            for (int mp = 0; mp < 2; ++mp) {
                f32x4 xr[2][2][2], tt[2][2][2];
#pragma unroll
                for (int mm = 0; mm < 2; ++mm)
#pragma unroll
                    for (int bj = 0; bj < 2; ++bj) { const size_t o = (size_t)(u.pm * 256 + ai * 128 + wr * 64 + (2 * mp + mm) * 16 + fr) * DM + u.pn * 256 + bj * 128 + wc * 32 + 8 * fq;
                        xr[mm][bj][0] = *(const f32x4*)(XR + o); xr[mm][bj][1] = *(const f32x4*)(XR + o + 4);
                        if (mode == 2) { tt[mm][bj][0] = *(const f32x4*)(T + o); tt[mm][bj][1] = *(const f32x4*)(T + o + 4); } }
#pragma unroll
                for (int mm = 0; mm < 2; ++mm) {
                    const int m = 2 * mp + mm;
                    const int row = u.pm * 256 + ai * 128 + wr * 64 + m * 16 + fr;
                    float ssq = 0.f;
#pragma unroll
                    for (int bj = 0; bj < 2; ++bj) {
                        const int col = u.pn * 256 + bj * 128 + wc * 32 + 8 * fq;
                        const size_t o = (size_t)row * DM + col;
                        f32x4 a0 = acc[ai][bj][m][0], a1 = acc[ai][bj][m][1];
                        f32x4 x0 = xr[mm][bj][0], x1 = xr[mm][bj][1];
                        if (mode == 2) {
#pragma unroll
                            for (int e = 0; e < 4; ++e) { a0[e] = tt[mm][bj][0][e] * sigmoidf_(a0[e]); a1[e] = tt[mm][bj][1][e] * sigmoidf_(a1[e]); } }
                        x0 += a0; x1 += a1;
                        *(f32x4*)(XR + o) = x0; *(f32x4*)(XR + o + 4) = x1;
                        ssq += (x0[0] * x0[0] + x0[1] * x0[1]) + (x0[2] * x0[2] + x0[3] * x0[3]) + (x1[0] * x1[0] + x1[1] * x1[1]) + (x1[2] * x1[2] + x1[3] * x1[3]);
                        if (XG) { if (gvec) { const f32x4 g0 = *(const f32x4*)(gvec + col), g1 = *(const f32x4*)(gvec + col + 4); x0 *= g0; x1 *= g1; }
                            *(v4u*)(XG + o) = pack8(x0, x1); }
                    }
                    if (SS) { ssq += shx<16>(ssq, fr + 16 * fq); ssq += shx<32>(ssq, fr + 16 * fq); if (fq == 0) SS[(size_t)row * 16 + u.pn * 4 + wc] = ssq; }
                }
                asm volatile("" ::: "memory");
            }
    }
};
struct EpiUp {
    static constexpr bool PERM = true, AFTER_DRAIN = false;
    bf16* H; const float* SS;
    DI void operator()(const f32x4 (&acc)[2][2][4][2], const Unit& u, int wr, int wc, int fr, int fq) const {
        asm volatile("" : "+v"(fr), "+v"(fq), "+s"(wr), "+s"(wc));
        float rs[2][4];
#pragma unroll
        for (int ai = 0; ai < 2; ++ai)
#pragma unroll
            for (int m = 0; m < 4; ++m) rs[ai][m] = row_rstd(SS, u.pm * 256 + ai * 128 + wr * 64 + m * 16 + fr, fq, fr + 16 * fq);
#pragma unroll
        for (int ai = 0; ai < 2; ++ai)
#pragma unroll
            for (int m = 0; m < 4; ++m) {
                const int row = u.pm * 256 + ai * 128 + wr * 64 + m * 16 + fr;
                const float rstd = rs[ai][m];
#pragma unroll
                for (int bj = 0; bj < 2; ++bj) {
                    const int col = u.pn * 256 + bj * 128 + wc * 32 + 8 * fq;
                    f32x4 v0 = acc[ai][bj][m][0] * rstd, v1 = acc[ai][bj][m][1] * rstd;
#pragma unroll
                    for (int e = 0; e < 4; ++e) { const float a = fmaxf(v0[e], 0.f), b = fmaxf(v1[e], 0.f); v0[e] = a * a; v1[e] = b * b; }
                    *(v4u*)(H + (size_t)row * DFF + col) = pack8(v0, v1);
                }
                asm volatile("" ::: "memory");
            }
    }
};
}
constexpr size_t al256(size_t x) { return (x + 255) & ~(size_t)255; }
constexpr size_t WS_CTL = 0, CTL_ZERO_BYTES = 1u << 20;
constexpr size_t SZ_WIN = (size_t)LDZ * DM * 2, SZ_WBR = (size_t)3072 * 512 * 2, SZ_WO3 = (size_t)DM * 3072 * 2, SZ_WUP = (size_t)DFF * DM * 2, SZ_WDN = (size_t)DM * DFF * 2,
                 SZ_WPL = (size_t)DM * PLE * 2, SZ_WPG = (size_t)DM * DM * 2, SZ_W1T = (size_t)2 * 64 * 2048 * 2, SZ_W2T = (size_t)2 * 64 * 64 * 2;
constexpr size_t WS_WIN = CTL_ZERO_BYTES, WS_WBR = WS_WIN + 2 * SZ_WIN, WS_WO3 = WS_WBR + 2 * SZ_WBR, WS_WUP = WS_WO3 + 2 * SZ_WO3, WS_WDN = WS_WUP + 2 * SZ_WUP,
                 WS_WPL = WS_WDN + 2 * SZ_WDN, WS_WPG = WS_WPL + 2 * SZ_WPL, WS_W1T = WS_WPG + 2 * SZ_WPG, WS_W2T = WS_W1T + 2 * SZ_W1T, WS_ROT = al256(WS_W2T + 2 * SZ_W2T);
constexpr size_t WS_P16 = WS_ROT + (size_t)TP * 64 * 8;
constexpr size_t WS_XR = WS_P16 + (size_t)2 * MROWS * PLE * 2;
constexpr size_t WS_XGA = WS_XR + (size_t)MROWS * DM * 4, WS_XGB = WS_XGA + (size_t)MROWS * DM * 2, WS_XGC = WS_XGB + (size_t)MROWS * DM * 2;
constexpr size_t WS_SSA = WS_XGC + (size_t)MROWS * DM * 2, WS_SSB = WS_SSA + (size_t)MROWS * 64;
constexpr size_t WS_Z = WS_SSB + (size_t)MROWS * 64, WS_ZS = WS_Z + (size_t)MROWS * LDZ * 2;
constexpr size_t WS_MIX = WS_ZS + (size_t)MROWS * 128, WS_GATED = WS_MIX + (size_t)MROWS * 1536 * 2, WS_HMID = WS_GATED + (size_t)MROWS * 3072 * 2;
constexpr size_t WS_TPLE = WS_HMID + (size_t)MROWS * DFF * 2;
constexpr size_t WS_KC = WS_TPLE + (size_t)MROWS * DM * 4;
constexpr size_t WS_KCS = WS_KC + (size_t)2 * 2 * 512 * 2 * 64 * 2;
constexpr int GREC = 73984;
constexpr size_t WS_GREC = WS_KCS + (size_t)2 * 128 * 128 * 2 * 64 * 2;
constexpr size_t WS_OGDN = WS_GREC + (size_t)1024 * GREC;
constexpr size_t WS_RKV = WS_OGDN + (size_t)MROWS * 512 * 4;
constexpr size_t WS_RST = WS_RKV + (size_t)512 * 16384 * 4;
constexpr size_t WS_QR = WS_RST + (size_t)512 * 16384 * 2, WS_KR = WS_QR + (size_t)MP * 512 * 2;
constexpr size_t WS_END = WS_KR + (size_t)MP * 512 * 2;
static_assert(WS_W1T % 256 == 0 && WS_Z % 256 == 0 && WS_GREC % 256 == 0 && WS_RKV % 256 == 0 && WS_KC % 256 == 0 && WS_XR % 256 == 0, "ws alignment");

constexpr int CW_TMO = 0, CW_BAR = 4096, CW_QUEUE = 8192;
constexpr int NWAVES = 8, NTHREADS = 512;
constexpr int RING_BYTES = 147456, LDSCTL_OFF = RING_BYTES, MISC_OFF = LDSCTL_OFF + 320, LDS_BYTES = RING_BYTES + 1024;

#define RLX_AGENT __ATOMIC_RELAXED, __HIP_MEMORY_SCOPE_AGENT
#define LDS_WAIT() asm volatile("s_waitcnt lgkmcnt(0)" ::: "memory")
#define VM_WAIT() asm volatile("s_waitcnt vmcnt(0)" ::: "memory")
#define XB_TMO      128
#define XB_XCNT(j)  (256  + 64 * (j))
#define XB_XSUB(j)  (1280 + 64 * (j))
#define XB_XGEN(j)  (2304 + 64 * (j))
#define XB_TOP      3328
#define XB_TOPGEN   3392
#define XCD_BAR_WORDS 3456
#define XB_SPIN_CAP (1u << 18)

__device__ __forceinline__ unsigned xb_ld(unsigned* p)              { return __hip_atomic_load(p, __ATOMIC_RELAXED, __HIP_MEMORY_SCOPE_AGENT); }
__device__ __forceinline__ unsigned xb_add(unsigned* p, unsigned v) { return __hip_atomic_fetch_add(p, v, __ATOMIC_RELAXED, __HIP_MEMORY_SCOPE_AGENT); }
__device__ __forceinline__ unsigned xb_xcc_id() { return (unsigned)__builtin_amdgcn_s_getreg((3 << 11) | 20) & 0xFu; }
#define XB_SPIN(cond, bar) do { unsigned _sp = 0; while (cond) { __builtin_amdgcn_s_sleep(1); \
    if ((++_sp & 255u) == 0u) { if (xb_ld(&(bar)[XB_TMO])) break; if (_sp > XB_SPIN_CAP) { atomicAdd(&(bar)[XB_TMO], 1u); break; } } } } while (0)

struct XcdBarrier {
    unsigned* bar; unsigned x;
    volatile LAS unsigned* st;
};

__device__ __forceinline__ XcdBarrier xcd_barrier_post(unsigned* bar, volatile LAS unsigned* st, bool t0) {
    XcdBarrier b; b.bar = bar; b.x = xb_xcc_id(); b.st = st;
    if (t0) (void)xb_add(&bar[XB_XCNT(b.x)], 1u);
    return b;
}
__device__ __forceinline__ void xcd_barrier_complete(unsigned* bar, unsigned x, unsigned& nloc, unsigned& nx) {
    const unsigned G = gridDim.x * gridDim.y * gridDim.z;
    unsigned sum, cnt, mine, sp = 0u;
    for (;;) {
        sum = 0u; cnt = 0u; mine = 0u;
#pragma unroll
        for (unsigned j = 0; j < 16; ++j) { const unsigned c = xb_ld(&bar[XB_XCNT(j)]); sum += c; cnt += (c > 0u) ? 1u : 0u; mine = (j == x) ? c : mine; }
        if (sum == G) break;
        __builtin_amdgcn_s_sleep(1);
        if ((++sp & 255u) == 0u) { if (xb_ld(&bar[XB_TMO])) break; if (sp > XB_SPIN_CAP) { atomicAdd(&bar[XB_TMO], 1u); break; } }
    }
    nloc = mine > 0u ? mine : 1u; nx = cnt > 0u ? cnt : 1u;
}

__device__ __forceinline__ void xcd_barrier(const XcdBarrier& b, bool t0) {
    asm volatile("s_waitcnt vmcnt(0)" ::: "memory");
    __syncthreads();
    if (t0) {
        unsigned* bar = b.bar;
        __builtin_amdgcn_s_waitcnt(0);
        unsigned nloc = b.st[0], nx = b.st[1];
        if (nloc == 0u) { xcd_barrier_complete(bar, b.x, nloc, nx); b.st[0] = nloc; b.st[1] = nx; }
        const unsigned old = xb_add(&bar[XB_XSUB(b.x)], 1u);
        const unsigned gen = old / nloc;
        if (old + 1u == (gen + 1u) * nloc) {
            __builtin_amdgcn_fence(__ATOMIC_RELEASE, "agent");
            asm volatile("s_waitcnt vmcnt(0)" ::: "memory");
            const unsigned og = xb_add(&bar[XB_TOP], 1u);
            const unsigned tg = og / nx;
            if (og + 1u == (tg + 1u) * nx) xb_add(&bar[XB_TOPGEN], 1u);
            else XB_SPIN(xb_ld(&bar[XB_TOPGEN]) == tg, bar);
            __builtin_amdgcn_fence(__ATOMIC_ACQUIRE, "agent");
            xb_add(&bar[XB_XGEN(b.x)], 1u);
            asm volatile("s_waitcnt vmcnt(0)" ::: "memory");
        } else {
            XB_SPIN(xb_ld(&bar[XB_XGEN(b.x)]) == gen, bar);
            __builtin_amdgcn_fence(__ATOMIC_ACQUIRE, "agent");
            asm volatile("s_waitcnt vmcnt(0)" ::: "memory");
        }
    }
    __syncthreads();
}
typedef const void* const __attribute__((address_space(4)))* kargp_t;
DI const float* KIN(int i) { const GAS float* p = (const GAS float*)((kargp_t)__builtin_amdgcn_kernarg_segment_ptr())[i]; asm volatile("" : "+s"(p)); return (const float*)p; }
DI float* KOUT() { GAS float* p = (GAS float*)((kargp_t)__builtin_amdgcn_kernarg_segment_ptr())[27]; asm volatile("" : "+s"(p)); return (float*)p; }
DI unsigned char* KWS() { GAS unsigned char* p = (GAS unsigned char*)((kargp_t)__builtin_amdgcn_kernarg_segment_ptr())[28]; asm volatile("" : "+s"(p)); return (unsigned char*)p; }
struct Frame {
    LAS unsigned char* lds;
    gu32* ctl;
    int tid, lane, wave, G, bid;
};
DI bf16x8 ld_frag_g(const bf16* p) { return __builtin_bit_cast(bf16x8, *(const v4u*)p); }
DI bf16x8 ld_frag_l(const LAS unsigned char* p) { return *(const LAS bf16x8*)p; }
DI f32x4 mfma16(bf16x8 a, bf16x8 b, f32x4 c) { return __builtin_amdgcn_mfma_f32_16x16x32_bf16(a, b, c, 0, 0, 0); }
DI bf16x8 pack_frag(const f32x4 a, const f32x4 b) { return __builtin_bit_cast(bf16x8, pack8(a, b)); }
DI int lane_id() { int l; asm volatile("v_mbcnt_lo_u32_b32 %0, -1, 0\n\tv_mbcnt_hi_u32_b32 %0, -1, %0" : "=v"(l)); return l; }
DI Frame fresh(const Frame& F0) {
    Frame F = F0; int w = F0.wave, g = F0.G, b = F0.bid; asm volatile("" : "+s"(w), "+s"(g), "+s"(b));
    int l = lane_id(); asm volatile("" : "+v"(l));
    unsigned lb = (unsigned)(uintptr_t)F0.lds; asm volatile("" : "+s"(lb)); F.lds = (LAS unsigned char*)(uintptr_t)lb;
    F.wave = w; F.lane = l; F.tid = w * 64 + l; F.G = g; F.bid = b; return F;
}
#define GRID_BAR() do { XcdBarrier b_; b_.bar = (unsigned*)((gu32*)(KWS() + WS_CTL) + CW_BAR); b_.x = xb_xcc_id(); b_.st = (volatile LAS unsigned*)(F.lds + MISC_OFF) + 8; \
    const Frame Fb_ = fresh(F); xcd_barrier(b_, Fb_.tid == 0); } while (0)
DI int win_colmap(int j) {
    if (j < 1280) return j; if (j < 2816) return j + 24; if (j < 8448) return j + 32; if (j < 8472) return j - 8448 + 1280; if (j < 8480) return j - 8472 + 2840; return -1;
}
DI void tr_item(const float* W, int ldw, int k0, int srccol, bf16* WT, size_t dst_row0, int ldt, int kdst0, int nrep, int krep, LAS float* scr, int lane) {
#pragma unroll 8
    for (int i = 0; i < 32; ++i) { const int kk = 2 * i + (lane >> 5); const float v_ = W[(size_t)(k0 + kk) * ldw + (srccol >= 0 ? srccol : 0)]; scr[kk * 33 + (lane & 31)] = (srccol >= 0) ? v_ : 0.f; }
    LDS_WAIT(); asm volatile("" ::: "memory");
    const int c = lane & 7;
#pragma unroll
    for (int j = 0; j < 4; ++j) { const int n = (lane >> 3) + 8 * j; const LAS float* s = scr + (8 * c) * 33 + n;
        v4u o; o.x = pk2(s[0 * 33], s[1 * 33]); o.y = pk2(s[2 * 33], s[3 * 33]); o.z = pk2(s[4 * 33], s[5 * 33]); o.w = pk2(s[6 * 33], s[7 * 33]);
        for (int r = 0; r < nrep; ++r) *(v4u*)(WT + (dst_row0 + n) * (size_t)ldt + kdst0 + r * krep + 8 * c) = o; }
    LDS_WAIT(); asm volatile("" ::: "memory");
}
DI void p0_prologue(Frame& F) {
    LAS float* scr = (LAS float*)(F.lds + F.wave * 16384);
    const int gw = F.bid * NWAVES + F.wave, NGW = F.G * NWAVES, lane = F.lane;
    unsigned char* ws = KWS();
    constexpr int I_A = 16 * 272, I_B = 3 * 8 * 32, I_C = 16 * 32, I_D = 16 * 128, I_E = 64 * 32, I_F = 4 * 32, I_G = 16 * 32, I_H = 2 * 32 * 2, I_I = 2 * 2;
    constexpr int I_L = I_A + I_B + I_C + I_D + I_E + I_F + I_G + I_H + I_I;
    for (int it = gw; it < 2 * I_L; it += NGW) {
        const int l = it / I_L; int r = it % I_L;
        if (r < I_A) { const int kb = r / 272, nb = r % 272; tr_item(KIN(11) + (size_t)l * DM * 8480, 8480, 64 * kb, win_colmap(32 * nb + (lane & 31)), (bf16*)(ws + WS_WIN + l * SZ_WIN), 32 * nb, DM, 64 * kb, 1, 0, scr, lane); continue; } r -= I_A;
        if (r < I_B) { const int b = r / 256, kb = (r % 256) / 32, nb = r % 32; tr_item(KIN(19) + (size_t)(l * 3 + b) * 512 * DM, DM, 64 * kb, 32 * nb + (lane & 31), (bf16*)(ws + WS_WBR + l * SZ_WBR), b * 1024 + 32 * nb, 512, 64 * kb, 1, 0, scr, lane); continue; } r -= I_B;
        if (r < I_C) { const int kb = r / 32, nb = r % 32; tr_item(KIN(20) + (size_t)l * DM * DM, DM, 64 * kb, 32 * nb + (lane & 31), (bf16*)(ws + WS_WO3 + l * SZ_WO3), 32 * nb, 3072, 64 * kb, 3, 1024, scr, lane); continue; } r -= I_C;
        if (r < I_D) { const int kb = r / 128, nb = r % 128; tr_item(KIN(22) + (size_t)l * DM * DFF, DFF, 64 * kb, 32 * nb + (lane & 31), (bf16*)(ws + WS_WUP + l * SZ_WUP), 32 * nb, DM, 64 * kb, 1, 0, scr, lane); continue; } r -= I_D;
        if (r < I_E) { const int kb = r / 32, nb = r % 32; tr_item(KIN(23) + (size_t)l * DFF * DM, DM, 64 * kb, 32 * nb + (lane & 31), (bf16*)(ws + WS_WDN + l * SZ_WDN), 32 * nb, DFF, 64 * kb, 1, 0, scr, lane); continue; } r -= I_E;
        if (r < I_F) { const int kb = r / 32, nb = r % 32; tr_item(KIN(24) + (size_t)l * PLE * DM, DM, 64 * kb, 32 * nb + (lane & 31), (bf16*)(ws + WS_WPL + l * SZ_WPL), 32 * nb, PLE, 64 * kb, 1, 0, scr, lane); continue; } r -= I_F;
        if (r < I_G) { const int kb = r / 32, nb = r % 32; tr_item(KIN(25) + (size_t)l * DM * DM, DM, 64 * kb, 32 * nb + (lane & 31), (bf16*)(ws + WS_WPG + l * SZ_WPG), 32 * nb, DM, 64 * kb, 1, 0, scr, lane); continue; } r -= I_G;
        if (r < I_H) { const int kv = r / 64, kb = (r % 64) / 2, nb = r % 2; tr_item(KIN(13) + (size_t)(l * 2 + kv) * 2048 * 64, 64, 64 * kb, 32 * nb + (lane & 31), (bf16*)(ws + WS_W1T + l * SZ_W1T) + (size_t)kv * 64 * 2048, 32 * nb, 2048, 64 * kb, 1, 0, scr, lane); continue; } r -= I_H;
        { const int kv = r / 2, nb = r % 2; tr_item(KIN(14) + (size_t)(l * 2 + kv) * 64 * 64, 64, 0, 32 * nb + (lane & 31), (bf16*)(ws + WS_W2T + l * SZ_W2T) + (size_t)kv * 64 * 64, 32 * nb, 64, 0, 1, 0, scr, lane); }
    }
    float* XR = (float*)(ws + WS_XR); bf16* XGA = (bf16*)(ws + WS_XGA); float* SSA = (float*)(ws + WS_SSA); bf16* P16 = (bf16*)(ws + WS_P16);
    const float* g0 = KIN(10);
    for (int row = gw; row < MROWS; row += NGW) {
        const float* xs = (row < MP) ? KIN(0) + (size_t)row * DM : KIN(1) + (size_t)(row - MP) * DM;
        float ss = 0.f;
#pragma unroll
        for (int j = 0; j < 2; ++j) {
            const int c = j * 512 + lane * 8;
            f32x4 a = *(const f32x4*)(xs + c), b = *(const f32x4*)(xs + c + 4);
            *(f32x4*)(XR + (size_t)row * DM + c) = a; *(f32x4*)(XR + (size_t)row * DM + c + 4) = b;
            ss += (a[0] * a[0] + a[1] * a[1]) + (a[2] * a[2] + a[3] * a[3]) + (b[0] * b[0] + b[1] * b[1]) + (b[2] * b[2] + b[3] * b[3]);
            const f32x4 ga = *(const f32x4*)(g0 + c), gb = *(const f32x4*)(g0 + c + 4);
            *(v4u*)(XGA + (size_t)row * DM + c) = pack8(a * ga, b * gb);
        }
        ss = wave_sum(ss, lane);
        if (lane < 16) SSA[(size_t)row * 16 + lane] = (lane == 0) ? ss : 0.f;
#pragma unroll
        for (int l = 0; l < 2; ++l) {
            const float* ps = (row < MP) ? KIN(8) + ((size_t)l * MP + row) * PLE : KIN(9) + ((size_t)l * MS + (row - MP)) * PLE;
            const f32x4 a = *(const f32x4*)(ps + lane * 4);
            v2u o; o.x = pk2(a[0], a[1]); o.y = pk2(a[2], a[3]);
            *(v2u*)(P16 + ((size_t)l * MROWS + row) * PLE + lane * 4) = o;
        }
    }
    const int gt = F.bid * NTHREADS + F.tid, NGT = F.G * NTHREADS;
    f32x2* ROT = (f32x2*)(ws + WS_ROT);
    for (int e = gt; e < TP * 64; e += NGT) {
        const int pos = e >> 6, i = e & 63;
        const float x = (float)i * (1.0f / 63.0f);
        const float inv = exp2f(-x * 13.287712379549449f);
        const float ang = (float)pos * inv;
        const double rev = (double)ang * 0.15915494309189535;
        const float fr = (float)(rev - floor(rev));
        ROT[e] = (f32x2){__builtin_amdgcn_cosf(fr), __builtin_amdgcn_sinf(fr)};
    }
    {
        const float* src = KIN(3); float* dst = KOUT() + O_WINS;
        constexpr int NE = 2 * 128 * 508 * 64;
        for (int e0 = gt; e0 < NE; e0 += 8 * NGT) {
            f32x4 v[8];
#pragma unroll
            for (int u = 0; u < 8; ++u) { const int e = e0 + u * NGT; const int ec = e < NE ? e : NE - 1; const int ls = ec / (508 * 64), r = ec % (508 * 64);
                v[u] = *(const f32x4*)(src + (size_t)ls * 512 * 256 + 4 * 256 + (size_t)r * 4); }
#pragma unroll
            for (int u = 0; u < 8; ++u) { const int e = e0 + u * NGT; if (e < NE) { const int ls = e / (508 * 64), r = e % (508 * 64); *(f32x4*)(dst + (size_t)ls * 512 * 256 + (size_t)r * 4) = v[u]; } }
        }
    }
}
DI float gelu_tanh(float x) { const float u = 0.7978845608028654f * (x + 0.044715f * x * x * x); const float e = __expf(2.f * u); return 0.5f * x * (1.f + (1.f - 2.f / (e + 1.f))); }
DI bf16x8 mk_frag(v2u a, v2u b) { v4u w; w.x = a.x; w.y = a.y; w.z = b.x; w.w = b.y; return __builtin_bit_cast(bf16x8, w); }

template <bool sample> DI void compress_job_t(Frame& F, int layer, int job) {
    int lane = F.lane, wave = F.wave; asm volatile("" : "+v"(lane), "+s"(wave));
    const int tid = wave * 64 + lane, quad = lane >> 4, rl = lane & 15;
    unsigned char* ws = KWS();
    int kv, bs, g0, nbase;
    if (sample) { kv = job >> 7; bs = job & 127; g0 = 0; nbase = 0; }
    else { const int j2 = job - 256; kv = j2 >> 3; bs = (j2 >> 2) & 1; g0 = (j2 >> 1) & 1; nbase = (j2 & 1) * 256; }
    const bf16* W1T = (const bf16*)(ws + WS_W1T + layer * SZ_W1T) + (size_t)kv * 64 * 2048;
    const bf16* W2T = (const bf16*)(ws + WS_W2T + layer * SZ_W2T) + (size_t)kv * 64 * 64;
    const float* pe = KIN(12) + (size_t)(layer * 2 + kv) * 32 * 64;
    const bf16* Z = (const bf16*)(ws + WS_Z);
    const int* pt = (const int*)KIN(7);
    const float* cache = KIN(2);
    LAS unsigned char* LW = F.lds;
    int gg[2], nn[2];
    size_t pb0[2], pb1[2];
#pragma unroll
    for (int tl = 0; tl < 2; ++tl) { const int T = 2 * wave + tl; if (sample) { gg[tl] = T >> 3; nn[tl] = 16 * (T & 7) + rl; } else { gg[tl] = g0; nn[tl] = nbase + 16 * T + rl; }
        pb0[tl] = 0; pb1[tl] = 0;
        if (sample) { const int p0 = (16 * nn[tl]) >> 7; const int p1 = p0 + 1 > 15 ? 15 : p0 + 1;
            pb0[tl] = (size_t)(layer * 2560 + pt[bs * 16 + p0]) * 128 * 512; pb1[tl] = (size_t)(layer * 2560 + pt[bs * 16 + p1]) * 128 * 512; } }
    f32x4 h[2][4];
#pragma unroll
    for (int tl = 0; tl < 2; ++tl)
#pragma unroll
        for (int i = 0; i < 4; ++i) h[tl][i] = (f32x4){0.f, 0.f, 0.f, 0.f};
#pragma unroll 1
    for (int c = 0; c < 4; ++c) {
        __syncthreads();
#pragma unroll
        for (int k = 0; k < 8; ++k) { const int pc = tid + 512 * k, r = pc >> 6, c16 = pc & 63;
            *(LAS v4u*)(LW + r * 1040 + c16 * 16) = *(const v4u*)(W1T + (size_t)r * 2048 + c * 512 + c16 * 8); }
        __syncthreads();
#pragma unroll 8
        for (int kk = 0; kk < 16; ++kk) {
            const int j = 8 * c + (kk >> 1), dim0 = (kk & 1) * 32 + quad * 8;
            const f32x4 pe0 = *(const f32x4*)(pe + j * 64 + dim0), pe1 = *(const f32x4*)(pe + j * 64 + dim0 + 4);
            bf16x8 xb[2];
#pragma unroll
            for (int tl = 0; tl < 2; ++tl) {
                f32x4 x0, x1;
                if (!sample) { const size_t row = (size_t)bs * TP + 16 * nn[tl] + j; unpack8(*(const v4u*)(Z + row * LDZ + ZC_KC + kv * 128 + gg[tl] * 64 + dim0), x0, x1); }
                else { int pos = 16 * nn[tl] + j; pos = pos > 2047 ? 2047 : pos;
                    const float* p = cache + (((pos >> 7) == ((16 * nn[tl]) >> 7)) ? pb0[tl] : pb1[tl]) + (size_t)(pos & 127) * 512 + kv * 128 + gg[tl] * 64 + dim0; x0 = *(const f32x4*)p; x1 = *(const f32x4*)(p + 4); }
                xb[tl] = pack_frag(x0 + pe0, x1 + pe1);
            }
#pragma unroll
            for (int ht = 0; ht < 4; ++ht) {
                const bf16x8 a = ld_frag_l(LW + (16 * ht + rl) * 1040 + (kk * 32 + quad * 8) * 2);
                h[0][ht] = mfma16(a, xb[0], h[0][ht]); h[1][ht] = mfma16(a, xb[1], h[1][ht]);
            }
        }
    }
#pragma unroll
    for (int tl = 0; tl < 2; ++tl) {
#pragma unroll
        for (int ht = 0; ht < 4; ++ht)
#pragma unroll
            for (int i = 0; i < 4; ++i) h[tl][ht][i] = gelu_tanh(h[tl][ht][i]);
        bf16x8 gb[2]; gb[0] = pack_frag(h[tl][0], h[tl][1]); gb[1] = pack_frag(h[tl][2], h[tl][3]);
        const int n = nn[tl], g = gg[tl];
        bf16* dst = sample ? (bf16*)(ws + WS_KCS) + ((((size_t)kv * 128 + bs) * 128 + n) * 2 + g) * 64 : (bf16*)(ws + WS_KC) + ((((size_t)kv * 2 + bs) * 512 + n) * 2 + g) * 64;
        const bool zero = sample && n == 127;
#pragma unroll
        for (int ot = 0; ot < 4; ++ot) {
            f32x4 o = (f32x4){0.f, 0.f, 0.f, 0.f};
#pragma unroll
            for (int s = 0; s < 2; ++s) {
                const bf16* wp = W2T + (16 * ot + rl) * 64 + 32 * s + 4 * quad;
                o = mfma16(mk_frag(*(const v2u*)wp, *(const v2u*)(wp + 16)), gb[s], o);
            }
            v2u w; w.x = zero ? 0u : pk2(o[0], o[1]); w.y = zero ? 0u : pk2(o[2], o[3]);
            *(v2u*)(dst + 16 * ot + 4 * quad) = w;
        }
    }
    __syncthreads();
}

DI v2u pack4(const f32x4 v) { v2u w; w.x = pk2(v[0], v[1]); w.y = pk2(v[2], v[3]); return w; }
DI void compress_sample_job(Frame& F, int layer, int job) {
    int lane = F.lane, wave = F.wave; asm volatile("" : "+v"(lane), "+s"(wave));
    const int tid = wave * 64 + lane, quad = lane >> 4, rl = lane & 15;
    unsigned char* ws = KWS();
    const int kv = job >> 7, bs = job & 127;
    const bf16* W1T = (const bf16*)(ws + WS_W1T + layer * SZ_W1T) + (size_t)kv * 64 * 2048;
    const bf16* W2T = (const bf16*)(ws + WS_W2T + layer * SZ_W2T) + (size_t)kv * 64 * 64;
    const float* pe = KIN(12) + (size_t)(layer * 2 + kv) * 32 * 64;
    const int* pt = (const int*)KIN(7);
    const float* cache = KIN(2);
    LAS unsigned char* XS = F.lds;
    LAS unsigned char* WS1 = F.lds + 69632;
    size_t toff[8];
#pragma unroll
    for (int k = 0; k < 8; ++k) { const int q = tid + 512 * k, m = q >> 5; const int pos = 16 * m; const int phys = pt[bs * 16 + (pos >> 7)];
        toff[k] = ((size_t)(layer * 2560 + phys) * 128 + (pos & 127)) * 512 + kv * 128 + 4 * (q & 31); }
    const int wr_ = tid >> 3, wc_ = tid & 7;
    int gg[2], nn[2];
#pragma unroll
    for (int tl = 0; tl < 2; ++tl) { const int T = 2 * wave + tl; gg[tl] = T >> 3; nn[tl] = 16 * (T & 7) + rl; }
    f32x4 h[2][4];
#pragma unroll
    for (int tl = 0; tl < 2; ++tl)
#pragma unroll
        for (int i = 0; i < 4; ++i) h[tl][i] = (f32x4){0.f, 0.f, 0.f, 0.f};
    f32x4 xr[8]; v4u wr2[2];
#define CS_ISSUE(r_) do { _Pragma("unroll") for (int k = 0; k < 8; ++k) xr[k] = *(const f32x4*)(cache + toff[k] + (size_t)(r_) * 512); \
        _Pragma("unroll") for (int u = 0; u < 2; ++u) wr2[u] = *(const v4u*)(W1T + (size_t)wr_ * 2048 + ((r_) + 16 * u) * 64 + wc_ * 8); } while (0)
    CS_ISSUE(0);
#pragma unroll 1
    for (int r = 0; r < 16; ++r) {
        __syncthreads();
#pragma unroll
        for (int k = 0; k < 8; ++k) { const int q = tid + 512 * k, m = q >> 5, c = q & 31, d = 4 * (c & 15);
#pragma unroll
            for (int u = 0; u < 2; ++u) { const f32x4 v = xr[k] + *(const f32x4*)(pe + (r + 16 * u) * 64 + d);
                *(LAS v2u*)(XS + u * 34816 + m * 272 + c * 8) = pack4(v); } }
#pragma unroll
        for (int u = 0; u < 2; ++u) *(LAS v4u*)(WS1 + u * 9216 + wr_ * 144 + wc_ * 16) = wr2[u];
        __syncthreads();
        { const int rn = r + 1 < 16 ? r + 1 : 15; CS_ISSUE(rn); }
#pragma unroll
        for (int u = 0; u < 2; ++u)
#pragma unroll
            for (int ks = 0; ks < 2; ++ks) {
                bf16x8 xb[2];
#pragma unroll
                for (int tl = 0; tl < 2; ++tl) { int m = nn[tl] + u; m = m > 127 ? 127 : m; xb[tl] = ld_frag_l(XS + u * 34816 + m * 272 + gg[tl] * 128 + ks * 64 + quad * 16); }
#pragma unroll
                for (int ht = 0; ht < 4; ++ht) { const bf16x8 a = ld_frag_l(WS1 + u * 9216 + (16 * ht + rl) * 144 + ks * 64 + quad * 16);
                    h[0][ht] = mfma16(a, xb[0], h[0][ht]); h[1][ht] = mfma16(a, xb[1], h[1][ht]); }
            }
    }
#undef CS_ISSUE
#pragma unroll
    for (int tl = 0; tl < 2; ++tl) {
#pragma unroll
        for (int ht = 0; ht < 4; ++ht)
#pragma unroll
            for (int i = 0; i < 4; ++i) h[tl][ht][i] = gelu_tanh(h[tl][ht][i]);
        bf16x8 gb[2]; gb[0] = pack_frag(h[tl][0], h[tl][1]); gb[1] = pack_frag(h[tl][2], h[tl][3]);
        const int n = nn[tl], g = gg[tl];
        bf16* dst = (bf16*)(ws + WS_KCS) + ((((size_t)kv * 128 + bs) * 128 + n) * 2 + g) * 64;
        const bool zero = n == 127;
#pragma unroll
        for (int ot = 0; ot < 4; ++ot) {
            f32x4 o = (f32x4){0.f, 0.f, 0.f, 0.f};
#pragma unroll
            for (int s = 0; s < 2; ++s) {
                const bf16* wp = W2T + (16 * ot + rl) * 64 + 32 * s + 4 * quad;
                o = mfma16(mk_frag(*(const v2u*)wp, *(const v2u*)(wp + 16)), gb[s], o);
            }
            v2u w; w.x = zero ? 0u : pk2(o[0], o[1]); w.y = zero ? 0u : pk2(o[2], o[3]);
            *(v2u*)(dst + 16 * ot + 4 * quad) = w;
        }
    }
    __syncthreads();
}
DI void compress_job(Frame& F, int layer, int job) { if (job < 256) compress_sample_job(F, layer, job); else compress_job_t<false>(F, layer, job); }
#ifndef PH_GPT
#define PH_GPT (-1)
#endif
#if PH_GPT >= 0
#define GP_T(k) do { if (tid == 0) { volatile LAS unsigned long long* gp_ = (volatile LAS unsigned long long*)(F.lds + LDSCTL_OFF + 448); const unsigned long long now_ = __builtin_amdgcn_s_memrealtime(); \
    if ((k) == PH_GPT) gp_[0] += now_ - gp_[1]; gp_[1] = now_; } } while (0)
#else
#define GP_T(k) do { } while (0)
#endif
DI int kperm(int idx) { const int s = idx >> 5, r = idx & 31; return 32 * s + 8 * ((r >> 2) & 3) + 4 * (r >> 4) + (r & 3); }
DI float softplusf_(float x) { return x > 20.f ? x : __logf(1.f + __expf(x)); }
DI float ret_lg(int h) { return h == 0 ? -0.031748697f : h == 1 ? -0.015748357f : h == 2 ? -0.007843178f : -0.0039138994f; }

DI void gdn_prep_unit(Frame& F, int layer, int unit) {
    int lane = F.lane, wave = F.wave; asm volatile("" : "+v"(lane), "+s"(wave));
    const int tid = wave * 64 + lane;
    const int b = unit >> 9, h = (unit >> 7) & 3, c = unit & 127;
    const int row0 = b * TP + 64 * c, t0 = 64 * c;
    GP_T(0);
    unsigned char* ws = KWS();
    const bf16* Z = (const bf16*)(ws + WS_Z);
    const float* ZS = (const float*)(ws + WS_ZS);
    LAS float* Lq = (LAS float*)(F.lds); LAS float* Lk = (LAS float*)(F.lds + 33792); LAS float* Lv = (LAS float*)(F.lds + 67584);
    LAS float* LA = (LAS float*)(F.lds + 101376); LAS float* LQK = (LAS float*)(F.lds + 117760);
    LAS float* Lg = (LAS float*)(F.lds + 134144); LAS float* Lb = Lg + 64; LAS float* Le = Lg + 128;
    const float* cw = KIN(15) + (size_t)layer * 4 * 1536;
    {
        v4u xs[6][4];
#pragma unroll
        for (int it0 = 0; it0 < 6; ++it0) {
            const int it = tid + it0 * NTHREADS, i = it / 48, ch = it % 48, col = (ch >> 4) * 512 + h * 128 + (ch & 15) * 8;
#pragma unroll
            for (int j = 0; j < 4; ++j) { const bool ok = (t0 + i - 3 + j) >= 0; xs[it0][j] = *(const v4u*)(Z + (size_t)(ok ? row0 + i - 3 + j : row0) * LDZ + ZC_GQKV + col); }
        }
        asm volatile("" ::: "memory");
#pragma unroll
        for (int it0 = 0; it0 < 6; ++it0) {
            const int it = tid + it0 * NTHREADS, i = it / 48, ch = it % 48, part = ch >> 4, cc = ch & 15;
            const int col = part * 512 + h * 128 + cc * 8;
            f32x4 y0 = (f32x4){0.f, 0.f, 0.f, 0.f}, y1 = y0;
#pragma unroll
            for (int j = 0; j < 4; ++j) {
                const float zf = ((t0 + i - 3 + j) >= 0) ? 1.f : 0.f;
                f32x4 x0, x1; unpack8(xs[it0][j], x0, x1);
                y0 += x0 * (*(const f32x4*)(cw + j * 1536 + col) * zf); y1 += x1 * (*(const f32x4*)(cw + j * 1536 + col + 4) * zf);
            }
#pragma unroll
            for (int e = 0; e < 4; ++e) { y0[e] = siluf_(y0[e]); y1[e] = siluf_(y1[e]); }
            LAS float* dst = (part == 0 ? Lq : part == 1 ? Lk : Lv) + i * 132 + cc * 8;
            *(LAS f32x4*)dst = y0; *(LAS f32x4*)(dst + 4) = y1;
        }
    }
    __syncthreads();
    GP_T(1);
    {
        float va[16], vb[16], ps[16];
#pragma unroll
        for (int q = 0; q < 16; ++q) { LAS float* vp = ((q < 8) ? Lq : Lk) + (wave * 8 + (q & 7)) * 132 + lane * 2; va[q] = vp[0]; vb[q] = vp[1]; ps[q] = va[q] * va[q] + vb[q] * vb[q]; }
#pragma unroll
        for (int q = 0; q < 16; ++q) ps[q] += shx<1>(ps[q], lane);
#pragma unroll
        for (int q = 0; q < 16; ++q) ps[q] += shx<2>(ps[q], lane);
#pragma unroll
        for (int q = 0; q < 16; ++q) ps[q] += shx<4>(ps[q], lane);
#pragma unroll
        for (int q = 0; q < 16; ++q) ps[q] += shx<8>(ps[q], lane);
#pragma unroll
        for (int q = 0; q < 16; ++q) ps[q] += shx<16>(ps[q], lane);
#pragma unroll
        for (int q = 0; q < 16; ++q) ps[q] += shx<32>(ps[q], lane);
#pragma unroll
        for (int q = 0; q < 16; ++q) { LAS float* vp = ((q < 8) ? Lq : Lk) + (wave * 8 + (q & 7)) * 132 + lane * 2; const float sc = rsqrtf(ps[q] + EPS) * ((q < 8) ? 0.08838834764831845f : 1.f); vp[0] = va[q] * sc; vp[1] = vb[q] * sc; }
    }
    if (wave == 0) {
        const float ga = ZS[(size_t)(row0 + lane) * 32 + 24 + h], gbv = ZS[(size_t)(row0 + lane) * 32 + 28 + h];
        float g = -__expf(KIN(16)[layer * 4 + h]) * softplusf_(ga + KIN(17)[layer * 4 + h]);
#pragma unroll
        for (int o = 1; o < 64; o <<= 1) { const float t = __int_as_float(__builtin_amdgcn_ds_bpermute(((lane - o) & 63) << 2, __float_as_int(g))); if (lane >= o) g += t; }
        Lg[lane] = g; Lb[lane] = sigmoidf_(gbv); Le[lane] = __expf(g);
    }
    __syncthreads();
    GP_T(2);
    {
        const int it = wave >> 1, quad = lane >> 4, rl = lane & 15;
        f32x4 ckk[2], cqk[2];
#pragma unroll
        for (int jj = 0; jj < 2; ++jj) { ckk[jj] = (f32x4){0.f, 0.f, 0.f, 0.f}; cqk[jj] = ckk[jj]; }
#pragma unroll
        for (int s = 0; s < 4; ++s) {
            const LAS float* kp = Lk + (16 * it + rl) * 132 + 32 * s + 8 * quad; const LAS float* qp = Lq + (16 * it + rl) * 132 + 32 * s + 8 * quad;
            const f32x4 ka0 = *(const LAS f32x4*)kp, ka1 = *(const LAS f32x4*)(kp + 4), qa0 = *(const LAS f32x4*)qp, qa1 = *(const LAS f32x4*)(qp + 4);
            const bf16x8 kah = pack_frag(ka0, ka1), qah = pack_frag(qa0, qa1);
            f32x4 h0, h1; unpack8(__builtin_bit_cast(v4u, kah), h0, h1); const bf16x8 kal = pack_frag(ka0 - h0, ka1 - h1);
            unpack8(__builtin_bit_cast(v4u, qah), h0, h1); const bf16x8 qal = pack_frag(qa0 - h0, qa1 - h1);
#pragma unroll
            for (int jj = 0; jj < 2; ++jj) {
                const int jt = (wave & 1) * 2 + jj;
                if (jt <= it) {
                    const LAS float* bp = Lk + (16 * jt + rl) * 132 + 32 * s + 8 * quad;
                    const f32x4 kb0 = *(const LAS f32x4*)bp, kb1 = *(const LAS f32x4*)(bp + 4);
                    const bf16x8 kbh = pack_frag(kb0, kb1); unpack8(__builtin_bit_cast(v4u, kbh), h0, h1); const bf16x8 kbl = pack_frag(kb0 - h0, kb1 - h1);
                    ckk[jj] = mfma16(kah, kbh, ckk[jj]); ckk[jj] = mfma16(kah, kbl, ckk[jj]); ckk[jj] = mfma16(kal, kbh, ckk[jj]);
                    cqk[jj] = mfma16(qah, kbh, cqk[jj]); cqk[jj] = mfma16(qah, kbl, cqk[jj]); cqk[jj] = mfma16(qal, kbh, cqk[jj]);
                }
            }
        }
#pragma unroll
        for (int jj = 0; jj < 2; ++jj) {
            const int j = 16 * ((wave & 1) * 2 + jj) + rl; const float gj = Lg[j];
#pragma unroll
            for (int e = 0; e < 4; ++e) { const int i = 16 * it + 4 * quad + e; const float dec = (i >= j) ? __expf(Lg[i] - gj) : 0.f;
                LA[i * 64 + j] = (i > j) ? Lb[i] * ckk[jj][e] * dec : 0.f; LQK[i * 64 + j] = cqk[jj][e] * dec; }
        }
    }
    __syncthreads();
    GP_T(3);
    unsigned char* rec = ws + WS_GREC + (size_t)unit * GREC;
    LAS float* TI = (LAS float*)(F.lds + 135168);
    if (tid < 64) {
        const int B = tid >> 4, c = tid & 15;
        float tc[16];
#pragma unroll
        for (int i = 0; i < 16; ++i) {
            float s0 = (i == c) ? 1.f : 0.f;
#pragma unroll
            for (int j = 0; j < i; ++j) s0 -= LA[(16 * B + i) * 64 + 16 * B + j] * tc[j];
            tc[i] = s0;
        }
#pragma unroll
        for (int i = 0; i < 16; ++i) TI[B * 256 + i * 16 + c] = tc[i];
    }
    {
        const float gl = Lg[63];
        for (int it = tid; it < 2560; it += NTHREADS) {
            if (it < 1024) {
                const int i = it >> 4, s = (it >> 2) & 3, quad = it & 3; const float e = Le[i];
                const f32x4 a = *(const LAS f32x4*)(Lq + i * 132 + 32 * s + 4 * quad) * e, bq = *(const LAS f32x4*)(Lq + i * 132 + 32 * s + 16 + 4 * quad) * e;
                *(v4u*)(rec + 16384 + i * 256 + (32 * s + 8 * quad) * 2) = pack8(a, bq);
            } else if (it < 2048) {
                const int r = it - 1024, dk = r >> 3, s2 = (r >> 2) & 1, quad = r & 3;
                f32x4 a, bq;
#pragma unroll
                for (int e = 0; e < 4; ++e) { const int ta = 32 * s2 + 4 * quad + e, tb = ta + 16; a[e] = Lk[ta * 132 + dk] * __expf(gl - Lg[ta]); bq[e] = Lk[tb * 132 + dk] * __expf(gl - Lg[tb]); }
                *(v4u*)(rec + 32768 + dk * 128 + (32 * s2 + 8 * quad) * 2) = pack8(a, bq);
            } else {
                const int r = it - 2048, i = r >> 3, s2 = (r >> 2) & 1, quad = r & 3;
                const f32x4 a = *(const LAS f32x4*)(LQK + i * 64 + 32 * s2 + 4 * quad), bq = *(const LAS f32x4*)(LQK + i * 64 + 32 * s2 + 16 + 4 * quad);
                *(v4u*)(rec + 65536 + i * 128 + (32 * s2 + 8 * quad) * 2) = pack8(a, bq);
            }
        }
        if (tid == 0) *(float*)(rec + 73728) = __expf(gl);
    }
    __syncthreads();
    GP_T(4);
    {
        const int col = tid & 255, hb = tid >> 8;
        LAS float* X = (col < 128) ? (Lv + col) : (Lk + (col - 128));
        const bool isw = col >= 128;
#pragma unroll 1
        for (int B = 0; B < 4; ++B) {
            float xb[8];
#pragma unroll
            for (int i = 0; i < 8; ++i) { const int r = 16 * B + 8 * hb + i; xb[i] = (isw ? Lb[r] * Le[r] : Lb[r]) * X[r * 132]; }
#pragma unroll 2
            for (int j4 = 0; j4 < 4 * B; ++j4) {
                const float x0 = X[(4 * j4) * 132], x1 = X[(4 * j4 + 1) * 132], x2 = X[(4 * j4 + 2) * 132], x3 = X[(4 * j4 + 3) * 132];
#pragma unroll
                for (int i = 0; i < 8; ++i) { const f32x4 a = *(const LAS f32x4*)(LA + (16 * B + 8 * hb + i) * 64 + 4 * j4); xb[i] -= (a[0] * x0 + a[1] * x1) + (a[2] * x2 + a[3] * x3); }
            }
#pragma unroll
            for (int i = 0; i < 8; ++i) X[(16 * B + 8 * hb + i) * 132] = xb[i];
            __syncthreads();
            float r[16];
#pragma unroll
            for (int jj = 0; jj < 16; ++jj) r[jj] = X[(16 * B + jj) * 132];
            __syncthreads();
#pragma unroll
            for (int i = 0; i < 8; ++i) {
                float s0 = 0.f, s1 = 0.f;
#pragma unroll
                for (int j4 = 0; j4 < 4; ++j4) { const f32x4 a = *(const LAS f32x4*)(TI + B * 256 + (8 * hb + i) * 16 + 4 * j4);
                    s0 += a[0] * r[4 * j4] + a[2] * r[4 * j4 + 2]; s1 += a[1] * r[4 * j4 + 1] + a[3] * r[4 * j4 + 3]; }
                X[(16 * B + 8 * hb + i) * 132] = s0 + s1;
            }
            __syncthreads();
        }
    }
    __syncthreads();
    GP_T(5);
    for (int it = tid; it < 2048; it += NTHREADS) {
        if (it < 1024) {
            const int dv = it >> 3, q = it & 7;
            v4u w; w.x = pk2(Lv[(8 * q) * 132 + dv], Lv[(8 * q + 1) * 132 + dv]); w.y = pk2(Lv[(8 * q + 2) * 132 + dv], Lv[(8 * q + 3) * 132 + dv]);
            w.z = pk2(Lv[(8 * q + 4) * 132 + dv], Lv[(8 * q + 5) * 132 + dv]); w.w = pk2(Lv[(8 * q + 6) * 132 + dv], Lv[(8 * q + 7) * 132 + dv]);
            *(v4u*)(rec + 49152 + dv * 128 + q * 16) = w;
        } else {
            const int r = it - 1024, i = r >> 4, s = (r >> 2) & 3, quad = r & 3;
            const f32x4 a = *(const LAS f32x4*)(Lk + i * 132 + 32 * s + 4 * quad), bq = *(const LAS f32x4*)(Lk + i * 132 + 32 * s + 16 + 4 * quad);
            *(v4u*)(rec + i * 256 + (32 * s + 8 * quad) * 2) = pack8(a, bq);
        }
    }
    __syncthreads();
    GP_T(6);
}

DI void ret_prep_unit(Frame& F, int layer, int unit) {
    int lane = F.lane, wave = F.wave; asm volatile("" : "+v"(lane), "+s"(wave));
    const int tid = wave * 64 + lane, quad = lane >> 4, rl = lane & 15;
    const int b = unit >> 8, h = (unit >> 6) & 3, c = unit & 63;
    const int row0 = b * TP + 128 * c;
    unsigned char* ws = KWS();
    const bf16* Z = (const bf16*)(ws + WS_Z);
    const f32x2* ROT = (const f32x2*)(ws + WS_ROT);
    bf16* QR = (bf16*)(ws + WS_QR); bf16* KR = (bf16*)(ws + WS_KR);
    LAS unsigned char* LK = F.lds; LAS unsigned char* LV = F.lds + 34816;
    const float lg = ret_lg(h);
    for (int it = tid; it < 1024; it += NTHREADS) {
        const int j = it >> 3, cc = it & 7, d0 = cc * 8;
        const size_t zr = (size_t)(row0 + j) * LDZ + ZC_RQKV + h * 128 + d0;
        f32x4 q1a, q1b, q2a, q2b, k1a, k1b, k2a, k2b;
        unpack8(*(const v4u*)(Z + zr), q1a, q1b); unpack8(*(const v4u*)(Z + zr + 64), q2a, q2b);
        unpack8(*(const v4u*)(Z + zr + 512), k1a, k1b); unpack8(*(const v4u*)(Z + zr + 512 + 64), k2a, k2b);
        const f32x2* rp = ROT + (size_t)(128 * c + j) * 64 + d0;
        const float kd = __expf((float)(127 - j) * lg);
        f32x4 oq1a, oq1b, oq2a, oq2b, ok1a, ok1b, ok2a, ok2b;
#pragma unroll
        for (int e = 0; e < 8; ++e) {
            const f32x2 cs = rp[e];
            const float q1 = e < 4 ? q1a[e & 3] : q1b[e & 3], q2 = e < 4 ? q2a[e & 3] : q2b[e & 3], k1 = e < 4 ? k1a[e & 3] : k1b[e & 3], k2 = e < 4 ? k2a[e & 3] : k2b[e & 3];
            const float rq1 = q1 * cs.x - q2 * cs.y, rq2 = q2 * cs.x + q1 * cs.y, rk1 = (k1 * cs.x - k2 * cs.y) * 0.08838834764831845f, rk2 = (k2 * cs.x + k1 * cs.y) * 0.08838834764831845f;
            if (e < 4) { oq1a[e & 3] = rq1; oq2a[e & 3] = rq2; ok1a[e & 3] = rk1; ok2a[e & 3] = rk2; } else { oq1b[e & 3] = rq1; oq2b[e & 3] = rq2; ok1b[e & 3] = rk1; ok2b[e & 3] = rk2; }
            *(LAS bf16*)(LK + (d0 + e) * 272 + j * 2) = (bf16)f2bf(rk1 * kd); *(LAS bf16*)(LK + (d0 + 64 + e) * 272 + j * 2) = (bf16)f2bf(rk2 * kd);
        }
        const size_t orow = (size_t)(row0 + j) * 512 + h * 128 + d0;
        *(v4u*)(QR + orow) = pack8(oq1a, oq1b); *(v4u*)(QR + orow + 64) = pack8(oq2a, oq2b);
        *(v4u*)(KR + orow) = pack8(ok1a, ok1b); *(v4u*)(KR + orow + 64) = pack8(ok2a, ok2b);
    }
    for (int it = tid; it < 2048; it += NTHREADS) {
        const int j = it >> 4, cc = it & 15;
        const v4u w = *(const v4u*)(Z + (size_t)(row0 + j) * LDZ + ZC_RQKV + 1024 + h * 128 + cc * 8);
        LAS unsigned char* d = LV + (cc * 8) * 272 + j * 2;
        *(LAS bf16*)(d) = (bf16)(w.x & 0xffff); *(LAS bf16*)(d + 272) = (bf16)(w.x >> 16); *(LAS bf16*)(d + 2 * 272) = (bf16)(w.y & 0xffff); *(LAS bf16*)(d + 3 * 272) = (bf16)(w.y >> 16);
        *(LAS bf16*)(d + 4 * 272) = (bf16)(w.z & 0xffff); *(LAS bf16*)(d + 5 * 272) = (bf16)(w.z >> 16); *(LAS bf16*)(d + 6 * 272) = (bf16)(w.w & 0xffff); *(LAS bf16*)(d + 7 * 272) = (bf16)(w.w >> 16);
    }
    __syncthreads();
    float* RKV = (float*)(ws + WS_RKV) + (size_t)unit * 16384;
#pragma unroll
    for (int nt = 0; nt < 8; ++nt) {
        f32x4 acc = (f32x4){0.f, 0.f, 0.f, 0.f};
#pragma unroll
        for (int s = 0; s < 4; ++s) acc = mfma16(ld_frag_l(LK + (16 * wave + rl) * 272 + (32 * s + 8 * quad) * 2), ld_frag_l(LV + (16 * nt + rl) * 272 + (32 * s + 8 * quad) * 2), acc);
#pragma unroll
        for (int i = 0; i < 4; ++i) RKV[(size_t)(16 * wave + 4 * quad + i) * 128 + 16 * nt + rl] = acc[i];
    }
    __syncthreads();
}
DI void sample_rec_unit(Frame& F, int layer, int unit) {
    int lane = F.lane, wave = F.wave; asm volatile("" : "+v"(lane), "+s"(wave));
    const int tid = wave * 64 + lane;
    const int kind = unit >> 9, s = (unit >> 2) & 127, h = unit & 3;
    const int dv = tid & 127, part = tid >> 7, r0 = MP + 4 * s;
    unsigned char* ws = KWS();
    const bf16* Z = (const bf16*)(ws + WS_Z);
    const float* ZS = (const float*)(ws + WS_ZS);
    LAS float* Lq = (LAS float*)(F.lds); LAS float* Lk = Lq + 512; LAS float* Lv = Lq + 1024; LAS float* red = Lq + 1536; LAS float* Lo = Lq + 2048; LAS float* sc = Lq + 2560;
    float S[32];
    if (kind == 0) {
        if (tid < 384) {
            const int pr = tid >> 7, d = tid & 127, col = pr * 512 + h * 128 + d;
            float xp[7], w[4];
#pragma unroll
            for (int i = 0; i < 3; ++i) xp[i] = KIN(4)[((size_t)(layer * 128 + s) * 3 + i) * 1536 + col];
#pragma unroll
            for (int j = 0; j < 4; ++j) xp[3 + j] = bf2f(Z[(size_t)(r0 + j) * LDZ + ZC_GQKV + col]);
#pragma unroll
            for (int i = 0; i < 4; ++i) w[i] = KIN(15)[(size_t)(layer * 4 + i) * 1536 + col];
            LAS float* dst = pr == 0 ? Lq : pr == 1 ? Lk : Lv;
#pragma unroll
            for (int j = 0; j < 4; ++j) dst[j * 128 + d] = siluf_(w[0] * xp[j] + w[1] * xp[j + 1] + w[2] * xp[j + 2] + w[3] * xp[j + 3]);
        }
        __syncthreads();
        {
            LAS float* vp = (wave < 4 ? Lq : Lk) + (wave & 3) * 128;
            const float a = vp[2 * lane], b = vp[2 * lane + 1];
            const float scl = rsqrtf(wave_sum(a * a + b * b, lane) + EPS) * (wave < 4 ? 0.08838834764831845f : 1.f);
            vp[2 * lane] = a * scl; vp[2 * lane + 1] = b * scl;
        }
        if (tid < 4) {
            const float ga = ZS[(size_t)(r0 + tid) * 32 + 24 + h], gb = ZS[(size_t)(r0 + tid) * 32 + 28 + h];
            sc[tid] = __expf(-__expf(KIN(16)[layer * 4 + h]) * softplusf_(ga + KIN(17)[layer * 4 + h])); sc[4 + tid] = sigmoidf_(gb);
        }
        __syncthreads();
        const float* Sin = KIN(5) + ((size_t)((layer * 128 + s) * 4 + h) * 128 + 32 * part) * 128 + dv;
#pragma unroll
        for (int i = 0; i < 32; ++i) S[i] = Sin[(size_t)i * 128];
#pragma unroll
        for (int j = 0; j < 4; ++j) {
            const float a = sc[j], beta = sc[4 + j];
            float p = 0.f;
#pragma unroll
            for (int i = 0; i < 32; ++i) { S[i] *= a; p += Lk[j * 128 + 32 * part + i] * S[i]; }
            red[part * 128 + dv] = p;
            __syncthreads();
            const float delta = beta * (Lv[j * 128 + dv] - ((red[dv] + red[128 + dv]) + (red[256 + dv] + red[384 + dv])));
            __syncthreads();
            float o = 0.f;
#pragma unroll
            for (int i = 0; i < 32; ++i) { S[i] += Lk[j * 128 + 32 * part + i] * delta; o += Lq[j * 128 + 32 * part + i] * S[i]; }
            red[part * 128 + dv] = o;
            __syncthreads();
            if (part == 0) Lo[j * 128 + dv] = (red[dv] + red[128 + dv]) + (red[256 + dv] + red[384 + dv]);
            __syncthreads();
        }
        float* Sout = KOUT() + O_GSS + ((size_t)((layer * 128 + s) * 4 + h) * 128 + 32 * part) * 128 + dv;
#pragma unroll
        for (int i = 0; i < 32; ++i) Sout[(size_t)i * 128] = S[i];
        ((float*)(ws + WS_OGDN))[(size_t)(r0 + part) * 512 + h * 128 + dv] = Lo[part * 128 + dv];
    } else {
        const f32x2* ROT = (const f32x2*)(ws + WS_ROT);
        if (tid < 384) {
            const int pr = tid >> 7, d = tid & 127;
#pragma unroll
            for (int j = 0; j < 4; ++j) {
                const bf16* zp = Z + (size_t)(r0 + j) * LDZ + ZC_RQKV + pr * 512 + h * 128;
                float v = bf2f(zp[d]);
                if (pr < 2) { const f32x2 cs = ROT[(size_t)(2048 + j) * 64 + (d & 63)]; const float o = bf2f(zp[d ^ 64]);
                    v = (d < 64) ? v * cs.x - o * cs.y : v * cs.x + o * cs.y; if (pr == 1) v *= 0.08838834764831845f; }
                (pr == 0 ? Lq : pr == 1 ? Lk : Lv)[j * 128 + d] = v;
            }
        }
        __syncthreads();
        const float gam = __expf(ret_lg(h));
        const float* Sin = KIN(6) + ((size_t)((layer * 128 + s) * 4 + h) * 128 + 32 * part) * 128 + dv;
#pragma unroll
        for (int i = 0; i < 32; ++i) S[i] = Sin[(size_t)i * 128];
#pragma unroll
        for (int j = 0; j < 4; ++j) {
            const float vv = Lv[j * 128 + dv];
            float o = 0.f;
#pragma unroll
            for (int i = 0; i < 32; ++i) { S[i] = S[i] * gam + Lk[j * 128 + 32 * part + i] * vv; o += Lq[j * 128 + 32 * part + i] * S[i]; }
            red[part * 128 + dv] = o;
            __syncthreads();
            if (part == 0) Lo[j * 128 + dv] = (red[dv] + red[128 + dv]) + (red[256 + dv] + red[384 + dv]);
            __syncthreads();
        }
        float* Sout = KOUT() + O_RSS + ((size_t)((layer * 128 + s) * 4 + h) * 128 + 32 * part) * 128 + dv;
#pragma unroll
        for (int i = 0; i < 32; ++i) Sout[(size_t)i * 128] = S[i];
        if (wave < 4) {
            const int j = wave; const float a = Lo[j * 128 + 2 * lane], b = Lo[j * 128 + 2 * lane + 1];
            const float scl = rsqrtf(wave_sum(a * a + b * b, lane) * (1.f / 128.f) + EPS);
            const bf16* gp = Z + (size_t)(r0 + j) * LDZ + ZC_RG + h * 128 + 2 * lane;
            *(unsigned*)((bf16*)(ws + WS_MIX) + (size_t)(r0 + j) * 1536 + 1024 + h * 128 + 2 * lane) = pk2(a * scl * siluf_(bf2f(gp[0])), b * scl * siluf_(bf2f(gp[1])));
        }
    }
    __syncthreads();
}

DI void gdn_scan_chain(Frame& F, int layer, int bh) {
    int lane = F.lane, wave = F.wave; asm volatile("" : "+v"(lane), "+s"(wave));
    const int tid = wave * 64 + lane, quad = lane >> 4, rl = lane & 15;
    unsigned char* ws = KWS();
    const unsigned char* recb = ws + WS_GREC + (size_t)bh * 128 * GREC;
    LAS unsigned char* L = F.lds;
    constexpr int L_WP = 0, L_QP = 17408, L_KT = 34816, L_UT = 53248, L_QK = 71680;
    f32x4 S[8];
#pragma unroll
    for (int i = 0; i < 8; ++i) S[i] = (f32x4){0.f, 0.f, 0.f, 0.f};
    v4u pf[9]; float egl;
#pragma unroll
    for (int k = 0; k < 9; ++k) pf[k] = *(const v4u*)(recb + (size_t)(tid + 512 * k) * 16);
    egl = *(const float*)(recb + 73728);
    float* OG = (float*)(ws + WS_OGDN);
    const int b = bh >> 2, h = bh & 3;
    for (int c = 0; c < 128; ++c) {
        __syncthreads();
#pragma unroll
        for (int k = 0; k < 9; ++k) {
            const int o = tid * 16 + (k & 1) * 8192;
            const int reg = k >> 1;
            int dst;
            if (reg < 2) dst = (reg == 0 ? L_WP : L_QP) + (o >> 8) * 272 + (o & 255);
            else dst = (reg == 2 ? L_KT : reg == 3 ? L_UT : L_QK) + (o >> 7) * 144 + (o & 127);
            *(LAS v4u*)(L + dst) = pf[k];
        }
        const float eg = egl;
        __syncthreads();
        {
            const unsigned char* rn = recb + (size_t)(c + 1 < 128 ? c + 1 : 127) * GREC;
#pragma unroll
            for (int k = 0; k < 9; ++k) pf[k] = *(const v4u*)(rn + (size_t)(tid + 512 * k) * 16);
            egl = *(const float*)(rn + 73728);
        }
        bf16x8 Sb[4];
#pragma unroll
        for (int s = 0; s < 4; ++s) Sb[s] = pack_frag(S[2 * s], S[2 * s + 1]);
        f32x4 vn[4], O[4];
#pragma unroll
        for (int rt = 0; rt < 4; ++rt) {
            f32x4 wsacc = (f32x4){0.f, 0.f, 0.f, 0.f}, o = wsacc;
#pragma unroll
            for (int s = 0; s < 4; ++s) {
                wsacc = mfma16(ld_frag_l(L + L_WP + (16 * rt + rl) * 272 + (32 * s + 8 * quad) * 2), Sb[s], wsacc);
                o = mfma16(ld_frag_l(L + L_QP + (16 * rt + rl) * 272 + (32 * s + 8 * quad) * 2), Sb[s], o);
            }
            const v2u uw = *(const LAS v2u*)(L + L_UT + (16 * wave + rl) * 144 + (16 * rt + 4 * quad) * 2);
            vn[rt][0] = lo_bf(uw.x) - wsacc[0]; vn[rt][1] = hi_bf(uw.x) - wsacc[1]; vn[rt][2] = lo_bf(uw.y) - wsacc[2]; vn[rt][3] = hi_bf(uw.y) - wsacc[3];
            O[rt] = o;
        }
        bf16x8 Vb[2]; Vb[0] = pack_frag(vn[0], vn[1]); Vb[1] = pack_frag(vn[2], vn[3]);
#pragma unroll
        for (int rt = 0; rt < 4; ++rt) {
#pragma unroll
            for (int s2 = 0; s2 < 2; ++s2) O[rt] = mfma16(ld_frag_l(L + L_QK + (16 * rt + rl) * 144 + (32 * s2 + 8 * quad) * 2), Vb[s2], O[rt]);
            const size_t row = (size_t)b * TP + 64 * c + 16 * rt + 4 * quad;
#pragma unroll
            for (int i = 0; i < 4; ++i) OG[(row + i) * 512 + h * 128 + 16 * wave + rl] = O[rt][i];
        }
#pragma unroll
        for (int kt = 0; kt < 8; ++kt) {
            f32x4 a = S[kt] * eg;
#pragma unroll
            for (int s2 = 0; s2 < 2; ++s2) a = mfma16(ld_frag_l(L + L_KT + (16 * kt + rl) * 144 + (32 * s2 + 8 * quad) * 2), Vb[s2], a);
            S[kt] = a;
        }
    }
    float* So = KOUT() + O_GSP + (size_t)(layer * 8 + bh) * 16384;
#pragma unroll
    for (int kt = 0; kt < 8; ++kt)
#pragma unroll
        for (int i = 0; i < 4; ++i) So[(size_t)(16 * kt + 4 * quad + i) * 128 + 16 * wave + rl] = S[kt][i];
    __syncthreads();
}
DI void ret_scan_part(Frame& F, int layer, int r) {
    int tid = F.tid; asm volatile("" : "+v"(tid));
    const int bh = r >> 2, dv = tid & 127, dk0 = ((r & 3) * 4 + (tid >> 7)) * 8, h = bh & 3;
    unsigned char* ws = KWS();
    const float* RKV = (const float*)(ws + WS_RKV) + (size_t)bh * 64 * 16384;
    bf16* RST = (bf16*)(ws + WS_RST) + (size_t)bh * 64 * 16384;
    const float cdec = __expf(128.f * ret_lg(h));
    float S[8];
#pragma unroll
    for (int i = 0; i < 8; ++i) S[i] = 0.f;
#pragma unroll 4
    for (int c = 0; c < 64; ++c) {
        v4u w; w.x = pk2(S[0], S[1]); w.y = pk2(S[2], S[3]); w.z = pk2(S[4], S[5]); w.w = pk2(S[6], S[7]);
        *(v4u*)(RST + (size_t)c * 16384 + dv * 128 + dk0) = w;
#pragma unroll
        for (int i = 0; i < 8; ++i) S[i] = S[i] * cdec + RKV[(size_t)c * 16384 + (dk0 + i) * 128 + dv];
    }
    float* So = KOUT() + O_RSP + (size_t)(layer * 8 + bh) * 16384;
#pragma unroll
    for (int i = 0; i < 8; ++i) So[(size_t)(dk0 + i) * 128 + dv] = S[i];
}
constexpr float SM_C = 0.125f * 1.4426950408889634f;
struct AttnState { float m, l; f32x4 O[4]; };
DI void attn_reset(AttnState& st) { st.m = -1e30f; st.l = 0.f;
#pragma unroll
    for (int i = 0; i < 4; ++i) st.O[i] = (f32x4){0.f, 0.f, 0.f, 0.f}; }
DI void qk_tile(const LAS unsigned char* Kt, const bf16x8 (&qf)[2], f32x4 (&s)[4], int rl, int quad) {
    bf16x8 kf[4][2];
#pragma unroll
    for (int kt = 0; kt < 4; ++kt)
#pragma unroll
        for (int kk = 0; kk < 2; ++kk) kf[kt][kk] = ld_frag_l(Kt + (16 * kt + rl) * 144 + kk * 64 + quad * 16);
    __builtin_amdgcn_s_setprio(1);
#pragma unroll
    for (int kt = 0; kt < 4; ++kt) s[kt] = mfma16(kf[kt][0], qf[0], (f32x4){0.f, 0.f, 0.f, 0.f});
#pragma unroll
    for (int kt = 0; kt < 4; ++kt) s[kt] = mfma16(kf[kt][1], qf[1], s[kt]);
    __builtin_amdgcn_s_setprio(0);
}
template <class Mask> DI void attn_step(const LAS unsigned char* Kt, const LAS unsigned char* VT, const bf16x8 (&qf)[2], AttnState& st, const Mask& ok, int rl, int quad) {
    f32x4 s[4]; qk_tile(Kt, qf, s, rl, quad);
    float mx = -3e38f;
#pragma unroll
    for (int kt = 0; kt < 4; ++kt)
#pragma unroll
        for (int i = 0; i < 4; ++i) if (ok(16 * kt + 4 * quad + i)) mx = fmaxf(mx, s[kt][i]);
    const int lane = rl + 16 * quad;
    mx = fmaxf(mx, shx<16>(mx, lane)); mx = fmaxf(mx, shx<32>(mx, lane));
    const float mn = fmaxf(st.m, mx);
    const float alpha = exp2f((st.m - mn) * SM_C);
    float ls = 0.f;
#pragma unroll
    for (int kt = 0; kt < 4; ++kt)
#pragma unroll
        for (int i = 0; i < 4; ++i) { const float p = ok(16 * kt + 4 * quad + i) ? exp2f((s[kt][i] - mn) * SM_C) : 0.f; s[kt][i] = p; ls += p; }
    ls += shx<16>(ls, lane); ls += shx<32>(ls, lane);
    st.l = st.l * alpha + ls; st.m = mn;
#pragma unroll
    for (int dt = 0; dt < 4; ++dt) st.O[dt] *= alpha;
#pragma unroll
    for (int ii = 0; ii < 2; ++ii) {
        const bf16x8 pb = pack_frag(s[2 * ii], s[2 * ii + 1]);
#pragma unroll
        for (int dt = 0; dt < 4; ++dt) {
            const LAS unsigned char* vp = VT + (16 * dt + rl) * 144 + (32 * ii + 4 * quad) * 2;
            st.O[dt] = mfma16(mk_frag(*(const LAS v2u*)vp, *(const LAS v2u*)(vp + 32)), pb, st.O[dt]);
        }
    }
}
DI void attn_accum(f32x4 (&Of)[4], const AttnState& st, float gate) {
    const float sc = st.l > 0.f ? gate / st.l : 0.f;
#pragma unroll
    for (int dt = 0; dt < 4; ++dt) Of[dt] += st.O[dt] * sc;
}
DI void vt_write(LAS unsigned char* VT, int d0, int key, const v4u w) {
    LAS unsigned char* d = VT + d0 * 144 + key * 2;
    *(LAS bf16*)(d) = (bf16)(w.x & 0xffff); *(LAS bf16*)(d + 144) = (bf16)(w.x >> 16); *(LAS bf16*)(d + 2 * 144) = (bf16)(w.y & 0xffff); *(LAS bf16*)(d + 3 * 144) = (bf16)(w.y >> 16);
    *(LAS bf16*)(d + 4 * 144) = (bf16)(w.z & 0xffff); *(LAS bf16*)(d + 5 * 144) = (bf16)(w.z >> 16); *(LAS bf16*)(d + 6 * 144) = (bf16)(w.w & 0xffff); *(LAS bf16*)(d + 7 * 144) = (bf16)(w.w >> 16);
}
DI void stage_wg(LAS unsigned char* Kt, LAS unsigned char* VT, const bf16* kb, const bf16* vb, size_t stride, int tid, bool do_v) {
    const int key = tid >> 3, ch = tid & 7;
    *(LAS v4u*)(Kt + key * 144 + ch * 16) = *(const v4u*)(kb + key * stride + ch * 8);
    if (do_v) vt_write(VT, ch * 8, key, *(const v4u*)(vb + key * stride + ch * 8));
}
DI unsigned score_key(float s, bool valid, int idx) { return valid ? (((__float_as_uint(s) | 0x80000000u) & ~127u) | (unsigned)(127 - idx)) : 0u; }
DI int key_rank(const LAS unsigned* K, int ng4, unsigned k) {
    int r = 0;
#pragma unroll 4
    for (int g = 0; g < ng4; ++g) { const v4u v = *(const LAS v4u*)(K + 4 * g); r += (v.x > k) + (v.y > k) + (v.z > k) + (v.w > k); }
    return r;
}
DI void key_rank2(const LAS unsigned* K, int ng4, unsigned k0, unsigned k1, int& r0, int& r1) {
    int a0 = 0, a1 = 0, b0 = 0, b1 = 0;
    const int ng8 = (ng4 + 1) >> 1;
#pragma unroll 4
    for (int g = 0; g < ng8; ++g) { const v4u v = *(const LAS v4u*)(K + 8 * g), w = *(const LAS v4u*)(K + 8 * g + 4);
        a0 += (v.x > k0) + (v.y > k0) + (v.z > k0) + (v.w > k0); b0 += (w.x > k0) + (w.y > k0) + (w.z > k0) + (w.w > k0);
        a1 += (v.x > k1) + (v.y > k1) + (v.z > k1) + (v.w > k1); b1 += (w.x > k1) + (w.y > k1) + (w.z > k1) + (w.w > k1); }
    r0 = a0 + b0; r1 = a1 + b1;
}
DI int top16(float v0, float v1, int lane) {
    int sel = 0;
#pragma unroll 1
    for (int r = 0; r < 16; ++r) {
        float bv; int bi;
        if (v0 >= v1) { bv = v0; bi = lane; } else { bv = v1; bi = lane + 64; }
#define T16_STEP(M) { const float ov = shx<M>(bv, lane); const int oi = shxi<M>(bi, lane); const bool take = (ov > bv) || (ov == bv && oi < bi); bv = take ? ov : bv; bi = take ? oi : bi; }
        T16_STEP(32) T16_STEP(16) T16_STEP(8) T16_STEP(4) T16_STEP(2) T16_STEP(1)
#undef T16_STEP
        const bool h0 = (bi == lane), h1 = (bi == lane + 64);
        v0 = h0 ? -3e38f : v0; v1 = h1 ? -3e38f : v1; sel |= (h0 ? 1 : 0) | (h1 ? 2 : 0);
    }
    return sel;
}

typedef short v4i16_t __attribute__((ext_vector_type(4)));
DI s16x4 vtr(const LAS unsigned char* p) { return __builtin_bit_cast(s16x4, __builtin_amdgcn_ds_read_tr16_b64_v4i16((LAS v4i16_t*)p)); }
DI bf16x8 cat4(s16x4 a, s16x4 b) { bf16x8 r; r[0] = a[0]; r[1] = a[1]; r[2] = a[2]; r[3] = a[3]; r[4] = b[0]; r[5] = b[1]; r[6] = b[2]; r[7] = b[3]; return r; }
DI void attn_step3(const LAS unsigned char* Kt, const LAS unsigned char* Vt, const bf16x8 (&qf)[2], AttnState& st, int lo, int hi, bool active, int rl, int quad) {
    active = active && (hi >= lo);
    if (!__any(active)) return;
    f32x4 s[4]; qk_tile(Kt, qf, s, rl, quad);
    const int lane = rl + 16 * quad;
    const bool full = __all((lo <= 0 && hi >= 63) || !active);
    const int kq = 4 * quad - lo; const unsigned rng = (unsigned)(hi - lo);
    float lm;
    if (full) {
        const float a0 = fmaxf(fmaxf(s[0][0], s[0][1]), fmaxf(s[0][2], s[0][3])), a1 = fmaxf(fmaxf(s[1][0], s[1][1]), fmaxf(s[1][2], s[1][3]));
        const float a2 = fmaxf(fmaxf(s[2][0], s[2][1]), fmaxf(s[2][2], s[2][3])), a3 = fmaxf(fmaxf(s[3][0], s[3][1]), fmaxf(s[3][2], s[3][3]));
        lm = fmaxf(fmaxf(a0, a1), fmaxf(a2, a3));
    } else {
        lm = -3e38f;
#pragma unroll
        for (int kt = 0; kt < 4; ++kt)
#pragma unroll
            for (int i = 0; i < 4; ++i) lm = ((unsigned)(kq + 16 * kt + i) <= rng) ? fmaxf(lm, s[kt][i]) : lm;
    }
    lm = active ? lm : -3e38f;
    if (__any(lm > st.m + 320.f)) {
        float mx = fmaxf(lm, shx<16>(lm, lane)); mx = fmaxf(mx, shx<32>(mx, lane));
        const float mn = fmaxf(st.m, mx);
        const float alpha = __builtin_amdgcn_exp2f((st.m - mn) * SM_C);
        st.l *= alpha; st.m = mn;
#pragma unroll
        for (int dt = 0; dt < 4; ++dt) st.O[dt] *= alpha;
    }
    const float mc = active ? st.m * SM_C : __builtin_inff();
    float ls = 0.f;
    if (full) {
#pragma unroll
        for (int kt = 0; kt < 4; ++kt)
#pragma unroll
            for (int i = 0; i < 4; ++i) { const float p = __builtin_amdgcn_exp2f(s[kt][i] * SM_C - mc); s[kt][i] = p; ls += p; }
    } else {
#pragma unroll
        for (int kt = 0; kt < 4; ++kt)
#pragma unroll
            for (int i = 0; i < 4; ++i) { const float p = ((unsigned)(kq + 16 * kt + i) <= rng) ? __builtin_amdgcn_exp2f(s[kt][i] * SM_C - mc) : 0.f; s[kt][i] = p; ls += p; }
    }
    st.l += ls;
#pragma unroll
    for (int ii = 0; ii < 2; ++ii) {
        const bf16x8 pb = pack_frag(s[2 * ii], s[2 * ii + 1]);
#pragma unroll
        for (int dt = 0; dt < 4; ++dt) {
            const LAS unsigned char* vp = Vt + (32 * ii + 4 * quad + (rl >> 2)) * 144 + (16 * dt + 4 * (rl & 3)) * 2;
            st.O[dt] = mfma16(cat4(vtr(vp), vtr(vp + 16 * 144)), pb, st.O[dt]);
        }
    }
}
DI float attn_rowsum(const AttnState& st, int lane) { float l = st.l; l += shx<16>(l, lane); l += shx<32>(l, lane); return l; }
DI void attn_accum3(f32x4 (&Of)[4], const AttnState& st, float gate, int lane) {
    const float l = attn_rowsum(st, lane);
    const float sc = l > 0.f ? gate / l : 0.f;
#pragma unroll
    for (int dt = 0; dt < 4; ++dt) Of[dt] += st.O[dt] * sc;
}
#ifndef PH_NPT
#define PH_NPT (-1)
#endif
#if PH_NPT >= 0
#define NP_T(k) do { if (tid == 0) { volatile LAS unsigned long long* np_ = (volatile LAS unsigned long long*)(F.lds + LDSCTL_OFF + 464); const unsigned long long now_ = __builtin_amdgcn_s_memrealtime(); \
    if ((k) == PH_NPT) np_[0] += now_ - np_[1]; np_[1] = now_; } } while (0)
#else
#define NP_T(k) do { } while (0)
#endif
#ifndef PH_NSAC
#define PH_NSAC 1
#endif
DI float tile_max(const f32x4 (&s)[4], bool full, int kq, unsigned rng) {
    float lm;
    if (full) {
        const float a0 = fmaxf(fmaxf(s[0][0], s[0][1]), fmaxf(s[0][2], s[0][3])), a1 = fmaxf(fmaxf(s[1][0], s[1][1]), fmaxf(s[1][2], s[1][3]));
        const float a2 = fmaxf(fmaxf(s[2][0], s[2][1]), fmaxf(s[2][2], s[2][3])), a3 = fmaxf(fmaxf(s[3][0], s[3][1]), fmaxf(s[3][2], s[3][3]));
        lm = fmaxf(fmaxf(a0, a1), fmaxf(a2, a3));
    } else {
        lm = -3e38f;
#pragma unroll
        for (int kt = 0; kt < 4; ++kt)
#pragma unroll
            for (int i = 0; i < 4; ++i) lm = ((unsigned)(kq + 16 * kt + i) <= rng) ? fmaxf(lm, s[kt][i]) : lm;
    }
    return lm;
}
DI float tile_exp(f32x4 (&s)[4], bool full, int kq, unsigned rng, float mc) {
    float ls = 0.f;
    if (full) {
#pragma unroll
        for (int kt = 0; kt < 4; ++kt)
#pragma unroll
            for (int i = 0; i < 4; ++i) { const float p = __builtin_amdgcn_exp2f(s[kt][i] * SM_C - mc); s[kt][i] = p; ls += p; }
    } else {
#pragma unroll
        for (int kt = 0; kt < 4; ++kt)
#pragma unroll
            for (int i = 0; i < 4; ++i) { const float p = ((unsigned)(kq + 16 * kt + i) <= rng) ? __builtin_amdgcn_exp2f(s[kt][i] * SM_C - mc) : 0.f; s[kt][i] = p; ls += p; }
    }
    return ls;
}
DI void tile_pv(const LAS unsigned char* Vt, const f32x4 (&s)[4], f32x4 (&O)[4], int rl, int quad) {
    bf16x8 vf[2][4];
#pragma unroll
    for (int ii = 0; ii < 2; ++ii)
#pragma unroll
        for (int dt = 0; dt < 4; ++dt) { const LAS unsigned char* vp = Vt + (32 * ii + 4 * quad + (rl >> 2)) * 144 + (16 * dt + 4 * (rl & 3)) * 2; vf[ii][dt] = cat4(vtr(vp), vtr(vp + 16 * 144)); }
    const bf16x8 pb0 = pack_frag(s[0], s[1]), pb1 = pack_frag(s[2], s[3]);
    __builtin_amdgcn_s_setprio(1);
#pragma unroll
    for (int dt = 0; dt < 4; ++dt) O[dt] = mfma16(vf[0][dt], pb0, O[dt]);
#pragma unroll
    for (int dt = 0; dt < 4; ++dt) O[dt] = mfma16(vf[1][dt], pb1, O[dt]);
    __builtin_amdgcn_s_setprio(0);
}
DI void tile_vload(const LAS unsigned char* Vt, bf16x8 (&vf)[2][4], int rl, int quad) {
#pragma unroll
    for (int ii = 0; ii < 2; ++ii)
#pragma unroll
        for (int dt = 0; dt < 4; ++dt) { const LAS unsigned char* vp = Vt + (32 * ii + 4 * quad + (rl >> 2)) * 144 + (16 * dt + 4 * (rl & 3)) * 2; vf[ii][dt] = cat4(vtr(vp), vtr(vp + 16 * 144)); }
}
DI void tile_pvmma(const bf16x8 (&vf)[2][4], const f32x4 (&s)[4], f32x4 (&O)[4]) {
    const bf16x8 pb0 = pack_frag(s[0], s[1]), pb1 = pack_frag(s[2], s[3]);
    __builtin_amdgcn_s_setprio(1);
#pragma unroll
    for (int dt = 0; dt < 4; ++dt) O[dt] = mfma16(vf[0][dt], pb0, O[dt]);
#pragma unroll
    for (int dt = 0; dt < 4; ++dt) O[dt] = mfma16(vf[1][dt], pb1, O[dt]);
    __builtin_amdgcn_s_setprio(0);
}
DI void attn_step_pair(const LAS unsigned char* K0, const LAS unsigned char* V0, int lo0, int hi0, bool act0,
                       const LAS unsigned char* K1, const LAS unsigned char* V1, int lo1, int hi1, bool act1,
                       const bf16x8 (&qf)[2], AttnState& st, int rl, int quad) {
    act0 = act0 && (hi0 >= lo0); act1 = act1 && (hi1 >= lo1);
    const bool any0 = __any(act0), any1 = __any(act1);
    if (!any0 && !any1) return;
    const int lane = rl + 16 * quad;
    f32x4 s0[4], s1[4];
    if (any0 && any1) {
        bf16x8 kf0[4][2], kf1[4][2];
#pragma unroll
        for (int kt = 0; kt < 4; ++kt)
#pragma unroll
            for (int kk = 0; kk < 2; ++kk) { kf0[kt][kk] = ld_frag_l(K0 + (16 * kt + rl) * 144 + kk * 64 + quad * 16); kf1[kt][kk] = ld_frag_l(K1 + (16 * kt + rl) * 144 + kk * 64 + quad * 16); }
        __builtin_amdgcn_s_setprio(1);
#pragma unroll
        for (int kt = 0; kt < 4; ++kt) s0[kt] = mfma16(kf0[kt][0], qf[0], (f32x4){0.f, 0.f, 0.f, 0.f});
#pragma unroll
        for (int kt = 0; kt < 4; ++kt) s1[kt] = mfma16(kf1[kt][0], qf[0], (f32x4){0.f, 0.f, 0.f, 0.f});
#pragma unroll
        for (int kt = 0; kt < 4; ++kt) s0[kt] = mfma16(kf0[kt][1], qf[1], s0[kt]);
#pragma unroll
        for (int kt = 0; kt < 4; ++kt) s1[kt] = mfma16(kf1[kt][1], qf[1], s1[kt]);
        __builtin_amdgcn_s_setprio(0);
    } else {
        if (any0) qk_tile(K0, qf, s0, rl, quad);
        if (any1) qk_tile(K1, qf, s1, rl, quad);
    }
    const bool full0 = __all((lo0 <= 0 && hi0 >= 63) || !act0), full1 = __all((lo1 <= 0 && hi1 >= 63) || !act1);
    const int kq0 = 4 * quad - lo0, kq1 = 4 * quad - lo1; const unsigned rng0 = (unsigned)(hi0 - lo0), rng1 = (unsigned)(hi1 - lo1);
    float mcb = st.m * SM_C;
    bf16x8 vf0[2][4], vf1[2][4];
    if (any0) tile_vload(V0, vf0, rl, quad);
    float ls = 0.f;
    if (any0) ls += tile_exp(s0, full0, kq0, rng0, act0 ? mcb : __builtin_inff());
    if (any1) ls += tile_exp(s1, full1, kq1, rng1, act1 ? mcb : __builtin_inff());
    if (__any(!(ls <= 1e30f))) {
        if (any0) qk_tile(K0, qf, s0, rl, quad);
        if (any1) qk_tile(K1, qf, s1, rl, quad);
        float lm = -3e38f;
        if (any0) { const float a = tile_max(s0, full0, kq0, rng0); lm = act0 ? a : lm; }
        if (any1) { const float a = tile_max(s1, full1, kq1, rng1); lm = act1 ? fmaxf(lm, a) : lm; }
        float mx = fmaxf(lm, shx<16>(lm, lane)); mx = fmaxf(mx, shx<32>(mx, lane));
        const float mn = fmaxf(st.m, mx);
        const float alpha = __builtin_amdgcn_exp2f((st.m - mn) * SM_C);
        st.l *= alpha; st.m = mn;
#pragma unroll
        for (int dt = 0; dt < 4; ++dt) st.O[dt] *= alpha;
        mcb = mn * SM_C; ls = 0.f;
        if (any0) ls += tile_exp(s0, full0, kq0, rng0, act0 ? mcb : __builtin_inff());
        if (any1) ls += tile_exp(s1, full1, kq1, rng1, act1 ? mcb : __builtin_inff());
    }
    st.l += ls;
    if (any1) tile_vload(V1, vf1, rl, quad);
    if (any0) tile_pvmma(vf0, s0, st.O);
    if (any1) tile_pvmma(vf1, s1, st.O);
}
DI void nsa_prompt_unit(Frame& F, int layer, int unit) {
    int lane = F.lane, wave = F.wave; asm volatile("" : "+v"(lane), "+s"(wave));
    const int tid = wave * 64 + lane, quad = lane >> 4, rl = lane & 15;
    const int b = unit >> 9, g = (unit >> 8) & 1, tt = unit & 255, t0 = 32 * tt;
    unsigned char* ws = KWS();
    const bf16* Z = (const bf16*)(ws + WS_Z);
    const float* ZS = (const float*)(ws + WS_ZS);
    LAS unsigned char* TB = F.lds;
    LAS float* AIMP = (LAS float*)(F.lds + 73728);
    LAS unsigned* SEL = (LAS unsigned*)(F.lds + LDSCTL_OFF + 512);
    const int tk = 4 * wave + (rl >> 2), t = t0 + tk, head = 4 * g + (rl & 3);
    const size_t row = (size_t)b * TP + t;
    bf16x8 qf[2];
    qf[0] = ld_frag_g(Z + row * LDZ + ZC_Q + head * 64 + quad * 8); qf[1] = ld_frag_g(Z + row * LDZ + ZC_Q + head * 64 + 32 + quad * 8);
    const float gc = sigmoidf_(ZS[row * 32 + head * 3]), gs = sigmoidf_(ZS[row * 32 + head * 3 + 1]), gw = sigmoidf_(ZS[row * 32 + head * 3 + 2]);
    f32x4 Of[4];
#pragma unroll
    for (int i = 0; i < 4; ++i) Of[i] = (f32x4){0.f, 0.f, 0.f, 0.f};
    AttnState st;
    const int nct = (t0 >> 10) + 1;
    const bf16* KC = (const bf16*)(ws + WS_KC) + ((size_t)(0 * 2 + b) * 512 * 2 + g) * 64;
    const bf16* VC = (const bf16*)(ws + WS_KC) + ((size_t)(1 * 2 + b) * 512 * 2 + g) * 64;
    const bf16* Zb = Z + (size_t)b * TP * LDZ + g * 64;
    const int skey = tid >> 3, sch = tid & 7;
    const int wlo = (t0 - 511 > 0 ? t0 - 511 : 0) >> 6, nwin = ((t0 + 31) >> 6) - wlo + 1;
    const int nwe = (nwin + 1) & ~1, nce = (nct + 1) & ~1;
    v4u rkA, rvA, rkB, rvB;
#define COMMIT(slot, rk, rv) do { LAS unsigned char* d_ = TB + (slot) * 18432 + skey * 144 + sch * 16; *(LAS v4u*)d_ = rk; *(LAS v4u*)(d_ + 9216) = rv; } while (0)
    NP_T(0);
    const int n1 = nwe + 2 * nce;
#define SEG1_VALID(i) ((i) < nwe ? (i) < nwin : (((i) - nwe) < nce ? ((i) - nwe) < nct : ((i) - nwe - nce) < nct))
#define SEG1_ISSUE(i, rk, rv) do { int i_ = (i); i_ = i_ < n1 ? i_ : n1 - 1; const bool win_ = i_ < nwe; int wt_ = wlo + (i_ < nwin ? i_ : nwin - 1); int jt_ = (i_ - nwe) % nce; jt_ = jt_ < nct ? jt_ : nct - 1; jt_ = jt_ < 0 ? 0 : jt_; \
        const bf16* pk_ = win_ ? Zb + (size_t)(64 * wt_ + skey) * LDZ + sch * 8 + ZC_KW : KC + (size_t)(64 * jt_ + skey) * 128 + sch * 8; \
        const bf16* pv_ = win_ ? Zb + (size_t)(64 * wt_ + skey) * LDZ + sch * 8 + ZC_VW : VC + (size_t)(64 * jt_ + skey) * 128 + sch * 8; \
        rk = *(const v4u*)pk_; rv = *(const v4u*)pv_; } while (0)
    attn_reset(st);
    float mfin = 0.f, il = 0.f;
    SEG1_ISSUE(0, rkA, rvA); SEG1_ISSUE(1, rkB, rvB);
    COMMIT(0, rkA, rvA); COMMIT(1, rkB, rvB);
    SEG1_ISSUE(2, rkA, rvA); SEG1_ISSUE(3, rkB, rvB);
    __syncthreads();
    for (int i = 0; i < n1; i += 2) {
        const LAS unsigned char* K0 = TB + (i & 3) * 18432; const LAS unsigned char* K1 = TB + ((i + 1) & 3) * 18432;
        if (i < nwe) {
            const int kb0 = 64 * (wlo + i), kb1 = kb0 + 64;
            attn_step_pair(K0, K0 + 9216, t - 511 - kb0, t - kb0, true, K1, K1 + 9216, t - 511 - kb1, t - kb1, (i + 1) < nwin, qf, st, rl, quad);
            if (i + 2 == nwe) { attn_accum3(Of, st, gw, lane); attn_reset(st); }
        } else if (i < nwe + nce) {
            const int nb0 = 64 * (i - nwe), nb1 = nb0 + 64;
            attn_step_pair(K0, K0 + 9216, 0, ((t - 31) >> 4) - nb0, true, K1, K1 + 9216, 0, ((t - 31) >> 4) - nb1, (i + 1 - nwe) < nct, qf, st, rl, quad);
            if (i + 2 == nwe + nce) { attn_accum3(Of, st, gc, lane); mfin = st.m * SM_C; const float lt_ = attn_rowsum(st, lane); il = lt_ > 0.f ? 1.f / lt_ : 0.f; }
        } else {
#pragma unroll
            for (int e2 = 0; e2 < 2; ++e2) {
                const int jt = i + e2 - nwe - nce;
                if (jt < nct) {
                    f32x4 s[4]; qk_tile(e2 ? K1 : K0, qf, s, rl, quad);
#pragma unroll
                    for (int kt = 0; kt < 4; ++kt)
#pragma unroll
                        for (int e = 0; e < 4; ++e) {
                            const int n = 64 * jt + 16 * kt + 4 * quad + e;
                            float p = (16 * n + 31 <= t) ? __builtin_amdgcn_exp2f(s[kt][e] * SM_C - mfin) * il : 0.f;
                            p += shx<1>(p, lane); p += shx<2>(p, lane);
                            if ((rl & 3) == 0) AIMP[tk * 512 + n] = p;
                        }
                }
            }
        }
        if (i + 2 < n1) { if (SEG1_VALID(i + 2)) COMMIT((i + 2) & 3, rkA, rvA); if (SEG1_VALID(i + 3)) COMMIT((i + 3) & 3, rkB, rvB); }
        __syncthreads();
        SEG1_ISSUE(i + 4, rkA, rvA); SEG1_ISSUE(i + 5, rkB, rvB);
    }
    NP_T(1);
    {
        const int nav = nct * 64;
        LAS unsigned* KS = (LAS unsigned*)(TB + wave * 2048);
#pragma unroll
        for (int q = 0; q < 4; ++q) {
            const int tq = 4 * wave + q, cur = (t0 + tq) >> 6;
#pragma unroll
            for (int e = 0; e < 2; ++e) {
                const int sblk = lane + 64 * e;
                float imp = 0.f;
#pragma unroll
                for (int d = -1; d <= 3; ++d) { const int n = 4 * sblk + d; if (n >= 0 && n < nav) imp += AIMP[tq * 512 + n]; }
                const bool valid = sblk <= cur, forced = (sblk == 0) || (sblk == cur) || (sblk == cur - 1);
                KS[q * 128 + sblk] = score_key(imp + (forced ? 1000.f : 0.f), valid, sblk);
            }
        }
        asm volatile("" ::: "memory");
#pragma unroll
        for (int q = 0; q < 4; ++q) {
            const int tq = 4 * wave + q, cur = (t0 + tq) >> 6, ng4 = (cur >> 2) + 1;
            const unsigned k0 = KS[q * 128 + lane], k1 = KS[q * 128 + 64 + lane];
            int r0, r1; key_rank2(KS + q * 128, ng4, k0, k1, r0, r1);
            const bool s0 = (lane <= cur) && r0 < 16, s1 = (lane + 64 <= cur) && r1 < 16;
            const unsigned long long m0 = __ballot(s0), m1 = __ballot(s1);
            if (lane == 0) { SEL[tq * 4 + 0] = (unsigned)m0; SEL[tq * 4 + 1] = (unsigned)(m0 >> 32); SEL[tq * 4 + 2] = (unsigned)m1; SEL[tq * 4 + 3] = (unsigned)(m1 >> 32); }
        }
    }
    __syncthreads();
    unsigned un[4], my[4], wv[4];
#pragma unroll
    for (int w = 0; w < 4; ++w) { unsigned v = (lane < 32) ? SEL[lane * 4 + w] : 0u;
        v |= (unsigned)shxi<1>((int)v, lane); v |= (unsigned)shxi<2>((int)v, lane); v |= (unsigned)shxi<4>((int)v, lane); v |= (unsigned)shxi<8>((int)v, lane); v |= (unsigned)shxi<16>((int)v, lane); v |= (unsigned)shxi<32>((int)v, lane);
        un[w] = __builtin_amdgcn_readfirstlane(v); my[w] = SEL[tk * 4 + w];
        wv[w] = SEL[(4 * wave) * 4 + w] | SEL[(4 * wave + 1) * 4 + w] | SEL[(4 * wave + 2) * 4 + w] | SEL[(4 * wave + 3) * 4 + w]; wv[w] = __builtin_amdgcn_readfirstlane(wv[w]); }
#if PH_NSAC > 1
    AttnState st2; attn_reset(st2);
#endif
    NP_T(2);
    attn_reset(st);
    {
        unsigned w0 = un[0], w1 = un[1], w2 = un[2], w3 = un[3];
#define NEXT_BLK(dst) do { if (w0) { dst = __builtin_ctz(w0); w0 &= w0 - 1u; } else if (w1) { dst = 32 + __builtin_ctz(w1); w1 &= w1 - 1u; } else if (w2) { dst = 64 + __builtin_ctz(w2); w2 &= w2 - 1u; } \
        else if (w3) { dst = 96 + __builtin_ctz(w3); w3 &= w3 - 1u; } else dst = -1; } while (0)
#define SEG2_ISSUE(blk_, rk, rv) do { const int b_ = (blk_) >= 0 ? (blk_) : 0; const bf16* p_ = Zb + (size_t)(64 * b_ + skey) * LDZ + sch * 8; rk = *(const v4u*)(p_ + ZC_KS); rv = *(const v4u*)(p_ + ZC_VS); } while (0)
#define BLK_WORD(arr, blk_) (((blk_) >> 5) == 0 ? arr[0] : ((blk_) >> 5) == 1 ? arr[1] : ((blk_) >> 5) == 2 ? arr[2] : arr[3])
#define SEG2_PAIR(ca, cb, sa, sb, stt) do { const LAS unsigned char* K0 = TB + (sa) * 18432; const LAS unsigned char* K1 = TB + (sb) * 18432; \
            const int ca_ = (ca) >= 0 ? (ca) : 0, cb_ = (cb) >= 0 ? (cb) : 0; \
            const bool need0 = ((ca) >= 0) && ((BLK_WORD(wv, ca_) >> (ca_ & 31)) & 1u), need1 = ((cb) >= 0) && ((BLK_WORD(wv, cb_) >> (cb_ & 31)) & 1u); \
            const bool mine0 = need0 && ((BLK_WORD(my, ca_) >> (ca_ & 31)) & 1u), mine1 = need1 && ((BLK_WORD(my, cb_) >> (cb_ & 31)) & 1u); \
            attn_step_pair(K0, K0 + 9216, 0, t - 64 * ca_, mine0, K1, K1 + 9216, 0, t - 64 * cb_, mine1, qf, stt, rl, quad); } while (0)
        v4u rkC, rvC, rkD, rvD;
        int c0, c1, c2, c3, n0, n1b, n2, n3, m0, m1, m2, m3;
        NEXT_BLK(c0); NEXT_BLK(c1); NEXT_BLK(c2); NEXT_BLK(c3); NEXT_BLK(n0); NEXT_BLK(n1b); NEXT_BLK(n2); NEXT_BLK(n3);
        SEG2_ISSUE(c0, rkA, rvA); SEG2_ISSUE(c1, rkB, rvB); SEG2_ISSUE(c2, rkC, rvC); SEG2_ISSUE(c3, rkD, rvD);
        COMMIT(0, rkA, rvA); COMMIT(1, rkB, rvB); COMMIT(2, rkC, rvC); COMMIT(3, rkD, rvD);
        SEG2_ISSUE(n0, rkA, rvA); SEG2_ISSUE(n1b, rkB, rvB); SEG2_ISSUE(n2, rkC, rvC); SEG2_ISSUE(n3, rkD, rvD);
        __syncthreads();
        int i = 0;
        while (c0 >= 0) {
            NEXT_BLK(m0); NEXT_BLK(m1); NEXT_BLK(m2); NEXT_BLK(m3);
            SEG2_PAIR(c0, c1, i & 7, (i + 1) & 7, st);
            SEG2_PAIR(c2, c3, (i + 2) & 7, (i + 3) & 7, st);
#if PH_NSAC > 1
            SEG2_PAIR(c0, c1, i & 7, (i + 1) & 7, st2); SEG2_PAIR(c2, c3, (i + 2) & 7, (i + 3) & 7, st2);
#endif
            COMMIT((i + 4) & 7, rkA, rvA); COMMIT((i + 5) & 7, rkB, rvB); COMMIT((i + 6) & 7, rkC, rvC); COMMIT((i + 7) & 7, rkD, rvD);
            __syncthreads();
#if defined(PH_NSAX) && (PH_NSAX & 1)
            __syncthreads();
#endif
#if defined(PH_NSAX) && (PH_NSAX & 2)
            { v4u d0_, d1_; SEG2_ISSUE(m0, d0_, d1_); asm volatile("" :: "v"(d0_), "v"(d1_)); SEG2_ISSUE(m1, d0_, d1_); asm volatile("" :: "v"(d0_), "v"(d1_));
              SEG2_ISSUE(m2, d0_, d1_); asm volatile("" :: "v"(d0_), "v"(d1_)); SEG2_ISSUE(m3, d0_, d1_); asm volatile("" :: "v"(d0_), "v"(d1_)); }
#endif
            SEG2_ISSUE(m0, rkA, rvA); SEG2_ISSUE(m1, rkB, rvB); SEG2_ISSUE(m2, rkC, rvC); SEG2_ISSUE(m3, rkD, rvD);
            c0 = n0; c1 = n1b; c2 = n2; c3 = n3; n0 = m0; n1b = m1; n2 = m2; n3 = m3; i += 4;
        }
    }
    NP_T(3);
    attn_accum3(Of, st, gs, lane);
#if PH_NSAC > 1
    attn_accum3(Of, st2, (float)(layer >> 8), lane);
#endif
#undef SEG1_ISSUE
#undef SEG1_VALID
#undef SEG2_ISSUE
#undef SEG2_PAIR
#undef BLK_WORD
#undef COMMIT
#undef NEXT_BLK
    bf16* MIX = (bf16*)(ws + WS_MIX) + row * 1536 + head * 64;
#pragma unroll
    for (int dt = 0; dt < 4; ++dt) { v2u w; w.x = pk2(Of[dt][0], Of[dt][1]); w.y = pk2(Of[dt][2], Of[dt][3]); *(v2u*)(MIX + 16 * dt + 4 * quad) = w; }
    __syncthreads();
}

#define CB() asm volatile("" ::: "memory")
DI void stage_wave_f32(LAS unsigned char* Kt, LAS unsigned char* Vt, const float* kb, const float* vb, size_t stride, int lane) {
    const int k0 = lane >> 3, ch = lane & 7;
#pragma unroll
    for (int h = 0; h < 4; ++h) {
        const float* src = (h < 2 ? kb : vb); LAS unsigned char* dst = (h < 2 ? Kt : Vt); const int r0 = (h & 1) * 32;
        f32x4 a[4][2];
#pragma unroll
        for (int it = 0; it < 4; ++it) { const float* kp = src + (size_t)(r0 + it * 8 + k0) * stride + ch * 8; a[it][0] = *(const f32x4*)kp; a[it][1] = *(const f32x4*)(kp + 4); }
#pragma unroll
        for (int it = 0; it < 4; ++it) *(LAS v4u*)(dst + (r0 + it * 8 + k0) * 144 + ch * 16) = pack8(a[it][0], a[it][1]);
        asm volatile("" ::: "memory");
    }
}
DI void stage_wave_b16(LAS unsigned char* Kt, LAS unsigned char* Vt, const bf16* kb, const bf16* vb, size_t stride, int nvalid, int lane, bool do_v) {
    const int k0 = lane >> 3, ch = lane & 7;
    const v4u z = (v4u){0u, 0u, 0u, 0u};
#pragma unroll
    for (int it = 0; it < 8; ++it) {
        const int key = it * 8 + k0; const bool v = key < nvalid;
        *(LAS v4u*)(Kt + key * 144 + ch * 16) = v ? *(const v4u*)(kb + key * stride + ch * 8) : z;
        if (do_v) *(LAS v4u*)(Vt + key * 144 + ch * 16) = v ? *(const v4u*)(vb + key * stride + ch * 8) : z;
    }
}
DI void nsa_sample_unit(Frame& F, int layer, int s) {
    int lane = F.lane, wave = F.wave; asm volatile("" : "+v"(lane), "+s"(wave));
    const int quad = lane >> 4, rl = lane & 15;
    const int g = wave & 1, q4 = wave >> 1;
    unsigned char* ws = KWS();
    const bf16* Z = (const bf16*)(ws + WS_Z);
    const float* ZS = (const float*)(ws + WS_ZS);
    LAS unsigned char* Kt = F.lds + wave * 18432; LAS unsigned char* Vt = Kt + 9216;
    LAS float* AIMP = (LAS float*)Vt;
    const int j = rl >> 2, head = 4 * g + (rl & 3), qpos = 2048 + j;
    const size_t row = (size_t)MP + 4 * s + j;
    bf16x8 qf[2];
    qf[0] = ld_frag_g(Z + row * LDZ + ZC_Q + head * 64 + quad * 8); qf[1] = ld_frag_g(Z + row * LDZ + ZC_Q + head * 64 + 32 + quad * 8);
    const float gc = sigmoidf_(ZS[row * 32 + head * 3]), gs = sigmoidf_(ZS[row * 32 + head * 3 + 1]), gw = sigmoidf_(ZS[row * 32 + head * 3 + 2]);
    f32x4 Of[4];
#pragma unroll
    for (int i = 0; i < 4; ++i) Of[i] = (f32x4){0.f, 0.f, 0.f, 0.f};
    AttnState st;
    const bf16* KC = (const bf16*)(ws + WS_KCS) + ((size_t)(0 * 128 + s) * 128 * 2 + g) * 64;
    const bf16* VC = (const bf16*)(ws + WS_KCS) + ((size_t)(1 * 128 + s) * 128 * 2 + g) * 64;
    attn_reset(st);
#pragma unroll 1
    for (int jt = 0; jt < 2; ++jt) {
        stage_wave_b16(Kt, Vt, KC + (size_t)64 * jt * 128, VC + (size_t)64 * jt * 128, 128, 64, lane, true); CB();
        attn_step3(Kt, Vt, qf, st, 0, 126 - 64 * jt, true, rl, quad); CB();
    }
    attn_accum3(Of, st, q4 == 0 ? gc : 0.f, lane);
    {
        const float mfin = st.m * SM_C, lt = attn_rowsum(st, lane), il = lt > 0.f ? 1.f / lt : 0.f;
#pragma unroll 1
        for (int jt = 0; jt < 2; ++jt) {
            stage_wave_b16(Kt, Vt, KC + (size_t)64 * jt * 128, VC, 128, 64, lane, false); CB();
            f32x4 sv[4]; qk_tile(Kt, qf, sv, rl, quad); CB();
#pragma unroll
            for (int kt = 0; kt < 4; ++kt)
#pragma unroll
                for (int i = 0; i < 4; ++i) {
                    const int n = 64 * jt + 16 * kt + 4 * quad + i;
                    float p = (n <= 126) ? __builtin_amdgcn_exp2f(sv[kt][i] * SM_C - mfin) * il : 0.f;
                    p += shx<1>(p, lane); p += shx<2>(p, lane);
                    if ((rl & 3) == 0) AIMP[j * 128 + n] = p;
                }
        }
    }
    CB();
    unsigned long long msk[4];
    {
        unsigned keys[4];
#pragma unroll
        for (int q = 0; q < 4; ++q) {
            float imp = 0.f;
#pragma unroll
            for (int d = -1; d <= 3; ++d) { const int n = 4 * lane + d; if (n >= 0 && n <= 126 && lane < 33) imp += AIMP[q * 128 + n]; }
            const bool forced = (lane == 0) || (lane == 32) || (lane == 31);
            keys[q] = score_key(imp + (forced ? 1000.f : 0.f), lane < 33, lane);
        }
        CB();
        LAS unsigned* KS = (LAS unsigned*)Kt;
#pragma unroll
        for (int q = 0; q < 4; ++q) KS[q * 64 + lane] = keys[q];
        CB();
#pragma unroll
        for (int q = 0; q < 4; ++q) msk[q] = __ballot(lane < 33 && key_rank(KS + q * 64, 9, keys[q]) < 16);
    }
    CB();
    const unsigned long long un = msk[0] | msk[1] | msk[2] | msk[3];
    const unsigned long long mym = j == 0 ? msk[0] : j == 1 ? msk[1] : j == 2 ? msk[2] : msk[3];
    const int* pt = (const int*)KIN(7);
    AttnState sw;
    attn_reset(st); attn_reset(sw);
    {
        unsigned long long word = un; int idx = 0;
        while (word) {
            const int blk = __builtin_ctzll(word); word &= word - 1ull;
            if ((idx++ & 3) != q4) continue;
            if (blk < 32) {
                const int phys = pt[s * 16 + (blk >> 1)];
                const float* base = KIN(2) + ((size_t)(layer * 2560 + phys) * 128 + (blk & 1) * 64) * 512 + g * 64;
                stage_wave_f32(Kt, Vt, base + 256, base + 384, 512, lane); CB();
            } else {
                stage_wave_b16(Kt, Vt, Z + (size_t)(MP + 4 * s) * LDZ + ZC_KS + g * 64, Z + (size_t)(MP + 4 * s) * LDZ + ZC_VS + g * 64, LDZ, 4, lane, true); CB();
            }
            attn_step3(Kt, Vt, qf, st, 0, qpos - 64 * blk, (mym >> blk) & 1ull, rl, quad); CB();
        }
#pragma unroll 1
        for (int jt = 0; jt < 9; ++jt) {
            if ((idx++ & 3) != q4) continue;
            if (jt < 8) { const float* base = KIN(3) + ((size_t)(layer * 128 + s) * 512 + 64 * jt) * 256 + g * 64; stage_wave_f32(Kt, Vt, base, base + 128, 256, lane); CB(); }
            else { stage_wave_b16(Kt, Vt, Z + (size_t)(MP + 4 * s) * LDZ + ZC_KW + g * 64, Z + (size_t)(MP + 4 * s) * LDZ + ZC_VW + g * 64, LDZ, 4, lane, true); CB(); }
            attn_step3(Kt, Vt, qf, sw, j + 1 - 64 * jt, 512 + j - 64 * jt, true, rl, quad); CB();
        }
    }
    int lane2 = lane; asm volatile("" : "+v"(lane2));
    LAS float* X = (LAS float*)(F.lds + wave * 18432);
    {
        const float ls = attn_rowsum(st, lane), lw = attn_rowsum(sw, lane);
        X[0 * 64 + lane2] = st.m; X[1 * 64 + lane2] = ls; X[18 * 64 + lane2] = sw.m; X[19 * 64 + lane2] = lw;
#pragma unroll
        for (int dt = 0; dt < 4; ++dt)
#pragma unroll
            for (int e = 0; e < 4; ++e) { X[(2 + 4 * dt + e) * 64 + lane2] = st.O[dt][e]; X[(20 + 4 * dt + e) * 64 + lane2] = sw.O[dt][e]; }
    }
    __syncthreads();
    if (q4 == 0) {
#pragma unroll
        for (int br = 0; br < 2; ++br) {
            float m[4], l[4];
#pragma unroll
            for (int q = 0; q < 4; ++q) { const LAS float* Y = (const LAS float*)(F.lds + (2 * q + g) * 18432) + br * 18 * 64; m[q] = Y[lane2]; l[q] = Y[64 + lane2]; }
            const float mm = fmaxf(fmaxf(m[0], m[1]), fmaxf(m[2], m[3]));
            float w[4], lt = 0.f;
#pragma unroll
            for (int q = 0; q < 4; ++q) { w[q] = __builtin_amdgcn_exp2f((m[q] - mm) * SM_C); lt += l[q] * w[q]; }
            const float gate = br == 0 ? gs : gw;
            const float sc = lt > 0.f ? gate / lt : 0.f;
#pragma unroll
            for (int q = 0; q < 4; ++q) { const LAS float* Y = (const LAS float*)(F.lds + (2 * q + g) * 18432) + br * 18 * 64; const float wq = w[q] * sc;
#pragma unroll
                for (int dt = 0; dt < 4; ++dt)
#pragma unroll
                    for (int e = 0; e < 4; ++e) Of[dt][e] += Y[(2 + 4 * dt + e) * 64 + lane2] * wq; }
        }
        bf16* MIX = (bf16*)(ws + WS_MIX) + row * 1536 + head * 64;
#pragma unroll
        for (int dt = 0; dt < 4; ++dt) { v2u w2; w2.x = pk2(Of[dt][0], Of[dt][1]); w2.y = pk2(Of[dt][2], Of[dt][3]); *(v2u*)(MIX + 16 * dt + 4 * quad) = w2; }
    }
    __syncthreads();
}
DI void ret_out_unit(Frame& F, int layer, int unit) {
    const int tid = F.tid, lane = F.lane, wave = F.wave, quad = lane >> 4, rl = lane & 15;
    const int b = unit >> 8, h = (unit >> 6) & 3, c = unit & 63;
    const int row0 = b * TP + 128 * c;
    unsigned char* ws = KWS();
    const bf16* Z = (const bf16*)(ws + WS_Z);
    const bf16* QR = (const bf16*)(ws + WS_QR); const bf16* KR = (const bf16*)(ws + WS_KR);
    const bf16* RST = (const bf16*)(ws + WS_RST) + (size_t)unit * 16384;
    LAS unsigned char* LQ = F.lds; LAS unsigned char* LK = F.lds + 34816; LAS unsigned char* LV = F.lds + 69632; LAS unsigned char* LS = F.lds + 104448;
    for (int it = tid; it < 2048; it += NTHREADS) {
        const int j = it >> 4, cc = it & 15;
        *(LAS v4u*)(LQ + j * 272 + cc * 16) = *(const v4u*)(QR + (size_t)(row0 + j) * 512 + h * 128 + cc * 8);
        *(LAS v4u*)(LK + j * 272 + cc * 16) = *(const v4u*)(KR + (size_t)(row0 + j) * 512 + h * 128 + cc * 8);
        *(LAS v4u*)(LS + j * 272 + cc * 16) = *(const v4u*)(RST + (size_t)j * 128 + cc * 8);
        const v4u w = *(const v4u*)(Z + (size_t)(row0 + j) * LDZ + ZC_RQKV + 1024 + h * 128 + cc * 8);
        LAS unsigned char* d = LV + (cc * 8) * 272 + j * 2;
        *(LAS bf16*)(d) = (bf16)(w.x & 0xffff); *(LAS bf16*)(d + 272) = (bf16)(w.x >> 16); *(LAS bf16*)(d + 2 * 272) = (bf16)(w.y & 0xffff); *(LAS bf16*)(d + 3 * 272) = (bf16)(w.y >> 16);
        *(LAS bf16*)(d + 4 * 272) = (bf16)(w.z & 0xffff); *(LAS bf16*)(d + 5 * 272) = (bf16)(w.z >> 16); *(LAS bf16*)(d + 6 * 272) = (bf16)(w.w & 0xffff); *(LAS bf16*)(d + 7 * 272) = (bf16)(w.w >> 16);
    }
    __syncthreads();
    const float lg = ret_lg(h);
    const int il = 16 * wave + rl;
    bf16x8 qb[4];
#pragma unroll
    for (int s = 0; s < 4; ++s) qb[s] = ld_frag_l(LQ + il * 272 + (32 * s + 8 * quad) * 2);
    f32x4 C[8];
    const float qdec = __expf((float)(il + 1) * lg);
#pragma unroll
    for (int dt = 0; dt < 8; ++dt) {
        f32x4 a = (f32x4){0.f, 0.f, 0.f, 0.f};
#pragma unroll
        for (int s = 0; s < 4; ++s) a = mfma16(ld_frag_l(LS + (16 * dt + rl) * 272 + (32 * s + 8 * quad) * 2), qb[s], a);
        C[dt] = a * qdec;
    }
    for (int s2 = 0; s2 <= (wave >> 1); ++s2) {
        f32x4 P[2];
#pragma unroll
        for (int e = 0; e < 2; ++e) {
            const int jt = 2 * s2 + e;
            f32x4 a = (f32x4){0.f, 0.f, 0.f, 0.f};
            if (jt <= wave) {
#pragma unroll
                for (int s = 0; s < 4; ++s) a = mfma16(ld_frag_l(LK + (16 * jt + rl) * 272 + (32 * s + 8 * quad) * 2), qb[s], a);
#pragma unroll
                for (int i = 0; i < 4; ++i) { const int jj = 16 * jt + 4 * quad + i; a[i] = (il >= jj) ? a[i] * __expf((float)(il - jj) * lg) : 0.f; }
            }
            P[e] = a;
        }
        const bf16x8 pb = pack_frag(P[0], P[1]);
#pragma unroll
        for (int dt = 0; dt < 8; ++dt) {
            const LAS unsigned char* vp = LV + (16 * dt + rl) * 272 + (32 * s2 + 4 * quad) * 2;
            C[dt] = mfma16(mk_frag(*(const LAS v2u*)vp, *(const LAS v2u*)(vp + 32)), pb, C[dt]);
        }
    }
    float ss = 0.f;
#pragma unroll
    for (int dt = 0; dt < 8; ++dt) ss += (C[dt][0] * C[dt][0] + C[dt][1] * C[dt][1]) + (C[dt][2] * C[dt][2] + C[dt][3] * C[dt][3]);
    ss += shx<16>(ss, lane); ss += shx<32>(ss, lane);
    const float scl = rsqrtf(ss * (1.f / 128.f) + EPS);
    const size_t row = (size_t)row0 + il;
#pragma unroll
    for (int dt = 0; dt < 8; ++dt) {
        const v2u gwd = *(const v2u*)(Z + row * LDZ + ZC_RG + h * 128 + 16 * dt + 4 * quad);
        v2u w; w.x = pk2(C[dt][0] * scl * siluf_(lo_bf(gwd.x)), C[dt][1] * scl * siluf_(hi_bf(gwd.x))); w.y = pk2(C[dt][2] * scl * siluf_(lo_bf(gwd.y)), C[dt][3] * scl * siluf_(hi_bf(gwd.y)));
        *(v2u*)((bf16*)(ws + WS_MIX) + row * 1536 + 1024 + h * 128 + 16 * dt + 4 * quad) = w;
    }
    __syncthreads();
}
DI void gdn_out_row(Frame& F, int layer, int row) {
    const int lane = F.lane;
    unsigned char* ws = KWS();
    const float* o = (const float*)(ws + WS_OGDN) + (size_t)row * 512 + lane * 8;
    const f32x4 a = *(const f32x4*)o, b = *(const f32x4*)(o + 4);
    float ss = (a[0] * a[0] + a[1] * a[1]) + (a[2] * a[2] + a[3] * a[3]) + (b[0] * b[0] + b[1] * b[1]) + (b[2] * b[2] + b[3] * b[3]);
    ss += shx<1>(ss, lane); ss += shx<2>(ss, lane); ss += shx<4>(ss, lane); ss += shx<8>(ss, lane);
    const float scl = rsqrtf(ss * (1.f / 128.f) + EPS);
    const float* ng = KIN(18) + layer * 128 + (lane & 15) * 8;
    const f32x4 ga = *(const f32x4*)ng, gb = *(const f32x4*)(ng + 4);
    f32x4 za, zb; unpack8(*(const v4u*)((const bf16*)(ws + WS_Z) + (size_t)row * LDZ + ZC_GZ + lane * 8), za, zb);
    f32x4 ra, rb;
#pragma unroll
    for (int e = 0; e < 4; ++e) { ra[e] = a[e] * scl * ga[e] * siluf_(za[e]); rb[e] = b[e] * scl * gb[e] * siluf_(zb[e]); }
    *(v4u*)((bf16*)(ws + WS_MIX) + (size_t)row * 1536 + 512 + lane * 8) = pack8(ra, rb);
}
DI void final_row(Frame& F, int row) {
    const int lane = F.lane;
    const float* x = (const float*)(KWS() + WS_XR) + (size_t)row * DM;
    float* y = (row < MP) ? KOUT() + O_YP + (size_t)row * DM : KOUT() + O_YS + (size_t)(row - MP) * DM;
    f32x4 v[4]; float ss = 0.f;
#pragma unroll
    for (int j = 0; j < 4; ++j) { v[j] = *(const f32x4*)(x + 256 * j + lane * 4); ss += (v[j][0] * v[j][0] + v[j][1] * v[j][1]) + (v[j][2] * v[j][2] + v[j][3] * v[j][3]); }
    const float scl = rsqrtf(wave_sum(ss, lane) * (1.f / DM) + EPS);
#pragma unroll
    for (int j = 0; j < 4; ++j) *(f32x4*)(y + 256 * j + lane * 4) = v[j] * scl * *(const f32x4*)(KIN(26) + 256 * j + lane * 4);
}
template <class Epi>
DI void sgemm_tile(Frame& F, const bf16* A, int lda, const bf16* Bt, int ldb, int K, int row0, int col0, const Epi& E) {
    int lane = F.lane, wave = F.wave; asm volatile("" : "+v"(lane), "+s"(wave));
    const int tid = wave * 64 + lane, quad = lane >> 4, rl = lane & 15;
    const int kper = K >> 3, nks = kper >> 5;
    f32x4 acc[2][4];
#pragma unroll
    for (int rt = 0; rt < 2; ++rt)
#pragma unroll
        for (int ct = 0; ct < 4; ++ct) acc[rt][ct] = (f32x4){0.f, 0.f, 0.f, 0.f};
    const bf16* ap = A + (size_t)(row0 + rl) * lda + wave * kper + quad * 8;
    const bf16* bp = Bt + (size_t)(col0 + rl) * ldb + wave * kper + quad * 8;
#pragma unroll 4
    for (int ks = 0; ks < nks; ++ks) {
        bf16x8 a[2], b[4];
#pragma unroll
        for (int rt = 0; rt < 2; ++rt) a[rt] = ld_frag_g(ap + (size_t)(16 * rt) * lda + ks * 32);
#pragma unroll
        for (int ct = 0; ct < 4; ++ct) b[ct] = ld_frag_g(bp + (size_t)(16 * ct) * ldb + ks * 32);
#pragma unroll
        for (int rt = 0; rt < 2; ++rt)
#pragma unroll
            for (int ct = 0; ct < 4; ++ct) acc[rt][ct] = mfma16(a[rt], b[ct], acc[rt][ct]);
    }
    LAS float* RED = (LAS float*)F.lds;
#pragma unroll
    for (int rt = 0; rt < 2; ++rt)
#pragma unroll
        for (int ct = 0; ct < 4; ++ct)
#pragma unroll
            for (int i = 0; i < 4; ++i) RED[wave * 2176 + (16 * rt + 4 * quad + i) * 68 + 16 * ct + rl] = acc[rt][ct][i];
    __syncthreads();
    const int r = tid >> 4, c4 = (tid & 15) * 4;
    f32x4 v = *(const LAS f32x4*)(RED + r * 68 + c4);
#pragma unroll
    for (int w = 1; w < 8; ++w) v += *(const LAS f32x4*)(RED + w * 2176 + r * 68 + c4);
    E(row0 + r, col0 + c4, v, lane);
    __syncthreads();
}
struct SEpiC {
    const bf16* Z; bf16* G;
    DI void operator()(int row, int col, f32x4 v, int lane) const {
        const v2u gw = *(const v2u*)(Z + (size_t)row * LDZ + ZC_MG + col);
        v[0] *= sigmoidf_(lo_bf(gw.x)); v[1] *= sigmoidf_(hi_bf(gw.x)); v[2] *= sigmoidf_(lo_bf(gw.y)); v[3] *= sigmoidf_(hi_bf(gw.y));
        *(v2u*)(G + (size_t)row * 3072 + col) = pack4(v);
    }
};
struct SEpiRes {
    float* XR; bf16* XG; const float* gvec; float* SS; float* T; int mode;
    DI void operator()(int row, int col, f32x4 v, int lane) const {
        const size_t o = (size_t)row * DM + col;
        if (mode == 1) { *(f32x4*)(T + o) = v; return; }
        f32x4 x = *(const f32x4*)(XR + o);
        if (mode == 2) { const f32x4 t = *(const f32x4*)(T + o);
#pragma unroll
            for (int e = 0; e < 4; ++e) v[e] = t[e] * sigmoidf_(v[e]); }
        x += v;
        *(f32x4*)(XR + o) = x;
        if (XG) { f32x4 y = x; if (gvec) y *= *(const f32x4*)(gvec + col); *(v2u*)(XG + o) = pack4(y); }
        if (SS) { float ssq = (x[0] * x[0] + x[1] * x[1]) + (x[2] * x[2] + x[3] * x[3]);
            ssq += shx<1>(ssq, lane); ssq += shx<2>(ssq, lane); ssq += shx<4>(ssq, lane); ssq += shx<8>(ssq, lane);
            if ((lane & 15) == 0) SS[(size_t)row * 16 + (col >> 6)] = ssq; }
    }
};
struct SEpiUp {
    bf16* H; const float* SS;
    DI void operator()(int row, int col, f32x4 v, int lane) const {
        const f32x4 p0 = *(const f32x4*)(SS + (size_t)row * 16), p1 = *(const f32x4*)(SS + (size_t)row * 16 + 4), p2 = *(const f32x4*)(SS + (size_t)row * 16 + 8), p3 = *(const f32x4*)(SS + (size_t)row * 16 + 12);
        const f32x4 ps = (p0 + p1) + (p2 + p3);
        const float rstd = rsqrtf(((ps[0] + ps[1]) + (ps[2] + ps[3])) * (1.f / DM) + EPS);
#pragma unroll
        for (int e = 0; e < 4; ++e) { const float a = fmaxf(v[e] * rstd, 0.f); v[e] = a * a; }
        *(v2u*)(H + (size_t)row * DFF + col) = pack4(v);
    }
};
#ifndef PH_P0
#define PH_P0 1
#endif
#ifndef PH_A
#define PH_A 1
#endif
#ifndef PH_B0a
#define PH_B0a 1
#endif
#ifndef PH_B0b
#define PH_B0b 1
#endif
#ifndef PH_B0c
#define PH_B0c 1
#endif
#ifndef PH_B0d
#define PH_B0d 1
#endif
#ifndef PH_SCAN
#define PH_SCAN 1
#endif
#ifndef PH_RSCAN
#define PH_RSCAN 1
#endif
#ifndef PH_NSAP
#define PH_NSAP 1
#endif
#ifndef PH_NSAS
#define PH_NSAS 1
#endif
#ifndef PH_B2
#define PH_B2 1
#endif
#ifndef PH_C
#define PH_C 1
#endif
#ifndef PH_XBAR
#define PH_XBAR 0
#endif
#ifndef PH_D
#define PH_D 1
#endif
#ifndef PH_E
#define PH_E 1
#endif
#ifndef PH_F
#define PH_F 1
#endif
#ifndef PH_G1
#define PH_G1 1
#endif
#ifndef PH_G2
#define PH_G2 1
#endif
#ifndef PH_TREG
#define PH_TREG (-1)
#endif
#if PH_TREG >= 0
#define TREG_MARK(r) do { const unsigned long long now_ = __builtin_amdgcn_s_memrealtime(); if ((r) == PH_TREG) tacc_ += now_ - tlast_; tlast_ = now_; } while (0)
#define TREG_SUB(r) do { const unsigned long long now_ = __builtin_amdgcn_s_memrealtime(); if ((r) == PH_TREG) tacc_ += now_ - tsub_; tsub_ = now_; } while (0)
#else
#define TREG_MARK(r) do { } while (0)
#define TREG_SUB(r) do { } while (0)
#endif
struct Args { const void* in[27]; float* out; unsigned char* ws; };
__global__ void __launch_bounds__(NTHREADS, 2) mk_fwd(Args args) {
    extern __shared__ __attribute__((aligned(16))) unsigned char lds_raw[];
    Frame F;
    F.lds = (LAS unsigned char*)lds_raw;
    F.wave = __builtin_amdgcn_readfirstlane((int)threadIdx.x >> 6); F.lane = 0; F.tid = 0;
    F.G = gridDim.x; F.bid = blockIdx.x;
    F.ctl = (gu32*)(KWS() + WS_CTL);
    { const Frame Fp = fresh(F); for (int u = Fp.tid; u < (LDS_BYTES - LDSCTL_OFF) / 4; u += NTHREADS) ((LAS unsigned*)(F.lds + LDSCTL_OFF))[u] = 0u;
      __syncthreads();
      (void)xcd_barrier_post((unsigned*)(F.ctl + CW_BAR), (volatile LAS unsigned*)(F.lds + MISC_OFF) + 8, Fp.tid == 0); }
    const int G = F.G, bid = F.bid;
#if PH_TREG >= 0
    unsigned long long tacc_ = 0ull, tlast_ = __builtin_amdgcn_s_memrealtime(), tsub_ = tlast_;
#endif

        for (int rp_ = 0; rp_ < PH_P0; ++rp_) {
    { Frame Fp = fresh(F); p0_prologue(Fp); }
        }
    GRID_BAR();
    TREG_MARK(0);

    for (int layer = 0; layer < NLAYER; ++layer) {
        for (int rp_ = 0; rp_ < PH_A; ++rp_) {
        {
            const Frame Fg = fresh(F); const int G = Fg.G, bid = Fg.bid;
            unsigned char* ws = KWS();
            pg8::Gemm g{(const bf16*)(ws + WS_XGA), (const bf16*)(ws + WS_WIN + layer * SZ_WIN), MROWS, LDZ, DM, DM, DM, 31, 0};
            pg8::StaticOrder S; S.init(MROWS, LDZ, G, bid);
            epi::EpiA E{(bf16*)(ws + WS_Z), (float*)(ws + WS_ZS), (const float*)(ws + WS_SSA), KOUT(), layer};
            pg8::gemm_phase<epi::EpiA, pg8::StaticOrder, true, true>(Fg.lds, g, S, E, Fg.tid);
        }
        }
        GRID_BAR();
    TREG_MARK(1);
#if PH_TREG >= 0
        tsub_ = __builtin_amdgcn_s_memrealtime();
#endif
        {
            Frame Fp = fresh(F);
            gu32* qhead = F.ctl + CW_QUEUE + 512 * layer + 384;
            volatile LAS int* qslot = (volatile LAS int*)(F.lds + MISC_OFF) + 16;
            constexpr int NI = 5 * 272 * PH_B0d, N2 = 1024 * PH_B0c, N3 = 512 * PH_B0b;
            for (;;) {
                if (Fp.tid == 0) qslot[0] = (int)__hip_atomic_fetch_add(qhead, 1u, __ATOMIC_RELAXED, __HIP_MEMORY_SCOPE_AGENT);
                __syncthreads();
                int it = qslot[0];
                __syncthreads();
                it = __builtin_amdgcn_readfirstlane(it);
                if (it >= NI + N2 + N3) break;
                TREG_SUB(99);
                if (it < NI) { const int k = it / 5, r = it % 5;
                    if (r == 0) compress_job(Fp, layer, k % 272);
                    else if (k < 256 * PH_B0a) gdn_prep_unit(Fp, layer, (4 * k + r - 1) & 1023); }
                else if (it < NI + N2) sample_rec_unit(Fp, layer, (it - NI) & 1023);
                else ret_prep_unit(Fp, layer, (it - NI - N2) & 511);
                TREG_SUB(it < NI ? ((it % 5) == 0 ? 40 : 41) : (it < NI + N2 ? 42 : 43));
            }
        }
        GRID_BAR();
    TREG_MARK(2);
        {
            Frame Fp = fresh(F);
            gu32* qbase = F.ctl + CW_QUEUE + 512 * layer;
            volatile LAS int* qslot = (volatile LAS int*)(F.lds + MISC_OFF) + 16;
            constexpr int NQ = 8 * PH_SCAN, NS = 128 * PH_NSAS, NR = 32 * PH_RSCAN, NP = 256 * PH_NSAP;
            const int pref = (int)(xb_xcc_id() & 3u);
            for (;;) {
                if (Fp.tid == 0) qslot[1] = (int)__hip_atomic_fetch_add(qbase, 1u, __ATOMIC_RELAXED, __HIP_MEMORY_SCOPE_AGENT);
                __syncthreads();
                int it = qslot[1];
                __syncthreads();
                it = __builtin_amdgcn_readfirstlane(it);
                if (it >= NQ + NR) break;
                TREG_SUB(99);
                if (it < NQ) gdn_scan_chain(Fp, layer, it & 7);
                else ret_scan_part(Fp, layer, (it - NQ) & 31);
                TREG_SUB(it < NQ ? 21 : 23);
            }
            const int when = Fp.bid & 3;
            bool tried = false;
            for (int nu = 0;; ++nu) {
                if (Fp.tid == 0) {
                    int kind = -1, idx = 0;
                    if (!tried && nu >= when) {
                        tried = true;
                        const int a = (int)__hip_atomic_fetch_add(qbase + 320, 1u, __ATOMIC_RELAXED, __HIP_MEMORY_SCOPE_AGENT);
                        if (a < NS) { kind = 4; idx = a; }
                    }
                    if (kind < 0) {
                        for (int k = 0; k < 4 && kind < 0; ++k) { const int s = (pref + k) & 3;
                            if ((int)__hip_atomic_load(qbase + 64 * (1 + s), __ATOMIC_RELAXED, __HIP_MEMORY_SCOPE_AGENT) < NP) {
                                const int r = (int)__hip_atomic_fetch_add(qbase + 64 * (1 + s), 1u, __ATOMIC_RELAXED, __HIP_MEMORY_SCOPE_AGENT);
                                if (r < NP) { kind = s; idx = r; } } }
                    }
                    if (kind < 0) {
                        const int a = (int)__hip_atomic_fetch_add(qbase + 320, 1u, __ATOMIC_RELAXED, __HIP_MEMORY_SCOPE_AGENT);
                        if (a < NS) { kind = 4; idx = a; }
                    }
                    qslot[0] = kind; qslot[1] = idx;
                }
                __syncthreads();
                int kind = qslot[0], it = qslot[1];
                __syncthreads();
                kind = __builtin_amdgcn_readfirstlane(kind); it = __builtin_amdgcn_readfirstlane(it);
                if (kind < 0) break;
                TREG_SUB(99);
                if (kind < 4) nsa_prompt_unit(Fp, layer, (kind << 8) | (255 - (it & 255)));
                else nsa_sample_unit(Fp, layer, it & 127);
                TREG_SUB(kind < 4 ? 20 : 22);
            }
        }
        GRID_BAR();
    TREG_MARK(3);
        for (int rp_ = 0; rp_ < PH_B2; ++rp_) {
        { Frame Fp = fresh(F); for (int u = Fp.bid; u < 512; u += Fp.G) ret_out_unit(Fp, layer, u); }
        { Frame Fp = fresh(F); for (int r = Fp.bid * NWAVES + Fp.wave; r < MROWS; r += Fp.G * NWAVES) gdn_out_row(Fp, layer, r); }
        }
        GRID_BAR();
    TREG_MARK(4);
        for (int rp_ = 0; rp_ < PH_C; ++rp_) {
        {
            const Frame Fg = fresh(F); const int G = Fg.G, bid = Fg.bid;
            unsigned char* ws = KWS();
            pg8::Gemm g{(const bf16*)(ws + WS_MIX), (const bf16*)(ws + WS_WBR + layer * SZ_WBR), MP, 3072, 512, 1536, 512, 2, 1024};
            pg8::StaticOrder S; S.init(MP, 3072, G, bid);
            epi::EpiC E{(const bf16*)(ws + WS_Z), (bf16*)(ws + WS_GATED)};
            pg8::gemm_phase<epi::EpiC, pg8::StaticOrder, true, true>(Fg.lds, g, S, E, Fg.tid);
            TREG_SUB(99);
            {
                Frame Fs = fresh(F); const SEpiC Es{(const bf16*)(ws + WS_Z), (bf16*)(ws + WS_GATED)};
                for (int tl = Fs.bid; tl < 16 * 48; tl += Fs.G) { const int rt = tl & 15, ct = tl >> 4, b = ct >> 4;
                    sgemm_tile(Fs, (const bf16*)(ws + WS_MIX) + b * 512, 1536, (const bf16*)(ws + WS_WBR + layer * SZ_WBR), 512, 512, MP + 32 * rt, 64 * ct, Es); }
            }
            TREG_SUB(31);
        }
        }
        GRID_BAR();
    TREG_MARK(5);
        for (int rp_ = 0; rp_ < PH_D; ++rp_) {
        {
            const Frame Fg = fresh(F); const int G = Fg.G, bid = Fg.bid;
            unsigned char* ws = KWS();
            pg8::Gemm g{(const bf16*)(ws + WS_GATED), (const bf16*)(ws + WS_WO3 + layer * SZ_WO3), MP, DM, 3072, 3072, 3072, 31, 0};
            pg8::StaticOrder S; S.init(MP, DM, G, bid);
            epi::EpiRes E{(float*)(ws + WS_XR), (bf16*)(ws + WS_XGB), KIN(21) + layer * DM, (float*)(ws + WS_SSB), nullptr, (rp_ + 1 < PH_D) ? 3 : 0};
            pg8::gemm_phase<epi::EpiRes, pg8::StaticOrder, true, true>(Fg.lds, g, S, E, Fg.tid);
            TREG_SUB(99);
            if (rp_ + 1 == PH_D) {
                Frame Fs = fresh(F); const SEpiRes Es{(float*)(ws + WS_XR), (bf16*)(ws + WS_XGB), KIN(21) + layer * DM, (float*)(ws + WS_SSB), nullptr, 0};
                for (int tl = Fs.bid; tl < 256; tl += Fs.G) sgemm_tile(Fs, (const bf16*)(ws + WS_GATED), 3072, (const bf16*)(ws + WS_WO3 + layer * SZ_WO3), 3072, 3072, MP + 32 * (tl & 15), 64 * (tl >> 4), Es);
            }
            TREG_SUB(32);
        }
        }
        GRID_BAR();
    TREG_MARK(6);
        for (int rp_ = 0; rp_ < PH_E; ++rp_) {
        {
            const Frame Fg = fresh(F); const int G = Fg.G, bid = Fg.bid;
            unsigned char* ws = KWS();
            pg8::Gemm g{(const bf16*)(ws + WS_XGB), (const bf16*)(ws + WS_WUP + layer * SZ_WUP), MP, DFF, DM, DM, DM, 31, 0};
            pg8::StaticOrder S; S.init(MP, DFF, G, bid);
            epi::EpiUp E{(bf16*)(ws + WS_HMID), (const float*)(ws + WS_SSB)};
            pg8::gemm_phase<epi::EpiUp, pg8::StaticOrder, true, true>(Fg.lds, g, S, E, Fg.tid);
            TREG_SUB(99);
            {
                Frame Fs = fresh(F); const SEpiUp Es{(bf16*)(ws + WS_HMID), (const float*)(ws + WS_SSB)};
                for (int tl = Fs.bid; tl < 16 * 64; tl += Fs.G) sgemm_tile(Fs, (const bf16*)(ws + WS_XGB), DM, (const bf16*)(ws + WS_WUP + layer * SZ_WUP), DM, DM, MP + 32 * (tl & 15), 64 * (tl >> 4), Es);
            }
            TREG_SUB(33);
        }
        }
        GRID_BAR();
    TREG_MARK(7);
        for (int rp_ = 0; rp_ < PH_F; ++rp_) {
        {
            const Frame Fg = fresh(F); const int G = Fg.G, bid = Fg.bid;
            unsigned char* ws = KWS();
            pg8::Gemm g{(const bf16*)(ws + WS_HMID), (const bf16*)(ws + WS_WDN + layer * SZ_WDN), MP, DM, DFF, DFF, DFF, 31, 0};
            pg8::StaticOrder S; S.init(MP, DM, G, bid);
            epi::EpiRes E{(float*)(ws + WS_XR), (bf16*)(ws + WS_XGC), nullptr, nullptr, nullptr, (rp_ + 1 < PH_F) ? 3 : 0};
            pg8::gemm_phase<epi::EpiRes, pg8::StaticOrder, true, true>(Fg.lds, g, S, E, Fg.tid);
            TREG_SUB(99);
            if (rp_ + 1 == PH_F) {
                Frame Fs = fresh(F); const SEpiRes Es{(float*)(ws + WS_XR), (bf16*)(ws + WS_XGC), nullptr, nullptr, nullptr, 0};
                for (int tl = Fs.bid; tl < 256; tl += Fs.G) sgemm_tile(Fs, (const bf16*)(ws + WS_HMID), DFF, (const bf16*)(ws + WS_WDN + layer * SZ_WDN), DFF, DFF, MP + 32 * (tl & 15), 64 * (tl >> 4), Es);
            }
            TREG_SUB(34);
        }
        }
        GRID_BAR();
    TREG_MARK(8);
        for (int rp_ = 0; rp_ < PH_G1; ++rp_) {
        {
            const Frame Fg = fresh(F); const int G = Fg.G, bid = Fg.bid;
            unsigned char* ws = KWS();
            int kple = PLE; asm volatile("" : "+s"(kple));
            pg8::Gemm g{(const bf16*)(ws + WS_P16) + (size_t)layer * MROWS * PLE, (const bf16*)(ws + WS_WPL + layer * SZ_WPL), MP, DM, kple, PLE, PLE, 31, 0};
            pg8::StaticOrder S; S.init(MP, DM, G, bid);
            epi::EpiRes E{nullptr, nullptr, nullptr, nullptr, (float*)(ws + WS_TPLE), 1};
            pg8::gemm_phase<epi::EpiRes, pg8::StaticOrder, true, true>(Fg.lds, g, S, E, Fg.tid);
            TREG_SUB(99);
            {
                Frame Fs = fresh(F); const SEpiRes Es{nullptr, nullptr, nullptr, nullptr, (float*)(ws + WS_TPLE), 1};
                for (int tl = Fs.bid; tl < 256; tl += Fs.G) sgemm_tile(Fs, (const bf16*)(ws + WS_P16) + (size_t)layer * MROWS * PLE, PLE, (const bf16*)(ws + WS_WPL + layer * SZ_WPL), PLE, PLE, MP + 32 * (tl & 15), 64 * (tl >> 4), Es);
            }
            TREG_SUB(35);
        }
        }
        for (int rp_ = 0; rp_ < PH_G2; ++rp_) {
        {
            const Frame Fg = fresh(F); const int G = Fg.G, bid = Fg.bid;
            unsigned char* ws = KWS();
            const bool more = layer + 1 < NLAYER;
            pg8::Gemm g{(const bf16*)(ws + WS_XGC), (const bf16*)(ws + WS_WPG + layer * SZ_WPG), MP, DM, DM, DM, DM, 31, 0};
            pg8::StaticOrder S; S.init(MP, DM, G, bid);
            epi::EpiRes E{(float*)(ws + WS_XR), more ? (bf16*)(ws + WS_XGA) : nullptr, more ? KIN(10) + (layer + 1) * DM : nullptr, more ? (float*)(ws + WS_SSA) : nullptr, (float*)(ws + WS_TPLE), (rp_ + 1 < PH_G2) ? 3 : 2};
            pg8::gemm_phase<epi::EpiRes, pg8::StaticOrder, true, true>(Fg.lds, g, S, E, Fg.tid);
            TREG_SUB(99);
            if (rp_ + 1 == PH_G2) {
                Frame Fs = fresh(F); const SEpiRes Es{(float*)(ws + WS_XR), more ? (bf16*)(ws + WS_XGA) : nullptr, more ? KIN(10) + (layer + 1) * DM : nullptr, more ? (float*)(ws + WS_SSA) : nullptr, (float*)(ws + WS_TPLE), 2};
                for (int tl = Fs.bid; tl < 256; tl += Fs.G) sgemm_tile(Fs, (const bf16*)(ws + WS_XGC), DM, (const bf16*)(ws + WS_WPG + layer * SZ_WPG), DM, DM, MP + 32 * (tl & 15), 64 * (tl >> 4), Es);
            }
            TREG_SUB(36);
        }
        }
        GRID_BAR();
    TREG_MARK(9);
    }
    for (int xb_ = 0; xb_ < PH_XBAR; ++xb_) GRID_BAR();
    { Frame Fp = fresh(F); for (int r = Fp.bid * NWAVES + Fp.wave; r < MROWS; r += Fp.G * NWAVES) final_row(Fp, r); }
    TREG_MARK(10);
#if PH_TREG >= 0
#if defined(PH_GPT) && PH_GPT >= 0
    tacc_ += *(volatile LAS unsigned long long*)(F.lds + LDSCTL_OFF + 448);
#endif
#if defined(PH_NPT) && PH_NPT >= 0
    tacc_ += *(volatile LAS unsigned long long*)(F.lds + LDSCTL_OFF + 464);
#endif
      { const unsigned long long tend_ = __builtin_amdgcn_s_memrealtime() + tacc_; while (__builtin_amdgcn_s_memrealtime() < tend_) __builtin_amdgcn_s_sleep(8); }
#endif
}

extern "C" void kernel_launch(void* const* d_in, const int* in_sizes, int n_in, void* d_out, int out_size, void* d_ws, size_t ws_size, hipStream_t stream) {
    static int grid = 0;
    if (grid == 0) {
        if (n_in != 27 || ws_size < WS_END) { fprintf(stderr, "kernel_launch: unexpected shapes (n_in %d out %d ws %zu, need %zu)\n", n_in, out_size, ws_size, (size_t)WS_END); grid = -1; return; }
        int dev = 0, cus = 0;
        if (hipGetDevice(&dev) != hipSuccess || hipDeviceGetAttribute(&cus, hipDeviceAttributeMultiprocessorCount, dev) != hipSuccess) { grid = -1; return; }
        if (hipFuncSetAttribute((const void*)mk_fwd, hipFuncAttributeMaxDynamicSharedMemorySize, LDS_BYTES) != hipSuccess) { fprintf(stderr, "kernel_launch: hipFuncSetAttribute failed\n"); grid = -1; return; }
        int per_cu = 0;
        if (hipOccupancyMaxActiveBlocksPerMultiprocessor(&per_cu, (const void*)mk_fwd, NTHREADS, LDS_BYTES) != hipSuccess || per_cu < 1) fprintf(stderr, "kernel_launch: occupancy query reports %d\n", per_cu);
        (void)hipGetLastError();
        grid = cus;
    }
    if (grid < 0) return;
    if (hipMemsetAsync((char*)d_ws + WS_CTL, 0, CTL_ZERO_BYTES, stream) != hipSuccess) return;
    Args a{};
    for (int i = 0; i < 27; ++i) a.in[i] = d_in[i];
    a.out = (float*)d_out; a.ws = (unsigned char*)d_ws;
    hipLaunchKernelGGL(mk_fwd, dim3(grid), dim3(NTHREADS), LDS_BYTES, stream, a);
}
```

```cpp
#include <hip/hip_runtime.h>
#include <cstdio>
#include <cstdint>
namespace pg8 {
#define PG8_LAS __attribute__((address_space(3)))
typedef unsigned short bf16_t;
typedef short bf16x8 __attribute__((ext_vector_type(8)));
typedef float f32x4 __attribute__((ext_vector_type(4)));
typedef unsigned u32x4 __attribute__((ext_vector_type(4)));
constexpr int BM = 256, BK = 64, HALF = 128, HTB = HALF * BK * 2  , STAGE_BYTES = 8 * HTB, NXCD = 8, WGM = 8;

__host__ __device__ __forceinline__ int lds_byte(int r, int c) { const int st = (r >> 4) * 2 + (c >> 5), rr = r & 15, cc = c & 31, ob = rr * 64 + cc * 2; return st * 1024 + (ob ^ (((ob >> 9) & 1) << 5)); }
__host__ __device__ __forceinline__ void stage_rc(int b, int& R, int& C) { const int st = b / 1024, sb = b % 1024, swz = sb ^ (((sb >> 9) & 1) << 5); R = (st >> 1) * 16 + swz / 64; C = (st & 1) * 32 + (swz % 64) / 2; }
__host__ __device__ __forceinline__ int perm32(int rho) { const int n = rho >> 4, i = rho & 15; return 8 * (i >> 2) + 4 * n + (i & 3); }

struct Unit { int pm, pn; };
struct Gemm { const bf16_t* A; const bf16_t* Bt; int M, N, K; int lda, ldb; int a_shift, a_off; };

struct StaticOrder {
    int nM, nN, nwg, G, c;
    __host__ __device__ void init(int M, int N, int G_, int c_) { nM = M / BM; nN = N / BM; nwg = nM * nN; G = G_; c = c_; }
    __host__ __device__ bool next(int i, Unit& u) const {
        const long L = (long)i * G + c; if (L >= nwg) return false;
        int wgid = (int)L; { const int q = nwg / NXCD, r = nwg % NXCD, xcd = wgid % NXCD, off = wgid / NXCD; wgid = (xcd < r ? xcd * (q + 1) : r * (q + 1) + (xcd - r) * q) + off; }
        const int nig = WGM * nN, gid = wgid / nig, fm = gid * WGM, gsz = (nM - fm) < WGM ? (nM - fm) : WGM;
        u.pm = fm + ((wgid % nig) % gsz); u.pn = (wgid % nig) / gsz; return true;
    }
    __device__ __forceinline__ void a_ready(const Unit&) const {}
    __device__ __forceinline__ void done(const Unit&) const {}
};

__device__ __forceinline__ unsigned cvt_pk_bf16(float lo, float hi) { unsigned r; asm volatile("v_cvt_pk_bf16_f32 %0, %1, %2" : "=v"(r) : "v"(lo), "v"(hi)); return r; }
typedef float f32x2 __attribute__((ext_vector_type(2)));
template <class Epi, class Sched, bool ALIGN_EPI = false, bool SP2 = false>
__device__ __forceinline__ void gemm_phase(PG8_LAS unsigned char* lds, const Gemm g, const Sched& S, const Epi& E, const int tid) {
    const int wid = __builtin_amdgcn_readfirstlane(tid >> 6), lane = tid & 63, wr = wid >> 2, wc = wid & 3, fr = lane & 15, fq = lane >> 4;
    const int K = g.K, nt = K / BK;
    unsigned voffA[2], voffB[2];
#pragma unroll
    for (int i = 0; i < 2; ++i) { int R, C; stage_rc(tid * 16 + i * 8192, R, C); const int Rb = Epi::PERM ? ((R & ~31) + perm32(R & 31)) : R;
        voffA[i] = (unsigned)(R * g.lda + C) * 2u; voffB[i] = (unsigned)(Rb * g.ldb + C) * 2u; }
    const size_t kstep = (size_t)(BK * 2);
    const size_t hstepA = (size_t)HALF * g.lda * 2, hstepB = (size_t)HALF * g.ldb * 2;
    const size_t tstepA = 2 * hstepA, tstepB = 2 * hstepB;
    const unsigned ldsw = (unsigned)wid * 1024u;
    const int aoff = lds_byte(wr * 64 + fr, fq * 8), boff = lds_byte(wc * 32 + fr, fq * 8);
#define PG8_SA(b, h) (((b) * 2 + (h)) * HTB)
#define PG8_SB(b, h) ((4 + (b) * 2 + (h)) * HTB)
#define PG8_STAGE(bufoff, gbase, voff) do { _Pragma("unroll") for (int _i = 0; _i < 2; ++_i) \
        __builtin_amdgcn_global_load_lds((const unsigned*)((const char*)(gbase) + (voff)[_i]), (PG8_LAS unsigned*)(lds + (bufoff) + ldsw + _i * 8192), 16, 0, 0); } while (0)
#define PG8_LDA(dst, b, h) do { _Pragma("unroll") for (int m = 0; m < 4; ++m) _Pragma("unroll") for (int k = 0; k < 2; ++k) dst[m][k] = *(const PG8_LAS bf16x8*)(lds + PG8_SA(b, h) + aoff + m * 2048 + k * 1024); } while (0)
#define PG8_LDB(dst, b, h) do { _Pragma("unroll") for (int n = 0; n < 2; ++n) _Pragma("unroll") for (int k = 0; k < 2; ++k) dst[n][k] = *(const PG8_LAS bf16x8*)(lds + PG8_SB(b, h) + boff + n * 2048 + k * 1024); } while (0)
#define PG8_MMA(ai, bj, At, Bt) do { __builtin_amdgcn_s_setprio(1); _Pragma("unroll") for (int m = 0; m < 4; ++m) _Pragma("unroll") for (int n = 0; n < 2; ++n) _Pragma("unroll") for (int k = 0; k < 2; ++k) \
        acc[ai][bj][m][n] = __builtin_amdgcn_mfma_f32_16x16x32_bf16(Bt[n][k], At[m][k], acc[ai][bj][m][n], 0, 0, 0); __builtin_amdgcn_s_setprio(0); } while (0)
#define PG8_WAIT_V(n) asm volatile("s_waitcnt vmcnt(" #n ")" ::: "memory")
#define PG8_WAIT_L(n) asm volatile("s_waitcnt lgkmcnt(" #n ")" ::: "memory")
#define PG8_BAR __builtin_amdgcn_s_barrier()
#define PG8_SCHED __builtin_amdgcn_sched_barrier(0)
    Unit cur, nxt; int ui = 0;
    if (!S.next(0, cur)) return;
    f32x4 acc[2][2][4][2];
#pragma unroll
    for (int a = 0; a < 2; ++a)
#pragma unroll
        for (int b = 0; b < 2; ++b)
#pragma unroll
            for (int m = 0; m < 4; ++m)
#pragma unroll
                for (int n = 0; n < 2; ++n) acc[a][b][m][n] = (f32x4){0.f, 0.f, 0.f, 0.f};
    bf16x8 At[4][2], B0[2][2], B1[2][2];
    const char* cA = (const char*)g.A + (size_t)cur.pm * tstepA + (size_t)(cur.pn >> g.a_shift) * (size_t)g.a_off; const char* cB = (const char*)g.Bt + (size_t)cur.pn * tstepB;
    S.a_ready(cur);
    if constexpr (SP2) {
        PG8_STAGE(PG8_SB(0, 0), cB, voffB); PG8_STAGE(PG8_SB(0, 1), cB + hstepB, voffB); PG8_STAGE(PG8_SA(0, 0), cA, voffA); PG8_STAGE(PG8_SA(0, 1), cA + hstepA, voffA);
        if (wr == 1) PG8_BAR;
        PG8_WAIT_V(2); PG8_BAR;
        PG8_STAGE(PG8_SB(1, 0), cB + kstep, voffB); PG8_STAGE(PG8_SA(1, 0), cA + kstep, voffA); PG8_STAGE(PG8_SB(1, 1), cB + hstepB + kstep, voffB);
        PG8_WAIT_V(6); PG8_BAR;
    } else {
        PG8_STAGE(PG8_SB(0, 0), cB, voffB); PG8_STAGE(PG8_SA(0, 0), cA, voffA); PG8_STAGE(PG8_SB(0, 1), cB + hstepB, voffB); PG8_STAGE(PG8_SA(0, 1), cA + hstepA, voffA);
        if (wr == 1) PG8_BAR;
        PG8_WAIT_V(4); PG8_BAR;
        PG8_STAGE(PG8_SB(1, 0), cB + kstep, voffB); PG8_STAGE(PG8_SA(1, 0), cA + kstep, voffA); PG8_STAGE(PG8_SB(1, 1), cB + hstepB + kstep, voffB);
        PG8_WAIT_V(6); PG8_BAR;
    }
    for (;;) {
        const bool has_next = S.next(ui + 1, nxt);
        const char* nA = has_next ? (const char*)g.A + (size_t)nxt.pm * tstepA + (size_t)(nxt.pn >> g.a_shift) * (size_t)g.a_off : cA; const char* nB = has_next ? (const char*)g.Bt + (size_t)nxt.pn * tstepB : cB;
        for (int t = 0; t < nt; t += 2) {
            const bool last = (t == nt - 2);
            const char* a1 = cA + (size_t)(t + 1) * kstep;
            const char* a2 = last ? nA : cA + (size_t)(t + 2) * kstep; const char* b2 = last ? nB : cB + (size_t)(t + 2) * kstep;
            const char* a3 = a2 + kstep; const char* b3 = b2 + kstep;
            if (last && has_next) S.a_ready(nxt);
            if constexpr (SP2) {
            PG8_LDB(B0, 0, 0); PG8_LDB(B1, 0, 1); PG8_SCHED; PG8_LDA(At, 0, 0); PG8_STAGE(PG8_SA(1, 1), a1 + hstepA, voffA);
            PG8_WAIT_V(8); PG8_WAIT_L(0); PG8_BAR; PG8_MMA(0, 0, At, B0); PG8_MMA(0, 1, At, B1); PG8_BAR; PG8_SCHED;
            PG8_LDA(At, 0, 1); PG8_STAGE(PG8_SB(0, 0), b2, voffB); PG8_STAGE(PG8_SB(0, 1), b2 + hstepB, voffB); PG8_STAGE(PG8_SA(0, 0), a2, voffA);
            PG8_WAIT_V(8); PG8_WAIT_L(0); PG8_BAR; PG8_MMA(1, 0, At, B0); PG8_MMA(1, 1, At, B1); PG8_BAR; PG8_SCHED;
            PG8_LDB(B0, 1, 0); PG8_LDB(B1, 1, 1); PG8_SCHED; PG8_LDA(At, 1, 0); PG8_STAGE(PG8_SA(0, 1), a2 + hstepA, voffA);
            PG8_WAIT_V(8); PG8_WAIT_L(0); PG8_BAR; PG8_MMA(0, 0, At, B0); PG8_MMA(0, 1, At, B1); PG8_BAR; PG8_SCHED;
            PG8_LDA(At, 1, 1); PG8_STAGE(PG8_SB(1, 0), b3, voffB); PG8_STAGE(PG8_SB(1, 1), b3 + hstepB, voffB); PG8_STAGE(PG8_SA(1, 0), a3, voffA);
            PG8_WAIT_V(8); PG8_WAIT_L(0); PG8_BAR; PG8_MMA(1, 0, At, B0); PG8_MMA(1, 1, At, B1); PG8_BAR; PG8_SCHED;
            } else {
            PG8_LDB(B0, 0, 0); PG8_SCHED; PG8_LDA(At, 0, 0); PG8_STAGE(PG8_SA(1, 1), a1 + hstepA, voffA);
            PG8_WAIT_L(8); PG8_BAR; PG8_WAIT_L(0); PG8_MMA(0, 0, At, B0); PG8_BAR; PG8_SCHED;
            PG8_LDB(B1, 0, 1); PG8_STAGE(PG8_SB(0, 0), b2, voffB);
            PG8_BAR; PG8_WAIT_L(0); PG8_MMA(0, 1, At, B1); PG8_BAR;
            PG8_LDA(At, 0, 1); PG8_STAGE(PG8_SA(0, 0), a2, voffA);
            PG8_BAR; PG8_WAIT_L(0); PG8_MMA(1, 0, At, B0); PG8_BAR; PG8_SCHED;
            PG8_STAGE(PG8_SB(0, 1), b2 + hstepB, voffB);
            PG8_WAIT_V(6); PG8_BAR; PG8_MMA(1, 1, At, B1); PG8_BAR;
            PG8_LDB(B0, 1, 0); PG8_SCHED; PG8_LDA(At, 1, 0); PG8_STAGE(PG8_SA(0, 1), a2 + hstepA, voffA);
            PG8_WAIT_L(8); PG8_BAR; PG8_WAIT_L(0); PG8_MMA(0, 0, At, B0); PG8_BAR; PG8_SCHED;
            PG8_LDB(B1, 1, 1); PG8_STAGE(PG8_SB(1, 0), b3, voffB);
            PG8_BAR; PG8_WAIT_L(0); PG8_MMA(0, 1, At, B1); PG8_BAR;
            PG8_LDA(At, 1, 1); PG8_STAGE(PG8_SA(1, 0), a3, voffA);
            PG8_BAR; PG8_WAIT_L(0); PG8_MMA(1, 0, At, B0); PG8_BAR; PG8_SCHED;
            PG8_STAGE(PG8_SB(1, 1), b3 + hstepB, voffB);
            PG8_WAIT_V(6); PG8_BAR; PG8_MMA(1, 1, At, B1); PG8_BAR;
            }
        }
        if constexpr (ALIGN_EPI) { if (wr == 0) PG8_BAR; }
        if constexpr (!Epi::AFTER_DRAIN) { E(acc, cur, wr, wc, fr, fq); S.done(cur); }
        if (!has_next) break;
#pragma unroll
        for (int a = 0; a < 2; ++a)
#pragma unroll
            for (int b = 0; b < 2; ++b)
#pragma unroll
                for (int m = 0; m < 4; ++m)
#pragma unroll
                    for (int n = 0; n < 2; ++n) acc[a][b][m][n] = (f32x4){0.f, 0.f, 0.f, 0.f};
        cur = nxt; cA = nA; cB = nB; ++ui;
        if constexpr (ALIGN_EPI) { if (wr == 1) PG8_BAR; }
    }
    PG8_WAIT_V(0);
    if constexpr (!ALIGN_EPI) { if (wr == 0) PG8_BAR; }
    PG8_BAR;
    if constexpr (Epi::AFTER_DRAIN) { E.fused(acc, cur, wr, wc, fr, fq, lds, wid, lane); S.done(cur); }
#undef PG8_SA
#undef PG8_SB
#undef PG8_STAGE
#undef PG8_LDA
#undef PG8_LDB
#undef PG8_MMA
#undef PG8_WAIT_V
#undef PG8_WAIT_L
#undef PG8_BAR
#undef PG8_SCHED
}
}
#define DI __device__ __forceinline__
#define GAS __attribute__((address_space(1)))
#define LAS __attribute__((address_space(3)))
typedef unsigned short bf16;
typedef unsigned v4u __attribute__((ext_vector_type(4)));
typedef unsigned v2u __attribute__((ext_vector_type(2)));
typedef float f32x4 __attribute__((ext_vector_type(4)));
typedef float f32x2 __attribute__((ext_vector_type(2)));
typedef short bf16x8 __attribute__((ext_vector_type(8)));
typedef short s16x4 __attribute__((ext_vector_type(4)));
typedef GAS unsigned gu32;

constexpr int DM = 1024, TP = 8192, MP = 16384, MS = 512, MROWS = 16896, LDZ = 8704, DFF = 4096, PLE = 256, NLAYER = 2;
constexpr int ZC_Q = 0, ZC_KC = 512, ZC_VC = 640, ZC_KS = 768, ZC_VS = 896, ZC_KW = 1024, ZC_VW = 1152, ZC_GQKV = 1280, ZC_GZ = 2816, ZC_RQKV = 3328, ZC_RG = 4864, ZC_MG = 5376, ZC_SM = 8448;
constexpr float EPS = 1e-6f;
constexpr size_t O_YP = 0, O_YS = O_YP + (size_t)MP * DM, O_KVP = O_YS + (size_t)MS * DM, O_KVS = O_KVP + (size_t)2 * MP * 512, O_WINP = O_KVS + (size_t)2 * MS * 512,
                 O_WINS = O_WINP + (size_t)2 * 2 * 512 * 256, O_CVP = O_WINS + (size_t)2 * 128 * 512 * 256, O_CVS = O_CVP + (size_t)2 * 2 * 3 * 1536, O_GSP = O_CVS + (size_t)2 * 128 * 3 * 1536,
                 O_GSS = O_GSP + (size_t)2 * 2 * 4 * 16384, O_RSP = O_GSS + (size_t)2 * 128 * 4 * 16384, O_RSS = O_RSP + (size_t)2 * 2 * 4 * 16384, O_END = O_RSS + (size_t)2 * 128 * 4 * 16384;

DI float bf2f(unsigned short b) { return __uint_as_float((unsigned)b << 16); }
DI unsigned f2bf(float f) { unsigned u = __float_as_uint(f); return (u + 0x7fffu + ((u >> 16) & 1u)) >> 16; }
typedef __bf16 bf16x2_t __attribute__((ext_vector_type(2)));
DI unsigned pk2(float lo, float hi) { const f32x2 v = {lo, hi}; return __builtin_bit_cast(unsigned, __builtin_convertvector(v, bf16x2_t)); }
DI float lo_bf(unsigned w) { return __uint_as_float(w << 16); }
DI float hi_bf(unsigned w) { return __uint_as_float(w & 0xffff0000u); }
DI float sigmoidf_(float x) { return 1.f / (1.f + __expf(-x)); }
DI float siluf_(float x) { return x / (1.f + __expf(-x)); }
DI v4u pack8(const f32x4 a, const f32x4 b) { v4u w; w.x = pk2(a[0], a[1]); w.y = pk2(a[2], a[3]); w.z = pk2(b[0], b[1]); w.w = pk2(b[2], b[3]); return w; }
DI void unpack8(const v4u w, f32x4& a, f32x4& b) { a[0] = lo_bf(w.x); a[1] = hi_bf(w.x); a[2] = lo_bf(w.y); a[3] = hi_bf(w.y); b[0] = lo_bf(w.z); b[1] = hi_bf(w.z); b[2] = lo_bf(w.w); b[3] = hi_bf(w.w); }

template <int M> DI int shxi(int v, int lane) {
    if constexpr (M < 32) return __builtin_amdgcn_ds_swizzle(v, (M << 10) | 0x1f);
    else return __builtin_amdgcn_ds_bpermute((lane ^ 32) << 2, v);
}
template <int M> DI float shx(float v, int lane) { return __int_as_float(shxi<M>(__float_as_int(v), lane)); }
DI float wave_sum(float v, int lane) { v += shx<1>(v, lane); v += shx<2>(v, lane); v += shx<4>(v, lane); v += shx<8>(v, lane); v += shx<16>(v, lane); v += shx<32>(v, lane); return v; }

namespace epi {
using pg8::Unit; using pg8::bf16_t;
DI float row_rstd(const float* SS, int row, int fq, int lane) {
    const f32x4 p = *(const f32x4*)(SS + (size_t)row * 16 + 4 * fq);
    float s = (p[0] + p[1]) + (p[2] + p[3]); s += shx<16>(s, lane); s += shx<32>(s, lane);
    return rsqrtf(s * (1.f / DM) + EPS);
}
struct EpiA {
    static constexpr bool PERM = true, AFTER_DRAIN = false;
    bf16* Z; float* ZS; const float* SS; float* out; int layer;
    DI void operator()(const f32x4 (&acc)[2][2][4][2], const Unit& u, int wr, int wc, int fr, int fq) const {
        asm volatile("" : "+v"(fr), "+v"(fq), "+s"(wr), "+s"(wc));
        const int pn = u.pn;
        float rs[2][4];
#pragma unroll
        for (int ai = 0; ai < 2; ++ai)
#pragma unroll
            for (int m = 0; m < 4; ++m) rs[ai][m] = row_rstd(SS, u.pm * 256 + ai * 128 + wr * 64 + m * 16 + fr, fq, fr + 16 * fq);
#pragma unroll
        for (int ai = 0; ai < 2; ++ai)
#pragma unroll
            for (int m = 0; m < 4; ++m) {
                const int row = u.pm * 256 + ai * 128 + wr * 64 + m * 16 + fr;
                const float rstd = rs[ai][m];
#pragma unroll
                for (int bj = 0; bj < 2; ++bj) {
                    const int col = pn * 256 + bj * 128 + wc * 32 + 8 * fq;
                    const f32x4 v0 = acc[ai][bj][m][0] * rstd, v1 = acc[ai][bj][m][1] * rstd;
                    *(v4u*)(Z + (size_t)row * LDZ + col) = pack8(v0, v1);
                    float* dst = nullptr;
                    if (pn == 2 || pn == 3) {
                        dst = (row < MP) ? out + O_KVP + ((size_t)layer * MP + row) * 512 + (col - 512) : out + O_KVS + ((size_t)layer * MS + (row - MP)) * 512 + (col - 512);
                    } else if (pn == 4) {
                        const int c2 = col - 1024;
                        if (row < MP) { const int t = row & (TP - 1), b = row >> 13; if (t >= TP - 512) dst = out + O_WINP + ((size_t)(layer * 2 + b) * 512 + (t - (TP - 512))) * 256 + c2; }
                        else { const int r2 = row - MP, s = r2 >> 2, j = r2 & 3; dst = out + O_WINS + ((size_t)(layer * 128 + s) * 512 + 508 + j) * 256 + c2; }
                    } else if (pn >= 5 && pn < 11) {
                        const int c2 = col - 1280;
                        if (row < MP) { const int t = row & (TP - 1), b = row >> 13; if (t >= TP - 3) dst = out + O_CVP + ((size_t)(layer * 2 + b) * 3 + (t - (TP - 3))) * 1536 + c2; }
                        else { const int r2 = row - MP, s = r2 >> 2, j = r2 & 3; if (j >= 1) dst = out + O_CVS + ((size_t)(layer * 128 + s) * 3 + (j - 1)) * 1536 + c2; }
                    } else if (pn == 33) {
                        if (bj == 0 && wc == 0) dst = ZS + (size_t)row * 32 + 8 * fq;
                    }
                    if (dst) { *(f32x4*)dst = v0; *(f32x4*)(dst + 4) = v1; }
                }
                asm volatile("" ::: "memory");
            }
    }
};
struct EpiC {
    static constexpr bool PERM = true, AFTER_DRAIN = false;
    const bf16* Z; bf16* G;
    DI void operator()(const f32x4 (&acc)[2][2][4][2], const Unit& u, int wr, int wc, int fr, int fq) const {
        asm volatile("" : "+v"(fr), "+v"(fq), "+s"(wr), "+s"(wc));
#pragma unroll
        for (int ai = 0; ai < 2; ++ai) {
            v4u gw[4][2];
#pragma unroll
            for (int m = 0; m < 4; ++m)
#pragma unroll
                for (int bj = 0; bj < 2; ++bj) gw[m][bj] = *(const v4u*)(Z + (size_t)(u.pm * 256 + ai * 128 + wr * 64 + m * 16 + fr) * LDZ + ZC_MG + u.pn * 256 + bj * 128 + wc * 32 + 8 * fq);
#pragma unroll
            for (int m = 0; m < 4; ++m) {
                const int row = u.pm * 256 + ai * 128 + wr * 64 + m * 16 + fr;
#pragma unroll
                for (int bj = 0; bj < 2; ++bj) {
                    const int col = u.pn * 256 + bj * 128 + wc * 32 + 8 * fq;
                    f32x4 g0, g1; unpack8(gw[m][bj], g0, g1);
                    f32x4 v0 = acc[ai][bj][m][0], v1 = acc[ai][bj][m][1];
#pragma unroll
                    for (int e = 0; e < 4; ++e) { v0[e] *= sigmoidf_(g0[e]); v1[e] *= sigmoidf_(g1[e]); }
                    *(v4u*)(G + (size_t)row * 3072 + col) = pack8(v0, v1);
                }
            }
            asm volatile("" ::: "memory");
        }
    }
};
struct EpiRes {
    static constexpr bool PERM = true, AFTER_DRAIN = false;
    float* XR; bf16* XG; const float* gvec; float* SS; float* T; int mode;
    DI void operator()(const f32x4 (&acc)[2][2][4][2], const Unit& u, int wr, int wc, int fr, int fq) const {
        asm volatile("" : "+v"(fr), "+v"(fq), "+s"(wr), "+s"(wc));
        if (mode == 3) return;
        if (mode == 1) {
#pragma unroll
            for (int ai = 0; ai < 2; ++ai)
#pragma unroll
                for (int m = 0; m < 4; ++m)
#pragma unroll
                    for (int bj = 0; bj < 2; ++bj) { const size_t o = (size_t)(u.pm * 256 + ai * 128 + wr * 64 + m * 16 + fr) * DM + u.pn * 256 + bj * 128 + wc * 32 + 8 * fq;
                        *(f32x4*)(T + o) = acc[ai][bj][m][0]; *(f32x4*)(T + o + 4) = acc[ai][bj][m][1]; }
            return;
        }
#pragma unroll
        for (int ai = 0; ai < 2; ++ai)
#pragma unroll
            for (int mp = 0; mp < 2; ++mp) {
                f32x4 xr[2][2][2], tt[2][2][2];
#pragma unroll
                for (int mm = 0; mm < 2; ++mm)
#pragma unroll
                    for (int bj = 0; bj < 2; ++bj) { const size_t o = (size_t)(u.pm * 256 + ai * 128 + wr * 64 + (2 * mp + mm) * 16 + fr) * DM + u.pn * 256 + bj * 128 + wc * 32 + 8 * fq;
                        xr[mm][bj][0] = *(const f32x4*)(XR + o); xr[mm][bj][1] = *(const f32x4*)(XR + o + 4);
                        if (mode == 2) { tt[mm][bj][0] = *(const f32x4*)(T + o); tt[mm][bj][1] = *(const f32x4*)(T + o + 4); } }
#pragma unroll
                for (int mm = 0; mm < 2; ++mm) {
                    const int m = 2 * mp + mm;
                    const int row = u.pm * 256 + ai * 128 + wr * 64 + m * 16 + fr;
                    float ssq = 0.f;
#pragma unroll
                    for (int bj = 0; bj < 2; ++bj) {
                        const int col = u.pn * 256 + bj * 128 + wc * 32 + 8 * fq;
                        const size_t o = (size_t)row * DM + col;
                        f32x4 a0 = acc[ai][bj][m][0], a1 = acc[ai][bj][m][1];
                        f32x4 x0 = xr[mm][bj][0], x1 = xr[mm][bj][1];
                        if (mode == 2) {
#pragma unroll
                            for (int e = 0; e < 4; ++e) { a0[e] = tt[mm][bj][0][e] * sigmoidf_(a0[e]); a1[e] = tt[mm][bj][1][e] * sigmoidf_(a1[e]); } }
                        x0 += a0; x1 += a1;
                        *(f32x4*)(XR + o) = x0; *(f32x4*)(XR + o + 4) = x1;
                        ssq += (x0[0] * x0[0] + x0[1] * x0[1]) + (x0[2] * x0[2] + x0[3] * x0[3]) + (x1[0] * x1[0] + x1[1] * x1[1]) + (x1[2] * x1[2] + x1[3] * x1[3]);
                        if (XG) { if (gvec) { const f32x4 g0 = *(const f32x4*)(gvec + col), g1 = *(const f32x4*)(gvec + col + 4); x0 *= g0; x1 *= g1; }
                            *(v4u*)(XG + o) = pack8(x0, x1); }
                    }
                    if (SS) { ssq += shx<16>(ssq, fr + 16 * fq); ssq += shx<32>(ssq, fr + 16 * fq); if (fq == 0) SS[(size_t)row * 16 + u.pn * 4 + wc] = ssq; }
                }
                asm volatile("" ::: "memory");
            }
    }
};
struct EpiUp {
    static constexpr bool PERM = true, AFTER_DRAIN = false;
    bf16* H; const float* SS;
    DI void operator()(const f32x4 (&acc)[2][2][4][2], const Unit& u, int wr, int wc, int fr, int fq) const {
        asm volatile("" : "+v"(fr), "+v"(fq), "+s"(wr), "+s"(wc));
        float rs[2][4];
#pragma unroll
        for (int ai = 0; ai < 2; ++ai)
#pragma unroll
            for (int m = 0; m < 4; ++m) rs[ai][m] = row_rstd(SS, u.pm * 256 + ai * 128 + wr * 64 + m * 16 + fr, fq, fr + 16 * fq);
#pragma unroll
        for (int ai = 0; ai < 2; ++ai)
#pragma unroll
            for (int m = 0; m < 4; ++m) {
                const int row = u.pm * 256 + ai * 128 + wr * 64 + m * 16 + fr;
                const float rstd = rs[ai][m];
#pragma unroll
                for (int bj = 0; bj < 2; ++bj) {
                    const int col = u.pn * 256 + bj * 128 + wc * 32 + 8 * fq;
                    f32x4 v0 = acc[ai][bj][m][0] * rstd, v1 = acc[ai][bj][m][1] * rstd;
#pragma unroll
                    for (int e = 0; e < 4; ++e) { const float a = fmaxf(v0[e], 0.f), b = fmaxf(v1[e], 0.f); v0[e] = a * a; v1[e] = b * b; }
                    *(v4u*)(H + (size_t)row * DFF + col) = pack8(v0, v1);
                }
                asm volatile("" ::: "memory");
            }
    }
};
}
constexpr size_t al256(size_t x) { return (x + 255) & ~(size_t)255; }
constexpr size_t WS_CTL = 0, CTL_ZERO_BYTES = 1u << 20;
constexpr size_t SZ_WIN = (size_t)LDZ * DM * 2, SZ_WBR = (size_t)3072 * 512 * 2, SZ_WO3 = (size_t)DM * 3072 * 2, SZ_WUP = (size_t)DFF * DM * 2, SZ_WDN = (size_t)DM * DFF * 2,
                 SZ_WPL = (size_t)DM * PLE * 2, SZ_WPG = (size_t)DM * DM * 2, SZ_W1T = (size_t)2 * 64 * 2048 * 2, SZ_W2T = (size_t)2 * 64 * 64 * 2;
constexpr size_t WS_WIN = CTL_ZERO_BYTES, WS_WBR = WS_WIN + 2 * SZ_WIN, WS_WO3 = WS_WBR + 2 * SZ_WBR, WS_WUP = WS_WO3 + 2 * SZ_WO3, WS_WDN = WS_WUP + 2 * SZ_WUP,
                 WS_WPL = WS_WDN + 2 * SZ_WDN, WS_WPG = WS_WPL + 2 * SZ_WPL, WS_W1T = WS_WPG + 2 * SZ_WPG, WS_W2T = WS_W1T + 2 * SZ_W1T, WS_ROT = al256(WS_W2T + 2 * SZ_W2T);
constexpr size_t WS_P16 = WS_ROT + (size_t)TP * 64 * 8;
constexpr size_t WS_XR = WS_P16 + (size_t)2 * MROWS * PLE * 2;
constexpr size_t WS_XGA = WS_XR + (size_t)MROWS * DM * 4, WS_XGB = WS_XGA + (size_t)MROWS * DM * 2, WS_XGC = WS_XGB + (size_t)MROWS * DM * 2;
constexpr size_t WS_SSA = WS_XGC + (size_t)MROWS * DM * 2, WS_SSB = WS_SSA + (size_t)MROWS * 64;
constexpr size_t WS_Z = WS_SSB + (size_t)MROWS * 64, WS_ZS = WS_Z + (size_t)MROWS * LDZ * 2;
constexpr size_t WS_MIX = WS_ZS + (size_t)MROWS * 128, WS_GATED = WS_MIX + (size_t)MROWS * 1536 * 2, WS_HMID = WS_GATED + (size_t)MROWS * 3072 * 2;
constexpr size_t WS_TPLE = WS_HMID + (size_t)MROWS * DFF * 2;
constexpr size_t WS_KC = WS_TPLE + (size_t)MROWS * DM * 4;
constexpr size_t WS_KCS = WS_KC + (size_t)2 * 2 * 512 * 2 * 64 * 2;
constexpr int GREC = 73984;
constexpr size_t WS_GREC = WS_KCS + (size_t)2 * 128 * 128 * 2 * 64 * 2;
constexpr size_t WS_OGDN = WS_GREC + (size_t)1024 * GREC;
constexpr size_t WS_RKV = WS_OGDN + (size_t)MROWS * 512 * 4;
constexpr size_t WS_RST = WS_RKV + (size_t)512 * 16384 * 4;
constexpr size_t WS_QR = WS_RST + (size_t)512 * 16384 * 2, WS_KR = WS_QR + (size_t)MP * 512 * 2;
constexpr size_t WS_END = WS_KR + (size_t)MP * 512 * 2;
static_assert(WS_W1T % 256 == 0 && WS_Z % 256 == 0 && WS_GREC % 256 == 0 && WS_RKV % 256 == 0 && WS_KC % 256 == 0 && WS_XR % 256 == 0, "ws alignment");

constexpr int CW_TMO = 0, CW_BAR = 4096, CW_QUEUE = 8192;
constexpr int NWAVES = 8, NTHREADS = 512;
constexpr int RING_BYTES = 147456, LDSCTL_OFF = RING_BYTES, MISC_OFF = LDSCTL_OFF + 320, LDS_BYTES = RING_BYTES + 1024;

#define RLX_AGENT __ATOMIC_RELAXED, __HIP_MEMORY_SCOPE_AGENT
#define LDS_WAIT() asm volatile("s_waitcnt lgkmcnt(0)" ::: "memory")
#define VM_WAIT() asm volatile("s_waitcnt vmcnt(0)" ::: "memory")
#define XB_TMO      128
#define XB_XCNT(j)  (256  + 64 * (j))
#define XB_XSUB(j)  (1280 + 64 * (j))
#define XB_XGEN(j)  (2304 + 64 * (j))
#define XB_TOP      3328
#define XB_TOPGEN   3392
#define XCD_BAR_WORDS 3456
#define XB_SPIN_CAP (1u << 18)

__device__ __forceinline__ unsigned xb_ld(unsigned* p)              { return __hip_atomic_load(p, __ATOMIC_RELAXED, __HIP_MEMORY_SCOPE_AGENT); }
__device__ __forceinline__ unsigned xb_add(unsigned* p, unsigned v) { return __hip_atomic_fetch_add(p, v, __ATOMIC_RELAXED, __HIP_MEMORY_SCOPE_AGENT); }
__device__ __forceinline__ unsigned xb_xcc_id() { return (unsigned)__builtin_amdgcn_s_getreg((3 << 11) | 20) & 0xFu; }
#define XB_SPIN(cond, bar) do { unsigned _sp = 0; while (cond) { __builtin_amdgcn_s_sleep(1); \
    if ((++_sp & 255u) == 0u) { if (xb_ld(&(bar)[XB_TMO])) break; if (_sp > XB_SPIN_CAP) { atomicAdd(&(bar)[XB_TMO], 1u); break; } } } } while (0)

struct XcdBarrier {
    unsigned* bar; unsigned x;
    volatile LAS unsigned* st;
};

__device__ __forceinline__ XcdBarrier xcd_barrier_post(unsigned* bar, volatile LAS unsigned* st, bool t0) {
    XcdBarrier b; b.bar = bar; b.x = xb_xcc_id(); b.st = st;
    if (t0) (void)xb_add(&bar[XB_XCNT(b.x)], 1u);
    return b;
}
__device__ __forceinline__ void xcd_barrier_complete(unsigned* bar, unsigned x, unsigned& nloc, unsigned& nx) {
    const unsigned G = gridDim.x * gridDim.y * gridDim.z;
    unsigned sum, cnt, mine, sp = 0u;
    for (;;) {
        sum = 0u; cnt = 0u; mine = 0u;
#pragma unroll
        for (unsigned j = 0; j < 16; ++j) { const unsigned c = xb_ld(&bar[XB_XCNT(j)]); sum += c; cnt += (c > 0u) ? 1u : 0u; mine = (j == x) ? c : mine; }
        if (sum == G) break;
        __builtin_amdgcn_s_sleep(1);
        if ((++sp & 255u) == 0u) { if (xb_ld(&bar[XB_TMO])) break; if (sp > XB_SPIN_CAP) { atomicAdd(&bar[XB_TMO], 1u); break; } }
    }
    nloc = mine > 0u ? mine : 1u; nx = cnt > 0u ? cnt : 1u;
}

__device__ __forceinline__ void xcd_barrier(const XcdBarrier& b, bool t0) {
    asm volatile("s_waitcnt vmcnt(0)" ::: "memory");
    __syncthreads();
    if (t0) {
        unsigned* bar = b.bar;
        __builtin_amdgcn_s_waitcnt(0);
        unsigned nloc = b.st[0], nx = b.st[1];
        if (nloc == 0u) { xcd_barrier_complete(bar, b.x, nloc, nx); b.st[0] = nloc; b.st[1] = nx; }
        const unsigned old = xb_add(&bar[XB_XSUB(b.x)], 1u);
        const unsigned gen = old / nloc;
        if (old + 1u == (gen + 1u) * nloc) {
            __builtin_amdgcn_fence(__ATOMIC_RELEASE, "agent");
            asm volatile("s_waitcnt vmcnt(0)" ::: "memory");
            const unsigned og = xb_add(&bar[XB_TOP], 1u);
            const unsigned tg = og / nx;
            if (og + 1u == (tg + 1u) * nx) xb_add(&bar[XB_TOPGEN], 1u);
            else XB_SPIN(xb_ld(&bar[XB_TOPGEN]) == tg, bar);
            __builtin_amdgcn_fence(__ATOMIC_ACQUIRE, "agent");
            xb_add(&bar[XB_XGEN(b.x)], 1u);
            asm volatile("s_waitcnt vmcnt(0)" ::: "memory");
        } else {
            XB_SPIN(xb_ld(&bar[XB_XGEN(b.x)]) == gen, bar);
            __builtin_amdgcn_fence(__ATOMIC_ACQUIRE, "agent");
            asm volatile("s_waitcnt vmcnt(0)" ::: "memory");
        }
    }
    __syncthreads();
}
typedef const void* const __attribute__((address_space(4)))* kargp_t;
DI const float* KIN(int i) { const GAS float* p = (const GAS float*)((kargp_t)__builtin_amdgcn_kernarg_segment_ptr())[i]; asm volatile("" : "+s"(p)); return (const float*)p; }
DI float* KOUT() { GAS float* p = (GAS float*)((kargp_t)__builtin_amdgcn_kernarg_segment_ptr())[27]; asm volatile("" : "+s"(p)); return (float*)p; }
DI unsigned char* KWS() { GAS unsigned char* p = (GAS unsigned char*)((kargp_t)__builtin_amdgcn_kernarg_segment_ptr())[28]; asm volatile("" : "+s"(p)); return (unsigned char*)p; }
struct Frame {
    LAS unsigned char* lds;
    gu32* ctl;
    int tid, lane, wave, G, bid;
};
DI bf16x8 ld_frag_g(const bf16* p) { return __builtin_bit_cast(bf16x8, *(const v4u*)p); }
DI bf16x8 ld_frag_l(const LAS unsigned char* p) { return *(const LAS bf16x8*)p; }
DI f32x4 mfma16(bf16x8 a, bf16x8 b, f32x4 c) { return __builtin_amdgcn_mfma_f32_16x16x32_bf16(a, b, c, 0, 0, 0); }
DI bf16x8 pack_frag(const f32x4 a, const f32x4 b) { return __builtin_bit_cast(bf16x8, pack8(a, b)); }
DI int lane_id() { int l; asm volatile("v_mbcnt_lo_u32_b32 %0, -1, 0\n\tv_mbcnt_hi_u32_b32 %0, -1, %0" : "=v"(l)); return l; }
DI Frame fresh(const Frame& F0) {
    Frame F = F0; int w = F0.wave, g = F0.G, b = F0.bid; asm volatile("" : "+s"(w), "+s"(g), "+s"(b));
    int l = lane_id(); asm volatile("" : "+v"(l));
    unsigned lb = (unsigned)(uintptr_t)F0.lds; asm volatile("" : "+s"(lb)); F.lds = (LAS unsigned char*)(uintptr_t)lb;
    F.wave = w; F.lane = l; F.tid = w * 64 + l; F.G = g; F.bid = b; return F;
}
#define GRID_BAR() do { XcdBarrier b_; b_.bar = (unsigned*)((gu32*)(KWS() + WS_CTL) + CW_BAR); b_.x = xb_xcc_id(); b_.st = (volatile LAS unsigned*)(F.lds + MISC_OFF) + 8; \
    const Frame Fb_ = fresh(F); xcd_barrier(b_, Fb_.tid == 0); } while (0)
DI int win_colmap(int j) {
    if (j < 1280) return j; if (j < 2816) return j + 24; if (j < 8448) return j + 32; if (j < 8472) return j - 8448 + 1280; if (j < 8480) return j - 8472 + 2840; return -1;
}
DI void tr_item(const float* W, int ldw, int k0, int srccol, bf16* WT, size_t dst_row0, int ldt, int kdst0, int nrep, int krep, LAS float* scr, int lane) {
#pragma unroll 8
    for (int i = 0; i < 32; ++i) { const int kk = 2 * i + (lane >> 5); const float v_ = W[(size_t)(k0 + kk) * ldw + (srccol >= 0 ? srccol : 0)]; scr[kk * 33 + (lane & 31)] = (srccol >= 0) ? v_ : 0.f; }
    LDS_WAIT(); asm volatile("" ::: "memory");
    const int c = lane & 7;
#pragma unroll
    for (int j = 0; j < 4; ++j) { const int n = (lane >> 3) + 8 * j; const LAS float* s = scr + (8 * c) * 33 + n;
        v4u o; o.x = pk2(s[0 * 33], s[1 * 33]); o.y = pk2(s[2 * 33], s[3 * 33]); o.z = pk2(s[4 * 33], s[5 * 33]); o.w = pk2(s[6 * 33], s[7 * 33]);
        for (int r = 0; r < nrep; ++r) *(v4u*)(WT + (dst_row0 + n) * (size_t)ldt + kdst0 + r * krep + 8 * c) = o; }
    LDS_WAIT(); asm volatile("" ::: "memory");
}
DI void p0_prologue(Frame& F) {
    LAS float* scr = (LAS float*)(F.lds + F.wave * 16384);
    const int gw = F.bid * NWAVES + F.wave, NGW = F.G * NWAVES, lane = F.lane;
    unsigned char* ws = KWS();
    constexpr int I_A = 16 * 272, I_B = 3 * 8 * 32, I_C = 16 * 32, I_D = 16 * 128, I_E = 64 * 32, I_F = 4 * 32, I_G = 16 * 32, I_H = 2 * 32 * 2, I_I = 2 * 2;
    constexpr int I_L = I_A + I_B + I_C + I_D + I_E + I_F + I_G + I_H + I_I;
    for (int it = gw; it < 2 * I_L; it += NGW) {
        const int l = it / I_L; int r = it % I_L;
        if (r < I_A) { const int kb = r / 272, nb = r % 272; tr_item(KIN(11) + (size_t)l * DM * 8480, 8480, 64 * kb, win_colmap(32 * nb + (lane & 31)), (bf16*)(ws + WS_WIN + l * SZ_WIN), 32 * nb, DM, 64 * kb, 1, 0, scr, lane); continue; } r -= I_A;
        if (r < I_B) { const int b = r / 256, kb = (r % 256) / 32, nb = r % 32; tr_item(KIN(19) + (size_t)(l * 3 + b) * 512 * DM, DM, 64 * kb, 32 * nb + (lane & 31), (bf16*)(ws + WS_WBR + l * SZ_WBR), b * 1024 + 32 * nb, 512, 64 * kb, 1, 0, scr, lane); continue; } r -= I_B;
        if (r < I_C) { const int kb = r / 32, nb = r % 32; tr_item(KIN(20) + (size_t)l * DM * DM, DM, 64 * kb, 32 * nb + (lane & 31), (bf16*)(ws + WS_WO3 + l * SZ_WO3), 32 * nb, 3072, 64 * kb, 3, 1024, scr, lane); continue; } r -= I_C;
        if (r < I_D) { const int kb = r / 128, nb = r % 128; tr_item(KIN(22) + (size_t)l * DM * DFF, DFF, 64 * kb, 32 * nb + (lane & 31), (bf16*)(ws + WS_WUP + l * SZ_WUP), 32 * nb, DM, 64 * kb, 1, 0, scr, lane); continue; } r -= I_D;
        if (r < I_E) { const int kb = r / 32, nb = r % 32; tr_item(KIN(23) + (size_t)l * DFF * DM, DM, 64 * kb, 32 * nb + (lane & 31), (bf16*)(ws + WS_WDN + l * SZ_WDN), 32 * nb, DFF, 64 * kb, 1, 0, scr, lane); continue; } r -= I_E;
        if (r < I_F) { const int kb = r / 32, nb = r % 32; tr_item(KIN(24) + (size_t)l * PLE * DM, DM, 64 * kb, 32 * nb + (lane & 31), (bf16*)(ws + WS_WPL + l * SZ_WPL), 32 * nb, PLE, 64 * kb, 1, 0, scr, lane); continue; } r -= I_F;
        if (r < I_G) { const int kb = r / 32, nb = r % 32; tr_item(KIN(25) + (size_t)l * DM * DM, DM, 64 * kb, 32 * nb + (lane & 31), (bf16*)(ws + WS_WPG + l * SZ_WPG), 32 * nb, DM, 64 * kb, 1, 0, scr, lane); continue; } r -= I_G;
        if (r < I_H) { const int kv = r / 64, kb = (r % 64) / 2, nb = r % 2; tr_item(KIN(13) + (size_t)(l * 2 + kv) * 2048 * 64, 64, 64 * kb, 32 * nb + (lane & 31), (bf16*)(ws + WS_W1T + l * SZ_W1T) + (size_t)kv * 64 * 2048, 32 * nb, 2048, 64 * kb, 1, 0, scr, lane); continue; } r -= I_H;
        { const int kv = r / 2, nb = r % 2; tr_item(KIN(14) + (size_t)(l * 2 + kv) * 64 * 64, 64, 0, 32 * nb + (lane & 31), (bf16*)(ws + WS_W2T + l * SZ_W2T) + (size_t)kv * 64 * 64, 32 * nb, 64, 0, 1, 0, scr, lane); }
    }
    float* XR = (float*)(ws + WS_XR); bf16* XGA = (bf16*)(ws + WS_XGA); float* SSA = (float*)(ws + WS_SSA); bf16* P16 = (bf16*)(ws + WS_P16);
    const float* g0 = KIN(10);
    for (int row = gw; row < MROWS; row += NGW) {
        const float* xs = (row < MP) ? KIN(0) + (size_t)row * DM : KIN(1) + (size_t)(row - MP) * DM;
        float ss = 0.f;
#pragma unroll
        for (int j = 0; j < 2; ++j) {
            const int c = j * 512 + lane * 8;
            f32x4 a = *(const f32x4*)(xs + c), b = *(const f32x4*)(xs + c + 4);
            *(f32x4*)(XR + (size_t)row * DM + c) = a; *(f32x4*)(XR + (size_t)row * DM + c + 4) = b;
            ss += (a[0] * a[0] + a[1] * a[1]) + (a[2] * a[2] + a[3] * a[3]) + (b[0] * b[0] + b[1] * b[1]) + (b[2] * b[2] + b[3] * b[3]);
            const f32x4 ga = *(const f32x4*)(g0 + c), gb = *(const f32x4*)(g0 + c + 4);
            *(v4u*)(XGA + (size_t)row * DM + c) = pack8(a * ga, b * gb);
        }
        ss = wave_sum(ss, lane);
        if (lane < 16) SSA[(size_t)row * 16 + lane] = (lane == 0) ? ss : 0.f;
#pragma unroll
        for (int l = 0; l < 2; ++l) {
            const float* ps = (row < MP) ? KIN(8) + ((size_t)l * MP + row) * PLE : KIN(9) + ((size_t)l * MS + (row - MP)) * PLE;
            const f32x4 a = *(const f32x4*)(ps + lane * 4);
            v2u o; o.x = pk2(a[0], a[1]); o.y = pk2(a[2], a[3]);
            *(v2u*)(P16 + ((size_t)l * MROWS + row) * PLE + lane * 4) = o;
        }
    }
    const int gt = F.bid * NTHREADS + F.tid, NGT = F.G * NTHREADS;
    f32x2* ROT = (f32x2*)(ws + WS_ROT);
    for (int e = gt; e < TP * 64; e += NGT) {
        const int pos = e >> 6, i = e & 63;
        const float x = (float)i * (1.0f / 63.0f);
        const float inv = exp2f(-x * 13.287712379549449f);
        const float ang = (float)pos * inv;
        const double rev = (double)ang * 0.15915494309189535;
        const float fr = (float)(rev - floor(rev));
        ROT[e] = (f32x2){__builtin_amdgcn_cosf(fr), __builtin_amdgcn_sinf(fr)};
    }
    {
        const float* src = KIN(3); float* dst = KOUT() + O_WINS;
        constexpr int NE = 2 * 128 * 508 * 64;
        for (int e0 = gt; e0 < NE; e0 += 8 * NGT) {
            f32x4 v[8];
#pragma unroll
            for (int u = 0; u < 8; ++u) { const int e = e0 + u * NGT; const int ec = e < NE ? e : NE - 1; const int ls = ec / (508 * 64), r = ec % (508 * 64);
                v[u] = *(const f32x4*)(src + (size_t)ls * 512 * 256 + 4 * 256 + (size_t)r * 4); }
#pragma unroll
            for (int u = 0; u < 8; ++u) { const int e = e0 + u * NGT; if (e < NE) { const int ls = e / (508 * 64), r = e % (508 * 64); *(f32x4*)(dst + (size_t)ls * 512 * 256 + (size_t)r * 4) = v[u]; } }
        }
    }
}
DI float gelu_tanh(float x) { const float u = 0.7978845608028654f * (x + 0.044715f * x * x * x); const float e = __expf(2.f * u); return 0.5f * x * (1.f + (1.f - 2.f / (e + 1.f))); }
DI bf16x8 mk_frag(v2u a, v2u b) { v4u w; w.x = a.x; w.y = a.y; w.z = b.x; w.w = b.y; return __builtin_bit_cast(bf16x8, w); }

template <bool sample> DI void compress_job_t(Frame& F, int layer, int job) {
    int lane = F.lane, wave = F.wave; asm volatile("" : "+v"(lane), "+s"(wave));
    const int tid = wave * 64 + lane, quad = lane >> 4, rl = lane & 15;
    unsigned char* ws = KWS();
    int kv, bs, g0, nbase;
    if (sample) { kv = job >> 7; bs = job & 127; g0 = 0; nbase = 0; }
    else { const int j2 = job - 256; kv = j2 >> 3; bs = (j2 >> 2) & 1; g0 = (j2 >> 1) & 1; nbase = (j2 & 1) * 256; }
    const bf16* W1T = (const bf16*)(ws + WS_W1T + layer * SZ_W1T) + (size_t)kv * 64 * 2048;
    const bf16* W2T = (const bf16*)(ws + WS_W2T + layer * SZ_W2T) + (size_t)kv * 64 * 64;
    const float* pe = KIN(12) + (size_t)(layer * 2 + kv) * 32 * 64;
    const bf16* Z = (const bf16*)(ws + WS_Z);
    const int* pt = (const int*)KIN(7);
    const float* cache = KIN(2);
    LAS unsigned char* LW = F.lds;
    int gg[2], nn[2];
    size_t pb0[2], pb1[2];
#pragma unroll
    for (int tl = 0; tl < 2; ++tl) { const int T = 2 * wave + tl; if (sample) { gg[tl] = T >> 3; nn[tl] = 16 * (T & 7) + rl; } else { gg[tl] = g0; nn[tl] = nbase + 16 * T + rl; }
        pb0[tl] = 0; pb1[tl] = 0;
        if (sample) { const int p0 = (16 * nn[tl]) >> 7; const int p1 = p0 + 1 > 15 ? 15 : p0 + 1;
            pb0[tl] = (size_t)(layer * 2560 + pt[bs * 16 + p0]) * 128 * 512; pb1[tl] = (size_t)(layer * 2560 + pt[bs * 16 + p1]) * 128 * 512; } }
    f32x4 h[2][4];
#pragma unroll
    for (int tl = 0; tl < 2; ++tl)
#pragma unroll
        for (int i = 0; i < 4; ++i) h[tl][i] = (f32x4){0.f, 0.f, 0.f, 0.f};
#pragma unroll 1
    for (int c = 0; c < 4; ++c) {
        __syncthreads();
#pragma unroll
        for (int k = 0; k < 8; ++k) { const int pc = tid + 512 * k, r = pc >> 6, c16 = pc & 63;
            *(LAS v4u*)(LW + r * 1040 + c16 * 16) = *(const v4u*)(W1T + (size_t)r * 2048 + c * 512 + c16 * 8); }
        __syncthreads();
#pragma unroll 8
        for (int kk = 0; kk < 16; ++kk) {
            const int j = 8 * c + (kk >> 1), dim0 = (kk & 1) * 32 + quad * 8;
            const f32x4 pe0 = *(const f32x4*)(pe + j * 64 + dim0), pe1 = *(const f32x4*)(pe + j * 64 + dim0 + 4);
            bf16x8 xb[2];
#pragma unroll
            for (int tl = 0; tl < 2; ++tl) {
                f32x4 x0, x1;
                if (!sample) { const size_t row = (size_t)bs * TP + 16 * nn[tl] + j; unpack8(*(const v4u*)(Z + row * LDZ + ZC_KC + kv * 128 + gg[tl] * 64 + dim0), x0, x1); }
                else { int pos = 16 * nn[tl] + j; pos = pos > 2047 ? 2047 : pos;
                    const float* p = cache + (((pos >> 7) == ((16 * nn[tl]) >> 7)) ? pb0[tl] : pb1[tl]) + (size_t)(pos & 127) * 512 + kv * 128 + gg[tl] * 64 + dim0; x0 = *(const f32x4*)p; x1 = *(const f32x4*)(p + 4); }
                xb[tl] = pack_frag(x0 + pe0, x1 + pe1);
            }
#pragma unroll
            for (int ht = 0; ht < 4; ++ht) {
                const bf16x8 a = ld_frag_l(LW + (16 * ht + rl) * 1040 + (kk * 32 + quad * 8) * 2);
                h[0][ht] = mfma16(a, xb[0], h[0][ht]); h[1][ht] = mfma16(a, xb[1], h[1][ht]);
            }
        }
    }
#pragma unroll
    for (int tl = 0; tl < 2; ++tl) {
#pragma unroll
        for (int ht = 0; ht < 4; ++ht)
#pragma unroll
            for (int i = 0; i < 4; ++i) h[tl][ht][i] = gelu_tanh(h[tl][ht][i]);
        bf16x8 gb[2]; gb[0] = pack_frag(h[tl][0], h[tl][1]); gb[1] = pack_frag(h[tl][2], h[tl][3]);
        const int n = nn[tl], g = gg[tl];
        bf16* dst = sample ? (bf16*)(ws + WS_KCS) + ((((size_t)kv * 128 + bs) * 128 + n) * 2 + g) * 64 : (bf16*)(ws + WS_KC) + ((((size_t)kv * 2 + bs) * 512 + n) * 2 + g) * 64;
        const bool zero = sample && n == 127;
#pragma unroll
        for (int ot = 0; ot < 4; ++ot) {
            f32x4 o = (f32x4){0.f, 0.f, 0.f, 0.f};
#pragma unroll
            for (int s = 0; s < 2; ++s) {
                const bf16* wp = W2T + (16 * ot + rl) * 64 + 32 * s + 4 * quad;
                o = mfma16(mk_frag(*(const v2u*)wp, *(const v2u*)(wp + 16)), gb[s], o);
            }
            v2u w; w.x = zero ? 0u : pk2(o[0], o[1]); w.y = zero ? 0u : pk2(o[2], o[3]);
            *(v2u*)(dst + 16 * ot + 4 * quad) = w;
        }
    }
    __syncthreads();
}

DI v2u pack4(const f32x4 v) { v2u w; w.x = pk2(v[0], v[1]); w.y = pk2(v[2], v[3]); return w; }
DI void compress_sample_job(Frame& F, int layer, int job) {
    int lane = F.lane, wave = F.wave; asm volatile("" : "+v"(lane), "+s"(wave));
    const int tid = wave * 64 + lane, quad = lane >> 4, rl = lane & 15;
    unsigned char* ws = KWS();
    const int kv = job >> 7, bs = job & 127;
    const bf16* W1T = (const bf16*)(ws + WS_W1T + layer * SZ_W1T) + (size_t)kv * 64 * 2048;
    const bf16* W2T = (const bf16*)(ws + WS_W2T + layer * SZ_W2T) + (size_t)kv * 64 * 64;
    const float* pe = KIN(12) + (size_t)(layer * 2 + kv) * 32 * 64;
    const int* pt = (const int*)KIN(7);
    const float* cache = KIN(2);
    LAS unsigned char* XS = F.lds;
    LAS unsigned char* WS1 = F.lds + 69632;
    size_t toff[8];
#pragma unroll
    for (int k = 0; k < 8; ++k) { const int q = tid + 512 * k, m = q >> 5; const int pos = 16 * m; const int phys = pt[bs * 16 + (pos >> 7)];
        toff[k] = ((size_t)(layer * 2560 + phys) * 128 + (pos & 127)) * 512 + kv * 128 + 4 * (q & 31); }
    const int wr_ = tid >> 3, wc_ = tid & 7;
    int gg[2], nn[2];
#pragma unroll
    for (int tl = 0; tl < 2; ++tl) { const int T = 2 * wave + tl; gg[tl] = T >> 3; nn[tl] = 16 * (T & 7) + rl; }
    f32x4 h[2][4];
#pragma unroll
    for (int tl = 0; tl < 2; ++tl)
#pragma unroll
        for (int i = 0; i < 4; ++i) h[tl][i] = (f32x4){0.f, 0.f, 0.f, 0.f};
    f32x4 xr[8]; v4u wr2[2];
#define CS_ISSUE(r_) do { _Pragma("unroll") for (int k = 0; k < 8; ++k) xr[k] = *(const f32x4*)(cache + toff[k] + (size_t)(r_) * 512); \
        _Pragma("unroll") for (int u = 0; u < 2; ++u) wr2[u] = *(const v4u*)(W1T + (size_t)wr_ * 2048 + ((r_) + 16 * u) * 64 + wc_ * 8); } while (0)
    CS_ISSUE(0);
#pragma unroll 1
    for (int r = 0; r < 16; ++r) {
        __syncthreads();
#pragma unroll
        for (int k = 0; k < 8; ++k) { const int q = tid + 512 * k, m = q >> 5, c = q & 31, d = 4 * (c & 15);
#pragma unroll
            for (int u = 0; u < 2; ++u) { const f32x4 v = xr[k] + *(const f32x4*)(pe + (r + 16 * u) * 64 + d);
                *(LAS v2u*)(XS + u * 34816 + m * 272 + c * 8) = pack4(v); } }
#pragma unroll
        for (int u = 0; u < 2; ++u) *(LAS v4u*)(WS1 + u * 9216 + wr_ * 144 + wc_ * 16) = wr2[u];
        __syncthreads();
        { const int rn = r + 1 < 16 ? r + 1 : 15; CS_ISSUE(rn); }
#pragma unroll
        for (int u = 0; u < 2; ++u)
#pragma unroll
            for (int ks = 0; ks < 2; ++ks) {
                bf16x8 xb[2];
#pragma unroll
                for (int tl = 0; tl < 2; ++tl) { int m = nn[tl] + u; m = m > 127 ? 127 : m; xb[tl] = ld_frag_l(XS + u * 34816 + m * 272 + gg[tl] * 128 + ks * 64 + quad * 16); }
#pragma unroll
                for (int ht = 0; ht < 4; ++ht) { const bf16x8 a = ld_frag_l(WS1 + u * 9216 + (16 * ht + rl) * 144 + ks * 64 + quad * 16);
                    h[0][ht] = mfma16(a, xb[0], h[0][ht]); h[1][ht] = mfma16(a, xb[1], h[1][ht]); }
            }
    }
#undef CS_ISSUE
#pragma unroll
    for (int tl = 0; tl < 2; ++tl) {
#pragma unroll
        for (int ht = 0; ht < 4; ++ht)
#pragma unroll
            for (int i = 0; i < 4; ++i) h[tl][ht][i] = gelu_tanh(h[tl][ht][i]);
        bf16x8 gb[2]; gb[0] = pack_frag(h[tl][0], h[tl][1]); gb[1] = pack_frag(h[tl][2], h[tl][3]);
        const int n = nn[tl], g = gg[tl];
        bf16* dst = (bf16*)(ws + WS_KCS) + ((((size_t)kv * 128 + bs) * 128 + n) * 2 + g) * 64;
        const bool zero = n == 127;
#pragma unroll
        for (int ot = 0; ot < 4; ++ot) {
            f32x4 o = (f32x4){0.f, 0.f, 0.f, 0.f};
#pragma unroll
            for (int s = 0; s < 2; ++s) {
                const bf16* wp = W2T + (16 * ot + rl) * 64 + 32 * s + 4 * quad;
                o = mfma16(mk_frag(*(const v2u*)wp, *(const v2u*)(wp + 16)), gb[s], o);
            }
            v2u w; w.x = zero ? 0u : pk2(o[0], o[1]); w.y = zero ? 0u : pk2(o[2], o[3]);
            *(v2u*)(dst + 16 * ot + 4 * quad) = w;
        }
    }
    __syncthreads();
}
DI void compress_job(Frame& F, int layer, int job) { if (job < 256) compress_sample_job(F, layer, job); else compress_job_t<false>(F, layer, job); }
#ifndef PH_GPT
#define PH_GPT (-1)
#endif
#if PH_GPT >= 0
#define GP_T(k) do { if (tid == 0) { volatile LAS unsigned long long* gp_ = (volatile LAS unsigned long long*)(F.lds + LDSCTL_OFF + 448); const unsigned long long now_ = __builtin_amdgcn_s_memrealtime(); \
    if ((k) == PH_GPT) gp_[0] += now_ - gp_[1]; gp_[1] = now_; } } while (0)
#else
#define GP_T(k) do { } while (0)
#endif
DI int kperm(int idx) { const int s = idx >> 5, r = idx & 31; return 32 * s + 8 * ((r >> 2) & 3) + 4 * (r >> 4) + (r & 3); }
DI float softplusf_(float x) { return x > 20.f ? x : __logf(1.f + __expf(x)); }
DI float ret_lg(int h) { return h == 0 ? -0.031748697f : h == 1 ? -0.015748357f : h == 2 ? -0.007843178f : -0.0039138994f; }

DI void gdn_prep_unit(Frame& F, int layer, int unit) {
    int lane = F.lane, wave = F.wave; asm volatile("" : "+v"(lane), "+s"(wave));
    const int tid = wave * 64 + lane;
    const int b = unit >> 9, h = (unit >> 7) & 3, c = unit & 127;
    const int row0 = b * TP + 64 * c, t0 = 64 * c;
    GP_T(0);
    unsigned char* ws = KWS();
    const bf16* Z = (const bf16*)(ws + WS_Z);
    const float* ZS = (const float*)(ws + WS_ZS);
    LAS float* Lq = (LAS float*)(F.lds); LAS float* Lk = (LAS float*)(F.lds + 33792); LAS float* Lv = (LAS float*)(F.lds + 67584);
    LAS float* LA = (LAS float*)(F.lds + 101376); LAS float* LQK = (LAS float*)(F.lds + 117760);
    LAS float* Lg = (LAS float*)(F.lds + 134144); LAS float* Lb = Lg + 64; LAS float* Le = Lg + 128;
    const float* cw = KIN(15) + (size_t)layer * 4 * 1536;
    {
        v4u xs[6][4];
#pragma unroll
        for (int it0 = 0; it0 < 6; ++it0) {
            const int it = tid + it0 * NTHREADS, i = it / 48, ch = it % 48, col = (ch >> 4) * 512 + h * 128 + (ch & 15) * 8;
#pragma unroll
            for (int j = 0; j < 4; ++j) { const bool ok = (t0 + i - 3 + j) >= 0; xs[it0][j] = *(const v4u*)(Z + (size_t)(ok ? row0 + i - 3 + j : row0) * LDZ + ZC_GQKV + col); }
        }
        asm volatile("" ::: "memory");
#pragma unroll
        for (int it0 = 0; it0 < 6; ++it0) {
            const int it = tid + it0 * NTHREADS, i = it / 48, ch = it % 48, part = ch >> 4, cc = ch & 15;
            const int col = part * 512 + h * 128 + cc * 8;
            f32x4 y0 = (f32x4){0.f, 0.f, 0.f, 0.f}, y1 = y0;
#pragma unroll
            for (int j = 0; j < 4; ++j) {
                const float zf = ((t0 + i - 3 + j) >= 0) ? 1.f : 0.f;
                f32x4 x0, x1; unpack8(xs[it0][j], x0, x1);
                y0 += x0 * (*(const f32x4*)(cw + j * 1536 + col) * zf); y1 += x1 * (*(const f32x4*)(cw + j * 1536 + col + 4) * zf);
            }
#pragma unroll
            for (int e = 0; e < 4; ++e) { y0[e] = siluf_(y0[e]); y1[e] = siluf_(y1[e]); }
            LAS float* dst = (part == 0 ? Lq : part == 1 ? Lk : Lv) + i * 132 + cc * 8;
            *(LAS f32x4*)dst = y0; *(LAS f32x4*)(dst + 4) = y1;
        }
    }
    __syncthreads();
    GP_T(1);
    {
        float va[16], vb[16], ps[16];
#pragma unroll
        for (int q = 0; q < 16; ++q) { LAS float* vp = ((q < 8) ? Lq : Lk) + (wave * 8 + (q & 7)) * 132 + lane * 2; va[q] = vp[0]; vb[q] = vp[1]; ps[q] = va[q] * va[q] + vb[q] * vb[q]; }
#pragma unroll
        for (int q = 0; q < 16; ++q) ps[q] += shx<1>(ps[q], lane);
#pragma unroll
        for (int q = 0; q < 16; ++q) ps[q] += shx<2>(ps[q], lane);
#pragma unroll
        for (int q = 0; q < 16; ++q) ps[q] += shx<4>(ps[q], lane);
#pragma unroll
        for (int q = 0; q < 16; ++q) ps[q] += shx<8>(ps[q], lane);
#pragma unroll
        for (int q = 0; q < 16; ++q) ps[q] += shx<16>(ps[q], lane);
#pragma unroll
        for (int q = 0; q < 16; ++q) ps[q] += shx<32>(ps[q], lane);
#pragma unroll
        for (int q = 0; q < 16; ++q) { LAS float* vp = ((q < 8) ? Lq : Lk) + (wave * 8 + (q & 7)) * 132 + lane * 2; const float sc = rsqrtf(ps[q] + EPS) * ((q < 8) ? 0.08838834764831845f : 1.f); vp[0] = va[q] * sc; vp[1] = vb[q] * sc; }
    }
    if (wave == 0) {
        const float ga = ZS[(size_t)(row0 + lane) * 32 + 24 + h], gbv = ZS[(size_t)(row0 + lane) * 32 + 28 + h];
        float g = -__expf(KIN(16)[layer * 4 + h]) * softplusf_(ga + KIN(17)[layer * 4 + h]);
#pragma unroll
        for (int o = 1; o < 64; o <<= 1) { const float t = __int_as_float(__builtin_amdgcn_ds_bpermute(((lane - o) & 63) << 2, __float_as_int(g))); if (lane >= o) g += t; }
        Lg[lane] = g; Lb[lane] = sigmoidf_(gbv); Le[lane] = __expf(g);
    }
    __syncthreads();
    GP_T(2);
    {
        const int it = wave >> 1, quad = lane >> 4, rl = lane & 15;
        f32x4 ckk[2], cqk[2];
#pragma unroll
        for (int jj = 0; jj < 2; ++jj) { ckk[jj] = (f32x4){0.f, 0.f, 0.f, 0.f}; cqk[jj] = ckk[jj]; }
#pragma unroll
        for (int s = 0; s < 4; ++s) {
            const LAS float* kp = Lk + (16 * it + rl) * 132 + 32 * s + 8 * quad; const LAS float* qp = Lq + (16 * it + rl) * 132 + 32 * s + 8 * quad;
            const f32x4 ka0 = *(const LAS f32x4*)kp, ka1 = *(const LAS f32x4*)(kp + 4), qa0 = *(const LAS f32x4*)qp, qa1 = *(const LAS f32x4*)(qp + 4);
            const bf16x8 kah = pack_frag(ka0, ka1), qah = pack_frag(qa0, qa1);
            f32x4 h0, h1; unpack8(__builtin_bit_cast(v4u, kah), h0, h1); const bf16x8 kal = pack_frag(ka0 - h0, ka1 - h1);
            unpack8(__builtin_bit_cast(v4u, qah), h0, h1); const bf16x8 qal = pack_frag(qa0 - h0, qa1 - h1);
#pragma unroll
            for (int jj = 0; jj < 2; ++jj) {
                const int jt = (wave & 1) * 2 + jj;
                if (jt <= it) {
                    const LAS float* bp = Lk + (16 * jt + rl) * 132 + 32 * s + 8 * quad;
                    const f32x4 kb0 = *(const LAS f32x4*)bp, kb1 = *(const LAS f32x4*)(bp + 4);
                    const bf16x8 kbh = pack_frag(kb0, kb1); unpack8(__builtin_bit_cast(v4u, kbh), h0, h1); const bf16x8 kbl = pack_frag(kb0 - h0, kb1 - h1);
                    ckk[jj] = mfma16(kah, kbh, ckk[jj]); ckk[jj] = mfma16(kah, kbl, ckk[jj]); ckk[jj] = mfma16(kal, kbh, ckk[jj]);
                    cqk[jj] = mfma16(qah, kbh, cqk[jj]); cqk[jj] = mfma16(qah, kbl, cqk[jj]); cqk[jj] = mfma16(qal, kbh, cqk[jj]);
                }
            }
        }
#pragma unroll
        for (int jj = 0; jj < 2; ++jj) {
            const int j = 16 * ((wave & 1) * 2 + jj) + rl; const float gj = Lg[j];
#pragma unroll
            for (int e = 0; e < 4; ++e) { const int i = 16 * it + 4 * quad + e; const float dec = (i >= j) ? __expf(Lg[i] - gj) : 0.f;
                LA[i * 64 + j] = (i > j) ? Lb[i] * ckk[jj][e] * dec : 0.f; LQK[i * 64 + j] = cqk[jj][e] * dec; }
        }
    }
    __syncthreads();
    GP_T(3);
    unsigned char* rec = ws + WS_GREC + (size_t)unit * GREC;
    LAS float* TI = (LAS float*)(F.lds + 135168);
    if (tid < 64) {
        const int B = tid >> 4, c = tid & 15;
        float tc[16];
#pragma unroll
        for (int i = 0; i < 16; ++i) {
            float s0 = (i == c) ? 1.f : 0.f;
#pragma unroll
            for (int j = 0; j < i; ++j) s0 -= LA[(16 * B + i) * 64 + 16 * B + j] * tc[j];
            tc[i] = s0;
        }
#pragma unroll
        for (int i = 0; i < 16; ++i) TI[B * 256 + i * 16 + c] = tc[i];
    }
    {
        const float gl = Lg[63];
        for (int it = tid; it < 2560; it += NTHREADS) {
            if (it < 1024) {
                const int i = it >> 4, s = (it >> 2) & 3, quad = it & 3; const float e = Le[i];
                const f32x4 a = *(const LAS f32x4*)(Lq + i * 132 + 32 * s + 4 * quad) * e, bq = *(const LAS f32x4*)(Lq + i * 132 + 32 * s + 16 + 4 * quad) * e;
                *(v4u*)(rec + 16384 + i * 256 + (32 * s + 8 * quad) * 2) = pack8(a, bq);
            } else if (it < 2048) {
                const int r = it - 1024, dk = r >> 3, s2 = (r >> 2) & 1, quad = r & 3;
                f32x4 a, bq;
#pragma unroll
                for (int e = 0; e < 4; ++e) { const int ta = 32 * s2 + 4 * quad + e, tb = ta + 16; a[e] = Lk[ta * 132 + dk] * __expf(gl - Lg[ta]); bq[e] = Lk[tb * 132 + dk] * __expf(gl - Lg[tb]); }
                *(v4u*)(rec + 32768 + dk * 128 + (32 * s2 + 8 * quad) * 2) = pack8(a, bq);
            } else {
                const int r = it - 2048, i = r >> 3, s2 = (r >> 2) & 1, quad = r & 3;
                const f32x4 a = *(const LAS f32x4*)(LQK + i * 64 + 32 * s2 + 4 * quad), bq = *(const LAS f32x4*)(LQK + i * 64 + 32 * s2 + 16 + 4 * quad);
                *(v4u*)(rec + 65536 + i * 128 + (32 * s2 + 8 * quad) * 2) = pack8(a, bq);
            }
        }
        if (tid == 0) *(float*)(rec + 73728) = __expf(gl);
    }
    __syncthreads();
    GP_T(4);
    {
        const int col = tid & 255, hb = tid >> 8;
        LAS float* X = (col < 128) ? (Lv + col) : (Lk + (col - 128));
        const bool isw = col >= 128;
#pragma unroll 1
        for (int B = 0; B < 4; ++B) {
            float xb[8];
#pragma unroll
            for (int i = 0; i < 8; ++i) { const int r = 16 * B + 8 * hb + i; xb[i] = (isw ? Lb[r] * Le[r] : Lb[r]) * X[r * 132]; }
#pragma unroll 2
            for (int j4 = 0; j4 < 4 * B; ++j4) {
                const float x0 = X[(4 * j4) * 132], x1 = X[(4 * j4 + 1) * 132], x2 = X[(4 * j4 + 2) * 132], x3 = X[(4 * j4 + 3) * 132];
#pragma unroll
                for (int i = 0; i < 8; ++i) { const f32x4 a = *(const LAS f32x4*)(LA + (16 * B + 8 * hb + i) * 64 + 4 * j4); xb[i] -= (a[0] * x0 + a[1] * x1) + (a[2] * x2 + a[3] * x3); }
            }
#pragma unroll
            for (int i = 0; i < 8; ++i) X[(16 * B + 8 * hb + i) * 132] = xb[i];
            __syncthreads();
            float r[16];
#pragma unroll
            for (int jj = 0; jj < 16; ++jj) r[jj] = X[(16 * B + jj) * 132];
            __syncthreads();
#pragma unroll
            for (int i = 0; i < 8; ++i) {
                float s0 = 0.f, s1 = 0.f;
#pragma unroll
                for (int j4 = 0; j4 < 4; ++j4) { const f32x4 a = *(const LAS f32x4*)(TI + B * 256 + (8 * hb + i) * 16 + 4 * j4);
                    s0 += a[0] * r[4 * j4] + a[2] * r[4 * j4 + 2]; s1 += a[1] * r[4 * j4 + 1] + a[3] * r[4 * j4 + 3]; }
                X[(16 * B + 8 * hb + i) * 132] = s0 + s1;
            }
            __syncthreads();
        }
    }
    __syncthreads();
    GP_T(5);
    for (int it = tid; it < 2048; it += NTHREADS) {
        if (it < 1024) {
            const int dv = it >> 3, q = it & 7;
            v4u w; w.x = pk2(Lv[(8 * q) * 132 + dv], Lv[(8 * q + 1) * 132 + dv]); w.y = pk2(Lv[(8 * q + 2) * 132 + dv], Lv[(8 * q + 3) * 132 + dv]);
            w.z = pk2(Lv[(8 * q + 4) * 132 + dv], Lv[(8 * q + 5) * 132 + dv]); w.w = pk2(Lv[(8 * q + 6) * 132 + dv], Lv[(8 * q + 7) * 132 + dv]);
            *(v4u*)(rec + 49152 + dv * 128 + q * 16) = w;
        } else {
            const int r = it - 1024, i = r >> 4, s = (r >> 2) & 3, quad = r & 3;
            const f32x4 a = *(const LAS f32x4*)(Lk + i * 132 + 32 * s + 4 * quad), bq = *(const LAS f32x4*)(Lk + i * 132 + 32 * s + 16 + 4 * quad);
            *(v4u*)(rec + i * 256 + (32 * s + 8 * quad) * 2) = pack8(a, bq);
        }
    }
    __syncthreads();
    GP_T(6);
}

DI void ret_prep_unit(Frame& F, int layer, int unit) {
    int lane = F.lane, wave = F.wave; asm volatile("" : "+v"(lane), "+s"(wave));
    const int tid = wave * 64 + lane, quad = lane >> 4, rl = lane & 15;
    const int b = unit >> 8, h = (unit >> 6) & 3, c = unit & 63;
    const int row0 = b * TP + 128 * c;
    unsigned char* ws = KWS();
    const bf16* Z = (const bf16*)(ws + WS_Z);
    const f32x2* ROT = (const f32x2*)(ws + WS_ROT);
    bf16* QR = (bf16*)(ws + WS_QR); bf16* KR = (bf16*)(ws + WS_KR);
    LAS unsigned char* LK = F.lds; LAS unsigned char* LV = F.lds + 34816;
    const float lg = ret_lg(h);
    for (int it = tid; it < 1024; it += NTHREADS) {
        const int j = it >> 3, cc = it & 7, d0 = cc * 8;
        const size_t zr = (size_t)(row0 + j) * LDZ + ZC_RQKV + h * 128 + d0;
        f32x4 q1a, q1b, q2a, q2b, k1a, k1b, k2a, k2b;
        unpack8(*(const v4u*)(Z + zr), q1a, q1b); unpack8(*(const v4u*)(Z + zr + 64), q2a, q2b);
        unpack8(*(const v4u*)(Z + zr + 512), k1a, k1b); unpack8(*(const v4u*)(Z + zr + 512 + 64), k2a, k2b);
        const f32x2* rp = ROT + (size_t)(128 * c + j) * 64 + d0;
        const float kd = __expf((float)(127 - j) * lg);
        f32x4 oq1a, oq1b, oq2a, oq2b, ok1a, ok1b, ok2a, ok2b;
#pragma unroll
        for (int e = 0; e < 8; ++e) {
            const f32x2 cs = rp[e];
            const float q1 = e < 4 ? q1a[e & 3] : q1b[e & 3], q2 = e < 4 ? q2a[e & 3] : q2b[e & 3], k1 = e < 4 ? k1a[e & 3] : k1b[e & 3], k2 = e < 4 ? k2a[e & 3] : k2b[e & 3];
            const float rq1 = q1 * cs.x - q2 * cs.y, rq2 = q2 * cs.x + q1 * cs.y, rk1 = (k1 * cs.x - k2 * cs.y) * 0.08838834764831845f, rk2 = (k2 * cs.x + k1 * cs.y) * 0.08838834764831845f;
            if (e < 4) { oq1a[e & 3] = rq1; oq2a[e & 3] = rq2; ok1a[e & 3] = rk1; ok2a[e & 3] = rk2; } else { oq1b[e & 3] = rq1; oq2b[e & 3] = rq2; ok1b[e & 3] = rk1; ok2b[e & 3] = rk2; }
            *(LAS bf16*)(LK + (d0 + e) * 272 + j * 2) = (bf16)f2bf(rk1 * kd); *(LAS bf16*)(LK + (d0 + 64 + e) * 272 + j * 2) = (bf16)f2bf(rk2 * kd);
        }
        const size_t orow = (size_t)(row0 + j) * 512 + h * 128 + d0;
        *(v4u*)(QR + orow) = pack8(oq1a, oq1b); *(v4u*)(QR + orow + 64) = pack8(oq2a, oq2b);
        *(v4u*)(KR + orow) = pack8(ok1a, ok1b); *(v4u*)(KR + orow + 64) = pack8(ok2a, ok2b);
    }
    for (int it = tid; it < 2048; it += NTHREADS) {
        const int j = it >> 4, cc = it & 15;
        const v4u w = *(const v4u*)(Z + (size_t)(row0 + j) * LDZ + ZC_RQKV + 1024 + h * 128 + cc * 8);
        LAS unsigned char* d = LV + (cc * 8) * 272 + j * 2;
        *(LAS bf16*)(d) = (bf16)(w.x & 0xffff); *(LAS bf16*)(d + 272) = (bf16)(w.x >> 16); *(LAS bf16*)(d + 2 * 272) = (bf16)(w.y & 0xffff); *(LAS bf16*)(d + 3 * 272) = (bf16)(w.y >> 16);
        *(LAS bf16*)(d + 4 * 272) = (bf16)(w.z & 0xffff); *(LAS bf16*)(d + 5 * 272) = (bf16)(w.z >> 16); *(LAS bf16*)(d + 6 * 272) = (bf16)(w.w & 0xffff); *(LAS bf16*)(d + 7 * 272) = (bf16)(w.w >> 16);
    }
    __syncthreads();
    float* RKV = (float*)(ws + WS_RKV) + (size_t)unit * 16384;
#pragma unroll
    for (int nt = 0; nt < 8; ++nt) {
        f32x4 acc = (f32x4){0.f, 0.f, 0.f, 0.f};
#pragma unroll
        for (int s = 0; s < 4; ++s) acc = mfma16(ld_frag_l(LK + (16 * wave + rl) * 272 + (32 * s + 8 * quad) * 2), ld_frag_l(LV + (16 * nt + rl) * 272 + (32 * s + 8 * quad) * 2), acc);
#pragma unroll
        for (int i = 0; i < 4; ++i) RKV[(size_t)(16 * wave + 4 * quad + i) * 128 + 16 * nt + rl] = acc[i];
    }
    __syncthreads();
}
DI void sample_rec_unit(Frame& F, int layer, int unit) {
    int lane = F.lane, wave = F.wave; asm volatile("" : "+v"(lane), "+s"(wave));
    const int tid = wave * 64 + lane;
    const int kind = unit >> 9, s = (unit >> 2) & 127, h = unit & 3;
    const int dv = tid & 127, part = tid >> 7, r0 = MP + 4 * s;
    unsigned char* ws = KWS();
    const bf16* Z = (const bf16*)(ws + WS_Z);
    const float* ZS = (const float*)(ws + WS_ZS);
    LAS float* Lq = (LAS float*)(F.lds); LAS float* Lk = Lq + 512; LAS float* Lv = Lq + 1024; LAS float* red = Lq + 1536; LAS float* Lo = Lq + 2048; LAS float* sc = Lq + 2560;
    float S[32];
    if (kind == 0) {
        if (tid < 384) {
            const int pr = tid >> 7, d = tid & 127, col = pr * 512 + h * 128 + d;
            float xp[7], w[4];
#pragma unroll
            for (int i = 0; i < 3; ++i) xp[i] = KIN(4)[((size_t)(layer * 128 + s) * 3 + i) * 1536 + col];
#pragma unroll
            for (int j = 0; j < 4; ++j) xp[3 + j] = bf2f(Z[(size_t)(r0 + j) * LDZ + ZC_GQKV + col]);
#pragma unroll
            for (int i = 0; i < 4; ++i) w[i] = KIN(15)[(size_t)(layer * 4 + i) * 1536 + col];
            LAS float* dst = pr == 0 ? Lq : pr == 1 ? Lk : Lv;
#pragma unroll
            for (int j = 0; j < 4; ++j) dst[j * 128 + d] = siluf_(w[0] * xp[j] + w[1] * xp[j + 1] + w[2] * xp[j + 2] + w[3] * xp[j + 3]);
        }
        __syncthreads();
        {
            LAS float* vp = (wave < 4 ? Lq : Lk) + (wave & 3) * 128;
            const float a = vp[2 * lane], b = vp[2 * lane + 1];
            const float scl = rsqrtf(wave_sum(a * a + b * b, lane) + EPS) * (wave < 4 ? 0.08838834764831845f : 1.f);
            vp[2 * lane] = a * scl; vp[2 * lane + 1] = b * scl;
        }
        if (tid < 4) {
            const float ga = ZS[(size_t)(r0 + tid) * 32 + 24 + h], gb = ZS[(size_t)(r0 + tid) * 32 + 28 + h];
            sc[tid] = __expf(-__expf(KIN(16)[layer * 4 + h]) * softplusf_(ga + KIN(17)[layer * 4 + h])); sc[4 + tid] = sigmoidf_(gb);
        }
        __syncthreads();
        const float* Sin = KIN(5) + ((size_t)((layer * 128 + s) * 4 + h) * 128 + 32 * part) * 128 + dv;
#pragma unroll
        for (int i = 0; i < 32; ++i) S[i] = Sin[(size_t)i * 128];
#pragma unroll
        for (int j = 0; j < 4; ++j) {
            const float a = sc[j], beta = sc[4 + j];
            float p = 0.f;
#pragma unroll
            for (int i = 0; i < 32; ++i) { S[i] *= a; p += Lk[j * 128 + 32 * part + i] * S[i]; }
            red[part * 128 + dv] = p;
            __syncthreads();
            const float delta = beta * (Lv[j * 128 + dv] - ((red[dv] + red[128 + dv]) + (red[256 + dv] + red[384 + dv])));
            __syncthreads();
            float o = 0.f;
#pragma unroll
            for (int i = 0; i < 32; ++i) { S[i] += Lk[j * 128 + 32 * part + i] * delta; o += Lq[j * 128 + 32 * part + i] * S[i]; }
            red[part * 128 + dv] = o;
            __syncthreads();
            if (part == 0) Lo[j * 128 + dv] = (red[dv] + red[128 + dv]) + (red[256 + dv] + red[384 + dv]);
            __syncthreads();
        }
        float* Sout = KOUT() + O_GSS + ((size_t)((layer * 128 + s) * 4 + h) * 128 + 32 * part) * 128 + dv;
#pragma unroll
        for (int i = 0; i < 32; ++i) Sout[(size_t)i * 128] = S[i];
        ((float*)(ws + WS_OGDN))[(size_t)(r0 + part) * 512 + h * 128 + dv] = Lo[part * 128 + dv];
    } else {
        const f32x2* ROT = (const f32x2*)(ws + WS_ROT);
        if (tid < 384) {
            const int pr = tid >> 7, d = tid & 127;
#pragma unroll
            for (int j = 0; j < 4; ++j) {
                const bf16* zp = Z + (size_t)(r0 + j) * LDZ + ZC_RQKV + pr * 512 + h * 128;
                float v = bf2f(zp[d]);
                if (pr < 2) { const f32x2 cs = ROT[(size_t)(2048 + j) * 64 + (d & 63)]; const float o = bf2f(zp[d ^ 64]);
                    v = (d < 64) ? v * cs.x - o * cs.y : v * cs.x + o * cs.y; if (pr == 1) v *= 0.08838834764831845f; }
                (pr == 0 ? Lq : pr == 1 ? Lk : Lv)[j * 128 + d] = v;
            }
        }
        __syncthreads();
        const float gam = __expf(ret_lg(h));
        const float* Sin = KIN(6) + ((size_t)((layer * 128 + s) * 4 + h) * 128 + 32 * part) * 128 + dv;
#pragma unroll
        for (int i = 0; i < 32; ++i) S[i] = Sin[(size_t)i * 128];
#pragma unroll
        for (int j = 0; j < 4; ++j) {
            const float vv = Lv[j * 128 + dv];
            float o = 0.f;
#pragma unroll
            for (int i = 0; i < 32; ++i) { S[i] = S[i] * gam + Lk[j * 128 + 32 * part + i] * vv; o += Lq[j * 128 + 32 * part + i] * S[i]; }
            red[part * 128 + dv] = o;
            __syncthreads();
            if (part == 0) Lo[j * 128 + dv] = (red[dv] + red[128 + dv]) + (red[256 + dv] + red[384 + dv]);
            __syncthreads();
        }
        float* Sout = KOUT() + O_RSS + ((size_t)((layer * 128 + s) * 4 + h) * 128 + 32 * part) * 128 + dv;
#pragma unroll
        for (int i = 0; i < 32; ++i) Sout[(size_t)i * 128] = S[i];
        if (wave < 4) {
            const int j = wave; const float a = Lo[j * 128 + 2 * lane], b = Lo[j * 128 + 2 * lane + 1];
            const float scl = rsqrtf(wave_sum(a * a + b * b, lane) * (1.f / 128.f) + EPS);
            const bf16* gp = Z + (size_t)(r0 + j) * LDZ + ZC_RG + h * 128 + 2 * lane;
            *(unsigned*)((bf16*)(ws + WS_MIX) + (size_t)(r0 + j) * 1536 + 1024 + h * 128 + 2 * lane) = pk2(a * scl * siluf_(bf2f(gp[0])), b * scl * siluf_(bf2f(gp[1])));
        }
    }
    __syncthreads();
}

DI void gdn_scan_chain(Frame& F, int layer, int bh) {
    int lane = F.lane, wave = F.wave; asm volatile("" : "+v"(lane), "+s"(wave));
    const int tid = wave * 64 + lane, quad = lane >> 4, rl = lane & 15;
    unsigned char* ws = KWS();
    const unsigned char* recb = ws + WS_GREC + (size_t)bh * 128 * GREC;
    LAS unsigned char* L = F.lds;
    constexpr int L_WP = 0, L_QP = 17408, L_KT = 34816, L_UT = 53248, L_QK = 71680;
    f32x4 S[8];
#pragma unroll
    for (int i = 0; i < 8; ++i) S[i] = (f32x4){0.f, 0.f, 0.f, 0.f};
    v4u pf[9]; float egl;
#pragma unroll
    for (int k = 0; k < 9; ++k) pf[k] = *(const v4u*)(recb + (size_t)(tid + 512 * k) * 16);
    egl = *(const float*)(recb + 73728);
    float* OG = (float*)(ws + WS_OGDN);
    const int b = bh >> 2, h = bh & 3;
    for (int c = 0; c < 128; ++c) {
        __syncthreads();
#pragma unroll
        for (int k = 0; k < 9; ++k) {
            const int o = tid * 16 + (k & 1) * 8192;
            const int reg = k >> 1;
            int dst;
            if (reg < 2) dst = (reg == 0 ? L_WP : L_QP) + (o >> 8) * 272 + (o & 255);
            else dst = (reg == 2 ? L_KT : reg == 3 ? L_UT : L_QK) + (o >> 7) * 144 + (o & 127);
            *(LAS v4u*)(L + dst) = pf[k];
        }
        const float eg = egl;
        __syncthreads();
        {
            const unsigned char* rn = recb + (size_t)(c + 1 < 128 ? c + 1 : 127) * GREC;
#pragma unroll
            for (int k = 0; k < 9; ++k) pf[k] = *(const v4u*)(rn + (size_t)(tid + 512 * k) * 16);
            egl = *(const float*)(rn + 73728);
        }
        bf16x8 Sb[4];
#pragma unroll
        for (int s = 0; s < 4; ++s) Sb[s] = pack_frag(S[2 * s], S[2 * s + 1]);
        f32x4 vn[4], O[4];
#pragma unroll
        for (int rt = 0; rt < 4; ++rt) {
            f32x4 wsacc = (f32x4){0.f, 0.f, 0.f, 0.f}, o = wsacc;
#pragma unroll
            for (int s = 0; s < 4; ++s) {
                wsacc = mfma16(ld_frag_l(L + L_WP + (16 * rt + rl) * 272 + (32 * s + 8 * quad) * 2), Sb[s], wsacc);
                o = mfma16(ld_frag_l(L + L_QP + (16 * rt + rl) * 272 + (32 * s + 8 * quad) * 2), Sb[s], o);
            }
            const v2u uw = *(const LAS v2u*)(L + L_UT + (16 * wave + rl) * 144 + (16 * rt + 4 * quad) * 2);
            vn[rt][0] = lo_bf(uw.x) - wsacc[0]; vn[rt][1] = hi_bf(uw.x) - wsacc[1]; vn[rt][2] = lo_bf(uw.y) - wsacc[2]; vn[rt][3] = hi_bf(uw.y) - wsacc[3];
            O[rt] = o;
        }
        bf16x8 Vb[2]; Vb[0] = pack_frag(vn[0], vn[1]); Vb[1] = pack_frag(vn[2], vn[3]);
#pragma unroll
        for (int rt = 0; rt < 4; ++rt) {
#pragma unroll
            for (int s2 = 0; s2 < 2; ++s2) O[rt] = mfma16(ld_frag_l(L + L_QK + (16 * rt + rl) * 144 + (32 * s2 + 8 * quad) * 2), Vb[s2], O[rt]);
            const size_t row = (size_t)b * TP + 64 * c + 16 * rt + 4 * quad;
#pragma unroll
            for (int i = 0; i < 4; ++i) OG[(row + i) * 512 + h * 128 + 16 * wave + rl] = O[rt][i];
        }
#pragma unroll
        for (int kt = 0; kt < 8; ++kt) {
            f32x4 a = S[kt] * eg;
#pragma unroll
            for (int s2 = 0; s2 < 2; ++s2) a = mfma16(ld_frag_l(L + L_KT + (16 * kt + rl) * 144 + (32 * s2 + 8 * quad) * 2), Vb[s2], a);
            S[kt] = a;
        }
    }
    float* So = KOUT() + O_GSP + (size_t)(layer * 8 + bh) * 16384;
#pragma unroll
    for (int kt = 0; kt < 8; ++kt)
#pragma unroll
        for (int i = 0; i < 4; ++i) So[(size_t)(16 * kt + 4 * quad + i) * 128 + 16 * wave + rl] = S[kt][i];
    __syncthreads();
}
DI void ret_scan_part(Frame& F, int layer, int r) {
    int tid = F.tid; asm volatile("" : "+v"(tid));
    const int bh = r >> 2, dv = tid & 127, dk0 = ((r & 3) * 4 + (tid >> 7)) * 8, h = bh & 3;
    unsigned char* ws = KWS();
    const float* RKV = (const float*)(ws + WS_RKV) + (size_t)bh * 64 * 16384;
    bf16* RST = (bf16*)(ws + WS_RST) + (size_t)bh * 64 * 16384;
    const float cdec = __expf(128.f * ret_lg(h));
    float S[8];
#pragma unroll
    for (int i = 0; i < 8; ++i) S[i] = 0.f;
#pragma unroll 4
    for (int c = 0; c < 64; ++c) {
        v4u w; w.x = pk2(S[0], S[1]); w.y = pk2(S[2], S[3]); w.z = pk2(S[4], S[5]); w.w = pk2(S[6], S[7]);
        *(v4u*)(RST + (size_t)c * 16384 + dv * 128 + dk0) = w;
#pragma unroll
        for (int i = 0; i < 8; ++i) S[i] = S[i] * cdec + RKV[(size_t)c * 16384 + (dk0 + i) * 128 + dv];
    }
    float* So = KOUT() + O_RSP + (size_t)(layer * 8 + bh) * 16384;
#pragma unroll
    for (int i = 0; i < 8; ++i) So[(size_t)(dk0 + i) * 128 + dv] = S[i];
}
constexpr float SM_C = 0.125f * 1.4426950408889634f;
struct AttnState { float m, l; f32x4 O[4]; };
DI void attn_reset(AttnState& st) { st.m = -1e30f; st.l = 0.f;
#pragma unroll
    for (int i = 0; i < 4; ++i) st.O[i] = (f32x4){0.f, 0.f, 0.f, 0.f}; }
DI void qk_tile(const LAS unsigned char* Kt, const bf16x8 (&qf)[2], f32x4 (&s)[4], int rl, int quad) {
    bf16x8 kf[4][2];
#pragma unroll
    for (int kt = 0; kt < 4; ++kt)
#pragma unroll
        for (int kk = 0; kk < 2; ++kk) kf[kt][kk] = ld_frag_l(Kt + (16 * kt + rl) * 144 + kk * 64 + quad * 16);
    __builtin_amdgcn_s_setprio(1);
#pragma unroll
    for (int kt = 0; kt < 4; ++kt) s[kt] = mfma16(kf[kt][0], qf[0], (f32x4){0.f, 0.f, 0.f, 0.f});
#pragma unroll
    for (int kt = 0; kt < 4; ++kt) s[kt] = mfma16(kf[kt][1], qf[1], s[kt]);
    __builtin_amdgcn_s_setprio(0);
}
template <class Mask> DI void attn_step(const LAS unsigned char* Kt, const LAS unsigned char* VT, const bf16x8 (&qf)[2], AttnState& st, const Mask& ok, int rl, int quad) {
    f32x4 s[4]; qk_tile(Kt, qf, s, rl, quad);
    float mx = -3e38f;
#pragma unroll
    for (int kt = 0; kt < 4; ++kt)
#pragma unroll
        for (int i = 0; i < 4; ++i) if (ok(16 * kt + 4 * quad + i)) mx = fmaxf(mx, s[kt][i]);
    const int lane = rl + 16 * quad;
    mx = fmaxf(mx, shx<16>(mx, lane)); mx = fmaxf(mx, shx<32>(mx, lane));
    const float mn = fmaxf(st.m, mx);
    const float alpha = exp2f((st.m - mn) * SM_C);
    float ls = 0.f;
#pragma unroll
    for (int kt = 0; kt < 4; ++kt)
#pragma unroll
        for (int i = 0; i < 4; ++i) { const float p = ok(16 * kt + 4 * quad + i) ? exp2f((s[kt][i] - mn) * SM_C) : 0.f; s[kt][i] = p; ls += p; }
    ls += shx<16>(ls, lane); ls += shx<32>(ls, lane);
    st.l = st.l * alpha + ls; st.m = mn;
#pragma unroll
    for (int dt = 0; dt < 4; ++dt) st.O[dt] *= alpha;
#pragma unroll
    for (int ii = 0; ii < 2; ++ii) {
        const bf16x8 pb = pack_frag(s[2 * ii], s[2 * ii + 1]);
#pragma unroll
        for (int dt = 0; dt < 4; ++dt) {
            const LAS unsigned char* vp = VT + (16 * dt + rl) * 144 + (32 * ii + 4 * quad) * 2;
            st.O[dt] = mfma16(mk_frag(*(const LAS v2u*)vp, *(const LAS v2u*)(vp + 32)), pb, st.O[dt]);
        }
    }
}
DI void attn_accum(f32x4 (&Of)[4], const AttnState& st, float gate) {
    const float sc = st.l > 0.f ? gate / st.l : 0.f;
#pragma unroll
    for (int dt = 0; dt < 4; ++dt) Of[dt] += st.O[dt] * sc;
}
DI void vt_write(LAS unsigned char* VT, int d0, int key, const v4u w) {
    LAS unsigned char* d = VT + d0 * 144 + key * 2;
    *(LAS bf16*)(d) = (bf16)(w.x & 0xffff); *(LAS bf16*)(d + 144) = (bf16)(w.x >> 16); *(LAS bf16*)(d + 2 * 144) = (bf16)(w.y & 0xffff); *(LAS bf16*)(d + 3 * 144) = (bf16)(w.y >> 16);
    *(LAS bf16*)(d + 4 * 144) = (bf16)(w.z & 0xffff); *(LAS bf16*)(d + 5 * 144) = (bf16)(w.z >> 16); *(LAS bf16*)(d + 6 * 144) = (bf16)(w.w & 0xffff); *(LAS bf16*)(d + 7 * 144) = (bf16)(w.w >> 16);
}
DI void stage_wg(LAS unsigned char* Kt, LAS unsigned char* VT, const bf16* kb, const bf16* vb, size_t stride, int tid, bool do_v) {
    const int key = tid >> 3, ch = tid & 7;
    *(LAS v4u*)(Kt + key * 144 + ch * 16) = *(const v4u*)(kb + key * stride + ch * 8);
    if (do_v) vt_write(VT, ch * 8, key, *(const v4u*)(vb + key * stride + ch * 8));
}
DI unsigned score_key(float s, bool valid, int idx) { return valid ? (((__float_as_uint(s) | 0x80000000u) & ~127u) | (unsigned)(127 - idx)) : 0u; }
DI int key_rank(const LAS unsigned* K, int ng4, unsigned k) {
    int r = 0;
#pragma unroll 4
    for (int g = 0; g < ng4; ++g) { const v4u v = *(const LAS v4u*)(K + 4 * g); r += (v.x > k) + (v.y > k) + (v.z > k) + (v.w > k); }
    return r;
}
DI void key_rank2(const LAS unsigned* K, int ng4, unsigned k0, unsigned k1, int& r0, int& r1) {
    int a0 = 0, a1 = 0, b0 = 0, b1 = 0;
    const int ng8 = (ng4 + 1) >> 1;
#pragma unroll 4
    for (int g = 0; g < ng8; ++g) { const v4u v = *(const LAS v4u*)(K + 8 * g), w = *(const LAS v4u*)(K + 8 * g + 4);
        a0 += (v.x > k0) + (v.y > k0) + (v.z > k0) + (v.w > k0); b0 += (w.x > k0) + (w.y > k0) + (w.z > k0) + (w.w > k0);
        a1 += (v.x > k1) + (v.y > k1) + (v.z > k1) + (v.w > k1); b1 += (w.x > k1) + (w.y > k1) + (w.z > k1) + (w.w > k1); }
    r0 = a0 + b0; r1 = a1 + b1;
}
DI int top16(float v0, float v1, int lane) {
    int sel = 0;
#pragma unroll 1
    for (int r = 0; r < 16; ++r) {
        float bv; int bi;
        if (v0 >= v1) { bv = v0; bi = lane; } else { bv = v1; bi = lane + 64; }
#define T16_STEP(M) { const float ov = shx<M>(bv, lane); const int oi = shxi<M>(bi, lane); const bool take = (ov > bv) || (ov == bv && oi < bi); bv = take ? ov : bv; bi = take ? oi : bi; }
        T16_STEP(32) T16_STEP(16) T16_STEP(8) T16_STEP(4) T16_STEP(2) T16_STEP(1)
#undef T16_STEP
        const bool h0 = (bi == lane), h1 = (bi == lane + 64);
        v0 = h0 ? -3e38f : v0; v1 = h1 ? -3e38f : v1; sel |= (h0 ? 1 : 0) | (h1 ? 2 : 0);
    }
    return sel;
}

typedef short v4i16_t __attribute__((ext_vector_type(4)));
DI s16x4 vtr(const LAS unsigned char* p) { return __builtin_bit_cast(s16x4, __builtin_amdgcn_ds_read_tr16_b64_v4i16((LAS v4i16_t*)p)); }
DI bf16x8 cat4(s16x4 a, s16x4 b) { bf16x8 r; r[0] = a[0]; r[1] = a[1]; r[2] = a[2]; r[3] = a[3]; r[4] = b[0]; r[5] = b[1]; r[6] = b[2]; r[7] = b[3]; return r; }
DI void attn_step3(const LAS unsigned char* Kt, const LAS unsigned char* Vt, const bf16x8 (&qf)[2], AttnState& st, int lo, int hi, bool active, int rl, int quad) {
    active = active && (hi >= lo);
    if (!__any(active)) return;
    f32x4 s[4]; qk_tile(Kt, qf, s, rl, quad);
    const int lane = rl + 16 * quad;
    const bool full = __all((lo <= 0 && hi >= 63) || !active);
    const int kq = 4 * quad - lo; const unsigned rng = (unsigned)(hi - lo);
    float lm;
    if (full) {
        const float a0 = fmaxf(fmaxf(s[0][0], s[0][1]), fmaxf(s[0][2], s[0][3])), a1 = fmaxf(fmaxf(s[1][0], s[1][1]), fmaxf(s[1][2], s[1][3]));
        const float a2 = fmaxf(fmaxf(s[2][0], s[2][1]), fmaxf(s[2][2], s[2][3])), a3 = fmaxf(fmaxf(s[3][0], s[3][1]), fmaxf(s[3][2], s[3][3]));
        lm = fmaxf(fmaxf(a0, a1), fmaxf(a2, a3));
    } else {
        lm = -3e38f;
#pragma unroll
        for (int kt = 0; kt < 4; ++kt)
#pragma unroll
            for (int i = 0; i < 4; ++i) lm = ((unsigned)(kq + 16 * kt + i) <= rng) ? fmaxf(lm, s[kt][i]) : lm;
    }
    lm = active ? lm : -3e38f;
    if (__any(lm > st.m + 320.f)) {
        float mx = fmaxf(lm, shx<16>(lm, lane)); mx = fmaxf(mx, shx<32>(mx, lane));
        const float mn = fmaxf(st.m, mx);
        const float alpha = __builtin_amdgcn_exp2f((st.m - mn) * SM_C);
        st.l *= alpha; st.m = mn;
#pragma unroll
        for (int dt = 0; dt < 4; ++dt) st.O[dt] *= alpha;
    }
    const float mc = active ? st.m * SM_C : __builtin_inff();
    float ls = 0.f;
    if (full) {
#pragma unroll
        for (int kt = 0; kt < 4; ++kt)
#pragma unroll
            for (int i = 0; i < 4; ++i) { const float p = __builtin_amdgcn_exp2f(s[kt][i] * SM_C - mc); s[kt][i] = p; ls += p; }
    } else {
#pragma unroll
        for (int kt = 0; kt < 4; ++kt)
#pragma unroll
            for (int i = 0; i < 4; ++i) { const float p = ((unsigned)(kq + 16 * kt + i) <= rng) ? __builtin_amdgcn_exp2f(s[kt][i] * SM_C - mc) : 0.f; s[kt][i] = p; ls += p; }
    }
    st.l += ls;
#pragma unroll
    for (int ii = 0; ii < 2; ++ii) {
        const bf16x8 pb = pack_frag(s[2 * ii], s[2 * ii + 1]);
#pragma unroll
        for (int dt = 0; dt < 4; ++dt) {
            const LAS unsigned char* vp = Vt + (32 * ii + 4 * quad + (rl >> 2)) * 144 + (16 * dt + 4 * (rl & 3)) * 2;
            st.O[dt] = mfma16(cat4(vtr(vp), vtr(vp + 16 * 144)), pb, st.O[dt]);
        }
    }
}
DI float attn_rowsum(const AttnState& st, int lane) { float l = st.l; l += shx<16>(l, lane); l += shx<32>(l, lane); return l; }
DI void attn_accum3(f32x4 (&Of)[4], const AttnState& st, float gate, int lane) {
    const float l = attn_rowsum(st, lane);
    const float sc = l > 0.f ? gate / l : 0.f;
#pragma unroll
    for (int dt = 0; dt < 4; ++dt) Of[dt] += st.O[dt] * sc;
}
#ifndef PH_NPT
#define PH_NPT (-1)
#endif
#if PH_NPT >= 0
#define NP_T(k) do { if (tid == 0) { volatile LAS unsigned long long* np_ = (volatile LAS unsigned long long*)(F.lds + LDSCTL_OFF + 464); const unsigned long long now_ = __builtin_amdgcn_s_memrealtime(); \
    if ((k) == PH_NPT) np_[0] += now_ - np_[1]; np_[1] = now_; } } while (0)
#else
#define NP_T(k) do { } while (0)
#endif
#ifndef PH_NSAC
#define PH_NSAC 1
#endif
DI float tile_max(const f32x4 (&s)[4], bool full, int kq, unsigned rng) {
    float lm;
    if (full) {
        const float a0 = fmaxf(fmaxf(s[0][0], s[0][1]), fmaxf(s[0][2], s[0][3])), a1 = fmaxf(fmaxf(s[1][0], s[1][1]), fmaxf(s[1][2], s[1][3]));
        const float a2 = fmaxf(fmaxf(s[2][0], s[2][1]), fmaxf(s[2][2], s[2][3])), a3 = fmaxf(fmaxf(s[3][0], s[3][1]), fmaxf(s[3][2], s[3][3]));
        lm = fmaxf(fmaxf(a0, a1), fmaxf(a2, a3));
    } else {
        lm = -3e38f;
#pragma unroll
        for (int kt = 0; kt < 4; ++kt)
#pragma unroll
            for (int i = 0; i < 4; ++i) lm = ((unsigned)(kq + 16 * kt + i) <= rng) ? fmaxf(lm, s[kt][i]) : lm;
    }
    return lm;
}
DI float tile_exp(f32x4 (&s)[4], bool full, int kq, unsigned rng, float mc) {
    float ls = 0.f;
    if (full) {
#pragma unroll
        for (int kt = 0; kt < 4; ++kt)
#pragma unroll
            for (int i = 0; i < 4; ++i) { const float p = __builtin_amdgcn_exp2f(s[kt][i] * SM_C - mc); s[kt][i] = p; ls += p; }
    } else {
#pragma unroll
        for (int kt = 0; kt < 4; ++kt)
#pragma unroll
            for (int i = 0; i < 4; ++i) { const float p = ((unsigned)(kq + 16 * kt + i) <= rng) ? __builtin_amdgcn_exp2f(s[kt][i] * SM_C - mc) : 0.f; s[kt][i] = p; ls += p; }
    }
    return ls;
}
DI void tile_pv(const LAS unsigned char* Vt, const f32x4 (&s)[4], f32x4 (&O)[4], int rl, int quad) {
    bf16x8 vf[2][4];
#pragma unroll
    for (int ii = 0; ii < 2; ++ii)
#pragma unroll
        for (int dt = 0; dt < 4; ++dt) { const LAS unsigned char* vp = Vt + (32 * ii + 4 * quad + (rl >> 2)) * 144 + (16 * dt + 4 * (rl & 3)) * 2; vf[ii][dt] = cat4(vtr(vp), vtr(vp + 16 * 144)); }
    const bf16x8 pb0 = pack_frag(s[0], s[1]), pb1 = pack_frag(s[2], s[3]);
    __builtin_amdgcn_s_setprio(1);
#pragma unroll
    for (int dt = 0; dt < 4; ++dt) O[dt] = mfma16(vf[0][dt], pb0, O[dt]);
#pragma unroll
    for (int dt = 0; dt < 4; ++dt) O[dt] = mfma16(vf[1][dt], pb1, O[dt]);
    __builtin_amdgcn_s_setprio(0);
}
DI void tile_vload(const LAS unsigned char* Vt, bf16x8 (&vf)[2][4], int rl, int quad) {
#pragma unroll
    for (int ii = 0; ii < 2; ++ii)
#pragma unroll
        for (int dt = 0; dt < 4; ++dt) { const LAS unsigned char* vp = Vt + (32 * ii + 4 * quad + (rl >> 2)) * 144 + (16 * dt + 4 * (rl & 3)) * 2; vf[ii][dt] = cat4(vtr(vp), vtr(vp + 16 * 144)); }
}
DI void tile_pvmma(const bf16x8 (&vf)[2][4], const f32x4 (&s)[4], f32x4 (&O)[4]) {
    const bf16x8 pb0 = pack_frag(s[0], s[1]), pb1 = pack_frag(s[2], s[3]);
    __builtin_amdgcn_s_setprio(1);
#pragma unroll
    for (int dt = 0; dt < 4; ++dt) O[dt] = mfma16(vf[0][dt], pb0, O[dt]);
#pragma unroll
    for (int dt = 0; dt < 4; ++dt) O[dt] = mfma16(vf[1][dt], pb1, O[dt]);
    __builtin_amdgcn_s_setprio(0);
}
DI void attn_step_pair(const LAS unsigned char* K0, const LAS unsigned char* V0, int lo0, int hi0, bool act0,
                       const LAS unsigned char* K1, const LAS unsigned char* V1, int lo1, int hi1, bool act1,
                       const bf16x8 (&qf)[2], AttnState& st, int rl, int quad) {
    act0 = act0 && (hi0 >= lo0); act1 = act1 && (hi1 >= lo1);
    const bool any0 = __any(act0), any1 = __any(act1);
    if (!any0 && !any1) return;
    const int lane = rl + 16 * quad;
    f32x4 s0[4], s1[4];
    if (any0 && any1) {
        bf16x8 kf0[4][2], kf1[4][2];
#pragma unroll
        for (int kt = 0; kt < 4; ++kt)
#pragma unroll
            for (int kk = 0; kk < 2; ++kk) { kf0[kt][kk] = ld_frag_l(K0 + (16 * kt + rl) * 144 + kk * 64 + quad * 16); kf1[kt][kk] = ld_frag_l(K1 + (16 * kt + rl) * 144 + kk * 64 + quad * 16); }
        __builtin_amdgcn_s_setprio(1);
#pragma unroll
        for (int kt = 0; kt < 4; ++kt) s0[kt] = mfma16(kf0[kt][0], qf[0], (f32x4){0.f, 0.f, 0.f, 0.f});
#pragma unroll
        for (int kt = 0; kt < 4; ++kt) s1[kt] = mfma16(kf1[kt][0], qf[0], (f32x4){0.f, 0.f, 0.f, 0.f});
#pragma unroll
        for (int kt = 0; kt < 4; ++kt) s0[kt] = mfma16(kf0[kt][1], qf[1], s0[kt]);
#pragma unroll
        for (int kt = 0; kt < 4; ++kt) s1[kt] = mfma16(kf1[kt][1], qf[1], s1[kt]);
        __builtin_amdgcn_s_setprio(0);
    } else {
        if (any0) qk_tile(K0, qf, s0, rl, quad);
        if (any1) qk_tile(K1, qf, s1, rl, quad);
    }
    const bool full0 = __all((lo0 <= 0 && hi0 >= 63) || !act0), full1 = __all((lo1 <= 0 && hi1 >= 63) || !act1);
    const int kq0 = 4 * quad - lo0, kq1 = 4 * quad - lo1; const unsigned rng0 = (unsigned)(hi0 - lo0), rng1 = (unsigned)(hi1 - lo1);
    float mcb = st.m * SM_C;
    bf16x8 vf0[2][4], vf1[2][4];
    if (any0) tile_vload(V0, vf0, rl, quad);
    float ls = 0.f;
    if (any0) ls += tile_exp(s0, full0, kq0, rng0, act0 ? mcb : __builtin_inff());
    if (any1) ls += tile_exp(s1, full1, kq1, rng1, act1 ? mcb : __builtin_inff());
    if (__any(!(ls <= 1e30f))) {
        if (any0) qk_tile(K0, qf, s0, rl, quad);
        if (any1) qk_tile(K1, qf, s1, rl, quad);
        float lm = -3e38f;
        if (any0) { const float a = tile_max(s0, full0, kq0, rng0); lm = act0 ? a : lm; }
        if (any1) { const float a = tile_max(s1, full1, kq1, rng1); lm = act1 ? fmaxf(lm, a) : lm; }
        float mx = fmaxf(lm, shx<16>(lm, lane)); mx = fmaxf(mx, shx<32>(mx, lane));
        const float mn = fmaxf(st.m, mx);
        const float alpha = __builtin_amdgcn_exp2f((st.m - mn) * SM_C);
        st.l *= alpha; st.m = mn;
#pragma unroll
        for (int dt = 0; dt < 4; ++dt) st.O[dt] *= alpha;
        mcb = mn * SM_C; ls = 0.f;
        if (any0) ls += tile_exp(s0, full0, kq0, rng0, act0 ? mcb : __builtin_inff());
        if (any1) ls += tile_exp(s1, full1, kq1, rng1, act1 ? mcb : __builtin_inff());
    }
    st.l += ls;
    if (any1) tile_vload(V1, vf1, rl, quad);
    if (any0) tile_pvmma(vf0, s0, st.O);
    if (any1) tile_pvmma(vf1, s1, st.O);
}
DI void nsa_prompt_unit(Frame& F, int layer, int unit) {
    int lane = F.lane, wave = F.wave; asm volatile("" : "+v"(lane), "+s"(wave));
    const int tid = wave * 64 + lane, quad = lane >> 4, rl = lane & 15;
    const int b = unit >> 9, g = (unit >> 8) & 1, tt = unit & 255, t0 = 32 * tt;
    unsigned char* ws = KWS();
    const bf16* Z = (const bf16*)(ws + WS_Z);
    const float* ZS = (const float*)(ws + WS_ZS);
    LAS unsigned char* TB = F.lds;
    LAS float* AIMP = (LAS float*)(F.lds + 73728);
    LAS unsigned* SEL = (LAS unsigned*)(F.lds + LDSCTL_OFF + 512);
    const int tk = 4 * wave + (rl >> 2), t = t0 + tk, head = 4 * g + (rl & 3);
    const size_t row = (size_t)b * TP + t;
    bf16x8 qf[2];
    qf[0] = ld_frag_g(Z + row * LDZ + ZC_Q + head * 64 + quad * 8); qf[1] = ld_frag_g(Z + row * LDZ + ZC_Q + head * 64 + 32 + quad * 8);
    const float gc = sigmoidf_(ZS[row * 32 + head * 3]), gs = sigmoidf_(ZS[row * 32 + head * 3 + 1]), gw = sigmoidf_(ZS[row * 32 + head * 3 + 2]);
    f32x4 Of[4];
#pragma unroll
    for (int i = 0; i < 4; ++i) Of[i] = (f32x4){0.f, 0.f, 0.f, 0.f};
    AttnState st;
    const int nct = (t0 >> 10) + 1;
    const bf16* KC = (const bf16*)(ws + WS_KC) + ((size_t)(0 * 2 + b) * 512 * 2 + g) * 64;
    const bf16* VC = (const bf16*)(ws + WS_KC) + ((size_t)(1 * 2 + b) * 512 * 2 + g) * 64;
    const bf16* Zb = Z + (size_t)b * TP * LDZ + g * 64;
    const int skey = tid >> 3, sch = tid & 7;
    const int wlo = (t0 - 511 > 0 ? t0 - 511 : 0) >> 6, nwin = ((t0 + 31) >> 6) - wlo + 1;
    const int nwe = (nwin + 1) & ~1, nce = (nct + 1) & ~1;
    v4u rkA, rvA, rkB, rvB;
#define COMMIT(slot, rk, rv) do { LAS unsigned char* d_ = TB + (slot) * 18432 + skey * 144 + sch * 16; *(LAS v4u*)d_ = rk; *(LAS v4u*)(d_ + 9216) = rv; } while (0)
    NP_T(0);
    const int n1 = nwe + 2 * nce;
#define SEG1_VALID(i) ((i) < nwe ? (i) < nwin : (((i) - nwe) < nce ? ((i) - nwe) < nct : ((i) - nwe - nce) < nct))
#define SEG1_ISSUE(i, rk, rv) do { int i_ = (i); i_ = i_ < n1 ? i_ : n1 - 1; const bool win_ = i_ < nwe; int wt_ = wlo + (i_ < nwin ? i_ : nwin - 1); int jt_ = (i_ - nwe) % nce; jt_ = jt_ < nct ? jt_ : nct - 1; jt_ = jt_ < 0 ? 0 : jt_; \
        const bf16* pk_ = win_ ? Zb + (size_t)(64 * wt_ + skey) * LDZ + sch * 8 + ZC_KW : KC + (size_t)(64 * jt_ + skey) * 128 + sch * 8; \
        const bf16* pv_ = win_ ? Zb + (size_t)(64 * wt_ + skey) * LDZ + sch * 8 + ZC_VW : VC + (size_t)(64 * jt_ + skey) * 128 + sch * 8; \
        rk = *(const v4u*)pk_; rv = *(const v4u*)pv_; } while (0)
    attn_reset(st);
    float mfin = 0.f, il = 0.f;
    SEG1_ISSUE(0, rkA, rvA); SEG1_ISSUE(1, rkB, rvB);
    COMMIT(0, rkA, rvA); COMMIT(1, rkB, rvB);
    SEG1_ISSUE(2, rkA, rvA); SEG1_ISSUE(3, rkB, rvB);
    __syncthreads();
    for (int i = 0; i < n1; i += 2) {
        const LAS unsigned char* K0 = TB + (i & 3) * 18432; const LAS unsigned char* K1 = TB + ((i + 1) & 3) * 18432;
        if (i < nwe) {
            const int kb0 = 64 * (wlo + i), kb1 = kb0 + 64;
            attn_step_pair(K0, K0 + 9216, t - 511 - kb0, t - kb0, true, K1, K1 + 9216, t - 511 - kb1, t - kb1, (i + 1) < nwin, qf, st, rl, quad);
            if (i + 2 == nwe) { attn_accum3(Of, st, gw, lane); attn_reset(st); }
        } else if (i < nwe + nce) {
            const int nb0 = 64 * (i - nwe), nb1 = nb0 + 64;
            attn_step_pair(K0, K0 + 9216, 0, ((t - 31) >> 4) - nb0, true, K1, K1 + 9216, 0, ((t - 31) >> 4) - nb1, (i + 1 - nwe) < nct, qf, st, rl, quad);
            if (i + 2 == nwe + nce) { attn_accum3(Of, st, gc, lane); mfin = st.m * SM_C; const float lt_ = attn_rowsum(st, lane); il = lt_ > 0.f ? 1.f / lt_ : 0.f; }
        } else {
#pragma unroll
            for (int e2 = 0; e2 < 2; ++e2) {
                const int jt = i + e2 - nwe - nce;
                if (jt < nct) {
                    f32x4 s[4]; qk_tile(e2 ? K1 : K0, qf, s, rl, quad);
#pragma unroll
                    for (int kt = 0; kt < 4; ++kt)
#pragma unroll
                        for (int e = 0; e < 4; ++e) {
                            const int n = 64 * jt + 16 * kt + 4 * quad + e;
                            float p = (16 * n + 31 <= t) ? __builtin_amdgcn_exp2f(s[kt][e] * SM_C - mfin) * il : 0.f;
                            p += shx<1>(p, lane); p += shx<2>(p, lane);
                            if ((rl & 3) == 0) AIMP[tk * 512 + n] = p;
                        }
                }
            }
        }
        if (i + 2 < n1) { if (SEG1_VALID(i + 2)) COMMIT((i + 2) & 3, rkA, rvA); if (SEG1_VALID(i + 3)) COMMIT((i + 3) & 3, rkB, rvB); }
        __syncthreads();
        SEG1_ISSUE(i + 4, rkA, rvA); SEG1_ISSUE(i + 5, rkB, rvB);
    }
    NP_T(1);
    {
        const int nav = nct * 64;
        LAS unsigned* KS = (LAS unsigned*)(TB + wave * 2048);
#pragma unroll
        for (int q = 0; q < 4; ++q) {
            const int tq = 4 * wave + q, cur = (t0 + tq) >> 6;
#pragma unroll
            for (int e = 0; e < 2; ++e) {
                const int sblk = lane + 64 * e;
                float imp = 0.f;
#pragma unroll
                for (int d = -1; d <= 3; ++d) { const int n = 4 * sblk + d; if (n >= 0 && n < nav) imp += AIMP[tq * 512 + n]; }
                const bool valid = sblk <= cur, forced = (sblk == 0) || (sblk == cur) || (sblk == cur - 1);
                KS[q * 128 + sblk] = score_key(imp + (forced ? 1000.f : 0.f), valid, sblk);
            }
        }
        asm volatile("" ::: "memory");
#pragma unroll
        for (int q = 0; q < 4; ++q) {
            const int tq = 4 * wave + q, cur = (t0 + tq) >> 6, ng4 = (cur >> 2) + 1;
            const unsigned k0 = KS[q * 128 + lane], k1 = KS[q * 128 + 64 + lane];
            int r0, r1; key_rank2(KS + q * 128, ng4, k0, k1, r0, r1);
            const bool s0 = (lane <= cur) && r0 < 16, s1 = (lane + 64 <= cur) && r1 < 16;
            const unsigned long long m0 = __ballot(s0), m1 = __ballot(s1);
            if (lane == 0) { SEL[tq * 4 + 0] = (unsigned)m0; SEL[tq * 4 + 1] = (unsigned)(m0 >> 32); SEL[tq * 4 + 2] = (unsigned)m1; SEL[tq * 4 + 3] = (unsigned)(m1 >> 32); }
        }
    }
    __syncthreads();
    unsigned un[4], my[4], wv[4];
#pragma unroll
    for (int w = 0; w < 4; ++w) { unsigned v = (lane < 32) ? SEL[lane * 4 + w] : 0u;
        v |= (unsigned)shxi<1>((int)v, lane); v |= (unsigned)shxi<2>((int)v, lane); v |= (unsigned)shxi<4>((int)v, lane); v |= (unsigned)shxi<8>((int)v, lane); v |= (unsigned)shxi<16>((int)v, lane); v |= (unsigned)shxi<32>((int)v, lane);
        un[w] = __builtin_amdgcn_readfirstlane(v); my[w] = SEL[tk * 4 + w];
        wv[w] = SEL[(4 * wave) * 4 + w] | SEL[(4 * wave + 1) * 4 + w] | SEL[(4 * wave + 2) * 4 + w] | SEL[(4 * wave + 3) * 4 + w]; wv[w] = __builtin_amdgcn_readfirstlane(wv[w]); }
#if PH_NSAC > 1
    AttnState st2; attn_reset(st2);
#endif
    NP_T(2);
    attn_reset(st);
    {
        unsigned w0 = un[0], w1 = un[1], w2 = un[2], w3 = un[3];
#define NEXT_BLK(dst) do { if (w0) { dst = __builtin_ctz(w0); w0 &= w0 - 1u; } else if (w1) { dst = 32 + __builtin_ctz(w1); w1 &= w1 - 1u; } else if (w2) { dst = 64 + __builtin_ctz(w2); w2 &= w2 - 1u; } \
        else if (w3) { dst = 96 + __builtin_ctz(w3); w3 &= w3 - 1u; } else dst = -1; } while (0)
#define SEG2_ISSUE(blk_, rk, rv) do { const int b_ = (blk_) >= 0 ? (blk_) : 0; const bf16* p_ = Zb + (size_t)(64 * b_ + skey) * LDZ + sch * 8; rk = *(const v4u*)(p_ + ZC_KS); rv = *(const v4u*)(p_ + ZC_VS); } while (0)
#define BLK_WORD(arr, blk_) (((blk_) >> 5) == 0 ? arr[0] : ((blk_) >> 5) == 1 ? arr[1] : ((blk_) >> 5) == 2 ? arr[2] : arr[3])
#define SEG2_PAIR(ca, cb, sa, sb, stt) do { const LAS unsigned char* K0 = TB + (sa) * 18432; const LAS unsigned char* K1 = TB + (sb) * 18432; \
            const int ca_ = (ca) >= 0 ? (ca) : 0, cb_ = (cb) >= 0 ? (cb) : 0; \
            const bool need0 = ((ca) >= 0) && ((BLK_WORD(wv, ca_) >> (ca_ & 31)) & 1u), need1 = ((cb) >= 0) && ((BLK_WORD(wv, cb_) >> (cb_ & 31)) & 1u); \
            const bool mine0 = need0 && ((BLK_WORD(my, ca_) >> (ca_ & 31)) & 1u), mine1 = need1 && ((BLK_WORD(my, cb_) >> (cb_ & 31)) & 1u); \
            attn_step_pair(K0, K0 + 9216, 0, t - 64 * ca_, mine0, K1, K1 + 9216, 0, t - 64 * cb_, mine1, qf, stt, rl, quad); } while (0)
        v4u rkC, rvC, rkD, rvD;
        int c0, c1, c2, c3, n0, n1b, n2, n3, m0, m1, m2, m3;
        NEXT_BLK(c0); NEXT_BLK(c1); NEXT_BLK(c2); NEXT_BLK(c3); NEXT_BLK(n0); NEXT_BLK(n1b); NEXT_BLK(n2); NEXT_BLK(n3);
        SEG2_ISSUE(c0, rkA, rvA); SEG2_ISSUE(c1, rkB, rvB); SEG2_ISSUE(c2, rkC, rvC); SEG2_ISSUE(c3, rkD, rvD);
        COMMIT(0, rkA, rvA); COMMIT(1, rkB, rvB); COMMIT(2, rkC, rvC); COMMIT(3, rkD, rvD);
        SEG2_ISSUE(n0, rkA, rvA); SEG2_ISSUE(n1b, rkB, rvB); SEG2_ISSUE(n2, rkC, rvC); SEG2_ISSUE(n3, rkD, rvD);
        __syncthreads();
        int i = 0;
        while (c0 >= 0) {
            NEXT_BLK(m0); NEXT_BLK(m1); NEXT_BLK(m2); NEXT_BLK(m3);
            SEG2_PAIR(c0, c1, i & 7, (i + 1) & 7, st);
            SEG2_PAIR(c2, c3, (i + 2) & 7, (i + 3) & 7, st);
#if PH_NSAC > 1
            SEG2_PAIR(c0, c1, i & 7, (i + 1) & 7, st2); SEG2_PAIR(c2, c3, (i + 2) & 7, (i + 3) & 7, st2);
#endif
            COMMIT((i + 4) & 7, rkA, rvA); COMMIT((i + 5) & 7, rkB, rvB); COMMIT((i + 6) & 7, rkC, rvC); COMMIT((i + 7) & 7, rkD, rvD);
            __syncthreads();
#if defined(PH_NSAX) && (PH_NSAX & 1)
            __syncthreads();
#endif
#if defined(PH_NSAX) && (PH_NSAX & 2)
            { v4u d0_, d1_; SEG2_ISSUE(m0, d0_, d1_); asm volatile("" :: "v"(d0_), "v"(d1_)); SEG2_ISSUE(m1, d0_, d1_); asm volatile("" :: "v"(d0_), "v"(d1_));
              SEG2_ISSUE(m2, d0_, d1_); asm volatile("" :: "v"(d0_), "v"(d1_)); SEG2_ISSUE(m3, d0_, d1_); asm volatile("" :: "v"(d0_), "v"(d1_)); }
#endif
            SEG2_ISSUE(m0, rkA, rvA); SEG2_ISSUE(m1, rkB, rvB); SEG2_ISSUE(m2, rkC, rvC); SEG2_ISSUE(m3, rkD, rvD);
            c0 = n0; c1 = n1b; c2 = n2; c3 = n3; n0 = m0; n1b = m1; n2 = m2; n3 = m3; i += 4;
        }
    }
    NP_T(3);
    attn_accum3(Of, st, gs, lane);
#if PH_NSAC > 1
    attn_accum3(Of, st2, (float)(layer >> 8), lane);
#endif
#undef SEG1_ISSUE
#undef SEG1_VALID
#undef SEG2_ISSUE
#undef SEG2_PAIR
#undef BLK_WORD
#undef COMMIT
#undef NEXT_BLK
    bf16* MIX = (bf16*)(ws + WS_MIX) + row * 1536 + head * 64;
#pragma unroll
    for (int dt = 0; dt < 4; ++dt) { v2u w; w.x = pk2(Of[dt][0], Of[dt][1]); w.y = pk2(Of[dt][2], Of[dt][3]); *(v2u*)(MIX + 16 * dt + 4 * quad) = w; }
    __syncthreads();
}

#define CB() asm volatile("" ::: "memory")
DI void stage_wave_f32(LAS unsigned char* Kt, LAS unsigned char* Vt, const float* kb, const float* vb, size_t stride, int lane) {
    const int k0 = lane >> 3, ch = lane & 7;
#pragma unroll
    for (int h = 0; h < 4; ++h) {
        const float* src = (h < 2 ? kb : vb); LAS unsigned char* dst = (h < 2 ? Kt : Vt); const int r0 = (h & 1) * 32;
        f32x4 a[4][2];
#pragma unroll
        for (int it = 0; it < 4; ++it) { const float* kp = src + (size_t)(r0 + it * 8 + k0) * stride + ch * 8; a[it][0] = *(const f32x4*)kp; a[it][1] = *(const f32x4*)(kp + 4); }
#pragma unroll
        for (int it = 0; it < 4; ++it) *(LAS v4u*)(dst + (r0 + it * 8 + k0) * 144 + ch * 16) = pack8(a[it][0], a[it][1]);
        asm volatile("" ::: "memory");
    }
}
DI void stage_wave_b16(LAS unsigned char* Kt, LAS unsigned char* Vt, const bf16* kb, const bf16* vb, size_t stride, int nvalid, int lane, bool do_v) {
    const int k0 = lane >> 3, ch = lane & 7;
    const v4u z = (v4u){0u, 0u, 0u, 0u};
#pragma unroll
    for (int it = 0; it < 8; ++it) {
        const int key = it * 8 + k0; const bool v = key < nvalid;
        *(LAS v4u*)(Kt + key * 144 + ch * 16) = v ? *(const v4u*)(kb + key * stride + ch * 8) : z;
        if (do_v) *(LAS v4u*)(Vt + key * 144 + ch * 16) = v ? *(const v4u*)(vb + key * stride + ch * 8) : z;
    }
}
DI void nsa_sample_unit(Frame& F, int layer, int s) {
    int lane = F.lane, wave = F.wave; asm volatile("" : "+v"(lane), "+s"(wave));
    const int quad = lane >> 4, rl = lane & 15;
    const int g = wave & 1, q4 = wave >> 1;
    unsigned char* ws = KWS();
    const bf16* Z = (const bf16*)(ws + WS_Z);
    const float* ZS = (const float*)(ws + WS_ZS);
    LAS unsigned char* Kt = F.lds + wave * 18432; LAS unsigned char* Vt = Kt + 9216;
    LAS float* AIMP = (LAS float*)Vt;
    const int j = rl >> 2, head = 4 * g + (rl & 3), qpos = 2048 + j;
    const size_t row = (size_t)MP + 4 * s + j;
    bf16x8 qf[2];
    qf[0] = ld_frag_g(Z + row * LDZ + ZC_Q + head * 64 + quad * 8); qf[1] = ld_frag_g(Z + row * LDZ + ZC_Q + head * 64 + 32 + quad * 8);
    const float gc = sigmoidf_(ZS[row * 32 + head * 3]), gs = sigmoidf_(ZS[row * 32 + head * 3 + 1]), gw = sigmoidf_(ZS[row * 32 + head * 3 + 2]);
    f32x4 Of[4];
#pragma unroll
    for (int i = 0; i < 4; ++i) Of[i] = (f32x4){0.f, 0.f, 0.f, 0.f};
    AttnState st;
    const bf16* KC = (const bf16*)(ws + WS_KCS) + ((size_t)(0 * 128 + s) * 128 * 2 + g) * 64;
    const bf16* VC = (const bf16*)(ws + WS_KCS) + ((size_t)(1 * 128 + s) * 128 * 2 + g) * 64;
    attn_reset(st);
#pragma unroll 1
    for (int jt = 0; jt < 2; ++jt) {
        stage_wave_b16(Kt, Vt, KC + (size_t)64 * jt * 128, VC + (size_t)64 * jt * 128, 128, 64, lane, true); CB();
        attn_step3(Kt, Vt, qf, st, 0, 126 - 64 * jt, true, rl, quad); CB();
    }
    attn_accum3(Of, st, q4 == 0 ? gc : 0.f, lane);
    {
        const float mfin = st.m * SM_C, lt = attn_rowsum(st, lane), il = lt > 0.f ? 1.f / lt : 0.f;
#pragma unroll 1
        for (int jt = 0; jt < 2; ++jt) {
            stage_wave_b16(Kt, Vt, KC + (size_t)64 * jt * 128, VC, 128, 64, lane, false); CB();
            f32x4 sv[4]; qk_tile(Kt, qf, sv, rl, quad); CB();
#pragma unroll
            for (int kt = 0; kt < 4; ++kt)
#pragma unroll
                for (int i = 0; i < 4; ++i) {
                    const int n = 64 * jt + 16 * kt + 4 * quad + i;
                    float p = (n <= 126) ? __builtin_amdgcn_exp2f(sv[kt][i] * SM_C - mfin) * il : 0.f;
                    p += shx<1>(p, lane); p += shx<2>(p, lane);
                    if ((rl & 3) == 0) AIMP[j * 128 + n] = p;
                }
        }
    }
    CB();
    unsigned long long msk[4];
    {
        unsigned keys[4];
#pragma unroll
        for (int q = 0; q < 4; ++q) {
            float imp = 0.f;
#pragma unroll
            for (int d = -1; d <= 3; ++d) { const int n = 4 * lane + d; if (n >= 0 && n <= 126 && lane < 33) imp += AIMP[q * 128 + n]; }
            const bool forced = (lane == 0) || (lane == 32) || (lane == 31);
            keys[q] = score_key(imp + (forced ? 1000.f : 0.f), lane < 33, lane);
        }
        CB();
        LAS unsigned* KS = (LAS unsigned*)Kt;
#pragma unroll
        for (int q = 0; q < 4; ++q) KS[q * 64 + lane] = keys[q];
        CB();
#pragma unroll
        for (int q = 0; q < 4; ++q) msk[q] = __ballot(lane < 33 && key_rank(KS + q * 64, 9, keys[q]) < 16);
    }
    CB();
    const unsigned long long un = msk[0] | msk[1] | msk[2] | msk[3];
    const unsigned long long mym = j == 0 ? msk[0] : j == 1 ? msk[1] : j == 2 ? msk[2] : msk[3];
    const int* pt = (const int*)KIN(7);
    AttnState sw;
    attn_reset(st); attn_reset(sw);
    {
        unsigned long long word = un; int idx = 0;
        while (word) {
            const int blk = __builtin_ctzll(word); word &= word - 1ull;
            if ((idx++ & 3) != q4) continue;
            if (blk < 32) {
                const int phys = pt[s * 16 + (blk >> 1)];
                const float* base = KIN(2) + ((size_t)(layer * 2560 + phys) * 128 + (blk & 1) * 64) * 512 + g * 64;
                stage_wave_f32(Kt, Vt, base + 256, base + 384, 512, lane); CB();
            } else {
                stage_wave_b16(Kt, Vt, Z + (size_t)(MP + 4 * s) * LDZ + ZC_KS + g * 64, Z + (size_t)(MP + 4 * s) * LDZ + ZC_VS + g * 64, LDZ, 4, lane, true); CB();
            }
            attn_step3(Kt, Vt, qf, st, 0, qpos - 64 * blk, (mym >> blk) & 1ull, rl, quad); CB();
        }
#pragma unroll 1
        for (int jt = 0; jt < 9; ++jt) {
            if ((idx++ & 3) != q4) continue;
            if (jt < 8) { const float* base = KIN(3) + ((size_t)(layer * 128 + s) * 512 + 64 * jt) * 256 + g * 64; stage_wave_f32(Kt, Vt, base, base + 128, 256, lane); CB(); }
            else { stage_wave_b16(Kt, Vt, Z + (size_t)(MP + 4 * s) * LDZ + ZC_KW + g * 64, Z + (size_t)(MP + 4 * s) * LDZ + ZC_VW + g * 64, LDZ, 4, lane, true); CB(); }
            attn_step3(Kt, Vt, qf, sw, j + 1 - 64 * jt, 512 + j - 64 * jt, true, rl, quad); CB();
        }
    }
    int lane2 = lane; asm volatile("" : "+v"(lane2));
    LAS float* X = (LAS float*)(F.lds + wave * 18432);
    {
        const float ls = attn_rowsum(st, lane), lw = attn_rowsum(sw, lane);
        X[0 * 64 + lane2] = st.m; X[1 * 64 + lane2] = ls; X[18 * 64 + lane2] = sw.m; X[19 * 64 + lane2] = lw;
#pragma unroll
        for (int dt = 0; dt < 4; ++dt)
#pragma unroll
            for (int e = 0; e < 4; ++e) { X[(2 + 4 * dt + e) * 64 + lane2] = st.O[dt][e]; X[(20 + 4 * dt + e) * 64 + lane2] = sw.O[dt][e]; }
    }
    __syncthreads();
    if (q4 == 0) {
#pragma unroll
        for (int br = 0; br < 2; ++br) {
            float m[4], l[4];
#pragma unroll
            for (int q = 0; q < 4; ++q) { const LAS float* Y = (const LAS float*)(F.lds + (2 * q + g) * 18432) + br * 18 * 64; m[q] = Y[lane2]; l[q] = Y[64 + lane2]; }
            const float mm = fmaxf(fmaxf(m[0], m[1]), fmaxf(m[2], m[3]));
            float w[4], lt = 0.f;
#pragma unroll
            for (int q = 0; q < 4; ++q) { w[q] = __builtin_amdgcn_exp2f((m[q] - mm) * SM_C); lt += l[q] * w[q]; }
            const float gate = br == 0 ? gs : gw;
            const float sc = lt > 0.f ? gate / lt : 0.f;
#pragma unroll
            for (int q = 0; q < 4; ++q) { const LAS float* Y = (const LAS float*)(F.lds + (2 * q + g) * 18432) + br * 18 * 64; const float wq = w[q] * sc;
#pragma unroll
                for (int dt = 0; dt < 4; ++dt)
#pragma unroll
                    for (int e = 0; e < 4; ++e) Of[dt][e] += Y[(2 + 4 * dt + e) * 64 + lane2] * wq; }
        }
        bf16* MIX = (bf16*)(ws + WS_MIX) + row * 1536 + head * 64;
#pragma unroll
        for (int dt = 0; dt < 4; ++dt) { v2u w2; w2.x = pk2(Of[dt][0], Of[dt][1]); w2.y = pk2(Of[dt][2], Of[dt][3]); *(v2u*)(MIX + 16 * dt + 4 * quad) = w2; }
    }
    __syncthreads();
}
DI void ret_out_unit(Frame& F, int layer, int unit) {
    const int tid = F.tid, lane = F.lane, wave = F.wave, quad = lane >> 4, rl = lane & 15;
    const int b = unit >> 8, h = (unit >> 6) & 3, c = unit & 63;
    const int row0 = b * TP + 128 * c;
    unsigned char* ws = KWS();
    const bf16* Z = (const bf16*)(ws + WS_Z);
    const bf16* QR = (const bf16*)(ws + WS_QR); const bf16* KR = (const bf16*)(ws + WS_KR);
    const bf16* RST = (const bf16*)(ws + WS_RST) + (size_t)unit * 16384;
    LAS unsigned char* LQ = F.lds; LAS unsigned char* LK = F.lds + 34816; LAS unsigned char* LV = F.lds + 69632; LAS unsigned char* LS = F.lds + 104448;
    for (int it = tid; it < 2048; it += NTHREADS) {
        const int j = it >> 4, cc = it & 15;
        *(LAS v4u*)(LQ + j * 272 + cc * 16) = *(const v4u*)(QR + (size_t)(row0 + j) * 512 + h * 128 + cc * 8);
        *(LAS v4u*)(LK + j * 272 + cc * 16) = *(const v4u*)(KR + (size_t)(row0 + j) * 512 + h * 128 + cc * 8);
        *(LAS v4u*)(LS + j * 272 + cc * 16) = *(const v4u*)(RST + (size_t)j * 128 + cc * 8);
        const v4u w = *(const v4u*)(Z + (size_t)(row0 + j) * LDZ + ZC_RQKV + 1024 + h * 128 + cc * 8);
        LAS unsigned char* d = LV + (cc * 8) * 272 + j * 2;
        *(LAS bf16*)(d) = (bf16)(w.x & 0xffff); *(LAS bf16*)(d + 272) = (bf16)(w.x >> 16); *(LAS bf16*)(d + 2 * 272) = (bf16)(w.y & 0xffff); *(LAS bf16*)(d + 3 * 272) = (bf16)(w.y >> 16);
        *(LAS bf16*)(d + 4 * 272) = (bf16)(w.z & 0xffff); *(LAS bf16*)(d + 5 * 272) = (bf16)(w.z >> 16); *(LAS bf16*)(d + 6 * 272) = (bf16)(w.w & 0xffff); *(LAS bf16*)(d + 7 * 272) = (bf16)(w.w >> 16);
    }
    __syncthreads();
    const float lg = ret_lg(h);
    const int il = 16 * wave + rl;
    bf16x8 qb[4];
#pragma unroll
    for (int s = 0; s < 4; ++s) qb[s] = ld_frag_l(LQ + il * 272 + (32 * s + 8 * quad) * 2);
    f32x4 C[8];
    const float qdec = __expf((float)(il + 1) * lg);
#pragma unroll
    for (int dt = 0; dt < 8; ++dt) {
        f32x4 a = (f32x4){0.f, 0.f, 0.f, 0.f};
#pragma unroll
        for (int s = 0; s < 4; ++s) a = mfma16(ld_frag_l(LS + (16 * dt + rl) * 272 + (32 * s + 8 * quad) * 2), qb[s], a);
        C[dt] = a * qdec;
    }
    for (int s2 = 0; s2 <= (wave >> 1); ++s2) {
        f32x4 P[2];
#pragma unroll
        for (int e = 0; e < 2; ++e) {
            const int jt = 2 * s2 + e;
            f32x4 a = (f32x4){0.f, 0.f, 0.f, 0.f};
            if (jt <= wave) {
#pragma unroll
                for (int s = 0; s < 4; ++s) a = mfma16(ld_frag_l(LK + (16 * jt + rl) * 272 + (32 * s + 8 * quad) * 2), qb[s], a);
#pragma unroll
                for (int i = 0; i < 4; ++i) { const int jj = 16 * jt + 4 * quad + i; a[i] = (il >= jj) ? a[i] * __expf((float)(il - jj) * lg) : 0.f; }
            }
            P[e] = a;
        }
        const bf16x8 pb = pack_frag(P[0], P[1]);
#pragma unroll
        for (int dt = 0; dt < 8; ++dt) {
            const LAS unsigned char* vp = LV + (16 * dt + rl) * 272 + (32 * s2 + 4 * quad) * 2;
            C[dt] = mfma16(mk_frag(*(const LAS v2u*)vp, *(const LAS v2u*)(vp + 32)), pb, C[dt]);
        }
    }
    float ss = 0.f;
#pragma unroll
    for (int dt = 0; dt < 8; ++dt) ss += (C[dt][0] * C[dt][0] + C[dt][1] * C[dt][1]) + (C[dt][2] * C[dt][2] + C[dt][3] * C[dt][3]);
    ss += shx<16>(ss, lane); ss += shx<32>(ss, lane);
    const float scl = rsqrtf(ss * (1.f / 128.f) + EPS);
    const size_t row = (size_t)row0 + il;
#pragma unroll
    for (int dt = 0; dt < 8; ++dt) {
        const v2u gwd = *(const v2u*)(Z + row * LDZ + ZC_RG + h * 128 + 16 * dt + 4 * quad);
        v2u w; w.x = pk2(C[dt][0] * scl * siluf_(lo_bf(gwd.x)), C[dt][1] * scl * siluf_(hi_bf(gwd.x))); w.y = pk2(C[dt][2] * scl * siluf_(lo_bf(gwd.y)), C[dt][3] * scl * siluf_(hi_bf(gwd.y)));
        *(v2u*)((bf16*)(ws + WS_MIX) + row * 1536 + 1024 + h * 128 + 16 * dt + 4 * quad) = w;
    }
    __syncthreads();
}
DI void gdn_out_row(Frame& F, int layer, int row) {
    const int lane = F.lane;
    unsigned char* ws = KWS();
    const float* o = (const float*)(ws + WS_OGDN) + (size_t)row * 512 + lane * 8;
    const f32x4 a = *(const f32x4*)o, b = *(const f32x4*)(o + 4);
    float ss = (a[0] * a[0] + a[1] * a[1]) + (a[2] * a[2] + a[3] * a[3]) + (b[0] * b[0] + b[1] * b[1]) + (b[2] * b[2] + b[3] * b[3]);
    ss += shx<1>(ss, lane); ss += shx<2>(ss, lane); ss += shx<4>(ss, lane); ss += shx<8>(ss, lane);
    const float scl = rsqrtf(ss * (1.f / 128.f) + EPS);
    const float* ng = KIN(18) + layer * 128 + (lane & 15) * 8;
    const f32x4 ga = *(const f32x4*)ng, gb = *(const f32x4*)(ng + 4);
    f32x4 za, zb; unpack8(*(const v4u*)((const bf16*)(ws + WS_Z) + (size_t)row * LDZ + ZC_GZ + lane * 8), za, zb);
    f32x4 ra, rb;
#pragma unroll
    for (int e = 0; e < 4; ++e) { ra[e] = a[e] * scl * ga[e] * siluf_(za[e]); rb[e] = b[e] * scl * gb[e] * siluf_(zb[e]); }
    *(v4u*)((bf16*)(ws + WS_MIX) + (size_t)row * 1536 + 512 + lane * 8) = pack8(ra, rb);
}
DI void final_row(Frame& F, int row) {
    const int lane = F.lane;
    const float* x = (const float*)(KWS() + WS_XR) + (size_t)row * DM;
    float* y = (row < MP) ? KOUT() + O_YP + (size_t)row * DM : KOUT() + O_YS + (size_t)(row - MP) * DM;
    f32x4 v[4]; float ss = 0.f;
#pragma unroll
    for (int j = 0; j < 4; ++j) { v[j] = *(const f32x4*)(x + 256 * j + lane * 4); ss += (v[j][0] * v[j][0] + v[j][1] * v[j][1]) + (v[j][2] * v[j][2] + v[j][3] * v[j][3]); }
    const float scl = rsqrtf(wave_sum(ss, lane) * (1.f / DM) + EPS);
#pragma unroll
    for (int j = 0; j < 4; ++j) *(f32x4*)(y + 256 * j + lane * 4) = v[j] * scl * *(const f32x4*)(KIN(26) + 256 * j + lane * 4);
}
template <class Epi>
DI void sgemm_tile(Frame& F, const bf16* A, int lda, const bf16* Bt, int ldb, int K, int row0, int col0, const Epi& E) {
    int lane = F.lane, wave = F.wave; asm volatile("" : "+v"(lane), "+s"(wave));
    const int tid = wave * 64 + lane, quad = lane >> 4, rl = lane & 15;
    const int kper = K >> 3, nks = kper >> 5;
    f32x4 acc[2][4];
#pragma unroll
    for (int rt = 0; rt < 2; ++rt)
#pragma unroll
        for (int ct = 0; ct < 4; ++ct) acc[rt][ct] = (f32x4){0.f, 0.f, 0.f, 0.f};
    const bf16* ap = A + (size_t)(row0 + rl) * lda + wave * kper + quad * 8;
    const bf16* bp = Bt + (size_t)(col0 + rl) * ldb + wave * kper + quad * 8;
#pragma unroll 4
    for (int ks = 0; ks < nks; ++ks) {
        bf16x8 a[2], b[4];
#pragma unroll
        for (int rt = 0; rt < 2; ++rt) a[rt] = ld_frag_g(ap + (size_t)(16 * rt) * lda + ks * 32);
#pragma unroll
        for (int ct = 0; ct < 4; ++ct) b[ct] = ld_frag_g(bp + (size_t)(16 * ct) * ldb + ks * 32);
#pragma unroll
        for (int rt = 0; rt < 2; ++rt)
#pragma unroll
            for (int ct = 0; ct < 4; ++ct) acc[rt][ct] = mfma16(a[rt], b[ct], acc[rt][ct]);
    }
    LAS float* RED = (LAS float*)F.lds;
#pragma unroll
    for (int rt = 0; rt < 2; ++rt)
#pragma unroll
        for (int ct = 0; ct < 4; ++ct)
#pragma unroll
            for (int i = 0; i < 4; ++i) RED[wave * 2176 + (16 * rt + 4 * quad + i) * 68 + 16 * ct + rl] = acc[rt][ct][i];
    __syncthreads();
    const int r = tid >> 4, c4 = (tid & 15) * 4;
    f32x4 v = *(const LAS f32x4*)(RED + r * 68 + c4);
#pragma unroll
    for (int w = 1; w < 8; ++w) v += *(const LAS f32x4*)(RED + w * 2176 + r * 68 + c4);
    E(row0 + r, col0 + c4, v, lane);
    __syncthreads();
}
struct SEpiC {
    const bf16* Z; bf16* G;
    DI void operator()(int row, int col, f32x4 v, int lane) const {
        const v2u gw = *(const v2u*)(Z + (size_t)row * LDZ + ZC_MG + col);
        v[0] *= sigmoidf_(lo_bf(gw.x)); v[1] *= sigmoidf_(hi_bf(gw.x)); v[2] *= sigmoidf_(lo_bf(gw.y)); v[3] *= sigmoidf_(hi_bf(gw.y));
        *(v2u*)(G + (size_t)row * 3072 + col) = pack4(v);
    }
};
struct SEpiRes {
    float* XR; bf16* XG; const float* gvec; float* SS; float* T; int mode;
    DI void operator()(int row, int col, f32x4 v, int lane) const {
        const size_t o = (size_t)row * DM + col;
        if (mode == 1) { *(f32x4*)(T + o) = v; return; }
        f32x4 x = *(const f32x4*)(XR + o);
        if (mode == 2) { const f32x4 t = *(const f32x4*)(T + o);
#pragma unroll
            for (int e = 0; e < 4; ++e) v[e] = t[e] * sigmoidf_(v[e]); }
        x += v;
        *(f32x4*)(XR + o) = x;
        if (XG) { f32x4 y = x; if (gvec) y *= *(const f32x4*)(gvec + col); *(v2u*)(XG + o) = pack4(y); }
        if (SS) { float ssq = (x[0] * x[0] + x[1] * x[1]) + (x[2] * x[2] + x[3] * x[3]);
            ssq += shx<1>(ssq, lane); ssq += shx<2>(ssq, lane); ssq += shx<4>(ssq, lane); ssq += shx<8>(ssq, lane);
            if ((lane & 15) == 0) SS[(size_t)row * 16 + (col >> 6)] = ssq; }
    }
};
struct SEpiUp {
    bf16* H; const float* SS;
    DI void operator()(int row, int col, f32x4 v, int lane) const {
        const f32x4 p0 = *(const f32x4*)(SS + (size_t)row * 16), p1 = *(const f32x4*)(SS + (size_t)row * 16 + 4), p2 = *(const f32x4*)(SS + (size_t)row * 16 + 8), p3 = *(const f32x4*)(SS + (size_t)row * 16 + 12);
        const f32x4 ps = (p0 + p1) + (p2 + p3);
        const float rstd = rsqrtf(((ps[0] + ps[1]) + (ps[2] + ps[3])) * (1.f / DM) + EPS);
#pragma unroll
        for (int e = 0; e < 4; ++e) { const float a = fmaxf(v[e] * rstd, 0.f); v[e] = a * a; }
        *(v2u*)(H + (size_t)row * DFF + col) = pack4(v);
    }
};
#ifndef PH_P0
#define PH_P0 1
#endif
#ifndef PH_A
#define PH_A 1
#endif
#ifndef PH_B0a
#define PH_B0a 1
#endif
#ifndef PH_B0b
#define PH_B0b 1
#endif
#ifndef PH_B0c
#define PH_B0c 1
#endif
#ifndef PH_B0d
#define PH_B0d 1
#endif
#ifndef PH_SCAN
#define PH_SCAN 1
#endif
#ifndef PH_RSCAN
#define PH_RSCAN 1
#endif
#ifndef PH_NSAP
#define PH_NSAP 1
#endif
#ifndef PH_NSAS
#define PH_NSAS 1
#endif
#ifndef PH_B2
#define PH_B2 1
#endif
#ifndef PH_C
#define PH_C 1
#endif
#ifndef PH_XBAR
#define PH_XBAR 0
#endif
#ifndef PH_D
#define PH_D 1
#endif
#ifndef PH_E
#define PH_E 1
#endif
#ifndef PH_F
#define PH_F 1
#endif
#ifndef PH_G1
#define PH_G1 1
#endif
#ifndef PH_G2
#define PH_G2 1
#endif
#ifndef PH_TREG
#define PH_TREG (-1)
#endif
#if PH_TREG >= 0
#define TREG_MARK(r) do { const unsigned long long now_ = __builtin_amdgcn_s_memrealtime(); if ((r) == PH_TREG) tacc_ += now_ - tlast_; tlast_ = now_; } while (0)
#define TREG_SUB(r) do { const unsigned long long now_ = __builtin_amdgcn_s_memrealtime(); if ((r) == PH_TREG) tacc_ += now_ - tsub_; tsub_ = now_; } while (0)
#else
#define TREG_MARK(r) do { } while (0)
#define TREG_SUB(r) do { } while (0)
#endif
struct Args { const void* in[27]; float* out; unsigned char* ws; };
__global__ void __launch_bounds__(NTHREADS, 2) mk_fwd(Args args) {
    extern __shared__ __attribute__((aligned(16))) unsigned char lds_raw[];
    Frame F;
    F.lds = (LAS unsigned char*)lds_raw;
    F.wave = __builtin_amdgcn_readfirstlane((int)threadIdx.x >> 6); F.lane = 0; F.tid = 0;
    F.G = gridDim.x; F.bid = blockIdx.x;
    F.ctl = (gu32*)(KWS() + WS_CTL);
    { const Frame Fp = fresh(F); for (int u = Fp.tid; u < (LDS_BYTES - LDSCTL_OFF) / 4; u += NTHREADS) ((LAS unsigned*)(F.lds + LDSCTL_OFF))[u] = 0u;
      __syncthreads();
      (void)xcd_barrier_post((unsigned*)(F.ctl + CW_BAR), (volatile LAS unsigned*)(F.lds + MISC_OFF) + 8, Fp.tid == 0); }
    const int G = F.G, bid = F.bid;
#if PH_TREG >= 0
    unsigned long long tacc_ = 0ull, tlast_ = __builtin_amdgcn_s_memrealtime(), tsub_ = tlast_;
#endif

        for (int rp_ = 0; rp_ < PH_P0; ++rp_) {
    { Frame Fp = fresh(F); p0_prologue(Fp); }
        }
    GRID_BAR();
    TREG_MARK(0);

    for (int layer = 0; layer < NLAYER; ++layer) {
        for (int rp_ = 0; rp_ < PH_A; ++rp_) {
        {
            const Frame Fg = fresh(F); const int G = Fg.G, bid = Fg.bid;
            unsigned char* ws = KWS();
            pg8::Gemm g{(const bf16*)(ws + WS_XGA), (const bf16*)(ws + WS_WIN + layer * SZ_WIN), MROWS, LDZ, DM, DM, DM, 31, 0};
            pg8::StaticOrder S; S.init(MROWS, LDZ, G, bid);
            epi::EpiA E{(bf16*)(ws + WS_Z), (float*)(ws + WS_ZS), (const float*)(ws + WS_SSA), KOUT(), layer};
            pg8::gemm_phase<epi::EpiA, pg8::StaticOrder, true, true>(Fg.lds, g, S, E, Fg.tid);
        }
        }
        GRID_BAR();
    TREG_MARK(1);
#if PH_TREG >= 0
        tsub_ = __builtin_amdgcn_s_memrealtime();
#endif
        {
            Frame Fp = fresh(F);
            gu32* qhead = F.ctl + CW_QUEUE + 512 * layer + 384;
            volatile LAS int* qslot = (volatile LAS int*)(F.lds + MISC_OFF) + 16;
            constexpr int NI = 5 * 272 * PH_B0d, N2 = 1024 * PH_B0c, N3 = 512 * PH_B0b;
            for (;;) {
                if (Fp.tid == 0) qslot[0] = (int)__hip_atomic_fetch_add(qhead, 1u, __ATOMIC_RELAXED, __HIP_MEMORY_SCOPE_AGENT);
                __syncthreads();
                int it = qslot[0];
                __syncthreads();
                it = __builtin_amdgcn_readfirstlane(it);
                if (it >= NI + N2 + N3) break;
                TREG_SUB(99);
                if (it < NI) { const int k = it / 5, r = it % 5;
                    if (r == 0) compress_job(Fp, layer, k % 272);
                    else if (k < 256 * PH_B0a) gdn_prep_unit(Fp, layer, (4 * k + r - 1) & 1023); }
                else { const int q = it - NI, g3 = q / 3, r3 = q % 3;
                    if (r3 < 2) sample_rec_unit(Fp, layer, (2 * g3 + r3) & 1023); else ret_prep_unit(Fp, layer, g3 & 511); }
                TREG_SUB(it < NI ? ((it % 5) == 0 ? 40 : 41) : (it < NI + N2 ? 42 : 43));
            }
        }
        GRID_BAR();
    TREG_MARK(2);
        {
            Frame Fp = fresh(F);
            gu32* qbase = F.ctl + CW_QUEUE + 512 * layer;
            volatile LAS int* qslot = (volatile LAS int*)(F.lds + MISC_OFF) + 16;
            constexpr int NQ = 8 * PH_SCAN, NS = 128 * PH_NSAS, NR = 32 * PH_RSCAN, NP = 256 * PH_NSAP;
            const int pref = (int)(xb_xcc_id() & 3u);
            for (;;) {
                if (Fp.tid == 0) qslot[1] = (int)__hip_atomic_fetch_add(qbase, 1u, __ATOMIC_RELAXED, __HIP_MEMORY_SCOPE_AGENT);
                __syncthreads();
                int it = qslot[1];
                __syncthreads();
                it = __builtin_amdgcn_readfirstlane(it);
                if (it >= NQ + NR) break;
                TREG_SUB(99);
                if (it < NQ) gdn_scan_chain(Fp, layer, it & 7);
                else ret_scan_part(Fp, layer, (it - NQ) & 31);
                TREG_SUB(it < NQ ? 21 : 23);
            }
            const int when = Fp.bid & 3;
            bool tried = false;
            for (int nu = 0;; ++nu) {
                if (Fp.tid == 0) {
                    int kind = -1, idx = 0;
                    if (!tried && nu >= when) {
                        tried = true;
                        const int a = (int)__hip_atomic_fetch_add(qbase + 320, 1u, __ATOMIC_RELAXED, __HIP_MEMORY_SCOPE_AGENT);
                        if (a < NS) { kind = 4; idx = a; }
                    }
                    if (kind < 0) {
                        for (int k = 0; k < 4 && kind < 0; ++k) { const int s = (pref + k) & 3;
                            if ((int)__hip_atomic_load(qbase + 64 * (1 + s), __ATOMIC_RELAXED, __HIP_MEMORY_SCOPE_AGENT) < NP) {
                                const int r = (int)__hip_atomic_fetch_add(qbase + 64 * (1 + s), 1u, __ATOMIC_RELAXED, __HIP_MEMORY_SCOPE_AGENT);
                                if (r < NP) { kind = s; idx = r; } } }
                    }
                    if (kind < 0) {
                        const int a = (int)__hip_atomic_fetch_add(qbase + 320, 1u, __ATOMIC_RELAXED, __HIP_MEMORY_SCOPE_AGENT);
                        if (a < NS) { kind = 4; idx = a; }
                    }
                    qslot[0] = kind; qslot[1] = idx;
                }
                __syncthreads();
                int kind = qslot[0], it = qslot[1];
                __syncthreads();
                kind = __builtin_amdgcn_readfirstlane(kind); it = __builtin_amdgcn_readfirstlane(it);
                if (kind < 0) break;
                TREG_SUB(99);
                if (kind < 4) nsa_prompt_unit(Fp, layer, (kind << 8) | (255 - (it & 255)));
                else nsa_sample_unit(Fp, layer, it & 127);
                TREG_SUB(kind < 4 ? 20 : 22);
            }
        }
        GRID_BAR();
    TREG_MARK(3);
        for (int rp_ = 0; rp_ < PH_B2; ++rp_) {
        { Frame Fp = fresh(F); for (int u = Fp.bid; u < 512; u += Fp.G) ret_out_unit(Fp, layer, u); }
        { Frame Fp = fresh(F); for (int r = Fp.bid * NWAVES + Fp.wave; r < MROWS; r += Fp.G * NWAVES) gdn_out_row(Fp, layer, r); }
        }
        GRID_BAR();
    TREG_MARK(4);
        for (int rp_ = 0; rp_ < PH_C; ++rp_) {
        {
            const Frame Fg = fresh(F); const int G = Fg.G, bid = Fg.bid;
            unsigned char* ws = KWS();
            pg8::Gemm g{(const bf16*)(ws + WS_MIX), (const bf16*)(ws + WS_WBR + layer * SZ_WBR), MP, 3072, 512, 1536, 512, 2, 1024};
            pg8::StaticOrder S; S.init(MP, 3072, G, bid);
            epi::EpiC E{(const bf16*)(ws + WS_Z), (bf16*)(ws + WS_GATED)};
            pg8::gemm_phase<epi::EpiC, pg8::StaticOrder, true, true>(Fg.lds, g, S, E, Fg.tid);
            TREG_SUB(99);
            {
                Frame Fs = fresh(F); const SEpiC Es{(const bf16*)(ws + WS_Z), (bf16*)(ws + WS_GATED)};
                for (int tl = Fs.bid; tl < 16 * 48; tl += Fs.G) { const int rt = tl & 15, ct = tl >> 4, b = ct >> 4;
                    sgemm_tile(Fs, (const bf16*)(ws + WS_MIX) + b * 512, 1536, (const bf16*)(ws + WS_WBR + layer * SZ_WBR), 512, 512, MP + 32 * rt, 64 * ct, Es); }
            }
            TREG_SUB(31);
        }
        }
        GRID_BAR();
    TREG_MARK(5);
        for (int rp_ = 0; rp_ < PH_D; ++rp_) {
        {
            const Frame Fg = fresh(F); const int G = Fg.G, bid = Fg.bid;
            unsigned char* ws = KWS();
            pg8::Gemm g{(const bf16*)(ws + WS_GATED), (const bf16*)(ws + WS_WO3 + layer * SZ_WO3), MP, DM, 3072, 3072, 3072, 31, 0};
            pg8::StaticOrder S; S.init(MP, DM, G, bid);
            epi::EpiRes E{(float*)(ws + WS_XR), (bf16*)(ws + WS_XGB), KIN(21) + layer * DM, (float*)(ws + WS_SSB), nullptr, (rp_ + 1 < PH_D) ? 3 : 0};
            pg8::gemm_phase<epi::EpiRes, pg8::StaticOrder, true, true>(Fg.lds, g, S, E, Fg.tid);
            TREG_SUB(99);
            if (rp_ + 1 == PH_D) {
                Frame Fs = fresh(F); const SEpiRes Es{(float*)(ws + WS_XR), (bf16*)(ws + WS_XGB), KIN(21) + layer * DM, (float*)(ws + WS_SSB), nullptr, 0};
                for (int tl = Fs.bid; tl < 256; tl += Fs.G) sgemm_tile(Fs, (const bf16*)(ws + WS_GATED), 3072, (const bf16*)(ws + WS_WO3 + layer * SZ_WO3), 3072, 3072, MP + 32 * (tl & 15), 64 * (tl >> 4), Es);
            }
            TREG_SUB(32);
        }
        }
        GRID_BAR();
    TREG_MARK(6);
        for (int rp_ = 0; rp_ < PH_E; ++rp_) {
        {
            const Frame Fg = fresh(F); const int G = Fg.G, bid = Fg.bid;
            unsigned char* ws = KWS();
            pg8::Gemm g{(const bf16*)(ws + WS_XGB), (const bf16*)(ws + WS_WUP + layer * SZ_WUP), MP, DFF, DM, DM, DM, 31, 0};
            pg8::StaticOrder S; S.init(MP, DFF, G, bid);
            epi::EpiUp E{(bf16*)(ws + WS_HMID), (const float*)(ws + WS_SSB)};
            pg8::gemm_phase<epi::EpiUp, pg8::StaticOrder, true, true>(Fg.lds, g, S, E, Fg.tid);
            TREG_SUB(99);
            {
                Frame Fs = fresh(F); const SEpiUp Es{(bf16*)(ws + WS_HMID), (const float*)(ws + WS_SSB)};
                for (int tl = Fs.bid; tl < 16 * 64; tl += Fs.G) sgemm_tile(Fs, (const bf16*)(ws + WS_XGB), DM, (const bf16*)(ws + WS_WUP + layer * SZ_WUP), DM, DM, MP + 32 * (tl & 15), 64 * (tl >> 4), Es);
            }
            TREG_SUB(33);
        }
        }
        GRID_BAR();
    TREG_MARK(7);
        for (int rp_ = 0; rp_ < PH_F; ++rp_) {
        {
            const Frame Fg = fresh(F); const int G = Fg.G, bid = Fg.bid;
            unsigned char* ws = KWS();
            pg8::Gemm g{(const bf16*)(ws + WS_HMID), (const bf16*)(ws + WS_WDN + layer * SZ_WDN), MP, DM, DFF, DFF, DFF, 31, 0};
            pg8::StaticOrder S; S.init(MP, DM, G, bid);
            epi::EpiRes E{(float*)(ws + WS_XR), (bf16*)(ws + WS_XGC), nullptr, nullptr, nullptr, (rp_ + 1 < PH_F) ? 3 : 0};
            pg8::gemm_phase<epi::EpiRes, pg8::StaticOrder, true, true>(Fg.lds, g, S, E, Fg.tid);
            TREG_SUB(99);
            if (rp_ + 1 == PH_F) {
                Frame Fs = fresh(F); const SEpiRes Es{(float*)(ws + WS_XR), (bf16*)(ws + WS_XGC), nullptr, nullptr, nullptr, 0};
                for (int tl = Fs.bid; tl < 256; tl += Fs.G) sgemm_tile(Fs, (const bf16*)(ws + WS_HMID), DFF, (const bf16*)(ws + WS_WDN + layer * SZ_WDN), DFF, DFF, MP + 32 * (tl & 15), 64 * (tl >> 4), Es);
            }
            TREG_SUB(34);
        }
        }
        GRID_BAR();
    TREG_MARK(8);
        for (int rp_ = 0; rp_ < PH_G1; ++rp_) {
        {
            const Frame Fg = fresh(F); const int G = Fg.G, bid = Fg.bid;
            unsigned char* ws = KWS();
            int kple = PLE; asm volatile("" : "+s"(kple));
            pg8::Gemm g{(const bf16*)(ws + WS_P16) + (size_t)layer * MROWS * PLE, (const bf16*)(ws + WS_WPL + layer * SZ_WPL), MP, DM, kple, PLE, PLE, 31, 0};
            pg8::StaticOrder S; S.init(MP, DM, G, bid);
            epi::EpiRes E{nullptr, nullptr, nullptr, nullptr, (float*)(ws + WS_TPLE), 1};
            pg8::gemm_phase<epi::EpiRes, pg8::StaticOrder, true, true>(Fg.lds, g, S, E, Fg.tid);
            TREG_SUB(99);
            {
                Frame Fs = fresh(F); const SEpiRes Es{nullptr, nullptr, nullptr, nullptr, (float*)(ws + WS_TPLE), 1};
                for (int tl = Fs.bid; tl < 256; tl += Fs.G) sgemm_tile(Fs, (const bf16*)(ws + WS_P16) + (size_t)layer * MROWS * PLE, PLE, (const bf16*)(ws + WS_WPL + layer * SZ_WPL), PLE, PLE, MP + 32 * (tl & 15), 64 * (tl >> 4), Es);
            }
            TREG_SUB(35);
        }
        }
        for (int rp_ = 0; rp_ < PH_G2; ++rp_) {
        {
            const Frame Fg = fresh(F); const int G = Fg.G, bid = Fg.bid;
            unsigned char* ws = KWS();
            const bool more = layer + 1 < NLAYER;
            pg8::Gemm g{(const bf16*)(ws + WS_XGC), (const bf16*)(ws + WS_WPG + layer * SZ_WPG), MP, DM, DM, DM, DM, 31, 0};
            pg8::StaticOrder S; S.init(MP, DM, G, bid);
            epi::EpiRes E{(float*)(ws + WS_XR), more ? (bf16*)(ws + WS_XGA) : nullptr, more ? KIN(10) + (layer + 1) * DM : nullptr, more ? (float*)(ws + WS_SSA) : nullptr, (float*)(ws + WS_TPLE), (rp_ + 1 < PH_G2) ? 3 : 2};
            pg8::gemm_phase<epi::EpiRes, pg8::StaticOrder, true, true>(Fg.lds, g, S, E, Fg.tid);
            TREG_SUB(99);
            if (rp_ + 1 == PH_G2) {
                Frame Fs = fresh(F); const SEpiRes Es{(float*)(ws + WS_XR), more ? (bf16*)(ws + WS_XGA) : nullptr, more ? KIN(10) + (layer + 1) * DM : nullptr, more ? (float*)(ws + WS_SSA) : nullptr, (float*)(ws + WS_TPLE), 2};
                for (int tl = Fs.bid; tl < 256; tl += Fs.G) sgemm_tile(Fs, (const bf16*)(ws + WS_XGC), DM, (const bf16*)(ws + WS_WPG + layer * SZ_WPG), DM, DM, MP + 32 * (tl & 15), 64 * (tl >> 4), Es);
            }
            TREG_SUB(36);
        }
        }
        GRID_BAR();
    TREG_MARK(9);
    }
    for (int xb_ = 0; xb_ < PH_XBAR; ++xb_) GRID_BAR();
    { Frame Fp = fresh(F); for (int r = Fp.bid * NWAVES + Fp.wave; r < MROWS; r += Fp.G * NWAVES) final_row(Fp, r); }
    TREG_MARK(10);
#if PH_TREG >= 0
#if defined(PH_GPT) && PH_GPT >= 0
    tacc_ += *(volatile LAS unsigned long long*)(F.lds + LDSCTL_OFF + 448);
#endif
#if defined(PH_NPT) && PH_NPT >= 0
    tacc_ += *(volatile LAS unsigned long long*)(F.lds + LDSCTL_OFF + 464);
#endif
      { const unsigned long long tend_ = __builtin_amdgcn_s_memrealtime() + tacc_; while (__builtin_amdgcn_s_memrealtime() < tend_) __builtin_amdgcn_s_sleep(8); }
#endif
}

extern "C" void kernel_launch(void* const* d_in, const int* in_sizes, int n_in, void* d_out, int out_size, void* d_ws, size_t ws_size, hipStream_t stream) {
    static int grid = 0;
    if (grid == 0) {
        if (n_in != 27 || ws_size < WS_END) { fprintf(stderr, "kernel_launch: unexpected shapes (n_in %d out %d ws %zu, need %zu)\n", n_in, out_size, ws_size, (size_t)WS_END); grid = -1; return; }
        int dev = 0, cus = 0;
        if (hipGetDevice(&dev) != hipSuccess || hipDeviceGetAttribute(&cus, hipDeviceAttributeMultiprocessorCount, dev) != hipSuccess) { grid = -1; return; }
        if (hipFuncSetAttribute((const void*)mk_fwd, hipFuncAttributeMaxDynamicSharedMemorySize, LDS_BYTES) != hipSuccess) { fprintf(stderr, "kernel_launch: hipFuncSetAttribute failed\n"); grid = -1; return; }
        int per_cu = 0;
        if (hipOccupancyMaxActiveBlocksPerMultiprocessor(&per_cu, (const void*)mk_fwd, NTHREADS, LDS_BYTES) != hipSuccess || per_cu < 1) fprintf(stderr, "kernel_launch: occupancy query reports %d\n", per_cu);
        (void)hipGetLastError();
        grid = cus;
    }
    if (grid < 0) return;
    if (hipMemsetAsync((char*)d_ws + WS_CTL, 0, CTL_ZERO_BYTES, stream) != hipSuccess) return;
    Args a{};
    for (int i = 0; i < 27; ++i) a.in[i] = d_in[i];
    a.out = (float*)d_out; a.ws = (unsigned char*)d_ws;
    hipLaunchKernelGGL(mk_fwd, dim3(grid), dim3(NTHREADS), LDS_BYTES, stream, a);
}
```

```cpp
#include <hip/hip_runtime.h>
#include <cstdio>
#include <cstdint>
namespace pg8 {
#define PG8_LAS __attribute__((address_space(3)))
typedef unsigned short bf16_t;
typedef short bf16x8 __attribute__((ext_vector_type(8)));
typedef float f32x4 __attribute__((ext_vector_type(4)));
typedef unsigned u32x4 __attribute__((ext_vector_type(4)));
constexpr int BM = 256, BK = 64, HALF = 128, HTB = HALF * BK * 2  , STAGE_BYTES = 8 * HTB, NXCD = 8, WGM = 8;

__host__ __device__ __forceinline__ int lds_byte(int r, int c) { const int st = (r >> 4) * 2 + (c >> 5), rr = r & 15, cc = c & 31, ob = rr * 64 + cc * 2; return st * 1024 + (ob ^ (((ob >> 9) & 1) << 5)); }
__host__ __device__ __forceinline__ void stage_rc(int b, int& R, int& C) { const int st = b / 1024, sb = b % 1024, swz = sb ^ (((sb >> 9) & 1) << 5); R = (st >> 1) * 16 + swz / 64; C = (st & 1) * 32 + (swz % 64) / 2; }
__host__ __device__ __forceinline__ int perm32(int rho) { const int n = rho >> 4, i = rho & 15; return 8 * (i >> 2) + 4 * n + (i & 3); }

struct Unit { int pm, pn; };
struct Gemm { const bf16_t* A; const bf16_t* Bt; int M, N, K; int lda, ldb; int a_shift, a_off; };

struct StaticOrder {
    int nM, nN, nwg, G, c;
    __host__ __device__ void init(int M, int N, int G_, int c_) { nM = M / BM; nN = N / BM; nwg = nM * nN; G = G_; c = c_; }
    __host__ __device__ bool next(int i, Unit& u) const {
        const long L = (long)i * G + c; if (L >= nwg) return false;
        int wgid = (int)L; { const int q = nwg / NXCD, r = nwg % NXCD, xcd = wgid % NXCD, off = wgid / NXCD; wgid = (xcd < r ? xcd * (q + 1) : r * (q + 1) + (xcd - r) * q) + off; }
        const int nig = WGM * nN, gid = wgid / nig, fm = gid * WGM, gsz = (nM - fm) < WGM ? (nM - fm) : WGM;
        u.pm = fm + ((wgid % nig) % gsz); u.pn = (wgid % nig) / gsz; return true;
    }
    __device__ __forceinline__ void a_ready(const Unit&) const {}
    __device__ __forceinline__ void done(const Unit&) const {}
};

__device__ __forceinline__ unsigned cvt_pk_bf16(float lo, float hi) { unsigned r; asm volatile("v_cvt_pk_bf16_f32 %0, %1, %2" : "=v"(r) : "v"(lo), "v"(hi)); return r; }
typedef float f32x2 __attribute__((ext_vector_type(2)));
template <class Epi, class Sched, bool ALIGN_EPI = false, bool SP2 = false>
__device__ __forceinline__ void gemm_phase(PG8_LAS unsigned char* lds, const Gemm g, const Sched& S, const Epi& E, const int tid) {
    const int wid = __builtin_amdgcn_readfirstlane(tid >> 6), lane = tid & 63, wr = wid >> 2, wc = wid & 3, fr = lane & 15, fq = lane >> 4;
    const int K = g.K, nt = K / BK;
    unsigned voffA[2], voffB[2];
#pragma unroll
    for (int i = 0; i < 2; ++i) { int R, C; stage_rc(tid * 16 + i * 8192, R, C); const int Rb = Epi::PERM ? ((R & ~31) + perm32(R & 31)) : R;
        voffA[i] = (unsigned)(R * g.lda + C) * 2u; voffB[i] = (unsigned)(Rb * g.ldb + C) * 2u; }
    const size_t kstep = (size_t)(BK * 2);
    const size_t hstepA = (size_t)HALF * g.lda * 2, hstepB = (size_t)HALF * g.ldb * 2;
    const size_t tstepA = 2 * hstepA, tstepB = 2 * hstepB;
    const unsigned ldsw = (unsigned)wid * 1024u;
    const int aoff = lds_byte(wr * 64 + fr, fq * 8), boff = lds_byte(wc * 32 + fr, fq * 8);
#define PG8_SA(b, h) (((b) * 2 + (h)) * HTB)
#define PG8_SB(b, h) ((4 + (b) * 2 + (h)) * HTB)
#define PG8_STAGE(bufoff, gbase, voff) do { _Pragma("unroll") for (int _i = 0; _i < 2; ++_i) \
        __builtin_amdgcn_global_load_lds((const unsigned*)((const char*)(gbase) + (voff)[_i]), (PG8_LAS unsigned*)(lds + (bufoff) + ldsw + _i * 8192), 16, 0, 0); } while (0)
#define PG8_LDA(dst, b, h) do { _Pragma("unroll") for (int m = 0; m < 4; ++m) _Pragma("unroll") for (int k = 0; k < 2; ++k) dst[m][k] = *(const PG8_LAS bf16x8*)(lds + PG8_SA(b, h) + aoff + m * 2048 + k * 1024); } while (0)
#define PG8_LDB(dst, b, h) do { _Pragma("unroll") for (int n = 0; n < 2; ++n) _Pragma("unroll") for (int k = 0; k < 2; ++k) dst[n][k] = *(const PG8_LAS bf16x8*)(lds + PG8_SB(b, h) + boff + n * 2048 + k * 1024); } while (0)
#define PG8_MMA(ai, bj, At, Bt) do { __builtin_amdgcn_s_setprio(1); _Pragma("unroll") for (int m = 0; m < 4; ++m) _Pragma("unroll") for (int n = 0; n < 2; ++n) _Pragma("unroll") for (int k = 0; k < 2; ++k) \
        acc[ai][bj][m][n] = __builtin_amdgcn_mfma_f32_16x16x32_bf16(Bt[n][k], At[m][k], acc[ai][bj][m][n], 0, 0, 0); __builtin_amdgcn_s_setprio(0); } while (0)
#define PG8_WAIT_V(n) asm volatile("s_waitcnt vmcnt(" #n ")" ::: "memory")
#define PG8_WAIT_L(n) asm volatile("s_waitcnt lgkmcnt(" #n ")" ::: "memory")
#define PG8_BAR __builtin_amdgcn_s_barrier()
#define PG8_SCHED __builtin_amdgcn_sched_barrier(0)
    Unit cur, nxt; int ui = 0;
    if (!S.next(0, cur)) return;
    f32x4 acc[2][2][4][2];
#pragma unroll
    for (int a = 0; a < 2; ++a)
#pragma unroll
        for (int b = 0; b < 2; ++b)
#pragma unroll
            for (int m = 0; m < 4; ++m)
#pragma unroll
                for (int n = 0; n < 2; ++n) acc[a][b][m][n] = (f32x4){0.f, 0.f, 0.f, 0.f};
    bf16x8 At[4][2], B0[2][2], B1[2][2];
    const char* cA = (const char*)g.A + (size_t)cur.pm * tstepA + (size_t)(cur.pn >> g.a_shift) * (size_t)g.a_off; const char* cB = (const char*)g.Bt + (size_t)cur.pn * tstepB;
    S.a_ready(cur);
    if constexpr (SP2) {
        PG8_STAGE(PG8_SB(0, 0), cB, voffB); PG8_STAGE(PG8_SB(0, 1), cB + hstepB, voffB); PG8_STAGE(PG8_SA(0, 0), cA, voffA); PG8_STAGE(PG8_SA(0, 1), cA + hstepA, voffA);
        if (wr == 1) PG8_BAR;
        PG8_WAIT_V(2); PG8_BAR;
        PG8_STAGE(PG8_SB(1, 0), cB + kstep, voffB); PG8_STAGE(PG8_SA(1, 0), cA + kstep, voffA); PG8_STAGE(PG8_SB(1, 1), cB + hstepB + kstep, voffB);
        PG8_WAIT_V(6); PG8_BAR;
    } else {
        PG8_STAGE(PG8_SB(0, 0), cB, voffB); PG8_STAGE(PG8_SA(0, 0), cA, voffA); PG8_STAGE(PG8_SB(0, 1), cB + hstepB, voffB); PG8_STAGE(PG8_SA(0, 1), cA + hstepA, voffA);
        if (wr == 1) PG8_BAR;
        PG8_WAIT_V(4); PG8_BAR;
        PG8_STAGE(PG8_SB(1, 0), cB + kstep, voffB); PG8_STAGE(PG8_SA(1, 0), cA + kstep, voffA); PG8_STAGE(PG8_SB(1, 1), cB + hstepB + kstep, voffB);
        PG8_WAIT_V(6); PG8_BAR;
    }
    for (;;) {
        const bool has_next = S.next(ui + 1, nxt);
        const char* nA = has_next ? (const char*)g.A + (size_t)nxt.pm * tstepA + (size_t)(nxt.pn >> g.a_shift) * (size_t)g.a_off : cA; const char* nB = has_next ? (const char*)g.Bt + (size_t)nxt.pn * tstepB : cB;
        for (int t = 0; t < nt; t += 2) {
            const bool last = (t == nt - 2);
            const char* a1 = cA + (size_t)(t + 1) * kstep;
            const char* a2 = last ? nA : cA + (size_t)(t + 2) * kstep; const char* b2 = last ? nB : cB + (size_t)(t + 2) * kstep;
            const char* a3 = a2 + kstep; const char* b3 = b2 + kstep;
            if (last && has_next) S.a_ready(nxt);
            if constexpr (SP2) {
            PG8_LDB(B0, 0, 0); PG8_LDB(B1, 0, 1); PG8_SCHED; PG8_LDA(At, 0, 0); PG8_STAGE(PG8_SA(1, 1), a1 + hstepA, voffA);
            PG8_WAIT_V(8); PG8_WAIT_L(0); PG8_BAR; PG8_MMA(0, 0, At, B0); PG8_MMA(0, 1, At, B1); PG8_BAR; PG8_SCHED;
            PG8_LDA(At, 0, 1); PG8_STAGE(PG8_SB(0, 0), b2, voffB); PG8_STAGE(PG8_SB(0, 1), b2 + hstepB, voffB); PG8_STAGE(PG8_SA(0, 0), a2, voffA);
            PG8_WAIT_V(8); PG8_WAIT_L(0); PG8_BAR; PG8_MMA(1, 0, At, B0); PG8_MMA(1, 1, At, B1); PG8_BAR; PG8_SCHED;
            PG8_LDB(B0, 1, 0); PG8_LDB(B1, 1, 1); PG8_SCHED; PG8_LDA(At, 1, 0); PG8_STAGE(PG8_SA(0, 1), a2 + hstepA, voffA);
            PG8_WAIT_V(8); PG8_WAIT_L(0); PG8_BAR; PG8_MMA(0, 0, At, B0); PG8_MMA(0, 1, At, B1); PG8_BAR; PG8_SCHED;
            PG8_LDA(At, 1, 1); PG8_STAGE(PG8_SB(1, 0), b3, voffB); PG8_STAGE(PG8_SB(1, 1), b3 + hstepB, voffB); PG8_STAGE(PG8_SA(1, 0), a3, voffA);
            PG8_WAIT_V(8); PG8_WAIT_L(0); PG8_BAR; PG8_MMA(1, 0, At, B0); PG8_MMA(1, 1, At, B1); PG8_BAR; PG8_SCHED;
            } else {
            PG8_LDB(B0, 0, 0); PG8_SCHED; PG8_LDA(At, 0, 0); PG8_STAGE(PG8_SA(1, 1), a1 + hstepA, voffA);
            PG8_WAIT_L(8); PG8_BAR; PG8_WAIT_L(0); PG8_MMA(0, 0, At, B0); PG8_BAR; PG8_SCHED;
            PG8_LDB(B1, 0, 1); PG8_STAGE(PG8_SB(0, 0), b2, voffB);
            PG8_BAR; PG8_WAIT_L(0); PG8_MMA(0, 1, At, B1); PG8_BAR;
            PG8_LDA(At, 0, 1); PG8_STAGE(PG8_SA(0, 0), a2, voffA);
            PG8_BAR; PG8_WAIT_L(0); PG8_MMA(1, 0, At, B0); PG8_BAR; PG8_SCHED;
            PG8_STAGE(PG8_SB(0, 1), b2 + hstepB, voffB);
            PG8_WAIT_V(6); PG8_BAR; PG8_MMA(1, 1, At, B1); PG8_BAR;
            PG8_LDB(B0, 1, 0); PG8_SCHED; PG8_LDA(At, 1, 0); PG8_STAGE(PG8_SA(0, 1), a2 + hstepA, voffA);
            PG8_WAIT_L(8); PG8_BAR; PG8_WAIT_L(0); PG8_MMA(0, 0, At, B0); PG8_BAR; PG8_SCHED;
            PG8_LDB(B1, 1, 1); PG8_STAGE(PG8_SB(1, 0), b3, voffB);
            PG8_BAR; PG8_WAIT_L(0); PG8_MMA(0, 1, At, B1); PG8_BAR;
            PG8_LDA(At, 1, 1); PG8_STAGE(PG8_SA(1, 0), a3, voffA);
            PG8_BAR; PG8_WAIT_L(0); PG8_MMA(1, 0, At, B0); PG8_BAR; PG8_SCHED;
            PG8_STAGE(PG8_SB(1, 1), b3 + hstepB, voffB);
            PG8_WAIT_V(6); PG8_BAR; PG8_MMA(1, 1, At, B1); PG8_BAR;
            }
        }
        if constexpr (ALIGN_EPI) { if (wr == 0) PG8_BAR; }
        if constexpr (!Epi::AFTER_DRAIN) { E(acc, cur, wr, wc, fr, fq); S.done(cur); }
        if (!has_next) break;
#pragma unroll
        for (int a = 0; a < 2; ++a)
#pragma unroll
            for (int b = 0; b < 2; ++b)
#pragma unroll
                for (int m = 0; m < 4; ++m)
#pragma unroll
                    for (int n = 0; n < 2; ++n) acc[a][b][m][n] = (f32x4){0.f, 0.f, 0.f, 0.f};
        cur = nxt; cA = nA; cB = nB; ++ui;
        if constexpr (ALIGN_EPI) { if (wr == 1) PG8_BAR; }
    }
    PG8_WAIT_V(0);
    if constexpr (!ALIGN_EPI) { if (wr == 0) PG8_BAR; }
    PG8_BAR;
    if constexpr (Epi::AFTER_DRAIN) { E.fused(acc, cur, wr, wc, fr, fq, lds, wid, lane); S.done(cur); }
#undef PG8_SA
#undef PG8_SB
#undef PG8_STAGE
#undef PG8_LDA
#undef PG8_LDB
#undef PG8_MMA
#undef PG8_WAIT_V
#undef PG8_WAIT_L
#undef PG8_BAR
#undef PG8_SCHED
}
}
#define DI __device__ __forceinline__
#define GAS __attribute__((address_space(1)))
#define LAS __attribute__((address_space(3)))
typedef unsigned short bf16;
typedef unsigned v4u __attribute__((ext_vector_type(4)));
typedef unsigned v2u __attribute__((ext_vector_type(2)));
typedef float f32x4 __attribute__((ext_vector_type(4)));
typedef float f32x2 __attribute__((ext_vector_type(2)));
typedef short bf16x8 __attribute__((ext_vector_type(8)));
typedef short s16x4 __attribute__((ext_vector_type(4)));
typedef GAS unsigned gu32;

constexpr int DM = 1024, TP = 8192, MP = 16384, MS = 512, MROWS = 16896, LDZ = 8704, DFF = 4096, PLE = 256, NLAYER = 2;
constexpr int ZC_Q = 0, ZC_KC = 512, ZC_VC = 640, ZC_KS = 768, ZC_VS = 896, ZC_KW = 1024, ZC_VW = 1152, ZC_GQKV = 1280, ZC_GZ = 2816, ZC_RQKV = 3328, ZC_RG = 4864, ZC_MG = 5376, ZC_SM = 8448;
constexpr float EPS = 1e-6f;
constexpr size_t O_YP = 0, O_YS = O_YP + (size_t)MP * DM, O_KVP = O_YS + (size_t)MS * DM, O_KVS = O_KVP + (size_t)2 * MP * 512, O_WINP = O_KVS + (size_t)2 * MS * 512,
                 O_WINS = O_WINP + (size_t)2 * 2 * 512 * 256, O_CVP = O_WINS + (size_t)2 * 128 * 512 * 256, O_CVS = O_CVP + (size_t)2 * 2 * 3 * 1536, O_GSP = O_CVS + (size_t)2 * 128 * 3 * 1536,
                 O_GSS = O_GSP + (size_t)2 * 2 * 4 * 16384, O_RSP = O_GSS + (size_t)2 * 128 * 4 * 16384, O_RSS = O_RSP + (size_t)2 * 2 * 4 * 16384, O_END = O_RSS + (size_t)2 * 128 * 4 * 16384;

DI float bf2f(unsigned short b) { return __uint_as_float((unsigned)b << 16); }
DI unsigned f2bf(float f) { unsigned u = __float_as_uint(f); return (u + 0x7fffu + ((u >> 16) & 1u)) >> 16; }
typedef __bf16 bf16x2_t __attribute__((ext_vector_type(2)));
DI unsigned pk2(float lo, float hi) { const f32x2 v = {lo, hi}; return __builtin_bit_cast(unsigned, __builtin_convertvector(v, bf16x2_t)); }
DI float lo_bf(unsigned w) { return __uint_as_float(w << 16); }
DI float hi_bf(unsigned w) { return __uint_as_float(w & 0xffff0000u); }
DI float sigmoidf_(float x) { return 1.f / (1.f + __expf(-x)); }
DI float siluf_(float x) { return x / (1.f + __expf(-x)); }
DI v4u pack8(const f32x4 a, const f32x4 b) { v4u w; w.x = pk2(a[0], a[1]); w.y = pk2(a[2], a[3]); w.z = pk2(b[0], b[1]); w.w = pk2(b[2], b[3]); return w; }
DI void unpack8(const v4u w, f32x4& a, f32x4& b) { a[0] = lo_bf(w.x); a[1] = hi_bf(w.x); a[2] = lo_bf(w.y); a[3] = hi_bf(w.y); b[0] = lo_bf(w.z); b[1] = hi_bf(w.z); b[2] = lo_bf(w.w); b[3] = hi_bf(w.w); }

template <int M> DI int shxi(int v, int lane) {
    if constexpr (M < 32) return __builtin_amdgcn_ds_swizzle(v, (M << 10) | 0x1f);
    else return __builtin_amdgcn_ds_bpermute((lane ^ 32) << 2, v);
}
template <int M> DI float shx(float v, int lane) { return __int_as_float(shxi<M>(__float_as_int(v), lane)); }
DI float wave_sum(float v, int lane) { v += shx<1>(v, lane); v += shx<2>(v, lane); v += shx<4>(v, lane); v += shx<8>(v, lane); v += shx<16>(v, lane); v += shx<32>(v, lane); return v; }

namespace epi {
using pg8::Unit; using pg8::bf16_t;
DI float row_rstd(const float* SS, int row, int fq, int lane) {
    const f32x4 p = *(const f32x4*)(SS + (size_t)row * 16 + 4 * fq);
    float s = (p[0] + p[1]) + (p[2] + p[3]); s += shx<16>(s, lane); s += shx<32>(s, lane);
    return rsqrtf(s * (1.f / DM) + EPS);
}
struct EpiA {
    static constexpr bool PERM = true, AFTER_DRAIN = false;
    bf16* Z; float* ZS; const float* SS; float* out; int layer;
    DI void operator()(const f32x4 (&acc)[2][2][4][2], const Unit& u, int wr, int wc, int fr, int fq) const {
        asm volatile("" : "+v"(fr), "+v"(fq), "+s"(wr), "+s"(wc));
        const int pn = u.pn;
        float rs[2][4];
#pragma unroll
        for (int ai = 0; ai < 2; ++ai)
#pragma unroll
            for (int m = 0; m < 4; ++m) rs[ai][m] = row_rstd(SS, u.pm * 256 + ai * 128 + wr * 64 + m * 16 + fr, fq, fr + 16 * fq);
#pragma unroll
        for (int ai = 0; ai < 2; ++ai)
#pragma unroll
            for (int m = 0; m < 4; ++m) {
                const int row = u.pm * 256 + ai * 128 + wr * 64 + m * 16 + fr;
                const float rstd = rs[ai][m];
#pragma unroll
                for (int bj = 0; bj < 2; ++bj) {
                    const int col = pn * 256 + bj * 128 + wc * 32 + 8 * fq;
                    const f32x4 v0 = acc[ai][bj][m][0] * rstd, v1 = acc[ai][bj][m][1] * rstd;
                    *(v4u*)(Z + (size_t)row * LDZ + col) = pack8(v0, v1);
                    float* dst = nullptr;
                    if (pn == 2 || pn == 3) {
                        dst = (row < MP) ? out + O_KVP + ((size_t)layer * MP + row) * 512 + (col - 512) : out + O_KVS + ((size_t)layer * MS + (row - MP)) * 512 + (col - 512);
                    } else if (pn == 4) {
                        const int c2 = col - 1024;
                        if (row < MP) { const int t = row & (TP - 1), b = row >> 13; if (t >= TP - 512) dst = out + O_WINP + ((size_t)(layer * 2 + b) * 512 + (t - (TP - 512))) * 256 + c2; }
                        else { const int r2 = row - MP, s = r2 >> 2, j = r2 & 3; dst = out + O_WINS + ((size_t)(layer * 128 + s) * 512 + 508 + j) * 256 + c2; }
                    } else if (pn >= 5 && pn < 11) {
                        const int c2 = col - 1280;
                        if (row < MP) { const int t = row & (TP - 1), b = row >> 13; if (t >= TP - 3) dst = out + O_CVP + ((size_t)(layer * 2 + b) * 3 + (t - (TP - 3))) * 1536 + c2; }
                        else { const int r2 = row - MP, s = r2 >> 2, j = r2 & 3; if (j >= 1) dst = out + O_CVS + ((size_t)(layer * 128 + s) * 3 + (j - 1)) * 1536 + c2; }
                    } else if (pn == 33) {
                        if (bj == 0 && wc == 0) dst = ZS + (size_t)row * 32 + 8 * fq;
                    }
                    if (dst) { *(f32x4*)dst = v0; *(f32x4*)(dst + 4) = v1; }
                }
                asm volatile("" ::: "memory");
            }
    }
};
struct EpiC {
    static constexpr bool PERM = true, AFTER_DRAIN = false;
    const bf16* Z; bf16* G;
    DI void operator()(const f32x4 (&acc)[2][2][4][2], const Unit& u, int wr, int wc, int fr, int fq) const {
        asm volatile("" : "+v"(fr), "+v"(fq), "+s"(wr), "+s"(wc));
#pragma unroll
        for (int ai = 0; ai < 2; ++ai) {
            v4u gw[4][2];
#pragma unroll
            for (int m = 0; m < 4; ++m)
#pragma unroll
                for (int bj = 0; bj < 2; ++bj) gw[m][bj] = *(const v4u*)(Z + (size_t)(u.pm * 256 + ai * 128 + wr * 64 + m * 16 + fr) * LDZ + ZC_MG + u.pn * 256 + bj * 128 + wc * 32 + 8 * fq);
#pragma unroll
            for (int m = 0; m < 4; ++m) {
                const int row = u.pm * 256 + ai * 128 + wr * 64 + m * 16 + fr;
#pragma unroll
                for (int bj = 0; bj < 2; ++bj) {
                    const int col = u.pn * 256 + bj * 128 + wc * 32 + 8 * fq;
                    f32x4 g0, g1; unpack8(gw[m][bj], g0, g1);
                    f32x4 v0 = acc[ai][bj][m][0], v1 = acc[ai][bj][m][1];
#pragma unroll
                    for (int e = 0; e < 4; ++e) { v0[e] *= sigmoidf_(g0[e]); v1[e] *= sigmoidf_(g1[e]); }
                    *(v4u*)(G + (size_t)row * 3072 + col) = pack8(v0, v1);
                }
            }
            asm volatile("" ::: "memory");
        }
    }
};
struct EpiRes {
    static constexpr bool PERM = true, AFTER_DRAIN = false;
    float* XR; bf16* XG; const float* gvec; float* SS; float* T; int mode;
    DI void operator()(const f32x4 (&acc)[2][2][4][2], const Unit& u, int wr, int wc, int fr, int fq) const {
        asm volatile("" : "+v"(fr), "+v"(fq), "+s"(wr), "+s"(wc));
        if (mode == 3) return;
        if (mode == 1) {
#pragma unroll
            for (int ai = 0; ai < 2; ++ai)
#pragma unroll
                for (int m = 0; m < 4; ++m)
#pragma unroll
                    for (int bj = 0; bj < 2; ++bj) { const size_t o = (size_t)(u.pm * 256 + ai * 128 + wr * 64 + m * 16 + fr) * DM + u.pn * 256 + bj * 128 + wc * 32 + 8 * fq;
                        *(f32x4*)(T + o) = acc[ai][bj][m][0]; *(f32x4*)(T + o + 4) = acc[ai][bj][m][1]; }
            return;
        }
#pragma unroll
        for (int ai = 0; ai < 2; ++ai)
#pragma unroll
            for (int mp = 0; mp < 2; ++mp) {
                f32x4 xr[2][2][2], tt[2][2][2];
#pragma unroll
                for (int mm = 0; mm < 2; ++mm)
#pragma unroll
                    for (int bj = 0; bj < 2; ++bj) { const size_t o = (size_t)(u.pm * 256 + ai * 128 + wr * 64 + (2 * mp + mm) * 16 + fr) * DM + u.pn * 256 + bj * 128 + wc * 32 + 8 * fq;
                        xr[mm][bj][0] = *(const f32x4*)(XR + o); xr[mm][bj][1] = *(const f32x4*)(XR + o + 4);
                        if (mode == 2) { tt[mm][bj][0] = *(const f32x4*)(T + o); tt[mm][bj][1] = *(const f32x4*)(T + o + 4); } }
#pragma unroll
                for (int mm = 0; mm < 2; ++mm) {
                    const int m = 2 * mp + mm;
                    const int row = u.pm * 256 + ai * 128 + wr * 64 + m * 16 + fr;
                    float ssq = 0.f;
#pragma unroll
                    for (int bj = 0; bj < 2; ++bj) {
                        const int col = u.pn * 256 + bj * 128 + wc * 32 + 8 * fq;
                        const size_t o = (size_t)row * DM + col;
                        f32x4 a0 = acc[ai][bj][m][0], a1 = acc[ai][bj][m][1];
                        f32x4 x0 = xr[mm][bj][0], x1 = xr[mm][bj][1];
                        if (mode == 2) {
#pragma unroll
                            for (int e = 0; e < 4; ++e) { a0[e] = tt[mm][bj][0][e] * sigmoidf_(a0[e]); a1[e] = tt[mm][bj][1][e] * sigmoidf_(a1[e]); } }
                        x0 += a0; x1 += a1;
                        *(f32x4*)(XR + o) = x0; *(f32x4*)(XR + o + 4) = x1;
                        ssq += (x0[0] * x0[0] + x0[1] * x0[1]) + (x0[2] * x0[2] + x0[3] * x0[3]) + (x1[0] * x1[0] + x1[1] * x1[1]) + (x1[2] * x1[2] + x1[3] * x1[3]);
                        if (XG) { if (gvec) { const f32x4 g0 = *(const f32x4*)(gvec + col), g1 = *(const f32x4*)(gvec + col + 4); x0 *= g0; x1 *= g1; }
                            *(v4u*)(XG + o) = pack8(x0, x1); }
                    }
                    if (SS) { ssq += shx<16>(ssq, fr + 16 * fq); ssq += shx<32>(ssq, fr + 16 * fq); if (fq == 0) SS[(size_t)row * 16 + u.pn * 4 + wc] = ssq; }
                }
                asm volatile("" ::: "memory");
            }
    }
};
struct EpiUp {
    static constexpr bool PERM = true, AFTER_DRAIN = false;
    bf16* H; const float* SS;
    DI void operator()(const f32x4 (&acc)[2][2][4][2], const Unit& u, int wr, int wc, int fr, int fq) const {
        asm volatile("" : "+v"(fr), "+v"(fq), "+s"(wr), "+s"(wc));
        float rs[2][4];
#pragma unroll
        for (int ai = 0; ai < 2; ++ai)
#pragma unroll
            for (int m = 0; m < 4; ++m) rs[ai][m] = row_rstd(SS, u.pm * 256 + ai * 128 + wr * 64 + m * 16 + fr, fq, fr + 16 * fq);
#pragma unroll
        for (int ai = 0; ai < 2; ++ai)
#pragma unroll
            for (int m = 0; m < 4; ++m) {
                const int row = u.pm * 256 + ai * 128 + wr * 64 + m * 16 + fr;
                const float rstd = rs[ai][m];
#pragma unroll
                for (int bj = 0; bj < 2; ++bj) {
                    const int col = u.pn * 256 + bj * 128 + wc * 32 + 8 * fq;
                    f32x4 v0 = acc[ai][bj][m][0] * rstd, v1 = acc[ai][bj][m][1] * rstd;
#pragma unroll
                    for (int e = 0; e < 4; ++e) { const float a = fmaxf(v0[e], 0.f), b = fmaxf(v1[e], 0.f); v0[e] = a * a; v1[e] = b * b; }
                    *(v4u*)(H + (size_t)row * DFF + col) = pack8(v0, v1);
                }
                asm volatile("" ::: "memory");
            }
    }
};
}
constexpr size_t al256(size_t x) { return (x + 255) & ~(size_t)255; }
constexpr size_t WS_CTL = 0, CTL_ZERO_BYTES = 1u << 20;
constexpr size_t SZ_WIN = (size_t)LDZ * DM * 2, SZ_WBR = (size_t)3072 * 512 * 2, SZ_WO3 = (size_t)DM * 3072 * 2, SZ_WUP = (size_t)DFF * DM * 2, SZ_WDN = (size_t)DM * DFF * 2,
                 SZ_WPL = (size_t)DM * PLE * 2, SZ_WPG = (size_t)DM * DM * 2, SZ_W1T = (size_t)2 * 64 * 2048 * 2, SZ_W2T = (size_t)2 * 64 * 64 * 2;
constexpr size_t WS_WIN = CTL_ZERO_BYTES, WS_WBR = WS_WIN + 2 * SZ_WIN, WS_WO3 = WS_WBR + 2 * SZ_WBR, WS_WUP = WS_WO3 + 2 * SZ_WO3, WS_WDN = WS_WUP + 2 * SZ_WUP,
                 WS_WPL = WS_WDN + 2 * SZ_WDN, WS_WPG = WS_WPL + 2 * SZ_WPL, WS_W1T = WS_WPG + 2 * SZ_WPG, WS_W2T = WS_W1T + 2 * SZ_W1T, WS_ROT = al256(WS_W2T + 2 * SZ_W2T);
constexpr size_t WS_P16 = WS_ROT + (size_t)TP * 64 * 8;
constexpr size_t WS_XR = WS_P16 + (size_t)2 * MROWS * PLE * 2;
constexpr size_t WS_XGA = WS_XR + (size_t)MROWS * DM * 4, WS_XGB = WS_XGA + (size_t)MROWS * DM * 2, WS_XGC = WS_XGB + (size_t)MROWS * DM * 2;
constexpr size_t WS_SSA = WS_XGC + (size_t)MROWS * DM * 2, WS_SSB = WS_SSA + (size_t)MROWS * 64;
constexpr size_t WS_Z = WS_SSB + (size_t)MROWS * 64, WS_ZS = WS_Z + (size_t)MROWS * LDZ * 2;
constexpr size_t WS_MIX = WS_ZS + (size_t)MROWS * 128, WS_GATED = WS_MIX + (size_t)MROWS * 1536 * 2, WS_HMID = WS_GATED + (size_t)MROWS * 3072 * 2;
constexpr size_t WS_TPLE = WS_HMID + (size_t)MROWS * DFF * 2;
constexpr size_t WS_KC = WS_TPLE + (size_t)MROWS * DM * 4;
constexpr size_t WS_KCS = WS_KC + (size_t)2 * 2 * 512 * 2 * 64 * 2;
constexpr int GREC = 73984;
constexpr size_t WS_GREC = WS_KCS + (size_t)2 * 128 * 128 * 2 * 64 * 2;
constexpr size_t WS_OGDN = WS_GREC + (size_t)1024 * GREC;
constexpr size_t WS_RKV = WS_OGDN + (size_t)MROWS * 512 * 4;
constexpr size_t WS_RST = WS_RKV + (size_t)512 * 16384 * 4;
constexpr size_t WS_QR = WS_RST + (size_t)512 * 16384 * 2, WS_KR = WS_QR + (size_t)MP * 512 * 2;
constexpr size_t WS_END = WS_KR + (size_t)MP * 512 * 2;
static_assert(WS_W1T % 256 == 0 && WS_Z % 256 == 0 && WS_GREC % 256 == 0 && WS_RKV % 256 == 0 && WS_KC % 256 == 0 && WS_XR % 256 == 0, "ws alignment");

constexpr int CW_TMO = 0, CW_BAR = 4096, CW_QUEUE = 8192;
constexpr int NWAVES = 8, NTHREADS = 512;
constexpr int RING_BYTES = 147456, LDSCTL_OFF = RING_BYTES, MISC_OFF = LDSCTL_OFF + 320, LDS_BYTES = RING_BYTES + 1024;

#define RLX_AGENT __ATOMIC_RELAXED, __HIP_MEMORY_SCOPE_AGENT
#define LDS_WAIT() asm volatile("s_waitcnt lgkmcnt(0)" ::: "memory")
#define VM_WAIT() asm volatile("s_waitcnt vmcnt(0)" ::: "memory")
#define XB_TMO      128
#define XB_XCNT(j)  (256  + 64 * (j))
#define XB_XSUB(j)  (1280 + 64 * (j))
#define XB_XGEN(j)  (2304 + 64 * (j))
#define XB_TOP      3328
#define XB_TOPGEN   3392
#define XCD_BAR_WORDS 3456
#define XB_SPIN_CAP (1u << 18)

__device__ __forceinline__ unsigned xb_ld(unsigned* p)              { return __hip_atomic_load(p, __ATOMIC_RELAXED, __HIP_MEMORY_SCOPE_AGENT); }
__device__ __forceinline__ unsigned xb_add(unsigned* p, unsigned v) { return __hip_atomic_fetch_add(p, v, __ATOMIC_RELAXED, __HIP_MEMORY_SCOPE_AGENT); }
__device__ __forceinline__ unsigned xb_xcc_id() { return (unsigned)__builtin_amdgcn_s_getreg((3 << 11) | 20) & 0xFu; }
#define XB_SPIN(cond, bar) do { unsigned _sp = 0; while (cond) { __builtin_amdgcn_s_sleep(1); \
    if ((++_sp & 255u) == 0u) { if (xb_ld(&(bar)[XB_TMO])) break; if (_sp > XB_SPIN_CAP) { atomicAdd(&(bar)[XB_TMO], 1u); break; } } } } while (0)

struct XcdBarrier {
    unsigned* bar; unsigned x;
    volatile LAS unsigned* st;
};

__device__ __forceinline__ XcdBarrier xcd_barrier_post(unsigned* bar, volatile LAS unsigned* st, bool t0) {
    XcdBarrier b; b.bar = bar; b.x = xb_xcc_id(); b.st = st;
    if (t0) (void)xb_add(&bar[XB_XCNT(b.x)], 1u);
    return b;
}
__device__ __forceinline__ void xcd_barrier_complete(unsigned* bar, unsigned x, unsigned& nloc, unsigned& nx) {
    const unsigned G = gridDim.x * gridDim.y * gridDim.z;
    unsigned sum, cnt, mine, sp = 0u;
    for (;;) {
        sum = 0u; cnt = 0u; mine = 0u;
#pragma unroll
        for (unsigned j = 0; j < 16; ++j) { const unsigned c = xb_ld(&bar[XB_XCNT(j)]); sum += c; cnt += (c > 0u) ? 1u : 0u; mine = (j == x) ? c : mine; }
        if (sum == G) break;
        __builtin_amdgcn_s_sleep(1);
        if ((++sp & 255u) == 0u) { if (xb_ld(&bar[XB_TMO])) break; if (sp > XB_SPIN_CAP) { atomicAdd(&bar[XB_TMO], 1u); break; } }
    }
    nloc = mine > 0u ? mine : 1u; nx = cnt > 0u ? cnt : 1u;
}

__device__ __forceinline__ void xcd_barrier(const XcdBarrier& b, bool t0) {
    asm volatile("s_waitcnt vmcnt(0)" ::: "memory");
    __syncthreads();
    if (t0) {
        unsigned* bar = b.bar;
        __builtin_amdgcn_s_waitcnt(0);
        unsigned nloc = b.st[0], nx = b.st[1];
        if (nloc == 0u) { xcd_barrier_complete(bar, b.x, nloc, nx); b.st[0] = nloc; b.st[1] = nx; }
        const unsigned old = xb_add(&bar[XB_XSUB(b.x)], 1u);
        const unsigned gen = old / nloc;
        if (old + 1u == (gen + 1u) * nloc) {
            __builtin_amdgcn_fence(__ATOMIC_RELEASE, "agent");
            asm volatile("s_waitcnt vmcnt(0)" ::: "memory");
            const unsigned og = xb_add(&bar[XB_TOP], 1u);
            const unsigned tg = og / nx;
            if (og + 1u == (tg + 1u) * nx) xb_add(&bar[XB_TOPGEN], 1u);
            else XB_SPIN(xb_ld(&bar[XB_TOPGEN]) == tg, bar);
            __builtin_amdgcn_fence(__ATOMIC_ACQUIRE, "agent");
            xb_add(&bar[XB_XGEN(b.x)], 1u);
            asm volatile("s_waitcnt vmcnt(0)" ::: "memory");
        } else {
            XB_SPIN(xb_ld(&bar[XB_XGEN(b.x)]) == gen, bar);
            __builtin_amdgcn_fence(__ATOMIC_ACQUIRE, "agent");
            asm volatile("s_waitcnt vmcnt(0)" ::: "memory");
        }
    }
    __syncthreads();
}
typedef const void* const __attribute__((address_space(4)))* kargp_t;
DI const float* KIN(int i) { const GAS float* p = (const GAS float*)((kargp_t)__builtin_amdgcn_kernarg_segment_ptr())[i]; asm volatile("" : "+s"(p)); return (const float*)p; }
DI float* KOUT() { GAS float* p = (GAS float*)((kargp_t)__builtin_amdgcn_kernarg_segment_ptr())[27]; asm volatile("" : "+s"(p)); return (float*)p; }
DI unsigned char* KWS() { GAS unsigned char* p = (GAS unsigned char*)((kargp_t)__builtin_amdgcn_kernarg_segment_ptr())[28]; asm volatile("" : "+s"(p)); return (unsigned char*)p; }
struct Frame {
    LAS unsigned char* lds;
    gu32* ctl;
    int tid, lane, wave, G, bid;
};
DI bf16x8 ld_frag_g(const bf16* p) { return __builtin_bit_cast(bf16x8, *(const v4u*)p); }
DI bf16x8 ld_frag_l(const LAS unsigned char* p) { return *(const LAS bf16x8*)p; }
DI f32x4 mfma16(bf16x8 a, bf16x8 b, f32x4 c) { return __builtin_amdgcn_mfma_f32_16x16x32_bf16(a, b, c, 0, 0, 0); }
DI bf16x8 pack_frag(const f32x4 a, const f32x4 b) { return __builtin_bit_cast(bf16x8, pack8(a, b)); }
DI int lane_id() { int l; asm volatile("v_mbcnt_lo_u32_b32 %0, -1, 0\n\tv_mbcnt_hi_u32_b32 %0, -1, %0" : "=v"(l)); return l; }
DI Frame fresh(const Frame& F0) {
    Frame F = F0; int w = F0.wave, g = F0.G, b = F0.bid; asm volatile("" : "+s"(w), "+s"(g), "+s"(b));
    int l = lane_id(); asm volatile("" : "+v"(l));
    unsigned lb = (unsigned)(uintptr_t)F0.lds; asm volatile("" : "+s"(lb)); F.lds = (LAS unsigned char*)(uintptr_t)lb;
    F.wave = w; F.lane = l; F.tid = w * 64 + l; F.G = g; F.bid = b; return F;
}
#define GRID_BAR() do { XcdBarrier b_; b_.bar = (unsigned*)((gu32*)(KWS() + WS_CTL) + CW_BAR); b_.x = xb_xcc_id(); b_.st = (volatile LAS unsigned*)(F.lds + MISC_OFF) + 8; \
    const Frame Fb_ = fresh(F); xcd_barrier(b_, Fb_.tid == 0); } while (0)
DI int win_colmap(int j) {
    if (j < 1280) return j; if (j < 2816) return j + 24; if (j < 8448) return j + 32; if (j < 8472) return j - 8448 + 1280; if (j < 8480) return j - 8472 + 2840; return -1;
}
DI void tr_item(const float* W, int ldw, int k0, int srccol, bf16* WT, size_t dst_row0, int ldt, int kdst0, int nrep, int krep, LAS float* scr, int lane) {
#pragma unroll 8
    for (int i = 0; i < 32; ++i) { const int kk = 2 * i + (lane >> 5); const float v_ = W[(size_t)(k0 + kk) * ldw + (srccol >= 0 ? srccol : 0)]; scr[kk * 33 + (lane & 31)] = (srccol >= 0) ? v_ : 0.f; }
    LDS_WAIT(); asm volatile("" ::: "memory");
    const int c = lane & 7;
#pragma unroll
    for (int j = 0; j < 4; ++j) { const int n = (lane >> 3) + 8 * j; const LAS float* s = scr + (8 * c) * 33 + n;
        v4u o; o.x = pk2(s[0 * 33], s[1 * 33]); o.y = pk2(s[2 * 33], s[3 * 33]); o.z = pk2(s[4 * 33], s[5 * 33]); o.w = pk2(s[6 * 33], s[7 * 33]);
        for (int r = 0; r < nrep; ++r) *(v4u*)(WT + (dst_row0 + n) * (size_t)ldt + kdst0 + r * krep + 8 * c) = o; }
    LDS_WAIT(); asm volatile("" ::: "memory");
}
DI void p0_prologue(Frame& F) {
    LAS float* scr = (LAS float*)(F.lds + F.wave * 16384);
    const int gw = F.bid * NWAVES + F.wave, NGW = F.G * NWAVES, lane = F.lane;
    unsigned char* ws = KWS();
    constexpr int I_A = 16 * 272, I_B = 3 * 8 * 32, I_C = 16 * 32, I_D = 16 * 128, I_E = 64 * 32, I_F = 4 * 32, I_G = 16 * 32, I_H = 2 * 32 * 2, I_I = 2 * 2;
    constexpr int I_L = I_A + I_B + I_C + I_D + I_E + I_F + I_G + I_H + I_I;
    for (int it = gw; it < 2 * I_L; it += NGW) {
        const int l = it / I_L; int r = it % I_L;
        if (r < I_A) { const int kb = r / 272, nb = r % 272; tr_item(KIN(11) + (size_t)l * DM * 8480, 8480, 64 * kb, win_colmap(32 * nb + (lane & 31)), (bf16*)(ws + WS_WIN + l * SZ_WIN), 32 * nb, DM, 64 * kb, 1, 0, scr, lane); continue; } r -= I_A;
        if (r < I_B) { const int b = r / 256, kb = (r % 256) / 32, nb = r % 32; tr_item(KIN(19) + (size_t)(l * 3 + b) * 512 * DM, DM, 64 * kb, 32 * nb + (lane & 31), (bf16*)(ws + WS_WBR + l * SZ_WBR), b * 1024 + 32 * nb, 512, 64 * kb, 1, 0, scr, lane); continue; } r -= I_B;
        if (r < I_C) { const int kb = r / 32, nb = r % 32; tr_item(KIN(20) + (size_t)l * DM * DM, DM, 64 * kb, 32 * nb + (lane & 31), (bf16*)(ws + WS_WO3 + l * SZ_WO3), 32 * nb, 3072, 64 * kb, 3, 1024, scr, lane); continue; } r -= I_C;
        if (r < I_D) { const int kb = r / 128, nb = r % 128; tr_item(KIN(22) + (size_t)l * DM * DFF, DFF, 64 * kb, 32 * nb + (lane & 31), (bf16*)(ws + WS_WUP + l * SZ_WUP), 32 * nb, DM, 64 * kb, 1, 0, scr, lane); continue; } r -= I_D;
        if (r < I_E) { const int kb = r / 32, nb = r % 32; tr_item(KIN(23) + (size_t)l * DFF * DM, DM, 64 * kb, 32 * nb + (lane & 31), (bf16*)(ws + WS_WDN + l * SZ_WDN), 32 * nb, DFF, 64 * kb, 1, 0, scr, lane); continue; } r -= I_E;
        if (r < I_F) { const int kb = r / 32, nb = r % 32; tr_item(KIN(24) + (size_t)l * PLE * DM, DM, 64 * kb, 32 * nb + (lane & 31), (bf16*)(ws + WS_WPL + l * SZ_WPL), 32 * nb, PLE, 64 * kb, 1, 0, scr, lane); continue; } r -= I_F;
        if (r < I_G) { const int kb = r / 32, nb = r % 32; tr_item(KIN(25) + (size_t)l * DM * DM, DM, 64 * kb, 32 * nb + (lane & 31), (bf16*)(ws + WS_WPG + l * SZ_WPG), 32 * nb, DM, 64 * kb, 1, 0, scr, lane); continue; } r -= I_G;
        if (r < I_H) { const int kv = r / 64, kb = (r % 64) / 2, nb = r % 2; tr_item(KIN(13) + (size_t)(l * 2 + kv) * 2048 * 64, 64, 64 * kb, 32 * nb + (lane & 31), (bf16*)(ws + WS_W1T + l * SZ_W1T) + (size_t)kv * 64 * 2048, 32 * nb, 2048, 64 * kb, 1, 0, scr, lane); continue; } r -= I_H;
        { const int kv = r / 2, nb = r % 2; tr_item(KIN(14) + (size_t)(l * 2 + kv) * 64 * 64, 64, 0, 32 * nb + (lane & 31), (bf16*)(ws + WS_W2T + l * SZ_W2T) + (size_t)kv * 64 * 64, 32 * nb, 64, 0, 1, 0, scr, lane); }
    }
    float* XR = (float*)(ws + WS_XR); bf16* XGA = (bf16*)(ws + WS_XGA); float* SSA = (float*)(ws + WS_SSA); bf16* P16 = (bf16*)(ws + WS_P16);
    const float* g0 = KIN(10);
    for (int row = gw; row < MROWS; row += NGW) {
        const float* xs = (row < MP) ? KIN(0) + (size_t)row * DM : KIN(1) + (size_t)(row - MP) * DM;
        float ss = 0.f;
#pragma unroll
        for (int j = 0; j < 2; ++j) {
            const int c = j * 512 + lane * 8;
            f32x4 a = *(const f32x4*)(xs + c), b = *(const f32x4*)(xs + c + 4);
            *(f32x4*)(XR + (size_t)row * DM + c) = a; *(f32x4*)(XR + (size_t)row * DM + c + 4) = b;
            ss += (a[0] * a[0] + a[1] * a[1]) + (a[2] * a[2] + a[3] * a[3]) + (b[0] * b[0] + b[1] * b[1]) + (b[2] * b[2] + b[3] * b[3]);
            const f32x4 ga = *(const f32x4*)(g0 + c), gb = *(const f32x4*)(g0 + c + 4);
            *(v4u*)(XGA + (size_t)row * DM + c) = pack8(a * ga, b * gb);
        }
        ss = wave_sum(ss, lane);
        if (lane < 16) SSA[(size_t)row * 16 + lane] = (lane == 0) ? ss : 0.f;
#pragma unroll
        for (int l = 0; l < 2; ++l) {
            const float* ps = (row < MP) ? KIN(8) + ((size_t)l * MP + row) * PLE : KIN(9) + ((size_t)l * MS + (row - MP)) * PLE;
            const f32x4 a = *(const f32x4*)(ps + lane * 4);
            v2u o; o.x = pk2(a[0], a[1]); o.y = pk2(a[2], a[3]);
            *(v2u*)(P16 + ((size_t)l * MROWS + row) * PLE + lane * 4) = o;
        }
    }
    const int gt = F.bid * NTHREADS + F.tid, NGT = F.G * NTHREADS;
    f32x2* ROT = (f32x2*)(ws + WS_ROT);
    for (int e = gt; e < TP * 64; e += NGT) {
        const int pos = e >> 6, i = e & 63;
        const float x = (float)i * (1.0f / 63.0f);
        const float inv = exp2f(-x * 13.287712379549449f);
        const float ang = (float)pos * inv;
        const double rev = (double)ang * 0.15915494309189535;
        const float fr = (float)(rev - floor(rev));
        ROT[e] = (f32x2){__builtin_amdgcn_cosf(fr), __builtin_amdgcn_sinf(fr)};
    }
}
DI float gelu_tanh(float x) { const float u = 0.7978845608028654f * (x + 0.044715f * x * x * x); const float e = __expf(2.f * u); return 0.5f * x * (1.f + (1.f - 2.f / (e + 1.f))); }
DI bf16x8 mk_frag(v2u a, v2u b) { v4u w; w.x = a.x; w.y = a.y; w.z = b.x; w.w = b.y; return __builtin_bit_cast(bf16x8, w); }

template <bool sample> DI void compress_job_t(Frame& F, int layer, int job) {
    int lane = F.lane, wave = F.wave; asm volatile("" : "+v"(lane), "+s"(wave));
    const int tid = wave * 64 + lane, quad = lane >> 4, rl = lane & 15;
    unsigned char* ws = KWS();
    int kv, bs, g0, nbase;
    if (sample) { kv = job >> 7; bs = job & 127; g0 = 0; nbase = 0; }
    else { const int j2 = job - 256; kv = j2 >> 3; bs = (j2 >> 2) & 1; g0 = (j2 >> 1) & 1; nbase = (j2 & 1) * 256; }
    const bf16* W1T = (const bf16*)(ws + WS_W1T + layer * SZ_W1T) + (size_t)kv * 64 * 2048;
    const bf16* W2T = (const bf16*)(ws + WS_W2T + layer * SZ_W2T) + (size_t)kv * 64 * 64;
    const float* pe = KIN(12) + (size_t)(layer * 2 + kv) * 32 * 64;
    const bf16* Z = (const bf16*)(ws + WS_Z);
    const int* pt = (const int*)KIN(7);
    const float* cache = KIN(2);
    LAS unsigned char* LW = F.lds;
    int gg[2], nn[2];
    size_t pb0[2], pb1[2];
#pragma unroll
    for (int tl = 0; tl < 2; ++tl) { const int T = 2 * wave + tl; if (sample) { gg[tl] = T >> 3; nn[tl] = 16 * (T & 7) + rl; } else { gg[tl] = g0; nn[tl] = nbase + 16 * T + rl; }
        pb0[tl] = 0; pb1[tl] = 0;
        if (sample) { const int p0 = (16 * nn[tl]) >> 7; const int p1 = p0 + 1 > 15 ? 15 : p0 + 1;
            pb0[tl] = (size_t)(layer * 2560 + pt[bs * 16 + p0]) * 128 * 512; pb1[tl] = (size_t)(layer * 2560 + pt[bs * 16 + p1]) * 128 * 512; } }
    f32x4 h[2][4];
#pragma unroll
    for (int tl = 0; tl < 2; ++tl)
#pragma unroll
        for (int i = 0; i < 4; ++i) h[tl][i] = (f32x4){0.f, 0.f, 0.f, 0.f};
#pragma unroll 1
    for (int c = 0; c < 4; ++c) {
        __syncthreads();
#pragma unroll
        for (int k = 0; k < 8; ++k) { const int pc = tid + 512 * k, r = pc >> 6, c16 = pc & 63;
            *(LAS v4u*)(LW + r * 1040 + c16 * 16) = *(const v4u*)(W1T + (size_t)r * 2048 + c * 512 + c16 * 8); }
        __syncthreads();
#pragma unroll 8
        for (int kk = 0; kk < 16; ++kk) {
            const int j = 8 * c + (kk >> 1), dim0 = (kk & 1) * 32 + quad * 8;
            const f32x4 pe0 = *(const f32x4*)(pe + j * 64 + dim0), pe1 = *(const f32x4*)(pe + j * 64 + dim0 + 4);
            bf16x8 xb[2];
#pragma unroll
            for (int tl = 0; tl < 2; ++tl) {
                f32x4 x0, x1;
                if (!sample) { const size_t row = (size_t)bs * TP + 16 * nn[tl] + j; unpack8(*(const v4u*)(Z + row * LDZ + ZC_KC + kv * 128 + gg[tl] * 64 + dim0), x0, x1); }
                else { int pos = 16 * nn[tl] + j; pos = pos > 2047 ? 2047 : pos;
                    const float* p = cache + (((pos >> 7) == ((16 * nn[tl]) >> 7)) ? pb0[tl] : pb1[tl]) + (size_t)(pos & 127) * 512 + kv * 128 + gg[tl] * 64 + dim0; x0 = *(const f32x4*)p; x1 = *(const f32x4*)(p + 4); }
                xb[tl] = pack_frag(x0 + pe0, x1 + pe1);
            }
#pragma unroll
            for (int ht = 0; ht < 4; ++ht) {
                const bf16x8 a = ld_frag_l(LW + (16 * ht + rl) * 1040 + (kk * 32 + quad * 8) * 2);
                h[0][ht] = mfma16(a, xb[0], h[0][ht]); h[1][ht] = mfma16(a, xb[1], h[1][ht]);
            }
        }
    }
#pragma unroll
    for (int tl = 0; tl < 2; ++tl) {
#pragma unroll
        for (int ht = 0; ht < 4; ++ht)
#pragma unroll
            for (int i = 0; i < 4; ++i) h[tl][ht][i] = gelu_tanh(h[tl][ht][i]);
        bf16x8 gb[2]; gb[0] = pack_frag(h[tl][0], h[tl][1]); gb[1] = pack_frag(h[tl][2], h[tl][3]);
        const int n = nn[tl], g = gg[tl];
        bf16* dst = sample ? (bf16*)(ws + WS_KCS) + ((((size_t)kv * 128 + bs) * 128 + n) * 2 + g) * 64 : (bf16*)(ws + WS_KC) + ((((size_t)kv * 2 + bs) * 512 + n) * 2 + g) * 64;
        const bool zero = sample && n == 127;
#pragma unroll
        for (int ot = 0; ot < 4; ++ot) {
            f32x4 o = (f32x4){0.f, 0.f, 0.f, 0.f};
#pragma unroll
            for (int s = 0; s < 2; ++s) {
                const bf16* wp = W2T + (16 * ot + rl) * 64 + 32 * s + 4 * quad;
                o = mfma16(mk_frag(*(const v2u*)wp, *(const v2u*)(wp + 16)), gb[s], o);
            }
            v2u w; w.x = zero ? 0u : pk2(o[0], o[1]); w.y = zero ? 0u : pk2(o[2], o[3]);
            *(v2u*)(dst + 16 * ot + 4 * quad) = w;
        }
    }
    __syncthreads();
}

DI v2u pack4(const f32x4 v) { v2u w; w.x = pk2(v[0], v[1]); w.y = pk2(v[2], v[3]); return w; }
DI void compress_sample_job(Frame& F, int layer, int job) {
    int lane = F.lane, wave = F.wave; asm volatile("" : "+v"(lane), "+s"(wave));
    const int tid = wave * 64 + lane, quad = lane >> 4, rl = lane & 15;
    unsigned char* ws = KWS();
    const int kv = job >> 7, bs = job & 127;
    const bf16* W1T = (const bf16*)(ws + WS_W1T + layer * SZ_W1T) + (size_t)kv * 64 * 2048;
    const bf16* W2T = (const bf16*)(ws + WS_W2T + layer * SZ_W2T) + (size_t)kv * 64 * 64;
    const float* pe = KIN(12) + (size_t)(layer * 2 + kv) * 32 * 64;
    const int* pt = (const int*)KIN(7);
    const float* cache = KIN(2);
    LAS unsigned char* XS = F.lds;
    LAS unsigned char* WS1 = F.lds + 69632;
    size_t toff[8];
#pragma unroll
    for (int k = 0; k < 8; ++k) { const int q = tid + 512 * k, m = q >> 5; const int pos = 16 * m; const int phys = pt[bs * 16 + (pos >> 7)];
        toff[k] = ((size_t)(layer * 2560 + phys) * 128 + (pos & 127)) * 512 + kv * 128 + 4 * (q & 31); }
    const int wr_ = tid >> 3, wc_ = tid & 7;
    int gg[2], nn[2];
#pragma unroll
    for (int tl = 0; tl < 2; ++tl) { const int T = 2 * wave + tl; gg[tl] = T >> 3; nn[tl] = 16 * (T & 7) + rl; }
    f32x4 h[2][4];
#pragma unroll
    for (int tl = 0; tl < 2; ++tl)
#pragma unroll
        for (int i = 0; i < 4; ++i) h[tl][i] = (f32x4){0.f, 0.f, 0.f, 0.f};
    f32x4 xr[8]; v4u wr2[2];
#define CS_ISSUE(r_) do { _Pragma("unroll") for (int k = 0; k < 8; ++k) xr[k] = *(const f32x4*)(cache + toff[k] + (size_t)(r_) * 512); \
        _Pragma("unroll") for (int u = 0; u < 2; ++u) wr2[u] = *(const v4u*)(W1T + (size_t)wr_ * 2048 + ((r_) + 16 * u) * 64 + wc_ * 8); } while (0)
    CS_ISSUE(0);
#pragma unroll 1
    for (int r = 0; r < 16; ++r) {
        __syncthreads();
#pragma unroll
        for (int k = 0; k < 8; ++k) { const int q = tid + 512 * k, m = q >> 5, c = q & 31, d = 4 * (c & 15);
#pragma unroll
            for (int u = 0; u < 2; ++u) { const f32x4 v = xr[k] + *(const f32x4*)(pe + (r + 16 * u) * 64 + d);
                *(LAS v2u*)(XS + u * 34816 + m * 272 + c * 8) = pack4(v); } }
#pragma unroll
        for (int u = 0; u < 2; ++u) *(LAS v4u*)(WS1 + u * 9216 + wr_ * 144 + wc_ * 16) = wr2[u];
        __syncthreads();
        { const int rn = r + 1 < 16 ? r + 1 : 15; CS_ISSUE(rn); }
#pragma unroll
        for (int u = 0; u < 2; ++u)
#pragma unroll
            for (int ks = 0; ks < 2; ++ks) {
                bf16x8 xb[2];
#pragma unroll
                for (int tl = 0; tl < 2; ++tl) { int m = nn[tl] + u; m = m > 127 ? 127 : m; xb[tl] = ld_frag_l(XS + u * 34816 + m * 272 + gg[tl] * 128 + ks * 64 + quad * 16); }
#pragma unroll
                for (int ht = 0; ht < 4; ++ht) { const bf16x8 a = ld_frag_l(WS1 + u * 9216 + (16 * ht + rl) * 144 + ks * 64 + quad * 16);
                    h[0][ht] = mfma16(a, xb[0], h[0][ht]); h[1][ht] = mfma16(a, xb[1], h[1][ht]); }
            }
    }
#undef CS_ISSUE
#pragma unroll
    for (int tl = 0; tl < 2; ++tl) {
#pragma unroll
        for (int ht = 0; ht < 4; ++ht)
#pragma unroll
            for (int i = 0; i < 4; ++i) h[tl][ht][i] = gelu_tanh(h[tl][ht][i]);
        bf16x8 gb[2]; gb[0] = pack_frag(h[tl][0], h[tl][1]); gb[1] = pack_frag(h[tl][2], h[tl][3]);
        const int n = nn[tl], g = gg[tl];
        bf16* dst = (bf16*)(ws + WS_KCS) + ((((size_t)kv * 128 + bs) * 128 + n) * 2 + g) * 64;
        const bool zero = n == 127;
#pragma unroll
        for (int ot = 0; ot < 4; ++ot) {
            f32x4 o = (f32x4){0.f, 0.f, 0.f, 0.f};
#pragma unroll
            for (int s = 0; s < 2; ++s) {
                const bf16* wp = W2T + (16 * ot + rl) * 64 + 32 * s + 4 * quad;
                o = mfma16(mk_frag(*(const v2u*)wp, *(const v2u*)(wp + 16)), gb[s], o);
            }
            v2u w; w.x = zero ? 0u : pk2(o[0], o[1]); w.y = zero ? 0u : pk2(o[2], o[3]);
            *(v2u*)(dst + 16 * ot + 4 * quad) = w;
        }
    }
    __syncthreads();
}
DI void compress_job(Frame& F, int layer, int job) { if (job < 256) compress_sample_job(F, layer, job); else compress_job_t<false>(F, layer, job); }
#ifndef PH_GPT
#define PH_GPT (-1)
#endif
#if PH_GPT >= 0
#define GP_T(k) do { if (tid == 0) { volatile LAS unsigned long long* gp_ = (volatile LAS unsigned long long*)(F.lds + LDSCTL_OFF + 448); const unsigned long long now_ = __builtin_amdgcn_s_memrealtime(); \
    if ((k) == PH_GPT) gp_[0] += now_ - gp_[1]; gp_[1] = now_; } } while (0)
#else
#define GP_T(k) do { } while (0)
#endif
DI int kperm(int idx) { const int s = idx >> 5, r = idx & 31; return 32 * s + 8 * ((r >> 2) & 3) + 4 * (r >> 4) + (r & 3); }
DI float softplusf_(float x) { return x > 20.f ? x : __logf(1.f + __expf(x)); }
DI float ret_lg(int h) { return h == 0 ? -0.031748697f : h == 1 ? -0.015748357f : h == 2 ? -0.007843178f : -0.0039138994f; }

DI void gdn_prep_unit(Frame& F, int layer, int unit) {
    int lane = F.lane, wave = F.wave; asm volatile("" : "+v"(lane), "+s"(wave));
    const int tid = wave * 64 + lane;
    const int b = unit >> 9, h = (unit >> 7) & 3, c = unit & 127;
    const int row0 = b * TP + 64 * c, t0 = 64 * c;
    GP_T(0);
    unsigned char* ws = KWS();
    const bf16* Z = (const bf16*)(ws + WS_Z);
    const float* ZS = (const float*)(ws + WS_ZS);
    LAS float* Lq = (LAS float*)(F.lds); LAS float* Lk = (LAS float*)(F.lds + 33792); LAS float* Lv = (LAS float*)(F.lds + 67584);
    LAS float* LA = (LAS float*)(F.lds + 101376); LAS float* LQK = (LAS float*)(F.lds + 117760);
    LAS float* Lg = (LAS float*)(F.lds + 134144); LAS float* Lb = Lg + 64; LAS float* Le = Lg + 128;
    const float* cw = KIN(15) + (size_t)layer * 4 * 1536;
    {
        v4u xs[6][4];
#pragma unroll
        for (int it0 = 0; it0 < 6; ++it0) {
            const int it = tid + it0 * NTHREADS, i = it / 48, ch = it % 48, col = (ch >> 4) * 512 + h * 128 + (ch & 15) * 8;
#pragma unroll
            for (int j = 0; j < 4; ++j) { const bool ok = (t0 + i - 3 + j) >= 0; xs[it0][j] = *(const v4u*)(Z + (size_t)(ok ? row0 + i - 3 + j : row0) * LDZ + ZC_GQKV + col); }
        }
        asm volatile("" ::: "memory");
#pragma unroll
        for (int it0 = 0; it0 < 6; ++it0) {
            const int it = tid + it0 * NTHREADS, i = it / 48, ch = it % 48, part = ch >> 4, cc = ch & 15;
            const int col = part * 512 + h * 128 + cc * 8;
            f32x4 y0 = (f32x4){0.f, 0.f, 0.f, 0.f}, y1 = y0;
#pragma unroll
            for (int j = 0; j < 4; ++j) {
                const float zf = ((t0 + i - 3 + j) >= 0) ? 1.f : 0.f;
                f32x4 x0, x1; unpack8(xs[it0][j], x0, x1);
                y0 += x0 * (*(const f32x4*)(cw + j * 1536 + col) * zf); y1 += x1 * (*(const f32x4*)(cw + j * 1536 + col + 4) * zf);
            }
#pragma unroll
            for (int e = 0; e < 4; ++e) { y0[e] = siluf_(y0[e]); y1[e] = siluf_(y1[e]); }
            LAS float* dst = (part == 0 ? Lq : part == 1 ? Lk : Lv) + i * 132 + cc * 8;
            *(LAS f32x4*)dst = y0; *(LAS f32x4*)(dst + 4) = y1;
        }
    }
    __syncthreads();
    GP_T(1);
    {
        float va[16], vb[16], ps[16];
#pragma unroll
        for (int q = 0; q < 16; ++q) { LAS float* vp = ((q < 8) ? Lq : Lk) + (wave * 8 + (q & 7)) * 132 + lane * 2; va[q] = vp[0]; vb[q] = vp[1]; ps[q] = va[q] * va[q] + vb[q] * vb[q]; }
#pragma unroll
        for (int q = 0; q < 16; ++q) ps[q] += shx<1>(ps[q], lane);
#pragma unroll
        for (int q = 0; q < 16; ++q) ps[q] += shx<2>(ps[q], lane);
#pragma unroll
        for (int q = 0; q < 16; ++q) ps[q] += shx<4>(ps[q], lane);
#pragma unroll
        for (int q = 0; q < 16; ++q) ps[q] += shx<8>(ps[q], lane);
#pragma unroll
        for (int q = 0; q < 16; ++q) ps[q] += shx<16>(ps[q], lane);
#pragma unroll
        for (int q = 0; q < 16; ++q) ps[q] += shx<32>(ps[q], lane);
#pragma unroll
        for (int q = 0; q < 16; ++q) { LAS float* vp = ((q < 8) ? Lq : Lk) + (wave * 8 + (q & 7)) * 132 + lane * 2; const float sc = rsqrtf(ps[q] + EPS) * ((q < 8) ? 0.08838834764831845f : 1.f); vp[0] = va[q] * sc; vp[1] = vb[q] * sc; }
    }
    if (wave == 0) {
        const float ga = ZS[(size_t)(row0 + lane) * 32 + 24 + h], gbv = ZS[(size_t)(row0 + lane) * 32 + 28 + h];
        float g = -__expf(KIN(16)[layer * 4 + h]) * softplusf_(ga + KIN(17)[layer * 4 + h]);
#pragma unroll
        for (int o = 1; o < 64; o <<= 1) { const float t = __int_as_float(__builtin_amdgcn_ds_bpermute(((lane - o) & 63) << 2, __float_as_int(g))); if (lane >= o) g += t; }
        Lg[lane] = g; Lb[lane] = sigmoidf_(gbv); Le[lane] = __expf(g);
    }
    __syncthreads();
    GP_T(2);
    {
        const int it = wave >> 1, quad = lane >> 4, rl = lane & 15;
        f32x4 ckk[2], cqk[2];
#pragma unroll
        for (int jj = 0; jj < 2; ++jj) { ckk[jj] = (f32x4){0.f, 0.f, 0.f, 0.f}; cqk[jj] = ckk[jj]; }
#pragma unroll
        for (int s = 0; s < 4; ++s) {
            const LAS float* kp = Lk + (16 * it + rl) * 132 + 32 * s + 8 * quad; const LAS float* qp = Lq + (16 * it + rl) * 132 + 32 * s + 8 * quad;
            const f32x4 ka0 = *(const LAS f32x4*)kp, ka1 = *(const LAS f32x4*)(kp + 4), qa0 = *(const LAS f32x4*)qp, qa1 = *(const LAS f32x4*)(qp + 4);
            const bf16x8 kah = pack_frag(ka0, ka1), qah = pack_frag(qa0, qa1);
            f32x4 h0, h1; unpack8(__builtin_bit_cast(v4u, kah), h0, h1); const bf16x8 kal = pack_frag(ka0 - h0, ka1 - h1);
            unpack8(__builtin_bit_cast(v4u, qah), h0, h1); const bf16x8 qal = pack_frag(qa0 - h0, qa1 - h1);
#pragma unroll
            for (int jj = 0; jj < 2; ++jj) {
                const int jt = (wave & 1) * 2 + jj;
                if (jt <= it) {
                    const LAS float* bp = Lk + (16 * jt + rl) * 132 + 32 * s + 8 * quad;
                    const f32x4 kb0 = *(const LAS f32x4*)bp, kb1 = *(const LAS f32x4*)(bp + 4);
                    const bf16x8 kbh = pack_frag(kb0, kb1); unpack8(__builtin_bit_cast(v4u, kbh), h0, h1); const bf16x8 kbl = pack_frag(kb0 - h0, kb1 - h1);
                    ckk[jj] = mfma16(kah, kbh, ckk[jj]); ckk[jj] = mfma16(kah, kbl, ckk[jj]); ckk[jj] = mfma16(kal, kbh, ckk[jj]);
                    cqk[jj] = mfma16(qah, kbh, cqk[jj]); cqk[jj] = mfma16(qah, kbl, cqk[jj]); cqk[jj] = mfma16(qal, kbh, cqk[jj]);
                }
            }
        }
#pragma unroll
        for (int jj = 0; jj < 2; ++jj) {
            const int j = 16 * ((wave & 1) * 2 + jj) + rl; const float gj = Lg[j];
#pragma unroll
            for (int e = 0; e < 4; ++e) { const int i = 16 * it + 4 * quad + e; const float dec = (i >= j) ? __expf(Lg[i] - gj) : 0.f;
                LA[i * 64 + j] = (i > j) ? Lb[i] * ckk[jj][e] * dec : 0.f; LQK[i * 64 + j] = cqk[jj][e] * dec; }
        }
    }
    __syncthreads();
    GP_T(3);
    unsigned char* rec = ws + WS_GREC + (size_t)unit * GREC;
    LAS float* TI = (LAS float*)(F.lds + 135168);
    if (tid < 64) {
        const int B = tid >> 4, c = tid & 15;
        float tc[16];
#pragma unroll
        for (int i = 0; i < 16; ++i) {
            float s0 = (i == c) ? 1.f : 0.f;
#pragma unroll
            for (int j = 0; j < i; ++j) s0 -= LA[(16 * B + i) * 64 + 16 * B + j] * tc[j];
            tc[i] = s0;
        }
#pragma unroll
        for (int i = 0; i < 16; ++i) TI[B * 256 + i * 16 + c] = tc[i];
    }
    {
        const float gl = Lg[63];
        for (int it = tid; it < 2560; it += NTHREADS) {
            if (it < 1024) {
                const int i = it >> 4, s = (it >> 2) & 3, quad = it & 3; const float e = Le[i];
                const f32x4 a = *(const LAS f32x4*)(Lq + i * 132 + 32 * s + 4 * quad) * e, bq = *(const LAS f32x4*)(Lq + i * 132 + 32 * s + 16 + 4 * quad) * e;
                *(v4u*)(rec + 16384 + i * 256 + (32 * s + 8 * quad) * 2) = pack8(a, bq);
            } else if (it < 2048) {
                const int r = it - 1024, dk = r >> 3, s2 = (r >> 2) & 1, quad = r & 3;
                f32x4 a, bq;
#pragma unroll
                for (int e = 0; e < 4; ++e) { const int ta = 32 * s2 + 4 * quad + e, tb = ta + 16; a[e] = Lk[ta * 132 + dk] * __expf(gl - Lg[ta]); bq[e] = Lk[tb * 132 + dk] * __expf(gl - Lg[tb]); }
                *(v4u*)(rec + 32768 + dk * 128 + (32 * s2 + 8 * quad) * 2) = pack8(a, bq);
            } else {
                const int r = it - 2048, i = r >> 3, s2 = (r >> 2) & 1, quad = r & 3;
                const f32x4 a = *(const LAS f32x4*)(LQK + i * 64 + 32 * s2 + 4 * quad), bq = *(const LAS f32x4*)(LQK + i * 64 + 32 * s2 + 16 + 4 * quad);
                *(v4u*)(rec + 65536 + i * 128 + (32 * s2 + 8 * quad) * 2) = pack8(a, bq);
            }
        }
        if (tid == 0) *(float*)(rec + 73728) = __expf(gl);
    }
    __syncthreads();
    GP_T(4);
    {
        const int col = tid & 255, hb = tid >> 8;
        LAS float* X = (col < 128) ? (Lv + col) : (Lk + (col - 128));
        const bool isw = col >= 128;
#pragma unroll 1
        for (int B = 0; B < 4; ++B) {
            float xb[8];
#pragma unroll
            for (int i = 0; i < 8; ++i) { const int r = 16 * B + 8 * hb + i; xb[i] = (isw ? Lb[r] * Le[r] : Lb[r]) * X[r * 132]; }
#pragma unroll 2
            for (int j4 = 0; j4 < 4 * B; ++j4) {
                const float x0 = X[(4 * j4) * 132], x1 = X[(4 * j4 + 1) * 132], x2 = X[(4 * j4 + 2) * 132], x3 = X[(4 * j4 + 3) * 132];
#pragma unroll
                for (int i = 0; i < 8; ++i) { const f32x4 a = *(const LAS f32x4*)(LA + (16 * B + 8 * hb + i) * 64 + 4 * j4); xb[i] -= (a[0] * x0 + a[1] * x1) + (a[2] * x2 + a[3] * x3); }
            }
#pragma unroll
            for (int i = 0; i < 8; ++i) X[(16 * B + 8 * hb + i) * 132] = xb[i];
            __syncthreads();
            float r[16];
#pragma unroll
            for (int jj = 0; jj < 16; ++jj) r[jj] = X[(16 * B + jj) * 132];
            __syncthreads();
#pragma unroll
            for (int i = 0; i < 8; ++i) {
                float s0 = 0.f, s1 = 0.f;
#pragma unroll
                for (int j4 = 0; j4 < 4; ++j4) { const f32x4 a = *(const LAS f32x4*)(TI + B * 256 + (8 * hb + i) * 16 + 4 * j4);
                    s0 += a[0] * r[4 * j4] + a[2] * r[4 * j4 + 2]; s1 += a[1] * r[4 * j4 + 1] + a[3] * r[4 * j4 + 3]; }
                X[(16 * B + 8 * hb + i) * 132] = s0 + s1;
            }
            __syncthreads();
        }
    }
    __syncthreads();
    GP_T(5);
    for (int it = tid; it < 2048; it += NTHREADS) {
        if (it < 1024) {
            const int dv = it >> 3, q = it & 7;
            v4u w; w.x = pk2(Lv[(8 * q) * 132 + dv], Lv[(8 * q + 1) * 132 + dv]); w.y = pk2(Lv[(8 * q + 2) * 132 + dv], Lv[(8 * q + 3) * 132 + dv]);
            w.z = pk2(Lv[(8 * q + 4) * 132 + dv], Lv[(8 * q + 5) * 132 + dv]); w.w = pk2(Lv[(8 * q + 6) * 132 + dv], Lv[(8 * q + 7) * 132 + dv]);
            *(v4u*)(rec + 49152 + dv * 128 + q * 16) = w;
        } else {
            const int r = it - 1024, i = r >> 4, s = (r >> 2) & 3, quad = r & 3;
            const f32x4 a = *(const LAS f32x4*)(Lk + i * 132 + 32 * s + 4 * quad), bq = *(const LAS f32x4*)(Lk + i * 132 + 32 * s + 16 + 4 * quad);
            *(v4u*)(rec + i * 256 + (32 * s + 8 * quad) * 2) = pack8(a, bq);
        }
    }
    __syncthreads();
    GP_T(6);
}

DI void ret_prep_unit(Frame& F, int layer, int unit) {
    int lane = F.lane, wave = F.wave; asm volatile("" : "+v"(lane), "+s"(wave));
    const int tid = wave * 64 + lane, quad = lane >> 4, rl = lane & 15;
    const int b = unit >> 8, h = (unit >> 6) & 3, c = unit & 63;
    const int row0 = b * TP + 128 * c;
    unsigned char* ws = KWS();
    const bf16* Z = (const bf16*)(ws + WS_Z);
    const f32x2* ROT = (const f32x2*)(ws + WS_ROT);
    bf16* QR = (bf16*)(ws + WS_QR); bf16* KR = (bf16*)(ws + WS_KR);
    LAS unsigned char* LK = F.lds; LAS unsigned char* LV = F.lds + 34816;
    const float lg = ret_lg(h);
    for (int it = tid; it < 1024; it += NTHREADS) {
        const int j = it >> 3, cc = it & 7, d0 = cc * 8;
        const size_t zr = (size_t)(row0 + j) * LDZ + ZC_RQKV + h * 128 + d0;
        f32x4 q1a, q1b, q2a, q2b, k1a, k1b, k2a, k2b;
        unpack8(*(const v4u*)(Z + zr), q1a, q1b); unpack8(*(const v4u*)(Z + zr + 64), q2a, q2b);
        unpack8(*(const v4u*)(Z + zr + 512), k1a, k1b); unpack8(*(const v4u*)(Z + zr + 512 + 64), k2a, k2b);
        const f32x2* rp = ROT + (size_t)(128 * c + j) * 64 + d0;
        const float kd = __expf((float)(127 - j) * lg);
        f32x4 oq1a, oq1b, oq2a, oq2b, ok1a, ok1b, ok2a, ok2b;
#pragma unroll
        for (int e = 0; e < 8; ++e) {
            const f32x2 cs = rp[e];
            const float q1 = e < 4 ? q1a[e & 3] : q1b[e & 3], q2 = e < 4 ? q2a[e & 3] : q2b[e & 3], k1 = e < 4 ? k1a[e & 3] : k1b[e & 3], k2 = e < 4 ? k2a[e & 3] : k2b[e & 3];
            const float rq1 = q1 * cs.x - q2 * cs.y, rq2 = q2 * cs.x + q1 * cs.y, rk1 = (k1 * cs.x - k2 * cs.y) * 0.08838834764831845f, rk2 = (k2 * cs.x + k1 * cs.y) * 0.08838834764831845f;
            if (e < 4) { oq1a[e & 3] = rq1; oq2a[e & 3] = rq2; ok1a[e & 3] = rk1; ok2a[e & 3] = rk2; } else { oq1b[e & 3] = rq1; oq2b[e & 3] = rq2; ok1b[e & 3] = rk1; ok2b[e & 3] = rk2; }
            *(LAS bf16*)(LK + (d0 + e) * 272 + j * 2) = (bf16)f2bf(rk1 * kd); *(LAS bf16*)(LK + (d0 + 64 + e) * 272 + j * 2) = (bf16)f2bf(rk2 * kd);
        }
        const size_t orow = (size_t)(row0 + j) * 512 + h * 128 + d0;
        *(v4u*)(QR + orow) = pack8(oq1a, oq1b); *(v4u*)(QR + orow + 64) = pack8(oq2a, oq2b);
        *(v4u*)(KR + orow) = pack8(ok1a, ok1b); *(v4u*)(KR + orow + 64) = pack8(ok2a, ok2b);
    }
    for (int it = tid; it < 2048; it += NTHREADS) {
        const int j = it >> 4, cc = it & 15;
        const v4u w = *(const v4u*)(Z + (size_t)(row0 + j) * LDZ + ZC_RQKV + 1024 + h * 128 + cc * 8);
        LAS unsigned char* d = LV + (cc * 8) * 272 + j * 2;
        *(LAS bf16*)(d) = (bf16)(w.x & 0xffff); *(LAS bf16*)(d + 272) = (bf16)(w.x >> 16); *(LAS bf16*)(d + 2 * 272) = (bf16)(w.y & 0xffff); *(LAS bf16*)(d + 3 * 272) = (bf16)(w.y >> 16);
        *(LAS bf16*)(d + 4 * 272) = (bf16)(w.z & 0xffff); *(LAS bf16*)(d + 5 * 272) = (bf16)(w.z >> 16); *(LAS bf16*)(d + 6 * 272) = (bf16)(w.w & 0xffff); *(LAS bf16*)(d + 7 * 272) = (bf16)(w.w >> 16);
    }
    __syncthreads();
    float* RKV = (float*)(ws + WS_RKV) + (size_t)unit * 16384;
#pragma unroll
    for (int nt = 0; nt < 8; ++nt) {
        f32x4 acc = (f32x4){0.f, 0.f, 0.f, 0.f};
#pragma unroll
        for (int s = 0; s < 4; ++s) acc = mfma16(ld_frag_l(LK + (16 * wave + rl) * 272 + (32 * s + 8 * quad) * 2), ld_frag_l(LV + (16 * nt + rl) * 272 + (32 * s + 8 * quad) * 2), acc);
#pragma unroll
        for (int i = 0; i < 4; ++i) RKV[(size_t)(16 * wave + 4 * quad + i) * 128 + 16 * nt + rl] = acc[i];
    }
    __syncthreads();
}
DI void sample_rec_unit(Frame& F, int layer, int unit) {
    int lane = F.lane, wave = F.wave; asm volatile("" : "+v"(lane), "+s"(wave));
    const int tid = wave * 64 + lane;
    const int kind = unit >> 9, s = (unit >> 2) & 127, h = unit & 3;
    const int dv = tid & 127, part = tid >> 7, r0 = MP + 4 * s;
    unsigned char* ws = KWS();
    const bf16* Z = (const bf16*)(ws + WS_Z);
    const float* ZS = (const float*)(ws + WS_ZS);
    LAS float* Lq = (LAS float*)(F.lds); LAS float* Lk = Lq + 512; LAS float* Lv = Lq + 1024; LAS float* red = Lq + 1536; LAS float* Lo = Lq + 2048; LAS float* sc = Lq + 2560;
    float S[32];
    if (kind == 0) {
        if (tid < 384) {
            const int pr = tid >> 7, d = tid & 127, col = pr * 512 + h * 128 + d;
            float xp[7], w[4];
#pragma unroll
            for (int i = 0; i < 3; ++i) xp[i] = KIN(4)[((size_t)(layer * 128 + s) * 3 + i) * 1536 + col];
#pragma unroll
            for (int j = 0; j < 4; ++j) xp[3 + j] = bf2f(Z[(size_t)(r0 + j) * LDZ + ZC_GQKV + col]);
#pragma unroll
            for (int i = 0; i < 4; ++i) w[i] = KIN(15)[(size_t)(layer * 4 + i) * 1536 + col];
            LAS float* dst = pr == 0 ? Lq : pr == 1 ? Lk : Lv;
#pragma unroll
            for (int j = 0; j < 4; ++j) dst[j * 128 + d] = siluf_(w[0] * xp[j] + w[1] * xp[j + 1] + w[2] * xp[j + 2] + w[3] * xp[j + 3]);
        }
        __syncthreads();
        {
            LAS float* vp = (wave < 4 ? Lq : Lk) + (wave & 3) * 128;
            const float a = vp[2 * lane], b = vp[2 * lane + 1];
            const float scl = rsqrtf(wave_sum(a * a + b * b, lane) + EPS) * (wave < 4 ? 0.08838834764831845f : 1.f);
            vp[2 * lane] = a * scl; vp[2 * lane + 1] = b * scl;
        }
        if (tid < 4) {
            const float ga = ZS[(size_t)(r0 + tid) * 32 + 24 + h], gb = ZS[(size_t)(r0 + tid) * 32 + 28 + h];
            sc[tid] = __expf(-__expf(KIN(16)[layer * 4 + h]) * softplusf_(ga + KIN(17)[layer * 4 + h])); sc[4 + tid] = sigmoidf_(gb);
        }
        __syncthreads();
        const float* Sin = KIN(5) + ((size_t)((layer * 128 + s) * 4 + h) * 128 + 32 * part) * 128 + dv;
#pragma unroll
        for (int i = 0; i < 32; ++i) S[i] = Sin[(size_t)i * 128];
#pragma unroll
        for (int j = 0; j < 4; ++j) {
            const float a = sc[j], beta = sc[4 + j];
            float p = 0.f;
#pragma unroll
            for (int i = 0; i < 32; ++i) { S[i] *= a; p += Lk[j * 128 + 32 * part + i] * S[i]; }
            red[part * 128 + dv] = p;
            __syncthreads();
            const float delta = beta * (Lv[j * 128 + dv] - ((red[dv] + red[128 + dv]) + (red[256 + dv] + red[384 + dv])));
            __syncthreads();
            float o = 0.f;
#pragma unroll
            for (int i = 0; i < 32; ++i) { S[i] += Lk[j * 128 + 32 * part + i] * delta; o += Lq[j * 128 + 32 * part + i] * S[i]; }
            red[part * 128 + dv] = o;
            __syncthreads();
            if (part == 0) Lo[j * 128 + dv] = (red[dv] + red[128 + dv]) + (red[256 + dv] + red[384 + dv]);
            __syncthreads();
        }
        float* Sout = KOUT() + O_GSS + ((size_t)((layer * 128 + s) * 4 + h) * 128 + 32 * part) * 128 + dv;
#pragma unroll
        for (int i = 0; i < 32; ++i) Sout[(size_t)i * 128] = S[i];
        ((float*)(ws + WS_OGDN))[(size_t)(r0 + part) * 512 + h * 128 + dv] = Lo[part * 128 + dv];
    } else {
        const f32x2* ROT = (const f32x2*)(ws + WS_ROT);
        if (tid < 384) {
            const int pr = tid >> 7, d = tid & 127;
#pragma unroll
            for (int j = 0; j < 4; ++j) {
                const bf16* zp = Z + (size_t)(r0 + j) * LDZ + ZC_RQKV + pr * 512 + h * 128;
                float v = bf2f(zp[d]);
                if (pr < 2) { const f32x2 cs = ROT[(size_t)(2048 + j) * 64 + (d & 63)]; const float o = bf2f(zp[d ^ 64]);
                    v = (d < 64) ? v * cs.x - o * cs.y : v * cs.x + o * cs.y; if (pr == 1) v *= 0.08838834764831845f; }
                (pr == 0 ? Lq : pr == 1 ? Lk : Lv)[j * 128 + d] = v;
            }
        }
        __syncthreads();
        const float gam = __expf(ret_lg(h));
        const float* Sin = KIN(6) + ((size_t)((layer * 128 + s) * 4 + h) * 128 + 32 * part) * 128 + dv;
#pragma unroll
        for (int i = 0; i < 32; ++i) S[i] = Sin[(size_t)i * 128];
#pragma unroll
        for (int j = 0; j < 4; ++j) {
            const float vv = Lv[j * 128 + dv];
            float o = 0.f;
#pragma unroll
            for (int i = 0; i < 32; ++i) { S[i] = S[i] * gam + Lk[j * 128 + 32 * part + i] * vv; o += Lq[j * 128 + 32 * part + i] * S[i]; }
            red[part * 128 + dv] = o;
            __syncthreads();
            if (part == 0) Lo[j * 128 + dv] = (red[dv] + red[128 + dv]) + (red[256 + dv] + red[384 + dv]);
            __syncthreads();
        }
        float* Sout = KOUT() + O_RSS + ((size_t)((layer * 128 + s) * 4 + h) * 128 + 32 * part) * 128 + dv;
#pragma unroll
        for (int i = 0; i < 32; ++i) Sout[(size_t)i * 128] = S[i];
        if (wave < 4) {
            const int j = wave; const float a = Lo[j * 128 + 2 * lane], b = Lo[j * 128 + 2 * lane + 1];
            const float scl = rsqrtf(wave_sum(a * a + b * b, lane) * (1.f / 128.f) + EPS);
            const bf16* gp = Z + (size_t)(r0 + j) * LDZ + ZC_RG + h * 128 + 2 * lane;
            *(unsigned*)((bf16*)(ws + WS_MIX) + (size_t)(r0 + j) * 1536 + 1024 + h * 128 + 2 * lane) = pk2(a * scl * siluf_(bf2f(gp[0])), b * scl * siluf_(bf2f(gp[1])));
        }
    }
    __syncthreads();
}

DI void gdn_scan_chain(Frame& F, int layer, int bh) {
    int lane = F.lane, wave = F.wave; asm volatile("" : "+v"(lane), "+s"(wave));
    const int tid = wave * 64 + lane, quad = lane >> 4, rl = lane & 15;
    unsigned char* ws = KWS();
    const unsigned char* recb = ws + WS_GREC + (size_t)bh * 128 * GREC;
    LAS unsigned char* L = F.lds;
    constexpr int L_WP = 0, L_QP = 17408, L_KT = 34816, L_UT = 53248, L_QK = 71680;
    f32x4 S[8];
#pragma unroll
    for (int i = 0; i < 8; ++i) S[i] = (f32x4){0.f, 0.f, 0.f, 0.f};
    v4u pf[9]; float egl;
#pragma unroll
    for (int k = 0; k < 9; ++k) pf[k] = *(const v4u*)(recb + (size_t)(tid + 512 * k) * 16);
    egl = *(const float*)(recb + 73728);
    float* OG = (float*)(ws + WS_OGDN);
    const int b = bh >> 2, h = bh & 3;
    for (int c = 0; c < 128; ++c) {
        __syncthreads();
#pragma unroll
        for (int k = 0; k < 9; ++k) {
            const int o = tid * 16 + (k & 1) * 8192;
            const int reg = k >> 1;
            int dst;
            if (reg < 2) dst = (reg == 0 ? L_WP : L_QP) + (o >> 8) * 272 + (o & 255);
            else dst = (reg == 2 ? L_KT : reg == 3 ? L_UT : L_QK) + (o >> 7) * 144 + (o & 127);
            *(LAS v4u*)(L + dst) = pf[k];
        }
        const float eg = egl;
        __syncthreads();
        {
            const unsigned char* rn = recb + (size_t)(c + 1 < 128 ? c + 1 : 127) * GREC;
#pragma unroll
            for (int k = 0; k < 9; ++k) pf[k] = *(const v4u*)(rn + (size_t)(tid + 512 * k) * 16);
            egl = *(const float*)(rn + 73728);
        }
        bf16x8 Sb[4];
#pragma unroll
        for (int s = 0; s < 4; ++s) Sb[s] = pack_frag(S[2 * s], S[2 * s + 1]);
        f32x4 vn[4], O[4];
#pragma unroll
        for (int rt = 0; rt < 4; ++rt) {
            f32x4 wsacc = (f32x4){0.f, 0.f, 0.f, 0.f}, o = wsacc;
#pragma unroll
            for (int s = 0; s < 4; ++s) {
                wsacc = mfma16(ld_frag_l(L + L_WP + (16 * rt + rl) * 272 + (32 * s + 8 * quad) * 2), Sb[s], wsacc);
                o = mfma16(ld_frag_l(L + L_QP + (16 * rt + rl) * 272 + (32 * s + 8 * quad) * 2), Sb[s], o);
            }
            const v2u uw = *(const LAS v2u*)(L + L_UT + (16 * wave + rl) * 144 + (16 * rt + 4 * quad) * 2);
            vn[rt][0] = lo_bf(uw.x) - wsacc[0]; vn[rt][1] = hi_bf(uw.x) - wsacc[1]; vn[rt][2] = lo_bf(uw.y) - wsacc[2]; vn[rt][3] = hi_bf(uw.y) - wsacc[3];
            O[rt] = o;
        }
        bf16x8 Vb[2]; Vb[0] = pack_frag(vn[0], vn[1]); Vb[1] = pack_frag(vn[2], vn[3]);
#pragma unroll
        for (int rt = 0; rt < 4; ++rt) {
#pragma unroll
            for (int s2 = 0; s2 < 2; ++s2) O[rt] = mfma16(ld_frag_l(L + L_QK + (16 * rt + rl) * 144 + (32 * s2 + 8 * quad) * 2), Vb[s2], O[rt]);
            const size_t row = (size_t)b * TP + 64 * c + 16 * rt + 4 * quad;
#pragma unroll
            for (int i = 0; i < 4; ++i) OG[(row + i) * 512 + h * 128 + 16 * wave + rl] = O[rt][i];
        }
#pragma unroll
        for (int kt = 0; kt < 8; ++kt) {
            f32x4 a = S[kt] * eg;
#pragma unroll
            for (int s2 = 0; s2 < 2; ++s2) a = mfma16(ld_frag_l(L + L_KT + (16 * kt + rl) * 144 + (32 * s2 + 8 * quad) * 2), Vb[s2], a);
            S[kt] = a;
        }
    }
    float* So = KOUT() + O_GSP + (size_t)(layer * 8 + bh) * 16384;
#pragma unroll
    for (int kt = 0; kt < 8; ++kt)
#pragma unroll
        for (int i = 0; i < 4; ++i) So[(size_t)(16 * kt + 4 * quad + i) * 128 + 16 * wave + rl] = S[kt][i];
    __syncthreads();
}
DI void ret_scan_part(Frame& F, int layer, int r) {
    int tid = F.tid; asm volatile("" : "+v"(tid));
    const int bh = r >> 2, dv = tid & 127, dk0 = ((r & 3) * 4 + (tid >> 7)) * 8, h = bh & 3;
    unsigned char* ws = KWS();
    const float* RKV = (const float*)(ws + WS_RKV) + (size_t)bh * 64 * 16384;
    bf16* RST = (bf16*)(ws + WS_RST) + (size_t)bh * 64 * 16384;
    const float cdec = __expf(128.f * ret_lg(h));
    float S[8];
#pragma unroll
    for (int i = 0; i < 8; ++i) S[i] = 0.f;
#pragma unroll 4
    for (int c = 0; c < 64; ++c) {
        v4u w; w.x = pk2(S[0], S[1]); w.y = pk2(S[2], S[3]); w.z = pk2(S[4], S[5]); w.w = pk2(S[6], S[7]);
        *(v4u*)(RST + (size_t)c * 16384 + dv * 128 + dk0) = w;
#pragma unroll
        for (int i = 0; i < 8; ++i) S[i] = S[i] * cdec + RKV[(size_t)c * 16384 + (dk0 + i) * 128 + dv];
    }
    float* So = KOUT() + O_RSP + (size_t)(layer * 8 + bh) * 16384;
#pragma unroll
    for (int i = 0; i < 8; ++i) So[(size_t)(dk0 + i) * 128 + dv] = S[i];
}
constexpr float SM_C = 0.125f * 1.4426950408889634f;
struct AttnState { float m, l; f32x4 O[4]; };
DI void attn_reset(AttnState& st) { st.m = -1e30f; st.l = 0.f;
#pragma unroll
    for (int i = 0; i < 4; ++i) st.O[i] = (f32x4){0.f, 0.f, 0.f, 0.f}; }
DI void qk_tile(const LAS unsigned char* Kt, const bf16x8 (&qf)[2], f32x4 (&s)[4], int rl, int quad) {
    bf16x8 kf[4][2];
#pragma unroll
    for (int kt = 0; kt < 4; ++kt)
#pragma unroll
        for (int kk = 0; kk < 2; ++kk) kf[kt][kk] = ld_frag_l(Kt + (16 * kt + rl) * 144 + kk * 64 + quad * 16);
    __builtin_amdgcn_s_setprio(1);
#pragma unroll
    for (int kt = 0; kt < 4; ++kt) s[kt] = mfma16(kf[kt][0], qf[0], (f32x4){0.f, 0.f, 0.f, 0.f});
#pragma unroll
    for (int kt = 0; kt < 4; ++kt) s[kt] = mfma16(kf[kt][1], qf[1], s[kt]);
    __builtin_amdgcn_s_setprio(0);
}
template <class Mask> DI void attn_step(const LAS unsigned char* Kt, const LAS unsigned char* VT, const bf16x8 (&qf)[2], AttnState& st, const Mask& ok, int rl, int quad) {
    f32x4 s[4]; qk_tile(Kt, qf, s, rl, quad);
    float mx = -3e38f;
#pragma unroll
    for (int kt = 0; kt < 4; ++kt)
#pragma unroll
        for (int i = 0; i < 4; ++i) if (ok(16 * kt + 4 * quad + i)) mx = fmaxf(mx, s[kt][i]);
    const int lane = rl + 16 * quad;
    mx = fmaxf(mx, shx<16>(mx, lane)); mx = fmaxf(mx, shx<32>(mx, lane));
    const float mn = fmaxf(st.m, mx);
    const float alpha = exp2f((st.m - mn) * SM_C);
    float ls = 0.f;
#pragma unroll
    for (int kt = 0; kt < 4; ++kt)
#pragma unroll
        for (int i = 0; i < 4; ++i) { const float p = ok(16 * kt + 4 * quad + i) ? exp2f((s[kt][i] - mn) * SM_C) : 0.f; s[kt][i] = p; ls += p; }
    ls += shx<16>(ls, lane); ls += shx<32>(ls, lane);
    st.l = st.l * alpha + ls; st.m = mn;
#pragma unroll
    for (int dt = 0; dt < 4; ++dt) st.O[dt] *= alpha;
#pragma unroll
    for (int ii = 0; ii < 2; ++ii) {
        const bf16x8 pb = pack_frag(s[2 * ii], s[2 * ii + 1]);
#pragma unroll
        for (int dt = 0; dt < 4; ++dt) {
            const LAS unsigned char* vp = VT + (16 * dt + rl) * 144 + (32 * ii + 4 * quad) * 2;
            st.O[dt] = mfma16(mk_frag(*(const LAS v2u*)vp, *(const LAS v2u*)(vp + 32)), pb, st.O[dt]);
        }
    }
}
DI void attn_accum(f32x4 (&Of)[4], const AttnState& st, float gate) {
    const float sc = st.l > 0.f ? gate / st.l : 0.f;
#pragma unroll
    for (int dt = 0; dt < 4; ++dt) Of[dt] += st.O[dt] * sc;
}
DI void vt_write(LAS unsigned char* VT, int d0, int key, const v4u w) {
    LAS unsigned char* d = VT + d0 * 144 + key * 2;
    *(LAS bf16*)(d) = (bf16)(w.x & 0xffff); *(LAS bf16*)(d + 144) = (bf16)(w.x >> 16); *(LAS bf16*)(d + 2 * 144) = (bf16)(w.y & 0xffff); *(LAS bf16*)(d + 3 * 144) = (bf16)(w.y >> 16);
    *(LAS bf16*)(d + 4 * 144) = (bf16)(w.z & 0xffff); *(LAS bf16*)(d + 5 * 144) = (bf16)(w.z >> 16); *(LAS bf16*)(d + 6 * 144) = (bf16)(w.w & 0xffff); *(LAS bf16*)(d + 7 * 144) = (bf16)(w.w >> 16);
}
DI void stage_wg(LAS unsigned char* Kt, LAS unsigned char* VT, const bf16* kb, const bf16* vb, size_t stride, int tid, bool do_v) {
    const int key = tid >> 3, ch = tid & 7;
    *(LAS v4u*)(Kt + key * 144 + ch * 16) = *(const v4u*)(kb + key * stride + ch * 8);
    if (do_v) vt_write(VT, ch * 8, key, *(const v4u*)(vb + key * stride + ch * 8));
}
DI unsigned score_key(float s, bool valid, int idx) { return valid ? (((__float_as_uint(s) | 0x80000000u) & ~127u) | (unsigned)(127 - idx)) : 0u; }
DI int key_rank(const LAS unsigned* K, int ng4, unsigned k) {
    int r = 0;
#pragma unroll 4
    for (int g = 0; g < ng4; ++g) { const v4u v = *(const LAS v4u*)(K + 4 * g); r += (v.x > k) + (v.y > k) + (v.z > k) + (v.w > k); }
    return r;
}
DI void key_rank2(const LAS unsigned* K, int ng4, unsigned k0, unsigned k1, int& r0, int& r1) {
    int a0 = 0, a1 = 0, b0 = 0, b1 = 0;
    const int ng8 = (ng4 + 1) >> 1;
#pragma unroll 4
    for (int g = 0; g < ng8; ++g) { const v4u v = *(const LAS v4u*)(K + 8 * g), w = *(const LAS v4u*)(K + 8 * g + 4);
        a0 += (v.x > k0) + (v.y > k0) + (v.z > k0) + (v.w > k0); b0 += (w.x > k0) + (w.y > k0) + (w.z > k0) + (w.w > k0);
        a1 += (v.x > k1) + (v.y > k1) + (v.z > k1) + (v.w > k1); b1 += (w.x > k1) + (w.y > k1) + (w.z > k1) + (w.w > k1); }
    r0 = a0 + b0; r1 = a1 + b1;
}
DI int top16(float v0, float v1, int lane) {
    int sel = 0;
#pragma unroll 1
    for (int r = 0; r < 16; ++r) {
        float bv; int bi;
        if (v0 >= v1) { bv = v0; bi = lane; } else { bv = v1; bi = lane + 64; }
#define T16_STEP(M) { const float ov = shx<M>(bv, lane); const int oi = shxi<M>(bi, lane); const bool take = (ov > bv) || (ov == bv && oi < bi); bv = take ? ov : bv; bi = take ? oi : bi; }
        T16_STEP(32) T16_STEP(16) T16_STEP(8) T16_STEP(4) T16_STEP(2) T16_STEP(1)
#undef T16_STEP
        const bool h0 = (bi == lane), h1 = (bi == lane + 64);
        v0 = h0 ? -3e38f : v0; v1 = h1 ? -3e38f : v1; sel |= (h0 ? 1 : 0) | (h1 ? 2 : 0);
    }
    return sel;
}

typedef short v4i16_t __attribute__((ext_vector_type(4)));
DI s16x4 vtr(const LAS unsigned char* p) { return __builtin_bit_cast(s16x4, __builtin_amdgcn_ds_read_tr16_b64_v4i16((LAS v4i16_t*)p)); }
DI bf16x8 cat4(s16x4 a, s16x4 b) { bf16x8 r; r[0] = a[0]; r[1] = a[1]; r[2] = a[2]; r[3] = a[3]; r[4] = b[0]; r[5] = b[1]; r[6] = b[2]; r[7] = b[3]; return r; }
DI void attn_step3(const LAS unsigned char* Kt, const LAS unsigned char* Vt, const bf16x8 (&qf)[2], AttnState& st, int lo, int hi, bool active, int rl, int quad) {
    active = active && (hi >= lo);
    if (!__any(active)) return;
    f32x4 s[4]; qk_tile(Kt, qf, s, rl, quad);
    const int lane = rl + 16 * quad;
    const bool full = __all((lo <= 0 && hi >= 63) || !active);
    const int kq = 4 * quad - lo; const unsigned rng = (unsigned)(hi - lo);
    float lm;
    if (full) {
        const float a0 = fmaxf(fmaxf(s[0][0], s[0][1]), fmaxf(s[0][2], s[0][3])), a1 = fmaxf(fmaxf(s[1][0], s[1][1]), fmaxf(s[1][2], s[1][3]));
        const float a2 = fmaxf(fmaxf(s[2][0], s[2][1]), fmaxf(s[2][2], s[2][3])), a3 = fmaxf(fmaxf(s[3][0], s[3][1]), fmaxf(s[3][2], s[3][3]));
        lm = fmaxf(fmaxf(a0, a1), fmaxf(a2, a3));
    } else {
        lm = -3e38f;
#pragma unroll
        for (int kt = 0; kt < 4; ++kt)
#pragma unroll
            for (int i = 0; i < 4; ++i) lm = ((unsigned)(kq + 16 * kt + i) <= rng) ? fmaxf(lm, s[kt][i]) : lm;
    }
    lm = active ? lm : -3e38f;
    if (__any(lm > st.m + 320.f)) {
        float mx = fmaxf(lm, shx<16>(lm, lane)); mx = fmaxf(mx, shx<32>(mx, lane));
        const float mn = fmaxf(st.m, mx);
        const float alpha = __builtin_amdgcn_exp2f((st.m - mn) * SM_C);
        st.l *= alpha; st.m = mn;
#pragma unroll
        for (int dt = 0; dt < 4; ++dt) st.O[dt] *= alpha;
    }
    const float mc = active ? st.m * SM_C : __builtin_inff();
    float ls = 0.f;
    if (full) {
#pragma unroll
        for (int kt = 0; kt < 4; ++kt)
#pragma unroll
            for (int i = 0; i < 4; ++i) { const float p = __builtin_amdgcn_exp2f(s[kt][i] * SM_C - mc); s[kt][i] = p; ls += p; }
    } else {
#pragma unroll
        for (int kt = 0; kt < 4; ++kt)
#pragma unroll
            for (int i = 0; i < 4; ++i) { const float p = ((unsigned)(kq + 16 * kt + i) <= rng) ? __builtin_amdgcn_exp2f(s[kt][i] * SM_C - mc) : 0.f; s[kt][i] = p; ls += p; }
    }
    st.l += ls;
#pragma unroll
    for (int ii = 0; ii < 2; ++ii) {
        const bf16x8 pb = pack_frag(s[2 * ii], s[2 * ii + 1]);
#pragma unroll
        for (int dt = 0; dt < 4; ++dt) {
            const LAS unsigned char* vp = Vt + (32 * ii + 4 * quad + (rl >> 2)) * 144 + (16 * dt + 4 * (rl & 3)) * 2;
            st.O[dt] = mfma16(cat4(vtr(vp), vtr(vp + 16 * 144)), pb, st.O[dt]);
        }
    }
}
DI float attn_rowsum(const AttnState& st, int lane) { float l = st.l; l += shx<16>(l, lane); l += shx<32>(l, lane); return l; }
DI void attn_accum3(f32x4 (&Of)[4], const AttnState& st, float gate, int lane) {
    const float l = attn_rowsum(st, lane);
    const float sc = l > 0.f ? gate / l : 0.f;
#pragma unroll
    for (int dt = 0; dt < 4; ++dt) Of[dt] += st.O[dt] * sc;
}
#ifndef PH_NPT
#define PH_NPT (-1)
#endif
#if PH_NPT >= 0
#define NP_T(k) do { if (tid == 0) { volatile LAS unsigned long long* np_ = (volatile LAS unsigned long long*)(F.lds + LDSCTL_OFF + 464); const unsigned long long now_ = __builtin_amdgcn_s_memrealtime(); \
    if ((k) == PH_NPT) np_[0] += now_ - np_[1]; np_[1] = now_; } } while (0)
#else
#define NP_T(k) do { } while (0)
#endif
#ifndef PH_NSAC
#define PH_NSAC 1
#endif
DI float tile_max(const f32x4 (&s)[4], bool full, int kq, unsigned rng) {
    float lm;
    if (full) {
        const float a0 = fmaxf(fmaxf(s[0][0], s[0][1]), fmaxf(s[0][2], s[0][3])), a1 = fmaxf(fmaxf(s[1][0], s[1][1]), fmaxf(s[1][2], s[1][3]));
        const float a2 = fmaxf(fmaxf(s[2][0], s[2][1]), fmaxf(s[2][2], s[2][3])), a3 = fmaxf(fmaxf(s[3][0], s[3][1]), fmaxf(s[3][2], s[3][3]));
        lm = fmaxf(fmaxf(a0, a1), fmaxf(a2, a3));
    } else {
        lm = -3e38f;
#pragma unroll
        for (int kt = 0; kt < 4; ++kt)
#pragma unroll
            for (int i = 0; i < 4; ++i) lm = ((unsigned)(kq + 16 * kt + i) <= rng) ? fmaxf(lm, s[kt][i]) : lm;
    }
    return lm;
}
DI float tile_exp(f32x4 (&s)[4], bool full, int kq, unsigned rng, float mc) {
    float ls = 0.f;
    if (full) {
#pragma unroll
        for (int kt = 0; kt < 4; ++kt)
#pragma unroll
            for (int i = 0; i < 4; ++i) { const float p = __builtin_amdgcn_exp2f(s[kt][i] * SM_C - mc); s[kt][i] = p; ls += p; }
    } else {
#pragma unroll
        for (int kt = 0; kt < 4; ++kt)
#pragma unroll
            for (int i = 0; i < 4; ++i) { const float p = ((unsigned)(kq + 16 * kt + i) <= rng) ? __builtin_amdgcn_exp2f(s[kt][i] * SM_C - mc) : 0.f; s[kt][i] = p; ls += p; }
    }
    return ls;
}
DI void tile_pv(const LAS unsigned char* Vt, const f32x4 (&s)[4], f32x4 (&O)[4], int rl, int quad) {
    bf16x8 vf[2][4];
#pragma unroll
    for (int ii = 0; ii < 2; ++ii)
#pragma unroll
        for (int dt = 0; dt < 4; ++dt) { const LAS unsigned char* vp = Vt + (32 * ii + 4 * quad + (rl >> 2)) * 144 + (16 * dt + 4 * (rl & 3)) * 2; vf[ii][dt] = cat4(vtr(vp), vtr(vp + 16 * 144)); }
    const bf16x8 pb0 = pack_frag(s[0], s[1]), pb1 = pack_frag(s[2], s[3]);
    __builtin_amdgcn_s_setprio(1);
#pragma unroll
    for (int dt = 0; dt < 4; ++dt) O[dt] = mfma16(vf[0][dt], pb0, O[dt]);
#pragma unroll
    for (int dt = 0; dt < 4; ++dt) O[dt] = mfma16(vf[1][dt], pb1, O[dt]);
    __builtin_amdgcn_s_setprio(0);
}
DI void tile_vload(const LAS unsigned char* Vt, bf16x8 (&vf)[2][4], int rl, int quad) {
#pragma unroll
    for (int ii = 0; ii < 2; ++ii)
#pragma unroll
        for (int dt = 0; dt < 4; ++dt) { const LAS unsigned char* vp = Vt + (32 * ii + 4 * quad + (rl >> 2)) * 144 + (16 * dt + 4 * (rl & 3)) * 2; vf[ii][dt] = cat4(vtr(vp), vtr(vp + 16 * 144)); }
}
DI void tile_pvmma(const bf16x8 (&vf)[2][4], const f32x4 (&s)[4], f32x4 (&O)[4]) {
    const bf16x8 pb0 = pack_frag(s[0], s[1]), pb1 = pack_frag(s[2], s[3]);
    __builtin_amdgcn_s_setprio(1);
#pragma unroll
    for (int dt = 0; dt < 4; ++dt) O[dt] = mfma16(vf[0][dt], pb0, O[dt]);
#pragma unroll
    for (int dt = 0; dt < 4; ++dt) O[dt] = mfma16(vf[1][dt], pb1, O[dt]);
    __builtin_amdgcn_s_setprio(0);
}
DI void attn_step_pair(const LAS unsigned char* K0, const LAS unsigned char* V0, int lo0, int hi0, bool act0,
                       const LAS unsigned char* K1, const LAS unsigned char* V1, int lo1, int hi1, bool act1,
                       const bf16x8 (&qf)[2], AttnState& st, int rl, int quad) {
    act0 = act0 && (hi0 >= lo0); act1 = act1 && (hi1 >= lo1);
    const bool any0 = __any(act0), any1 = __any(act1);
    if (!any0 && !any1) return;
    const int lane = rl + 16 * quad;
    f32x4 s0[4], s1[4];
    if (any0 && any1) {
        bf16x8 kf0[4][2], kf1[4][2];
#pragma unroll
        for (int kt = 0; kt < 4; ++kt)
#pragma unroll
            for (int kk = 0; kk < 2; ++kk) { kf0[kt][kk] = ld_frag_l(K0 + (16 * kt + rl) * 144 + kk * 64 + quad * 16); kf1[kt][kk] = ld_frag_l(K1 + (16 * kt + rl) * 144 + kk * 64 + quad * 16); }
        __builtin_amdgcn_s_setprio(1);
#pragma unroll
        for (int kt = 0; kt < 4; ++kt) s0[kt] = mfma16(kf0[kt][0], qf[0], (f32x4){0.f, 0.f, 0.f, 0.f});
#pragma unroll
        for (int kt = 0; kt < 4; ++kt) s1[kt] = mfma16(kf1[kt][0], qf[0], (f32x4){0.f, 0.f, 0.f, 0.f});
#pragma unroll
        for (int kt = 0; kt < 4; ++kt) s0[kt] = mfma16(kf0[kt][1], qf[1], s0[kt]);
#pragma unroll
        for (int kt = 0; kt < 4; ++kt) s1[kt] = mfma16(kf1[kt][1], qf[1], s1[kt]);
        __builtin_amdgcn_s_setprio(0);
    } else {
        if (any0) qk_tile(K0, qf, s0, rl, quad);
        if (any1) qk_tile(K1, qf, s1, rl, quad);
    }
    const bool full0 = __all((lo0 <= 0 && hi0 >= 63) || !act0), full1 = __all((lo1 <= 0 && hi1 >= 63) || !act1);
    const int kq0 = 4 * quad - lo0, kq1 = 4 * quad - lo1; const unsigned rng0 = (unsigned)(hi0 - lo0), rng1 = (unsigned)(hi1 - lo1);
    float mcb = st.m * SM_C;
    bf16x8 vf0[2][4], vf1[2][4];
    if (any0) tile_vload(V0, vf0, rl, quad);
    float ls = 0.f;
    if (any0) ls += tile_exp(s0, full0, kq0, rng0, act0 ? mcb : __builtin_inff());
    if (any1) ls += tile_exp(s1, full1, kq1, rng1, act1 ? mcb : __builtin_inff());
    if (__any(!(ls <= 1e30f))) {
        if (any0) qk_tile(K0, qf, s0, rl, quad);
        if (any1) qk_tile(K1, qf, s1, rl, quad);
        float lm = -3e38f;
        if (any0) { const float a = tile_max(s0, full0, kq0, rng0); lm = act0 ? a : lm; }
        if (any1) { const float a = tile_max(s1, full1, kq1, rng1); lm = act1 ? fmaxf(lm, a) : lm; }
        float mx = fmaxf(lm, shx<16>(lm, lane)); mx = fmaxf(mx, shx<32>(mx, lane));
        const float mn = fmaxf(st.m, mx);
        const float alpha = __builtin_amdgcn_exp2f((st.m - mn) * SM_C);
        st.l *= alpha; st.m = mn;
#pragma unroll
        for (int dt = 0; dt < 4; ++dt) st.O[dt] *= alpha;
        mcb = mn * SM_C; ls = 0.f;
        if (any0) ls += tile_exp(s0, full0, kq0, rng0, act0 ? mcb : __builtin_inff());
        if (any1) ls += tile_exp(s1, full1, kq1, rng1, act1 ? mcb : __builtin_inff());
    }
    st.l += ls;
    if (any1) tile_vload(V1, vf1, rl, quad);
    if (any0) tile_pvmma(vf0, s0, st.O);
    if (any1) tile_pvmma(vf1, s1, st.O);
}
DI void nsa_prompt_unit(Frame& F, int layer, int unit) {
    int lane = F.lane, wave = F.wave; asm volatile("" : "+v"(lane), "+s"(wave));
    const int tid = wave * 64 + lane, quad = lane >> 4, rl = lane & 15;
    const int b = unit >> 9, g = (unit >> 8) & 1, tt = unit & 255, t0 = 32 * tt;
    unsigned char* ws = KWS();
    const bf16* Z = (const bf16*)(ws + WS_Z);
    const float* ZS = (const float*)(ws + WS_ZS);
    LAS unsigned char* TB = F.lds;
    LAS float* AIMP = (LAS float*)(F.lds + 73728);
    LAS unsigned* SEL = (LAS unsigned*)(F.lds + LDSCTL_OFF + 512);
    const int tk = 4 * wave + (rl >> 2), t = t0 + tk, head = 4 * g + (rl & 3);
    const size_t row = (size_t)b * TP + t;
    bf16x8 qf[2];
    qf[0] = ld_frag_g(Z + row * LDZ + ZC_Q + head * 64 + quad * 8); qf[1] = ld_frag_g(Z + row * LDZ + ZC_Q + head * 64 + 32 + quad * 8);
    const float gc = sigmoidf_(ZS[row * 32 + head * 3]), gs = sigmoidf_(ZS[row * 32 + head * 3 + 1]), gw = sigmoidf_(ZS[row * 32 + head * 3 + 2]);
    f32x4 Of[4];
#pragma unroll
    for (int i = 0; i < 4; ++i) Of[i] = (f32x4){0.f, 0.f, 0.f, 0.f};
    AttnState st;
    const int nct = (t0 >> 10) + 1;
    const bf16* KC = (const bf16*)(ws + WS_KC) + ((size_t)(0 * 2 + b) * 512 * 2 + g) * 64;
    const bf16* VC = (const bf16*)(ws + WS_KC) + ((size_t)(1 * 2 + b) * 512 * 2 + g) * 64;
    const bf16* Zb = Z + (size_t)b * TP * LDZ + g * 64;
    const int skey = tid >> 3, sch = tid & 7;
    const int wlo = (t0 - 511 > 0 ? t0 - 511 : 0) >> 6, nwin = ((t0 + 31) >> 6) - wlo + 1;
    const int nwe = (nwin + 1) & ~1, nce = (nct + 1) & ~1;
    v4u rkA, rvA, rkB, rvB;
#define COMMIT(slot, rk, rv) do { LAS unsigned char* d_ = TB + (slot) * 18432 + skey * 144 + sch * 16; *(LAS v4u*)d_ = rk; *(LAS v4u*)(d_ + 9216) = rv; } while (0)
    NP_T(0);
    const int n1 = nwe + 2 * nce;
#define SEG1_VALID(i) ((i) < nwe ? (i) < nwin : (((i) - nwe) < nce ? ((i) - nwe) < nct : ((i) - nwe - nce) < nct))
#define SEG1_ISSUE(i, rk, rv) do { int i_ = (i); i_ = i_ < n1 ? i_ : n1 - 1; const bool win_ = i_ < nwe; int wt_ = wlo + (i_ < nwin ? i_ : nwin - 1); int jt_ = (i_ - nwe) % nce; jt_ = jt_ < nct ? jt_ : nct - 1; jt_ = jt_ < 0 ? 0 : jt_; \
        const bf16* pk_ = win_ ? Zb + (size_t)(64 * wt_ + skey) * LDZ + sch * 8 + ZC_KW : KC + (size_t)(64 * jt_ + skey) * 128 + sch * 8; \
        const bf16* pv_ = win_ ? Zb + (size_t)(64 * wt_ + skey) * LDZ + sch * 8 + ZC_VW : VC + (size_t)(64 * jt_ + skey) * 128 + sch * 8; \
        rk = *(const v4u*)pk_; rv = *(const v4u*)pv_; } while (0)
    attn_reset(st);
    float mfin = 0.f, il = 0.f;
    SEG1_ISSUE(0, rkA, rvA); SEG1_ISSUE(1, rkB, rvB);
    COMMIT(0, rkA, rvA); COMMIT(1, rkB, rvB);
    SEG1_ISSUE(2, rkA, rvA); SEG1_ISSUE(3, rkB, rvB);
    __syncthreads();
    for (int i = 0; i < n1; i += 2) {
        const LAS unsigned char* K0 = TB + (i & 3) * 18432; const LAS unsigned char* K1 = TB + ((i + 1) & 3) * 18432;
        if (i < nwe) {
            const int kb0 = 64 * (wlo + i), kb1 = kb0 + 64;
            attn_step_pair(K0, K0 + 9216, t - 511 - kb0, t - kb0, true, K1, K1 + 9216, t - 511 - kb1, t - kb1, (i + 1) < nwin, qf, st, rl, quad);
            if (i + 2 == nwe) { attn_accum3(Of, st, gw, lane); attn_reset(st); }
        } else if (i < nwe + nce) {
            const int nb0 = 64 * (i - nwe), nb1 = nb0 + 64;
            attn_step_pair(K0, K0 + 9216, 0, ((t - 31) >> 4) - nb0, true, K1, K1 + 9216, 0, ((t - 31) >> 4) - nb1, (i + 1 - nwe) < nct, qf, st, rl, quad);
            if (i + 2 == nwe + nce) { attn_accum3(Of, st, gc, lane); mfin = st.m * SM_C; const float lt_ = attn_rowsum(st, lane); il = lt_ > 0.f ? 1.f / lt_ : 0.f; }
        } else {
#pragma unroll
            for (int e2 = 0; e2 < 2; ++e2) {
                const int jt = i + e2 - nwe - nce;
                if (jt < nct) {
                    f32x4 s[4]; qk_tile(e2 ? K1 : K0, qf, s, rl, quad);
#pragma unroll
                    for (int kt = 0; kt < 4; ++kt)
#pragma unroll
                        for (int e = 0; e < 4; ++e) {
                            const int n = 64 * jt + 16 * kt + 4 * quad + e;
                            float p = (16 * n + 31 <= t) ? __builtin_amdgcn_exp2f(s[kt][e] * SM_C - mfin) * il : 0.f;
                            p += shx<1>(p, lane); p += shx<2>(p, lane);
                            if ((rl & 3) == 0) AIMP[tk * 512 + n] = p;
                        }
                }
            }
        }
        if (i + 2 < n1) { if (SEG1_VALID(i + 2)) COMMIT((i + 2) & 3, rkA, rvA); if (SEG1_VALID(i + 3)) COMMIT((i + 3) & 3, rkB, rvB); }
        __syncthreads();
        SEG1_ISSUE(i + 4, rkA, rvA); SEG1_ISSUE(i + 5, rkB, rvB);
    }
    NP_T(1);
    {
        const int nav = nct * 64;
        LAS unsigned* KS = (LAS unsigned*)(TB + wave * 2048);
#pragma unroll
        for (int q = 0; q < 4; ++q) {
            const int tq = 4 * wave + q, cur = (t0 + tq) >> 6;
#pragma unroll
            for (int e = 0; e < 2; ++e) {
                const int sblk = lane + 64 * e;
                float imp = 0.f;
#pragma unroll
                for (int d = -1; d <= 3; ++d) { const int n = 4 * sblk + d; if (n >= 0 && n < nav) imp += AIMP[tq * 512 + n]; }
                const bool valid = sblk <= cur, forced = (sblk == 0) || (sblk == cur) || (sblk == cur - 1);
                KS[q * 128 + sblk] = score_key(imp + (forced ? 1000.f : 0.f), valid, sblk);
            }
        }
        asm volatile("" ::: "memory");
#pragma unroll
        for (int q = 0; q < 4; ++q) {
            const int tq = 4 * wave + q, cur = (t0 + tq) >> 6, ng4 = (cur >> 2) + 1;
            const unsigned k0 = KS[q * 128 + lane], k1 = KS[q * 128 + 64 + lane];
            int r0, r1; key_rank2(KS + q * 128, ng4, k0, k1, r0, r1);
            const bool s0 = (lane <= cur) && r0 < 16, s1 = (lane + 64 <= cur) && r1 < 16;
            const unsigned long long m0 = __ballot(s0), m1 = __ballot(s1);
            if (lane == 0) { SEL[tq * 4 + 0] = (unsigned)m0; SEL[tq * 4 + 1] = (unsigned)(m0 >> 32); SEL[tq * 4 + 2] = (unsigned)m1; SEL[tq * 4 + 3] = (unsigned)(m1 >> 32); }
        }
    }
    __syncthreads();
    unsigned un[4], my[4], wv[4];
#pragma unroll
    for (int w = 0; w < 4; ++w) { unsigned v = (lane < 32) ? SEL[lane * 4 + w] : 0u;
        v |= (unsigned)shxi<1>((int)v, lane); v |= (unsigned)shxi<2>((int)v, lane); v |= (unsigned)shxi<4>((int)v, lane); v |= (unsigned)shxi<8>((int)v, lane); v |= (unsigned)shxi<16>((int)v, lane); v |= (unsigned)shxi<32>((int)v, lane);
        un[w] = __builtin_amdgcn_readfirstlane(v); my[w] = SEL[tk * 4 + w];
        wv[w] = SEL[(4 * wave) * 4 + w] | SEL[(4 * wave + 1) * 4 + w] | SEL[(4 * wave + 2) * 4 + w] | SEL[(4 * wave + 3) * 4 + w]; wv[w] = __builtin_amdgcn_readfirstlane(wv[w]); }
#if PH_NSAC > 1
    AttnState st2; attn_reset(st2);
#endif
    NP_T(2);
    attn_reset(st);
    {
        unsigned w0 = un[0], w1 = un[1], w2 = un[2], w3 = un[3];
#define NEXT_BLK(dst) do { if (w0) { dst = __builtin_ctz(w0); w0 &= w0 - 1u; } else if (w1) { dst = 32 + __builtin_ctz(w1); w1 &= w1 - 1u; } else if (w2) { dst = 64 + __builtin_ctz(w2); w2 &= w2 - 1u; } \
        else if (w3) { dst = 96 + __builtin_ctz(w3); w3 &= w3 - 1u; } else dst = -1; } while (0)
#define SEG2_ISSUE(blk_, rk, rv) do { const int b_ = (blk_) >= 0 ? (blk_) : 0; const bf16* p_ = Zb + (size_t)(64 * b_ + skey) * LDZ + sch * 8; rk = *(const v4u*)(p_ + ZC_KS); rv = *(const v4u*)(p_ + ZC_VS); } while (0)
#define BLK_WORD(arr, blk_) (((blk_) >> 5) == 0 ? arr[0] : ((blk_) >> 5) == 1 ? arr[1] : ((blk_) >> 5) == 2 ? arr[2] : arr[3])
#define SEG2_PAIR(ca, cb, sa, sb, stt) do { const LAS unsigned char* K0 = TB + (sa) * 18432; const LAS unsigned char* K1 = TB + (sb) * 18432; \
            const int ca_ = (ca) >= 0 ? (ca) : 0, cb_ = (cb) >= 0 ? (cb) : 0; \
            const bool need0 = ((ca) >= 0) && ((BLK_WORD(wv, ca_) >> (ca_ & 31)) & 1u), need1 = ((cb) >= 0) && ((BLK_WORD(wv, cb_) >> (cb_ & 31)) & 1u); \
            const bool mine0 = need0 && ((BLK_WORD(my, ca_) >> (ca_ & 31)) & 1u), mine1 = need1 && ((BLK_WORD(my, cb_) >> (cb_ & 31)) & 1u); \
            attn_step_pair(K0, K0 + 9216, 0, t - 64 * ca_, mine0, K1, K1 + 9216, 0, t - 64 * cb_, mine1, qf, stt, rl, quad); } while (0)
        v4u rkC, rvC, rkD, rvD;
        int c0, c1, c2, c3, n0, n1b, n2, n3, m0, m1, m2, m3;
        NEXT_BLK(c0); NEXT_BLK(c1); NEXT_BLK(c2); NEXT_BLK(c3); NEXT_BLK(n0); NEXT_BLK(n1b); NEXT_BLK(n2); NEXT_BLK(n3);
        SEG2_ISSUE(c0, rkA, rvA); SEG2_ISSUE(c1, rkB, rvB); SEG2_ISSUE(c2, rkC, rvC); SEG2_ISSUE(c3, rkD, rvD);
        COMMIT(0, rkA, rvA); COMMIT(1, rkB, rvB); COMMIT(2, rkC, rvC); COMMIT(3, rkD, rvD);
        SEG2_ISSUE(n0, rkA, rvA); SEG2_ISSUE(n1b, rkB, rvB); SEG2_ISSUE(n2, rkC, rvC); SEG2_ISSUE(n3, rkD, rvD);
        __syncthreads();
        int i = 0;
        while (c0 >= 0) {
            NEXT_BLK(m0); NEXT_BLK(m1); NEXT_BLK(m2); NEXT_BLK(m3);
            SEG2_PAIR(c0, c1, i & 7, (i + 1) & 7, st);
            SEG2_PAIR(c2, c3, (i + 2) & 7, (i + 3) & 7, st);
#if PH_NSAC > 1
            SEG2_PAIR(c0, c1, i & 7, (i + 1) & 7, st2); SEG2_PAIR(c2, c3, (i + 2) & 7, (i + 3) & 7, st2);
#endif
            COMMIT((i + 4) & 7, rkA, rvA); COMMIT((i + 5) & 7, rkB, rvB); COMMIT((i + 6) & 7, rkC, rvC); COMMIT((i + 7) & 7, rkD, rvD);
            __syncthreads();
#if defined(PH_NSAX) && (PH_NSAX & 1)
            __syncthreads();
#endif
#if defined(PH_NSAX) && (PH_NSAX & 2)
            { v4u d0_, d1_; SEG2_ISSUE(m0, d0_, d1_); asm volatile("" :: "v"(d0_), "v"(d1_)); SEG2_ISSUE(m1, d0_, d1_); asm volatile("" :: "v"(d0_), "v"(d1_));
              SEG2_ISSUE(m2, d0_, d1_); asm volatile("" :: "v"(d0_), "v"(d1_)); SEG2_ISSUE(m3, d0_, d1_); asm volatile("" :: "v"(d0_), "v"(d1_)); }
#endif
            SEG2_ISSUE(m0, rkA, rvA); SEG2_ISSUE(m1, rkB, rvB); SEG2_ISSUE(m2, rkC, rvC); SEG2_ISSUE(m3, rkD, rvD);
            c0 = n0; c1 = n1b; c2 = n2; c3 = n3; n0 = m0; n1b = m1; n2 = m2; n3 = m3; i += 4;
        }
    }
    NP_T(3);
    attn_accum3(Of, st, gs, lane);
#if PH_NSAC > 1
    attn_accum3(Of, st2, (float)(layer >> 8), lane);
#endif
#undef SEG1_ISSUE
#undef SEG1_VALID
#undef SEG2_ISSUE
#undef SEG2_PAIR
#undef BLK_WORD
#undef COMMIT
#undef NEXT_BLK
    bf16* MIX = (bf16*)(ws + WS_MIX) + row * 1536 + head * 64;
#pragma unroll
    for (int dt = 0; dt < 4; ++dt) { v2u w; w.x = pk2(Of[dt][0], Of[dt][1]); w.y = pk2(Of[dt][2], Of[dt][3]); *(v2u*)(MIX + 16 * dt + 4 * quad) = w; }
    __syncthreads();
}

#define CB() asm volatile("" ::: "memory")
DI void stage_wave_f32(LAS unsigned char* Kt, LAS unsigned char* Vt, const float* kb, const float* vb, size_t stride, int lane, float* ck = nullptr, float* cv = nullptr, int rowskip = 0) {
    const int k0 = lane >> 3, ch = lane & 7;
#pragma unroll
    for (int h = 0; h < 4; ++h) {
        const float* src = (h < 2 ? kb : vb); LAS unsigned char* dst = (h < 2 ? Kt : Vt); const int r0 = (h & 1) * 32; float* cp = (h < 2 ? ck : cv);
        f32x4 a[4][2];
#pragma unroll
        for (int it = 0; it < 4; ++it) { const float* kp = src + (size_t)(r0 + it * 8 + k0) * stride + ch * 8; a[it][0] = *(const f32x4*)kp; a[it][1] = *(const f32x4*)(kp + 4); }
#pragma unroll
        for (int it = 0; it < 4; ++it) *(LAS v4u*)(dst + (r0 + it * 8 + k0) * 144 + ch * 16) = pack8(a[it][0], a[it][1]);
        if (cp) {
#pragma unroll
            for (int it = 0; it < 4; ++it) { const int rr = r0 + it * 8 + k0; if (rr >= rowskip) { float* op = cp + (size_t)rr * stride + ch * 8; *(f32x4*)op = a[it][0]; *(f32x4*)(op + 4) = a[it][1]; } }
        }
        asm volatile("" ::: "memory");
    }
}
DI void stage_wave_b16(LAS unsigned char* Kt, LAS unsigned char* Vt, const bf16* kb, const bf16* vb, size_t stride, int nvalid, int lane, bool do_v) {
    const int k0 = lane >> 3, ch = lane & 7;
    const v4u z = (v4u){0u, 0u, 0u, 0u};
#pragma unroll
    for (int it = 0; it < 8; ++it) {
        const int key = it * 8 + k0; const bool v = key < nvalid;
        *(LAS v4u*)(Kt + key * 144 + ch * 16) = v ? *(const v4u*)(kb + key * stride + ch * 8) : z;
        if (do_v) *(LAS v4u*)(Vt + key * 144 + ch * 16) = v ? *(const v4u*)(vb + key * stride + ch * 8) : z;
    }
}
DI void nsa_sample_unit(Frame& F, int layer, int s) {
    int lane = F.lane, wave = F.wave; asm volatile("" : "+v"(lane), "+s"(wave));
    const int quad = lane >> 4, rl = lane & 15;
    const int g = wave & 1, q4 = wave >> 1;
    unsigned char* ws = KWS();
    const bf16* Z = (const bf16*)(ws + WS_Z);
    const float* ZS = (const float*)(ws + WS_ZS);
    LAS unsigned char* Kt = F.lds + wave * 18432; LAS unsigned char* Vt = Kt + 9216;
    LAS float* AIMP = (LAS float*)Vt;
    const int j = rl >> 2, head = 4 * g + (rl & 3), qpos = 2048 + j;
    const size_t row = (size_t)MP + 4 * s + j;
    bf16x8 qf[2];
    qf[0] = ld_frag_g(Z + row * LDZ + ZC_Q + head * 64 + quad * 8); qf[1] = ld_frag_g(Z + row * LDZ + ZC_Q + head * 64 + 32 + quad * 8);
    const float gc = sigmoidf_(ZS[row * 32 + head * 3]), gs = sigmoidf_(ZS[row * 32 + head * 3 + 1]), gw = sigmoidf_(ZS[row * 32 + head * 3 + 2]);
    f32x4 Of[4];
#pragma unroll
    for (int i = 0; i < 4; ++i) Of[i] = (f32x4){0.f, 0.f, 0.f, 0.f};
    AttnState st;
    const bf16* KC = (const bf16*)(ws + WS_KCS) + ((size_t)(0 * 128 + s) * 128 * 2 + g) * 64;
    const bf16* VC = (const bf16*)(ws + WS_KCS) + ((size_t)(1 * 128 + s) * 128 * 2 + g) * 64;
    attn_reset(st);
#pragma unroll 1
    for (int jt = 0; jt < 2; ++jt) {
        stage_wave_b16(Kt, Vt, KC + (size_t)64 * jt * 128, VC + (size_t)64 * jt * 128, 128, 64, lane, true); CB();
        attn_step3(Kt, Vt, qf, st, 0, 126 - 64 * jt, true, rl, quad); CB();
    }
    attn_accum3(Of, st, q4 == 0 ? gc : 0.f, lane);
    {
        const float mfin = st.m * SM_C, lt = attn_rowsum(st, lane), il = lt > 0.f ? 1.f / lt : 0.f;
#pragma unroll 1
        for (int jt = 0; jt < 2; ++jt) {
            stage_wave_b16(Kt, Vt, KC + (size_t)64 * jt * 128, VC, 128, 64, lane, false); CB();
            f32x4 sv[4]; qk_tile(Kt, qf, sv, rl, quad); CB();
#pragma unroll
            for (int kt = 0; kt < 4; ++kt)
#pragma unroll
                for (int i = 0; i < 4; ++i) {
                    const int n = 64 * jt + 16 * kt + 4 * quad + i;
                    float p = (n <= 126) ? __builtin_amdgcn_exp2f(sv[kt][i] * SM_C - mfin) * il : 0.f;
                    p += shx<1>(p, lane); p += shx<2>(p, lane);
                    if ((rl & 3) == 0) AIMP[j * 128 + n] = p;
                }
        }
    }
    CB();
    unsigned long long msk[4];
    {
        unsigned keys[4];
#pragma unroll
        for (int q = 0; q < 4; ++q) {
            float imp = 0.f;
#pragma unroll
            for (int d = -1; d <= 3; ++d) { const int n = 4 * lane + d; if (n >= 0 && n <= 126 && lane < 33) imp += AIMP[q * 128 + n]; }
            const bool forced = (lane == 0) || (lane == 32) || (lane == 31);
            keys[q] = score_key(imp + (forced ? 1000.f : 0.f), lane < 33, lane);
        }
        CB();
        LAS unsigned* KS = (LAS unsigned*)Kt;
#pragma unroll
        for (int q = 0; q < 4; ++q) KS[q * 64 + lane] = keys[q];
        CB();
#pragma unroll
        for (int q = 0; q < 4; ++q) msk[q] = __ballot(lane < 33 && key_rank(KS + q * 64, 9, keys[q]) < 16);
    }
    CB();
    const unsigned long long un = msk[0] | msk[1] | msk[2] | msk[3];
    const unsigned long long mym = j == 0 ? msk[0] : j == 1 ? msk[1] : j == 2 ? msk[2] : msk[3];
    const int* pt = (const int*)KIN(7);
    AttnState sw;
    attn_reset(st); attn_reset(sw);
    {
        unsigned long long word = un; int idx = 0;
        while (word) {
            const int blk = __builtin_ctzll(word); word &= word - 1ull;
            if ((idx++ & 3) != q4) continue;
            if (blk < 32) {
                const int phys = pt[s * 16 + (blk >> 1)];
                const float* base = KIN(2) + ((size_t)(layer * 2560 + phys) * 128 + (blk & 1) * 64) * 512 + g * 64;
                stage_wave_f32(Kt, Vt, base + 256, base + 384, 512, lane); CB();
            } else {
                stage_wave_b16(Kt, Vt, Z + (size_t)(MP + 4 * s) * LDZ + ZC_KS + g * 64, Z + (size_t)(MP + 4 * s) * LDZ + ZC_VS + g * 64, LDZ, 4, lane, true); CB();
            }
            attn_step3(Kt, Vt, qf, st, 0, qpos - 64 * blk, (mym >> blk) & 1ull, rl, quad); CB();
        }
#pragma unroll 1
        for (int jt = 0; jt < 9; ++jt) {
            if ((idx++ & 3) != q4) continue;
            if (jt < 8) { const float* base = KIN(3) + ((size_t)(layer * 128 + s) * 512 + 64 * jt) * 256 + g * 64;
                float* ob = KOUT() + O_WINS + ((size_t)(layer * 128 + s) * 512 + 64 * jt) * 256 + g * 64 - (size_t)4 * 256;
                stage_wave_f32(Kt, Vt, base, base + 128, 256, lane, ob, ob + 128, jt == 0 ? 4 : 0); CB(); }
            else { stage_wave_b16(Kt, Vt, Z + (size_t)(MP + 4 * s) * LDZ + ZC_KW + g * 64, Z + (size_t)(MP + 4 * s) * LDZ + ZC_VW + g * 64, LDZ, 4, lane, true); CB(); }
            attn_step3(Kt, Vt, qf, sw, j + 1 - 64 * jt, 512 + j - 64 * jt, true, rl, quad); CB();
        }
    }
    int lane2 = lane; asm volatile("" : "+v"(lane2));
    LAS float* X = (LAS float*)(F.lds + wave * 18432);
    {
        const float ls = attn_rowsum(st, lane), lw = attn_rowsum(sw, lane);
        X[0 * 64 + lane2] = st.m; X[1 * 64 + lane2] = ls; X[18 * 64 + lane2] = sw.m; X[19 * 64 + lane2] = lw;
#pragma unroll
        for (int dt = 0; dt < 4; ++dt)
#pragma unroll
            for (int e = 0; e < 4; ++e) { X[(2 + 4 * dt + e) * 64 + lane2] = st.O[dt][e]; X[(20 + 4 * dt + e) * 64 + lane2] = sw.O[dt][e]; }
    }
    __syncthreads();
    if (q4 == 0) {
#pragma unroll
        for (int br = 0; br < 2; ++br) {
            float m[4], l[4];
#pragma unroll
            for (int q = 0; q < 4; ++q) { const LAS float* Y = (const LAS float*)(F.lds + (2 * q + g) * 18432) + br * 18 * 64; m[q] = Y[lane2]; l[q] = Y[64 + lane2]; }
            const float mm = fmaxf(fmaxf(m[0], m[1]), fmaxf(m[2], m[3]));
            float w[4], lt = 0.f;
#pragma unroll
            for (int q = 0; q < 4; ++q) { w[q] = __builtin_amdgcn_exp2f((m[q] - mm) * SM_C); lt += l[q] * w[q]; }
            const float gate = br == 0 ? gs : gw;
            const float sc = lt > 0.f ? gate / lt : 0.f;
#pragma unroll
            for (int q = 0; q < 4; ++q) { const LAS float* Y = (const LAS float*)(F.lds + (2 * q + g) * 18432) + br * 18 * 64; const float wq = w[q] * sc;
#pragma unroll
                for (int dt = 0; dt < 4; ++dt)
#pragma unroll
                    for (int e = 0; e < 4; ++e) Of[dt][e] += Y[(2 + 4 * dt + e) * 64 + lane2] * wq; }
        }
        bf16* MIX = (bf16*)(ws + WS_MIX) + row * 1536 + head * 64;
#pragma unroll
        for (int dt = 0; dt < 4; ++dt) { v2u w2; w2.x = pk2(Of[dt][0], Of[dt][1]); w2.y = pk2(Of[dt][2], Of[dt][3]); *(v2u*)(MIX + 16 * dt + 4 * quad) = w2; }
    }
    __syncthreads();
}
DI void ret_out_unit(Frame& F, int layer, int unit) {
    const int tid = F.tid, lane = F.lane, wave = F.wave, quad = lane >> 4, rl = lane & 15;
    const int b = unit >> 8, h = (unit >> 6) & 3, c = unit & 63;
    const int row0 = b * TP + 128 * c;
    unsigned char* ws = KWS();
    const bf16* Z = (const bf16*)(ws + WS_Z);
    const bf16* QR = (const bf16*)(ws + WS_QR); const bf16* KR = (const bf16*)(ws + WS_KR);
    const bf16* RST = (const bf16*)(ws + WS_RST) + (size_t)unit * 16384;
    LAS unsigned char* LQ = F.lds; LAS unsigned char* LK = F.lds + 34816; LAS unsigned char* LV = F.lds + 69632; LAS unsigned char* LS = F.lds + 104448;
    for (int it = tid; it < 2048; it += NTHREADS) {
        const int j = it >> 4, cc = it & 15;
        *(LAS v4u*)(LQ + j * 272 + cc * 16) = *(const v4u*)(QR + (size_t)(row0 + j) * 512 + h * 128 + cc * 8);
        *(LAS v4u*)(LK + j * 272 + cc * 16) = *(const v4u*)(KR + (size_t)(row0 + j) * 512 + h * 128 + cc * 8);
        *(LAS v4u*)(LS + j * 272 + cc * 16) = *(const v4u*)(RST + (size_t)j * 128 + cc * 8);
        const v4u w = *(const v4u*)(Z + (size_t)(row0 + j) * LDZ + ZC_RQKV + 1024 + h * 128 + cc * 8);
        LAS unsigned char* d = LV + (cc * 8) * 272 + j * 2;
        *(LAS bf16*)(d) = (bf16)(w.x & 0xffff); *(LAS bf16*)(d + 272) = (bf16)(w.x >> 16); *(LAS bf16*)(d + 2 * 272) = (bf16)(w.y & 0xffff); *(LAS bf16*)(d + 3 * 272) = (bf16)(w.y >> 16);
        *(LAS bf16*)(d + 4 * 272) = (bf16)(w.z & 0xffff); *(LAS bf16*)(d + 5 * 272) = (bf16)(w.z >> 16); *(LAS bf16*)(d + 6 * 272) = (bf16)(w.w & 0xffff); *(LAS bf16*)(d + 7 * 272) = (bf16)(w.w >> 16);
    }
    __syncthreads();
    const float lg = ret_lg(h);
    const int il = 16 * wave + rl;
    bf16x8 qb[4];
#pragma unroll
    for (int s = 0; s < 4; ++s) qb[s] = ld_frag_l(LQ + il * 272 + (32 * s + 8 * quad) * 2);
    f32x4 C[8];
    const float qdec = __expf((float)(il + 1) * lg);
#pragma unroll
    for (int dt = 0; dt < 8; ++dt) {
        f32x4 a = (f32x4){0.f, 0.f, 0.f, 0.f};
#pragma unroll
        for (int s = 0; s < 4; ++s) a = mfma16(ld_frag_l(LS + (16 * dt + rl) * 272 + (32 * s + 8 * quad) * 2), qb[s], a);
        C[dt] = a * qdec;
    }
    for (int s2 = 0; s2 <= (wave >> 1); ++s2) {
        f32x4 P[2];
#pragma unroll
        for (int e = 0; e < 2; ++e) {
            const int jt = 2 * s2 + e;
            f32x4 a = (f32x4){0.f, 0.f, 0.f, 0.f};
            if (jt <= wave) {
#pragma unroll
                for (int s = 0; s < 4; ++s) a = mfma16(ld_frag_l(LK + (16 * jt + rl) * 272 + (32 * s + 8 * quad) * 2), qb[s], a);
#pragma unroll
                for (int i = 0; i < 4; ++i) { const int jj = 16 * jt + 4 * quad + i; a[i] = (il >= jj) ? a[i] * __expf((float)(il - jj) * lg) : 0.f; }
            }
            P[e] = a;
        }
        const bf16x8 pb = pack_frag(P[0], P[1]);
#pragma unroll
        for (int dt = 0; dt < 8; ++dt) {
            const LAS unsigned char* vp = LV + (16 * dt + rl) * 272 + (32 * s2 + 4 * quad) * 2;
            C[dt] = mfma16(mk_frag(*(const LAS v2u*)vp, *(const LAS v2u*)(vp + 32)), pb, C[dt]);
        }
    }
    float ss = 0.f;
#pragma unroll
    for (int dt = 0; dt < 8; ++dt) ss += (C[dt][0] * C[dt][0] + C[dt][1] * C[dt][1]) + (C[dt][2] * C[dt][2] + C[dt][3] * C[dt][3]);
    ss += shx<16>(ss, lane); ss += shx<32>(ss, lane);
    const float scl = rsqrtf(ss * (1.f / 128.f) + EPS);
    const size_t row = (size_t)row0 + il;
#pragma unroll
    for (int dt = 0; dt < 8; ++dt) {
        const v2u gwd = *(const v2u*)(Z + row * LDZ + ZC_RG + h * 128 + 16 * dt + 4 * quad);
        v2u w; w.x = pk2(C[dt][0] * scl * siluf_(lo_bf(gwd.x)), C[dt][1] * scl * siluf_(hi_bf(gwd.x))); w.y = pk2(C[dt][2] * scl * siluf_(lo_bf(gwd.y)), C[dt][3] * scl * siluf_(hi_bf(gwd.y)));
        *(v2u*)((bf16*)(ws + WS_MIX) + row * 1536 + 1024 + h * 128 + 16 * dt + 4 * quad) = w;
    }
    __syncthreads();
}
DI void gdn_out_row(Frame& F, int layer, int row) {
    const int lane = F.lane;
    unsigned char* ws = KWS();
    const float* o = (const float*)(ws + WS_OGDN) + (size_t)row * 512 + lane * 8;
    const f32x4 a = *(const f32x4*)o, b = *(const f32x4*)(o + 4);
    float ss = (a[0] * a[0] + a[1] * a[1]) + (a[2] * a[2] + a[3] * a[3]) + (b[0] * b[0] + b[1] * b[1]) + (b[2] * b[2] + b[3] * b[3]);
    ss += shx<1>(ss, lane); ss += shx<2>(ss, lane); ss += shx<4>(ss, lane); ss += shx<8>(ss, lane);
    const float scl = rsqrtf(ss * (1.f / 128.f) + EPS);
    const float* ng = KIN(18) + layer * 128 + (lane & 15) * 8;
    const f32x4 ga = *(const f32x4*)ng, gb = *(const f32x4*)(ng + 4);
    f32x4 za, zb; unpack8(*(const v4u*)((const bf16*)(ws + WS_Z) + (size_t)row * LDZ + ZC_GZ + lane * 8), za, zb);
    f32x4 ra, rb;
#pragma unroll
    for (int e = 0; e < 4; ++e) { ra[e] = a[e] * scl * ga[e] * siluf_(za[e]); rb[e] = b[e] * scl * gb[e] * siluf_(zb[e]); }
    *(v4u*)((bf16*)(ws + WS_MIX) + (size_t)row * 1536 + 512 + lane * 8) = pack8(ra, rb);
}
DI void final_row(Frame& F, int row) {
    const int lane = F.lane;
    const float* x = (const float*)(KWS() + WS_XR) + (size_t)row * DM;
    float* y = (row < MP) ? KOUT() + O_YP + (size_t)row * DM : KOUT() + O_YS + (size_t)(row - MP) * DM;
    f32x4 v[4]; float ss = 0.f;
#pragma unroll
    for (int j = 0; j < 4; ++j) { v[j] = *(const f32x4*)(x + 256 * j + lane * 4); ss += (v[j][0] * v[j][0] + v[j][1] * v[j][1]) + (v[j][2] * v[j][2] + v[j][3] * v[j][3]); }
    const float scl = rsqrtf(wave_sum(ss, lane) * (1.f / DM) + EPS);
#pragma unroll
    for (int j = 0; j < 4; ++j) *(f32x4*)(y + 256 * j + lane * 4) = v[j] * scl * *(const f32x4*)(KIN(26) + 256 * j + lane * 4);
}
template <class Epi>
DI void sgemm_tile(Frame& F, const bf16* A, int lda, const bf16* Bt, int ldb, int K, int row0, int col0, const Epi& E) {
    int lane = F.lane, wave = F.wave; asm volatile("" : "+v"(lane), "+s"(wave));
    const int tid = wave * 64 + lane, quad = lane >> 4, rl = lane & 15;
    const int kper = K >> 3, nks = kper >> 5;
    f32x4 acc[2][4];
#pragma unroll
    for (int rt = 0; rt < 2; ++rt)
#pragma unroll
        for (int ct = 0; ct < 4; ++ct) acc[rt][ct] = (f32x4){0.f, 0.f, 0.f, 0.f};
    const bf16* ap = A + (size_t)(row0 + rl) * lda + wave * kper + quad * 8;
    const bf16* bp = Bt + (size_t)(col0 + rl) * ldb + wave * kper + quad * 8;
#pragma unroll 4
    for (int ks = 0; ks < nks; ++ks) {
        bf16x8 a[2], b[4];
#pragma unroll
        for (int rt = 0; rt < 2; ++rt) a[rt] = ld_frag_g(ap + (size_t)(16 * rt) * lda + ks * 32);
#pragma unroll
        for (int ct = 0; ct < 4; ++ct) b[ct] = ld_frag_g(bp + (size_t)(16 * ct) * ldb + ks * 32);
#pragma unroll
        for (int rt = 0; rt < 2; ++rt)
#pragma unroll
            for (int ct = 0; ct < 4; ++ct) acc[rt][ct] = mfma16(a[rt], b[ct], acc[rt][ct]);
    }
    LAS float* RED = (LAS float*)F.lds;
#pragma unroll
    for (int rt = 0; rt < 2; ++rt)
#pragma unroll
        for (int ct = 0; ct < 4; ++ct)
#pragma unroll
            for (int i = 0; i < 4; ++i) RED[wave * 2176 + (16 * rt + 4 * quad + i) * 68 + 16 * ct + rl] = acc[rt][ct][i];
    __syncthreads();
    const int r = tid >> 4, c4 = (tid & 15) * 4;
    f32x4 v = *(const LAS f32x4*)(RED + r * 68 + c4);
#pragma unroll
    for (int w = 1; w < 8; ++w) v += *(const LAS f32x4*)(RED + w * 2176 + r * 68 + c4);
    E(row0 + r, col0 + c4, v, lane);
    __syncthreads();
}
struct SEpiC {
    const bf16* Z; bf16* G;
    DI void operator()(int row, int col, f32x4 v, int lane) const {
        const v2u gw = *(const v2u*)(Z + (size_t)row * LDZ + ZC_MG + col);
        v[0] *= sigmoidf_(lo_bf(gw.x)); v[1] *= sigmoidf_(hi_bf(gw.x)); v[2] *= sigmoidf_(lo_bf(gw.y)); v[3] *= sigmoidf_(hi_bf(gw.y));
        *(v2u*)(G + (size_t)row * 3072 + col) = pack4(v);
    }
};
struct SEpiRes {
    float* XR; bf16* XG; const float* gvec; float* SS; float* T; int mode;
    DI void operator()(int row, int col, f32x4 v, int lane) const {
        const size_t o = (size_t)row * DM + col;
        if (mode == 1) { *(f32x4*)(T + o) = v; return; }
        f32x4 x = *(const f32x4*)(XR + o);
        if (mode == 2) { const f32x4 t = *(const f32x4*)(T + o);
#pragma unroll
            for (int e = 0; e < 4; ++e) v[e] = t[e] * sigmoidf_(v[e]); }
        x += v;
        *(f32x4*)(XR + o) = x;
        if (XG) { f32x4 y = x; if (gvec) y *= *(const f32x4*)(gvec + col); *(v2u*)(XG + o) = pack4(y); }
        if (SS) { float ssq = (x[0] * x[0] + x[1] * x[1]) + (x[2] * x[2] + x[3] * x[3]);
            ssq += shx<1>(ssq, lane); ssq += shx<2>(ssq, lane); ssq += shx<4>(ssq, lane); ssq += shx<8>(ssq, lane);
            if ((lane & 15) == 0) SS[(size_t)row * 16 + (col >> 6)] = ssq; }
    }
};
struct SEpiUp {
    bf16* H; const float* SS;
    DI void operator()(int row, int col, f32x4 v, int lane) const {
        const f32x4 p0 = *(const f32x4*)(SS + (size_t)row * 16), p1 = *(const f32x4*)(SS + (size_t)row * 16 + 4), p2 = *(const f32x4*)(SS + (size_t)row * 16 + 8), p3 = *(const f32x4*)(SS + (size_t)row * 16 + 12);
        const f32x4 ps = (p0 + p1) + (p2 + p3);
        const float rstd = rsqrtf(((ps[0] + ps[1]) + (ps[2] + ps[3])) * (1.f / DM) + EPS);
#pragma unroll
        for (int e = 0; e < 4; ++e) { const float a = fmaxf(v[e] * rstd, 0.f); v[e] = a * a; }
        *(v2u*)(H + (size_t)row * DFF + col) = pack4(v);
    }
};
#ifndef PH_P0
#define PH_P0 1
#endif
#ifndef PH_A
#define PH_A 1
#endif
#ifndef PH_B0a
#define PH_B0a 1
#endif
#ifndef PH_B0b
#define PH_B0b 1
#endif
#ifndef PH_B0c
#define PH_B0c 1
#endif
#ifndef PH_B0d
#define PH_B0d 1
#endif
#ifndef PH_SCAN
#define PH_SCAN 1
#endif
#ifndef PH_RSCAN
#define PH_RSCAN 1
#endif
#ifndef PH_NSAP
#define PH_NSAP 1
#endif
#ifndef PH_NSAS
#define PH_NSAS 1
#endif
#ifndef PH_B2
#define PH_B2 1
#endif
#ifndef PH_C
#define PH_C 1
#endif
#ifndef PH_XBAR
#define PH_XBAR 0
#endif
#ifndef PH_D
#define PH_D 1
#endif
#ifndef PH_E
#define PH_E 1
#endif
#ifndef PH_F
#define PH_F 1
#endif
#ifndef PH_G1
#define PH_G1 1
#endif
#ifndef PH_G2
#define PH_G2 1
#endif
#ifndef PH_TREG
#define PH_TREG (-1)
#endif
#if PH_TREG >= 0
#define TREG_MARK(r) do { const unsigned long long now_ = __builtin_amdgcn_s_memrealtime(); if ((r) == PH_TREG) tacc_ += now_ - tlast_; tlast_ = now_; } while (0)
#define TREG_SUB(r) do { const unsigned long long now_ = __builtin_amdgcn_s_memrealtime(); if ((r) == PH_TREG) tacc_ += now_ - tsub_; tsub_ = now_; } while (0)
#else
#define TREG_MARK(r) do { } while (0)
#define TREG_SUB(r) do { } while (0)
#endif
struct Args { const void* in[27]; float* out; unsigned char* ws; };
__global__ void __launch_bounds__(NTHREADS, 2) mk_fwd(Args args) {
    extern __shared__ __attribute__((aligned(16))) unsigned char lds_raw[];
    Frame F;
    F.lds = (LAS unsigned char*)lds_raw;
    F.wave = __builtin_amdgcn_readfirstlane((int)threadIdx.x >> 6); F.lane = 0; F.tid = 0;
    F.G = gridDim.x; F.bid = blockIdx.x;
    F.ctl = (gu32*)(KWS() + WS_CTL);
    { const Frame Fp = fresh(F); for (int u = Fp.tid; u < (LDS_BYTES - LDSCTL_OFF) / 4; u += NTHREADS) ((LAS unsigned*)(F.lds + LDSCTL_OFF))[u] = 0u;
      __syncthreads();
      (void)xcd_barrier_post((unsigned*)(F.ctl + CW_BAR), (volatile LAS unsigned*)(F.lds + MISC_OFF) + 8, Fp.tid == 0); }
    const int G = F.G, bid = F.bid;
#if PH_TREG >= 0
    unsigned long long tacc_ = 0ull, tlast_ = __builtin_amdgcn_s_memrealtime(), tsub_ = tlast_;
#endif

        for (int rp_ = 0; rp_ < PH_P0; ++rp_) {
    { Frame Fp = fresh(F); p0_prologue(Fp); }
        }
    GRID_BAR();
    TREG_MARK(0);

    for (int layer = 0; layer < NLAYER; ++layer) {
        for (int rp_ = 0; rp_ < PH_A; ++rp_) {
        {
            const Frame Fg = fresh(F); const int G = Fg.G, bid = Fg.bid;
            unsigned char* ws = KWS();
            pg8::Gemm g{(const bf16*)(ws + WS_XGA), (const bf16*)(ws + WS_WIN + layer * SZ_WIN), MROWS, LDZ, DM, DM, DM, 31, 0};
            pg8::StaticOrder S; S.init(MROWS, LDZ, G, bid);
            epi::EpiA E{(bf16*)(ws + WS_Z), (float*)(ws + WS_ZS), (const float*)(ws + WS_SSA), KOUT(), layer};
            pg8::gemm_phase<epi::EpiA, pg8::StaticOrder, true, true>(Fg.lds, g, S, E, Fg.tid);
        }
        }
        GRID_BAR();
    TREG_MARK(1);
#if PH_TREG >= 0
        tsub_ = __builtin_amdgcn_s_memrealtime();
#endif
        {
            Frame Fp = fresh(F);
            gu32* qhead = F.ctl + CW_QUEUE + 512 * layer + 384;
            volatile LAS int* qslot = (volatile LAS int*)(F.lds + MISC_OFF) + 16;
            constexpr int NI = 5 * 272 * PH_B0d, N2 = 1024 * PH_B0c, N3 = 512 * PH_B0b;
            for (;;) {
                if (Fp.tid == 0) qslot[0] = (int)__hip_atomic_fetch_add(qhead, 1u, __ATOMIC_RELAXED, __HIP_MEMORY_SCOPE_AGENT);
                __syncthreads();
                int it = qslot[0];
                __syncthreads();
                it = __builtin_amdgcn_readfirstlane(it);
                if (it >= NI + N2 + N3) break;
                TREG_SUB(99);
                if (it < NI) { const int k = it / 5, r = it % 5;
                    if (r == 0) compress_job(Fp, layer, k % 272);
                    else if (k < 256 * PH_B0a) gdn_prep_unit(Fp, layer, (4 * k + r - 1) & 1023); }
                else { const int q = it - NI, g3 = q / 3, r3 = q % 3;
                    if (r3 < 2) sample_rec_unit(Fp, layer, (2 * g3 + r3) & 1023); else ret_prep_unit(Fp, layer, g3 & 511); }
                TREG_SUB(it < NI ? ((it % 5) == 0 ? 40 : 41) : (it < NI + N2 ? 42 : 43));
            }
        }
        GRID_BAR();
    TREG_MARK(2);
        {
            Frame Fp = fresh(F);
            gu32* qbase = F.ctl + CW_QUEUE + 512 * layer;
            volatile LAS int* qslot = (volatile LAS int*)(F.lds + MISC_OFF) + 16;
            constexpr int NQ = 8 * PH_SCAN, NS = 128 * PH_NSAS, NR = 32 * PH_RSCAN, NP = 256 * PH_NSAP;
            const int pref = (int)(xb_xcc_id() & 3u);
            for (;;) {
                if (Fp.tid == 0) qslot[1] = (int)__hip_atomic_fetch_add(qbase, 1u, __ATOMIC_RELAXED, __HIP_MEMORY_SCOPE_AGENT);
                __syncthreads();
                int it = qslot[1];
                __syncthreads();
                it = __builtin_amdgcn_readfirstlane(it);
                if (it >= NQ + NR) break;
                TREG_SUB(99);
                if (it < NQ) gdn_scan_chain(Fp, layer, it & 7);
                else ret_scan_part(Fp, layer, (it - NQ) & 31);
                TREG_SUB(it < NQ ? 21 : 23);
            }
            const int when = Fp.bid & 3;
            bool tried = false;
            for (int nu = 0;; ++nu) {
                if (Fp.tid == 0) {
                    int kind = -1, idx = 0;
                    if (!tried && nu >= when) {
                        tried = true;
                        const int a = (int)__hip_atomic_fetch_add(qbase + 320, 1u, __ATOMIC_RELAXED, __HIP_MEMORY_SCOPE_AGENT);
                        if (a < NS) { kind = 4; idx = a; }
                    }
                    if (kind < 0) {
                        for (int k = 0; k < 4 && kind < 0; ++k) { const int s = (pref + k) & 3;
                            if ((int)__hip_atomic_load(qbase + 64 * (1 + s), __ATOMIC_RELAXED, __HIP_MEMORY_SCOPE_AGENT) < NP) {
                                const int r = (int)__hip_atomic_fetch_add(qbase + 64 * (1 + s), 1u, __ATOMIC_RELAXED, __HIP_MEMORY_SCOPE_AGENT);
                                if (r < NP) { kind = s; idx = r; } } }
                    }
                    if (kind < 0) {
                        const int a = (int)__hip_atomic_fetch_add(qbase + 320, 1u, __ATOMIC_RELAXED, __HIP_MEMORY_SCOPE_AGENT);
                        if (a < NS) { kind = 4; idx = a; }
                    }
                    qslot[0] = kind; qslot[1] = idx;
                }
                __syncthreads();
                int kind = qslot[0], it = qslot[1];
                __syncthreads();
                kind = __builtin_amdgcn_readfirstlane(kind); it = __builtin_amdgcn_readfirstlane(it);
                if (kind < 0) break;
                TREG_SUB(99);
                if (kind < 4) nsa_prompt_unit(Fp, layer, (kind << 8) | (255 - (it & 255)));
                else nsa_sample_unit(Fp, layer, it & 127);
                TREG_SUB(kind < 4 ? 20 : 22);
            }
        }
        GRID_BAR();
    TREG_MARK(3);
        for (int rp_ = 0; rp_ < PH_B2; ++rp_) {
        { Frame Fp = fresh(F); for (int u = Fp.bid; u < 512; u += Fp.G) ret_out_unit(Fp, layer, u); }
        { Frame Fp = fresh(F); for (int r = Fp.bid * NWAVES + Fp.wave; r < MROWS; r += Fp.G * NWAVES) gdn_out_row(Fp, layer, r); }
        }
        GRID_BAR();
    TREG_MARK(4);
        for (int rp_ = 0; rp_ < PH_C; ++rp_) {
        {
            const Frame Fg = fresh(F); const int G = Fg.G, bid = Fg.bid;
            unsigned char* ws = KWS();
            pg8::Gemm g{(const bf16*)(ws + WS_MIX), (const bf16*)(ws + WS_WBR + layer * SZ_WBR), MP, 3072, 512, 1536, 512, 2, 1024};
            pg8::StaticOrder S; S.init(MP, 3072, G, bid);
            epi::EpiC E{(const bf16*)(ws + WS_Z), (bf16*)(ws + WS_GATED)};
            pg8::gemm_phase<epi::EpiC, pg8::StaticOrder, true, true>(Fg.lds, g, S, E, Fg.tid);
            TREG_SUB(99);
            {
                Frame Fs = fresh(F); const SEpiC Es{(const bf16*)(ws + WS_Z), (bf16*)(ws + WS_GATED)};
                for (int tl = Fs.bid; tl < 16 * 48; tl += Fs.G) { const int rt = tl & 15, ct = tl >> 4, b = ct >> 4;
                    sgemm_tile(Fs, (const bf16*)(ws + WS_MIX) + b * 512, 1536, (const bf16*)(ws + WS_WBR + layer * SZ_WBR), 512, 512, MP + 32 * rt, 64 * ct, Es); }
            }
            TREG_SUB(31);
        }
        }
        GRID_BAR();
    TREG_MARK(5);
        for (int rp_ = 0; rp_ < PH_D; ++rp_) {
        {
            const Frame Fg = fresh(F); const int G = Fg.G, bid = Fg.bid;
            unsigned char* ws = KWS();
            pg8::Gemm g{(const bf16*)(ws + WS_GATED), (const bf16*)(ws + WS_WO3 + layer * SZ_WO3), MP, DM, 3072, 3072, 3072, 31, 0};
            pg8::StaticOrder S; S.init(MP, DM, G, bid);
            epi::EpiRes E{(float*)(ws + WS_XR), (bf16*)(ws + WS_XGB), KIN(21) + layer * DM, (float*)(ws + WS_SSB), nullptr, (rp_ + 1 < PH_D) ? 3 : 0};
            pg8::gemm_phase<epi::EpiRes, pg8::StaticOrder, true, true>(Fg.lds, g, S, E, Fg.tid);
            TREG_SUB(99);
            if (rp_ + 1 == PH_D) {
                Frame Fs = fresh(F); const SEpiRes Es{(float*)(ws + WS_XR), (bf16*)(ws + WS_XGB), KIN(21) + layer * DM, (float*)(ws + WS_SSB), nullptr, 0};
                for (int tl = Fs.bid; tl < 256; tl += Fs.G) sgemm_tile(Fs, (const bf16*)(ws + WS_GATED), 3072, (const bf16*)(ws + WS_WO3 + layer * SZ_WO3), 3072, 3072, MP + 32 * (tl & 15), 64 * (tl >> 4), Es);
            }
            TREG_SUB(32);
        }
        }
        GRID_BAR();
    TREG_MARK(6);
        for (int rp_ = 0; rp_ < PH_E; ++rp_) {
        {
            const Frame Fg = fresh(F); const int G = Fg.G, bid = Fg.bid;
            unsigned char* ws = KWS();
            pg8::Gemm g{(const bf16*)(ws + WS_XGB), (const bf16*)(ws + WS_WUP + layer * SZ_WUP), MP, DFF, DM, DM, DM, 31, 0};
            pg8::StaticOrder S; S.init(MP, DFF, G, bid);
            epi::EpiUp E{(bf16*)(ws + WS_HMID), (const float*)(ws + WS_SSB)};
            pg8::gemm_phase<epi::EpiUp, pg8::StaticOrder, true, true>(Fg.lds, g, S, E, Fg.tid);
            TREG_SUB(99);
            {
                Frame Fs = fresh(F); const SEpiUp Es{(bf16*)(ws + WS_HMID), (const float*)(ws + WS_SSB)};
                for (int tl = Fs.bid; tl < 16 * 64; tl += Fs.G) sgemm_tile(Fs, (const bf16*)(ws + WS_XGB), DM, (const bf16*)(ws + WS_WUP + layer * SZ_WUP), DM, DM, MP + 32 * (tl & 15), 64 * (tl >> 4), Es);
            }
            TREG_SUB(33);
        }
        }
        GRID_BAR();
    TREG_MARK(7);
        for (int rp_ = 0; rp_ < PH_F; ++rp_) {
        {
            const Frame Fg = fresh(F); const int G = Fg.G, bid = Fg.bid;
            unsigned char* ws = KWS();
            pg8::Gemm g{(const bf16*)(ws + WS_HMID), (const bf16*)(ws + WS_WDN + layer * SZ_WDN), MP, DM, DFF, DFF, DFF, 31, 0};
            pg8::StaticOrder S; S.init(MP, DM, G, bid);
            epi::EpiRes E{(float*)(ws + WS_XR), (bf16*)(ws + WS_XGC), nullptr, nullptr, nullptr, (rp_ + 1 < PH_F) ? 3 : 0};
            pg8::gemm_phase<epi::EpiRes, pg8::StaticOrder, true, true>(Fg.lds, g, S, E, Fg.tid);
            TREG_SUB(99);
            if (rp_ + 1 == PH_F) {
                Frame Fs = fresh(F); const SEpiRes Es{(float*)(ws + WS_XR), (bf16*)(ws + WS_XGC), nullptr, nullptr, nullptr, 0};
                for (int tl = Fs.bid; tl < 256; tl += Fs.G) sgemm_tile(Fs, (const bf16*)(ws + WS_HMID), DFF, (const bf16*)(ws + WS_WDN + layer * SZ_WDN), DFF, DFF, MP + 32 * (tl & 15), 64 * (tl >> 4), Es);
            }
            TREG_SUB(34);
        }
        }
        GRID_BAR();
    TREG_MARK(8);
        for (int rp_ = 0; rp_ < PH_G1; ++rp_) {
        {
            const Frame Fg = fresh(F); const int G = Fg.G, bid = Fg.bid;
            unsigned char* ws = KWS();
            int kple = PLE; asm volatile("" : "+s"(kple));
            pg8::Gemm g{(const bf16*)(ws + WS_P16) + (size_t)layer * MROWS * PLE, (const bf16*)(ws + WS_WPL + layer * SZ_WPL), MP, DM, kple, PLE, PLE, 31, 0};
            pg8::StaticOrder S; S.init(MP, DM, G, bid);
            epi::EpiRes E{nullptr, nullptr, nullptr, nullptr, (float*)(ws + WS_TPLE), 1};
            pg8::gemm_phase<epi::EpiRes, pg8::StaticOrder, true, true>(Fg.lds, g, S, E, Fg.tid);
            TREG_SUB(99);
            {
                Frame Fs = fresh(F); const SEpiRes Es{nullptr, nullptr, nullptr, nullptr, (float*)(ws + WS_TPLE), 1};
                for (int tl = Fs.bid; tl < 256; tl += Fs.G) sgemm_tile(Fs, (const bf16*)(ws + WS_P16) + (size_t)layer * MROWS * PLE, PLE, (const bf16*)(ws + WS_WPL + layer * SZ_WPL), PLE, PLE, MP + 32 * (tl & 15), 64 * (tl >> 4), Es);
            }
            TREG_SUB(35);
        }
        }
        for (int rp_ = 0; rp_ < PH_G2; ++rp_) {
        {
            const Frame Fg = fresh(F); const int G = Fg.G, bid = Fg.bid;
            unsigned char* ws = KWS();
            const bool more = layer + 1 < NLAYER;
            pg8::Gemm g{(const bf16*)(ws + WS_XGC), (const bf16*)(ws + WS_WPG + layer * SZ_WPG), MP, DM, DM, DM, DM, 31, 0};
            pg8::StaticOrder S; S.init(MP, DM, G, bid);
            epi::EpiRes E{(float*)(ws + WS_XR), more ? (bf16*)(ws + WS_XGA) : nullptr, more ? KIN(10) + (layer + 1) * DM : nullptr, more ? (float*)(ws + WS_SSA) : nullptr, (float*)(ws + WS_TPLE), (rp_ + 1 < PH_G2) ? 3 : 2};
            pg8::gemm_phase<epi::EpiRes, pg8::StaticOrder, true, true>(Fg.lds, g, S, E, Fg.tid);
            TREG_SUB(99);
            if (rp_ + 1 == PH_G2) {
                Frame Fs = fresh(F); const SEpiRes Es{(float*)(ws + WS_XR), more ? (bf16*)(ws + WS_XGA) : nullptr, more ? KIN(10) + (layer + 1) * DM : nullptr, more ? (float*)(ws + WS_SSA) : nullptr, (float*)(ws + WS_TPLE), 2};
                for (int tl = Fs.bid; tl < 256; tl += Fs.G) sgemm_tile(Fs, (const bf16*)(ws + WS_XGC), DM, (const bf16*)(ws + WS_WPG + layer * SZ_WPG), DM, DM, MP + 32 * (tl & 15), 64 * (tl >> 4), Es);
            }
            TREG_SUB(36);
        }
        }
        GRID_BAR();
    TREG_MARK(9);
    }
    for (int xb_ = 0; xb_ < PH_XBAR; ++xb_) GRID_BAR();
    { Frame Fp = fresh(F); for (int r = Fp.bid * NWAVES + Fp.wave; r < MROWS; r += Fp.G * NWAVES) final_row(Fp, r); }
    TREG_MARK(10);
#if PH_TREG >= 0
#if defined(PH_GPT) && PH_GPT >= 0
    tacc_ += *(volatile LAS unsigned long long*)(F.lds + LDSCTL_OFF + 448);
#endif
#if defined(PH_NPT) && PH_NPT >= 0
    tacc_ += *(volatile LAS unsigned long long*)(F.lds + LDSCTL_OFF + 464);
#endif
      { const unsigned long long tend_ = __builtin_amdgcn_s_memrealtime() + tacc_; while (__builtin_amdgcn_s_memrealtime() < tend_) __builtin_amdgcn_s_sleep(8); }
#endif
}

extern "C" void kernel_launch(void* const* d_in, const int* in_sizes, int n_in, void* d_out, int out_size, void* d_ws, size_t ws_size, hipStream_t stream) {
    static int grid = 0;
    if (grid == 0) {
        if (n_in != 27 || ws_size < WS_END) { fprintf(stderr, "kernel_launch: unexpected shapes (n_in %d out %d ws %zu, need %zu)\n", n_in, out_size, ws_size, (size_t)WS_END); grid = -1; return; }
        int dev = 0, cus = 0;
        if (hipGetDevice(&dev) != hipSuccess || hipDeviceGetAttribute(&cus, hipDeviceAttributeMultiprocessorCount, dev) != hipSuccess) { grid = -1; return; }
        if (hipFuncSetAttribute((const void*)mk_fwd, hipFuncAttributeMaxDynamicSharedMemorySize, LDS_BYTES) != hipSuccess) { fprintf(stderr, "kernel_launch: hipFuncSetAttribute failed\n"); grid = -1; return; }
        int per_cu = 0;
        if (hipOccupancyMaxActiveBlocksPerMultiprocessor(&per_cu, (const void*)mk_fwd, NTHREADS, LDS_BYTES) != hipSuccess || per_cu < 1) fprintf(stderr, "kernel_launch: occupancy query reports %d\n", per_cu);
        (void)hipGetLastError();
        grid = cus;
    }
    if (grid < 0) return;
    if (hipMemsetAsync((char*)d_ws + WS_CTL, 0, CTL_ZERO_BYTES, stream) != hipSuccess) return;
    Args a{};
    for (int i = 0; i < 27; ++i) a.in[i] = d_in[i];
    a.out = (float*)d_out; a.ws = (unsigned char*)d_ws;
    hipLaunchKernelGGL(mk_fwd, dim3(grid), dim3(NTHREADS), LDS_BYTES, stream, a);
}
```

```cpp
#include <hip/hip_runtime.h>
#include <cstdio>
#include <cstdint>
namespace pg8 {
#define PG8_LAS __attribute__((address_space(3)))
typedef unsigned short bf16_t;
typedef short bf16x8 __attribute__((ext_vector_type(8)));
typedef float f32x4 __attribute__((ext_vector_type(4)));
typedef unsigned u32x4 __attribute__((ext_vector_type(4)));
constexpr int BM = 256, BK = 64, HALF = 128, HTB = HALF * BK * 2  , STAGE_BYTES = 8 * HTB, NXCD = 8, WGM = 8;

__host__ __device__ __forceinline__ int lds_byte(int r, int c) { const int st = (r >> 4) * 2 + (c >> 5), rr = r & 15, cc = c & 31, ob = rr * 64 + cc * 2; return st * 1024 + (ob ^ (((ob >> 9) & 1) << 5)); }
__host__ __device__ __forceinline__ void stage_rc(int b, int& R, int& C) { const int st = b / 1024, sb = b % 1024, swz = sb ^ (((sb >> 9) & 1) << 5); R = (st >> 1) * 16 + swz / 64; C = (st & 1) * 32 + (swz % 64) / 2; }
__host__ __device__ __forceinline__ int perm32(int rho) { const int n = rho >> 4, i = rho & 15; return 8 * (i >> 2) + 4 * n + (i & 3); }

struct Unit { int pm, pn; };
struct Gemm { const bf16_t* A; const bf16_t* Bt; int M, N, K; int lda, ldb; int a_shift, a_off; };

struct StaticOrder {
    int nM, nN, nwg, G, c;
    __host__ __device__ void init(int M, int N, int G_, int c_) { nM = M / BM; nN = N / BM; nwg = nM * nN; G = G_; c = c_; }
    __host__ __device__ bool next(int i, Unit& u) const {
        const long L = (long)i * G + c; if (L >= nwg) return false;
        int wgid = (int)L; { const int q = nwg / NXCD, r = nwg % NXCD, xcd = wgid % NXCD, off = wgid / NXCD; wgid = (xcd < r ? xcd * (q + 1) : r * (q + 1) + (xcd - r) * q) + off; }
        const int nig = WGM * nN, gid = wgid / nig, fm = gid * WGM, gsz = (nM - fm) < WGM ? (nM - fm) : WGM;
        u.pm = fm + ((wgid % nig) % gsz); u.pn = (wgid % nig) / gsz; return true;
    }
    __device__ __forceinline__ void a_ready(const Unit&) const {}
    __device__ __forceinline__ void done(const Unit&) const {}
};

__device__ __forceinline__ unsigned cvt_pk_bf16(float lo, float hi) { unsigned r; asm volatile("v_cvt_pk_bf16_f32 %0, %1, %2" : "=v"(r) : "v"(lo), "v"(hi)); return r; }
typedef float f32x2 __attribute__((ext_vector_type(2)));
template <class Epi, class Sched, bool ALIGN_EPI = false, bool SP2 = false>
__device__ __forceinline__ void gemm_phase(PG8_LAS unsigned char* lds, const Gemm g, const Sched& S, const Epi& E, const int tid) {
    const int wid = __builtin_amdgcn_readfirstlane(tid >> 6), lane = tid & 63, wr = wid >> 2, wc = wid & 3, fr = lane & 15, fq = lane >> 4;
    const int K = g.K, nt = K / BK;
    unsigned voffA[2], voffB[2];
#pragma unroll
    for (int i = 0; i < 2; ++i) { int R, C; stage_rc(tid * 16 + i * 8192, R, C); const int Rb = Epi::PERM ? ((R & ~31) + perm32(R & 31)) : R;
        voffA[i] = (unsigned)(R * g.lda + C) * 2u; voffB[i] = (unsigned)(Rb * g.ldb + C) * 2u; }
    const size_t kstep = (size_t)(BK * 2);
    const size_t hstepA = (size_t)HALF * g.lda * 2, hstepB = (size_t)HALF * g.ldb * 2;
    const size_t tstepA = 2 * hstepA, tstepB = 2 * hstepB;
    const unsigned ldsw = (unsigned)wid * 1024u;
    const int aoff = lds_byte(wr * 64 + fr, fq * 8), boff = lds_byte(wc * 32 + fr, fq * 8);
#define PG8_SA(b, h) (((b) * 2 + (h)) * HTB)
#define PG8_SB(b, h) ((4 + (b) * 2 + (h)) * HTB)
#define PG8_STAGE(bufoff, gbase, voff) do { _Pragma("unroll") for (int _i = 0; _i < 2; ++_i) \
        __builtin_amdgcn_global_load_lds((const unsigned*)((const char*)(gbase) + (voff)[_i]), (PG8_LAS unsigned*)(lds + (bufoff) + ldsw + _i * 8192), 16, 0, 0); } while (0)
#define PG8_LDA(dst, b, h) do { _Pragma("unroll") for (int m = 0; m < 4; ++m) _Pragma("unroll") for (int k = 0; k < 2; ++k) dst[m][k] = *(const PG8_LAS bf16x8*)(lds + PG8_SA(b, h) + aoff + m * 2048 + k * 1024); } while (0)
#define PG8_LDB(dst, b, h) do { _Pragma("unroll") for (int n = 0; n < 2; ++n) _Pragma("unroll") for (int k = 0; k < 2; ++k) dst[n][k] = *(const PG8_LAS bf16x8*)(lds + PG8_SB(b, h) + boff + n * 2048 + k * 1024); } while (0)
#define PG8_MMA(ai, bj, At, Bt) do { __builtin_amdgcn_s_setprio(1); _Pragma("unroll") for (int m = 0; m < 4; ++m) _Pragma("unroll") for (int n = 0; n < 2; ++n) _Pragma("unroll") for (int k = 0; k < 2; ++k) \
        acc[ai][bj][m][n] = __builtin_amdgcn_mfma_f32_16x16x32_bf16(Bt[n][k], At[m][k], acc[ai][bj][m][n], 0, 0, 0); __builtin_amdgcn_s_setprio(0); } while (0)
#define PG8_WAIT_V(n) asm volatile("s_waitcnt vmcnt(" #n ")" ::: "memory")
#define PG8_WAIT_L(n) asm volatile("s_waitcnt lgkmcnt(" #n ")" ::: "memory")
#define PG8_BAR __builtin_amdgcn_s_barrier()
#define PG8_SCHED __builtin_amdgcn_sched_barrier(0)
    Unit cur, nxt; int ui = 0;
    if (!S.next(0, cur)) return;
    f32x4 acc[2][2][4][2];
#pragma unroll
    for (int a = 0; a < 2; ++a)
#pragma unroll
        for (int b = 0; b < 2; ++b)
#pragma unroll
            for (int m = 0; m < 4; ++m)
#pragma unroll
                for (int n = 0; n < 2; ++n) acc[a][b][m][n] = (f32x4){0.f, 0.f, 0.f, 0.f};
    bf16x8 At[4][2], B0[2][2], B1[2][2];
    const char* cA = (const char*)g.A + (size_t)cur.pm * tstepA + (size_t)(cur.pn >> g.a_shift) * (size_t)g.a_off; const char* cB = (const char*)g.Bt + (size_t)cur.pn * tstepB;
    S.a_ready(cur);
    if constexpr (SP2) {
        PG8_STAGE(PG8_SB(0, 0), cB, voffB); PG8_STAGE(PG8_SB(0, 1), cB + hstepB, voffB); PG8_STAGE(PG8_SA(0, 0), cA, voffA); PG8_STAGE(PG8_SA(0, 1), cA + hstepA, voffA);
        if (wr == 1) PG8_BAR;
        PG8_WAIT_V(2); PG8_BAR;
        PG8_STAGE(PG8_SB(1, 0), cB + kstep, voffB); PG8_STAGE(PG8_SA(1, 0), cA + kstep, voffA); PG8_STAGE(PG8_SB(1, 1), cB + hstepB + kstep, voffB);
        PG8_WAIT_V(6); PG8_BAR;
    } else {
        PG8_STAGE(PG8_SB(0, 0), cB, voffB); PG8_STAGE(PG8_SA(0, 0), cA, voffA); PG8_STAGE(PG8_SB(0, 1), cB + hstepB, voffB); PG8_STAGE(PG8_SA(0, 1), cA + hstepA, voffA);
        if (wr == 1) PG8_BAR;
        PG8_WAIT_V(4); PG8_BAR;
        PG8_STAGE(PG8_SB(1, 0), cB + kstep, voffB); PG8_STAGE(PG8_SA(1, 0), cA + kstep, voffA); PG8_STAGE(PG8_SB(1, 1), cB + hstepB + kstep, voffB);
        PG8_WAIT_V(6); PG8_BAR;
    }
    for (;;) {
        const bool has_next = S.next(ui + 1, nxt);
        const char* nA = has_next ? (const char*)g.A + (size_t)nxt.pm * tstepA + (size_t)(nxt.pn >> g.a_shift) * (size_t)g.a_off : cA; const char* nB = has_next ? (const char*)g.Bt + (size_t)nxt.pn * tstepB : cB;
        for (int t = 0; t < nt; t += 2) {
            const bool last = (t == nt - 2);
            const char* a1 = cA + (size_t)(t + 1) * kstep;
            const char* a2 = last ? nA : cA + (size_t)(t + 2) * kstep; const char* b2 = last ? nB : cB + (size_t)(t + 2) * kstep;
            const char* a3 = a2 + kstep; const char* b3 = b2 + kstep;
            if (last && has_next) S.a_ready(nxt);
            if constexpr (SP2) {
            PG8_LDB(B0, 0, 0); PG8_LDB(B1, 0, 1); PG8_SCHED; PG8_LDA(At, 0, 0); PG8_STAGE(PG8_SA(1, 1), a1 + hstepA, voffA);
            PG8_WAIT_V(8); PG8_WAIT_L(0); PG8_BAR; PG8_MMA(0, 0, At, B0); PG8_MMA(0, 1, At, B1); PG8_BAR; PG8_SCHED;
            PG8_LDA(At, 0, 1); PG8_STAGE(PG8_SB(0, 0), b2, voffB); PG8_STAGE(PG8_SB(0, 1), b2 + hstepB, voffB); PG8_STAGE(PG8_SA(0, 0), a2, voffA);
            PG8_WAIT_V(8); PG8_WAIT_L(0); PG8_BAR; PG8_MMA(1, 0, At, B0); PG8_MMA(1, 1, At, B1); PG8_BAR; PG8_SCHED;
            PG8_LDB(B0, 1, 0); PG8_LDB(B1, 1, 1); PG8_SCHED; PG8_LDA(At, 1, 0); PG8_STAGE(PG8_SA(0, 1), a2 + hstepA, voffA);
            PG8_WAIT_V(8); PG8_WAIT_L(0); PG8_BAR; PG8_MMA(0, 0, At, B0); PG8_MMA(0, 1, At, B1); PG8_BAR; PG8_SCHED;
            PG8_LDA(At, 1, 1); PG8_STAGE(PG8_SB(1, 0), b3, voffB); PG8_STAGE(PG8_SB(1, 1), b3 + hstepB, voffB); PG8_STAGE(PG8_SA(1, 0), a3, voffA);
            PG8_WAIT_V(8); PG8_WAIT_L(0); PG8_BAR; PG8_MMA(1, 0, At, B0); PG8_MMA(1, 1, At, B1); PG8_BAR; PG8_SCHED;
            } else {
            PG8_LDB(B0, 0, 0); PG8_SCHED; PG8_LDA(At, 0, 0); PG8_STAGE(PG8_SA(1, 1), a1 + hstepA, voffA);
            PG8_WAIT_L(8); PG8_BAR; PG8_WAIT_L(0); PG8_MMA(0, 0, At, B0); PG8_BAR; PG8_SCHED;
            PG8_LDB(B1, 0, 1); PG8_STAGE(PG8_SB(0, 0), b2, voffB);
            PG8_BAR; PG8_WAIT_L(0); PG8_MMA(0, 1, At, B1); PG8_BAR;
            PG8_LDA(At, 0, 1); PG8_STAGE(PG8_SA(0, 0), a2, voffA);
            PG8_BAR; PG8_WAIT_L(0); PG8_MMA(1, 0, At, B0); PG8_BAR; PG8_SCHED;
            PG8_STAGE(PG8_SB(0, 1), b2 + hstepB, voffB);
            PG8_WAIT_V(6); PG8_BAR; PG8_MMA(1, 1, At, B1); PG8_BAR;
            PG8_LDB(B0, 1, 0); PG8_SCHED; PG8_LDA(At, 1, 0); PG8_STAGE(PG8_SA(0, 1), a2 + hstepA, voffA);
            PG8_WAIT_L(8); PG8_BAR; PG8_WAIT_L(0); PG8_MMA(0, 0, At, B0); PG8_BAR; PG8_SCHED;
            PG8_LDB(B1, 1, 1); PG8_STAGE(PG8_SB(1, 0), b3, voffB);
            PG8_BAR; PG8_WAIT_L(0); PG8_MMA(0, 1, At, B1); PG8_BAR;
            PG8_LDA(At, 1, 1); PG8_STAGE(PG8_SA(1, 0), a3, voffA);
            PG8_BAR; PG8_WAIT_L(0); PG8_MMA(1, 0, At, B0); PG8_BAR; PG8_SCHED;
            PG8_STAGE(PG8_SB(1, 1), b3 + hstepB, voffB);
            PG8_WAIT_V(6); PG8_BAR; PG8_MMA(1, 1, At, B1); PG8_BAR;
            }
        }
        if constexpr (ALIGN_EPI) { if (wr == 0) PG8_BAR; }
        if constexpr (!Epi::AFTER_DRAIN) { E(acc, cur, wr, wc, fr, fq); S.done(cur); }
        if (!has_next) break;
#pragma unroll
        for (int a = 0; a < 2; ++a)
#pragma unroll
            for (int b = 0; b < 2; ++b)
#pragma unroll
                for (int m = 0; m < 4; ++m)
#pragma unroll
                    for (int n = 0; n < 2; ++n) acc[a][b][m][n] = (f32x4){0.f, 0.f, 0.f, 0.f};
        cur = nxt; cA = nA; cB = nB; ++ui;
        if constexpr (ALIGN_EPI) { if (wr == 1) PG8_BAR; }
    }
    PG8_WAIT_V(0);
    if constexpr (!ALIGN_EPI) { if (wr == 0) PG8_BAR; }
    PG8_BAR;
    if constexpr (Epi::AFTER_DRAIN) { E.fused(acc, cur, wr, wc, fr, fq, lds, wid, lane); S.done(cur); }
#undef PG8_SA
#undef PG8_SB
#undef PG8_STAGE
#undef PG8_LDA
#undef PG8_LDB
#undef PG8_MMA
#undef PG8_WAIT_V
#undef PG8_WAIT_L
#undef PG8_BAR
#undef PG8_SCHED
}
}
#define DI __device__ __forceinline__
#define GAS __attribute__((address_space(1)))
#define LAS __attribute__((address_space(3)))
typedef unsigned short bf16;
typedef unsigned v4u __attribute__((ext_vector_type(4)));
typedef unsigned v2u __attribute__((ext_vector_type(2)));
typedef float f32x4 __attribute__((ext_vector_type(4)));
typedef float f32x2 __attribute__((ext_vector_type(2)));
typedef short bf16x8 __attribute__((ext_vector_type(8)));
typedef short s16x4 __attribute__((ext_vector_type(4)));
typedef GAS unsigned gu32;

constexpr int DM = 1024, TP = 8192, MP = 16384, MS = 512, MROWS = 16896, LDZ = 8704, DFF = 4096, PLE = 256, NLAYER = 2;
constexpr int ZC_Q = 0, ZC_KC = 512, ZC_VC = 640, ZC_KS = 768, ZC_VS = 896, ZC_KW = 1024, ZC_VW = 1152, ZC_GQKV = 1280, ZC_GZ = 2816, ZC_RQKV = 3328, ZC_RG = 4864, ZC_MG = 5376, ZC_SM = 8448;
constexpr float EPS = 1e-6f;
constexpr size_t O_YP = 0, O_YS = O_YP + (size_t)MP * DM, O_KVP = O_YS + (size_t)MS * DM, O_KVS = O_KVP + (size_t)2 * MP * 512, O_WINP = O_KVS + (size_t)2 * MS * 512,
                 O_WINS = O_WINP + (size_t)2 * 2 * 512 * 256, O_CVP = O_WINS + (size_t)2 * 128 * 512 * 256, O_CVS = O_CVP + (size_t)2 * 2 * 3 * 1536, O_GSP = O_CVS + (size_t)2 * 128 * 3 * 1536,
                 O_GSS = O_GSP + (size_t)2 * 2 * 4 * 16384, O_RSP = O_GSS + (size_t)2 * 128 * 4 * 16384, O_RSS = O_RSP + (size_t)2 * 2 * 4 * 16384, O_END = O_RSS + (size_t)2 * 128 * 4 * 16384;

DI float bf2f(unsigned short b) { return __uint_as_float((unsigned)b << 16); }
DI unsigned f2bf(float f) { unsigned u = __float_as_uint(f); return (u + 0x7fffu + ((u >> 16) & 1u)) >> 16; }
typedef __bf16 bf16x2_t __attribute__((ext_vector_type(2)));
DI unsigned pk2(float lo, float hi) { const f32x2 v = {lo, hi}; return __builtin_bit_cast(unsigned, __builtin_convertvector(v, bf16x2_t)); }
DI float lo_bf(unsigned w) { return __uint_as_float(w << 16); }
DI float hi_bf(unsigned w) { return __uint_as_float(w & 0xffff0000u); }
DI float sigmoidf_(float x) { return 1.f / (1.f + __expf(-x)); }
DI float siluf_(float x) { return x / (1.f + __expf(-x)); }
DI v4u pack8(const f32x4 a, const f32x4 b) { v4u w; w.x = pk2(a[0], a[1]); w.y = pk2(a[2], a[3]); w.z = pk2(b[0], b[1]); w.w = pk2(b[2], b[3]); return w; }
DI void unpack8(const v4u w, f32x4& a, f32x4& b) { a[0] = lo_bf(w.x); a[1] = hi_bf(w.x); a[2] = lo_bf(w.y); a[3] = hi_bf(w.y); b[0] = lo_bf(w.z); b[1] = hi_bf(w.z); b[2] = lo_bf(w.w); b[3] = hi_bf(w.w); }

template <int M> DI int shxi(int v, int lane) {
    if constexpr (M < 32) return __builtin_amdgcn_ds_swizzle(v, (M << 10) | 0x1f);
    else return __builtin_amdgcn_ds_bpermute((lane ^ 32) << 2, v);
}
template <int M> DI float shx(float v, int lane) { return __int_as_float(shxi<M>(__float_as_int(v), lane)); }
DI float wave_sum(float v, int lane) { v += shx<1>(v, lane); v += shx<2>(v, lane); v += shx<4>(v, lane); v += shx<8>(v, lane); v += shx<16>(v, lane); v += shx<32>(v, lane); return v; }

namespace epi {
using pg8::Unit; using pg8::bf16_t;
DI float row_rstd(const float* SS, int row, int fq, int lane) {
    const f32x4 p = *(const f32x4*)(SS + (size_t)row * 16 + 4 * fq);
    float s = (p[0] + p[1]) + (p[2] + p[3]); s += shx<16>(s, lane); s += shx<32>(s, lane);
    return rsqrtf(s * (1.f / DM) + EPS);
}
struct EpiA {
    static constexpr bool PERM = true, AFTER_DRAIN = false;
    bf16* Z; float* ZS; const float* SS; float* out; int layer;
    DI void operator()(const f32x4 (&acc)[2][2][4][2], const Unit& u, int wr, int wc, int fr, int fq) const {
        asm volatile("" : "+v"(fr), "+v"(fq), "+s"(wr), "+s"(wc));
        const int pn = u.pn;
        float rs[2][4];
#pragma unroll
        for (int ai = 0; ai < 2; ++ai)
#pragma unroll
            for (int m = 0; m < 4; ++m) rs[ai][m] = row_rstd(SS, u.pm * 256 + ai * 128 + wr * 64 + m * 16 + fr, fq, fr + 16 * fq);
#pragma unroll
        for (int ai = 0; ai < 2; ++ai)
#pragma unroll
            for (int m = 0; m < 4; ++m) {
                const int row = u.pm * 256 + ai * 128 + wr * 64 + m * 16 + fr;
                const float rstd = rs[ai][m];
#pragma unroll
                for (int bj = 0; bj < 2; ++bj) {
                    const int col = pn * 256 + bj * 128 + wc * 32 + 8 * fq;
                    const f32x4 v0 = acc[ai][bj][m][0] * rstd, v1 = acc[ai][bj][m][1] * rstd;
                    *(v4u*)(Z + (size_t)row * LDZ + col) = pack8(v0, v1);
                    float* dst = nullptr;
                    if (pn == 2 || pn == 3) {
                        dst = (row < MP) ? out + O_KVP + ((size_t)layer * MP + row) * 512 + (col - 512) : out + O_KVS + ((size_t)layer * MS + (row - MP)) * 512 + (col - 512);
                    } else if (pn == 4) {
                        const int c2 = col - 1024;
                        if (row < MP) { const int t = row & (TP - 1), b = row >> 13; if (t >= TP - 512) dst = out + O_WINP + ((size_t)(layer * 2 + b) * 512 + (t - (TP - 512))) * 256 + c2; }
                        else { const int r2 = row - MP, s = r2 >> 2, j = r2 & 3; dst = out + O_WINS + ((size_t)(layer * 128 + s) * 512 + 508 + j) * 256 + c2; }
                    } else if (pn >= 5 && pn < 11) {
                        const int c2 = col - 1280;
                        if (row < MP) { const int t = row & (TP - 1), b = row >> 13; if (t >= TP - 3) dst = out + O_CVP + ((size_t)(layer * 2 + b) * 3 + (t - (TP - 3))) * 1536 + c2; }
                        else { const int r2 = row - MP, s = r2 >> 2, j = r2 & 3; if (j >= 1) dst = out + O_CVS + ((size_t)(layer * 128 + s) * 3 + (j - 1)) * 1536 + c2; }
                    } else if (pn == 33) {
                        if (bj == 0 && wc == 0) dst = ZS + (size_t)row * 32 + 8 * fq;
                    }
                    if (dst) { *(f32x4*)dst = v0; *(f32x4*)(dst + 4) = v1; }
                }
                asm volatile("" ::: "memory");
            }
    }
};
struct EpiC {
    static constexpr bool PERM = true, AFTER_DRAIN = false;
    const bf16* Z; bf16* G;
    DI void operator()(const f32x4 (&acc)[2][2][4][2], const Unit& u, int wr, int wc, int fr, int fq) const {
        asm volatile("" : "+v"(fr), "+v"(fq), "+s"(wr), "+s"(wc));
#pragma unroll
        for (int ai = 0; ai < 2; ++ai) {
            v4u gw[4][2];
#pragma unroll
            for (int m = 0; m < 4; ++m)
#pragma unroll
                for (int bj = 0; bj < 2; ++bj) gw[m][bj] = *(const v4u*)(Z + (size_t)(u.pm * 256 + ai * 128 + wr * 64 + m * 16 + fr) * LDZ + ZC_MG + u.pn * 256 + bj * 128 + wc * 32 + 8 * fq);
#pragma unroll
            for (int m = 0; m < 4; ++m) {
                const int row = u.pm * 256 + ai * 128 + wr * 64 + m * 16 + fr;
#pragma unroll
                for (int bj = 0; bj < 2; ++bj) {
                    const int col = u.pn * 256 + bj * 128 + wc * 32 + 8 * fq;
                    f32x4 g0, g1; unpack8(gw[m][bj], g0, g1);
                    f32x4 v0 = acc[ai][bj][m][0], v1 = acc[ai][bj][m][1];
#pragma unroll
                    for (int e = 0; e < 4; ++e) { v0[e] *= sigmoidf_(g0[e]); v1[e] *= sigmoidf_(g1[e]); }
                    *(v4u*)(G + (size_t)row * 3072 + col) = pack8(v0, v1);
                }
            }
            asm volatile("" ::: "memory");
        }
    }
};
struct EpiRes {
    static constexpr bool PERM = true, AFTER_DRAIN = false;
    float* XR; bf16* XG; const float* gvec; float* SS; float* T; int mode;
    const float* XRr;
    DI void operator()(const f32x4 (&acc)[2][2][4][2], const Unit& u, int wr, int wc, int fr, int fq) const {
        asm volatile("" : "+v"(fr), "+v"(fq), "+s"(wr), "+s"(wc));
        if (mode == 3) return;
        if (mode == 1) {
#pragma unroll
            for (int ai = 0; ai < 2; ++ai)
#pragma unroll
                for (int m = 0; m < 4; ++m)
#pragma unroll
                    for (int bj = 0; bj < 2; ++bj) { const size_t o = (size_t)(u.pm * 256 + ai * 128 + wr * 64 + m * 16 + fr) * DM + u.pn * 256 + bj * 128 + wc * 32 + 8 * fq;
                        *(f32x4*)(T + o) = acc[ai][bj][m][0]; *(f32x4*)(T + o + 4) = acc[ai][bj][m][1]; }
            return;
        }
#pragma unroll
        for (int ai = 0; ai < 2; ++ai)
#pragma unroll
            for (int mp = 0; mp < 2; ++mp) {
                f32x4 xr[2][2][2], tt[2][2][2];
#pragma unroll
                for (int mm = 0; mm < 2; ++mm)
#pragma unroll
                    for (int bj = 0; bj < 2; ++bj) { const size_t o = (size_t)(u.pm * 256 + ai * 128 + wr * 64 + (2 * mp + mm) * 16 + fr) * DM + u.pn * 256 + bj * 128 + wc * 32 + 8 * fq;
                        xr[mm][bj][0] = *(const f32x4*)(XRr + o); xr[mm][bj][1] = *(const f32x4*)(XRr + o + 4);
                        if (mode == 2) { tt[mm][bj][0] = *(const f32x4*)(T + o); tt[mm][bj][1] = *(const f32x4*)(T + o + 4); } }
#pragma unroll
                for (int mm = 0; mm < 2; ++mm) {
                    const int m = 2 * mp + mm;
                    const int row = u.pm * 256 + ai * 128 + wr * 64 + m * 16 + fr;
                    float ssq = 0.f;
#pragma unroll
                    for (int bj = 0; bj < 2; ++bj) {
                        const int col = u.pn * 256 + bj * 128 + wc * 32 + 8 * fq;
                        const size_t o = (size_t)row * DM + col;
                        f32x4 a0 = acc[ai][bj][m][0], a1 = acc[ai][bj][m][1];
                        f32x4 x0 = xr[mm][bj][0], x1 = xr[mm][bj][1];
                        if (mode == 2) {
#pragma unroll
                            for (int e = 0; e < 4; ++e) { a0[e] = tt[mm][bj][0][e] * sigmoidf_(a0[e]); a1[e] = tt[mm][bj][1][e] * sigmoidf_(a1[e]); } }
                        x0 += a0; x1 += a1;
                        *(f32x4*)(XR + o) = x0; *(f32x4*)(XR + o + 4) = x1;
                        ssq += (x0[0] * x0[0] + x0[1] * x0[1]) + (x0[2] * x0[2] + x0[3] * x0[3]) + (x1[0] * x1[0] + x1[1] * x1[1]) + (x1[2] * x1[2] + x1[3] * x1[3]);
                        if (XG) { if (gvec) { const f32x4 g0 = *(const f32x4*)(gvec + col), g1 = *(const f32x4*)(gvec + col + 4); x0 *= g0; x1 *= g1; }
                            *(v4u*)(XG + o) = pack8(x0, x1); }
                    }
                    if (SS) { ssq += shx<16>(ssq, fr + 16 * fq); ssq += shx<32>(ssq, fr + 16 * fq); if (fq == 0) SS[(size_t)row * 16 + u.pn * 4 + wc] = ssq; }
                }
                asm volatile("" ::: "memory");
            }
    }
};
struct EpiUp {
    static constexpr bool PERM = true, AFTER_DRAIN = false;
    bf16* H; const float* SS;
    DI void operator()(const f32x4 (&acc)[2][2][4][2], const Unit& u, int wr, int wc, int fr, int fq) const {
        asm volatile("" : "+v"(fr), "+v"(fq), "+s"(wr), "+s"(wc));
        float rs[2][4];
#pragma unroll
        for (int ai = 0; ai < 2; ++ai)
#pragma unroll
            for (int m = 0; m < 4; ++m) rs[ai][m] = row_rstd(SS, u.pm * 256 + ai * 128 + wr * 64 + m * 16 + fr, fq, fr + 16 * fq);
#pragma unroll
        for (int ai = 0; ai < 2; ++ai)
#pragma unroll
            for (int m = 0; m < 4; ++m) {
                const int row = u.pm * 256 + ai * 128 + wr * 64 + m * 16 + fr;
                const float rstd = rs[ai][m];
#pragma unroll
                for (int bj = 0; bj < 2; ++bj) {
                    const int col = u.pn * 256 + bj * 128 + wc * 32 + 8 * fq;
                    f32x4 v0 = acc[ai][bj][m][0] * rstd, v1 = acc[ai][bj][m][1] * rstd;
#pragma unroll
                    for (int e = 0; e < 4; ++e) { const float a = fmaxf(v0[e], 0.f), b = fmaxf(v1[e], 0.f); v0[e] = a * a; v1[e] = b * b; }
                    *(v4u*)(H + (size_t)row * DFF + col) = pack8(v0, v1);
                }
                asm volatile("" ::: "memory");
            }
    }
};
}
constexpr size_t al256(size_t x) { return (x + 255) & ~(size_t)255; }
constexpr size_t WS_CTL = 0, CTL_ZERO_BYTES = 1u << 20;
constexpr size_t SZ_WIN = (size_t)LDZ * DM * 2, SZ_WBR = (size_t)3072 * 512 * 2, SZ_WO3 = (size_t)DM * 3072 * 2, SZ_WUP = (size_t)DFF * DM * 2, SZ_WDN = (size_t)DM * DFF * 2,
                 SZ_WPL = (size_t)DM * PLE * 2, SZ_WPG = (size_t)DM * DM * 2, SZ_W1T = (size_t)2 * 64 * 2048 * 2, SZ_W2T = (size_t)2 * 64 * 64 * 2;
constexpr size_t WS_WIN = CTL_ZERO_BYTES, WS_WBR = WS_WIN + 2 * SZ_WIN, WS_WO3 = WS_WBR + 2 * SZ_WBR, WS_WUP = WS_WO3 + 2 * SZ_WO3, WS_WDN = WS_WUP + 2 * SZ_WUP,
                 WS_WPL = WS_WDN + 2 * SZ_WDN, WS_WPG = WS_WPL + 2 * SZ_WPL, WS_W1T = WS_WPG + 2 * SZ_WPG, WS_W2T = WS_W1T + 2 * SZ_W1T, WS_ROT = al256(WS_W2T + 2 * SZ_W2T);
constexpr size_t WS_P16 = WS_ROT + (size_t)TP * 64 * 8;
constexpr size_t WS_XR = WS_P16 + (size_t)2 * MROWS * PLE * 2;
constexpr size_t WS_XGA = WS_XR + (size_t)MROWS * DM * 4, WS_XGB = WS_XGA + (size_t)MROWS * DM * 2, WS_XGC = WS_XGB + (size_t)MROWS * DM * 2;
constexpr size_t WS_SSA = WS_XGC + (size_t)MROWS * DM * 2, WS_SSB = WS_SSA + (size_t)MROWS * 64;
constexpr size_t WS_Z = WS_SSB + (size_t)MROWS * 64, WS_ZS = WS_Z + (size_t)MROWS * LDZ * 2;
constexpr size_t WS_MIX = WS_ZS + (size_t)MROWS * 128, WS_GATED = WS_MIX + (size_t)MROWS * 1536 * 2, WS_HMID = WS_GATED + (size_t)MROWS * 3072 * 2;
constexpr size_t WS_TPLE = WS_HMID + (size_t)MROWS * DFF * 2;
constexpr size_t WS_KC = WS_TPLE + (size_t)MROWS * DM * 4;
constexpr size_t WS_KCS = WS_KC + (size_t)2 * 2 * 512 * 2 * 64 * 2;
constexpr int GREC = 73984;
constexpr size_t WS_GREC = WS_KCS + (size_t)2 * 128 * 128 * 2 * 64 * 2;
constexpr size_t WS_OGDN = WS_GREC + (size_t)1024 * GREC;
constexpr size_t WS_RKV = WS_OGDN + (size_t)MROWS * 512 * 4;
constexpr size_t WS_RST = WS_RKV + (size_t)512 * 16384 * 4;
constexpr size_t WS_QR = WS_RST + (size_t)512 * 16384 * 2, WS_KR = WS_QR + (size_t)MP * 512 * 2;
constexpr size_t WS_END = WS_KR + (size_t)MP * 512 * 2;
static_assert(WS_W1T % 256 == 0 && WS_Z % 256 == 0 && WS_GREC % 256 == 0 && WS_RKV % 256 == 0 && WS_KC % 256 == 0 && WS_XR % 256 == 0, "ws alignment");

constexpr int CW_TMO = 0, CW_BAR = 4096, CW_QUEUE = 8192;
constexpr int NWAVES = 8, NTHREADS = 512;
constexpr int RING_BYTES = 147456, LDSCTL_OFF = RING_BYTES, MISC_OFF = LDSCTL_OFF + 320, LDS_BYTES = RING_BYTES + 1024;

#define RLX_AGENT __ATOMIC_RELAXED, __HIP_MEMORY_SCOPE_AGENT
#define LDS_WAIT() asm volatile("s_waitcnt lgkmcnt(0)" ::: "memory")
#define VM_WAIT() asm volatile("s_waitcnt vmcnt(0)" ::: "memory")
#define XB_TMO      128
#define XB_XCNT(j)  (256  + 64 * (j))
#define XB_XSUB(j)  (1280 + 64 * (j))
#define XB_XGEN(j)  (2304 + 64 * (j))
#define XB_TOP      3328
#define XB_TOPGEN   3392
#define XCD_BAR_WORDS 3456
#define XB_SPIN_CAP (1u << 18)

__device__ __forceinline__ unsigned xb_ld(unsigned* p)              { return __hip_atomic_load(p, __ATOMIC_RELAXED, __HIP_MEMORY_SCOPE_AGENT); }
__device__ __forceinline__ unsigned xb_add(unsigned* p, unsigned v) { return __hip_atomic_fetch_add(p, v, __ATOMIC_RELAXED, __HIP_MEMORY_SCOPE_AGENT); }
__device__ __forceinline__ unsigned xb_xcc_id() { return (unsigned)__builtin_amdgcn_s_getreg((3 << 11) | 20) & 0xFu; }
#define XB_SPIN(cond, bar) do { unsigned _sp = 0; while (cond) { __builtin_amdgcn_s_sleep(1); \
    if ((++_sp & 255u) == 0u) { if (xb_ld(&(bar)[XB_TMO])) break; if (_sp > XB_SPIN_CAP) { atomicAdd(&(bar)[XB_TMO], 1u); break; } } } } while (0)

struct XcdBarrier {
    unsigned* bar; unsigned x;
    volatile LAS unsigned* st;
};

__device__ __forceinline__ XcdBarrier xcd_barrier_post(unsigned* bar, volatile LAS unsigned* st, bool t0) {
    XcdBarrier b; b.bar = bar; b.x = xb_xcc_id(); b.st = st;
    if (t0) (void)xb_add(&bar[XB_XCNT(b.x)], 1u);
    return b;
}
__device__ __forceinline__ void xcd_barrier_complete(unsigned* bar, unsigned x, unsigned& nloc, unsigned& nx) {
    const unsigned G = gridDim.x * gridDim.y * gridDim.z;
    unsigned sum, cnt, mine, sp = 0u;
    for (;;) {
        sum = 0u; cnt = 0u; mine = 0u;
#pragma unroll
        for (unsigned j = 0; j < 16; ++j) { const unsigned c = xb_ld(&bar[XB_XCNT(j)]); sum += c; cnt += (c > 0u) ? 1u : 0u; mine = (j == x) ? c : mine; }
        if (sum == G) break;
        __builtin_amdgcn_s_sleep(1);
        if ((++sp & 255u) == 0u) { if (xb_ld(&bar[XB_TMO])) break; if (sp > XB_SPIN_CAP) { atomicAdd(&bar[XB_TMO], 1u); break; } }
    }
    nloc = mine > 0u ? mine : 1u; nx = cnt > 0u ? cnt : 1u;
}

__device__ __forceinline__ void xcd_barrier(const XcdBarrier& b, bool t0) {
    asm volatile("s_waitcnt vmcnt(0)" ::: "memory");
    __syncthreads();
    if (t0) {
        unsigned* bar = b.bar;
        __builtin_amdgcn_s_waitcnt(0);
        unsigned nloc = b.st[0], nx = b.st[1];
        if (nloc == 0u) { xcd_barrier_complete(bar, b.x, nloc, nx); b.st[0] = nloc; b.st[1] = nx; }
        const unsigned old = xb_add(&bar[XB_XSUB(b.x)], 1u);
        const unsigned gen = old / nloc;
        if (old + 1u == (gen + 1u) * nloc) {
            __builtin_amdgcn_fence(__ATOMIC_RELEASE, "agent");
            asm volatile("s_waitcnt vmcnt(0)" ::: "memory");
            const unsigned og = xb_add(&bar[XB_TOP], 1u);
            const unsigned tg = og / nx;
            if (og + 1u == (tg + 1u) * nx) xb_add(&bar[XB_TOPGEN], 1u);
            else XB_SPIN(xb_ld(&bar[XB_TOPGEN]) == tg, bar);
            __builtin_amdgcn_fence(__ATOMIC_ACQUIRE, "agent");
            xb_add(&bar[XB_XGEN(b.x)], 1u);
            asm volatile("s_waitcnt vmcnt(0)" ::: "memory");
        } else {
            XB_SPIN(xb_ld(&bar[XB_XGEN(b.x)]) == gen, bar);
            __builtin_amdgcn_fence(__ATOMIC_ACQUIRE, "agent");
            asm volatile("s_waitcnt vmcnt(0)" ::: "memory");
        }
    }
    __syncthreads();
}
typedef const void* const __attribute__((address_space(4)))* kargp_t;
DI const float* KIN(int i) { const GAS float* p = (const GAS float*)((kargp_t)__builtin_amdgcn_kernarg_segment_ptr())[i]; asm volatile("" : "+s"(p)); return (const float*)p; }
DI float* KOUT() { GAS float* p = (GAS float*)((kargp_t)__builtin_amdgcn_kernarg_segment_ptr())[27]; asm volatile("" : "+s"(p)); return (float*)p; }
DI unsigned char* KWS() { GAS unsigned char* p = (GAS unsigned char*)((kargp_t)__builtin_amdgcn_kernarg_segment_ptr())[28]; asm volatile("" : "+s"(p)); return (unsigned char*)p; }
struct Frame {
    LAS unsigned char* lds;
    gu32* ctl;
    int tid, lane, wave, G, bid;
};
DI bf16x8 ld_frag_g(const bf16* p) { return __builtin_bit_cast(bf16x8, *(const v4u*)p); }
DI bf16x8 ld_frag_l(const LAS unsigned char* p) { return *(const LAS bf16x8*)p; }
DI f32x4 mfma16(bf16x8 a, bf16x8 b, f32x4 c) { return __builtin_amdgcn_mfma_f32_16x16x32_bf16(a, b, c, 0, 0, 0); }
DI bf16x8 pack_frag(const f32x4 a, const f32x4 b) { return __builtin_bit_cast(bf16x8, pack8(a, b)); }
DI int lane_id() { int l; asm volatile("v_mbcnt_lo_u32_b32 %0, -1, 0\n\tv_mbcnt_hi_u32_b32 %0, -1, %0" : "=v"(l)); return l; }
DI Frame fresh(const Frame& F0) {
    Frame F = F0; int w = F0.wave, g = F0.G, b = F0.bid; asm volatile("" : "+s"(w), "+s"(g), "+s"(b));
    int l = lane_id(); asm volatile("" : "+v"(l));
    unsigned lb = (unsigned)(uintptr_t)F0.lds; asm volatile("" : "+s"(lb)); F.lds = (LAS unsigned char*)(uintptr_t)lb;
    F.wave = w; F.lane = l; F.tid = w * 64 + l; F.G = g; F.bid = b; return F;
}
#define GRID_BAR() do { XcdBarrier b_; b_.bar = (unsigned*)((gu32*)(KWS() + WS_CTL) + CW_BAR); b_.x = xb_xcc_id(); b_.st = (volatile LAS unsigned*)(F.lds + MISC_OFF) + 8; \
    const Frame Fb_ = fresh(F); xcd_barrier(b_, Fb_.tid == 0); } while (0)
DI int win_colmap(int j) {
    if (j < 1280) return j; if (j < 2816) return j + 24; if (j < 8448) return j + 32; if (j < 8472) return j - 8448 + 1280; if (j < 8480) return j - 8472 + 2840; return -1;
}
DI void tr_item(const float* W, int ldw, int k0, int srccol, bf16* WT, size_t dst_row0, int ldt, int kdst0, int nrep, int krep, LAS float* scr, int lane) {
#pragma unroll 8
    for (int i = 0; i < 32; ++i) { const int kk = 2 * i + (lane >> 5); const float v_ = W[(size_t)(k0 + kk) * ldw + (srccol >= 0 ? srccol : 0)]; scr[kk * 33 + (lane & 31)] = (srccol >= 0) ? v_ : 0.f; }
    LDS_WAIT(); asm volatile("" ::: "memory");
    const int c = lane & 7;
#pragma unroll
    for (int j = 0; j < 4; ++j) { const int n = (lane >> 3) + 8 * j; const LAS float* s = scr + (8 * c) * 33 + n;
        v4u o; o.x = pk2(s[0 * 33], s[1 * 33]); o.y = pk2(s[2 * 33], s[3 * 33]); o.z = pk2(s[4 * 33], s[5 * 33]); o.w = pk2(s[6 * 33], s[7 * 33]);
        for (int r = 0; r < nrep; ++r) *(v4u*)(WT + (dst_row0 + n) * (size_t)ldt + kdst0 + r * krep + 8 * c) = o; }
    LDS_WAIT(); asm volatile("" ::: "memory");
}
DI void p0_prologue(Frame& F) {
    LAS float* scr = (LAS float*)(F.lds + F.wave * 16384);
    const int gw = F.bid * NWAVES + F.wave, NGW = F.G * NWAVES, lane = F.lane;
    unsigned char* ws = KWS();
    constexpr int I_A = 16 * 272, I_B = 3 * 8 * 32, I_C = 16 * 32, I_D = 16 * 128, I_E = 64 * 32, I_F = 4 * 32, I_G = 16 * 32, I_H = 2 * 32 * 2, I_I = 2 * 2;
    constexpr int I_L = I_A + I_B + I_C + I_D + I_E + I_F + I_G + I_H + I_I;
    for (int it = gw; it < 2 * I_L; it += NGW) {
        const int l = it / I_L; int r = it % I_L;
        if (r < I_A) { const int kb = r / 272, nb = r % 272; tr_item(KIN(11) + (size_t)l * DM * 8480, 8480, 64 * kb, win_colmap(32 * nb + (lane & 31)), (bf16*)(ws + WS_WIN + l * SZ_WIN), 32 * nb, DM, 64 * kb, 1, 0, scr, lane); continue; } r -= I_A;
        if (r < I_B) { const int b = r / 256, kb = (r % 256) / 32, nb = r % 32; tr_item(KIN(19) + (size_t)(l * 3 + b) * 512 * DM, DM, 64 * kb, 32 * nb + (lane & 31), (bf16*)(ws + WS_WBR + l * SZ_WBR), b * 1024 + 32 * nb, 512, 64 * kb, 1, 0, scr, lane); continue; } r -= I_B;
        if (r < I_C) { const int kb = r / 32, nb = r % 32; tr_item(KIN(20) + (size_t)l * DM * DM, DM, 64 * kb, 32 * nb + (lane & 31), (bf16*)(ws + WS_WO3 + l * SZ_WO3), 32 * nb, 3072, 64 * kb, 3, 1024, scr, lane); continue; } r -= I_C;
        if (r < I_D) { const int kb = r / 128, nb = r % 128; tr_item(KIN(22) + (size_t)l * DM * DFF, DFF, 64 * kb, 32 * nb + (lane & 31), (bf16*)(ws + WS_WUP + l * SZ_WUP), 32 * nb, DM, 64 * kb, 1, 0, scr, lane); continue; } r -= I_D;
        if (r < I_E) { const int kb = r / 32, nb = r % 32; tr_item(KIN(23) + (size_t)l * DFF * DM, DM, 64 * kb, 32 * nb + (lane & 31), (bf16*)(ws + WS_WDN + l * SZ_WDN), 32 * nb, DFF, 64 * kb, 1, 0, scr, lane); continue; } r -= I_E;
        if (r < I_F) { const int kb = r / 32, nb = r % 32; tr_item(KIN(24) + (size_t)l * PLE * DM, DM, 64 * kb, 32 * nb + (lane & 31), (bf16*)(ws + WS_WPL + l * SZ_WPL), 32 * nb, PLE, 64 * kb, 1, 0, scr, lane); continue; } r -= I_F;
        if (r < I_G) { const int kb = r / 32, nb = r % 32; tr_item(KIN(25) + (size_t)l * DM * DM, DM, 64 * kb, 32 * nb + (lane & 31), (bf16*)(ws + WS_WPG + l * SZ_WPG), 32 * nb, DM, 64 * kb, 1, 0, scr, lane); continue; } r -= I_G;
        if (r < I_H) { const int kv = r / 64, kb = (r % 64) / 2, nb = r % 2; tr_item(KIN(13) + (size_t)(l * 2 + kv) * 2048 * 64, 64, 64 * kb, 32 * nb + (lane & 31), (bf16*)(ws + WS_W1T + l * SZ_W1T) + (size_t)kv * 64 * 2048, 32 * nb, 2048, 64 * kb, 1, 0, scr, lane); continue; } r -= I_H;
        { const int kv = r / 2, nb = r % 2; tr_item(KIN(14) + (size_t)(l * 2 + kv) * 64 * 64, 64, 0, 32 * nb + (lane & 31), (bf16*)(ws + WS_W2T + l * SZ_W2T) + (size_t)kv * 64 * 64, 32 * nb, 64, 0, 1, 0, scr, lane); }
    }
    bf16* XGA = (bf16*)(ws + WS_XGA); float* SSA = (float*)(ws + WS_SSA); bf16* P16 = (bf16*)(ws + WS_P16);
    const float* g0 = KIN(10);
    for (int row = gw; row < MROWS; row += NGW) {
        const float* xs = (row < MP) ? KIN(0) + (size_t)row * DM : KIN(1) + (size_t)(row - MP) * DM;
        float ss = 0.f;
#pragma unroll
        for (int j = 0; j < 2; ++j) {
            const int c = j * 512 + lane * 8;
            f32x4 a = *(const f32x4*)(xs + c), b = *(const f32x4*)(xs + c + 4);
            ss += (a[0] * a[0] + a[1] * a[1]) + (a[2] * a[2] + a[3] * a[3]) + (b[0] * b[0] + b[1] * b[1]) + (b[2] * b[2] + b[3] * b[3]);
            const f32x4 ga = *(const f32x4*)(g0 + c), gb = *(const f32x4*)(g0 + c + 4);
            *(v4u*)(XGA + (size_t)row * DM + c) = pack8(a * ga, b * gb);
        }
        ss = wave_sum(ss, lane);
        if (lane < 16) SSA[(size_t)row * 16 + lane] = (lane == 0) ? ss : 0.f;
#pragma unroll
        for (int l = 0; l < 2; ++l) {
            const float* ps = (row < MP) ? KIN(8) + ((size_t)l * MP + row) * PLE : KIN(9) + ((size_t)l * MS + (row - MP)) * PLE;
            const f32x4 a = *(const f32x4*)(ps + lane * 4);
            v2u o; o.x = pk2(a[0], a[1]); o.y = pk2(a[2], a[3]);
            *(v2u*)(P16 + ((size_t)l * MROWS + row) * PLE + lane * 4) = o;
        }
    }
    const int gt = F.bid * NTHREADS + F.tid, NGT = F.G * NTHREADS;
    f32x2* ROT = (f32x2*)(ws + WS_ROT);
    for (int e = gt; e < TP * 64; e += NGT) {
        const int pos = e >> 6, i = e & 63;
        const float x = (float)i * (1.0f / 63.0f);
        const float inv = exp2f(-x * 13.287712379549449f);
        const float ang = (float)pos * inv;
        const double rev = (double)ang * 0.15915494309189535;
        const float fr = (float)(rev - floor(rev));
        ROT[e] = (f32x2){__builtin_amdgcn_cosf(fr), __builtin_amdgcn_sinf(fr)};
    }
}
DI float gelu_tanh(float x) { const float u = 0.7978845608028654f * (x + 0.044715f * x * x * x); const float e = __expf(2.f * u); return 0.5f * x * (1.f + (1.f - 2.f / (e + 1.f))); }
DI bf16x8 mk_frag(v2u a, v2u b) { v4u w; w.x = a.x; w.y = a.y; w.z = b.x; w.w = b.y; return __builtin_bit_cast(bf16x8, w); }

template <bool sample> DI void compress_job_t(Frame& F, int layer, int job) {
    int lane = F.lane, wave = F.wave; asm volatile("" : "+v"(lane), "+s"(wave));
    const int tid = wave * 64 + lane, quad = lane >> 4, rl = lane & 15;
    unsigned char* ws = KWS();
    int kv, bs, g0, nbase;
    if (sample) { kv = job >> 7; bs = job & 127; g0 = 0; nbase = 0; }
    else { const int j2 = job - 256; kv = j2 >> 3; bs = (j2 >> 2) & 1; g0 = (j2 >> 1) & 1; nbase = (j2 & 1) * 256; }
    const bf16* W1T = (const bf16*)(ws + WS_W1T + layer * SZ_W1T) + (size_t)kv * 64 * 2048;
    const bf16* W2T = (const bf16*)(ws + WS_W2T + layer * SZ_W2T) + (size_t)kv * 64 * 64;
    const float* pe = KIN(12) + (size_t)(layer * 2 + kv) * 32 * 64;
    const bf16* Z = (const bf16*)(ws + WS_Z);
    const int* pt = (const int*)KIN(7);
    const float* cache = KIN(2);
    LAS unsigned char* LW = F.lds;
    int gg[2], nn[2];
    size_t pb0[2], pb1[2];
#pragma unroll
    for (int tl = 0; tl < 2; ++tl) { const int T = 2 * wave + tl; if (sample) { gg[tl] = T >> 3; nn[tl] = 16 * (T & 7) + rl; } else { gg[tl] = g0; nn[tl] = nbase + 16 * T + rl; }
        pb0[tl] = 0; pb1[tl] = 0;
        if (sample) { const int p0 = (16 * nn[tl]) >> 7; const int p1 = p0 + 1 > 15 ? 15 : p0 + 1;
            pb0[tl] = (size_t)(layer * 2560 + pt[bs * 16 + p0]) * 128 * 512; pb1[tl] = (size_t)(layer * 2560 + pt[bs * 16 + p1]) * 128 * 512; } }
    f32x4 h[2][4];
#pragma unroll
    for (int tl = 0; tl < 2; ++tl)
#pragma unroll
        for (int i = 0; i < 4; ++i) h[tl][i] = (f32x4){0.f, 0.f, 0.f, 0.f};
#pragma unroll 1
    for (int c = 0; c < 4; ++c) {
        __syncthreads();
#pragma unroll
        for (int k = 0; k < 8; ++k) { const int pc = tid + 512 * k, r = pc >> 6, c16 = pc & 63;
            *(LAS v4u*)(LW + r * 1040 + c16 * 16) = *(const v4u*)(W1T + (size_t)r * 2048 + c * 512 + c16 * 8); }
        __syncthreads();
#pragma unroll 8
        for (int kk = 0; kk < 16; ++kk) {
            const int j = 8 * c + (kk >> 1), dim0 = (kk & 1) * 32 + quad * 8;
            const f32x4 pe0 = *(const f32x4*)(pe + j * 64 + dim0), pe1 = *(const f32x4*)(pe + j * 64 + dim0 + 4);
            bf16x8 xb[2];
#pragma unroll
            for (int tl = 0; tl < 2; ++tl) {
                f32x4 x0, x1;
                if (!sample) { const size_t row = (size_t)bs * TP + 16 * nn[tl] + j; unpack8(*(const v4u*)(Z + row * LDZ + ZC_KC + kv * 128 + gg[tl] * 64 + dim0), x0, x1); }
                else { int pos = 16 * nn[tl] + j; pos = pos > 2047 ? 2047 : pos;
                    const float* p = cache + (((pos >> 7) == ((16 * nn[tl]) >> 7)) ? pb0[tl] : pb1[tl]) + (size_t)(pos & 127) * 512 + kv * 128 + gg[tl] * 64 + dim0; x0 = *(const f32x4*)p; x1 = *(const f32x4*)(p + 4); }
                xb[tl] = pack_frag(x0 + pe0, x1 + pe1);
            }
#pragma unroll
            for (int ht = 0; ht < 4; ++ht) {
                const bf16x8 a = ld_frag_l(LW + (16 * ht + rl) * 1040 + (kk * 32 + quad * 8) * 2);
                h[0][ht] = mfma16(a, xb[0], h[0][ht]); h[1][ht] = mfma16(a, xb[1], h[1][ht]);
            }
        }
    }
#pragma unroll
    for (int tl = 0; tl < 2; ++tl) {
#pragma unroll
        for (int ht = 0; ht < 4; ++ht)
#pragma unroll
            for (int i = 0; i < 4; ++i) h[tl][ht][i] = gelu_tanh(h[tl][ht][i]);
        bf16x8 gb[2]; gb[0] = pack_frag(h[tl][0], h[tl][1]); gb[1] = pack_frag(h[tl][2], h[tl][3]);
        const int n = nn[tl], g = gg[tl];
        bf16* dst = sample ? (bf16*)(ws + WS_KCS) + ((((size_t)kv * 128 + bs) * 128 + n) * 2 + g) * 64 : (bf16*)(ws + WS_KC) + ((((size_t)kv * 2 + bs) * 512 + n) * 2 + g) * 64;
        const bool zero = sample && n == 127;
#pragma unroll
        for (int ot = 0; ot < 4; ++ot) {
            f32x4 o = (f32x4){0.f, 0.f, 0.f, 0.f};
#pragma unroll
            for (int s = 0; s < 2; ++s) {
                const bf16* wp = W2T + (16 * ot + rl) * 64 + 32 * s + 4 * quad;
                o = mfma16(mk_frag(*(const v2u*)wp, *(const v2u*)(wp + 16)), gb[s], o);
            }
            v2u w; w.x = zero ? 0u : pk2(o[0], o[1]); w.y = zero ? 0u : pk2(o[2], o[3]);
            *(v2u*)(dst + 16 * ot + 4 * quad) = w;
        }
    }
    __syncthreads();
}

DI v2u pack4(const f32x4 v) { v2u w; w.x = pk2(v[0], v[1]); w.y = pk2(v[2], v[3]); return w; }
DI void compress_sample_job(Frame& F, int layer, int job) {
    int lane = F.lane, wave = F.wave; asm volatile("" : "+v"(lane), "+s"(wave));
    const int tid = wave * 64 + lane, quad = lane >> 4, rl = lane & 15;
    unsigned char* ws = KWS();
    const int kv = job >> 7, bs = job & 127;
    const bf16* W1T = (const bf16*)(ws + WS_W1T + layer * SZ_W1T) + (size_t)kv * 64 * 2048;
    const bf16* W2T = (const bf16*)(ws + WS_W2T + layer * SZ_W2T) + (size_t)kv * 64 * 64;
    const float* pe = KIN(12) + (size_t)(layer * 2 + kv) * 32 * 64;
    const int* pt = (const int*)KIN(7);
    const float* cache = KIN(2);
    LAS unsigned char* XS = F.lds;
    LAS unsigned char* WS1 = F.lds + 69632;
    size_t toff[8];
#pragma unroll
    for (int k = 0; k < 8; ++k) { const int q = tid + 512 * k, m = q >> 5; const int pos = 16 * m; const int phys = pt[bs * 16 + (pos >> 7)];
        toff[k] = ((size_t)(layer * 2560 + phys) * 128 + (pos & 127)) * 512 + kv * 128 + 4 * (q & 31); }
    const int wr_ = tid >> 3, wc_ = tid & 7;
    int gg[2], nn[2];
#pragma unroll
    for (int tl = 0; tl < 2; ++tl) { const int T = 2 * wave + tl; gg[tl] = T >> 3; nn[tl] = 16 * (T & 7) + rl; }
    f32x4 h[2][4];
#pragma unroll
    for (int tl = 0; tl < 2; ++tl)
#pragma unroll
        for (int i = 0; i < 4; ++i) h[tl][i] = (f32x4){0.f, 0.f, 0.f, 0.f};
    f32x4 xr[8]; v4u wr2[2];
#define CS_ISSUE(r_) do { _Pragma("unroll") for (int k = 0; k < 8; ++k) xr[k] = *(const f32x4*)(cache + toff[k] + (size_t)(r_) * 512); \
        _Pragma("unroll") for (int u = 0; u < 2; ++u) wr2[u] = *(const v4u*)(W1T + (size_t)wr_ * 2048 + ((r_) + 16 * u) * 64 + wc_ * 8); } while (0)
    CS_ISSUE(0);
#pragma unroll 1
    for (int r = 0; r < 16; ++r) {
        __syncthreads();
#pragma unroll
        for (int k = 0; k < 8; ++k) { const int q = tid + 512 * k, m = q >> 5, c = q & 31, d = 4 * (c & 15);
#pragma unroll
            for (int u = 0; u < 2; ++u) { const f32x4 v = xr[k] + *(const f32x4*)(pe + (r + 16 * u) * 64 + d);
                *(LAS v2u*)(XS + u * 34816 + m * 272 + c * 8) = pack4(v); } }
#pragma unroll
        for (int u = 0; u < 2; ++u) *(LAS v4u*)(WS1 + u * 9216 + wr_ * 144 + wc_ * 16) = wr2[u];
        __syncthreads();
        { const int rn = r + 1 < 16 ? r + 1 : 15; CS_ISSUE(rn); }
#pragma unroll
        for (int u = 0; u < 2; ++u)
#pragma unroll
            for (int ks = 0; ks < 2; ++ks) {
                bf16x8 xb[2];
#pragma unroll
                for (int tl = 0; tl < 2; ++tl) { int m = nn[tl] + u; m = m > 127 ? 127 : m; xb[tl] = ld_frag_l(XS + u * 34816 + m * 272 + gg[tl] * 128 + ks * 64 + quad * 16); }
#pragma unroll
                for (int ht = 0; ht < 4; ++ht) { const bf16x8 a = ld_frag_l(WS1 + u * 9216 + (16 * ht + rl) * 144 + ks * 64 + quad * 16);
                    h[0][ht] = mfma16(a, xb[0], h[0][ht]); h[1][ht] = mfma16(a, xb[1], h[1][ht]); }
            }
    }
#undef CS_ISSUE
#pragma unroll
    for (int tl = 0; tl < 2; ++tl) {
#pragma unroll
        for (int ht = 0; ht < 4; ++ht)
#pragma unroll
            for (int i = 0; i < 4; ++i) h[tl][ht][i] = gelu_tanh(h[tl][ht][i]);
        bf16x8 gb[2]; gb[0] = pack_frag(h[tl][0], h[tl][1]); gb[1] = pack_frag(h[tl][2], h[tl][3]);
        const int n = nn[tl], g = gg[tl];
        bf16* dst = (bf16*)(ws + WS_KCS) + ((((size_t)kv * 128 + bs) * 128 + n) * 2 + g) * 64;
        const bool zero = n == 127;
#pragma unroll
        for (int ot = 0; ot < 4; ++ot) {
            f32x4 o = (f32x4){0.f, 0.f, 0.f, 0.f};
#pragma unroll
            for (int s = 0; s < 2; ++s) {
                const bf16* wp = W2T + (16 * ot + rl) * 64 + 32 * s + 4 * quad;
                o = mfma16(mk_frag(*(const v2u*)wp, *(const v2u*)(wp + 16)), gb[s], o);
            }
            v2u w; w.x = zero ? 0u : pk2(o[0], o[1]); w.y = zero ? 0u : pk2(o[2], o[3]);
            *(v2u*)(dst + 16 * ot + 4 * quad) = w;
        }
    }
    __syncthreads();
}
DI void compress_job(Frame& F, int layer, int job) { if (job < 256) compress_sample_job(F, layer, job); else compress_job_t<false>(F, layer, job); }
#ifndef PH_GPT
#define PH_GPT (-1)
#endif
#if PH_GPT >= 0
#define GP_T(k) do { if (tid == 0) { volatile LAS unsigned long long* gp_ = (volatile LAS unsigned long long*)(F.lds + LDSCTL_OFF + 448); const unsigned long long now_ = __builtin_amdgcn_s_memrealtime(); \
    if ((k) == PH_GPT) gp_[0] += now_ - gp_[1]; gp_[1] = now_; } } while (0)
#else
#define GP_T(k) do { } while (0)
#endif
DI int kperm(int idx) { const int s = idx >> 5, r = idx & 31; return 32 * s + 8 * ((r >> 2) & 3) + 4 * (r >> 4) + (r & 3); }
DI float softplusf_(float x) { return x > 20.f ? x : __logf(1.f + __expf(x)); }
DI float ret_lg(int h) { return h == 0 ? -0.031748697f : h == 1 ? -0.015748357f : h == 2 ? -0.007843178f : -0.0039138994f; }

DI void gdn_prep_unit(Frame& F, int layer, int unit) {
    int lane = F.lane, wave = F.wave; asm volatile("" : "+v"(lane), "+s"(wave));
    const int tid = wave * 64 + lane;
    const int b = unit >> 9, h = (unit >> 7) & 3, c = unit & 127;
    const int row0 = b * TP + 64 * c, t0 = 64 * c;
    GP_T(0);
    unsigned char* ws = KWS();
    const bf16* Z = (const bf16*)(ws + WS_Z);
    const float* ZS = (const float*)(ws + WS_ZS);
    LAS float* Lq = (LAS float*)(F.lds); LAS float* Lk = (LAS float*)(F.lds + 33792); LAS float* Lv = (LAS float*)(F.lds + 67584);
    LAS float* LA = (LAS float*)(F.lds + 101376); LAS float* LQK = (LAS float*)(F.lds + 117760);
    LAS float* Lg = (LAS float*)(F.lds + 134144); LAS float* Lb = Lg + 64; LAS float* Le = Lg + 128;
    const float* cw = KIN(15) + (size_t)layer * 4 * 1536;
    {
        v4u xs[6][4];
#pragma unroll
        for (int it0 = 0; it0 < 6; ++it0) {
            const int it = tid + it0 * NTHREADS, i = it / 48, ch = it % 48, col = (ch >> 4) * 512 + h * 128 + (ch & 15) * 8;
#pragma unroll
            for (int j = 0; j < 4; ++j) { const bool ok = (t0 + i - 3 + j) >= 0; xs[it0][j] = *(const v4u*)(Z + (size_t)(ok ? row0 + i - 3 + j : row0) * LDZ + ZC_GQKV + col); }
        }
        asm volatile("" ::: "memory");
#pragma unroll
        for (int it0 = 0; it0 < 6; ++it0) {
            const int it = tid + it0 * NTHREADS, i = it / 48, ch = it % 48, part = ch >> 4, cc = ch & 15;
            const int col = part * 512 + h * 128 + cc * 8;
            f32x4 y0 = (f32x4){0.f, 0.f, 0.f, 0.f}, y1 = y0;
#pragma unroll
            for (int j = 0; j < 4; ++j) {
                const float zf = ((t0 + i - 3 + j) >= 0) ? 1.f : 0.f;
                f32x4 x0, x1; unpack8(xs[it0][j], x0, x1);
                y0 += x0 * (*(const f32x4*)(cw + j * 1536 + col) * zf); y1 += x1 * (*(const f32x4*)(cw + j * 1536 + col + 4) * zf);
            }
#pragma unroll
            for (int e = 0; e < 4; ++e) { y0[e] = siluf_(y0[e]); y1[e] = siluf_(y1[e]); }
            LAS float* dst = (part == 0 ? Lq : part == 1 ? Lk : Lv) + i * 132 + cc * 8;
            *(LAS f32x4*)dst = y0; *(LAS f32x4*)(dst + 4) = y1;
        }
    }
    __syncthreads();
    GP_T(1);
    {
        float va[16], vb[16], ps[16];
#pragma unroll
        for (int q = 0; q < 16; ++q) { LAS float* vp = ((q < 8) ? Lq : Lk) + (wave * 8 + (q & 7)) * 132 + lane * 2; va[q] = vp[0]; vb[q] = vp[1]; ps[q] = va[q] * va[q] + vb[q] * vb[q]; }
#pragma unroll
        for (int q = 0; q < 16; ++q) ps[q] += shx<1>(ps[q], lane);
#pragma unroll
        for (int q = 0; q < 16; ++q) ps[q] += shx<2>(ps[q], lane);
#pragma unroll
        for (int q = 0; q < 16; ++q) ps[q] += shx<4>(ps[q], lane);
#pragma unroll
        for (int q = 0; q < 16; ++q) ps[q] += shx<8>(ps[q], lane);
#pragma unroll
        for (int q = 0; q < 16; ++q) ps[q] += shx<16>(ps[q], lane);
#pragma unroll
        for (int q = 0; q < 16; ++q) ps[q] += shx<32>(ps[q], lane);
#pragma unroll
        for (int q = 0; q < 16; ++q) { LAS float* vp = ((q < 8) ? Lq : Lk) + (wave * 8 + (q & 7)) * 132 + lane * 2; const float sc = rsqrtf(ps[q] + EPS) * ((q < 8) ? 0.08838834764831845f : 1.f); vp[0] = va[q] * sc; vp[1] = vb[q] * sc; }
    }
    if (wave == 0) {
        const float ga = ZS[(size_t)(row0 + lane) * 32 + 24 + h], gbv = ZS[(size_t)(row0 + lane) * 32 + 28 + h];
        float g = -__expf(KIN(16)[layer * 4 + h]) * softplusf_(ga + KIN(17)[layer * 4 + h]);
#pragma unroll
        for (int o = 1; o < 64; o <<= 1) { const float t = __int_as_float(__builtin_amdgcn_ds_bpermute(((lane - o) & 63) << 2, __float_as_int(g))); if (lane >= o) g += t; }
        Lg[lane] = g; Lb[lane] = sigmoidf_(gbv); Le[lane] = __expf(g);
    }
    __syncthreads();
    GP_T(2);
    {
        const int it = wave >> 1, quad = lane >> 4, rl = lane & 15;
        f32x4 ckk[2], cqk[2];
#pragma unroll
        for (int jj = 0; jj < 2; ++jj) { ckk[jj] = (f32x4){0.f, 0.f, 0.f, 0.f}; cqk[jj] = ckk[jj]; }
#pragma unroll
        for (int s = 0; s < 4; ++s) {
            const LAS float* kp = Lk + (16 * it + rl) * 132 + 32 * s + 8 * quad; const LAS float* qp = Lq + (16 * it + rl) * 132 + 32 * s + 8 * quad;
            const f32x4 ka0 = *(const LAS f32x4*)kp, ka1 = *(const LAS f32x4*)(kp + 4), qa0 = *(const LAS f32x4*)qp, qa1 = *(const LAS f32x4*)(qp + 4);
            const bf16x8 kah = pack_frag(ka0, ka1), qah = pack_frag(qa0, qa1);
            f32x4 h0, h1; unpack8(__builtin_bit_cast(v4u, kah), h0, h1); const bf16x8 kal = pack_frag(ka0 - h0, ka1 - h1);
            unpack8(__builtin_bit_cast(v4u, qah), h0, h1); const bf16x8 qal = pack_frag(qa0 - h0, qa1 - h1);
#pragma unroll
            for (int jj = 0; jj < 2; ++jj) {
                const int jt = (wave & 1) * 2 + jj;
                if (jt <= it) {
                    const LAS float* bp = Lk + (16 * jt + rl) * 132 + 32 * s + 8 * quad;
                    const f32x4 kb0 = *(const LAS f32x4*)bp, kb1 = *(const LAS f32x4*)(bp + 4);
                    const bf16x8 kbh = pack_frag(kb0, kb1); unpack8(__builtin_bit_cast(v4u, kbh), h0, h1); const bf16x8 kbl = pack_frag(kb0 - h0, kb1 - h1);
                    ckk[jj] = mfma16(kah, kbh, ckk[jj]); ckk[jj] = mfma16(kah, kbl, ckk[jj]); ckk[jj] = mfma16(kal, kbh, ckk[jj]);
                    cqk[jj] = mfma16(qah, kbh, cqk[jj]); cqk[jj] = mfma16(qah, kbl, cqk[jj]); cqk[jj] = mfma16(qal, kbh, cqk[jj]);
                }
            }
        }
#pragma unroll
        for (int jj = 0; jj < 2; ++jj) {
            const int j = 16 * ((wave & 1) * 2 + jj) + rl; const float gj = Lg[j];
#pragma unroll
            for (int e = 0; e < 4; ++e) { const int i = 16 * it + 4 * quad + e; const float dec = (i >= j) ? __expf(Lg[i] - gj) : 0.f;
                LA[i * 64 + j] = (i > j) ? Lb[i] * ckk[jj][e] * dec : 0.f; LQK[i * 64 + j] = cqk[jj][e] * dec; }
        }
    }
    __syncthreads();
    GP_T(3);
    unsigned char* rec = ws + WS_GREC + (size_t)unit * GREC;
    LAS float* TI = (LAS float*)(F.lds + 135168);
    if (tid < 64) {
        const int B = tid >> 4, c = tid & 15;
        float tc[16];
#pragma unroll
        for (int i = 0; i < 16; ++i) {
            float s0 = (i == c) ? 1.f : 0.f;
#pragma unroll
            for (int j = 0; j < i; ++j) s0 -= LA[(16 * B + i) * 64 + 16 * B + j] * tc[j];
            tc[i] = s0;
        }
#pragma unroll
        for (int i = 0; i < 16; ++i) TI[B * 256 + i * 16 + c] = tc[i];
    }
    {
        const float gl = Lg[63];
        for (int it = tid; it < 2560; it += NTHREADS) {
            if (it < 1024) {
                const int i = it >> 4, s = (it >> 2) & 3, quad = it & 3; const float e = Le[i];
                const f32x4 a = *(const LAS f32x4*)(Lq + i * 132 + 32 * s + 4 * quad) * e, bq = *(const LAS f32x4*)(Lq + i * 132 + 32 * s + 16 + 4 * quad) * e;
                *(v4u*)(rec + 16384 + i * 256 + (32 * s + 8 * quad) * 2) = pack8(a, bq);
            } else if (it < 2048) {
                const int r = it - 1024, dk = r >> 3, s2 = (r >> 2) & 1, quad = r & 3;
                f32x4 a, bq;
#pragma unroll
                for (int e = 0; e < 4; ++e) { const int ta = 32 * s2 + 4 * quad + e, tb = ta + 16; a[e] = Lk[ta * 132 + dk] * __expf(gl - Lg[ta]); bq[e] = Lk[tb * 132 + dk] * __expf(gl - Lg[tb]); }
                *(v4u*)(rec + 32768 + dk * 128 + (32 * s2 + 8 * quad) * 2) = pack8(a, bq);
            } else {
                const int r = it - 2048, i = r >> 3, s2 = (r >> 2) & 1, quad = r & 3;
                const f32x4 a = *(const LAS f32x4*)(LQK + i * 64 + 32 * s2 + 4 * quad), bq = *(const LAS f32x4*)(LQK + i * 64 + 32 * s2 + 16 + 4 * quad);
                *(v4u*)(rec + 65536 + i * 128 + (32 * s2 + 8 * quad) * 2) = pack8(a, bq);
            }
        }
        if (tid == 0) *(float*)(rec + 73728) = __expf(gl);
    }
    __syncthreads();
    GP_T(4);
    {
        const int col = tid & 255, hb = tid >> 8;
        LAS float* X = (col < 128) ? (Lv + col) : (Lk + (col - 128));
        const bool isw = col >= 128;
#pragma unroll 1
        for (int B = 0; B < 4; ++B) {
            float xb[8];
#pragma unroll
            for (int i = 0; i < 8; ++i) { const int r = 16 * B + 8 * hb + i; xb[i] = (isw ? Lb[r] * Le[r] : Lb[r]) * X[r * 132]; }
#pragma unroll 2
            for (int j4 = 0; j4 < 4 * B; ++j4) {
                const float x0 = X[(4 * j4) * 132], x1 = X[(4 * j4 + 1) * 132], x2 = X[(4 * j4 + 2) * 132], x3 = X[(4 * j4 + 3) * 132];
#pragma unroll
                for (int i = 0; i < 8; ++i) { const f32x4 a = *(const LAS f32x4*)(LA + (16 * B + 8 * hb + i) * 64 + 4 * j4); xb[i] -= (a[0] * x0 + a[1] * x1) + (a[2] * x2 + a[3] * x3); }
            }
#pragma unroll
            for (int i = 0; i < 8; ++i) X[(16 * B + 8 * hb + i) * 132] = xb[i];
            __syncthreads();
            float r[16];
#pragma unroll
            for (int jj = 0; jj < 16; ++jj) r[jj] = X[(16 * B + jj) * 132];
            __syncthreads();
#pragma unroll
            for (int i = 0; i < 8; ++i) {
                float s0 = 0.f, s1 = 0.f;
#pragma unroll
                for (int j4 = 0; j4 < 4; ++j4) { const f32x4 a = *(const LAS f32x4*)(TI + B * 256 + (8 * hb + i) * 16 + 4 * j4);
                    s0 += a[0] * r[4 * j4] + a[2] * r[4 * j4 + 2]; s1 += a[1] * r[4 * j4 + 1] + a[3] * r[4 * j4 + 3]; }
                X[(16 * B + 8 * hb + i) * 132] = s0 + s1;
            }
            __syncthreads();
        }
    }
    __syncthreads();
    GP_T(5);
    for (int it = tid; it < 2048; it += NTHREADS) {
        if (it < 1024) {
            const int dv = it >> 3, q = it & 7;
            v4u w; w.x = pk2(Lv[(8 * q) * 132 + dv], Lv[(8 * q + 1) * 132 + dv]); w.y = pk2(Lv[(8 * q + 2) * 132 + dv], Lv[(8 * q + 3) * 132 + dv]);
            w.z = pk2(Lv[(8 * q + 4) * 132 + dv], Lv[(8 * q + 5) * 132 + dv]); w.w = pk2(Lv[(8 * q + 6) * 132 + dv], Lv[(8 * q + 7) * 132 + dv]);
            *(v4u*)(rec + 49152 + dv * 128 + q * 16) = w;
        } else {
            const int r = it - 1024, i = r >> 4, s = (r >> 2) & 3, quad = r & 3;
            const f32x4 a = *(const LAS f32x4*)(Lk + i * 132 + 32 * s + 4 * quad), bq = *(const LAS f32x4*)(Lk + i * 132 + 32 * s + 16 + 4 * quad);
            *(v4u*)(rec + i * 256 + (32 * s + 8 * quad) * 2) = pack8(a, bq);
        }
    }
    __syncthreads();
    GP_T(6);
}

DI void ret_prep_unit(Frame& F, int layer, int unit) {
    int lane = F.lane, wave = F.wave; asm volatile("" : "+v"(lane), "+s"(wave));
    const int tid = wave * 64 + lane, quad = lane >> 4, rl = lane & 15;
    const int b = unit >> 8, h = (unit >> 6) & 3, c = unit & 63;
    const int row0 = b * TP + 128 * c;
    unsigned char* ws = KWS();
    const bf16* Z = (const bf16*)(ws + WS_Z);
    const f32x2* ROT = (const f32x2*)(ws + WS_ROT);
    bf16* QR = (bf16*)(ws + WS_QR); bf16* KR = (bf16*)(ws + WS_KR);
    LAS unsigned char* LK = F.lds; LAS unsigned char* LV = F.lds + 34816;
    const float lg = ret_lg(h);
    for (int it = tid; it < 1024; it += NTHREADS) {
        const int j = it >> 3, cc = it & 7, d0 = cc * 8;
        const size_t zr = (size_t)(row0 + j) * LDZ + ZC_RQKV + h * 128 + d0;
        f32x4 q1a, q1b, q2a, q2b, k1a, k1b, k2a, k2b;
        unpack8(*(const v4u*)(Z + zr), q1a, q1b); unpack8(*(const v4u*)(Z + zr + 64), q2a, q2b);
        unpack8(*(const v4u*)(Z + zr + 512), k1a, k1b); unpack8(*(const v4u*)(Z + zr + 512 + 64), k2a, k2b);
        const f32x2* rp = ROT + (size_t)(128 * c + j) * 64 + d0;
        const float kd = __expf((float)(127 - j) * lg);
        f32x4 oq1a, oq1b, oq2a, oq2b, ok1a, ok1b, ok2a, ok2b;
#pragma unroll
        for (int e = 0; e < 8; ++e) {
            const f32x2 cs = rp[e];
            const float q1 = e < 4 ? q1a[e & 3] : q1b[e & 3], q2 = e < 4 ? q2a[e & 3] : q2b[e & 3], k1 = e < 4 ? k1a[e & 3] : k1b[e & 3], k2 = e < 4 ? k2a[e & 3] : k2b[e & 3];
            const float rq1 = q1 * cs.x - q2 * cs.y, rq2 = q2 * cs.x + q1 * cs.y, rk1 = (k1 * cs.x - k2 * cs.y) * 0.08838834764831845f, rk2 = (k2 * cs.x + k1 * cs.y) * 0.08838834764831845f;
            if (e < 4) { oq1a[e & 3] = rq1; oq2a[e & 3] = rq2; ok1a[e & 3] = rk1; ok2a[e & 3] = rk2; } else { oq1b[e & 3] = rq1; oq2b[e & 3] = rq2; ok1b[e & 3] = rk1; ok2b[e & 3] = rk2; }
            *(LAS bf16*)(LK + (d0 + e) * 272 + j * 2) = (bf16)f2bf(rk1 * kd); *(LAS bf16*)(LK + (d0 + 64 + e) * 272 + j * 2) = (bf16)f2bf(rk2 * kd);
        }
        const size_t orow = (size_t)(row0 + j) * 512 + h * 128 + d0;
        *(v4u*)(QR + orow) = pack8(oq1a, oq1b); *(v4u*)(QR + orow + 64) = pack8(oq2a, oq2b);
        *(v4u*)(KR + orow) = pack8(ok1a, ok1b); *(v4u*)(KR + orow + 64) = pack8(ok2a, ok2b);
    }
    for (int it = tid; it < 2048; it += NTHREADS) {
        const int j = it >> 4, cc = it & 15;
        const v4u w = *(const v4u*)(Z + (size_t)(row0 + j) * LDZ + ZC_RQKV + 1024 + h * 128 + cc * 8);
        LAS unsigned char* d = LV + (cc * 8) * 272 + j * 2;
        *(LAS bf16*)(d) = (bf16)(w.x & 0xffff); *(LAS bf16*)(d + 272) = (bf16)(w.x >> 16); *(LAS bf16*)(d + 2 * 272) = (bf16)(w.y & 0xffff); *(LAS bf16*)(d + 3 * 272) = (bf16)(w.y >> 16);
        *(LAS bf16*)(d + 4 * 272) = (bf16)(w.z & 0xffff); *(LAS bf16*)(d + 5 * 272) = (bf16)(w.z >> 16); *(LAS bf16*)(d + 6 * 272) = (bf16)(w.w & 0xffff); *(LAS bf16*)(d + 7 * 272) = (bf16)(w.w >> 16);
    }
    __syncthreads();
    float* RKV = (float*)(ws + WS_RKV) + (size_t)unit * 16384;
#pragma unroll
    for (int nt = 0; nt < 8; ++nt) {
        f32x4 acc = (f32x4){0.f, 0.f, 0.f, 0.f};
#pragma unroll
        for (int s = 0; s < 4; ++s) acc = mfma16(ld_frag_l(LK + (16 * wave + rl) * 272 + (32 * s + 8 * quad) * 2), ld_frag_l(LV + (16 * nt + rl) * 272 + (32 * s + 8 * quad) * 2), acc);
#pragma unroll
        for (int i = 0; i < 4; ++i) RKV[(size_t)(16 * wave + 4 * quad + i) * 128 + 16 * nt + rl] = acc[i];
    }
    __syncthreads();
}
DI void sample_rec_unit(Frame& F, int layer, int unit) {
    int lane = F.lane, wave = F.wave; asm volatile("" : "+v"(lane), "+s"(wave));
    const int tid = wave * 64 + lane;
    const int kind = unit >> 9, s = (unit >> 2) & 127, h = unit & 3;
    const int dv = tid & 127, part = tid >> 7, r0 = MP + 4 * s;
    unsigned char* ws = KWS();
    const bf16* Z = (const bf16*)(ws + WS_Z);
    const float* ZS = (const float*)(ws + WS_ZS);
    LAS float* Lq = (LAS float*)(F.lds); LAS float* Lk = Lq + 512; LAS float* Lv = Lq + 1024; LAS float* red = Lq + 1536; LAS float* Lo = Lq + 2048; LAS float* sc = Lq + 2560;
    float S[32];
    if (kind == 0) {
        if (tid < 384) {
            const int pr = tid >> 7, d = tid & 127, col = pr * 512 + h * 128 + d;
            float xp[7], w[4];
#pragma unroll
            for (int i = 0; i < 3; ++i) xp[i] = KIN(4)[((size_t)(layer * 128 + s) * 3 + i) * 1536 + col];
#pragma unroll
            for (int j = 0; j < 4; ++j) xp[3 + j] = bf2f(Z[(size_t)(r0 + j) * LDZ + ZC_GQKV + col]);
#pragma unroll
            for (int i = 0; i < 4; ++i) w[i] = KIN(15)[(size_t)(layer * 4 + i) * 1536 + col];
            LAS float* dst = pr == 0 ? Lq : pr == 1 ? Lk : Lv;
#pragma unroll
            for (int j = 0; j < 4; ++j) dst[j * 128 + d] = siluf_(w[0] * xp[j] + w[1] * xp[j + 1] + w[2] * xp[j + 2] + w[3] * xp[j + 3]);
        }
        __syncthreads();
        {
            LAS float* vp = (wave < 4 ? Lq : Lk) + (wave & 3) * 128;
            const float a = vp[2 * lane], b = vp[2 * lane + 1];
            const float scl = rsqrtf(wave_sum(a * a + b * b, lane) + EPS) * (wave < 4 ? 0.08838834764831845f : 1.f);
            vp[2 * lane] = a * scl; vp[2 * lane + 1] = b * scl;
        }
        if (tid < 4) {
            const float ga = ZS[(size_t)(r0 + tid) * 32 + 24 + h], gb = ZS[(size_t)(r0 + tid) * 32 + 28 + h];
            sc[tid] = __expf(-__expf(KIN(16)[layer * 4 + h]) * softplusf_(ga + KIN(17)[layer * 4 + h])); sc[4 + tid] = sigmoidf_(gb);
        }
        __syncthreads();
        const float* Sin = KIN(5) + ((size_t)((layer * 128 + s) * 4 + h) * 128 + 32 * part) * 128 + dv;
#pragma unroll
        for (int i = 0; i < 32; ++i) S[i] = Sin[(size_t)i * 128];
#pragma unroll
        for (int j = 0; j < 4; ++j) {
            const float a = sc[j], beta = sc[4 + j];
            float p = 0.f;
#pragma unroll
            for (int i = 0; i < 32; ++i) { S[i] *= a; p += Lk[j * 128 + 32 * part + i] * S[i]; }
            red[part * 128 + dv] = p;
            __syncthreads();
            const float delta = beta * (Lv[j * 128 + dv] - ((red[dv] + red[128 + dv]) + (red[256 + dv] + red[384 + dv])));
            __syncthreads();
            float o = 0.f;
#pragma unroll
            for (int i = 0; i < 32; ++i) { S[i] += Lk[j * 128 + 32 * part + i] * delta; o += Lq[j * 128 + 32 * part + i] * S[i]; }
            red[part * 128 + dv] = o;
            __syncthreads();
            if (part == 0) Lo[j * 128 + dv] = (red[dv] + red[128 + dv]) + (red[256 + dv] + red[384 + dv]);
            __syncthreads();
        }
        float* Sout = KOUT() + O_GSS + ((size_t)((layer * 128 + s) * 4 + h) * 128 + 32 * part) * 128 + dv;
#pragma unroll
        for (int i = 0; i < 32; ++i) Sout[(size_t)i * 128] = S[i];
        ((float*)(ws + WS_OGDN))[(size_t)(r0 + part) * 512 + h * 128 + dv] = Lo[part * 128 + dv];
    } else {
        const f32x2* ROT = (const f32x2*)(ws + WS_ROT);
        if (tid < 384) {
            const int pr = tid >> 7, d = tid & 127;
#pragma unroll
            for (int j = 0; j < 4; ++j) {
                const bf16* zp = Z + (size_t)(r0 + j) * LDZ + ZC_RQKV + pr * 512 + h * 128;
                float v = bf2f(zp[d]);
                if (pr < 2) { const f32x2 cs = ROT[(size_t)(2048 + j) * 64 + (d & 63)]; const float o = bf2f(zp[d ^ 64]);
                    v = (d < 64) ? v * cs.x - o * cs.y : v * cs.x + o * cs.y; if (pr == 1) v *= 0.08838834764831845f; }
                (pr == 0 ? Lq : pr == 1 ? Lk : Lv)[j * 128 + d] = v;
            }
        }
        __syncthreads();
        const float gam = __expf(ret_lg(h));
        const float* Sin = KIN(6) + ((size_t)((layer * 128 + s) * 4 + h) * 128 + 32 * part) * 128 + dv;
#pragma unroll
        for (int i = 0; i < 32; ++i) S[i] = Sin[(size_t)i * 128];
#pragma unroll
        for (int j = 0; j < 4; ++j) {
            const float vv = Lv[j * 128 + dv];
            float o = 0.f;
#pragma unroll
            for (int i = 0; i < 32; ++i) { S[i] = S[i] * gam + Lk[j * 128 + 32 * part + i] * vv; o += Lq[j * 128 + 32 * part + i] * S[i]; }
            red[part * 128 + dv] = o;
            __syncthreads();
            if (part == 0) Lo[j * 128 + dv] = (red[dv] + red[128 + dv]) + (red[256 + dv] + red[384 + dv]);
            __syncthreads();
        }
        float* Sout = KOUT() + O_RSS + ((size_t)((layer * 128 + s) * 4 + h) * 128 + 32 * part) * 128 + dv;
#pragma unroll
        for (int i = 0; i < 32; ++i) Sout[(size_t)i * 128] = S[i];
        if (wave < 4) {
            const int j = wave; const float a = Lo[j * 128 + 2 * lane], b = Lo[j * 128 + 2 * lane + 1];
            const float scl = rsqrtf(wave_sum(a * a + b * b, lane) * (1.f / 128.f) + EPS);
            const bf16* gp = Z + (size_t)(r0 + j) * LDZ + ZC_RG + h * 128 + 2 * lane;
            *(unsigned*)((bf16*)(ws + WS_MIX) + (size_t)(r0 + j) * 1536 + 1024 + h * 128 + 2 * lane) = pk2(a * scl * siluf_(bf2f(gp[0])), b * scl * siluf_(bf2f(gp[1])));
        }
    }
    __syncthreads();
}

DI void gdn_scan_chain(Frame& F, int layer, int bh) {
    int lane = F.lane, wave = F.wave; asm volatile("" : "+v"(lane), "+s"(wave));
    const int tid = wave * 64 + lane, quad = lane >> 4, rl = lane & 15;
    unsigned char* ws = KWS();
    const unsigned char* recb = ws + WS_GREC + (size_t)bh * 128 * GREC;
    LAS unsigned char* L = F.lds;
    constexpr int L_WP = 0, L_QP = 17408, L_KT = 34816, L_UT = 53248, L_QK = 71680;
    f32x4 S[8];
#pragma unroll
    for (int i = 0; i < 8; ++i) S[i] = (f32x4){0.f, 0.f, 0.f, 0.f};
    v4u pf[9]; float egl;
#pragma unroll
    for (int k = 0; k < 9; ++k) pf[k] = *(const v4u*)(recb + (size_t)(tid + 512 * k) * 16);
    egl = *(const float*)(recb + 73728);
    float* OG = (float*)(ws + WS_OGDN);
    const int b = bh >> 2, h = bh & 3;
    for (int c = 0; c < 128; ++c) {
        __syncthreads();
#pragma unroll
        for (int k = 0; k < 9; ++k) {
            const int o = tid * 16 + (k & 1) * 8192;
            const int reg = k >> 1;
            int dst;
            if (reg < 2) dst = (reg == 0 ? L_WP : L_QP) + (o >> 8) * 272 + (o & 255);
            else dst = (reg == 2 ? L_KT : reg == 3 ? L_UT : L_QK) + (o >> 7) * 144 + (o & 127);
            *(LAS v4u*)(L + dst) = pf[k];
        }
        const float eg = egl;
        __syncthreads();
        {
            const unsigned char* rn = recb + (size_t)(c + 1 < 128 ? c + 1 : 127) * GREC;
#pragma unroll
            for (int k = 0; k < 9; ++k) pf[k] = *(const v4u*)(rn + (size_t)(tid + 512 * k) * 16);
            egl = *(const float*)(rn + 73728);
        }
        bf16x8 Sb[4];
#pragma unroll
        for (int s = 0; s < 4; ++s) Sb[s] = pack_frag(S[2 * s], S[2 * s + 1]);
        f32x4 vn[4], O[4];
#pragma unroll
        for (int rt = 0; rt < 4; ++rt) {
            f32x4 wsacc = (f32x4){0.f, 0.f, 0.f, 0.f}, o = wsacc;
#pragma unroll
            for (int s = 0; s < 4; ++s) {
                wsacc = mfma16(ld_frag_l(L + L_WP + (16 * rt + rl) * 272 + (32 * s + 8 * quad) * 2), Sb[s], wsacc);
                o = mfma16(ld_frag_l(L + L_QP + (16 * rt + rl) * 272 + (32 * s + 8 * quad) * 2), Sb[s], o);
            }
            const v2u uw = *(const LAS v2u*)(L + L_UT + (16 * wave + rl) * 144 + (16 * rt + 4 * quad) * 2);
            vn[rt][0] = lo_bf(uw.x) - wsacc[0]; vn[rt][1] = hi_bf(uw.x) - wsacc[1]; vn[rt][2] = lo_bf(uw.y) - wsacc[2]; vn[rt][3] = hi_bf(uw.y) - wsacc[3];
            O[rt] = o;
        }
        bf16x8 Vb[2]; Vb[0] = pack_frag(vn[0], vn[1]); Vb[1] = pack_frag(vn[2], vn[3]);
#pragma unroll
        for (int rt = 0; rt < 4; ++rt) {
#pragma unroll
            for (int s2 = 0; s2 < 2; ++s2) O[rt] = mfma16(ld_frag_l(L + L_QK + (16 * rt + rl) * 144 + (32 * s2 + 8 * quad) * 2), Vb[s2], O[rt]);
            const size_t row = (size_t)b * TP + 64 * c + 16 * rt + 4 * quad;
#pragma unroll
            for (int i = 0; i < 4; ++i) OG[(row + i) * 512 + h * 128 + 16 * wave + rl] = O[rt][i];
        }
#pragma unroll
        for (int kt = 0; kt < 8; ++kt) {
            f32x4 a = S[kt] * eg;
#pragma unroll
            for (int s2 = 0; s2 < 2; ++s2) a = mfma16(ld_frag_l(L + L_KT + (16 * kt + rl) * 144 + (32 * s2 + 8 * quad) * 2), Vb[s2], a);
            S[kt] = a;
        }
    }
    float* So = KOUT() + O_GSP + (size_t)(layer * 8 + bh) * 16384;
#pragma unroll
    for (int kt = 0; kt < 8; ++kt)
#pragma unroll
        for (int i = 0; i < 4; ++i) So[(size_t)(16 * kt + 4 * quad + i) * 128 + 16 * wave + rl] = S[kt][i];
    __syncthreads();
}
DI void ret_scan_part(Frame& F, int layer, int r) {
    int tid = F.tid; asm volatile("" : "+v"(tid));
    const int bh = r >> 2, dv = tid & 127, dk0 = ((r & 3) * 4 + (tid >> 7)) * 8, h = bh & 3;
    unsigned char* ws = KWS();
    const float* RKV = (const float*)(ws + WS_RKV) + (size_t)bh * 64 * 16384;
    bf16* RST = (bf16*)(ws + WS_RST) + (size_t)bh * 64 * 16384;
    const float cdec = __expf(128.f * ret_lg(h));
    float S[8];
#pragma unroll
    for (int i = 0; i < 8; ++i) S[i] = 0.f;
#pragma unroll 4
    for (int c = 0; c < 64; ++c) {
        v4u w; w.x = pk2(S[0], S[1]); w.y = pk2(S[2], S[3]); w.z = pk2(S[4], S[5]); w.w = pk2(S[6], S[7]);
        *(v4u*)(RST + (size_t)c * 16384 + dv * 128 + dk0) = w;
#pragma unroll
        for (int i = 0; i < 8; ++i) S[i] = S[i] * cdec + RKV[(size_t)c * 16384 + (dk0 + i) * 128 + dv];
    }
    float* So = KOUT() + O_RSP + (size_t)(layer * 8 + bh) * 16384;
#pragma unroll
    for (int i = 0; i < 8; ++i) So[(size_t)(dk0 + i) * 128 + dv] = S[i];
}
constexpr float SM_C = 0.125f * 1.4426950408889634f;
struct AttnState { float m, l; f32x4 O[4]; };
DI void attn_reset(AttnState& st) { st.m = -1e30f; st.l = 0.f;
#pragma unroll
    for (int i = 0; i < 4; ++i) st.O[i] = (f32x4){0.f, 0.f, 0.f, 0.f}; }
DI void qk_tile(const LAS unsigned char* Kt, const bf16x8 (&qf)[2], f32x4 (&s)[4], int rl, int quad) {
    bf16x8 kf[4][2];
#pragma unroll
    for (int kt = 0; kt < 4; ++kt)
#pragma unroll
        for (int kk = 0; kk < 2; ++kk) kf[kt][kk] = ld_frag_l(Kt + (16 * kt + rl) * 144 + kk * 64 + quad * 16);
    __builtin_amdgcn_s_setprio(1);
#pragma unroll
    for (int kt = 0; kt < 4; ++kt) s[kt] = mfma16(kf[kt][0], qf[0], (f32x4){0.f, 0.f, 0.f, 0.f});
#pragma unroll
    for (int kt = 0; kt < 4; ++kt) s[kt] = mfma16(kf[kt][1], qf[1], s[kt]);
    __builtin_amdgcn_s_setprio(0);
}
template <class Mask> DI void attn_step(const LAS unsigned char* Kt, const LAS unsigned char* VT, const bf16x8 (&qf)[2], AttnState& st, const Mask& ok, int rl, int quad) {
    f32x4 s[4]; qk_tile(Kt, qf, s, rl, quad);
    float mx = -3e38f;
#pragma unroll
    for (int kt = 0; kt < 4; ++kt)
#pragma unroll
        for (int i = 0; i < 4; ++i) if (ok(16 * kt + 4 * quad + i)) mx = fmaxf(mx, s[kt][i]);
    const int lane = rl + 16 * quad;
    mx = fmaxf(mx, shx<16>(mx, lane)); mx = fmaxf(mx, shx<32>(mx, lane));
    const float mn = fmaxf(st.m, mx);
    const float alpha = exp2f((st.m - mn) * SM_C);
    float ls = 0.f;
#pragma unroll
    for (int kt = 0; kt < 4; ++kt)
#pragma unroll
        for (int i = 0; i < 4; ++i) { const float p = ok(16 * kt + 4 * quad + i) ? exp2f((s[kt][i] - mn) * SM_C) : 0.f; s[kt][i] = p; ls += p; }
    ls += shx<16>(ls, lane); ls += shx<32>(ls, lane);
    st.l = st.l * alpha + ls; st.m = mn;
#pragma unroll
    for (int dt = 0; dt < 4; ++dt) st.O[dt] *= alpha;
#pragma unroll
    for (int ii = 0; ii < 2; ++ii) {
        const bf16x8 pb = pack_frag(s[2 * ii], s[2 * ii + 1]);
#pragma unroll
        for (int dt = 0; dt < 4; ++dt) {
            const LAS unsigned char* vp = VT + (16 * dt + rl) * 144 + (32 * ii + 4 * quad) * 2;
            st.O[dt] = mfma16(mk_frag(*(const LAS v2u*)vp, *(const LAS v2u*)(vp + 32)), pb, st.O[dt]);
        }
    }
}
DI void attn_accum(f32x4 (&Of)[4], const AttnState& st, float gate) {
    const float sc = st.l > 0.f ? gate / st.l : 0.f;
#pragma unroll
    for (int dt = 0; dt < 4; ++dt) Of[dt] += st.O[dt] * sc;
}
DI void vt_write(LAS unsigned char* VT, int d0, int key, const v4u w) {
    LAS unsigned char* d = VT + d0 * 144 + key * 2;
    *(LAS bf16*)(d) = (bf16)(w.x & 0xffff); *(LAS bf16*)(d + 144) = (bf16)(w.x >> 16); *(LAS bf16*)(d + 2 * 144) = (bf16)(w.y & 0xffff); *(LAS bf16*)(d + 3 * 144) = (bf16)(w.y >> 16);
    *(LAS bf16*)(d + 4 * 144) = (bf16)(w.z & 0xffff); *(LAS bf16*)(d + 5 * 144) = (bf16)(w.z >> 16); *(LAS bf16*)(d + 6 * 144) = (bf16)(w.w & 0xffff); *(LAS bf16*)(d + 7 * 144) = (bf16)(w.w >> 16);
}
DI void stage_wg(LAS unsigned char* Kt, LAS unsigned char* VT, const bf16* kb, const bf16* vb, size_t stride, int tid, bool do_v) {
    const int key = tid >> 3, ch = tid & 7;
    *(LAS v4u*)(Kt + key * 144 + ch * 16) = *(const v4u*)(kb + key * stride + ch * 8);
    if (do_v) vt_write(VT, ch * 8, key, *(const v4u*)(vb + key * stride + ch * 8));
}
DI unsigned score_key(float s, bool valid, int idx) { return valid ? (((__float_as_uint(s) | 0x80000000u) & ~127u) | (unsigned)(127 - idx)) : 0u; }
DI int key_rank(const LAS unsigned* K, int ng4, unsigned k) {
    int r = 0;
#pragma unroll 4
    for (int g = 0; g < ng4; ++g) { const v4u v = *(const LAS v4u*)(K + 4 * g); r += (v.x > k) + (v.y > k) + (v.z > k) + (v.w > k); }
    return r;
}
DI void key_rank2(const LAS unsigned* K, int ng4, unsigned k0, unsigned k1, int& r0, int& r1) {
    int a0 = 0, a1 = 0, b0 = 0, b1 = 0;
    const int ng8 = (ng4 + 1) >> 1;
#pragma unroll 4
    for (int g = 0; g < ng8; ++g) { const v4u v = *(const LAS v4u*)(K + 8 * g), w = *(const LAS v4u*)(K + 8 * g + 4);
        a0 += (v.x > k0) + (v.y > k0) + (v.z > k0) + (v.w > k0); b0 += (w.x > k0) + (w.y > k0) + (w.z > k0) + (w.w > k0);
        a1 += (v.x > k1) + (v.y > k1) + (v.z > k1) + (v.w > k1); b1 += (w.x > k1) + (w.y > k1) + (w.z > k1) + (w.w > k1); }
    r0 = a0 + b0; r1 = a1 + b1;
}
DI int top16(float v0, float v1, int lane) {
    int sel = 0;
#pragma unroll 1
    for (int r = 0; r < 16; ++r) {
        float bv; int bi;
        if (v0 >= v1) { bv = v0; bi = lane; } else { bv = v1; bi = lane + 64; }
#define T16_STEP(M) { const float ov = shx<M>(bv, lane); const int oi = shxi<M>(bi, lane); const bool take = (ov > bv) || (ov == bv && oi < bi); bv = take ? ov : bv; bi = take ? oi : bi; }
        T16_STEP(32) T16_STEP(16) T16_STEP(8) T16_STEP(4) T16_STEP(2) T16_STEP(1)
#undef T16_STEP
        const bool h0 = (bi == lane), h1 = (bi == lane + 64);
        v0 = h0 ? -3e38f : v0; v1 = h1 ? -3e38f : v1; sel |= (h0 ? 1 : 0) | (h1 ? 2 : 0);
    }
    return sel;
}

typedef short v4i16_t __attribute__((ext_vector_type(4)));
DI s16x4 vtr(const LAS unsigned char* p) { return __builtin_bit_cast(s16x4, __builtin_amdgcn_ds_read_tr16_b64_v4i16((LAS v4i16_t*)p)); }
DI bf16x8 cat4(s16x4 a, s16x4 b) { bf16x8 r; r[0] = a[0]; r[1] = a[1]; r[2] = a[2]; r[3] = a[3]; r[4] = b[0]; r[5] = b[1]; r[6] = b[2]; r[7] = b[3]; return r; }
DI void attn_step3(const LAS unsigned char* Kt, const LAS unsigned char* Vt, const bf16x8 (&qf)[2], AttnState& st, int lo, int hi, bool active, int rl, int quad) {
    active = active && (hi >= lo);
    if (!__any(active)) return;
    f32x4 s[4]; qk_tile(Kt, qf, s, rl, quad);
    const int lane = rl + 16 * quad;
    const bool full = __all((lo <= 0 && hi >= 63) || !active);
    const int kq = 4 * quad - lo; const unsigned rng = (unsigned)(hi - lo);
    float lm;
    if (full) {
        const float a0 = fmaxf(fmaxf(s[0][0], s[0][1]), fmaxf(s[0][2], s[0][3])), a1 = fmaxf(fmaxf(s[1][0], s[1][1]), fmaxf(s[1][2], s[1][3]));
        const float a2 = fmaxf(fmaxf(s[2][0], s[2][1]), fmaxf(s[2][2], s[2][3])), a3 = fmaxf(fmaxf(s[3][0], s[3][1]), fmaxf(s[3][2], s[3][3]));
        lm = fmaxf(fmaxf(a0, a1), fmaxf(a2, a3));
    } else {
        lm = -3e38f;
#pragma unroll
        for (int kt = 0; kt < 4; ++kt)
#pragma unroll
            for (int i = 0; i < 4; ++i) lm = ((unsigned)(kq + 16 * kt + i) <= rng) ? fmaxf(lm, s[kt][i]) : lm;
    }
    lm = active ? lm : -3e38f;
    if (__any(lm > st.m + 320.f)) {
        float mx = fmaxf(lm, shx<16>(lm, lane)); mx = fmaxf(mx, shx<32>(mx, lane));
        const float mn = fmaxf(st.m, mx);
        const float alpha = __builtin_amdgcn_exp2f((st.m - mn) * SM_C);
        st.l *= alpha; st.m = mn;
#pragma unroll
        for (int dt = 0; dt < 4; ++dt) st.O[dt] *= alpha;
    }
    const float mc = active ? st.m * SM_C : __builtin_inff();
    float ls = 0.f;
    if (full) {
#pragma unroll
        for (int kt = 0; kt < 4; ++kt)
#pragma unroll
            for (int i = 0; i < 4; ++i) { const float p = __builtin_amdgcn_exp2f(s[kt][i] * SM_C - mc); s[kt][i] = p; ls += p; }
    } else {
#pragma unroll
        for (int kt = 0; kt < 4; ++kt)
#pragma unroll
            for (int i = 0; i < 4; ++i) { const float p = ((unsigned)(kq + 16 * kt + i) <= rng) ? __builtin_amdgcn_exp2f(s[kt][i] * SM_C - mc) : 0.f; s[kt][i] = p; ls += p; }
    }
    st.l += ls;
#pragma unroll
    for (int ii = 0; ii < 2; ++ii) {
        const bf16x8 pb = pack_frag(s[2 * ii], s[2 * ii + 1]);
#pragma unroll
        for (int dt = 0; dt < 4; ++dt) {
            const LAS unsigned char* vp = Vt + (32 * ii + 4 * quad + (rl >> 2)) * 144 + (16 * dt + 4 * (rl & 3)) * 2;
            st.O[dt] = mfma16(cat4(vtr(vp), vtr(vp + 16 * 144)), pb, st.O[dt]);
        }
    }
}
DI float attn_rowsum(const AttnState& st, int lane) { float l = st.l; l += shx<16>(l, lane); l += shx<32>(l, lane); return l; }
DI void attn_accum3(f32x4 (&Of)[4], const AttnState& st, float gate, int lane) {
    const float l = attn_rowsum(st, lane);
    const float sc = l > 0.f ? gate / l : 0.f;
#pragma unroll
    for (int dt = 0; dt < 4; ++dt) Of[dt] += st.O[dt] * sc;
}
#ifndef PH_NPT
#define PH_NPT (-1)
#endif
#if PH_NPT >= 0
#define NP_T(k) do { if (tid == 0) { volatile LAS unsigned long long* np_ = (volatile LAS unsigned long long*)(F.lds + LDSCTL_OFF + 464); const unsigned long long now_ = __builtin_amdgcn_s_memrealtime(); \
    if ((k) == PH_NPT) np_[0] += now_ - np_[1]; np_[1] = now_; } } while (0)
#else
#define NP_T(k) do { } while (0)
#endif
#ifndef PH_NSAC
#define PH_NSAC 1
#endif
DI float tile_max(const f32x4 (&s)[4], bool full, int kq, unsigned rng) {
    float lm;
    if (full) {
        const float a0 = fmaxf(fmaxf(s[0][0], s[0][1]), fmaxf(s[0][2], s[0][3])), a1 = fmaxf(fmaxf(s[1][0], s[1][1]), fmaxf(s[1][2], s[1][3]));
        const float a2 = fmaxf(fmaxf(s[2][0], s[2][1]), fmaxf(s[2][2], s[2][3])), a3 = fmaxf(fmaxf(s[3][0], s[3][1]), fmaxf(s[3][2], s[3][3]));
        lm = fmaxf(fmaxf(a0, a1), fmaxf(a2, a3));
    } else {
        lm = -3e38f;
#pragma unroll
        for (int kt = 0; kt < 4; ++kt)
#pragma unroll
            for (int i = 0; i < 4; ++i) lm = ((unsigned)(kq + 16 * kt + i) <= rng) ? fmaxf(lm, s[kt][i]) : lm;
    }
    return lm;
}
DI float tile_exp(f32x4 (&s)[4], bool full, int kq, unsigned rng, float mc) {
    float ls = 0.f;
    if (full) {
#pragma unroll
        for (int kt = 0; kt < 4; ++kt)
#pragma unroll
            for (int i = 0; i < 4; ++i) { const float p = __builtin_amdgcn_exp2f(s[kt][i] * SM_C - mc); s[kt][i] = p; ls += p; }
    } else {
#pragma unroll
        for (int kt = 0; kt < 4; ++kt)
#pragma unroll
            for (int i = 0; i < 4; ++i) { const float p = ((unsigned)(kq + 16 * kt + i) <= rng) ? __builtin_amdgcn_exp2f(s[kt][i] * SM_C - mc) : 0.f; s[kt][i] = p; ls += p; }
    }
    return ls;
}
DI void tile_pv(const LAS unsigned char* Vt, const f32x4 (&s)[4], f32x4 (&O)[4], int rl, int quad) {
    bf16x8 vf[2][4];
#pragma unroll
    for (int ii = 0; ii < 2; ++ii)
#pragma unroll
        for (int dt = 0; dt < 4; ++dt) { const LAS unsigned char* vp = Vt + (32 * ii + 4 * quad + (rl >> 2)) * 144 + (16 * dt + 4 * (rl & 3)) * 2; vf[ii][dt] = cat4(vtr(vp), vtr(vp + 16 * 144)); }
    const bf16x8 pb0 = pack_frag(s[0], s[1]), pb1 = pack_frag(s[2], s[3]);
    __builtin_amdgcn_s_setprio(1);
#pragma unroll
    for (int dt = 0; dt < 4; ++dt) O[dt] = mfma16(vf[0][dt], pb0, O[dt]);
#pragma unroll
    for (int dt = 0; dt < 4; ++dt) O[dt] = mfma16(vf[1][dt], pb1, O[dt]);
    __builtin_amdgcn_s_setprio(0);
}
DI void tile_vload(const LAS unsigned char* Vt, bf16x8 (&vf)[2][4], int rl, int quad) {
#pragma unroll
    for (int ii = 0; ii < 2; ++ii)
#pragma unroll
        for (int dt = 0; dt < 4; ++dt) { const LAS unsigned char* vp = Vt + (32 * ii + 4 * quad + (rl >> 2)) * 144 + (16 * dt + 4 * (rl & 3)) * 2; vf[ii][dt] = cat4(vtr(vp), vtr(vp + 16 * 144)); }
}
DI void tile_pvmma(const bf16x8 (&vf)[2][4], const f32x4 (&s)[4], f32x4 (&O)[4]) {
    const bf16x8 pb0 = pack_frag(s[0], s[1]), pb1 = pack_frag(s[2], s[3]);
    __builtin_amdgcn_s_setprio(1);
#pragma unroll
    for (int dt = 0; dt < 4; ++dt) O[dt] = mfma16(vf[0][dt], pb0, O[dt]);
#pragma unroll
    for (int dt = 0; dt < 4; ++dt) O[dt] = mfma16(vf[1][dt], pb1, O[dt]);
    __builtin_amdgcn_s_setprio(0);
}
DI void attn_step_pair(const LAS unsigned char* K0, const LAS unsigned char* V0, int lo0, int hi0, bool act0,
                       const LAS unsigned char* K1, const LAS unsigned char* V1, int lo1, int hi1, bool act1,
                       const bf16x8 (&qf)[2], AttnState& st, int rl, int quad) {
    act0 = act0 && (hi0 >= lo0); act1 = act1 && (hi1 >= lo1);
    const bool any0 = __any(act0), any1 = __any(act1);
    if (!any0 && !any1) return;
    const int lane = rl + 16 * quad;
    f32x4 s0[4], s1[4];
    if (any0 && any1) {
        bf16x8 kf0[4][2], kf1[4][2];
#pragma unroll
        for (int kt = 0; kt < 4; ++kt)
#pragma unroll
            for (int kk = 0; kk < 2; ++kk) { kf0[kt][kk] = ld_frag_l(K0 + (16 * kt + rl) * 144 + kk * 64 + quad * 16); kf1[kt][kk] = ld_frag_l(K1 + (16 * kt + rl) * 144 + kk * 64 + quad * 16); }
        __builtin_amdgcn_s_setprio(1);
#pragma unroll
        for (int kt = 0; kt < 4; ++kt) s0[kt] = mfma16(kf0[kt][0], qf[0], (f32x4){0.f, 0.f, 0.f, 0.f});
#pragma unroll
        for (int kt = 0; kt < 4; ++kt) s1[kt] = mfma16(kf1[kt][0], qf[0], (f32x4){0.f, 0.f, 0.f, 0.f});
#pragma unroll
        for (int kt = 0; kt < 4; ++kt) s0[kt] = mfma16(kf0[kt][1], qf[1], s0[kt]);
#pragma unroll
        for (int kt = 0; kt < 4; ++kt) s1[kt] = mfma16(kf1[kt][1], qf[1], s1[kt]);
        __builtin_amdgcn_s_setprio(0);
    } else {
        if (any0) qk_tile(K0, qf, s0, rl, quad);
        if (any1) qk_tile(K1, qf, s1, rl, quad);
    }
    const bool full0 = __all((lo0 <= 0 && hi0 >= 63) || !act0), full1 = __all((lo1 <= 0 && hi1 >= 63) || !act1);
    const int kq0 = 4 * quad - lo0, kq1 = 4 * quad - lo1; const unsigned rng0 = (unsigned)(hi0 - lo0), rng1 = (unsigned)(hi1 - lo1);
    float mcb = st.m * SM_C;
    bf16x8 vf0[2][4], vf1[2][4];
    if (any0) tile_vload(V0, vf0, rl, quad);
    float ls = 0.f;
    if (any0) ls += tile_exp(s0, full0, kq0, rng0, act0 ? mcb : __builtin_inff());
    if (any1) ls += tile_exp(s1, full1, kq1, rng1, act1 ? mcb : __builtin_inff());
    if (__any(!(ls <= 1e30f))) {
        if (any0) qk_tile(K0, qf, s0, rl, quad);
        if (any1) qk_tile(K1, qf, s1, rl, quad);
        float lm = -3e38f;
        if (any0) { const float a = tile_max(s0, full0, kq0, rng0); lm = act0 ? a : lm; }
        if (any1) { const float a = tile_max(s1, full1, kq1, rng1); lm = act1 ? fmaxf(lm, a) : lm; }
        float mx = fmaxf(lm, shx<16>(lm, lane)); mx = fmaxf(mx, shx<32>(mx, lane));
        const float mn = fmaxf(st.m, mx);
        const float alpha = __builtin_amdgcn_exp2f((st.m - mn) * SM_C);
        st.l *= alpha; st.m = mn;
#pragma unroll
        for (int dt = 0; dt < 4; ++dt) st.O[dt] *= alpha;
        mcb = mn * SM_C; ls = 0.f;
        if (any0) ls += tile_exp(s0, full0, kq0, rng0, act0 ? mcb : __builtin_inff());
        if (any1) ls += tile_exp(s1, full1, kq1, rng1, act1 ? mcb : __builtin_inff());
    }
    st.l += ls;
    if (any1) tile_vload(V1, vf1, rl, quad);
    if (any0) tile_pvmma(vf0, s0, st.O);
    if (any1) tile_pvmma(vf1, s1, st.O);
}
DI void nsa_prompt_unit(Frame& F, int layer, int unit) {
    int lane = F.lane, wave = F.wave; asm volatile("" : "+v"(lane), "+s"(wave));
    const int tid = wave * 64 + lane, quad = lane >> 4, rl = lane & 15;
    const int b = unit >> 9, g = (unit >> 8) & 1, tt = unit & 255, t0 = 32 * tt;
    unsigned char* ws = KWS();
    const bf16* Z = (const bf16*)(ws + WS_Z);
    const float* ZS = (const float*)(ws + WS_ZS);
    LAS unsigned char* TB = F.lds;
    LAS float* AIMP = (LAS float*)(F.lds + 73728);
    LAS unsigned* SEL = (LAS unsigned*)(F.lds + LDSCTL_OFF + 512);
    const int tk = 4 * wave + (rl >> 2), t = t0 + tk, head = 4 * g + (rl & 3);
    const size_t row = (size_t)b * TP + t;
    bf16x8 qf[2];
    qf[0] = ld_frag_g(Z + row * LDZ + ZC_Q + head * 64 + quad * 8); qf[1] = ld_frag_g(Z + row * LDZ + ZC_Q + head * 64 + 32 + quad * 8);
    const float gc = sigmoidf_(ZS[row * 32 + head * 3]), gs = sigmoidf_(ZS[row * 32 + head * 3 + 1]), gw = sigmoidf_(ZS[row * 32 + head * 3 + 2]);
    f32x4 Of[4];
#pragma unroll
    for (int i = 0; i < 4; ++i) Of[i] = (f32x4){0.f, 0.f, 0.f, 0.f};
    AttnState st;
    const int nct = (t0 >> 10) + 1;
    const bf16* KC = (const bf16*)(ws + WS_KC) + ((size_t)(0 * 2 + b) * 512 * 2 + g) * 64;
    const bf16* VC = (const bf16*)(ws + WS_KC) + ((size_t)(1 * 2 + b) * 512 * 2 + g) * 64;
    const bf16* Zb = Z + (size_t)b * TP * LDZ + g * 64;
    const int skey = tid >> 3, sch = tid & 7;
    const int wlo = (t0 - 511 > 0 ? t0 - 511 : 0) >> 6, nwin = ((t0 + 31) >> 6) - wlo + 1;
    const int nwe = (nwin + 1) & ~1, nce = (nct + 1) & ~1;
    v4u rkA, rvA, rkB, rvB;
#define COMMIT(slot, rk, rv) do { LAS unsigned char* d_ = TB + (slot) * 18432 + skey * 144 + sch * 16; *(LAS v4u*)d_ = rk; *(LAS v4u*)(d_ + 9216) = rv; } while (0)
    NP_T(0);
    const int n1 = nwe + 2 * nce;
#define SEG1_VALID(i) ((i) < nwe ? (i) < nwin : (((i) - nwe) < nce ? ((i) - nwe) < nct : ((i) - nwe - nce) < nct))
#define SEG1_ISSUE(i, rk, rv) do { int i_ = (i); i_ = i_ < n1 ? i_ : n1 - 1; const bool win_ = i_ < nwe; int wt_ = wlo + (i_ < nwin ? i_ : nwin - 1); int jt_ = (i_ - nwe) % nce; jt_ = jt_ < nct ? jt_ : nct - 1; jt_ = jt_ < 0 ? 0 : jt_; \
        const bf16* pk_ = win_ ? Zb + (size_t)(64 * wt_ + skey) * LDZ + sch * 8 + ZC_KW : KC + (size_t)(64 * jt_ + skey) * 128 + sch * 8; \
        const bf16* pv_ = win_ ? Zb + (size_t)(64 * wt_ + skey) * LDZ + sch * 8 + ZC_VW : VC + (size_t)(64 * jt_ + skey) * 128 + sch * 8; \
        rk = *(const v4u*)pk_; rv = *(const v4u*)pv_; } while (0)
    attn_reset(st);
    float mfin = 0.f, il = 0.f;
    SEG1_ISSUE(0, rkA, rvA); SEG1_ISSUE(1, rkB, rvB);
    COMMIT(0, rkA, rvA); COMMIT(1, rkB, rvB);
    SEG1_ISSUE(2, rkA, rvA); SEG1_ISSUE(3, rkB, rvB);
    __syncthreads();
    for (int i = 0; i < n1; i += 2) {
        const LAS unsigned char* K0 = TB + (i & 3) * 18432; const LAS unsigned char* K1 = TB + ((i + 1) & 3) * 18432;
        if (i < nwe) {
            const int kb0 = 64 * (wlo + i), kb1 = kb0 + 64;
            attn_step_pair(K0, K0 + 9216, t - 511 - kb0, t - kb0, true, K1, K1 + 9216, t - 511 - kb1, t - kb1, (i + 1) < nwin, qf, st, rl, quad);
            if (i + 2 == nwe) { attn_accum3(Of, st, gw, lane); attn_reset(st); }
        } else if (i < nwe + nce) {
            const int nb0 = 64 * (i - nwe), nb1 = nb0 + 64;
            attn_step_pair(K0, K0 + 9216, 0, ((t - 31) >> 4) - nb0, true, K1, K1 + 9216, 0, ((t - 31) >> 4) - nb1, (i + 1 - nwe) < nct, qf, st, rl, quad);
            if (i + 2 == nwe + nce) { attn_accum3(Of, st, gc, lane); mfin = st.m * SM_C; const float lt_ = attn_rowsum(st, lane); il = lt_ > 0.f ? 1.f / lt_ : 0.f; }
        } else {
#pragma unroll
            for (int e2 = 0; e2 < 2; ++e2) {
                const int jt = i + e2 - nwe - nce;
                if (jt < nct) {
                    f32x4 s[4]; qk_tile(e2 ? K1 : K0, qf, s, rl, quad);
#pragma unroll
                    for (int kt = 0; kt < 4; ++kt)
#pragma unroll
                        for (int e = 0; e < 4; ++e) {
                            const int n = 64 * jt + 16 * kt + 4 * quad + e;
                            float p = (16 * n + 31 <= t) ? __builtin_amdgcn_exp2f(s[kt][e] * SM_C - mfin) * il : 0.f;
                            p += shx<1>(p, lane); p += shx<2>(p, lane);
                            if ((rl & 3) == 0) AIMP[tk * 512 + n] = p;
                        }
                }
            }
        }
        if (i + 2 < n1) { if (SEG1_VALID(i + 2)) COMMIT((i + 2) & 3, rkA, rvA); if (SEG1_VALID(i + 3)) COMMIT((i + 3) & 3, rkB, rvB); }
        __syncthreads();
        SEG1_ISSUE(i + 4, rkA, rvA); SEG1_ISSUE(i + 5, rkB, rvB);
    }
    NP_T(1);
    {
        const int nav = nct * 64;
        LAS unsigned* KS = (LAS unsigned*)(TB + wave * 2048);
#pragma unroll
        for (int q = 0; q < 4; ++q) {
            const int tq = 4 * wave + q, cur = (t0 + tq) >> 6;
#pragma unroll
            for (int e = 0; e < 2; ++e) {
                const int sblk = lane + 64 * e;
                float imp = 0.f;
#pragma unroll
                for (int d = -1; d <= 3; ++d) { const int n = 4 * sblk + d; if (n >= 0 && n < nav) imp += AIMP[tq * 512 + n]; }
                const bool valid = sblk <= cur, forced = (sblk == 0) || (sblk == cur) || (sblk == cur - 1);
                KS[q * 128 + sblk] = score_key(imp + (forced ? 1000.f : 0.f), valid, sblk);
            }
        }
        asm volatile("" ::: "memory");
#pragma unroll
        for (int q = 0; q < 4; ++q) {
            const int tq = 4 * wave + q, cur = (t0 + tq) >> 6, ng4 = (cur >> 2) + 1;
            const unsigned k0 = KS[q * 128 + lane], k1 = KS[q * 128 + 64 + lane];
            int r0, r1; key_rank2(KS + q * 128, ng4, k0, k1, r0, r1);
            const bool s0 = (lane <= cur) && r0 < 16, s1 = (lane + 64 <= cur) && r1 < 16;
            const unsigned long long m0 = __ballot(s0), m1 = __ballot(s1);
            if (lane == 0) { SEL[tq * 4 + 0] = (unsigned)m0; SEL[tq * 4 + 1] = (unsigned)(m0 >> 32); SEL[tq * 4 + 2] = (unsigned)m1; SEL[tq * 4 + 3] = (unsigned)(m1 >> 32); }
        }
    }
    __syncthreads();
    unsigned un[4], my[4], wv[4];
#pragma unroll
    for (int w = 0; w < 4; ++w) { unsigned v = (lane < 32) ? SEL[lane * 4 + w] : 0u;
        v |= (unsigned)shxi<1>((int)v, lane); v |= (unsigned)shxi<2>((int)v, lane); v |= (unsigned)shxi<4>((int)v, lane); v |= (unsigned)shxi<8>((int)v, lane); v |= (unsigned)shxi<16>((int)v, lane); v |= (unsigned)shxi<32>((int)v, lane);
        un[w] = __builtin_amdgcn_readfirstlane(v); my[w] = SEL[tk * 4 + w];
        wv[w] = SEL[(4 * wave) * 4 + w] | SEL[(4 * wave + 1) * 4 + w] | SEL[(4 * wave + 2) * 4 + w] | SEL[(4 * wave + 3) * 4 + w]; wv[w] = __builtin_amdgcn_readfirstlane(wv[w]); }
#if PH_NSAC > 1
    AttnState st2; attn_reset(st2);
#endif
    NP_T(2);
    attn_reset(st);
    {
        unsigned w0 = un[0], w1 = un[1], w2 = un[2], w3 = un[3];
#define NEXT_BLK(dst) do { if (w0) { dst = __builtin_ctz(w0); w0 &= w0 - 1u; } else if (w1) { dst = 32 + __builtin_ctz(w1); w1 &= w1 - 1u; } else if (w2) { dst = 64 + __builtin_ctz(w2); w2 &= w2 - 1u; } \
        else if (w3) { dst = 96 + __builtin_ctz(w3); w3 &= w3 - 1u; } else dst = -1; } while (0)
#define SEG2_ISSUE(blk_, rk, rv) do { const int b_ = (blk_) >= 0 ? (blk_) : 0; const bf16* p_ = Zb + (size_t)(64 * b_ + skey) * LDZ + sch * 8; rk = *(const v4u*)(p_ + ZC_KS); rv = *(const v4u*)(p_ + ZC_VS); } while (0)
#define BLK_WORD(arr, blk_) (((blk_) >> 5) == 0 ? arr[0] : ((blk_) >> 5) == 1 ? arr[1] : ((blk_) >> 5) == 2 ? arr[2] : arr[3])
#define SEG2_PAIR(ca, cb, sa, sb, stt) do { const LAS unsigned char* K0 = TB + (sa) * 18432; const LAS unsigned char* K1 = TB + (sb) * 18432; \
            const int ca_ = (ca) >= 0 ? (ca) : 0, cb_ = (cb) >= 0 ? (cb) : 0; \
            const bool need0 = ((ca) >= 0) && ((BLK_WORD(wv, ca_) >> (ca_ & 31)) & 1u), need1 = ((cb) >= 0) && ((BLK_WORD(wv, cb_) >> (cb_ & 31)) & 1u); \
            const bool mine0 = need0 && ((BLK_WORD(my, ca_) >> (ca_ & 31)) & 1u), mine1 = need1 && ((BLK_WORD(my, cb_) >> (cb_ & 31)) & 1u); \
            attn_step_pair(K0, K0 + 9216, 0, t - 64 * ca_, mine0, K1, K1 + 9216, 0, t - 64 * cb_, mine1, qf, stt, rl, quad); } while (0)
        v4u rkC, rvC, rkD, rvD;
        int c0, c1, c2, c3, n0, n1b, n2, n3, m0, m1, m2, m3;
        NEXT_BLK(c0); NEXT_BLK(c1); NEXT_BLK(c2); NEXT_BLK(c3); NEXT_BLK(n0); NEXT_BLK(n1b); NEXT_BLK(n2); NEXT_BLK(n3);
        SEG2_ISSUE(c0, rkA, rvA); SEG2_ISSUE(c1, rkB, rvB); SEG2_ISSUE(c2, rkC, rvC); SEG2_ISSUE(c3, rkD, rvD);
        COMMIT(0, rkA, rvA); COMMIT(1, rkB, rvB); COMMIT(2, rkC, rvC); COMMIT(3, rkD, rvD);
        SEG2_ISSUE(n0, rkA, rvA); SEG2_ISSUE(n1b, rkB, rvB); SEG2_ISSUE(n2, rkC, rvC); SEG2_ISSUE(n3, rkD, rvD);
        __syncthreads();
        int i = 0;
        while (c0 >= 0) {
            NEXT_BLK(m0); NEXT_BLK(m1); NEXT_BLK(m2); NEXT_BLK(m3);
            SEG2_PAIR(c0, c1, i & 7, (i + 1) & 7, st);
            SEG2_PAIR(c2, c3, (i + 2) & 7, (i + 3) & 7, st);
#if PH_NSAC > 1
            SEG2_PAIR(c0, c1, i & 7, (i + 1) & 7, st2); SEG2_PAIR(c2, c3, (i + 2) & 7, (i + 3) & 7, st2);
#endif
            COMMIT((i + 4) & 7, rkA, rvA); COMMIT((i + 5) & 7, rkB, rvB); COMMIT((i + 6) & 7, rkC, rvC); COMMIT((i + 7) & 7, rkD, rvD);
            __syncthreads();
#if defined(PH_NSAX) && (PH_NSAX & 1)
            __syncthreads();
#endif
#if defined(PH_NSAX) && (PH_NSAX & 2)
            { v4u d0_, d1_; SEG2_ISSUE(m0, d0_, d1_); asm volatile("" :: "v"(d0_), "v"(d1_)); SEG2_ISSUE(m1, d0_, d1_); asm volatile("" :: "v"(d0_), "v"(d1_));
              SEG2_ISSUE(m2, d0_, d1_); asm volatile("" :: "v"(d0_), "v"(d1_)); SEG2_ISSUE(m3, d0_, d1_); asm volatile("" :: "v"(d0_), "v"(d1_)); }
#endif
            SEG2_ISSUE(m0, rkA, rvA); SEG2_ISSUE(m1, rkB, rvB); SEG2_ISSUE(m2, rkC, rvC); SEG2_ISSUE(m3, rkD, rvD);
            c0 = n0; c1 = n1b; c2 = n2; c3 = n3; n0 = m0; n1b = m1; n2 = m2; n3 = m3; i += 4;
        }
    }
    NP_T(3);
    attn_accum3(Of, st, gs, lane);
#if PH_NSAC > 1
    attn_accum3(Of, st2, (float)(layer >> 8), lane);
#endif
#undef SEG1_ISSUE
#undef SEG1_VALID
#undef SEG2_ISSUE
#undef SEG2_PAIR
#undef BLK_WORD
#undef COMMIT
#undef NEXT_BLK
    bf16* MIX = (bf16*)(ws + WS_MIX) + row * 1536 + head * 64;
#pragma unroll
    for (int dt = 0; dt < 4; ++dt) { v2u w; w.x = pk2(Of[dt][0], Of[dt][1]); w.y = pk2(Of[dt][2], Of[dt][3]); *(v2u*)(MIX + 16 * dt + 4 * quad) = w; }
    __syncthreads();
}

#define CB() asm volatile("" ::: "memory")
DI void stage_wave_f32(LAS unsigned char* Kt, LAS unsigned char* Vt, const float* kb, const float* vb, size_t stride, int lane, float* ck = nullptr, float* cv = nullptr, int rowskip = 0) {
    const int k0 = lane >> 3, ch = lane & 7;
#pragma unroll
    for (int h = 0; h < 4; ++h) {
        const float* src = (h < 2 ? kb : vb); LAS unsigned char* dst = (h < 2 ? Kt : Vt); const int r0 = (h & 1) * 32; float* cp = (h < 2 ? ck : cv);
        f32x4 a[4][2];
#pragma unroll
        for (int it = 0; it < 4; ++it) { const float* kp = src + (size_t)(r0 + it * 8 + k0) * stride + ch * 8; a[it][0] = *(const f32x4*)kp; a[it][1] = *(const f32x4*)(kp + 4); }
#pragma unroll
        for (int it = 0; it < 4; ++it) *(LAS v4u*)(dst + (r0 + it * 8 + k0) * 144 + ch * 16) = pack8(a[it][0], a[it][1]);
        if (cp) {
#pragma unroll
            for (int it = 0; it < 4; ++it) { const int rr = r0 + it * 8 + k0; if (rr >= rowskip) { float* op = cp + (size_t)rr * stride + ch * 8; *(f32x4*)op = a[it][0]; *(f32x4*)(op + 4) = a[it][1]; } }
        }
        asm volatile("" ::: "memory");
    }
}
DI void stage_wave_b16(LAS unsigned char* Kt, LAS unsigned char* Vt, const bf16* kb, const bf16* vb, size_t stride, int nvalid, int lane, bool do_v) {
    const int k0 = lane >> 3, ch = lane & 7;
    const v4u z = (v4u){0u, 0u, 0u, 0u};
#pragma unroll
    for (int it = 0; it < 8; ++it) {
        const int key = it * 8 + k0; const bool v = key < nvalid;
        *(LAS v4u*)(Kt + key * 144 + ch * 16) = v ? *(const v4u*)(kb + key * stride + ch * 8) : z;
        if (do_v) *(LAS v4u*)(Vt + key * 144 + ch * 16) = v ? *(const v4u*)(vb + key * stride + ch * 8) : z;
    }
}
DI void nsa_sample_unit(Frame& F, int layer, int s) {
    int lane = F.lane, wave = F.wave; asm volatile("" : "+v"(lane), "+s"(wave));
    const int quad = lane >> 4, rl = lane & 15;
    const int g = wave & 1, q4 = wave >> 1;
    unsigned char* ws = KWS();
    const bf16* Z = (const bf16*)(ws + WS_Z);
    const float* ZS = (const float*)(ws + WS_ZS);
    LAS unsigned char* Kt = F.lds + wave * 18432; LAS unsigned char* Vt = Kt + 9216;
    LAS float* AIMP = (LAS float*)Vt;
    const int j = rl >> 2, head = 4 * g + (rl & 3), qpos = 2048 + j;
    const size_t row = (size_t)MP + 4 * s + j;
    bf16x8 qf[2];
    qf[0] = ld_frag_g(Z + row * LDZ + ZC_Q + head * 64 + quad * 8); qf[1] = ld_frag_g(Z + row * LDZ + ZC_Q + head * 64 + 32 + quad * 8);
    const float gc = sigmoidf_(ZS[row * 32 + head * 3]), gs = sigmoidf_(ZS[row * 32 + head * 3 + 1]), gw = sigmoidf_(ZS[row * 32 + head * 3 + 2]);
    f32x4 Of[4];
#pragma unroll
    for (int i = 0; i < 4; ++i) Of[i] = (f32x4){0.f, 0.f, 0.f, 0.f};
    AttnState st;
    const bf16* KC = (const bf16*)(ws + WS_KCS) + ((size_t)(0 * 128 + s) * 128 * 2 + g) * 64;
    const bf16* VC = (const bf16*)(ws + WS_KCS) + ((size_t)(1 * 128 + s) * 128 * 2 + g) * 64;
    attn_reset(st);
#pragma unroll 1
    for (int jt = 0; jt < 2; ++jt) {
        stage_wave_b16(Kt, Vt, KC + (size_t)64 * jt * 128, VC + (size_t)64 * jt * 128, 128, 64, lane, true); CB();
        attn_step3(Kt, Vt, qf, st, 0, 126 - 64 * jt, true, rl, quad); CB();
    }
    attn_accum3(Of, st, q4 == 0 ? gc : 0.f, lane);
    {
        const float mfin = st.m * SM_C, lt = attn_rowsum(st, lane), il = lt > 0.f ? 1.f / lt : 0.f;
#pragma unroll 1
        for (int jt = 0; jt < 2; ++jt) {
            stage_wave_b16(Kt, Vt, KC + (size_t)64 * jt * 128, VC, 128, 64, lane, false); CB();
            f32x4 sv[4]; qk_tile(Kt, qf, sv, rl, quad); CB();
#pragma unroll
            for (int kt = 0; kt < 4; ++kt)
#pragma unroll
                for (int i = 0; i < 4; ++i) {
                    const int n = 64 * jt + 16 * kt + 4 * quad + i;
                    float p = (n <= 126) ? __builtin_amdgcn_exp2f(sv[kt][i] * SM_C - mfin) * il : 0.f;
                    p += shx<1>(p, lane); p += shx<2>(p, lane);
                    if ((rl & 3) == 0) AIMP[j * 128 + n] = p;
                }
        }
    }
    CB();
    unsigned long long msk[4];
    {
        unsigned keys[4];
#pragma unroll
        for (int q = 0; q < 4; ++q) {
            float imp = 0.f;
#pragma unroll
            for (int d = -1; d <= 3; ++d) { const int n = 4 * lane + d; if (n >= 0 && n <= 126 && lane < 33) imp += AIMP[q * 128 + n]; }
            const bool forced = (lane == 0) || (lane == 32) || (lane == 31);
            keys[q] = score_key(imp + (forced ? 1000.f : 0.f), lane < 33, lane);
        }
        CB();
        LAS unsigned* KS = (LAS unsigned*)Kt;
#pragma unroll
        for (int q = 0; q < 4; ++q) KS[q * 64 + lane] = keys[q];
        CB();
#pragma unroll
        for (int q = 0; q < 4; ++q) msk[q] = __ballot(lane < 33 && key_rank(KS + q * 64, 9, keys[q]) < 16);
    }
    CB();
    const unsigned long long un = msk[0] | msk[1] | msk[2] | msk[3];
    const unsigned long long mym = j == 0 ? msk[0] : j == 1 ? msk[1] : j == 2 ? msk[2] : msk[3];
    const int* pt = (const int*)KIN(7);
    AttnState sw;
    attn_reset(st); attn_reset(sw);
    {
        unsigned long long word = un; int idx = 0;
        while (word) {
            const int blk = __builtin_ctzll(word); word &= word - 1ull;
            if ((idx++ & 3) != q4) continue;
            if (blk < 32) {
                const int phys = pt[s * 16 + (blk >> 1)];
                const float* base = KIN(2) + ((size_t)(layer * 2560 + phys) * 128 + (blk & 1) * 64) * 512 + g * 64;
                stage_wave_f32(Kt, Vt, base + 256, base + 384, 512, lane); CB();
            } else {
                stage_wave_b16(Kt, Vt, Z + (size_t)(MP + 4 * s) * LDZ + ZC_KS + g * 64, Z + (size_t)(MP + 4 * s) * LDZ + ZC_VS + g * 64, LDZ, 4, lane, true); CB();
            }
            attn_step3(Kt, Vt, qf, st, 0, qpos - 64 * blk, (mym >> blk) & 1ull, rl, quad); CB();
        }
#pragma unroll 1
        for (int jt = 0; jt < 9; ++jt) {
            if ((idx++ & 3) != q4) continue;
            if (jt < 8) { const float* base = KIN(3) + ((size_t)(layer * 128 + s) * 512 + 64 * jt) * 256 + g * 64;
                float* ob = KOUT() + O_WINS + ((size_t)(layer * 128 + s) * 512 + 64 * jt) * 256 + g * 64 - (size_t)4 * 256;
                stage_wave_f32(Kt, Vt, base, base + 128, 256, lane, ob, ob + 128, jt == 0 ? 4 : 0); CB(); }
            else { stage_wave_b16(Kt, Vt, Z + (size_t)(MP + 4 * s) * LDZ + ZC_KW + g * 64, Z + (size_t)(MP + 4 * s) * LDZ + ZC_VW + g * 64, LDZ, 4, lane, true); CB(); }
            attn_step3(Kt, Vt, qf, sw, j + 1 - 64 * jt, 512 + j - 64 * jt, true, rl, quad); CB();
        }
    }
    int lane2 = lane; asm volatile("" : "+v"(lane2));
    LAS float* X = (LAS float*)(F.lds + wave * 18432);
    {
        const float ls = attn_rowsum(st, lane), lw = attn_rowsum(sw, lane);
        X[0 * 64 + lane2] = st.m; X[1 * 64 + lane2] = ls; X[18 * 64 + lane2] = sw.m; X[19 * 64 + lane2] = lw;
#pragma unroll
        for (int dt = 0; dt < 4; ++dt)
#pragma unroll
            for (int e = 0; e < 4; ++e) { X[(2 + 4 * dt + e) * 64 + lane2] = st.O[dt][e]; X[(20 + 4 * dt + e) * 64 + lane2] = sw.O[dt][e]; }
    }
    __syncthreads();
    if (q4 == 0) {
#pragma unroll
        for (int br = 0; br < 2; ++br) {
            float m[4], l[4];
#pragma unroll
            for (int q = 0; q < 4; ++q) { const LAS float* Y = (const LAS float*)(F.lds + (2 * q + g) * 18432) + br * 18 * 64; m[q] = Y[lane2]; l[q] = Y[64 + lane2]; }
            const float mm = fmaxf(fmaxf(m[0], m[1]), fmaxf(m[2], m[3]));
            float w[4], lt = 0.f;
#pragma unroll
            for (int q = 0; q < 4; ++q) { w[q] = __builtin_amdgcn_exp2f((m[q] - mm) * SM_C); lt += l[q] * w[q]; }
            const float gate = br == 0 ? gs : gw;
            const float sc = lt > 0.f ? gate / lt : 0.f;
#pragma unroll
            for (int q = 0; q < 4; ++q) { const LAS float* Y = (const LAS float*)(F.lds + (2 * q + g) * 18432) + br * 18 * 64; const float wq = w[q] * sc;
#pragma unroll
                for (int dt = 0; dt < 4; ++dt)
#pragma unroll
                    for (int e = 0; e < 4; ++e) Of[dt][e] += Y[(2 + 4 * dt + e) * 64 + lane2] * wq; }
        }
        bf16* MIX = (bf16*)(ws + WS_MIX) + row * 1536 + head * 64;
#pragma unroll
        for (int dt = 0; dt < 4; ++dt) { v2u w2; w2.x = pk2(Of[dt][0], Of[dt][1]); w2.y = pk2(Of[dt][2], Of[dt][3]); *(v2u*)(MIX + 16 * dt + 4 * quad) = w2; }
    }
    __syncthreads();
}
DI void ret_out_unit(Frame& F, int layer, int unit) {
    const int tid = F.tid, lane = F.lane, wave = F.wave, quad = lane >> 4, rl = lane & 15;
    const int b = unit >> 8, h = (unit >> 6) & 3, c = unit & 63;
    const int row0 = b * TP + 128 * c;
    unsigned char* ws = KWS();
    const bf16* Z = (const bf16*)(ws + WS_Z);
    const bf16* QR = (const bf16*)(ws + WS_QR); const bf16* KR = (const bf16*)(ws + WS_KR);
    const bf16* RST = (const bf16*)(ws + WS_RST) + (size_t)unit * 16384;
    LAS unsigned char* LQ = F.lds; LAS unsigned char* LK = F.lds + 34816; LAS unsigned char* LV = F.lds + 69632; LAS unsigned char* LS = F.lds + 104448;
    for (int it = tid; it < 2048; it += NTHREADS) {
        const int j = it >> 4, cc = it & 15;
        *(LAS v4u*)(LQ + j * 272 + cc * 16) = *(const v4u*)(QR + (size_t)(row0 + j) * 512 + h * 128 + cc * 8);
        *(LAS v4u*)(LK + j * 272 + cc * 16) = *(const v4u*)(KR + (size_t)(row0 + j) * 512 + h * 128 + cc * 8);
        *(LAS v4u*)(LS + j * 272 + cc * 16) = *(const v4u*)(RST + (size_t)j * 128 + cc * 8);
        const v4u w = *(const v4u*)(Z + (size_t)(row0 + j) * LDZ + ZC_RQKV + 1024 + h * 128 + cc * 8);
        LAS unsigned char* d = LV + (cc * 8) * 272 + j * 2;
        *(LAS bf16*)(d) = (bf16)(w.x & 0xffff); *(LAS bf16*)(d + 272) = (bf16)(w.x >> 16); *(LAS bf16*)(d + 2 * 272) = (bf16)(w.y & 0xffff); *(LAS bf16*)(d + 3 * 272) = (bf16)(w.y >> 16);
        *(LAS bf16*)(d + 4 * 272) = (bf16)(w.z & 0xffff); *(LAS bf16*)(d + 5 * 272) = (bf16)(w.z >> 16); *(LAS bf16*)(d + 6 * 272) = (bf16)(w.w & 0xffff); *(LAS bf16*)(d + 7 * 272) = (bf16)(w.w >> 16);
    }
    __syncthreads();
    const float lg = ret_lg(h);
    const int il = 16 * wave + rl;
    bf16x8 qb[4];
#pragma unroll
    for (int s = 0; s < 4; ++s) qb[s] = ld_frag_l(LQ + il * 272 + (32 * s + 8 * quad) * 2);
    f32x4 C[8];
    const float qdec = __expf((float)(il + 1) * lg);
#pragma unroll
    for (int dt = 0; dt < 8; ++dt) {
        f32x4 a = (f32x4){0.f, 0.f, 0.f, 0.f};
#pragma unroll
        for (int s = 0; s < 4; ++s) a = mfma16(ld_frag_l(LS + (16 * dt + rl) * 272 + (32 * s + 8 * quad) * 2), qb[s], a);
        C[dt] = a * qdec;
    }
    for (int s2 = 0; s2 <= (wave >> 1); ++s2) {
        f32x4 P[2];
#pragma unroll
        for (int e = 0; e < 2; ++e) {
            const int jt = 2 * s2 + e;
            f32x4 a = (f32x4){0.f, 0.f, 0.f, 0.f};
            if (jt <= wave) {
#pragma unroll
                for (int s = 0; s < 4; ++s) a = mfma16(ld_frag_l(LK + (16 * jt + rl) * 272 + (32 * s + 8 * quad) * 2), qb[s], a);
#pragma unroll
                for (int i = 0; i < 4; ++i) { const int jj = 16 * jt + 4 * quad + i; a[i] = (il >= jj) ? a[i] * __expf((float)(il - jj) * lg) : 0.f; }
            }
            P[e] = a;
        }
        const bf16x8 pb = pack_frag(P[0], P[1]);
#pragma unroll
        for (int dt = 0; dt < 8; ++dt) {
            const LAS unsigned char* vp = LV + (16 * dt + rl) * 272 + (32 * s2 + 4 * quad) * 2;
            C[dt] = mfma16(mk_frag(*(const LAS v2u*)vp, *(const LAS v2u*)(vp + 32)), pb, C[dt]);
        }
    }
    float ss = 0.f;
#pragma unroll
    for (int dt = 0; dt < 8; ++dt) ss += (C[dt][0] * C[dt][0] + C[dt][1] * C[dt][1]) + (C[dt][2] * C[dt][2] + C[dt][3] * C[dt][3]);
    ss += shx<16>(ss, lane); ss += shx<32>(ss, lane);
    const float scl = rsqrtf(ss * (1.f / 128.f) + EPS);
    const size_t row = (size_t)row0 + il;
#pragma unroll
    for (int dt = 0; dt < 8; ++dt) {
        const v2u gwd = *(const v2u*)(Z + row * LDZ + ZC_RG + h * 128 + 16 * dt + 4 * quad);
        v2u w; w.x = pk2(C[dt][0] * scl * siluf_(lo_bf(gwd.x)), C[dt][1] * scl * siluf_(hi_bf(gwd.x))); w.y = pk2(C[dt][2] * scl * siluf_(lo_bf(gwd.y)), C[dt][3] * scl * siluf_(hi_bf(gwd.y)));
        *(v2u*)((bf16*)(ws + WS_MIX) + row * 1536 + 1024 + h * 128 + 16 * dt + 4 * quad) = w;
    }
    __syncthreads();
}
DI void gdn_out_row(Frame& F, int layer, int row) {
    const int lane = F.lane;
    unsigned char* ws = KWS();
    const float* o = (const float*)(ws + WS_OGDN) + (size_t)row * 512 + lane * 8;
    const f32x4 a = *(const f32x4*)o, b = *(const f32x4*)(o + 4);
    float ss = (a[0] * a[0] + a[1] * a[1]) + (a[2] * a[2] + a[3] * a[3]) + (b[0] * b[0] + b[1] * b[1]) + (b[2] * b[2] + b[3] * b[3]);
    ss += shx<1>(ss, lane); ss += shx<2>(ss, lane); ss += shx<4>(ss, lane); ss += shx<8>(ss, lane);
    const float scl = rsqrtf(ss * (1.f / 128.f) + EPS);
    const float* ng = KIN(18) + layer * 128 + (lane & 15) * 8;
    const f32x4 ga = *(const f32x4*)ng, gb = *(const f32x4*)(ng + 4);
    f32x4 za, zb; unpack8(*(const v4u*)((const bf16*)(ws + WS_Z) + (size_t)row * LDZ + ZC_GZ + lane * 8), za, zb);
    f32x4 ra, rb;
#pragma unroll
    for (int e = 0; e < 4; ++e) { ra[e] = a[e] * scl * ga[e] * siluf_(za[e]); rb[e] = b[e] * scl * gb[e] * siluf_(zb[e]); }
    *(v4u*)((bf16*)(ws + WS_MIX) + (size_t)row * 1536 + 512 + lane * 8) = pack8(ra, rb);
}
DI void final_row(Frame& F, int row) {
    const int lane = F.lane;
    const float* x = (const float*)(KWS() + WS_XR) + (size_t)row * DM;
    float* y = (row < MP) ? KOUT() + O_YP + (size_t)row * DM : KOUT() + O_YS + (size_t)(row - MP) * DM;
    f32x4 v[4]; float ss = 0.f;
#pragma unroll
    for (int j = 0; j < 4; ++j) { v[j] = *(const f32x4*)(x + 256 * j + lane * 4); ss += (v[j][0] * v[j][0] + v[j][1] * v[j][1]) + (v[j][2] * v[j][2] + v[j][3] * v[j][3]); }
    const float scl = rsqrtf(wave_sum(ss, lane) * (1.f / DM) + EPS);
#pragma unroll
    for (int j = 0; j < 4; ++j) *(f32x4*)(y + 256 * j + lane * 4) = v[j] * scl * *(const f32x4*)(KIN(26) + 256 * j + lane * 4);
}
template <class Epi>
DI void sgemm_tile(Frame& F, const bf16* A, int lda, const bf16* Bt, int ldb, int K, int row0, int col0, const Epi& E) {
    int lane = F.lane, wave = F.wave; asm volatile("" : "+v"(lane), "+s"(wave));
    const int tid = wave * 64 + lane, quad = lane >> 4, rl = lane & 15;
    const int kper = K >> 3, nks = kper >> 5;
    f32x4 acc[2][4];
#pragma unroll
    for (int rt = 0; rt < 2; ++rt)
#pragma unroll
        for (int ct = 0; ct < 4; ++ct) acc[rt][ct] = (f32x4){0.f, 0.f, 0.f, 0.f};
    const bf16* ap = A + (size_t)(row0 + rl) * lda + wave * kper + quad * 8;
    const bf16* bp = Bt + (size_t)(col0 + rl) * ldb + wave * kper + quad * 8;
#pragma unroll 4
    for (int ks = 0; ks < nks; ++ks) {
        bf16x8 a[2], b[4];
#pragma unroll
        for (int rt = 0; rt < 2; ++rt) a[rt] = ld_frag_g(ap + (size_t)(16 * rt) * lda + ks * 32);
#pragma unroll
        for (int ct = 0; ct < 4; ++ct) b[ct] = ld_frag_g(bp + (size_t)(16 * ct) * ldb + ks * 32);
#pragma unroll
        for (int rt = 0; rt < 2; ++rt)
#pragma unroll
            for (int ct = 0; ct < 4; ++ct) acc[rt][ct] = mfma16(a[rt], b[ct], acc[rt][ct]);
    }
    LAS float* RED = (LAS float*)F.lds;
#pragma unroll
    for (int rt = 0; rt < 2; ++rt)
#pragma unroll
        for (int ct = 0; ct < 4; ++ct)
#pragma unroll
            for (int i = 0; i < 4; ++i) RED[wave * 2176 + (16 * rt + 4 * quad + i) * 68 + 16 * ct + rl] = acc[rt][ct][i];
    __syncthreads();
    const int r = tid >> 4, c4 = (tid & 15) * 4;
    f32x4 v = *(const LAS f32x4*)(RED + r * 68 + c4);
#pragma unroll
    for (int w = 1; w < 8; ++w) v += *(const LAS f32x4*)(RED + w * 2176 + r * 68 + c4);
    E(row0 + r, col0 + c4, v, lane);
    __syncthreads();
}
struct SEpiC {
    const bf16* Z; bf16* G;
    DI void operator()(int row, int col, f32x4 v, int lane) const {
        const v2u gw = *(const v2u*)(Z + (size_t)row * LDZ + ZC_MG + col);
        v[0] *= sigmoidf_(lo_bf(gw.x)); v[1] *= sigmoidf_(hi_bf(gw.x)); v[2] *= sigmoidf_(lo_bf(gw.y)); v[3] *= sigmoidf_(hi_bf(gw.y));
        *(v2u*)(G + (size_t)row * 3072 + col) = pack4(v);
    }
};
struct SEpiRes {
    float* XR; bf16* XG; const float* gvec; float* SS; float* T; int mode; const float* XRr;
    DI void operator()(int row, int col, f32x4 v, int lane) const {
        const size_t o = (size_t)row * DM + col;
        if (mode == 1) { *(f32x4*)(T + o) = v; return; }
        f32x4 x = *(const f32x4*)(XRr + o);
        if (mode == 2) { const f32x4 t = *(const f32x4*)(T + o);
#pragma unroll
            for (int e = 0; e < 4; ++e) v[e] = t[e] * sigmoidf_(v[e]); }
        x += v;
        *(f32x4*)(XR + o) = x;
        if (XG) { f32x4 y = x; if (gvec) y *= *(const f32x4*)(gvec + col); *(v2u*)(XG + o) = pack4(y); }
        if (SS) { float ssq = (x[0] * x[0] + x[1] * x[1]) + (x[2] * x[2] + x[3] * x[3]);
            ssq += shx<1>(ssq, lane); ssq += shx<2>(ssq, lane); ssq += shx<4>(ssq, lane); ssq += shx<8>(ssq, lane);
            if ((lane & 15) == 0) SS[(size_t)row * 16 + (col >> 6)] = ssq; }
    }
};
struct SEpiUp {
    bf16* H; const float* SS;
    DI void operator()(int row, int col, f32x4 v, int lane) const {
        const f32x4 p0 = *(const f32x4*)(SS + (size_t)row * 16), p1 = *(const f32x4*)(SS + (size_t)row * 16 + 4), p2 = *(const f32x4*)(SS + (size_t)row * 16 + 8), p3 = *(const f32x4*)(SS + (size_t)row * 16 + 12);
        const f32x4 ps = (p0 + p1) + (p2 + p3);
        const float rstd = rsqrtf(((ps[0] + ps[1]) + (ps[2] + ps[3])) * (1.f / DM) + EPS);
#pragma unroll
        for (int e = 0; e < 4; ++e) { const float a = fmaxf(v[e] * rstd, 0.f); v[e] = a * a; }
        *(v2u*)(H + (size_t)row * DFF + col) = pack4(v);
    }
};
#ifndef PH_P0
#define PH_P0 1
#endif
#ifndef PH_A
#define PH_A 1
#endif
#ifndef PH_B0a
#define PH_B0a 1
#endif
#ifndef PH_B0b
#define PH_B0b 1
#endif
#ifndef PH_B0c
#define PH_B0c 1
#endif
#ifndef PH_B0d
#define PH_B0d 1
#endif
#ifndef PH_SCAN
#define PH_SCAN 1
#endif
#ifndef PH_RSCAN
#define PH_RSCAN 1
#endif
#ifndef PH_NSAP
#define PH_NSAP 1
#endif
#ifndef PH_NSAS
#define PH_NSAS 1
#endif
#ifndef PH_B2
#define PH_B2 1
#endif
#ifndef PH_C
#define PH_C 1
#endif
#ifndef PH_XBAR
#define PH_XBAR 0
#endif
#ifndef PH_D
#define PH_D 1
#endif
#ifndef PH_E
#define PH_E 1
#endif
#ifndef PH_F
#define PH_F 1
#endif
#ifndef PH_G1
#define PH_G1 1
#endif
#ifndef PH_G2
#define PH_G2 1
#endif
#ifndef PH_TREG
#define PH_TREG (-1)
#endif
#if PH_TREG >= 0
#define TREG_MARK(r) do { const unsigned long long now_ = __builtin_amdgcn_s_memrealtime(); if ((r) == PH_TREG) tacc_ += now_ - tlast_; tlast_ = now_; } while (0)
#define TREG_SUB(r) do { const unsigned long long now_ = __builtin_amdgcn_s_memrealtime(); if ((r) == PH_TREG) tacc_ += now_ - tsub_; tsub_ = now_; } while (0)
#else
#define TREG_MARK(r) do { } while (0)
#define TREG_SUB(r) do { } while (0)
#endif
struct Args { const void* in[27]; float* out; unsigned char* ws; };
__global__ void __launch_bounds__(NTHREADS, 2) mk_fwd(Args args) {
    extern __shared__ __attribute__((aligned(16))) unsigned char lds_raw[];
    Frame F;
    F.lds = (LAS unsigned char*)lds_raw;
    F.wave = __builtin_amdgcn_readfirstlane((int)threadIdx.x >> 6); F.lane = 0; F.tid = 0;
    F.G = gridDim.x; F.bid = blockIdx.x;
    F.ctl = (gu32*)(KWS() + WS_CTL);
    { const Frame Fp = fresh(F); for (int u = Fp.tid; u < (LDS_BYTES - LDSCTL_OFF) / 4; u += NTHREADS) ((LAS unsigned*)(F.lds + LDSCTL_OFF))[u] = 0u;
      __syncthreads();
      (void)xcd_barrier_post((unsigned*)(F.ctl + CW_BAR), (volatile LAS unsigned*)(F.lds + MISC_OFF) + 8, Fp.tid == 0); }
    const int G = F.G, bid = F.bid;
#if PH_TREG >= 0
    unsigned long long tacc_ = 0ull, tlast_ = __builtin_amdgcn_s_memrealtime(), tsub_ = tlast_;
#endif

        for (int rp_ = 0; rp_ < PH_P0; ++rp_) {
    { Frame Fp = fresh(F); p0_prologue(Fp); }
        }
    GRID_BAR();
    TREG_MARK(0);

    for (int layer = 0; layer < NLAYER; ++layer) {
        for (int rp_ = 0; rp_ < PH_A; ++rp_) {
        {
            const Frame Fg = fresh(F); const int G = Fg.G, bid = Fg.bid;
            unsigned char* ws = KWS();
            pg8::Gemm g{(const bf16*)(ws + WS_XGA), (const bf16*)(ws + WS_WIN + layer * SZ_WIN), MROWS, LDZ, DM, DM, DM, 31, 0};
            pg8::StaticOrder S; S.init(MROWS, LDZ, G, bid);
            epi::EpiA E{(bf16*)(ws + WS_Z), (float*)(ws + WS_ZS), (const float*)(ws + WS_SSA), KOUT(), layer};
            pg8::gemm_phase<epi::EpiA, pg8::StaticOrder, true, true>(Fg.lds, g, S, E, Fg.tid);
        }
        }
        GRID_BAR();
    TREG_MARK(1);
#if PH_TREG >= 0
        tsub_ = __builtin_amdgcn_s_memrealtime();
#endif
        {
            Frame Fp = fresh(F);
            gu32* qhead = F.ctl + CW_QUEUE + 512 * layer + 384;
            volatile LAS int* qslot = (volatile LAS int*)(F.lds + MISC_OFF) + 16;
            constexpr int NI = 5 * 272 * PH_B0d, N2 = 1024 * PH_B0c, N3 = 512 * PH_B0b;
            for (;;) {
                if (Fp.tid == 0) qslot[0] = (int)__hip_atomic_fetch_add(qhead, 1u, __ATOMIC_RELAXED, __HIP_MEMORY_SCOPE_AGENT);
                __syncthreads();
                int it = qslot[0];
                __syncthreads();
                it = __builtin_amdgcn_readfirstlane(it);
                if (it >= NI + N2 + N3) break;
                TREG_SUB(99);
                if (it < NI) { const int k = it / 5, r = it % 5;
                    if (r == 0) compress_job(Fp, layer, k % 272);
                    else if (k < 256 * PH_B0a) gdn_prep_unit(Fp, layer, (4 * k + r - 1) & 1023); }
                else { const int q = it - NI, g3 = q / 3, r3 = q % 3;
                    if (r3 < 2) sample_rec_unit(Fp, layer, (2 * g3 + r3) & 1023); else ret_prep_unit(Fp, layer, g3 & 511); }
                TREG_SUB(it < NI ? ((it % 5) == 0 ? 40 : 41) : (it < NI + N2 ? 42 : 43));
            }
        }
        GRID_BAR();
    TREG_MARK(2);
        {
            Frame Fp = fresh(F);
            gu32* qbase = F.ctl + CW_QUEUE + 512 * layer;
            volatile LAS int* qslot = (volatile LAS int*)(F.lds + MISC_OFF) + 16;
            constexpr int NQ = 8 * PH_SCAN, NS = 128 * PH_NSAS, NR = 32 * PH_RSCAN, NP = 256 * PH_NSAP;
            const int pref = (int)(xb_xcc_id() & 3u);
            for (;;) {
                if (Fp.tid == 0) qslot[1] = (int)__hip_atomic_fetch_add(qbase, 1u, __ATOMIC_RELAXED, __HIP_MEMORY_SCOPE_AGENT);
                __syncthreads();
                int it = qslot[1];
                __syncthreads();
                it = __builtin_amdgcn_readfirstlane(it);
                if (it >= NQ + NR) break;
                TREG_SUB(99);
                if (it < NQ) gdn_scan_chain(Fp, layer, it & 7);
                else ret_scan_part(Fp, layer, (it - NQ) & 31);
                TREG_SUB(it < NQ ? 21 : 23);
            }
            const int when = Fp.bid & 3;
            bool tried = false;
            for (int nu = 0;; ++nu) {
                if (Fp.tid == 0) {
                    int kind = -1, idx = 0;
                    if (!tried && nu >= when) {
                        tried = true;
                        const int a = (int)__hip_atomic_fetch_add(qbase + 320, 1u, __ATOMIC_RELAXED, __HIP_MEMORY_SCOPE_AGENT);
                        if (a < NS) { kind = 4; idx = a; }
                    }
                    if (kind < 0) {
                        for (int k = 0; k < 4 && kind < 0; ++k) { const int s = (pref + k) & 3;
                            if ((int)__hip_atomic_load(qbase + 64 * (1 + s), __ATOMIC_RELAXED, __HIP_MEMORY_SCOPE_AGENT) < NP) {
                                const int r = (int)__hip_atomic_fetch_add(qbase + 64 * (1 + s), 1u, __ATOMIC_RELAXED, __HIP_MEMORY_SCOPE_AGENT);
                                if (r < NP) { kind = s; idx = r; } } }
                    }
                    if (kind < 0) {
                        const int a = (int)__hip_atomic_fetch_add(qbase + 320, 1u, __ATOMIC_RELAXED, __HIP_MEMORY_SCOPE_AGENT);
                        if (a < NS) { kind = 4; idx = a; }
                    }
                    qslot[0] = kind; qslot[1] = idx;
                }
                __syncthreads();
                int kind = qslot[0], it = qslot[1];
                __syncthreads();
                kind = __builtin_amdgcn_readfirstlane(kind); it = __builtin_amdgcn_readfirstlane(it);
                if (kind < 0) break;
                TREG_SUB(99);
                if (kind < 4) nsa_prompt_unit(Fp, layer, (kind << 8) | (255 - (it & 255)));
                else nsa_sample_unit(Fp, layer, it & 127);
                TREG_SUB(kind < 4 ? 20 : 22);
            }
        }
        GRID_BAR();
    TREG_MARK(3);
        for (int rp_ = 0; rp_ < PH_B2; ++rp_) {
        { Frame Fp = fresh(F); for (int u = Fp.bid; u < 512; u += Fp.G) ret_out_unit(Fp, layer, u); }
        { Frame Fp = fresh(F); for (int r = Fp.bid * NWAVES + Fp.wave; r < MROWS; r += Fp.G * NWAVES) gdn_out_row(Fp, layer, r); }
        }
        GRID_BAR();
    TREG_MARK(4);
        for (int rp_ = 0; rp_ < PH_C; ++rp_) {
        {
            const Frame Fg = fresh(F); const int G = Fg.G, bid = Fg.bid;
            unsigned char* ws = KWS();
            pg8::Gemm g{(const bf16*)(ws + WS_MIX), (const bf16*)(ws + WS_WBR + layer * SZ_WBR), MP, 3072, 512, 1536, 512, 2, 1024};
            pg8::StaticOrder S; S.init(MP, 3072, G, bid);
            epi::EpiC E{(const bf16*)(ws + WS_Z), (bf16*)(ws + WS_GATED)};
            pg8::gemm_phase<epi::EpiC, pg8::StaticOrder, true, true>(Fg.lds, g, S, E, Fg.tid);
            TREG_SUB(99);
            {
                Frame Fs = fresh(F); const SEpiC Es{(const bf16*)(ws + WS_Z), (bf16*)(ws + WS_GATED)};
                for (int tl = Fs.bid; tl < 16 * 48; tl += Fs.G) { const int rt = tl & 15, ct = tl >> 4, b = ct >> 4;
                    sgemm_tile(Fs, (const bf16*)(ws + WS_MIX) + b * 512, 1536, (const bf16*)(ws + WS_WBR + layer * SZ_WBR), 512, 512, MP + 32 * rt, 64 * ct, Es); }
            }
            TREG_SUB(31);
        }
        }
        GRID_BAR();
    TREG_MARK(5);
        for (int rp_ = 0; rp_ < PH_D; ++rp_) {
        {
            const Frame Fg = fresh(F); const int G = Fg.G, bid = Fg.bid;
            unsigned char* ws = KWS();
            pg8::Gemm g{(const bf16*)(ws + WS_GATED), (const bf16*)(ws + WS_WO3 + layer * SZ_WO3), MP, DM, 3072, 3072, 3072, 31, 0};
            pg8::StaticOrder S; S.init(MP, DM, G, bid);
            epi::EpiRes E{(float*)(ws + WS_XR), (bf16*)(ws + WS_XGB), KIN(21) + layer * DM, (float*)(ws + WS_SSB), nullptr, (rp_ + 1 < PH_D) ? 3 : 0, layer == 0 ? KIN(0) : (const float*)(ws + WS_XR)};
            pg8::gemm_phase<epi::EpiRes, pg8::StaticOrder, true, true>(Fg.lds, g, S, E, Fg.tid);
            TREG_SUB(99);
            if (rp_ + 1 == PH_D) {
                Frame Fs = fresh(F); const SEpiRes Es{(float*)(ws + WS_XR), (bf16*)(ws + WS_XGB), KIN(21) + layer * DM, (float*)(ws + WS_SSB), nullptr, 0, layer == 0 ? KIN(1) - (size_t)MP * DM : (const float*)(ws + WS_XR)};
                for (int tl = Fs.bid; tl < 256; tl += Fs.G) sgemm_tile(Fs, (const bf16*)(ws + WS_GATED), 3072, (const bf16*)(ws + WS_WO3 + layer * SZ_WO3), 3072, 3072, MP + 32 * (tl & 15), 64 * (tl >> 4), Es);
            }
            TREG_SUB(32);
        }
        }
        GRID_BAR();
    TREG_MARK(6);
        for (int rp_ = 0; rp_ < PH_E; ++rp_) {
        {
            const Frame Fg = fresh(F); const int G = Fg.G, bid = Fg.bid;
            unsigned char* ws = KWS();
            pg8::Gemm g{(const bf16*)(ws + WS_XGB), (const bf16*)(ws + WS_WUP + layer * SZ_WUP), MP, DFF, DM, DM, DM, 31, 0};
            pg8::StaticOrder S; S.init(MP, DFF, G, bid);
            epi::EpiUp E{(bf16*)(ws + WS_HMID), (const float*)(ws + WS_SSB)};
            pg8::gemm_phase<epi::EpiUp, pg8::StaticOrder, true, true>(Fg.lds, g, S, E, Fg.tid);
            TREG_SUB(99);
            {
                Frame Fs = fresh(F); const SEpiUp Es{(bf16*)(ws + WS_HMID), (const float*)(ws + WS_SSB)};
                for (int tl = Fs.bid; tl < 16 * 64; tl += Fs.G) sgemm_tile(Fs, (const bf16*)(ws + WS_XGB), DM, (const bf16*)(ws + WS_WUP + layer * SZ_WUP), DM, DM, MP + 32 * (tl & 15), 64 * (tl >> 4), Es);
            }
            TREG_SUB(33);
        }
        }
        GRID_BAR();
    TREG_MARK(7);
        for (int rp_ = 0; rp_ < PH_F; ++rp_) {
        {
            const Frame Fg = fresh(F); const int G = Fg.G, bid = Fg.bid;
            unsigned char* ws = KWS();
            pg8::Gemm g{(const bf16*)(ws + WS_HMID), (const bf16*)(ws + WS_WDN + layer * SZ_WDN), MP, DM, DFF, DFF, DFF, 31, 0};
            pg8::StaticOrder S; S.init(MP, DM, G, bid);
            epi::EpiRes E{(float*)(ws + WS_XR), (bf16*)(ws + WS_XGC), nullptr, nullptr, nullptr, (rp_ + 1 < PH_F) ? 3 : 0, (const float*)(ws + WS_XR)};
            pg8::gemm_phase<epi::EpiRes, pg8::StaticOrder, true, true>(Fg.lds, g, S, E, Fg.tid);
            TREG_SUB(99);
            if (rp_ + 1 == PH_F) {
                Frame Fs = fresh(F); const SEpiRes Es{(float*)(ws + WS_XR), (bf16*)(ws + WS_XGC), nullptr, nullptr, nullptr, 0, (const float*)(ws + WS_XR)};
                for (int tl = Fs.bid; tl < 256; tl += Fs.G) sgemm_tile(Fs, (const bf16*)(ws + WS_HMID), DFF, (const bf16*)(ws + WS_WDN + layer * SZ_WDN), DFF, DFF, MP + 32 * (tl & 15), 64 * (tl >> 4), Es);
            }
            TREG_SUB(34);
        }
        }
        GRID_BAR();
    TREG_MARK(8);
        for (int rp_ = 0; rp_ < PH_G1; ++rp_) {
        {
            const Frame Fg = fresh(F); const int G = Fg.G, bid = Fg.bid;
            unsigned char* ws = KWS();
            int kple = PLE; asm volatile("" : "+s"(kple));
            pg8::Gemm g{(const bf16*)(ws + WS_P16) + (size_t)layer * MROWS * PLE, (const bf16*)(ws + WS_WPL + layer * SZ_WPL), MP, DM, kple, PLE, PLE, 31, 0};
            pg8::StaticOrder S; S.init(MP, DM, G, bid);
            epi::EpiRes E{nullptr, nullptr, nullptr, nullptr, (float*)(ws + WS_TPLE), 1, nullptr};
            pg8::gemm_phase<epi::EpiRes, pg8::StaticOrder, true, true>(Fg.lds, g, S, E, Fg.tid);
            TREG_SUB(99);
            {
                Frame Fs = fresh(F); const SEpiRes Es{nullptr, nullptr, nullptr, nullptr, (float*)(ws + WS_TPLE), 1, nullptr};
                for (int tl = Fs.bid; tl < 256; tl += Fs.G) sgemm_tile(Fs, (const bf16*)(ws + WS_P16) + (size_t)layer * MROWS * PLE, PLE, (const bf16*)(ws + WS_WPL + layer * SZ_WPL), PLE, PLE, MP + 32 * (tl & 15), 64 * (tl >> 4), Es);
            }
            TREG_SUB(35);
        }
        }
        for (int rp_ = 0; rp_ < PH_G2; ++rp_) {
        {
            const Frame Fg = fresh(F); const int G = Fg.G, bid = Fg.bid;
            unsigned char* ws = KWS();
            const bool more = layer + 1 < NLAYER;
            pg8::Gemm g{(const bf16*)(ws + WS_XGC), (const bf16*)(ws + WS_WPG + layer * SZ_WPG), MP, DM, DM, DM, DM, 31, 0};
            pg8::StaticOrder S; S.init(MP, DM, G, bid);
            epi::EpiRes E{(float*)(ws + WS_XR), more ? (bf16*)(ws + WS_XGA) : nullptr, more ? KIN(10) + (layer + 1) * DM : nullptr, more ? (float*)(ws + WS_SSA) : nullptr, (float*)(ws + WS_TPLE), (rp_ + 1 < PH_G2) ? 3 : 2, (const float*)(ws + WS_XR)};
            pg8::gemm_phase<epi::EpiRes, pg8::StaticOrder, true, true>(Fg.lds, g, S, E, Fg.tid);
            TREG_SUB(99);
            if (rp_ + 1 == PH_G2) {
                Frame Fs = fresh(F); const SEpiRes Es{(float*)(ws + WS_XR), more ? (bf16*)(ws + WS_XGA) : nullptr, more ? KIN(10) + (layer + 1) * DM : nullptr, more ? (float*)(ws + WS_SSA) : nullptr, (float*)(ws + WS_TPLE), 2, (const float*)(ws + WS_XR)};
                for (int tl = Fs.bid; tl < 256; tl += Fs.G) sgemm_tile(Fs, (const bf16*)(ws + WS_XGC), DM, (const bf16*)(ws + WS_WPG + layer * SZ_WPG), DM, DM, MP + 32 * (tl & 15), 64 * (tl >> 4), Es);
            }
            TREG_SUB(36);
        }
        }
        GRID_BAR();
    TREG_MARK(9);
    }
    for (int xb_ = 0; xb_ < PH_XBAR; ++xb_) GRID_BAR();
    { Frame Fp = fresh(F); for (int r = Fp.bid * NWAVES + Fp.wave; r < MROWS; r += Fp.G * NWAVES) final_row(Fp, r); }
    TREG_MARK(10);
#if PH_TREG >= 0
#if defined(PH_GPT) && PH_GPT >= 0
    tacc_ += *(volatile LAS unsigned long long*)(F.lds + LDSCTL_OFF + 448);
#endif
#if defined(PH_NPT) && PH_NPT >= 0
    tacc_ += *(volatile LAS unsigned long long*)(F.lds + LDSCTL_OFF + 464);
#endif
      { const unsigned long long tend_ = __builtin_amdgcn_s_memrealtime() + tacc_; while (__builtin_amdgcn_s_memrealtime() < tend_) __builtin_amdgcn_s_sleep(8); }
#endif
}

extern "C" void kernel_launch(void* const* d_in, const int* in_sizes, int n_in, void* d_out, int out_size, void* d_ws, size_t ws_size, hipStream_t stream) {
    static int grid = 0;
    if (grid == 0) {
        if (n_in != 27 || ws_size < WS_END) { fprintf(stderr, "kernel_launch: unexpected shapes (n_in %d out %d ws %zu, need %zu)\n", n_in, out_size, ws_size, (size_t)WS_END); grid = -1; return; }
        int dev = 0, cus = 0;
        if (hipGetDevice(&dev) != hipSuccess || hipDeviceGetAttribute(&cus, hipDeviceAttributeMultiprocessorCount, dev) != hipSuccess) { grid = -1; return; }
        if (hipFuncSetAttribute((const void*)mk_fwd, hipFuncAttributeMaxDynamicSharedMemorySize, LDS_BYTES) != hipSuccess) { fprintf(stderr, "kernel_launch: hipFuncSetAttribute failed\n"); grid = -1; return; }
        int per_cu = 0;
        if (hipOccupancyMaxActiveBlocksPerMultiprocessor(&per_cu, (const void*)mk_fwd, NTHREADS, LDS_BYTES) != hipSuccess || per_cu < 1) fprintf(stderr, "kernel_launch: occupancy query reports %d\n", per_cu);
        (void)hipGetLastError();
        grid = cus;
    }
    if (grid < 0) return;
    if (hipMemsetAsync((char*)d_ws + WS_CTL, 0, CTL_ZERO_BYTES, stream) != hipSuccess) return;
    Args a{};
    for (int i = 0; i < 27; ++i) a.in[i] = d_in[i];
    a.out = (float*)d_out; a.ws = (unsigned char*)d_ws;
    hipLaunchKernelGGL(mk_fwd, dim3(grid), dim3(NTHREADS), LDS_BYTES, stream, a);
}
```

```cpp
#include <hip/hip_runtime.h>
#include <cstdio>
#include <cstdint>
namespace pg8 {
#define PG8_LAS __attribute__((address_space(3)))
typedef unsigned short bf16_t;
typedef short bf16x8 __attribute__((ext_vector_type(8)));
typedef float f32x4 __attribute__((ext_vector_type(4)));
typedef unsigned u32x4 __attribute__((ext_vector_type(4)));
constexpr int BM = 256, BK = 64, HALF = 128, HTB = HALF * BK * 2  , STAGE_BYTES = 8 * HTB, NXCD = 8, WGM = 8;

__host__ __device__ __forceinline__ int lds_byte(int r, int c) { const int st = (r >> 4) * 2 + (c >> 5), rr = r & 15, cc = c & 31, ob = rr * 64 + cc * 2; return st * 1024 + (ob ^ (((ob >> 9) & 1) << 5)); }
__host__ __device__ __forceinline__ void stage_rc(int b, int& R, int& C) { const int st = b / 1024, sb = b % 1024, swz = sb ^ (((sb >> 9) & 1) << 5); R = (st >> 1) * 16 + swz / 64; C = (st & 1) * 32 + (swz % 64) / 2; }
__host__ __device__ __forceinline__ int perm32(int rho) { const int n = rho >> 4, i = rho & 15; return 8 * (i >> 2) + 4 * n + (i & 3); }

struct Unit { int pm, pn; };
struct Gemm { const bf16_t* A; const bf16_t* Bt; int M, N, K; int lda, ldb; int a_shift, a_off; };

struct StaticOrder {
    int nM, nN, nwg, G, c;
    __host__ __device__ void init(int M, int N, int G_, int c_) { nM = M / BM; nN = N / BM; nwg = nM * nN; G = G_; c = c_; }
    __host__ __device__ bool next(int i, Unit& u) const {
        const long L = (long)i * G + c; if (L >= nwg) return false;
        int wgid = (int)L; { const int q = nwg / NXCD, r = nwg % NXCD, xcd = wgid % NXCD, off = wgid / NXCD; wgid = (xcd < r ? xcd * (q + 1) : r * (q + 1) + (xcd - r) * q) + off; }
        const int nig = WGM * nN, gid = wgid / nig, fm = gid * WGM, gsz = (nM - fm) < WGM ? (nM - fm) : WGM;
        u.pm = fm + ((wgid % nig) % gsz); u.pn = (wgid % nig) / gsz; return true;
    }
    __device__ __forceinline__ void a_ready(const Unit&) const {}
    __device__ __forceinline__ void done(const Unit&) const {}
};

__device__ __forceinline__ unsigned cvt_pk_bf16(float lo, float hi) { unsigned r; asm volatile("v_cvt_pk_bf16_f32 %0, %1, %2" : "=v"(r) : "v"(lo), "v"(hi)); return r; }
typedef float f32x2 __attribute__((ext_vector_type(2)));
template <class Epi, class Sched, bool ALIGN_EPI = false, bool SP2 = false>
__device__ __forceinline__ void gemm_phase(PG8_LAS unsigned char* lds, const Gemm g, const Sched& S, const Epi& E, const int tid) {
    const int wid = __builtin_amdgcn_readfirstlane(tid >> 6), lane = tid & 63, wr = wid >> 2, wc = wid & 3, fr = lane & 15, fq = lane >> 4;
    const int K = g.K, nt = K / BK;
    unsigned voffA[2], voffB[2];
#pragma unroll
    for (int i = 0; i < 2; ++i) { int R, C; stage_rc(tid * 16 + i * 8192, R, C); const int Rb = Epi::PERM ? ((R & ~31) + perm32(R & 31)) : R;
        voffA[i] = (unsigned)(R * g.lda + C) * 2u; voffB[i] = (unsigned)(Rb * g.ldb + C) * 2u; }
    const size_t kstep = (size_t)(BK * 2);
    const size_t hstepA = (size_t)HALF * g.lda * 2, hstepB = (size_t)HALF * g.ldb * 2;
    const size_t tstepA = 2 * hstepA, tstepB = 2 * hstepB;
    const unsigned ldsw = (unsigned)wid * 1024u;
    const int aoff = lds_byte(wr * 64 + fr, fq * 8), boff = lds_byte(wc * 32 + fr, fq * 8);
#define PG8_SA(b, h) (((b) * 2 + (h)) * HTB)
#define PG8_SB(b, h) ((4 + (b) * 2 + (h)) * HTB)
#define PG8_STAGE(bufoff, gbase, voff) do { _Pragma("unroll") for (int _i = 0; _i < 2; ++_i) \
        __builtin_amdgcn_global_load_lds((const unsigned*)((const char*)(gbase) + (voff)[_i]), (PG8_LAS unsigned*)(lds + (bufoff) + ldsw + _i * 8192), 16, 0, 0); } while (0)
#define PG8_LDA(dst, b, h) do { _Pragma("unroll") for (int m = 0; m < 4; ++m) _Pragma("unroll") for (int k = 0; k < 2; ++k) dst[m][k] = *(const PG8_LAS bf16x8*)(lds + PG8_SA(b, h) + aoff + m * 2048 + k * 1024); } while (0)
#define PG8_LDB(dst, b, h) do { _Pragma("unroll") for (int n = 0; n < 2; ++n) _Pragma("unroll") for (int k = 0; k < 2; ++k) dst[n][k] = *(const PG8_LAS bf16x8*)(lds + PG8_SB(b, h) + boff + n * 2048 + k * 1024); } while (0)
#define PG8_MMA(ai, bj, At, Bt) do { __builtin_amdgcn_s_setprio(1); _Pragma("unroll") for (int m = 0; m < 4; ++m) _Pragma("unroll") for (int n = 0; n < 2; ++n) _Pragma("unroll") for (int k = 0; k < 2; ++k) \
        acc[ai][bj][m][n] = __builtin_amdgcn_mfma_f32_16x16x32_bf16(Bt[n][k], At[m][k], acc[ai][bj][m][n], 0, 0, 0); __builtin_amdgcn_s_setprio(0); } while (0)
#define PG8_WAIT_V(n) asm volatile("s_waitcnt vmcnt(" #n ")" ::: "memory")
#define PG8_WAIT_L(n) asm volatile("s_waitcnt lgkmcnt(" #n ")" ::: "memory")
#define PG8_BAR __builtin_amdgcn_s_barrier()
#define PG8_SCHED __builtin_amdgcn_sched_barrier(0)
    Unit cur, nxt; int ui = 0;
    if (!S.next(0, cur)) return;
    f32x4 acc[2][2][4][2];
#pragma unroll
    for (int a = 0; a < 2; ++a)
#pragma unroll
        for (int b = 0; b < 2; ++b)
#pragma unroll
            for (int m = 0; m < 4; ++m)
#pragma unroll
                for (int n = 0; n < 2; ++n) acc[a][b][m][n] = (f32x4){0.f, 0.f, 0.f, 0.f};
    bf16x8 At[4][2], B0[2][2], B1[2][2];
    const char* cA = (const char*)g.A + (size_t)cur.pm * tstepA + (size_t)(cur.pn >> g.a_shift) * (size_t)g.a_off; const char* cB = (const char*)g.Bt + (size_t)cur.pn * tstepB;
    S.a_ready(cur);
    if constexpr (SP2) {
        PG8_STAGE(PG8_SB(0, 0), cB, voffB); PG8_STAGE(PG8_SB(0, 1), cB + hstepB, voffB); PG8_STAGE(PG8_SA(0, 0), cA, voffA); PG8_STAGE(PG8_SA(0, 1), cA + hstepA, voffA);
        if (wr == 1) PG8_BAR;
        PG8_WAIT_V(2); PG8_BAR;
        PG8_STAGE(PG8_SB(1, 0), cB + kstep, voffB); PG8_STAGE(PG8_SA(1, 0), cA + kstep, voffA); PG8_STAGE(PG8_SB(1, 1), cB + hstepB + kstep, voffB);
        PG8_WAIT_V(6); PG8_BAR;
    } else {
        PG8_STAGE(PG8_SB(0, 0), cB, voffB); PG8_STAGE(PG8_SA(0, 0), cA, voffA); PG8_STAGE(PG8_SB(0, 1), cB + hstepB, voffB); PG8_STAGE(PG8_SA(0, 1), cA + hstepA, voffA);
        if (wr == 1) PG8_BAR;
        PG8_WAIT_V(4); PG8_BAR;
        PG8_STAGE(PG8_SB(1, 0), cB + kstep, voffB); PG8_STAGE(PG8_SA(1, 0), cA + kstep, voffA); PG8_STAGE(PG8_SB(1, 1), cB + hstepB + kstep, voffB);
        PG8_WAIT_V(6); PG8_BAR;
    }
    for (;;) {
        const bool has_next = S.next(ui + 1, nxt);
        const char* nA = has_next ? (const char*)g.A + (size_t)nxt.pm * tstepA + (size_t)(nxt.pn >> g.a_shift) * (size_t)g.a_off : cA; const char* nB = has_next ? (const char*)g.Bt + (size_t)nxt.pn * tstepB : cB;
        for (int t = 0; t < nt; t += 2) {
            const bool last = (t == nt - 2);
            const char* a1 = cA + (size_t)(t + 1) * kstep;
            const char* a2 = last ? nA : cA + (size_t)(t + 2) * kstep; const char* b2 = last ? nB : cB + (size_t)(t + 2) * kstep;
            const char* a3 = a2 + kstep; const char* b3 = b2 + kstep;
            if (last && has_next) S.a_ready(nxt);
            if constexpr (SP2) {
            PG8_LDB(B0, 0, 0); PG8_LDB(B1, 0, 1); PG8_SCHED; PG8_LDA(At, 0, 0); PG8_STAGE(PG8_SA(1, 1), a1 + hstepA, voffA);
            PG8_WAIT_V(8); PG8_WAIT_L(0); PG8_BAR; PG8_MMA(0, 0, At, B0); PG8_MMA(0, 1, At, B1); PG8_BAR; PG8_SCHED;
            PG8_LDA(At, 0, 1); PG8_STAGE(PG8_SB(0, 0), b2, voffB); PG8_STAGE(PG8_SB(0, 1), b2 + hstepB, voffB); PG8_STAGE(PG8_SA(0, 0), a2, voffA);
            PG8_WAIT_V(8); PG8_WAIT_L(0); PG8_BAR; PG8_MMA(1, 0, At, B0); PG8_MMA(1, 1, At, B1); PG8_BAR; PG8_SCHED;
            PG8_LDB(B0, 1, 0); PG8_LDB(B1, 1, 1); PG8_SCHED; PG8_LDA(At, 1, 0); PG8_STAGE(PG8_SA(0, 1), a2 + hstepA, voffA);
            PG8_WAIT_V(8); PG8_WAIT_L(0); PG8_BAR; PG8_MMA(0, 0, At, B0); PG8_MMA(0, 1, At, B1); PG8_BAR; PG8_SCHED;
            PG8_LDA(At, 1, 1); PG8_STAGE(PG8_SB(1, 0), b3, voffB); PG8_STAGE(PG8_SB(1, 1), b3 + hstepB, voffB); PG8_STAGE(PG8_SA(1, 0), a3, voffA);
            PG8_WAIT_V(8); PG8_WAIT_L(0); PG8_BAR; PG8_MMA(1, 0, At, B0); PG8_MMA(1, 1, At, B1); PG8_BAR; PG8_SCHED;
            } else {
            PG8_LDB(B0, 0, 0); PG8_SCHED; PG8_LDA(At, 0, 0); PG8_STAGE(PG8_SA(1, 1), a1 + hstepA, voffA);
            PG8_WAIT_L(8); PG8_BAR; PG8_WAIT_L(0); PG8_MMA(0, 0, At, B0); PG8_BAR; PG8_SCHED;
            PG8_LDB(B1, 0, 1); PG8_STAGE(PG8_SB(0, 0), b2, voffB);
            PG8_BAR; PG8_WAIT_L(0); PG8_MMA(0, 1, At, B1); PG8_BAR;
            PG8_LDA(At, 0, 1); PG8_STAGE(PG8_SA(0, 0), a2, voffA);
            PG8_BAR; PG8_WAIT_L(0); PG8_MMA(1, 0, At, B0); PG8_BAR; PG8_SCHED;
            PG8_STAGE(PG8_SB(0, 1), b2 + hstepB, voffB);
            PG8_WAIT_V(6); PG8_BAR; PG8_MMA(1, 1, At, B1); PG8_BAR;
            PG8_LDB(B0, 1, 0); PG8_SCHED; PG8_LDA(At, 1, 0); PG8_STAGE(PG8_SA(0, 1), a2 + hstepA, voffA);
            PG8_WAIT_L(8); PG8_BAR; PG8_WAIT_L(0); PG8_MMA(0, 0, At, B0); PG8_BAR; PG8_SCHED;
            PG8_LDB(B1, 1, 1); PG8_STAGE(PG8_SB(1, 0), b3, voffB);
            PG8_BAR; PG8_WAIT_L(0); PG8_MMA(0, 1, At, B1); PG8_BAR;
            PG8_LDA(At, 1, 1); PG8_STAGE(PG8_SA(1, 0), a3, voffA);
            PG8_BAR; PG8_WAIT_L(0); PG8_MMA(1, 0, At, B0); PG8_BAR; PG8_SCHED;
            PG8_STAGE(PG8_SB(1, 1), b3 + hstepB, voffB);
            PG8_WAIT_V(6); PG8_BAR; PG8_MMA(1, 1, At, B1); PG8_BAR;
            }
        }
        if constexpr (ALIGN_EPI) { if (wr == 0) PG8_BAR; }
        if constexpr (!Epi::AFTER_DRAIN) { E(acc, cur, wr, wc, fr, fq); S.done(cur); }
        if (!has_next) break;
#pragma unroll
        for (int a = 0; a < 2; ++a)
#pragma unroll
            for (int b = 0; b < 2; ++b)
#pragma unroll
                for (int m = 0; m < 4; ++m)
#pragma unroll
                    for (int n = 0; n < 2; ++n) acc[a][b][m][n] = (f32x4){0.f, 0.f, 0.f, 0.f};
        cur = nxt; cA = nA; cB = nB; ++ui;
        if constexpr (ALIGN_EPI) { if (wr == 1) PG8_BAR; }
    }
    PG8_WAIT_V(0);
    if constexpr (!ALIGN_EPI) { if (wr == 0) PG8_BAR; }
    PG8_BAR;
    if constexpr (Epi::AFTER_DRAIN) { E.fused(acc, cur, wr, wc, fr, fq, lds, wid, lane); S.done(cur); }
#undef PG8_SA
#undef PG8_SB
#undef PG8_STAGE
#undef PG8_LDA
#undef PG8_LDB
#undef PG8_MMA
#undef PG8_WAIT_V
#undef PG8_WAIT_L
#undef PG8_BAR
#undef PG8_SCHED
}
}
#define DI __device__ __forceinline__
#define GAS __attribute__((address_space(1)))
#define LAS __attribute__((address_space(3)))
typedef unsigned short bf16;
typedef unsigned v4u __attribute__((ext_vector_type(4)));
typedef unsigned v2u __attribute__((ext_vector_type(2)));
typedef float f32x4 __attribute__((ext_vector_type(4)));
typedef float f32x2 __attribute__((ext_vector_type(2)));
typedef short bf16x8 __attribute__((ext_vector_type(8)));
typedef short s16x4 __attribute__((ext_vector_type(4)));
typedef GAS unsigned gu32;

constexpr int DM = 1024, TP = 8192, MP = 16384, MS = 512, MROWS = 16896, LDZ = 8704, DFF = 4096, PLE = 256, NLAYER = 2;
constexpr int ZC_Q = 0, ZC_KC = 512, ZC_VC = 640, ZC_KS = 768, ZC_VS = 896, ZC_KW = 1024, ZC_VW = 1152, ZC_GQKV = 1280, ZC_GZ = 2816, ZC_RQKV = 3328, ZC_RG = 4864, ZC_MG = 5376, ZC_SM = 8448;
constexpr float EPS = 1e-6f;
constexpr size_t O_YP = 0, O_YS = O_YP + (size_t)MP * DM, O_KVP = O_YS + (size_t)MS * DM, O_KVS = O_KVP + (size_t)2 * MP * 512, O_WINP = O_KVS + (size_t)2 * MS * 512,
                 O_WINS = O_WINP + (size_t)2 * 2 * 512 * 256, O_CVP = O_WINS + (size_t)2 * 128 * 512 * 256, O_CVS = O_CVP + (size_t)2 * 2 * 3 * 1536, O_GSP = O_CVS + (size_t)2 * 128 * 3 * 1536,
                 O_GSS = O_GSP + (size_t)2 * 2 * 4 * 16384, O_RSP = O_GSS + (size_t)2 * 128 * 4 * 16384, O_RSS = O_RSP + (size_t)2 * 2 * 4 * 16384, O_END = O_RSS + (size_t)2 * 128 * 4 * 16384;

DI float bf2f(unsigned short b) { return __uint_as_float((unsigned)b << 16); }
DI unsigned f2bf(float f) { unsigned u = __float_as_uint(f); return (u + 0x7fffu + ((u >> 16) & 1u)) >> 16; }
typedef __bf16 bf16x2_t __attribute__((ext_vector_type(2)));
DI unsigned pk2(float lo, float hi) { const f32x2 v = {lo, hi}; return __builtin_bit_cast(unsigned, __builtin_convertvector(v, bf16x2_t)); }
DI float lo_bf(unsigned w) { return __uint_as_float(w << 16); }
DI float hi_bf(unsigned w) { return __uint_as_float(w & 0xffff0000u); }
DI float sigmoidf_(float x) { return 1.f / (1.f + __expf(-x)); }
DI float siluf_(float x) { return x / (1.f + __expf(-x)); }
DI v4u pack8(const f32x4 a, const f32x4 b) { v4u w; w.x = pk2(a[0], a[1]); w.y = pk2(a[2], a[3]); w.z = pk2(b[0], b[1]); w.w = pk2(b[2], b[3]); return w; }
DI void unpack8(const v4u w, f32x4& a, f32x4& b) { a[0] = lo_bf(w.x); a[1] = hi_bf(w.x); a[2] = lo_bf(w.y); a[3] = hi_bf(w.y); b[0] = lo_bf(w.z); b[1] = hi_bf(w.z); b[2] = lo_bf(w.w); b[3] = hi_bf(w.w); }

template <int M> DI int shxi(int v, int lane) {
    if constexpr (M < 32) return __builtin_amdgcn_ds_swizzle(v, (M << 10) | 0x1f);
    else return __builtin_amdgcn_ds_bpermute((lane ^ 32) << 2, v);
}
template <int M> DI float shx(float v, int lane) { return __int_as_float(shxi<M>(__float_as_int(v), lane)); }
DI float wave_sum(float v, int lane) { v += shx<1>(v, lane); v += shx<2>(v, lane); v += shx<4>(v, lane); v += shx<8>(v, lane); v += shx<16>(v, lane); v += shx<32>(v, lane); return v; }

namespace epi {
using pg8::Unit; using pg8::bf16_t;
DI float row_rstd(const float* SS, int row, int fq, int lane) {
    const f32x4 p = *(const f32x4*)(SS + (size_t)row * 16 + 4 * fq);
    float s = (p[0] + p[1]) + (p[2] + p[3]); s += shx<16>(s, lane); s += shx<32>(s, lane);
    return rsqrtf(s * (1.f / DM) + EPS);
}
struct EpiA {
    static constexpr bool PERM = true, AFTER_DRAIN = false;
    bf16* Z; float* ZS; const float* SS; float* out; int layer;
    DI void operator()(const f32x4 (&acc)[2][2][4][2], const Unit& u, int wr, int wc, int fr, int fq) const {
        asm volatile("" : "+v"(fr), "+v"(fq), "+s"(wr), "+s"(wc));
        const int pn = u.pn;
        float rs[2][4];
#pragma unroll
        for (int ai = 0; ai < 2; ++ai)
#pragma unroll
            for (int m = 0; m < 4; ++m) rs[ai][m] = row_rstd(SS, u.pm * 256 + ai * 128 + wr * 64 + m * 16 + fr, fq, fr + 16 * fq);
#pragma unroll
        for (int ai = 0; ai < 2; ++ai)
#pragma unroll
            for (int m = 0; m < 4; ++m) {
                const int row = u.pm * 256 + ai * 128 + wr * 64 + m * 16 + fr;
                const float rstd = rs[ai][m];
#pragma unroll
                for (int bj = 0; bj < 2; ++bj) {
                    const int col = pn * 256 + bj * 128 + wc * 32 + 8 * fq;
                    const f32x4 v0 = acc[ai][bj][m][0] * rstd, v1 = acc[ai][bj][m][1] * rstd;
                    *(v4u*)(Z + (size_t)row * LDZ + col) = pack8(v0, v1);
                    float* dst = nullptr;
                    if (pn == 2 || pn == 3) {
                        dst = (row < MP) ? out + O_KVP + ((size_t)layer * MP + row) * 512 + (col - 512) : out + O_KVS + ((size_t)layer * MS + (row - MP)) * 512 + (col - 512);
                    } else if (pn == 4) {
                        const int c2 = col - 1024;
                        if (row < MP) { const int t = row & (TP - 1), b = row >> 13; if (t >= TP - 512) dst = out + O_WINP + ((size_t)(layer * 2 + b) * 512 + (t - (TP - 512))) * 256 + c2; }
                        else { const int r2 = row - MP, s = r2 >> 2, j = r2 & 3; dst = out + O_WINS + ((size_t)(layer * 128 + s) * 512 + 508 + j) * 256 + c2; }
                    } else if (pn >= 5 && pn < 11) {
                        const int c2 = col - 1280;
                        if (row < MP) { const int t = row & (TP - 1), b = row >> 13; if (t >= TP - 3) dst = out + O_CVP + ((size_t)(layer * 2 + b) * 3 + (t - (TP - 3))) * 1536 + c2; }
                        else { const int r2 = row - MP, s = r2 >> 2, j = r2 & 3; if (j >= 1) dst = out + O_CVS + ((size_t)(layer * 128 + s) * 3 + (j - 1)) * 1536 + c2; }
                    } else if (pn == 33) {
                        if (bj == 0 && wc == 0) dst = ZS + (size_t)row * 32 + 8 * fq;
                    }
                    if (dst) { *(f32x4*)dst = v0; *(f32x4*)(dst + 4) = v1; }
                }
                asm volatile("" ::: "memory");
            }
    }
};
struct EpiC {
    static constexpr bool PERM = true, AFTER_DRAIN = false;
    const bf16* Z; bf16* G;
    DI void operator()(const f32x4 (&acc)[2][2][4][2], const Unit& u, int wr, int wc, int fr, int fq) const {
        asm volatile("" : "+v"(fr), "+v"(fq), "+s"(wr), "+s"(wc));
#pragma unroll
        for (int ai = 0; ai < 2; ++ai) {
            v4u gw[4][2];
#pragma unroll
            for (int m = 0; m < 4; ++m)
#pragma unroll
                for (int bj = 0; bj < 2; ++bj) gw[m][bj] = *(const v4u*)(Z + (size_t)(u.pm * 256 + ai * 128 + wr * 64 + m * 16 + fr) * LDZ + ZC_MG + u.pn * 256 + bj * 128 + wc * 32 + 8 * fq);
#pragma unroll
            for (int m = 0; m < 4; ++m) {
                const int row = u.pm * 256 + ai * 128 + wr * 64 + m * 16 + fr;
#pragma unroll
                for (int bj = 0; bj < 2; ++bj) {
                    const int col = u.pn * 256 + bj * 128 + wc * 32 + 8 * fq;
                    f32x4 g0, g1; unpack8(gw[m][bj], g0, g1);
                    f32x4 v0 = acc[ai][bj][m][0], v1 = acc[ai][bj][m][1];
#pragma unroll
                    for (int e = 0; e < 4; ++e) { v0[e] *= sigmoidf_(g0[e]); v1[e] *= sigmoidf_(g1[e]); }
                    *(v4u*)(G + (size_t)row * 3072 + col) = pack8(v0, v1);
                }
            }
            asm volatile("" ::: "memory");
        }
    }
};
struct EpiRes {
    static constexpr bool PERM = true, AFTER_DRAIN = false;
    float* XR; bf16* XG; const float* gvec; float* SS; float* T; int mode;
    const float* XRr;
    DI void operator()(const f32x4 (&acc)[2][2][4][2], const Unit& u, int wr, int wc, int fr, int fq) const {
        asm volatile("" : "+v"(fr), "+v"(fq), "+s"(wr), "+s"(wc));
        if (mode == 3) return;
        if (mode == 1) {
#pragma unroll
            for (int ai = 0; ai < 2; ++ai)
#pragma unroll
                for (int m = 0; m < 4; ++m)
#pragma unroll
                    for (int bj = 0; bj < 2; ++bj) { const size_t o = (size_t)(u.pm * 256 + ai * 128 + wr * 64 + m * 16 + fr) * DM + u.pn * 256 + bj * 128 + wc * 32 + 8 * fq;
                        *(v4u*)((bf16*)T + o) = pack8(acc[ai][bj][m][0], acc[ai][bj][m][1]); }
            return;
        }
#pragma unroll
        for (int ai = 0; ai < 2; ++ai)
#pragma unroll
            for (int mp = 0; mp < 2; ++mp) {
                f32x4 xr[2][2][2], tt[2][2][2];
#pragma unroll
                for (int mm = 0; mm < 2; ++mm)
#pragma unroll
                    for (int bj = 0; bj < 2; ++bj) { const size_t o = (size_t)(u.pm * 256 + ai * 128 + wr * 64 + (2 * mp + mm) * 16 + fr) * DM + u.pn * 256 + bj * 128 + wc * 32 + 8 * fq;
                        xr[mm][bj][0] = *(const f32x4*)(XRr + o); xr[mm][bj][1] = *(const f32x4*)(XRr + o + 4);
                        if (mode == 2) unpack8(*(const v4u*)((const bf16*)T + o), tt[mm][bj][0], tt[mm][bj][1]); }
#pragma unroll
                for (int mm = 0; mm < 2; ++mm) {
                    const int m = 2 * mp + mm;
                    const int row = u.pm * 256 + ai * 128 + wr * 64 + m * 16 + fr;
                    float ssq = 0.f;
#pragma unroll
                    for (int bj = 0; bj < 2; ++bj) {
                        const int col = u.pn * 256 + bj * 128 + wc * 32 + 8 * fq;
                        const size_t o = (size_t)row * DM + col;
                        f32x4 a0 = acc[ai][bj][m][0], a1 = acc[ai][bj][m][1];
                        f32x4 x0 = xr[mm][bj][0], x1 = xr[mm][bj][1];
                        if (mode == 2) {
#pragma unroll
                            for (int e = 0; e < 4; ++e) { a0[e] = tt[mm][bj][0][e] * sigmoidf_(a0[e]); a1[e] = tt[mm][bj][1][e] * sigmoidf_(a1[e]); } }
                        x0 += a0; x1 += a1;
                        *(f32x4*)(XR + o) = x0; *(f32x4*)(XR + o + 4) = x1;
                        ssq += (x0[0] * x0[0] + x0[1] * x0[1]) + (x0[2] * x0[2] + x0[3] * x0[3]) + (x1[0] * x1[0] + x1[1] * x1[1]) + (x1[2] * x1[2] + x1[3] * x1[3]);
                        if (XG) { if (gvec) { const f32x4 g0 = *(const f32x4*)(gvec + col), g1 = *(const f32x4*)(gvec + col + 4); x0 *= g0; x1 *= g1; }
                            *(v4u*)(XG + o) = pack8(x0, x1); }
                    }
                    if (SS) { ssq += shx<16>(ssq, fr + 16 * fq); ssq += shx<32>(ssq, fr + 16 * fq); if (fq == 0) SS[(size_t)row * 16 + u.pn * 4 + wc] = ssq; }
                }
                asm volatile("" ::: "memory");
            }
    }
};
struct EpiUp {
    static constexpr bool PERM = true, AFTER_DRAIN = false;
    bf16* H; const float* SS;
    DI void operator()(const f32x4 (&acc)[2][2][4][2], const Unit& u, int wr, int wc, int fr, int fq) const {
        asm volatile("" : "+v"(fr), "+v"(fq), "+s"(wr), "+s"(wc));
        float rs[2][4];
#pragma unroll
        for (int ai = 0; ai < 2; ++ai)
#pragma unroll
            for (int m = 0; m < 4; ++m) rs[ai][m] = row_rstd(SS, u.pm * 256 + ai * 128 + wr * 64 + m * 16 + fr, fq, fr + 16 * fq);
#pragma unroll
        for (int ai = 0; ai < 2; ++ai)
#pragma unroll
            for (int m = 0; m < 4; ++m) {
                const int row = u.pm * 256 + ai * 128 + wr * 64 + m * 16 + fr;
                const float rstd = rs[ai][m];
#pragma unroll
                for (int bj = 0; bj < 2; ++bj) {
                    const int col = u.pn * 256 + bj * 128 + wc * 32 + 8 * fq;
                    f32x4 v0 = acc[ai][bj][m][0] * rstd, v1 = acc[ai][bj][m][1] * rstd;
#pragma unroll
                    for (int e = 0; e < 4; ++e) { const float a = fmaxf(v0[e], 0.f), b = fmaxf(v1[e], 0.f); v0[e] = a * a; v1[e] = b * b; }
                    *(v4u*)(H + (size_t)row * DFF + col) = pack8(v0, v1);
                }
                asm volatile("" ::: "memory");
            }
    }
};
}
constexpr size_t al256(size_t x) { return (x + 255) & ~(size_t)255; }
constexpr size_t WS_CTL = 0, CTL_ZERO_BYTES = 1u << 20;
constexpr size_t SZ_WIN = (size_t)LDZ * DM * 2, SZ_WBR = (size_t)3072 * 512 * 2, SZ_WO3 = (size_t)DM * 3072 * 2, SZ_WUP = (size_t)DFF * DM * 2, SZ_WDN = (size_t)DM * DFF * 2,
                 SZ_WPL = (size_t)DM * PLE * 2, SZ_WPG = (size_t)DM * DM * 2, SZ_W1T = (size_t)2 * 64 * 2048 * 2, SZ_W2T = (size_t)2 * 64 * 64 * 2;
constexpr size_t WS_WIN = CTL_ZERO_BYTES, WS_WBR = WS_WIN + 2 * SZ_WIN, WS_WO3 = WS_WBR + 2 * SZ_WBR, WS_WUP = WS_WO3 + 2 * SZ_WO3, WS_WDN = WS_WUP + 2 * SZ_WUP,
                 WS_WPL = WS_WDN + 2 * SZ_WDN, WS_WPG = WS_WPL + 2 * SZ_WPL, WS_W1T = WS_WPG + 2 * SZ_WPG, WS_W2T = WS_W1T + 2 * SZ_W1T, WS_ROT = al256(WS_W2T + 2 * SZ_W2T);
constexpr size_t WS_P16 = WS_ROT + (size_t)TP * 64 * 8;
constexpr size_t WS_XR = WS_P16 + (size_t)2 * MROWS * PLE * 2;
constexpr size_t WS_XGA = WS_XR + (size_t)MROWS * DM * 4, WS_XGB = WS_XGA + (size_t)MROWS * DM * 2, WS_XGC = WS_XGB + (size_t)MROWS * DM * 2;
constexpr size_t WS_SSA = WS_XGC + (size_t)MROWS * DM * 2, WS_SSB = WS_SSA + (size_t)MROWS * 64;
constexpr size_t WS_Z = WS_SSB + (size_t)MROWS * 64, WS_ZS = WS_Z + (size_t)MROWS * LDZ * 2;
constexpr size_t WS_MIX = WS_ZS + (size_t)MROWS * 128, WS_GATED = WS_MIX + (size_t)MROWS * 1536 * 2, WS_HMID = WS_GATED + (size_t)MROWS * 3072 * 2;
constexpr size_t WS_TPLE = WS_HMID + (size_t)MROWS * DFF * 2;
constexpr size_t WS_KC = WS_TPLE + (size_t)MROWS * DM * 4;
constexpr size_t WS_KCS = WS_KC + (size_t)2 * 2 * 512 * 2 * 64 * 2;
constexpr int GREC = 73984;
constexpr size_t WS_GREC = WS_KCS + (size_t)2 * 128 * 128 * 2 * 64 * 2;
constexpr size_t WS_OGDN = WS_GREC + (size_t)1024 * GREC;
constexpr size_t WS_RKV = WS_OGDN + (size_t)MROWS * 512 * 4;
constexpr size_t WS_RST = WS_RKV + (size_t)512 * 16384 * 4;
constexpr size_t WS_QR = WS_RST + (size_t)512 * 16384 * 2, WS_KR = WS_QR + (size_t)MP * 512 * 2;
constexpr size_t WS_END = WS_KR + (size_t)MP * 512 * 2;
static_assert(WS_W1T % 256 == 0 && WS_Z % 256 == 0 && WS_GREC % 256 == 0 && WS_RKV % 256 == 0 && WS_KC % 256 == 0 && WS_XR % 256 == 0, "ws alignment");

constexpr int CW_TMO = 0, CW_BAR = 4096, CW_QUEUE = 8192;
constexpr int NWAVES = 8, NTHREADS = 512;
constexpr int RING_BYTES = 147456, LDSCTL_OFF = RING_BYTES, MISC_OFF = LDSCTL_OFF + 320, LDS_BYTES = RING_BYTES + 1024;

#define RLX_AGENT __ATOMIC_RELAXED, __HIP_MEMORY_SCOPE_AGENT
#define LDS_WAIT() asm volatile("s_waitcnt lgkmcnt(0)" ::: "memory")
#define VM_WAIT() asm volatile("s_waitcnt vmcnt(0)" ::: "memory")
#define XB_TMO      128
#define XB_XCNT(j)  (256  + 64 * (j))
#define XB_XSUB(j)  (1280 + 64 * (j))
#define XB_XGEN(j)  (2304 + 64 * (j))
#define XB_TOP      3328
#define XB_TOPGEN   3392
#define XCD_BAR_WORDS 3456
#define XB_SPIN_CAP (1u << 18)

__device__ __forceinline__ unsigned xb_ld(unsigned* p)              { return __hip_atomic_load(p, __ATOMIC_RELAXED, __HIP_MEMORY_SCOPE_AGENT); }
__device__ __forceinline__ unsigned xb_add(unsigned* p, unsigned v) { return __hip_atomic_fetch_add(p, v, __ATOMIC_RELAXED, __HIP_MEMORY_SCOPE_AGENT); }
__device__ __forceinline__ unsigned xb_xcc_id() { return (unsigned)__builtin_amdgcn_s_getreg((3 << 11) | 20) & 0xFu; }
#define XB_SPIN(cond, bar) do { unsigned _sp = 0; while (cond) { __builtin_amdgcn_s_sleep(1); \
    if ((++_sp & 255u) == 0u) { if (xb_ld(&(bar)[XB_TMO])) break; if (_sp > XB_SPIN_CAP) { atomicAdd(&(bar)[XB_TMO], 1u); break; } } } } while (0)

struct XcdBarrier {
    unsigned* bar; unsigned x;
    volatile LAS unsigned* st;
};

__device__ __forceinline__ XcdBarrier xcd_barrier_post(unsigned* bar, volatile LAS unsigned* st, bool t0) {
    XcdBarrier b; b.bar = bar; b.x = xb_xcc_id(); b.st = st;
    if (t0) (void)xb_add(&bar[XB_XCNT(b.x)], 1u);
    return b;
}
__device__ __forceinline__ void xcd_barrier_complete(unsigned* bar, unsigned x, unsigned& nloc, unsigned& nx) {
    const unsigned G = gridDim.x * gridDim.y * gridDim.z;
    unsigned sum, cnt, mine, sp = 0u;
    for (;;) {
        sum = 0u; cnt = 0u; mine = 0u;
#pragma unroll
        for (unsigned j = 0; j < 16; ++j) { const unsigned c = xb_ld(&bar[XB_XCNT(j)]); sum += c; cnt += (c > 0u) ? 1u : 0u; mine = (j == x) ? c : mine; }
        if (sum == G) break;
        __builtin_amdgcn_s_sleep(1);
        if ((++sp & 255u) == 0u) { if (xb_ld(&bar[XB_TMO])) break; if (sp > XB_SPIN_CAP) { atomicAdd(&bar[XB_TMO], 1u); break; } }
    }
    nloc = mine > 0u ? mine : 1u; nx = cnt > 0u ? cnt : 1u;
}

__device__ __forceinline__ void xcd_barrier(const XcdBarrier& b, bool t0) {
    asm volatile("s_waitcnt vmcnt(0)" ::: "memory");
    __syncthreads();
    if (t0) {
        unsigned* bar = b.bar;
        __builtin_amdgcn_s_waitcnt(0);
        unsigned nloc = b.st[0], nx = b.st[1];
        if (nloc == 0u) { xcd_barrier_complete(bar, b.x, nloc, nx); b.st[0] = nloc; b.st[1] = nx; }
        const unsigned old = xb_add(&bar[XB_XSUB(b.x)], 1u);
        const unsigned gen = old / nloc;
        if (old + 1u == (gen + 1u) * nloc) {
            __builtin_amdgcn_fence(__ATOMIC_RELEASE, "agent");
            asm volatile("s_waitcnt vmcnt(0)" ::: "memory");
            const unsigned og = xb_add(&bar[XB_TOP], 1u);
            const unsigned tg = og / nx;
            if (og + 1u == (tg + 1u) * nx) xb_add(&bar[XB_TOPGEN], 1u);
            else XB_SPIN(xb_ld(&bar[XB_TOPGEN]) == tg, bar);
            __builtin_amdgcn_fence(__ATOMIC_ACQUIRE, "agent");
            xb_add(&bar[XB_XGEN(b.x)], 1u);
            asm volatile("s_waitcnt vmcnt(0)" ::: "memory");
        } else {
            XB_SPIN(xb_ld(&bar[XB_XGEN(b.x)]) == gen, bar);
            __builtin_amdgcn_fence(__ATOMIC_ACQUIRE, "agent");
            asm volatile("s_waitcnt vmcnt(0)" ::: "memory");
        }
    }
    __syncthreads();
}
typedef const void* const __attribute__((address_space(4)))* kargp_t;
DI const float* KIN(int i) { const GAS float* p = (const GAS float*)((kargp_t)__builtin_amdgcn_kernarg_segment_ptr())[i]; asm volatile("" : "+s"(p)); return (const float*)p; }
DI float* KOUT() { GAS float* p = (GAS float*)((kargp_t)__builtin_amdgcn_kernarg_segment_ptr())[27]; asm volatile("" : "+s"(p)); return (float*)p; }
DI unsigned char* KWS() { GAS unsigned char* p = (GAS unsigned char*)((kargp_t)__builtin_amdgcn_kernarg_segment_ptr())[28]; asm volatile("" : "+s"(p)); return (unsigned char*)p; }
struct Frame {
    LAS unsigned char* lds;
    gu32* ctl;
    int tid, lane, wave, G, bid;
};
DI bf16x8 ld_frag_g(const bf16* p) { return __builtin_bit_cast(bf16x8, *(const v4u*)p); }
DI bf16x8 ld_frag_l(const LAS unsigned char* p) { return *(const LAS bf16x8*)p; }
DI f32x4 mfma16(bf16x8 a, bf16x8 b, f32x4 c) { return __builtin_amdgcn_mfma_f32_16x16x32_bf16(a, b, c, 0, 0, 0); }
DI bf16x8 pack_frag(const f32x4 a, const f32x4 b) { return __builtin_bit_cast(bf16x8, pack8(a, b)); }
DI int lane_id() { int l; asm volatile("v_mbcnt_lo_u32_b32 %0, -1, 0\n\tv_mbcnt_hi_u32_b32 %0, -1, %0" : "=v"(l)); return l; }
DI Frame fresh(const Frame& F0) {
    Frame F = F0; int w = F0.wave, g = F0.G, b = F0.bid; asm volatile("" : "+s"(w), "+s"(g), "+s"(b));
    int l = lane_id(); asm volatile("" : "+v"(l));
    unsigned lb = (unsigned)(uintptr_t)F0.lds; asm volatile("" : "+s"(lb)); F.lds = (LAS unsigned char*)(uintptr_t)lb;
    F.wave = w; F.lane = l; F.tid = w * 64 + l; F.G = g; F.bid = b; return F;
}
#define GRID_BAR() do { XcdBarrier b_; b_.bar = (unsigned*)((gu32*)(KWS() + WS_CTL) + CW_BAR); b_.x = xb_xcc_id(); b_.st = (volatile LAS unsigned*)(F.lds + MISC_OFF) + 8; \
    const Frame Fb_ = fresh(F); xcd_barrier(b_, Fb_.tid == 0); } while (0)
DI int win_colmap(int j) {
    if (j < 1280) return j; if (j < 2816) return j + 24; if (j < 8448) return j + 32; if (j < 8472) return j - 8448 + 1280; if (j < 8480) return j - 8472 + 2840; return -1;
}
DI void tr_item(const float* W, int ldw, int k0, int srccol, bf16* WT, size_t dst_row0, int ldt, int kdst0, int nrep, int krep, LAS float* scr, int lane) {
#pragma unroll 8
    for (int i = 0; i < 32; ++i) { const int kk = 2 * i + (lane >> 5); const float v_ = W[(size_t)(k0 + kk) * ldw + (srccol >= 0 ? srccol : 0)]; scr[kk * 33 + (lane & 31)] = (srccol >= 0) ? v_ : 0.f; }
    LDS_WAIT(); asm volatile("" ::: "memory");
    const int c = lane & 7;
#pragma unroll
    for (int j = 0; j < 4; ++j) { const int n = (lane >> 3) + 8 * j; const LAS float* s = scr + (8 * c) * 33 + n;
        v4u o; o.x = pk2(s[0 * 33], s[1 * 33]); o.y = pk2(s[2 * 33], s[3 * 33]); o.z = pk2(s[4 * 33], s[5 * 33]); o.w = pk2(s[6 * 33], s[7 * 33]);
        for (int r = 0; r < nrep; ++r) *(v4u*)(WT + (dst_row0 + n) * (size_t)ldt + kdst0 + r * krep + 8 * c) = o; }
    LDS_WAIT(); asm volatile("" ::: "memory");
}
DI void p0_prologue(Frame& F) {
    LAS float* scr = (LAS float*)(F.lds + F.wave * 16384);
    const int gw = F.bid * NWAVES + F.wave, NGW = F.G * NWAVES, lane = F.lane;
    unsigned char* ws = KWS();
    constexpr int I_A = 16 * 272, I_B = 3 * 8 * 32, I_C = 16 * 32, I_D = 16 * 128, I_E = 64 * 32, I_F = 4 * 32, I_G = 16 * 32, I_H = 2 * 32 * 2, I_I = 2 * 2;
    constexpr int I_L = I_A + I_B + I_C + I_D + I_E + I_F + I_G + I_H + I_I;
    for (int it = gw; it < 2 * I_L; it += NGW) {
        const int l = it / I_L; int r = it % I_L;
        if (r < I_A) { const int kb = r / 272, nb = r % 272; tr_item(KIN(11) + (size_t)l * DM * 8480, 8480, 64 * kb, win_colmap(32 * nb + (lane & 31)), (bf16*)(ws + WS_WIN + l * SZ_WIN), 32 * nb, DM, 64 * kb, 1, 0, scr, lane); continue; } r -= I_A;
        if (r < I_B) { const int b = r / 256, kb = (r % 256) / 32, nb = r % 32; tr_item(KIN(19) + (size_t)(l * 3 + b) * 512 * DM, DM, 64 * kb, 32 * nb + (lane & 31), (bf16*)(ws + WS_WBR + l * SZ_WBR), b * 1024 + 32 * nb, 512, 64 * kb, 1, 0, scr, lane); continue; } r -= I_B;
        if (r < I_C) { const int kb = r / 32, nb = r % 32; tr_item(KIN(20) + (size_t)l * DM * DM, DM, 64 * kb, 32 * nb + (lane & 31), (bf16*)(ws + WS_WO3 + l * SZ_WO3), 32 * nb, 3072, 64 * kb, 3, 1024, scr, lane); continue; } r -= I_C;
        if (r < I_D) { const int kb = r / 128, nb = r % 128; tr_item(KIN(22) + (size_t)l * DM * DFF, DFF, 64 * kb, 32 * nb + (lane & 31), (bf16*)(ws + WS_WUP + l * SZ_WUP), 32 * nb, DM, 64 * kb, 1, 0, scr, lane); continue; } r -= I_D;
        if (r < I_E) { const int kb = r / 32, nb = r % 32; tr_item(KIN(23) + (size_t)l * DFF * DM, DM, 64 * kb, 32 * nb + (lane & 31), (bf16*)(ws + WS_WDN + l * SZ_WDN), 32 * nb, DFF, 64 * kb, 1, 0, scr, lane); continue; } r -= I_E;
        if (r < I_F) { const int kb = r / 32, nb = r % 32; tr_item(KIN(24) + (size_t)l * PLE * DM, DM, 64 * kb, 32 * nb + (lane & 31), (bf16*)(ws + WS_WPL + l * SZ_WPL), 32 * nb, PLE, 64 * kb, 1, 0, scr, lane); continue; } r -= I_F;
        if (r < I_G) { const int kb = r / 32, nb = r % 32; tr_item(KIN(25) + (size_t)l * DM * DM, DM, 64 * kb, 32 * nb + (lane & 31), (bf16*)(ws + WS_WPG + l * SZ_WPG), 32 * nb, DM, 64 * kb, 1, 0, scr, lane); continue; } r -= I_G;
        if (r < I_H) { const int kv = r / 64, kb = (r % 64) / 2, nb = r % 2; tr_item(KIN(13) + (size_t)(l * 2 + kv) * 2048 * 64, 64, 64 * kb, 32 * nb + (lane & 31), (bf16*)(ws + WS_W1T + l * SZ_W1T) + (size_t)kv * 64 * 2048, 32 * nb, 2048, 64 * kb, 1, 0, scr, lane); continue; } r -= I_H;
        { const int kv = r / 2, nb = r % 2; tr_item(KIN(14) + (size_t)(l * 2 + kv) * 64 * 64, 64, 0, 32 * nb + (lane & 31), (bf16*)(ws + WS_W2T + l * SZ_W2T) + (size_t)kv * 64 * 64, 32 * nb, 64, 0, 1, 0, scr, lane); }
    }
    bf16* XGA = (bf16*)(ws + WS_XGA); float* SSA = (float*)(ws + WS_SSA); bf16* P16 = (bf16*)(ws + WS_P16);
    const float* g0 = KIN(10);
    for (int row = gw; row < MROWS; row += NGW) {
        const float* xs = (row < MP) ? KIN(0) + (size_t)row * DM : KIN(1) + (size_t)(row - MP) * DM;
        float ss = 0.f;
#pragma unroll
        for (int j = 0; j < 2; ++j) {
            const int c = j * 512 + lane * 8;
            f32x4 a = *(const f32x4*)(xs + c), b = *(const f32x4*)(xs + c + 4);
            ss += (a[0] * a[0] + a[1] * a[1]) + (a[2] * a[2] + a[3] * a[3]) + (b[0] * b[0] + b[1] * b[1]) + (b[2] * b[2] + b[3] * b[3]);
            const f32x4 ga = *(const f32x4*)(g0 + c), gb = *(const f32x4*)(g0 + c + 4);
            *(v4u*)(XGA + (size_t)row * DM + c) = pack8(a * ga, b * gb);
        }
        ss = wave_sum(ss, lane);
        if (lane < 16) SSA[(size_t)row * 16 + lane] = (lane == 0) ? ss : 0.f;
#pragma unroll
        for (int l = 0; l < 2; ++l) {
            const float* ps = (row < MP) ? KIN(8) + ((size_t)l * MP + row) * PLE : KIN(9) + ((size_t)l * MS + (row - MP)) * PLE;
            const f32x4 a = *(const f32x4*)(ps + lane * 4);
            v2u o; o.x = pk2(a[0], a[1]); o.y = pk2(a[2], a[3]);
            *(v2u*)(P16 + ((size_t)l * MROWS + row) * PLE + lane * 4) = o;
        }
    }
    const int gt = F.bid * NTHREADS + F.tid, NGT = F.G * NTHREADS;
    f32x2* ROT = (f32x2*)(ws + WS_ROT);
    for (int e = gt; e < TP * 64; e += NGT) {
        const int pos = e >> 6, i = e & 63;
        const float x = (float)i * (1.0f / 63.0f);
        const float inv = exp2f(-x * 13.287712379549449f);
        const float ang = (float)pos * inv;
        const double rev = (double)ang * 0.15915494309189535;
        const float fr = (float)(rev - floor(rev));
        ROT[e] = (f32x2){__builtin_amdgcn_cosf(fr), __builtin_amdgcn_sinf(fr)};
    }
}
DI float gelu_tanh(float x) { const float u = 0.7978845608028654f * (x + 0.044715f * x * x * x); const float e = __expf(2.f * u); return 0.5f * x * (1.f + (1.f - 2.f / (e + 1.f))); }
DI bf16x8 mk_frag(v2u a, v2u b) { v4u w; w.x = a.x; w.y = a.y; w.z = b.x; w.w = b.y; return __builtin_bit_cast(bf16x8, w); }

template <bool sample> DI void compress_job_t(Frame& F, int layer, int job) {
    int lane = F.lane, wave = F.wave; asm volatile("" : "+v"(lane), "+s"(wave));
    const int tid = wave * 64 + lane, quad = lane >> 4, rl = lane & 15;
    unsigned char* ws = KWS();
    int kv, bs, g0, nbase;
    if (sample) { kv = job >> 7; bs = job & 127; g0 = 0; nbase = 0; }
    else { const int j2 = job - 256; kv = j2 >> 3; bs = (j2 >> 2) & 1; g0 = (j2 >> 1) & 1; nbase = (j2 & 1) * 256; }
    const bf16* W1T = (const bf16*)(ws + WS_W1T + layer * SZ_W1T) + (size_t)kv * 64 * 2048;
    const bf16* W2T = (const bf16*)(ws + WS_W2T + layer * SZ_W2T) + (size_t)kv * 64 * 64;
    const float* pe = KIN(12) + (size_t)(layer * 2 + kv) * 32 * 64;
    const bf16* Z = (const bf16*)(ws + WS_Z);
    const int* pt = (const int*)KIN(7);
    const float* cache = KIN(2);
    LAS unsigned char* LW = F.lds;
    int gg[2], nn[2];
    size_t pb0[2], pb1[2];
#pragma unroll
    for (int tl = 0; tl < 2; ++tl) { const int T = 2 * wave + tl; if (sample) { gg[tl] = T >> 3; nn[tl] = 16 * (T & 7) + rl; } else { gg[tl] = g0; nn[tl] = nbase + 16 * T + rl; }
        pb0[tl] = 0; pb1[tl] = 0;
        if (sample) { const int p0 = (16 * nn[tl]) >> 7; const int p1 = p0 + 1 > 15 ? 15 : p0 + 1;
            pb0[tl] = (size_t)(layer * 2560 + pt[bs * 16 + p0]) * 128 * 512; pb1[tl] = (size_t)(layer * 2560 + pt[bs * 16 + p1]) * 128 * 512; } }
    f32x4 h[2][4];
#pragma unroll
    for (int tl = 0; tl < 2; ++tl)
#pragma unroll
        for (int i = 0; i < 4; ++i) h[tl][i] = (f32x4){0.f, 0.f, 0.f, 0.f};
#pragma unroll 1
    for (int c = 0; c < 4; ++c) {
        __syncthreads();
#pragma unroll
        for (int k = 0; k < 8; ++k) { const int pc = tid + 512 * k, r = pc >> 6, c16 = pc & 63;
            *(LAS v4u*)(LW + r * 1040 + c16 * 16) = *(const v4u*)(W1T + (size_t)r * 2048 + c * 512 + c16 * 8); }
        __syncthreads();
#pragma unroll 8
        for (int kk = 0; kk < 16; ++kk) {
            const int j = 8 * c + (kk >> 1), dim0 = (kk & 1) * 32 + quad * 8;
            const f32x4 pe0 = *(const f32x4*)(pe + j * 64 + dim0), pe1 = *(const f32x4*)(pe + j * 64 + dim0 + 4);
            bf16x8 xb[2];
#pragma unroll
            for (int tl = 0; tl < 2; ++tl) {
                f32x4 x0, x1;
                if (!sample) { const size_t row = (size_t)bs * TP + 16 * nn[tl] + j; unpack8(*(const v4u*)(Z + row * LDZ + ZC_KC + kv * 128 + gg[tl] * 64 + dim0), x0, x1); }
                else { int pos = 16 * nn[tl] + j; pos = pos > 2047 ? 2047 : pos;
                    const float* p = cache + (((pos >> 7) == ((16 * nn[tl]) >> 7)) ? pb0[tl] : pb1[tl]) + (size_t)(pos & 127) * 512 + kv * 128 + gg[tl] * 64 + dim0; x0 = *(const f32x4*)p; x1 = *(const f32x4*)(p + 4); }
                xb[tl] = pack_frag(x0 + pe0, x1 + pe1);
            }
#pragma unroll
            for (int ht = 0; ht < 4; ++ht) {
                const bf16x8 a = ld_frag_l(LW + (16 * ht + rl) * 1040 + (kk * 32 + quad * 8) * 2);
                h[0][ht] = mfma16(a, xb[0], h[0][ht]); h[1][ht] = mfma16(a, xb[1], h[1][ht]);
            }
        }
    }
#pragma unroll
    for (int tl = 0; tl < 2; ++tl) {
#pragma unroll
        for (int ht = 0; ht < 4; ++ht)
#pragma unroll
            for (int i = 0; i < 4; ++i) h[tl][ht][i] = gelu_tanh(h[tl][ht][i]);
        bf16x8 gb[2]; gb[0] = pack_frag(h[tl][0], h[tl][1]); gb[1] = pack_frag(h[tl][2], h[tl][3]);
        const int n = nn[tl], g = gg[tl];
        bf16* dst = sample ? (bf16*)(ws + WS_KCS) + ((((size_t)kv * 128 + bs) * 128 + n) * 2 + g) * 64 : (bf16*)(ws + WS_KC) + ((((size_t)kv * 2 + bs) * 512 + n) * 2 + g) * 64;
        const bool zero = sample && n == 127;
#pragma unroll
        for (int ot = 0; ot < 4; ++ot) {
            f32x4 o = (f32x4){0.f, 0.f, 0.f, 0.f};
#pragma unroll
            for (int s = 0; s < 2; ++s) {
                const bf16* wp = W2T + (16 * ot + rl) * 64 + 32 * s + 4 * quad;
                o = mfma16(mk_frag(*(const v2u*)wp, *(const v2u*)(wp + 16)), gb[s], o);
            }
            v2u w; w.x = zero ? 0u : pk2(o[0], o[1]); w.y = zero ? 0u : pk2(o[2], o[3]);
            *(v2u*)(dst + 16 * ot + 4 * quad) = w;
        }
    }
    __syncthreads();
}

DI v2u pack4(const f32x4 v) { v2u w; w.x = pk2(v[0], v[1]); w.y = pk2(v[2], v[3]); return w; }
DI void compress_sample_job(Frame& F, int layer, int job) {
    int lane = F.lane, wave = F.wave; asm volatile("" : "+v"(lane), "+s"(wave));
    const int tid = wave * 64 + lane, quad = lane >> 4, rl = lane & 15;
    unsigned char* ws = KWS();
    const int kv = job >> 7, bs = job & 127;
    const bf16* W1T = (const bf16*)(ws + WS_W1T + layer * SZ_W1T) + (size_t)kv * 64 * 2048;
    const bf16* W2T = (const bf16*)(ws + WS_W2T + layer * SZ_W2T) + (size_t)kv * 64 * 64;
    const float* pe = KIN(12) + (size_t)(layer * 2 + kv) * 32 * 64;
    const int* pt = (const int*)KIN(7);
    const float* cache = KIN(2);
    LAS unsigned char* XS = F.lds;
    LAS unsigned char* WS1 = F.lds + 69632;
    size_t toff[8];
#pragma unroll
    for (int k = 0; k < 8; ++k) { const int q = tid + 512 * k, m = q >> 5; const int pos = 16 * m; const int phys = pt[bs * 16 + (pos >> 7)];
        toff[k] = ((size_t)(layer * 2560 + phys) * 128 + (pos & 127)) * 512 + kv * 128 + 4 * (q & 31); }
    const int wr_ = tid >> 3, wc_ = tid & 7;
    int gg[2], nn[2];
#pragma unroll
    for (int tl = 0; tl < 2; ++tl) { const int T = 2 * wave + tl; gg[tl] = T >> 3; nn[tl] = 16 * (T & 7) + rl; }
    f32x4 h[2][4];
#pragma unroll
    for (int tl = 0; tl < 2; ++tl)
#pragma unroll
        for (int i = 0; i < 4; ++i) h[tl][i] = (f32x4){0.f, 0.f, 0.f, 0.f};
    f32x4 xr[8]; v4u wr2[2];
#define CS_ISSUE(r_) do { _Pragma("unroll") for (int k = 0; k < 8; ++k) xr[k] = *(const f32x4*)(cache + toff[k] + (size_t)(r_) * 512); \
        _Pragma("unroll") for (int u = 0; u < 2; ++u) wr2[u] = *(const v4u*)(W1T + (size_t)wr_ * 2048 + ((r_) + 16 * u) * 64 + wc_ * 8); } while (0)
    CS_ISSUE(0);
#pragma unroll 1
    for (int r = 0; r < 16; ++r) {
        __syncthreads();
#pragma unroll
        for (int k = 0; k < 8; ++k) { const int q = tid + 512 * k, m = q >> 5, c = q & 31, d = 4 * (c & 15);
#pragma unroll
            for (int u = 0; u < 2; ++u) { const f32x4 v = xr[k] + *(const f32x4*)(pe + (r + 16 * u) * 64 + d);
                *(LAS v2u*)(XS + u * 34816 + m * 272 + c * 8) = pack4(v); } }
#pragma unroll
        for (int u = 0; u < 2; ++u) *(LAS v4u*)(WS1 + u * 9216 + wr_ * 144 + wc_ * 16) = wr2[u];
        __syncthreads();
        { const int rn = r + 1 < 16 ? r + 1 : 15; CS_ISSUE(rn); }
#pragma unroll
        for (int u = 0; u < 2; ++u)
#pragma unroll
            for (int ks = 0; ks < 2; ++ks) {
                bf16x8 xb[2];
#pragma unroll
                for (int tl = 0; tl < 2; ++tl) { int m = nn[tl] + u; m = m > 127 ? 127 : m; xb[tl] = ld_frag_l(XS + u * 34816 + m * 272 + gg[tl] * 128 + ks * 64 + quad * 16); }
#pragma unroll
                for (int ht = 0; ht < 4; ++ht) { const bf16x8 a = ld_frag_l(WS1 + u * 9216 + (16 * ht + rl) * 144 + ks * 64 + quad * 16);
                    h[0][ht] = mfma16(a, xb[0], h[0][ht]); h[1][ht] = mfma16(a, xb[1], h[1][ht]); }
            }
    }
#undef CS_ISSUE
#pragma unroll
    for (int tl = 0; tl < 2; ++tl) {
#pragma unroll
        for (int ht = 0; ht < 4; ++ht)
#pragma unroll
            for (int i = 0; i < 4; ++i) h[tl][ht][i] = gelu_tanh(h[tl][ht][i]);
        bf16x8 gb[2]; gb[0] = pack_frag(h[tl][0], h[tl][1]); gb[1] = pack_frag(h[tl][2], h[tl][3]);
        const int n = nn[tl], g = gg[tl];
        bf16* dst = (bf16*)(ws + WS_KCS) + ((((size_t)kv * 128 + bs) * 128 + n) * 2 + g) * 64;
        const bool zero = n == 127;
#pragma unroll
        for (int ot = 0; ot < 4; ++ot) {
            f32x4 o = (f32x4){0.f, 0.f, 0.f, 0.f};
#pragma unroll
            for (int s = 0; s < 2; ++s) {
                const bf16* wp = W2T + (16 * ot + rl) * 64 + 32 * s + 4 * quad;
                o = mfma16(mk_frag(*(const v2u*)wp, *(const v2u*)(wp + 16)), gb[s], o);
            }
            v2u w; w.x = zero ? 0u : pk2(o[0], o[1]); w.y = zero ? 0u : pk2(o[2], o[3]);
            *(v2u*)(dst + 16 * ot + 4 * quad) = w;
        }
    }
    __syncthreads();
}
DI void compress_job(Frame& F, int layer, int job) { if (job < 256) compress_sample_job(F, layer, job); else compress_job_t<false>(F, layer, job); }
#ifndef PH_GPT
#define PH_GPT (-1)
#endif
#if PH_GPT >= 0
#define GP_T(k) do { if (tid == 0) { volatile LAS unsigned long long* gp_ = (volatile LAS unsigned long long*)(F.lds + LDSCTL_OFF + 448); const unsigned long long now_ = __builtin_amdgcn_s_memrealtime(); \
    if ((k) == PH_GPT) gp_[0] += now_ - gp_[1]; gp_[1] = now_; } } while (0)
#else
#define GP_T(k) do { } while (0)
#endif
DI int kperm(int idx) { const int s = idx >> 5, r = idx & 31; return 32 * s + 8 * ((r >> 2) & 3) + 4 * (r >> 4) + (r & 3); }
DI float softplusf_(float x) { return x > 20.f ? x : __logf(1.f + __expf(x)); }
DI float ret_lg(int h) { return h == 0 ? -0.031748697f : h == 1 ? -0.015748357f : h == 2 ? -0.007843178f : -0.0039138994f; }

DI void gdn_prep_unit(Frame& F, int layer, int unit) {
    int lane = F.lane, wave = F.wave; asm volatile("" : "+v"(lane), "+s"(wave));
    const int tid = wave * 64 + lane;
    const int b = unit >> 9, h = (unit >> 7) & 3, c = unit & 127;
    const int row0 = b * TP + 64 * c, t0 = 64 * c;
    GP_T(0);
    unsigned char* ws = KWS();
    const bf16* Z = (const bf16*)(ws + WS_Z);
    const float* ZS = (const float*)(ws + WS_ZS);
    LAS float* Lq = (LAS float*)(F.lds); LAS float* Lk = (LAS float*)(F.lds + 33792); LAS float* Lv = (LAS float*)(F.lds + 67584);
    LAS float* LA = (LAS float*)(F.lds + 101376); LAS float* LQK = (LAS float*)(F.lds + 117760);
    LAS float* Lg = (LAS float*)(F.lds + 134144); LAS float* Lb = Lg + 64; LAS float* Le = Lg + 128;
    const float* cw = KIN(15) + (size_t)layer * 4 * 1536;
    {
        v4u xs[6][4];
#pragma unroll
        for (int it0 = 0; it0 < 6; ++it0) {
            const int it = tid + it0 * NTHREADS, i = it / 48, ch = it % 48, col = (ch >> 4) * 512 + h * 128 + (ch & 15) * 8;
#pragma unroll
            for (int j = 0; j < 4; ++j) { const bool ok = (t0 + i - 3 + j) >= 0; xs[it0][j] = *(const v4u*)(Z + (size_t)(ok ? row0 + i - 3 + j : row0) * LDZ + ZC_GQKV + col); }
        }
        asm volatile("" ::: "memory");
#pragma unroll
        for (int it0 = 0; it0 < 6; ++it0) {
            const int it = tid + it0 * NTHREADS, i = it / 48, ch = it % 48, part = ch >> 4, cc = ch & 15;
            const int col = part * 512 + h * 128 + cc * 8;
            f32x4 y0 = (f32x4){0.f, 0.f, 0.f, 0.f}, y1 = y0;
#pragma unroll
            for (int j = 0; j < 4; ++j) {
                const float zf = ((t0 + i - 3 + j) >= 0) ? 1.f : 0.f;
                f32x4 x0, x1; unpack8(xs[it0][j], x0, x1);
                y0 += x0 * (*(const f32x4*)(cw + j * 1536 + col) * zf); y1 += x1 * (*(const f32x4*)(cw + j * 1536 + col + 4) * zf);
            }
#pragma unroll
            for (int e = 0; e < 4; ++e) { y0[e] = siluf_(y0[e]); y1[e] = siluf_(y1[e]); }
            LAS float* dst = (part == 0 ? Lq : part == 1 ? Lk : Lv) + i * 132 + cc * 8;
            *(LAS f32x4*)dst = y0; *(LAS f32x4*)(dst + 4) = y1;
        }
    }
    __syncthreads();
    GP_T(1);
    {
        float va[16], vb[16], ps[16];
#pragma unroll
        for (int q = 0; q < 16; ++q) { LAS float* vp = ((q < 8) ? Lq : Lk) + (wave * 8 + (q & 7)) * 132 + lane * 2; va[q] = vp[0]; vb[q] = vp[1]; ps[q] = va[q] * va[q] + vb[q] * vb[q]; }
#pragma unroll
        for (int q = 0; q < 16; ++q) ps[q] += shx<1>(ps[q], lane);
#pragma unroll
        for (int q = 0; q < 16; ++q) ps[q] += shx<2>(ps[q], lane);
#pragma unroll
        for (int q = 0; q < 16; ++q) ps[q] += shx<4>(ps[q], lane);
#pragma unroll
        for (int q = 0; q < 16; ++q) ps[q] += shx<8>(ps[q], lane);
#pragma unroll
        for (int q = 0; q < 16; ++q) ps[q] += shx<16>(ps[q], lane);
#pragma unroll
        for (int q = 0; q < 16; ++q) ps[q] += shx<32>(ps[q], lane);
#pragma unroll
        for (int q = 0; q < 16; ++q) { LAS float* vp = ((q < 8) ? Lq : Lk) + (wave * 8 + (q & 7)) * 132 + lane * 2; const float sc = rsqrtf(ps[q] + EPS) * ((q < 8) ? 0.08838834764831845f : 1.f); vp[0] = va[q] * sc; vp[1] = vb[q] * sc; }
    }
    if (wave == 0) {
        const float ga = ZS[(size_t)(row0 + lane) * 32 + 24 + h], gbv = ZS[(size_t)(row0 + lane) * 32 + 28 + h];
        float g = -__expf(KIN(16)[layer * 4 + h]) * softplusf_(ga + KIN(17)[layer * 4 + h]);
#pragma unroll
        for (int o = 1; o < 64; o <<= 1) { const float t = __int_as_float(__builtin_amdgcn_ds_bpermute(((lane - o) & 63) << 2, __float_as_int(g))); if (lane >= o) g += t; }
        Lg[lane] = g; Lb[lane] = sigmoidf_(gbv); Le[lane] = __expf(g);
    }
    __syncthreads();
    GP_T(2);
    {
        const int it = wave >> 1, quad = lane >> 4, rl = lane & 15;
        f32x4 ckk[2], cqk[2];
#pragma unroll
        for (int jj = 0; jj < 2; ++jj) { ckk[jj] = (f32x4){0.f, 0.f, 0.f, 0.f}; cqk[jj] = ckk[jj]; }
#pragma unroll
        for (int s = 0; s < 4; ++s) {
            const LAS float* kp = Lk + (16 * it + rl) * 132 + 32 * s + 8 * quad; const LAS float* qp = Lq + (16 * it + rl) * 132 + 32 * s + 8 * quad;
            const f32x4 ka0 = *(const LAS f32x4*)kp, ka1 = *(const LAS f32x4*)(kp + 4), qa0 = *(const LAS f32x4*)qp, qa1 = *(const LAS f32x4*)(qp + 4);
            const bf16x8 kah = pack_frag(ka0, ka1), qah = pack_frag(qa0, qa1);
            f32x4 h0, h1; unpack8(__builtin_bit_cast(v4u, kah), h0, h1); const bf16x8 kal = pack_frag(ka0 - h0, ka1 - h1);
            unpack8(__builtin_bit_cast(v4u, qah), h0, h1); const bf16x8 qal = pack_frag(qa0 - h0, qa1 - h1);
#pragma unroll
            for (int jj = 0; jj < 2; ++jj) {
                const int jt = (wave & 1) * 2 + jj;
                if (jt <= it) {
                    const LAS float* bp = Lk + (16 * jt + rl) * 132 + 32 * s + 8 * quad;
                    const f32x4 kb0 = *(const LAS f32x4*)bp, kb1 = *(const LAS f32x4*)(bp + 4);
                    const bf16x8 kbh = pack_frag(kb0, kb1); unpack8(__builtin_bit_cast(v4u, kbh), h0, h1); const bf16x8 kbl = pack_frag(kb0 - h0, kb1 - h1);
                    ckk[jj] = mfma16(kah, kbh, ckk[jj]); ckk[jj] = mfma16(kah, kbl, ckk[jj]); ckk[jj] = mfma16(kal, kbh, ckk[jj]);
                    cqk[jj] = mfma16(qah, kbh, cqk[jj]); cqk[jj] = mfma16(qah, kbl, cqk[jj]); cqk[jj] = mfma16(qal, kbh, cqk[jj]);
                }
            }
        }
#pragma unroll
        for (int jj = 0; jj < 2; ++jj) {
            const int j = 16 * ((wave & 1) * 2 + jj) + rl; const float gj = Lg[j];
#pragma unroll
            for (int e = 0; e < 4; ++e) { const int i = 16 * it + 4 * quad + e; const float dec = (i >= j) ? __expf(Lg[i] - gj) : 0.f;
                LA[i * 64 + j] = (i > j) ? Lb[i] * ckk[jj][e] * dec : 0.f; LQK[i * 64 + j] = cqk[jj][e] * dec; }
        }
    }
    __syncthreads();
    GP_T(3);
    unsigned char* rec = ws + WS_GREC + (size_t)unit * GREC;
    LAS float* TI = (LAS float*)(F.lds + 135168);
    if (tid < 64) {
        const int B = tid >> 4, c = tid & 15;
        float tc[16];
#pragma unroll
        for (int i = 0; i < 16; ++i) {
            float s0 = (i == c) ? 1.f : 0.f;
#pragma unroll
            for (int j = 0; j < i; ++j) s0 -= LA[(16 * B + i) * 64 + 16 * B + j] * tc[j];
            tc[i] = s0;
        }
#pragma unroll
        for (int i = 0; i < 16; ++i) TI[B * 256 + i * 16 + c] = tc[i];
    }
    {
        const float gl = Lg[63];
        for (int it = tid; it < 2560; it += NTHREADS) {
            if (it < 1024) {
                const int i = it >> 4, s = (it >> 2) & 3, quad = it & 3; const float e = Le[i];
                const f32x4 a = *(const LAS f32x4*)(Lq + i * 132 + 32 * s + 4 * quad) * e, bq = *(const LAS f32x4*)(Lq + i * 132 + 32 * s + 16 + 4 * quad) * e;
                *(v4u*)(rec + 16384 + i * 256 + (32 * s + 8 * quad) * 2) = pack8(a, bq);
            } else if (it < 2048) {
                const int r = it - 1024, dk = r >> 3, s2 = (r >> 2) & 1, quad = r & 3;
                f32x4 a, bq;
#pragma unroll
                for (int e = 0; e < 4; ++e) { const int ta = 32 * s2 + 4 * quad + e, tb = ta + 16; a[e] = Lk[ta * 132 + dk] * __expf(gl - Lg[ta]); bq[e] = Lk[tb * 132 + dk] * __expf(gl - Lg[tb]); }
                *(v4u*)(rec + 32768 + dk * 128 + (32 * s2 + 8 * quad) * 2) = pack8(a, bq);
            } else {
                const int r = it - 2048, i = r >> 3, s2 = (r >> 2) & 1, quad = r & 3;
                const f32x4 a = *(const LAS f32x4*)(LQK + i * 64 + 32 * s2 + 4 * quad), bq = *(const LAS f32x4*)(LQK + i * 64 + 32 * s2 + 16 + 4 * quad);
                *(v4u*)(rec + 65536 + i * 128 + (32 * s2 + 8 * quad) * 2) = pack8(a, bq);
            }
        }
        if (tid == 0) *(float*)(rec + 73728) = __expf(gl);
    }
    __syncthreads();
    GP_T(4);
    {
        const int col = tid & 255, hb = tid >> 8;
        LAS float* X = (col < 128) ? (Lv + col) : (Lk + (col - 128));
        const bool isw = col >= 128;
#pragma unroll 1
        for (int B = 0; B < 4; ++B) {
            float xb[8];
#pragma unroll
            for (int i = 0; i < 8; ++i) { const int r = 16 * B + 8 * hb + i; xb[i] = (isw ? Lb[r] * Le[r] : Lb[r]) * X[r * 132]; }
#pragma unroll 2
            for (int j4 = 0; j4 < 4 * B; ++j4) {
                const float x0 = X[(4 * j4) * 132], x1 = X[(4 * j4 + 1) * 132], x2 = X[(4 * j4 + 2) * 132], x3 = X[(4 * j4 + 3) * 132];
#pragma unroll
                for (int i = 0; i < 8; ++i) { const f32x4 a = *(const LAS f32x4*)(LA + (16 * B + 8 * hb + i) * 64 + 4 * j4); xb[i] -= (a[0] * x0 + a[1] * x1) + (a[2] * x2 + a[3] * x3); }
            }
#pragma unroll
            for (int i = 0; i < 8; ++i) X[(16 * B + 8 * hb + i) * 132] = xb[i];
            __syncthreads();
            float r[16];
#pragma unroll
            for (int jj = 0; jj < 16; ++jj) r[jj] = X[(16 * B + jj) * 132];
            __syncthreads();
#pragma unroll
            for (int i = 0; i < 8; ++i) {
                float s0 = 0.f, s1 = 0.f;
#pragma unroll
                for (int j4 = 0; j4 < 4; ++j4) { const f32x4 a = *(const LAS f32x4*)(TI + B * 256 + (8 * hb + i) * 16 + 4 * j4);
                    s0 += a[0] * r[4 * j4] + a[2] * r[4 * j4 + 2]; s1 += a[1] * r[4 * j4 + 1] + a[3] * r[4 * j4 + 3]; }
                X[(16 * B + 8 * hb + i) * 132] = s0 + s1;
            }
            __syncthreads();
        }
    }
    __syncthreads();
    GP_T(5);
    for (int it = tid; it < 2048; it += NTHREADS) {
        if (it < 1024) {
            const int dv = it >> 3, q = it & 7;
            v4u w; w.x = pk2(Lv[(8 * q) * 132 + dv], Lv[(8 * q + 1) * 132 + dv]); w.y = pk2(Lv[(8 * q + 2) * 132 + dv], Lv[(8 * q + 3) * 132 + dv]);
            w.z = pk2(Lv[(8 * q + 4) * 132 + dv], Lv[(8 * q + 5) * 132 + dv]); w.w = pk2(Lv[(8 * q + 6) * 132 + dv], Lv[(8 * q + 7) * 132 + dv]);
            *(v4u*)(rec + 49152 + dv * 128 + q * 16) = w;
        } else {
            const int r = it - 1024, i = r >> 4, s = (r >> 2) & 3, quad = r & 3;
            const f32x4 a = *(const LAS f32x4*)(Lk + i * 132 + 32 * s + 4 * quad), bq = *(const LAS f32x4*)(Lk + i * 132 + 32 * s + 16 + 4 * quad);
            *(v4u*)(rec + i * 256 + (32 * s + 8 * quad) * 2) = pack8(a, bq);
        }
    }
    __syncthreads();
    GP_T(6);
}

DI void ret_prep_unit(Frame& F, int layer, int unit) {
    int lane = F.lane, wave = F.wave; asm volatile("" : "+v"(lane), "+s"(wave));
    const int tid = wave * 64 + lane, quad = lane >> 4, rl = lane & 15;
    const int b = unit >> 8, h = (unit >> 6) & 3, c = unit & 63;
    const int row0 = b * TP + 128 * c;
    unsigned char* ws = KWS();
    const bf16* Z = (const bf16*)(ws + WS_Z);
    const f32x2* ROT = (const f32x2*)(ws + WS_ROT);
    bf16* QR = (bf16*)(ws + WS_QR); bf16* KR = (bf16*)(ws + WS_KR);
    LAS unsigned char* LK = F.lds; LAS unsigned char* LV = F.lds + 34816;
    const float lg = ret_lg(h);
    for (int it = tid; it < 1024; it += NTHREADS) {
        const int j = it >> 3, cc = it & 7, d0 = cc * 8;
        const size_t zr = (size_t)(row0 + j) * LDZ + ZC_RQKV + h * 128 + d0;
        f32x4 q1a, q1b, q2a, q2b, k1a, k1b, k2a, k2b;
        unpack8(*(const v4u*)(Z + zr), q1a, q1b); unpack8(*(const v4u*)(Z + zr + 64), q2a, q2b);
        unpack8(*(const v4u*)(Z + zr + 512), k1a, k1b); unpack8(*(const v4u*)(Z + zr + 512 + 64), k2a, k2b);
        const f32x2* rp = ROT + (size_t)(128 * c + j) * 64 + d0;
        const float kd = __expf((float)(127 - j) * lg);
        f32x4 oq1a, oq1b, oq2a, oq2b, ok1a, ok1b, ok2a, ok2b;
#pragma unroll
        for (int e = 0; e < 8; ++e) {
            const f32x2 cs = rp[e];
            const float q1 = e < 4 ? q1a[e & 3] : q1b[e & 3], q2 = e < 4 ? q2a[e & 3] : q2b[e & 3], k1 = e < 4 ? k1a[e & 3] : k1b[e & 3], k2 = e < 4 ? k2a[e & 3] : k2b[e & 3];
            const float rq1 = q1 * cs.x - q2 * cs.y, rq2 = q2 * cs.x + q1 * cs.y, rk1 = (k1 * cs.x - k2 * cs.y) * 0.08838834764831845f, rk2 = (k2 * cs.x + k1 * cs.y) * 0.08838834764831845f;
            if (e < 4) { oq1a[e & 3] = rq1; oq2a[e & 3] = rq2; ok1a[e & 3] = rk1; ok2a[e & 3] = rk2; } else { oq1b[e & 3] = rq1; oq2b[e & 3] = rq2; ok1b[e & 3] = rk1; ok2b[e & 3] = rk2; }
            *(LAS bf16*)(LK + (d0 + e) * 272 + j * 2) = (bf16)f2bf(rk1 * kd); *(LAS bf16*)(LK + (d0 + 64 + e) * 272 + j * 2) = (bf16)f2bf(rk2 * kd);
        }
        const size_t orow = (size_t)(row0 + j) * 512 + h * 128 + d0;
        *(v4u*)(QR + orow) = pack8(oq1a, oq1b); *(v4u*)(QR + orow + 64) = pack8(oq2a, oq2b);
        *(v4u*)(KR + orow) = pack8(ok1a, ok1b); *(v4u*)(KR + orow + 64) = pack8(ok2a, ok2b);
    }
    for (int it = tid; it < 2048; it += NTHREADS) {
        const int j = it >> 4, cc = it & 15;
        const v4u w = *(const v4u*)(Z + (size_t)(row0 + j) * LDZ + ZC_RQKV + 1024 + h * 128 + cc * 8);
        LAS unsigned char* d = LV + (cc * 8) * 272 + j * 2;
        *(LAS bf16*)(d) = (bf16)(w.x & 0xffff); *(LAS bf16*)(d + 272) = (bf16)(w.x >> 16); *(LAS bf16*)(d + 2 * 272) = (bf16)(w.y & 0xffff); *(LAS bf16*)(d + 3 * 272) = (bf16)(w.y >> 16);
        *(LAS bf16*)(d + 4 * 272) = (bf16)(w.z & 0xffff); *(LAS bf16*)(d + 5 * 272) = (bf16)(w.z >> 16); *(LAS bf16*)(d + 6 * 272) = (bf16)(w.w & 0xffff); *(LAS bf16*)(d + 7 * 272) = (bf16)(w.w >> 16);
    }
    __syncthreads();
    float* RKV = (float*)(ws + WS_RKV) + (size_t)unit * 16384;
#pragma unroll
    for (int nt = 0; nt < 8; ++nt) {
        f32x4 acc = (f32x4){0.f, 0.f, 0.f, 0.f};
#pragma unroll
        for (int s = 0; s < 4; ++s) acc = mfma16(ld_frag_l(LK + (16 * wave + rl) * 272 + (32 * s + 8 * quad) * 2), ld_frag_l(LV + (16 * nt + rl) * 272 + (32 * s + 8 * quad) * 2), acc);
#pragma unroll
        for (int i = 0; i < 4; ++i) RKV[(size_t)(16 * wave + 4 * quad + i) * 128 + 16 * nt + rl] = acc[i];
    }
    __syncthreads();
}
DI void sample_rec_unit(Frame& F, int layer, int unit) {
    int lane = F.lane, wave = F.wave; asm volatile("" : "+v"(lane), "+s"(wave));
    const int tid = wave * 64 + lane;
    const int kind = unit >> 9, s = (unit >> 2) & 127, h = unit & 3;
    const int dv = tid & 127, part = tid >> 7, r0 = MP + 4 * s;
    unsigned char* ws = KWS();
    const bf16* Z = (const bf16*)(ws + WS_Z);
    const float* ZS = (const float*)(ws + WS_ZS);
    LAS float* Lq = (LAS float*)(F.lds); LAS float* Lk = Lq + 512; LAS float* Lv = Lq + 1024; LAS float* red = Lq + 1536; LAS float* Lo = Lq + 2048; LAS float* sc = Lq + 2560;
    float S[32];
    if (kind == 0) {
        if (tid < 384) {
            const int pr = tid >> 7, d = tid & 127, col = pr * 512 + h * 128 + d;
            float xp[7], w[4];
#pragma unroll
            for (int i = 0; i < 3; ++i) xp[i] = KIN(4)[((size_t)(layer * 128 + s) * 3 + i) * 1536 + col];
#pragma unroll
            for (int j = 0; j < 4; ++j) xp[3 + j] = bf2f(Z[(size_t)(r0 + j) * LDZ + ZC_GQKV + col]);
#pragma unroll
            for (int i = 0; i < 4; ++i) w[i] = KIN(15)[(size_t)(layer * 4 + i) * 1536 + col];
            LAS float* dst = pr == 0 ? Lq : pr == 1 ? Lk : Lv;
#pragma unroll
            for (int j = 0; j < 4; ++j) dst[j * 128 + d] = siluf_(w[0] * xp[j] + w[1] * xp[j + 1] + w[2] * xp[j + 2] + w[3] * xp[j + 3]);
        }
        __syncthreads();
        {
            LAS float* vp = (wave < 4 ? Lq : Lk) + (wave & 3) * 128;
            const float a = vp[2 * lane], b = vp[2 * lane + 1];
            const float scl = rsqrtf(wave_sum(a * a + b * b, lane) + EPS) * (wave < 4 ? 0.08838834764831845f : 1.f);
            vp[2 * lane] = a * scl; vp[2 * lane + 1] = b * scl;
        }
        if (tid < 4) {
            const float ga = ZS[(size_t)(r0 + tid) * 32 + 24 + h], gb = ZS[(size_t)(r0 + tid) * 32 + 28 + h];
            sc[tid] = __expf(-__expf(KIN(16)[layer * 4 + h]) * softplusf_(ga + KIN(17)[layer * 4 + h])); sc[4 + tid] = sigmoidf_(gb);
        }
        __syncthreads();
        const float* Sin = KIN(5) + ((size_t)((layer * 128 + s) * 4 + h) * 128 + 32 * part) * 128 + dv;
#pragma unroll
        for (int i = 0; i < 32; ++i) S[i] = Sin[(size_t)i * 128];
#pragma unroll
        for (int j = 0; j < 4; ++j) {
            const float a = sc[j], beta = sc[4 + j];
            float p = 0.f;
#pragma unroll
            for (int i = 0; i < 32; ++i) { S[i] *= a; p += Lk[j * 128 + 32 * part + i] * S[i]; }
            red[part * 128 + dv] = p;
            __syncthreads();
            const float delta = beta * (Lv[j * 128 + dv] - ((red[dv] + red[128 + dv]) + (red[256 + dv] + red[384 + dv])));
            __syncthreads();
            float o = 0.f;
#pragma unroll
            for (int i = 0; i < 32; ++i) { S[i] += Lk[j * 128 + 32 * part + i] * delta; o += Lq[j * 128 + 32 * part + i] * S[i]; }
            red[part * 128 + dv] = o;
            __syncthreads();
            if (part == 0) Lo[j * 128 + dv] = (red[dv] + red[128 + dv]) + (red[256 + dv] + red[384 + dv]);
            __syncthreads();
        }
        float* Sout = KOUT() + O_GSS + ((size_t)((layer * 128 + s) * 4 + h) * 128 + 32 * part) * 128 + dv;
#pragma unroll
        for (int i = 0; i < 32; ++i) Sout[(size_t)i * 128] = S[i];
        ((float*)(ws + WS_OGDN))[(size_t)(r0 + part) * 512 + h * 128 + dv] = Lo[part * 128 + dv];
    } else {
        const f32x2* ROT = (const f32x2*)(ws + WS_ROT);
        if (tid < 384) {
            const int pr = tid >> 7, d = tid & 127;
#pragma unroll
            for (int j = 0; j < 4; ++j) {
                const bf16* zp = Z + (size_t)(r0 + j) * LDZ + ZC_RQKV + pr * 512 + h * 128;
                float v = bf2f(zp[d]);
                if (pr < 2) { const f32x2 cs = ROT[(size_t)(2048 + j) * 64 + (d & 63)]; const float o = bf2f(zp[d ^ 64]);
                    v = (d < 64) ? v * cs.x - o * cs.y : v * cs.x + o * cs.y; if (pr == 1) v *= 0.08838834764831845f; }
                (pr == 0 ? Lq : pr == 1 ? Lk : Lv)[j * 128 + d] = v;
            }
        }
        __syncthreads();
        const float gam = __expf(ret_lg(h));
        const float* Sin = KIN(6) + ((size_t)((layer * 128 + s) * 4 + h) * 128 + 32 * part) * 128 + dv;
#pragma unroll
        for (int i = 0; i < 32; ++i) S[i] = Sin[(size_t)i * 128];
#pragma unroll
        for (int j = 0; j < 4; ++j) {
            const float vv = Lv[j * 128 + dv];
            float o = 0.f;
#pragma unroll
            for (int i = 0; i < 32; ++i) { S[i] = S[i] * gam + Lk[j * 128 + 32 * part + i] * vv; o += Lq[j * 128 + 32 * part + i] * S[i]; }
            red[part * 128 + dv] = o;
            __syncthreads();
            if (part == 0) Lo[j * 128 + dv] = (red[dv] + red[128 + dv]) + (red[256 + dv] + red[384 + dv]);
            __syncthreads();
        }
        float* Sout = KOUT() + O_RSS + ((size_t)((layer * 128 + s) * 4 + h) * 128 + 32 * part) * 128 + dv;
#pragma unroll
        for (int i = 0; i < 32; ++i) Sout[(size_t)i * 128] = S[i];
        if (wave < 4) {
            const int j = wave; const float a = Lo[j * 128 + 2 * lane], b = Lo[j * 128 + 2 * lane + 1];
            const float scl = rsqrtf(wave_sum(a * a + b * b, lane) * (1.f / 128.f) + EPS);
            const bf16* gp = Z + (size_t)(r0 + j) * LDZ + ZC_RG + h * 128 + 2 * lane;
            *(unsigned*)((bf16*)(ws + WS_MIX) + (size_t)(r0 + j) * 1536 + 1024 + h * 128 + 2 * lane) = pk2(a * scl * siluf_(bf2f(gp[0])), b * scl * siluf_(bf2f(gp[1])));
        }
    }
    __syncthreads();
}

DI void gdn_scan_chain(Frame& F, int layer, int bh) {
    int lane = F.lane, wave = F.wave; asm volatile("" : "+v"(lane), "+s"(wave));
    const int tid = wave * 64 + lane, quad = lane >> 4, rl = lane & 15;
    unsigned char* ws = KWS();
    const unsigned char* recb = ws + WS_GREC + (size_t)bh * 128 * GREC;
    LAS unsigned char* L = F.lds;
    constexpr int L_WP = 0, L_QP = 17408, L_KT = 34816, L_UT = 53248, L_QK = 71680;
    f32x4 S[8];
#pragma unroll
    for (int i = 0; i < 8; ++i) S[i] = (f32x4){0.f, 0.f, 0.f, 0.f};
    v4u pf[9]; float egl;
#pragma unroll
    for (int k = 0; k < 9; ++k) pf[k] = *(const v4u*)(recb + (size_t)(tid + 512 * k) * 16);
    egl = *(const float*)(recb + 73728);
    float* OG = (float*)(ws + WS_OGDN);
    const int b = bh >> 2, h = bh & 3;
    for (int c = 0; c < 128; ++c) {
        __syncthreads();
#pragma unroll
        for (int k = 0; k < 9; ++k) {
            const int o = tid * 16 + (k & 1) * 8192;
            const int reg = k >> 1;
            int dst;
            if (reg < 2) dst = (reg == 0 ? L_WP : L_QP) + (o >> 8) * 272 + (o & 255);
            else dst = (reg == 2 ? L_KT : reg == 3 ? L_UT : L_QK) + (o >> 7) * 144 + (o & 127);
            *(LAS v4u*)(L + dst) = pf[k];
        }
        const float eg = egl;
        __syncthreads();
        {
            const unsigned char* rn = recb + (size_t)(c + 1 < 128 ? c + 1 : 127) * GREC;
#pragma unroll
            for (int k = 0; k < 9; ++k) pf[k] = *(const v4u*)(rn + (size_t)(tid + 512 * k) * 16);
            egl = *(const float*)(rn + 73728);
        }
        bf16x8 Sb[4];
#pragma unroll
        for (int s = 0; s < 4; ++s) Sb[s] = pack_frag(S[2 * s], S[2 * s + 1]);
        f32x4 vn[4], O[4];
#pragma unroll
        for (int rt = 0; rt < 4; ++rt) {
            f32x4 wsacc = (f32x4){0.f, 0.f, 0.f, 0.f}, o = wsacc;
#pragma unroll
            for (int s = 0; s < 4; ++s) {
                wsacc = mfma16(ld_frag_l(L + L_WP + (16 * rt + rl) * 272 + (32 * s + 8 * quad) * 2), Sb[s], wsacc);
                o = mfma16(ld_frag_l(L + L_QP + (16 * rt + rl) * 272 + (32 * s + 8 * quad) * 2), Sb[s], o);
            }
            const v2u uw = *(const LAS v2u*)(L + L_UT + (16 * wave + rl) * 144 + (16 * rt + 4 * quad) * 2);
            vn[rt][0] = lo_bf(uw.x) - wsacc[0]; vn[rt][1] = hi_bf(uw.x) - wsacc[1]; vn[rt][2] = lo_bf(uw.y) - wsacc[2]; vn[rt][3] = hi_bf(uw.y) - wsacc[3];
            O[rt] = o;
        }
        bf16x8 Vb[2]; Vb[0] = pack_frag(vn[0], vn[1]); Vb[1] = pack_frag(vn[2], vn[3]);
#pragma unroll
        for (int rt = 0; rt < 4; ++rt) {
#pragma unroll
            for (int s2 = 0; s2 < 2; ++s2) O[rt] = mfma16(ld_frag_l(L + L_QK + (16 * rt + rl) * 144 + (32 * s2 + 8 * quad) * 2), Vb[s2], O[rt]);
            const size_t row = (size_t)b * TP + 64 * c + 16 * rt + 4 * quad;
#pragma unroll
            for (int i = 0; i < 4; ++i) OG[(row + i) * 512 + h * 128 + 16 * wave + rl] = O[rt][i];
        }
#pragma unroll
        for (int kt = 0; kt < 8; ++kt) {
            f32x4 a = S[kt] * eg;
#pragma unroll
            for (int s2 = 0; s2 < 2; ++s2) a = mfma16(ld_frag_l(L + L_KT + (16 * kt + rl) * 144 + (32 * s2 + 8 * quad) * 2), Vb[s2], a);
            S[kt] = a;
        }
    }
    float* So = KOUT() + O_GSP + (size_t)(layer * 8 + bh) * 16384;
#pragma unroll
    for (int kt = 0; kt < 8; ++kt)
#pragma unroll
        for (int i = 0; i < 4; ++i) So[(size_t)(16 * kt + 4 * quad + i) * 128 + 16 * wave + rl] = S[kt][i];
    __syncthreads();
}
DI void ret_scan_part(Frame& F, int layer, int r) {
    int tid = F.tid; asm volatile("" : "+v"(tid));
    const int bh = r >> 2, dv = tid & 127, dk0 = ((r & 3) * 4 + (tid >> 7)) * 8, h = bh & 3;
    unsigned char* ws = KWS();
    const float* RKV = (const float*)(ws + WS_RKV) + (size_t)bh * 64 * 16384;
    bf16* RST = (bf16*)(ws + WS_RST) + (size_t)bh * 64 * 16384;
    const float cdec = __expf(128.f * ret_lg(h));
    float S[8];
#pragma unroll
    for (int i = 0; i < 8; ++i) S[i] = 0.f;
#pragma unroll 4
    for (int c = 0; c < 64; ++c) {
        v4u w; w.x = pk2(S[0], S[1]); w.y = pk2(S[2], S[3]); w.z = pk2(S[4], S[5]); w.w = pk2(S[6], S[7]);
        *(v4u*)(RST + (size_t)c * 16384 + dv * 128 + dk0) = w;
#pragma unroll
        for (int i = 0; i < 8; ++i) S[i] = S[i] * cdec + RKV[(size_t)c * 16384 + (dk0 + i) * 128 + dv];
    }
    float* So = KOUT() + O_RSP + (size_t)(layer * 8 + bh) * 16384;
#pragma unroll
    for (int i = 0; i < 8; ++i) So[(size_t)(dk0 + i) * 128 + dv] = S[i];
}
constexpr float SM_C = 0.125f * 1.4426950408889634f;
struct AttnState { float m, l; f32x4 O[4]; };
DI void attn_reset(AttnState& st) { st.m = -1e30f; st.l = 0.f;
#pragma unroll
    for (int i = 0; i < 4; ++i) st.O[i] = (f32x4){0.f, 0.f, 0.f, 0.f}; }
DI void qk_tile(const LAS unsigned char* Kt, const bf16x8 (&qf)[2], f32x4 (&s)[4], int rl, int quad) {
    bf16x8 kf[4][2];
#pragma unroll
    for (int kt = 0; kt < 4; ++kt)
#pragma unroll
        for (int kk = 0; kk < 2; ++kk) kf[kt][kk] = ld_frag_l(Kt + (16 * kt + rl) * 144 + kk * 64 + quad * 16);
    __builtin_amdgcn_s_setprio(1);
#pragma unroll
    for (int kt = 0; kt < 4; ++kt) s[kt] = mfma16(kf[kt][0], qf[0], (f32x4){0.f, 0.f, 0.f, 0.f});
#pragma unroll
    for (int kt = 0; kt < 4; ++kt) s[kt] = mfma16(kf[kt][1], qf[1], s[kt]);
    __builtin_amdgcn_s_setprio(0);
}
template <class Mask> DI void attn_step(const LAS unsigned char* Kt, const LAS unsigned char* VT, const bf16x8 (&qf)[2], AttnState& st, const Mask& ok, int rl, int quad) {
    f32x4 s[4]; qk_tile(Kt, qf, s, rl, quad);
    float mx = -3e38f;
#pragma unroll
    for (int kt = 0; kt < 4; ++kt)
#pragma unroll
        for (int i = 0; i < 4; ++i) if (ok(16 * kt + 4 * quad + i)) mx = fmaxf(mx, s[kt][i]);
    const int lane = rl + 16 * quad;
    mx = fmaxf(mx, shx<16>(mx, lane)); mx = fmaxf(mx, shx<32>(mx, lane));
    const float mn = fmaxf(st.m, mx);
    const float alpha = exp2f((st.m - mn) * SM_C);
    float ls = 0.f;
#pragma unroll
    for (int kt = 0; kt < 4; ++kt)
#pragma unroll
        for (int i = 0; i < 4; ++i) { const float p = ok(16 * kt + 4 * quad + i) ? exp2f((s[kt][i] - mn) * SM_C) : 0.f; s[kt][i] = p; ls += p; }
    ls += shx<16>(ls, lane); ls += shx<32>(ls, lane);
    st.l = st.l * alpha + ls; st.m = mn;
#pragma unroll
    for (int dt = 0; dt < 4; ++dt) st.O[dt] *= alpha;
#pragma unroll
    for (int ii = 0; ii < 2; ++ii) {
        const bf16x8 pb = pack_frag(s[2 * ii], s[2 * ii + 1]);
#pragma unroll
        for (int dt = 0; dt < 4; ++dt) {
            const LAS unsigned char* vp = VT + (16 * dt + rl) * 144 + (32 * ii + 4 * quad) * 2;
            st.O[dt] = mfma16(mk_frag(*(const LAS v2u*)vp, *(const LAS v2u*)(vp + 32)), pb, st.O[dt]);
        }
    }
}
DI void attn_accum(f32x4 (&Of)[4], const AttnState& st, float gate) {
    const float sc = st.l > 0.f ? gate / st.l : 0.f;
#pragma unroll
    for (int dt = 0; dt < 4; ++dt) Of[dt] += st.O[dt] * sc;
}
DI void vt_write(LAS unsigned char* VT, int d0, int key, const v4u w) {
    LAS unsigned char* d = VT + d0 * 144 + key * 2;
    *(LAS bf16*)(d) = (bf16)(w.x & 0xffff); *(LAS bf16*)(d + 144) = (bf16)(w.x >> 16); *(LAS bf16*)(d + 2 * 144) = (bf16)(w.y & 0xffff); *(LAS bf16*)(d + 3 * 144) = (bf16)(w.y >> 16);
    *(LAS bf16*)(d + 4 * 144) = (bf16)(w.z & 0xffff); *(LAS bf16*)(d + 5 * 144) = (bf16)(w.z >> 16); *(LAS bf16*)(d + 6 * 144) = (bf16)(w.w & 0xffff); *(LAS bf16*)(d + 7 * 144) = (bf16)(w.w >> 16);
}
DI void stage_wg(LAS unsigned char* Kt, LAS unsigned char* VT, const bf16* kb, const bf16* vb, size_t stride, int tid, bool do_v) {
    const int key = tid >> 3, ch = tid & 7;
    *(LAS v4u*)(Kt + key * 144 + ch * 16) = *(const v4u*)(kb + key * stride + ch * 8);
    if (do_v) vt_write(VT, ch * 8, key, *(const v4u*)(vb + key * stride + ch * 8));
}
DI unsigned score_key(float s, bool valid, int idx) { return valid ? (((__float_as_uint(s) | 0x80000000u) & ~127u) | (unsigned)(127 - idx)) : 0u; }
DI int key_rank(const LAS unsigned* K, int ng4, unsigned k) {
    int r = 0;
#pragma unroll 4
    for (int g = 0; g < ng4; ++g) { const v4u v = *(const LAS v4u*)(K + 4 * g); r += (v.x > k) + (v.y > k) + (v.z > k) + (v.w > k); }
    return r;
}
DI void key_rank2(const LAS unsigned* K, int ng4, unsigned k0, unsigned k1, int& r0, int& r1) {
    int a0 = 0, a1 = 0, b0 = 0, b1 = 0;
    const int ng8 = (ng4 + 1) >> 1;
#pragma unroll 4
    for (int g = 0; g < ng8; ++g) { const v4u v = *(const LAS v4u*)(K + 8 * g), w = *(const LAS v4u*)(K + 8 * g + 4);
        a0 += (v.x > k0) + (v.y > k0) + (v.z > k0) + (v.w > k0); b0 += (w.x > k0) + (w.y > k0) + (w.z > k0) + (w.w > k0);
        a1 += (v.x > k1) + (v.y > k1) + (v.z > k1) + (v.w > k1); b1 += (w.x > k1) + (w.y > k1) + (w.z > k1) + (w.w > k1); }
    r0 = a0 + b0; r1 = a1 + b1;
}
DI int top16(float v0, float v1, int lane) {
    int sel = 0;
#pragma unroll 1
    for (int r = 0; r < 16; ++r) {
        float bv; int bi;
        if (v0 >= v1) { bv = v0; bi = lane; } else { bv = v1; bi = lane + 64; }
#define T16_STEP(M) { const float ov = shx<M>(bv, lane); const int oi = shxi<M>(bi, lane); const bool take = (ov > bv) || (ov == bv && oi < bi); bv = take ? ov : bv; bi = take ? oi : bi; }
        T16_STEP(32) T16_STEP(16) T16_STEP(8) T16_STEP(4) T16_STEP(2) T16_STEP(1)
#undef T16_STEP
        const bool h0 = (bi == lane), h1 = (bi == lane + 64);
        v0 = h0 ? -3e38f : v0; v1 = h1 ? -3e38f : v1; sel |= (h0 ? 1 : 0) | (h1 ? 2 : 0);
    }
    return sel;
}

typedef short v4i16_t __attribute__((ext_vector_type(4)));
DI s16x4 vtr(const LAS unsigned char* p) { return __builtin_bit_cast(s16x4, __builtin_amdgcn_ds_read_tr16_b64_v4i16((LAS v4i16_t*)p)); }
DI bf16x8 cat4(s16x4 a, s16x4 b) { bf16x8 r; r[0] = a[0]; r[1] = a[1]; r[2] = a[2]; r[3] = a[3]; r[4] = b[0]; r[5] = b[1]; r[6] = b[2]; r[7] = b[3]; return r; }
DI void attn_step3(const LAS unsigned char* Kt, const LAS unsigned char* Vt, const bf16x8 (&qf)[2], AttnState& st, int lo, int hi, bool active, int rl, int quad) {
    active = active && (hi >= lo);
    if (!__any(active)) return;
    f32x4 s[4]; qk_tile(Kt, qf, s, rl, quad);
    const int lane = rl + 16 * quad;
    const bool full = __all((lo <= 0 && hi >= 63) || !active);
    const int kq = 4 * quad - lo; const unsigned rng = (unsigned)(hi - lo);
    float lm;
    if (full) {
        const float a0 = fmaxf(fmaxf(s[0][0], s[0][1]), fmaxf(s[0][2], s[0][3])), a1 = fmaxf(fmaxf(s[1][0], s[1][1]), fmaxf(s[1][2], s[1][3]));
        const float a2 = fmaxf(fmaxf(s[2][0], s[2][1]), fmaxf(s[2][2], s[2][3])), a3 = fmaxf(fmaxf(s[3][0], s[3][1]), fmaxf(s[3][2], s[3][3]));
        lm = fmaxf(fmaxf(a0, a1), fmaxf(a2, a3));
    } else {
        lm = -3e38f;
#pragma unroll
        for (int kt = 0; kt < 4; ++kt)
#pragma unroll
            for (int i = 0; i < 4; ++i) lm = ((unsigned)(kq + 16 * kt + i) <= rng) ? fmaxf(lm, s[kt][i]) : lm;
    }
    lm = active ? lm : -3e38f;
    if (__any(lm > st.m + 320.f)) {
        float mx = fmaxf(lm, shx<16>(lm, lane)); mx = fmaxf(mx, shx<32>(mx, lane));
        const float mn = fmaxf(st.m, mx);
        const float alpha = __builtin_amdgcn_exp2f((st.m - mn) * SM_C);
        st.l *= alpha; st.m = mn;
#pragma unroll
        for (int dt = 0; dt < 4; ++dt) st.O[dt] *= alpha;
    }
    const float mc = active ? st.m * SM_C : __builtin_inff();
    float ls = 0.f;
    if (full) {
#pragma unroll
        for (int kt = 0; kt < 4; ++kt)
#pragma unroll
            for (int i = 0; i < 4; ++i) { const float p = __builtin_amdgcn_exp2f(s[kt][i] * SM_C - mc); s[kt][i] = p; ls += p; }
    } else {
#pragma unroll
        for (int kt = 0; kt < 4; ++kt)
#pragma unroll
            for (int i = 0; i < 4; ++i) { const float p = ((unsigned)(kq + 16 * kt + i) <= rng) ? __builtin_amdgcn_exp2f(s[kt][i] * SM_C - mc) : 0.f; s[kt][i] = p; ls += p; }
    }
    st.l += ls;
#pragma unroll
    for (int ii = 0; ii < 2; ++ii) {
        const bf16x8 pb = pack_frag(s[2 * ii], s[2 * ii + 1]);
#pragma unroll
        for (int dt = 0; dt < 4; ++dt) {
            const LAS unsigned char* vp = Vt + (32 * ii + 4 * quad + (rl >> 2)) * 144 + (16 * dt + 4 * (rl & 3)) * 2;
            st.O[dt] = mfma16(cat4(vtr(vp), vtr(vp + 16 * 144)), pb, st.O[dt]);
        }
    }
}
DI float attn_rowsum(const AttnState& st, int lane) { float l = st.l; l += shx<16>(l, lane); l += shx<32>(l, lane); return l; }
DI void attn_accum3(f32x4 (&Of)[4], const AttnState& st, float gate, int lane) {
    const float l = attn_rowsum(st, lane);
    const float sc = l > 0.f ? gate / l : 0.f;
#pragma unroll
    for (int dt = 0; dt < 4; ++dt) Of[dt] += st.O[dt] * sc;
}
#ifndef PH_NPT
#define PH_NPT (-1)
#endif
#if PH_NPT >= 0
#define NP_T(k) do { if (tid == 0) { volatile LAS unsigned long long* np_ = (volatile LAS unsigned long long*)(F.lds + LDSCTL_OFF + 464); const unsigned long long now_ = __builtin_amdgcn_s_memrealtime(); \
    if ((k) == PH_NPT) np_[0] += now_ - np_[1]; np_[1] = now_; } } while (0)
#else
#define NP_T(k) do { } while (0)
#endif
#ifndef PH_NSAC
#define PH_NSAC 1
#endif
DI float tile_max(const f32x4 (&s)[4], bool full, int kq, unsigned rng) {
    float lm;
    if (full) {
        const float a0 = fmaxf(fmaxf(s[0][0], s[0][1]), fmaxf(s[0][2], s[0][3])), a1 = fmaxf(fmaxf(s[1][0], s[1][1]), fmaxf(s[1][2], s[1][3]));
        const float a2 = fmaxf(fmaxf(s[2][0], s[2][1]), fmaxf(s[2][2], s[2][3])), a3 = fmaxf(fmaxf(s[3][0], s[3][1]), fmaxf(s[3][2], s[3][3]));
        lm = fmaxf(fmaxf(a0, a1), fmaxf(a2, a3));
    } else {
        lm = -3e38f;
#pragma unroll
        for (int kt = 0; kt < 4; ++kt)
#pragma unroll
            for (int i = 0; i < 4; ++i) lm = ((unsigned)(kq + 16 * kt + i) <= rng) ? fmaxf(lm, s[kt][i]) : lm;
    }
    return lm;
}
DI float tile_exp(f32x4 (&s)[4], bool full, int kq, unsigned rng, float mc) {
    float ls = 0.f;
    if (full) {
#pragma unroll
        for (int kt = 0; kt < 4; ++kt)
#pragma unroll
            for (int i = 0; i < 4; ++i) { const float p = __builtin_amdgcn_exp2f(s[kt][i] * SM_C - mc); s[kt][i] = p; ls += p; }
    } else {
#pragma unroll
        for (int kt = 0; kt < 4; ++kt)
#pragma unroll
            for (int i = 0; i < 4; ++i) { const float p = ((unsigned)(kq + 16 * kt + i) <= rng) ? __builtin_amdgcn_exp2f(s[kt][i] * SM_C - mc) : 0.f; s[kt][i] = p; ls += p; }
    }
    return ls;
}
DI void tile_pv(const LAS unsigned char* Vt, const f32x4 (&s)[4], f32x4 (&O)[4], int rl, int quad) {
    bf16x8 vf[2][4];
#pragma unroll
    for (int ii = 0; ii < 2; ++ii)
#pragma unroll
        for (int dt = 0; dt < 4; ++dt) { const LAS unsigned char* vp = Vt + (32 * ii + 4 * quad + (rl >> 2)) * 144 + (16 * dt + 4 * (rl & 3)) * 2; vf[ii][dt] = cat4(vtr(vp), vtr(vp + 16 * 144)); }
    const bf16x8 pb0 = pack_frag(s[0], s[1]), pb1 = pack_frag(s[2], s[3]);
    __builtin_amdgcn_s_setprio(1);
#pragma unroll
    for (int dt = 0; dt < 4; ++dt) O[dt] = mfma16(vf[0][dt], pb0, O[dt]);
#pragma unroll
    for (int dt = 0; dt < 4; ++dt) O[dt] = mfma16(vf[1][dt], pb1, O[dt]);
    __builtin_amdgcn_s_setprio(0);
}
DI void tile_vload(const LAS unsigned char* Vt, bf16x8 (&vf)[2][4], int rl, int quad) {
#pragma unroll
    for (int ii = 0; ii < 2; ++ii)
#pragma unroll
        for (int dt = 0; dt < 4; ++dt) { const LAS unsigned char* vp = Vt + (32 * ii + 4 * quad + (rl >> 2)) * 144 + (16 * dt + 4 * (rl & 3)) * 2; vf[ii][dt] = cat4(vtr(vp), vtr(vp + 16 * 144)); }
}
DI void tile_pvmma(const bf16x8 (&vf)[2][4], const f32x4 (&s)[4], f32x4 (&O)[4]) {
    const bf16x8 pb0 = pack_frag(s[0], s[1]), pb1 = pack_frag(s[2], s[3]);
    __builtin_amdgcn_s_setprio(1);
#pragma unroll
    for (int dt = 0; dt < 4; ++dt) O[dt] = mfma16(vf[0][dt], pb0, O[dt]);
#pragma unroll
    for (int dt = 0; dt < 4; ++dt) O[dt] = mfma16(vf[1][dt], pb1, O[dt]);
    __builtin_amdgcn_s_setprio(0);
}
DI void attn_step_pair(const LAS unsigned char* K0, const LAS unsigned char* V0, int lo0, int hi0, bool act0,
                       const LAS unsigned char* K1, const LAS unsigned char* V1, int lo1, int hi1, bool act1,
                       const bf16x8 (&qf)[2], AttnState& st, int rl, int quad) {
    act0 = act0 && (hi0 >= lo0); act1 = act1 && (hi1 >= lo1);
    const bool any0 = __any(act0), any1 = __any(act1);
    if (!any0 && !any1) return;
    const int lane = rl + 16 * quad;
    f32x4 s0[4], s1[4];
    if (any0 && any1) {
        bf16x8 kf0[4][2], kf1[4][2];
#pragma unroll
        for (int kt = 0; kt < 4; ++kt)
#pragma unroll
            for (int kk = 0; kk < 2; ++kk) { kf0[kt][kk] = ld_frag_l(K0 + (16 * kt + rl) * 144 + kk * 64 + quad * 16); kf1[kt][kk] = ld_frag_l(K1 + (16 * kt + rl) * 144 + kk * 64 + quad * 16); }
        __builtin_amdgcn_s_setprio(1);
#pragma unroll
        for (int kt = 0; kt < 4; ++kt) s0[kt] = mfma16(kf0[kt][0], qf[0], (f32x4){0.f, 0.f, 0.f, 0.f});
#pragma unroll
        for (int kt = 0; kt < 4; ++kt) s1[kt] = mfma16(kf1[kt][0], qf[0], (f32x4){0.f, 0.f, 0.f, 0.f});
#pragma unroll
        for (int kt = 0; kt < 4; ++kt) s0[kt] = mfma16(kf0[kt][1], qf[1], s0[kt]);
#pragma unroll
        for (int kt = 0; kt < 4; ++kt) s1[kt] = mfma16(kf1[kt][1], qf[1], s1[kt]);
        __builtin_amdgcn_s_setprio(0);
    } else {
        if (any0) qk_tile(K0, qf, s0, rl, quad);
        if (any1) qk_tile(K1, qf, s1, rl, quad);
    }
    const bool full0 = __all((lo0 <= 0 && hi0 >= 63) || !act0), full1 = __all((lo1 <= 0 && hi1 >= 63) || !act1);
    const int kq0 = 4 * quad - lo0, kq1 = 4 * quad - lo1; const unsigned rng0 = (unsigned)(hi0 - lo0), rng1 = (unsigned)(hi1 - lo1);
    float mcb = st.m * SM_C;
    bf16x8 vf0[2][4], vf1[2][4];
    if (any0) tile_vload(V0, vf0, rl, quad);
    float ls = 0.f;
    if (any0) ls += tile_exp(s0, full0, kq0, rng0, act0 ? mcb : __builtin_inff());
    if (any1) ls += tile_exp(s1, full1, kq1, rng1, act1 ? mcb : __builtin_inff());
    if (__any(!(ls <= 1e30f))) {
        if (any0) qk_tile(K0, qf, s0, rl, quad);
        if (any1) qk_tile(K1, qf, s1, rl, quad);
        float lm = -3e38f;
        if (any0) { const float a = tile_max(s0, full0, kq0, rng0); lm = act0 ? a : lm; }
        if (any1) { const float a = tile_max(s1, full1, kq1, rng1); lm = act1 ? fmaxf(lm, a) : lm; }
        float mx = fmaxf(lm, shx<16>(lm, lane)); mx = fmaxf(mx, shx<32>(mx, lane));
        const float mn = fmaxf(st.m, mx);
        const float alpha = __builtin_amdgcn_exp2f((st.m - mn) * SM_C);
        st.l *= alpha; st.m = mn;
#pragma unroll
        for (int dt = 0; dt < 4; ++dt) st.O[dt] *= alpha;
        mcb = mn * SM_C; ls = 0.f;
        if (any0) ls += tile_exp(s0, full0, kq0, rng0, act0 ? mcb : __builtin_inff());
        if (any1) ls += tile_exp(s1, full1, kq1, rng1, act1 ? mcb : __builtin_inff());
    }
    st.l += ls;
    if (any1) tile_vload(V1, vf1, rl, quad);
    if (any0) tile_pvmma(vf0, s0, st.O);
    if (any1) tile_pvmma(vf1, s1, st.O);
}
DI void nsa_prompt_unit(Frame& F, int layer, int unit) {
    int lane = F.lane, wave = F.wave; asm volatile("" : "+v"(lane), "+s"(wave));
    const int tid = wave * 64 + lane, quad = lane >> 4, rl = lane & 15;
    const int b = unit >> 9, g = (unit >> 8) & 1, tt = unit & 255, t0 = 32 * tt;
    unsigned char* ws = KWS();
    const bf16* Z = (const bf16*)(ws + WS_Z);
    const float* ZS = (const float*)(ws + WS_ZS);
    LAS unsigned char* TB = F.lds;
    LAS float* AIMP = (LAS float*)(F.lds + 73728);
    LAS unsigned* SEL = (LAS unsigned*)(F.lds + LDSCTL_OFF + 512);
    const int tk = 4 * wave + (rl >> 2), t = t0 + tk, head = 4 * g + (rl & 3);
    const size_t row = (size_t)b * TP + t;
    bf16x8 qf[2];
    qf[0] = ld_frag_g(Z + row * LDZ + ZC_Q + head * 64 + quad * 8); qf[1] = ld_frag_g(Z + row * LDZ + ZC_Q + head * 64 + 32 + quad * 8);
    const float gc = sigmoidf_(ZS[row * 32 + head * 3]), gs = sigmoidf_(ZS[row * 32 + head * 3 + 1]), gw = sigmoidf_(ZS[row * 32 + head * 3 + 2]);
    f32x4 Of[4];
#pragma unroll
    for (int i = 0; i < 4; ++i) Of[i] = (f32x4){0.f, 0.f, 0.f, 0.f};
    AttnState st;
    const int nct = (t0 >> 10) + 1;
    const bf16* KC = (const bf16*)(ws + WS_KC) + ((size_t)(0 * 2 + b) * 512 * 2 + g) * 64;
    const bf16* VC = (const bf16*)(ws + WS_KC) + ((size_t)(1 * 2 + b) * 512 * 2 + g) * 64;
    const bf16* Zb = Z + (size_t)b * TP * LDZ + g * 64;
    const int skey = tid >> 3, sch = tid & 7;
    const int wlo = (t0 - 511 > 0 ? t0 - 511 : 0) >> 6, nwin = ((t0 + 31) >> 6) - wlo + 1;
    const int nwe = (nwin + 1) & ~1, nce = (nct + 1) & ~1;
    v4u rkA, rvA, rkB, rvB;
#define COMMIT(slot, rk, rv) do { LAS unsigned char* d_ = TB + (slot) * 18432 + skey * 144 + sch * 16; *(LAS v4u*)d_ = rk; *(LAS v4u*)(d_ + 9216) = rv; } while (0)
    NP_T(0);
    const int n1 = nwe + 2 * nce;
#define SEG1_VALID(i) ((i) < nwe ? (i) < nwin : (((i) - nwe) < nce ? ((i) - nwe) < nct : ((i) - nwe - nce) < nct))
#define SEG1_ISSUE(i, rk, rv) do { int i_ = (i); i_ = i_ < n1 ? i_ : n1 - 1; const bool win_ = i_ < nwe; int wt_ = wlo + (i_ < nwin ? i_ : nwin - 1); int jt_ = (i_ - nwe) % nce; jt_ = jt_ < nct ? jt_ : nct - 1; jt_ = jt_ < 0 ? 0 : jt_; \
        const bf16* pk_ = win_ ? Zb + (size_t)(64 * wt_ + skey) * LDZ + sch * 8 + ZC_KW : KC + (size_t)(64 * jt_ + skey) * 128 + sch * 8; \
        const bf16* pv_ = win_ ? Zb + (size_t)(64 * wt_ + skey) * LDZ + sch * 8 + ZC_VW : VC + (size_t)(64 * jt_ + skey) * 128 + sch * 8; \
        rk = *(const v4u*)pk_; rv = *(const v4u*)pv_; } while (0)
    attn_reset(st);
    float mfin = 0.f, il = 0.f;
    SEG1_ISSUE(0, rkA, rvA); SEG1_ISSUE(1, rkB, rvB);
    COMMIT(0, rkA, rvA); COMMIT(1, rkB, rvB);
    SEG1_ISSUE(2, rkA, rvA); SEG1_ISSUE(3, rkB, rvB);
    __syncthreads();
    for (int i = 0; i < n1; i += 2) {
        const LAS unsigned char* K0 = TB + (i & 3) * 18432; const LAS unsigned char* K1 = TB + ((i + 1) & 3) * 18432;
        if (i < nwe) {
            const int kb0 = 64 * (wlo + i), kb1 = kb0 + 64;
            attn_step_pair(K0, K0 + 9216, t - 511 - kb0, t - kb0, true, K1, K1 + 9216, t - 511 - kb1, t - kb1, (i + 1) < nwin, qf, st, rl, quad);
            if (i + 2 == nwe) { attn_accum3(Of, st, gw, lane); attn_reset(st); }
        } else if (i < nwe + nce) {
            const int nb0 = 64 * (i - nwe), nb1 = nb0 + 64;
            attn_step_pair(K0, K0 + 9216, 0, ((t - 31) >> 4) - nb0, true, K1, K1 + 9216, 0, ((t - 31) >> 4) - nb1, (i + 1 - nwe) < nct, qf, st, rl, quad);
            if (i + 2 == nwe + nce) { attn_accum3(Of, st, gc, lane); mfin = st.m * SM_C; const float lt_ = attn_rowsum(st, lane); il = lt_ > 0.f ? 1.f / lt_ : 0.f; }
        } else {
#pragma unroll
            for (int e2 = 0; e2 < 2; ++e2) {
                const int jt = i + e2 - nwe - nce;
                if (jt < nct) {
                    f32x4 s[4]; qk_tile(e2 ? K1 : K0, qf, s, rl, quad);
#pragma unroll
                    for (int kt = 0; kt < 4; ++kt)
#pragma unroll
                        for (int e = 0; e < 4; ++e) {
                            const int n = 64 * jt + 16 * kt + 4 * quad + e;
                            float p = (16 * n + 31 <= t) ? __builtin_amdgcn_exp2f(s[kt][e] * SM_C - mfin) * il : 0.f;
                            p += shx<1>(p, lane); p += shx<2>(p, lane);
                            if ((rl & 3) == 0) AIMP[tk * 512 + n] = p;
                        }
                }
            }
        }
        if (i + 2 < n1) { if (SEG1_VALID(i + 2)) COMMIT((i + 2) & 3, rkA, rvA); if (SEG1_VALID(i + 3)) COMMIT((i + 3) & 3, rkB, rvB); }
        __syncthreads();
        SEG1_ISSUE(i + 4, rkA, rvA); SEG1_ISSUE(i + 5, rkB, rvB);
    }
    NP_T(1);
    {
        const int nav = nct * 64;
        LAS unsigned* KS = (LAS unsigned*)(TB + wave * 2048);
#pragma unroll
        for (int q = 0; q < 4; ++q) {
            const int tq = 4 * wave + q, cur = (t0 + tq) >> 6;
#pragma unroll
            for (int e = 0; e < 2; ++e) {
                const int sblk = lane + 64 * e;
                float imp = 0.f;
#pragma unroll
                for (int d = -1; d <= 3; ++d) { const int n = 4 * sblk + d; if (n >= 0 && n < nav) imp += AIMP[tq * 512 + n]; }
                const bool valid = sblk <= cur, forced = (sblk == 0) || (sblk == cur) || (sblk == cur - 1);
                KS[q * 128 + sblk] = score_key(imp + (forced ? 1000.f : 0.f), valid, sblk);
            }
        }
        asm volatile("" ::: "memory");
#pragma unroll
        for (int q = 0; q < 4; ++q) {
            const int tq = 4 * wave + q, cur = (t0 + tq) >> 6, ng4 = (cur >> 2) + 1;
            const unsigned k0 = KS[q * 128 + lane], k1 = KS[q * 128 + 64 + lane];
            int r0, r1; key_rank2(KS + q * 128, ng4, k0, k1, r0, r1);
            const bool s0 = (lane <= cur) && r0 < 16, s1 = (lane + 64 <= cur) && r1 < 16;
            const unsigned long long m0 = __ballot(s0), m1 = __ballot(s1);
            if (lane == 0) { SEL[tq * 4 + 0] = (unsigned)m0; SEL[tq * 4 + 1] = (unsigned)(m0 >> 32); SEL[tq * 4 + 2] = (unsigned)m1; SEL[tq * 4 + 3] = (unsigned)(m1 >> 32); }
        }
    }
    __syncthreads();
    unsigned un[4], my[4], wv[4];
#pragma unroll
    for (int w = 0; w < 4; ++w) { unsigned v = (lane < 32) ? SEL[lane * 4 + w] : 0u;
        v |= (unsigned)shxi<1>((int)v, lane); v |= (unsigned)shxi<2>((int)v, lane); v |= (unsigned)shxi<4>((int)v, lane); v |= (unsigned)shxi<8>((int)v, lane); v |= (unsigned)shxi<16>((int)v, lane); v |= (unsigned)shxi<32>((int)v, lane);
        un[w] = __builtin_amdgcn_readfirstlane(v); my[w] = SEL[tk * 4 + w];
        wv[w] = SEL[(4 * wave) * 4 + w] | SEL[(4 * wave + 1) * 4 + w] | SEL[(4 * wave + 2) * 4 + w] | SEL[(4 * wave + 3) * 4 + w]; wv[w] = __builtin_amdgcn_readfirstlane(wv[w]); }
#if PH_NSAC > 1
    AttnState st2; attn_reset(st2);
#endif
    NP_T(2);
    attn_reset(st);
    {
        unsigned w0 = un[0], w1 = un[1], w2 = un[2], w3 = un[3];
#define NEXT_BLK(dst) do { if (w0) { dst = __builtin_ctz(w0); w0 &= w0 - 1u; } else if (w1) { dst = 32 + __builtin_ctz(w1); w1 &= w1 - 1u; } else if (w2) { dst = 64 + __builtin_ctz(w2); w2 &= w2 - 1u; } \
        else if (w3) { dst = 96 + __builtin_ctz(w3); w3 &= w3 - 1u; } else dst = -1; } while (0)
#define SEG2_ISSUE(blk_, rk, rv) do { const int b_ = (blk_) >= 0 ? (blk_) : 0; const bf16* p_ = Zb + (size_t)(64 * b_ + skey) * LDZ + sch * 8; rk = *(const v4u*)(p_ + ZC_KS); rv = *(const v4u*)(p_ + ZC_VS); } while (0)
#define BLK_WORD(arr, blk_) (((blk_) >> 5) == 0 ? arr[0] : ((blk_) >> 5) == 1 ? arr[1] : ((blk_) >> 5) == 2 ? arr[2] : arr[3])
#define SEG2_PAIR(ca, cb, sa, sb, stt) do { const LAS unsigned char* K0 = TB + (sa) * 18432; const LAS unsigned char* K1 = TB + (sb) * 18432; \
            const int ca_ = (ca) >= 0 ? (ca) : 0, cb_ = (cb) >= 0 ? (cb) : 0; \
            const bool need0 = ((ca) >= 0) && ((BLK_WORD(wv, ca_) >> (ca_ & 31)) & 1u), need1 = ((cb) >= 0) && ((BLK_WORD(wv, cb_) >> (cb_ & 31)) & 1u); \
            const bool mine0 = need0 && ((BLK_WORD(my, ca_) >> (ca_ & 31)) & 1u), mine1 = need1 && ((BLK_WORD(my, cb_) >> (cb_ & 31)) & 1u); \
            attn_step_pair(K0, K0 + 9216, 0, t - 64 * ca_, mine0, K1, K1 + 9216, 0, t - 64 * cb_, mine1, qf, stt, rl, quad); } while (0)
        v4u rkC, rvC, rkD, rvD;
        int c0, c1, c2, c3, n0, n1b, n2, n3, m0, m1, m2, m3;
        NEXT_BLK(c0); NEXT_BLK(c1); NEXT_BLK(c2); NEXT_BLK(c3); NEXT_BLK(n0); NEXT_BLK(n1b); NEXT_BLK(n2); NEXT_BLK(n3);
        SEG2_ISSUE(c0, rkA, rvA); SEG2_ISSUE(c1, rkB, rvB); SEG2_ISSUE(c2, rkC, rvC); SEG2_ISSUE(c3, rkD, rvD);
        COMMIT(0, rkA, rvA); COMMIT(1, rkB, rvB); COMMIT(2, rkC, rvC); COMMIT(3, rkD, rvD);
        SEG2_ISSUE(n0, rkA, rvA); SEG2_ISSUE(n1b, rkB, rvB); SEG2_ISSUE(n2, rkC, rvC); SEG2_ISSUE(n3, rkD, rvD);
        __syncthreads();
        int i = 0;
        while (c0 >= 0) {
            NEXT_BLK(m0); NEXT_BLK(m1); NEXT_BLK(m2); NEXT_BLK(m3);
            SEG2_PAIR(c0, c1, i & 7, (i + 1) & 7, st);
            SEG2_PAIR(c2, c3, (i + 2) & 7, (i + 3) & 7, st);
#if PH_NSAC > 1
            SEG2_PAIR(c0, c1, i & 7, (i + 1) & 7, st2); SEG2_PAIR(c2, c3, (i + 2) & 7, (i + 3) & 7, st2);
#endif
            COMMIT((i + 4) & 7, rkA, rvA); COMMIT((i + 5) & 7, rkB, rvB); COMMIT((i + 6) & 7, rkC, rvC); COMMIT((i + 7) & 7, rkD, rvD);
            __syncthreads();
#if defined(PH_NSAX) && (PH_NSAX & 1)
            __syncthreads();
#endif
#if defined(PH_NSAX) && (PH_NSAX & 2)
            { v4u d0_, d1_; SEG2_ISSUE(m0, d0_, d1_); asm volatile("" :: "v"(d0_), "v"(d1_)); SEG2_ISSUE(m1, d0_, d1_); asm volatile("" :: "v"(d0_), "v"(d1_));
              SEG2_ISSUE(m2, d0_, d1_); asm volatile("" :: "v"(d0_), "v"(d1_)); SEG2_ISSUE(m3, d0_, d1_); asm volatile("" :: "v"(d0_), "v"(d1_)); }
#endif
            SEG2_ISSUE(m0, rkA, rvA); SEG2_ISSUE(m1, rkB, rvB); SEG2_ISSUE(m2, rkC, rvC); SEG2_ISSUE(m3, rkD, rvD);
            c0 = n0; c1 = n1b; c2 = n2; c3 = n3; n0 = m0; n1b = m1; n2 = m2; n3 = m3; i += 4;
        }
    }
    NP_T(3);
    attn_accum3(Of, st, gs, lane);
#if PH_NSAC > 1
    attn_accum3(Of, st2, (float)(layer >> 8), lane);
#endif
#undef SEG1_ISSUE
#undef SEG1_VALID
#undef SEG2_ISSUE
#undef SEG2_PAIR
#undef BLK_WORD
#undef COMMIT
#undef NEXT_BLK
    bf16* MIX = (bf16*)(ws + WS_MIX) + row * 1536 + head * 64;
#pragma unroll
    for (int dt = 0; dt < 4; ++dt) { v2u w; w.x = pk2(Of[dt][0], Of[dt][1]); w.y = pk2(Of[dt][2], Of[dt][3]); *(v2u*)(MIX + 16 * dt + 4 * quad) = w; }
    __syncthreads();
}

#define CB() asm volatile("" ::: "memory")
DI void stage_wave_f32(LAS unsigned char* Kt, LAS unsigned char* Vt, const float* kb, const float* vb, size_t stride, int lane, float* ck = nullptr, float* cv = nullptr, int rowskip = 0) {
    const int k0 = lane >> 3, ch = lane & 7;
#pragma unroll
    for (int h = 0; h < 4; ++h) {
        const float* src = (h < 2 ? kb : vb); LAS unsigned char* dst = (h < 2 ? Kt : Vt); const int r0 = (h & 1) * 32; float* cp = (h < 2 ? ck : cv);
        f32x4 a[4][2];
#pragma unroll
        for (int it = 0; it < 4; ++it) { const float* kp = src + (size_t)(r0 + it * 8 + k0) * stride + ch * 8; a[it][0] = *(const f32x4*)kp; a[it][1] = *(const f32x4*)(kp + 4); }
#pragma unroll
        for (int it = 0; it < 4; ++it) *(LAS v4u*)(dst + (r0 + it * 8 + k0) * 144 + ch * 16) = pack8(a[it][0], a[it][1]);
        if (cp) {
#pragma unroll
            for (int it = 0; it < 4; ++it) { const int rr = r0 + it * 8 + k0; if (rr >= rowskip) { float* op = cp + (size_t)rr * stride + ch * 8; *(f32x4*)op = a[it][0]; *(f32x4*)(op + 4) = a[it][1]; } }
        }
        asm volatile("" ::: "memory");
    }
}
DI void stage_wave_b16(LAS unsigned char* Kt, LAS unsigned char* Vt, const bf16* kb, const bf16* vb, size_t stride, int nvalid, int lane, bool do_v) {
    const int k0 = lane >> 3, ch = lane & 7;
    const v4u z = (v4u){0u, 0u, 0u, 0u};
#pragma unroll
    for (int it = 0; it < 8; ++it) {
        const int key = it * 8 + k0; const bool v = key < nvalid;
        *(LAS v4u*)(Kt + key * 144 + ch * 16) = v ? *(const v4u*)(kb + key * stride + ch * 8) : z;
        if (do_v) *(LAS v4u*)(Vt + key * 144 + ch * 16) = v ? *(const v4u*)(vb + key * stride + ch * 8) : z;
    }
}
DI void nsa_sample_unit(Frame& F, int layer, int s) {
    int lane = F.lane, wave = F.wave; asm volatile("" : "+v"(lane), "+s"(wave));
    const int quad = lane >> 4, rl = lane & 15;
    const int g = wave & 1, q4 = wave >> 1;
    unsigned char* ws = KWS();
    const bf16* Z = (const bf16*)(ws + WS_Z);
    const float* ZS = (const float*)(ws + WS_ZS);
    LAS unsigned char* Kt = F.lds + wave * 18432; LAS unsigned char* Vt = Kt + 9216;
    LAS float* AIMP = (LAS float*)Vt;
    const int j = rl >> 2, head = 4 * g + (rl & 3), qpos = 2048 + j;
    const size_t row = (size_t)MP + 4 * s + j;
    bf16x8 qf[2];
    qf[0] = ld_frag_g(Z + row * LDZ + ZC_Q + head * 64 + quad * 8); qf[1] = ld_frag_g(Z + row * LDZ + ZC_Q + head * 64 + 32 + quad * 8);
    const float gc = sigmoidf_(ZS[row * 32 + head * 3]), gs = sigmoidf_(ZS[row * 32 + head * 3 + 1]), gw = sigmoidf_(ZS[row * 32 + head * 3 + 2]);
    f32x4 Of[4];
#pragma unroll
    for (int i = 0; i < 4; ++i) Of[i] = (f32x4){0.f, 0.f, 0.f, 0.f};
    AttnState st;
    const bf16* KC = (const bf16*)(ws + WS_KCS) + ((size_t)(0 * 128 + s) * 128 * 2 + g) * 64;
    const bf16* VC = (const bf16*)(ws + WS_KCS) + ((size_t)(1 * 128 + s) * 128 * 2 + g) * 64;
    attn_reset(st);
#pragma unroll 1
    for (int jt = 0; jt < 2; ++jt) {
        stage_wave_b16(Kt, Vt, KC + (size_t)64 * jt * 128, VC + (size_t)64 * jt * 128, 128, 64, lane, true); CB();
        attn_step3(Kt, Vt, qf, st, 0, 126 - 64 * jt, true, rl, quad); CB();
    }
    attn_accum3(Of, st, q4 == 0 ? gc : 0.f, lane);
    {
        const float mfin = st.m * SM_C, lt = attn_rowsum(st, lane), il = lt > 0.f ? 1.f / lt : 0.f;
#pragma unroll 1
        for (int jt = 0; jt < 2; ++jt) {
            stage_wave_b16(Kt, Vt, KC + (size_t)64 * jt * 128, VC, 128, 64, lane, false); CB();
            f32x4 sv[4]; qk_tile(Kt, qf, sv, rl, quad); CB();
#pragma unroll
            for (int kt = 0; kt < 4; ++kt)
#pragma unroll
                for (int i = 0; i < 4; ++i) {
                    const int n = 64 * jt + 16 * kt + 4 * quad + i;
                    float p = (n <= 126) ? __builtin_amdgcn_exp2f(sv[kt][i] * SM_C - mfin) * il : 0.f;
                    p += shx<1>(p, lane); p += shx<2>(p, lane);
                    if ((rl & 3) == 0) AIMP[j * 128 + n] = p;
                }
        }
    }
    CB();
    unsigned long long msk[4];
    {
        unsigned keys[4];
#pragma unroll
        for (int q = 0; q < 4; ++q) {
            float imp = 0.f;
#pragma unroll
            for (int d = -1; d <= 3; ++d) { const int n = 4 * lane + d; if (n >= 0 && n <= 126 && lane < 33) imp += AIMP[q * 128 + n]; }
            const bool forced = (lane == 0) || (lane == 32) || (lane == 31);
            keys[q] = score_key(imp + (forced ? 1000.f : 0.f), lane < 33, lane);
        }
        CB();
        LAS unsigned* KS = (LAS unsigned*)Kt;
#pragma unroll
        for (int q = 0; q < 4; ++q) KS[q * 64 + lane] = keys[q];
        CB();
#pragma unroll
        for (int q = 0; q < 4; ++q) msk[q] = __ballot(lane < 33 && key_rank(KS + q * 64, 9, keys[q]) < 16);
    }
    CB();
    const unsigned long long un = msk[0] | msk[1] | msk[2] | msk[3];
    const unsigned long long mym = j == 0 ? msk[0] : j == 1 ? msk[1] : j == 2 ? msk[2] : msk[3];
    const int* pt = (const int*)KIN(7);
    AttnState sw;
    attn_reset(st); attn_reset(sw);
    {
        unsigned long long word = un; int idx = 0;
        while (word) {
            const int blk = __builtin_ctzll(word); word &= word - 1ull;
            if ((idx++ & 3) != q4) continue;
            if (blk < 32) {
                const int phys = pt[s * 16 + (blk >> 1)];
                const float* base = KIN(2) + ((size_t)(layer * 2560 + phys) * 128 + (blk & 1) * 64) * 512 + g * 64;
                stage_wave_f32(Kt, Vt, base + 256, base + 384, 512, lane); CB();
            } else {
                stage_wave_b16(Kt, Vt, Z + (size_t)(MP + 4 * s) * LDZ + ZC_KS + g * 64, Z + (size_t)(MP + 4 * s) * LDZ + ZC_VS + g * 64, LDZ, 4, lane, true); CB();
            }
            attn_step3(Kt, Vt, qf, st, 0, qpos - 64 * blk, (mym >> blk) & 1ull, rl, quad); CB();
        }
#pragma unroll 1
        for (int jt = 0; jt < 9; ++jt) {
            if ((idx++ & 3) != q4) continue;
            if (jt < 8) { const float* base = KIN(3) + ((size_t)(layer * 128 + s) * 512 + 64 * jt) * 256 + g * 64;
                float* ob = KOUT() + O_WINS + ((size_t)(layer * 128 + s) * 512 + 64 * jt) * 256 + g * 64 - (size_t)4 * 256;
                stage_wave_f32(Kt, Vt, base, base + 128, 256, lane, ob, ob + 128, jt == 0 ? 4 : 0); CB(); }
            else { stage_wave_b16(Kt, Vt, Z + (size_t)(MP + 4 * s) * LDZ + ZC_KW + g * 64, Z + (size_t)(MP + 4 * s) * LDZ + ZC_VW + g * 64, LDZ, 4, lane, true); CB(); }
            attn_step3(Kt, Vt, qf, sw, j + 1 - 64 * jt, 512 + j - 64 * jt, true, rl, quad); CB();
        }
    }
    int lane2 = lane; asm volatile("" : "+v"(lane2));
    LAS float* X = (LAS float*)(F.lds + wave * 18432);
    {
        const float ls = attn_rowsum(st, lane), lw = attn_rowsum(sw, lane);
        X[0 * 64 + lane2] = st.m; X[1 * 64 + lane2] = ls; X[18 * 64 + lane2] = sw.m; X[19 * 64 + lane2] = lw;
#pragma unroll
        for (int dt = 0; dt < 4; ++dt)
#pragma unroll
            for (int e = 0; e < 4; ++e) { X[(2 + 4 * dt + e) * 64 + lane2] = st.O[dt][e]; X[(20 + 4 * dt + e) * 64 + lane2] = sw.O[dt][e]; }
    }
    __syncthreads();
    if (q4 == 0) {
#pragma unroll
        for (int br = 0; br < 2; ++br) {
            float m[4], l[4];
#pragma unroll
            for (int q = 0; q < 4; ++q) { const LAS float* Y = (const LAS float*)(F.lds + (2 * q + g) * 18432) + br * 18 * 64; m[q] = Y[lane2]; l[q] = Y[64 + lane2]; }
            const float mm = fmaxf(fmaxf(m[0], m[1]), fmaxf(m[2], m[3]));
            float w[4], lt = 0.f;
#pragma unroll
            for (int q = 0; q < 4; ++q) { w[q] = __builtin_amdgcn_exp2f((m[q] - mm) * SM_C); lt += l[q] * w[q]; }
            const float gate = br == 0 ? gs : gw;
            const float sc = lt > 0.f ? gate / lt : 0.f;
#pragma unroll
            for (int q = 0; q < 4; ++q) { const LAS float* Y = (const LAS float*)(F.lds + (2 * q + g) * 18432) + br * 18 * 64; const float wq = w[q] * sc;
#pragma unroll
                for (int dt = 0; dt < 4; ++dt)
#pragma unroll
                    for (int e = 0; e < 4; ++e) Of[dt][e] += Y[(2 + 4 * dt + e) * 64 + lane2] * wq; }
        }
        bf16* MIX = (bf16*)(ws + WS_MIX) + row * 1536 + head * 64;
#pragma unroll
        for (int dt = 0; dt < 4; ++dt) { v2u w2; w2.x = pk2(Of[dt][0], Of[dt][1]); w2.y = pk2(Of[dt][2], Of[dt][3]); *(v2u*)(MIX + 16 * dt + 4 * quad) = w2; }
    }
    __syncthreads();
}
DI void ret_out_unit(Frame& F, int layer, int unit) {
    const int tid = F.tid, lane = F.lane, wave = F.wave, quad = lane >> 4, rl = lane & 15;
    const int b = unit >> 8, h = (unit >> 6) & 3, c = unit & 63;
    const int row0 = b * TP + 128 * c;
    unsigned char* ws = KWS();
    const bf16* Z = (const bf16*)(ws + WS_Z);
    const bf16* QR = (const bf16*)(ws + WS_QR); const bf16* KR = (const bf16*)(ws + WS_KR);
    const bf16* RST = (const bf16*)(ws + WS_RST) + (size_t)unit * 16384;
    LAS unsigned char* LQ = F.lds; LAS unsigned char* LK = F.lds + 34816; LAS unsigned char* LV = F.lds + 69632; LAS unsigned char* LS = F.lds + 104448;
    for (int it = tid; it < 2048; it += NTHREADS) {
        const int j = it >> 4, cc = it & 15;
        *(LAS v4u*)(LQ + j * 272 + cc * 16) = *(const v4u*)(QR + (size_t)(row0 + j) * 512 + h * 128 + cc * 8);
        *(LAS v4u*)(LK + j * 272 + cc * 16) = *(const v4u*)(KR + (size_t)(row0 + j) * 512 + h * 128 + cc * 8);
        *(LAS v4u*)(LS + j * 272 + cc * 16) = *(const v4u*)(RST + (size_t)j * 128 + cc * 8);
        const v4u w = *(const v4u*)(Z + (size_t)(row0 + j) * LDZ + ZC_RQKV + 1024 + h * 128 + cc * 8);
        LAS unsigned char* d = LV + (cc * 8) * 272 + j * 2;
        *(LAS bf16*)(d) = (bf16)(w.x & 0xffff); *(LAS bf16*)(d + 272) = (bf16)(w.x >> 16); *(LAS bf16*)(d + 2 * 272) = (bf16)(w.y & 0xffff); *(LAS bf16*)(d + 3 * 272) = (bf16)(w.y >> 16);
        *(LAS bf16*)(d + 4 * 272) = (bf16)(w.z & 0xffff); *(LAS bf16*)(d + 5 * 272) = (bf16)(w.z >> 16); *(LAS bf16*)(d + 6 * 272) = (bf16)(w.w & 0xffff); *(LAS bf16*)(d + 7 * 272) = (bf16)(w.w >> 16);
    }
    __syncthreads();
    const float lg = ret_lg(h);
    const int il = 16 * wave + rl;
    bf16x8 qb[4];
#pragma unroll
    for (int s = 0; s < 4; ++s) qb[s] = ld_frag_l(LQ + il * 272 + (32 * s + 8 * quad) * 2);
    f32x4 C[8];
    const float qdec = __expf((float)(il + 1) * lg);
#pragma unroll
    for (int dt = 0; dt < 8; ++dt) {
        f32x4 a = (f32x4){0.f, 0.f, 0.f, 0.f};
#pragma unroll
        for (int s = 0; s < 4; ++s) a = mfma16(ld_frag_l(LS + (16 * dt + rl) * 272 + (32 * s + 8 * quad) * 2), qb[s], a);
        C[dt] = a * qdec;
    }
    for (int s2 = 0; s2 <= (wave >> 1); ++s2) {
        f32x4 P[2];
#pragma unroll
        for (int e = 0; e < 2; ++e) {
            const int jt = 2 * s2 + e;
            f32x4 a = (f32x4){0.f, 0.f, 0.f, 0.f};
            if (jt <= wave) {
#pragma unroll
                for (int s = 0; s < 4; ++s) a = mfma16(ld_frag_l(LK + (16 * jt + rl) * 272 + (32 * s + 8 * quad) * 2), qb[s], a);
#pragma unroll
                for (int i = 0; i < 4; ++i) { const int jj = 16 * jt + 4 * quad + i; a[i] = (il >= jj) ? a[i] * __expf((float)(il - jj) * lg) : 0.f; }
            }
            P[e] = a;
        }
        const bf16x8 pb = pack_frag(P[0], P[1]);
#pragma unroll
        for (int dt = 0; dt < 8; ++dt) {
            const LAS unsigned char* vp = LV + (16 * dt + rl) * 272 + (32 * s2 + 4 * quad) * 2;
            C[dt] = mfma16(mk_frag(*(const LAS v2u*)vp, *(const LAS v2u*)(vp + 32)), pb, C[dt]);
        }
    }
    float ss = 0.f;
#pragma unroll
    for (int dt = 0; dt < 8; ++dt) ss += (C[dt][0] * C[dt][0] + C[dt][1] * C[dt][1]) + (C[dt][2] * C[dt][2] + C[dt][3] * C[dt][3]);
    ss += shx<16>(ss, lane); ss += shx<32>(ss, lane);
    const float scl = rsqrtf(ss * (1.f / 128.f) + EPS);
    const size_t row = (size_t)row0 + il;
#pragma unroll
    for (int dt = 0; dt < 8; ++dt) {
        const v2u gwd = *(const v2u*)(Z + row * LDZ + ZC_RG + h * 128 + 16 * dt + 4 * quad);
        v2u w; w.x = pk2(C[dt][0] * scl * siluf_(lo_bf(gwd.x)), C[dt][1] * scl * siluf_(hi_bf(gwd.x))); w.y = pk2(C[dt][2] * scl * siluf_(lo_bf(gwd.y)), C[dt][3] * scl * siluf_(hi_bf(gwd.y)));
        *(v2u*)((bf16*)(ws + WS_MIX) + row * 1536 + 1024 + h * 128 + 16 * dt + 4 * quad) = w;
    }
    __syncthreads();
}
DI void gdn_out_row(Frame& F, int layer, int row) {
    const int lane = F.lane;
    unsigned char* ws = KWS();
    const float* o = (const float*)(ws + WS_OGDN) + (size_t)row * 512 + lane * 8;
    const f32x4 a = *(const f32x4*)o, b = *(const f32x4*)(o + 4);
    float ss = (a[0] * a[0] + a[1] * a[1]) + (a[2] * a[2] + a[3] * a[3]) + (b[0] * b[0] + b[1] * b[1]) + (b[2] * b[2] + b[3] * b[3]);
    ss += shx<1>(ss, lane); ss += shx<2>(ss, lane); ss += shx<4>(ss, lane); ss += shx<8>(ss, lane);
    const float scl = rsqrtf(ss * (1.f / 128.f) + EPS);
    const float* ng = KIN(18) + layer * 128 + (lane & 15) * 8;
    const f32x4 ga = *(const f32x4*)ng, gb = *(const f32x4*)(ng + 4);
    f32x4 za, zb; unpack8(*(const v4u*)((const bf16*)(ws + WS_Z) + (size_t)row * LDZ + ZC_GZ + lane * 8), za, zb);
    f32x4 ra, rb;
#pragma unroll
    for (int e = 0; e < 4; ++e) { ra[e] = a[e] * scl * ga[e] * siluf_(za[e]); rb[e] = b[e] * scl * gb[e] * siluf_(zb[e]); }
    *(v4u*)((bf16*)(ws + WS_MIX) + (size_t)row * 1536 + 512 + lane * 8) = pack8(ra, rb);
}
DI void final_row(Frame& F, int row) {
    const int lane = F.lane;
    const float* x = (const float*)(KWS() + WS_XR) + (size_t)row * DM;
    float* y = (row < MP) ? KOUT() + O_YP + (size_t)row * DM : KOUT() + O_YS + (size_t)(row - MP) * DM;
    f32x4 v[4]; float ss = 0.f;
#pragma unroll
    for (int j = 0; j < 4; ++j) { v[j] = *(const f32x4*)(x + 256 * j + lane * 4); ss += (v[j][0] * v[j][0] + v[j][1] * v[j][1]) + (v[j][2] * v[j][2] + v[j][3] * v[j][3]); }
    const float scl = rsqrtf(wave_sum(ss, lane) * (1.f / DM) + EPS);
#pragma unroll
    for (int j = 0; j < 4; ++j) *(f32x4*)(y + 256 * j + lane * 4) = v[j] * scl * *(const f32x4*)(KIN(26) + 256 * j + lane * 4);
}
template <class Epi>
DI void sgemm_tile(Frame& F, const bf16* A, int lda, const bf16* Bt, int ldb, int K, int row0, int col0, const Epi& E) {
    int lane = F.lane, wave = F.wave; asm volatile("" : "+v"(lane), "+s"(wave));
    const int tid = wave * 64 + lane, quad = lane >> 4, rl = lane & 15;
    const int kper = K >> 3, nks = kper >> 5;
    f32x4 acc[2][4];
#pragma unroll
    for (int rt = 0; rt < 2; ++rt)
#pragma unroll
        for (int ct = 0; ct < 4; ++ct) acc[rt][ct] = (f32x4){0.f, 0.f, 0.f, 0.f};
    const bf16* ap = A + (size_t)(row0 + rl) * lda + wave * kper + quad * 8;
    const bf16* bp = Bt + (size_t)(col0 + rl) * ldb + wave * kper + quad * 8;
#pragma unroll 4
    for (int ks = 0; ks < nks; ++ks) {
        bf16x8 a[2], b[4];
#pragma unroll
        for (int rt = 0; rt < 2; ++rt) a[rt] = ld_frag_g(ap + (size_t)(16 * rt) * lda + ks * 32);
#pragma unroll
        for (int ct = 0; ct < 4; ++ct) b[ct] = ld_frag_g(bp + (size_t)(16 * ct) * ldb + ks * 32);
#pragma unroll
        for (int rt = 0; rt < 2; ++rt)
#pragma unroll
            for (int ct = 0; ct < 4; ++ct) acc[rt][ct] = mfma16(a[rt], b[ct], acc[rt][ct]);
    }
    LAS float* RED = (LAS float*)F.lds;
#pragma unroll
    for (int rt = 0; rt < 2; ++rt)
#pragma unroll
        for (int ct = 0; ct < 4; ++ct)
#pragma unroll
            for (int i = 0; i < 4; ++i) RED[wave * 2176 + (16 * rt + 4 * quad + i) * 68 + 16 * ct + rl] = acc[rt][ct][i];
    __syncthreads();
    const int r = tid >> 4, c4 = (tid & 15) * 4;
    f32x4 v = *(const LAS f32x4*)(RED + r * 68 + c4);
#pragma unroll
    for (int w = 1; w < 8; ++w) v += *(const LAS f32x4*)(RED + w * 2176 + r * 68 + c4);
    E(row0 + r, col0 + c4, v, lane);
    __syncthreads();
}
struct SEpiC {
    const bf16* Z; bf16* G;
    DI void operator()(int row, int col, f32x4 v, int lane) const {
        const v2u gw = *(const v2u*)(Z + (size_t)row * LDZ + ZC_MG + col);
        v[0] *= sigmoidf_(lo_bf(gw.x)); v[1] *= sigmoidf_(hi_bf(gw.x)); v[2] *= sigmoidf_(lo_bf(gw.y)); v[3] *= sigmoidf_(hi_bf(gw.y));
        *(v2u*)(G + (size_t)row * 3072 + col) = pack4(v);
    }
};
struct SEpiRes {
    float* XR; bf16* XG; const float* gvec; float* SS; float* T; int mode; const float* XRr;
    DI void operator()(int row, int col, f32x4 v, int lane) const {
        const size_t o = (size_t)row * DM + col;
        if (mode == 1) { *(v2u*)((bf16*)T + o) = pack4(v); return; }
        f32x4 x = *(const f32x4*)(XRr + o);
        if (mode == 2) { const v2u tw = *(const v2u*)((const bf16*)T + o); const f32x4 t = (f32x4){lo_bf(tw.x), hi_bf(tw.x), lo_bf(tw.y), hi_bf(tw.y)};
#pragma unroll
            for (int e = 0; e < 4; ++e) v[e] = t[e] * sigmoidf_(v[e]); }
        x += v;
        *(f32x4*)(XR + o) = x;
        if (XG) { f32x4 y = x; if (gvec) y *= *(const f32x4*)(gvec + col); *(v2u*)(XG + o) = pack4(y); }
        if (SS) { float ssq = (x[0] * x[0] + x[1] * x[1]) + (x[2] * x[2] + x[3] * x[3]);
            ssq += shx<1>(ssq, lane); ssq += shx<2>(ssq, lane); ssq += shx<4>(ssq, lane); ssq += shx<8>(ssq, lane);
            if ((lane & 15) == 0) SS[(size_t)row * 16 + (col >> 6)] = ssq; }
    }
};
struct SEpiUp {
    bf16* H; const float* SS;
    DI void operator()(int row, int col, f32x4 v, int lane) const {
        const f32x4 p0 = *(const f32x4*)(SS + (size_t)row * 16), p1 = *(const f32x4*)(SS + (size_t)row * 16 + 4), p2 = *(const f32x4*)(SS + (size_t)row * 16 + 8), p3 = *(const f32x4*)(SS + (size_t)row * 16 + 12);
        const f32x4 ps = (p0 + p1) + (p2 + p3);
        const float rstd = rsqrtf(((ps[0] + ps[1]) + (ps[2] + ps[3])) * (1.f / DM) + EPS);
#pragma unroll
        for (int e = 0; e < 4; ++e) { const float a = fmaxf(v[e] * rstd, 0.f); v[e] = a * a; }
        *(v2u*)(H + (size_t)row * DFF + col) = pack4(v);
    }
};
#ifndef PH_P0
#define PH_P0 1
#endif
#ifndef PH_A
#define PH_A 1
#endif
#ifndef PH_B0a
#define PH_B0a 1
#endif
#ifndef PH_B0b
#define PH_B0b 1
#endif
#ifndef PH_B0c
#define PH_B0c 1
#endif
#ifndef PH_B0d
#define PH_B0d 1
#endif
#ifndef PH_SCAN
#define PH_SCAN 1
#endif
#ifndef PH_RSCAN
#define PH_RSCAN 1
#endif
#ifndef PH_NSAP
#define PH_NSAP 1
#endif
#ifndef PH_NSAS
#define PH_NSAS 1
#endif
#ifndef PH_B2
#define PH_B2 1
#endif
#ifndef PH_C
#define PH_C 1
#endif
#ifndef PH_XBAR
#define PH_XBAR 0
#endif
#ifndef PH_D
#define PH_D 1
#endif
#ifndef PH_E
#define PH_E 1
#endif
#ifndef PH_F
#define PH_F 1
#endif
#ifndef PH_G1
#define PH_G1 1
#endif
#ifndef PH_G2
#define PH_G2 1
#endif
#ifndef PH_TREG
#define PH_TREG (-1)
#endif
#if PH_TREG >= 0
#define TREG_MARK(r) do { const unsigned long long now_ = __builtin_amdgcn_s_memrealtime(); if ((r) == PH_TREG) tacc_ += now_ - tlast_; tlast_ = now_; } while (0)
#define TREG_SUB(r) do { const unsigned long long now_ = __builtin_amdgcn_s_memrealtime(); if ((r) == PH_TREG) tacc_ += now_ - tsub_; tsub_ = now_; } while (0)
#else
#define TREG_MARK(r) do { } while (0)
#define TREG_SUB(r) do { } while (0)
#endif
struct Args { const void* in[27]; float* out; unsigned char* ws; };
__global__ void __launch_bounds__(NTHREADS, 2) mk_fwd(Args args) {
    extern __shared__ __attribute__((aligned(16))) unsigned char lds_raw[];
    Frame F;
    F.lds = (LAS unsigned char*)lds_raw;
    F.wave = __builtin_amdgcn_readfirstlane((int)threadIdx.x >> 6); F.lane = 0; F.tid = 0;
    F.G = gridDim.x; F.bid = blockIdx.x;
    F.ctl = (gu32*)(KWS() + WS_CTL);
    { const Frame Fp = fresh(F); for (int u = Fp.tid; u < (LDS_BYTES - LDSCTL_OFF) / 4; u += NTHREADS) ((LAS unsigned*)(F.lds + LDSCTL_OFF))[u] = 0u;
      __syncthreads();
      (void)xcd_barrier_post((unsigned*)(F.ctl + CW_BAR), (volatile LAS unsigned*)(F.lds + MISC_OFF) + 8, Fp.tid == 0); }
    const int G = F.G, bid = F.bid;
#if PH_TREG >= 0
    unsigned long long tacc_ = 0ull, tlast_ = __builtin_amdgcn_s_memrealtime(), tsub_ = tlast_;
#endif

        for (int rp_ = 0; rp_ < PH_P0; ++rp_) {
    { Frame Fp = fresh(F); p0_prologue(Fp); }
        }
    GRID_BAR();
    TREG_MARK(0);

    for (int layer = 0; layer < NLAYER; ++layer) {
        for (int rp_ = 0; rp_ < PH_A; ++rp_) {
        {
            const Frame Fg = fresh(F); const int G = Fg.G, bid = Fg.bid;
            unsigned char* ws = KWS();
            pg8::Gemm g{(const bf16*)(ws + WS_XGA), (const bf16*)(ws + WS_WIN + layer * SZ_WIN), MROWS, LDZ, DM, DM, DM, 31, 0};
            pg8::StaticOrder S; S.init(MROWS, LDZ, G, bid);
            epi::EpiA E{(bf16*)(ws + WS_Z), (float*)(ws + WS_ZS), (const float*)(ws + WS_SSA), KOUT(), layer};
            pg8::gemm_phase<epi::EpiA, pg8::StaticOrder, true, true>(Fg.lds, g, S, E, Fg.tid);
        }
        }
        GRID_BAR();
    TREG_MARK(1);
#if PH_TREG >= 0
        tsub_ = __builtin_amdgcn_s_memrealtime();
#endif
        {
            Frame Fp = fresh(F);
            gu32* qhead = F.ctl + CW_QUEUE + 512 * layer + 384;
            volatile LAS int* qslot = (volatile LAS int*)(F.lds + MISC_OFF) + 16;
            constexpr int NI = 5 * 272 * PH_B0d, N2 = 1024 * PH_B0c, N3 = 512 * PH_B0b;
            for (;;) {
                if (Fp.tid == 0) qslot[0] = (int)__hip_atomic_fetch_add(qhead, 1u, __ATOMIC_RELAXED, __HIP_MEMORY_SCOPE_AGENT);
                __syncthreads();
                int it = qslot[0];
                __syncthreads();
                it = __builtin_amdgcn_readfirstlane(it);
                if (it >= NI + N2 + N3) break;
                TREG_SUB(99);
                if (it < NI) { const int k = it / 5, r = it % 5;
                    if (r == 0) compress_job(Fp, layer, k % 272);
                    else if (k < 256 * PH_B0a) gdn_prep_unit(Fp, layer, (4 * k + r - 1) & 1023); }
                else { const int q = it - NI, g3 = q / 3, r3 = q % 3;
                    if (r3 < 2) sample_rec_unit(Fp, layer, (2 * g3 + r3) & 1023); else ret_prep_unit(Fp, layer, g3 & 511); }
                TREG_SUB(it < NI ? ((it % 5) == 0 ? 40 : 41) : (it < NI + N2 ? 42 : 43));
            }
        }
        GRID_BAR();
    TREG_MARK(2);
        {
            Frame Fp = fresh(F);
            gu32* qbase = F.ctl + CW_QUEUE + 512 * layer;
            volatile LAS int* qslot = (volatile LAS int*)(F.lds + MISC_OFF) + 16;
            constexpr int NQ = 8 * PH_SCAN, NS = 128 * PH_NSAS, NR = 32 * PH_RSCAN, NP = 256 * PH_NSAP;
            const int pref = (int)(xb_xcc_id() & 3u);
            for (;;) {
                if (Fp.tid == 0) qslot[1] = (int)__hip_atomic_fetch_add(qbase, 1u, __ATOMIC_RELAXED, __HIP_MEMORY_SCOPE_AGENT);
                __syncthreads();
                int it = qslot[1];
                __syncthreads();
                it = __builtin_amdgcn_readfirstlane(it);
                if (it >= NQ + NR) break;
                TREG_SUB(99);
                if (it < NQ) gdn_scan_chain(Fp, layer, it & 7);
                else ret_scan_part(Fp, layer, (it - NQ) & 31);
                TREG_SUB(it < NQ ? 21 : 23);
            }
            const int when = Fp.bid & 3;
            bool tried = false;
            for (int nu = 0;; ++nu) {
                if (Fp.tid == 0) {
                    int kind = -1, idx = 0;
                    if (!tried && nu >= when) {
                        tried = true;
                        const int a = (int)__hip_atomic_fetch_add(qbase + 320, 1u, __ATOMIC_RELAXED, __HIP_MEMORY_SCOPE_AGENT);
                        if (a < NS) { kind = 4; idx = a; }
                    }
                    if (kind < 0) {
                        for (int k = 0; k < 4 && kind < 0; ++k) { const int s = (pref + k) & 3;
                            if ((int)__hip_atomic_load(qbase + 64 * (1 + s), __ATOMIC_RELAXED, __HIP_MEMORY_SCOPE_AGENT) < NP) {
                                const int r = (int)__hip_atomic_fetch_add(qbase + 64 * (1 + s), 1u, __ATOMIC_RELAXED, __HIP_MEMORY_SCOPE_AGENT);
                                if (r < NP) { kind = s; idx = r; } } }
                    }
                    if (kind < 0) {
                        const int a = (int)__hip_atomic_fetch_add(qbase + 320, 1u, __ATOMIC_RELAXED, __HIP_MEMORY_SCOPE_AGENT);
                        if (a < NS) { kind = 4; idx = a; }
                    }
                    qslot[0] = kind; qslot[1] = idx;
                }
                __syncthreads();
                int kind = qslot[0], it = qslot[1];
                __syncthreads();
                kind = __builtin_amdgcn_readfirstlane(kind); it = __builtin_amdgcn_readfirstlane(it);
                if (kind < 0) break;
                TREG_SUB(99);
                if (kind < 4) nsa_prompt_unit(Fp, layer, (kind << 8) | (255 - (it & 255)));
                else nsa_sample_unit(Fp, layer, it & 127);
                TREG_SUB(kind < 4 ? 20 : 22);
            }
        }
        GRID_BAR();
    TREG_MARK(3);
        for (int rp_ = 0; rp_ < PH_B2; ++rp_) {
        { Frame Fp = fresh(F); for (int u = Fp.bid; u < 512; u += Fp.G) ret_out_unit(Fp, layer, u); }
        { Frame Fp = fresh(F); for (int r = Fp.bid * NWAVES + Fp.wave; r < MROWS; r += Fp.G * NWAVES) gdn_out_row(Fp, layer, r); }
        }
        GRID_BAR();
    TREG_MARK(4);
        for (int rp_ = 0; rp_ < PH_C; ++rp_) {
        {
            const Frame Fg = fresh(F); const int G = Fg.G, bid = Fg.bid;
            unsigned char* ws = KWS();
            pg8::Gemm g{(const bf16*)(ws + WS_MIX), (const bf16*)(ws + WS_WBR + layer * SZ_WBR), MP, 3072, 512, 1536, 512, 2, 1024};
            pg8::StaticOrder S; S.init(MP, 3072, G, bid);
            epi::EpiC E{(const bf16*)(ws + WS_Z), (bf16*)(ws + WS_GATED)};
            pg8::gemm_phase<epi::EpiC, pg8::StaticOrder, true, true>(Fg.lds, g, S, E, Fg.tid);
            TREG_SUB(99);
            {
                Frame Fs = fresh(F); const SEpiC Es{(const bf16*)(ws + WS_Z), (bf16*)(ws + WS_GATED)};
                for (int tl = Fs.bid; tl < 16 * 48; tl += Fs.G) { const int rt = tl & 15, ct = tl >> 4, b = ct >> 4;
                    sgemm_tile(Fs, (const bf16*)(ws + WS_MIX) + b * 512, 1536, (const bf16*)(ws + WS_WBR + layer * SZ_WBR), 512, 512, MP + 32 * rt, 64 * ct, Es); }
            }
            TREG_SUB(31);
        }
        }
        GRID_BAR();
    TREG_MARK(5);
        for (int rp_ = 0; rp_ < PH_D; ++rp_) {
        {
            const Frame Fg = fresh(F); const int G = Fg.G, bid = Fg.bid;
            unsigned char* ws = KWS();
            pg8::Gemm g{(const bf16*)(ws + WS_GATED), (const bf16*)(ws + WS_WO3 + layer * SZ_WO3), MP, DM, 3072, 3072, 3072, 31, 0};
            pg8::StaticOrder S; S.init(MP, DM, G, bid);
            epi::EpiRes E{(float*)(ws + WS_XR), (bf16*)(ws + WS_XGB), KIN(21) + layer * DM, (float*)(ws + WS_SSB), nullptr, (rp_ + 1 < PH_D) ? 3 : 0, layer == 0 ? KIN(0) : (const float*)(ws + WS_XR)};
            pg8::gemm_phase<epi::EpiRes, pg8::StaticOrder, true, true>(Fg.lds, g, S, E, Fg.tid);
            TREG_SUB(99);
            if (rp_ + 1 == PH_D) {
                Frame Fs = fresh(F); const SEpiRes Es{(float*)(ws + WS_XR), (bf16*)(ws + WS_XGB), KIN(21) + layer * DM, (float*)(ws + WS_SSB), nullptr, 0, layer == 0 ? KIN(1) - (size_t)MP * DM : (const float*)(ws + WS_XR)};
                for (int tl = Fs.bid; tl < 256; tl += Fs.G) sgemm_tile(Fs, (const bf16*)(ws + WS_GATED), 3072, (const bf16*)(ws + WS_WO3 + layer * SZ_WO3), 3072, 3072, MP + 32 * (tl & 15), 64 * (tl >> 4), Es);
            }
            TREG_SUB(32);
        }
        }
        GRID_BAR();
    TREG_MARK(6);
        for (int rp_ = 0; rp_ < PH_E; ++rp_) {
        {
            const Frame Fg = fresh(F); const int G = Fg.G, bid = Fg.bid;
            unsigned char* ws = KWS();
            pg8::Gemm g{(const bf16*)(ws + WS_XGB), (const bf16*)(ws + WS_WUP + layer * SZ_WUP), MP, DFF, DM, DM, DM, 31, 0};
            pg8::StaticOrder S; S.init(MP, DFF, G, bid);
            epi::EpiUp E{(bf16*)(ws + WS_HMID), (const float*)(ws + WS_SSB)};
            pg8::gemm_phase<epi::EpiUp, pg8::StaticOrder, true, true>(Fg.lds, g, S, E, Fg.tid);
            TREG_SUB(99);
            {
                Frame Fs = fresh(F); const SEpiUp Es{(bf16*)(ws + WS_HMID), (const float*)(ws + WS_SSB)};
                for (int tl = Fs.bid; tl < 16 * 64; tl += Fs.G) sgemm_tile(Fs, (const bf16*)(ws + WS_XGB), DM, (const bf16*)(ws + WS_WUP + layer * SZ_WUP), DM, DM, MP + 32 * (tl & 15), 64 * (tl >> 4), Es);
            }
            TREG_SUB(33);
        }
        }
        GRID_BAR();
    TREG_MARK(7);
        for (int rp_ = 0; rp_ < PH_F; ++rp_) {
        {
            const Frame Fg = fresh(F); const int G = Fg.G, bid = Fg.bid;
            unsigned char* ws = KWS();
            pg8::Gemm g{(const bf16*)(ws + WS_HMID), (const bf16*)(ws + WS_WDN + layer * SZ_WDN), MP, DM, DFF, DFF, DFF, 31, 0};
            pg8::StaticOrder S; S.init(MP, DM, G, bid);
            epi::EpiRes E{(float*)(ws + WS_XR), (bf16*)(ws + WS_XGC), nullptr, nullptr, nullptr, (rp_ + 1 < PH_F) ? 3 : 0, (const float*)(ws + WS_XR)};
            pg8::gemm_phase<epi::EpiRes, pg8::StaticOrder, true, true>(Fg.lds, g, S, E, Fg.tid);
            TREG_SUB(99);
            if (rp_ + 1 == PH_F) {
                Frame Fs = fresh(F); const SEpiRes Es{(float*)(ws + WS_XR), (bf16*)(ws + WS_XGC), nullptr, nullptr, nullptr, 0, (const float*)(ws + WS_XR)};
                for (int tl = Fs.bid; tl < 256; tl += Fs.G) sgemm_tile(Fs, (const bf16*)(ws + WS_HMID), DFF, (const bf16*)(ws + WS_WDN + layer * SZ_WDN), DFF, DFF, MP + 32 * (tl & 15), 64 * (tl >> 4), Es);
            }
            TREG_SUB(34);
        }
        }
        GRID_BAR();
    TREG_MARK(8);
        for (int rp_ = 0; rp_ < PH_G1; ++rp_) {
        {
            const Frame Fg = fresh(F); const int G = Fg.G, bid = Fg.bid;
            unsigned char* ws = KWS();
            int kple = PLE; asm volatile("" : "+s"(kple));
            pg8::Gemm g{(const bf16*)(ws + WS_P16) + (size_t)layer * MROWS * PLE, (const bf16*)(ws + WS_WPL + layer * SZ_WPL), MP, DM, kple, PLE, PLE, 31, 0};
            pg8::StaticOrder S; S.init(MP, DM, G, bid);
            epi::EpiRes E{nullptr, nullptr, nullptr, nullptr, (float*)(ws + WS_TPLE), 1, nullptr};
            pg8::gemm_phase<epi::EpiRes, pg8::StaticOrder, true, true>(Fg.lds, g, S, E, Fg.tid);
            TREG_SUB(99);
            {
                Frame Fs = fresh(F); const SEpiRes Es{nullptr, nullptr, nullptr, nullptr, (float*)(ws + WS_TPLE), 1, nullptr};
                for (int tl = Fs.bid; tl < 256; tl += Fs.G) sgemm_tile(Fs, (const bf16*)(ws + WS_P16) + (size_t)layer * MROWS * PLE, PLE, (const bf16*)(ws + WS_WPL + layer * SZ_WPL), PLE, PLE, MP + 32 * (tl & 15), 64 * (tl >> 4), Es);
            }
            TREG_SUB(35);
        }
        }
        for (int rp_ = 0; rp_ < PH_G2; ++rp_) {
        {
            const Frame Fg = fresh(F); const int G = Fg.G, bid = Fg.bid;
            unsigned char* ws = KWS();
            const bool more = layer + 1 < NLAYER;
            pg8::Gemm g{(const bf16*)(ws + WS_XGC), (const bf16*)(ws + WS_WPG + layer * SZ_WPG), MP, DM, DM, DM, DM, 31, 0};
            pg8::StaticOrder S; S.init(MP, DM, G, bid);
            epi::EpiRes E{(float*)(ws + WS_XR), more ? (bf16*)(ws + WS_XGA) : nullptr, more ? KIN(10) + (layer + 1) * DM : nullptr, more ? (float*)(ws + WS_SSA) : nullptr, (float*)(ws + WS_TPLE), (rp_ + 1 < PH_G2) ? 3 : 2, (const float*)(ws + WS_XR)};
            pg8::gemm_phase<epi::EpiRes, pg8::StaticOrder, true, true>(Fg.lds, g, S, E, Fg.tid);
            TREG_SUB(99);
            if (rp_ + 1 == PH_G2) {
                Frame Fs = fresh(F); const SEpiRes Es{(float*)(ws + WS_XR), more ? (bf16*)(ws + WS_XGA) : nullptr, more ? KIN(10) + (layer + 1) * DM : nullptr, more ? (float*)(ws + WS_SSA) : nullptr, (float*)(ws + WS_TPLE), 2, (const float*)(ws + WS_XR)};
                for (int tl = Fs.bid; tl < 256; tl += Fs.G) sgemm_tile(Fs, (const bf16*)(ws + WS_XGC), DM, (const bf16*)(ws + WS_WPG + layer * SZ_WPG), DM, DM, MP + 32 * (tl & 15), 64 * (tl >> 4), Es);
            }
            TREG_SUB(36);
        }
        }
        GRID_BAR();
    TREG_MARK(9);
    }
    for (int xb_ = 0; xb_ < PH_XBAR; ++xb_) GRID_BAR();
    { Frame Fp = fresh(F); for (int r = Fp.bid * NWAVES + Fp.wave; r < MROWS; r += Fp.G * NWAVES) final_row(Fp, r); }
    TREG_MARK(10);
#if PH_TREG >= 0
#if defined(PH_GPT) && PH_GPT >= 0
    tacc_ += *(volatile LAS unsigned long long*)(F.lds + LDSCTL_OFF + 448);
#endif
#if defined(PH_NPT) && PH_NPT >= 0
    tacc_ += *(volatile LAS unsigned long long*)(F.lds + LDSCTL_OFF + 464);
#endif
      { const unsigned long long tend_ = __builtin_amdgcn_s_memrealtime() + tacc_; while (__builtin_amdgcn_s_memrealtime() < tend_) __builtin_amdgcn_s_sleep(8); }
#endif
}

extern "C" void kernel_launch(void* const* d_in, const int* in_sizes, int n_in, void* d_out, int out_size, void* d_ws, size_t ws_size, hipStream_t stream) {
    static int grid = 0;
    if (grid == 0) {
        if (n_in != 27 || ws_size < WS_END) { fprintf(stderr, "kernel_launch: unexpected shapes (n_in %d out %d ws %zu, need %zu)\n", n_in, out_size, ws_size, (size_t)WS_END); grid = -1; return; }
        int dev = 0, cus = 0;
        if (hipGetDevice(&dev) != hipSuccess || hipDeviceGetAttribute(&cus, hipDeviceAttributeMultiprocessorCount, dev) != hipSuccess) { grid = -1; return; }
        if (hipFuncSetAttribute((const void*)mk_fwd, hipFuncAttributeMaxDynamicSharedMemorySize, LDS_BYTES) != hipSuccess) { fprintf(stderr, "kernel_launch: hipFuncSetAttribute failed\n"); grid = -1; return; }
        int per_cu = 0;
        if (hipOccupancyMaxActiveBlocksPerMultiprocessor(&per_cu, (const void*)mk_fwd, NTHREADS, LDS_BYTES) != hipSuccess || per_cu < 1) fprintf(stderr, "kernel_launch: occupancy query reports %d\n", per_cu);
        (void)hipGetLastError();
        grid = cus;
    }
    if (grid < 0) return;
    if (hipMemsetAsync((char*)d_ws + WS_CTL, 0, CTL_ZERO_BYTES, stream) != hipSuccess) return;
    Args a{};
    for (int i = 0; i < 27; ++i) a.in[i] = d_in[i];
    a.out = (float*)d_out; a.ws = (unsigned char*)d_ws;
    hipLaunchKernelGGL(mk_fwd, dim3(grid), dim3(NTHREADS), LDS_BYTES, stream, a);
}
```

```cpp
#include <hip/hip_runtime.h>
#include <cstdio>
#include <cstdint>
namespace pg8 {
#define PG8_LAS __attribute__((address_space(3)))
typedef unsigned short bf16_t;
typedef short bf16x8 __attribute__((ext_vector_type(8)));
typedef float f32x4 __attribute__((ext_vector_type(4)));
typedef unsigned u32x4 __attribute__((ext_vector_type(4)));
constexpr int BM = 256, BK = 64, HALF = 128, HTB = HALF * BK * 2  , STAGE_BYTES = 8 * HTB, NXCD = 8, WGM = 8;

__host__ __device__ __forceinline__ int lds_byte(int r, int c) { const int st = (r >> 4) * 2 + (c >> 5), rr = r & 15, cc = c & 31, ob = rr * 64 + cc * 2; return st * 1024 + (ob ^ (((ob >> 9) & 1) << 5)); }
__host__ __device__ __forceinline__ void stage_rc(int b, int& R, int& C) { const int st = b / 1024, sb = b % 1024, swz = sb ^ (((sb >> 9) & 1) << 5); R = (st >> 1) * 16 + swz / 64; C = (st & 1) * 32 + (swz % 64) / 2; }
__host__ __device__ __forceinline__ int perm32(int rho) { const int n = rho >> 4, i = rho & 15; return 8 * (i >> 2) + 4 * n + (i & 3); }

struct Unit { int pm, pn; };
struct Gemm { const bf16_t* A; const bf16_t* Bt; int M, N, K; int lda, ldb; int a_shift, a_off; };

struct StaticOrder {
    int nM, nN, nwg, G, c;
    __host__ __device__ void init(int M, int N, int G_, int c_) { nM = M / BM; nN = N / BM; nwg = nM * nN; G = G_; c = c_; }
    __host__ __device__ bool next(int i, Unit& u) const {
        const long L = (long)i * G + c; if (L >= nwg) return false;
        int wgid = (int)L; { const int q = nwg / NXCD, r = nwg % NXCD, xcd = wgid % NXCD, off = wgid / NXCD; wgid = (xcd < r ? xcd * (q + 1) : r * (q + 1) + (xcd - r) * q) + off; }
        const int nig = WGM * nN, gid = wgid / nig, fm = gid * WGM, gsz = (nM - fm) < WGM ? (nM - fm) : WGM;
        u.pm = fm + ((wgid % nig) % gsz); u.pn = (wgid % nig) / gsz; return true;
    }
    __device__ __forceinline__ void a_ready(const Unit&) const {}
    __device__ __forceinline__ void done(const Unit&) const {}
};

__device__ __forceinline__ unsigned cvt_pk_bf16(float lo, float hi) { unsigned r; asm volatile("v_cvt_pk_bf16_f32 %0, %1, %2" : "=v"(r) : "v"(lo), "v"(hi)); return r; }
typedef float f32x2 __attribute__((ext_vector_type(2)));
template <class Epi, class Sched, bool ALIGN_EPI = false, bool SP2 = false>
__device__ __forceinline__ void gemm_phase(PG8_LAS unsigned char* lds, const Gemm g, const Sched& S, const Epi& E, const int tid) {
    const int wid = __builtin_amdgcn_readfirstlane(tid >> 6), lane = tid & 63, wr = wid >> 2, wc = wid & 3, fr = lane & 15, fq = lane >> 4;
    const int K = g.K, nt = K / BK;
    unsigned voffA[2], voffB[2];
#pragma unroll
    for (int i = 0; i < 2; ++i) { int R, C; stage_rc(tid * 16 + i * 8192, R, C); const int Rb = Epi::PERM ? ((R & ~31) + perm32(R & 31)) : R;
        voffA[i] = (unsigned)(R * g.lda + C) * 2u; voffB[i] = (unsigned)(Rb * g.ldb + C) * 2u; }
    const size_t kstep = (size_t)(BK * 2);
    const size_t hstepA = (size_t)HALF * g.lda * 2, hstepB = (size_t)HALF * g.ldb * 2;
    const size_t tstepA = 2 * hstepA, tstepB = 2 * hstepB;
    const unsigned ldsw = (unsigned)wid * 1024u;
    const int aoff = lds_byte(wr * 64 + fr, fq * 8), boff = lds_byte(wc * 32 + fr, fq * 8);
#define PG8_SA(b, h) (((b) * 2 + (h)) * HTB)
#define PG8_SB(b, h) ((4 + (b) * 2 + (h)) * HTB)
#define PG8_STAGE(bufoff, gbase, voff) do { _Pragma("unroll") for (int _i = 0; _i < 2; ++_i) \
        __builtin_amdgcn_global_load_lds((const unsigned*)((const char*)(gbase) + (voff)[_i]), (PG8_LAS unsigned*)(lds + (bufoff) + ldsw + _i * 8192), 16, 0, 0); } while (0)
#define PG8_LDA(dst, b, h) do { _Pragma("unroll") for (int m = 0; m < 4; ++m) _Pragma("unroll") for (int k = 0; k < 2; ++k) dst[m][k] = *(const PG8_LAS bf16x8*)(lds + PG8_SA(b, h) + aoff + m * 2048 + k * 1024); } while (0)
#define PG8_LDB(dst, b, h) do { _Pragma("unroll") for (int n = 0; n < 2; ++n) _Pragma("unroll") for (int k = 0; k < 2; ++k) dst[n][k] = *(const PG8_LAS bf16x8*)(lds + PG8_SB(b, h) + boff + n * 2048 + k * 1024); } while (0)
#define PG8_MMA(ai, bj, At, Bt) do { __builtin_amdgcn_s_setprio(1); _Pragma("unroll") for (int m = 0; m < 4; ++m) _Pragma("unroll") for (int n = 0; n < 2; ++n) _Pragma("unroll") for (int k = 0; k < 2; ++k) \
        acc[ai][bj][m][n] = __builtin_amdgcn_mfma_f32_16x16x32_bf16(Bt[n][k], At[m][k], acc[ai][bj][m][n], 0, 0, 0); __builtin_amdgcn_s_setprio(0); } while (0)
#define PG8_WAIT_V(n) asm volatile("s_waitcnt vmcnt(" #n ")" ::: "memory")
#define PG8_WAIT_L(n) asm volatile("s_waitcnt lgkmcnt(" #n ")" ::: "memory")
#define PG8_BAR __builtin_amdgcn_s_barrier()
#define PG8_SCHED __builtin_amdgcn_sched_barrier(0)
    Unit cur, nxt; int ui = 0;
    if (!S.next(0, cur)) return;
    f32x4 acc[2][2][4][2];
#pragma unroll
    for (int a = 0; a < 2; ++a)
#pragma unroll
        for (int b = 0; b < 2; ++b)
#pragma unroll
            for (int m = 0; m < 4; ++m)
#pragma unroll
                for (int n = 0; n < 2; ++n) acc[a][b][m][n] = (f32x4){0.f, 0.f, 0.f, 0.f};
    bf16x8 At[4][2], B0[2][2], B1[2][2];
    const char* cA = (const char*)g.A + (size_t)cur.pm * tstepA + (size_t)(cur.pn >> g.a_shift) * (size_t)g.a_off; const char* cB = (const char*)g.Bt + (size_t)cur.pn * tstepB;
    S.a_ready(cur);
    if constexpr (SP2) {
        PG8_STAGE(PG8_SB(0, 0), cB, voffB); PG8_STAGE(PG8_SB(0, 1), cB + hstepB, voffB); PG8_STAGE(PG8_SA(0, 0), cA, voffA); PG8_STAGE(PG8_SA(0, 1), cA + hstepA, voffA);
        if (wr == 1) PG8_BAR;
        PG8_WAIT_V(2); PG8_BAR;
        PG8_STAGE(PG8_SB(1, 0), cB + kstep, voffB); PG8_STAGE(PG8_SA(1, 0), cA + kstep, voffA); PG8_STAGE(PG8_SB(1, 1), cB + hstepB + kstep, voffB);
        PG8_WAIT_V(6); PG8_BAR;
    } else {
        PG8_STAGE(PG8_SB(0, 0), cB, voffB); PG8_STAGE(PG8_SA(0, 0), cA, voffA); PG8_STAGE(PG8_SB(0, 1), cB + hstepB, voffB); PG8_STAGE(PG8_SA(0, 1), cA + hstepA, voffA);
        if (wr == 1) PG8_BAR;
        PG8_WAIT_V(4); PG8_BAR;
        PG8_STAGE(PG8_SB(1, 0), cB + kstep, voffB); PG8_STAGE(PG8_SA(1, 0), cA + kstep, voffA); PG8_STAGE(PG8_SB(1, 1), cB + hstepB + kstep, voffB);
        PG8_WAIT_V(6); PG8_BAR;
    }
    for (;;) {
        const bool has_next = S.next(ui + 1, nxt);
        const char* nA = has_next ? (const char*)g.A + (size_t)nxt.pm * tstepA + (size_t)(nxt.pn >> g.a_shift) * (size_t)g.a_off : cA; const char* nB = has_next ? (const char*)g.Bt + (size_t)nxt.pn * tstepB : cB;
        for (int t = 0; t < nt; t += 2) {
            const bool last = (t == nt - 2);
            const char* a1 = cA + (size_t)(t + 1) * kstep;
            const char* a2 = last ? nA : cA + (size_t)(t + 2) * kstep; const char* b2 = last ? nB : cB + (size_t)(t + 2) * kstep;
            const char* a3 = a2 + kstep; const char* b3 = b2 + kstep;
            if (last && has_next) S.a_ready(nxt);
            if constexpr (SP2) {
            PG8_LDB(B0, 0, 0); PG8_LDB(B1, 0, 1); PG8_SCHED; PG8_LDA(At, 0, 0); PG8_STAGE(PG8_SA(1, 1), a1 + hstepA, voffA);
            PG8_WAIT_V(8); PG8_WAIT_L(0); PG8_BAR; PG8_MMA(0, 0, At, B0); PG8_MMA(0, 1, At, B1); PG8_BAR; PG8_SCHED;
            PG8_LDA(At, 0, 1); PG8_STAGE(PG8_SB(0, 0), b2, voffB); PG8_STAGE(PG8_SB(0, 1), b2 + hstepB, voffB); PG8_STAGE(PG8_SA(0, 0), a2, voffA);
            PG8_WAIT_V(8); PG8_WAIT_L(0); PG8_BAR; PG8_MMA(1, 0, At, B0); PG8_MMA(1, 1, At, B1); PG8_BAR; PG8_SCHED;
            PG8_LDB(B0, 1, 0); PG8_LDB(B1, 1, 1); PG8_SCHED; PG8_LDA(At, 1, 0); PG8_STAGE(PG8_SA(0, 1), a2 + hstepA, voffA);
            PG8_WAIT_V(8); PG8_WAIT_L(0); PG8_BAR; PG8_MMA(0, 0, At, B0); PG8_MMA(0, 1, At, B1); PG8_BAR; PG8_SCHED;
            PG8_LDA(At, 1, 1); PG8_STAGE(PG8_SB(1, 0), b3, voffB); PG8_STAGE(PG8_SB(1, 1), b3 + hstepB, voffB); PG8_STAGE(PG8_SA(1, 0), a3, voffA);
            PG8_WAIT_V(8); PG8_WAIT_L(0); PG8_BAR; PG8_MMA(1, 0, At, B0); PG8_MMA(1, 1, At, B1); PG8_BAR; PG8_SCHED;
            } else {
            PG8_LDB(B0, 0, 0); PG8_SCHED; PG8_LDA(At, 0, 0); PG8_STAGE(PG8_SA(1, 1), a1 + hstepA, voffA);
            PG8_WAIT_L(8); PG8_BAR; PG8_WAIT_L(0); PG8_MMA(0, 0, At, B0); PG8_BAR; PG8_SCHED;
            PG8_LDB(B1, 0, 1); PG8_STAGE(PG8_SB(0, 0), b2, voffB);
            PG8_BAR; PG8_WAIT_L(0); PG8_MMA(0, 1, At, B1); PG8_BAR;
            PG8_LDA(At, 0, 1); PG8_STAGE(PG8_SA(0, 0), a2, voffA);
            PG8_BAR; PG8_WAIT_L(0); PG8_MMA(1, 0, At, B0); PG8_BAR; PG8_SCHED;
            PG8_STAGE(PG8_SB(0, 1), b2 + hstepB, voffB);
            PG8_WAIT_V(6); PG8_BAR; PG8_MMA(1, 1, At, B1); PG8_BAR;
            PG8_LDB(B0, 1, 0); PG8_SCHED; PG8_LDA(At, 1, 0); PG8_STAGE(PG8_SA(0, 1), a2 + hstepA, voffA);
            PG8_WAIT_L(8); PG8_BAR; PG8_WAIT_L(0); PG8_MMA(0, 0, At, B0); PG8_BAR; PG8_SCHED;
            PG8_LDB(B1, 1, 1); PG8_STAGE(PG8_SB(1, 0), b3, voffB);
            PG8_BAR; PG8_WAIT_L(0); PG8_MMA(0, 1, At, B1); PG8_BAR;
            PG8_LDA(At, 1, 1); PG8_STAGE(PG8_SA(1, 0), a3, voffA);
            PG8_BAR; PG8_WAIT_L(0); PG8_MMA(1, 0, At, B0); PG8_BAR; PG8_SCHED;
            PG8_STAGE(PG8_SB(1, 1), b3 + hstepB, voffB);
            PG8_WAIT_V(6); PG8_BAR; PG8_MMA(1, 1, At, B1); PG8_BAR;
            }
        }
        if constexpr (ALIGN_EPI) { if (wr == 0) PG8_BAR; }
        if constexpr (!Epi::AFTER_DRAIN) { E(acc, cur, wr, wc, fr, fq); S.done(cur); }
        if (!has_next) break;
#pragma unroll
        for (int a = 0; a < 2; ++a)
#pragma unroll
            for (int b = 0; b < 2; ++b)
#pragma unroll
                for (int m = 0; m < 4; ++m)
#pragma unroll
                    for (int n = 0; n < 2; ++n) acc[a][b][m][n] = (f32x4){0.f, 0.f, 0.f, 0.f};
        cur = nxt; cA = nA; cB = nB; ++ui;
        if constexpr (ALIGN_EPI) { if (wr == 1) PG8_BAR; }
    }
    PG8_WAIT_V(0);
    if constexpr (!ALIGN_EPI) { if (wr == 0) PG8_BAR; }
    PG8_BAR;
    if constexpr (Epi::AFTER_DRAIN) { E.fused(acc, cur, wr, wc, fr, fq, lds, wid, lane); S.done(cur); }
#undef PG8_SA
#undef PG8_SB
#undef PG8_STAGE
#undef PG8_LDA
#undef PG8_LDB
#undef PG8_MMA
#undef PG8_WAIT_V
#undef PG8_WAIT_L
#undef PG8_BAR
#undef PG8_SCHED
}
}
#define DI __device__ __forceinline__
#define GAS __attribute__((address_space(1)))
#define LAS __attribute__((address_space(3)))
typedef unsigned short bf16;
typedef unsigned v4u __attribute__((ext_vector_type(4)));
typedef unsigned v2u __attribute__((ext_vector_type(2)));
typedef float f32x4 __attribute__((ext_vector_type(4)));
typedef float f32x2 __attribute__((ext_vector_type(2)));
typedef short bf16x8 __attribute__((ext_vector_type(8)));
typedef short s16x4 __attribute__((ext_vector_type(4)));
typedef GAS unsigned gu32;

constexpr int DM = 1024, TP = 8192, MP = 16384, MS = 512, MROWS = 16896, LDZ = 8704, DFF = 4096, PLE = 256, NLAYER = 2;
constexpr int ZC_Q = 0, ZC_KC = 512, ZC_VC = 640, ZC_KS = 768, ZC_VS = 896, ZC_KW = 1024, ZC_VW = 1152, ZC_GQKV = 1280, ZC_GZ = 2816, ZC_RQKV = 3328, ZC_RG = 4864, ZC_MG = 5376, ZC_SM = 8448;
constexpr float EPS = 1e-6f;
constexpr size_t O_YP = 0, O_YS = O_YP + (size_t)MP * DM, O_KVP = O_YS + (size_t)MS * DM, O_KVS = O_KVP + (size_t)2 * MP * 512, O_WINP = O_KVS + (size_t)2 * MS * 512,
                 O_WINS = O_WINP + (size_t)2 * 2 * 512 * 256, O_CVP = O_WINS + (size_t)2 * 128 * 512 * 256, O_CVS = O_CVP + (size_t)2 * 2 * 3 * 1536, O_GSP = O_CVS + (size_t)2 * 128 * 3 * 1536,
                 O_GSS = O_GSP + (size_t)2 * 2 * 4 * 16384, O_RSP = O_GSS + (size_t)2 * 128 * 4 * 16384, O_RSS = O_RSP + (size_t)2 * 2 * 4 * 16384, O_END = O_RSS + (size_t)2 * 128 * 4 * 16384;

DI float bf2f(unsigned short b) { return __uint_as_float((unsigned)b << 16); }
DI unsigned f2bf(float f) { unsigned u = __float_as_uint(f); return (u + 0x7fffu + ((u >> 16) & 1u)) >> 16; }
typedef __bf16 bf16x2_t __attribute__((ext_vector_type(2)));
DI unsigned pk2(float lo, float hi) { const f32x2 v = {lo, hi}; return __builtin_bit_cast(unsigned, __builtin_convertvector(v, bf16x2_t)); }
DI float lo_bf(unsigned w) { return __uint_as_float(w << 16); }
DI float hi_bf(unsigned w) { return __uint_as_float(w & 0xffff0000u); }
DI float sigmoidf_(float x) { return 1.f / (1.f + __expf(-x)); }
DI float siluf_(float x) { return x / (1.f + __expf(-x)); }
DI v4u pack8(const f32x4 a, const f32x4 b) { v4u w; w.x = pk2(a[0], a[1]); w.y = pk2(a[2], a[3]); w.z = pk2(b[0], b[1]); w.w = pk2(b[2], b[3]); return w; }
DI void unpack8(const v4u w, f32x4& a, f32x4& b) { a[0] = lo_bf(w.x); a[1] = hi_bf(w.x); a[2] = lo_bf(w.y); a[3] = hi_bf(w.y); b[0] = lo_bf(w.z); b[1] = hi_bf(w.z); b[2] = lo_bf(w.w); b[3] = hi_bf(w.w); }

template <int M> DI int shxi(int v, int lane) {
    if constexpr (M < 32) return __builtin_amdgcn_ds_swizzle(v, (M << 10) | 0x1f);
    else return __builtin_amdgcn_ds_bpermute((lane ^ 32) << 2, v);
}
template <int M> DI float shx(float v, int lane) { return __int_as_float(shxi<M>(__float_as_int(v), lane)); }
DI float wave_sum(float v, int lane) { v += shx<1>(v, lane); v += shx<2>(v, lane); v += shx<4>(v, lane); v += shx<8>(v, lane); v += shx<16>(v, lane); v += shx<32>(v, lane); return v; }

namespace epi {
using pg8::Unit; using pg8::bf16_t;
DI float row_rstd(const float* SS, int row, int fq, int lane) {
    const f32x4 p = *(const f32x4*)(SS + (size_t)row * 16 + 4 * fq);
    float s = (p[0] + p[1]) + (p[2] + p[3]); s += shx<16>(s, lane); s += shx<32>(s, lane);
    return rsqrtf(s * (1.f / DM) + EPS);
}
struct EpiA {
    static constexpr bool PERM = true, AFTER_DRAIN = false;
    bf16* Z; float* ZS; const float* SS; float* out; int layer;
    DI void operator()(const f32x4 (&acc)[2][2][4][2], const Unit& u, int wr, int wc, int fr, int fq) const {
        asm volatile("" : "+v"(fr), "+v"(fq), "+s"(wr), "+s"(wc));
        const int pn = u.pn;
        float rs[2][4];
#pragma unroll
        for (int ai = 0; ai < 2; ++ai)
#pragma unroll
            for (int m = 0; m < 4; ++m) rs[ai][m] = row_rstd(SS, u.pm * 256 + ai * 128 + wr * 64 + m * 16 + fr, fq, fr + 16 * fq);
#pragma unroll
        for (int ai = 0; ai < 2; ++ai)
#pragma unroll
            for (int m = 0; m < 4; ++m) {
                const int row = u.pm * 256 + ai * 128 + wr * 64 + m * 16 + fr;
                const float rstd = rs[ai][m];
#pragma unroll
                for (int bj = 0; bj < 2; ++bj) {
                    const int col = pn * 256 + bj * 128 + wc * 32 + 8 * fq;
                    const f32x4 v0 = acc[ai][bj][m][0] * rstd, v1 = acc[ai][bj][m][1] * rstd;
                    *(v4u*)(Z + (size_t)row * LDZ + col) = pack8(v0, v1);
                    float* dst = nullptr;
                    if (pn == 2 || pn == 3) {
                        dst = (row < MP) ? out + O_KVP + ((size_t)layer * MP + row) * 512 + (col - 512) : out + O_KVS + ((size_t)layer * MS + (row - MP)) * 512 + (col - 512);
                    } else if (pn == 4) {
                        const int c2 = col - 1024;
                        if (row < MP) { const int t = row & (TP - 1), b = row >> 13; if (t >= TP - 512) dst = out + O_WINP + ((size_t)(layer * 2 + b) * 512 + (t - (TP - 512))) * 256 + c2; }
                        else { const int r2 = row - MP, s = r2 >> 2, j = r2 & 3; dst = out + O_WINS + ((size_t)(layer * 128 + s) * 512 + 508 + j) * 256 + c2; }
                    } else if (pn >= 5 && pn < 11) {
                        const int c2 = col - 1280;
                        if (row < MP) { const int t = row & (TP - 1), b = row >> 13; if (t >= TP - 3) dst = out + O_CVP + ((size_t)(layer * 2 + b) * 3 + (t - (TP - 3))) * 1536 + c2; }
                        else { const int r2 = row - MP, s = r2 >> 2, j = r2 & 3; if (j >= 1) dst = out + O_CVS + ((size_t)(layer * 128 + s) * 3 + (j - 1)) * 1536 + c2; }
                    } else if (pn == 33) {
                        if (bj == 0 && wc == 0) dst = ZS + (size_t)row * 32 + 8 * fq;
                    }
                    if (dst) { *(f32x4*)dst = v0; *(f32x4*)(dst + 4) = v1; }
                }
                asm volatile("" ::: "memory");
            }
    }
};
struct EpiC {
    static constexpr bool PERM = true, AFTER_DRAIN = false;
    const bf16* Z; bf16* G;
    DI void operator()(const f32x4 (&acc)[2][2][4][2], const Unit& u, int wr, int wc, int fr, int fq) const {
        asm volatile("" : "+v"(fr), "+v"(fq), "+s"(wr), "+s"(wc));
#pragma unroll
        for (int ai = 0; ai < 2; ++ai) {
            v4u gw[4][2];
#pragma unroll
            for (int m = 0; m < 4; ++m)
#pragma unroll
                for (int bj = 0; bj < 2; ++bj) gw[m][bj] = *(const v4u*)(Z + (size_t)(u.pm * 256 + ai * 128 + wr * 64 + m * 16 + fr) * LDZ + ZC_MG + u.pn * 256 + bj * 128 + wc * 32 + 8 * fq);
#pragma unroll
            for (int m = 0; m < 4; ++m) {
                const int row = u.pm * 256 + ai * 128 + wr * 64 + m * 16 + fr;
#pragma unroll
                for (int bj = 0; bj < 2; ++bj) {
                    const int col = u.pn * 256 + bj * 128 + wc * 32 + 8 * fq;
                    f32x4 g0, g1; unpack8(gw[m][bj], g0, g1);
                    f32x4 v0 = acc[ai][bj][m][0], v1 = acc[ai][bj][m][1];
#pragma unroll
                    for (int e = 0; e < 4; ++e) { v0[e] *= sigmoidf_(g0[e]); v1[e] *= sigmoidf_(g1[e]); }
                    *(v4u*)(G + (size_t)row * 3072 + col) = pack8(v0, v1);
                }
            }
            asm volatile("" ::: "memory");
        }
    }
};
struct EpiCM {
    static constexpr bool PERM = true, AFTER_DRAIN = false;
    const bf16* Z; bf16* MRG; float* PART;
    DI void operator()(const f32x4 (&acc)[2][2][4][2], const Unit& u, int wr, int wc, int fr, int fq) const {
        asm volatile("" : "+v"(fr), "+v"(fq), "+s"(wr), "+s"(wc));
        const int b = u.pn >> 2, pn4 = u.pn & 3;
#pragma unroll
        for (int ai = 0; ai < 2; ++ai)
#pragma unroll
            for (int mp = 0; mp < 2; ++mp) {
                v4u gw[2][2];
#pragma unroll
                for (int mm = 0; mm < 2; ++mm)
#pragma unroll
                    for (int bj = 0; bj < 2; ++bj) gw[mm][bj] = *(const v4u*)(Z + (size_t)(u.pm * 256 + ai * 128 + wr * 64 + (2 * mp + mm) * 16 + fr) * LDZ + ZC_MG + b * 1024 + pn4 * 256 + bj * 128 + wc * 32 + 8 * fq);
#pragma unroll
                for (int mm = 0; mm < 2; ++mm) {
                    const int m = 2 * mp + mm;
                    const int row = u.pm * 256 + ai * 128 + wr * 64 + m * 16 + fr;
#pragma unroll
                    for (int bj = 0; bj < 2; ++bj) {
                        const int oc = pn4 * 256 + bj * 128 + wc * 32 + 8 * fq;
                        const size_t o = (size_t)row * DM + oc;
                        f32x4 g0, g1; unpack8(gw[mm][bj], g0, g1);
                        f32x4 v0 = acc[ai][bj][m][0], v1 = acc[ai][bj][m][1];
#pragma unroll
                        for (int e = 0; e < 4; ++e) { v0[e] *= sigmoidf_(g0[e]); v1[e] *= sigmoidf_(g1[e]); }
                        { const float fb = b > 0 ? 1.f : 0.f; v0 += *(const f32x4*)(PART + o) * fb; v1 += *(const f32x4*)(PART + o + 4) * fb; }
                        if (b < 2) { *(f32x4*)(PART + o) = v0; *(f32x4*)(PART + o + 4) = v1; }
                        else *(v4u*)(MRG + o) = pack8(v0, v1);
                    }
                }
                asm volatile("" ::: "memory");
            }
    }
};
}
namespace pg8 {
struct BranchOrder {
    StaticOrder S1;
    __host__ __device__ void init(int M, int G_, int c_) { S1.init(M, 1024, G_, c_); }
    __host__ __device__ bool next(int i, Unit& u) const { if (i >= 3) return false; const bool ok = S1.next(0, u); u.pn += 4 * i; return ok; }
    __device__ __forceinline__ void a_ready(const Unit&) const {}
    __device__ __forceinline__ void done(const Unit&) const {}
};
}
namespace epi {
using pg8::Unit; using pg8::bf16_t;
struct EpiRes {
    static constexpr bool PERM = true, AFTER_DRAIN = false;
    float* XR; bf16* XG; const float* gvec; float* SS; float* T; int mode;
    const float* XRr;
    DI void operator()(const f32x4 (&acc)[2][2][4][2], const Unit& u, int wr, int wc, int fr, int fq) const {
        asm volatile("" : "+v"(fr), "+v"(fq), "+s"(wr), "+s"(wc));
        if (mode == 3) return;
        if (mode == 1) {
#pragma unroll
            for (int ai = 0; ai < 2; ++ai)
#pragma unroll
                for (int m = 0; m < 4; ++m)
#pragma unroll
                    for (int bj = 0; bj < 2; ++bj) { const size_t o = (size_t)(u.pm * 256 + ai * 128 + wr * 64 + m * 16 + fr) * DM + u.pn * 256 + bj * 128 + wc * 32 + 8 * fq;
                        *(v4u*)((bf16*)T + o) = pack8(acc[ai][bj][m][0], acc[ai][bj][m][1]); }
            return;
        }
#pragma unroll
        for (int ai = 0; ai < 2; ++ai)
#pragma unroll
            for (int mp = 0; mp < 2; ++mp) {
                f32x4 xr[2][2][2], tt[2][2][2];
#pragma unroll
                for (int mm = 0; mm < 2; ++mm)
#pragma unroll
                    for (int bj = 0; bj < 2; ++bj) { const size_t o = (size_t)(u.pm * 256 + ai * 128 + wr * 64 + (2 * mp + mm) * 16 + fr) * DM + u.pn * 256 + bj * 128 + wc * 32 + 8 * fq;
                        xr[mm][bj][0] = *(const f32x4*)(XRr + o); xr[mm][bj][1] = *(const f32x4*)(XRr + o + 4);
                        if (mode == 2) unpack8(*(const v4u*)((const bf16*)T + o), tt[mm][bj][0], tt[mm][bj][1]); }
#pragma unroll
                for (int mm = 0; mm < 2; ++mm) {
                    const int m = 2 * mp + mm;
                    const int row = u.pm * 256 + ai * 128 + wr * 64 + m * 16 + fr;
                    float ssq = 0.f;
#pragma unroll
                    for (int bj = 0; bj < 2; ++bj) {
                        const int col = u.pn * 256 + bj * 128 + wc * 32 + 8 * fq;
                        const size_t o = (size_t)row * DM + col;
                        f32x4 a0 = acc[ai][bj][m][0], a1 = acc[ai][bj][m][1];
                        f32x4 x0 = xr[mm][bj][0], x1 = xr[mm][bj][1];
                        if (mode == 2) {
#pragma unroll
                            for (int e = 0; e < 4; ++e) { a0[e] = tt[mm][bj][0][e] * sigmoidf_(a0[e]); a1[e] = tt[mm][bj][1][e] * sigmoidf_(a1[e]); } }
                        x0 += a0; x1 += a1;
                        *(f32x4*)(XR + o) = x0; *(f32x4*)(XR + o + 4) = x1;
                        ssq += (x0[0] * x0[0] + x0[1] * x0[1]) + (x0[2] * x0[2] + x0[3] * x0[3]) + (x1[0] * x1[0] + x1[1] * x1[1]) + (x1[2] * x1[2] + x1[3] * x1[3]);
                        if (XG) { if (gvec) { const f32x4 g0 = *(const f32x4*)(gvec + col), g1 = *(const f32x4*)(gvec + col + 4); x0 *= g0; x1 *= g1; }
                            *(v4u*)(XG + o) = pack8(x0, x1); }
                    }
                    if (SS) { ssq += shx<16>(ssq, fr + 16 * fq); ssq += shx<32>(ssq, fr + 16 * fq); if (fq == 0) SS[(size_t)row * 16 + u.pn * 4 + wc] = ssq; }
                }
                asm volatile("" ::: "memory");
            }
    }
};
struct EpiUp {
    static constexpr bool PERM = true, AFTER_DRAIN = false;
    bf16* H; const float* SS;
    DI void operator()(const f32x4 (&acc)[2][2][4][2], const Unit& u, int wr, int wc, int fr, int fq) const {
        asm volatile("" : "+v"(fr), "+v"(fq), "+s"(wr), "+s"(wc));
        float rs[2][4];
#pragma unroll
        for (int ai = 0; ai < 2; ++ai)
#pragma unroll
            for (int m = 0; m < 4; ++m) rs[ai][m] = row_rstd(SS, u.pm * 256 + ai * 128 + wr * 64 + m * 16 + fr, fq, fr + 16 * fq);
#pragma unroll
        for (int ai = 0; ai < 2; ++ai)
#pragma unroll
            for (int m = 0; m < 4; ++m) {
                const int row = u.pm * 256 + ai * 128 + wr * 64 + m * 16 + fr;
                const float rstd = rs[ai][m];
#pragma unroll
                for (int bj = 0; bj < 2; ++bj) {
                    const int col = u.pn * 256 + bj * 128 + wc * 32 + 8 * fq;
                    f32x4 v0 = acc[ai][bj][m][0] * rstd, v1 = acc[ai][bj][m][1] * rstd;
#pragma unroll
                    for (int e = 0; e < 4; ++e) { const float a = fmaxf(v0[e], 0.f), b = fmaxf(v1[e], 0.f); v0[e] = a * a; v1[e] = b * b; }
                    *(v4u*)(H + (size_t)row * DFF + col) = pack8(v0, v1);
                }
                asm volatile("" ::: "memory");
            }
    }
};
}
constexpr size_t al256(size_t x) { return (x + 255) & ~(size_t)255; }
constexpr size_t WS_CTL = 0, CTL_ZERO_BYTES = 1u << 20;
constexpr size_t SZ_WIN = (size_t)LDZ * DM * 2, SZ_WBR = (size_t)3072 * 512 * 2, SZ_WO3 = (size_t)DM * 3072 * 2, SZ_WUP = (size_t)DFF * DM * 2, SZ_WDN = (size_t)DM * DFF * 2,
                 SZ_WPL = (size_t)DM * PLE * 2, SZ_WPG = (size_t)DM * DM * 2, SZ_W1T = (size_t)2 * 64 * 2048 * 2, SZ_W2T = (size_t)2 * 64 * 64 * 2;
constexpr size_t WS_WIN = CTL_ZERO_BYTES, WS_WBR = WS_WIN + 2 * SZ_WIN, WS_WO3 = WS_WBR + 2 * SZ_WBR, WS_WUP = WS_WO3 + 2 * SZ_WO3, WS_WDN = WS_WUP + 2 * SZ_WUP,
                 WS_WPL = WS_WDN + 2 * SZ_WDN, WS_WPG = WS_WPL + 2 * SZ_WPL, WS_W1T = WS_WPG + 2 * SZ_WPG, WS_W2T = WS_W1T + 2 * SZ_W1T, WS_ROT = al256(WS_W2T + 2 * SZ_W2T);
constexpr size_t WS_P16 = WS_ROT + (size_t)TP * 64 * 8;
constexpr size_t WS_XR = WS_P16 + (size_t)2 * MROWS * PLE * 2;
constexpr size_t WS_XGA = WS_XR + (size_t)MROWS * DM * 4, WS_XGB = WS_XGA + (size_t)MROWS * DM * 2, WS_XGC = WS_XGB + (size_t)MROWS * DM * 2;
constexpr size_t WS_SSA = WS_XGC + (size_t)MROWS * DM * 2, WS_SSB = WS_SSA + (size_t)MROWS * 64;
constexpr size_t WS_Z = WS_SSB + (size_t)MROWS * 64, WS_ZS = WS_Z + (size_t)MROWS * LDZ * 2;
constexpr size_t WS_MIX = WS_ZS + (size_t)MROWS * 128, WS_GATED = WS_MIX + (size_t)MROWS * 1536 * 2, WS_HMID = WS_GATED + (size_t)MROWS * 3072 * 2;
constexpr size_t WS_TPLE = WS_HMID + (size_t)MROWS * DFF * 2;
constexpr size_t WS_KC = WS_TPLE + (size_t)MROWS * DM * 4;
constexpr size_t WS_KCS = WS_KC + (size_t)2 * 2 * 512 * 2 * 64 * 2;
constexpr int GREC = 73984;
constexpr size_t WS_GREC = WS_KCS + (size_t)2 * 128 * 128 * 2 * 64 * 2;
constexpr size_t WS_OGDN = WS_GREC + (size_t)1024 * GREC;
constexpr size_t WS_RKV = WS_OGDN + (size_t)MROWS * 512 * 4;
constexpr size_t WS_RST = WS_RKV + (size_t)512 * 16384 * 4;
constexpr size_t WS_QR = WS_RST + (size_t)512 * 16384 * 2, WS_KR = WS_QR + (size_t)MP * 512 * 2;
constexpr size_t WS_MRG = WS_KR + (size_t)MP * 512 * 2;
constexpr size_t WS_PART = WS_MRG + (size_t)MP * DM * 2;
constexpr size_t WS_END = WS_PART + (size_t)MP * DM * 4;
static_assert(WS_W1T % 256 == 0 && WS_Z % 256 == 0 && WS_GREC % 256 == 0 && WS_RKV % 256 == 0 && WS_KC % 256 == 0 && WS_XR % 256 == 0, "ws alignment");

constexpr int CW_TMO = 0, CW_BAR = 4096, CW_QUEUE = 8192;
constexpr int NWAVES = 8, NTHREADS = 512;
constexpr int RING_BYTES = 147456, LDSCTL_OFF = RING_BYTES, MISC_OFF = LDSCTL_OFF + 320, LDS_BYTES = RING_BYTES + 1024;

#define RLX_AGENT __ATOMIC_RELAXED, __HIP_MEMORY_SCOPE_AGENT
#define LDS_WAIT() asm volatile("s_waitcnt lgkmcnt(0)" ::: "memory")
#define VM_WAIT() asm volatile("s_waitcnt vmcnt(0)" ::: "memory")
#define XB_TMO      128
#define XB_XCNT(j)  (256  + 64 * (j))
#define XB_XSUB(j)  (1280 + 64 * (j))
#define XB_XGEN(j)  (2304 + 64 * (j))
#define XB_TOP      3328
#define XB_TOPGEN   3392
#define XCD_BAR_WORDS 3456
#define XB_SPIN_CAP (1u << 18)

__device__ __forceinline__ unsigned xb_ld(unsigned* p)              { return __hip_atomic_load(p, __ATOMIC_RELAXED, __HIP_MEMORY_SCOPE_AGENT); }
__device__ __forceinline__ unsigned xb_add(unsigned* p, unsigned v) { return __hip_atomic_fetch_add(p, v, __ATOMIC_RELAXED, __HIP_MEMORY_SCOPE_AGENT); }
__device__ __forceinline__ unsigned xb_xcc_id() { return (unsigned)__builtin_amdgcn_s_getreg((3 << 11) | 20) & 0xFu; }
#define XB_SPIN(cond, bar) do { unsigned _sp = 0; while (cond) { __builtin_amdgcn_s_sleep(1); \
    if ((++_sp & 255u) == 0u) { if (xb_ld(&(bar)[XB_TMO])) break; if (_sp > XB_SPIN_CAP) { atomicAdd(&(bar)[XB_TMO], 1u); break; } } } } while (0)

struct XcdBarrier {
    unsigned* bar; unsigned x;
    volatile LAS unsigned* st;
};

__device__ __forceinline__ XcdBarrier xcd_barrier_post(unsigned* bar, volatile LAS unsigned* st, bool t0) {
    XcdBarrier b; b.bar = bar; b.x = xb_xcc_id(); b.st = st;
    if (t0) (void)xb_add(&bar[XB_XCNT(b.x)], 1u);
    return b;
}
__device__ __forceinline__ void xcd_barrier_complete(unsigned* bar, unsigned x, unsigned& nloc, unsigned& nx) {
    const unsigned G = gridDim.x * gridDim.y * gridDim.z;
    unsigned sum, cnt, mine, sp = 0u;
    for (;;) {
        sum = 0u; cnt = 0u; mine = 0u;
#pragma unroll
        for (unsigned j = 0; j < 16; ++j) { const unsigned c = xb_ld(&bar[XB_XCNT(j)]); sum += c; cnt += (c > 0u) ? 1u : 0u; mine = (j == x) ? c : mine; }
        if (sum == G) break;
        __builtin_amdgcn_s_sleep(1);
        if ((++sp & 255u) == 0u) { if (xb_ld(&bar[XB_TMO])) break; if (sp > XB_SPIN_CAP) { atomicAdd(&bar[XB_TMO], 1u); break; } }
    }
    nloc = mine > 0u ? mine : 1u; nx = cnt > 0u ? cnt : 1u;
}

__device__ __forceinline__ void xcd_barrier(const XcdBarrier& b, bool t0) {
    asm volatile("s_waitcnt vmcnt(0)" ::: "memory");
    __syncthreads();
    if (t0) {
        unsigned* bar = b.bar;
        __builtin_amdgcn_s_waitcnt(0);
        unsigned nloc = b.st[0], nx = b.st[1];
        if (nloc == 0u) { xcd_barrier_complete(bar, b.x, nloc, nx); b.st[0] = nloc; b.st[1] = nx; }
        const unsigned old = xb_add(&bar[XB_XSUB(b.x)], 1u);
        const unsigned gen = old / nloc;
        if (old + 1u == (gen + 1u) * nloc) {
            __builtin_amdgcn_fence(__ATOMIC_RELEASE, "agent");
            asm volatile("s_waitcnt vmcnt(0)" ::: "memory");
            const unsigned og = xb_add(&bar[XB_TOP], 1u);
            const unsigned tg = og / nx;
            if (og + 1u == (tg + 1u) * nx) xb_add(&bar[XB_TOPGEN], 1u);
            else XB_SPIN(xb_ld(&bar[XB_TOPGEN]) == tg, bar);
            __builtin_amdgcn_fence(__ATOMIC_ACQUIRE, "agent");
            xb_add(&bar[XB_XGEN(b.x)], 1u);
            asm volatile("s_waitcnt vmcnt(0)" ::: "memory");
        } else {
            XB_SPIN(xb_ld(&bar[XB_XGEN(b.x)]) == gen, bar);
            __builtin_amdgcn_fence(__ATOMIC_ACQUIRE, "agent");
            asm volatile("s_waitcnt vmcnt(0)" ::: "memory");
        }
    }
    __syncthreads();
}
typedef const void* const __attribute__((address_space(4)))* kargp_t;
DI const float* KIN(int i) { const GAS float* p = (const GAS float*)((kargp_t)__builtin_amdgcn_kernarg_segment_ptr())[i]; asm volatile("" : "+s"(p)); return (const float*)p; }
DI float* KOUT() { GAS float* p = (GAS float*)((kargp_t)__builtin_amdgcn_kernarg_segment_ptr())[27]; asm volatile("" : "+s"(p)); return (float*)p; }
DI unsigned char* KWS() { GAS unsigned char* p = (GAS unsigned char*)((kargp_t)__builtin_amdgcn_kernarg_segment_ptr())[28]; asm volatile("" : "+s"(p)); return (unsigned char*)p; }
struct Frame {
    LAS unsigned char* lds;
    gu32* ctl;
    int tid, lane, wave, G, bid;
};
DI bf16x8 ld_frag_g(const bf16* p) { return __builtin_bit_cast(bf16x8, *(const v4u*)p); }
DI bf16x8 ld_frag_l(const LAS unsigned char* p) { return *(const LAS bf16x8*)p; }
DI f32x4 mfma16(bf16x8 a, bf16x8 b, f32x4 c) { return __builtin_amdgcn_mfma_f32_16x16x32_bf16(a, b, c, 0, 0, 0); }
DI bf16x8 pack_frag(const f32x4 a, const f32x4 b) { return __builtin_bit_cast(bf16x8, pack8(a, b)); }
DI int lane_id() { int l; asm volatile("v_mbcnt_lo_u32_b32 %0, -1, 0\n\tv_mbcnt_hi_u32_b32 %0, -1, %0" : "=v"(l)); return l; }
DI Frame fresh(const Frame& F0) {
    Frame F = F0; int w = F0.wave, g = F0.G, b = F0.bid; asm volatile("" : "+s"(w), "+s"(g), "+s"(b));
    int l = lane_id(); asm volatile("" : "+v"(l));
    unsigned lb = (unsigned)(uintptr_t)F0.lds; asm volatile("" : "+s"(lb)); F.lds = (LAS unsigned char*)(uintptr_t)lb;
    F.wave = w; F.lane = l; F.tid = w * 64 + l; F.G = g; F.bid = b; return F;
}
#define GRID_BAR() do { XcdBarrier b_; b_.bar = (unsigned*)((gu32*)(KWS() + WS_CTL) + CW_BAR); b_.x = xb_xcc_id(); b_.st = (volatile LAS unsigned*)(F.lds + MISC_OFF) + 8; \
    const Frame Fb_ = fresh(F); xcd_barrier(b_, Fb_.tid == 0); } while (0)
DI int win_colmap(int j) {
    if (j < 1280) return j; if (j < 2816) return j + 24; if (j < 8448) return j + 32; if (j < 8472) return j - 8448 + 1280; if (j < 8480) return j - 8472 + 2840; return -1;
}
DI void tr_item(const float* W, int ldw, int k0, int srccol, bf16* WT, size_t dst_row0, int ldt, int kdst0, int nrep, int krep, LAS float* scr, int lane) {
#pragma unroll 8
    for (int i = 0; i < 32; ++i) { const int kk = 2 * i + (lane >> 5); const float v_ = W[(size_t)(k0 + kk) * ldw + (srccol >= 0 ? srccol : 0)]; scr[kk * 33 + (lane & 31)] = (srccol >= 0) ? v_ : 0.f; }
    LDS_WAIT(); asm volatile("" ::: "memory");
    const int c = lane & 7;
#pragma unroll
    for (int j = 0; j < 4; ++j) { const int n = (lane >> 3) + 8 * j; const LAS float* s = scr + (8 * c) * 33 + n;
        v4u o; o.x = pk2(s[0 * 33], s[1 * 33]); o.y = pk2(s[2 * 33], s[3 * 33]); o.z = pk2(s[4 * 33], s[5 * 33]); o.w = pk2(s[6 * 33], s[7 * 33]);
        for (int r = 0; r < nrep; ++r) *(v4u*)(WT + (dst_row0 + n) * (size_t)ldt + kdst0 + r * krep + 8 * c) = o; }
    LDS_WAIT(); asm volatile("" ::: "memory");
}
DI void p0_prologue(Frame& F) {
    LAS float* scr = (LAS float*)(F.lds + F.wave * 16384);
    const int gw = F.bid * NWAVES + F.wave, NGW = F.G * NWAVES, lane = F.lane;
    unsigned char* ws = KWS();
    constexpr int I_A = 16 * 272, I_B = 3 * 8 * 32, I_C = 16 * 32, I_D = 16 * 128, I_E = 64 * 32, I_F = 4 * 32, I_G = 16 * 32, I_H = 2 * 32 * 2, I_I = 2 * 2;
    constexpr int I_L = I_A + I_B + I_C + I_D + I_E + I_F + I_G + I_H + I_I;
    for (int it = gw; it < 2 * I_L; it += NGW) {
        const int l = it / I_L; int r = it % I_L;
        if (r < I_A) { const int kb = r / 272, nb = r % 272; tr_item(KIN(11) + (size_t)l * DM * 8480, 8480, 64 * kb, win_colmap(32 * nb + (lane & 31)), (bf16*)(ws + WS_WIN + l * SZ_WIN), 32 * nb, DM, 64 * kb, 1, 0, scr, lane); continue; } r -= I_A;
        if (r < I_B) { const int b = r / 256, kb = (r % 256) / 32, nb = r % 32; tr_item(KIN(19) + (size_t)(l * 3 + b) * 512 * DM, DM, 64 * kb, 32 * nb + (lane & 31), (bf16*)(ws + WS_WBR + l * SZ_WBR), b * 1024 + 32 * nb, 512, 64 * kb, 1, 0, scr, lane); continue; } r -= I_B;
        if (r < I_C) { const int kb = r / 32, nb = r % 32; tr_item(KIN(20) + (size_t)l * DM * DM, DM, 64 * kb, 32 * nb + (lane & 31), (bf16*)(ws + WS_WO3 + l * SZ_WO3), 32 * nb, 3072, 64 * kb, 3, 1024, scr, lane); continue; } r -= I_C;
        if (r < I_D) { const int kb = r / 128, nb = r % 128; tr_item(KIN(22) + (size_t)l * DM * DFF, DFF, 64 * kb, 32 * nb + (lane & 31), (bf16*)(ws + WS_WUP + l * SZ_WUP), 32 * nb, DM, 64 * kb, 1, 0, scr, lane); continue; } r -= I_D;
        if (r < I_E) { const int kb = r / 32, nb = r % 32; tr_item(KIN(23) + (size_t)l * DFF * DM, DM, 64 * kb, 32 * nb + (lane & 31), (bf16*)(ws + WS_WDN + l * SZ_WDN), 32 * nb, DFF, 64 * kb, 1, 0, scr, lane); continue; } r -= I_E;
        if (r < I_F) { const int kb = r / 32, nb = r % 32; tr_item(KIN(24) + (size_t)l * PLE * DM, DM, 64 * kb, 32 * nb + (lane & 31), (bf16*)(ws + WS_WPL + l * SZ_WPL), 32 * nb, PLE, 64 * kb, 1, 0, scr, lane); continue; } r -= I_F;
        if (r < I_G) { const int kb = r / 32, nb = r % 32; tr_item(KIN(25) + (size_t)l * DM * DM, DM, 64 * kb, 32 * nb + (lane & 31), (bf16*)(ws + WS_WPG + l * SZ_WPG), 32 * nb, DM, 64 * kb, 1, 0, scr, lane); continue; } r -= I_G;
        if (r < I_H) { const int kv = r / 64, kb = (r % 64) / 2, nb = r % 2; tr_item(KIN(13) + (size_t)(l * 2 + kv) * 2048 * 64, 64, 64 * kb, 32 * nb + (lane & 31), (bf16*)(ws + WS_W1T + l * SZ_W1T) + (size_t)kv * 64 * 2048, 32 * nb, 2048, 64 * kb, 1, 0, scr, lane); continue; } r -= I_H;
        { const int kv = r / 2, nb = r % 2; tr_item(KIN(14) + (size_t)(l * 2 + kv) * 64 * 64, 64, 0, 32 * nb + (lane & 31), (bf16*)(ws + WS_W2T + l * SZ_W2T) + (size_t)kv * 64 * 64, 32 * nb, 64, 0, 1, 0, scr, lane); }
    }
    bf16* XGA = (bf16*)(ws + WS_XGA); float* SSA = (float*)(ws + WS_SSA); bf16* P16 = (bf16*)(ws + WS_P16);
    const float* g0 = KIN(10);
    for (int row = gw; row < MROWS; row += NGW) {
        const float* xs = (row < MP) ? KIN(0) + (size_t)row * DM : KIN(1) + (size_t)(row - MP) * DM;
        float ss = 0.f;
#pragma unroll
        for (int j = 0; j < 2; ++j) {
            const int c = j * 512 + lane * 8;
            f32x4 a = *(const f32x4*)(xs + c), b = *(const f32x4*)(xs + c + 4);
            ss += (a[0] * a[0] + a[1] * a[1]) + (a[2] * a[2] + a[3] * a[3]) + (b[0] * b[0] + b[1] * b[1]) + (b[2] * b[2] + b[3] * b[3]);
            const f32x4 ga = *(const f32x4*)(g0 + c), gb = *(const f32x4*)(g0 + c + 4);
            *(v4u*)(XGA + (size_t)row * DM + c) = pack8(a * ga, b * gb);
        }
        ss = wave_sum(ss, lane);
        if (lane < 16) SSA[(size_t)row * 16 + lane] = (lane == 0) ? ss : 0.f;
#pragma unroll
        for (int l = 0; l < 2; ++l) {
            const float* ps = (row < MP) ? KIN(8) + ((size_t)l * MP + row) * PLE : KIN(9) + ((size_t)l * MS + (row - MP)) * PLE;
            const f32x4 a = *(const f32x4*)(ps + lane * 4);
            v2u o; o.x = pk2(a[0], a[1]); o.y = pk2(a[2], a[3]);
            *(v2u*)(P16 + ((size_t)l * MROWS + row) * PLE + lane * 4) = o;
        }
    }
    const int gt = F.bid * NTHREADS + F.tid, NGT = F.G * NTHREADS;
    f32x2* ROT = (f32x2*)(ws + WS_ROT);
    for (int e = gt; e < TP * 64; e += NGT) {
        const int pos = e >> 6, i = e & 63;
        const float x = (float)i * (1.0f / 63.0f);
        const float inv = exp2f(-x * 13.287712379549449f);
        const float ang = (float)pos * inv;
        const double rev = (double)ang * 0.15915494309189535;
        const float fr = (float)(rev - floor(rev));
        ROT[e] = (f32x2){__builtin_amdgcn_cosf(fr), __builtin_amdgcn_sinf(fr)};
    }
}
DI float gelu_tanh(float x) { const float u = 0.7978845608028654f * (x + 0.044715f * x * x * x); const float e = __expf(2.f * u); return 0.5f * x * (1.f + (1.f - 2.f / (e + 1.f))); }
DI bf16x8 mk_frag(v2u a, v2u b) { v4u w; w.x = a.x; w.y = a.y; w.z = b.x; w.w = b.y; return __builtin_bit_cast(bf16x8, w); }

template <bool sample> DI void compress_job_t(Frame& F, int layer, int job) {
    int lane = F.lane, wave = F.wave; asm volatile("" : "+v"(lane), "+s"(wave));
    const int tid = wave * 64 + lane, quad = lane >> 4, rl = lane & 15;
    unsigned char* ws = KWS();
    int kv, bs, g0, nbase;
    if (sample) { kv = job >> 7; bs = job & 127; g0 = 0; nbase = 0; }
    else { const int j2 = job - 256; kv = j2 >> 3; bs = (j2 >> 2) & 1; g0 = (j2 >> 1) & 1; nbase = (j2 & 1) * 256; }
    const bf16* W1T = (const bf16*)(ws + WS_W1T + layer * SZ_W1T) + (size_t)kv * 64 * 2048;
    const bf16* W2T = (const bf16*)(ws + WS_W2T + layer * SZ_W2T) + (size_t)kv * 64 * 64;
    const float* pe = KIN(12) + (size_t)(layer * 2 + kv) * 32 * 64;
    const bf16* Z = (const bf16*)(ws + WS_Z);
    const int* pt = (const int*)KIN(7);
    const float* cache = KIN(2);
    LAS unsigned char* LW = F.lds;
    int gg[2], nn[2];
    size_t pb0[2], pb1[2];
#pragma unroll
    for (int tl = 0; tl < 2; ++tl) { const int T = 2 * wave + tl; if (sample) { gg[tl] = T >> 3; nn[tl] = 16 * (T & 7) + rl; } else { gg[tl] = g0; nn[tl] = nbase + 16 * T + rl; }
        pb0[tl] = 0; pb1[tl] = 0;
        if (sample) { const int p0 = (16 * nn[tl]) >> 7; const int p1 = p0 + 1 > 15 ? 15 : p0 + 1;
            pb0[tl] = (size_t)(layer * 2560 + pt[bs * 16 + p0]) * 128 * 512; pb1[tl] = (size_t)(layer * 2560 + pt[bs * 16 + p1]) * 128 * 512; } }
    f32x4 h[2][4];
#pragma unroll
    for (int tl = 0; tl < 2; ++tl)
#pragma unroll
        for (int i = 0; i < 4; ++i) h[tl][i] = (f32x4){0.f, 0.f, 0.f, 0.f};
#pragma unroll 1
    for (int c = 0; c < 4; ++c) {
        __syncthreads();
#pragma unroll
        for (int k = 0; k < 8; ++k) { const int pc = tid + 512 * k, r = pc >> 6, c16 = pc & 63;
            *(LAS v4u*)(LW + r * 1040 + c16 * 16) = *(const v4u*)(W1T + (size_t)r * 2048 + c * 512 + c16 * 8); }
        __syncthreads();
#pragma unroll 8
        for (int kk = 0; kk < 16; ++kk) {
            const int j = 8 * c + (kk >> 1), dim0 = (kk & 1) * 32 + quad * 8;
            const f32x4 pe0 = *(const f32x4*)(pe + j * 64 + dim0), pe1 = *(const f32x4*)(pe + j * 64 + dim0 + 4);
            bf16x8 xb[2];
#pragma unroll
            for (int tl = 0; tl < 2; ++tl) {
                f32x4 x0, x1;
                if (!sample) { const size_t row = (size_t)bs * TP + 16 * nn[tl] + j; unpack8(*(const v4u*)(Z + row * LDZ + ZC_KC + kv * 128 + gg[tl] * 64 + dim0), x0, x1); }
                else { int pos = 16 * nn[tl] + j; pos = pos > 2047 ? 2047 : pos;
                    const float* p = cache + (((pos >> 7) == ((16 * nn[tl]) >> 7)) ? pb0[tl] : pb1[tl]) + (size_t)(pos & 127) * 512 + kv * 128 + gg[tl] * 64 + dim0; x0 = *(const f32x4*)p; x1 = *(const f32x4*)(p + 4); }
                xb[tl] = pack_frag(x0 + pe0, x1 + pe1);
            }
#pragma unroll
            for (int ht = 0; ht < 4; ++ht) {
                const bf16x8 a = ld_frag_l(LW + (16 * ht + rl) * 1040 + (kk * 32 + quad * 8) * 2);
                h[0][ht] = mfma16(a, xb[0], h[0][ht]); h[1][ht] = mfma16(a, xb[1], h[1][ht]);
            }
        }
    }
#pragma unroll
    for (int tl = 0; tl < 2; ++tl) {
#pragma unroll
        for (int ht = 0; ht < 4; ++ht)
#pragma unroll
            for (int i = 0; i < 4; ++i) h[tl][ht][i] = gelu_tanh(h[tl][ht][i]);
        bf16x8 gb[2]; gb[0] = pack_frag(h[tl][0], h[tl][1]); gb[1] = pack_frag(h[tl][2], h[tl][3]);
        const int n = nn[tl], g = gg[tl];
        bf16* dst = sample ? (bf16*)(ws + WS_KCS) + ((((size_t)kv * 128 + bs) * 128 + n) * 2 + g) * 64 : (bf16*)(ws + WS_KC) + ((((size_t)kv * 2 + bs) * 512 + n) * 2 + g) * 64;
        const bool zero = sample && n == 127;
#pragma unroll
        for (int ot = 0; ot < 4; ++ot) {
            f32x4 o = (f32x4){0.f, 0.f, 0.f, 0.f};
#pragma unroll
            for (int s = 0; s < 2; ++s) {
                const bf16* wp = W2T + (16 * ot + rl) * 64 + 32 * s + 4 * quad;
                o = mfma16(mk_frag(*(const v2u*)wp, *(const v2u*)(wp + 16)), gb[s], o);
            }
            v2u w; w.x = zero ? 0u : pk2(o[0], o[1]); w.y = zero ? 0u : pk2(o[2], o[3]);
            *(v2u*)(dst + 16 * ot + 4 * quad) = w;
        }
    }
    __syncthreads();
}

DI v2u pack4(const f32x4 v) { v2u w; w.x = pk2(v[0], v[1]); w.y = pk2(v[2], v[3]); return w; }
DI void compress_sample_job(Frame& F, int layer, int job) {
    int lane = F.lane, wave = F.wave; asm volatile("" : "+v"(lane), "+s"(wave));
    const int tid = wave * 64 + lane, quad = lane >> 4, rl = lane & 15;
    unsigned char* ws = KWS();
    const int kv = job >> 7, bs = job & 127;
    const bf16* W1T = (const bf16*)(ws + WS_W1T + layer * SZ_W1T) + (size_t)kv * 64 * 2048;
    const bf16* W2T = (const bf16*)(ws + WS_W2T + layer * SZ_W2T) + (size_t)kv * 64 * 64;
    const float* pe = KIN(12) + (size_t)(layer * 2 + kv) * 32 * 64;
    const int* pt = (const int*)KIN(7);
    const float* cache = KIN(2);
    LAS unsigned char* XS = F.lds;
    LAS unsigned char* WS1 = F.lds + 69632;
    size_t toff[8];
#pragma unroll
    for (int k = 0; k < 8; ++k) { const int q = tid + 512 * k, m = q >> 5; const int pos = 16 * m; const int phys = pt[bs * 16 + (pos >> 7)];
        toff[k] = ((size_t)(layer * 2560 + phys) * 128 + (pos & 127)) * 512 + kv * 128 + 4 * (q & 31); }
    const int wr_ = tid >> 3, wc_ = tid & 7;
    int gg[2], nn[2];
#pragma unroll
    for (int tl = 0; tl < 2; ++tl) { const int T = 2 * wave + tl; gg[tl] = T >> 3; nn[tl] = 16 * (T & 7) + rl; }
    f32x4 h[2][4];
#pragma unroll
    for (int tl = 0; tl < 2; ++tl)
#pragma unroll
        for (int i = 0; i < 4; ++i) h[tl][i] = (f32x4){0.f, 0.f, 0.f, 0.f};
    f32x4 xr[8]; v4u wr2[2];
#define CS_ISSUE(r_) do { _Pragma("unroll") for (int k = 0; k < 8; ++k) xr[k] = *(const f32x4*)(cache + toff[k] + (size_t)(r_) * 512); \
        _Pragma("unroll") for (int u = 0; u < 2; ++u) wr2[u] = *(const v4u*)(W1T + (size_t)wr_ * 2048 + ((r_) + 16 * u) * 64 + wc_ * 8); } while (0)
    CS_ISSUE(0);
#pragma unroll 1
    for (int r = 0; r < 16; ++r) {
        __syncthreads();
#pragma unroll
        for (int k = 0; k < 8; ++k) { const int q = tid + 512 * k, m = q >> 5, c = q & 31, d = 4 * (c & 15);
#pragma unroll
            for (int u = 0; u < 2; ++u) { const f32x4 v = xr[k] + *(const f32x4*)(pe + (r + 16 * u) * 64 + d);
                *(LAS v2u*)(XS + u * 34816 + m * 272 + c * 8) = pack4(v); } }
#pragma unroll
        for (int u = 0; u < 2; ++u) *(LAS v4u*)(WS1 + u * 9216 + wr_ * 144 + wc_ * 16) = wr2[u];
        __syncthreads();
        { const int rn = r + 1 < 16 ? r + 1 : 15; CS_ISSUE(rn); }
#pragma unroll
        for (int u = 0; u < 2; ++u)
#pragma unroll
            for (int ks = 0; ks < 2; ++ks) {
                bf16x8 xb[2];
#pragma unroll
                for (int tl = 0; tl < 2; ++tl) { int m = nn[tl] + u; m = m > 127 ? 127 : m; xb[tl] = ld_frag_l(XS + u * 34816 + m * 272 + gg[tl] * 128 + ks * 64 + quad * 16); }
#pragma unroll
                for (int ht = 0; ht < 4; ++ht) { const bf16x8 a = ld_frag_l(WS1 + u * 9216 + (16 * ht + rl) * 144 + ks * 64 + quad * 16);
                    h[0][ht] = mfma16(a, xb[0], h[0][ht]); h[1][ht] = mfma16(a, xb[1], h[1][ht]); }
            }
    }
#undef CS_ISSUE
#pragma unroll
    for (int tl = 0; tl < 2; ++tl) {
#pragma unroll
        for (int ht = 0; ht < 4; ++ht)
#pragma unroll
            for (int i = 0; i < 4; ++i) h[tl][ht][i] = gelu_tanh(h[tl][ht][i]);
        bf16x8 gb[2]; gb[0] = pack_frag(h[tl][0], h[tl][1]); gb[1] = pack_frag(h[tl][2], h[tl][3]);
        const int n = nn[tl], g = gg[tl];
        bf16* dst = (bf16*)(ws + WS_KCS) + ((((size_t)kv * 128 + bs) * 128 + n) * 2 + g) * 64;
        const bool zero = n == 127;
#pragma unroll
        for (int ot = 0; ot < 4; ++ot) {
            f32x4 o = (f32x4){0.f, 0.f, 0.f, 0.f};
#pragma unroll
            for (int s = 0; s < 2; ++s) {
                const bf16* wp = W2T + (16 * ot + rl) * 64 + 32 * s + 4 * quad;
                o = mfma16(mk_frag(*(const v2u*)wp, *(const v2u*)(wp + 16)), gb[s], o);
            }
            v2u w; w.x = zero ? 0u : pk2(o[0], o[1]); w.y = zero ? 0u : pk2(o[2], o[3]);
            *(v2u*)(dst + 16 * ot + 4 * quad) = w;
        }
    }
    __syncthreads();
}
DI void compress_job(Frame& F, int layer, int job) { if (job < 256) compress_sample_job(F, layer, job); else compress_job_t<false>(F, layer, job); }
#ifndef PH_GPT
#define PH_GPT (-1)
#endif
#if PH_GPT >= 0
#define GP_T(k) do { if (tid == 0) { volatile LAS unsigned long long* gp_ = (volatile LAS unsigned long long*)(F.lds + LDSCTL_OFF + 448); const unsigned long long now_ = __builtin_amdgcn_s_memrealtime(); \
    if ((k) == PH_GPT) gp_[0] += now_ - gp_[1]; gp_[1] = now_; } } while (0)
#else
#define GP_T(k) do { } while (0)
#endif
DI int kperm(int idx) { const int s = idx >> 5, r = idx & 31; return 32 * s + 8 * ((r >> 2) & 3) + 4 * (r >> 4) + (r & 3); }
DI float softplusf_(float x) { return x > 20.f ? x : __logf(1.f + __expf(x)); }
DI float ret_lg(int h) { return h == 0 ? -0.031748697f : h == 1 ? -0.015748357f : h == 2 ? -0.007843178f : -0.0039138994f; }

DI void gdn_prep_unit(Frame& F, int layer, int unit) {
    int lane = F.lane, wave = F.wave; asm volatile("" : "+v"(lane), "+s"(wave));
    const int tid = wave * 64 + lane;
    const int b = unit >> 9, h = (unit >> 7) & 3, c = unit & 127;
    const int row0 = b * TP + 64 * c, t0 = 64 * c;
    GP_T(0);
    unsigned char* ws = KWS();
    const bf16* Z = (const bf16*)(ws + WS_Z);
    const float* ZS = (const float*)(ws + WS_ZS);
    LAS float* Lq = (LAS float*)(F.lds); LAS float* Lk = (LAS float*)(F.lds + 33792); LAS float* Lv = (LAS float*)(F.lds + 67584);
    LAS float* LA = (LAS float*)(F.lds + 101376); LAS float* LQK = (LAS float*)(F.lds + 117760);
    LAS float* Lg = (LAS float*)(F.lds + 134144); LAS float* Lb = Lg + 64; LAS float* Le = Lg + 128;
    const float* cw = KIN(15) + (size_t)layer * 4 * 1536;
    {
        v4u xs[6][4];
#pragma unroll
        for (int it0 = 0; it0 < 6; ++it0) {
            const int it = tid + it0 * NTHREADS, i = it / 48, ch = it % 48, col = (ch >> 4) * 512 + h * 128 + (ch & 15) * 8;
#pragma unroll
            for (int j = 0; j < 4; ++j) { const bool ok = (t0 + i - 3 + j) >= 0; xs[it0][j] = *(const v4u*)(Z + (size_t)(ok ? row0 + i - 3 + j : row0) * LDZ + ZC_GQKV + col); }
        }
        asm volatile("" ::: "memory");
#pragma unroll
        for (int it0 = 0; it0 < 6; ++it0) {
            const int it = tid + it0 * NTHREADS, i = it / 48, ch = it % 48, part = ch >> 4, cc = ch & 15;
            const int col = part * 512 + h * 128 + cc * 8;
            f32x4 y0 = (f32x4){0.f, 0.f, 0.f, 0.f}, y1 = y0;
#pragma unroll
            for (int j = 0; j < 4; ++j) {
                const float zf = ((t0 + i - 3 + j) >= 0) ? 1.f : 0.f;
                f32x4 x0, x1; unpack8(xs[it0][j], x0, x1);
                y0 += x0 * (*(const f32x4*)(cw + j * 1536 + col) * zf); y1 += x1 * (*(const f32x4*)(cw + j * 1536 + col + 4) * zf);
            }
#pragma unroll
            for (int e = 0; e < 4; ++e) { y0[e] = siluf_(y0[e]); y1[e] = siluf_(y1[e]); }
            LAS float* dst = (part == 0 ? Lq : part == 1 ? Lk : Lv) + i * 132 + cc * 8;
            *(LAS f32x4*)dst = y0; *(LAS f32x4*)(dst + 4) = y1;
        }
    }
    __syncthreads();
    GP_T(1);
    {
        float va[16], vb[16], ps[16];
#pragma unroll
        for (int q = 0; q < 16; ++q) { LAS float* vp = ((q < 8) ? Lq : Lk) + (wave * 8 + (q & 7)) * 132 + lane * 2; va[q] = vp[0]; vb[q] = vp[1]; ps[q] = va[q] * va[q] + vb[q] * vb[q]; }
#pragma unroll
        for (int q = 0; q < 16; ++q) ps[q] += shx<1>(ps[q], lane);
#pragma unroll
        for (int q = 0; q < 16; ++q) ps[q] += shx<2>(ps[q], lane);
#pragma unroll
        for (int q = 0; q < 16; ++q) ps[q] += shx<4>(ps[q], lane);
#pragma unroll
        for (int q = 0; q < 16; ++q) ps[q] += shx<8>(ps[q], lane);
#pragma unroll
        for (int q = 0; q < 16; ++q) ps[q] += shx<16>(ps[q], lane);
#pragma unroll
        for (int q = 0; q < 16; ++q) ps[q] += shx<32>(ps[q], lane);
#pragma unroll
        for (int q = 0; q < 16; ++q) { LAS float* vp = ((q < 8) ? Lq : Lk) + (wave * 8 + (q & 7)) * 132 + lane * 2; const float sc = rsqrtf(ps[q] + EPS) * ((q < 8) ? 0.08838834764831845f : 1.f); vp[0] = va[q] * sc; vp[1] = vb[q] * sc; }
    }
    if (wave == 0) {
        const float ga = ZS[(size_t)(row0 + lane) * 32 + 24 + h], gbv = ZS[(size_t)(row0 + lane) * 32 + 28 + h];
        float g = -__expf(KIN(16)[layer * 4 + h]) * softplusf_(ga + KIN(17)[layer * 4 + h]);
#pragma unroll
        for (int o = 1; o < 64; o <<= 1) { const float t = __int_as_float(__builtin_amdgcn_ds_bpermute(((lane - o) & 63) << 2, __float_as_int(g))); if (lane >= o) g += t; }
        Lg[lane] = g; Lb[lane] = sigmoidf_(gbv); Le[lane] = __expf(g);
    }
    __syncthreads();
    GP_T(2);
    {
        const int it = wave >> 1, quad = lane >> 4, rl = lane & 15;
        f32x4 ckk[2], cqk[2];
#pragma unroll
        for (int jj = 0; jj < 2; ++jj) { ckk[jj] = (f32x4){0.f, 0.f, 0.f, 0.f}; cqk[jj] = ckk[jj]; }
#pragma unroll
        for (int s = 0; s < 4; ++s) {
            const LAS float* kp = Lk + (16 * it + rl) * 132 + 32 * s + 8 * quad; const LAS float* qp = Lq + (16 * it + rl) * 132 + 32 * s + 8 * quad;
            const f32x4 ka0 = *(const LAS f32x4*)kp, ka1 = *(const LAS f32x4*)(kp + 4), qa0 = *(const LAS f32x4*)qp, qa1 = *(const LAS f32x4*)(qp + 4);
            const bf16x8 kah = pack_frag(ka0, ka1), qah = pack_frag(qa0, qa1);
            f32x4 h0, h1; unpack8(__builtin_bit_cast(v4u, kah), h0, h1); const bf16x8 kal = pack_frag(ka0 - h0, ka1 - h1);
            unpack8(__builtin_bit_cast(v4u, qah), h0, h1); const bf16x8 qal = pack_frag(qa0 - h0, qa1 - h1);
#pragma unroll
            for (int jj = 0; jj < 2; ++jj) {
                const int jt = (wave & 1) * 2 + jj;
                if (jt <= it) {
                    const LAS float* bp = Lk + (16 * jt + rl) * 132 + 32 * s + 8 * quad;
                    const f32x4 kb0 = *(const LAS f32x4*)bp, kb1 = *(const LAS f32x4*)(bp + 4);
                    const bf16x8 kbh = pack_frag(kb0, kb1); unpack8(__builtin_bit_cast(v4u, kbh), h0, h1); const bf16x8 kbl = pack_frag(kb0 - h0, kb1 - h1);
                    ckk[jj] = mfma16(kah, kbh, ckk[jj]); ckk[jj] = mfma16(kah, kbl, ckk[jj]); ckk[jj] = mfma16(kal, kbh, ckk[jj]);
                    cqk[jj] = mfma16(qah, kbh, cqk[jj]); cqk[jj] = mfma16(qah, kbl, cqk[jj]); cqk[jj] = mfma16(qal, kbh, cqk[jj]);
                }
            }
        }
#pragma unroll
        for (int jj = 0; jj < 2; ++jj) {
            const int j = 16 * ((wave & 1) * 2 + jj) + rl; const float gj = Lg[j];
#pragma unroll
            for (int e = 0; e < 4; ++e) { const int i = 16 * it + 4 * quad + e; const float dec = (i >= j) ? __expf(Lg[i] - gj) : 0.f;
                LA[i * 64 + j] = (i > j) ? Lb[i] * ckk[jj][e] * dec : 0.f; LQK[i * 64 + j] = cqk[jj][e] * dec; }
        }
    }
    __syncthreads();
    GP_T(3);
    unsigned char* rec = ws + WS_GREC + (size_t)unit * GREC;
    LAS float* TI = (LAS float*)(F.lds + 135168);
    if (tid < 64) {
        const int B = tid >> 4, c = tid & 15;
        float tc[16];
#pragma unroll
        for (int i = 0; i < 16; ++i) {
            float s0 = (i == c) ? 1.f : 0.f;
#pragma unroll
            for (int j = 0; j < i; ++j) s0 -= LA[(16 * B + i) * 64 + 16 * B + j] * tc[j];
            tc[i] = s0;
        }
#pragma unroll
        for (int i = 0; i < 16; ++i) TI[B * 256 + i * 16 + c] = tc[i];
    }
    {
        const float gl = Lg[63];
        for (int it = tid; it < 2560; it += NTHREADS) {
            if (it < 1024) {
                const int i = it >> 4, s = (it >> 2) & 3, quad = it & 3; const float e = Le[i];
                const f32x4 a = *(const LAS f32x4*)(Lq + i * 132 + 32 * s + 4 * quad) * e, bq = *(const LAS f32x4*)(Lq + i * 132 + 32 * s + 16 + 4 * quad) * e;
                *(v4u*)(rec + 16384 + i * 256 + (32 * s + 8 * quad) * 2) = pack8(a, bq);
            } else if (it < 2048) {
                const int r = it - 1024, dk = r >> 3, s2 = (r >> 2) & 1, quad = r & 3;
                f32x4 a, bq;
#pragma unroll
                for (int e = 0; e < 4; ++e) { const int ta = 32 * s2 + 4 * quad + e, tb = ta + 16; a[e] = Lk[ta * 132 + dk] * __expf(gl - Lg[ta]); bq[e] = Lk[tb * 132 + dk] * __expf(gl - Lg[tb]); }
                *(v4u*)(rec + 32768 + dk * 128 + (32 * s2 + 8 * quad) * 2) = pack8(a, bq);
            } else {
                const int r = it - 2048, i = r >> 3, s2 = (r >> 2) & 1, quad = r & 3;
                const f32x4 a = *(const LAS f32x4*)(LQK + i * 64 + 32 * s2 + 4 * quad), bq = *(const LAS f32x4*)(LQK + i * 64 + 32 * s2 + 16 + 4 * quad);
                *(v4u*)(rec + 65536 + i * 128 + (32 * s2 + 8 * quad) * 2) = pack8(a, bq);
            }
        }
        if (tid == 0) *(float*)(rec + 73728) = __expf(gl);
    }
    __syncthreads();
    GP_T(4);
    {
        const int col = tid & 255, hb = tid >> 8;
        LAS float* X = (col < 128) ? (Lv + col) : (Lk + (col - 128));
        const bool isw = col >= 128;
#pragma unroll 1
        for (int B = 0; B < 4; ++B) {
            float xb[8];
#pragma unroll
            for (int i = 0; i < 8; ++i) { const int r = 16 * B + 8 * hb + i; xb[i] = (isw ? Lb[r] * Le[r] : Lb[r]) * X[r * 132]; }
#pragma unroll 2
            for (int j4 = 0; j4 < 4 * B; ++j4) {
                const float x0 = X[(4 * j4) * 132], x1 = X[(4 * j4 + 1) * 132], x2 = X[(4 * j4 + 2) * 132], x3 = X[(4 * j4 + 3) * 132];
#pragma unroll
                for (int i = 0; i < 8; ++i) { const f32x4 a = *(const LAS f32x4*)(LA + (16 * B + 8 * hb + i) * 64 + 4 * j4); xb[i] -= (a[0] * x0 + a[1] * x1) + (a[2] * x2 + a[3] * x3); }
            }
#pragma unroll
            for (int i = 0; i < 8; ++i) X[(16 * B + 8 * hb + i) * 132] = xb[i];
            __syncthreads();
            float r[16];
#pragma unroll
            for (int jj = 0; jj < 16; ++jj) r[jj] = X[(16 * B + jj) * 132];
            __syncthreads();
#pragma unroll
            for (int i = 0; i < 8; ++i) {
                float s0 = 0.f, s1 = 0.f;
#pragma unroll
                for (int j4 = 0; j4 < 4; ++j4) { const f32x4 a = *(const LAS f32x4*)(TI + B * 256 + (8 * hb + i) * 16 + 4 * j4);
                    s0 += a[0] * r[4 * j4] + a[2] * r[4 * j4 + 2]; s1 += a[1] * r[4 * j4 + 1] + a[3] * r[4 * j4 + 3]; }
                X[(16 * B + 8 * hb + i) * 132] = s0 + s1;
            }
            __syncthreads();
        }
    }
    __syncthreads();
    GP_T(5);
    for (int it = tid; it < 2048; it += NTHREADS) {
        if (it < 1024) {
            const int dv = it >> 3, q = it & 7;
            v4u w; w.x = pk2(Lv[(8 * q) * 132 + dv], Lv[(8 * q + 1) * 132 + dv]); w.y = pk2(Lv[(8 * q + 2) * 132 + dv], Lv[(8 * q + 3) * 132 + dv]);
            w.z = pk2(Lv[(8 * q + 4) * 132 + dv], Lv[(8 * q + 5) * 132 + dv]); w.w = pk2(Lv[(8 * q + 6) * 132 + dv], Lv[(8 * q + 7) * 132 + dv]);
            *(v4u*)(rec + 49152 + dv * 128 + q * 16) = w;
        } else {
            const int r = it - 1024, i = r >> 4, s = (r >> 2) & 3, quad = r & 3;
            const f32x4 a = *(const LAS f32x4*)(Lk + i * 132 + 32 * s + 4 * quad), bq = *(const LAS f32x4*)(Lk + i * 132 + 32 * s + 16 + 4 * quad);
            *(v4u*)(rec + i * 256 + (32 * s + 8 * quad) * 2) = pack8(a, bq);
        }
    }
    __syncthreads();
    GP_T(6);
}

DI void ret_prep_unit(Frame& F, int layer, int unit) {
    int lane = F.lane, wave = F.wave; asm volatile("" : "+v"(lane), "+s"(wave));
    const int tid = wave * 64 + lane, quad = lane >> 4, rl = lane & 15;
    const int b = unit >> 8, h = (unit >> 6) & 3, c = unit & 63;
    const int row0 = b * TP + 128 * c;
    unsigned char* ws = KWS();
    const bf16* Z = (const bf16*)(ws + WS_Z);
    const f32x2* ROT = (const f32x2*)(ws + WS_ROT);
    bf16* QR = (bf16*)(ws + WS_QR); bf16* KR = (bf16*)(ws + WS_KR);
    LAS unsigned char* LK = F.lds; LAS unsigned char* LV = F.lds + 34816;
    const float lg = ret_lg(h);
    for (int it = tid; it < 1024; it += NTHREADS) {
        const int j = it >> 3, cc = it & 7, d0 = cc * 8;
        const size_t zr = (size_t)(row0 + j) * LDZ + ZC_RQKV + h * 128 + d0;
        f32x4 q1a, q1b, q2a, q2b, k1a, k1b, k2a, k2b;
        unpack8(*(const v4u*)(Z + zr), q1a, q1b); unpack8(*(const v4u*)(Z + zr + 64), q2a, q2b);
        unpack8(*(const v4u*)(Z + zr + 512), k1a, k1b); unpack8(*(const v4u*)(Z + zr + 512 + 64), k2a, k2b);
        const f32x2* rp = ROT + (size_t)(128 * c + j) * 64 + d0;
        const float kd = __expf((float)(127 - j) * lg);
        f32x4 oq1a, oq1b, oq2a, oq2b, ok1a, ok1b, ok2a, ok2b;
#pragma unroll
        for (int e = 0; e < 8; ++e) {
            const f32x2 cs = rp[e];
            const float q1 = e < 4 ? q1a[e & 3] : q1b[e & 3], q2 = e < 4 ? q2a[e & 3] : q2b[e & 3], k1 = e < 4 ? k1a[e & 3] : k1b[e & 3], k2 = e < 4 ? k2a[e & 3] : k2b[e & 3];
            const float rq1 = q1 * cs.x - q2 * cs.y, rq2 = q2 * cs.x + q1 * cs.y, rk1 = (k1 * cs.x - k2 * cs.y) * 0.08838834764831845f, rk2 = (k2 * cs.x + k1 * cs.y) * 0.08838834764831845f;
            if (e < 4) { oq1a[e & 3] = rq1; oq2a[e & 3] = rq2; ok1a[e & 3] = rk1; ok2a[e & 3] = rk2; } else { oq1b[e & 3] = rq1; oq2b[e & 3] = rq2; ok1b[e & 3] = rk1; ok2b[e & 3] = rk2; }
            *(LAS bf16*)(LK + (d0 + e) * 272 + j * 2) = (bf16)f2bf(rk1 * kd); *(LAS bf16*)(LK + (d0 + 64 + e) * 272 + j * 2) = (bf16)f2bf(rk2 * kd);
        }
        const size_t orow = (size_t)(row0 + j) * 512 + h * 128 + d0;
        *(v4u*)(QR + orow) = pack8(oq1a, oq1b); *(v4u*)(QR + orow + 64) = pack8(oq2a, oq2b);
        *(v4u*)(KR + orow) = pack8(ok1a, ok1b); *(v4u*)(KR + orow + 64) = pack8(ok2a, ok2b);
    }
    for (int it = tid; it < 2048; it += NTHREADS) {
        const int j = it >> 4, cc = it & 15;
        const v4u w = *(const v4u*)(Z + (size_t)(row0 + j) * LDZ + ZC_RQKV + 1024 + h * 128 + cc * 8);
        LAS unsigned char* d = LV + (cc * 8) * 272 + j * 2;
        *(LAS bf16*)(d) = (bf16)(w.x & 0xffff); *(LAS bf16*)(d + 272) = (bf16)(w.x >> 16); *(LAS bf16*)(d + 2 * 272) = (bf16)(w.y & 0xffff); *(LAS bf16*)(d + 3 * 272) = (bf16)(w.y >> 16);
        *(LAS bf16*)(d + 4 * 272) = (bf16)(w.z & 0xffff); *(LAS bf16*)(d + 5 * 272) = (bf16)(w.z >> 16); *(LAS bf16*)(d + 6 * 272) = (bf16)(w.w & 0xffff); *(LAS bf16*)(d + 7 * 272) = (bf16)(w.w >> 16);
    }
    __syncthreads();
    float* RKV = (float*)(ws + WS_RKV) + (size_t)unit * 16384;
#pragma unroll
    for (int nt = 0; nt < 8; ++nt) {
        f32x4 acc = (f32x4){0.f, 0.f, 0.f, 0.f};
#pragma unroll
        for (int s = 0; s < 4; ++s) acc = mfma16(ld_frag_l(LK + (16 * wave + rl) * 272 + (32 * s + 8 * quad) * 2), ld_frag_l(LV + (16 * nt + rl) * 272 + (32 * s + 8 * quad) * 2), acc);
#pragma unroll
        for (int i = 0; i < 4; ++i) RKV[(size_t)(16 * wave + 4 * quad + i) * 128 + 16 * nt + rl] = acc[i];
    }
    __syncthreads();
}
DI void sample_rec_unit(Frame& F, int layer, int unit) {
    int lane = F.lane, wave = F.wave; asm volatile("" : "+v"(lane), "+s"(wave));
    const int tid = wave * 64 + lane;
    const int kind = unit >> 9, s = (unit >> 2) & 127, h = unit & 3;
    const int dv = tid & 127, part = tid >> 7, r0 = MP + 4 * s;
    unsigned char* ws = KWS();
    const bf16* Z = (const bf16*)(ws + WS_Z);
    const float* ZS = (const float*)(ws + WS_ZS);
    LAS float* Lq = (LAS float*)(F.lds); LAS float* Lk = Lq + 512; LAS float* Lv = Lq + 1024; LAS float* red = Lq + 1536; LAS float* Lo = Lq + 2048; LAS float* sc = Lq + 2560;
    float S[32];
    if (kind == 0) {
        if (tid < 384) {
            const int pr = tid >> 7, d = tid & 127, col = pr * 512 + h * 128 + d;
            float xp[7], w[4];
#pragma unroll
            for (int i = 0; i < 3; ++i) xp[i] = KIN(4)[((size_t)(layer * 128 + s) * 3 + i) * 1536 + col];
#pragma unroll
            for (int j = 0; j < 4; ++j) xp[3 + j] = bf2f(Z[(size_t)(r0 + j) * LDZ + ZC_GQKV + col]);
#pragma unroll
            for (int i = 0; i < 4; ++i) w[i] = KIN(15)[(size_t)(layer * 4 + i) * 1536 + col];
            LAS float* dst = pr == 0 ? Lq : pr == 1 ? Lk : Lv;
#pragma unroll
            for (int j = 0; j < 4; ++j) dst[j * 128 + d] = siluf_(w[0] * xp[j] + w[1] * xp[j + 1] + w[2] * xp[j + 2] + w[3] * xp[j + 3]);
        }
        __syncthreads();
        {
            LAS float* vp = (wave < 4 ? Lq : Lk) + (wave & 3) * 128;
            const float a = vp[2 * lane], b = vp[2 * lane + 1];
            const float scl = rsqrtf(wave_sum(a * a + b * b, lane) + EPS) * (wave < 4 ? 0.08838834764831845f : 1.f);
            vp[2 * lane] = a * scl; vp[2 * lane + 1] = b * scl;
        }
        if (tid < 4) {
            const float ga = ZS[(size_t)(r0 + tid) * 32 + 24 + h], gb = ZS[(size_t)(r0 + tid) * 32 + 28 + h];
            sc[tid] = __expf(-__expf(KIN(16)[layer * 4 + h]) * softplusf_(ga + KIN(17)[layer * 4 + h])); sc[4 + tid] = sigmoidf_(gb);
        }
        __syncthreads();
        const float* Sin = KIN(5) + ((size_t)((layer * 128 + s) * 4 + h) * 128 + 32 * part) * 128 + dv;
#pragma unroll
        for (int i = 0; i < 32; ++i) S[i] = Sin[(size_t)i * 128];
#pragma unroll
        for (int j = 0; j < 4; ++j) {
            const float a = sc[j], beta = sc[4 + j];
            float p = 0.f;
#pragma unroll
            for (int i = 0; i < 32; ++i) { S[i] *= a; p += Lk[j * 128 + 32 * part + i] * S[i]; }
            red[part * 128 + dv] = p;
            __syncthreads();
            const float delta = beta * (Lv[j * 128 + dv] - ((red[dv] + red[128 + dv]) + (red[256 + dv] + red[384 + dv])));
            __syncthreads();
            float o = 0.f;
#pragma unroll
            for (int i = 0; i < 32; ++i) { S[i] += Lk[j * 128 + 32 * part + i] * delta; o += Lq[j * 128 + 32 * part + i] * S[i]; }
            red[part * 128 + dv] = o;
            __syncthreads();
            if (part == 0) Lo[j * 128 + dv] = (red[dv] + red[128 + dv]) + (red[256 + dv] + red[384 + dv]);
            __syncthreads();
        }
        float* Sout = KOUT() + O_GSS + ((size_t)((layer * 128 + s) * 4 + h) * 128 + 32 * part) * 128 + dv;
#pragma unroll
        for (int i = 0; i < 32; ++i) Sout[(size_t)i * 128] = S[i];
        ((float*)(ws + WS_OGDN))[(size_t)(r0 + part) * 512 + h * 128 + dv] = Lo[part * 128 + dv];
    } else {
        const f32x2* ROT = (const f32x2*)(ws + WS_ROT);
        if (tid < 384) {
            const int pr = tid >> 7, d = tid & 127;
#pragma unroll
            for (int j = 0; j < 4; ++j) {
                const bf16* zp = Z + (size_t)(r0 + j) * LDZ + ZC_RQKV + pr * 512 + h * 128;
                float v = bf2f(zp[d]);
                if (pr < 2) { const f32x2 cs = ROT[(size_t)(2048 + j) * 64 + (d & 63)]; const float o = bf2f(zp[d ^ 64]);
                    v = (d < 64) ? v * cs.x - o * cs.y : v * cs.x + o * cs.y; if (pr == 1) v *= 0.08838834764831845f; }
                (pr == 0 ? Lq : pr == 1 ? Lk : Lv)[j * 128 + d] = v;
            }
        }
        __syncthreads();
        const float gam = __expf(ret_lg(h));
        const float* Sin = KIN(6) + ((size_t)((layer * 128 + s) * 4 + h) * 128 + 32 * part) * 128 + dv;
#pragma unroll
        for (int i = 0; i < 32; ++i) S[i] = Sin[(size_t)i * 128];
#pragma unroll
        for (int j = 0; j < 4; ++j) {
            const float vv = Lv[j * 128 + dv];
            float o = 0.f;
#pragma unroll
            for (int i = 0; i < 32; ++i) { S[i] = S[i] * gam + Lk[j * 128 + 32 * part + i] * vv; o += Lq[j * 128 + 32 * part + i] * S[i]; }
            red[part * 128 + dv] = o;
            __syncthreads();
            if (part == 0) Lo[j * 128 + dv] = (red[dv] + red[128 + dv]) + (red[256 + dv] + red[384 + dv]);
            __syncthreads();
        }
        float* Sout = KOUT() + O_RSS + ((size_t)((layer * 128 + s) * 4 + h) * 128 + 32 * part) * 128 + dv;
#pragma unroll
        for (int i = 0; i < 32; ++i) Sout[(size_t)i * 128] = S[i];
        if (wave < 4) {
            const int j = wave; const float a = Lo[j * 128 + 2 * lane], b = Lo[j * 128 + 2 * lane + 1];
            const float scl = rsqrtf(wave_sum(a * a + b * b, lane) * (1.f / 128.f) + EPS);
            const bf16* gp = Z + (size_t)(r0 + j) * LDZ + ZC_RG + h * 128 + 2 * lane;
            *(unsigned*)((bf16*)(ws + WS_MIX) + (size_t)(r0 + j) * 1536 + 1024 + h * 128 + 2 * lane) = pk2(a * scl * siluf_(bf2f(gp[0])), b * scl * siluf_(bf2f(gp[1])));
        }
    }
    __syncthreads();
}

DI void gdn_scan_chain(Frame& F, int layer, int bh) {
    int lane = F.lane, wave = F.wave; asm volatile("" : "+v"(lane), "+s"(wave));
    const int tid = wave * 64 + lane, quad = lane >> 4, rl = lane & 15;
    unsigned char* ws = KWS();
    const unsigned char* recb = ws + WS_GREC + (size_t)bh * 128 * GREC;
    LAS unsigned char* L = F.lds;
    constexpr int L_WP = 0, L_QP = 17408, L_KT = 34816, L_UT = 53248, L_QK = 71680;
    f32x4 S[8];
#pragma unroll
    for (int i = 0; i < 8; ++i) S[i] = (f32x4){0.f, 0.f, 0.f, 0.f};
    v4u pf[9]; float egl;
#pragma unroll
    for (int k = 0; k < 9; ++k) pf[k] = *(const v4u*)(recb + (size_t)(tid + 512 * k) * 16);
    egl = *(const float*)(recb + 73728);
    float* OG = (float*)(ws + WS_OGDN);
    const int b = bh >> 2, h = bh & 3;
    for (int c = 0; c < 128; ++c) {
        __syncthreads();
#pragma unroll
        for (int k = 0; k < 9; ++k) {
            const int o = tid * 16 + (k & 1) * 8192;
            const int reg = k >> 1;
            int dst;
            if (reg < 2) dst = (reg == 0 ? L_WP : L_QP) + (o >> 8) * 272 + (o & 255);
            else dst = (reg == 2 ? L_KT : reg == 3 ? L_UT : L_QK) + (o >> 7) * 144 + (o & 127);
            *(LAS v4u*)(L + dst) = pf[k];
        }
        const float eg = egl;
        __syncthreads();
        {
            const unsigned char* rn = recb + (size_t)(c + 1 < 128 ? c + 1 : 127) * GREC;
#pragma unroll
            for (int k = 0; k < 9; ++k) pf[k] = *(const v4u*)(rn + (size_t)(tid + 512 * k) * 16);
            egl = *(const float*)(rn + 73728);
        }
        bf16x8 Sb[4];
#pragma unroll
        for (int s = 0; s < 4; ++s) Sb[s] = pack_frag(S[2 * s], S[2 * s + 1]);
        f32x4 vn[4], O[4];
#pragma unroll
        for (int rt = 0; rt < 4; ++rt) {
            f32x4 wsacc = (f32x4){0.f, 0.f, 0.f, 0.f}, o = wsacc;
#pragma unroll
            for (int s = 0; s < 4; ++s) {
                wsacc = mfma16(ld_frag_l(L + L_WP + (16 * rt + rl) * 272 + (32 * s + 8 * quad) * 2), Sb[s], wsacc);
                o = mfma16(ld_frag_l(L + L_QP + (16 * rt + rl) * 272 + (32 * s + 8 * quad) * 2), Sb[s], o);
            }
            const v2u uw = *(const LAS v2u*)(L + L_UT + (16 * wave + rl) * 144 + (16 * rt + 4 * quad) * 2);
            vn[rt][0] = lo_bf(uw.x) - wsacc[0]; vn[rt][1] = hi_bf(uw.x) - wsacc[1]; vn[rt][2] = lo_bf(uw.y) - wsacc[2]; vn[rt][3] = hi_bf(uw.y) - wsacc[3];
            O[rt] = o;
        }
        bf16x8 Vb[2]; Vb[0] = pack_frag(vn[0], vn[1]); Vb[1] = pack_frag(vn[2], vn[3]);
#pragma unroll
        for (int rt = 0; rt < 4; ++rt) {
#pragma unroll
            for (int s2 = 0; s2 < 2; ++s2) O[rt] = mfma16(ld_frag_l(L + L_QK + (16 * rt + rl) * 144 + (32 * s2 + 8 * quad) * 2), Vb[s2], O[rt]);
            const size_t row = (size_t)b * TP + 64 * c + 16 * rt + 4 * quad;
#pragma unroll
            for (int i = 0; i < 4; ++i) OG[(row + i) * 512 + h * 128 + 16 * wave + rl] = O[rt][i];
        }
#pragma unroll
        for (int kt = 0; kt < 8; ++kt) {
            f32x4 a = S[kt] * eg;
#pragma unroll
            for (int s2 = 0; s2 < 2; ++s2) a = mfma16(ld_frag_l(L + L_KT + (16 * kt + rl) * 144 + (32 * s2 + 8 * quad) * 2), Vb[s2], a);
            S[kt] = a;
        }
    }
    float* So = KOUT() + O_GSP + (size_t)(layer * 8 + bh) * 16384;
#pragma unroll
    for (int kt = 0; kt < 8; ++kt)
#pragma unroll
        for (int i = 0; i < 4; ++i) So[(size_t)(16 * kt + 4 * quad + i) * 128 + 16 * wave + rl] = S[kt][i];
    __syncthreads();
}
DI void ret_scan_part(Frame& F, int layer, int r) {
    int tid = F.tid; asm volatile("" : "+v"(tid));
    const int bh = r >> 2, dv = tid & 127, dk0 = ((r & 3) * 4 + (tid >> 7)) * 8, h = bh & 3;
    unsigned char* ws = KWS();
    const float* RKV = (const float*)(ws + WS_RKV) + (size_t)bh * 64 * 16384;
    bf16* RST = (bf16*)(ws + WS_RST) + (size_t)bh * 64 * 16384;
    const float cdec = __expf(128.f * ret_lg(h));
    float S[8];
#pragma unroll
    for (int i = 0; i < 8; ++i) S[i] = 0.f;
#pragma unroll 4
    for (int c = 0; c < 64; ++c) {
        v4u w; w.x = pk2(S[0], S[1]); w.y = pk2(S[2], S[3]); w.z = pk2(S[4], S[5]); w.w = pk2(S[6], S[7]);
        *(v4u*)(RST + (size_t)c * 16384 + dv * 128 + dk0) = w;
#pragma unroll
        for (int i = 0; i < 8; ++i) S[i] = S[i] * cdec + RKV[(size_t)c * 16384 + (dk0 + i) * 128 + dv];
    }
    float* So = KOUT() + O_RSP + (size_t)(layer * 8 + bh) * 16384;
#pragma unroll
    for (int i = 0; i < 8; ++i) So[(size_t)(dk0 + i) * 128 + dv] = S[i];
}
constexpr float SM_C = 0.125f * 1.4426950408889634f;
struct AttnState { float m, l; f32x4 O[4]; };
DI void attn_reset(AttnState& st) { st.m = -1e30f; st.l = 0.f;
#pragma unroll
    for (int i = 0; i < 4; ++i) st.O[i] = (f32x4){0.f, 0.f, 0.f, 0.f}; }
DI void qk_tile(const LAS unsigned char* Kt, const bf16x8 (&qf)[2], f32x4 (&s)[4], int rl, int quad) {
    bf16x8 kf[4][2];
#pragma unroll
    for (int kt = 0; kt < 4; ++kt)
#pragma unroll
        for (int kk = 0; kk < 2; ++kk) kf[kt][kk] = ld_frag_l(Kt + (16 * kt + rl) * 144 + kk * 64 + quad * 16);
    __builtin_amdgcn_s_setprio(1);
#pragma unroll
    for (int kt = 0; kt < 4; ++kt) s[kt] = mfma16(kf[kt][0], qf[0], (f32x4){0.f, 0.f, 0.f, 0.f});
#pragma unroll
    for (int kt = 0; kt < 4; ++kt) s[kt] = mfma16(kf[kt][1], qf[1], s[kt]);
    __builtin_amdgcn_s_setprio(0);
}
template <class Mask> DI void attn_step(const LAS unsigned char* Kt, const LAS unsigned char* VT, const bf16x8 (&qf)[2], AttnState& st, const Mask& ok, int rl, int quad) {
    f32x4 s[4]; qk_tile(Kt, qf, s, rl, quad);
    float mx = -3e38f;
#pragma unroll
    for (int kt = 0; kt < 4; ++kt)
#pragma unroll
        for (int i = 0; i < 4; ++i) if (ok(16 * kt + 4 * quad + i)) mx = fmaxf(mx, s[kt][i]);
    const int lane = rl + 16 * quad;
    mx = fmaxf(mx, shx<16>(mx, lane)); mx = fmaxf(mx, shx<32>(mx, lane));
    const float mn = fmaxf(st.m, mx);
    const float alpha = exp2f((st.m - mn) * SM_C);
    float ls = 0.f;
#pragma unroll
    for (int kt = 0; kt < 4; ++kt)
#pragma unroll
        for (int i = 0; i < 4; ++i) { const float p = ok(16 * kt + 4 * quad + i) ? exp2f((s[kt][i] - mn) * SM_C) : 0.f; s[kt][i] = p; ls += p; }
    ls += shx<16>(ls, lane); ls += shx<32>(ls, lane);
    st.l = st.l * alpha + ls; st.m = mn;
#pragma unroll
    for (int dt = 0; dt < 4; ++dt) st.O[dt] *= alpha;
#pragma unroll
    for (int ii = 0; ii < 2; ++ii) {
        const bf16x8 pb = pack_frag(s[2 * ii], s[2 * ii + 1]);
#pragma unroll
        for (int dt = 0; dt < 4; ++dt) {
            const LAS unsigned char* vp = VT + (16 * dt + rl) * 144 + (32 * ii + 4 * quad) * 2;
            st.O[dt] = mfma16(mk_frag(*(const LAS v2u*)vp, *(const LAS v2u*)(vp + 32)), pb, st.O[dt]);
        }
    }
}
DI void attn_accum(f32x4 (&Of)[4], const AttnState& st, float gate) {
    const float sc = st.l > 0.f ? gate / st.l : 0.f;
#pragma unroll
    for (int dt = 0; dt < 4; ++dt) Of[dt] += st.O[dt] * sc;
}
DI void vt_write(LAS unsigned char* VT, int d0, int key, const v4u w) {
    LAS unsigned char* d = VT + d0 * 144 + key * 2;
    *(LAS bf16*)(d) = (bf16)(w.x & 0xffff); *(LAS bf16*)(d + 144) = (bf16)(w.x >> 16); *(LAS bf16*)(d + 2 * 144) = (bf16)(w.y & 0xffff); *(LAS bf16*)(d + 3 * 144) = (bf16)(w.y >> 16);
    *(LAS bf16*)(d + 4 * 144) = (bf16)(w.z & 0xffff); *(LAS bf16*)(d + 5 * 144) = (bf16)(w.z >> 16); *(LAS bf16*)(d + 6 * 144) = (bf16)(w.w & 0xffff); *(LAS bf16*)(d + 7 * 144) = (bf16)(w.w >> 16);
}
DI void stage_wg(LAS unsigned char* Kt, LAS unsigned char* VT, const bf16* kb, const bf16* vb, size_t stride, int tid, bool do_v) {
    const int key = tid >> 3, ch = tid & 7;
    *(LAS v4u*)(Kt + key * 144 + ch * 16) = *(const v4u*)(kb + key * stride + ch * 8);
    if (do_v) vt_write(VT, ch * 8, key, *(const v4u*)(vb + key * stride + ch * 8));
}
DI unsigned score_key(float s, bool valid, int idx) { return valid ? (((__float_as_uint(s) | 0x80000000u) & ~127u) | (unsigned)(127 - idx)) : 0u; }
DI int key_rank(const LAS unsigned* K, int ng4, unsigned k) {
    int r = 0;
#pragma unroll 4
    for (int g = 0; g < ng4; ++g) { const v4u v = *(const LAS v4u*)(K + 4 * g); r += (v.x > k) + (v.y > k) + (v.z > k) + (v.w > k); }
    return r;
}
DI void key_rank2(const LAS unsigned* K, int ng4, unsigned k0, unsigned k1, int& r0, int& r1) {
    int a0 = 0, a1 = 0, b0 = 0, b1 = 0;
    const int ng8 = (ng4 + 1) >> 1;
#pragma unroll 4
    for (int g = 0; g < ng8; ++g) { const v4u v = *(const LAS v4u*)(K + 8 * g), w = *(const LAS v4u*)(K + 8 * g + 4);
        a0 += (v.x > k0) + (v.y > k0) + (v.z > k0) + (v.w > k0); b0 += (w.x > k0) + (w.y > k0) + (w.z > k0) + (w.w > k0);
        a1 += (v.x > k1) + (v.y > k1) + (v.z > k1) + (v.w > k1); b1 += (w.x > k1) + (w.y > k1) + (w.z > k1) + (w.w > k1); }
    r0 = a0 + b0; r1 = a1 + b1;
}
DI int top16(float v0, float v1, int lane) {
    int sel = 0;
#pragma unroll 1
    for (int r = 0; r < 16; ++r) {
        float bv; int bi;
        if (v0 >= v1) { bv = v0; bi = lane; } else { bv = v1; bi = lane + 64; }
#define T16_STEP(M) { const float ov = shx<M>(bv, lane); const int oi = shxi<M>(bi, lane); const bool take = (ov > bv) || (ov == bv && oi < bi); bv = take ? ov : bv; bi = take ? oi : bi; }
        T16_STEP(32) T16_STEP(16) T16_STEP(8) T16_STEP(4) T16_STEP(2) T16_STEP(1)
#undef T16_STEP
        const bool h0 = (bi == lane), h1 = (bi == lane + 64);
        v0 = h0 ? -3e38f : v0; v1 = h1 ? -3e38f : v1; sel |= (h0 ? 1 : 0) | (h1 ? 2 : 0);
    }
    return sel;
}

typedef short v4i16_t __attribute__((ext_vector_type(4)));
DI s16x4 vtr(const LAS unsigned char* p) { return __builtin_bit_cast(s16x4, __builtin_amdgcn_ds_read_tr16_b64_v4i16((LAS v4i16_t*)p)); }
DI bf16x8 cat4(s16x4 a, s16x4 b) { bf16x8 r; r[0] = a[0]; r[1] = a[1]; r[2] = a[2]; r[3] = a[3]; r[4] = b[0]; r[5] = b[1]; r[6] = b[2]; r[7] = b[3]; return r; }
DI void attn_step3(const LAS unsigned char* Kt, const LAS unsigned char* Vt, const bf16x8 (&qf)[2], AttnState& st, int lo, int hi, bool active, int rl, int quad) {
    active = active && (hi >= lo);
    if (!__any(active)) return;
    f32x4 s[4]; qk_tile(Kt, qf, s, rl, quad);
    const int lane = rl + 16 * quad;
    const bool full = __all((lo <= 0 && hi >= 63) || !active);
    const int kq = 4 * quad - lo; const unsigned rng = (unsigned)(hi - lo);
    float lm;
    if (full) {
        const float a0 = fmaxf(fmaxf(s[0][0], s[0][1]), fmaxf(s[0][2], s[0][3])), a1 = fmaxf(fmaxf(s[1][0], s[1][1]), fmaxf(s[1][2], s[1][3]));
        const float a2 = fmaxf(fmaxf(s[2][0], s[2][1]), fmaxf(s[2][2], s[2][3])), a3 = fmaxf(fmaxf(s[3][0], s[3][1]), fmaxf(s[3][2], s[3][3]));
        lm = fmaxf(fmaxf(a0, a1), fmaxf(a2, a3));
    } else {
        lm = -3e38f;
#pragma unroll
        for (int kt = 0; kt < 4; ++kt)
#pragma unroll
            for (int i = 0; i < 4; ++i) lm = ((unsigned)(kq + 16 * kt + i) <= rng) ? fmaxf(lm, s[kt][i]) : lm;
    }
    lm = active ? lm : -3e38f;
    if (__any(lm > st.m + 320.f)) {
        float mx = fmaxf(lm, shx<16>(lm, lane)); mx = fmaxf(mx, shx<32>(mx, lane));
        const float mn = fmaxf(st.m, mx);
        const float alpha = __builtin_amdgcn_exp2f((st.m - mn) * SM_C);
        st.l *= alpha; st.m = mn;
#pragma unroll
        for (int dt = 0; dt < 4; ++dt) st.O[dt] *= alpha;
    }
    const float mc = active ? st.m * SM_C : __builtin_inff();
    float ls = 0.f;
    if (full) {
#pragma unroll
        for (int kt = 0; kt < 4; ++kt)
#pragma unroll
            for (int i = 0; i < 4; ++i) { const float p = __builtin_amdgcn_exp2f(s[kt][i] * SM_C - mc); s[kt][i] = p; ls += p; }
    } else {
#pragma unroll
        for (int kt = 0; kt < 4; ++kt)
#pragma unroll
            for (int i = 0; i < 4; ++i) { const float p = ((unsigned)(kq + 16 * kt + i) <= rng) ? __builtin_amdgcn_exp2f(s[kt][i] * SM_C - mc) : 0.f; s[kt][i] = p; ls += p; }
    }
    st.l += ls;
#pragma unroll
    for (int ii = 0; ii < 2; ++ii) {
        const bf16x8 pb = pack_frag(s[2 * ii], s[2 * ii + 1]);
#pragma unroll
        for (int dt = 0; dt < 4; ++dt) {
            const LAS unsigned char* vp = Vt + (32 * ii + 4 * quad + (rl >> 2)) * 144 + (16 * dt + 4 * (rl & 3)) * 2;
            st.O[dt] = mfma16(cat4(vtr(vp), vtr(vp + 16 * 144)), pb, st.O[dt]);
        }
    }
}
DI float attn_rowsum(const AttnState& st, int lane) { float l = st.l; l += shx<16>(l, lane); l += shx<32>(l, lane); return l; }
DI void attn_accum3(f32x4 (&Of)[4], const AttnState& st, float gate, int lane) {
    const float l = attn_rowsum(st, lane);
    const float sc = l > 0.f ? gate / l : 0.f;
#pragma unroll
    for (int dt = 0; dt < 4; ++dt) Of[dt] += st.O[dt] * sc;
}
#ifndef PH_NPT
#define PH_NPT (-1)
#endif
#if PH_NPT >= 0
#define NP_T(k) do { if (tid == 0) { volatile LAS unsigned long long* np_ = (volatile LAS unsigned long long*)(F.lds + LDSCTL_OFF + 464); const unsigned long long now_ = __builtin_amdgcn_s_memrealtime(); \
    if ((k) == PH_NPT) np_[0] += now_ - np_[1]; np_[1] = now_; } } while (0)
#else
#define NP_T(k) do { } while (0)
#endif
#ifndef PH_NSAC
#define PH_NSAC 1
#endif
DI float tile_max(const f32x4 (&s)[4], bool full, int kq, unsigned rng) {
    float lm;
    if (full) {
        const float a0 = fmaxf(fmaxf(s[0][0], s[0][1]), fmaxf(s[0][2], s[0][3])), a1 = fmaxf(fmaxf(s[1][0], s[1][1]), fmaxf(s[1][2], s[1][3]));
        const float a2 = fmaxf(fmaxf(s[2][0], s[2][1]), fmaxf(s[2][2], s[2][3])), a3 = fmaxf(fmaxf(s[3][0], s[3][1]), fmaxf(s[3][2], s[3][3]));
        lm = fmaxf(fmaxf(a0, a1), fmaxf(a2, a3));
    } else {
        lm = -3e38f;
#pragma unroll
        for (int kt = 0; kt < 4; ++kt)
#pragma unroll
            for (int i = 0; i < 4; ++i) lm = ((unsigned)(kq + 16 * kt + i) <= rng) ? fmaxf(lm, s[kt][i]) : lm;
    }
    return lm;
}
DI float tile_exp(f32x4 (&s)[4], bool full, int kq, unsigned rng, float mc) {
    float ls = 0.f;
    if (full) {
#pragma unroll
        for (int kt = 0; kt < 4; ++kt)
#pragma unroll
            for (int i = 0; i < 4; ++i) { const float p = __builtin_amdgcn_exp2f(s[kt][i] * SM_C - mc); s[kt][i] = p; ls += p; }
    } else {
#pragma unroll
        for (int kt = 0; kt < 4; ++kt)
#pragma unroll
            for (int i = 0; i < 4; ++i) { const float p = ((unsigned)(kq + 16 * kt + i) <= rng) ? __builtin_amdgcn_exp2f(s[kt][i] * SM_C - mc) : 0.f; s[kt][i] = p; ls += p; }
    }
    return ls;
}
DI void tile_pv(const LAS unsigned char* Vt, const f32x4 (&s)[4], f32x4 (&O)[4], int rl, int quad) {
    bf16x8 vf[2][4];
#pragma unroll
    for (int ii = 0; ii < 2; ++ii)
#pragma unroll
        for (int dt = 0; dt < 4; ++dt) { const LAS unsigned char* vp = Vt + (32 * ii + 4 * quad + (rl >> 2)) * 144 + (16 * dt + 4 * (rl & 3)) * 2; vf[ii][dt] = cat4(vtr(vp), vtr(vp + 16 * 144)); }
    const bf16x8 pb0 = pack_frag(s[0], s[1]), pb1 = pack_frag(s[2], s[3]);
    __builtin_amdgcn_s_setprio(1);
#pragma unroll
    for (int dt = 0; dt < 4; ++dt) O[dt] = mfma16(vf[0][dt], pb0, O[dt]);
#pragma unroll
    for (int dt = 0; dt < 4; ++dt) O[dt] = mfma16(vf[1][dt], pb1, O[dt]);
    __builtin_amdgcn_s_setprio(0);
}
DI void tile_vload(const LAS unsigned char* Vt, bf16x8 (&vf)[2][4], int rl, int quad) {
#pragma unroll
    for (int ii = 0; ii < 2; ++ii)
#pragma unroll
        for (int dt = 0; dt < 4; ++dt) { const LAS unsigned char* vp = Vt + (32 * ii + 4 * quad + (rl >> 2)) * 144 + (16 * dt + 4 * (rl & 3)) * 2; vf[ii][dt] = cat4(vtr(vp), vtr(vp + 16 * 144)); }
}
DI void tile_pvmma(const bf16x8 (&vf)[2][4], const f32x4 (&s)[4], f32x4 (&O)[4]) {
    const bf16x8 pb0 = pack_frag(s[0], s[1]), pb1 = pack_frag(s[2], s[3]);
    __builtin_amdgcn_s_setprio(1);
#pragma unroll
    for (int dt = 0; dt < 4; ++dt) O[dt] = mfma16(vf[0][dt], pb0, O[dt]);
#pragma unroll
    for (int dt = 0; dt < 4; ++dt) O[dt] = mfma16(vf[1][dt], pb1, O[dt]);
    __builtin_amdgcn_s_setprio(0);
}
DI void attn_step_pair(const LAS unsigned char* K0, const LAS unsigned char* V0, int lo0, int hi0, bool act0,
                       const LAS unsigned char* K1, const LAS unsigned char* V1, int lo1, int hi1, bool act1,
                       const bf16x8 (&qf)[2], AttnState& st, int rl, int quad) {
    act0 = act0 && (hi0 >= lo0); act1 = act1 && (hi1 >= lo1);
    const bool any0 = __any(act0), any1 = __any(act1);
    if (!any0 && !any1) return;
    const int lane = rl + 16 * quad;
    f32x4 s0[4], s1[4];
    if (any0 && any1) {
        bf16x8 kf0[4][2], kf1[4][2];
#pragma unroll
        for (int kt = 0; kt < 4; ++kt)
#pragma unroll
            for (int kk = 0; kk < 2; ++kk) { kf0[kt][kk] = ld_frag_l(K0 + (16 * kt + rl) * 144 + kk * 64 + quad * 16); kf1[kt][kk] = ld_frag_l(K1 + (16 * kt + rl) * 144 + kk * 64 + quad * 16); }
        __builtin_amdgcn_s_setprio(1);
#pragma unroll
        for (int kt = 0; kt < 4; ++kt) s0[kt] = mfma16(kf0[kt][0], qf[0], (f32x4){0.f, 0.f, 0.f, 0.f});
#pragma unroll
        for (int kt = 0; kt < 4; ++kt) s1[kt] = mfma16(kf1[kt][0], qf[0], (f32x4){0.f, 0.f, 0.f, 0.f});
#pragma unroll
        for (int kt = 0; kt < 4; ++kt) s0[kt] = mfma16(kf0[kt][1], qf[1], s0[kt]);
#pragma unroll
        for (int kt = 0; kt < 4; ++kt) s1[kt] = mfma16(kf1[kt][1], qf[1], s1[kt]);
        __builtin_amdgcn_s_setprio(0);
    } else {
        if (any0) qk_tile(K0, qf, s0, rl, quad);
        if (any1) qk_tile(K1, qf, s1, rl, quad);
    }
    const bool full0 = __all((lo0 <= 0 && hi0 >= 63) || !act0), full1 = __all((lo1 <= 0 && hi1 >= 63) || !act1);
    const int kq0 = 4 * quad - lo0, kq1 = 4 * quad - lo1; const unsigned rng0 = (unsigned)(hi0 - lo0), rng1 = (unsigned)(hi1 - lo1);
    float mcb = st.m * SM_C;
    bf16x8 vf0[2][4], vf1[2][4];
    if (any0) tile_vload(V0, vf0, rl, quad);
    float ls = 0.f;
    if (any0) ls += tile_exp(s0, full0, kq0, rng0, act0 ? mcb : __builtin_inff());
    if (any1) ls += tile_exp(s1, full1, kq1, rng1, act1 ? mcb : __builtin_inff());
    if (__any(!(ls <= 1e30f))) {
        if (any0) qk_tile(K0, qf, s0, rl, quad);
        if (any1) qk_tile(K1, qf, s1, rl, quad);
        float lm = -3e38f;
        if (any0) { const float a = tile_max(s0, full0, kq0, rng0); lm = act0 ? a : lm; }
        if (any1) { const float a = tile_max(s1, full1, kq1, rng1); lm = act1 ? fmaxf(lm, a) : lm; }
        float mx = fmaxf(lm, shx<16>(lm, lane)); mx = fmaxf(mx, shx<32>(mx, lane));
        const float mn = fmaxf(st.m, mx);
        const float alpha = __builtin_amdgcn_exp2f((st.m - mn) * SM_C);
        st.l *= alpha; st.m = mn;
#pragma unroll
        for (int dt = 0; dt < 4; ++dt) st.O[dt] *= alpha;
        mcb = mn * SM_C; ls = 0.f;
        if (any0) ls += tile_exp(s0, full0, kq0, rng0, act0 ? mcb : __builtin_inff());
        if (any1) ls += tile_exp(s1, full1, kq1, rng1, act1 ? mcb : __builtin_inff());
    }
    st.l += ls;
    if (any1) tile_vload(V1, vf1, rl, quad);
    if (any0) tile_pvmma(vf0, s0, st.O);
    if (any1) tile_pvmma(vf1, s1, st.O);
}
DI void nsa_prompt_unit(Frame& F, int layer, int unit) {
    int lane = F.lane, wave = F.wave; asm volatile("" : "+v"(lane), "+s"(wave));
    const int tid = wave * 64 + lane, quad = lane >> 4, rl = lane & 15;
    const int b = unit >> 9, g = (unit >> 8) & 1, tt = unit & 255, t0 = 32 * tt;
    unsigned char* ws = KWS();
    const bf16* Z = (const bf16*)(ws + WS_Z);
    const float* ZS = (const float*)(ws + WS_ZS);
    LAS unsigned char* TB = F.lds;
    LAS float* AIMP = (LAS float*)(F.lds + 73728);
    LAS unsigned* SEL = (LAS unsigned*)(F.lds + LDSCTL_OFF + 512);
    const int tk = 4 * wave + (rl >> 2), t = t0 + tk, head = 4 * g + (rl & 3);
    const size_t row = (size_t)b * TP + t;
    bf16x8 qf[2];
    qf[0] = ld_frag_g(Z + row * LDZ + ZC_Q + head * 64 + quad * 8); qf[1] = ld_frag_g(Z + row * LDZ + ZC_Q + head * 64 + 32 + quad * 8);
    const float gc = sigmoidf_(ZS[row * 32 + head * 3]), gs = sigmoidf_(ZS[row * 32 + head * 3 + 1]), gw = sigmoidf_(ZS[row * 32 + head * 3 + 2]);
    f32x4 Of[4];
#pragma unroll
    for (int i = 0; i < 4; ++i) Of[i] = (f32x4){0.f, 0.f, 0.f, 0.f};
    AttnState st;
    const int nct = (t0 >> 10) + 1;
    const bf16* KC = (const bf16*)(ws + WS_KC) + ((size_t)(0 * 2 + b) * 512 * 2 + g) * 64;
    const bf16* VC = (const bf16*)(ws + WS_KC) + ((size_t)(1 * 2 + b) * 512 * 2 + g) * 64;
    const bf16* Zb = Z + (size_t)b * TP * LDZ + g * 64;
    const int skey = tid >> 3, sch = tid & 7;
    const int wlo = (t0 - 511 > 0 ? t0 - 511 : 0) >> 6, nwin = ((t0 + 31) >> 6) - wlo + 1;
    const int nwe = (nwin + 1) & ~1, nce = (nct + 1) & ~1;
    v4u rkA, rvA, rkB, rvB;
#define COMMIT(slot, rk, rv) do { LAS unsigned char* d_ = TB + (slot) * 18432 + skey * 144 + sch * 16; *(LAS v4u*)d_ = rk; *(LAS v4u*)(d_ + 9216) = rv; } while (0)
    NP_T(0);
    const int n1 = nwe + 2 * nce;
#define SEG1_VALID(i) ((i) < nwe ? (i) < nwin : (((i) - nwe) < nce ? ((i) - nwe) < nct : ((i) - nwe - nce) < nct))
#define SEG1_ISSUE(i, rk, rv) do { int i_ = (i); i_ = i_ < n1 ? i_ : n1 - 1; const bool win_ = i_ < nwe; int wt_ = wlo + (i_ < nwin ? i_ : nwin - 1); int jt_ = (i_ - nwe) % nce; jt_ = jt_ < nct ? jt_ : nct - 1; jt_ = jt_ < 0 ? 0 : jt_; \
        const bf16* pk_ = win_ ? Zb + (size_t)(64 * wt_ + skey) * LDZ + sch * 8 + ZC_KW : KC + (size_t)(64 * jt_ + skey) * 128 + sch * 8; \
        const bf16* pv_ = win_ ? Zb + (size_t)(64 * wt_ + skey) * LDZ + sch * 8 + ZC_VW : VC + (size_t)(64 * jt_ + skey) * 128 + sch * 8; \
        rk = *(const v4u*)pk_; rv = *(const v4u*)pv_; } while (0)
    attn_reset(st);
    float mfin = 0.f, il = 0.f;
    SEG1_ISSUE(0, rkA, rvA); SEG1_ISSUE(1, rkB, rvB);
    COMMIT(0, rkA, rvA); COMMIT(1, rkB, rvB);
    SEG1_ISSUE(2, rkA, rvA); SEG1_ISSUE(3, rkB, rvB);
    __syncthreads();
    for (int i = 0; i < n1; i += 2) {
        const LAS unsigned char* K0 = TB + (i & 3) * 18432; const LAS unsigned char* K1 = TB + ((i + 1) & 3) * 18432;
        if (i < nwe) {
            const int kb0 = 64 * (wlo + i), kb1 = kb0 + 64;
            attn_step_pair(K0, K0 + 9216, t - 511 - kb0, t - kb0, true, K1, K1 + 9216, t - 511 - kb1, t - kb1, (i + 1) < nwin, qf, st, rl, quad);
            if (i + 2 == nwe) { attn_accum3(Of, st, gw, lane); attn_reset(st); }
        } else if (i < nwe + nce) {
            const int nb0 = 64 * (i - nwe), nb1 = nb0 + 64;
            attn_step_pair(K0, K0 + 9216, 0, ((t - 31) >> 4) - nb0, true, K1, K1 + 9216, 0, ((t - 31) >> 4) - nb1, (i + 1 - nwe) < nct, qf, st, rl, quad);
            if (i + 2 == nwe + nce) { attn_accum3(Of, st, gc, lane); mfin = st.m * SM_C; const float lt_ = attn_rowsum(st, lane); il = lt_ > 0.f ? 1.f / lt_ : 0.f; }
        } else {
#pragma unroll
            for (int e2 = 0; e2 < 2; ++e2) {
                const int jt = i + e2 - nwe - nce;
                if (jt < nct) {
                    f32x4 s[4]; qk_tile(e2 ? K1 : K0, qf, s, rl, quad);
#pragma unroll
                    for (int kt = 0; kt < 4; ++kt)
#pragma unroll
                        for (int e = 0; e < 4; ++e) {
                            const int n = 64 * jt + 16 * kt + 4 * quad + e;
                            float p = (16 * n + 31 <= t) ? __builtin_amdgcn_exp2f(s[kt][e] * SM_C - mfin) * il : 0.f;
                            p += shx<1>(p, lane); p += shx<2>(p, lane);
                            if ((rl & 3) == 0) AIMP[tk * 512 + n] = p;
                        }
                }
            }
        }
        if (i + 2 < n1) { if (SEG1_VALID(i + 2)) COMMIT((i + 2) & 3, rkA, rvA); if (SEG1_VALID(i + 3)) COMMIT((i + 3) & 3, rkB, rvB); }
        __syncthreads();
        SEG1_ISSUE(i + 4, rkA, rvA); SEG1_ISSUE(i + 5, rkB, rvB);
    }
    NP_T(1);
    {
        const int nav = nct * 64;
        LAS unsigned* KS = (LAS unsigned*)(TB + wave * 2048);
#pragma unroll
        for (int q = 0; q < 4; ++q) {
            const int tq = 4 * wave + q, cur = (t0 + tq) >> 6;
#pragma unroll
            for (int e = 0; e < 2; ++e) {
                const int sblk = lane + 64 * e;
                float imp = 0.f;
#pragma unroll
                for (int d = -1; d <= 3; ++d) { const int n = 4 * sblk + d; if (n >= 0 && n < nav) imp += AIMP[tq * 512 + n]; }
                const bool valid = sblk <= cur, forced = (sblk == 0) || (sblk == cur) || (sblk == cur - 1);
                KS[q * 128 + sblk] = score_key(imp + (forced ? 1000.f : 0.f), valid, sblk);
            }
        }
        asm volatile("" ::: "memory");
#pragma unroll
        for (int q = 0; q < 4; ++q) {
            const int tq = 4 * wave + q, cur = (t0 + tq) >> 6, ng4 = (cur >> 2) + 1;
            const unsigned k0 = KS[q * 128 + lane], k1 = KS[q * 128 + 64 + lane];
            int r0, r1; key_rank2(KS + q * 128, ng4, k0, k1, r0, r1);
            const bool s0 = (lane <= cur) && r0 < 16, s1 = (lane + 64 <= cur) && r1 < 16;
            const unsigned long long m0 = __ballot(s0), m1 = __ballot(s1);
            if (lane == 0) { SEL[tq * 4 + 0] = (unsigned)m0; SEL[tq * 4 + 1] = (unsigned)(m0 >> 32); SEL[tq * 4 + 2] = (unsigned)m1; SEL[tq * 4 + 3] = (unsigned)(m1 >> 32); }
        }
    }
    __syncthreads();
    unsigned un[4], my[4], wv[4];
#pragma unroll
    for (int w = 0; w < 4; ++w) { unsigned v = (lane < 32) ? SEL[lane * 4 + w] : 0u;
        v |= (unsigned)shxi<1>((int)v, lane); v |= (unsigned)shxi<2>((int)v, lane); v |= (unsigned)shxi<4>((int)v, lane); v |= (unsigned)shxi<8>((int)v, lane); v |= (unsigned)shxi<16>((int)v, lane); v |= (unsigned)shxi<32>((int)v, lane);
        un[w] = __builtin_amdgcn_readfirstlane(v); my[w] = SEL[tk * 4 + w];
        wv[w] = SEL[(4 * wave) * 4 + w] | SEL[(4 * wave + 1) * 4 + w] | SEL[(4 * wave + 2) * 4 + w] | SEL[(4 * wave + 3) * 4 + w]; wv[w] = __builtin_amdgcn_readfirstlane(wv[w]); }
#if PH_NSAC > 1
    AttnState st2; attn_reset(st2);
#endif
    NP_T(2);
    attn_reset(st);
    {
        unsigned w0 = un[0], w1 = un[1], w2 = un[2], w3 = un[3];
#define NEXT_BLK(dst) do { if (w0) { dst = __builtin_ctz(w0); w0 &= w0 - 1u; } else if (w1) { dst = 32 + __builtin_ctz(w1); w1 &= w1 - 1u; } else if (w2) { dst = 64 + __builtin_ctz(w2); w2 &= w2 - 1u; } \
        else if (w3) { dst = 96 + __builtin_ctz(w3); w3 &= w3 - 1u; } else dst = -1; } while (0)
#define SEG2_ISSUE(blk_, rk, rv) do { const int b_ = (blk_) >= 0 ? (blk_) : 0; const bf16* p_ = Zb + (size_t)(64 * b_ + skey) * LDZ + sch * 8; rk = *(const v4u*)(p_ + ZC_KS); rv = *(const v4u*)(p_ + ZC_VS); } while (0)
#define BLK_WORD(arr, blk_) (((blk_) >> 5) == 0 ? arr[0] : ((blk_) >> 5) == 1 ? arr[1] : ((blk_) >> 5) == 2 ? arr[2] : arr[3])
#define SEG2_PAIR(ca, cb, sa, sb, stt) do { const LAS unsigned char* K0 = TB + (sa) * 18432; const LAS unsigned char* K1 = TB + (sb) * 18432; \
            const int ca_ = (ca) >= 0 ? (ca) : 0, cb_ = (cb) >= 0 ? (cb) : 0; \
            const bool need0 = ((ca) >= 0) && ((BLK_WORD(wv, ca_) >> (ca_ & 31)) & 1u), need1 = ((cb) >= 0) && ((BLK_WORD(wv, cb_) >> (cb_ & 31)) & 1u); \
            const bool mine0 = need0 && ((BLK_WORD(my, ca_) >> (ca_ & 31)) & 1u), mine1 = need1 && ((BLK_WORD(my, cb_) >> (cb_ & 31)) & 1u); \
            attn_step_pair(K0, K0 + 9216, 0, t - 64 * ca_, mine0, K1, K1 + 9216, 0, t - 64 * cb_, mine1, qf, stt, rl, quad); } while (0)
        v4u rkC, rvC, rkD, rvD;
        int c0, c1, c2, c3, n0, n1b, n2, n3, m0, m1, m2, m3;
        NEXT_BLK(c0); NEXT_BLK(c1); NEXT_BLK(c2); NEXT_BLK(c3); NEXT_BLK(n0); NEXT_BLK(n1b); NEXT_BLK(n2); NEXT_BLK(n3);
        SEG2_ISSUE(c0, rkA, rvA); SEG2_ISSUE(c1, rkB, rvB); SEG2_ISSUE(c2, rkC, rvC); SEG2_ISSUE(c3, rkD, rvD);
        COMMIT(0, rkA, rvA); COMMIT(1, rkB, rvB); COMMIT(2, rkC, rvC); COMMIT(3, rkD, rvD);
        SEG2_ISSUE(n0, rkA, rvA); SEG2_ISSUE(n1b, rkB, rvB); SEG2_ISSUE(n2, rkC, rvC); SEG2_ISSUE(n3, rkD, rvD);
        __syncthreads();
        int i = 0;
        while (c0 >= 0) {
            NEXT_BLK(m0); NEXT_BLK(m1); NEXT_BLK(m2); NEXT_BLK(m3);
            SEG2_PAIR(c0, c1, i & 7, (i + 1) & 7, st);
            SEG2_PAIR(c2, c3, (i + 2) & 7, (i + 3) & 7, st);
#if PH_NSAC > 1
            SEG2_PAIR(c0, c1, i & 7, (i + 1) & 7, st2); SEG2_PAIR(c2, c3, (i + 2) & 7, (i + 3) & 7, st2);
#endif
            COMMIT((i + 4) & 7, rkA, rvA); COMMIT((i + 5) & 7, rkB, rvB); COMMIT((i + 6) & 7, rkC, rvC); COMMIT((i + 7) & 7, rkD, rvD);
            __syncthreads();
#if defined(PH_NSAX) && (PH_NSAX & 1)
            __syncthreads();
#endif
#if defined(PH_NSAX) && (PH_NSAX & 2)
            { v4u d0_, d1_; SEG2_ISSUE(m0, d0_, d1_); asm volatile("" :: "v"(d0_), "v"(d1_)); SEG2_ISSUE(m1, d0_, d1_); asm volatile("" :: "v"(d0_), "v"(d1_));
              SEG2_ISSUE(m2, d0_, d1_); asm volatile("" :: "v"(d0_), "v"(d1_)); SEG2_ISSUE(m3, d0_, d1_); asm volatile("" :: "v"(d0_), "v"(d1_)); }
#endif
            SEG2_ISSUE(m0, rkA, rvA); SEG2_ISSUE(m1, rkB, rvB); SEG2_ISSUE(m2, rkC, rvC); SEG2_ISSUE(m3, rkD, rvD);
            c0 = n0; c1 = n1b; c2 = n2; c3 = n3; n0 = m0; n1b = m1; n2 = m2; n3 = m3; i += 4;
        }
    }
    NP_T(3);
    attn_accum3(Of, st, gs, lane);
#if PH_NSAC > 1
    attn_accum3(Of, st2, (float)(layer >> 8), lane);
#endif
#undef SEG1_ISSUE
#undef SEG1_VALID
#undef SEG2_ISSUE
#undef SEG2_PAIR
#undef BLK_WORD
#undef COMMIT
#undef NEXT_BLK
    bf16* MIX = (bf16*)(ws + WS_MIX) + row * 1536 + head * 64;
#pragma unroll
    for (int dt = 0; dt < 4; ++dt) { v2u w; w.x = pk2(Of[dt][0], Of[dt][1]); w.y = pk2(Of[dt][2], Of[dt][3]); *(v2u*)(MIX + 16 * dt + 4 * quad) = w; }
    __syncthreads();
}

#define CB() asm volatile("" ::: "memory")
DI void stage_wave_f32(LAS unsigned char* Kt, LAS unsigned char* Vt, const float* kb, const float* vb, size_t stride, int lane, float* ck = nullptr, float* cv = nullptr, int rowskip = 0) {
    const int k0 = lane >> 3, ch = lane & 7;
#pragma unroll
    for (int h = 0; h < 4; ++h) {
        const float* src = (h < 2 ? kb : vb); LAS unsigned char* dst = (h < 2 ? Kt : Vt); const int r0 = (h & 1) * 32; float* cp = (h < 2 ? ck : cv);
        f32x4 a[4][2];
#pragma unroll
        for (int it = 0; it < 4; ++it) { const float* kp = src + (size_t)(r0 + it * 8 + k0) * stride + ch * 8; a[it][0] = *(const f32x4*)kp; a[it][1] = *(const f32x4*)(kp + 4); }
#pragma unroll
        for (int it = 0; it < 4; ++it) *(LAS v4u*)(dst + (r0 + it * 8 + k0) * 144 + ch * 16) = pack8(a[it][0], a[it][1]);
        if (cp) {
#pragma unroll
            for (int it = 0; it < 4; ++it) { const int rr = r0 + it * 8 + k0; if (rr >= rowskip) { float* op = cp + (size_t)rr * stride + ch * 8; *(f32x4*)op = a[it][0]; *(f32x4*)(op + 4) = a[it][1]; } }
        }
        asm volatile("" ::: "memory");
    }
}
DI void stage_wave_b16(LAS unsigned char* Kt, LAS unsigned char* Vt, const bf16* kb, const bf16* vb, size_t stride, int nvalid, int lane, bool do_v) {
    const int k0 = lane >> 3, ch = lane & 7;
    const v4u z = (v4u){0u, 0u, 0u, 0u};
#pragma unroll
    for (int it = 0; it < 8; ++it) {
        const int key = it * 8 + k0; const bool v = key < nvalid;
        *(LAS v4u*)(Kt + key * 144 + ch * 16) = v ? *(const v4u*)(kb + key * stride + ch * 8) : z;
        if (do_v) *(LAS v4u*)(Vt + key * 144 + ch * 16) = v ? *(const v4u*)(vb + key * stride + ch * 8) : z;
    }
}
DI void nsa_sample_unit(Frame& F, int layer, int s) {
    int lane = F.lane, wave = F.wave; asm volatile("" : "+v"(lane), "+s"(wave));
    const int quad = lane >> 4, rl = lane & 15;
    const int g = wave & 1, q4 = wave >> 1;
    unsigned char* ws = KWS();
    const bf16* Z = (const bf16*)(ws + WS_Z);
    const float* ZS = (const float*)(ws + WS_ZS);
    LAS unsigned char* Kt = F.lds + wave * 18432; LAS unsigned char* Vt = Kt + 9216;
    LAS float* AIMP = (LAS float*)Vt;
    const int j = rl >> 2, head = 4 * g + (rl & 3), qpos = 2048 + j;
    const size_t row = (size_t)MP + 4 * s + j;
    bf16x8 qf[2];
    qf[0] = ld_frag_g(Z + row * LDZ + ZC_Q + head * 64 + quad * 8); qf[1] = ld_frag_g(Z + row * LDZ + ZC_Q + head * 64 + 32 + quad * 8);
    const float gc = sigmoidf_(ZS[row * 32 + head * 3]), gs = sigmoidf_(ZS[row * 32 + head * 3 + 1]), gw = sigmoidf_(ZS[row * 32 + head * 3 + 2]);
    f32x4 Of[4];
#pragma unroll
    for (int i = 0; i < 4; ++i) Of[i] = (f32x4){0.f, 0.f, 0.f, 0.f};
    AttnState st;
    const bf16* KC = (const bf16*)(ws + WS_KCS) + ((size_t)(0 * 128 + s) * 128 * 2 + g) * 64;
    const bf16* VC = (const bf16*)(ws + WS_KCS) + ((size_t)(1 * 128 + s) * 128 * 2 + g) * 64;
    attn_reset(st);
#pragma unroll 1
    for (int jt = 0; jt < 2; ++jt) {
        stage_wave_b16(Kt, Vt, KC + (size_t)64 * jt * 128, VC + (size_t)64 * jt * 128, 128, 64, lane, true); CB();
        attn_step3(Kt, Vt, qf, st, 0, 126 - 64 * jt, true, rl, quad); CB();
    }
    attn_accum3(Of, st, q4 == 0 ? gc : 0.f, lane);
    {
        const float mfin = st.m * SM_C, lt = attn_rowsum(st, lane), il = lt > 0.f ? 1.f / lt : 0.f;
#pragma unroll 1
        for (int jt = 0; jt < 2; ++jt) {
            stage_wave_b16(Kt, Vt, KC + (size_t)64 * jt * 128, VC, 128, 64, lane, false); CB();
            f32x4 sv[4]; qk_tile(Kt, qf, sv, rl, quad); CB();
#pragma unroll
            for (int kt = 0; kt < 4; ++kt)
#pragma unroll
                for (int i = 0; i < 4; ++i) {
                    const int n = 64 * jt + 16 * kt + 4 * quad + i;
                    float p = (n <= 126) ? __builtin_amdgcn_exp2f(sv[kt][i] * SM_C - mfin) * il : 0.f;
                    p += shx<1>(p, lane); p += shx<2>(p, lane);
                    if ((rl & 3) == 0) AIMP[j * 128 + n] = p;
                }
        }
    }
    CB();
    unsigned long long msk[4];
    {
        unsigned keys[4];
#pragma unroll
        for (int q = 0; q < 4; ++q) {
            float imp = 0.f;
#pragma unroll
            for (int d = -1; d <= 3; ++d) { const int n = 4 * lane + d; if (n >= 0 && n <= 126 && lane < 33) imp += AIMP[q * 128 + n]; }
            const bool forced = (lane == 0) || (lane == 32) || (lane == 31);
            keys[q] = score_key(imp + (forced ? 1000.f : 0.f), lane < 33, lane);
        }
        CB();
        LAS unsigned* KS = (LAS unsigned*)Kt;
#pragma unroll
        for (int q = 0; q < 4; ++q) KS[q * 64 + lane] = keys[q];
        CB();
#pragma unroll
        for (int q = 0; q < 4; ++q) msk[q] = __ballot(lane < 33 && key_rank(KS + q * 64, 9, keys[q]) < 16);
    }
    CB();
    const unsigned long long un = msk[0] | msk[1] | msk[2] | msk[3];
    const unsigned long long mym = j == 0 ? msk[0] : j == 1 ? msk[1] : j == 2 ? msk[2] : msk[3];
    const int* pt = (const int*)KIN(7);
    AttnState sw;
    attn_reset(st); attn_reset(sw);
    {
        unsigned long long word = un; int idx = 0;
        while (word) {
            const int blk = __builtin_ctzll(word); word &= word - 1ull;
            if ((idx++ & 3) != q4) continue;
            if (blk < 32) {
                const int phys = pt[s * 16 + (blk >> 1)];
                const float* base = KIN(2) + ((size_t)(layer * 2560 + phys) * 128 + (blk & 1) * 64) * 512 + g * 64;
                stage_wave_f32(Kt, Vt, base + 256, base + 384, 512, lane); CB();
            } else {
                stage_wave_b16(Kt, Vt, Z + (size_t)(MP + 4 * s) * LDZ + ZC_KS + g * 64, Z + (size_t)(MP + 4 * s) * LDZ + ZC_VS + g * 64, LDZ, 4, lane, true); CB();
            }
            attn_step3(Kt, Vt, qf, st, 0, qpos - 64 * blk, (mym >> blk) & 1ull, rl, quad); CB();
        }
#pragma unroll 1
        for (int jt = 0; jt < 9; ++jt) {
            if ((idx++ & 3) != q4) continue;
            if (jt < 8) { const float* base = KIN(3) + ((size_t)(layer * 128 + s) * 512 + 64 * jt) * 256 + g * 64;
                float* ob = KOUT() + O_WINS + ((size_t)(layer * 128 + s) * 512 + 64 * jt) * 256 + g * 64 - (size_t)4 * 256;
                stage_wave_f32(Kt, Vt, base, base + 128, 256, lane, ob, ob + 128, jt == 0 ? 4 : 0); CB(); }
            else { stage_wave_b16(Kt, Vt, Z + (size_t)(MP + 4 * s) * LDZ + ZC_KW + g * 64, Z + (size_t)(MP + 4 * s) * LDZ + ZC_VW + g * 64, LDZ, 4, lane, true); CB(); }
            attn_step3(Kt, Vt, qf, sw, j + 1 - 64 * jt, 512 + j - 64 * jt, true, rl, quad); CB();
        }
    }
    int lane2 = lane; asm volatile("" : "+v"(lane2));
    LAS float* X = (LAS float*)(F.lds + wave * 18432);
    {
        const float ls = attn_rowsum(st, lane), lw = attn_rowsum(sw, lane);
        X[0 * 64 + lane2] = st.m; X[1 * 64 + lane2] = ls; X[18 * 64 + lane2] = sw.m; X[19 * 64 + lane2] = lw;
#pragma unroll
        for (int dt = 0; dt < 4; ++dt)
#pragma unroll
            for (int e = 0; e < 4; ++e) { X[(2 + 4 * dt + e) * 64 + lane2] = st.O[dt][e]; X[(20 + 4 * dt + e) * 64 + lane2] = sw.O[dt][e]; }
    }
    __syncthreads();
    if (q4 == 0) {
#pragma unroll
        for (int br = 0; br < 2; ++br) {
            float m[4], l[4];
#pragma unroll
            for (int q = 0; q < 4; ++q) { const LAS float* Y = (const LAS float*)(F.lds + (2 * q + g) * 18432) + br * 18 * 64; m[q] = Y[lane2]; l[q] = Y[64 + lane2]; }
            const float mm = fmaxf(fmaxf(m[0], m[1]), fmaxf(m[2], m[3]));
            float w[4], lt = 0.f;
#pragma unroll
            for (int q = 0; q < 4; ++q) { w[q] = __builtin_amdgcn_exp2f((m[q] - mm) * SM_C); lt += l[q] * w[q]; }
            const float gate = br == 0 ? gs : gw;
            const float sc = lt > 0.f ? gate / lt : 0.f;
#pragma unroll
            for (int q = 0; q < 4; ++q) { const LAS float* Y = (const LAS float*)(F.lds + (2 * q + g) * 18432) + br * 18 * 64; const float wq = w[q] * sc;
#pragma unroll
                for (int dt = 0; dt < 4; ++dt)
#pragma unroll
                    for (int e = 0; e < 4; ++e) Of[dt][e] += Y[(2 + 4 * dt + e) * 64 + lane2] * wq; }
        }
        bf16* MIX = (bf16*)(ws + WS_MIX) + row * 1536 + head * 64;
#pragma unroll
        for (int dt = 0; dt < 4; ++dt) { v2u w2; w2.x = pk2(Of[dt][0], Of[dt][1]); w2.y = pk2(Of[dt][2], Of[dt][3]); *(v2u*)(MIX + 16 * dt + 4 * quad) = w2; }
    }
    __syncthreads();
}
DI void ret_out_unit(Frame& F, int layer, int unit) {
    const int tid = F.tid, lane = F.lane, wave = F.wave, quad = lane >> 4, rl = lane & 15;
    const int b = unit >> 8, h = (unit >> 6) & 3, c = unit & 63;
    const int row0 = b * TP + 128 * c;
    unsigned char* ws = KWS();
    const bf16* Z = (const bf16*)(ws + WS_Z);
    const bf16* QR = (const bf16*)(ws + WS_QR); const bf16* KR = (const bf16*)(ws + WS_KR);
    const bf16* RST = (const bf16*)(ws + WS_RST) + (size_t)unit * 16384;
    LAS unsigned char* LQ = F.lds; LAS unsigned char* LK = F.lds + 34816; LAS unsigned char* LV = F.lds + 69632; LAS unsigned char* LS = F.lds + 104448;
    for (int it = tid; it < 2048; it += NTHREADS) {
        const int j = it >> 4, cc = it & 15;
        *(LAS v4u*)(LQ + j * 272 + cc * 16) = *(const v4u*)(QR + (size_t)(row0 + j) * 512 + h * 128 + cc * 8);
        *(LAS v4u*)(LK + j * 272 + cc * 16) = *(const v4u*)(KR + (size_t)(row0 + j) * 512 + h * 128 + cc * 8);
        *(LAS v4u*)(LS + j * 272 + cc * 16) = *(const v4u*)(RST + (size_t)j * 128 + cc * 8);
        const v4u w = *(const v4u*)(Z + (size_t)(row0 + j) * LDZ + ZC_RQKV + 1024 + h * 128 + cc * 8);
        LAS unsigned char* d = LV + (cc * 8) * 272 + j * 2;
        *(LAS bf16*)(d) = (bf16)(w.x & 0xffff); *(LAS bf16*)(d + 272) = (bf16)(w.x >> 16); *(LAS bf16*)(d + 2 * 272) = (bf16)(w.y & 0xffff); *(LAS bf16*)(d + 3 * 272) = (bf16)(w.y >> 16);
        *(LAS bf16*)(d + 4 * 272) = (bf16)(w.z & 0xffff); *(LAS bf16*)(d + 5 * 272) = (bf16)(w.z >> 16); *(LAS bf16*)(d + 6 * 272) = (bf16)(w.w & 0xffff); *(LAS bf16*)(d + 7 * 272) = (bf16)(w.w >> 16);
    }
    __syncthreads();
    const float lg = ret_lg(h);
    const int il = 16 * wave + rl;
    bf16x8 qb[4];
#pragma unroll
    for (int s = 0; s < 4; ++s) qb[s] = ld_frag_l(LQ + il * 272 + (32 * s + 8 * quad) * 2);
    f32x4 C[8];
    const float qdec = __expf((float)(il + 1) * lg);
#pragma unroll
    for (int dt = 0; dt < 8; ++dt) {
        f32x4 a = (f32x4){0.f, 0.f, 0.f, 0.f};
#pragma unroll
        for (int s = 0; s < 4; ++s) a = mfma16(ld_frag_l(LS + (16 * dt + rl) * 272 + (32 * s + 8 * quad) * 2), qb[s], a);
        C[dt] = a * qdec;
    }
    for (int s2 = 0; s2 <= (wave >> 1); ++s2) {
        f32x4 P[2];
#pragma unroll
        for (int e = 0; e < 2; ++e) {
            const int jt = 2 * s2 + e;
            f32x4 a = (f32x4){0.f, 0.f, 0.f, 0.f};
            if (jt <= wave) {
#pragma unroll
                for (int s = 0; s < 4; ++s) a = mfma16(ld_frag_l(LK + (16 * jt + rl) * 272 + (32 * s + 8 * quad) * 2), qb[s], a);
#pragma unroll
                for (int i = 0; i < 4; ++i) { const int jj = 16 * jt + 4 * quad + i; a[i] = (il >= jj) ? a[i] * __expf((float)(il - jj) * lg) : 0.f; }
            }
            P[e] = a;
        }
        const bf16x8 pb = pack_frag(P[0], P[1]);
#pragma unroll
        for (int dt = 0; dt < 8; ++dt) {
            const LAS unsigned char* vp = LV + (16 * dt + rl) * 272 + (32 * s2 + 4 * quad) * 2;
            C[dt] = mfma16(mk_frag(*(const LAS v2u*)vp, *(const LAS v2u*)(vp + 32)), pb, C[dt]);
        }
    }
    float ss = 0.f;
#pragma unroll
    for (int dt = 0; dt < 8; ++dt) ss += (C[dt][0] * C[dt][0] + C[dt][1] * C[dt][1]) + (C[dt][2] * C[dt][2] + C[dt][3] * C[dt][3]);
    ss += shx<16>(ss, lane); ss += shx<32>(ss, lane);
    const float scl = rsqrtf(ss * (1.f / 128.f) + EPS);
    const size_t row = (size_t)row0 + il;
#pragma unroll
    for (int dt = 0; dt < 8; ++dt) {
        const v2u gwd = *(const v2u*)(Z + row * LDZ + ZC_RG + h * 128 + 16 * dt + 4 * quad);
        v2u w; w.x = pk2(C[dt][0] * scl * siluf_(lo_bf(gwd.x)), C[dt][1] * scl * siluf_(hi_bf(gwd.x))); w.y = pk2(C[dt][2] * scl * siluf_(lo_bf(gwd.y)), C[dt][3] * scl * siluf_(hi_bf(gwd.y)));
        *(v2u*)((bf16*)(ws + WS_MIX) + row * 1536 + 1024 + h * 128 + 16 * dt + 4 * quad) = w;
    }
    __syncthreads();
}
DI void gdn_out_row(Frame& F, int layer, int row) {
    const int lane = F.lane;
    unsigned char* ws = KWS();
    const float* o = (const float*)(ws + WS_OGDN) + (size_t)row * 512 + lane * 8;
    const f32x4 a = *(const f32x4*)o, b = *(const f32x4*)(o + 4);
    float ss = (a[0] * a[0] + a[1] * a[1]) + (a[2] * a[2] + a[3] * a[3]) + (b[0] * b[0] + b[1] * b[1]) + (b[2] * b[2] + b[3] * b[3]);
    ss += shx<1>(ss, lane); ss += shx<2>(ss, lane); ss += shx<4>(ss, lane); ss += shx<8>(ss, lane);
    const float scl = rsqrtf(ss * (1.f / 128.f) + EPS);
    const float* ng = KIN(18) + layer * 128 + (lane & 15) * 8;
    const f32x4 ga = *(const f32x4*)ng, gb = *(const f32x4*)(ng + 4);
    f32x4 za, zb; unpack8(*(const v4u*)((const bf16*)(ws + WS_Z) + (size_t)row * LDZ + ZC_GZ + lane * 8), za, zb);
    f32x4 ra, rb;
#pragma unroll
    for (int e = 0; e < 4; ++e) { ra[e] = a[e] * scl * ga[e] * siluf_(za[e]); rb[e] = b[e] * scl * gb[e] * siluf_(zb[e]); }
    *(v4u*)((bf16*)(ws + WS_MIX) + (size_t)row * 1536 + 512 + lane * 8) = pack8(ra, rb);
}
DI void final_row(Frame& F, int row) {
    const int lane = F.lane;
    const float* x = (const float*)(KWS() + WS_XR) + (size_t)row * DM;
    float* y = (row < MP) ? KOUT() + O_YP + (size_t)row * DM : KOUT() + O_YS + (size_t)(row - MP) * DM;
    f32x4 v[4]; float ss = 0.f;
#pragma unroll
    for (int j = 0; j < 4; ++j) { v[j] = *(const f32x4*)(x + 256 * j + lane * 4); ss += (v[j][0] * v[j][0] + v[j][1] * v[j][1]) + (v[j][2] * v[j][2] + v[j][3] * v[j][3]); }
    const float scl = rsqrtf(wave_sum(ss, lane) * (1.f / DM) + EPS);
#pragma unroll
    for (int j = 0; j < 4; ++j) *(f32x4*)(y + 256 * j + lane * 4) = v[j] * scl * *(const f32x4*)(KIN(26) + 256 * j + lane * 4);
}
template <class Epi>
DI void sgemm_tile(Frame& F, const bf16* A, int lda, const bf16* Bt, int ldb, int K, int row0, int col0, const Epi& E) {
    int lane = F.lane, wave = F.wave; asm volatile("" : "+v"(lane), "+s"(wave));
    const int tid = wave * 64 + lane, quad = lane >> 4, rl = lane & 15;
    const int kper = K >> 3, nks = kper >> 5;
    f32x4 acc[2][4];
#pragma unroll
    for (int rt = 0; rt < 2; ++rt)
#pragma unroll
        for (int ct = 0; ct < 4; ++ct) acc[rt][ct] = (f32x4){0.f, 0.f, 0.f, 0.f};
    const bf16* ap = A + (size_t)(row0 + rl) * lda + wave * kper + quad * 8;
    const bf16* bp = Bt + (size_t)(col0 + rl) * ldb + wave * kper + quad * 8;
#pragma unroll 4
    for (int ks = 0; ks < nks; ++ks) {
        bf16x8 a[2], b[4];
#pragma unroll
        for (int rt = 0; rt < 2; ++rt) a[rt] = ld_frag_g(ap + (size_t)(16 * rt) * lda + ks * 32);
#pragma unroll
        for (int ct = 0; ct < 4; ++ct) b[ct] = ld_frag_g(bp + (size_t)(16 * ct) * ldb + ks * 32);
#pragma unroll
        for (int rt = 0; rt < 2; ++rt)
#pragma unroll
            for (int ct = 0; ct < 4; ++ct) acc[rt][ct] = mfma16(a[rt], b[ct], acc[rt][ct]);
    }
    LAS float* RED = (LAS float*)F.lds;
#pragma unroll
    for (int rt = 0; rt < 2; ++rt)
#pragma unroll
        for (int ct = 0; ct < 4; ++ct)
#pragma unroll
            for (int i = 0; i < 4; ++i) RED[wave * 2176 + (16 * rt + 4 * quad + i) * 68 + 16 * ct + rl] = acc[rt][ct][i];
    __syncthreads();
    const int r = tid >> 4, c4 = (tid & 15) * 4;
    f32x4 v = *(const LAS f32x4*)(RED + r * 68 + c4);
#pragma unroll
    for (int w = 1; w < 8; ++w) v += *(const LAS f32x4*)(RED + w * 2176 + r * 68 + c4);
    E(row0 + r, col0 + c4, v, lane);
    __syncthreads();
}
struct SEpiC {
    const bf16* Z; bf16* G;
    DI void operator()(int row, int col, f32x4 v, int lane) const {
        const v2u gw = *(const v2u*)(Z + (size_t)row * LDZ + ZC_MG + col);
        v[0] *= sigmoidf_(lo_bf(gw.x)); v[1] *= sigmoidf_(hi_bf(gw.x)); v[2] *= sigmoidf_(lo_bf(gw.y)); v[3] *= sigmoidf_(hi_bf(gw.y));
        *(v2u*)(G + (size_t)row * 3072 + col) = pack4(v);
    }
};
struct SEpiRes {
    float* XR; bf16* XG; const float* gvec; float* SS; float* T; int mode; const float* XRr;
    DI void operator()(int row, int col, f32x4 v, int lane) const {
        const size_t o = (size_t)row * DM + col;
        if (mode == 1) { *(v2u*)((bf16*)T + o) = pack4(v); return; }
        f32x4 x = *(const f32x4*)(XRr + o);
        if (mode == 2) { const v2u tw = *(const v2u*)((const bf16*)T + o); const f32x4 t = (f32x4){lo_bf(tw.x), hi_bf(tw.x), lo_bf(tw.y), hi_bf(tw.y)};
#pragma unroll
            for (int e = 0; e < 4; ++e) v[e] = t[e] * sigmoidf_(v[e]); }
        x += v;
        *(f32x4*)(XR + o) = x;
        if (XG) { f32x4 y = x; if (gvec) y *= *(const f32x4*)(gvec + col); *(v2u*)(XG + o) = pack4(y); }
        if (SS) { float ssq = (x[0] * x[0] + x[1] * x[1]) + (x[2] * x[2] + x[3] * x[3]);
            ssq += shx<1>(ssq, lane); ssq += shx<2>(ssq, lane); ssq += shx<4>(ssq, lane); ssq += shx<8>(ssq, lane);
            if ((lane & 15) == 0) SS[(size_t)row * 16 + (col >> 6)] = ssq; }
    }
};
struct SEpiUp {
    bf16* H; const float* SS;
    DI void operator()(int row, int col, f32x4 v, int lane) const {
        const f32x4 p0 = *(const f32x4*)(SS + (size_t)row * 16), p1 = *(const f32x4*)(SS + (size_t)row * 16 + 4), p2 = *(const f32x4*)(SS + (size_t)row * 16 + 8), p3 = *(const f32x4*)(SS + (size_t)row * 16 + 12);
        const f32x4 ps = (p0 + p1) + (p2 + p3);
        const float rstd = rsqrtf(((ps[0] + ps[1]) + (ps[2] + ps[3])) * (1.f / DM) + EPS);
#pragma unroll
        for (int e = 0; e < 4; ++e) { const float a = fmaxf(v[e] * rstd, 0.f); v[e] = a * a; }
        *(v2u*)(H + (size_t)row * DFF + col) = pack4(v);
    }
};
#ifndef PH_P0
#define PH_P0 1
#endif
#ifndef PH_A
#define PH_A 1
#endif
#ifndef PH_B0a
#define PH_B0a 1
#endif
#ifndef PH_B0b
#define PH_B0b 1
#endif
#ifndef PH_B0c
#define PH_B0c 1
#endif
#ifndef PH_B0d
#define PH_B0d 1
#endif
#ifndef PH_SCAN
#define PH_SCAN 1
#endif
#ifndef PH_RSCAN
#define PH_RSCAN 1
#endif
#ifndef PH_NSAP
#define PH_NSAP 1
#endif
#ifndef PH_NSAS
#define PH_NSAS 1
#endif
#ifndef PH_B2
#define PH_B2 1
#endif
#ifndef PH_C
#define PH_C 1
#endif
#ifndef PH_XBAR
#define PH_XBAR 0
#endif
#ifndef PH_D
#define PH_D 1
#endif
#ifndef PH_E
#define PH_E 1
#endif
#ifndef PH_F
#define PH_F 1
#endif
#ifndef PH_G1
#define PH_G1 1
#endif
#ifndef PH_G2
#define PH_G2 1
#endif
#ifndef PH_TREG
#define PH_TREG (-1)
#endif
#if PH_TREG >= 0
#define TREG_MARK(r) do { const unsigned long long now_ = __builtin_amdgcn_s_memrealtime(); if ((r) == PH_TREG) tacc_ += now_ - tlast_; tlast_ = now_; } while (0)
#define TREG_SUB(r) do { const unsigned long long now_ = __builtin_amdgcn_s_memrealtime(); if ((r) == PH_TREG) tacc_ += now_ - tsub_; tsub_ = now_; } while (0)
#else
#define TREG_MARK(r) do { } while (0)
#define TREG_SUB(r) do { } while (0)
#endif
struct Args { const void* in[27]; float* out; unsigned char* ws; };
__global__ void __launch_bounds__(NTHREADS, 2) mk_fwd(Args args) {
    extern __shared__ __attribute__((aligned(16))) unsigned char lds_raw[];
    Frame F;
    F.lds = (LAS unsigned char*)lds_raw;
    F.wave = __builtin_amdgcn_readfirstlane((int)threadIdx.x >> 6); F.lane = 0; F.tid = 0;
    F.G = gridDim.x; F.bid = blockIdx.x;
    F.ctl = (gu32*)(KWS() + WS_CTL);
    { const Frame Fp = fresh(F); for (int u = Fp.tid; u < (LDS_BYTES - LDSCTL_OFF) / 4; u += NTHREADS) ((LAS unsigned*)(F.lds + LDSCTL_OFF))[u] = 0u;
      __syncthreads();
      (void)xcd_barrier_post((unsigned*)(F.ctl + CW_BAR), (volatile LAS unsigned*)(F.lds + MISC_OFF) + 8, Fp.tid == 0); }
    const int G = F.G, bid = F.bid;
#if PH_TREG >= 0
    unsigned long long tacc_ = 0ull, tlast_ = __builtin_amdgcn_s_memrealtime(), tsub_ = tlast_;
#endif

        for (int rp_ = 0; rp_ < PH_P0; ++rp_) {
    { Frame Fp = fresh(F); p0_prologue(Fp); }
        }
    GRID_BAR();
    TREG_MARK(0);

    for (int layer = 0; layer < NLAYER; ++layer) {
        for (int rp_ = 0; rp_ < PH_A; ++rp_) {
        {
            const Frame Fg = fresh(F); const int G = Fg.G, bid = Fg.bid;
            unsigned char* ws = KWS();
            pg8::Gemm g{(const bf16*)(ws + WS_XGA), (const bf16*)(ws + WS_WIN + layer * SZ_WIN), MROWS, LDZ, DM, DM, DM, 31, 0};
            pg8::StaticOrder S; S.init(MROWS, LDZ, G, bid);
            epi::EpiA E{(bf16*)(ws + WS_Z), (float*)(ws + WS_ZS), (const float*)(ws + WS_SSA), KOUT(), layer};
            pg8::gemm_phase<epi::EpiA, pg8::StaticOrder, true, true>(Fg.lds, g, S, E, Fg.tid);
        }
        }
        GRID_BAR();
    TREG_MARK(1);
#if PH_TREG >= 0
        tsub_ = __builtin_amdgcn_s_memrealtime();
#endif
        {
            Frame Fp = fresh(F);
            gu32* qhead = F.ctl + CW_QUEUE + 512 * layer + 384;
            volatile LAS int* qslot = (volatile LAS int*)(F.lds + MISC_OFF) + 16;
            constexpr int NI = 5 * 272 * PH_B0d, N2 = 1024 * PH_B0c, N3 = 512 * PH_B0b;
            for (;;) {
                if (Fp.tid == 0) qslot[0] = (int)__hip_atomic_fetch_add(qhead, 1u, __ATOMIC_RELAXED, __HIP_MEMORY_SCOPE_AGENT);
                __syncthreads();
                int it = qslot[0];
                __syncthreads();
                it = __builtin_amdgcn_readfirstlane(it);
                if (it >= NI + N2 + N3) break;
                TREG_SUB(99);
                if (it < NI) { const int k = it / 5, r = it % 5;
                    if (r == 0) compress_job(Fp, layer, k % 272);
                    else if (k < 256 * PH_B0a) gdn_prep_unit(Fp, layer, (4 * k + r - 1) & 1023); }
                else { const int q = it - NI, g3 = q / 3, r3 = q % 3;
                    if (r3 < 2) sample_rec_unit(Fp, layer, (2 * g3 + r3) & 1023); else ret_prep_unit(Fp, layer, g3 & 511); }
                TREG_SUB(it < NI ? ((it % 5) == 0 ? 40 : 41) : (it < NI + N2 ? 42 : 43));
            }
        }
        GRID_BAR();
    TREG_MARK(2);
        {
            Frame Fp = fresh(F);
            gu32* qbase = F.ctl + CW_QUEUE + 512 * layer;
            volatile LAS int* qslot = (volatile LAS int*)(F.lds + MISC_OFF) + 16;
            constexpr int NQ = 8 * PH_SCAN, NS = 128 * PH_NSAS, NR = 32 * PH_RSCAN, NP = 256 * PH_NSAP;
            const int pref = (int)(xb_xcc_id() & 3u);
            for (;;) {
                if (Fp.tid == 0) qslot[1] = (int)__hip_atomic_fetch_add(qbase, 1u, __ATOMIC_RELAXED, __HIP_MEMORY_SCOPE_AGENT);
                __syncthreads();
                int it = qslot[1];
                __syncthreads();
                it = __builtin_amdgcn_readfirstlane(it);
                if (it >= NQ + NR) break;
                TREG_SUB(99);
                if (it < NQ) gdn_scan_chain(Fp, layer, it & 7);
                else ret_scan_part(Fp, layer, (it - NQ) & 31);
                TREG_SUB(it < NQ ? 21 : 23);
            }
            const int when = Fp.bid & 3;
            bool tried = false;
            for (int nu = 0;; ++nu) {
                if (Fp.tid == 0) {
                    int kind = -1, idx = 0;
                    if (!tried && nu >= when) {
                        tried = true;
                        const int a = (int)__hip_atomic_fetch_add(qbase + 320, 1u, __ATOMIC_RELAXED, __HIP_MEMORY_SCOPE_AGENT);
                        if (a < NS) { kind = 4; idx = a; }
                    }
                    if (kind < 0) {
                        for (int k = 0; k < 4 && kind < 0; ++k) { const int s = (pref + k) & 3;
                            if ((int)__hip_atomic_load(qbase + 64 * (1 + s), __ATOMIC_RELAXED, __HIP_MEMORY_SCOPE_AGENT) < NP) {
                                const int r = (int)__hip_atomic_fetch_add(qbase + 64 * (1 + s), 1u, __ATOMIC_RELAXED, __HIP_MEMORY_SCOPE_AGENT);
                                if (r < NP) { kind = s; idx = r; } } }
                    }
                    if (kind < 0) {
                        const int a = (int)__hip_atomic_fetch_add(qbase + 320, 1u, __ATOMIC_RELAXED, __HIP_MEMORY_SCOPE_AGENT);
                        if (a < NS) { kind = 4; idx = a; }
                    }
                    qslot[0] = kind; qslot[1] = idx;
                }
                __syncthreads();
                int kind = qslot[0], it = qslot[1];
                __syncthreads();
                kind = __builtin_amdgcn_readfirstlane(kind); it = __builtin_amdgcn_readfirstlane(it);
                if (kind < 0) break;
                TREG_SUB(99);
                if (kind < 4) nsa_prompt_unit(Fp, layer, (kind << 8) | (255 - (it & 255)));
                else nsa_sample_unit(Fp, layer, it & 127);
                TREG_SUB(kind < 4 ? 20 : 22);
            }
        }
        GRID_BAR();
    TREG_MARK(3);
        for (int rp_ = 0; rp_ < PH_B2; ++rp_) {
        { Frame Fp = fresh(F); for (int u = Fp.bid; u < 512; u += Fp.G) ret_out_unit(Fp, layer, u); }
        { Frame Fp = fresh(F); for (int r = Fp.bid * NWAVES + Fp.wave; r < MROWS; r += Fp.G * NWAVES) gdn_out_row(Fp, layer, r); }
        }
        GRID_BAR();
    TREG_MARK(4);
        for (int rp_ = 0; rp_ < PH_C; ++rp_) {
        {
            const Frame Fg = fresh(F); const int G = Fg.G, bid = Fg.bid;
            unsigned char* ws = KWS();
            pg8::Gemm g{(const bf16*)(ws + WS_MIX), (const bf16*)(ws + WS_WBR + layer * SZ_WBR), MP, 3072, 512, 1536, 512, 2, 1024};
            pg8::BranchOrder S; S.init(MP, G, bid);
            epi::EpiCM E{(const bf16*)(ws + WS_Z), (bf16*)(ws + WS_MRG), (float*)(ws + WS_PART)};
            pg8::gemm_phase<epi::EpiCM, pg8::BranchOrder, true, true>(Fg.lds, g, S, E, Fg.tid);
            TREG_SUB(99);
            {
                Frame Fs = fresh(F); const SEpiC Es{(const bf16*)(ws + WS_Z), (bf16*)(ws + WS_GATED)};
                for (int tl = Fs.bid; tl < 16 * 48; tl += Fs.G) { const int rt = tl & 15, ct = tl >> 4, b = ct >> 4;
                    sgemm_tile(Fs, (const bf16*)(ws + WS_MIX) + b * 512, 1536, (const bf16*)(ws + WS_WBR + layer * SZ_WBR), 512, 512, MP + 32 * rt, 64 * ct, Es); }
            }
            TREG_SUB(31);
        }
        }
        GRID_BAR();
    TREG_MARK(5);
        for (int rp_ = 0; rp_ < PH_D; ++rp_) {
        {
            const Frame Fg = fresh(F); const int G = Fg.G, bid = Fg.bid;
            unsigned char* ws = KWS();
            pg8::Gemm g{(const bf16*)(ws + WS_MRG), (const bf16*)(ws + WS_WO3 + layer * SZ_WO3), MP, DM, DM, DM, 3072, 31, 0};
            pg8::StaticOrder S; S.init(MP, DM, G, bid);
            epi::EpiRes E{(float*)(ws + WS_XR), (bf16*)(ws + WS_XGB), KIN(21) + layer * DM, (float*)(ws + WS_SSB), nullptr, (rp_ + 1 < PH_D) ? 3 : 0, layer == 0 ? KIN(0) : (const float*)(ws + WS_XR)};
            pg8::gemm_phase<epi::EpiRes, pg8::StaticOrder, true, true>(Fg.lds, g, S, E, Fg.tid);
            TREG_SUB(99);
            if (rp_ + 1 == PH_D) {
                Frame Fs = fresh(F); const SEpiRes Es{(float*)(ws + WS_XR), (bf16*)(ws + WS_XGB), KIN(21) + layer * DM, (float*)(ws + WS_SSB), nullptr, 0, layer == 0 ? KIN(1) - (size_t)MP * DM : (const float*)(ws + WS_XR)};
                for (int tl = Fs.bid; tl < 256; tl += Fs.G) sgemm_tile(Fs, (const bf16*)(ws + WS_GATED), 3072, (const bf16*)(ws + WS_WO3 + layer * SZ_WO3), 3072, 3072, MP + 32 * (tl & 15), 64 * (tl >> 4), Es);
            }
            TREG_SUB(32);
        }
        }
        GRID_BAR();
    TREG_MARK(6);
        for (int rp_ = 0; rp_ < PH_E; ++rp_) {
        {
            const Frame Fg = fresh(F); const int G = Fg.G, bid = Fg.bid;
            unsigned char* ws = KWS();
            pg8::Gemm g{(const bf16*)(ws + WS_XGB), (const bf16*)(ws + WS_WUP + layer * SZ_WUP), MP, DFF, DM, DM, DM, 31, 0};
            pg8::StaticOrder S; S.init(MP, DFF, G, bid);
            epi::EpiUp E{(bf16*)(ws + WS_HMID), (const float*)(ws + WS_SSB)};
            pg8::gemm_phase<epi::EpiUp, pg8::StaticOrder, true, true>(Fg.lds, g, S, E, Fg.tid);
            TREG_SUB(99);
            {
                Frame Fs = fresh(F); const SEpiUp Es{(bf16*)(ws + WS_HMID), (const float*)(ws + WS_SSB)};
                for (int tl = Fs.bid; tl < 16 * 64; tl += Fs.G) sgemm_tile(Fs, (const bf16*)(ws + WS_XGB), DM, (const bf16*)(ws + WS_WUP + layer * SZ_WUP), DM, DM, MP + 32 * (tl & 15), 64 * (tl >> 4), Es);
            }
            TREG_SUB(33);
        }
        }
        GRID_BAR();
    TREG_MARK(7);
        for (int rp_ = 0; rp_ < PH_F; ++rp_) {
        {
            const Frame Fg = fresh(F); const int G = Fg.G, bid = Fg.bid;
            unsigned char* ws = KWS();
            pg8::Gemm g{(const bf16*)(ws + WS_HMID), (const bf16*)(ws + WS_WDN + layer * SZ_WDN), MP, DM, DFF, DFF, DFF, 31, 0};
            pg8::StaticOrder S; S.init(MP, DM, G, bid);
            epi::EpiRes E{(float*)(ws + WS_XR), (bf16*)(ws + WS_XGC), nullptr, nullptr, nullptr, (rp_ + 1 < PH_F) ? 3 : 0, (const float*)(ws + WS_XR)};
            pg8::gemm_phase<epi::EpiRes, pg8::StaticOrder, true, true>(Fg.lds, g, S, E, Fg.tid);
            TREG_SUB(99);
            if (rp_ + 1 == PH_F) {
                Frame Fs = fresh(F); const SEpiRes Es{(float*)(ws + WS_XR), (bf16*)(ws + WS_XGC), nullptr, nullptr, nullptr, 0, (const float*)(ws + WS_XR)};
                for (int tl = Fs.bid; tl < 256; tl += Fs.G) sgemm_tile(Fs, (const bf16*)(ws + WS_HMID), DFF, (const bf16*)(ws + WS_WDN + layer * SZ_WDN), DFF, DFF, MP + 32 * (tl & 15), 64 * (tl >> 4), Es);
            }
            TREG_SUB(34);
        }
        }
        GRID_BAR();
    TREG_MARK(8);
        for (int rp_ = 0; rp_ < PH_G1; ++rp_) {
        {
            const Frame Fg = fresh(F); const int G = Fg.G, bid = Fg.bid;
            unsigned char* ws = KWS();
            int kple = PLE; asm volatile("" : "+s"(kple));
            pg8::Gemm g{(const bf16*)(ws + WS_P16) + (size_t)layer * MROWS * PLE, (const bf16*)(ws + WS_WPL + layer * SZ_WPL), MP, DM, kple, PLE, PLE, 31, 0};
            pg8::StaticOrder S; S.init(MP, DM, G, bid);
            epi::EpiRes E{nullptr, nullptr, nullptr, nullptr, (float*)(ws + WS_TPLE), 1, nullptr};
            pg8::gemm_phase<epi::EpiRes, pg8::StaticOrder, true, true>(Fg.lds, g, S, E, Fg.tid);
            TREG_SUB(99);
            {
                Frame Fs = fresh(F); const SEpiRes Es{nullptr, nullptr, nullptr, nullptr, (float*)(ws + WS_TPLE), 1, nullptr};
                for (int tl = Fs.bid; tl < 256; tl += Fs.G) sgemm_tile(Fs, (const bf16*)(ws + WS_P16) + (size_t)layer * MROWS * PLE, PLE, (const bf16*)(ws + WS_WPL + layer * SZ_WPL), PLE, PLE, MP + 32 * (tl & 15), 64 * (tl >> 4), Es);
            }
            TREG_SUB(35);
        }
        }
        for (int rp_ = 0; rp_ < PH_G2; ++rp_) {
        {
            const Frame Fg = fresh(F); const int G = Fg.G, bid = Fg.bid;
            unsigned char* ws = KWS();
            const bool more = layer + 1 < NLAYER;
            pg8::Gemm g{(const bf16*)(ws + WS_XGC), (const bf16*)(ws + WS_WPG + layer * SZ_WPG), MP, DM, DM, DM, DM, 31, 0};
            pg8::StaticOrder S; S.init(MP, DM, G, bid);
            epi::EpiRes E{(float*)(ws + WS_XR), more ? (bf16*)(ws + WS_XGA) : nullptr, more ? KIN(10) + (layer + 1) * DM : nullptr, more ? (float*)(ws + WS_SSA) : nullptr, (float*)(ws + WS_TPLE), (rp_ + 1 < PH_G2) ? 3 : 2, (const float*)(ws + WS_XR)};
            pg8::gemm_phase<epi::EpiRes, pg8::StaticOrder, true, true>(Fg.lds, g, S, E, Fg.tid);
            TREG_SUB(99);
            if (rp_ + 1 == PH_G2) {
                Frame Fs = fresh(F); const SEpiRes Es{(float*)(ws + WS_XR), more ? (bf16*)(ws + WS_XGA) : nullptr, more ? KIN(10) + (layer + 1) * DM : nullptr, more ? (float*)(ws + WS_SSA) : nullptr, (float*)(ws + WS_TPLE), 2, (const float*)(ws + WS_XR)};
                for (int tl = Fs.bid; tl < 256; tl += Fs.G) sgemm_tile(Fs, (const bf16*)(ws + WS_XGC), DM, (const bf16*)(ws + WS_WPG + layer * SZ_WPG), DM, DM, MP + 32 * (tl & 15), 64 * (tl >> 4), Es);
            }
            TREG_SUB(36);
        }
        }
        GRID_BAR();
    TREG_MARK(9);
    }
    for (int xb_ = 0; xb_ < PH_XBAR; ++xb_) GRID_BAR();
    { Frame Fp = fresh(F); for (int r = Fp.bid * NWAVES + Fp.wave; r < MROWS; r += Fp.G * NWAVES) final_row(Fp, r); }
    TREG_MARK(10);
#if PH_TREG >= 0
#if defined(PH_GPT) && PH_GPT >= 0
    tacc_ += *(volatile LAS unsigned long long*)(F.lds + LDSCTL_OFF + 448);
#endif
#if defined(PH_NPT) && PH_NPT >= 0
    tacc_ += *(volatile LAS unsigned long long*)(F.lds + LDSCTL_OFF + 464);
#endif
      { const unsigned long long tend_ = __builtin_amdgcn_s_memrealtime() + tacc_; while (__builtin_amdgcn_s_memrealtime() < tend_) __builtin_amdgcn_s_sleep(8); }
#endif
}

extern "C" void kernel_launch(void* const* d_in, const int* in_sizes, int n_in, void* d_out, int out_size, void* d_ws, size_t ws_size, hipStream_t stream) {
    static int grid = 0;
    if (grid == 0) {
        if (n_in != 27 || ws_size < WS_END) { fprintf(stderr, "kernel_launch: unexpected shapes (n_in %d out %d ws %zu, need %zu)\n", n_in, out_size, ws_size, (size_t)WS_END); grid = -1; return; }
        int dev = 0, cus = 0;
        if (hipGetDevice(&dev) != hipSuccess || hipDeviceGetAttribute(&cus, hipDeviceAttributeMultiprocessorCount, dev) != hipSuccess) { grid = -1; return; }
        if (hipFuncSetAttribute((const void*)mk_fwd, hipFuncAttributeMaxDynamicSharedMemorySize, LDS_BYTES) != hipSuccess) { fprintf(stderr, "kernel_launch: hipFuncSetAttribute failed\n"); grid = -1; return; }
        int per_cu = 0;
        if (hipOccupancyMaxActiveBlocksPerMultiprocessor(&per_cu, (const void*)mk_fwd, NTHREADS, LDS_BYTES) != hipSuccess || per_cu < 1) fprintf(stderr, "kernel_launch: occupancy query reports %d\n", per_cu);
        (void)hipGetLastError();
        grid = cus;
    }
    if (grid < 0) return;
    if (hipMemsetAsync((char*)d_ws + WS_CTL, 0, CTL_ZERO_BYTES, stream) != hipSuccess) return;
    Args a{};
    for (int i = 0; i < 27; ++i) a.in[i] = d_in[i];
    a.out = (float*)d_out; a.ws = (unsigned char*)d_ws;
    hipLaunchKernelGGL(mk_fwd, dim3(grid), dim3(NTHREADS), LDS_BYTES, stream, a);
}
```

```cpp
#include <hip/hip_runtime.h>
#include <cstdio>
#include <cstdint>
namespace pg8 {
#define PG8_LAS __attribute__((address_space(3)))
typedef unsigned short bf16_t;
typedef short bf16x8 __attribute__((ext_vector_type(8)));
typedef float f32x4 __attribute__((ext_vector_type(4)));
typedef unsigned u32x4 __attribute__((ext_vector_type(4)));
constexpr int BM = 256, BK = 64, HALF = 128, HTB = HALF * BK * 2  , STAGE_BYTES = 8 * HTB, NXCD = 8, WGM = 8;

__host__ __device__ __forceinline__ int lds_byte(int r, int c) { const int st = (r >> 4) * 2 + (c >> 5), rr = r & 15, cc = c & 31, ob = rr * 64 + cc * 2; return st * 1024 + (ob ^ (((ob >> 9) & 1) << 5)); }
__host__ __device__ __forceinline__ void stage_rc(int b, int& R, int& C) { const int st = b / 1024, sb = b % 1024, swz = sb ^ (((sb >> 9) & 1) << 5); R = (st >> 1) * 16 + swz / 64; C = (st & 1) * 32 + (swz % 64) / 2; }
__host__ __device__ __forceinline__ int perm32(int rho) { const int n = rho >> 4, i = rho & 15; return 8 * (i >> 2) + 4 * n + (i & 3); }

struct Unit { int pm, pn; };
struct Gemm { const bf16_t* A; const bf16_t* Bt; int M, N, K; int lda, ldb; int a_shift, a_off; };

struct StaticOrder {
    int nM, nN, nwg, G, c;
    __host__ __device__ void init(int M, int N, int G_, int c_) { nM = M / BM; nN = N / BM; nwg = nM * nN; G = G_; c = c_; }
    __host__ __device__ bool next(int i, Unit& u) const {
        const long L = (long)i * G + c; if (L >= nwg) return false;
        int wgid = (int)L; { const int q = nwg / NXCD, r = nwg % NXCD, xcd = wgid % NXCD, off = wgid / NXCD; wgid = (xcd < r ? xcd * (q + 1) : r * (q + 1) + (xcd - r) * q) + off; }
        const int nig = WGM * nN, gid = wgid / nig, fm = gid * WGM, gsz = (nM - fm) < WGM ? (nM - fm) : WGM;
        u.pm = fm + ((wgid % nig) % gsz); u.pn = (wgid % nig) / gsz; return true;
    }
    __device__ __forceinline__ void a_ready(const Unit&) const {}
    __device__ __forceinline__ void done(const Unit&) const {}
};

__device__ __forceinline__ unsigned cvt_pk_bf16(float lo, float hi) { unsigned r; asm volatile("v_cvt_pk_bf16_f32 %0, %1, %2" : "=v"(r) : "v"(lo), "v"(hi)); return r; }
typedef float f32x2 __attribute__((ext_vector_type(2)));
template <class Epi, class Sched, bool ALIGN_EPI = false, bool SP2 = false>
__device__ __forceinline__ void gemm_phase(PG8_LAS unsigned char* lds, const Gemm g, const Sched& S, const Epi& E, const int tid) {
    const int wid = __builtin_amdgcn_readfirstlane(tid >> 6), lane = tid & 63, wr = wid >> 2, wc = wid & 3, fr = lane & 15, fq = lane >> 4;
    const int K = g.K, nt = K / BK;
    unsigned voffA[2], voffB[2];
#pragma unroll
    for (int i = 0; i < 2; ++i) { int R, C; stage_rc(tid * 16 + i * 8192, R, C); const int Rb = Epi::PERM ? ((R & ~31) + perm32(R & 31)) : R;
        voffA[i] = (unsigned)(R * g.lda + C) * 2u; voffB[i] = (unsigned)(Rb * g.ldb + C) * 2u; }
    const size_t kstep = (size_t)(BK * 2);
    const size_t hstepA = (size_t)HALF * g.lda * 2, hstepB = (size_t)HALF * g.ldb * 2;
    const size_t tstepA = 2 * hstepA, tstepB = 2 * hstepB;
    const unsigned ldsw = (unsigned)wid * 1024u;
    const int aoff = lds_byte(wr * 64 + fr, fq * 8), boff = lds_byte(wc * 32 + fr, fq * 8);
#define PG8_SA(b, h) (((b) * 2 + (h)) * HTB)
#define PG8_SB(b, h) ((4 + (b) * 2 + (h)) * HTB)
#define PG8_STAGE(bufoff, gbase, voff) do { _Pragma("unroll") for (int _i = 0; _i < 2; ++_i) \
        __builtin_amdgcn_global_load_lds((const unsigned*)((const char*)(gbase) + (voff)[_i]), (PG8_LAS unsigned*)(lds + (bufoff) + ldsw + _i * 8192), 16, 0, 0); } while (0)
#define PG8_LDA(dst, b, h) do { _Pragma("unroll") for (int m = 0; m < 4; ++m) _Pragma("unroll") for (int k = 0; k < 2; ++k) dst[m][k] = *(const PG8_LAS bf16x8*)(lds + PG8_SA(b, h) + aoff + m * 2048 + k * 1024); } while (0)
#define PG8_LDB(dst, b, h) do { _Pragma("unroll") for (int n = 0; n < 2; ++n) _Pragma("unroll") for (int k = 0; k < 2; ++k) dst[n][k] = *(const PG8_LAS bf16x8*)(lds + PG8_SB(b, h) + boff + n * 2048 + k * 1024); } while (0)
#define PG8_MMA(ai, bj, At, Bt) do { __builtin_amdgcn_s_setprio(1); _Pragma("unroll") for (int m = 0; m < 4; ++m) _Pragma("unroll") for (int n = 0; n < 2; ++n) _Pragma("unroll") for (int k = 0; k < 2; ++k) \
        acc[ai][bj][m][n] = __builtin_amdgcn_mfma_f32_16x16x32_bf16(Bt[n][k], At[m][k], acc[ai][bj][m][n], 0, 0, 0); __builtin_amdgcn_s_setprio(0); } while (0)
#define PG8_WAIT_V(n) asm volatile("s_waitcnt vmcnt(" #n ")" ::: "memory")
#define PG8_WAIT_L(n) asm volatile("s_waitcnt lgkmcnt(" #n ")" ::: "memory")
#define PG8_BAR __builtin_amdgcn_s_barrier()
#define PG8_SCHED __builtin_amdgcn_sched_barrier(0)
    Unit cur, nxt; int ui = 0;
    if (!S.next(0, cur)) return;
    f32x4 acc[2][2][4][2];
#pragma unroll
    for (int a = 0; a < 2; ++a)
#pragma unroll
        for (int b = 0; b < 2; ++b)
#pragma unroll
            for (int m = 0; m < 4; ++m)
#pragma unroll
                for (int n = 0; n < 2; ++n) acc[a][b][m][n] = (f32x4){0.f, 0.f, 0.f, 0.f};
    bf16x8 At[4][2], B0[2][2], B1[2][2];
    const char* cA = (const char*)g.A + (size_t)cur.pm * tstepA + (size_t)(cur.pn >> g.a_shift) * (size_t)g.a_off; const char* cB = (const char*)g.Bt + (size_t)cur.pn * tstepB;
    S.a_ready(cur);
    if constexpr (SP2) {
        PG8_STAGE(PG8_SB(0, 0), cB, voffB); PG8_STAGE(PG8_SB(0, 1), cB + hstepB, voffB); PG8_STAGE(PG8_SA(0, 0), cA, voffA); PG8_STAGE(PG8_SA(0, 1), cA + hstepA, voffA);
        if (wr == 1) PG8_BAR;
        PG8_WAIT_V(2); PG8_BAR;
        PG8_STAGE(PG8_SB(1, 0), cB + kstep, voffB); PG8_STAGE(PG8_SA(1, 0), cA + kstep, voffA); PG8_STAGE(PG8_SB(1, 1), cB + hstepB + kstep, voffB);
        PG8_WAIT_V(6); PG8_BAR;
    } else {
        PG8_STAGE(PG8_SB(0, 0), cB, voffB); PG8_STAGE(PG8_SA(0, 0), cA, voffA); PG8_STAGE(PG8_SB(0, 1), cB + hstepB, voffB); PG8_STAGE(PG8_SA(0, 1), cA + hstepA, voffA);
        if (wr == 1) PG8_BAR;
        PG8_WAIT_V(4); PG8_BAR;
        PG8_STAGE(PG8_SB(1, 0), cB + kstep, voffB); PG8_STAGE(PG8_SA(1, 0), cA + kstep, voffA); PG8_STAGE(PG8_SB(1, 1), cB + hstepB + kstep, voffB);
        PG8_WAIT_V(6); PG8_BAR;
    }
    for (;;) {
        const bool has_next = S.next(ui + 1, nxt);
        const char* nA = has_next ? (const char*)g.A + (size_t)nxt.pm * tstepA + (size_t)(nxt.pn >> g.a_shift) * (size_t)g.a_off : cA; const char* nB = has_next ? (const char*)g.Bt + (size_t)nxt.pn * tstepB : cB;
        for (int t = 0; t < nt; t += 2) {
            const bool last = (t == nt - 2);
            const char* a1 = cA + (size_t)(t + 1) * kstep;
            const char* a2 = last ? nA : cA + (size_t)(t + 2) * kstep; const char* b2 = last ? nB : cB + (size_t)(t + 2) * kstep;
            const char* a3 = a2 + kstep; const char* b3 = b2 + kstep;
            if (last && has_next) S.a_ready(nxt);
            if constexpr (SP2) {
            PG8_LDB(B0, 0, 0); PG8_LDB(B1, 0, 1); PG8_SCHED; PG8_LDA(At, 0, 0); PG8_STAGE(PG8_SA(1, 1), a1 + hstepA, voffA);
            PG8_WAIT_V(8); PG8_WAIT_L(0); PG8_BAR; PG8_MMA(0, 0, At, B0); PG8_MMA(0, 1, At, B1); PG8_BAR; PG8_SCHED;
            PG8_LDA(At, 0, 1); PG8_STAGE(PG8_SB(0, 0), b2, voffB); PG8_STAGE(PG8_SB(0, 1), b2 + hstepB, voffB); PG8_STAGE(PG8_SA(0, 0), a2, voffA);
            PG8_WAIT_V(8); PG8_WAIT_L(0); PG8_BAR; PG8_MMA(1, 0, At, B0); PG8_MMA(1, 1, At, B1); PG8_BAR; PG8_SCHED;
            PG8_LDB(B0, 1, 0); PG8_LDB(B1, 1, 1); PG8_SCHED; PG8_LDA(At, 1, 0); PG8_STAGE(PG8_SA(0, 1), a2 + hstepA, voffA);
            PG8_WAIT_V(8); PG8_WAIT_L(0); PG8_BAR; PG8_MMA(0, 0, At, B0); PG8_MMA(0, 1, At, B1); PG8_BAR; PG8_SCHED;
            PG8_LDA(At, 1, 1); PG8_STAGE(PG8_SB(1, 0), b3, voffB); PG8_STAGE(PG8_SB(1, 1), b3 + hstepB, voffB); PG8_STAGE(PG8_SA(1, 0), a3, voffA);
            PG8_WAIT_V(8); PG8_WAIT_L(0); PG8_BAR; PG8_MMA(1, 0, At, B0); PG8_MMA(1, 1, At, B1); PG8_BAR; PG8_SCHED;
            } else {
            PG8_LDB(B0, 0, 0); PG8_SCHED; PG8_LDA(At, 0, 0); PG8_STAGE(PG8_SA(1, 1), a1 + hstepA, voffA);
            PG8_WAIT_L(8); PG8_BAR; PG8_WAIT_L(0); PG8_MMA(0, 0, At, B0); PG8_BAR; PG8_SCHED;
            PG8_LDB(B1, 0, 1); PG8_STAGE(PG8_SB(0, 0), b2, voffB);
            PG8_BAR; PG8_WAIT_L(0); PG8_MMA(0, 1, At, B1); PG8_BAR;
            PG8_LDA(At, 0, 1); PG8_STAGE(PG8_SA(0, 0), a2, voffA);
            PG8_BAR; PG8_WAIT_L(0); PG8_MMA(1, 0, At, B0); PG8_BAR; PG8_SCHED;
            PG8_STAGE(PG8_SB(0, 1), b2 + hstepB, voffB);
            PG8_WAIT_V(6); PG8_BAR; PG8_MMA(1, 1, At, B1); PG8_BAR;
            PG8_LDB(B0, 1, 0); PG8_SCHED; PG8_LDA(At, 1, 0); PG8_STAGE(PG8_SA(0, 1), a2 + hstepA, voffA);
            PG8_WAIT_L(8); PG8_BAR; PG8_WAIT_L(0); PG8_MMA(0, 0, At, B0); PG8_BAR; PG8_SCHED;
            PG8_LDB(B1, 1, 1); PG8_STAGE(PG8_SB(1, 0), b3, voffB);
            PG8_BAR; PG8_WAIT_L(0); PG8_MMA(0, 1, At, B1); PG8_BAR;
            PG8_LDA(At, 1, 1); PG8_STAGE(PG8_SA(1, 0), a3, voffA);
            PG8_BAR; PG8_WAIT_L(0); PG8_MMA(1, 0, At, B0); PG8_BAR; PG8_SCHED;
            PG8_STAGE(PG8_SB(1, 1), b3 + hstepB, voffB);
            PG8_WAIT_V(6); PG8_BAR; PG8_MMA(1, 1, At, B1); PG8_BAR;
            }
        }
        if constexpr (ALIGN_EPI) { if (wr == 0) PG8_BAR; }
        if constexpr (!Epi::AFTER_DRAIN) { E(acc, cur, wr, wc, fr, fq); S.done(cur); }
        if (!has_next) break;
#pragma unroll
        for (int a = 0; a < 2; ++a)
#pragma unroll
            for (int b = 0; b < 2; ++b)
#pragma unroll
                for (int m = 0; m < 4; ++m)
#pragma unroll
                    for (int n = 0; n < 2; ++n) acc[a][b][m][n] = (f32x4){0.f, 0.f, 0.f, 0.f};
        cur = nxt; cA = nA; cB = nB; ++ui;
        if constexpr (ALIGN_EPI) { if (wr == 1) PG8_BAR; }
    }
    PG8_WAIT_V(0);
    if constexpr (!ALIGN_EPI) { if (wr == 0) PG8_BAR; }
    PG8_BAR;
    if constexpr (Epi::AFTER_DRAIN) { E.fused(acc, cur, wr, wc, fr, fq, lds, wid, lane); S.done(cur); }
#undef PG8_SA
#undef PG8_SB
#undef PG8_STAGE
#undef PG8_LDA
#undef PG8_LDB
#undef PG8_MMA
#undef PG8_WAIT_V
#undef PG8_WAIT_L
#undef PG8_BAR
#undef PG8_SCHED
}
}
#define DI __device__ __forceinline__
#define GAS __attribute__((address_space(1)))
#define LAS __attribute__((address_space(3)))
typedef unsigned short bf16;
typedef unsigned v4u __attribute__((ext_vector_type(4)));
typedef unsigned v2u __attribute__((ext_vector_type(2)));
typedef float f32x4 __attribute__((ext_vector_type(4)));
typedef float f32x2 __attribute__((ext_vector_type(2)));
typedef short bf16x8 __attribute__((ext_vector_type(8)));
typedef short s16x4 __attribute__((ext_vector_type(4)));
typedef GAS unsigned gu32;

constexpr int DM = 1024, TP = 8192, MP = 16384, MS = 512, MROWS = 16896, LDZ = 8704, DFF = 4096, PLE = 256, NLAYER = 2;
constexpr int ZC_Q = 0, ZC_KC = 512, ZC_VC = 640, ZC_KS = 768, ZC_VS = 896, ZC_KW = 1024, ZC_VW = 1152, ZC_GQKV = 1280, ZC_GZ = 2816, ZC_RQKV = 3328, ZC_RG = 4864, ZC_MG = 5376, ZC_SM = 8448;
constexpr float EPS = 1e-6f;
constexpr size_t O_YP = 0, O_YS = O_YP + (size_t)MP * DM, O_KVP = O_YS + (size_t)MS * DM, O_KVS = O_KVP + (size_t)2 * MP * 512, O_WINP = O_KVS + (size_t)2 * MS * 512,
                 O_WINS = O_WINP + (size_t)2 * 2 * 512 * 256, O_CVP = O_WINS + (size_t)2 * 128 * 512 * 256, O_CVS = O_CVP + (size_t)2 * 2 * 3 * 1536, O_GSP = O_CVS + (size_t)2 * 128 * 3 * 1536,
                 O_GSS = O_GSP + (size_t)2 * 2 * 4 * 16384, O_RSP = O_GSS + (size_t)2 * 128 * 4 * 16384, O_RSS = O_RSP + (size_t)2 * 2 * 4 * 16384, O_END = O_RSS + (size_t)2 * 128 * 4 * 16384;

DI float bf2f(unsigned short b) { return __uint_as_float((unsigned)b << 16); }
DI unsigned f2bf(float f) { unsigned u = __float_as_uint(f); return (u + 0x7fffu + ((u >> 16) & 1u)) >> 16; }
typedef __bf16 bf16x2_t __attribute__((ext_vector_type(2)));
DI unsigned pk2(float lo, float hi) { const f32x2 v = {lo, hi}; return __builtin_bit_cast(unsigned, __builtin_convertvector(v, bf16x2_t)); }
DI float lo_bf(unsigned w) { return __uint_as_float(w << 16); }
DI float hi_bf(unsigned w) { return __uint_as_float(w & 0xffff0000u); }
DI float sigmoidf_(float x) { return 1.f / (1.f + __expf(-x)); }
DI float siluf_(float x) { return x / (1.f + __expf(-x)); }
DI v4u pack8(const f32x4 a, const f32x4 b) { v4u w; w.x = pk2(a[0], a[1]); w.y = pk2(a[2], a[3]); w.z = pk2(b[0], b[1]); w.w = pk2(b[2], b[3]); return w; }
DI void unpack8(const v4u w, f32x4& a, f32x4& b) { a[0] = lo_bf(w.x); a[1] = hi_bf(w.x); a[2] = lo_bf(w.y); a[3] = hi_bf(w.y); b[0] = lo_bf(w.z); b[1] = hi_bf(w.z); b[2] = lo_bf(w.w); b[3] = hi_bf(w.w); }

template <int M> DI int shxi(int v, int lane) {
    if constexpr (M < 32) return __builtin_amdgcn_ds_swizzle(v, (M << 10) | 0x1f);
    else return __builtin_amdgcn_ds_bpermute((lane ^ 32) << 2, v);
}
template <int M> DI float shx(float v, int lane) { return __int_as_float(shxi<M>(__float_as_int(v), lane)); }
DI float wave_sum(float v, int lane) { v += shx<1>(v, lane); v += shx<2>(v, lane); v += shx<4>(v, lane); v += shx<8>(v, lane); v += shx<16>(v, lane); v += shx<32>(v, lane); return v; }

namespace epi {
using pg8::Unit; using pg8::bf16_t;
DI float row_rstd(const float* SS, int row, int fq, int lane) {
    const f32x4 p = *(const f32x4*)(SS + (size_t)row * 16 + 4 * fq);
    float s = (p[0] + p[1]) + (p[2] + p[3]); s += shx<16>(s, lane); s += shx<32>(s, lane);
    return rsqrtf(s * (1.f / DM) + EPS);
}
struct EpiA {
    static constexpr bool PERM = true, AFTER_DRAIN = false;
    bf16* Z; float* ZS; const float* SS; float* out; int layer;
    DI void operator()(const f32x4 (&acc)[2][2][4][2], const Unit& u, int wr, int wc, int fr, int fq) const {
        asm volatile("" : "+v"(fr), "+v"(fq), "+s"(wr), "+s"(wc));
        const int pn = u.pn;
        float rs[2][4];
#pragma unroll
        for (int ai = 0; ai < 2; ++ai)
#pragma unroll
            for (int m = 0; m < 4; ++m) rs[ai][m] = row_rstd(SS, u.pm * 256 + ai * 128 + wr * 64 + m * 16 + fr, fq, fr + 16 * fq);
#pragma unroll
        for (int ai = 0; ai < 2; ++ai)
#pragma unroll
            for (int m = 0; m < 4; ++m) {
                const int row = u.pm * 256 + ai * 128 + wr * 64 + m * 16 + fr;
                const float rstd = rs[ai][m];
#pragma unroll
                for (int bj = 0; bj < 2; ++bj) {
                    const int col = pn * 256 + bj * 128 + wc * 32 + 8 * fq;
                    const f32x4 v0 = acc[ai][bj][m][0] * rstd, v1 = acc[ai][bj][m][1] * rstd;
                    *(v4u*)(Z + (size_t)row * LDZ + col) = pack8(v0, v1);
                    float* dst = nullptr;
                    if (pn == 2 || pn == 3) {
                        dst = (row < MP) ? out + O_KVP + ((size_t)layer * MP + row) * 512 + (col - 512) : out + O_KVS + ((size_t)layer * MS + (row - MP)) * 512 + (col - 512);
                    } else if (pn == 4) {
                        const int c2 = col - 1024;
                        if (row < MP) { const int t = row & (TP - 1), b = row >> 13; if (t >= TP - 512) dst = out + O_WINP + ((size_t)(layer * 2 + b) * 512 + (t - (TP - 512))) * 256 + c2; }
                        else { const int r2 = row - MP, s = r2 >> 2, j = r2 & 3; dst = out + O_WINS + ((size_t)(layer * 128 + s) * 512 + 508 + j) * 256 + c2; }
                    } else if (pn >= 5 && pn < 11) {
                        const int c2 = col - 1280;
                        if (row < MP) { const int t = row & (TP - 1), b = row >> 13; if (t >= TP - 3) dst = out + O_CVP + ((size_t)(layer * 2 + b) * 3 + (t - (TP - 3))) * 1536 + c2; }
                        else { const int r2 = row - MP, s = r2 >> 2, j = r2 & 3; if (j >= 1) dst = out + O_CVS + ((size_t)(layer * 128 + s) * 3 + (j - 1)) * 1536 + c2; }
                    } else if (pn == 33) {
                        if (bj == 0 && wc == 0) dst = ZS + (size_t)row * 32 + 8 * fq;
                    }
                    if (dst) { *(f32x4*)dst = v0; *(f32x4*)(dst + 4) = v1; }
                }
                asm volatile("" ::: "memory");
            }
    }
};
struct EpiC {
    static constexpr bool PERM = true, AFTER_DRAIN = false;
    const bf16* Z; bf16* G;
    DI void operator()(const f32x4 (&acc)[2][2][4][2], const Unit& u, int wr, int wc, int fr, int fq) const {
        asm volatile("" : "+v"(fr), "+v"(fq), "+s"(wr), "+s"(wc));
#pragma unroll
        for (int ai = 0; ai < 2; ++ai) {
            v4u gw[4][2];
#pragma unroll
            for (int m = 0; m < 4; ++m)
#pragma unroll
                for (int bj = 0; bj < 2; ++bj) gw[m][bj] = *(const v4u*)(Z + (size_t)(u.pm * 256 + ai * 128 + wr * 64 + m * 16 + fr) * LDZ + ZC_MG + u.pn * 256 + bj * 128 + wc * 32 + 8 * fq);
#pragma unroll
            for (int m = 0; m < 4; ++m) {
                const int row = u.pm * 256 + ai * 128 + wr * 64 + m * 16 + fr;
#pragma unroll
                for (int bj = 0; bj < 2; ++bj) {
                    const int col = u.pn * 256 + bj * 128 + wc * 32 + 8 * fq;
                    f32x4 g0, g1; unpack8(gw[m][bj], g0, g1);
                    f32x4 v0 = acc[ai][bj][m][0], v1 = acc[ai][bj][m][1];
#pragma unroll
                    for (int e = 0; e < 4; ++e) { v0[e] *= sigmoidf_(g0[e]); v1[e] *= sigmoidf_(g1[e]); }
                    *(v4u*)(G + (size_t)row * 3072 + col) = pack8(v0, v1);
                }
            }
            asm volatile("" ::: "memory");
        }
    }
};
struct EpiCM {
    static constexpr bool PERM = true, AFTER_DRAIN = false;
    const bf16* Z; bf16* MRG; float* PART;
    DI void operator()(const f32x4 (&acc)[2][2][4][2], const Unit& u, int wr, int wc, int fr, int fq) const {
        asm volatile("" : "+v"(fr), "+v"(fq), "+s"(wr), "+s"(wc));
        const int b = u.pn >> 2, pn4 = u.pn & 3;
#pragma unroll
        for (int ai = 0; ai < 2; ++ai)
#pragma unroll
            for (int mp = 0; mp < 2; ++mp) {
                v4u gw[2][2];
#pragma unroll
                for (int mm = 0; mm < 2; ++mm)
#pragma unroll
                    for (int bj = 0; bj < 2; ++bj) gw[mm][bj] = *(const v4u*)(Z + (size_t)(u.pm * 256 + ai * 128 + wr * 64 + (2 * mp + mm) * 16 + fr) * LDZ + ZC_MG + b * 1024 + pn4 * 256 + bj * 128 + wc * 32 + 8 * fq);
#pragma unroll
                for (int mm = 0; mm < 2; ++mm) {
                    const int m = 2 * mp + mm;
                    const int row = u.pm * 256 + ai * 128 + wr * 64 + m * 16 + fr;
#pragma unroll
                    for (int bj = 0; bj < 2; ++bj) {
                        const int oc = pn4 * 256 + bj * 128 + wc * 32 + 8 * fq;
                        const size_t o = (size_t)row * DM + oc;
                        f32x4 g0, g1; unpack8(gw[mm][bj], g0, g1);
                        f32x4 v0 = acc[ai][bj][m][0], v1 = acc[ai][bj][m][1];
#pragma unroll
                        for (int e = 0; e < 4; ++e) { v0[e] *= sigmoidf_(g0[e]); v1[e] *= sigmoidf_(g1[e]); }
                        if (b > 0) { v0 += *(const f32x4*)(PART + o); v1 += *(const f32x4*)(PART + o + 4); }
                        if (b < 2) { *(f32x4*)(PART + o) = v0; *(f32x4*)(PART + o + 4) = v1; }
                        else *(v4u*)(MRG + o) = pack8(v0, v1);
                    }
                }
                asm volatile("" ::: "memory");
            }
    }
};
}
namespace pg8 {
struct BranchOrder {
    StaticOrder S1;
    __host__ __device__ void init(int M, int G_, int c_) { S1.init(M, 1024, G_, c_); }
    __host__ __device__ bool next(int i, Unit& u) const { if (i >= 3) return false; const bool ok = S1.next(0, u); u.pn += 4 * i; return ok; }
    __device__ __forceinline__ void a_ready(const Unit&) const {}
    __device__ __forceinline__ void done(const Unit&) const {}
};
}
namespace epi {
using pg8::Unit; using pg8::bf16_t;
struct EpiRes {
    static constexpr bool PERM = true, AFTER_DRAIN = false;
    float* XR; bf16* XG; const float* gvec; float* SS; float* T; int mode;
    const float* XRr;
    DI void operator()(const f32x4 (&acc)[2][2][4][2], const Unit& u, int wr, int wc, int fr, int fq) const {
        asm volatile("" : "+v"(fr), "+v"(fq), "+s"(wr), "+s"(wc));
        if (mode == 3) return;
        if (mode == 1) {
#pragma unroll
            for (int ai = 0; ai < 2; ++ai)
#pragma unroll
                for (int m = 0; m < 4; ++m)
#pragma unroll
                    for (int bj = 0; bj < 2; ++bj) { const size_t o = (size_t)(u.pm * 256 + ai * 128 + wr * 64 + m * 16 + fr) * DM + u.pn * 256 + bj * 128 + wc * 32 + 8 * fq;
                        *(v4u*)((bf16*)T + o) = pack8(acc[ai][bj][m][0], acc[ai][bj][m][1]); }
            return;
        }
#pragma unroll
        for (int ai = 0; ai < 2; ++ai)
#pragma unroll
            for (int mp = 0; mp < 2; ++mp) {
                f32x4 xr[2][2][2], tt[2][2][2];
#pragma unroll
                for (int mm = 0; mm < 2; ++mm)
#pragma unroll
                    for (int bj = 0; bj < 2; ++bj) { const size_t o = (size_t)(u.pm * 256 + ai * 128 + wr * 64 + (2 * mp + mm) * 16 + fr) * DM + u.pn * 256 + bj * 128 + wc * 32 + 8 * fq;
                        xr[mm][bj][0] = *(const f32x4*)(XRr + o); xr[mm][bj][1] = *(const f32x4*)(XRr + o + 4);
                        if (mode == 2) unpack8(*(const v4u*)((const bf16*)T + o), tt[mm][bj][0], tt[mm][bj][1]); }
#pragma unroll
                for (int mm = 0; mm < 2; ++mm) {
                    const int m = 2 * mp + mm;
                    const int row = u.pm * 256 + ai * 128 + wr * 64 + m * 16 + fr;
                    float ssq = 0.f;
#pragma unroll
                    for (int bj = 0; bj < 2; ++bj) {
                        const int col = u.pn * 256 + bj * 128 + wc * 32 + 8 * fq;
                        const size_t o = (size_t)row * DM + col;
                        f32x4 a0 = acc[ai][bj][m][0], a1 = acc[ai][bj][m][1];
                        f32x4 x0 = xr[mm][bj][0], x1 = xr[mm][bj][1];
                        if (mode == 2) {
#pragma unroll
                            for (int e = 0; e < 4; ++e) { a0[e] = tt[mm][bj][0][e] * sigmoidf_(a0[e]); a1[e] = tt[mm][bj][1][e] * sigmoidf_(a1[e]); } }
                        x0 += a0; x1 += a1;
                        *(f32x4*)(XR + o) = x0; *(f32x4*)(XR + o + 4) = x1;
                        ssq += (x0[0] * x0[0] + x0[1] * x0[1]) + (x0[2] * x0[2] + x0[3] * x0[3]) + (x1[0] * x1[0] + x1[1] * x1[1]) + (x1[2] * x1[2] + x1[3] * x1[3]);
                        if (XG) { if (gvec) { const f32x4 g0 = *(const f32x4*)(gvec + col), g1 = *(const f32x4*)(gvec + col + 4); x0 *= g0; x1 *= g1; }
                            *(v4u*)(XG + o) = pack8(x0, x1); }
                    }
                    if (SS) { ssq += shx<16>(ssq, fr + 16 * fq); ssq += shx<32>(ssq, fr + 16 * fq); if (fq == 0) SS[(size_t)row * 16 + u.pn * 4 + wc] = ssq; }
                }
                asm volatile("" ::: "memory");
            }
    }
};
struct EpiUp {
    static constexpr bool PERM = true, AFTER_DRAIN = false;
    bf16* H; const float* SS;
    DI void operator()(const f32x4 (&acc)[2][2][4][2], const Unit& u, int wr, int wc, int fr, int fq) const {
        asm volatile("" : "+v"(fr), "+v"(fq), "+s"(wr), "+s"(wc));
        float rs[2][4];
#pragma unroll
        for (int ai = 0; ai < 2; ++ai)
#pragma unroll
            for (int m = 0; m < 4; ++m) rs[ai][m] = row_rstd(SS, u.pm * 256 + ai * 128 + wr * 64 + m * 16 + fr, fq, fr + 16 * fq);
#pragma unroll
        for (int ai = 0; ai < 2; ++ai)
#pragma unroll
            for (int m = 0; m < 4; ++m) {
                const int row = u.pm * 256 + ai * 128 + wr * 64 + m * 16 + fr;
                const float rstd = rs[ai][m];
#pragma unroll
                for (int bj = 0; bj < 2; ++bj) {
                    const int col = u.pn * 256 + bj * 128 + wc * 32 + 8 * fq;
                    f32x4 v0 = acc[ai][bj][m][0] * rstd, v1 = acc[ai][bj][m][1] * rstd;
#pragma unroll
                    for (int e = 0; e < 4; ++e) { const float a = fmaxf(v0[e], 0.f), b = fmaxf(v1[e], 0.f); v0[e] = a * a; v1[e] = b * b; }
                    *(v4u*)(H + (size_t)row * DFF + col) = pack8(v0, v1);
                }
                asm volatile("" ::: "memory");
            }
    }
};
}
constexpr size_t al256(size_t x) { return (x + 255) & ~(size_t)255; }
constexpr size_t WS_CTL = 0, CTL_ZERO_BYTES = 1u << 20;
constexpr size_t SZ_WIN = (size_t)LDZ * DM * 2, SZ_WBR = (size_t)3072 * 512 * 2, SZ_WO3 = (size_t)DM * 3072 * 2, SZ_WUP = (size_t)DFF * DM * 2, SZ_WDN = (size_t)DM * DFF * 2,
                 SZ_WPL = (size_t)DM * PLE * 2, SZ_WPG = (size_t)DM * DM * 2, SZ_W1T = (size_t)2 * 64 * 2048 * 2, SZ_W2T = (size_t)2 * 64 * 64 * 2;
constexpr size_t WS_WIN = CTL_ZERO_BYTES, WS_WBR = WS_WIN + 2 * SZ_WIN, WS_WO3 = WS_WBR + 2 * SZ_WBR, WS_WUP = WS_WO3 + 2 * SZ_WO3, WS_WDN = WS_WUP + 2 * SZ_WUP,
                 WS_WPL = WS_WDN + 2 * SZ_WDN, WS_WPG = WS_WPL + 2 * SZ_WPL, WS_W1T = WS_WPG + 2 * SZ_WPG, WS_W2T = WS_W1T + 2 * SZ_W1T, WS_ROT = al256(WS_W2T + 2 * SZ_W2T);
constexpr size_t WS_P16 = WS_ROT + (size_t)TP * 64 * 8;
constexpr size_t WS_XR = WS_P16 + (size_t)2 * MROWS * PLE * 2;
constexpr size_t WS_XGA = WS_XR + (size_t)MROWS * DM * 4, WS_XGB = WS_XGA + (size_t)MROWS * DM * 2, WS_XGC = WS_XGB + (size_t)MROWS * DM * 2;
constexpr size_t WS_SSA = WS_XGC + (size_t)MROWS * DM * 2, WS_SSB = WS_SSA + (size_t)MROWS * 64;
constexpr size_t WS_Z = WS_SSB + (size_t)MROWS * 64, WS_ZS = WS_Z + (size_t)MROWS * LDZ * 2;
constexpr size_t WS_MIX = WS_ZS + (size_t)MROWS * 128, WS_GATED = WS_MIX + (size_t)MROWS * 1536 * 2, WS_HMID = WS_GATED + (size_t)MROWS * 3072 * 2;
constexpr size_t WS_TPLE = WS_HMID + (size_t)MROWS * DFF * 2;
constexpr size_t WS_KC = WS_TPLE + (size_t)MROWS * DM * 4;
constexpr size_t WS_KCS = WS_KC + (size_t)2 * 2 * 512 * 2 * 64 * 2;
constexpr int GREC = 73984;
constexpr size_t WS_GREC = WS_KCS + (size_t)2 * 128 * 128 * 2 * 64 * 2;
constexpr size_t WS_OGDN = WS_GREC + (size_t)1024 * GREC;
constexpr size_t WS_RKV = WS_OGDN + (size_t)MROWS * 512 * 4;
constexpr size_t WS_RST = WS_RKV + (size_t)512 * 16384 * 4;
constexpr size_t WS_QR = WS_RST + (size_t)512 * 16384 * 2, WS_KR = WS_QR + (size_t)MP * 512 * 2;
constexpr size_t WS_MRG = WS_KR + (size_t)MP * 512 * 2;
constexpr size_t WS_PART = WS_MRG + (size_t)MP * DM * 2;
constexpr size_t WS_END = WS_PART + (size_t)MP * DM * 4;
static_assert(WS_W1T % 256 == 0 && WS_Z % 256 == 0 && WS_GREC % 256 == 0 && WS_RKV % 256 == 0 && WS_KC % 256 == 0 && WS_XR % 256 == 0, "ws alignment");

constexpr int CW_TMO = 0, CW_BAR = 4096, CW_QUEUE = 8192;
constexpr int NWAVES = 8, NTHREADS = 512;
constexpr int RING_BYTES = 147456, LDSCTL_OFF = RING_BYTES, MISC_OFF = LDSCTL_OFF + 320, LDS_BYTES = RING_BYTES + 1024;

#define RLX_AGENT __ATOMIC_RELAXED, __HIP_MEMORY_SCOPE_AGENT
#define LDS_WAIT() asm volatile("s_waitcnt lgkmcnt(0)" ::: "memory")
#define VM_WAIT() asm volatile("s_waitcnt vmcnt(0)" ::: "memory")
#define XB_TMO      128
#define XB_XCNT(j)  (256  + 64 * (j))
#define XB_XSUB(j)  (1280 + 64 * (j))
#define XB_XGEN(j)  (2304 + 64 * (j))
#define XB_TOP      3328
#define XB_TOPGEN   3392
#define XCD_BAR_WORDS 3456
#define XB_SPIN_CAP (1u << 18)

__device__ __forceinline__ unsigned xb_ld(unsigned* p)              { return __hip_atomic_load(p, __ATOMIC_RELAXED, __HIP_MEMORY_SCOPE_AGENT); }
__device__ __forceinline__ unsigned xb_add(unsigned* p, unsigned v) { return __hip_atomic_fetch_add(p, v, __ATOMIC_RELAXED, __HIP_MEMORY_SCOPE_AGENT); }
__device__ __forceinline__ unsigned xb_xcc_id() { return (unsigned)__builtin_amdgcn_s_getreg((3 << 11) | 20) & 0xFu; }
#define XB_SPIN(cond, bar) do { unsigned _sp = 0; while (cond) { __builtin_amdgcn_s_sleep(1); \
    if ((++_sp & 255u) == 0u) { if (xb_ld(&(bar)[XB_TMO])) break; if (_sp > XB_SPIN_CAP) { atomicAdd(&(bar)[XB_TMO], 1u); break; } } } } while (0)

struct XcdBarrier {
    unsigned* bar; unsigned x;
    volatile LAS unsigned* st;
};

__device__ __forceinline__ XcdBarrier xcd_barrier_post(unsigned* bar, volatile LAS unsigned* st, bool t0) {
    XcdBarrier b; b.bar = bar; b.x = xb_xcc_id(); b.st = st;
    if (t0) (void)xb_add(&bar[XB_XCNT(b.x)], 1u);
    return b;
}
__device__ __forceinline__ void xcd_barrier_complete(unsigned* bar, unsigned x, unsigned& nloc, unsigned& nx) {
    const unsigned G = gridDim.x * gridDim.y * gridDim.z;
    unsigned sum, cnt, mine, sp = 0u;
    for (;;) {
        sum = 0u; cnt = 0u; mine = 0u;
#pragma unroll
        for (unsigned j = 0; j < 16; ++j) { const unsigned c = xb_ld(&bar[XB_XCNT(j)]); sum += c; cnt += (c > 0u) ? 1u : 0u; mine = (j == x) ? c : mine; }
        if (sum == G) break;
        __builtin_amdgcn_s_sleep(1);
        if ((++sp & 255u) == 0u) { if (xb_ld(&bar[XB_TMO])) break; if (sp > XB_SPIN_CAP) { atomicAdd(&bar[XB_TMO], 1u); break; } }
    }
    nloc = mine > 0u ? mine : 1u; nx = cnt > 0u ? cnt : 1u;
}

__device__ __forceinline__ void xcd_barrier(const XcdBarrier& b, bool t0) {
    asm volatile("s_waitcnt vmcnt(0)" ::: "memory");
    __syncthreads();
    if (t0) {
        unsigned* bar = b.bar;
        __builtin_amdgcn_s_waitcnt(0);
        unsigned nloc = b.st[0], nx = b.st[1];
        if (nloc == 0u) { xcd_barrier_complete(bar, b.x, nloc, nx); b.st[0] = nloc; b.st[1] = nx; }
        const unsigned old = xb_add(&bar[XB_XSUB(b.x)], 1u);
        const unsigned gen = old / nloc;
        if (old + 1u == (gen + 1u) * nloc) {
            __builtin_amdgcn_fence(__ATOMIC_RELEASE, "agent");
            asm volatile("s_waitcnt vmcnt(0)" ::: "memory");
            const unsigned og = xb_add(&bar[XB_TOP], 1u);
            const unsigned tg = og / nx;
            if (og + 1u == (tg + 1u) * nx) xb_add(&bar[XB_TOPGEN], 1u);
            else XB_SPIN(xb_ld(&bar[XB_TOPGEN]) == tg, bar);
            __builtin_amdgcn_fence(__ATOMIC_ACQUIRE, "agent");
            xb_add(&bar[XB_XGEN(b.x)], 1u);
            asm volatile("s_waitcnt vmcnt(0)" ::: "memory");
        } else {
            XB_SPIN(xb_ld(&bar[XB_XGEN(b.x)]) == gen, bar);
            __builtin_amdgcn_fence(__ATOMIC_ACQUIRE, "agent");
            asm volatile("s_waitcnt vmcnt(0)" ::: "memory");
        }
    }
    __syncthreads();
}
typedef const void* const __attribute__((address_space(4)))* kargp_t;
DI const float* KIN(int i) { const GAS float* p = (const GAS float*)((kargp_t)__builtin_amdgcn_kernarg_segment_ptr())[i]; asm volatile("" : "+s"(p)); return (const float*)p; }
DI float* KOUT() { GAS float* p = (GAS float*)((kargp_t)__builtin_amdgcn_kernarg_segment_ptr())[27]; asm volatile("" : "+s"(p)); return (float*)p; }
DI unsigned char* KWS() { GAS unsigned char* p = (GAS unsigned char*)((kargp_t)__builtin_amdgcn_kernarg_segment_ptr())[28]; asm volatile("" : "+s"(p)); return (unsigned char*)p; }
struct Frame {
    LAS unsigned char* lds;
    gu32* ctl;
    int tid, lane, wave, G, bid;
};
DI bf16x8 ld_frag_g(const bf16* p) { return __builtin_bit_cast(bf16x8, *(const v4u*)p); }
DI bf16x8 ld_frag_l(const LAS unsigned char* p) { return *(const LAS bf16x8*)p; }
DI f32x4 mfma16(bf16x8 a, bf16x8 b, f32x4 c) { return __builtin_amdgcn_mfma_f32_16x16x32_bf16(a, b, c, 0, 0, 0); }
DI bf16x8 pack_frag(const f32x4 a, const f32x4 b) { return __builtin_bit_cast(bf16x8, pack8(a, b)); }
DI int lane_id() { int l; asm volatile("v_mbcnt_lo_u32_b32 %0, -1, 0\n\tv_mbcnt_hi_u32_b32 %0, -1, %0" : "=v"(l)); return l; }
DI Frame fresh(const Frame& F0) {
    Frame F = F0; int w = F0.wave, g = F0.G, b = F0.bid; asm volatile("" : "+s"(w), "+s"(g), "+s"(b));
    int l = lane_id(); asm volatile("" : "+v"(l));
    unsigned lb = (unsigned)(uintptr_t)F0.lds; asm volatile("" : "+s"(lb)); F.lds = (LAS unsigned char*)(uintptr_t)lb;
    F.wave = w; F.lane = l; F.tid = w * 64 + l; F.G = g; F.bid = b; return F;
}
#define GRID_BAR() do { XcdBarrier b_; b_.bar = (unsigned*)((gu32*)(KWS() + WS_CTL) + CW_BAR); b_.x = xb_xcc_id(); b_.st = (volatile LAS unsigned*)(F.lds + MISC_OFF) + 8; \
    const Frame Fb_ = fresh(F); xcd_barrier(b_, Fb_.tid == 0); } while (0)
DI int win_colmap(int j) {
    if (j < 1280) return j; if (j < 2816) return j + 24; if (j < 8448) return j + 32; if (j < 8472) return j - 8448 + 1280; if (j < 8480) return j - 8472 + 2840; return -1;
}
DI void tr_item(const float* W, int ldw, int k0, int srccol, bf16* WT, size_t dst_row0, int ldt, int kdst0, int nrep, int krep, LAS float* scr, int lane) {
#pragma unroll 8
    for (int i = 0; i < 32; ++i) { const int kk = 2 * i + (lane >> 5); const float v_ = W[(size_t)(k0 + kk) * ldw + (srccol >= 0 ? srccol : 0)]; scr[kk * 33 + (lane & 31)] = (srccol >= 0) ? v_ : 0.f; }
    LDS_WAIT(); asm volatile("" ::: "memory");
    const int c = lane & 7;
#pragma unroll
    for (int j = 0; j < 4; ++j) { const int n = (lane >> 3) + 8 * j; const LAS float* s = scr + (8 * c) * 33 + n;
        v4u o; o.x = pk2(s[0 * 33], s[1 * 33]); o.y = pk2(s[2 * 33], s[3 * 33]); o.z = pk2(s[4 * 33], s[5 * 33]); o.w = pk2(s[6 * 33], s[7 * 33]);
        for (int r = 0; r < nrep; ++r) *(v4u*)(WT + (dst_row0 + n) * (size_t)ldt + kdst0 + r * krep + 8 * c) = o; }
    LDS_WAIT(); asm volatile("" ::: "memory");
}
DI void p0_prologue(Frame& F) {
    LAS float* scr = (LAS float*)(F.lds + F.wave * 16384);
    const int gw = F.bid * NWAVES + F.wave, NGW = F.G * NWAVES, lane = F.lane;
    unsigned char* ws = KWS();
    constexpr int I_A = 16 * 272, I_B = 3 * 8 * 32, I_C = 16 * 32, I_D = 16 * 128, I_E = 64 * 32, I_F = 4 * 32, I_G = 16 * 32, I_H = 2 * 32 * 2, I_I = 2 * 2;
    constexpr int I_L = I_A + I_B + I_C + I_D + I_E + I_F + I_G + I_H + I_I;
    for (int it = gw; it < 2 * I_L; it += NGW) {
        const int l = it / I_L; int r = it % I_L;
        if (r < I_A) { const int kb = r / 272, nb = r % 272; tr_item(KIN(11) + (size_t)l * DM * 8480, 8480, 64 * kb, win_colmap(32 * nb + (lane & 31)), (bf16*)(ws + WS_WIN + l * SZ_WIN), 32 * nb, DM, 64 * kb, 1, 0, scr, lane); continue; } r -= I_A;
        if (r < I_B) { const int b = r / 256, kb = (r % 256) / 32, nb = r % 32; tr_item(KIN(19) + (size_t)(l * 3 + b) * 512 * DM, DM, 64 * kb, 32 * nb + (lane & 31), (bf16*)(ws + WS_WBR + l * SZ_WBR), b * 1024 + 32 * nb, 512, 64 * kb, 1, 0, scr, lane); continue; } r -= I_B;
        if (r < I_C) { const int kb = r / 32, nb = r % 32; tr_item(KIN(20) + (size_t)l * DM * DM, DM, 64 * kb, 32 * nb + (lane & 31), (bf16*)(ws + WS_WO3 + l * SZ_WO3), 32 * nb, 3072, 64 * kb, 3, 1024, scr, lane); continue; } r -= I_C;
        if (r < I_D) { const int kb = r / 128, nb = r % 128; tr_item(KIN(22) + (size_t)l * DM * DFF, DFF, 64 * kb, 32 * nb + (lane & 31), (bf16*)(ws + WS_WUP + l * SZ_WUP), 32 * nb, DM, 64 * kb, 1, 0, scr, lane); continue; } r -= I_D;
        if (r < I_E) { const int kb = r / 32, nb = r % 32; tr_item(KIN(23) + (size_t)l * DFF * DM, DM, 64 * kb, 32 * nb + (lane & 31), (bf16*)(ws + WS_WDN + l * SZ_WDN), 32 * nb, DFF, 64 * kb, 1, 0, scr, lane); continue; } r -= I_E;
        if (r < I_F) { const int kb = r / 32, nb = r % 32; tr_item(KIN(24) + (size_t)l * PLE * DM, DM, 64 * kb, 32 * nb + (lane & 31), (bf16*)(ws + WS_WPL + l * SZ_WPL), 32 * nb, PLE, 64 * kb, 1, 0, scr, lane); continue; } r -= I_F;
        if (r < I_G) { const int kb = r / 32, nb = r % 32; tr_item(KIN(25) + (size_t)l * DM * DM, DM, 64 * kb, 32 * nb + (lane & 31), (bf16*)(ws + WS_WPG + l * SZ_WPG), 32 * nb, DM, 64 * kb, 1, 0, scr, lane); continue; } r -= I_G;
        if (r < I_H) { const int kv = r / 64, kb = (r % 64) / 2, nb = r % 2; tr_item(KIN(13) + (size_t)(l * 2 + kv) * 2048 * 64, 64, 64 * kb, 32 * nb + (lane & 31), (bf16*)(ws + WS_W1T + l * SZ_W1T) + (size_t)kv * 64 * 2048, 32 * nb, 2048, 64 * kb, 1, 0, scr, lane); continue; } r -= I_H;
        { const int kv = r / 2, nb = r % 2; tr_item(KIN(14) + (size_t)(l * 2 + kv) * 64 * 64, 64, 0, 32 * nb + (lane & 31), (bf16*)(ws + WS_W2T + l * SZ_W2T) + (size_t)kv * 64 * 64, 32 * nb, 64, 0, 1, 0, scr, lane); }
    }
    bf16* XGA = (bf16*)(ws + WS_XGA); float* SSA = (float*)(ws + WS_SSA); bf16* P16 = (bf16*)(ws + WS_P16);
    const float* g0 = KIN(10);
    for (int row = gw; row < MROWS; row += NGW) {
        const float* xs = (row < MP) ? KIN(0) + (size_t)row * DM : KIN(1) + (size_t)(row - MP) * DM;
        float ss = 0.f;
#pragma unroll
        for (int j = 0; j < 2; ++j) {
            const int c = j * 512 + lane * 8;
            f32x4 a = *(const f32x4*)(xs + c), b = *(const f32x4*)(xs + c + 4);
            ss += (a[0] * a[0] + a[1] * a[1]) + (a[2] * a[2] + a[3] * a[3]) + (b[0] * b[0] + b[1] * b[1]) + (b[2] * b[2] + b[3] * b[3]);
            const f32x4 ga = *(const f32x4*)(g0 + c), gb = *(const f32x4*)(g0 + c + 4);
            *(v4u*)(XGA + (size_t)row * DM + c) = pack8(a * ga, b * gb);
        }
        ss = wave_sum(ss, lane);
        if (lane < 16) SSA[(size_t)row * 16 + lane] = (lane == 0) ? ss : 0.f;
#pragma unroll
        for (int l = 0; l < 2; ++l) {
            const float* ps = (row < MP) ? KIN(8) + ((size_t)l * MP + row) * PLE : KIN(9) + ((size_t)l * MS + (row - MP)) * PLE;
            const f32x4 a = *(const f32x4*)(ps + lane * 4);
            v2u o; o.x = pk2(a[0], a[1]); o.y = pk2(a[2], a[3]);
            *(v2u*)(P16 + ((size_t)l * MROWS + row) * PLE + lane * 4) = o;
        }
    }
    const int gt = F.bid * NTHREADS + F.tid, NGT = F.G * NTHREADS;
    f32x2* ROT = (f32x2*)(ws + WS_ROT);
    for (int e = gt; e < TP * 64; e += NGT) {
        const int pos = e >> 6, i = e & 63;
        const float x = (float)i * (1.0f / 63.0f);
        const float inv = exp2f(-x * 13.287712379549449f);
        const float ang = (float)pos * inv;
        const double rev = (double)ang * 0.15915494309189535;
        const float fr = (float)(rev - floor(rev));
        ROT[e] = (f32x2){__builtin_amdgcn_cosf(fr), __builtin_amdgcn_sinf(fr)};
    }
}
DI float gelu_tanh(float x) { const float u = 0.7978845608028654f * (x + 0.044715f * x * x * x); const float e = __expf(2.f * u); return 0.5f * x * (1.f + (1.f - 2.f / (e + 1.f))); }
DI bf16x8 mk_frag(v2u a, v2u b) { v4u w; w.x = a.x; w.y = a.y; w.z = b.x; w.w = b.y; return __builtin_bit_cast(bf16x8, w); }

template <bool sample> DI void compress_job_t(Frame& F, int layer, int job) {
    int lane = F.lane, wave = F.wave; asm volatile("" : "+v"(lane), "+s"(wave));
    const int tid = wave * 64 + lane, quad = lane >> 4, rl = lane & 15;
    unsigned char* ws = KWS();
    int kv, bs, g0, nbase;
    if (sample) { kv = job >> 7; bs = job & 127; g0 = 0; nbase = 0; }
    else { const int j2 = job - 256; kv = j2 >> 3; bs = (j2 >> 2) & 1; g0 = (j2 >> 1) & 1; nbase = (j2 & 1) * 256; }
    const bf16* W1T = (const bf16*)(ws + WS_W1T + layer * SZ_W1T) + (size_t)kv * 64 * 2048;
    const bf16* W2T = (const bf16*)(ws + WS_W2T + layer * SZ_W2T) + (size_t)kv * 64 * 64;
    const float* pe = KIN(12) + (size_t)(layer * 2 + kv) * 32 * 64;
    const bf16* Z = (const bf16*)(ws + WS_Z);
    const int* pt = (const int*)KIN(7);
    const float* cache = KIN(2);
    LAS unsigned char* LW = F.lds;
    int gg[2], nn[2];
    size_t pb0[2], pb1[2];
#pragma unroll
    for (int tl = 0; tl < 2; ++tl) { const int T = 2 * wave + tl; if (sample) { gg[tl] = T >> 3; nn[tl] = 16 * (T & 7) + rl; } else { gg[tl] = g0; nn[tl] = nbase + 16 * T + rl; }
        pb0[tl] = 0; pb1[tl] = 0;
        if (sample) { const int p0 = (16 * nn[tl]) >> 7; const int p1 = p0 + 1 > 15 ? 15 : p0 + 1;
            pb0[tl] = (size_t)(layer * 2560 + pt[bs * 16 + p0]) * 128 * 512; pb1[tl] = (size_t)(layer * 2560 + pt[bs * 16 + p1]) * 128 * 512; } }
    f32x4 h[2][4];
#pragma unroll
    for (int tl = 0; tl < 2; ++tl)
#pragma unroll
        for (int i = 0; i < 4; ++i) h[tl][i] = (f32x4){0.f, 0.f, 0.f, 0.f};
#pragma unroll 1
    for (int c = 0; c < 4; ++c) {
        __syncthreads();
#pragma unroll
        for (int k = 0; k < 8; ++k) { const int pc = tid + 512 * k, r = pc >> 6, c16 = pc & 63;
            *(LAS v4u*)(LW + r * 1040 + c16 * 16) = *(const v4u*)(W1T + (size_t)r * 2048 + c * 512 + c16 * 8); }
        __syncthreads();
#pragma unroll 8
        for (int kk = 0; kk < 16; ++kk) {
            const int j = 8 * c + (kk >> 1), dim0 = (kk & 1) * 32 + quad * 8;
            const f32x4 pe0 = *(const f32x4*)(pe + j * 64 + dim0), pe1 = *(const f32x4*)(pe + j * 64 + dim0 + 4);
            bf16x8 xb[2];
#pragma unroll
            for (int tl = 0; tl < 2; ++tl) {
                f32x4 x0, x1;
                if (!sample) { const size_t row = (size_t)bs * TP + 16 * nn[tl] + j; unpack8(*(const v4u*)(Z + row * LDZ + ZC_KC + kv * 128 + gg[tl] * 64 + dim0), x0, x1); }
                else { int pos = 16 * nn[tl] + j; pos = pos > 2047 ? 2047 : pos;
                    const float* p = cache + (((pos >> 7) == ((16 * nn[tl]) >> 7)) ? pb0[tl] : pb1[tl]) + (size_t)(pos & 127) * 512 + kv * 128 + gg[tl] * 64 + dim0; x0 = *(const f32x4*)p; x1 = *(const f32x4*)(p + 4); }
                xb[tl] = pack_frag(x0 + pe0, x1 + pe1);
            }
#pragma unroll
            for (int ht = 0; ht < 4; ++ht) {
                const bf16x8 a = ld_frag_l(LW + (16 * ht + rl) * 1040 + (kk * 32 + quad * 8) * 2);
                h[0][ht] = mfma16(a, xb[0], h[0][ht]); h[1][ht] = mfma16(a, xb[1], h[1][ht]);
            }
        }
    }
#pragma unroll
    for (int tl = 0; tl < 2; ++tl) {
#pragma unroll
        for (int ht = 0; ht < 4; ++ht)
#pragma unroll
            for (int i = 0; i < 4; ++i) h[tl][ht][i] = gelu_tanh(h[tl][ht][i]);
        bf16x8 gb[2]; gb[0] = pack_frag(h[tl][0], h[tl][1]); gb[1] = pack_frag(h[tl][2], h[tl][3]);
        const int n = nn[tl], g = gg[tl];
        bf16* dst = sample ? (bf16*)(ws + WS_KCS) + ((((size_t)kv * 128 + bs) * 128 + n) * 2 + g) * 64 : (bf16*)(ws + WS_KC) + ((((size_t)kv * 2 + bs) * 512 + n) * 2 + g) * 64;
        const bool zero = sample && n == 127;
#pragma unroll
        for (int ot = 0; ot < 4; ++ot) {
            f32x4 o = (f32x4){0.f, 0.f, 0.f, 0.f};
#pragma unroll
            for (int s = 0; s < 2; ++s) {
                const bf16* wp = W2T + (16 * ot + rl) * 64 + 32 * s + 4 * quad;
                o = mfma16(mk_frag(*(const v2u*)wp, *(const v2u*)(wp + 16)), gb[s], o);
            }
            v2u w; w.x = zero ? 0u : pk2(o[0], o[1]); w.y = zero ? 0u : pk2(o[2], o[3]);
            *(v2u*)(dst + 16 * ot + 4 * quad) = w;
        }
    }
    __syncthreads();
}

DI v2u pack4(const f32x4 v) { v2u w; w.x = pk2(v[0], v[1]); w.y = pk2(v[2], v[3]); return w; }
DI void compress_sample_job(Frame& F, int layer, int job) {
    int lane = F.lane, wave = F.wave; asm volatile("" : "+v"(lane), "+s"(wave));
    const int tid = wave * 64 + lane, quad = lane >> 4, rl = lane & 15;
    unsigned char* ws = KWS();
    const int kv = job >> 7, bs = job & 127;
    const bf16* W1T = (const bf16*)(ws + WS_W1T + layer * SZ_W1T) + (size_t)kv * 64 * 2048;
    const bf16* W2T = (const bf16*)(ws + WS_W2T + layer * SZ_W2T) + (size_t)kv * 64 * 64;
    const float* pe = KIN(12) + (size_t)(layer * 2 + kv) * 32 * 64;
    const int* pt = (const int*)KIN(7);
    const float* cache = KIN(2);
    LAS unsigned char* XS = F.lds;
    LAS unsigned char* WS1 = F.lds + 69632;
    size_t toff[8];
#pragma unroll
    for (int k = 0; k < 8; ++k) { const int q = tid + 512 * k, m = q >> 5; const int pos = 16 * m; const int phys = pt[bs * 16 + (pos >> 7)];
        toff[k] = ((size_t)(layer * 2560 + phys) * 128 + (pos & 127)) * 512 + kv * 128 + 4 * (q & 31); }
    const int wr_ = tid >> 3, wc_ = tid & 7;
    int gg[2], nn[2];
#pragma unroll
    for (int tl = 0; tl < 2; ++tl) { const int T = 2 * wave + tl; gg[tl] = T >> 3; nn[tl] = 16 * (T & 7) + rl; }
    f32x4 h[2][4];
#pragma unroll
    for (int tl = 0; tl < 2; ++tl)
#pragma unroll
        for (int i = 0; i < 4; ++i) h[tl][i] = (f32x4){0.f, 0.f, 0.f, 0.f};
    f32x4 xr[8]; v4u wr2[2];
#define CS_ISSUE(r_) do { _Pragma("unroll") for (int k = 0; k < 8; ++k) xr[k] = *(const f32x4*)(cache + toff[k] + (size_t)(r_) * 512); \
        _Pragma("unroll") for (int u = 0; u < 2; ++u) wr2[u] = *(const v4u*)(W1T + (size_t)wr_ * 2048 + ((r_) + 16 * u) * 64 + wc_ * 8); } while (0)
    CS_ISSUE(0);
#pragma unroll 1
    for (int r = 0; r < 16; ++r) {
        __syncthreads();
#pragma unroll
        for (int k = 0; k < 8; ++k) { const int q = tid + 512 * k, m = q >> 5, c = q & 31, d = 4 * (c & 15);
#pragma unroll
            for (int u = 0; u < 2; ++u) { const f32x4 v = xr[k] + *(const f32x4*)(pe + (r + 16 * u) * 64 + d);
                *(LAS v2u*)(XS + u * 34816 + m * 272 + c * 8) = pack4(v); } }
#pragma unroll
        for (int u = 0; u < 2; ++u) *(LAS v4u*)(WS1 + u * 9216 + wr_ * 144 + wc_ * 16) = wr2[u];
        __syncthreads();
        { const int rn = r + 1 < 16 ? r + 1 : 15; CS_ISSUE(rn); }
#pragma unroll
        for (int u = 0; u < 2; ++u)
#pragma unroll
            for (int ks = 0; ks < 2; ++ks) {
                bf16x8 xb[2];
#pragma unroll
                for (int tl = 0; tl < 2; ++tl) { int m = nn[tl] + u; m = m > 127 ? 127 : m; xb[tl] = ld_frag_l(XS + u * 34816 + m * 272 + gg[tl] * 128 + ks * 64 + quad * 16); }
#pragma unroll
                for (int ht = 0; ht < 4; ++ht) { const bf16x8 a = ld_frag_l(WS1 + u * 9216 + (16 * ht + rl) * 144 + ks * 64 + quad * 16);
                    h[0][ht] = mfma16(a, xb[0], h[0][ht]); h[1][ht] = mfma16(a, xb[1], h[1][ht]); }
            }
    }
#undef CS_ISSUE
#pragma unroll
    for (int tl = 0; tl < 2; ++tl) {
#pragma unroll
        for (int ht = 0; ht < 4; ++ht)
#pragma unroll
            for (int i = 0; i < 4; ++i) h[tl][ht][i] = gelu_tanh(h[tl][ht][i]);
        bf16x8 gb[2]; gb[0] = pack_frag(h[tl][0], h[tl][1]); gb[1] = pack_frag(h[tl][2], h[tl][3]);
        const int n = nn[tl], g = gg[tl];
        bf16* dst = (bf16*)(ws + WS_KCS) + ((((size_t)kv * 128 + bs) * 128 + n) * 2 + g) * 64;
        const bool zero = n == 127;
#pragma unroll
        for (int ot = 0; ot < 4; ++ot) {
            f32x4 o = (f32x4){0.f, 0.f, 0.f, 0.f};
#pragma unroll
            for (int s = 0; s < 2; ++s) {
                const bf16* wp = W2T + (16 * ot + rl) * 64 + 32 * s + 4 * quad;
                o = mfma16(mk_frag(*(const v2u*)wp, *(const v2u*)(wp + 16)), gb[s], o);
            }
            v2u w; w.x = zero ? 0u : pk2(o[0], o[1]); w.y = zero ? 0u : pk2(o[2], o[3]);
            *(v2u*)(dst + 16 * ot + 4 * quad) = w;
        }
    }
    __syncthreads();
}
DI void compress_job(Frame& F, int layer, int job) { if (job < 256) compress_sample_job(F, layer, job); else compress_job_t<false>(F, layer, job); }
#ifndef PH_GPT
#define PH_GPT (-1)
#endif
#if PH_GPT >= 0
#define GP_T(k) do { if (tid == 0) { volatile LAS unsigned long long* gp_ = (volatile LAS unsigned long long*)(F.lds + LDSCTL_OFF + 448); const unsigned long long now_ = __builtin_amdgcn_s_memrealtime(); \
    if ((k) == PH_GPT) gp_[0] += now_ - gp_[1]; gp_[1] = now_; } } while (0)
#else
#define GP_T(k) do { } while (0)
#endif
DI int kperm(int idx) { const int s = idx >> 5, r = idx & 31; return 32 * s + 8 * ((r >> 2) & 3) + 4 * (r >> 4) + (r & 3); }
DI float softplusf_(float x) { return x > 20.f ? x : __logf(1.f + __expf(x)); }
DI float ret_lg(int h) { return h == 0 ? -0.031748697f : h == 1 ? -0.015748357f : h == 2 ? -0.007843178f : -0.0039138994f; }

DI void gdn_prep_unit(Frame& F, int layer, int unit) {
    int lane = F.lane, wave = F.wave; asm volatile("" : "+v"(lane), "+s"(wave));
    const int tid = wave * 64 + lane;
    const int b = unit >> 9, h = (unit >> 7) & 3, c = unit & 127;
    const int row0 = b * TP + 64 * c, t0 = 64 * c;
    GP_T(0);
    unsigned char* ws = KWS();
    const bf16* Z = (const bf16*)(ws + WS_Z);
    const float* ZS = (const float*)(ws + WS_ZS);
    LAS float* Lq = (LAS float*)(F.lds); LAS float* Lk = (LAS float*)(F.lds + 33792); LAS float* Lv = (LAS float*)(F.lds + 67584);
    LAS float* LA = (LAS float*)(F.lds + 101376); LAS float* LQK = (LAS float*)(F.lds + 117760);
    LAS float* Lg = (LAS float*)(F.lds + 134144); LAS float* Lb = Lg + 64; LAS float* Le = Lg + 128;
    const float* cw = KIN(15) + (size_t)layer * 4 * 1536;
    {
        v4u xs[6][4];
#pragma unroll
        for (int it0 = 0; it0 < 6; ++it0) {
            const int it = tid + it0 * NTHREADS, i = it / 48, ch = it % 48, col = (ch >> 4) * 512 + h * 128 + (ch & 15) * 8;
#pragma unroll
            for (int j = 0; j < 4; ++j) { const bool ok = (t0 + i - 3 + j) >= 0; xs[it0][j] = *(const v4u*)(Z + (size_t)(ok ? row0 + i - 3 + j : row0) * LDZ + ZC_GQKV + col); }
        }
        asm volatile("" ::: "memory");
#pragma unroll
        for (int it0 = 0; it0 < 6; ++it0) {
            const int it = tid + it0 * NTHREADS, i = it / 48, ch = it % 48, part = ch >> 4, cc = ch & 15;
            const int col = part * 512 + h * 128 + cc * 8;
            f32x4 y0 = (f32x4){0.f, 0.f, 0.f, 0.f}, y1 = y0;
#pragma unroll
            for (int j = 0; j < 4; ++j) {
                const float zf = ((t0 + i - 3 + j) >= 0) ? 1.f : 0.f;
                f32x4 x0, x1; unpack8(xs[it0][j], x0, x1);
                y0 += x0 * (*(const f32x4*)(cw + j * 1536 + col) * zf); y1 += x1 * (*(const f32x4*)(cw + j * 1536 + col + 4) * zf);
            }
#pragma unroll
            for (int e = 0; e < 4; ++e) { y0[e] = siluf_(y0[e]); y1[e] = siluf_(y1[e]); }
            LAS float* dst = (part == 0 ? Lq : part == 1 ? Lk : Lv) + i * 132 + cc * 8;
            *(LAS f32x4*)dst = y0; *(LAS f32x4*)(dst + 4) = y1;
        }
    }
    __syncthreads();
    GP_T(1);
    {
        float va[16], vb[16], ps[16];
#pragma unroll
        for (int q = 0; q < 16; ++q) { LAS float* vp = ((q < 8) ? Lq : Lk) + (wave * 8 + (q & 7)) * 132 + lane * 2; va[q] = vp[0]; vb[q] = vp[1]; ps[q] = va[q] * va[q] + vb[q] * vb[q]; }
#pragma unroll
        for (int q = 0; q < 16; ++q) ps[q] += shx<1>(ps[q], lane);
#pragma unroll
        for (int q = 0; q < 16; ++q) ps[q] += shx<2>(ps[q], lane);
#pragma unroll
        for (int q = 0; q < 16; ++q) ps[q] += shx<4>(ps[q], lane);
#pragma unroll
        for (int q = 0; q < 16; ++q) ps[q] += shx<8>(ps[q], lane);
#pragma unroll
        for (int q = 0; q < 16; ++q) ps[q] += shx<16>(ps[q], lane);
#pragma unroll
        for (int q = 0; q < 16; ++q) ps[q] += shx<32>(ps[q], lane);
#pragma unroll
        for (int q = 0; q < 16; ++q) { LAS float* vp = ((q < 8) ? Lq : Lk) + (wave * 8 + (q & 7)) * 132 + lane * 2; const float sc = rsqrtf(ps[q] + EPS) * ((q < 8) ? 0.08838834764831845f : 1.f); vp[0] = va[q] * sc; vp[1] = vb[q] * sc; }
    }
    if (wave == 0) {
        const float ga = ZS[(size_t)(row0 + lane) * 32 + 24 + h], gbv = ZS[(size_t)(row0 + lane) * 32 + 28 + h];
        float g = -__expf(KIN(16)[layer * 4 + h]) * softplusf_(ga + KIN(17)[layer * 4 + h]);
#pragma unroll
        for (int o = 1; o < 64; o <<= 1) { const float t = __int_as_float(__builtin_amdgcn_ds_bpermute(((lane - o) & 63) << 2, __float_as_int(g))); if (lane >= o) g += t; }
        Lg[lane] = g; Lb[lane] = sigmoidf_(gbv); Le[lane] = __expf(g);
    }
    __syncthreads();
    GP_T(2);
    {
        const int it = wave >> 1, quad = lane >> 4, rl = lane & 15;
        f32x4 ckk[2], cqk[2];
#pragma unroll
        for (int jj = 0; jj < 2; ++jj) { ckk[jj] = (f32x4){0.f, 0.f, 0.f, 0.f}; cqk[jj] = ckk[jj]; }
#pragma unroll
        for (int s = 0; s < 4; ++s) {
            const LAS float* kp = Lk + (16 * it + rl) * 132 + 32 * s + 8 * quad; const LAS float* qp = Lq + (16 * it + rl) * 132 + 32 * s + 8 * quad;
            const f32x4 ka0 = *(const LAS f32x4*)kp, ka1 = *(const LAS f32x4*)(kp + 4), qa0 = *(const LAS f32x4*)qp, qa1 = *(const LAS f32x4*)(qp + 4);
            const bf16x8 kah = pack_frag(ka0, ka1), qah = pack_frag(qa0, qa1);
            f32x4 h0, h1; unpack8(__builtin_bit_cast(v4u, kah), h0, h1); const bf16x8 kal = pack_frag(ka0 - h0, ka1 - h1);
            unpack8(__builtin_bit_cast(v4u, qah), h0, h1); const bf16x8 qal = pack_frag(qa0 - h0, qa1 - h1);
#pragma unroll
            for (int jj = 0; jj < 2; ++jj) {
                const int jt = (wave & 1) * 2 + jj;
                if (jt <= it) {
                    const LAS float* bp = Lk + (16 * jt + rl) * 132 + 32 * s + 8 * quad;
                    const f32x4 kb0 = *(const LAS f32x4*)bp, kb1 = *(const LAS f32x4*)(bp + 4);
                    const bf16x8 kbh = pack_frag(kb0, kb1); unpack8(__builtin_bit_cast(v4u, kbh), h0, h1); const bf16x8 kbl = pack_frag(kb0 - h0, kb1 - h1);
                    ckk[jj] = mfma16(kah, kbh, ckk[jj]); ckk[jj] = mfma16(kah, kbl, ckk[jj]); ckk[jj] = mfma16(kal, kbh, ckk[jj]);
                    cqk[jj] = mfma16(qah, kbh, cqk[jj]); cqk[jj] = mfma16(qah, kbl, cqk[jj]); cqk[jj] = mfma16(qal, kbh, cqk[jj]);
                }
            }
        }
#pragma unroll
        for (int jj = 0; jj < 2; ++jj) {
            const int j = 16 * ((wave & 1) * 2 + jj) + rl; const float gj = Lg[j];
#pragma unroll
            for (int e = 0; e < 4; ++e) { const int i = 16 * it + 4 * quad + e; const float dec = (i >= j) ? __expf(Lg[i] - gj) : 0.f;
                LA[i * 64 + j] = (i > j) ? Lb[i] * ckk[jj][e] * dec : 0.f; LQK[i * 64 + j] = cqk[jj][e] * dec; }
        }
    }
    __syncthreads();
    GP_T(3);
    unsigned char* rec = ws + WS_GREC + (size_t)unit * GREC;
    LAS float* TI = (LAS float*)(F.lds + 135168);
    if (tid < 64) {
        const int B = tid >> 4, c = tid & 15;
        float tc[16];
#pragma unroll
        for (int i = 0; i < 16; ++i) {
            float s0 = (i == c) ? 1.f : 0.f;
#pragma unroll
            for (int j = 0; j < i; ++j) s0 -= LA[(16 * B + i) * 64 + 16 * B + j] * tc[j];
            tc[i] = s0;
        }
#pragma unroll
        for (int i = 0; i < 16; ++i) TI[B * 256 + i * 16 + c] = tc[i];
    }
    {
        const float gl = Lg[63];
        for (int it = tid; it < 2560; it += NTHREADS) {
            if (it < 1024) {
                const int i = it >> 4, s = (it >> 2) & 3, quad = it & 3; const float e = Le[i];
                const f32x4 a = *(const LAS f32x4*)(Lq + i * 132 + 32 * s + 4 * quad) * e, bq = *(const LAS f32x4*)(Lq + i * 132 + 32 * s + 16 + 4 * quad) * e;
                *(v4u*)(rec + 16384 + i * 256 + (32 * s + 8 * quad) * 2) = pack8(a, bq);
            } else if (it < 2048) {
                const int r = it - 1024, dk = r >> 3, s2 = (r >> 2) & 1, quad = r & 3;
                f32x4 a, bq;
#pragma unroll
                for (int e = 0; e < 4; ++e) { const int ta = 32 * s2 + 4 * quad + e, tb = ta + 16; a[e] = Lk[ta * 132 + dk] * __expf(gl - Lg[ta]); bq[e] = Lk[tb * 132 + dk] * __expf(gl - Lg[tb]); }
                *(v4u*)(rec + 32768 + dk * 128 + (32 * s2 + 8 * quad) * 2) = pack8(a, bq);
            } else {
                const int r = it - 2048, i = r >> 3, s2 = (r >> 2) & 1, quad = r & 3;
                const f32x4 a = *(const LAS f32x4*)(LQK + i * 64 + 32 * s2 + 4 * quad), bq = *(const LAS f32x4*)(LQK + i * 64 + 32 * s2 + 16 + 4 * quad);
                *(v4u*)(rec + 65536 + i * 128 + (32 * s2 + 8 * quad) * 2) = pack8(a, bq);
            }
        }
        if (tid == 0) *(float*)(rec + 73728) = __expf(gl);
    }
    __syncthreads();
    GP_T(4);
    {
        const int col = tid & 255, hb = tid >> 8;
        LAS float* X = (col < 128) ? (Lv + col) : (Lk + (col - 128));
        const bool isw = col >= 128;
#pragma unroll 1
        for (int B = 0; B < 4; ++B) {
            float xb[8];
#pragma unroll
            for (int i = 0; i < 8; ++i) { const int r = 16 * B + 8 * hb + i; xb[i] = (isw ? Lb[r] * Le[r] : Lb[r]) * X[r * 132]; }
#pragma unroll 2
            for (int j4 = 0; j4 < 4 * B; ++j4) {
                const float x0 = X[(4 * j4) * 132], x1 = X[(4 * j4 + 1) * 132], x2 = X[(4 * j4 + 2) * 132], x3 = X[(4 * j4 + 3) * 132];
#pragma unroll
                for (int i = 0; i < 8; ++i) { const f32x4 a = *(const LAS f32x4*)(LA + (16 * B + 8 * hb + i) * 64 + 4 * j4); xb[i] -= (a[0] * x0 + a[1] * x1) + (a[2] * x2 + a[3] * x3); }
            }
#pragma unroll
            for (int i = 0; i < 8; ++i) X[(16 * B + 8 * hb + i) * 132] = xb[i];
            __syncthreads();
            float r[16];
#pragma unroll
            for (int jj = 0; jj < 16; ++jj) r[jj] = X[(16 * B + jj) * 132];
            __syncthreads();
#pragma unroll
            for (int i = 0; i < 8; ++i) {
                float s0 = 0.f, s1 = 0.f;
#pragma unroll
                for (int j4 = 0; j4 < 4; ++j4) { const f32x4 a = *(const LAS f32x4*)(TI + B * 256 + (8 * hb + i) * 16 + 4 * j4);
                    s0 += a[0] * r[4 * j4] + a[2] * r[4 * j4 + 2]; s1 += a[1] * r[4 * j4 + 1] + a[3] * r[4 * j4 + 3]; }
                X[(16 * B + 8 * hb + i) * 132] = s0 + s1;
            }
            __syncthreads();
        }
    }
    __syncthreads();
    GP_T(5);
    for (int it = tid; it < 2048; it += NTHREADS) {
        if (it < 1024) {
            const int dv = it >> 3, q = it & 7;
            v4u w; w.x = pk2(Lv[(8 * q) * 132 + dv], Lv[(8 * q + 1) * 132 + dv]); w.y = pk2(Lv[(8 * q + 2) * 132 + dv], Lv[(8 * q + 3) * 132 + dv]);
            w.z = pk2(Lv[(8 * q + 4) * 132 + dv], Lv[(8 * q + 5) * 132 + dv]); w.w = pk2(Lv[(8 * q + 6) * 132 + dv], Lv[(8 * q + 7) * 132 + dv]);
            *(v4u*)(rec + 49152 + dv * 128 + q * 16) = w;
        } else {
            const int r = it - 1024, i = r >> 4, s = (r >> 2) & 3, quad = r & 3;
            const f32x4 a = *(const LAS f32x4*)(Lk + i * 132 + 32 * s + 4 * quad), bq = *(const LAS f32x4*)(Lk + i * 132 + 32 * s + 16 + 4 * quad);
            *(v4u*)(rec + i * 256 + (32 * s + 8 * quad) * 2) = pack8(a, bq);
        }
    }
    __syncthreads();
    GP_T(6);
}

DI void ret_prep_unit(Frame& F, int layer, int unit) {
    int lane = F.lane, wave = F.wave; asm volatile("" : "+v"(lane), "+s"(wave));
    const int tid = wave * 64 + lane, quad = lane >> 4, rl = lane & 15;
    const int b = unit >> 8, h = (unit >> 6) & 3, c = unit & 63;
    const int row0 = b * TP + 128 * c;
    unsigned char* ws = KWS();
    const bf16* Z = (const bf16*)(ws + WS_Z);
    const f32x2* ROT = (const f32x2*)(ws + WS_ROT);
    bf16* QR = (bf16*)(ws + WS_QR); bf16* KR = (bf16*)(ws + WS_KR);
    LAS unsigned char* LK = F.lds; LAS unsigned char* LV = F.lds + 34816;
    const float lg = ret_lg(h);
    for (int it = tid; it < 1024; it += NTHREADS) {
        const int j = it >> 3, cc = it & 7, d0 = cc * 8;
        const size_t zr = (size_t)(row0 + j) * LDZ + ZC_RQKV + h * 128 + d0;
        f32x4 q1a, q1b, q2a, q2b, k1a, k1b, k2a, k2b;
        unpack8(*(const v4u*)(Z + zr), q1a, q1b); unpack8(*(const v4u*)(Z + zr + 64), q2a, q2b);
        unpack8(*(const v4u*)(Z + zr + 512), k1a, k1b); unpack8(*(const v4u*)(Z + zr + 512 + 64), k2a, k2b);
        const f32x2* rp = ROT + (size_t)(128 * c + j) * 64 + d0;
        const float kd = __expf((float)(127 - j) * lg);
        f32x4 oq1a, oq1b, oq2a, oq2b, ok1a, ok1b, ok2a, ok2b;
#pragma unroll
        for (int e = 0; e < 8; ++e) {
            const f32x2 cs = rp[e];
            const float q1 = e < 4 ? q1a[e & 3] : q1b[e & 3], q2 = e < 4 ? q2a[e & 3] : q2b[e & 3], k1 = e < 4 ? k1a[e & 3] : k1b[e & 3], k2 = e < 4 ? k2a[e & 3] : k2b[e & 3];
            const float rq1 = q1 * cs.x - q2 * cs.y, rq2 = q2 * cs.x + q1 * cs.y, rk1 = (k1 * cs.x - k2 * cs.y) * 0.08838834764831845f, rk2 = (k2 * cs.x + k1 * cs.y) * 0.08838834764831845f;
            if (e < 4) { oq1a[e & 3] = rq1; oq2a[e & 3] = rq2; ok1a[e & 3] = rk1; ok2a[e & 3] = rk2; } else { oq1b[e & 3] = rq1; oq2b[e & 3] = rq2; ok1b[e & 3] = rk1; ok2b[e & 3] = rk2; }
            *(LAS bf16*)(LK + (d0 + e) * 272 + j * 2) = (bf16)f2bf(rk1 * kd); *(LAS bf16*)(LK + (d0 + 64 + e) * 272 + j * 2) = (bf16)f2bf(rk2 * kd);
        }
        const size_t orow = (size_t)(row0 + j) * 512 + h * 128 + d0;
        *(v4u*)(QR + orow) = pack8(oq1a, oq1b); *(v4u*)(QR + orow + 64) = pack8(oq2a, oq2b);
        *(v4u*)(KR + orow) = pack8(ok1a, ok1b); *(v4u*)(KR + orow + 64) = pack8(ok2a, ok2b);
    }
    for (int it = tid; it < 2048; it += NTHREADS) {
        const int j = it >> 4, cc = it & 15;
        const v4u w = *(const v4u*)(Z + (size_t)(row0 + j) * LDZ + ZC_RQKV + 1024 + h * 128 + cc * 8);
        LAS unsigned char* d = LV + (cc * 8) * 272 + j * 2;
        *(LAS bf16*)(d) = (bf16)(w.x & 0xffff); *(LAS bf16*)(d + 272) = (bf16)(w.x >> 16); *(LAS bf16*)(d + 2 * 272) = (bf16)(w.y & 0xffff); *(LAS bf16*)(d + 3 * 272) = (bf16)(w.y >> 16);
        *(LAS bf16*)(d + 4 * 272) = (bf16)(w.z & 0xffff); *(LAS bf16*)(d + 5 * 272) = (bf16)(w.z >> 16); *(LAS bf16*)(d + 6 * 272) = (bf16)(w.w & 0xffff); *(LAS bf16*)(d + 7 * 272) = (bf16)(w.w >> 16);
    }
    __syncthreads();
    float* RKV = (float*)(ws + WS_RKV) + (size_t)unit * 16384;
#pragma unroll
    for (int nt = 0; nt < 8; ++nt) {
        f32x4 acc = (f32x4){0.f, 0.f, 0.f, 0.f};
#pragma unroll
        for (int s = 0; s < 4; ++s) acc = mfma16(ld_frag_l(LK + (16 * wave + rl) * 272 + (32 * s + 8 * quad) * 2), ld_frag_l(LV + (16 * nt + rl) * 272 + (32 * s + 8 * quad) * 2), acc);
#pragma unroll
        for (int i = 0; i < 4; ++i) RKV[(size_t)(16 * wave + 4 * quad + i) * 128 + 16 * nt + rl] = acc[i];
    }
    __syncthreads();
}
DI void sample_rec_unit(Frame& F, int layer, int unit) {
    int lane = F.lane, wave = F.wave; asm volatile("" : "+v"(lane), "+s"(wave));
    const int tid = wave * 64 + lane;
    const int kind = unit >> 9, s = (unit >> 2) & 127, h = unit & 3;
    const int dv = tid & 127, part = tid >> 7, r0 = MP + 4 * s;
    unsigned char* ws = KWS();
    const bf16* Z = (const bf16*)(ws + WS_Z);
    const float* ZS = (const float*)(ws + WS_ZS);
    LAS float* Lq = (LAS float*)(F.lds); LAS float* Lk = Lq + 512; LAS float* Lv = Lq + 1024; LAS float* red = Lq + 1536; LAS float* Lo = Lq + 2048; LAS float* sc = Lq + 2560;
    float S[32];
    if (kind == 0) {
        if (tid < 384) {
            const int pr = tid >> 7, d = tid & 127, col = pr * 512 + h * 128 + d;
            float xp[7], w[4];
#pragma unroll
            for (int i = 0; i < 3; ++i) xp[i] = KIN(4)[((size_t)(layer * 128 + s) * 3 + i) * 1536 + col];
#pragma unroll
            for (int j = 0; j < 4; ++j) xp[3 + j] = bf2f(Z[(size_t)(r0 + j) * LDZ + ZC_GQKV + col]);
#pragma unroll
            for (int i = 0; i < 4; ++i) w[i] = KIN(15)[(size_t)(layer * 4 + i) * 1536 + col];
            LAS float* dst = pr == 0 ? Lq : pr == 1 ? Lk : Lv;
#pragma unroll
            for (int j = 0; j < 4; ++j) dst[j * 128 + d] = siluf_(w[0] * xp[j] + w[1] * xp[j + 1] + w[2] * xp[j + 2] + w[3] * xp[j + 3]);
        }
        __syncthreads();
        {
            LAS float* vp = (wave < 4 ? Lq : Lk) + (wave & 3) * 128;
            const float a = vp[2 * lane], b = vp[2 * lane + 1];
            const float scl = rsqrtf(wave_sum(a * a + b * b, lane) + EPS) * (wave < 4 ? 0.08838834764831845f : 1.f);
            vp[2 * lane] = a * scl; vp[2 * lane + 1] = b * scl;
        }
        if (tid < 4) {
            const float ga = ZS[(size_t)(r0 + tid) * 32 + 24 + h], gb = ZS[(size_t)(r0 + tid) * 32 + 28 + h];
            sc[tid] = __expf(-__expf(KIN(16)[layer * 4 + h]) * softplusf_(ga + KIN(17)[layer * 4 + h])); sc[4 + tid] = sigmoidf_(gb);
        }
        __syncthreads();
        const float* Sin = KIN(5) + ((size_t)((layer * 128 + s) * 4 + h) * 128 + 32 * part) * 128 + dv;
#pragma unroll
        for (int i = 0; i < 32; ++i) S[i] = Sin[(size_t)i * 128];
#pragma unroll
        for (int j = 0; j < 4; ++j) {
            const float a = sc[j], beta = sc[4 + j];
            float p = 0.f;
#pragma unroll
            for (int i = 0; i < 32; ++i) { S[i] *= a; p += Lk[j * 128 + 32 * part + i] * S[i]; }
            red[part * 128 + dv] = p;
            __syncthreads();
            const float delta = beta * (Lv[j * 128 + dv] - ((red[dv] + red[128 + dv]) + (red[256 + dv] + red[384 + dv])));
            __syncthreads();
            float o = 0.f;
#pragma unroll
            for (int i = 0; i < 32; ++i) { S[i] += Lk[j * 128 + 32 * part + i] * delta; o += Lq[j * 128 + 32 * part + i] * S[i]; }
            red[part * 128 + dv] = o;
            __syncthreads();
            if (part == 0) Lo[j * 128 + dv] = (red[dv] + red[128 + dv]) + (red[256 + dv] + red[384 + dv]);
            __syncthreads();
        }
        float* Sout = KOUT() + O_GSS + ((size_t)((layer * 128 + s) * 4 + h) * 128 + 32 * part) * 128 + dv;
#pragma unroll
        for (int i = 0; i < 32; ++i) Sout[(size_t)i * 128] = S[i];
        ((float*)(ws + WS_OGDN))[(size_t)(r0 + part) * 512 + h * 128 + dv] = Lo[part * 128 + dv];
    } else {
        const f32x2* ROT = (const f32x2*)(ws + WS_ROT);
        if (tid < 384) {
            const int pr = tid >> 7, d = tid & 127;
#pragma unroll
            for (int j = 0; j < 4; ++j) {
                const bf16* zp = Z + (size_t)(r0 + j) * LDZ + ZC_RQKV + pr * 512 + h * 128;
                float v = bf2f(zp[d]);
                if (pr < 2) { const f32x2 cs = ROT[(size_t)(2048 + j) * 64 + (d & 63)]; const float o = bf2f(zp[d ^ 64]);
                    v = (d < 64) ? v * cs.x - o * cs.y : v * cs.x + o * cs.y; if (pr == 1) v *= 0.08838834764831845f; }
                (pr == 0 ? Lq : pr == 1 ? Lk : Lv)[j * 128 + d] = v;
            }
        }
        __syncthreads();
        const float gam = __expf(ret_lg(h));
        const float* Sin = KIN(6) + ((size_t)((layer * 128 + s) * 4 + h) * 128 + 32 * part) * 128 + dv;
#pragma unroll
        for (int i = 0; i < 32; ++i) S[i] = Sin[(size_t)i * 128];
#pragma unroll
        for (int j = 0; j < 4; ++j) {
            const float vv = Lv[j * 128 + dv];
            float o = 0.f;
#pragma unroll
            for (int i = 0; i < 32; ++i) { S[i] = S[i] * gam + Lk[j * 128 + 32 * part + i] * vv; o += Lq[j * 128 + 32 * part + i] * S[i]; }
            red[part * 128 + dv] = o;
            __syncthreads();
            if (part == 0) Lo[j * 128 + dv] = (red[dv] + red[128 + dv]) + (red[256 + dv] + red[384 + dv]);
            __syncthreads();
        }
        float* Sout = KOUT() + O_RSS + ((size_t)((layer * 128 + s) * 4 + h) * 128 + 32 * part) * 128 + dv;
#pragma unroll
        for (int i = 0; i < 32; ++i) Sout[(size_t)i * 128] = S[i];
        if (wave < 4) {
            const int j = wave; const float a = Lo[j * 128 + 2 * lane], b = Lo[j * 128 + 2 * lane + 1];
            const float scl = rsqrtf(wave_sum(a * a + b * b, lane) * (1.f / 128.f) + EPS);
            const bf16* gp = Z + (size_t)(r0 + j) * LDZ + ZC_RG + h * 128 + 2 * lane;
            *(unsigned*)((bf16*)(ws + WS_MIX) + (size_t)(r0 + j) * 1536 + 1024 + h * 128 + 2 * lane) = pk2(a * scl * siluf_(bf2f(gp[0])), b * scl * siluf_(bf2f(gp[1])));
        }
    }
    __syncthreads();
}

DI void gdn_scan_chain(Frame& F, int layer, int bh) {
    int lane = F.lane, wave = F.wave; asm volatile("" : "+v"(lane), "+s"(wave));
    const int tid = wave * 64 + lane, quad = lane >> 4, rl = lane & 15;
    unsigned char* ws = KWS();
    const unsigned char* recb = ws + WS_GREC + (size_t)bh * 128 * GREC;
    LAS unsigned char* L = F.lds;
    constexpr int L_WP = 0, L_QP = 17408, L_KT = 34816, L_UT = 53248, L_QK = 71680;
    f32x4 S[8];
#pragma unroll
    for (int i = 0; i < 8; ++i) S[i] = (f32x4){0.f, 0.f, 0.f, 0.f};
    v4u pf[9]; float egl;
#pragma unroll
    for (int k = 0; k < 9; ++k) pf[k] = *(const v4u*)(recb + (size_t)(tid + 512 * k) * 16);
    egl = *(const float*)(recb + 73728);
    float* OG = (float*)(ws + WS_OGDN);
    const int b = bh >> 2, h = bh & 3;
    for (int c = 0; c < 128; ++c) {
        __syncthreads();
#pragma unroll
        for (int k = 0; k < 9; ++k) {
            const int o = tid * 16 + (k & 1) * 8192;
            const int reg = k >> 1;
            int dst;
            if (reg < 2) dst = (reg == 0 ? L_WP : L_QP) + (o >> 8) * 272 + (o & 255);
            else dst = (reg == 2 ? L_KT : reg == 3 ? L_UT : L_QK) + (o >> 7) * 144 + (o & 127);
            *(LAS v4u*)(L + dst) = pf[k];
        }
        const float eg = egl;
        __syncthreads();
        {
            const unsigned char* rn = recb + (size_t)(c + 1 < 128 ? c + 1 : 127) * GREC;
#pragma unroll
            for (int k = 0; k < 9; ++k) pf[k] = *(const v4u*)(rn + (size_t)(tid + 512 * k) * 16);
            egl = *(const float*)(rn + 73728);
        }
        bf16x8 Sb[4];
#pragma unroll
        for (int s = 0; s < 4; ++s) Sb[s] = pack_frag(S[2 * s], S[2 * s + 1]);
        f32x4 vn[4], O[4];
#pragma unroll
        for (int rt = 0; rt < 4; ++rt) {
            f32x4 wsacc = (f32x4){0.f, 0.f, 0.f, 0.f}, o = wsacc;
#pragma unroll
            for (int s = 0; s < 4; ++s) {
                wsacc = mfma16(ld_frag_l(L + L_WP + (16 * rt + rl) * 272 + (32 * s + 8 * quad) * 2), Sb[s], wsacc);
                o = mfma16(ld_frag_l(L + L_QP + (16 * rt + rl) * 272 + (32 * s + 8 * quad) * 2), Sb[s], o);
            }
            const v2u uw = *(const LAS v2u*)(L + L_UT + (16 * wave + rl) * 144 + (16 * rt + 4 * quad) * 2);
            vn[rt][0] = lo_bf(uw.x) - wsacc[0]; vn[rt][1] = hi_bf(uw.x) - wsacc[1]; vn[rt][2] = lo_bf(uw.y) - wsacc[2]; vn[rt][3] = hi_bf(uw.y) - wsacc[3];
            O[rt] = o;
        }
        bf16x8 Vb[2]; Vb[0] = pack_frag(vn[0], vn[1]); Vb[1] = pack_frag(vn[2], vn[3]);
#pragma unroll
        for (int rt = 0; rt < 4; ++rt) {
#pragma unroll
            for (int s2 = 0; s2 < 2; ++s2) O[rt] = mfma16(ld_frag_l(L + L_QK + (16 * rt + rl) * 144 + (32 * s2 + 8 * quad) * 2), Vb[s2], O[rt]);
            const size_t row = (size_t)b * TP + 64 * c + 16 * rt + 4 * quad;
#pragma unroll
            for (int i = 0; i < 4; ++i) OG[(row + i) * 512 + h * 128 + 16 * wave + rl] = O[rt][i];
        }
#pragma unroll
        for (int kt = 0; kt < 8; ++kt) {
            f32x4 a = S[kt] * eg;
#pragma unroll
            for (int s2 = 0; s2 < 2; ++s2) a = mfma16(ld_frag_l(L + L_KT + (16 * kt + rl) * 144 + (32 * s2 + 8 * quad) * 2), Vb[s2], a);
            S[kt] = a;
        }
    }
    float* So = KOUT() + O_GSP + (size_t)(layer * 8 + bh) * 16384;
#pragma unroll
    for (int kt = 0; kt < 8; ++kt)
#pragma unroll
        for (int i = 0; i < 4; ++i) So[(size_t)(16 * kt + 4 * quad + i) * 128 + 16 * wave + rl] = S[kt][i];
    __syncthreads();
}
DI void ret_scan_part(Frame& F, int layer, int r) {
    int tid = F.tid; asm volatile("" : "+v"(tid));
    const int bh = r >> 2, dv = tid & 127, dk0 = ((r & 3) * 4 + (tid >> 7)) * 8, h = bh & 3;
    unsigned char* ws = KWS();
    const float* RKV = (const float*)(ws + WS_RKV) + (size_t)bh * 64 * 16384;
    bf16* RST = (bf16*)(ws + WS_RST) + (size_t)bh * 64 * 16384;
    const float cdec = __expf(128.f * ret_lg(h));
    float S[8];
#pragma unroll
    for (int i = 0; i < 8; ++i) S[i] = 0.f;
#pragma unroll 4
    for (int c = 0; c < 64; ++c) {
        v4u w; w.x = pk2(S[0], S[1]); w.y = pk2(S[2], S[3]); w.z = pk2(S[4], S[5]); w.w = pk2(S[6], S[7]);
        *(v4u*)(RST + (size_t)c * 16384 + dv * 128 + dk0) = w;
#pragma unroll
        for (int i = 0; i < 8; ++i) S[i] = S[i] * cdec + RKV[(size_t)c * 16384 + (dk0 + i) * 128 + dv];
    }
    float* So = KOUT() + O_RSP + (size_t)(layer * 8 + bh) * 16384;
#pragma unroll
    for (int i = 0; i < 8; ++i) So[(size_t)(dk0 + i) * 128 + dv] = S[i];
}
constexpr float SM_C = 0.125f * 1.4426950408889634f;
struct AttnState { float m, l; f32x4 O[4]; };
DI void attn_reset(AttnState& st) { st.m = -1e30f; st.l = 0.f;
#pragma unroll
    for (int i = 0; i < 4; ++i) st.O[i] = (f32x4){0.f, 0.f, 0.f, 0.f}; }
DI void qk_tile(const LAS unsigned char* Kt, const bf16x8 (&qf)[2], f32x4 (&s)[4], int rl, int quad) {
    bf16x8 kf[4][2];
#pragma unroll
    for (int kt = 0; kt < 4; ++kt)
#pragma unroll
        for (int kk = 0; kk < 2; ++kk) kf[kt][kk] = ld_frag_l(Kt + (16 * kt + rl) * 144 + kk * 64 + quad * 16);
    __builtin_amdgcn_s_setprio(1);
#pragma unroll
    for (int kt = 0; kt < 4; ++kt) s[kt] = mfma16(kf[kt][0], qf[0], (f32x4){0.f, 0.f, 0.f, 0.f});
#pragma unroll
    for (int kt = 0; kt < 4; ++kt) s[kt] = mfma16(kf[kt][1], qf[1], s[kt]);
    __builtin_amdgcn_s_setprio(0);
}
template <class Mask> DI void attn_step(const LAS unsigned char* Kt, const LAS unsigned char* VT, const bf16x8 (&qf)[2], AttnState& st, const Mask& ok, int rl, int quad) {
    f32x4 s[4]; qk_tile(Kt, qf, s, rl, quad);
    float mx = -3e38f;
#pragma unroll
    for (int kt = 0; kt < 4; ++kt)
#pragma unroll
        for (int i = 0; i < 4; ++i) if (ok(16 * kt + 4 * quad + i)) mx = fmaxf(mx, s[kt][i]);
    const int lane = rl + 16 * quad;
    mx = fmaxf(mx, shx<16>(mx, lane)); mx = fmaxf(mx, shx<32>(mx, lane));
    const float mn = fmaxf(st.m, mx);
    const float alpha = exp2f((st.m - mn) * SM_C);
    float ls = 0.f;
#pragma unroll
    for (int kt = 0; kt < 4; ++kt)
#pragma unroll
        for (int i = 0; i < 4; ++i) { const float p = ok(16 * kt + 4 * quad + i) ? exp2f((s[kt][i] - mn) * SM_C) : 0.f; s[kt][i] = p; ls += p; }
    ls += shx<16>(ls, lane); ls += shx<32>(ls, lane);
    st.l = st.l * alpha + ls; st.m = mn;
#pragma unroll
    for (int dt = 0; dt < 4; ++dt) st.O[dt] *= alpha;
#pragma unroll
    for (int ii = 0; ii < 2; ++ii) {
        const bf16x8 pb = pack_frag(s[2 * ii], s[2 * ii + 1]);
#pragma unroll
        for (int dt = 0; dt < 4; ++dt) {
            const LAS unsigned char* vp = VT + (16 * dt + rl) * 144 + (32 * ii + 4 * quad) * 2;
            st.O[dt] = mfma16(mk_frag(*(const LAS v2u*)vp, *(const LAS v2u*)(vp + 32)), pb, st.O[dt]);
        }
    }
}
DI void attn_accum(f32x4 (&Of)[4], const AttnState& st, float gate) {
    const float sc = st.l > 0.f ? gate / st.l : 0.f;
#pragma unroll
    for (int dt = 0; dt < 4; ++dt) Of[dt] += st.O[dt] * sc;
}
DI void vt_write(LAS unsigned char* VT, int d0, int key, const v4u w) {
    LAS unsigned char* d = VT + d0 * 144 + key * 2;
    *(LAS bf16*)(d) = (bf16)(w.x & 0xffff); *(LAS bf16*)(d + 144) = (bf16)(w.x >> 16); *(LAS bf16*)(d + 2 * 144) = (bf16)(w.y & 0xffff); *(LAS bf16*)(d + 3 * 144) = (bf16)(w.y >> 16);
    *(LAS bf16*)(d + 4 * 144) = (bf16)(w.z & 0xffff); *(LAS bf16*)(d + 5 * 144) = (bf16)(w.z >> 16); *(LAS bf16*)(d + 6 * 144) = (bf16)(w.w & 0xffff); *(LAS bf16*)(d + 7 * 144) = (bf16)(w.w >> 16);
}
DI void stage_wg(LAS unsigned char* Kt, LAS unsigned char* VT, const bf16* kb, const bf16* vb, size_t stride, int tid, bool do_v) {
    const int key = tid >> 3, ch = tid & 7;
    *(LAS v4u*)(Kt + key * 144 + ch * 16) = *(const v4u*)(kb + key * stride + ch * 8);
    if (do_v) vt_write(VT, ch * 8, key, *(const v4u*)(vb + key * stride + ch * 8));
}
DI unsigned score_key(float s, bool valid, int idx) { return valid ? (((__float_as_uint(s) | 0x80000000u) & ~127u) | (unsigned)(127 - idx)) : 0u; }
DI int key_rank(const LAS unsigned* K, int ng4, unsigned k) {
    int r = 0;
#pragma unroll 4
    for (int g = 0; g < ng4; ++g) { const v4u v = *(const LAS v4u*)(K + 4 * g); r += (v.x > k) + (v.y > k) + (v.z > k) + (v.w > k); }
    return r;
}
DI void key_rank2(const LAS unsigned* K, int ng4, unsigned k0, unsigned k1, int& r0, int& r1) {
    int a0 = 0, a1 = 0, b0 = 0, b1 = 0;
    const int ng8 = (ng4 + 1) >> 1;
#pragma unroll 4
    for (int g = 0; g < ng8; ++g) { const v4u v = *(const LAS v4u*)(K + 8 * g), w = *(const LAS v4u*)(K + 8 * g + 4);
        a0 += (v.x > k0) + (v.y > k0) + (v.z > k0) + (v.w > k0); b0 += (w.x > k0) + (w.y > k0) + (w.z > k0) + (w.w > k0);
        a1 += (v.x > k1) + (v.y > k1) + (v.z > k1) + (v.w > k1); b1 += (w.x > k1) + (w.y > k1) + (w.z > k1) + (w.w > k1); }
    r0 = a0 + b0; r1 = a1 + b1;
}
DI int top16(float v0, float v1, int lane) {
    int sel = 0;
#pragma unroll 1
    for (int r = 0; r < 16; ++r) {
        float bv; int bi;
        if (v0 >= v1) { bv = v0; bi = lane; } else { bv = v1; bi = lane + 64; }
#define T16_STEP(M) { const float ov = shx<M>(bv, lane); const int oi = shxi<M>(bi, lane); const bool take = (ov > bv) || (ov == bv && oi < bi); bv = take ? ov : bv; bi = take ? oi : bi; }
        T16_STEP(32) T16_STEP(16) T16_STEP(8) T16_STEP(4) T16_STEP(2) T16_STEP(1)
#undef T16_STEP
        const bool h0 = (bi == lane), h1 = (bi == lane + 64);
        v0 = h0 ? -3e38f : v0; v1 = h1 ? -3e38f : v1; sel |= (h0 ? 1 : 0) | (h1 ? 2 : 0);
    }
    return sel;
}

typedef short v4i16_t __attribute__((ext_vector_type(4)));
DI s16x4 vtr(const LAS unsigned char* p) { return __builtin_bit_cast(s16x4, __builtin_amdgcn_ds_read_tr16_b64_v4i16((LAS v4i16_t*)p)); }
DI bf16x8 cat4(s16x4 a, s16x4 b) { bf16x8 r; r[0] = a[0]; r[1] = a[1]; r[2] = a[2]; r[3] = a[3]; r[4] = b[0]; r[5] = b[1]; r[6] = b[2]; r[7] = b[3]; return r; }
DI void attn_step3(const LAS unsigned char* Kt, const LAS unsigned char* Vt, const bf16x8 (&qf)[2], AttnState& st, int lo, int hi, bool active, int rl, int quad) {
    active = active && (hi >= lo);
    if (!__any(active)) return;
    f32x4 s[4]; qk_tile(Kt, qf, s, rl, quad);
    const int lane = rl + 16 * quad;
    const bool full = __all((lo <= 0 && hi >= 63) || !active);
    const int kq = 4 * quad - lo; const unsigned rng = (unsigned)(hi - lo);
    float lm;
    if (full) {
        const float a0 = fmaxf(fmaxf(s[0][0], s[0][1]), fmaxf(s[0][2], s[0][3])), a1 = fmaxf(fmaxf(s[1][0], s[1][1]), fmaxf(s[1][2], s[1][3]));
        const float a2 = fmaxf(fmaxf(s[2][0], s[2][1]), fmaxf(s[2][2], s[2][3])), a3 = fmaxf(fmaxf(s[3][0], s[3][1]), fmaxf(s[3][2], s[3][3]));
        lm = fmaxf(fmaxf(a0, a1), fmaxf(a2, a3));
    } else {
        lm = -3e38f;
#pragma unroll
        for (int kt = 0; kt < 4; ++kt)
#pragma unroll
            for (int i = 0; i < 4; ++i) lm = ((unsigned)(kq + 16 * kt + i) <= rng) ? fmaxf(lm, s[kt][i]) : lm;
    }
    lm = active ? lm : -3e38f;
    if (__any(lm > st.m + 320.f)) {
        float mx = fmaxf(lm, shx<16>(lm, lane)); mx = fmaxf(mx, shx<32>(mx, lane));
        const float mn = fmaxf(st.m, mx);
        const float alpha = __builtin_amdgcn_exp2f((st.m - mn) * SM_C);
        st.l *= alpha; st.m = mn;
#pragma unroll
        for (int dt = 0; dt < 4; ++dt) st.O[dt] *= alpha;
    }
    const float mc = active ? st.m * SM_C : __builtin_inff();
    float ls = 0.f;
    if (full) {
#pragma unroll
        for (int kt = 0; kt < 4; ++kt)
#pragma unroll
            for (int i = 0; i < 4; ++i) { const float p = __builtin_amdgcn_exp2f(s[kt][i] * SM_C - mc); s[kt][i] = p; ls += p; }
    } else {
#pragma unroll
        for (int kt = 0; kt < 4; ++kt)
#pragma unroll
            for (int i = 0; i < 4; ++i) { const float p = ((unsigned)(kq + 16 * kt + i) <= rng) ? __builtin_amdgcn_exp2f(s[kt][i] * SM_C - mc) : 0.f; s[kt][i] = p; ls += p; }
    }
    st.l += ls;
#pragma unroll
    for (int ii = 0; ii < 2; ++ii) {
        const bf16x8 pb = pack_frag(s[2 * ii], s[2 * ii + 1]);
#pragma unroll
        for (int dt = 0; dt < 4; ++dt) {
            const LAS unsigned char* vp = Vt + (32 * ii + 4 * quad + (rl >> 2)) * 144 + (16 * dt + 4 * (rl & 3)) * 2;
            st.O[dt] = mfma16(cat4(vtr(vp), vtr(vp + 16 * 144)), pb, st.O[dt]);
        }
    }
}
DI float attn_rowsum(const AttnState& st, int lane) { float l = st.l; l += shx<16>(l, lane); l += shx<32>(l, lane); return l; }
DI void attn_accum3(f32x4 (&Of)[4], const AttnState& st, float gate, int lane) {
    const float l = attn_rowsum(st, lane);
    const float sc = l > 0.f ? gate / l : 0.f;
#pragma unroll
    for (int dt = 0; dt < 4; ++dt) Of[dt] += st.O[dt] * sc;
}
#ifndef PH_NPT
#define PH_NPT (-1)
#endif
#if PH_NPT >= 0
#define NP_T(k) do { if (tid == 0) { volatile LAS unsigned long long* np_ = (volatile LAS unsigned long long*)(F.lds + LDSCTL_OFF + 464); const unsigned long long now_ = __builtin_amdgcn_s_memrealtime(); \
    if ((k) == PH_NPT) np_[0] += now_ - np_[1]; np_[1] = now_; } } while (0)
#else
#define NP_T(k) do { } while (0)
#endif
#ifndef PH_NSAC
#define PH_NSAC 1
#endif
DI float tile_max(const f32x4 (&s)[4], bool full, int kq, unsigned rng) {
    float lm;
    if (full) {
        const float a0 = fmaxf(fmaxf(s[0][0], s[0][1]), fmaxf(s[0][2], s[0][3])), a1 = fmaxf(fmaxf(s[1][0], s[1][1]), fmaxf(s[1][2], s[1][3]));
        const float a2 = fmaxf(fmaxf(s[2][0], s[2][1]), fmaxf(s[2][2], s[2][3])), a3 = fmaxf(fmaxf(s[3][0], s[3][1]), fmaxf(s[3][2], s[3][3]));
        lm = fmaxf(fmaxf(a0, a1), fmaxf(a2, a3));
    } else {
        lm = -3e38f;
#pragma unroll
        for (int kt = 0; kt < 4; ++kt)
#pragma unroll
            for (int i = 0; i < 4; ++i) lm = ((unsigned)(kq + 16 * kt + i) <= rng) ? fmaxf(lm, s[kt][i]) : lm;
    }
    return lm;
}
DI float tile_exp(f32x4 (&s)[4], bool full, int kq, unsigned rng, float mc) {
    float ls = 0.f;
    if (full) {
#pragma unroll
        for (int kt = 0; kt < 4; ++kt)
#pragma unroll
            for (int i = 0; i < 4; ++i) { const float p = __builtin_amdgcn_exp2f(s[kt][i] * SM_C - mc); s[kt][i] = p; ls += p; }
    } else {
#pragma unroll
        for (int kt = 0; kt < 4; ++kt)
#pragma unroll
            for (int i = 0; i < 4; ++i) { const float p = ((unsigned)(kq + 16 * kt + i) <= rng) ? __builtin_amdgcn_exp2f(s[kt][i] * SM_C - mc) : 0.f; s[kt][i] = p; ls += p; }
    }
    return ls;
}
DI void tile_pv(const LAS unsigned char* Vt, const f32x4 (&s)[4], f32x4 (&O)[4], int rl, int quad) {
    bf16x8 vf[2][4];
#pragma unroll
    for (int ii = 0; ii < 2; ++ii)
#pragma unroll
        for (int dt = 0; dt < 4; ++dt) { const LAS unsigned char* vp = Vt + (32 * ii + 4 * quad + (rl >> 2)) * 144 + (16 * dt + 4 * (rl & 3)) * 2; vf[ii][dt] = cat4(vtr(vp), vtr(vp + 16 * 144)); }
    const bf16x8 pb0 = pack_frag(s[0], s[1]), pb1 = pack_frag(s[2], s[3]);
    __builtin_amdgcn_s_setprio(1);
#pragma unroll
    for (int dt = 0; dt < 4; ++dt) O[dt] = mfma16(vf[0][dt], pb0, O[dt]);
#pragma unroll
    for (int dt = 0; dt < 4; ++dt) O[dt] = mfma16(vf[1][dt], pb1, O[dt]);
    __builtin_amdgcn_s_setprio(0);
}
DI void tile_vload(const LAS unsigned char* Vt, bf16x8 (&vf)[2][4], int rl, int quad) {
#pragma unroll
    for (int ii = 0; ii < 2; ++ii)
#pragma unroll
        for (int dt = 0; dt < 4; ++dt) { const LAS unsigned char* vp = Vt + (32 * ii + 4 * quad + (rl >> 2)) * 144 + (16 * dt + 4 * (rl & 3)) * 2; vf[ii][dt] = cat4(vtr(vp), vtr(vp + 16 * 144)); }
}
DI void tile_pvmma(const bf16x8 (&vf)[2][4], const f32x4 (&s)[4], f32x4 (&O)[4]) {
    const bf16x8 pb0 = pack_frag(s[0], s[1]), pb1 = pack_frag(s[2], s[3]);
    __builtin_amdgcn_s_setprio(1);
#pragma unroll
    for (int dt = 0; dt < 4; ++dt) O[dt] = mfma16(vf[0][dt], pb0, O[dt]);
#pragma unroll
    for (int dt = 0; dt < 4; ++dt) O[dt] = mfma16(vf[1][dt], pb1, O[dt]);
    __builtin_amdgcn_s_setprio(0);
}
DI void attn_step_pair(const LAS unsigned char* K0, const LAS unsigned char* V0, int lo0, int hi0, bool act0,
                       const LAS unsigned char* K1, const LAS unsigned char* V1, int lo1, int hi1, bool act1,
                       const bf16x8 (&qf)[2], AttnState& st, int rl, int quad) {
    act0 = act0 && (hi0 >= lo0); act1 = act1 && (hi1 >= lo1);
    const bool any0 = __any(act0), any1 = __any(act1);
    if (!any0 && !any1) return;
    const int lane = rl + 16 * quad;
    f32x4 s0[4], s1[4];
    if (any0 && any1) {
        bf16x8 kf0[4][2], kf1[4][2];
#pragma unroll
        for (int kt = 0; kt < 4; ++kt)
#pragma unroll
            for (int kk = 0; kk < 2; ++kk) { kf0[kt][kk] = ld_frag_l(K0 + (16 * kt + rl) * 144 + kk * 64 + quad * 16); kf1[kt][kk] = ld_frag_l(K1 + (16 * kt + rl) * 144 + kk * 64 + quad * 16); }
        __builtin_amdgcn_s_setprio(1);
#pragma unroll
        for (int kt = 0; kt < 4; ++kt) s0[kt] = mfma16(kf0[kt][0], qf[0], (f32x4){0.f, 0.f, 0.f, 0.f});
#pragma unroll
        for (int kt = 0; kt < 4; ++kt) s1[kt] = mfma16(kf1[kt][0], qf[0], (f32x4){0.f, 0.f, 0.f, 0.f});
#pragma unroll
        for (int kt = 0; kt < 4; ++kt) s0[kt] = mfma16(kf0[kt][1], qf[1], s0[kt]);
#pragma unroll
        for (int kt = 0; kt < 4; ++kt) s1[kt] = mfma16(kf1[kt][1], qf[1], s1[kt]);
        __builtin_amdgcn_s_setprio(0);
    } else {
        if (any0) qk_tile(K0, qf, s0, rl, quad);
        if (any1) qk_tile(K1, qf, s1, rl, quad);
    }
    const bool full0 = __all((lo0 <= 0 && hi0 >= 63) || !act0), full1 = __all((lo1 <= 0 && hi1 >= 63) || !act1);
    const int kq0 = 4 * quad - lo0, kq1 = 4 * quad - lo1; const unsigned rng0 = (unsigned)(hi0 - lo0), rng1 = (unsigned)(hi1 - lo1);
    float mcb = st.m * SM_C;
    bf16x8 vf0[2][4], vf1[2][4];
    if (any0) tile_vload(V0, vf0, rl, quad);
    float ls = 0.f;
    if (any0) ls += tile_exp(s0, full0, kq0, rng0, act0 ? mcb : __builtin_inff());
    if (any1) ls += tile_exp(s1, full1, kq1, rng1, act1 ? mcb : __builtin_inff());
    if (__any(!(ls <= 1e30f))) {
        if (any0) qk_tile(K0, qf, s0, rl, quad);
        if (any1) qk_tile(K1, qf, s1, rl, quad);
        float lm = -3e38f;
        if (any0) { const float a = tile_max(s0, full0, kq0, rng0); lm = act0 ? a : lm; }
        if (any1) { const float a = tile_max(s1, full1, kq1, rng1); lm = act1 ? fmaxf(lm, a) : lm; }
        float mx = fmaxf(lm, shx<16>(lm, lane)); mx = fmaxf(mx, shx<32>(mx, lane));
        const float mn = fmaxf(st.m, mx);
        const float alpha = __builtin_amdgcn_exp2f((st.m - mn) * SM_C);
        st.l *= alpha; st.m = mn;
#pragma unroll
        for (int dt = 0; dt < 4; ++dt) st.O[dt] *= alpha;
        mcb = mn * SM_C; ls = 0.f;
        if (any0) ls += tile_exp(s0, full0, kq0, rng0, act0 ? mcb : __builtin_inff());
        if (any1) ls += tile_exp(s1, full1, kq1, rng1, act1 ? mcb : __builtin_inff());
    }
    st.l += ls;
    if (any1) tile_vload(V1, vf1, rl, quad);
    if (any0) tile_pvmma(vf0, s0, st.O);
    if (any1) tile_pvmma(vf1, s1, st.O);
}
DI void nsa_prompt_unit(Frame& F, int layer, int unit) {
    int lane = F.lane, wave = F.wave; asm volatile("" : "+v"(lane), "+s"(wave));
    const int tid = wave * 64 + lane, quad = lane >> 4, rl = lane & 15;
    const int b = unit >> 9, g = (unit >> 8) & 1, tt = unit & 255, t0 = 32 * tt;
    unsigned char* ws = KWS();
    const bf16* Z = (const bf16*)(ws + WS_Z);
    const float* ZS = (const float*)(ws + WS_ZS);
    LAS unsigned char* TB = F.lds;
    LAS float* AIMP = (LAS float*)(F.lds + 73728);
    LAS unsigned* SEL = (LAS unsigned*)(F.lds + LDSCTL_OFF + 512);
    const int tk = 4 * wave + (rl >> 2), t = t0 + tk, head = 4 * g + (rl & 3);
    const size_t row = (size_t)b * TP + t;
    bf16x8 qf[2];
    qf[0] = ld_frag_g(Z + row * LDZ + ZC_Q + head * 64 + quad * 8); qf[1] = ld_frag_g(Z + row * LDZ + ZC_Q + head * 64 + 32 + quad * 8);
    const float gc = sigmoidf_(ZS[row * 32 + head * 3]), gs = sigmoidf_(ZS[row * 32 + head * 3 + 1]), gw = sigmoidf_(ZS[row * 32 + head * 3 + 2]);
    f32x4 Of[4];
#pragma unroll
    for (int i = 0; i < 4; ++i) Of[i] = (f32x4){0.f, 0.f, 0.f, 0.f};
    AttnState st;
    const int nct = (t0 >> 10) + 1;
    const bf16* KC = (const bf16*)(ws + WS_KC) + ((size_t)(0 * 2 + b) * 512 * 2 + g) * 64;
    const bf16* VC = (const bf16*)(ws + WS_KC) + ((size_t)(1 * 2 + b) * 512 * 2 + g) * 64;
    const bf16* Zb = Z + (size_t)b * TP * LDZ + g * 64;
    const int skey = tid >> 3, sch = tid & 7;
    const int wlo = (t0 - 511 > 0 ? t0 - 511 : 0) >> 6, nwin = ((t0 + 31) >> 6) - wlo + 1;
    const int nwe = (nwin + 1) & ~1, nce = (nct + 1) & ~1;
    v4u rkA, rvA, rkB, rvB;
#define COMMIT(slot, rk, rv) do { LAS unsigned char* d_ = TB + (slot) * 18432 + skey * 144 + sch * 16; *(LAS v4u*)d_ = rk; *(LAS v4u*)(d_ + 9216) = rv; } while (0)
    NP_T(0);
    const int n1 = nwe + 2 * nce;
#define SEG1_VALID(i) ((i) < nwe ? (i) < nwin : (((i) - nwe) < nce ? ((i) - nwe) < nct : ((i) - nwe - nce) < nct))
#define SEG1_ISSUE(i, rk, rv) do { int i_ = (i); i_ = i_ < n1 ? i_ : n1 - 1; const bool win_ = i_ < nwe; int wt_ = wlo + (i_ < nwin ? i_ : nwin - 1); int jt_ = (i_ - nwe) % nce; jt_ = jt_ < nct ? jt_ : nct - 1; jt_ = jt_ < 0 ? 0 : jt_; \
        const bf16* pk_ = win_ ? Zb + (size_t)(64 * wt_ + skey) * LDZ + sch * 8 + ZC_KW : KC + (size_t)(64 * jt_ + skey) * 128 + sch * 8; \
        const bf16* pv_ = win_ ? Zb + (size_t)(64 * wt_ + skey) * LDZ + sch * 8 + ZC_VW : VC + (size_t)(64 * jt_ + skey) * 128 + sch * 8; \
        rk = *(const v4u*)pk_; rv = *(const v4u*)pv_; } while (0)
    attn_reset(st);
    float mfin = 0.f, il = 0.f;
    SEG1_ISSUE(0, rkA, rvA); SEG1_ISSUE(1, rkB, rvB);
    COMMIT(0, rkA, rvA); COMMIT(1, rkB, rvB);
    SEG1_ISSUE(2, rkA, rvA); SEG1_ISSUE(3, rkB, rvB);
    __syncthreads();
    for (int i = 0; i < n1; i += 2) {
        const LAS unsigned char* K0 = TB + (i & 3) * 18432; const LAS unsigned char* K1 = TB + ((i + 1) & 3) * 18432;
        if (i < nwe) {
            const int kb0 = 64 * (wlo + i), kb1 = kb0 + 64;
            attn_step_pair(K0, K0 + 9216, t - 511 - kb0, t - kb0, true, K1, K1 + 9216, t - 511 - kb1, t - kb1, (i + 1) < nwin, qf, st, rl, quad);
            if (i + 2 == nwe) { attn_accum3(Of, st, gw, lane); attn_reset(st); }
        } else if (i < nwe + nce) {
            const int nb0 = 64 * (i - nwe), nb1 = nb0 + 64;
            attn_step_pair(K0, K0 + 9216, 0, ((t - 31) >> 4) - nb0, true, K1, K1 + 9216, 0, ((t - 31) >> 4) - nb1, (i + 1 - nwe) < nct, qf, st, rl, quad);
            if (i + 2 == nwe + nce) { attn_accum3(Of, st, gc, lane); mfin = st.m * SM_C; const float lt_ = attn_rowsum(st, lane); il = lt_ > 0.f ? 1.f / lt_ : 0.f; }
        } else {
#pragma unroll
            for (int e2 = 0; e2 < 2; ++e2) {
                const int jt = i + e2 - nwe - nce;
                if (jt < nct) {
                    f32x4 s[4]; qk_tile(e2 ? K1 : K0, qf, s, rl, quad);
#pragma unroll
                    for (int kt = 0; kt < 4; ++kt)
#pragma unroll
                        for (int e = 0; e < 4; ++e) {
                            const int n = 64 * jt + 16 * kt + 4 * quad + e;
                            float p = (16 * n + 31 <= t) ? __builtin_amdgcn_exp2f(s[kt][e] * SM_C - mfin) * il : 0.f;
                            p += shx<1>(p, lane); p += shx<2>(p, lane);
                            if ((rl & 3) == 0) AIMP[tk * 512 + n] = p;
                        }
                }
            }
        }
        if (i + 2 < n1) { if (SEG1_VALID(i + 2)) COMMIT((i + 2) & 3, rkA, rvA); if (SEG1_VALID(i + 3)) COMMIT((i + 3) & 3, rkB, rvB); }
        __syncthreads();
        SEG1_ISSUE(i + 4, rkA, rvA); SEG1_ISSUE(i + 5, rkB, rvB);
    }
    NP_T(1);
    {
        const int nav = nct * 64;
        LAS unsigned* KS = (LAS unsigned*)(TB + wave * 2048);
#pragma unroll
        for (int q = 0; q < 4; ++q) {
            const int tq = 4 * wave + q, cur = (t0 + tq) >> 6;
#pragma unroll
            for (int e = 0; e < 2; ++e) {
                const int sblk = lane + 64 * e;
                float imp = 0.f;
#pragma unroll
                for (int d = -1; d <= 3; ++d) { const int n = 4 * sblk + d; if (n >= 0 && n < nav) imp += AIMP[tq * 512 + n]; }
                const bool valid = sblk <= cur, forced = (sblk == 0) || (sblk == cur) || (sblk == cur - 1);
                KS[q * 128 + sblk] = score_key(imp + (forced ? 1000.f : 0.f), valid, sblk);
            }
        }
        asm volatile("" ::: "memory");
#pragma unroll
        for (int q = 0; q < 4; ++q) {
            const int tq = 4 * wave + q, cur = (t0 + tq) >> 6, ng4 = (cur >> 2) + 1;
            const unsigned k0 = KS[q * 128 + lane], k1 = KS[q * 128 + 64 + lane];
            int r0, r1; key_rank2(KS + q * 128, ng4, k0, k1, r0, r1);
            const bool s0 = (lane <= cur) && r0 < 16, s1 = (lane + 64 <= cur) && r1 < 16;
            const unsigned long long m0 = __ballot(s0), m1 = __ballot(s1);
            if (lane == 0) { SEL[tq * 4 + 0] = (unsigned)m0; SEL[tq * 4 + 1] = (unsigned)(m0 >> 32); SEL[tq * 4 + 2] = (unsigned)m1; SEL[tq * 4 + 3] = (unsigned)(m1 >> 32); }
        }
    }
    __syncthreads();
    unsigned un[4], my[4], wv[4];
#pragma unroll
    for (int w = 0; w < 4; ++w) { unsigned v = (lane < 32) ? SEL[lane * 4 + w] : 0u;
        v |= (unsigned)shxi<1>((int)v, lane); v |= (unsigned)shxi<2>((int)v, lane); v |= (unsigned)shxi<4>((int)v, lane); v |= (unsigned)shxi<8>((int)v, lane); v |= (unsigned)shxi<16>((int)v, lane); v |= (unsigned)shxi<32>((int)v, lane);
        un[w] = __builtin_amdgcn_readfirstlane(v); my[w] = SEL[tk * 4 + w];
        wv[w] = SEL[(4 * wave) * 4 + w] | SEL[(4 * wave + 1) * 4 + w] | SEL[(4 * wave + 2) * 4 + w] | SEL[(4 * wave + 3) * 4 + w]; wv[w] = __builtin_amdgcn_readfirstlane(wv[w]); }
#if PH_NSAC > 1
    AttnState st2; attn_reset(st2);
#endif
    NP_T(2);
    attn_reset(st);
    {
        unsigned w0 = un[0], w1 = un[1], w2 = un[2], w3 = un[3];
#define NEXT_BLK(dst) do { if (w0) { dst = __builtin_ctz(w0); w0 &= w0 - 1u; } else if (w1) { dst = 32 + __builtin_ctz(w1); w1 &= w1 - 1u; } else if (w2) { dst = 64 + __builtin_ctz(w2); w2 &= w2 - 1u; } \
        else if (w3) { dst = 96 + __builtin_ctz(w3); w3 &= w3 - 1u; } else dst = -1; } while (0)
#define SEG2_ISSUE(blk_, rk, rv) do { const int b_ = (blk_) >= 0 ? (blk_) : 0; const bf16* p_ = Zb + (size_t)(64 * b_ + skey) * LDZ + sch * 8; rk = *(const v4u*)(p_ + ZC_KS); rv = *(const v4u*)(p_ + ZC_VS); } while (0)
#define BLK_WORD(arr, blk_) (((blk_) >> 5) == 0 ? arr[0] : ((blk_) >> 5) == 1 ? arr[1] : ((blk_) >> 5) == 2 ? arr[2] : arr[3])
#define SEG2_PAIR(ca, cb, sa, sb, stt) do { const LAS unsigned char* K0 = TB + (sa) * 18432; const LAS unsigned char* K1 = TB + (sb) * 18432; \
            const int ca_ = (ca) >= 0 ? (ca) : 0, cb_ = (cb) >= 0 ? (cb) : 0; \
            const bool need0 = ((ca) >= 0) && ((BLK_WORD(wv, ca_) >> (ca_ & 31)) & 1u), need1 = ((cb) >= 0) && ((BLK_WORD(wv, cb_) >> (cb_ & 31)) & 1u); \
            const bool mine0 = need0 && ((BLK_WORD(my, ca_) >> (ca_ & 31)) & 1u), mine1 = need1 && ((BLK_WORD(my, cb_) >> (cb_ & 31)) & 1u); \
            attn_step_pair(K0, K0 + 9216, 0, t - 64 * ca_, mine0, K1, K1 + 9216, 0, t - 64 * cb_, mine1, qf, stt, rl, quad); } while (0)
        v4u rkC, rvC, rkD, rvD;
        int c0, c1, c2, c3, n0, n1b, n2, n3, m0, m1, m2, m3;
        NEXT_BLK(c0); NEXT_BLK(c1); NEXT_BLK(c2); NEXT_BLK(c3); NEXT_BLK(n0); NEXT_BLK(n1b); NEXT_BLK(n2); NEXT_BLK(n3);
        SEG2_ISSUE(c0, rkA, rvA); SEG2_ISSUE(c1, rkB, rvB); SEG2_ISSUE(c2, rkC, rvC); SEG2_ISSUE(c3, rkD, rvD);
        COMMIT(0, rkA, rvA); COMMIT(1, rkB, rvB); COMMIT(2, rkC, rvC); COMMIT(3, rkD, rvD);
        SEG2_ISSUE(n0, rkA, rvA); SEG2_ISSUE(n1b, rkB, rvB); SEG2_ISSUE(n2, rkC, rvC); SEG2_ISSUE(n3, rkD, rvD);
        __syncthreads();
        int i = 0;
        while (c0 >= 0) {
            NEXT_BLK(m0); NEXT_BLK(m1); NEXT_BLK(m2); NEXT_BLK(m3);
            SEG2_PAIR(c0, c1, i & 7, (i + 1) & 7, st);
            SEG2_PAIR(c2, c3, (i + 2) & 7, (i + 3) & 7, st);
#if PH_NSAC > 1
            SEG2_PAIR(c0, c1, i & 7, (i + 1) & 7, st2); SEG2_PAIR(c2, c3, (i + 2) & 7, (i + 3) & 7, st2);
#endif
            COMMIT((i + 4) & 7, rkA, rvA); COMMIT((i + 5) & 7, rkB, rvB); COMMIT((i + 6) & 7, rkC, rvC); COMMIT((i + 7) & 7, rkD, rvD);
            __syncthreads();
#if defined(PH_NSAX) && (PH_NSAX & 1)
            __syncthreads();
#endif
#if defined(PH_NSAX) && (PH_NSAX & 2)
            { v4u d0_, d1_; SEG2_ISSUE(m0, d0_, d1_); asm volatile("" :: "v"(d0_), "v"(d1_)); SEG2_ISSUE(m1, d0_, d1_); asm volatile("" :: "v"(d0_), "v"(d1_));
              SEG2_ISSUE(m2, d0_, d1_); asm volatile("" :: "v"(d0_), "v"(d1_)); SEG2_ISSUE(m3, d0_, d1_); asm volatile("" :: "v"(d0_), "v"(d1_)); }
#endif
            SEG2_ISSUE(m0, rkA, rvA); SEG2_ISSUE(m1, rkB, rvB); SEG2_ISSUE(m2, rkC, rvC); SEG2_ISSUE(m3, rkD, rvD);
            c0 = n0; c1 = n1b; c2 = n2; c3 = n3; n0 = m0; n1b = m1; n2 = m2; n3 = m3; i += 4;
        }
    }
    NP_T(3);
    attn_accum3(Of, st, gs, lane);
#if PH_NSAC > 1
    attn_accum3(Of, st2, (float)(layer >> 8), lane);
#endif
#undef SEG1_ISSUE
#undef SEG1_VALID
#undef SEG2_ISSUE
#undef SEG2_PAIR
#undef BLK_WORD
#undef COMMIT
#undef NEXT_BLK
    bf16* MIX = (bf16*)(ws + WS_MIX) + row * 1536 + head * 64;
#pragma unroll
    for (int dt = 0; dt < 4; ++dt) { v2u w; w.x = pk2(Of[dt][0], Of[dt][1]); w.y = pk2(Of[dt][2], Of[dt][3]); *(v2u*)(MIX + 16 * dt + 4 * quad) = w; }
    __syncthreads();
}

#define CB() asm volatile("" ::: "memory")
DI void stage_wave_f32(LAS unsigned char* Kt, LAS unsigned char* Vt, const float* kb, const float* vb, size_t stride, int lane, float* ck = nullptr, float* cv = nullptr, int rowskip = 0) {
    const int k0 = lane >> 3, ch = lane & 7;
#pragma unroll
    for (int h = 0; h < 4; ++h) {
        const float* src = (h < 2 ? kb : vb); LAS unsigned char* dst = (h < 2 ? Kt : Vt); const int r0 = (h & 1) * 32; float* cp = (h < 2 ? ck : cv);
        f32x4 a[4][2];
#pragma unroll
        for (int it = 0; it < 4; ++it) { const float* kp = src + (size_t)(r0 + it * 8 + k0) * stride + ch * 8; a[it][0] = *(const f32x4*)kp; a[it][1] = *(const f32x4*)(kp + 4); }
#pragma unroll
        for (int it = 0; it < 4; ++it) *(LAS v4u*)(dst + (r0 + it * 8 + k0) * 144 + ch * 16) = pack8(a[it][0], a[it][1]);
        if (cp) {
#pragma unroll
            for (int it = 0; it < 4; ++it) { const int rr = r0 + it * 8 + k0; if (rr >= rowskip) { float* op = cp + (size_t)rr * stride + ch * 8; *(f32x4*)op = a[it][0]; *(f32x4*)(op + 4) = a[it][1]; } }
        }
        asm volatile("" ::: "memory");
    }
}
DI void stage_wave_b16(LAS unsigned char* Kt, LAS unsigned char* Vt, const bf16* kb, const bf16* vb, size_t stride, int nvalid, int lane, bool do_v) {
    const int k0 = lane >> 3, ch = lane & 7;
    const v4u z = (v4u){0u, 0u, 0u, 0u};
#pragma unroll
    for (int it = 0; it < 8; ++it) {
        const int key = it * 8 + k0; const bool v = key < nvalid;
        *(LAS v4u*)(Kt + key * 144 + ch * 16) = v ? *(const v4u*)(kb + key * stride + ch * 8) : z;
        if (do_v) *(LAS v4u*)(Vt + key * 144 + ch * 16) = v ? *(const v4u*)(vb + key * stride + ch * 8) : z;
    }
}
DI void nsa_sample_unit(Frame& F, int layer, int s) {
    int lane = F.lane, wave = F.wave; asm volatile("" : "+v"(lane), "+s"(wave));
    const int quad = lane >> 4, rl = lane & 15;
    const int g = wave & 1, q4 = wave >> 1;
    unsigned char* ws = KWS();
    const bf16* Z = (const bf16*)(ws + WS_Z);
    const float* ZS = (const float*)(ws + WS_ZS);
    LAS unsigned char* Kt = F.lds + wave * 18432; LAS unsigned char* Vt = Kt + 9216;
    LAS float* AIMP = (LAS float*)Vt;
    const int j = rl >> 2, head = 4 * g + (rl & 3), qpos = 2048 + j;
    const size_t row = (size_t)MP + 4 * s + j;
    bf16x8 qf[2];
    qf[0] = ld_frag_g(Z + row * LDZ + ZC_Q + head * 64 + quad * 8); qf[1] = ld_frag_g(Z + row * LDZ + ZC_Q + head * 64 + 32 + quad * 8);
    const float gc = sigmoidf_(ZS[row * 32 + head * 3]), gs = sigmoidf_(ZS[row * 32 + head * 3 + 1]), gw = sigmoidf_(ZS[row * 32 + head * 3 + 2]);
    f32x4 Of[4];
#pragma unroll
    for (int i = 0; i < 4; ++i) Of[i] = (f32x4){0.f, 0.f, 0.f, 0.f};
    AttnState st;
    const bf16* KC = (const bf16*)(ws + WS_KCS) + ((size_t)(0 * 128 + s) * 128 * 2 + g) * 64;
    const bf16* VC = (const bf16*)(ws + WS_KCS) + ((size_t)(1 * 128 + s) * 128 * 2 + g) * 64;
    attn_reset(st);
#pragma unroll 1
    for (int jt = 0; jt < 2; ++jt) {
        stage_wave_b16(Kt, Vt, KC + (size_t)64 * jt * 128, VC + (size_t)64 * jt * 128, 128, 64, lane, true); CB();
        attn_step3(Kt, Vt, qf, st, 0, 126 - 64 * jt, true, rl, quad); CB();
    }
    attn_accum3(Of, st, q4 == 0 ? gc : 0.f, lane);
    {
        const float mfin = st.m * SM_C, lt = attn_rowsum(st, lane), il = lt > 0.f ? 1.f / lt : 0.f;
#pragma unroll 1
        for (int jt = 0; jt < 2; ++jt) {
            stage_wave_b16(Kt, Vt, KC + (size_t)64 * jt * 128, VC, 128, 64, lane, false); CB();
            f32x4 sv[4]; qk_tile(Kt, qf, sv, rl, quad); CB();
#pragma unroll
            for (int kt = 0; kt < 4; ++kt)
#pragma unroll
                for (int i = 0; i < 4; ++i) {
                    const int n = 64 * jt + 16 * kt + 4 * quad + i;
                    float p = (n <= 126) ? __builtin_amdgcn_exp2f(sv[kt][i] * SM_C - mfin) * il : 0.f;
                    p += shx<1>(p, lane); p += shx<2>(p, lane);
                    if ((rl & 3) == 0) AIMP[j * 128 + n] = p;
                }
        }
    }
    CB();
    unsigned long long msk[4];
    {
        unsigned keys[4];
#pragma unroll
        for (int q = 0; q < 4; ++q) {
            float imp = 0.f;
#pragma unroll
            for (int d = -1; d <= 3; ++d) { const int n = 4 * lane + d; if (n >= 0 && n <= 126 && lane < 33) imp += AIMP[q * 128 + n]; }
            const bool forced = (lane == 0) || (lane == 32) || (lane == 31);
            keys[q] = score_key(imp + (forced ? 1000.f : 0.f), lane < 33, lane);
        }
        CB();
        LAS unsigned* KS = (LAS unsigned*)Kt;
#pragma unroll
        for (int q = 0; q < 4; ++q) KS[q * 64 + lane] = keys[q];
        CB();
#pragma unroll
        for (int q = 0; q < 4; ++q) msk[q] = __ballot(lane < 33 && key_rank(KS + q * 64, 9, keys[q]) < 16);
    }
    CB();
    const unsigned long long un = msk[0] | msk[1] | msk[2] | msk[3];
    const unsigned long long mym = j == 0 ? msk[0] : j == 1 ? msk[1] : j == 2 ? msk[2] : msk[3];
    const int* pt = (const int*)KIN(7);
    AttnState sw;
    attn_reset(st); attn_reset(sw);
    {
        unsigned long long word = un; int idx = 0;
        while (word) {
            const int blk = __builtin_ctzll(word); word &= word - 1ull;
            if ((idx++ & 3) != q4) continue;
            if (blk < 32) {
                const int phys = pt[s * 16 + (blk >> 1)];
                const float* base = KIN(2) + ((size_t)(layer * 2560 + phys) * 128 + (blk & 1) * 64) * 512 + g * 64;
                stage_wave_f32(Kt, Vt, base + 256, base + 384, 512, lane); CB();
            } else {
                stage_wave_b16(Kt, Vt, Z + (size_t)(MP + 4 * s) * LDZ + ZC_KS + g * 64, Z + (size_t)(MP + 4 * s) * LDZ + ZC_VS + g * 64, LDZ, 4, lane, true); CB();
            }
            attn_step3(Kt, Vt, qf, st, 0, qpos - 64 * blk, (mym >> blk) & 1ull, rl, quad); CB();
        }
#pragma unroll 1
        for (int jt = 0; jt < 9; ++jt) {
            if ((idx++ & 3) != q4) continue;
            if (jt < 8) { const float* base = KIN(3) + ((size_t)(layer * 128 + s) * 512 + 64 * jt) * 256 + g * 64;
                float* ob = KOUT() + O_WINS + ((size_t)(layer * 128 + s) * 512 + 64 * jt) * 256 + g * 64 - (size_t)4 * 256;
                stage_wave_f32(Kt, Vt, base, base + 128, 256, lane, ob, ob + 128, jt == 0 ? 4 : 0); CB(); }
            else { stage_wave_b16(Kt, Vt, Z + (size_t)(MP + 4 * s) * LDZ + ZC_KW + g * 64, Z + (size_t)(MP + 4 * s) * LDZ + ZC_VW + g * 64, LDZ, 4, lane, true); CB(); }
            attn_step3(Kt, Vt, qf, sw, j + 1 - 64 * jt, 512 + j - 64 * jt, true, rl, quad); CB();
        }
    }
    int lane2 = lane; asm volatile("" : "+v"(lane2));
    LAS float* X = (LAS float*)(F.lds + wave * 18432);
    {
        const float ls = attn_rowsum(st, lane), lw = attn_rowsum(sw, lane);
        X[0 * 64 + lane2] = st.m; X[1 * 64 + lane2] = ls; X[18 * 64 + lane2] = sw.m; X[19 * 64 + lane2] = lw;
#pragma unroll
        for (int dt = 0; dt < 4; ++dt)
#pragma unroll
            for (int e = 0; e < 4; ++e) { X[(2 + 4 * dt + e) * 64 + lane2] = st.O[dt][e]; X[(20 + 4 * dt + e) * 64 + lane2] = sw.O[dt][e]; }
    }
    __syncthreads();
    if (q4 == 0) {
#pragma unroll
        for (int br = 0; br < 2; ++br) {
            float m[4], l[4];
#pragma unroll
            for (int q = 0; q < 4; ++q) { const LAS float* Y = (const LAS float*)(F.lds + (2 * q + g) * 18432) + br * 18 * 64; m[q] = Y[lane2]; l[q] = Y[64 + lane2]; }
            const float mm = fmaxf(fmaxf(m[0], m[1]), fmaxf(m[2], m[3]));
            float w[4], lt = 0.f;
#pragma unroll
            for (int q = 0; q < 4; ++q) { w[q] = __builtin_amdgcn_exp2f((m[q] - mm) * SM_C); lt += l[q] * w[q]; }
            const float gate = br == 0 ? gs : gw;
            const float sc = lt > 0.f ? gate / lt : 0.f;
#pragma unroll
            for (int q = 0; q < 4; ++q) { const LAS float* Y = (const LAS float*)(F.lds + (2 * q + g) * 18432) + br * 18 * 64; const float wq = w[q] * sc;
#pragma unroll
                for (int dt = 0; dt < 4; ++dt)
#pragma unroll
                    for (int e = 0; e < 4; ++e) Of[dt][e] += Y[(2 + 4 * dt + e) * 64 + lane2] * wq; }
        }
        bf16* MIX = (bf16*)(ws + WS_MIX) + row * 1536 + head * 64;
#pragma unroll
        for (int dt = 0; dt < 4; ++dt) { v2u w2; w2.x = pk2(Of[dt][0], Of[dt][1]); w2.y = pk2(Of[dt][2], Of[dt][3]); *(v2u*)(MIX + 16 * dt + 4 * quad) = w2; }
    }
    __syncthreads();
}
DI void ret_out_unit(Frame& F, int layer, int unit) {
    const int tid = F.tid, lane = F.lane, wave = F.wave, quad = lane >> 4, rl = lane & 15;
    const int b = unit >> 8, h = (unit >> 6) & 3, c = unit & 63;
    const int row0 = b * TP + 128 * c;
    unsigned char* ws = KWS();
    const bf16* Z = (const bf16*)(ws + WS_Z);
    const bf16* QR = (const bf16*)(ws + WS_QR); const bf16* KR = (const bf16*)(ws + WS_KR);
    const bf16* RST = (const bf16*)(ws + WS_RST) + (size_t)unit * 16384;
    LAS unsigned char* LQ = F.lds; LAS unsigned char* LK = F.lds + 34816; LAS unsigned char* LV = F.lds + 69632; LAS unsigned char* LS = F.lds + 104448;
    for (int it = tid; it < 2048; it += NTHREADS) {
        const int j = it >> 4, cc = it & 15;
        *(LAS v4u*)(LQ + j * 272 + cc * 16) = *(const v4u*)(QR + (size_t)(row0 + j) * 512 + h * 128 + cc * 8);
        *(LAS v4u*)(LK + j * 272 + cc * 16) = *(const v4u*)(KR + (size_t)(row0 + j) * 512 + h * 128 + cc * 8);
        *(LAS v4u*)(LS + j * 272 + cc * 16) = *(const v4u*)(RST + (size_t)j * 128 + cc * 8);
        const v4u w = *(const v4u*)(Z + (size_t)(row0 + j) * LDZ + ZC_RQKV + 1024 + h * 128 + cc * 8);
        LAS unsigned char* d = LV + (cc * 8) * 272 + j * 2;
        *(LAS bf16*)(d) = (bf16)(w.x & 0xffff); *(LAS bf16*)(d + 272) = (bf16)(w.x >> 16); *(LAS bf16*)(d + 2 * 272) = (bf16)(w.y & 0xffff); *(LAS bf16*)(d + 3 * 272) = (bf16)(w.y >> 16);
        *(LAS bf16*)(d + 4 * 272) = (bf16)(w.z & 0xffff); *(LAS bf16*)(d + 5 * 272) = (bf16)(w.z >> 16); *(LAS bf16*)(d + 6 * 272) = (bf16)(w.w & 0xffff); *(LAS bf16*)(d + 7 * 272) = (bf16)(w.w >> 16);
    }
    __syncthreads();
    const float lg = ret_lg(h);
    const int il = 16 * wave + rl;
    bf16x8 qb[4];
#pragma unroll
    for (int s = 0; s < 4; ++s) qb[s] = ld_frag_l(LQ + il * 272 + (32 * s + 8 * quad) * 2);
    f32x4 C[8];
    const float qdec = __expf((float)(il + 1) * lg);
#pragma unroll
    for (int dt = 0; dt < 8; ++dt) {
        f32x4 a = (f32x4){0.f, 0.f, 0.f, 0.f};
#pragma unroll
        for (int s = 0; s < 4; ++s) a = mfma16(ld_frag_l(LS + (16 * dt + rl) * 272 + (32 * s + 8 * quad) * 2), qb[s], a);
        C[dt] = a * qdec;
    }
    for (int s2 = 0; s2 <= (wave >> 1); ++s2) {
        f32x4 P[2];
#pragma unroll
        for (int e = 0; e < 2; ++e) {
            const int jt = 2 * s2 + e;
            f32x4 a = (f32x4){0.f, 0.f, 0.f, 0.f};
            if (jt <= wave) {
#pragma unroll
                for (int s = 0; s < 4; ++s) a = mfma16(ld_frag_l(LK + (16 * jt + rl) * 272 + (32 * s + 8 * quad) * 2), qb[s], a);
#pragma unroll
                for (int i = 0; i < 4; ++i) { const int jj = 16 * jt + 4 * quad + i; a[i] = (il >= jj) ? a[i] * __expf((float)(il - jj) * lg) : 0.f; }
            }
            P[e] = a;
        }
        const bf16x8 pb = pack_frag(P[0], P[1]);
#pragma unroll
        for (int dt = 0; dt < 8; ++dt) {
            const LAS unsigned char* vp = LV + (16 * dt + rl) * 272 + (32 * s2 + 4 * quad) * 2;
            C[dt] = mfma16(mk_frag(*(const LAS v2u*)vp, *(const LAS v2u*)(vp + 32)), pb, C[dt]);
        }
    }
    float ss = 0.f;
#pragma unroll
    for (int dt = 0; dt < 8; ++dt) ss += (C[dt][0] * C[dt][0] + C[dt][1] * C[dt][1]) + (C[dt][2] * C[dt][2] + C[dt][3] * C[dt][3]);
    ss += shx<16>(ss, lane); ss += shx<32>(ss, lane);
    const float scl = rsqrtf(ss * (1.f / 128.f) + EPS);
    const size_t row = (size_t)row0 + il;
#pragma unroll
    for (int dt = 0; dt < 8; ++dt) {
        const v2u gwd = *(const v2u*)(Z + row * LDZ + ZC_RG + h * 128 + 16 * dt + 4 * quad);
        v2u w; w.x = pk2(C[dt][0] * scl * siluf_(lo_bf(gwd.x)), C[dt][1] * scl * siluf_(hi_bf(gwd.x))); w.y = pk2(C[dt][2] * scl * siluf_(lo_bf(gwd.y)), C[dt][3] * scl * siluf_(hi_bf(gwd.y)));
        *(v2u*)((bf16*)(ws + WS_MIX) + row * 1536 + 1024 + h * 128 + 16 * dt + 4 * quad) = w;
    }
    __syncthreads();
}
DI void gdn_out_row(Frame& F, int layer, int row) {
    const int lane = F.lane;
    unsigned char* ws = KWS();
    const float* o = (const float*)(ws + WS_OGDN) + (size_t)row * 512 + lane * 8;
    const f32x4 a = *(const f32x4*)o, b = *(const f32x4*)(o + 4);
    float ss = (a[0] * a[0] + a[1] * a[1]) + (a[2] * a[2] + a[3] * a[3]) + (b[0] * b[0] + b[1] * b[1]) + (b[2] * b[2] + b[3] * b[3]);
    ss += shx<1>(ss, lane); ss += shx<2>(ss, lane); ss += shx<4>(ss, lane); ss += shx<8>(ss, lane);
    const float scl = rsqrtf(ss * (1.f / 128.f) + EPS);
    const float* ng = KIN(18) + layer * 128 + (lane & 15) * 8;
    const f32x4 ga = *(const f32x4*)ng, gb = *(const f32x4*)(ng + 4);
    f32x4 za, zb; unpack8(*(const v4u*)((const bf16*)(ws + WS_Z) + (size_t)row * LDZ + ZC_GZ + lane * 8), za, zb);
    f32x4 ra, rb;
#pragma unroll
    for (int e = 0; e < 4; ++e) { ra[e] = a[e] * scl * ga[e] * siluf_(za[e]); rb[e] = b[e] * scl * gb[e] * siluf_(zb[e]); }
    *(v4u*)((bf16*)(ws + WS_MIX) + (size_t)row * 1536 + 512 + lane * 8) = pack8(ra, rb);
}
DI void final_row(Frame& F, int row) {
    const int lane = F.lane;
    const float* x = (const float*)(KWS() + WS_XR) + (size_t)row * DM;
    float* y = (row < MP) ? KOUT() + O_YP + (size_t)row * DM : KOUT() + O_YS + (size_t)(row - MP) * DM;
    f32x4 v[4]; float ss = 0.f;
#pragma unroll
    for (int j = 0; j < 4; ++j) { v[j] = *(const f32x4*)(x + 256 * j + lane * 4); ss += (v[j][0] * v[j][0] + v[j][1] * v[j][1]) + (v[j][2] * v[j][2] + v[j][3] * v[j][3]); }
    const float scl = rsqrtf(wave_sum(ss, lane) * (1.f / DM) + EPS);
#pragma unroll
    for (int j = 0; j < 4; ++j) *(f32x4*)(y + 256 * j + lane * 4) = v[j] * scl * *(const f32x4*)(KIN(26) + 256 * j + lane * 4);
}
template <class Epi>
DI void sgemm_tile(Frame& F, const bf16* A, int lda, const bf16* Bt, int ldb, int K, int row0, int col0, const Epi& E) {
    int lane = F.lane, wave = F.wave; asm volatile("" : "+v"(lane), "+s"(wave));
    const int tid = wave * 64 + lane, quad = lane >> 4, rl = lane & 15;
    const int kper = K >> 3, nks = kper >> 5;
    f32x4 acc[2][4];
#pragma unroll
    for (int rt = 0; rt < 2; ++rt)
#pragma unroll
        for (int ct = 0; ct < 4; ++ct) acc[rt][ct] = (f32x4){0.f, 0.f, 0.f, 0.f};
    const bf16* ap = A + (size_t)(row0 + rl) * lda + wave * kper + quad * 8;
    const bf16* bp = Bt + (size_t)(col0 + rl) * ldb + wave * kper + quad * 8;
#pragma unroll 4
    for (int ks = 0; ks < nks; ++ks) {
        bf16x8 a[2], b[4];
#pragma unroll
        for (int rt = 0; rt < 2; ++rt) a[rt] = ld_frag_g(ap + (size_t)(16 * rt) * lda + ks * 32);
#pragma unroll
        for (int ct = 0; ct < 4; ++ct) b[ct] = ld_frag_g(bp + (size_t)(16 * ct) * ldb + ks * 32);
#pragma unroll
        for (int rt = 0; rt < 2; ++rt)
#pragma unroll
            for (int ct = 0; ct < 4; ++ct) acc[rt][ct] = mfma16(a[rt], b[ct], acc[rt][ct]);
    }
    LAS float* RED = (LAS float*)F.lds;
#pragma unroll
    for (int rt = 0; rt < 2; ++rt)
#pragma unroll
        for (int ct = 0; ct < 4; ++ct)
#pragma unroll
            for (int i = 0; i < 4; ++i) RED[wave * 2176 + (16 * rt + 4 * quad + i) * 68 + 16 * ct + rl] = acc[rt][ct][i];
    __syncthreads();
    const int r = tid >> 4, c4 = (tid & 15) * 4;
    f32x4 v = *(const LAS f32x4*)(RED + r * 68 + c4);
#pragma unroll
    for (int w = 1; w < 8; ++w) v += *(const LAS f32x4*)(RED + w * 2176 + r * 68 + c4);
    E(row0 + r, col0 + c4, v, lane);
    __syncthreads();
}
struct SEpiC {
    const bf16* Z; bf16* G;
    DI void operator()(int row, int col, f32x4 v, int lane) const {
        const v2u gw = *(const v2u*)(Z + (size_t)row * LDZ + ZC_MG + col);
        v[0] *= sigmoidf_(lo_bf(gw.x)); v[1] *= sigmoidf_(hi_bf(gw.x)); v[2] *= sigmoidf_(lo_bf(gw.y)); v[3] *= sigmoidf_(hi_bf(gw.y));
        *(v2u*)(G + (size_t)row * 3072 + col) = pack4(v);
    }
};
struct SEpiRes {
    float* XR; bf16* XG; const float* gvec; float* SS; float* T; int mode; const float* XRr;
    DI void operator()(int row, int col, f32x4 v, int lane) const {
        const size_t o = (size_t)row * DM + col;
        if (mode == 1) { *(v2u*)((bf16*)T + o) = pack4(v); return; }
        f32x4 x = *(const f32x4*)(XRr + o);
        if (mode == 2) { const v2u tw = *(const v2u*)((const bf16*)T + o); const f32x4 t = (f32x4){lo_bf(tw.x), hi_bf(tw.x), lo_bf(tw.y), hi_bf(tw.y)};
#pragma unroll
            for (int e = 0; e < 4; ++e) v[e] = t[e] * sigmoidf_(v[e]); }
        x += v;
        *(f32x4*)(XR + o) = x;
        if (XG) { f32x4 y = x; if (gvec) y *= *(const f32x4*)(gvec + col); *(v2u*)(XG + o) = pack4(y); }
        if (SS) { float ssq = (x[0] * x[0] + x[1] * x[1]) + (x[2] * x[2] + x[3] * x[3]);
            ssq += shx<1>(ssq, lane); ssq += shx<2>(ssq, lane); ssq += shx<4>(ssq, lane); ssq += shx<8>(ssq, lane);
            if ((lane & 15) == 0) SS[(size_t)row * 16 + (col >> 6)] = ssq; }
    }
};
struct SEpiUp {
    bf16* H; const float* SS;
    DI void operator()(int row, int col, f32x4 v, int lane) const {
        const f32x4 p0 = *(const f32x4*)(SS + (size_t)row * 16), p1 = *(const f32x4*)(SS + (size_t)row * 16 + 4), p2 = *(const f32x4*)(SS + (size_t)row * 16 + 8), p3 = *(const f32x4*)(SS + (size_t)row * 16 + 12);
        const f32x4 ps = (p0 + p1) + (p2 + p3);
        const float rstd = rsqrtf(((ps[0] + ps[1]) + (ps[2] + ps[3])) * (1.f / DM) + EPS);
#pragma unroll
        for (int e = 0; e < 4; ++e) { const float a = fmaxf(v[e] * rstd, 0.f); v[e] = a * a; }
        *(v2u*)(H + (size_t)row * DFF + col) = pack4(v);
    }
};
#ifndef PH_P0
#define PH_P0 1
#endif
#ifndef PH_A
#define PH_A 1
#endif
#ifndef PH_B0a
#define PH_B0a 1
#endif
#ifndef PH_B0b
#define PH_B0b 1
#endif
#ifndef PH_B0c
#define PH_B0c 1
#endif
#ifndef PH_B0d
#define PH_B0d 1
#endif
#ifndef PH_SCAN
#define PH_SCAN 1
#endif
#ifndef PH_RSCAN
#define PH_RSCAN 1
#endif
#ifndef PH_NSAP
#define PH_NSAP 1
#endif
#ifndef PH_NSAS
#define PH_NSAS 1
#endif
#ifndef PH_B2
#define PH_B2 1
#endif
#ifndef PH_C
#define PH_C 1
#endif
#ifndef PH_XBAR
#define PH_XBAR 0
#endif
#ifndef PH_D
#define PH_D 1
#endif
#ifndef PH_E
#define PH_E 1
#endif
#ifndef PH_F
#define PH_F 1
#endif
#ifndef PH_G1
#define PH_G1 1
#endif
#ifndef PH_G2
#define PH_G2 1
#endif
#ifndef PH_TREG
#define PH_TREG (-1)
#endif
#if PH_TREG >= 0
#define TREG_MARK(r) do { const unsigned long long now_ = __builtin_amdgcn_s_memrealtime(); if ((r) == PH_TREG) tacc_ += now_ - tlast_; tlast_ = now_; } while (0)
#define TREG_SUB(r) do { const unsigned long long now_ = __builtin_amdgcn_s_memrealtime(); if ((r) == PH_TREG) tacc_ += now_ - tsub_; tsub_ = now_; } while (0)
#else
#define TREG_MARK(r) do { } while (0)
#define TREG_SUB(r) do { } while (0)
#endif
struct Args { const void* in[27]; float* out; unsigned char* ws; };
__global__ void __launch_bounds__(NTHREADS, 2) mk_fwd(Args args) {
    extern __shared__ __attribute__((aligned(16))) unsigned char lds_raw[];
    Frame F;
    F.lds = (LAS unsigned char*)lds_raw;
    F.wave = __builtin_amdgcn_readfirstlane((int)threadIdx.x >> 6); F.lane = 0; F.tid = 0;
    F.G = gridDim.x; F.bid = blockIdx.x;
    F.ctl = (gu32*)(KWS() + WS_CTL);
    { const Frame Fp = fresh(F); for (int u = Fp.tid; u < (LDS_BYTES - LDSCTL_OFF) / 4; u += NTHREADS) ((LAS unsigned*)(F.lds + LDSCTL_OFF))[u] = 0u;
      __syncthreads();
      (void)xcd_barrier_post((unsigned*)(F.ctl + CW_BAR), (volatile LAS unsigned*)(F.lds + MISC_OFF) + 8, Fp.tid == 0); }
    const int G = F.G, bid = F.bid;
#if PH_TREG >= 0
    unsigned long long tacc_ = 0ull, tlast_ = __builtin_amdgcn_s_memrealtime(), tsub_ = tlast_;
#endif

        for (int rp_ = 0; rp_ < PH_P0; ++rp_) {
    { Frame Fp = fresh(F); p0_prologue(Fp); }
        }
    GRID_BAR();
    TREG_MARK(0);

    for (int layer = 0; layer < NLAYER; ++layer) {
        for (int rp_ = 0; rp_ < PH_A; ++rp_) {
        {
            const Frame Fg = fresh(F); const int G = Fg.G, bid = Fg.bid;
            unsigned char* ws = KWS();
            pg8::Gemm g{(const bf16*)(ws + WS_XGA), (const bf16*)(ws + WS_WIN + layer * SZ_WIN), MROWS, LDZ, DM, DM, DM, 31, 0};
            pg8::StaticOrder S; S.init(MROWS, LDZ, G, bid);
            epi::EpiA E{(bf16*)(ws + WS_Z), (float*)(ws + WS_ZS), (const float*)(ws + WS_SSA), KOUT(), layer};
            pg8::gemm_phase<epi::EpiA, pg8::StaticOrder, true, true>(Fg.lds, g, S, E, Fg.tid);
        }
        }
        GRID_BAR();
    TREG_MARK(1);
#if PH_TREG >= 0
        tsub_ = __builtin_amdgcn_s_memrealtime();
#endif
        {
            Frame Fp = fresh(F);
            gu32* qhead = F.ctl + CW_QUEUE + 512 * layer + 384;
            volatile LAS int* qslot = (volatile LAS int*)(F.lds + MISC_OFF) + 16;
            constexpr int NI = 5 * 272 * PH_B0d, N2 = 1024 * PH_B0c, N3 = 512 * PH_B0b;
            for (;;) {
                if (Fp.tid == 0) qslot[0] = (int)__hip_atomic_fetch_add(qhead, 1u, __ATOMIC_RELAXED, __HIP_MEMORY_SCOPE_AGENT);
                __syncthreads();
                int it = qslot[0];
                __syncthreads();
                it = __builtin_amdgcn_readfirstlane(it);
                if (it >= NI + N2 + N3) break;
                TREG_SUB(99);
                if (it < NI) { const int k = it / 5, r = it % 5;
                    if (r == 0) compress_job(Fp, layer, k % 272);
                    else if (k < 256 * PH_B0a) gdn_prep_unit(Fp, layer, (4 * k + r - 1) & 1023); }
                else { const int q = it - NI, g3 = q / 3, r3 = q % 3;
                    if (r3 < 2) sample_rec_unit(Fp, layer, (2 * g3 + r3) & 1023); else ret_prep_unit(Fp, layer, g3 & 511); }
                TREG_SUB(it < NI ? ((it % 5) == 0 ? 40 : 41) : (it < NI + N2 ? 42 : 43));
            }
        }
        GRID_BAR();
    TREG_MARK(2);
        {
            Frame Fp = fresh(F);
            gu32* qbase = F.ctl + CW_QUEUE + 512 * layer;
            volatile LAS int* qslot = (volatile LAS int*)(F.lds + MISC_OFF) + 16;
            constexpr int NQ = 8 * PH_SCAN, NS = 128 * PH_NSAS, NR = 32 * PH_RSCAN, NP = 256 * PH_NSAP;
            const int pref = (int)(xb_xcc_id() & 3u);
            for (;;) {
                if (Fp.tid == 0) qslot[1] = (int)__hip_atomic_fetch_add(qbase, 1u, __ATOMIC_RELAXED, __HIP_MEMORY_SCOPE_AGENT);
                __syncthreads();
                int it = qslot[1];
                __syncthreads();
                it = __builtin_amdgcn_readfirstlane(it);
                if (it >= NQ + NR) break;
                TREG_SUB(99);
                if (it < NQ) gdn_scan_chain(Fp, layer, it & 7);
                else ret_scan_part(Fp, layer, (it - NQ) & 31);
                TREG_SUB(it < NQ ? 21 : 23);
            }
            const int when = Fp.bid & 3;
            bool tried = false;
            for (int nu = 0;; ++nu) {
                if (Fp.tid == 0) {
                    int kind = -1, idx = 0;
                    if (!tried && nu >= when) {
                        tried = true;
                        const int a = (int)__hip_atomic_fetch_add(qbase + 320, 1u, __ATOMIC_RELAXED, __HIP_MEMORY_SCOPE_AGENT);
                        if (a < NS) { kind = 4; idx = a; }
                    }
                    if (kind < 0) {
                        for (int k = 0; k < 4 && kind < 0; ++k) { const int s = (pref + k) & 3;
                            if ((int)__hip_atomic_load(qbase + 64 * (1 + s), __ATOMIC_RELAXED, __HIP_MEMORY_SCOPE_AGENT) < NP) {
                                const int r = (int)__hip_atomic_fetch_add(qbase + 64 * (1 + s), 1u, __ATOMIC_RELAXED, __HIP_MEMORY_SCOPE_AGENT);
                                if (r < NP) { kind = s; idx = r; } } }
                    }
                    if (kind < 0) {
                        const int a = (int)__hip_atomic_fetch_add(qbase + 320, 1u, __ATOMIC_RELAXED, __HIP_MEMORY_SCOPE_AGENT);
                        if (a < NS) { kind = 4; idx = a; }
                    }
                    qslot[0] = kind; qslot[1] = idx;
                }
                __syncthreads();
                int kind = qslot[0], it = qslot[1];
                __syncthreads();
                kind = __builtin_amdgcn_readfirstlane(kind); it = __builtin_amdgcn_readfirstlane(it);
                if (kind < 0) break;
                TREG_SUB(99);
                if (kind < 4) nsa_prompt_unit(Fp, layer, (kind << 8) | (255 - (it & 255)));
                else nsa_sample_unit(Fp, layer, it & 127);
                TREG_SUB(kind < 4 ? 20 : 22);
            }
        }
        GRID_BAR();
    TREG_MARK(3);
        for (int rp_ = 0; rp_ < PH_B2; ++rp_) {
        { Frame Fp = fresh(F); for (int u = Fp.bid; u < 512; u += Fp.G) ret_out_unit(Fp, layer, u); }
        { Frame Fp = fresh(F); for (int r = Fp.bid * NWAVES + Fp.wave; r < MROWS; r += Fp.G * NWAVES) gdn_out_row(Fp, layer, r); }
        }
        GRID_BAR();
    TREG_MARK(4);
        for (int rp_ = 0; rp_ < PH_C; ++rp_) {
        {
            const Frame Fg = fresh(F); const int G = Fg.G, bid = Fg.bid;
            unsigned char* ws = KWS();
            pg8::Gemm g{(const bf16*)(ws + WS_MIX), (const bf16*)(ws + WS_WBR + layer * SZ_WBR), MP, 3072, 512, 1536, 512, 2, 1024};
            pg8::BranchOrder S; S.init(MP, G, bid);
            epi::EpiCM E{(const bf16*)(ws + WS_Z), (bf16*)(ws + WS_MRG), (float*)(ws + WS_PART)};
            pg8::gemm_phase<epi::EpiCM, pg8::BranchOrder, true, true>(Fg.lds, g, S, E, Fg.tid);
            TREG_SUB(99);
            {
                Frame Fs = fresh(F); const SEpiC Es{(const bf16*)(ws + WS_Z), (bf16*)(ws + WS_GATED)};
                for (int tl = Fs.bid; tl < 16 * 48; tl += Fs.G) { const int rt = tl & 15, ct = tl >> 4, b = ct >> 4;
                    sgemm_tile(Fs, (const bf16*)(ws + WS_MIX) + b * 512, 1536, (const bf16*)(ws + WS_WBR + layer * SZ_WBR), 512, 512, MP + 32 * rt, 64 * ct, Es); }
            }
            TREG_SUB(31);
        }
        }
        GRID_BAR();
    TREG_MARK(5);
        for (int rp_ = 0; rp_ < PH_D; ++rp_) {
        {
            const Frame Fg = fresh(F); const int G = Fg.G, bid = Fg.bid;
            unsigned char* ws = KWS();
            pg8::Gemm g{(const bf16*)(ws + WS_MRG), (const bf16*)(ws + WS_WO3 + layer * SZ_WO3), MP, DM, DM, DM, 3072, 31, 0};
            pg8::StaticOrder S; S.init(MP, DM, G, bid);
            epi::EpiRes E{(float*)(ws + WS_XR), (bf16*)(ws + WS_XGB), KIN(21) + layer * DM, (float*)(ws + WS_SSB), nullptr, (rp_ + 1 < PH_D) ? 3 : 0, layer == 0 ? KIN(0) : (const float*)(ws + WS_XR)};
            pg8::gemm_phase<epi::EpiRes, pg8::StaticOrder, true, true>(Fg.lds, g, S, E, Fg.tid);
            TREG_SUB(99);
            if (rp_ + 1 == PH_D) {
                Frame Fs = fresh(F); const SEpiRes Es{(float*)(ws + WS_XR), (bf16*)(ws + WS_XGB), KIN(21) + layer * DM, (float*)(ws + WS_SSB), nullptr, 0, layer == 0 ? KIN(1) - (size_t)MP * DM : (const float*)(ws + WS_XR)};
                for (int tl = Fs.bid; tl < 256; tl += Fs.G) sgemm_tile(Fs, (const bf16*)(ws + WS_GATED), 3072, (const bf16*)(ws + WS_WO3 + layer * SZ_WO3), 3072, 3072, MP + 32 * (tl & 15), 64 * (tl >> 4), Es);
            }
            TREG_SUB(32);
        }
        }
        GRID_BAR();
    TREG_MARK(6);
        for (int rp_ = 0; rp_ < PH_E; ++rp_) {
        {
            const Frame Fg = fresh(F); const int G = Fg.G, bid = Fg.bid;
            unsigned char* ws = KWS();
            pg8::Gemm g{(const bf16*)(ws + WS_XGB), (const bf16*)(ws + WS_WUP + layer * SZ_WUP), MP, DFF, DM, DM, DM, 31, 0};
            pg8::StaticOrder S; S.init(MP, DFF, G, bid);
            epi::EpiUp E{(bf16*)(ws + WS_HMID), (const float*)(ws + WS_SSB)};
            pg8::gemm_phase<epi::EpiUp, pg8::StaticOrder, true, true>(Fg.lds, g, S, E, Fg.tid);
            TREG_SUB(99);
            {
                Frame Fs = fresh(F); const SEpiUp Es{(bf16*)(ws + WS_HMID), (const float*)(ws + WS_SSB)};
                for (int tl = Fs.bid; tl < 16 * 64; tl += Fs.G) sgemm_tile(Fs, (const bf16*)(ws + WS_XGB), DM, (const bf16*)(ws + WS_WUP + layer * SZ_WUP), DM, DM, MP + 32 * (tl & 15), 64 * (tl >> 4), Es);
            }
            TREG_SUB(33);
        }
        }
        GRID_BAR();
    TREG_MARK(7);
        for (int rp_ = 0; rp_ < PH_F; ++rp_) {
        {
            const Frame Fg = fresh(F); const int G = Fg.G, bid = Fg.bid;
            unsigned char* ws = KWS();
            pg8::Gemm g{(const bf16*)(ws + WS_HMID), (const bf16*)(ws + WS_WDN + layer * SZ_WDN), MP, DM, DFF, DFF, DFF, 31, 0};
            pg8::StaticOrder S; S.init(MP, DM, G, bid);
            epi::EpiRes E{(float*)(ws + WS_XR), (bf16*)(ws + WS_XGC), nullptr, nullptr, nullptr, (rp_ + 1 < PH_F) ? 3 : 0, (const float*)(ws + WS_XR)};
            pg8::gemm_phase<epi::EpiRes, pg8::StaticOrder, true, true>(Fg.lds, g, S, E, Fg.tid);
            TREG_SUB(99);
            if (rp_ + 1 == PH_F) {
                Frame Fs = fresh(F); const SEpiRes Es{(float*)(ws + WS_XR), (bf16*)(ws + WS_XGC), nullptr, nullptr, nullptr, 0, (const float*)(ws + WS_XR)};
                for (int tl = Fs.bid; tl < 256; tl += Fs.G) sgemm_tile(Fs, (const bf16*)(ws + WS_HMID), DFF, (const bf16*)(ws + WS_WDN + layer * SZ_WDN), DFF, DFF, MP + 32 * (tl & 15), 64 * (tl >> 4), Es);
            }
            TREG_SUB(34);
        }
        }
        GRID_BAR();
    TREG_MARK(8);
        for (int rp_ = 0; rp_ < PH_G1; ++rp_) {
        {
            const Frame Fg = fresh(F); const int G = Fg.G, bid = Fg.bid;
            unsigned char* ws = KWS();
            int kple = PLE; asm volatile("" : "+s"(kple));
            pg8::Gemm g{(const bf16*)(ws + WS_P16) + (size_t)layer * MROWS * PLE, (const bf16*)(ws + WS_WPL + layer * SZ_WPL), MP, DM, kple, PLE, PLE, 31, 0};
            pg8::StaticOrder S; S.init(MP, DM, G, bid);
            epi::EpiRes E{nullptr, nullptr, nullptr, nullptr, (float*)(ws + WS_TPLE), 1, nullptr};
            pg8::gemm_phase<epi::EpiRes, pg8::StaticOrder, true, true>(Fg.lds, g, S, E, Fg.tid);
            TREG_SUB(99);
            {
                Frame Fs = fresh(F); const SEpiRes Es{nullptr, nullptr, nullptr, nullptr, (float*)(ws + WS_TPLE), 1, nullptr};
                for (int tl = Fs.bid; tl < 256; tl += Fs.G) sgemm_tile(Fs, (const bf16*)(ws + WS_P16) + (size_t)layer * MROWS * PLE, PLE, (const bf16*)(ws + WS_WPL + layer * SZ_WPL), PLE, PLE, MP + 32 * (tl & 15), 64 * (tl >> 4), Es);
            }
            TREG_SUB(35);
        }
        }
        for (int rp_ = 0; rp_ < PH_G2; ++rp_) {
        {
            const Frame Fg = fresh(F); const int G = Fg.G, bid = Fg.bid;
            unsigned char* ws = KWS();
            const bool more = layer + 1 < NLAYER;
            pg8::Gemm g{(const bf16*)(ws + WS_XGC), (const bf16*)(ws + WS_WPG + layer * SZ_WPG), MP, DM, DM, DM, DM, 31, 0};
            pg8::StaticOrder S; S.init(MP, DM, G, bid);
            epi::EpiRes E{(float*)(ws + WS_XR), more ? (bf16*)(ws + WS_XGA) : nullptr, more ? KIN(10) + (layer + 1) * DM : nullptr, more ? (float*)(ws + WS_SSA) : nullptr, (float*)(ws + WS_TPLE), (rp_ + 1 < PH_G2) ? 3 : 2, (const float*)(ws + WS_XR)};
            pg8::gemm_phase<epi::EpiRes, pg8::StaticOrder, true, true>(Fg.lds, g, S, E, Fg.tid);
            TREG_SUB(99);
            if (rp_ + 1 == PH_G2) {
                Frame Fs = fresh(F); const SEpiRes Es{(float*)(ws + WS_XR), more ? (bf16*)(ws + WS_XGA) : nullptr, more ? KIN(10) + (layer + 1) * DM : nullptr, more ? (float*)(ws + WS_SSA) : nullptr, (float*)(ws + WS_TPLE), 2, (const float*)(ws + WS_XR)};
                for (int tl = Fs.bid; tl < 256; tl += Fs.G) sgemm_tile(Fs, (const bf16*)(ws + WS_XGC), DM, (const bf16*)(ws + WS_WPG + layer * SZ_WPG), DM, DM, MP + 32 * (tl & 15), 64 * (tl >> 4), Es);
            }
            TREG_SUB(36);
        }
        }
        GRID_BAR();
    TREG_MARK(9);
    }
    for (int xb_ = 0; xb_ < PH_XBAR; ++xb_) GRID_BAR();
    { Frame Fp = fresh(F); for (int r = Fp.bid * NWAVES + Fp.wave; r < MROWS; r += Fp.G * NWAVES) final_row(Fp, r); }
    TREG_MARK(10);
#if PH_TREG >= 0
#if defined(PH_GPT) && PH_GPT >= 0
    tacc_ += *(volatile LAS unsigned long long*)(F.lds + LDSCTL_OFF + 448);
#endif
#if defined(PH_NPT) && PH_NPT >= 0
    tacc_ += *(volatile LAS unsigned long long*)(F.lds + LDSCTL_OFF + 464);
#endif
      { const unsigned long long tend_ = __builtin_amdgcn_s_memrealtime() + tacc_; while (__builtin_amdgcn_s_memrealtime() < tend_) __builtin_amdgcn_s_sleep(8); }
#endif
}

extern "C" void kernel_launch(void* const* d_in, const int* in_sizes, int n_in, void* d_out, int out_size, void* d_ws, size_t ws_size, hipStream_t stream) {
    static int grid = 0;
    if (grid == 0) {
        if (n_in != 27 || ws_size < WS_END) { fprintf(stderr, "kernel_launch: unexpected shapes (n_in %d out %d ws %zu, need %zu)\n", n_in, out_size, ws_size, (size_t)WS_END); grid = -1; return; }
        int dev = 0, cus = 0;
        if (hipGetDevice(&dev) != hipSuccess || hipDeviceGetAttribute(&cus, hipDeviceAttributeMultiprocessorCount, dev) != hipSuccess) { grid = -1; return; }
        if (hipFuncSetAttribute((const void*)mk_fwd, hipFuncAttributeMaxDynamicSharedMemorySize, LDS_BYTES) != hipSuccess) { fprintf(stderr, "kernel_launch: hipFuncSetAttribute failed\n"); grid = -1; return; }
        int per_cu = 0;
        if (hipOccupancyMaxActiveBlocksPerMultiprocessor(&per_cu, (const void*)mk_fwd, NTHREADS, LDS_BYTES) != hipSuccess || per_cu < 1) fprintf(stderr, "kernel_launch: occupancy query reports %d\n", per_cu);
        (void)hipGetLastError();
        grid = cus;
    }
    if (grid < 0) return;
    if (hipMemsetAsync((char*)d_ws + WS_CTL, 0, CTL_ZERO_BYTES, stream) != hipSuccess) return;
    Args a{};
    for (int i = 0; i < 27; ++i) a.in[i] = d_in[i];
    a.out = (float*)d_out; a.ws = (unsigned char*)d_ws;
    hipLaunchKernelGGL(mk_fwd, dim3(grid), dim3(NTHREADS), LDS_BYTES, stream, a);
}
```

```cpp
#include <hip/hip_runtime.h>
#include <cstdio>
#include <cstdint>
namespace pg8 {
#define PG8_LAS __attribute__((address_space(3)))
typedef unsigned short bf16_t;
typedef short bf16x8 __attribute__((ext_vector_type(8)));
typedef float f32x4 __attribute__((ext_vector_type(4)));
typedef unsigned u32x4 __attribute__((ext_vector_type(4)));
constexpr int BM = 256, BK = 64, HALF = 128, HTB = HALF * BK * 2  , STAGE_BYTES = 8 * HTB, NXCD = 8, WGM = 8;

__host__ __device__ __forceinline__ int lds_byte(int r, int c) { const int st = (r >> 4) * 2 + (c >> 5), rr = r & 15, cc = c & 31, ob = rr * 64 + cc * 2; return st * 1024 + (ob ^ (((ob >> 9) & 1) << 5)); }
__host__ __device__ __forceinline__ void stage_rc(int b, int& R, int& C) { const int st = b / 1024, sb = b % 1024, swz = sb ^ (((sb >> 9) & 1) << 5); R = (st >> 1) * 16 + swz / 64; C = (st & 1) * 32 + (swz % 64) / 2; }
__host__ __device__ __forceinline__ int perm32(int rho) { const int n = rho >> 4, i = rho & 15; return 8 * (i >> 2) + 4 * n + (i & 3); }

struct Unit { int pm, pn; };
struct Gemm { const bf16_t* A; const bf16_t* Bt; int M, N, K; int lda, ldb; int a_shift, a_off; };

struct StaticOrder {
    int nM, nN, nwg, G, c;
    __host__ __device__ void init(int M, int N, int G_, int c_) { nM = M / BM; nN = N / BM; nwg = nM * nN; G = G_; c = c_; }
    __host__ __device__ bool next(int i, Unit& u) const {
        const long L = (long)i * G + c; if (L >= nwg) return false;
        int wgid = (int)L; { const int q = nwg / NXCD, r = nwg % NXCD, xcd = wgid % NXCD, off = wgid / NXCD; wgid = (xcd < r ? xcd * (q + 1) : r * (q + 1) + (xcd - r) * q) + off; }
        const int nig = WGM * nN, gid = wgid / nig, fm = gid * WGM, gsz = (nM - fm) < WGM ? (nM - fm) : WGM;
        u.pm = fm + ((wgid % nig) % gsz); u.pn = (wgid % nig) / gsz; return true;
    }
    __device__ __forceinline__ void a_ready(const Unit&) const {}
    __device__ __forceinline__ void done(const Unit&) const {}
};

__device__ __forceinline__ unsigned cvt_pk_bf16(float lo, float hi) { unsigned r; asm volatile("v_cvt_pk_bf16_f32 %0, %1, %2" : "=v"(r) : "v"(lo), "v"(hi)); return r; }
typedef float f32x2 __attribute__((ext_vector_type(2)));
template <class Epi, class Sched, bool ALIGN_EPI = false, bool SP2 = false>
__device__ __forceinline__ void gemm_phase(PG8_LAS unsigned char* lds, const Gemm g, const Sched& S, const Epi& E, const int tid) {
    const int wid = __builtin_amdgcn_readfirstlane(tid >> 6), lane = tid & 63, wr = wid >> 2, wc = wid & 3, fr = lane & 15, fq = lane >> 4;
    const int K = g.K, nt = K / BK;
    unsigned voffA[2], voffB[2];
#pragma unroll
    for (int i = 0; i < 2; ++i) { int R, C; stage_rc(tid * 16 + i * 8192, R, C); const int Rb = Epi::PERM ? ((R & ~31) + perm32(R & 31)) : R;
        voffA[i] = (unsigned)(R * g.lda + C) * 2u; voffB[i] = (unsigned)(Rb * g.ldb + C) * 2u; }
    const size_t kstep = (size_t)(BK * 2);
    const size_t hstepA = (size_t)HALF * g.lda * 2, hstepB = (size_t)HALF * g.ldb * 2;
    const size_t tstepA = 2 * hstepA, tstepB = 2 * hstepB;
    const unsigned ldsw = (unsigned)wid * 1024u;
    const int aoff = lds_byte(wr * 64 + fr, fq * 8), boff = lds_byte(wc * 32 + fr, fq * 8);
#define PG8_SA(b, h) (((b) * 2 + (h)) * HTB)
#define PG8_SB(b, h) ((4 + (b) * 2 + (h)) * HTB)
#define PG8_STAGE(bufoff, gbase, voff) do { _Pragma("unroll") for (int _i = 0; _i < 2; ++_i) \
        __builtin_amdgcn_global_load_lds((const unsigned*)((const char*)(gbase) + (voff)[_i]), (PG8_LAS unsigned*)(lds + (bufoff) + ldsw + _i * 8192), 16, 0, 0); } while (0)
#define PG8_LDA(dst, b, h) do { _Pragma("unroll") for (int m = 0; m < 4; ++m) _Pragma("unroll") for (int k = 0; k < 2; ++k) dst[m][k] = *(const PG8_LAS bf16x8*)(lds + PG8_SA(b, h) + aoff + m * 2048 + k * 1024); } while (0)
#define PG8_LDB(dst, b, h) do { _Pragma("unroll") for (int n = 0; n < 2; ++n) _Pragma("unroll") for (int k = 0; k < 2; ++k) dst[n][k] = *(const PG8_LAS bf16x8*)(lds + PG8_SB(b, h) + boff + n * 2048 + k * 1024); } while (0)
#define PG8_MMA(ai, bj, At, Bt) do { __builtin_amdgcn_s_setprio(1); _Pragma("unroll") for (int m = 0; m < 4; ++m) _Pragma("unroll") for (int n = 0; n < 2; ++n) _Pragma("unroll") for (int k = 0; k < 2; ++k) \
        acc[ai][bj][m][n] = __builtin_amdgcn_mfma_f32_16x16x32_bf16(Bt[n][k], At[m][k], acc[ai][bj][m][n], 0, 0, 0); __builtin_amdgcn_s_setprio(0); } while (0)
#define PG8_WAIT_V(n) asm volatile("s_waitcnt vmcnt(" #n ")" ::: "memory")
#define PG8_WAIT_L(n) asm volatile("s_waitcnt lgkmcnt(" #n ")" ::: "memory")
#define PG8_BAR __builtin_amdgcn_s_barrier()
#define PG8_SCHED __builtin_amdgcn_sched_barrier(0)
    Unit cur, nxt; int ui = 0;
    if (!S.next(0, cur)) return;
    f32x4 acc[2][2][4][2];
#pragma unroll
    for (int a = 0; a < 2; ++a)
#pragma unroll
        for (int b = 0; b < 2; ++b)
#pragma unroll
            for (int m = 0; m < 4; ++m)
#pragma unroll
                for (int n = 0; n < 2; ++n) acc[a][b][m][n] = (f32x4){0.f, 0.f, 0.f, 0.f};
    bf16x8 At[4][2], B0[2][2], B1[2][2];
    const char* cA = (const char*)g.A + (size_t)cur.pm * tstepA + (size_t)(cur.pn >> g.a_shift) * (size_t)g.a_off; const char* cB = (const char*)g.Bt + (size_t)cur.pn * tstepB;
    S.a_ready(cur);
    if constexpr (SP2) {
        PG8_STAGE(PG8_SB(0, 0), cB, voffB); PG8_STAGE(PG8_SB(0, 1), cB + hstepB, voffB); PG8_STAGE(PG8_SA(0, 0), cA, voffA); PG8_STAGE(PG8_SA(0, 1), cA + hstepA, voffA);
        if (wr == 1) PG8_BAR;
        PG8_WAIT_V(2); PG8_BAR;
        PG8_STAGE(PG8_SB(1, 0), cB + kstep, voffB); PG8_STAGE(PG8_SA(1, 0), cA + kstep, voffA); PG8_STAGE(PG8_SB(1, 1), cB + hstepB + kstep, voffB);
        PG8_WAIT_V(6); PG8_BAR;
    } else {
        PG8_STAGE(PG8_SB(0, 0), cB, voffB); PG8_STAGE(PG8_SA(0, 0), cA, voffA); PG8_STAGE(PG8_SB(0, 1), cB + hstepB, voffB); PG8_STAGE(PG8_SA(0, 1), cA + hstepA, voffA);
        if (wr == 1) PG8_BAR;
        PG8_WAIT_V(4); PG8_BAR;
        PG8_STAGE(PG8_SB(1, 0), cB + kstep, voffB); PG8_STAGE(PG8_SA(1, 0), cA + kstep, voffA); PG8_STAGE(PG8_SB(1, 1), cB + hstepB + kstep, voffB);
        PG8_WAIT_V(6); PG8_BAR;
    }
    for (;;) {
        const bool has_next = S.next(ui + 1, nxt);
        const char* nA = has_next ? (const char*)g.A + (size_t)nxt.pm * tstepA + (size_t)(nxt.pn >> g.a_shift) * (size_t)g.a_off : cA; const char* nB = has_next ? (const char*)g.Bt + (size_t)nxt.pn * tstepB : cB;
        for (int t = 0; t < nt; t += 2) {
            const bool last = (t == nt - 2);
            const char* a1 = cA + (size_t)(t + 1) * kstep;
            const char* a2 = last ? nA : cA + (size_t)(t + 2) * kstep; const char* b2 = last ? nB : cB + (size_t)(t + 2) * kstep;
            const char* a3 = a2 + kstep; const char* b3 = b2 + kstep;
            if (last && has_next) S.a_ready(nxt);
            if constexpr (SP2) {
            PG8_LDB(B0, 0, 0); PG8_LDB(B1, 0, 1); PG8_SCHED; PG8_LDA(At, 0, 0); PG8_STAGE(PG8_SA(1, 1), a1 + hstepA, voffA);
            PG8_WAIT_V(8); PG8_WAIT_L(0); PG8_BAR; PG8_MMA(0, 0, At, B0); PG8_MMA(0, 1, At, B1); PG8_BAR; PG8_SCHED;
            PG8_LDA(At, 0, 1); PG8_STAGE(PG8_SB(0, 0), b2, voffB); PG8_STAGE(PG8_SB(0, 1), b2 + hstepB, voffB); PG8_STAGE(PG8_SA(0, 0), a2, voffA);
            PG8_WAIT_V(8); PG8_WAIT_L(0); PG8_BAR; PG8_MMA(1, 0, At, B0); PG8_MMA(1, 1, At, B1); PG8_BAR; PG8_SCHED;
            PG8_LDB(B0, 1, 0); PG8_LDB(B1, 1, 1); PG8_SCHED; PG8_LDA(At, 1, 0); PG8_STAGE(PG8_SA(0, 1), a2 + hstepA, voffA);
            PG8_WAIT_V(8); PG8_WAIT_L(0); PG8_BAR; PG8_MMA(0, 0, At, B0); PG8_MMA(0, 1, At, B1); PG8_BAR; PG8_SCHED;
            PG8_LDA(At, 1, 1); PG8_STAGE(PG8_SB(1, 0), b3, voffB); PG8_STAGE(PG8_SB(1, 1), b3 + hstepB, voffB); PG8_STAGE(PG8_SA(1, 0), a3, voffA);
            PG8_WAIT_V(8); PG8_WAIT_L(0); PG8_BAR; PG8_MMA(1, 0, At, B0); PG8_MMA(1, 1, At, B1); PG8_BAR; PG8_SCHED;
            } else {
            PG8_LDB(B0, 0, 0); PG8_SCHED; PG8_LDA(At, 0, 0); PG8_STAGE(PG8_SA(1, 1), a1 + hstepA, voffA);
            PG8_WAIT_L(8); PG8_BAR; PG8_WAIT_L(0); PG8_MMA(0, 0, At, B0); PG8_BAR; PG8_SCHED;
            PG8_LDB(B1, 0, 1); PG8_STAGE(PG8_SB(0, 0), b2, voffB);
            PG8_BAR; PG8_WAIT_L(0); PG8_MMA(0, 1, At, B1); PG8_BAR;
            PG8_LDA(At, 0, 1); PG8_STAGE(PG8_SA(0, 0), a2, voffA);
            PG8_BAR; PG8_WAIT_L(0); PG8_MMA(1, 0, At, B0); PG8_BAR; PG8_SCHED;
            PG8_STAGE(PG8_SB(0, 1), b2 + hstepB, voffB);
            PG8_WAIT_V(6); PG8_BAR; PG8_MMA(1, 1, At, B1); PG8_BAR;
            PG8_LDB(B0, 1, 0); PG8_SCHED; PG8_LDA(At, 1, 0); PG8_STAGE(PG8_SA(0, 1), a2 + hstepA, voffA);
            PG8_WAIT_L(8); PG8_BAR; PG8_WAIT_L(0); PG8_MMA(0, 0, At, B0); PG8_BAR; PG8_SCHED;
            PG8_LDB(B1, 1, 1); PG8_STAGE(PG8_SB(1, 0), b3, voffB);
            PG8_BAR; PG8_WAIT_L(0); PG8_MMA(0, 1, At, B1); PG8_BAR;
            PG8_LDA(At, 1, 1); PG8_STAGE(PG8_SA(1, 0), a3, voffA);
            PG8_BAR; PG8_WAIT_L(0); PG8_MMA(1, 0, At, B0); PG8_BAR; PG8_SCHED;
            PG8_STAGE(PG8_SB(1, 1), b3 + hstepB, voffB);
            PG8_WAIT_V(6); PG8_BAR; PG8_MMA(1, 1, At, B1); PG8_BAR;
            }
        }
        if constexpr (ALIGN_EPI) { if (wr == 0) PG8_BAR; }
        if constexpr (!Epi::AFTER_DRAIN) { E(acc, cur, wr, wc, fr, fq); S.done(cur); }
        if (!has_next) break;
#pragma unroll
        for (int a = 0; a < 2; ++a)
#pragma unroll
            for (int b = 0; b < 2; ++b)
#pragma unroll
                for (int m = 0; m < 4; ++m)
#pragma unroll
                    for (int n = 0; n < 2; ++n) acc[a][b][m][n] = (f32x4){0.f, 0.f, 0.f, 0.f};
        cur = nxt; cA = nA; cB = nB; ++ui;
        if constexpr (ALIGN_EPI) { if (wr == 1) PG8_BAR; }
    }
    PG8_WAIT_V(0);
    if constexpr (!ALIGN_EPI) { if (wr == 0) PG8_BAR; }
    PG8_BAR;
    if constexpr (Epi::AFTER_DRAIN) { E.fused(acc, cur, wr, wc, fr, fq, lds, wid, lane); S.done(cur); }
#undef PG8_SA
#undef PG8_SB
#undef PG8_STAGE
#undef PG8_LDA
#undef PG8_LDB
#undef PG8_MMA
#undef PG8_WAIT_V
#undef PG8_WAIT_L
#undef PG8_BAR
#undef PG8_SCHED
}
}
#define DI __device__ __forceinline__
#define GAS __attribute__((address_space(1)))
#define LAS __attribute__((address_space(3)))
typedef unsigned short bf16;
typedef unsigned v4u __attribute__((ext_vector_type(4)));
typedef unsigned v2u __attribute__((ext_vector_type(2)));
typedef float f32x4 __attribute__((ext_vector_type(4)));
typedef float f32x2 __attribute__((ext_vector_type(2)));
typedef short bf16x8 __attribute__((ext_vector_type(8)));
typedef short s16x4 __attribute__((ext_vector_type(4)));
typedef GAS unsigned gu32;

constexpr int DM = 1024, TP = 8192, MP = 16384, MS = 512, MROWS = 16896, LDZ = 8704, DFF = 4096, PLE = 256, NLAYER = 2;
constexpr int ZC_Q = 0, ZC_KC = 512, ZC_VC = 640, ZC_KS = 768, ZC_VS = 896, ZC_KW = 1024, ZC_VW = 1152, ZC_GQKV = 1280, ZC_GZ = 2816, ZC_RQKV = 3328, ZC_RG = 4864, ZC_MG = 5376, ZC_SM = 8448;
constexpr float EPS = 1e-6f;
constexpr size_t O_YP = 0, O_YS = O_YP + (size_t)MP * DM, O_KVP = O_YS + (size_t)MS * DM, O_KVS = O_KVP + (size_t)2 * MP * 512, O_WINP = O_KVS + (size_t)2 * MS * 512,
                 O_WINS = O_WINP + (size_t)2 * 2 * 512 * 256, O_CVP = O_WINS + (size_t)2 * 128 * 512 * 256, O_CVS = O_CVP + (size_t)2 * 2 * 3 * 1536, O_GSP = O_CVS + (size_t)2 * 128 * 3 * 1536,
                 O_GSS = O_GSP + (size_t)2 * 2 * 4 * 16384, O_RSP = O_GSS + (size_t)2 * 128 * 4 * 16384, O_RSS = O_RSP + (size_t)2 * 2 * 4 * 16384, O_END = O_RSS + (size_t)2 * 128 * 4 * 16384;

DI float bf2f(unsigned short b) { return __uint_as_float((unsigned)b << 16); }
DI unsigned f2bf(float f) { unsigned u = __float_as_uint(f); return (u + 0x7fffu + ((u >> 16) & 1u)) >> 16; }
typedef __bf16 bf16x2_t __attribute__((ext_vector_type(2)));
DI unsigned pk2(float lo, float hi) { const f32x2 v = {lo, hi}; return __builtin_bit_cast(unsigned, __builtin_convertvector(v, bf16x2_t)); }
DI float lo_bf(unsigned w) { return __uint_as_float(w << 16); }
DI float hi_bf(unsigned w) { return __uint_as_float(w & 0xffff0000u); }
DI float sigmoidf_(float x) { return 1.f / (1.f + __expf(-x)); }
DI float siluf_(float x) { return x / (1.f + __expf(-x)); }
DI v4u pack8(const f32x4 a, const f32x4 b) { v4u w; w.x = pk2(a[0], a[1]); w.y = pk2(a[2], a[3]); w.z = pk2(b[0], b[1]); w.w = pk2(b[2], b[3]); return w; }
DI void unpack8(const v4u w, f32x4& a, f32x4& b) { a[0] = lo_bf(w.x); a[1] = hi_bf(w.x); a[2] = lo_bf(w.y); a[3] = hi_bf(w.y); b[0] = lo_bf(w.z); b[1] = hi_bf(w.z); b[2] = lo_bf(w.w); b[3] = hi_bf(w.w); }

template <int M> DI int shxi(int v, int lane) {
    if constexpr (M < 32) return __builtin_amdgcn_ds_swizzle(v, (M << 10) | 0x1f);
    else return __builtin_amdgcn_ds_bpermute((lane ^ 32) << 2, v);
}
template <int M> DI float shx(float v, int lane) { return __int_as_float(shxi<M>(__float_as_int(v), lane)); }
DI float wave_sum(float v, int lane) { v += shx<1>(v, lane); v += shx<2>(v, lane); v += shx<4>(v, lane); v += shx<8>(v, lane); v += shx<16>(v, lane); v += shx<32>(v, lane); return v; }

namespace epi {
using pg8::Unit; using pg8::bf16_t;
DI float row_rstd(const float* SS, int row, int fq, int lane) {
    const f32x4 p = *(const f32x4*)(SS + (size_t)row * 16 + 4 * fq);
    float s = (p[0] + p[1]) + (p[2] + p[3]); s += shx<16>(s, lane); s += shx<32>(s, lane);
    return rsqrtf(s * (1.f / DM) + EPS);
}
struct EpiA {
    static constexpr bool PERM = true, AFTER_DRAIN = false;
    bf16* Z; float* ZS; const float* SS; float* out; int layer;
    DI void operator()(const f32x4 (&acc)[2][2][4][2], const Unit& u, int wr, int wc, int fr, int fq) const {
        asm volatile("" : "+v"(fr), "+v"(fq), "+s"(wr), "+s"(wc));
        const int pn = u.pn;
        float rs[2][4];
#pragma unroll
        for (int ai = 0; ai < 2; ++ai)
#pragma unroll
            for (int m = 0; m < 4; ++m) rs[ai][m] = row_rstd(SS, u.pm * 256 + ai * 128 + wr * 64 + m * 16 + fr, fq, fr + 16 * fq);
#pragma unroll
        for (int ai = 0; ai < 2; ++ai)
#pragma unroll
            for (int m = 0; m < 4; ++m) {
                const int row = u.pm * 256 + ai * 128 + wr * 64 + m * 16 + fr;
                const float rstd = rs[ai][m];
#pragma unroll
                for (int bj = 0; bj < 2; ++bj) {
                    const int col = pn * 256 + bj * 128 + wc * 32 + 8 * fq;
                    const f32x4 v0 = acc[ai][bj][m][0] * rstd, v1 = acc[ai][bj][m][1] * rstd;
                    *(v4u*)(Z + (size_t)row * LDZ + col) = pack8(v0, v1);
                    float* dst = nullptr;
                    if (pn == 2 || pn == 3) {
                        dst = (row < MP) ? out + O_KVP + ((size_t)layer * MP + row) * 512 + (col - 512) : out + O_KVS + ((size_t)layer * MS + (row - MP)) * 512 + (col - 512);
                    } else if (pn == 4) {
                        const int c2 = col - 1024;
                        if (row < MP) { const int t = row & (TP - 1), b = row >> 13; if (t >= TP - 512) dst = out + O_WINP + ((size_t)(layer * 2 + b) * 512 + (t - (TP - 512))) * 256 + c2; }
                        else { const int r2 = row - MP, s = r2 >> 2, j = r2 & 3; dst = out + O_WINS + ((size_t)(layer * 128 + s) * 512 + 508 + j) * 256 + c2; }
                    } else if (pn >= 5 && pn < 11) {
                        const int c2 = col - 1280;
                        if (row < MP) { const int t = row & (TP - 1), b = row >> 13; if (t >= TP - 3) dst = out + O_CVP + ((size_t)(layer * 2 + b) * 3 + (t - (TP - 3))) * 1536 + c2; }
                        else { const int r2 = row - MP, s = r2 >> 2, j = r2 & 3; if (j >= 1) dst = out + O_CVS + ((size_t)(layer * 128 + s) * 3 + (j - 1)) * 1536 + c2; }
                    } else if (pn == 33) {
                        if (bj == 0 && wc == 0) dst = ZS + (size_t)row * 32 + 8 * fq;
                    }
                    if (dst) { *(f32x4*)dst = v0; *(f32x4*)(dst + 4) = v1; }
                }
                asm volatile("" ::: "memory");
            }
    }
};
struct EpiC {
    static constexpr bool PERM = true, AFTER_DRAIN = false;
    const bf16* Z; bf16* G;
    DI void operator()(const f32x4 (&acc)[2][2][4][2], const Unit& u, int wr, int wc, int fr, int fq) const {
        asm volatile("" : "+v"(fr), "+v"(fq), "+s"(wr), "+s"(wc));
#pragma unroll
        for (int ai = 0; ai < 2; ++ai) {
            v4u gw[4][2];
#pragma unroll
            for (int m = 0; m < 4; ++m)
#pragma unroll
                for (int bj = 0; bj < 2; ++bj) gw[m][bj] = *(const v4u*)(Z + (size_t)(u.pm * 256 + ai * 128 + wr * 64 + m * 16 + fr) * LDZ + ZC_MG + u.pn * 256 + bj * 128 + wc * 32 + 8 * fq);
#pragma unroll
            for (int m = 0; m < 4; ++m) {
                const int row = u.pm * 256 + ai * 128 + wr * 64 + m * 16 + fr;
#pragma unroll
                for (int bj = 0; bj < 2; ++bj) {
                    const int col = u.pn * 256 + bj * 128 + wc * 32 + 8 * fq;
                    f32x4 g0, g1; unpack8(gw[m][bj], g0, g1);
                    f32x4 v0 = acc[ai][bj][m][0], v1 = acc[ai][bj][m][1];
#pragma unroll
                    for (int e = 0; e < 4; ++e) { v0[e] *= sigmoidf_(g0[e]); v1[e] *= sigmoidf_(g1[e]); }
                    *(v4u*)(G + (size_t)row * 3072 + col) = pack8(v0, v1);
                }
            }
            asm volatile("" ::: "memory");
        }
    }
};
struct EpiCM {
    static constexpr bool PERM = true, AFTER_DRAIN = false;
    const bf16* Z; bf16* MRG; float* PART;
    DI void operator()(const f32x4 (&acc)[2][2][4][2], const Unit& u, int wr, int wc, int fr, int fq) const {
        asm volatile("" : "+v"(fr), "+v"(fq), "+s"(wr), "+s"(wc));
        const int b = u.pn >> 2, pn4 = u.pn & 3;
#pragma unroll
        for (int ai = 0; ai < 2; ++ai)
#pragma unroll
            for (int mp = 0; mp < 2; ++mp) {
                v4u gw[2][2];
#pragma unroll
                for (int mm = 0; mm < 2; ++mm)
#pragma unroll
                    for (int bj = 0; bj < 2; ++bj) gw[mm][bj] = *(const v4u*)(Z + (size_t)(u.pm * 256 + ai * 128 + wr * 64 + (2 * mp + mm) * 16 + fr) * LDZ + ZC_MG + b * 1024 + pn4 * 256 + bj * 128 + wc * 32 + 8 * fq);
#pragma unroll
                for (int mm = 0; mm < 2; ++mm) {
                    const int m = 2 * mp + mm;
                    const int row = u.pm * 256 + ai * 128 + wr * 64 + m * 16 + fr;
#pragma unroll
                    for (int bj = 0; bj < 2; ++bj) {
                        const int oc = pn4 * 256 + bj * 128 + wc * 32 + 8 * fq;
                        const size_t o = (size_t)row * DM + oc;
                        f32x4 g0, g1; unpack8(gw[mm][bj], g0, g1);
                        f32x4 v0 = acc[ai][bj][m][0], v1 = acc[ai][bj][m][1];
#pragma unroll
                        for (int e = 0; e < 4; ++e) { v0[e] *= sigmoidf_(g0[e]); v1[e] *= sigmoidf_(g1[e]); }
                        if (b > 0) { f32x4 p0, p1; unpack8(*(const v4u*)(MRG + o), p0, p1); v0 += p0; v1 += p1; }
                        *(v4u*)(MRG + o) = pack8(v0, v1);
                    }
                }
                asm volatile("" ::: "memory");
            }
    }
};
}
namespace pg8 {
struct BranchOrder {
    StaticOrder S1;
    __host__ __device__ void init(int M, int G_, int c_) { S1.init(M, 1024, G_, c_); }
    __host__ __device__ bool next(int i, Unit& u) const { if (i >= 3) return false; const bool ok = S1.next(0, u); u.pn += 4 * i; return ok; }
    __device__ __forceinline__ void a_ready(const Unit&) const {}
    __device__ __forceinline__ void done(const Unit&) const {}
};
}
namespace epi {
using pg8::Unit; using pg8::bf16_t;
struct EpiRes {
    static constexpr bool PERM = true, AFTER_DRAIN = false;
    float* XR; bf16* XG; const float* gvec; float* SS; float* T; int mode;
    const float* XRr;
    DI void operator()(const f32x4 (&acc)[2][2][4][2], const Unit& u, int wr, int wc, int fr, int fq) const {
        asm volatile("" : "+v"(fr), "+v"(fq), "+s"(wr), "+s"(wc));
        if (mode == 3) return;
        if (mode == 1) {
#pragma unroll
            for (int ai = 0; ai < 2; ++ai)
#pragma unroll
                for (int m = 0; m < 4; ++m)
#pragma unroll
                    for (int bj = 0; bj < 2; ++bj) { const size_t o = (size_t)(u.pm * 256 + ai * 128 + wr * 64 + m * 16 + fr) * DM + u.pn * 256 + bj * 128 + wc * 32 + 8 * fq;
                        *(v4u*)((bf16*)T + o) = pack8(acc[ai][bj][m][0], acc[ai][bj][m][1]); }
            return;
        }
#pragma unroll
        for (int ai = 0; ai < 2; ++ai)
#pragma unroll
            for (int mp = 0; mp < 2; ++mp) {
                f32x4 xr[2][2][2], tt[2][2][2];
#pragma unroll
                for (int mm = 0; mm < 2; ++mm)
#pragma unroll
                    for (int bj = 0; bj < 2; ++bj) { const size_t o = (size_t)(u.pm * 256 + ai * 128 + wr * 64 + (2 * mp + mm) * 16 + fr) * DM + u.pn * 256 + bj * 128 + wc * 32 + 8 * fq;
                        xr[mm][bj][0] = *(const f32x4*)(XRr + o); xr[mm][bj][1] = *(const f32x4*)(XRr + o + 4);
                        if (mode == 2) unpack8(*(const v4u*)((const bf16*)T + o), tt[mm][bj][0], tt[mm][bj][1]); }
#pragma unroll
                for (int mm = 0; mm < 2; ++mm) {
                    const int m = 2 * mp + mm;
                    const int row = u.pm * 256 + ai * 128 + wr * 64 + m * 16 + fr;
                    float ssq = 0.f;
#pragma unroll
                    for (int bj = 0; bj < 2; ++bj) {
                        const int col = u.pn * 256 + bj * 128 + wc * 32 + 8 * fq;
                        const size_t o = (size_t)row * DM + col;
                        f32x4 a0 = acc[ai][bj][m][0], a1 = acc[ai][bj][m][1];
                        f32x4 x0 = xr[mm][bj][0], x1 = xr[mm][bj][1];
                        if (mode == 2) {
#pragma unroll
                            for (int e = 0; e < 4; ++e) { a0[e] = tt[mm][bj][0][e] * sigmoidf_(a0[e]); a1[e] = tt[mm][bj][1][e] * sigmoidf_(a1[e]); } }
                        x0 += a0; x1 += a1;
                        *(f32x4*)(XR + o) = x0; *(f32x4*)(XR + o + 4) = x1;
                        ssq += (x0[0] * x0[0] + x0[1] * x0[1]) + (x0[2] * x0[2] + x0[3] * x0[3]) + (x1[0] * x1[0] + x1[1] * x1[1]) + (x1[2] * x1[2] + x1[3] * x1[3]);
                        if (XG) { if (gvec) { const f32x4 g0 = *(const f32x4*)(gvec + col), g1 = *(const f32x4*)(gvec + col + 4); x0 *= g0; x1 *= g1; }
                            *(v4u*)(XG + o) = pack8(x0, x1); }
                    }
                    if (SS) { ssq += shx<16>(ssq, fr + 16 * fq); ssq += shx<32>(ssq, fr + 16 * fq); if (fq == 0) SS[(size_t)row * 16 + u.pn * 4 + wc] = ssq; }
                }
                asm volatile("" ::: "memory");
            }
    }
};
struct EpiUp {
    static constexpr bool PERM = true, AFTER_DRAIN = false;
    bf16* H; const float* SS;
    DI void operator()(const f32x4 (&acc)[2][2][4][2], const Unit& u, int wr, int wc, int fr, int fq) const {
        asm volatile("" : "+v"(fr), "+v"(fq), "+s"(wr), "+s"(wc));
        float rs[2][4];
#pragma unroll
        for (int ai = 0; ai < 2; ++ai)
#pragma unroll
            for (int m = 0; m < 4; ++m) rs[ai][m] = row_rstd(SS, u.pm * 256 + ai * 128 + wr * 64 + m * 16 + fr, fq, fr + 16 * fq);
#pragma unroll
        for (int ai = 0; ai < 2; ++ai)
#pragma unroll
            for (int m = 0; m < 4; ++m) {
                const int row = u.pm * 256 + ai * 128 + wr * 64 + m * 16 + fr;
                const float rstd = rs[ai][m];
#pragma unroll
                for (int bj = 0; bj < 2; ++bj) {
                    const int col = u.pn * 256 + bj * 128 + wc * 32 + 8 * fq;
                    f32x4 v0 = acc[ai][bj][m][0] * rstd, v1 = acc[ai][bj][m][1] * rstd;
#pragma unroll
                    for (int e = 0; e < 4; ++e) { const float a = fmaxf(v0[e], 0.f), b = fmaxf(v1[e], 0.f); v0[e] = a * a; v1[e] = b * b; }
                    *(v4u*)(H + (size_t)row * DFF + col) = pack8(v0, v1);
                }
                asm volatile("" ::: "memory");
            }
    }
};
}
constexpr size_t al256(size_t x) { return (x + 255) & ~(size_t)255; }
constexpr size_t WS_CTL = 0, CTL_ZERO_BYTES = 1u << 20;
constexpr size_t SZ_WIN = (size_t)LDZ * DM * 2, SZ_WBR = (size_t)3072 * 512 * 2, SZ_WO3 = (size_t)DM * 3072 * 2, SZ_WUP = (size_t)DFF * DM * 2, SZ_WDN = (size_t)DM * DFF * 2,
                 SZ_WPL = (size_t)DM * PLE * 2, SZ_WPG = (size_t)DM * DM * 2, SZ_W1T = (size_t)2 * 64 * 2048 * 2, SZ_W2T = (size_t)2 * 64 * 64 * 2;
constexpr size_t WS_WIN = CTL_ZERO_BYTES, WS_WBR = WS_WIN + 2 * SZ_WIN, WS_WO3 = WS_WBR + 2 * SZ_WBR, WS_WUP = WS_WO3 + 2 * SZ_WO3, WS_WDN = WS_WUP + 2 * SZ_WUP,
                 WS_WPL = WS_WDN + 2 * SZ_WDN, WS_WPG = WS_WPL + 2 * SZ_WPL, WS_W1T = WS_WPG + 2 * SZ_WPG, WS_W2T = WS_W1T + 2 * SZ_W1T, WS_ROT = al256(WS_W2T + 2 * SZ_W2T);
constexpr size_t WS_P16 = WS_ROT + (size_t)TP * 64 * 8;
constexpr size_t WS_XR = WS_P16 + (size_t)2 * MROWS * PLE * 2;
constexpr size_t WS_XGA = WS_XR + (size_t)MROWS * DM * 4, WS_XGB = WS_XGA + (size_t)MROWS * DM * 2, WS_XGC = WS_XGB + (size_t)MROWS * DM * 2;
constexpr size_t WS_SSA = WS_XGC + (size_t)MROWS * DM * 2, WS_SSB = WS_SSA + (size_t)MROWS * 64;
constexpr size_t WS_Z = WS_SSB + (size_t)MROWS * 64, WS_ZS = WS_Z + (size_t)MROWS * LDZ * 2;
constexpr size_t WS_MIX = WS_ZS + (size_t)MROWS * 128, WS_GATED = WS_MIX + (size_t)MROWS * 1536 * 2, WS_HMID = WS_GATED + (size_t)MROWS * 3072 * 2;
constexpr size_t WS_TPLE = WS_HMID + (size_t)MROWS * DFF * 2;
constexpr size_t WS_KC = WS_TPLE + (size_t)MROWS * DM * 4;
constexpr size_t WS_KCS = WS_KC + (size_t)2 * 2 * 512 * 2 * 64 * 2;
constexpr int GREC = 73984;
constexpr size_t WS_GREC = WS_KCS + (size_t)2 * 128 * 128 * 2 * 64 * 2;
constexpr size_t WS_OGDN = WS_GREC + (size_t)1024 * GREC;
constexpr size_t WS_RKV = WS_OGDN + (size_t)MROWS * 512 * 4;
constexpr size_t WS_RST = WS_RKV + (size_t)512 * 16384 * 4;
constexpr size_t WS_QR = WS_RST + (size_t)512 * 16384 * 2, WS_KR = WS_QR + (size_t)MP * 512 * 2;
constexpr size_t WS_MRG = WS_KR + (size_t)MP * 512 * 2;
constexpr size_t WS_PART = WS_MRG + (size_t)MP * DM * 2;
constexpr size_t WS_END = WS_PART + (size_t)MP * DM * 4;
static_assert(WS_W1T % 256 == 0 && WS_Z % 256 == 0 && WS_GREC % 256 == 0 && WS_RKV % 256 == 0 && WS_KC % 256 == 0 && WS_XR % 256 == 0, "ws alignment");

constexpr int CW_TMO = 0, CW_BAR = 4096, CW_QUEUE = 8192;
constexpr int NWAVES = 8, NTHREADS = 512;
constexpr int RING_BYTES = 147456, LDSCTL_OFF = RING_BYTES, MISC_OFF = LDSCTL_OFF + 320, LDS_BYTES = RING_BYTES + 1024;

#define RLX_AGENT __ATOMIC_RELAXED, __HIP_MEMORY_SCOPE_AGENT
#define LDS_WAIT() asm volatile("s_waitcnt lgkmcnt(0)" ::: "memory")
#define VM_WAIT() asm volatile("s_waitcnt vmcnt(0)" ::: "memory")
#define XB_TMO      128
#define XB_XCNT(j)  (256  + 64 * (j))
#define XB_XSUB(j)  (1280 + 64 * (j))
#define XB_XGEN(j)  (2304 + 64 * (j))
#define XB_TOP      3328
#define XB_TOPGEN   3392
#define XCD_BAR_WORDS 3456
#define XB_SPIN_CAP (1u << 18)

__device__ __forceinline__ unsigned xb_ld(unsigned* p)              { return __hip_atomic_load(p, __ATOMIC_RELAXED, __HIP_MEMORY_SCOPE_AGENT); }
__device__ __forceinline__ unsigned xb_add(unsigned* p, unsigned v) { return __hip_atomic_fetch_add(p, v, __ATOMIC_RELAXED, __HIP_MEMORY_SCOPE_AGENT); }
__device__ __forceinline__ unsigned xb_xcc_id() { return (unsigned)__builtin_amdgcn_s_getreg((3 << 11) | 20) & 0xFu; }
#define XB_SPIN(cond, bar) do { unsigned _sp = 0; while (cond) { __builtin_amdgcn_s_sleep(1); \
    if ((++_sp & 255u) == 0u) { if (xb_ld(&(bar)[XB_TMO])) break; if (_sp > XB_SPIN_CAP) { atomicAdd(&(bar)[XB_TMO], 1u); break; } } } } while (0)

struct XcdBarrier {
    unsigned* bar; unsigned x;
    volatile LAS unsigned* st;
};

__device__ __forceinline__ XcdBarrier xcd_barrier_post(unsigned* bar, volatile LAS unsigned* st, bool t0) {
    XcdBarrier b; b.bar = bar; b.x = xb_xcc_id(); b.st = st;
    if (t0) (void)xb_add(&bar[XB_XCNT(b.x)], 1u);
    return b;
}
__device__ __forceinline__ void xcd_barrier_complete(unsigned* bar, unsigned x, unsigned& nloc, unsigned& nx) {
    const unsigned G = gridDim.x * gridDim.y * gridDim.z;
    unsigned sum, cnt, mine, sp = 0u;
    for (;;) {
        sum = 0u; cnt = 0u; mine = 0u;
#pragma unroll
        for (unsigned j = 0; j < 16; ++j) { const unsigned c = xb_ld(&bar[XB_XCNT(j)]); sum += c; cnt += (c > 0u) ? 1u : 0u; mine = (j == x) ? c : mine; }
        if (sum == G) break;
        __builtin_amdgcn_s_sleep(1);
        if ((++sp & 255u) == 0u) { if (xb_ld(&bar[XB_TMO])) break; if (sp > XB_SPIN_CAP) { atomicAdd(&bar[XB_TMO], 1u); break; } }
    }
    nloc = mine > 0u ? mine : 1u; nx = cnt > 0u ? cnt : 1u;
}

__device__ __forceinline__ void xcd_barrier(const XcdBarrier& b, bool t0) {
    asm volatile("s_waitcnt vmcnt(0)" ::: "memory");
    __syncthreads();
    if (t0) {
        unsigned* bar = b.bar;
        __builtin_amdgcn_s_waitcnt(0);
        unsigned nloc = b.st[0], nx = b.st[1];
        if (nloc == 0u) { xcd_barrier_complete(bar, b.x, nloc, nx); b.st[0] = nloc; b.st[1] = nx; }
        const unsigned old = xb_add(&bar[XB_XSUB(b.x)], 1u);
        const unsigned gen = old / nloc;
        if (old + 1u == (gen + 1u) * nloc) {
            __builtin_amdgcn_fence(__ATOMIC_RELEASE, "agent");
            asm volatile("s_waitcnt vmcnt(0)" ::: "memory");
            const unsigned og = xb_add(&bar[XB_TOP], 1u);
            const unsigned tg = og / nx;
            if (og + 1u == (tg + 1u) * nx) xb_add(&bar[XB_TOPGEN], 1u);
            else XB_SPIN(xb_ld(&bar[XB_TOPGEN]) == tg, bar);
            __builtin_amdgcn_fence(__ATOMIC_ACQUIRE, "agent");
            xb_add(&bar[XB_XGEN(b.x)], 1u);
            asm volatile("s_waitcnt vmcnt(0)" ::: "memory");
        } else {
            XB_SPIN(xb_ld(&bar[XB_XGEN(b.x)]) == gen, bar);
            __builtin_amdgcn_fence(__ATOMIC_ACQUIRE, "agent");
            asm volatile("s_waitcnt vmcnt(0)" ::: "memory");
        }
    }
    __syncthreads();
}
typedef const void* const __attribute__((address_space(4)))* kargp_t;
DI const float* KIN(int i) { const GAS float* p = (const GAS float*)((kargp_t)__builtin_amdgcn_kernarg_segment_ptr())[i]; asm volatile("" : "+s"(p)); return (const float*)p; }
DI float* KOUT() { GAS float* p = (GAS float*)((kargp_t)__builtin_amdgcn_kernarg_segment_ptr())[27]; asm volatile("" : "+s"(p)); return (float*)p; }
DI unsigned char* KWS() { GAS unsigned char* p = (GAS unsigned char*)((kargp_t)__builtin_amdgcn_kernarg_segment_ptr())[28]; asm volatile("" : "+s"(p)); return (unsigned char*)p; }
struct Frame {
    LAS unsigned char* lds;
    gu32* ctl;
    int tid, lane, wave, G, bid;
};
DI bf16x8 ld_frag_g(const bf16* p) { return __builtin_bit_cast(bf16x8, *(const v4u*)p); }
DI bf16x8 ld_frag_l(const LAS unsigned char* p) { return *(const LAS bf16x8*)p; }
DI f32x4 mfma16(bf16x8 a, bf16x8 b, f32x4 c) { return __builtin_amdgcn_mfma_f32_16x16x32_bf16(a, b, c, 0, 0, 0); }
DI bf16x8 pack_frag(const f32x4 a, const f32x4 b) { return __builtin_bit_cast(bf16x8, pack8(a, b)); }
DI int lane_id() { int l; asm volatile("v_mbcnt_lo_u32_b32 %0, -1, 0\n\tv_mbcnt_hi_u32_b32 %0, -1, %0" : "=v"(l)); return l; }
DI Frame fresh(const Frame& F0) {
    Frame F = F0; int w = F0.wave, g = F0.G, b = F0.bid; asm volatile("" : "+s"(w), "+s"(g), "+s"(b));
    int l = lane_id(); asm volatile("" : "+v"(l));
    unsigned lb = (unsigned)(uintptr_t)F0.lds; asm volatile("" : "+s"(lb)); F.lds = (LAS unsigned char*)(uintptr_t)lb;
    F.wave = w; F.lane = l; F.tid = w * 64 + l; F.G = g; F.bid = b; return F;
}
#define GRID_BAR() do { XcdBarrier b_; b_.bar = (unsigned*)((gu32*)(KWS() + WS_CTL) + CW_BAR); b_.x = xb_xcc_id(); b_.st = (volatile LAS unsigned*)(F.lds + MISC_OFF) + 8; \
    const Frame Fb_ = fresh(F); xcd_barrier(b_, Fb_.tid == 0); } while (0)
DI int win_colmap(int j) {
    if (j < 1280) return j; if (j < 2816) return j + 24; if (j < 8448) return j + 32; if (j < 8472) return j - 8448 + 1280; if (j < 8480) return j - 8472 + 2840; return -1;
}
DI void tr_item(const float* W, int ldw, int k0, int srccol, bf16* WT, size_t dst_row0, int ldt, int kdst0, int nrep, int krep, LAS float* scr, int lane) {
#pragma unroll 8
    for (int i = 0; i < 32; ++i) { const int kk = 2 * i + (lane >> 5); const float v_ = W[(size_t)(k0 + kk) * ldw + (srccol >= 0 ? srccol : 0)]; scr[kk * 33 + (lane & 31)] = (srccol >= 0) ? v_ : 0.f; }
    LDS_WAIT(); asm volatile("" ::: "memory");
    const int c = lane & 7;
#pragma unroll
    for (int j = 0; j < 4; ++j) { const int n = (lane >> 3) + 8 * j; const LAS float* s = scr + (8 * c) * 33 + n;
        v4u o; o.x = pk2(s[0 * 33], s[1 * 33]); o.y = pk2(s[2 * 33], s[3 * 33]); o.z = pk2(s[4 * 33], s[5 * 33]); o.w = pk2(s[6 * 33], s[7 * 33]);
        for (int r = 0; r < nrep; ++r) *(v4u*)(WT + (dst_row0 + n) * (size_t)ldt + kdst0 + r * krep + 8 * c) = o; }
    LDS_WAIT(); asm volatile("" ::: "memory");
}
DI void p0_prologue(Frame& F) {
    LAS float* scr = (LAS float*)(F.lds + F.wave * 16384);
    const int gw = F.bid * NWAVES + F.wave, NGW = F.G * NWAVES, lane = F.lane;
    unsigned char* ws = KWS();
    constexpr int I_A = 16 * 272, I_B = 3 * 8 * 32, I_C = 16 * 32, I_D = 16 * 128, I_E = 64 * 32, I_F = 4 * 32, I_G = 16 * 32, I_H = 2 * 32 * 2, I_I = 2 * 2;
    constexpr int I_L = I_A + I_B + I_C + I_D + I_E + I_F + I_G + I_H + I_I;
    for (int it = gw; it < 2 * I_L; it += NGW) {
        const int l = it / I_L; int r = it % I_L;
        if (r < I_A) { const int kb = r / 272, nb = r % 272; tr_item(KIN(11) + (size_t)l * DM * 8480, 8480, 64 * kb, win_colmap(32 * nb + (lane & 31)), (bf16*)(ws + WS_WIN + l * SZ_WIN), 32 * nb, DM, 64 * kb, 1, 0, scr, lane); continue; } r -= I_A;
        if (r < I_B) { const int b = r / 256, kb = (r % 256) / 32, nb = r % 32; tr_item(KIN(19) + (size_t)(l * 3 + b) * 512 * DM, DM, 64 * kb, 32 * nb + (lane & 31), (bf16*)(ws + WS_WBR + l * SZ_WBR), b * 1024 + 32 * nb, 512, 64 * kb, 1, 0, scr, lane); continue; } r -= I_B;
        if (r < I_C) { const int kb = r / 32, nb = r % 32; tr_item(KIN(20) + (size_t)l * DM * DM, DM, 64 * kb, 32 * nb + (lane & 31), (bf16*)(ws + WS_WO3 + l * SZ_WO3), 32 * nb, 3072, 64 * kb, 3, 1024, scr, lane); continue; } r -= I_C;
        if (r < I_D) { const int kb = r / 128, nb = r % 128; tr_item(KIN(22) + (size_t)l * DM * DFF, DFF, 64 * kb, 32 * nb + (lane & 31), (bf16*)(ws + WS_WUP + l * SZ_WUP), 32 * nb, DM, 64 * kb, 1, 0, scr, lane); continue; } r -= I_D;
        if (r < I_E) { const int kb = r / 32, nb = r % 32; tr_item(KIN(23) + (size_t)l * DFF * DM, DM, 64 * kb, 32 * nb + (lane & 31), (bf16*)(ws + WS_WDN + l * SZ_WDN), 32 * nb, DFF, 64 * kb, 1, 0, scr, lane); continue; } r -= I_E;
        if (r < I_F) { const int kb = r / 32, nb = r % 32; tr_item(KIN(24) + (size_t)l * PLE * DM, DM, 64 * kb, 32 * nb + (lane & 31), (bf16*)(ws + WS_WPL + l * SZ_WPL), 32 * nb, PLE, 64 * kb, 1, 0, scr, lane); continue; } r -= I_F;
        if (r < I_G) { const int kb = r / 32, nb = r % 32; tr_item(KIN(25) + (size_t)l * DM * DM, DM, 64 * kb, 32 * nb + (lane & 31), (bf16*)(ws + WS_WPG + l * SZ_WPG), 32 * nb, DM, 64 * kb, 1, 0, scr, lane); continue; } r -= I_G;
        if (r < I_H) { const int kv = r / 64, kb = (r % 64) / 2, nb = r % 2; tr_item(KIN(13) + (size_t)(l * 2 + kv) * 2048 * 64, 64, 64 * kb, 32 * nb + (lane & 31), (bf16*)(ws + WS_W1T + l * SZ_W1T) + (size_t)kv * 64 * 2048, 32 * nb, 2048, 64 * kb, 1, 0, scr, lane); continue; } r -= I_H;
        { const int kv = r / 2, nb = r % 2; tr_item(KIN(14) + (size_t)(l * 2 + kv) * 64 * 64, 64, 0, 32 * nb + (lane & 31), (bf16*)(ws + WS_W2T + l * SZ_W2T) + (size_t)kv * 64 * 64, 32 * nb, 64, 0, 1, 0, scr, lane); }
    }
    bf16* XGA = (bf16*)(ws + WS_XGA); float* SSA = (float*)(ws + WS_SSA); bf16* P16 = (bf16*)(ws + WS_P16);
    const float* g0 = KIN(10);
    for (int row = gw; row < MROWS; row += NGW) {
        const float* xs = (row < MP) ? KIN(0) + (size_t)row * DM : KIN(1) + (size_t)(row - MP) * DM;
        float ss = 0.f;
#pragma unroll
        for (int j = 0; j < 2; ++j) {
            const int c = j * 512 + lane * 8;
            f32x4 a = *(const f32x4*)(xs + c), b = *(const f32x4*)(xs + c + 4);
            ss += (a[0] * a[0] + a[1] * a[1]) + (a[2] * a[2] + a[3] * a[3]) + (b[0] * b[0] + b[1] * b[1]) + (b[2] * b[2] + b[3] * b[3]);
            const f32x4 ga = *(const f32x4*)(g0 + c), gb = *(const f32x4*)(g0 + c + 4);
            *(v4u*)(XGA + (size_t)row * DM + c) = pack8(a * ga, b * gb);
        }
        ss = wave_sum(ss, lane);
        if (lane < 16) SSA[(size_t)row * 16 + lane] = (lane == 0) ? ss : 0.f;
#pragma unroll
        for (int l = 0; l < 2; ++l) {
            const float* ps = (row < MP) ? KIN(8) + ((size_t)l * MP + row) * PLE : KIN(9) + ((size_t)l * MS + (row - MP)) * PLE;
            const f32x4 a = *(const f32x4*)(ps + lane * 4);
            v2u o; o.x = pk2(a[0], a[1]); o.y = pk2(a[2], a[3]);
            *(v2u*)(P16 + ((size_t)l * MROWS + row) * PLE + lane * 4) = o;
        }
    }
    const int gt = F.bid * NTHREADS + F.tid, NGT = F.G * NTHREADS;
    f32x2* ROT = (f32x2*)(ws + WS_ROT);
    for (int e = gt; e < TP * 64; e += NGT) {
        const int pos = e >> 6, i = e & 63;
        const float x = (float)i * (1.0f / 63.0f);
        const float inv = exp2f(-x * 13.287712379549449f);
        const float ang = (float)pos * inv;
        const double rev = (double)ang * 0.15915494309189535;
        const float fr = (float)(rev - floor(rev));
        ROT[e] = (f32x2){__builtin_amdgcn_cosf(fr), __builtin_amdgcn_sinf(fr)};
    }
}
DI float gelu_tanh(float x) { const float u = 0.7978845608028654f * (x + 0.044715f * x * x * x); const float e = __expf(2.f * u); return 0.5f * x * (1.f + (1.f - 2.f / (e + 1.f))); }
DI bf16x8 mk_frag(v2u a, v2u b) { v4u w; w.x = a.x; w.y = a.y; w.z = b.x; w.w = b.y; return __builtin_bit_cast(bf16x8, w); }

template <bool sample> DI void compress_job_t(Frame& F, int layer, int job) {
    int lane = F.lane, wave = F.wave; asm volatile("" : "+v"(lane), "+s"(wave));
    const int tid = wave * 64 + lane, quad = lane >> 4, rl = lane & 15;
    unsigned char* ws = KWS();
    int kv, bs, g0, nbase;
    if (sample) { kv = job >> 7; bs = job & 127; g0 = 0; nbase = 0; }
    else { const int j2 = job - 256; kv = j2 >> 3; bs = (j2 >> 2) & 1; g0 = (j2 >> 1) & 1; nbase = (j2 & 1) * 256; }
    const bf16* W1T = (const bf16*)(ws + WS_W1T + layer * SZ_W1T) + (size_t)kv * 64 * 2048;
    const bf16* W2T = (const bf16*)(ws + WS_W2T + layer * SZ_W2T) + (size_t)kv * 64 * 64;
    const float* pe = KIN(12) + (size_t)(layer * 2 + kv) * 32 * 64;
    const bf16* Z = (const bf16*)(ws + WS_Z);
    const int* pt = (const int*)KIN(7);
    const float* cache = KIN(2);
    LAS unsigned char* LW = F.lds;
    int gg[2], nn[2];
    size_t pb0[2], pb1[2];
#pragma unroll
    for (int tl = 0; tl < 2; ++tl) { const int T = 2 * wave + tl; if (sample) { gg[tl] = T >> 3; nn[tl] = 16 * (T & 7) + rl; } else { gg[tl] = g0; nn[tl] = nbase + 16 * T + rl; }
        pb0[tl] = 0; pb1[tl] = 0;
        if (sample) { const int p0 = (16 * nn[tl]) >> 7; const int p1 = p0 + 1 > 15 ? 15 : p0 + 1;
            pb0[tl] = (size_t)(layer * 2560 + pt[bs * 16 + p0]) * 128 * 512; pb1[tl] = (size_t)(layer * 2560 + pt[bs * 16 + p1]) * 128 * 512; } }
    f32x4 h[2][4];
#pragma unroll
    for (int tl = 0; tl < 2; ++tl)
#pragma unroll
        for (int i = 0; i < 4; ++i) h[tl][i] = (f32x4){0.f, 0.f, 0.f, 0.f};
#pragma unroll 1
    for (int c = 0; c < 4; ++c) {
        __syncthreads();
#pragma unroll
        for (int k = 0; k < 8; ++k) { const int pc = tid + 512 * k, r = pc >> 6, c16 = pc & 63;
            *(LAS v4u*)(LW + r * 1040 + c16 * 16) = *(const v4u*)(W1T + (size_t)r * 2048 + c * 512 + c16 * 8); }
        __syncthreads();
#pragma unroll 8
        for (int kk = 0; kk < 16; ++kk) {
            const int j = 8 * c + (kk >> 1), dim0 = (kk & 1) * 32 + quad * 8;
            const f32x4 pe0 = *(const f32x4*)(pe + j * 64 + dim0), pe1 = *(const f32x4*)(pe + j * 64 + dim0 + 4);
            bf16x8 xb[2];
#pragma unroll
            for (int tl = 0; tl < 2; ++tl) {
                f32x4 x0, x1;
                if (!sample) { const size_t row = (size_t)bs * TP + 16 * nn[tl] + j; unpack8(*(const v4u*)(Z + row * LDZ + ZC_KC + kv * 128 + gg[tl] * 64 + dim0), x0, x1); }
                else { int pos = 16 * nn[tl] + j; pos = pos > 2047 ? 2047 : pos;
                    const float* p = cache + (((pos >> 7) == ((16 * nn[tl]) >> 7)) ? pb0[tl] : pb1[tl]) + (size_t)(pos & 127) * 512 + kv * 128 + gg[tl] * 64 + dim0; x0 = *(const f32x4*)p; x1 = *(const f32x4*)(p + 4); }
                xb[tl] = pack_frag(x0 + pe0, x1 + pe1);
            }
#pragma unroll
            for (int ht = 0; ht < 4; ++ht) {
                const bf16x8 a = ld_frag_l(LW + (16 * ht + rl) * 1040 + (kk * 32 + quad * 8) * 2);
                h[0][ht] = mfma16(a, xb[0], h[0][ht]); h[1][ht] = mfma16(a, xb[1], h[1][ht]);
            }
        }
    }
#pragma unroll
    for (int tl = 0; tl < 2; ++tl) {
#pragma unroll
        for (int ht = 0; ht < 4; ++ht)
#pragma unroll
            for (int i = 0; i < 4; ++i) h[tl][ht][i] = gelu_tanh(h[tl][ht][i]);
        bf16x8 gb[2]; gb[0] = pack_frag(h[tl][0], h[tl][1]); gb[1] = pack_frag(h[tl][2], h[tl][3]);
        const int n = nn[tl], g = gg[tl];
        bf16* dst = sample ? (bf16*)(ws + WS_KCS) + ((((size_t)kv * 128 + bs) * 128 + n) * 2 + g) * 64 : (bf16*)(ws + WS_KC) + ((((size_t)kv * 2 + bs) * 512 + n) * 2 + g) * 64;
        const bool zero = sample && n == 127;
#pragma unroll
        for (int ot = 0; ot < 4; ++ot) {
            f32x4 o = (f32x4){0.f, 0.f, 0.f, 0.f};
#pragma unroll
            for (int s = 0; s < 2; ++s) {
                const bf16* wp = W2T + (16 * ot + rl) * 64 + 32 * s + 4 * quad;
                o = mfma16(mk_frag(*(const v2u*)wp, *(const v2u*)(wp + 16)), gb[s], o);
            }
            v2u w; w.x = zero ? 0u : pk2(o[0], o[1]); w.y = zero ? 0u : pk2(o[2], o[3]);
            *(v2u*)(dst + 16 * ot + 4 * quad) = w;
        }
    }
    __syncthreads();
}

DI v2u pack4(const f32x4 v) { v2u w; w.x = pk2(v[0], v[1]); w.y = pk2(v[2], v[3]); return w; }
DI void compress_sample_job(Frame& F, int layer, int job) {
    int lane = F.lane, wave = F.wave; asm volatile("" : "+v"(lane), "+s"(wave));
    const int tid = wave * 64 + lane, quad = lane >> 4, rl = lane & 15;
    unsigned char* ws = KWS();
    const int kv = job >> 7, bs = job & 127;
    const bf16* W1T = (const bf16*)(ws + WS_W1T + layer * SZ_W1T) + (size_t)kv * 64 * 2048;
    const bf16* W2T = (const bf16*)(ws + WS_W2T + layer * SZ_W2T) + (size_t)kv * 64 * 64;
    const float* pe = KIN(12) + (size_t)(layer * 2 + kv) * 32 * 64;
    const int* pt = (const int*)KIN(7);
    const float* cache = KIN(2);
    LAS unsigned char* XS = F.lds;
    LAS unsigned char* WS1 = F.lds + 69632;
    size_t toff[8];
#pragma unroll
    for (int k = 0; k < 8; ++k) { const int q = tid + 512 * k, m = q >> 5; const int pos = 16 * m; const int phys = pt[bs * 16 + (pos >> 7)];
        toff[k] = ((size_t)(layer * 2560 + phys) * 128 + (pos & 127)) * 512 + kv * 128 + 4 * (q & 31); }
    const int wr_ = tid >> 3, wc_ = tid & 7;
    int gg[2], nn[2];
#pragma unroll
    for (int tl = 0; tl < 2; ++tl) { const int T = 2 * wave + tl; gg[tl] = T >> 3; nn[tl] = 16 * (T & 7) + rl; }
    f32x4 h[2][4];
#pragma unroll
    for (int tl = 0; tl < 2; ++tl)
#pragma unroll
        for (int i = 0; i < 4; ++i) h[tl][i] = (f32x4){0.f, 0.f, 0.f, 0.f};
    f32x4 xr[8]; v4u wr2[2];
#define CS_ISSUE(r_) do { _Pragma("unroll") for (int k = 0; k < 8; ++k) xr[k] = *(const f32x4*)(cache + toff[k] + (size_t)(r_) * 512); \
        _Pragma("unroll") for (int u = 0; u < 2; ++u) wr2[u] = *(const v4u*)(W1T + (size_t)wr_ * 2048 + ((r_) + 16 * u) * 64 + wc_ * 8); } while (0)
    CS_ISSUE(0);
#pragma unroll 1
    for (int r = 0; r < 16; ++r) {
        __syncthreads();
#pragma unroll
        for (int k = 0; k < 8; ++k) { const int q = tid + 512 * k, m = q >> 5, c = q & 31, d = 4 * (c & 15);
#pragma unroll
            for (int u = 0; u < 2; ++u) { const f32x4 v = xr[k] + *(const f32x4*)(pe + (r + 16 * u) * 64 + d);
                *(LAS v2u*)(XS + u * 34816 + m * 272 + c * 8) = pack4(v); } }
#pragma unroll
        for (int u = 0; u < 2; ++u) *(LAS v4u*)(WS1 + u * 9216 + wr_ * 144 + wc_ * 16) = wr2[u];
        __syncthreads();
        { const int rn = r + 1 < 16 ? r + 1 : 15; CS_ISSUE(rn); }
#pragma unroll
        for (int u = 0; u < 2; ++u)
#pragma unroll
            for (int ks = 0; ks < 2; ++ks) {
                bf16x8 xb[2];
#pragma unroll
                for (int tl = 0; tl < 2; ++tl) { int m = nn[tl] + u; m = m > 127 ? 127 : m; xb[tl] = ld_frag_l(XS + u * 34816 + m * 272 + gg[tl] * 128 + ks * 64 + quad * 16); }
#pragma unroll
                for (int ht = 0; ht < 4; ++ht) { const bf16x8 a = ld_frag_l(WS1 + u * 9216 + (16 * ht + rl) * 144 + ks * 64 + quad * 16);
                    h[0][ht] = mfma16(a, xb[0], h[0][ht]); h[1][ht] = mfma16(a, xb[1], h[1][ht]); }
            }
    }
#undef CS_ISSUE
#pragma unroll
    for (int tl = 0; tl < 2; ++tl) {
#pragma unroll
        for (int ht = 0; ht < 4; ++ht)
#pragma unroll
            for (int i = 0; i < 4; ++i) h[tl][ht][i] = gelu_tanh(h[tl][ht][i]);
        bf16x8 gb[2]; gb[0] = pack_frag(h[tl][0], h[tl][1]); gb[1] = pack_frag(h[tl][2], h[tl][3]);
        const int n = nn[tl], g = gg[tl];
        bf16* dst = (bf16*)(ws + WS_KCS) + ((((size_t)kv * 128 + bs) * 128 + n) * 2 + g) * 64;
        const bool zero = n == 127;
#pragma unroll
        for (int ot = 0; ot < 4; ++ot) {
            f32x4 o = (f32x4){0.f, 0.f, 0.f, 0.f};
#pragma unroll
            for (int s = 0; s < 2; ++s) {
                const bf16* wp = W2T + (16 * ot + rl) * 64 + 32 * s + 4 * quad;
                o = mfma16(mk_frag(*(const v2u*)wp, *(const v2u*)(wp + 16)), gb[s], o);
            }
            v2u w; w.x = zero ? 0u : pk2(o[0], o[1]); w.y = zero ? 0u : pk2(o[2], o[3]);
            *(v2u*)(dst + 16 * ot + 4 * quad) = w;
        }
    }
    __syncthreads();
}
DI void compress_job(Frame& F, int layer, int job) { if (job < 256) compress_sample_job(F, layer, job); else compress_job_t<false>(F, layer, job); }
#ifndef PH_GPT
#define PH_GPT (-1)
#endif
#if PH_GPT >= 0
#define GP_T(k) do { if (tid == 0) { volatile LAS unsigned long long* gp_ = (volatile LAS unsigned long long*)(F.lds + LDSCTL_OFF + 448); const unsigned long long now_ = __builtin_amdgcn_s_memrealtime(); \
    if ((k) == PH_GPT) gp_[0] += now_ - gp_[1]; gp_[1] = now_; } } while (0)
#else
#define GP_T(k) do { } while (0)
#endif
DI int kperm(int idx) { const int s = idx >> 5, r = idx & 31; return 32 * s + 8 * ((r >> 2) & 3) + 4 * (r >> 4) + (r & 3); }
DI float softplusf_(float x) { return x > 20.f ? x : __logf(1.f + __expf(x)); }
DI float ret_lg(int h) { return h == 0 ? -0.031748697f : h == 1 ? -0.015748357f : h == 2 ? -0.007843178f : -0.0039138994f; }

DI void gdn_prep_unit(Frame& F, int layer, int unit) {
    int lane = F.lane, wave = F.wave; asm volatile("" : "+v"(lane), "+s"(wave));
    const int tid = wave * 64 + lane;
    const int b = unit >> 9, h = (unit >> 7) & 3, c = unit & 127;
    const int row0 = b * TP + 64 * c, t0 = 64 * c;
    GP_T(0);
    unsigned char* ws = KWS();
    const bf16* Z = (const bf16*)(ws + WS_Z);
    const float* ZS = (const float*)(ws + WS_ZS);
    LAS float* Lq = (LAS float*)(F.lds); LAS float* Lk = (LAS float*)(F.lds + 33792); LAS float* Lv = (LAS float*)(F.lds + 67584);
    LAS float* LA = (LAS float*)(F.lds + 101376); LAS float* LQK = (LAS float*)(F.lds + 117760);
    LAS float* Lg = (LAS float*)(F.lds + 134144); LAS float* Lb = Lg + 64; LAS float* Le = Lg + 128;
    const float* cw = KIN(15) + (size_t)layer * 4 * 1536;
    {
        v4u xs[6][4];
#pragma unroll
        for (int it0 = 0; it0 < 6; ++it0) {
            const int it = tid + it0 * NTHREADS, i = it / 48, ch = it % 48, col = (ch >> 4) * 512 + h * 128 + (ch & 15) * 8;
#pragma unroll
            for (int j = 0; j < 4; ++j) { const bool ok = (t0 + i - 3 + j) >= 0; xs[it0][j] = *(const v4u*)(Z + (size_t)(ok ? row0 + i - 3 + j : row0) * LDZ + ZC_GQKV + col); }
        }
        asm volatile("" ::: "memory");
#pragma unroll
        for (int it0 = 0; it0 < 6; ++it0) {
            const int it = tid + it0 * NTHREADS, i = it / 48, ch = it % 48, part = ch >> 4, cc = ch & 15;
            const int col = part * 512 + h * 128 + cc * 8;
            f32x4 y0 = (f32x4){0.f, 0.f, 0.f, 0.f}, y1 = y0;
#pragma unroll
            for (int j = 0; j < 4; ++j) {
                const float zf = ((t0 + i - 3 + j) >= 0) ? 1.f : 0.f;
                f32x4 x0, x1; unpack8(xs[it0][j], x0, x1);
                y0 += x0 * (*(const f32x4*)(cw + j * 1536 + col) * zf); y1 += x1 * (*(const f32x4*)(cw + j * 1536 + col + 4) * zf);
            }
#pragma unroll
            for (int e = 0; e < 4; ++e) { y0[e] = siluf_(y0[e]); y1[e] = siluf_(y1[e]); }
            LAS float* dst = (part == 0 ? Lq : part == 1 ? Lk : Lv) + i * 132 + cc * 8;
            *(LAS f32x4*)dst = y0; *(LAS f32x4*)(dst + 4) = y1;
        }
    }
    __syncthreads();
    GP_T(1);
    {
        float va[16], vb[16], ps[16];
#pragma unroll
        for (int q = 0; q < 16; ++q) { LAS float* vp = ((q < 8) ? Lq : Lk) + (wave * 8 + (q & 7)) * 132 + lane * 2; va[q] = vp[0]; vb[q] = vp[1]; ps[q] = va[q] * va[q] + vb[q] * vb[q]; }
#pragma unroll
        for (int q = 0; q < 16; ++q) ps[q] += shx<1>(ps[q], lane);
#pragma unroll
        for (int q = 0; q < 16; ++q) ps[q] += shx<2>(ps[q], lane);
#pragma unroll
        for (int q = 0; q < 16; ++q) ps[q] += shx<4>(ps[q], lane);
#pragma unroll
        for (int q = 0; q < 16; ++q) ps[q] += shx<8>(ps[q], lane);
#pragma unroll
        for (int q = 0; q < 16; ++q) ps[q] += shx<16>(ps[q], lane);
#pragma unroll
        for (int q = 0; q < 16; ++q) ps[q] += shx<32>(ps[q], lane);
#pragma unroll
        for (int q = 0; q < 16; ++q) { LAS float* vp = ((q < 8) ? Lq : Lk) + (wave * 8 + (q & 7)) * 132 + lane * 2; const float sc = rsqrtf(ps[q] + EPS) * ((q < 8) ? 0.08838834764831845f : 1.f); vp[0] = va[q] * sc; vp[1] = vb[q] * sc; }
    }
    if (wave == 0) {
        const float ga = ZS[(size_t)(row0 + lane) * 32 + 24 + h], gbv = ZS[(size_t)(row0 + lane) * 32 + 28 + h];
        float g = -__expf(KIN(16)[layer * 4 + h]) * softplusf_(ga + KIN(17)[layer * 4 + h]);
#pragma unroll
        for (int o = 1; o < 64; o <<= 1) { const float t = __int_as_float(__builtin_amdgcn_ds_bpermute(((lane - o) & 63) << 2, __float_as_int(g))); if (lane >= o) g += t; }
        Lg[lane] = g; Lb[lane] = sigmoidf_(gbv); Le[lane] = __expf(g);
    }
    __syncthreads();
    GP_T(2);
    {
        const int it = wave >> 1, quad = lane >> 4, rl = lane & 15;
        f32x4 ckk[2], cqk[2];
#pragma unroll
        for (int jj = 0; jj < 2; ++jj) { ckk[jj] = (f32x4){0.f, 0.f, 0.f, 0.f}; cqk[jj] = ckk[jj]; }
#pragma unroll
        for (int s = 0; s < 4; ++s) {
            const LAS float* kp = Lk + (16 * it + rl) * 132 + 32 * s + 8 * quad; const LAS float* qp = Lq + (16 * it + rl) * 132 + 32 * s + 8 * quad;
            const f32x4 ka0 = *(const LAS f32x4*)kp, ka1 = *(const LAS f32x4*)(kp + 4), qa0 = *(const LAS f32x4*)qp, qa1 = *(const LAS f32x4*)(qp + 4);
            const bf16x8 kah = pack_frag(ka0, ka1), qah = pack_frag(qa0, qa1);
            f32x4 h0, h1; unpack8(__builtin_bit_cast(v4u, kah), h0, h1); const bf16x8 kal = pack_frag(ka0 - h0, ka1 - h1);
            unpack8(__builtin_bit_cast(v4u, qah), h0, h1); const bf16x8 qal = pack_frag(qa0 - h0, qa1 - h1);
#pragma unroll
            for (int jj = 0; jj < 2; ++jj) {
                const int jt = (wave & 1) * 2 + jj;
                if (jt <= it) {
                    const LAS float* bp = Lk + (16 * jt + rl) * 132 + 32 * s + 8 * quad;
                    const f32x4 kb0 = *(const LAS f32x4*)bp, kb1 = *(const LAS f32x4*)(bp + 4);
                    const bf16x8 kbh = pack_frag(kb0, kb1); unpack8(__builtin_bit_cast(v4u, kbh), h0, h1); const bf16x8 kbl = pack_frag(kb0 - h0, kb1 - h1);
                    ckk[jj] = mfma16(kah, kbh, ckk[jj]); ckk[jj] = mfma16(kah, kbl, ckk[jj]); ckk[jj] = mfma16(kal, kbh, ckk[jj]);
                    cqk[jj] = mfma16(qah, kbh, cqk[jj]); cqk[jj] = mfma16(qah, kbl, cqk[jj]); cqk[jj] = mfma16(qal, kbh, cqk[jj]);
                }
            }
        }
#pragma unroll
        for (int jj = 0; jj < 2; ++jj) {
            const int j = 16 * ((wave & 1) * 2 + jj) + rl; const float gj = Lg[j];
#pragma unroll
            for (int e = 0; e < 4; ++e) { const int i = 16 * it + 4 * quad + e; const float dec = (i >= j) ? __expf(Lg[i] - gj) : 0.f;
                LA[i * 64 + j] = (i > j) ? Lb[i] * ckk[jj][e] * dec : 0.f; LQK[i * 64 + j] = cqk[jj][e] * dec; }
        }
    }
    __syncthreads();
    GP_T(3);
    unsigned char* rec = ws + WS_GREC + (size_t)unit * GREC;
    LAS float* TI = (LAS float*)(F.lds + 135168);
    if (tid < 64) {
        const int B = tid >> 4, c = tid & 15;
        float tc[16];
#pragma unroll
        for (int i = 0; i < 16; ++i) {
            float s0 = (i == c) ? 1.f : 0.f;
#pragma unroll
            for (int j = 0; j < i; ++j) s0 -= LA[(16 * B + i) * 64 + 16 * B + j] * tc[j];
            tc[i] = s0;
        }
#pragma unroll
        for (int i = 0; i < 16; ++i) TI[B * 256 + i * 16 + c] = tc[i];
    }
    {
        const float gl = Lg[63];
        for (int it = tid; it < 2560; it += NTHREADS) {
            if (it < 1024) {
                const int i = it >> 4, s = (it >> 2) & 3, quad = it & 3; const float e = Le[i];
                const f32x4 a = *(const LAS f32x4*)(Lq + i * 132 + 32 * s + 4 * quad) * e, bq = *(const LAS f32x4*)(Lq + i * 132 + 32 * s + 16 + 4 * quad) * e;
                *(v4u*)(rec + 16384 + i * 256 + (32 * s + 8 * quad) * 2) = pack8(a, bq);
            } else if (it < 2048) {
                const int r = it - 1024, dk = r >> 3, s2 = (r >> 2) & 1, quad = r & 3;
                f32x4 a, bq;
#pragma unroll
                for (int e = 0; e < 4; ++e) { const int ta = 32 * s2 + 4 * quad + e, tb = ta + 16; a[e] = Lk[ta * 132 + dk] * __expf(gl - Lg[ta]); bq[e] = Lk[tb * 132 + dk] * __expf(gl - Lg[tb]); }
                *(v4u*)(rec + 32768 + dk * 128 + (32 * s2 + 8 * quad) * 2) = pack8(a, bq);
            } else {
                const int r = it - 2048, i = r >> 3, s2 = (r >> 2) & 1, quad = r & 3;
                const f32x4 a = *(const LAS f32x4*)(LQK + i * 64 + 32 * s2 + 4 * quad), bq = *(const LAS f32x4*)(LQK + i * 64 + 32 * s2 + 16 + 4 * quad);
                *(v4u*)(rec + 65536 + i * 128 + (32 * s2 + 8 * quad) * 2) = pack8(a, bq);
            }
        }
        if (tid == 0) *(float*)(rec + 73728) = __expf(gl);
    }
    __syncthreads();
    GP_T(4);
    {
        const int col = tid & 255, hb = tid >> 8;
        LAS float* X = (col < 128) ? (Lv + col) : (Lk + (col - 128));
        const bool isw = col >= 128;
#pragma unroll 1
        for (int B = 0; B < 4; ++B) {
            float xb[8];
#pragma unroll
            for (int i = 0; i < 8; ++i) { const int r = 16 * B + 8 * hb + i; xb[i] = (isw ? Lb[r] * Le[r] : Lb[r]) * X[r * 132]; }
#pragma unroll 2
            for (int j4 = 0; j4 < 4 * B; ++j4) {
                const float x0 = X[(4 * j4) * 132], x1 = X[(4 * j4 + 1) * 132], x2 = X[(4 * j4 + 2) * 132], x3 = X[(4 * j4 + 3) * 132];
#pragma unroll
                for (int i = 0; i < 8; ++i) { const f32x4 a = *(const LAS f32x4*)(LA + (16 * B + 8 * hb + i) * 64 + 4 * j4); xb[i] -= (a[0] * x0 + a[1] * x1) + (a[2] * x2 + a[3] * x3); }
            }
#pragma unroll
            for (int i = 0; i < 8; ++i) X[(16 * B + 8 * hb + i) * 132] = xb[i];
            __syncthreads();
            float r[16];
#pragma unroll
            for (int jj = 0; jj < 16; ++jj) r[jj] = X[(16 * B + jj) * 132];
            __syncthreads();
#pragma unroll
            for (int i = 0; i < 8; ++i) {
                float s0 = 0.f, s1 = 0.f;
#pragma unroll
                for (int j4 = 0; j4 < 4; ++j4) { const f32x4 a = *(const LAS f32x4*)(TI + B * 256 + (8 * hb + i) * 16 + 4 * j4);
                    s0 += a[0] * r[4 * j4] + a[2] * r[4 * j4 + 2]; s1 += a[1] * r[4 * j4 + 1] + a[3] * r[4 * j4 + 3]; }
                X[(16 * B + 8 * hb + i) * 132] = s0 + s1;
            }
            __syncthreads();
        }
    }
    __syncthreads();
    GP_T(5);
    for (int it = tid; it < 2048; it += NTHREADS) {
        if (it < 1024) {
            const int dv = it >> 3, q = it & 7;
            v4u w; w.x = pk2(Lv[(8 * q) * 132 + dv], Lv[(8 * q + 1) * 132 + dv]); w.y = pk2(Lv[(8 * q + 2) * 132 + dv], Lv[(8 * q + 3) * 132 + dv]);
            w.z = pk2(Lv[(8 * q + 4) * 132 + dv], Lv[(8 * q + 5) * 132 + dv]); w.w = pk2(Lv[(8 * q + 6) * 132 + dv], Lv[(8 * q + 7) * 132 + dv]);
            *(v4u*)(rec + 49152 + dv * 128 + q * 16) = w;
        } else {
            const int r = it - 1024, i = r >> 4, s = (r >> 2) & 3, quad = r & 3;
            const f32x4 a = *(const LAS f32x4*)(Lk + i * 132 + 32 * s + 4 * quad), bq = *(const LAS f32x4*)(Lk + i * 132 + 32 * s + 16 + 4 * quad);
            *(v4u*)(rec + i * 256 + (32 * s + 8 * quad) * 2) = pack8(a, bq);
        }
    }
    __syncthreads();
    GP_T(6);
}

DI void ret_prep_unit(Frame& F, int layer, int unit) {
    int lane = F.lane, wave = F.wave; asm volatile("" : "+v"(lane), "+s"(wave));
    const int tid = wave * 64 + lane, quad = lane >> 4, rl = lane & 15;
    const int b = unit >> 8, h = (unit >> 6) & 3, c = unit & 63;
    const int row0 = b * TP + 128 * c;
    unsigned char* ws = KWS();
    const bf16* Z = (const bf16*)(ws + WS_Z);
    const f32x2* ROT = (const f32x2*)(ws + WS_ROT);
    bf16* QR = (bf16*)(ws + WS_QR); bf16* KR = (bf16*)(ws + WS_KR);
    LAS unsigned char* LK = F.lds; LAS unsigned char* LV = F.lds + 34816;
    const float lg = ret_lg(h);
    for (int it = tid; it < 1024; it += NTHREADS) {
        const int j = it >> 3, cc = it & 7, d0 = cc * 8;
        const size_t zr = (size_t)(row0 + j) * LDZ + ZC_RQKV + h * 128 + d0;
        f32x4 q1a, q1b, q2a, q2b, k1a, k1b, k2a, k2b;
        unpack8(*(const v4u*)(Z + zr), q1a, q1b); unpack8(*(const v4u*)(Z + zr + 64), q2a, q2b);
        unpack8(*(const v4u*)(Z + zr + 512), k1a, k1b); unpack8(*(const v4u*)(Z + zr + 512 + 64), k2a, k2b);
        const f32x2* rp = ROT + (size_t)(128 * c + j) * 64 + d0;
        const float kd = __expf((float)(127 - j) * lg);
        f32x4 oq1a, oq1b, oq2a, oq2b, ok1a, ok1b, ok2a, ok2b;
#pragma unroll
        for (int e = 0; e < 8; ++e) {
            const f32x2 cs = rp[e];
            const float q1 = e < 4 ? q1a[e & 3] : q1b[e & 3], q2 = e < 4 ? q2a[e & 3] : q2b[e & 3], k1 = e < 4 ? k1a[e & 3] : k1b[e & 3], k2 = e < 4 ? k2a[e & 3] : k2b[e & 3];
            const float rq1 = q1 * cs.x - q2 * cs.y, rq2 = q2 * cs.x + q1 * cs.y, rk1 = (k1 * cs.x - k2 * cs.y) * 0.08838834764831845f, rk2 = (k2 * cs.x + k1 * cs.y) * 0.08838834764831845f;
            if (e < 4) { oq1a[e & 3] = rq1; oq2a[e & 3] = rq2; ok1a[e & 3] = rk1; ok2a[e & 3] = rk2; } else { oq1b[e & 3] = rq1; oq2b[e & 3] = rq2; ok1b[e & 3] = rk1; ok2b[e & 3] = rk2; }
            *(LAS bf16*)(LK + (d0 + e) * 272 + j * 2) = (bf16)f2bf(rk1 * kd); *(LAS bf16*)(LK + (d0 + 64 + e) * 272 + j * 2) = (bf16)f2bf(rk2 * kd);
        }
        const size_t orow = (size_t)(row0 + j) * 512 + h * 128 + d0;
        *(v4u*)(QR + orow) = pack8(oq1a, oq1b); *(v4u*)(QR + orow + 64) = pack8(oq2a, oq2b);
        *(v4u*)(KR + orow) = pack8(ok1a, ok1b); *(v4u*)(KR + orow + 64) = pack8(ok2a, ok2b);
    }
    for (int it = tid; it < 2048; it += NTHREADS) {
        const int j = it >> 4, cc = it & 15;
        const v4u w = *(const v4u*)(Z + (size_t)(row0 + j) * LDZ + ZC_RQKV + 1024 + h * 128 + cc * 8);
        LAS unsigned char* d = LV + (cc * 8) * 272 + j * 2;
        *(LAS bf16*)(d) = (bf16)(w.x & 0xffff); *(LAS bf16*)(d + 272) = (bf16)(w.x >> 16); *(LAS bf16*)(d + 2 * 272) = (bf16)(w.y & 0xffff); *(LAS bf16*)(d + 3 * 272) = (bf16)(w.y >> 16);
        *(LAS bf16*)(d + 4 * 272) = (bf16)(w.z & 0xffff); *(LAS bf16*)(d + 5 * 272) = (bf16)(w.z >> 16); *(LAS bf16*)(d + 6 * 272) = (bf16)(w.w & 0xffff); *(LAS bf16*)(d + 7 * 272) = (bf16)(w.w >> 16);
    }
    __syncthreads();
    float* RKV = (float*)(ws + WS_RKV) + (size_t)unit * 16384;
#pragma unroll
    for (int nt = 0; nt < 8; ++nt) {
        f32x4 acc = (f32x4){0.f, 0.f, 0.f, 0.f};
#pragma unroll
        for (int s = 0; s < 4; ++s) acc = mfma16(ld_frag_l(LK + (16 * wave + rl) * 272 + (32 * s + 8 * quad) * 2), ld_frag_l(LV + (16 * nt + rl) * 272 + (32 * s + 8 * quad) * 2), acc);
#pragma unroll
        for (int i = 0; i < 4; ++i) RKV[(size_t)(16 * wave + 4 * quad + i) * 128 + 16 * nt + rl] = acc[i];
    }
    __syncthreads();
}
DI void sample_rec_unit(Frame& F, int layer, int unit) {
    int lane = F.lane, wave = F.wave; asm volatile("" : "+v"(lane), "+s"(wave));
    const int tid = wave * 64 + lane;
    const int kind = unit >> 9, s = (unit >> 2) & 127, h = unit & 3;
    const int dv = tid & 127, part = tid >> 7, r0 = MP + 4 * s;
    unsigned char* ws = KWS();
    const bf16* Z = (const bf16*)(ws + WS_Z);
    const float* ZS = (const float*)(ws + WS_ZS);
    LAS float* Lq = (LAS float*)(F.lds); LAS float* Lk = Lq + 512; LAS float* Lv = Lq + 1024; LAS float* red = Lq + 1536; LAS float* Lo = Lq + 2048; LAS float* sc = Lq + 2560;
    float S[32];
    if (kind == 0) {
        if (tid < 384) {
            const int pr = tid >> 7, d = tid & 127, col = pr * 512 + h * 128 + d;
            float xp[7], w[4];
#pragma unroll
            for (int i = 0; i < 3; ++i) xp[i] = KIN(4)[((size_t)(layer * 128 + s) * 3 + i) * 1536 + col];
#pragma unroll
            for (int j = 0; j < 4; ++j) xp[3 + j] = bf2f(Z[(size_t)(r0 + j) * LDZ + ZC_GQKV + col]);
#pragma unroll
            for (int i = 0; i < 4; ++i) w[i] = KIN(15)[(size_t)(layer * 4 + i) * 1536 + col];
            LAS float* dst = pr == 0 ? Lq : pr == 1 ? Lk : Lv;
#pragma unroll
            for (int j = 0; j < 4; ++j) dst[j * 128 + d] = siluf_(w[0] * xp[j] + w[1] * xp[j + 1] + w[2] * xp[j + 2] + w[3] * xp[j + 3]);
        }
        __syncthreads();
        {
            LAS float* vp = (wave < 4 ? Lq : Lk) + (wave & 3) * 128;
            const float a = vp[2 * lane], b = vp[2 * lane + 1];
            const float scl = rsqrtf(wave_sum(a * a + b * b, lane) + EPS) * (wave < 4 ? 0.08838834764831845f : 1.f);
            vp[2 * lane] = a * scl; vp[2 * lane + 1] = b * scl;
        }
        if (tid < 4) {
            const float ga = ZS[(size_t)(r0 + tid) * 32 + 24 + h], gb = ZS[(size_t)(r0 + tid) * 32 + 28 + h];
            sc[tid] = __expf(-__expf(KIN(16)[layer * 4 + h]) * softplusf_(ga + KIN(17)[layer * 4 + h])); sc[4 + tid] = sigmoidf_(gb);
        }
        __syncthreads();
        const float* Sin = KIN(5) + ((size_t)((layer * 128 + s) * 4 + h) * 128 + 32 * part) * 128 + dv;
#pragma unroll
        for (int i = 0; i < 32; ++i) S[i] = Sin[(size_t)i * 128];
#pragma unroll
        for (int j = 0; j < 4; ++j) {
            const float a = sc[j], beta = sc[4 + j];
            float p = 0.f;
#pragma unroll
            for (int i = 0; i < 32; ++i) { S[i] *= a; p += Lk[j * 128 + 32 * part + i] * S[i]; }
            red[part * 128 + dv] = p;
            __syncthreads();
            const float delta = beta * (Lv[j * 128 + dv] - ((red[dv] + red[128 + dv]) + (red[256 + dv] + red[384 + dv])));
            __syncthreads();
            float o = 0.f;
#pragma unroll
            for (int i = 0; i < 32; ++i) { S[i] += Lk[j * 128 + 32 * part + i] * delta; o += Lq[j * 128 + 32 * part + i] * S[i]; }
            red[part * 128 + dv] = o;
            __syncthreads();
            if (part == 0) Lo[j * 128 + dv] = (red[dv] + red[128 + dv]) + (red[256 + dv] + red[384 + dv]);
            __syncthreads();
        }
        float* Sout = KOUT() + O_GSS + ((size_t)((layer * 128 + s) * 4 + h) * 128 + 32 * part) * 128 + dv;
#pragma unroll
        for (int i = 0; i < 32; ++i) Sout[(size_t)i * 128] = S[i];
        ((float*)(ws + WS_OGDN))[(size_t)(r0 + part) * 512 + h * 128 + dv] = Lo[part * 128 + dv];
    } else {
        const f32x2* ROT = (const f32x2*)(ws + WS_ROT);
        if (tid < 384) {
            const int pr = tid >> 7, d = tid & 127;
#pragma unroll
            for (int j = 0; j < 4; ++j) {
                const bf16* zp = Z + (size_t)(r0 + j) * LDZ + ZC_RQKV + pr * 512 + h * 128;
                float v = bf2f(zp[d]);
                if (pr < 2) { const f32x2 cs = ROT[(size_t)(2048 + j) * 64 + (d & 63)]; const float o = bf2f(zp[d ^ 64]);
                    v = (d < 64) ? v * cs.x - o * cs.y : v * cs.x + o * cs.y; if (pr == 1) v *= 0.08838834764831845f; }
                (pr == 0 ? Lq : pr == 1 ? Lk : Lv)[j * 128 + d] = v;
            }
        }
        __syncthreads();
        const float gam = __expf(ret_lg(h));
        const float* Sin = KIN(6) + ((size_t)((layer * 128 + s) * 4 + h) * 128 + 32 * part) * 128 + dv;
#pragma unroll
        for (int i = 0; i < 32; ++i) S[i] = Sin[(size_t)i * 128];
#pragma unroll
        for (int j = 0; j < 4; ++j) {
            const float vv = Lv[j * 128 + dv];
            float o = 0.f;
#pragma unroll
            for (int i = 0; i < 32; ++i) { S[i] = S[i] * gam + Lk[j * 128 + 32 * part + i] * vv; o += Lq[j * 128 + 32 * part + i] * S[i]; }
            red[part * 128 + dv] = o;
            __syncthreads();
            if (part == 0) Lo[j * 128 + dv] = (red[dv] + red[128 + dv]) + (red[256 + dv] + red[384 + dv]);
            __syncthreads();
        }
        float* Sout = KOUT() + O_RSS + ((size_t)((layer * 128 + s) * 4 + h) * 128 + 32 * part) * 128 + dv;
#pragma unroll
        for (int i = 0; i < 32; ++i) Sout[(size_t)i * 128] = S[i];
        if (wave < 4) {
            const int j = wave; const float a = Lo[j * 128 + 2 * lane], b = Lo[j * 128 + 2 * lane + 1];
            const float scl = rsqrtf(wave_sum(a * a + b * b, lane) * (1.f / 128.f) + EPS);
            const bf16* gp = Z + (size_t)(r0 + j) * LDZ + ZC_RG + h * 128 + 2 * lane;
            *(unsigned*)((bf16*)(ws + WS_MIX) + (size_t)(r0 + j) * 1536 + 1024 + h * 128 + 2 * lane) = pk2(a * scl * siluf_(bf2f(gp[0])), b * scl * siluf_(bf2f(gp[1])));
        }
    }
    __syncthreads();
}

DI void gdn_scan_chain(Frame& F, int layer, int bh) {
    int lane = F.lane, wave = F.wave; asm volatile("" : "+v"(lane), "+s"(wave));
    const int tid = wave * 64 + lane, quad = lane >> 4, rl = lane & 15;
    unsigned char* ws = KWS();
    const unsigned char* recb = ws + WS_GREC + (size_t)bh * 128 * GREC;
    LAS unsigned char* L = F.lds;
    constexpr int L_WP = 0, L_QP = 17408, L_KT = 34816, L_UT = 53248, L_QK = 71680;
    f32x4 S[8];
#pragma unroll
    for (int i = 0; i < 8; ++i) S[i] = (f32x4){0.f, 0.f, 0.f, 0.f};
    v4u pf[9]; float egl;
#pragma unroll
    for (int k = 0; k < 9; ++k) pf[k] = *(const v4u*)(recb + (size_t)(tid + 512 * k) * 16);
    egl = *(const float*)(recb + 73728);
    float* OG = (float*)(ws + WS_OGDN);
    const int b = bh >> 2, h = bh & 3;
    for (int c = 0; c < 128; ++c) {
        __syncthreads();
#pragma unroll
        for (int k = 0; k < 9; ++k) {
            const int o = tid * 16 + (k & 1) * 8192;
            const int reg = k >> 1;
            int dst;
            if (reg < 2) dst = (reg == 0 ? L_WP : L_QP) + (o >> 8) * 272 + (o & 255);
            else dst = (reg == 2 ? L_KT : reg == 3 ? L_UT : L_QK) + (o >> 7) * 144 + (o & 127);
            *(LAS v4u*)(L + dst) = pf[k];
        }
        const float eg = egl;
        __syncthreads();
        {
            const unsigned char* rn = recb + (size_t)(c + 1 < 128 ? c + 1 : 127) * GREC;
#pragma unroll
            for (int k = 0; k < 9; ++k) pf[k] = *(const v4u*)(rn + (size_t)(tid + 512 * k) * 16);
            egl = *(const float*)(rn + 73728);
        }
        bf16x8 Sb[4];
#pragma unroll
        for (int s = 0; s < 4; ++s) Sb[s] = pack_frag(S[2 * s], S[2 * s + 1]);
        f32x4 vn[4], O[4];
#pragma unroll
        for (int rt = 0; rt < 4; ++rt) {
            f32x4 wsacc = (f32x4){0.f, 0.f, 0.f, 0.f}, o = wsacc;
#pragma unroll
            for (int s = 0; s < 4; ++s) {
                wsacc = mfma16(ld_frag_l(L + L_WP + (16 * rt + rl) * 272 + (32 * s + 8 * quad) * 2), Sb[s], wsacc);
                o = mfma16(ld_frag_l(L + L_QP + (16 * rt + rl) * 272 + (32 * s + 8 * quad) * 2), Sb[s], o);
            }
            const v2u uw = *(const LAS v2u*)(L + L_UT + (16 * wave + rl) * 144 + (16 * rt + 4 * quad) * 2);
            vn[rt][0] = lo_bf(uw.x) - wsacc[0]; vn[rt][1] = hi_bf(uw.x) - wsacc[1]; vn[rt][2] = lo_bf(uw.y) - wsacc[2]; vn[rt][3] = hi_bf(uw.y) - wsacc[3];
            O[rt] = o;
        }
        bf16x8 Vb[2]; Vb[0] = pack_frag(vn[0], vn[1]); Vb[1] = pack_frag(vn[2], vn[3]);
#pragma unroll
        for (int rt = 0; rt < 4; ++rt) {
#pragma unroll
            for (int s2 = 0; s2 < 2; ++s2) O[rt] = mfma16(ld_frag_l(L + L_QK + (16 * rt + rl) * 144 + (32 * s2 + 8 * quad) * 2), Vb[s2], O[rt]);
            const size_t row = (size_t)b * TP + 64 * c + 16 * rt + 4 * quad;
#pragma unroll
            for (int i = 0; i < 4; ++i) OG[(row + i) * 512 + h * 128 + 16 * wave + rl] = O[rt][i];
        }
#pragma unroll
        for (int kt = 0; kt < 8; ++kt) {
            f32x4 a = S[kt] * eg;
#pragma unroll
            for (int s2 = 0; s2 < 2; ++s2) a = mfma16(ld_frag_l(L + L_KT + (16 * kt + rl) * 144 + (32 * s2 + 8 * quad) * 2), Vb[s2], a);
            S[kt] = a;
        }
    }
    float* So = KOUT() + O_GSP + (size_t)(layer * 8 + bh) * 16384;
#pragma unroll
    for (int kt = 0; kt < 8; ++kt)
#pragma unroll
        for (int i = 0; i < 4; ++i) So[(size_t)(16 * kt + 4 * quad + i) * 128 + 16 * wave + rl] = S[kt][i];
    __syncthreads();
}
DI void ret_scan_part(Frame& F, int layer, int r) {
    int tid = F.tid; asm volatile("" : "+v"(tid));
    const int bh = r >> 2, dv = tid & 127, dk0 = ((r & 3) * 4 + (tid >> 7)) * 8, h = bh & 3;
    unsigned char* ws = KWS();
    const float* RKV = (const float*)(ws + WS_RKV) + (size_t)bh * 64 * 16384;
    bf16* RST = (bf16*)(ws + WS_RST) + (size_t)bh * 64 * 16384;
    const float cdec = __expf(128.f * ret_lg(h));
    float S[8];
#pragma unroll
    for (int i = 0; i < 8; ++i) S[i] = 0.f;
#pragma unroll 4
    for (int c = 0; c < 64; ++c) {
        v4u w; w.x = pk2(S[0], S[1]); w.y = pk2(S[2], S[3]); w.z = pk2(S[4], S[5]); w.w = pk2(S[6], S[7]);
        *(v4u*)(RST + (size_t)c * 16384 + dv * 128 + dk0) = w;
#pragma unroll
        for (int i = 0; i < 8; ++i) S[i] = S[i] * cdec + RKV[(size_t)c * 16384 + (dk0 + i) * 128 + dv];
    }
    float* So = KOUT() + O_RSP + (size_t)(layer * 8 + bh) * 16384;
#pragma unroll
    for (int i = 0; i < 8; ++i) So[(size_t)(dk0 + i) * 128 + dv] = S[i];
}
constexpr float SM_C = 0.125f * 1.4426950408889634f;
struct AttnState { float m, l; f32x4 O[4]; };
DI void attn_reset(AttnState& st) { st.m = -1e30f; st.l = 0.f;
#pragma unroll
    for (int i = 0; i < 4; ++i) st.O[i] = (f32x4){0.f, 0.f, 0.f, 0.f}; }
DI void qk_tile(const LAS unsigned char* Kt, const bf16x8 (&qf)[2], f32x4 (&s)[4], int rl, int quad) {
    bf16x8 kf[4][2];
#pragma unroll
    for (int kt = 0; kt < 4; ++kt)
#pragma unroll
        for (int kk = 0; kk < 2; ++kk) kf[kt][kk] = ld_frag_l(Kt + (16 * kt + rl) * 144 + kk * 64 + quad * 16);
    __builtin_amdgcn_s_setprio(1);
#pragma unroll
    for (int kt = 0; kt < 4; ++kt) s[kt] = mfma16(kf[kt][0], qf[0], (f32x4){0.f, 0.f, 0.f, 0.f});
#pragma unroll
    for (int kt = 0; kt < 4; ++kt) s[kt] = mfma16(kf[kt][1], qf[1], s[kt]);
    __builtin_amdgcn_s_setprio(0);
}
template <class Mask> DI void attn_step(const LAS unsigned char* Kt, const LAS unsigned char* VT, const bf16x8 (&qf)[2], AttnState& st, const Mask& ok, int rl, int quad) {
    f32x4 s[4]; qk_tile(Kt, qf, s, rl, quad);
    float mx = -3e38f;
#pragma unroll
    for (int kt = 0; kt < 4; ++kt)
#pragma unroll
        for (int i = 0; i < 4; ++i) if (ok(16 * kt + 4 * quad + i)) mx = fmaxf(mx, s[kt][i]);
    const int lane = rl + 16 * quad;
    mx = fmaxf(mx, shx<16>(mx, lane)); mx = fmaxf(mx, shx<32>(mx, lane));
    const float mn = fmaxf(st.m, mx);
    const float alpha = exp2f((st.m - mn) * SM_C);
    float ls = 0.f;
#pragma unroll
    for (int kt = 0; kt < 4; ++kt)
#pragma unroll
        for (int i = 0; i < 4; ++i) { const float p = ok(16 * kt + 4 * quad + i) ? exp2f((s[kt][i] - mn) * SM_C) : 0.f; s[kt][i] = p; ls += p; }
    ls += shx<16>(ls, lane); ls += shx<32>(ls, lane);
    st.l = st.l * alpha + ls; st.m = mn;
#pragma unroll
    for (int dt = 0; dt < 4; ++dt) st.O[dt] *= alpha;
#pragma unroll
    for (int ii = 0; ii < 2; ++ii) {
        const bf16x8 pb = pack_frag(s[2 * ii], s[2 * ii + 1]);
#pragma unroll
        for (int dt = 0; dt < 4; ++dt) {
            const LAS unsigned char* vp = VT + (16 * dt + rl) * 144 + (32 * ii + 4 * quad) * 2;
            st.O[dt] = mfma16(mk_frag(*(const LAS v2u*)vp, *(const LAS v2u*)(vp + 32)), pb, st.O[dt]);
        }
    }
}
DI void attn_accum(f32x4 (&Of)[4], const AttnState& st, float gate) {
    const float sc = st.l > 0.f ? gate / st.l : 0.f;
#pragma unroll
    for (int dt = 0; dt < 4; ++dt) Of[dt] += st.O[dt] * sc;
}
DI void vt_write(LAS unsigned char* VT, int d0, int key, const v4u w) {
    LAS unsigned char* d = VT + d0 * 144 + key * 2;
    *(LAS bf16*)(d) = (bf16)(w.x & 0xffff); *(LAS bf16*)(d + 144) = (bf16)(w.x >> 16); *(LAS bf16*)(d + 2 * 144) = (bf16)(w.y & 0xffff); *(LAS bf16*)(d + 3 * 144) = (bf16)(w.y >> 16);
    *(LAS bf16*)(d + 4 * 144) = (bf16)(w.z & 0xffff); *(LAS bf16*)(d + 5 * 144) = (bf16)(w.z >> 16); *(LAS bf16*)(d + 6 * 144) = (bf16)(w.w & 0xffff); *(LAS bf16*)(d + 7 * 144) = (bf16)(w.w >> 16);
}
DI void stage_wg(LAS unsigned char* Kt, LAS unsigned char* VT, const bf16* kb, const bf16* vb, size_t stride, int tid, bool do_v) {
    const int key = tid >> 3, ch = tid & 7;
    *(LAS v4u*)(Kt + key * 144 + ch * 16) = *(const v4u*)(kb + key * stride + ch * 8);
    if (do_v) vt_write(VT, ch * 8, key, *(const v4u*)(vb + key * stride + ch * 8));
}
DI unsigned score_key(float s, bool valid, int idx) { return valid ? (((__float_as_uint(s) | 0x80000000u) & ~127u) | (unsigned)(127 - idx)) : 0u; }
DI int key_rank(const LAS unsigned* K, int ng4, unsigned k) {
    int r = 0;
#pragma unroll 4
    for (int g = 0; g < ng4; ++g) { const v4u v = *(const LAS v4u*)(K + 4 * g); r += (v.x > k) + (v.y > k) + (v.z > k) + (v.w > k); }
    return r;
}
DI void key_rank2(const LAS unsigned* K, int ng4, unsigned k0, unsigned k1, int& r0, int& r1) {
    int a0 = 0, a1 = 0, b0 = 0, b1 = 0;
    const int ng8 = (ng4 + 1) >> 1;
#pragma unroll 4
    for (int g = 0; g < ng8; ++g) { const v4u v = *(const LAS v4u*)(K + 8 * g), w = *(const LAS v4u*)(K + 8 * g + 4);
        a0 += (v.x > k0) + (v.y > k0) + (v.z > k0) + (v.w > k0); b0 += (w.x > k0) + (w.y > k0) + (w.z > k0) + (w.w > k0);
        a1 += (v.x > k1) + (v.y > k1) + (v.z > k1) + (v.w > k1); b1 += (w.x > k1) + (w.y > k1) + (w.z > k1) + (w.w > k1); }
    r0 = a0 + b0; r1 = a1 + b1;
}
DI int top16(float v0, float v1, int lane) {
    int sel = 0;
#pragma unroll 1
    for (int r = 0; r < 16; ++r) {
        float bv; int bi;
        if (v0 >= v1) { bv = v0; bi = lane; } else { bv = v1; bi = lane + 64; }
#define T16_STEP(M) { const float ov = shx<M>(bv, lane); const int oi = shxi<M>(bi, lane); const bool take = (ov > bv) || (ov == bv && oi < bi); bv = take ? ov : bv; bi = take ? oi : bi; }
        T16_STEP(32) T16_STEP(16) T16_STEP(8) T16_STEP(4) T16_STEP(2) T16_STEP(1)
#undef T16_STEP
        const bool h0 = (bi == lane), h1 = (bi == lane + 64);
        v0 = h0 ? -3e38f : v0; v1 = h1 ? -3e38f : v1; sel |= (h0 ? 1 : 0) | (h1 ? 2 : 0);
    }
    return sel;
}

typedef short v4i16_t __attribute__((ext_vector_type(4)));
DI s16x4 vtr(const LAS unsigned char* p) { return __builtin_bit_cast(s16x4, __builtin_amdgcn_ds_read_tr16_b64_v4i16((LAS v4i16_t*)p)); }
DI bf16x8 cat4(s16x4 a, s16x4 b) { bf16x8 r; r[0] = a[0]; r[1] = a[1]; r[2] = a[2]; r[3] = a[3]; r[4] = b[0]; r[5] = b[1]; r[6] = b[2]; r[7] = b[3]; return r; }
DI void attn_step3(const LAS unsigned char* Kt, const LAS unsigned char* Vt, const bf16x8 (&qf)[2], AttnState& st, int lo, int hi, bool active, int rl, int quad) {
    active = active && (hi >= lo);
    if (!__any(active)) return;
    f32x4 s[4]; qk_tile(Kt, qf, s, rl, quad);
    const int lane = rl + 16 * quad;
    const bool full = __all((lo <= 0 && hi >= 63) || !active);
    const int kq = 4 * quad - lo; const unsigned rng = (unsigned)(hi - lo);
    float lm;
    if (full) {
        const float a0 = fmaxf(fmaxf(s[0][0], s[0][1]), fmaxf(s[0][2], s[0][3])), a1 = fmaxf(fmaxf(s[1][0], s[1][1]), fmaxf(s[1][2], s[1][3]));
        const float a2 = fmaxf(fmaxf(s[2][0], s[2][1]), fmaxf(s[2][2], s[2][3])), a3 = fmaxf(fmaxf(s[3][0], s[3][1]), fmaxf(s[3][2], s[3][3]));
        lm = fmaxf(fmaxf(a0, a1), fmaxf(a2, a3));
    } else {
        lm = -3e38f;
#pragma unroll
        for (int kt = 0; kt < 4; ++kt)
#pragma unroll
            for (int i = 0; i < 4; ++i) lm = ((unsigned)(kq + 16 * kt + i) <= rng) ? fmaxf(lm, s[kt][i]) : lm;
    }
    lm = active ? lm : -3e38f;
    if (__any(lm > st.m + 320.f)) {
        float mx = fmaxf(lm, shx<16>(lm, lane)); mx = fmaxf(mx, shx<32>(mx, lane));
        const float mn = fmaxf(st.m, mx);
        const float alpha = __builtin_amdgcn_exp2f((st.m - mn) * SM_C);
        st.l *= alpha; st.m = mn;
#pragma unroll
        for (int dt = 0; dt < 4; ++dt) st.O[dt] *= alpha;
    }
    const float mc = active ? st.m * SM_C : __builtin_inff();
    float ls = 0.f;
    if (full) {
#pragma unroll
        for (int kt = 0; kt < 4; ++kt)
#pragma unroll
            for (int i = 0; i < 4; ++i) { const float p = __builtin_amdgcn_exp2f(s[kt][i] * SM_C - mc); s[kt][i] = p; ls += p; }
    } else {
#pragma unroll
        for (int kt = 0; kt < 4; ++kt)
#pragma unroll
            for (int i = 0; i < 4; ++i) { const float p = ((unsigned)(kq + 16 * kt + i) <= rng) ? __builtin_amdgcn_exp2f(s[kt][i] * SM_C - mc) : 0.f; s[kt][i] = p; ls += p; }
    }
    st.l += ls;
#pragma unroll
    for (int ii = 0; ii < 2; ++ii) {
        const bf16x8 pb = pack_frag(s[2 * ii], s[2 * ii + 1]);
#pragma unroll
        for (int dt = 0; dt < 4; ++dt) {
            const LAS unsigned char* vp = Vt + (32 * ii + 4 * quad + (rl >> 2)) * 144 + (16 * dt + 4 * (rl & 3)) * 2;
            st.O[dt] = mfma16(cat4(vtr(vp), vtr(vp + 16 * 144)), pb, st.O[dt]);
        }
    }
}
DI float attn_rowsum(const AttnState& st, int lane) { float l = st.l; l += shx<16>(l, lane); l += shx<32>(l, lane); return l; }
DI void attn_accum3(f32x4 (&Of)[4], const AttnState& st, float gate, int lane) {
    const float l = attn_rowsum(st, lane);
    const float sc = l > 0.f ? gate / l : 0.f;
#pragma unroll
    for (int dt = 0; dt < 4; ++dt) Of[dt] += st.O[dt] * sc;
}
#ifndef PH_NPT
#define PH_NPT (-1)
#endif
#if PH_NPT >= 0
#define NP_T(k) do { if (tid == 0) { volatile LAS unsigned long long* np_ = (volatile LAS unsigned long long*)(F.lds + LDSCTL_OFF + 464); const unsigned long long now_ = __builtin_amdgcn_s_memrealtime(); \
    if ((k) == PH_NPT) np_[0] += now_ - np_[1]; np_[1] = now_; } } while (0)
#else
#define NP_T(k) do { } while (0)
#endif
#ifndef PH_NSAC
#define PH_NSAC 1
#endif
DI float tile_max(const f32x4 (&s)[4], bool full, int kq, unsigned rng) {
    float lm;
    if (full) {
        const float a0 = fmaxf(fmaxf(s[0][0], s[0][1]), fmaxf(s[0][2], s[0][3])), a1 = fmaxf(fmaxf(s[1][0], s[1][1]), fmaxf(s[1][2], s[1][3]));
        const float a2 = fmaxf(fmaxf(s[2][0], s[2][1]), fmaxf(s[2][2], s[2][3])), a3 = fmaxf(fmaxf(s[3][0], s[3][1]), fmaxf(s[3][2], s[3][3]));
        lm = fmaxf(fmaxf(a0, a1), fmaxf(a2, a3));
    } else {
        lm = -3e38f;
#pragma unroll
        for (int kt = 0; kt < 4; ++kt)
#pragma unroll
            for (int i = 0; i < 4; ++i) lm = ((unsigned)(kq + 16 * kt + i) <= rng) ? fmaxf(lm, s[kt][i]) : lm;
    }
    return lm;
}
DI float tile_exp(f32x4 (&s)[4], bool full, int kq, unsigned rng, float mc) {
    float ls = 0.f;
    if (full) {
#pragma unroll
        for (int kt = 0; kt < 4; ++kt)
#pragma unroll
            for (int i = 0; i < 4; ++i) { const float p = __builtin_amdgcn_exp2f(s[kt][i] * SM_C - mc); s[kt][i] = p; ls += p; }
    } else {
#pragma unroll
        for (int kt = 0; kt < 4; ++kt)
#pragma unroll
            for (int i = 0; i < 4; ++i) { const float p = ((unsigned)(kq + 16 * kt + i) <= rng) ? __builtin_amdgcn_exp2f(s[kt][i] * SM_C - mc) : 0.f; s[kt][i] = p; ls += p; }
    }
    return ls;
}
DI void tile_pv(const LAS unsigned char* Vt, const f32x4 (&s)[4], f32x4 (&O)[4], int rl, int quad) {
    bf16x8 vf[2][4];
#pragma unroll
    for (int ii = 0; ii < 2; ++ii)
#pragma unroll
        for (int dt = 0; dt < 4; ++dt) { const LAS unsigned char* vp = Vt + (32 * ii + 4 * quad + (rl >> 2)) * 144 + (16 * dt + 4 * (rl & 3)) * 2; vf[ii][dt] = cat4(vtr(vp), vtr(vp + 16 * 144)); }
    const bf16x8 pb0 = pack_frag(s[0], s[1]), pb1 = pack_frag(s[2], s[3]);
    __builtin_amdgcn_s_setprio(1);
#pragma unroll
    for (int dt = 0; dt < 4; ++dt) O[dt] = mfma16(vf[0][dt], pb0, O[dt]);
#pragma unroll
    for (int dt = 0; dt < 4; ++dt) O[dt] = mfma16(vf[1][dt], pb1, O[dt]);
    __builtin_amdgcn_s_setprio(0);
}
DI void tile_vload(const LAS unsigned char* Vt, bf16x8 (&vf)[2][4], int rl, int quad) {
#pragma unroll
    for (int ii = 0; ii < 2; ++ii)
#pragma unroll
        for (int dt = 0; dt < 4; ++dt) { const LAS unsigned char* vp = Vt + (32 * ii + 4 * quad + (rl >> 2)) * 144 + (16 * dt + 4 * (rl & 3)) * 2; vf[ii][dt] = cat4(vtr(vp), vtr(vp + 16 * 144)); }
}
DI void tile_pvmma(const bf16x8 (&vf)[2][4], const f32x4 (&s)[4], f32x4 (&O)[4]) {
    const bf16x8 pb0 = pack_frag(s[0], s[1]), pb1 = pack_frag(s[2], s[3]);
    __builtin_amdgcn_s_setprio(1);
#pragma unroll
    for (int dt = 0; dt < 4; ++dt) O[dt] = mfma16(vf[0][dt], pb0, O[dt]);
#pragma unroll
    for (int dt = 0; dt < 4; ++dt) O[dt] = mfma16(vf[1][dt], pb1, O[dt]);
    __builtin_amdgcn_s_setprio(0);
}
DI void attn_step_pair(const LAS unsigned char* K0, const LAS unsigned char* V0, int lo0, int hi0, bool act0,
                       const LAS unsigned char* K1, const LAS unsigned char* V1, int lo1, int hi1, bool act1,
                       const bf16x8 (&qf)[2], AttnState& st, int rl, int quad) {
    act0 = act0 && (hi0 >= lo0); act1 = act1 && (hi1 >= lo1);
    const bool any0 = __any(act0), any1 = __any(act1);
    if (!any0 && !any1) return;
    const int lane = rl + 16 * quad;
    f32x4 s0[4], s1[4];
    if (any0 && any1) {
        bf16x8 kf0[4][2], kf1[4][2];
#pragma unroll
        for (int kt = 0; kt < 4; ++kt)
#pragma unroll
            for (int kk = 0; kk < 2; ++kk) { kf0[kt][kk] = ld_frag_l(K0 + (16 * kt + rl) * 144 + kk * 64 + quad * 16); kf1[kt][kk] = ld_frag_l(K1 + (16 * kt + rl) * 144 + kk * 64 + quad * 16); }
        __builtin_amdgcn_s_setprio(1);
#pragma unroll
        for (int kt = 0; kt < 4; ++kt) s0[kt] = mfma16(kf0[kt][0], qf[0], (f32x4){0.f, 0.f, 0.f, 0.f});
#pragma unroll
        for (int kt = 0; kt < 4; ++kt) s1[kt] = mfma16(kf1[kt][0], qf[0], (f32x4){0.f, 0.f, 0.f, 0.f});
#pragma unroll
        for (int kt = 0; kt < 4; ++kt) s0[kt] = mfma16(kf0[kt][1], qf[1], s0[kt]);
#pragma unroll
        for (int kt = 0; kt < 4; ++kt) s1[kt] = mfma16(kf1[kt][1], qf[1], s1[kt]);
        __builtin_amdgcn_s_setprio(0);
    } else {
        if (any0) qk_tile(K0, qf, s0, rl, quad);
        if (any1) qk_tile(K1, qf, s1, rl, quad);
    }
    const bool full0 = __all((lo0 <= 0 && hi0 >= 63) || !act0), full1 = __all((lo1 <= 0 && hi1 >= 63) || !act1);
    const int kq0 = 4 * quad - lo0, kq1 = 4 * quad - lo1; const unsigned rng0 = (unsigned)(hi0 - lo0), rng1 = (unsigned)(hi1 - lo1);
    float mcb = st.m * SM_C;
    bf16x8 vf0[2][4], vf1[2][4];
    if (any0) tile_vload(V0, vf0, rl, quad);
    float ls = 0.f;
    if (any0) ls += tile_exp(s0, full0, kq0, rng0, act0 ? mcb : __builtin_inff());
    if (any1) ls += tile_exp(s1, full1, kq1, rng1, act1 ? mcb : __builtin_inff());
    if (__any(!(ls <= 1e30f))) {
        if (any0) qk_tile(K0, qf, s0, rl, quad);
        if (any1) qk_tile(K1, qf, s1, rl, quad);
        float lm = -3e38f;
        if (any0) { const float a = tile_max(s0, full0, kq0, rng0); lm = act0 ? a : lm; }
        if (any1) { const float a = tile_max(s1, full1, kq1, rng1); lm = act1 ? fmaxf(lm, a) : lm; }
        float mx = fmaxf(lm, shx<16>(lm, lane)); mx = fmaxf(mx, shx<32>(mx, lane));
        const float mn = fmaxf(st.m, mx);
        const float alpha = __builtin_amdgcn_exp2f((st.m - mn) * SM_C);
        st.l *= alpha; st.m = mn;
#pragma unroll
        for (int dt = 0; dt < 4; ++dt) st.O[dt] *= alpha;
        mcb = mn * SM_C; ls = 0.f;
        if (any0) ls += tile_exp(s0, full0, kq0, rng0, act0 ? mcb : __builtin_inff());
        if (any1) ls += tile_exp(s1, full1, kq1, rng1, act1 ? mcb : __builtin_inff());
    }
    st.l += ls;
    if (any1) tile_vload(V1, vf1, rl, quad);
    if (any0) tile_pvmma(vf0, s0, st.O);
    if (any1) tile_pvmma(vf1, s1, st.O);
}
DI void nsa_prompt_unit(Frame& F, int layer, int unit) {
    int lane = F.lane, wave = F.wave; asm volatile("" : "+v"(lane), "+s"(wave));
    const int tid = wave * 64 + lane, quad = lane >> 4, rl = lane & 15;
    const int b = unit >> 9, g = (unit >> 8) & 1, tt = unit & 255, t0 = 32 * tt;
    unsigned char* ws = KWS();
    const bf16* Z = (const bf16*)(ws + WS_Z);
    const float* ZS = (const float*)(ws + WS_ZS);
    LAS unsigned char* TB = F.lds;
    LAS float* AIMP = (LAS float*)(F.lds + 73728);
    LAS unsigned* SEL = (LAS unsigned*)(F.lds + LDSCTL_OFF + 512);
    const int tk = 4 * wave + (rl >> 2), t = t0 + tk, head = 4 * g + (rl & 3);
    const size_t row = (size_t)b * TP + t;
    bf16x8 qf[2];
    qf[0] = ld_frag_g(Z + row * LDZ + ZC_Q + head * 64 + quad * 8); qf[1] = ld_frag_g(Z + row * LDZ + ZC_Q + head * 64 + 32 + quad * 8);
    const float gc = sigmoidf_(ZS[row * 32 + head * 3]), gs = sigmoidf_(ZS[row * 32 + head * 3 + 1]), gw = sigmoidf_(ZS[row * 32 + head * 3 + 2]);
    f32x4 Of[4];
#pragma unroll
    for (int i = 0; i < 4; ++i) Of[i] = (f32x4){0.f, 0.f, 0.f, 0.f};
    AttnState st;
    const int nct = (t0 >> 10) + 1;
    const bf16* KC = (const bf16*)(ws + WS_KC) + ((size_t)(0 * 2 + b) * 512 * 2 + g) * 64;
    const bf16* VC = (const bf16*)(ws + WS_KC) + ((size_t)(1 * 2 + b) * 512 * 2 + g) * 64;
    const bf16* Zb = Z + (size_t)b * TP * LDZ + g * 64;
    const int skey = tid >> 3, sch = tid & 7;
    const int wlo = (t0 - 511 > 0 ? t0 - 511 : 0) >> 6, nwin = ((t0 + 31) >> 6) - wlo + 1;
    const int nwe = (nwin + 1) & ~1, nce = (nct + 1) & ~1;
    v4u rkA, rvA, rkB, rvB;
#define COMMIT(slot, rk, rv) do { LAS unsigned char* d_ = TB + (slot) * 18432 + skey * 144 + sch * 16; *(LAS v4u*)d_ = rk; *(LAS v4u*)(d_ + 9216) = rv; } while (0)
    NP_T(0);
    const int n1 = nwe + 2 * nce;
#define SEG1_VALID(i) ((i) < nwe ? (i) < nwin : (((i) - nwe) < nce ? ((i) - nwe) < nct : ((i) - nwe - nce) < nct))
#define SEG1_ISSUE(i, rk, rv) do { int i_ = (i); i_ = i_ < n1 ? i_ : n1 - 1; const bool win_ = i_ < nwe; int wt_ = wlo + (i_ < nwin ? i_ : nwin - 1); int jt_ = (i_ - nwe) % nce; jt_ = jt_ < nct ? jt_ : nct - 1; jt_ = jt_ < 0 ? 0 : jt_; \
        const bf16* pk_ = win_ ? Zb + (size_t)(64 * wt_ + skey) * LDZ + sch * 8 + ZC_KW : KC + (size_t)(64 * jt_ + skey) * 128 + sch * 8; \
        const bf16* pv_ = win_ ? Zb + (size_t)(64 * wt_ + skey) * LDZ + sch * 8 + ZC_VW : VC + (size_t)(64 * jt_ + skey) * 128 + sch * 8; \
        rk = *(const v4u*)pk_; rv = *(const v4u*)pv_; } while (0)
    attn_reset(st);
    float mfin = 0.f, il = 0.f;
    SEG1_ISSUE(0, rkA, rvA); SEG1_ISSUE(1, rkB, rvB);
    COMMIT(0, rkA, rvA); COMMIT(1, rkB, rvB);
    SEG1_ISSUE(2, rkA, rvA); SEG1_ISSUE(3, rkB, rvB);
    __syncthreads();
    for (int i = 0; i < n1; i += 2) {
        const LAS unsigned char* K0 = TB + (i & 3) * 18432; const LAS unsigned char* K1 = TB + ((i + 1) & 3) * 18432;
        if (i < nwe) {
            const int kb0 = 64 * (wlo + i), kb1 = kb0 + 64;
            attn_step_pair(K0, K0 + 9216, t - 511 - kb0, t - kb0, true, K1, K1 + 9216, t - 511 - kb1, t - kb1, (i + 1) < nwin, qf, st, rl, quad);
            if (i + 2 == nwe) { attn_accum3(Of, st, gw, lane); attn_reset(st); }
        } else if (i < nwe + nce) {
            const int nb0 = 64 * (i - nwe), nb1 = nb0 + 64;
            attn_step_pair(K0, K0 + 9216, 0, ((t - 31) >> 4) - nb0, true, K1, K1 + 9216, 0, ((t - 31) >> 4) - nb1, (i + 1 - nwe) < nct, qf, st, rl, quad);
            if (i + 2 == nwe + nce) { attn_accum3(Of, st, gc, lane); mfin = st.m * SM_C; const float lt_ = attn_rowsum(st, lane); il = lt_ > 0.f ? 1.f / lt_ : 0.f; }
        } else {
#pragma unroll
            for (int e2 = 0; e2 < 2; ++e2) {
                const int jt = i + e2 - nwe - nce;
                if (jt < nct) {
                    f32x4 s[4]; qk_tile(e2 ? K1 : K0, qf, s, rl, quad);
#pragma unroll
                    for (int kt = 0; kt < 4; ++kt)
#pragma unroll
                        for (int e = 0; e < 4; ++e) {
                            const int n = 64 * jt + 16 * kt + 4 * quad + e;
                            float p = (16 * n + 31 <= t) ? __builtin_amdgcn_exp2f(s[kt][e] * SM_C - mfin) * il : 0.f;
                            p += shx<1>(p, lane); p += shx<2>(p, lane);
                            if ((rl & 3) == 0) AIMP[tk * 512 + n] = p;
                        }
                }
            }
        }
        if (i + 2 < n1) { if (SEG1_VALID(i + 2)) COMMIT((i + 2) & 3, rkA, rvA); if (SEG1_VALID(i + 3)) COMMIT((i + 3) & 3, rkB, rvB); }
        __syncthreads();
        SEG1_ISSUE(i + 4, rkA, rvA); SEG1_ISSUE(i + 5, rkB, rvB);
    }
    NP_T(1);
    {
        const int nav = nct * 64;
        LAS unsigned* KS = (LAS unsigned*)(TB + wave * 2048);
#pragma unroll
        for (int q = 0; q < 4; ++q) {
            const int tq = 4 * wave + q, cur = (t0 + tq) >> 6;
#pragma unroll
            for (int e = 0; e < 2; ++e) {
                const int sblk = lane + 64 * e;
                float imp = 0.f;
#pragma unroll
                for (int d = -1; d <= 3; ++d) { const int n = 4 * sblk + d; if (n >= 0 && n < nav) imp += AIMP[tq * 512 + n]; }
                const bool valid = sblk <= cur, forced = (sblk == 0) || (sblk == cur) || (sblk == cur - 1);
                KS[q * 128 + sblk] = score_key(imp + (forced ? 1000.f : 0.f), valid, sblk);
            }
        }
        asm volatile("" ::: "memory");
#pragma unroll
        for (int q = 0; q < 4; ++q) {
            const int tq = 4 * wave + q, cur = (t0 + tq) >> 6, ng4 = (cur >> 2) + 1;
            const unsigned k0 = KS[q * 128 + lane], k1 = KS[q * 128 + 64 + lane];
            int r0, r1; key_rank2(KS + q * 128, ng4, k0, k1, r0, r1);
            const bool s0 = (lane <= cur) && r0 < 16, s1 = (lane + 64 <= cur) && r1 < 16;
            const unsigned long long m0 = __ballot(s0), m1 = __ballot(s1);
            if (lane == 0) { SEL[tq * 4 + 0] = (unsigned)m0; SEL[tq * 4 + 1] = (unsigned)(m0 >> 32); SEL[tq * 4 + 2] = (unsigned)m1; SEL[tq * 4 + 3] = (unsigned)(m1 >> 32); }
        }
    }
    __syncthreads();
    unsigned un[4], my[4], wv[4];
#pragma unroll
    for (int w = 0; w < 4; ++w) { unsigned v = (lane < 32) ? SEL[lane * 4 + w] : 0u;
        v |= (unsigned)shxi<1>((int)v, lane); v |= (unsigned)shxi<2>((int)v, lane); v |= (unsigned)shxi<4>((int)v, lane); v |= (unsigned)shxi<8>((int)v, lane); v |= (unsigned)shxi<16>((int)v, lane); v |= (unsigned)shxi<32>((int)v, lane);
        un[w] = __builtin_amdgcn_readfirstlane(v); my[w] = SEL[tk * 4 + w];
        wv[w] = SEL[(4 * wave) * 4 + w] | SEL[(4 * wave + 1) * 4 + w] | SEL[(4 * wave + 2) * 4 + w] | SEL[(4 * wave + 3) * 4 + w]; wv[w] = __builtin_amdgcn_readfirstlane(wv[w]); }
#if PH_NSAC > 1
    AttnState st2; attn_reset(st2);
#endif
    NP_T(2);
    attn_reset(st);
    {
        unsigned w0 = un[0], w1 = un[1], w2 = un[2], w3 = un[3];
#define NEXT_BLK(dst) do { if (w0) { dst = __builtin_ctz(w0); w0 &= w0 - 1u; } else if (w1) { dst = 32 + __builtin_ctz(w1); w1 &= w1 - 1u; } else if (w2) { dst = 64 + __builtin_ctz(w2); w2 &= w2 - 1u; } \
        else if (w3) { dst = 96 + __builtin_ctz(w3); w3 &= w3 - 1u; } else dst = -1; } while (0)
#define SEG2_ISSUE(blk_, rk, rv) do { const int b_ = (blk_) >= 0 ? (blk_) : 0; const bf16* p_ = Zb + (size_t)(64 * b_ + skey) * LDZ + sch * 8; rk = *(const v4u*)(p_ + ZC_KS); rv = *(const v4u*)(p_ + ZC_VS); } while (0)
#define BLK_WORD(arr, blk_) (((blk_) >> 5) == 0 ? arr[0] : ((blk_) >> 5) == 1 ? arr[1] : ((blk_) >> 5) == 2 ? arr[2] : arr[3])
#define SEG2_PAIR(ca, cb, sa, sb, stt) do { const LAS unsigned char* K0 = TB + (sa) * 18432; const LAS unsigned char* K1 = TB + (sb) * 18432; \
            const int ca_ = (ca) >= 0 ? (ca) : 0, cb_ = (cb) >= 0 ? (cb) : 0; \
            const bool need0 = ((ca) >= 0) && ((BLK_WORD(wv, ca_) >> (ca_ & 31)) & 1u), need1 = ((cb) >= 0) && ((BLK_WORD(wv, cb_) >> (cb_ & 31)) & 1u); \
            const bool mine0 = need0 && ((BLK_WORD(my, ca_) >> (ca_ & 31)) & 1u), mine1 = need1 && ((BLK_WORD(my, cb_) >> (cb_ & 31)) & 1u); \
            attn_step_pair(K0, K0 + 9216, 0, t - 64 * ca_, mine0, K1, K1 + 9216, 0, t - 64 * cb_, mine1, qf, stt, rl, quad); } while (0)
        v4u rkC, rvC, rkD, rvD;
        int c0, c1, c2, c3, n0, n1b, n2, n3, m0, m1, m2, m3;
        NEXT_BLK(c0); NEXT_BLK(c1); NEXT_BLK(c2); NEXT_BLK(c3); NEXT_BLK(n0); NEXT_BLK(n1b); NEXT_BLK(n2); NEXT_BLK(n3);
        SEG2_ISSUE(c0, rkA, rvA); SEG2_ISSUE(c1, rkB, rvB); SEG2_ISSUE(c2, rkC, rvC); SEG2_ISSUE(c3, rkD, rvD);
        COMMIT(0, rkA, rvA); COMMIT(1, rkB, rvB); COMMIT(2, rkC, rvC); COMMIT(3, rkD, rvD);
        SEG2_ISSUE(n0, rkA, rvA); SEG2_ISSUE(n1b, rkB, rvB); SEG2_ISSUE(n2, rkC, rvC); SEG2_ISSUE(n3, rkD, rvD);
        __syncthreads();
        int i = 0;
        while (c0 >= 0) {
            NEXT_BLK(m0); NEXT_BLK(m1); NEXT_BLK(m2); NEXT_BLK(m3);
            SEG2_PAIR(c0, c1, i & 7, (i + 1) & 7, st);
            SEG2_PAIR(c2, c3, (i + 2) & 7, (i + 3) & 7, st);
#if PH_NSAC > 1
            SEG2_PAIR(c0, c1, i & 7, (i + 1) & 7, st2); SEG2_PAIR(c2, c3, (i + 2) & 7, (i + 3) & 7, st2);
#endif
            COMMIT((i + 4) & 7, rkA, rvA); COMMIT((i + 5) & 7, rkB, rvB); COMMIT((i + 6) & 7, rkC, rvC); COMMIT((i + 7) & 7, rkD, rvD);
            __syncthreads();
#if defined(PH_NSAX) && (PH_NSAX & 1)
            __syncthreads();
#endif
#if defined(PH_NSAX) && (PH_NSAX & 2)
            { v4u d0_, d1_; SEG2_ISSUE(m0, d0_, d1_); asm volatile("" :: "v"(d0_), "v"(d1_)); SEG2_ISSUE(m1, d0_, d1_); asm volatile("" :: "v"(d0_), "v"(d1_));
              SEG2_ISSUE(m2, d0_, d1_); asm volatile("" :: "v"(d0_), "v"(d1_)); SEG2_ISSUE(m3, d0_, d1_); asm volatile("" :: "v"(d0_), "v"(d1_)); }
#endif
            SEG2_ISSUE(m0, rkA, rvA); SEG2_ISSUE(m1, rkB, rvB); SEG2_ISSUE(m2, rkC, rvC); SEG2_ISSUE(m3, rkD, rvD);
            c0 = n0; c1 = n1b; c2 = n2; c3 = n3; n0 = m0; n1b = m1; n2 = m2; n3 = m3; i += 4;
        }
    }
    NP_T(3);
    attn_accum3(Of, st, gs, lane);
#if PH_NSAC > 1
    attn_accum3(Of, st2, (float)(layer >> 8), lane);
#endif
#undef SEG1_ISSUE
#undef SEG1_VALID
#undef SEG2_ISSUE
#undef SEG2_PAIR
#undef BLK_WORD
#undef COMMIT
#undef NEXT_BLK
    bf16* MIX = (bf16*)(ws + WS_MIX) + row * 1536 + head * 64;
#pragma unroll
    for (int dt = 0; dt < 4; ++dt) { v2u w; w.x = pk2(Of[dt][0], Of[dt][1]); w.y = pk2(Of[dt][2], Of[dt][3]); *(v2u*)(MIX + 16 * dt + 4 * quad) = w; }
    __syncthreads();
}

#define CB() asm volatile("" ::: "memory")
DI void stage_wave_f32(LAS unsigned char* Kt, LAS unsigned char* Vt, const float* kb, const float* vb, size_t stride, int lane, float* ck = nullptr, float* cv = nullptr, int rowskip = 0) {
    const int k0 = lane >> 3, ch = lane & 7;
#pragma unroll
    for (int h = 0; h < 4; ++h) {
        const float* src = (h < 2 ? kb : vb); LAS unsigned char* dst = (h < 2 ? Kt : Vt); const int r0 = (h & 1) * 32; float* cp = (h < 2 ? ck : cv);
        f32x4 a[4][2];
#pragma unroll
        for (int it = 0; it < 4; ++it) { const float* kp = src + (size_t)(r0 + it * 8 + k0) * stride + ch * 8; a[it][0] = *(const f32x4*)kp; a[it][1] = *(const f32x4*)(kp + 4); }
#pragma unroll
        for (int it = 0; it < 4; ++it) *(LAS v4u*)(dst + (r0 + it * 8 + k0) * 144 + ch * 16) = pack8(a[it][0], a[it][1]);
        if (cp) {
#pragma unroll
            for (int it = 0; it < 4; ++it) { const int rr = r0 + it * 8 + k0; if (rr >= rowskip) { float* op = cp + (size_t)rr * stride + ch * 8; *(f32x4*)op = a[it][0]; *(f32x4*)(op + 4) = a[it][1]; } }
        }
        asm volatile("" ::: "memory");
    }
}
DI void stage_wave_b16(LAS unsigned char* Kt, LAS unsigned char* Vt, const bf16* kb, const bf16* vb, size_t stride, int nvalid, int lane, bool do_v) {
    const int k0 = lane >> 3, ch = lane & 7;
    const v4u z = (v4u){0u, 0u, 0u, 0u};
#pragma unroll
    for (int it = 0; it < 8; ++it) {
        const int key = it * 8 + k0; const bool v = key < nvalid;
        *(LAS v4u*)(Kt + key * 144 + ch * 16) = v ? *(const v4u*)(kb + key * stride + ch * 8) : z;
        if (do_v) *(LAS v4u*)(Vt + key * 144 + ch * 16) = v ? *(const v4u*)(vb + key * stride + ch * 8) : z;
    }
}
DI void nsa_sample_unit(Frame& F, int layer, int s) {
    int lane = F.lane, wave = F.wave; asm volatile("" : "+v"(lane), "+s"(wave));
    const int quad = lane >> 4, rl = lane & 15;
    const int g = wave & 1, q4 = wave >> 1;
    unsigned char* ws = KWS();
    const bf16* Z = (const bf16*)(ws + WS_Z);
    const float* ZS = (const float*)(ws + WS_ZS);
    LAS unsigned char* Kt = F.lds + wave * 18432; LAS unsigned char* Vt = Kt + 9216;
    LAS float* AIMP = (LAS float*)Vt;
    const int j = rl >> 2, head = 4 * g + (rl & 3), qpos = 2048 + j;
    const size_t row = (size_t)MP + 4 * s + j;
    bf16x8 qf[2];
    qf[0] = ld_frag_g(Z + row * LDZ + ZC_Q + head * 64 + quad * 8); qf[1] = ld_frag_g(Z + row * LDZ + ZC_Q + head * 64 + 32 + quad * 8);
    const float gc = sigmoidf_(ZS[row * 32 + head * 3]), gs = sigmoidf_(ZS[row * 32 + head * 3 + 1]), gw = sigmoidf_(ZS[row * 32 + head * 3 + 2]);
    f32x4 Of[4];
#pragma unroll
    for (int i = 0; i < 4; ++i) Of[i] = (f32x4){0.f, 0.f, 0.f, 0.f};
    AttnState st;
    const bf16* KC = (const bf16*)(ws + WS_KCS) + ((size_t)(0 * 128 + s) * 128 * 2 + g) * 64;
    const bf16* VC = (const bf16*)(ws + WS_KCS) + ((size_t)(1 * 128 + s) * 128 * 2 + g) * 64;
    attn_reset(st);
#pragma unroll 1
    for (int jt = 0; jt < 2; ++jt) {
        stage_wave_b16(Kt, Vt, KC + (size_t)64 * jt * 128, VC + (size_t)64 * jt * 128, 128, 64, lane, true); CB();
        attn_step3(Kt, Vt, qf, st, 0, 126 - 64 * jt, true, rl, quad); CB();
    }
    attn_accum3(Of, st, q4 == 0 ? gc : 0.f, lane);
    {
        const float mfin = st.m * SM_C, lt = attn_rowsum(st, lane), il = lt > 0.f ? 1.f / lt : 0.f;
#pragma unroll 1
        for (int jt = 0; jt < 2; ++jt) {
            stage_wave_b16(Kt, Vt, KC + (size_t)64 * jt * 128, VC, 128, 64, lane, false); CB();
            f32x4 sv[4]; qk_tile(Kt, qf, sv, rl, quad); CB();
#pragma unroll
            for (int kt = 0; kt < 4; ++kt)
#pragma unroll
                for (int i = 0; i < 4; ++i) {
                    const int n = 64 * jt + 16 * kt + 4 * quad + i;
                    float p = (n <= 126) ? __builtin_amdgcn_exp2f(sv[kt][i] * SM_C - mfin) * il : 0.f;
                    p += shx<1>(p, lane); p += shx<2>(p, lane);
                    if ((rl & 3) == 0) AIMP[j * 128 + n] = p;
                }
        }
    }
    CB();
    unsigned long long msk[4];
    {
        unsigned keys[4];
#pragma unroll
        for (int q = 0; q < 4; ++q) {
            float imp = 0.f;
#pragma unroll
            for (int d = -1; d <= 3; ++d) { const int n = 4 * lane + d; if (n >= 0 && n <= 126 && lane < 33) imp += AIMP[q * 128 + n]; }
            const bool forced = (lane == 0) || (lane == 32) || (lane == 31);
            keys[q] = score_key(imp + (forced ? 1000.f : 0.f), lane < 33, lane);
        }
        CB();
        LAS unsigned* KS = (LAS unsigned*)Kt;
#pragma unroll
        for (int q = 0; q < 4; ++q) KS[q * 64 + lane] = keys[q];
        CB();
#pragma unroll
        for (int q = 0; q < 4; ++q) msk[q] = __ballot(lane < 33 && key_rank(KS + q * 64, 9, keys[q]) < 16);
    }
    CB();
    const unsigned long long un = msk[0] | msk[1] | msk[2] | msk[3];
    const unsigned long long mym = j == 0 ? msk[0] : j == 1 ? msk[1] : j == 2 ? msk[2] : msk[3];
    const int* pt = (const int*)KIN(7);
    AttnState sw;
    attn_reset(st); attn_reset(sw);
    {
        unsigned long long word = un; int idx = 0;
        while (word) {
            const int blk = __builtin_ctzll(word); word &= word - 1ull;
            if ((idx++ & 3) != q4) continue;
            if (blk < 32) {
                const int phys = pt[s * 16 + (blk >> 1)];
                const float* base = KIN(2) + ((size_t)(layer * 2560 + phys) * 128 + (blk & 1) * 64) * 512 + g * 64;
                stage_wave_f32(Kt, Vt, base + 256, base + 384, 512, lane); CB();
            } else {
                stage_wave_b16(Kt, Vt, Z + (size_t)(MP + 4 * s) * LDZ + ZC_KS + g * 64, Z + (size_t)(MP + 4 * s) * LDZ + ZC_VS + g * 64, LDZ, 4, lane, true); CB();
            }
            attn_step3(Kt, Vt, qf, st, 0, qpos - 64 * blk, (mym >> blk) & 1ull, rl, quad); CB();
        }
#pragma unroll 1
        for (int jt = 0; jt < 9; ++jt) {
            if ((idx++ & 3) != q4) continue;
            if (jt < 8) { const float* base = KIN(3) + ((size_t)(layer * 128 + s) * 512 + 64 * jt) * 256 + g * 64;
                float* ob = KOUT() + O_WINS + ((size_t)(layer * 128 + s) * 512 + 64 * jt) * 256 + g * 64 - (size_t)4 * 256;
                stage_wave_f32(Kt, Vt, base, base + 128, 256, lane, ob, ob + 128, jt == 0 ? 4 : 0); CB(); }
            else { stage_wave_b16(Kt, Vt, Z + (size_t)(MP + 4 * s) * LDZ + ZC_KW + g * 64, Z + (size_t)(MP + 4 * s) * LDZ + ZC_VW + g * 64, LDZ, 4, lane, true); CB(); }
            attn_step3(Kt, Vt, qf, sw, j + 1 - 64 * jt, 512 + j - 64 * jt, true, rl, quad); CB();
        }
    }
    int lane2 = lane; asm volatile("" : "+v"(lane2));
    LAS float* X = (LAS float*)(F.lds + wave * 18432);
    {
        const float ls = attn_rowsum(st, lane), lw = attn_rowsum(sw, lane);
        X[0 * 64 + lane2] = st.m; X[1 * 64 + lane2] = ls; X[18 * 64 + lane2] = sw.m; X[19 * 64 + lane2] = lw;
#pragma unroll
        for (int dt = 0; dt < 4; ++dt)
#pragma unroll
            for (int e = 0; e < 4; ++e) { X[(2 + 4 * dt + e) * 64 + lane2] = st.O[dt][e]; X[(20 + 4 * dt + e) * 64 + lane2] = sw.O[dt][e]; }
    }
    __syncthreads();
    if (q4 == 0) {
#pragma unroll
        for (int br = 0; br < 2; ++br) {
            float m[4], l[4];
#pragma unroll
            for (int q = 0; q < 4; ++q) { const LAS float* Y = (const LAS float*)(F.lds + (2 * q + g) * 18432) + br * 18 * 64; m[q] = Y[lane2]; l[q] = Y[64 + lane2]; }
            const float mm = fmaxf(fmaxf(m[0], m[1]), fmaxf(m[2], m[3]));
            float w[4], lt = 0.f;
#pragma unroll
            for (int q = 0; q < 4; ++q) { w[q] = __builtin_amdgcn_exp2f((m[q] - mm) * SM_C); lt += l[q] * w[q]; }
            const float gate = br == 0 ? gs : gw;
            const float sc = lt > 0.f ? gate / lt : 0.f;
#pragma unroll
            for (int q = 0; q < 4; ++q) { const LAS float* Y = (const LAS float*)(F.lds + (2 * q + g) * 18432) + br * 18 * 64; const float wq = w[q] * sc;
#pragma unroll
                for (int dt = 0; dt < 4; ++dt)
#pragma unroll
                    for (int e = 0; e < 4; ++e) Of[dt][e] += Y[(2 + 4 * dt + e) * 64 + lane2] * wq; }
        }
        bf16* MIX = (bf16*)(ws + WS_MIX) + row * 1536 + head * 64;
#pragma unroll
        for (int dt = 0; dt < 4; ++dt) { v2u w2; w2.x = pk2(Of[dt][0], Of[dt][1]); w2.y = pk2(Of[dt][2], Of[dt][3]); *(v2u*)(MIX + 16 * dt + 4 * quad) = w2; }
    }
    __syncthreads();
}
DI void ret_out_unit(Frame& F, int layer, int unit) {
    const int tid = F.tid, lane = F.lane, wave = F.wave, quad = lane >> 4, rl = lane & 15;
    const int b = unit >> 8, h = (unit >> 6) & 3, c = unit & 63;
    const int row0 = b * TP + 128 * c;
    unsigned char* ws = KWS();
    const bf16* Z = (const bf16*)(ws + WS_Z);
    const bf16* QR = (const bf16*)(ws + WS_QR); const bf16* KR = (const bf16*)(ws + WS_KR);
    const bf16* RST = (const bf16*)(ws + WS_RST) + (size_t)unit * 16384;
    LAS unsigned char* LQ = F.lds; LAS unsigned char* LK = F.lds + 34816; LAS unsigned char* LV = F.lds + 69632; LAS unsigned char* LS = F.lds + 104448;
    for (int it = tid; it < 2048; it += NTHREADS) {
        const int j = it >> 4, cc = it & 15;
        *(LAS v4u*)(LQ + j * 272 + cc * 16) = *(const v4u*)(QR + (size_t)(row0 + j) * 512 + h * 128 + cc * 8);
        *(LAS v4u*)(LK + j * 272 + cc * 16) = *(const v4u*)(KR + (size_t)(row0 + j) * 512 + h * 128 + cc * 8);
        *(LAS v4u*)(LS + j * 272 + cc * 16) = *(const v4u*)(RST + (size_t)j * 128 + cc * 8);
        const v4u w = *(const v4u*)(Z + (size_t)(row0 + j) * LDZ + ZC_RQKV + 1024 + h * 128 + cc * 8);
        LAS unsigned char* d = LV + (cc * 8) * 272 + j * 2;
        *(LAS bf16*)(d) = (bf16)(w.x & 0xffff); *(LAS bf16*)(d + 272) = (bf16)(w.x >> 16); *(LAS bf16*)(d + 2 * 272) = (bf16)(w.y & 0xffff); *(LAS bf16*)(d + 3 * 272) = (bf16)(w.y >> 16);
        *(LAS bf16*)(d + 4 * 272) = (bf16)(w.z & 0xffff); *(LAS bf16*)(d + 5 * 272) = (bf16)(w.z >> 16); *(LAS bf16*)(d + 6 * 272) = (bf16)(w.w & 0xffff); *(LAS bf16*)(d + 7 * 272) = (bf16)(w.w >> 16);
    }
    __syncthreads();
    const float lg = ret_lg(h);
    const int il = 16 * wave + rl;
    bf16x8 qb[4];
#pragma unroll
    for (int s = 0; s < 4; ++s) qb[s] = ld_frag_l(LQ + il * 272 + (32 * s + 8 * quad) * 2);
    f32x4 C[8];
    const float qdec = __expf((float)(il + 1) * lg);
#pragma unroll
    for (int dt = 0; dt < 8; ++dt) {
        f32x4 a = (f32x4){0.f, 0.f, 0.f, 0.f};
#pragma unroll
        for (int s = 0; s < 4; ++s) a = mfma16(ld_frag_l(LS + (16 * dt + rl) * 272 + (32 * s + 8 * quad) * 2), qb[s], a);
        C[dt] = a * qdec;
    }
    for (int s2 = 0; s2 <= (wave >> 1); ++s2) {
        f32x4 P[2];
#pragma unroll
        for (int e = 0; e < 2; ++e) {
            const int jt = 2 * s2 + e;
            f32x4 a = (f32x4){0.f, 0.f, 0.f, 0.f};
            if (jt <= wave) {
#pragma unroll
                for (int s = 0; s < 4; ++s) a = mfma16(ld_frag_l(LK + (16 * jt + rl) * 272 + (32 * s + 8 * quad) * 2), qb[s], a);
#pragma unroll
                for (int i = 0; i < 4; ++i) { const int jj = 16 * jt + 4 * quad + i; a[i] = (il >= jj) ? a[i] * __expf((float)(il - jj) * lg) : 0.f; }
            }
            P[e] = a;
        }
        const bf16x8 pb = pack_frag(P[0], P[1]);
#pragma unroll
        for (int dt = 0; dt < 8; ++dt) {
            const LAS unsigned char* vp = LV + (16 * dt + rl) * 272 + (32 * s2 + 4 * quad) * 2;
            C[dt] = mfma16(mk_frag(*(const LAS v2u*)vp, *(const LAS v2u*)(vp + 32)), pb, C[dt]);
        }
    }
    float ss = 0.f;
#pragma unroll
    for (int dt = 0; dt < 8; ++dt) ss += (C[dt][0] * C[dt][0] + C[dt][1] * C[dt][1]) + (C[dt][2] * C[dt][2] + C[dt][3] * C[dt][3]);
    ss += shx<16>(ss, lane); ss += shx<32>(ss, lane);
    const float scl = rsqrtf(ss * (1.f / 128.f) + EPS);
    const size_t row = (size_t)row0 + il;
#pragma unroll
    for (int dt = 0; dt < 8; ++dt) {
        const v2u gwd = *(const v2u*)(Z + row * LDZ + ZC_RG + h * 128 + 16 * dt + 4 * quad);
        v2u w; w.x = pk2(C[dt][0] * scl * siluf_(lo_bf(gwd.x)), C[dt][1] * scl * siluf_(hi_bf(gwd.x))); w.y = pk2(C[dt][2] * scl * siluf_(lo_bf(gwd.y)), C[dt][3] * scl * siluf_(hi_bf(gwd.y)));
        *(v2u*)((bf16*)(ws + WS_MIX) + row * 1536 + 1024 + h * 128 + 16 * dt + 4 * quad) = w;
    }
    __syncthreads();
}
DI void gdn_out_row(Frame& F, int layer, int row) {
    const int lane = F.lane;
    unsigned char* ws = KWS();
    const float* o = (const float*)(ws + WS_OGDN) + (size_t)row * 512 + lane * 8;
    const f32x4 a = *(const f32x4*)o, b = *(const f32x4*)(o + 4);
    float ss = (a[0] * a[0] + a[1] * a[1]) + (a[2] * a[2] + a[3] * a[3]) + (b[0] * b[0] + b[1] * b[1]) + (b[2] * b[2] + b[3] * b[3]);
    ss += shx<1>(ss, lane); ss += shx<2>(ss, lane); ss += shx<4>(ss, lane); ss += shx<8>(ss, lane);
    const float scl = rsqrtf(ss * (1.f / 128.f) + EPS);
    const float* ng = KIN(18) + layer * 128 + (lane & 15) * 8;
    const f32x4 ga = *(const f32x4*)ng, gb = *(const f32x4*)(ng + 4);
    f32x4 za, zb; unpack8(*(const v4u*)((const bf16*)(ws + WS_Z) + (size_t)row * LDZ + ZC_GZ + lane * 8), za, zb);
    f32x4 ra, rb;
#pragma unroll
    for (int e = 0; e < 4; ++e) { ra[e] = a[e] * scl * ga[e] * siluf_(za[e]); rb[e] = b[e] * scl * gb[e] * siluf_(zb[e]); }
    *(v4u*)((bf16*)(ws + WS_MIX) + (size_t)row * 1536 + 512 + lane * 8) = pack8(ra, rb);
}
DI void final_row(Frame& F, int row) {
    const int lane = F.lane;
    const float* x = (const float*)(KWS() + WS_XR) + (size_t)row * DM;
    float* y = (row < MP) ? KOUT() + O_YP + (size_t)row * DM : KOUT() + O_YS + (size_t)(row - MP) * DM;
    f32x4 v[4]; float ss = 0.f;
#pragma unroll
    for (int j = 0; j < 4; ++j) { v[j] = *(const f32x4*)(x + 256 * j + lane * 4); ss += (v[j][0] * v[j][0] + v[j][1] * v[j][1]) + (v[j][2] * v[j][2] + v[j][3] * v[j][3]); }
    const float scl = rsqrtf(wave_sum(ss, lane) * (1.f / DM) + EPS);
#pragma unroll
    for (int j = 0; j < 4; ++j) *(f32x4*)(y + 256 * j + lane * 4) = v[j] * scl * *(const f32x4*)(KIN(26) + 256 * j + lane * 4);
}
template <class Epi>
DI void sgemm_tile(Frame& F, const bf16* A, int lda, const bf16* Bt, int ldb, int K, int row0, int col0, const Epi& E) {
    int lane = F.lane, wave = F.wave; asm volatile("" : "+v"(lane), "+s"(wave));
    const int tid = wave * 64 + lane, quad = lane >> 4, rl = lane & 15;
    const int kper = K >> 3, nks = kper >> 5;
    f32x4 acc[2][4];
#pragma unroll
    for (int rt = 0; rt < 2; ++rt)
#pragma unroll
        for (int ct = 0; ct < 4; ++ct) acc[rt][ct] = (f32x4){0.f, 0.f, 0.f, 0.f};
    const bf16* ap = A + (size_t)(row0 + rl) * lda + wave * kper + quad * 8;
    const bf16* bp = Bt + (size_t)(col0 + rl) * ldb + wave * kper + quad * 8;
#pragma unroll 4
    for (int ks = 0; ks < nks; ++ks) {
        bf16x8 a[2], b[4];
#pragma unroll
        for (int rt = 0; rt < 2; ++rt) a[rt] = ld_frag_g(ap + (size_t)(16 * rt) * lda + ks * 32);
#pragma unroll
        for (int ct = 0; ct < 4; ++ct) b[ct] = ld_frag_g(bp + (size_t)(16 * ct) * ldb + ks * 32);
#pragma unroll
        for (int rt = 0; rt < 2; ++rt)
#pragma unroll
            for (int ct = 0; ct < 4; ++ct) acc[rt][ct] = mfma16(a[rt], b[ct], acc[rt][ct]);
    }
    LAS float* RED = (LAS float*)F.lds;
#pragma unroll
    for (int rt = 0; rt < 2; ++rt)
#pragma unroll
        for (int ct = 0; ct < 4; ++ct)
#pragma unroll
            for (int i = 0; i < 4; ++i) RED[wave * 2176 + (16 * rt + 4 * quad + i) * 68 + 16 * ct + rl] = acc[rt][ct][i];
    __syncthreads();
    const int r = tid >> 4, c4 = (tid & 15) * 4;
    f32x4 v = *(const LAS f32x4*)(RED + r * 68 + c4);
#pragma unroll
    for (int w = 1; w < 8; ++w) v += *(const LAS f32x4*)(RED + w * 2176 + r * 68 + c4);
    E(row0 + r, col0 + c4, v, lane);
    __syncthreads();
}
struct SEpiC {
    const bf16* Z; bf16* G;
    DI void operator()(int row, int col, f32x4 v, int lane) const {
        const v2u gw = *(const v2u*)(Z + (size_t)row * LDZ + ZC_MG + col);
        v[0] *= sigmoidf_(lo_bf(gw.x)); v[1] *= sigmoidf_(hi_bf(gw.x)); v[2] *= sigmoidf_(lo_bf(gw.y)); v[3] *= sigmoidf_(hi_bf(gw.y));
        *(v2u*)(G + (size_t)row * 3072 + col) = pack4(v);
    }
};
struct SEpiRes {
    float* XR; bf16* XG; const float* gvec; float* SS; float* T; int mode; const float* XRr;
    DI void operator()(int row, int col, f32x4 v, int lane) const {
        const size_t o = (size_t)row * DM + col;
        if (mode == 1) { *(v2u*)((bf16*)T + o) = pack4(v); return; }
        f32x4 x = *(const f32x4*)(XRr + o);
        if (mode == 2) { const v2u tw = *(const v2u*)((const bf16*)T + o); const f32x4 t = (f32x4){lo_bf(tw.x), hi_bf(tw.x), lo_bf(tw.y), hi_bf(tw.y)};
#pragma unroll
            for (int e = 0; e < 4; ++e) v[e] = t[e] * sigmoidf_(v[e]); }
        x += v;
        *(f32x4*)(XR + o) = x;
        if (XG) { f32x4 y = x; if (gvec) y *= *(const f32x4*)(gvec + col); *(v2u*)(XG + o) = pack4(y); }
        if (SS) { float ssq = (x[0] * x[0] + x[1] * x[1]) + (x[2] * x[2] + x[3] * x[3]);
            ssq += shx<1>(ssq, lane); ssq += shx<2>(ssq, lane); ssq += shx<4>(ssq, lane); ssq += shx<8>(ssq, lane);
            if ((lane & 15) == 0) SS[(size_t)row * 16 + (col >> 6)] = ssq; }
    }
};
struct SEpiUp {
    bf16* H; const float* SS;
    DI void operator()(int row, int col, f32x4 v, int lane) const {
        const f32x4 p0 = *(const f32x4*)(SS + (size_t)row * 16), p1 = *(const f32x4*)(SS + (size_t)row * 16 + 4), p2 = *(const f32x4*)(SS + (size_t)row * 16 + 8), p3 = *(const f32x4*)(SS + (size_t)row * 16 + 12);
        const f32x4 ps = (p0 + p1) + (p2 + p3);
        const float rstd = rsqrtf(((ps[0] + ps[1]) + (ps[2] + ps[3])) * (1.f / DM) + EPS);
#pragma unroll
        for (int e = 0; e < 4; ++e) { const float a = fmaxf(v[e] * rstd, 0.f); v[e] = a * a; }
        *(v2u*)(H + (size_t)row * DFF + col) = pack4(v);
    }
};
#ifndef PH_P0
#define PH_P0 1
#endif
#ifndef PH_A
#define PH_A 1
#endif
#ifndef PH_B0a
#define PH_B0a 1
#endif
#ifndef PH_B0b
#define PH_B0b 1
#endif
#ifndef PH_B0c
#define PH_B0c 1
#endif
#ifndef PH_B0d
#define PH_B0d 1
#endif
#ifndef PH_SCAN
#define PH_SCAN 1
#endif
#ifndef PH_RSCAN
#define PH_RSCAN 1
#endif
#ifndef PH_NSAP
#define PH_NSAP 1
#endif
#ifndef PH_NSAS
#define PH_NSAS 1
#endif
#ifndef PH_B2
#define PH_B2 1
#endif
#ifndef PH_C
#define PH_C 1
#endif
#ifndef PH_XBAR
#define PH_XBAR 0
#endif
#ifndef PH_D
#define PH_D 1
#endif
#ifndef PH_E
#define PH_E 1
#endif
#ifndef PH_F
#define PH_F 1
#endif
#ifndef PH_G1
#define PH_G1 1
#endif
#ifndef PH_G2
#define PH_G2 1
#endif
#ifndef PH_TREG
#define PH_TREG (-1)
#endif
#if PH_TREG >= 0
#define TREG_MARK(r) do { const unsigned long long now_ = __builtin_amdgcn_s_memrealtime(); if ((r) == PH_TREG) tacc_ += now_ - tlast_; tlast_ = now_; } while (0)
#define TREG_SUB(r) do { const unsigned long long now_ = __builtin_amdgcn_s_memrealtime(); if ((r) == PH_TREG) tacc_ += now_ - tsub_; tsub_ = now_; } while (0)
#else
#define TREG_MARK(r) do { } while (0)
#define TREG_SUB(r) do { } while (0)
#endif
struct Args { const void* in[27]; float* out; unsigned char* ws; };
__global__ void __launch_bounds__(NTHREADS, 2) mk_fwd(Args args) {
    extern __shared__ __attribute__((aligned(16))) unsigned char lds_raw[];
    Frame F;
    F.lds = (LAS unsigned char*)lds_raw;
    F.wave = __builtin_amdgcn_readfirstlane((int)threadIdx.x >> 6); F.lane = 0; F.tid = 0;
    F.G = gridDim.x; F.bid = blockIdx.x;
    F.ctl = (gu32*)(KWS() + WS_CTL);
    { const Frame Fp = fresh(F); for (int u = Fp.tid; u < (LDS_BYTES - LDSCTL_OFF) / 4; u += NTHREADS) ((LAS unsigned*)(F.lds + LDSCTL_OFF))[u] = 0u;
      __syncthreads();
      (void)xcd_barrier_post((unsigned*)(F.ctl + CW_BAR), (volatile LAS unsigned*)(F.lds + MISC_OFF) + 8, Fp.tid == 0); }
    const int G = F.G, bid = F.bid;
#if PH_TREG >= 0
    unsigned long long tacc_ = 0ull, tlast_ = __builtin_amdgcn_s_memrealtime(), tsub_ = tlast_;
#endif

        for (int rp_ = 0; rp_ < PH_P0; ++rp_) {
    { Frame Fp = fresh(F); p0_prologue(Fp); }
        }
    GRID_BAR();
    TREG_MARK(0);

    for (int layer = 0; layer < NLAYER; ++layer) {
        for (int rp_ = 0; rp_ < PH_A; ++rp_) {
        {
            const Frame Fg = fresh(F); const int G = Fg.G, bid = Fg.bid;
            unsigned char* ws = KWS();
            pg8::Gemm g{(const bf16*)(ws + WS_XGA), (const bf16*)(ws + WS_WIN + layer * SZ_WIN), MROWS, LDZ, DM, DM, DM, 31, 0};
            pg8::StaticOrder S; S.init(MROWS, LDZ, G, bid);
            epi::EpiA E{(bf16*)(ws + WS_Z), (float*)(ws + WS_ZS), (const float*)(ws + WS_SSA), KOUT(), layer};
            pg8::gemm_phase<epi::EpiA, pg8::StaticOrder, true, true>(Fg.lds, g, S, E, Fg.tid);
        }
        }
        GRID_BAR();
    TREG_MARK(1);
#if PH_TREG >= 0
        tsub_ = __builtin_amdgcn_s_memrealtime();
#endif
        {
            Frame Fp = fresh(F);
            gu32* qhead = F.ctl + CW_QUEUE + 512 * layer + 384;
            volatile LAS int* qslot = (volatile LAS int*)(F.lds + MISC_OFF) + 16;
            constexpr int NI = 5 * 272 * PH_B0d, N2 = 1024 * PH_B0c, N3 = 512 * PH_B0b;
            for (;;) {
                if (Fp.tid == 0) qslot[0] = (int)__hip_atomic_fetch_add(qhead, 1u, __ATOMIC_RELAXED, __HIP_MEMORY_SCOPE_AGENT);
                __syncthreads();
                int it = qslot[0];
                __syncthreads();
                it = __builtin_amdgcn_readfirstlane(it);
                if (it >= NI + N2 + N3) break;
                TREG_SUB(99);
                if (it < NI) { const int k = it / 5, r = it % 5;
                    if (r == 0) compress_job(Fp, layer, k % 272);
                    else if (k < 256 * PH_B0a) gdn_prep_unit(Fp, layer, (4 * k + r - 1) & 1023); }
                else { const int q = it - NI, g3 = q / 3, r3 = q % 3;
                    if (r3 < 2) sample_rec_unit(Fp, layer, (2 * g3 + r3) & 1023); else ret_prep_unit(Fp, layer, g3 & 511); }
                TREG_SUB(it < NI ? ((it % 5) == 0 ? 40 : 41) : (it < NI + N2 ? 42 : 43));
            }
        }
        GRID_BAR();
    TREG_MARK(2);
        {
            Frame Fp = fresh(F);
            gu32* qbase = F.ctl + CW_QUEUE + 512 * layer;
            volatile LAS int* qslot = (volatile LAS int*)(F.lds + MISC_OFF) + 16;
            constexpr int NQ = 8 * PH_SCAN, NS = 128 * PH_NSAS, NR = 32 * PH_RSCAN, NP = 256 * PH_NSAP;
            const int pref = (int)(xb_xcc_id() & 3u);
            for (;;) {
                if (Fp.tid == 0) qslot[1] = (int)__hip_atomic_fetch_add(qbase, 1u, __ATOMIC_RELAXED, __HIP_MEMORY_SCOPE_AGENT);
                __syncthreads();
                int it = qslot[1];
                __syncthreads();
                it = __builtin_amdgcn_readfirstlane(it);
                if (it >= NQ + NR) break;
                TREG_SUB(99);
                if (it < NQ) gdn_scan_chain(Fp, layer, it & 7);
                else ret_scan_part(Fp, layer, (it - NQ) & 31);
                TREG_SUB(it < NQ ? 21 : 23);
            }
            const int when = Fp.bid & 3;
            bool tried = false;
            for (int nu = 0;; ++nu) {
                if (Fp.tid == 0) {
                    int kind = -1, idx = 0;
                    if (!tried && nu >= when) {
                        tried = true;
                        const int a = (int)__hip_atomic_fetch_add(qbase + 320, 1u, __ATOMIC_RELAXED, __HIP_MEMORY_SCOPE_AGENT);
                        if (a < NS) { kind = 4; idx = a; }
                    }
                    if (kind < 0) {
                        for (int k = 0; k < 4 && kind < 0; ++k) { const int s = (pref + k) & 3;
                            if ((int)__hip_atomic_load(qbase + 64 * (1 + s), __ATOMIC_RELAXED, __HIP_MEMORY_SCOPE_AGENT) < NP) {
                                const int r = (int)__hip_atomic_fetch_add(qbase + 64 * (1 + s), 1u, __ATOMIC_RELAXED, __HIP_MEMORY_SCOPE_AGENT);
                                if (r < NP) { kind = s; idx = r; } } }
                    }
                    if (kind < 0) {
                        const int a = (int)__hip_atomic_fetch_add(qbase + 320, 1u, __ATOMIC_RELAXED, __HIP_MEMORY_SCOPE_AGENT);
                        if (a < NS) { kind = 4; idx = a; }
                    }
                    qslot[0] = kind; qslot[1] = idx;
                }
                __syncthreads();
                int kind = qslot[0], it = qslot[1];
                __syncthreads();
                kind = __builtin_amdgcn_readfirstlane(kind); it = __builtin_amdgcn_readfirstlane(it);
                if (kind < 0) break;
                TREG_SUB(99);
                if (kind < 4) nsa_prompt_unit(Fp, layer, (kind << 8) | (255 - (it & 255)));
                else nsa_sample_unit(Fp, layer, it & 127);
                TREG_SUB(kind < 4 ? 20 : 22);
            }
        }
        GRID_BAR();
    TREG_MARK(3);
        for (int rp_ = 0; rp_ < PH_B2; ++rp_) {
        { Frame Fp = fresh(F); for (int u = Fp.bid; u < 512; u += Fp.G) ret_out_unit(Fp, layer, u); }
        { Frame Fp = fresh(F); for (int r = Fp.bid * NWAVES + Fp.wave; r < MROWS; r += Fp.G * NWAVES) gdn_out_row(Fp, layer, r); }
        }
        GRID_BAR();
    TREG_MARK(4);
        for (int rp_ = 0; rp_ < PH_C; ++rp_) {
        {
            const Frame Fg = fresh(F); const int G = Fg.G, bid = Fg.bid;
            unsigned char* ws = KWS();
            pg8::Gemm g{(const bf16*)(ws + WS_MIX), (const bf16*)(ws + WS_WBR + layer * SZ_WBR), MP, 3072, 512, 1536, 512, 2, 1024};
            pg8::BranchOrder S; S.init(MP, G, bid);
            epi::EpiCM E{(const bf16*)(ws + WS_Z), (bf16*)(ws + WS_MRG), (float*)(ws + WS_PART)};
            pg8::gemm_phase<epi::EpiCM, pg8::BranchOrder, true, true>(Fg.lds, g, S, E, Fg.tid);
            TREG_SUB(99);
            {
                Frame Fs = fresh(F); const SEpiC Es{(const bf16*)(ws + WS_Z), (bf16*)(ws + WS_GATED)};
                for (int tl = Fs.bid; tl < 16 * 48; tl += Fs.G) { const int rt = tl & 15, ct = tl >> 4, b = ct >> 4;
                    sgemm_tile(Fs, (const bf16*)(ws + WS_MIX) + b * 512, 1536, (const bf16*)(ws + WS_WBR + layer * SZ_WBR), 512, 512, MP + 32 * rt, 64 * ct, Es); }
            }
            TREG_SUB(31);
        }
        }
        GRID_BAR();
    TREG_MARK(5);
        for (int rp_ = 0; rp_ < PH_D; ++rp_) {
        {
            const Frame Fg = fresh(F); const int G = Fg.G, bid = Fg.bid;
            unsigned char* ws = KWS();
            pg8::Gemm g{(const bf16*)(ws + WS_MRG), (const bf16*)(ws + WS_WO3 + layer * SZ_WO3), MP, DM, DM, DM, 3072, 31, 0};
            pg8::StaticOrder S; S.init(MP, DM, G, bid);
            epi::EpiRes E{(float*)(ws + WS_XR), (bf16*)(ws + WS_XGB), KIN(21) + layer * DM, (float*)(ws + WS_SSB), nullptr, (rp_ + 1 < PH_D) ? 3 : 0, layer == 0 ? KIN(0) : (const float*)(ws + WS_XR)};
            pg8::gemm_phase<epi::EpiRes, pg8::StaticOrder, true, true>(Fg.lds, g, S, E, Fg.tid);
            TREG_SUB(99);
            if (rp_ + 1 == PH_D) {
                Frame Fs = fresh(F); const SEpiRes Es{(float*)(ws + WS_XR), (bf16*)(ws + WS_XGB), KIN(21) + layer * DM, (float*)(ws + WS_SSB), nullptr, 0, layer == 0 ? KIN(1) - (size_t)MP * DM : (const float*)(ws + WS_XR)};
                for (int tl = Fs.bid; tl < 256; tl += Fs.G) sgemm_tile(Fs, (const bf16*)(ws + WS_GATED), 3072, (const bf16*)(ws + WS_WO3 + layer * SZ_WO3), 3072, 3072, MP + 32 * (tl & 15), 64 * (tl >> 4), Es);
            }
            TREG_SUB(32);
        }
        }
        GRID_BAR();
    TREG_MARK(6);
        for (int rp_ = 0; rp_ < PH_E; ++rp_) {
        {
            const Frame Fg = fresh(F); const int G = Fg.G, bid = Fg.bid;
            unsigned char* ws = KWS();
            pg8::Gemm g{(const bf16*)(ws + WS_XGB), (const bf16*)(ws + WS_WUP + layer * SZ_WUP), MP, DFF, DM, DM, DM, 31, 0};
            pg8::StaticOrder S; S.init(MP, DFF, G, bid);
            epi::EpiUp E{(bf16*)(ws + WS_HMID), (const float*)(ws + WS_SSB)};
            pg8::gemm_phase<epi::EpiUp, pg8::StaticOrder, true, true>(Fg.lds, g, S, E, Fg.tid);
            TREG_SUB(99);
            {
                Frame Fs = fresh(F); const SEpiUp Es{(bf16*)(ws + WS_HMID), (const float*)(ws + WS_SSB)};
                for (int tl = Fs.bid; tl < 16 * 64; tl += Fs.G) sgemm_tile(Fs, (const bf16*)(ws + WS_XGB), DM, (const bf16*)(ws + WS_WUP + layer * SZ_WUP), DM, DM, MP + 32 * (tl & 15), 64 * (tl >> 4), Es);
            }
            TREG_SUB(33);
        }
        }
        GRID_BAR();
    TREG_MARK(7);
        for (int rp_ = 0; rp_ < PH_F; ++rp_) {
        {
            const Frame Fg = fresh(F); const int G = Fg.G, bid = Fg.bid;
            unsigned char* ws = KWS();
            pg8::Gemm g{(const bf16*)(ws + WS_HMID), (const bf16*)(ws + WS_WDN + layer * SZ_WDN), MP, DM, DFF, DFF, DFF, 31, 0};
            pg8::StaticOrder S; S.init(MP, DM, G, bid);
            epi::EpiRes E{(float*)(ws + WS_XR), (bf16*)(ws + WS_XGC), nullptr, nullptr, nullptr, (rp_ + 1 < PH_F) ? 3 : 0, (const float*)(ws + WS_XR)};
            pg8::gemm_phase<epi::EpiRes, pg8::StaticOrder, true, true>(Fg.lds, g, S, E, Fg.tid);
            TREG_SUB(99);
            if (rp_ + 1 == PH_F) {
                Frame Fs = fresh(F); const SEpiRes Es{(float*)(ws + WS_XR), (bf16*)(ws + WS_XGC), nullptr, nullptr, nullptr, 0, (const float*)(ws + WS_XR)};
                for (int tl = Fs.bid; tl < 256; tl += Fs.G) sgemm_tile(Fs, (const bf16*)(ws + WS_HMID), DFF, (const bf16*)(ws + WS_WDN + layer * SZ_WDN), DFF, DFF, MP + 32 * (tl & 15), 64 * (tl >> 4), Es);
            }
            TREG_SUB(34);
        }
        }
        GRID_BAR();
    TREG_MARK(8);
        for (int rp_ = 0; rp_ < PH_G1; ++rp_) {
        {
            const Frame Fg = fresh(F); const int G = Fg.G, bid = Fg.bid;
            unsigned char* ws = KWS();
            int kple = PLE; asm volatile("" : "+s"(kple));
            pg8::Gemm g{(const bf16*)(ws + WS_P16) + (size_t)layer * MROWS * PLE, (const bf16*)(ws + WS_WPL + layer * SZ_WPL), MP, DM, kple, PLE, PLE, 31, 0};
            pg8::StaticOrder S; S.init(MP, DM, G, bid);
            epi::EpiRes E{nullptr, nullptr, nullptr, nullptr, (float*)(ws + WS_TPLE), 1, nullptr};
            pg8::gemm_phase<epi::EpiRes, pg8::StaticOrder, true, true>(Fg.lds, g, S, E, Fg.tid);
            TREG_SUB(99);
            {
                Frame Fs = fresh(F); const SEpiRes Es{nullptr, nullptr, nullptr, nullptr, (float*)(ws + WS_TPLE), 1, nullptr};
                for (int tl = Fs.bid; tl < 256; tl += Fs.G) sgemm_tile(Fs, (const bf16*)(ws + WS_P16) + (size_t)layer * MROWS * PLE, PLE, (const bf16*)(ws + WS_WPL + layer * SZ_WPL), PLE, PLE, MP + 32 * (tl & 15), 64 * (tl >> 4), Es);
            }
            TREG_SUB(35);
        }
        }
        for (int rp_ = 0; rp_ < PH_G2; ++rp_) {
        {
            const Frame Fg = fresh(F); const int G = Fg.G, bid = Fg.bid;
            unsigned char* ws = KWS();
            const bool more = layer + 1 < NLAYER;
            pg8::Gemm g{(const bf16*)(ws + WS_XGC), (const bf16*)(ws + WS_WPG + layer * SZ_WPG), MP, DM, DM, DM, DM, 31, 0};
            pg8::StaticOrder S; S.init(MP, DM, G, bid);
            epi::EpiRes E{(float*)(ws + WS_XR), more ? (bf16*)(ws + WS_XGA) : nullptr, more ? KIN(10) + (layer + 1) * DM : nullptr, more ? (float*)(ws + WS_SSA) : nullptr, (float*)(ws + WS_TPLE), (rp_ + 1 < PH_G2) ? 3 : 2, (const float*)(ws + WS_XR)};
            pg8::gemm_phase<epi::EpiRes, pg8::StaticOrder, true, true>(Fg.lds, g, S, E, Fg.tid);
            TREG_SUB(99);
            if (rp_ + 1 == PH_G2) {
                Frame Fs = fresh(F); const SEpiRes Es{(float*)(ws + WS_XR), more ? (bf16*)(ws + WS_XGA) : nullptr, more ? KIN(10) + (layer + 1) * DM : nullptr, more ? (float*)(ws + WS_SSA) : nullptr, (float*)(ws + WS_TPLE), 2, (const float*)(ws + WS_XR)};
                for (int tl = Fs.bid; tl < 256; tl += Fs.G) sgemm_tile(Fs, (const bf16*)(ws + WS_XGC), DM, (const bf16*)(ws + WS_WPG + layer * SZ_WPG), DM, DM, MP + 32 * (tl & 15), 64 * (tl >> 4), Es);
            }
            TREG_SUB(36);
        }
        }
        GRID_BAR();
    TREG_MARK(9);
    }
    for (int xb_ = 0; xb_ < PH_XBAR; ++xb_) GRID_BAR();
    { Frame Fp = fresh(F); for (int r = Fp.bid * NWAVES + Fp.wave; r < MROWS; r += Fp.G * NWAVES) final_row(Fp, r); }
    TREG_MARK(10);
#if PH_TREG >= 0
#if defined(PH_GPT) && PH_GPT >= 0
    tacc_ += *(volatile LAS unsigned long long*)(F.lds + LDSCTL_OFF + 448);
#endif
#if defined(PH_NPT) && PH_NPT >= 0
    tacc_ += *(volatile LAS unsigned long long*)(F.lds + LDSCTL_OFF + 464);
#endif
      { const unsigned long long tend_ = __builtin_amdgcn_s_memrealtime() + tacc_; while (__builtin_amdgcn_s_memrealtime() < tend_) __builtin_amdgcn_s_sleep(8); }
#endif
}

extern "C" void kernel_launch(void* const* d_in, const int* in_sizes, int n_in, void* d_out, int out_size, void* d_ws, size_t ws_size, hipStream_t stream) {
    static int grid = 0;
    if (grid == 0) {
        if (n_in != 27 || ws_size < WS_END) { fprintf(stderr, "kernel_launch: unexpected shapes (n_in %d out %d ws %zu, need %zu)\n", n_in, out_size, ws_size, (size_t)WS_END); grid = -1; return; }
        int dev = 0, cus = 0;
        if (hipGetDevice(&dev) != hipSuccess || hipDeviceGetAttribute(&cus, hipDeviceAttributeMultiprocessorCount, dev) != hipSuccess) { grid = -1; return; }
        if (hipFuncSetAttribute((const void*)mk_fwd, hipFuncAttributeMaxDynamicSharedMemorySize, LDS_BYTES) != hipSuccess) { fprintf(stderr, "kernel_launch: hipFuncSetAttribute failed\n"); grid = -1; return; }
        int per_cu = 0;
        if (hipOccupancyMaxActiveBlocksPerMultiprocessor(&per_cu, (const void*)mk_fwd, NTHREADS, LDS_BYTES) != hipSuccess || per_cu < 1) fprintf(stderr, "kernel_launch: occupancy query reports %d\n", per_cu);
        (void)hipGetLastError();
        grid = cus;
    }
    if (grid < 0) return;
    if (hipMemsetAsync((char*)d_ws + WS_CTL, 0, CTL_ZERO_BYTES, stream) != hipSuccess) return;
    Args a{};
    for (int i = 0; i < 27; ++i) a.in[i] = d_in[i];
    a.out = (float*)d_out; a.ws = (unsigned char*)d_ws;
    hipLaunchKernelGGL(mk_fwd, dim3(grid), dim3(NTHREADS), LDS_BYTES, stream, a);
}
```

```cpp
#include <hip/hip_runtime.h>
#include <cstdio>
#include <cstdint>
namespace pg8 {
#define PG8_LAS __attribute__((address_space(3)))
typedef unsigned short bf16_t;
typedef short bf16x8 __attribute__((ext_vector_type(8)));
typedef float f32x4 __attribute__((ext_vector_type(4)));
typedef unsigned u32x4 __attribute__((ext_vector_type(4)));
constexpr int BM = 256, BK = 64, HALF = 128, HTB = HALF * BK * 2  , STAGE_BYTES = 8 * HTB, NXCD = 8, WGM = 8;

__host__ __device__ __forceinline__ int lds_byte(int r, int c) { const int st = (r >> 4) * 2 + (c >> 5), rr = r & 15, cc = c & 31, ob = rr * 64 + cc * 2; return st * 1024 + (ob ^ (((ob >> 9) & 1) << 5)); }
__host__ __device__ __forceinline__ void stage_rc(int b, int& R, int& C) { const int st = b / 1024, sb = b % 1024, swz = sb ^ (((sb >> 9) & 1) << 5); R = (st >> 1) * 16 + swz / 64; C = (st & 1) * 32 + (swz % 64) / 2; }
__host__ __device__ __forceinline__ int perm32(int rho) { const int n = rho >> 4, i = rho & 15; return 8 * (i >> 2) + 4 * n + (i & 3); }

struct Unit { int pm, pn; };
struct Gemm { const bf16_t* A; const bf16_t* Bt; int M, N, K; int lda, ldb; int a_shift, a_off; };

struct StaticOrder {
    int nM, nN, nwg, G, c;
    __host__ __device__ void init(int M, int N, int G_, int c_) { nM = M / BM; nN = N / BM; nwg = nM * nN; G = G_; c = c_; }
    __host__ __device__ bool next(int i, Unit& u) const {
        const long L = (long)i * G + c; if (L >= nwg) return false;
        int wgid = (int)L; { const int q = nwg / NXCD, r = nwg % NXCD, xcd = wgid % NXCD, off = wgid / NXCD; wgid = (xcd < r ? xcd * (q + 1) : r * (q + 1) + (xcd - r) * q) + off; }
        const int nig = WGM * nN, gid = wgid / nig, fm = gid * WGM, gsz = (nM - fm) < WGM ? (nM - fm) : WGM;
        u.pm = fm + ((wgid % nig) % gsz); u.pn = (wgid % nig) / gsz; return true;
    }
    __device__ __forceinline__ void a_ready(const Unit&) const {}
    __device__ __forceinline__ void done(const Unit&) const {}
};

__device__ __forceinline__ unsigned cvt_pk_bf16(float lo, float hi) { unsigned r; asm volatile("v_cvt_pk_bf16_f32 %0, %1, %2" : "=v"(r) : "v"(lo), "v"(hi)); return r; }
typedef float f32x2 __attribute__((ext_vector_type(2)));
template <class Epi, class Sched, bool ALIGN_EPI = false, bool SP2 = false>
__device__ __forceinline__ void gemm_phase(PG8_LAS unsigned char* lds, const Gemm g, const Sched& S, const Epi& E, const int tid) {
    const int wid = __builtin_amdgcn_readfirstlane(tid >> 6), lane = tid & 63, wr = wid >> 2, wc = wid & 3, fr = lane & 15, fq = lane >> 4;
    const int K = g.K, nt = K / BK;
    unsigned voffA[2], voffB[2];
#pragma unroll
    for (int i = 0; i < 2; ++i) { int R, C; stage_rc(tid * 16 + i * 8192, R, C); const int Rb = Epi::PERM ? ((R & ~31) + perm32(R & 31)) : R;
        voffA[i] = (unsigned)(R * g.lda + C) * 2u; voffB[i] = (unsigned)(Rb * g.ldb + C) * 2u; }
    const size_t kstep = (size_t)(BK * 2);
    const size_t hstepA = (size_t)HALF * g.lda * 2, hstepB = (size_t)HALF * g.ldb * 2;
    const size_t tstepA = 2 * hstepA, tstepB = 2 * hstepB;
    const unsigned ldsw = (unsigned)wid * 1024u;
    const int aoff = lds_byte(wr * 64 + fr, fq * 8), boff = lds_byte(wc * 32 + fr, fq * 8);
#define PG8_SA(b, h) (((b) * 2 + (h)) * HTB)
#define PG8_SB(b, h) ((4 + (b) * 2 + (h)) * HTB)
#define PG8_STAGE(bufoff, gbase, voff) do { _Pragma("unroll") for (int _i = 0; _i < 2; ++_i) \
        __builtin_amdgcn_global_load_lds((const unsigned*)((const char*)(gbase) + (voff)[_i]), (PG8_LAS unsigned*)(lds + (bufoff) + ldsw + _i * 8192), 16, 0, 0); } while (0)
#define PG8_LDA(dst, b, h) do { _Pragma("unroll") for (int m = 0; m < 4; ++m) _Pragma("unroll") for (int k = 0; k < 2; ++k) dst[m][k] = *(const PG8_LAS bf16x8*)(lds + PG8_SA(b, h) + aoff + m * 2048 + k * 1024); } while (0)
#define PG8_LDB(dst, b, h) do { _Pragma("unroll") for (int n = 0; n < 2; ++n) _Pragma("unroll") for (int k = 0; k < 2; ++k) dst[n][k] = *(const PG8_LAS bf16x8*)(lds + PG8_SB(b, h) + boff + n * 2048 + k * 1024); } while (0)
#define PG8_MMA(ai, bj, At, Bt) do { __builtin_amdgcn_s_setprio(1); _Pragma("unroll") for (int m = 0; m < 4; ++m) _Pragma("unroll") for (int n = 0; n < 2; ++n) _Pragma("unroll") for (int k = 0; k < 2; ++k) \
        acc[ai][bj][m][n] = __builtin_amdgcn_mfma_f32_16x16x32_bf16(Bt[n][k], At[m][k], acc[ai][bj][m][n], 0, 0, 0); __builtin_amdgcn_s_setprio(0); } while (0)
#define PG8_WAIT_V(n) asm volatile("s_waitcnt vmcnt(" #n ")" ::: "memory")
#define PG8_WAIT_L(n) asm volatile("s_waitcnt lgkmcnt(" #n ")" ::: "memory")
#define PG8_BAR __builtin_amdgcn_s_barrier()
#define PG8_SCHED __builtin_amdgcn_sched_barrier(0)
    Unit cur, nxt; int ui = 0;
    if (!S.next(0, cur)) return;
    f32x4 acc[2][2][4][2];
#pragma unroll
    for (int a = 0; a < 2; ++a)
#pragma unroll
        for (int b = 0; b < 2; ++b)
#pragma unroll
            for (int m = 0; m < 4; ++m)
#pragma unroll
                for (int n = 0; n < 2; ++n) acc[a][b][m][n] = (f32x4){0.f, 0.f, 0.f, 0.f};
    bf16x8 At[4][2], B0[2][2], B1[2][2];
    const char* cA = (const char*)g.A + (size_t)cur.pm * tstepA + (size_t)(cur.pn >> g.a_shift) * (size_t)g.a_off; const char* cB = (const char*)g.Bt + (size_t)cur.pn * tstepB;
    S.a_ready(cur);
    if constexpr (SP2) {
        PG8_STAGE(PG8_SB(0, 0), cB, voffB); PG8_STAGE(PG8_SB(0, 1), cB + hstepB, voffB); PG8_STAGE(PG8_SA(0, 0), cA, voffA); PG8_STAGE(PG8_SA(0, 1), cA + hstepA, voffA);
        if (wr == 1) PG8_BAR;
        PG8_WAIT_V(2); PG8_BAR;
        PG8_STAGE(PG8_SB(1, 0), cB + kstep, voffB); PG8_STAGE(PG8_SA(1, 0), cA + kstep, voffA); PG8_STAGE(PG8_SB(1, 1), cB + hstepB + kstep, voffB);
        PG8_WAIT_V(6); PG8_BAR;
    } else {
        PG8_STAGE(PG8_SB(0, 0), cB, voffB); PG8_STAGE(PG8_SA(0, 0), cA, voffA); PG8_STAGE(PG8_SB(0, 1), cB + hstepB, voffB); PG8_STAGE(PG8_SA(0, 1), cA + hstepA, voffA);
        if (wr == 1) PG8_BAR;
        PG8_WAIT_V(4); PG8_BAR;
        PG8_STAGE(PG8_SB(1, 0), cB + kstep, voffB); PG8_STAGE(PG8_SA(1, 0), cA + kstep, voffA); PG8_STAGE(PG8_SB(1, 1), cB + hstepB + kstep, voffB);
        PG8_WAIT_V(6); PG8_BAR;
    }
    for (;;) {
        const bool has_next = S.next(ui + 1, nxt);
        const char* nA = has_next ? (const char*)g.A + (size_t)nxt.pm * tstepA + (size_t)(nxt.pn >> g.a_shift) * (size_t)g.a_off : cA; const char* nB = has_next ? (const char*)g.Bt + (size_t)nxt.pn * tstepB : cB;
        for (int t = 0; t < nt; t += 2) {
            const bool last = (t == nt - 2);
            const char* a1 = cA + (size_t)(t + 1) * kstep;
            const char* a2 = last ? nA : cA + (size_t)(t + 2) * kstep; const char* b2 = last ? nB : cB + (size_t)(t + 2) * kstep;
            const char* a3 = a2 + kstep; const char* b3 = b2 + kstep;
            if (last && has_next) S.a_ready(nxt);
            if constexpr (SP2) {
            PG8_LDB(B0, 0, 0); PG8_LDB(B1, 0, 1); PG8_SCHED; PG8_LDA(At, 0, 0); PG8_STAGE(PG8_SA(1, 1), a1 + hstepA, voffA);
            PG8_WAIT_V(8); PG8_WAIT_L(0); PG8_BAR; PG8_MMA(0, 0, At, B0); PG8_MMA(0, 1, At, B1); PG8_BAR; PG8_SCHED;
            PG8_LDA(At, 0, 1); PG8_STAGE(PG8_SB(0, 0), b2, voffB); PG8_STAGE(PG8_SB(0, 1), b2 + hstepB, voffB); PG8_STAGE(PG8_SA(0, 0), a2, voffA);
            PG8_WAIT_V(8); PG8_WAIT_L(0); PG8_BAR; PG8_MMA(1, 0, At, B0); PG8_MMA(1, 1, At, B1); PG8_BAR; PG8_SCHED;
            PG8_LDB(B0, 1, 0); PG8_LDB(B1, 1, 1); PG8_SCHED; PG8_LDA(At, 1, 0); PG8_STAGE(PG8_SA(0, 1), a2 + hstepA, voffA);
            PG8_WAIT_V(8); PG8_WAIT_L(0); PG8_BAR; PG8_MMA(0, 0, At, B0); PG8_MMA(0, 1, At, B1); PG8_BAR; PG8_SCHED;
            PG8_LDA(At, 1, 1); PG8_STAGE(PG8_SB(1, 0), b3, voffB); PG8_STAGE(PG8_SB(1, 1), b3 + hstepB, voffB); PG8_STAGE(PG8_SA(1, 0), a3, voffA);
            PG8_WAIT_V(8); PG8_WAIT_L(0); PG8_BAR; PG8_MMA(1, 0, At, B0); PG8_MMA(1, 1, At, B1); PG8_BAR; PG8_SCHED;
            } else {
            PG8_LDB(B0, 0, 0); PG8_SCHED; PG8_LDA(At, 0, 0); PG8_STAGE(PG8_SA(1, 1), a1 + hstepA, voffA);
            PG8_WAIT_L(8); PG8_BAR; PG8_WAIT_L(0); PG8_MMA(0, 0, At, B0); PG8_BAR; PG8_SCHED;
            PG8_LDB(B1, 0, 1); PG8_STAGE(PG8_SB(0, 0), b2, voffB);
            PG8_BAR; PG8_WAIT_L(0); PG8_MMA(0, 1, At, B1); PG8_BAR;
            PG8_LDA(At, 0, 1); PG8_STAGE(PG8_SA(0, 0), a2, voffA);
            PG8_BAR; PG8_WAIT_L(0); PG8_MMA(1, 0, At, B0); PG8_BAR; PG8_SCHED;
            PG8_STAGE(PG8_SB(0, 1), b2 + hstepB, voffB);
            PG8_WAIT_V(6); PG8_BAR; PG8_MMA(1, 1, At, B1); PG8_BAR;
            PG8_LDB(B0, 1, 0); PG8_SCHED; PG8_LDA(At, 1, 0); PG8_STAGE(PG8_SA(0, 1), a2 + hstepA, voffA);
            PG8_WAIT_L(8); PG8_BAR; PG8_WAIT_L(0); PG8_MMA(0, 0, At, B0); PG8_BAR; PG8_SCHED;
            PG8_LDB(B1, 1, 1); PG8_STAGE(PG8_SB(1, 0), b3, voffB);
            PG8_BAR; PG8_WAIT_L(0); PG8_MMA(0, 1, At, B1); PG8_BAR;
            PG8_LDA(At, 1, 1); PG8_STAGE(PG8_SA(1, 0), a3, voffA);
            PG8_BAR; PG8_WAIT_L(0); PG8_MMA(1, 0, At, B0); PG8_BAR; PG8_SCHED;
            PG8_STAGE(PG8_SB(1, 1), b3 + hstepB, voffB);
            PG8_WAIT_V(6); PG8_BAR; PG8_MMA(1, 1, At, B1); PG8_BAR;
            }
        }
        if constexpr (ALIGN_EPI) { if (wr == 0) PG8_BAR; }
        if constexpr (!Epi::AFTER_DRAIN) { E(acc, cur, wr, wc, fr, fq); S.done(cur); }
        if (!has_next) break;
#pragma unroll
        for (int a = 0; a < 2; ++a)
#pragma unroll
            for (int b = 0; b < 2; ++b)
#pragma unroll
                for (int m = 0; m < 4; ++m)
#pragma unroll
                    for (int n = 0; n < 2; ++n) acc[a][b][m][n] = (f32x4){0.f, 0.f, 0.f, 0.f};
        cur = nxt; cA = nA; cB = nB; ++ui;
        if constexpr (ALIGN_EPI) { if (wr == 1) PG8_BAR; }
    }
    PG8_WAIT_V(0);
    if constexpr (!ALIGN_EPI) { if (wr == 0) PG8_BAR; }
    PG8_BAR;
    if constexpr (Epi::AFTER_DRAIN) { E.fused(acc, cur, wr, wc, fr, fq, lds, wid, lane); S.done(cur); }
#undef PG8_SA
#undef PG8_SB
#undef PG8_STAGE
#undef PG8_LDA
#undef PG8_LDB
#undef PG8_MMA
#undef PG8_WAIT_V
#undef PG8_WAIT_L
#undef PG8_BAR
#undef PG8_SCHED
}
}
#define DI __device__ __forceinline__
#define GAS __attribute__((address_space(1)))
#define LAS __attribute__((address_space(3)))
typedef unsigned short bf16;
typedef unsigned v4u __attribute__((ext_vector_type(4)));
typedef unsigned v2u __attribute__((ext_vector_type(2)));
typedef float f32x4 __attribute__((ext_vector_type(4)));
typedef float f32x2 __attribute__((ext_vector_type(2)));
typedef short bf16x8 __attribute__((ext_vector_type(8)));
typedef short s16x4 __attribute__((ext_vector_type(4)));
typedef GAS unsigned gu32;

constexpr int DM = 1024, TP = 8192, MP = 16384, MS = 512, MROWS = 16896, LDZ = 8704, DFF = 4096, PLE = 256, NLAYER = 2;
constexpr int ZC_Q = 0, ZC_KC = 512, ZC_VC = 640, ZC_KS = 768, ZC_VS = 896, ZC_KW = 1024, ZC_VW = 1152, ZC_GQKV = 1280, ZC_GZ = 2816, ZC_RQKV = 3328, ZC_RG = 4864, ZC_MG = 5376, ZC_SM = 8448;
constexpr float EPS = 1e-6f;
constexpr size_t O_YP = 0, O_YS = O_YP + (size_t)MP * DM, O_KVP = O_YS + (size_t)MS * DM, O_KVS = O_KVP + (size_t)2 * MP * 512, O_WINP = O_KVS + (size_t)2 * MS * 512,
                 O_WINS = O_WINP + (size_t)2 * 2 * 512 * 256, O_CVP = O_WINS + (size_t)2 * 128 * 512 * 256, O_CVS = O_CVP + (size_t)2 * 2 * 3 * 1536, O_GSP = O_CVS + (size_t)2 * 128 * 3 * 1536,
                 O_GSS = O_GSP + (size_t)2 * 2 * 4 * 16384, O_RSP = O_GSS + (size_t)2 * 128 * 4 * 16384, O_RSS = O_RSP + (size_t)2 * 2 * 4 * 16384, O_END = O_RSS + (size_t)2 * 128 * 4 * 16384;

DI float bf2f(unsigned short b) { return __uint_as_float((unsigned)b << 16); }
DI unsigned f2bf(float f) { unsigned u = __float_as_uint(f); return (u + 0x7fffu + ((u >> 16) & 1u)) >> 16; }
typedef __bf16 bf16x2_t __attribute__((ext_vector_type(2)));
DI unsigned pk2(float lo, float hi) { const f32x2 v = {lo, hi}; return __builtin_bit_cast(unsigned, __builtin_convertvector(v, bf16x2_t)); }
DI float lo_bf(unsigned w) { return __uint_as_float(w << 16); }
DI float hi_bf(unsigned w) { return __uint_as_float(w & 0xffff0000u); }
DI float sigmoidf_(float x) { return 1.f / (1.f + __expf(-x)); }
DI float siluf_(float x) { return x / (1.f + __expf(-x)); }
DI v4u pack8(const f32x4 a, const f32x4 b) { v4u w; w.x = pk2(a[0], a[1]); w.y = pk2(a[2], a[3]); w.z = pk2(b[0], b[1]); w.w = pk2(b[2], b[3]); return w; }
DI void unpack8(const v4u w, f32x4& a, f32x4& b) { a[0] = lo_bf(w.x); a[1] = hi_bf(w.x); a[2] = lo_bf(w.y); a[3] = hi_bf(w.y); b[0] = lo_bf(w.z); b[1] = hi_bf(w.z); b[2] = lo_bf(w.w); b[3] = hi_bf(w.w); }

template <int M> DI int shxi(int v, int lane) {
    if constexpr (M < 32) return __builtin_amdgcn_ds_swizzle(v, (M << 10) | 0x1f);
    else return __builtin_amdgcn_ds_bpermute((lane ^ 32) << 2, v);
}
template <int M> DI float shx(float v, int lane) { return __int_as_float(shxi<M>(__float_as_int(v), lane)); }
DI float wave_sum(float v, int lane) { v += shx<1>(v, lane); v += shx<2>(v, lane); v += shx<4>(v, lane); v += shx<8>(v, lane); v += shx<16>(v, lane); v += shx<32>(v, lane); return v; }

namespace epi {
using pg8::Unit; using pg8::bf16_t;
DI float row_rstd(const float* SS, int row, int fq, int lane) {
    const f32x4 p = *(const f32x4*)(SS + (size_t)row * 16 + 4 * fq);
    float s = (p[0] + p[1]) + (p[2] + p[3]); s += shx<16>(s, lane); s += shx<32>(s, lane);
    return rsqrtf(s * (1.f / DM) + EPS);
}
struct EpiA {
    static constexpr bool PERM = true, AFTER_DRAIN = false;
    bf16* Z; float* ZS; const float* SS; float* out; int layer;
    DI void operator()(const f32x4 (&acc)[2][2][4][2], const Unit& u, int wr, int wc, int fr, int fq) const {
        asm volatile("" : "+v"(fr), "+v"(fq), "+s"(wr), "+s"(wc));
        const int pn = u.pn;
        float rs[2][4];
#pragma unroll
        for (int ai = 0; ai < 2; ++ai)
#pragma unroll
            for (int m = 0; m < 4; ++m) rs[ai][m] = row_rstd(SS, u.pm * 256 + ai * 128 + wr * 64 + m * 16 + fr, fq, fr + 16 * fq);
#pragma unroll
        for (int ai = 0; ai < 2; ++ai)
#pragma unroll
            for (int m = 0; m < 4; ++m) {
                const int row = u.pm * 256 + ai * 128 + wr * 64 + m * 16 + fr;
                const float rstd = rs[ai][m];
#pragma unroll
                for (int bj = 0; bj < 2; ++bj) {
                    const int col = pn * 256 + bj * 128 + wc * 32 + 8 * fq;
                    const f32x4 v0 = acc[ai][bj][m][0] * rstd, v1 = acc[ai][bj][m][1] * rstd;
                    *(v4u*)(Z + (size_t)row * LDZ + col) = pack8(v0, v1);
                    float* dst = nullptr;
                    if (pn == 2 || pn == 3) {
                        dst = (row < MP) ? out + O_KVP + ((size_t)layer * MP + row) * 512 + (col - 512) : out + O_KVS + ((size_t)layer * MS + (row - MP)) * 512 + (col - 512);
                    } else if (pn == 4) {
                        const int c2 = col - 1024;
                        if (row < MP) { const int t = row & (TP - 1), b = row >> 13; if (t >= TP - 512) dst = out + O_WINP + ((size_t)(layer * 2 + b) * 512 + (t - (TP - 512))) * 256 + c2; }
                        else { const int r2 = row - MP, s = r2 >> 2, j = r2 & 3; dst = out + O_WINS + ((size_t)(layer * 128 + s) * 512 + 508 + j) * 256 + c2; }
                    } else if (pn >= 5 && pn < 11) {
                        const int c2 = col - 1280;
                        if (row < MP) { const int t = row & (TP - 1), b = row >> 13; if (t >= TP - 3) dst = out + O_CVP + ((size_t)(layer * 2 + b) * 3 + (t - (TP - 3))) * 1536 + c2; }
                        else { const int r2 = row - MP, s = r2 >> 2, j = r2 & 3; if (j >= 1) dst = out + O_CVS + ((size_t)(layer * 128 + s) * 3 + (j - 1)) * 1536 + c2; }
                    } else if (pn == 33) {
                        if (bj == 0 && wc == 0) dst = ZS + (size_t)row * 32 + 8 * fq;
                    }
                    if (dst) { *(f32x4*)dst = v0; *(f32x4*)(dst + 4) = v1; }
                }
                asm volatile("" ::: "memory");
            }
    }
};
struct EpiC {
    static constexpr bool PERM = true, AFTER_DRAIN = false;
    const bf16* Z; bf16* G;
    DI void operator()(const f32x4 (&acc)[2][2][4][2], const Unit& u, int wr, int wc, int fr, int fq) const {
        asm volatile("" : "+v"(fr), "+v"(fq), "+s"(wr), "+s"(wc));
#pragma unroll
        for (int ai = 0; ai < 2; ++ai) {
            v4u gw[4][2];
#pragma unroll
            for (int m = 0; m < 4; ++m)
#pragma unroll
                for (int bj = 0; bj < 2; ++bj) gw[m][bj] = *(const v4u*)(Z + (size_t)(u.pm * 256 + ai * 128 + wr * 64 + m * 16 + fr) * LDZ + ZC_MG + u.pn * 256 + bj * 128 + wc * 32 + 8 * fq);
#pragma unroll
            for (int m = 0; m < 4; ++m) {
                const int row = u.pm * 256 + ai * 128 + wr * 64 + m * 16 + fr;
#pragma unroll
                for (int bj = 0; bj < 2; ++bj) {
                    const int col = u.pn * 256 + bj * 128 + wc * 32 + 8 * fq;
                    f32x4 g0, g1; unpack8(gw[m][bj], g0, g1);
                    f32x4 v0 = acc[ai][bj][m][0], v1 = acc[ai][bj][m][1];
#pragma unroll
                    for (int e = 0; e < 4; ++e) { v0[e] *= sigmoidf_(g0[e]); v1[e] *= sigmoidf_(g1[e]); }
                    *(v4u*)(G + (size_t)row * 3072 + col) = pack8(v0, v1);
                }
            }
            asm volatile("" ::: "memory");
        }
    }
};
struct EpiCM {
    static constexpr bool PERM = true, AFTER_DRAIN = false;
    const bf16* Z; bf16* MRG; float* PART;
    DI void operator()(const f32x4 (&acc)[2][2][4][2], const Unit& u, int wr, int wc, int fr, int fq) const {
        asm volatile("" : "+v"(fr), "+v"(fq), "+s"(wr), "+s"(wc));
        const int b = u.pn >> 2, pn4 = u.pn & 3;
#pragma unroll
        for (int ai = 0; ai < 2; ++ai)
#pragma unroll
            for (int mp = 0; mp < 2; ++mp) {
                v4u gw[2][2], pw[2][2];
#pragma unroll
                for (int mm = 0; mm < 2; ++mm)
#pragma unroll
                    for (int bj = 0; bj < 2; ++bj) { gw[mm][bj] = *(const v4u*)(Z + (size_t)(u.pm * 256 + ai * 128 + wr * 64 + (2 * mp + mm) * 16 + fr) * LDZ + ZC_MG + b * 1024 + pn4 * 256 + bj * 128 + wc * 32 + 8 * fq);
                        pw[mm][bj] = (v4u){0u, 0u, 0u, 0u}; if (b > 0) pw[mm][bj] = *(const v4u*)(MRG + (size_t)(u.pm * 256 + ai * 128 + wr * 64 + (2 * mp + mm) * 16 + fr) * DM + pn4 * 256 + bj * 128 + wc * 32 + 8 * fq); }
#pragma unroll
                for (int mm = 0; mm < 2; ++mm) {
                    const int m = 2 * mp + mm;
                    const int row = u.pm * 256 + ai * 128 + wr * 64 + m * 16 + fr;
#pragma unroll
                    for (int bj = 0; bj < 2; ++bj) {
                        const int oc = pn4 * 256 + bj * 128 + wc * 32 + 8 * fq;
                        const size_t o = (size_t)row * DM + oc;
                        f32x4 g0, g1; unpack8(gw[mm][bj], g0, g1);
                        f32x4 v0 = acc[ai][bj][m][0], v1 = acc[ai][bj][m][1];
#pragma unroll
                        for (int e = 0; e < 4; ++e) { v0[e] *= sigmoidf_(g0[e]); v1[e] *= sigmoidf_(g1[e]); }
                        if (b > 0) { f32x4 p0, p1; unpack8(pw[mm][bj], p0, p1); v0 += p0; v1 += p1; }
                        *(v4u*)(MRG + o) = pack8(v0, v1);
                    }
                }
                asm volatile("" ::: "memory");
            }
    }
};
}
namespace pg8 {
struct BranchOrder {
    StaticOrder S1;
    __host__ __device__ void init(int M, int G_, int c_) { S1.init(M, 1024, G_, c_); }
    __host__ __device__ bool next(int i, Unit& u) const { if (i >= 3) return false; const bool ok = S1.next(0, u); u.pn += 4 * i; return ok; }
    __device__ __forceinline__ void a_ready(const Unit&) const {}
    __device__ __forceinline__ void done(const Unit&) const {}
};
}
namespace epi {
using pg8::Unit; using pg8::bf16_t;
struct EpiRes {
    static constexpr bool PERM = true, AFTER_DRAIN = false;
    float* XR; bf16* XG; const float* gvec; float* SS; float* T; int mode;
    const float* XRr;
    DI void operator()(const f32x4 (&acc)[2][2][4][2], const Unit& u, int wr, int wc, int fr, int fq) const {
        asm volatile("" : "+v"(fr), "+v"(fq), "+s"(wr), "+s"(wc));
        if (mode == 3) return;
        if (mode == 1) {
#pragma unroll
            for (int ai = 0; ai < 2; ++ai)
#pragma unroll
                for (int m = 0; m < 4; ++m)
#pragma unroll
                    for (int bj = 0; bj < 2; ++bj) { const size_t o = (size_t)(u.pm * 256 + ai * 128 + wr * 64 + m * 16 + fr) * DM + u.pn * 256 + bj * 128 + wc * 32 + 8 * fq;
                        *(v4u*)((bf16*)T + o) = pack8(acc[ai][bj][m][0], acc[ai][bj][m][1]); }
            return;
        }
        f32x4 gv[2][2];
#pragma unroll
        for (int bj = 0; bj < 2; ++bj) { gv[bj][0] = f32x4{1.f, 1.f, 1.f, 1.f}; gv[bj][1] = gv[bj][0]; }
        if (XG && gvec) {
#pragma unroll
            for (int bj = 0; bj < 2; ++bj) { const int col = u.pn * 256 + bj * 128 + wc * 32 + 8 * fq; gv[bj][0] = *(const f32x4*)(gvec + col); gv[bj][1] = *(const f32x4*)(gvec + col + 4); }
        }
#pragma unroll
        for (int ai = 0; ai < 2; ++ai)
#pragma unroll
            for (int mp = 0; mp < 2; ++mp) {
                f32x4 xr[2][2][2], tt[2][2][2];
#pragma unroll
                for (int mm = 0; mm < 2; ++mm)
#pragma unroll
                    for (int bj = 0; bj < 2; ++bj) { const size_t o = (size_t)(u.pm * 256 + ai * 128 + wr * 64 + (2 * mp + mm) * 16 + fr) * DM + u.pn * 256 + bj * 128 + wc * 32 + 8 * fq;
                        xr[mm][bj][0] = *(const f32x4*)(XRr + o); xr[mm][bj][1] = *(const f32x4*)(XRr + o + 4);
                        if (mode == 2) unpack8(*(const v4u*)((const bf16*)T + o), tt[mm][bj][0], tt[mm][bj][1]); }
#pragma unroll
                for (int mm = 0; mm < 2; ++mm) {
                    const int m = 2 * mp + mm;
                    const int row = u.pm * 256 + ai * 128 + wr * 64 + m * 16 + fr;
                    float ssq = 0.f;
#pragma unroll
                    for (int bj = 0; bj < 2; ++bj) {
                        const int col = u.pn * 256 + bj * 128 + wc * 32 + 8 * fq;
                        const size_t o = (size_t)row * DM + col;
                        f32x4 a0 = acc[ai][bj][m][0], a1 = acc[ai][bj][m][1];
                        f32x4 x0 = xr[mm][bj][0], x1 = xr[mm][bj][1];
                        if (mode == 2) {
#pragma unroll
                            for (int e = 0; e < 4; ++e) { a0[e] = tt[mm][bj][0][e] * sigmoidf_(a0[e]); a1[e] = tt[mm][bj][1][e] * sigmoidf_(a1[e]); } }
                        x0 += a0; x1 += a1;
                        *(f32x4*)(XR + o) = x0; *(f32x4*)(XR + o + 4) = x1;
                        ssq += (x0[0] * x0[0] + x0[1] * x0[1]) + (x0[2] * x0[2] + x0[3] * x0[3]) + (x1[0] * x1[0] + x1[1] * x1[1]) + (x1[2] * x1[2] + x1[3] * x1[3]);
                        if (XG) { x0 *= gv[bj][0]; x1 *= gv[bj][1];
                            *(v4u*)(XG + o) = pack8(x0, x1); }
                    }
                    if (SS) { ssq += shx<16>(ssq, fr + 16 * fq); ssq += shx<32>(ssq, fr + 16 * fq); if (fq == 0) SS[(size_t)row * 16 + u.pn * 4 + wc] = ssq; }
                }
                asm volatile("" ::: "memory");
            }
    }
};
struct EpiUp {
    static constexpr bool PERM = true, AFTER_DRAIN = false;
    bf16* H; const float* SS;
    DI void operator()(const f32x4 (&acc)[2][2][4][2], const Unit& u, int wr, int wc, int fr, int fq) const {
        asm volatile("" : "+v"(fr), "+v"(fq), "+s"(wr), "+s"(wc));
        float rs[2][4];
#pragma unroll
        for (int ai = 0; ai < 2; ++ai)
#pragma unroll
            for (int m = 0; m < 4; ++m) rs[ai][m] = row_rstd(SS, u.pm * 256 + ai * 128 + wr * 64 + m * 16 + fr, fq, fr + 16 * fq);
#pragma unroll
        for (int ai = 0; ai < 2; ++ai)
#pragma unroll
            for (int m = 0; m < 4; ++m) {
                const int row = u.pm * 256 + ai * 128 + wr * 64 + m * 16 + fr;
                const float rstd = rs[ai][m];
#pragma unroll
                for (int bj = 0; bj < 2; ++bj) {
                    const int col = u.pn * 256 + bj * 128 + wc * 32 + 8 * fq;
                    f32x4 v0 = acc[ai][bj][m][0] * rstd, v1 = acc[ai][bj][m][1] * rstd;
#pragma unroll
                    for (int e = 0; e < 4; ++e) { const float a = fmaxf(v0[e], 0.f), b = fmaxf(v1[e], 0.f); v0[e] = a * a; v1[e] = b * b; }
                    *(v4u*)(H + (size_t)row * DFF + col) = pack8(v0, v1);
                }
                asm volatile("" ::: "memory");
            }
    }
};
}
constexpr size_t al256(size_t x) { return (x + 255) & ~(size_t)255; }
constexpr size_t WS_CTL = 0, CTL_ZERO_BYTES = 1u << 20;
constexpr size_t SZ_WIN = (size_t)LDZ * DM * 2, SZ_WBR = (size_t)3072 * 512 * 2, SZ_WO3 = (size_t)DM * 3072 * 2, SZ_WUP = (size_t)DFF * DM * 2, SZ_WDN = (size_t)DM * DFF * 2,
                 SZ_WPL = (size_t)DM * PLE * 2, SZ_WPG = (size_t)DM * DM * 2, SZ_W1T = (size_t)2 * 64 * 2048 * 2, SZ_W2T = (size_t)2 * 64 * 64 * 2;
constexpr size_t WS_WIN = CTL_ZERO_BYTES, WS_WBR = WS_WIN + 2 * SZ_WIN, WS_WO3 = WS_WBR + 2 * SZ_WBR, WS_WUP = WS_WO3 + 2 * SZ_WO3, WS_WDN = WS_WUP + 2 * SZ_WUP,
                 WS_WPL = WS_WDN + 2 * SZ_WDN, WS_WPG = WS_WPL + 2 * SZ_WPL, WS_W1T = WS_WPG + 2 * SZ_WPG, WS_W2T = WS_W1T + 2 * SZ_W1T, WS_ROT = al256(WS_W2T + 2 * SZ_W2T);
constexpr size_t WS_P16 = WS_ROT + (size_t)TP * 64 * 8;
constexpr size_t WS_XR = WS_P16 + (size_t)2 * MROWS * PLE * 2;
constexpr size_t WS_XGA = WS_XR + (size_t)MROWS * DM * 4, WS_XGB = WS_XGA + (size_t)MROWS * DM * 2, WS_XGC = WS_XGB + (size_t)MROWS * DM * 2;
constexpr size_t WS_SSA = WS_XGC + (size_t)MROWS * DM * 2, WS_SSB = WS_SSA + (size_t)MROWS * 64;
constexpr size_t WS_Z = WS_SSB + (size_t)MROWS * 64, WS_ZS = WS_Z + (size_t)MROWS * LDZ * 2;
constexpr size_t WS_MIX = WS_ZS + (size_t)MROWS * 128, WS_GATED = WS_MIX + (size_t)MROWS * 1536 * 2, WS_HMID = WS_GATED + (size_t)MROWS * 3072 * 2;
constexpr size_t WS_TPLE = WS_HMID + (size_t)MROWS * DFF * 2;
constexpr size_t WS_KC = WS_TPLE + (size_t)MROWS * DM * 4;
constexpr size_t WS_KCS = WS_KC + (size_t)2 * 2 * 512 * 2 * 64 * 2;
constexpr int GREC = 73984;
constexpr size_t WS_GREC = WS_KCS + (size_t)2 * 128 * 128 * 2 * 64 * 2;
constexpr size_t WS_OGDN = WS_GREC + (size_t)1024 * GREC;
constexpr size_t WS_RKV = WS_OGDN + (size_t)MROWS * 512 * 4;
constexpr size_t WS_RST = WS_RKV + (size_t)512 * 16384 * 4;
constexpr size_t WS_QR = WS_RST + (size_t)512 * 16384 * 2, WS_KR = WS_QR + (size_t)MP * 512 * 2;
constexpr size_t WS_MRG = WS_KR + (size_t)MP * 512 * 2;
constexpr size_t WS_PART = WS_MRG + (size_t)MROWS * DM * 2;
constexpr size_t WS_END = WS_PART + (size_t)MP * DM * 4;
static_assert(WS_W1T % 256 == 0 && WS_Z % 256 == 0 && WS_GREC % 256 == 0 && WS_RKV % 256 == 0 && WS_KC % 256 == 0 && WS_XR % 256 == 0, "ws alignment");

constexpr int CW_TMO = 0, CW_BAR = 4096, CW_QUEUE = 8192;
constexpr int NWAVES = 8, NTHREADS = 512;
constexpr int RING_BYTES = 147456, LDSCTL_OFF = RING_BYTES, MISC_OFF = LDSCTL_OFF + 320, LDS_BYTES = RING_BYTES + 1024;

#define RLX_AGENT __ATOMIC_RELAXED, __HIP_MEMORY_SCOPE_AGENT
#define LDS_WAIT() asm volatile("s_waitcnt lgkmcnt(0)" ::: "memory")
#define VM_WAIT() asm volatile("s_waitcnt vmcnt(0)" ::: "memory")
#define XB_TMO      128
#define XB_XCNT(j)  (256  + 64 * (j))
#define XB_XSUB(j)  (1280 + 64 * (j))
#define XB_XGEN(j)  (2304 + 64 * (j))
#define XB_TOP      3328
#define XB_TOPGEN   3392
#define XCD_BAR_WORDS 3456
#define XB_SPIN_CAP (1u << 18)

__device__ __forceinline__ unsigned xb_ld(unsigned* p)              { return __hip_atomic_load(p, __ATOMIC_RELAXED, __HIP_MEMORY_SCOPE_AGENT); }
__device__ __forceinline__ unsigned xb_add(unsigned* p, unsigned v) { return __hip_atomic_fetch_add(p, v, __ATOMIC_RELAXED, __HIP_MEMORY_SCOPE_AGENT); }
__device__ __forceinline__ unsigned xb_xcc_id() { return (unsigned)__builtin_amdgcn_s_getreg((3 << 11) | 20) & 0xFu; }
#define XB_SPIN(cond, bar) do { unsigned _sp = 0; while (cond) { __builtin_amdgcn_s_sleep(1); \
    if ((++_sp & 255u) == 0u) { if (xb_ld(&(bar)[XB_TMO])) break; if (_sp > XB_SPIN_CAP) { atomicAdd(&(bar)[XB_TMO], 1u); break; } } } } while (0)

struct XcdBarrier {
    unsigned* bar; unsigned x;
    volatile LAS unsigned* st;
};

__device__ __forceinline__ XcdBarrier xcd_barrier_post(unsigned* bar, volatile LAS unsigned* st, bool t0) {
    XcdBarrier b; b.bar = bar; b.x = xb_xcc_id(); b.st = st;
    if (t0) (void)xb_add(&bar[XB_XCNT(b.x)], 1u);
    return b;
}
__device__ __forceinline__ void xcd_barrier_complete(unsigned* bar, unsigned x, unsigned& nloc, unsigned& nx) {
    const unsigned G = gridDim.x * gridDim.y * gridDim.z;
    unsigned sum, cnt, mine, sp = 0u;
    for (;;) {
        sum = 0u; cnt = 0u; mine = 0u;
#pragma unroll
        for (unsigned j = 0; j < 16; ++j) { const unsigned c = xb_ld(&bar[XB_XCNT(j)]); sum += c; cnt += (c > 0u) ? 1u : 0u; mine = (j == x) ? c : mine; }
        if (sum == G) break;
        __builtin_amdgcn_s_sleep(1);
        if ((++sp & 255u) == 0u) { if (xb_ld(&bar[XB_TMO])) break; if (sp > XB_SPIN_CAP) { atomicAdd(&bar[XB_TMO], 1u); break; } }
    }
    nloc = mine > 0u ? mine : 1u; nx = cnt > 0u ? cnt : 1u;
}

__device__ __forceinline__ void xcd_barrier(const XcdBarrier& b, bool t0) {
    asm volatile("s_waitcnt vmcnt(0)" ::: "memory");
    __syncthreads();
    if (t0) {
        unsigned* bar = b.bar;
        __builtin_amdgcn_s_waitcnt(0);
        unsigned nloc = b.st[0], nx = b.st[1];
        if (nloc == 0u) { xcd_barrier_complete(bar, b.x, nloc, nx); b.st[0] = nloc; b.st[1] = nx; }
        const unsigned old = xb_add(&bar[XB_XSUB(b.x)], 1u);
        const unsigned gen = old / nloc;
        if (old + 1u == (gen + 1u) * nloc) {
            __builtin_amdgcn_fence(__ATOMIC_RELEASE, "agent");
            asm volatile("s_waitcnt vmcnt(0)" ::: "memory");
            const unsigned og = xb_add(&bar[XB_TOP], 1u);
            const unsigned tg = og / nx;
            if (og + 1u == (tg + 1u) * nx) xb_add(&bar[XB_TOPGEN], 1u);
            else XB_SPIN(xb_ld(&bar[XB_TOPGEN]) == tg, bar);
            __builtin_amdgcn_fence(__ATOMIC_ACQUIRE, "agent");
            xb_add(&bar[XB_XGEN(b.x)], 1u);
            asm volatile("s_waitcnt vmcnt(0)" ::: "memory");
        } else {
            XB_SPIN(xb_ld(&bar[XB_XGEN(b.x)]) == gen, bar);
            __builtin_amdgcn_fence(__ATOMIC_ACQUIRE, "agent");
            asm volatile("s_waitcnt vmcnt(0)" ::: "memory");
        }
    }
    __syncthreads();
}
typedef const void* const __attribute__((address_space(4)))* kargp_t;
DI const float* KIN(int i) { const GAS float* p = (const GAS float*)((kargp_t)__builtin_amdgcn_kernarg_segment_ptr())[i]; asm volatile("" : "+s"(p)); return (const float*)p; }
DI float* KOUT() { GAS float* p = (GAS float*)((kargp_t)__builtin_amdgcn_kernarg_segment_ptr())[27]; asm volatile("" : "+s"(p)); return (float*)p; }
DI unsigned char* KWS() { GAS unsigned char* p = (GAS unsigned char*)((kargp_t)__builtin_amdgcn_kernarg_segment_ptr())[28]; asm volatile("" : "+s"(p)); return (unsigned char*)p; }
struct Frame {
    LAS unsigned char* lds;
    gu32* ctl;
    int tid, lane, wave, G, bid;
};
DI bf16x8 ld_frag_g(const bf16* p) { return __builtin_bit_cast(bf16x8, *(const v4u*)p); }
DI bf16x8 ld_frag_l(const LAS unsigned char* p) { return *(const LAS bf16x8*)p; }
DI f32x4 mfma16(bf16x8 a, bf16x8 b, f32x4 c) { return __builtin_amdgcn_mfma_f32_16x16x32_bf16(a, b, c, 0, 0, 0); }
DI bf16x8 pack_frag(const f32x4 a, const f32x4 b) { return __builtin_bit_cast(bf16x8, pack8(a, b)); }
DI int lane_id() { int l; asm volatile("v_mbcnt_lo_u32_b32 %0, -1, 0\n\tv_mbcnt_hi_u32_b32 %0, -1, %0" : "=v"(l)); return l; }
DI Frame fresh(const Frame& F0) {
    Frame F = F0; int w = F0.wave, g = F0.G, b = F0.bid; asm volatile("" : "+s"(w), "+s"(g), "+s"(b));
    int l = lane_id(); asm volatile("" : "+v"(l));
    unsigned lb = (unsigned)(uintptr_t)F0.lds; asm volatile("" : "+s"(lb)); F.lds = (LAS unsigned char*)(uintptr_t)lb;
    F.wave = w; F.lane = l; F.tid = w * 64 + l; F.G = g; F.bid = b; return F;
}
#define GRID_BAR() do { XcdBarrier b_; b_.bar = (unsigned*)((gu32*)(KWS() + WS_CTL) + CW_BAR); b_.x = xb_xcc_id(); b_.st = (volatile LAS unsigned*)(F.lds + MISC_OFF) + 8; \
    const Frame Fb_ = fresh(F); xcd_barrier(b_, Fb_.tid == 0); } while (0)
DI int win_colmap(int j) {
    if (j < 1280) return j; if (j < 2816) return j + 24; if (j < 8448) return j + 32; if (j < 8472) return j - 8448 + 1280; if (j < 8480) return j - 8472 + 2840; return -1;
}
DI void tr_item(const float* W, int ldw, int k0, int srccol, bf16* WT, size_t dst_row0, int ldt, int kdst0, int nrep, int krep, LAS float* scr, int lane) {
#pragma unroll
    for (int i = 0; i < 32; ++i) { const int kk = 2 * i + (lane >> 5); const float v_ = W[(size_t)(k0 + kk) * ldw + (srccol >= 0 ? srccol : 0)]; scr[kk * 33 + (lane & 31)] = (srccol >= 0) ? v_ : 0.f; }
    LDS_WAIT(); asm volatile("" ::: "memory");
    const int c = lane & 7;
#pragma unroll
    for (int j = 0; j < 4; ++j) { const int n = (lane >> 3) + 8 * j; const LAS float* s = scr + (8 * c) * 33 + n;
        v4u o; o.x = pk2(s[0 * 33], s[1 * 33]); o.y = pk2(s[2 * 33], s[3 * 33]); o.z = pk2(s[4 * 33], s[5 * 33]); o.w = pk2(s[6 * 33], s[7 * 33]);
        for (int r = 0; r < nrep; ++r) *(v4u*)(WT + (dst_row0 + n) * (size_t)ldt + kdst0 + r * krep + 8 * c) = o; }
    LDS_WAIT(); asm volatile("" ::: "memory");
}
DI void p0_prologue(Frame& F) {
    LAS float* scr = (LAS float*)(F.lds + F.wave * 16384);
    const int gw = F.bid * NWAVES + F.wave, NGW = F.G * NWAVES, lane = F.lane;
    unsigned char* ws = KWS();
    constexpr int I_A = 16 * 272, I_B = 3 * 8 * 32, I_C = 16 * 32, I_D = 16 * 128, I_E = 64 * 32, I_F = 4 * 32, I_G = 16 * 32, I_H = 2 * 32 * 2, I_I = 2 * 2;
    constexpr int I_L = I_A + I_B + I_C + I_D + I_E + I_F + I_G + I_H + I_I;
    for (int it = gw; it < 2 * I_L; it += NGW) {
        const int l = it / I_L; int r = it % I_L;
        if (r < I_A) { const int kb = r / 272, nb = r % 272; tr_item(KIN(11) + (size_t)l * DM * 8480, 8480, 64 * kb, win_colmap(32 * nb + (lane & 31)), (bf16*)(ws + WS_WIN + l * SZ_WIN), 32 * nb, DM, 64 * kb, 1, 0, scr, lane); continue; } r -= I_A;
        if (r < I_B) { const int b = r / 256, kb = (r % 256) / 32, nb = r % 32; tr_item(KIN(19) + (size_t)(l * 3 + b) * 512 * DM, DM, 64 * kb, 32 * nb + (lane & 31), (bf16*)(ws + WS_WBR + l * SZ_WBR), b * 1024 + 32 * nb, 512, 64 * kb, 1, 0, scr, lane); continue; } r -= I_B;
        if (r < I_C) { const int kb = r / 32, nb = r % 32; tr_item(KIN(20) + (size_t)l * DM * DM, DM, 64 * kb, 32 * nb + (lane & 31), (bf16*)(ws + WS_WO3 + l * SZ_WO3), 32 * nb, 3072, 64 * kb, 3, 1024, scr, lane); continue; } r -= I_C;
        if (r < I_D) { const int kb = r / 128, nb = r % 128; tr_item(KIN(22) + (size_t)l * DM * DFF, DFF, 64 * kb, 32 * nb + (lane & 31), (bf16*)(ws + WS_WUP + l * SZ_WUP), 32 * nb, DM, 64 * kb, 1, 0, scr, lane); continue; } r -= I_D;
        if (r < I_E) { const int kb = r / 32, nb = r % 32; tr_item(KIN(23) + (size_t)l * DFF * DM, DM, 64 * kb, 32 * nb + (lane & 31), (bf16*)(ws + WS_WDN + l * SZ_WDN), 32 * nb, DFF, 64 * kb, 1, 0, scr, lane); continue; } r -= I_E;
        if (r < I_F) { const int kb = r / 32, nb = r % 32; tr_item(KIN(24) + (size_t)l * PLE * DM, DM, 64 * kb, 32 * nb + (lane & 31), (bf16*)(ws + WS_WPL + l * SZ_WPL), 32 * nb, PLE, 64 * kb, 1, 0, scr, lane); continue; } r -= I_F;
        if (r < I_G) { const int kb = r / 32, nb = r % 32; tr_item(KIN(25) + (size_t)l * DM * DM, DM, 64 * kb, 32 * nb + (lane & 31), (bf16*)(ws + WS_WPG + l * SZ_WPG), 32 * nb, DM, 64 * kb, 1, 0, scr, lane); continue; } r -= I_G;
        if (r < I_H) { const int kv = r / 64, kb = (r % 64) / 2, nb = r % 2; tr_item(KIN(13) + (size_t)(l * 2 + kv) * 2048 * 64, 64, 64 * kb, 32 * nb + (lane & 31), (bf16*)(ws + WS_W1T + l * SZ_W1T) + (size_t)kv * 64 * 2048, 32 * nb, 2048, 64 * kb, 1, 0, scr, lane); continue; } r -= I_H;
        { const int kv = r / 2, nb = r % 2; tr_item(KIN(14) + (size_t)(l * 2 + kv) * 64 * 64, 64, 0, 32 * nb + (lane & 31), (bf16*)(ws + WS_W2T + l * SZ_W2T) + (size_t)kv * 64 * 64, 32 * nb, 64, 0, 1, 0, scr, lane); }
    }
    bf16* XGA = (bf16*)(ws + WS_XGA); float* SSA = (float*)(ws + WS_SSA); bf16* P16 = (bf16*)(ws + WS_P16);
    const float* g0 = KIN(10);
    for (int row = gw; row < MROWS; row += NGW) {
        const float* xs = (row < MP) ? KIN(0) + (size_t)row * DM : KIN(1) + (size_t)(row - MP) * DM;
        float ss = 0.f;
#pragma unroll
        for (int j = 0; j < 2; ++j) {
            const int c = j * 512 + lane * 8;
            f32x4 a = *(const f32x4*)(xs + c), b = *(const f32x4*)(xs + c + 4);
            ss += (a[0] * a[0] + a[1] * a[1]) + (a[2] * a[2] + a[3] * a[3]) + (b[0] * b[0] + b[1] * b[1]) + (b[2] * b[2] + b[3] * b[3]);
            const f32x4 ga = *(const f32x4*)(g0 + c), gb = *(const f32x4*)(g0 + c + 4);
            *(v4u*)(XGA + (size_t)row * DM + c) = pack8(a * ga, b * gb);
        }
        ss = wave_sum(ss, lane);
        if (lane < 16) SSA[(size_t)row * 16 + lane] = (lane == 0) ? ss : 0.f;
#pragma unroll
        for (int l = 0; l < 2; ++l) {
            const float* ps = (row < MP) ? KIN(8) + ((size_t)l * MP + row) * PLE : KIN(9) + ((size_t)l * MS + (row - MP)) * PLE;
            const f32x4 a = *(const f32x4*)(ps + lane * 4);
            v2u o; o.x = pk2(a[0], a[1]); o.y = pk2(a[2], a[3]);
            *(v2u*)(P16 + ((size_t)l * MROWS + row) * PLE + lane * 4) = o;
        }
    }
    const int gt = F.bid * NTHREADS + F.tid, NGT = F.G * NTHREADS;
    f32x2* ROT = (f32x2*)(ws + WS_ROT);
    for (int e = gt; e < TP * 64; e += NGT) {
        const int pos = e >> 6, i = e & 63;
        const float x = (float)i * (1.0f / 63.0f);
        const float inv = exp2f(-x * 13.287712379549449f);
        const float ang = (float)pos * inv;
        const double rev = (double)ang * 0.15915494309189535;
        const float fr = (float)(rev - floor(rev));
        ROT[e] = (f32x2){__builtin_amdgcn_cosf(fr), __builtin_amdgcn_sinf(fr)};
    }
}
DI float gelu_tanh(float x) { const float u = 0.7978845608028654f * (x + 0.044715f * x * x * x); const float e = __expf(2.f * u); return 0.5f * x * (1.f + (1.f - 2.f / (e + 1.f))); }
DI bf16x8 mk_frag(v2u a, v2u b) { v4u w; w.x = a.x; w.y = a.y; w.z = b.x; w.w = b.y; return __builtin_bit_cast(bf16x8, w); }

template <bool sample> DI void compress_job_t(Frame& F, int layer, int job) {
    int lane = F.lane, wave = F.wave; asm volatile("" : "+v"(lane), "+s"(wave));
    const int tid = wave * 64 + lane, quad = lane >> 4, rl = lane & 15;
    unsigned char* ws = KWS();
    int kv, bs, g0, nbase;
    if (sample) { kv = job >> 7; bs = job & 127; g0 = 0; nbase = 0; }
    else { const int j2 = job - 256; kv = j2 >> 3; bs = (j2 >> 2) & 1; g0 = (j2 >> 1) & 1; nbase = (j2 & 1) * 256; }
    const bf16* W1T = (const bf16*)(ws + WS_W1T + layer * SZ_W1T) + (size_t)kv * 64 * 2048;
    const bf16* W2T = (const bf16*)(ws + WS_W2T + layer * SZ_W2T) + (size_t)kv * 64 * 64;
    const float* pe = KIN(12) + (size_t)(layer * 2 + kv) * 32 * 64;
    const bf16* Z = (const bf16*)(ws + WS_Z);
    const int* pt = (const int*)KIN(7);
    const float* cache = KIN(2);
    LAS unsigned char* LW = F.lds;
    int gg[2], nn[2];
    size_t pb0[2], pb1[2];
#pragma unroll
    for (int tl = 0; tl < 2; ++tl) { const int T = 2 * wave + tl; if (sample) { gg[tl] = T >> 3; nn[tl] = 16 * (T & 7) + rl; } else { gg[tl] = g0; nn[tl] = nbase + 16 * T + rl; }
        pb0[tl] = 0; pb1[tl] = 0;
        if (sample) { const int p0 = (16 * nn[tl]) >> 7; const int p1 = p0 + 1 > 15 ? 15 : p0 + 1;
            pb0[tl] = (size_t)(layer * 2560 + pt[bs * 16 + p0]) * 128 * 512; pb1[tl] = (size_t)(layer * 2560 + pt[bs * 16 + p1]) * 128 * 512; } }
    f32x4 h[2][4];
#pragma unroll
    for (int tl = 0; tl < 2; ++tl)
#pragma unroll
        for (int i = 0; i < 4; ++i) h[tl][i] = (f32x4){0.f, 0.f, 0.f, 0.f};
#pragma unroll 1
    for (int c = 0; c < 4; ++c) {
        __syncthreads();
#pragma unroll
        for (int k = 0; k < 8; ++k) { const int pc = tid + 512 * k, r = pc >> 6, c16 = pc & 63;
            *(LAS v4u*)(LW + r * 1040 + c16 * 16) = *(const v4u*)(W1T + (size_t)r * 2048 + c * 512 + c16 * 8); }
        __syncthreads();
#pragma unroll 8
        for (int kk = 0; kk < 16; ++kk) {
            const int j = 8 * c + (kk >> 1), dim0 = (kk & 1) * 32 + quad * 8;
            const f32x4 pe0 = *(const f32x4*)(pe + j * 64 + dim0), pe1 = *(const f32x4*)(pe + j * 64 + dim0 + 4);
            bf16x8 xb[2];
#pragma unroll
            for (int tl = 0; tl < 2; ++tl) {
                f32x4 x0, x1;
                if (!sample) { const size_t row = (size_t)bs * TP + 16 * nn[tl] + j; unpack8(*(const v4u*)(Z + row * LDZ + ZC_KC + kv * 128 + gg[tl] * 64 + dim0), x0, x1); }
                else { int pos = 16 * nn[tl] + j; pos = pos > 2047 ? 2047 : pos;
                    const float* p = cache + (((pos >> 7) == ((16 * nn[tl]) >> 7)) ? pb0[tl] : pb1[tl]) + (size_t)(pos & 127) * 512 + kv * 128 + gg[tl] * 64 + dim0; x0 = *(const f32x4*)p; x1 = *(const f32x4*)(p + 4); }
                xb[tl] = pack_frag(x0 + pe0, x1 + pe1);
            }
#pragma unroll
            for (int ht = 0; ht < 4; ++ht) {
                const bf16x8 a = ld_frag_l(LW + (16 * ht + rl) * 1040 + (kk * 32 + quad * 8) * 2);
                h[0][ht] = mfma16(a, xb[0], h[0][ht]); h[1][ht] = mfma16(a, xb[1], h[1][ht]);
            }
        }
    }
#pragma unroll
    for (int tl = 0; tl < 2; ++tl) {
#pragma unroll
        for (int ht = 0; ht < 4; ++ht)
#pragma unroll
            for (int i = 0; i < 4; ++i) h[tl][ht][i] = gelu_tanh(h[tl][ht][i]);
        bf16x8 gb[2]; gb[0] = pack_frag(h[tl][0], h[tl][1]); gb[1] = pack_frag(h[tl][2], h[tl][3]);
        const int n = nn[tl], g = gg[tl];
        bf16* dst = sample ? (bf16*)(ws + WS_KCS) + ((((size_t)kv * 128 + bs) * 128 + n) * 2 + g) * 64 : (bf16*)(ws + WS_KC) + ((((size_t)kv * 2 + bs) * 512 + n) * 2 + g) * 64;
        const bool zero = sample && n == 127;
#pragma unroll
        for (int ot = 0; ot < 4; ++ot) {
            f32x4 o = (f32x4){0.f, 0.f, 0.f, 0.f};
#pragma unroll
            for (int s = 0; s < 2; ++s) {
                const bf16* wp = W2T + (16 * ot + rl) * 64 + 32 * s + 4 * quad;
                o = mfma16(mk_frag(*(const v2u*)wp, *(const v2u*)(wp + 16)), gb[s], o);
            }
            v2u w; w.x = zero ? 0u : pk2(o[0], o[1]); w.y = zero ? 0u : pk2(o[2], o[3]);
            *(v2u*)(dst + 16 * ot + 4 * quad) = w;
        }
    }
    __syncthreads();
}

DI v2u pack4(const f32x4 v) { v2u w; w.x = pk2(v[0], v[1]); w.y = pk2(v[2], v[3]); return w; }
DI void compress_sample_job(Frame& F, int layer, int job) {
    int lane = F.lane, wave = F.wave; asm volatile("" : "+v"(lane), "+s"(wave));
    const int tid = wave * 64 + lane, quad = lane >> 4, rl = lane & 15;
    unsigned char* ws = KWS();
    const int kv = job >> 7, bs = job & 127;
    const bf16* W1T = (const bf16*)(ws + WS_W1T + layer * SZ_W1T) + (size_t)kv * 64 * 2048;
    const bf16* W2T = (const bf16*)(ws + WS_W2T + layer * SZ_W2T) + (size_t)kv * 64 * 64;
    const float* pe = KIN(12) + (size_t)(layer * 2 + kv) * 32 * 64;
    const int* pt = (const int*)KIN(7);
    const float* cache = KIN(2);
    LAS unsigned char* XS = F.lds;
    LAS unsigned char* WS1 = F.lds + 69632;
    size_t toff[8];
#pragma unroll
    for (int k = 0; k < 8; ++k) { const int q = tid + 512 * k, m = q >> 5; const int pos = 16 * m; const int phys = pt[bs * 16 + (pos >> 7)];
        toff[k] = ((size_t)(layer * 2560 + phys) * 128 + (pos & 127)) * 512 + kv * 128 + 4 * (q & 31); }
    const int wr_ = tid >> 3, wc_ = tid & 7;
    int gg[2], nn[2];
#pragma unroll
    for (int tl = 0; tl < 2; ++tl) { const int T = 2 * wave + tl; gg[tl] = T >> 3; nn[tl] = 16 * (T & 7) + rl; }
    f32x4 h[2][4];
#pragma unroll
    for (int tl = 0; tl < 2; ++tl)
#pragma unroll
        for (int i = 0; i < 4; ++i) h[tl][i] = (f32x4){0.f, 0.f, 0.f, 0.f};
    f32x4 xr[8]; v4u wr2[2];
#define CS_ISSUE(r_) do { _Pragma("unroll") for (int k = 0; k < 8; ++k) xr[k] = *(const f32x4*)(cache + toff[k] + (size_t)(r_) * 512); \
        _Pragma("unroll") for (int u = 0; u < 2; ++u) wr2[u] = *(const v4u*)(W1T + (size_t)wr_ * 2048 + ((r_) + 16 * u) * 64 + wc_ * 8); } while (0)
    CS_ISSUE(0);
#pragma unroll 1
    for (int r = 0; r < 16; ++r) {
        __syncthreads();
#pragma unroll
        for (int k = 0; k < 8; ++k) { const int q = tid + 512 * k, m = q >> 5, c = q & 31, d = 4 * (c & 15);
#pragma unroll
            for (int u = 0; u < 2; ++u) { const f32x4 v = xr[k] + *(const f32x4*)(pe + (r + 16 * u) * 64 + d);
                *(LAS v2u*)(XS + u * 34816 + m * 272 + c * 8) = pack4(v); } }
#pragma unroll
        for (int u = 0; u < 2; ++u) *(LAS v4u*)(WS1 + u * 9216 + wr_ * 144 + wc_ * 16) = wr2[u];
        __syncthreads();
        { const int rn = r + 1 < 16 ? r + 1 : 15; CS_ISSUE(rn); }
#pragma unroll
        for (int u = 0; u < 2; ++u)
#pragma unroll
            for (int ks = 0; ks < 2; ++ks) {
                bf16x8 xb[2];
#pragma unroll
                for (int tl = 0; tl < 2; ++tl) { int m = nn[tl] + u; m = m > 127 ? 127 : m; xb[tl] = ld_frag_l(XS + u * 34816 + m * 272 + gg[tl] * 128 + ks * 64 + quad * 16); }
#pragma unroll
                for (int ht = 0; ht < 4; ++ht) { const bf16x8 a = ld_frag_l(WS1 + u * 9216 + (16 * ht + rl) * 144 + ks * 64 + quad * 16);
                    h[0][ht] = mfma16(a, xb[0], h[0][ht]); h[1][ht] = mfma16(a, xb[1], h[1][ht]); }
            }
    }
#undef CS_ISSUE
#pragma unroll
    for (int tl = 0; tl < 2; ++tl) {
#pragma unroll
        for (int ht = 0; ht < 4; ++ht)
#pragma unroll
            for (int i = 0; i < 4; ++i) h[tl][ht][i] = gelu_tanh(h[tl][ht][i]);
        bf16x8 gb[2]; gb[0] = pack_frag(h[tl][0], h[tl][1]); gb[1] = pack_frag(h[tl][2], h[tl][3]);
        const int n = nn[tl], g = gg[tl];
        bf16* dst = (bf16*)(ws + WS_KCS) + ((((size_t)kv * 128 + bs) * 128 + n) * 2 + g) * 64;
        const bool zero = n == 127;
#pragma unroll
        for (int ot = 0; ot < 4; ++ot) {
            f32x4 o = (f32x4){0.f, 0.f, 0.f, 0.f};
#pragma unroll
            for (int s = 0; s < 2; ++s) {
                const bf16* wp = W2T + (16 * ot + rl) * 64 + 32 * s + 4 * quad;
                o = mfma16(mk_frag(*(const v2u*)wp, *(const v2u*)(wp + 16)), gb[s], o);
            }
            v2u w; w.x = zero ? 0u : pk2(o[0], o[1]); w.y = zero ? 0u : pk2(o[2], o[3]);
            *(v2u*)(dst + 16 * ot + 4 * quad) = w;
        }
    }
    __syncthreads();
}
DI void compress_job(Frame& F, int layer, int job) { if (job < 256) compress_sample_job(F, layer, job); else compress_job_t<false>(F, layer, job); }
#ifndef PH_GPT
#define PH_GPT (-1)
#endif
#if PH_GPT >= 0
#define GP_T(k) do { if (tid == 0) { volatile LAS unsigned long long* gp_ = (volatile LAS unsigned long long*)(F.lds + LDSCTL_OFF + 448); const unsigned long long now_ = __builtin_amdgcn_s_memrealtime(); \
    if ((k) == PH_GPT) gp_[0] += now_ - gp_[1]; gp_[1] = now_; } } while (0)
#else
#define GP_T(k) do { } while (0)
#endif
DI int kperm(int idx) { const int s = idx >> 5, r = idx & 31; return 32 * s + 8 * ((r >> 2) & 3) + 4 * (r >> 4) + (r & 3); }
DI float softplusf_(float x) { return x > 20.f ? x : __logf(1.f + __expf(x)); }
DI float ret_lg(int h) { return h == 0 ? -0.031748697f : h == 1 ? -0.015748357f : h == 2 ? -0.007843178f : -0.0039138994f; }

DI void gdn_prep_unit(Frame& F, int layer, int unit) {
    int lane = F.lane, wave = F.wave; asm volatile("" : "+v"(lane), "+s"(wave));
    const int tid = wave * 64 + lane;
    const int b = unit >> 9, h = (unit >> 7) & 3, c = unit & 127;
    const int row0 = b * TP + 64 * c, t0 = 64 * c;
    GP_T(0);
    unsigned char* ws = KWS();
    const bf16* Z = (const bf16*)(ws + WS_Z);
    const float* ZS = (const float*)(ws + WS_ZS);
    LAS float* Lq = (LAS float*)(F.lds); LAS float* Lk = (LAS float*)(F.lds + 33792); LAS float* Lv = (LAS float*)(F.lds + 67584);
    LAS float* LA = (LAS float*)(F.lds + 101376); LAS float* LQK = (LAS float*)(F.lds + 117760);
    LAS float* Lg = (LAS float*)(F.lds + 134144); LAS float* Lb = Lg + 64; LAS float* Le = Lg + 128;
    const float* cw = KIN(15) + (size_t)layer * 4 * 1536;
    {
        v4u xs[6][4];
#pragma unroll
        for (int it0 = 0; it0 < 6; ++it0) {
            const int it = tid + it0 * NTHREADS, i = it / 48, ch = it % 48, col = (ch >> 4) * 512 + h * 128 + (ch & 15) * 8;
#pragma unroll
            for (int j = 0; j < 4; ++j) { const bool ok = (t0 + i - 3 + j) >= 0; xs[it0][j] = *(const v4u*)(Z + (size_t)(ok ? row0 + i - 3 + j : row0) * LDZ + ZC_GQKV + col); }
        }
        LAS float* LCW = (LAS float*)(F.lds + 139264);
        if (tid < 384) { const int j = tid / 96, w96 = tid % 96, part = w96 >> 5, d4 = w96 & 31;
            *(LAS f32x4*)(LCW + j * 384 + part * 128 + d4 * 4) = *(const f32x4*)(cw + j * 1536 + part * 512 + h * 128 + d4 * 4); }
        __syncthreads();
#pragma unroll
        for (int it0 = 0; it0 < 6; ++it0) {
            const int it = tid + it0 * NTHREADS, i = it / 48, ch = it % 48, part = ch >> 4, cc = ch & 15;
            f32x4 y0 = (f32x4){0.f, 0.f, 0.f, 0.f}, y1 = y0;
#pragma unroll
            for (int j = 0; j < 4; ++j) {
                const float zf = ((t0 + i - 3 + j) >= 0) ? 1.f : 0.f;
                f32x4 x0, x1; unpack8(xs[it0][j], x0, x1);
                const LAS float* wp = LCW + j * 384 + part * 128 + cc * 8;
                y0 += x0 * (*(const LAS f32x4*)wp * zf); y1 += x1 * (*(const LAS f32x4*)(wp + 4) * zf);
            }
#pragma unroll
            for (int e = 0; e < 4; ++e) { y0[e] = siluf_(y0[e]); y1[e] = siluf_(y1[e]); }
            LAS float* dst = (part == 0 ? Lq : part == 1 ? Lk : Lv) + i * 132 + cc * 8;
            *(LAS f32x4*)dst = y0; *(LAS f32x4*)(dst + 4) = y1;
        }
    }
    __syncthreads();
    GP_T(1);
    {
        float va[16], vb[16], ps[16];
#pragma unroll
        for (int q = 0; q < 16; ++q) { LAS float* vp = ((q < 8) ? Lq : Lk) + (wave * 8 + (q & 7)) * 132 + lane * 2; va[q] = vp[0]; vb[q] = vp[1]; ps[q] = va[q] * va[q] + vb[q] * vb[q]; }
#pragma unroll
        for (int q = 0; q < 16; ++q) ps[q] += shx<1>(ps[q], lane);
#pragma unroll
        for (int q = 0; q < 16; ++q) ps[q] += shx<2>(ps[q], lane);
#pragma unroll
        for (int q = 0; q < 16; ++q) ps[q] += shx<4>(ps[q], lane);
#pragma unroll
        for (int q = 0; q < 16; ++q) ps[q] += shx<8>(ps[q], lane);
#pragma unroll
        for (int q = 0; q < 16; ++q) ps[q] += shx<16>(ps[q], lane);
#pragma unroll
        for (int q = 0; q < 16; ++q) ps[q] += shx<32>(ps[q], lane);
#pragma unroll
        for (int q = 0; q < 16; ++q) { LAS float* vp = ((q < 8) ? Lq : Lk) + (wave * 8 + (q & 7)) * 132 + lane * 2; const float sc = rsqrtf(ps[q] + EPS) * ((q < 8) ? 0.08838834764831845f : 1.f); vp[0] = va[q] * sc; vp[1] = vb[q] * sc; }
    }
    if (wave == 0) {
        const float ga = ZS[(size_t)(row0 + lane) * 32 + 24 + h], gbv = ZS[(size_t)(row0 + lane) * 32 + 28 + h];
        float g = -__expf(KIN(16)[layer * 4 + h]) * softplusf_(ga + KIN(17)[layer * 4 + h]);
#pragma unroll
        for (int o = 1; o < 64; o <<= 1) { const float t = __int_as_float(__builtin_amdgcn_ds_bpermute(((lane - o) & 63) << 2, __float_as_int(g))); if (lane >= o) g += t; }
        Lg[lane] = g; Lb[lane] = sigmoidf_(gbv); Le[lane] = __expf(g);
    }
    __syncthreads();
    GP_T(2);
    {
        const int it = wave >> 1, quad = lane >> 4, rl = lane & 15;
        f32x4 ckk[2], cqk[2];
#pragma unroll
        for (int jj = 0; jj < 2; ++jj) { ckk[jj] = (f32x4){0.f, 0.f, 0.f, 0.f}; cqk[jj] = ckk[jj]; }
#pragma unroll
        for (int s = 0; s < 4; ++s) {
            const LAS float* kp = Lk + (16 * it + rl) * 132 + 32 * s + 8 * quad; const LAS float* qp = Lq + (16 * it + rl) * 132 + 32 * s + 8 * quad;
            const f32x4 ka0 = *(const LAS f32x4*)kp, ka1 = *(const LAS f32x4*)(kp + 4), qa0 = *(const LAS f32x4*)qp, qa1 = *(const LAS f32x4*)(qp + 4);
            const bf16x8 kah = pack_frag(ka0, ka1), qah = pack_frag(qa0, qa1);
            f32x4 h0, h1; unpack8(__builtin_bit_cast(v4u, kah), h0, h1); const bf16x8 kal = pack_frag(ka0 - h0, ka1 - h1);
            unpack8(__builtin_bit_cast(v4u, qah), h0, h1); const bf16x8 qal = pack_frag(qa0 - h0, qa1 - h1);
#pragma unroll
            for (int jj = 0; jj < 2; ++jj) {
                const int jt = (wave & 1) * 2 + jj;
                if (jt <= it) {
                    const LAS float* bp = Lk + (16 * jt + rl) * 132 + 32 * s + 8 * quad;
                    const f32x4 kb0 = *(const LAS f32x4*)bp, kb1 = *(const LAS f32x4*)(bp + 4);
                    const bf16x8 kbh = pack_frag(kb0, kb1); unpack8(__builtin_bit_cast(v4u, kbh), h0, h1); const bf16x8 kbl = pack_frag(kb0 - h0, kb1 - h1);
                    ckk[jj] = mfma16(kah, kbh, ckk[jj]); ckk[jj] = mfma16(kah, kbl, ckk[jj]); ckk[jj] = mfma16(kal, kbh, ckk[jj]);
                    cqk[jj] = mfma16(qah, kbh, cqk[jj]); cqk[jj] = mfma16(qah, kbl, cqk[jj]); cqk[jj] = mfma16(qal, kbh, cqk[jj]);
                }
            }
        }
#pragma unroll
        for (int jj = 0; jj < 2; ++jj) {
            const int j = 16 * ((wave & 1) * 2 + jj) + rl; const float gj = Lg[j];
#pragma unroll
            for (int e = 0; e < 4; ++e) { const int i = 16 * it + 4 * quad + e; const float dec = (i >= j) ? __expf(Lg[i] - gj) : 0.f;
                LA[i * 64 + j] = (i > j) ? Lb[i] * ckk[jj][e] * dec : 0.f; LQK[i * 64 + j] = cqk[jj][e] * dec; }
        }
    }
    __syncthreads();
    GP_T(3);
    unsigned char* rec = ws + WS_GREC + (size_t)unit * GREC;
    LAS float* TI = (LAS float*)(F.lds + 135168);
    if (tid < 64) {
        const int B = tid >> 4, c = tid & 15;
        float tc[16];
#pragma unroll
        for (int i = 0; i < 16; ++i) {
            float s0 = (i == c) ? 1.f : 0.f;
#pragma unroll
            for (int j = 0; j < i; ++j) s0 -= LA[(16 * B + i) * 64 + 16 * B + j] * tc[j];
            tc[i] = s0;
        }
#pragma unroll
        for (int i = 0; i < 16; ++i) TI[B * 256 + i * 16 + c] = tc[i];
    }
    {
        const float gl = Lg[63];
        for (int it = tid; it < 2560; it += NTHREADS) {
            if (it < 1024) {
                const int i = it >> 4, s = (it >> 2) & 3, quad = it & 3; const float e = Le[i];
                const f32x4 a = *(const LAS f32x4*)(Lq + i * 132 + 32 * s + 4 * quad) * e, bq = *(const LAS f32x4*)(Lq + i * 132 + 32 * s + 16 + 4 * quad) * e;
                *(v4u*)(rec + 16384 + i * 256 + (32 * s + 8 * quad) * 2) = pack8(a, bq);
            } else if (it < 2048) {
                const int r = it - 1024, dk = r >> 3, s2 = (r >> 2) & 1, quad = r & 3;
                f32x4 a, bq;
#pragma unroll
                for (int e = 0; e < 4; ++e) { const int ta = 32 * s2 + 4 * quad + e, tb = ta + 16; a[e] = Lk[ta * 132 + dk] * __expf(gl - Lg[ta]); bq[e] = Lk[tb * 132 + dk] * __expf(gl - Lg[tb]); }
                *(v4u*)(rec + 32768 + dk * 128 + (32 * s2 + 8 * quad) * 2) = pack8(a, bq);
            } else {
                const int r = it - 2048, i = r >> 3, s2 = (r >> 2) & 1, quad = r & 3;
                const f32x4 a = *(const LAS f32x4*)(LQK + i * 64 + 32 * s2 + 4 * quad), bq = *(const LAS f32x4*)(LQK + i * 64 + 32 * s2 + 16 + 4 * quad);
                *(v4u*)(rec + 65536 + i * 128 + (32 * s2 + 8 * quad) * 2) = pack8(a, bq);
            }
        }
        if (tid == 0) *(float*)(rec + 73728) = __expf(gl);
    }
    __syncthreads();
    GP_T(4);
    {
        const int col = tid & 255, hb = tid >> 8;
        LAS float* X = (col < 128) ? (Lv + col) : (Lk + (col - 128));
        const bool isw = col >= 128;
#pragma unroll 1
        for (int B = 0; B < 4; ++B) {
            float xb[8];
#pragma unroll
            for (int i = 0; i < 8; ++i) { const int r = 16 * B + 8 * hb + i; xb[i] = (isw ? Lb[r] * Le[r] : Lb[r]) * X[r * 132]; }
#pragma unroll 2
            for (int j4 = 0; j4 < 4 * B; ++j4) {
                const float x0 = X[(4 * j4) * 132], x1 = X[(4 * j4 + 1) * 132], x2 = X[(4 * j4 + 2) * 132], x3 = X[(4 * j4 + 3) * 132];
#pragma unroll
                for (int i = 0; i < 8; ++i) { const f32x4 a = *(const LAS f32x4*)(LA + (16 * B + 8 * hb + i) * 64 + 4 * j4); xb[i] -= (a[0] * x0 + a[1] * x1) + (a[2] * x2 + a[3] * x3); }
            }
#pragma unroll
            for (int i = 0; i < 8; ++i) X[(16 * B + 8 * hb + i) * 132] = xb[i];
            __syncthreads();
            float r[16];
#pragma unroll
            for (int jj = 0; jj < 16; ++jj) r[jj] = X[(16 * B + jj) * 132];
            __syncthreads();
#pragma unroll
            for (int i = 0; i < 8; ++i) {
                float s0 = 0.f, s1 = 0.f;
#pragma unroll
                for (int j4 = 0; j4 < 4; ++j4) { const f32x4 a = *(const LAS f32x4*)(TI + B * 256 + (8 * hb + i) * 16 + 4 * j4);
                    s0 += a[0] * r[4 * j4] + a[2] * r[4 * j4 + 2]; s1 += a[1] * r[4 * j4 + 1] + a[3] * r[4 * j4 + 3]; }
                X[(16 * B + 8 * hb + i) * 132] = s0 + s1;
            }
            __syncthreads();
        }
    }
    __syncthreads();
    GP_T(5);
    for (int it = tid; it < 2048; it += NTHREADS) {
        if (it < 1024) {
            const int dv = it >> 3, q = it & 7;
            v4u w; w.x = pk2(Lv[(8 * q) * 132 + dv], Lv[(8 * q + 1) * 132 + dv]); w.y = pk2(Lv[(8 * q + 2) * 132 + dv], Lv[(8 * q + 3) * 132 + dv]);
            w.z = pk2(Lv[(8 * q + 4) * 132 + dv], Lv[(8 * q + 5) * 132 + dv]); w.w = pk2(Lv[(8 * q + 6) * 132 + dv], Lv[(8 * q + 7) * 132 + dv]);
            *(v4u*)(rec + 49152 + dv * 128 + q * 16) = w;
        } else {
            const int r = it - 1024, i = r >> 4, s = (r >> 2) & 3, quad = r & 3;
            const f32x4 a = *(const LAS f32x4*)(Lk + i * 132 + 32 * s + 4 * quad), bq = *(const LAS f32x4*)(Lk + i * 132 + 32 * s + 16 + 4 * quad);
            *(v4u*)(rec + i * 256 + (32 * s + 8 * quad) * 2) = pack8(a, bq);
        }
    }
    __syncthreads();
    GP_T(6);
}

DI void ret_prep_unit(Frame& F, int layer, int unit) {
    int lane = F.lane, wave = F.wave; asm volatile("" : "+v"(lane), "+s"(wave));
    const int tid = wave * 64 + lane, quad = lane >> 4, rl = lane & 15;
    const int b = unit >> 8, h = (unit >> 6) & 3, c = unit & 63;
    const int row0 = b * TP + 128 * c;
    unsigned char* ws = KWS();
    const bf16* Z = (const bf16*)(ws + WS_Z);
    const f32x2* ROT = (const f32x2*)(ws + WS_ROT);
    bf16* QR = (bf16*)(ws + WS_QR); bf16* KR = (bf16*)(ws + WS_KR);
    LAS unsigned char* LK = F.lds; LAS unsigned char* LV = F.lds + 34816;
    const float lg = ret_lg(h);
    for (int it = tid; it < 1024; it += NTHREADS) {
        const int j = it >> 3, cc = it & 7, d0 = cc * 8;
        const size_t zr = (size_t)(row0 + j) * LDZ + ZC_RQKV + h * 128 + d0;
        f32x4 q1a, q1b, q2a, q2b, k1a, k1b, k2a, k2b;
        unpack8(*(const v4u*)(Z + zr), q1a, q1b); unpack8(*(const v4u*)(Z + zr + 64), q2a, q2b);
        unpack8(*(const v4u*)(Z + zr + 512), k1a, k1b); unpack8(*(const v4u*)(Z + zr + 512 + 64), k2a, k2b);
        const f32x2* rp = ROT + (size_t)(128 * c + j) * 64 + d0;
        const float kd = __expf((float)(127 - j) * lg);
        f32x4 oq1a, oq1b, oq2a, oq2b, ok1a, ok1b, ok2a, ok2b;
#pragma unroll
        for (int e = 0; e < 8; ++e) {
            const f32x2 cs = rp[e];
            const float q1 = e < 4 ? q1a[e & 3] : q1b[e & 3], q2 = e < 4 ? q2a[e & 3] : q2b[e & 3], k1 = e < 4 ? k1a[e & 3] : k1b[e & 3], k2 = e < 4 ? k2a[e & 3] : k2b[e & 3];
            const float rq1 = q1 * cs.x - q2 * cs.y, rq2 = q2 * cs.x + q1 * cs.y, rk1 = (k1 * cs.x - k2 * cs.y) * 0.08838834764831845f, rk2 = (k2 * cs.x + k1 * cs.y) * 0.08838834764831845f;
            if (e < 4) { oq1a[e & 3] = rq1; oq2a[e & 3] = rq2; ok1a[e & 3] = rk1; ok2a[e & 3] = rk2; } else { oq1b[e & 3] = rq1; oq2b[e & 3] = rq2; ok1b[e & 3] = rk1; ok2b[e & 3] = rk2; }
            *(LAS bf16*)(LK + (d0 + e) * 272 + j * 2) = (bf16)f2bf(rk1 * kd); *(LAS bf16*)(LK + (d0 + 64 + e) * 272 + j * 2) = (bf16)f2bf(rk2 * kd);
        }
        const size_t orow = (size_t)(row0 + j) * 512 + h * 128 + d0;
        *(v4u*)(QR + orow) = pack8(oq1a, oq1b); *(v4u*)(QR + orow + 64) = pack8(oq2a, oq2b);
        *(v4u*)(KR + orow) = pack8(ok1a, ok1b); *(v4u*)(KR + orow + 64) = pack8(ok2a, ok2b);
    }
    for (int it = tid; it < 2048; it += NTHREADS) {
        const int j = it >> 4, cc = it & 15;
        const v4u w = *(const v4u*)(Z + (size_t)(row0 + j) * LDZ + ZC_RQKV + 1024 + h * 128 + cc * 8);
        LAS unsigned char* d = LV + (cc * 8) * 272 + j * 2;
        *(LAS bf16*)(d) = (bf16)(w.x & 0xffff); *(LAS bf16*)(d + 272) = (bf16)(w.x >> 16); *(LAS bf16*)(d + 2 * 272) = (bf16)(w.y & 0xffff); *(LAS bf16*)(d + 3 * 272) = (bf16)(w.y >> 16);
        *(LAS bf16*)(d + 4 * 272) = (bf16)(w.z & 0xffff); *(LAS bf16*)(d + 5 * 272) = (bf16)(w.z >> 16); *(LAS bf16*)(d + 6 * 272) = (bf16)(w.w & 0xffff); *(LAS bf16*)(d + 7 * 272) = (bf16)(w.w >> 16);
    }
    __syncthreads();
    float* RKV = (float*)(ws + WS_RKV) + (size_t)unit * 16384;
#pragma unroll
    for (int nt = 0; nt < 8; ++nt) {
        f32x4 acc = (f32x4){0.f, 0.f, 0.f, 0.f};
#pragma unroll
        for (int s = 0; s < 4; ++s) acc = mfma16(ld_frag_l(LK + (16 * wave + rl) * 272 + (32 * s + 8 * quad) * 2), ld_frag_l(LV + (16 * nt + rl) * 272 + (32 * s + 8 * quad) * 2), acc);
#pragma unroll
        for (int i = 0; i < 4; ++i) RKV[(size_t)(16 * wave + 4 * quad + i) * 128 + 16 * nt + rl] = acc[i];
    }
    __syncthreads();
}
DI void sample_rec_unit(Frame& F, int layer, int unit) {
    int lane = F.lane, wave = F.wave; asm volatile("" : "+v"(lane), "+s"(wave));
    const int tid = wave * 64 + lane;
    const int kind = unit >> 9, s = (unit >> 2) & 127, h = unit & 3;
    const int dv = tid & 127, part = tid >> 7, r0 = MP + 4 * s;
    unsigned char* ws = KWS();
    const bf16* Z = (const bf16*)(ws + WS_Z);
    const float* ZS = (const float*)(ws + WS_ZS);
    LAS float* Lq = (LAS float*)(F.lds); LAS float* Lk = Lq + 512; LAS float* Lv = Lq + 1024; LAS float* red = Lq + 1536; LAS float* Lo = Lq + 2048; LAS float* sc = Lq + 2560;
    float S[32];
    if (kind == 0) {
        if (tid < 384) {
            const int pr = tid >> 7, d = tid & 127, col = pr * 512 + h * 128 + d;
            float xp[7], w[4];
#pragma unroll
            for (int i = 0; i < 3; ++i) xp[i] = KIN(4)[((size_t)(layer * 128 + s) * 3 + i) * 1536 + col];
#pragma unroll
            for (int j = 0; j < 4; ++j) xp[3 + j] = bf2f(Z[(size_t)(r0 + j) * LDZ + ZC_GQKV + col]);
#pragma unroll
            for (int i = 0; i < 4; ++i) w[i] = KIN(15)[(size_t)(layer * 4 + i) * 1536 + col];
            LAS float* dst = pr == 0 ? Lq : pr == 1 ? Lk : Lv;
#pragma unroll
            for (int j = 0; j < 4; ++j) dst[j * 128 + d] = siluf_(w[0] * xp[j] + w[1] * xp[j + 1] + w[2] * xp[j + 2] + w[3] * xp[j + 3]);
        }
        __syncthreads();
        {
            LAS float* vp = (wave < 4 ? Lq : Lk) + (wave & 3) * 128;
            const float a = vp[2 * lane], b = vp[2 * lane + 1];
            const float scl = rsqrtf(wave_sum(a * a + b * b, lane) + EPS) * (wave < 4 ? 0.08838834764831845f : 1.f);
            vp[2 * lane] = a * scl; vp[2 * lane + 1] = b * scl;
        }
        if (tid < 4) {
            const float ga = ZS[(size_t)(r0 + tid) * 32 + 24 + h], gb = ZS[(size_t)(r0 + tid) * 32 + 28 + h];
            sc[tid] = __expf(-__expf(KIN(16)[layer * 4 + h]) * softplusf_(ga + KIN(17)[layer * 4 + h])); sc[4 + tid] = sigmoidf_(gb);
        }
        __syncthreads();
        const float* Sin = KIN(5) + ((size_t)((layer * 128 + s) * 4 + h) * 128 + 32 * part) * 128 + dv;
#pragma unroll
        for (int i = 0; i < 32; ++i) S[i] = Sin[(size_t)i * 128];
#pragma unroll
        for (int j = 0; j < 4; ++j) {
            const float a = sc[j], beta = sc[4 + j];
            float p = 0.f;
#pragma unroll
            for (int i = 0; i < 32; ++i) { S[i] *= a; p += Lk[j * 128 + 32 * part + i] * S[i]; }
            red[part * 128 + dv] = p;
            __syncthreads();
            const float delta = beta * (Lv[j * 128 + dv] - ((red[dv] + red[128 + dv]) + (red[256 + dv] + red[384 + dv])));
            __syncthreads();
            float o = 0.f;
#pragma unroll
            for (int i = 0; i < 32; ++i) { S[i] += Lk[j * 128 + 32 * part + i] * delta; o += Lq[j * 128 + 32 * part + i] * S[i]; }
            red[part * 128 + dv] = o;
            __syncthreads();
            if (part == 0) Lo[j * 128 + dv] = (red[dv] + red[128 + dv]) + (red[256 + dv] + red[384 + dv]);
            __syncthreads();
        }
        float* Sout = KOUT() + O_GSS + ((size_t)((layer * 128 + s) * 4 + h) * 128 + 32 * part) * 128 + dv;
#pragma unroll
        for (int i = 0; i < 32; ++i) Sout[(size_t)i * 128] = S[i];
        ((bf16*)(ws + WS_OGDN))[(size_t)(r0 + part) * 512 + h * 128 + dv] = (bf16)f2bf(Lo[part * 128 + dv]);
    } else {
        const f32x2* ROT = (const f32x2*)(ws + WS_ROT);
        if (tid < 384) {
            const int pr = tid >> 7, d = tid & 127;
#pragma unroll
            for (int j = 0; j < 4; ++j) {
                const bf16* zp = Z + (size_t)(r0 + j) * LDZ + ZC_RQKV + pr * 512 + h * 128;
                float v = bf2f(zp[d]);
                if (pr < 2) { const f32x2 cs = ROT[(size_t)(2048 + j) * 64 + (d & 63)]; const float o = bf2f(zp[d ^ 64]);
                    v = (d < 64) ? v * cs.x - o * cs.y : v * cs.x + o * cs.y; if (pr == 1) v *= 0.08838834764831845f; }
                (pr == 0 ? Lq : pr == 1 ? Lk : Lv)[j * 128 + d] = v;
            }
        }
        __syncthreads();
        const float gam = __expf(ret_lg(h));
        const float* Sin = KIN(6) + ((size_t)((layer * 128 + s) * 4 + h) * 128 + 32 * part) * 128 + dv;
#pragma unroll
        for (int i = 0; i < 32; ++i) S[i] = Sin[(size_t)i * 128];
#pragma unroll
        for (int j = 0; j < 4; ++j) {
            const float vv = Lv[j * 128 + dv];
            float o = 0.f;
#pragma unroll
            for (int i = 0; i < 32; ++i) { S[i] = S[i] * gam + Lk[j * 128 + 32 * part + i] * vv; o += Lq[j * 128 + 32 * part + i] * S[i]; }
            red[part * 128 + dv] = o;
            __syncthreads();
            if (part == 0) Lo[j * 128 + dv] = (red[dv] + red[128 + dv]) + (red[256 + dv] + red[384 + dv]);
            __syncthreads();
        }
        float* Sout = KOUT() + O_RSS + ((size_t)((layer * 128 + s) * 4 + h) * 128 + 32 * part) * 128 + dv;
#pragma unroll
        for (int i = 0; i < 32; ++i) Sout[(size_t)i * 128] = S[i];
        if (wave < 4) {
            const int j = wave; const float a = Lo[j * 128 + 2 * lane], b = Lo[j * 128 + 2 * lane + 1];
            const float scl = rsqrtf(wave_sum(a * a + b * b, lane) * (1.f / 128.f) + EPS);
            const bf16* gp = Z + (size_t)(r0 + j) * LDZ + ZC_RG + h * 128 + 2 * lane;
            *(unsigned*)((bf16*)(ws + WS_MIX) + (size_t)(r0 + j) * 1536 + 1024 + h * 128 + 2 * lane) = pk2(a * scl * siluf_(bf2f(gp[0])), b * scl * siluf_(bf2f(gp[1])));
        }
    }
    __syncthreads();
}

DI void gdn_scan_chain(Frame& F, int layer, int bh) {
    int lane = F.lane, wave = F.wave; asm volatile("" : "+v"(lane), "+s"(wave));
    const int tid = wave * 64 + lane, quad = lane >> 4, rl = lane & 15;
    unsigned char* ws = KWS();
    const unsigned char* recb = ws + WS_GREC + (size_t)bh * 128 * GREC;
    LAS unsigned char* L = F.lds;
    constexpr int L_WP = 0, L_QP = 17408, L_KT = 34816, L_UT = 53248, L_QK = 71680;
    f32x4 S[8];
#pragma unroll
    for (int i = 0; i < 8; ++i) S[i] = (f32x4){0.f, 0.f, 0.f, 0.f};
    v4u pf[9]; float egl;
#pragma unroll
    for (int k = 0; k < 9; ++k) pf[k] = *(const v4u*)(recb + (size_t)(tid + 512 * k) * 16);
    egl = *(const float*)(recb + 73728);
    bf16* OG = (bf16*)(ws + WS_OGDN);
    const int b = bh >> 2, h = bh & 3;
    for (int c = 0; c < 128; ++c) {
        __syncthreads();
#pragma unroll
        for (int k = 0; k < 9; ++k) {
            const int o = tid * 16 + (k & 1) * 8192;
            const int reg = k >> 1;
            int dst;
            if (reg < 2) dst = (reg == 0 ? L_WP : L_QP) + (o >> 8) * 272 + (o & 255);
            else dst = (reg == 2 ? L_KT : reg == 3 ? L_UT : L_QK) + (o >> 7) * 144 + (o & 127);
            *(LAS v4u*)(L + dst) = pf[k];
        }
        const float eg = egl;
        __syncthreads();
        {
            const unsigned char* rn = recb + (size_t)(c + 1 < 128 ? c + 1 : 127) * GREC;
#pragma unroll
            for (int k = 0; k < 9; ++k) pf[k] = *(const v4u*)(rn + (size_t)(tid + 512 * k) * 16);
            egl = *(const float*)(rn + 73728);
        }
        bf16x8 Sb[4];
#pragma unroll
        for (int s = 0; s < 4; ++s) Sb[s] = pack_frag(S[2 * s], S[2 * s + 1]);
        f32x4 vn[4], O[4];
#pragma unroll
        for (int rt = 0; rt < 4; ++rt) {
            f32x4 wsacc = (f32x4){0.f, 0.f, 0.f, 0.f}, o = wsacc;
#pragma unroll
            for (int s = 0; s < 4; ++s) {
                wsacc = mfma16(ld_frag_l(L + L_WP + (16 * rt + rl) * 272 + (32 * s + 8 * quad) * 2), Sb[s], wsacc);
                o = mfma16(ld_frag_l(L + L_QP + (16 * rt + rl) * 272 + (32 * s + 8 * quad) * 2), Sb[s], o);
            }
            const v2u uw = *(const LAS v2u*)(L + L_UT + (16 * wave + rl) * 144 + (16 * rt + 4 * quad) * 2);
            vn[rt][0] = lo_bf(uw.x) - wsacc[0]; vn[rt][1] = hi_bf(uw.x) - wsacc[1]; vn[rt][2] = lo_bf(uw.y) - wsacc[2]; vn[rt][3] = hi_bf(uw.y) - wsacc[3];
            O[rt] = o;
        }
        bf16x8 Vb[2]; Vb[0] = pack_frag(vn[0], vn[1]); Vb[1] = pack_frag(vn[2], vn[3]);
#pragma unroll
        for (int rt = 0; rt < 4; ++rt) {
#pragma unroll
            for (int s2 = 0; s2 < 2; ++s2) O[rt] = mfma16(ld_frag_l(L + L_QK + (16 * rt + rl) * 144 + (32 * s2 + 8 * quad) * 2), Vb[s2], O[rt]);
            const size_t row = (size_t)b * TP + 64 * c + 16 * rt + 4 * quad;
#pragma unroll
            for (int i = 0; i < 4; ++i) OG[(row + i) * 512 + h * 128 + 16 * wave + rl] = (bf16)f2bf(O[rt][i]);
        }
#pragma unroll
        for (int kt = 0; kt < 8; ++kt) {
            f32x4 a = S[kt] * eg;
#pragma unroll
            for (int s2 = 0; s2 < 2; ++s2) a = mfma16(ld_frag_l(L + L_KT + (16 * kt + rl) * 144 + (32 * s2 + 8 * quad) * 2), Vb[s2], a);
            S[kt] = a;
        }
    }
    float* So = KOUT() + O_GSP + (size_t)(layer * 8 + bh) * 16384;
#pragma unroll
    for (int kt = 0; kt < 8; ++kt)
#pragma unroll
        for (int i = 0; i < 4; ++i) So[(size_t)(16 * kt + 4 * quad + i) * 128 + 16 * wave + rl] = S[kt][i];
    __syncthreads();
}
DI void ret_scan_part(Frame& F, int layer, int r) {
    int tid = F.tid; asm volatile("" : "+v"(tid));
    const int bh = r >> 2, dv = tid & 127, dk0 = ((r & 3) * 4 + (tid >> 7)) * 8, h = bh & 3;
    unsigned char* ws = KWS();
    const float* RKV = (const float*)(ws + WS_RKV) + (size_t)bh * 64 * 16384;
    bf16* RST = (bf16*)(ws + WS_RST) + (size_t)bh * 64 * 16384;
    const float cdec = __expf(128.f * ret_lg(h));
    float S[8];
#pragma unroll
    for (int i = 0; i < 8; ++i) S[i] = 0.f;
#pragma unroll 4
    for (int c = 0; c < 64; ++c) {
        v4u w; w.x = pk2(S[0], S[1]); w.y = pk2(S[2], S[3]); w.z = pk2(S[4], S[5]); w.w = pk2(S[6], S[7]);
        *(v4u*)(RST + (size_t)c * 16384 + dv * 128 + dk0) = w;
#pragma unroll
        for (int i = 0; i < 8; ++i) S[i] = S[i] * cdec + RKV[(size_t)c * 16384 + (dk0 + i) * 128 + dv];
    }
    float* So = KOUT() + O_RSP + (size_t)(layer * 8 + bh) * 16384;
#pragma unroll
    for (int i = 0; i < 8; ++i) So[(size_t)(dk0 + i) * 128 + dv] = S[i];
}
constexpr float SM_C = 0.125f * 1.4426950408889634f;
struct AttnState { float m, l; f32x4 O[4]; };
DI void attn_reset(AttnState& st) { st.m = -1e30f; st.l = 0.f;
#pragma unroll
    for (int i = 0; i < 4; ++i) st.O[i] = (f32x4){0.f, 0.f, 0.f, 0.f}; }
DI void qk_tile(const LAS unsigned char* Kt, const bf16x8 (&qf)[2], f32x4 (&s)[4], int rl, int quad) {
    bf16x8 kf[4][2];
#pragma unroll
    for (int kt = 0; kt < 4; ++kt)
#pragma unroll
        for (int kk = 0; kk < 2; ++kk) kf[kt][kk] = ld_frag_l(Kt + (16 * kt + rl) * 144 + kk * 64 + quad * 16);
    __builtin_amdgcn_s_setprio(1);
#pragma unroll
    for (int kt = 0; kt < 4; ++kt) s[kt] = mfma16(kf[kt][0], qf[0], (f32x4){0.f, 0.f, 0.f, 0.f});
#pragma unroll
    for (int kt = 0; kt < 4; ++kt) s[kt] = mfma16(kf[kt][1], qf[1], s[kt]);
    __builtin_amdgcn_s_setprio(0);
}
template <class Mask> DI void attn_step(const LAS unsigned char* Kt, const LAS unsigned char* VT, const bf16x8 (&qf)[2], AttnState& st, const Mask& ok, int rl, int quad) {
    f32x4 s[4]; qk_tile(Kt, qf, s, rl, quad);
    float mx = -3e38f;
#pragma unroll
    for (int kt = 0; kt < 4; ++kt)
#pragma unroll
        for (int i = 0; i < 4; ++i) if (ok(16 * kt + 4 * quad + i)) mx = fmaxf(mx, s[kt][i]);
    const int lane = rl + 16 * quad;
    mx = fmaxf(mx, shx<16>(mx, lane)); mx = fmaxf(mx, shx<32>(mx, lane));
    const float mn = fmaxf(st.m, mx);
    const float alpha = exp2f((st.m - mn) * SM_C);
    float ls = 0.f;
#pragma unroll
    for (int kt = 0; kt < 4; ++kt)
#pragma unroll
        for (int i = 0; i < 4; ++i) { const float p = ok(16 * kt + 4 * quad + i) ? exp2f((s[kt][i] - mn) * SM_C) : 0.f; s[kt][i] = p; ls += p; }
    ls += shx<16>(ls, lane); ls += shx<32>(ls, lane);
    st.l = st.l * alpha + ls; st.m = mn;
#pragma unroll
    for (int dt = 0; dt < 4; ++dt) st.O[dt] *= alpha;
#pragma unroll
    for (int ii = 0; ii < 2; ++ii) {
        const bf16x8 pb = pack_frag(s[2 * ii], s[2 * ii + 1]);
#pragma unroll
        for (int dt = 0; dt < 4; ++dt) {
            const LAS unsigned char* vp = VT + (16 * dt + rl) * 144 + (32 * ii + 4 * quad) * 2;
            st.O[dt] = mfma16(mk_frag(*(const LAS v2u*)vp, *(const LAS v2u*)(vp + 32)), pb, st.O[dt]);
        }
    }
}
DI void attn_accum(f32x4 (&Of)[4], const AttnState& st, float gate) {
    const float sc = st.l > 0.f ? gate / st.l : 0.f;
#pragma unroll
    for (int dt = 0; dt < 4; ++dt) Of[dt] += st.O[dt] * sc;
}
DI void vt_write(LAS unsigned char* VT, int d0, int key, const v4u w) {
    LAS unsigned char* d = VT + d0 * 144 + key * 2;
    *(LAS bf16*)(d) = (bf16)(w.x & 0xffff); *(LAS bf16*)(d + 144) = (bf16)(w.x >> 16); *(LAS bf16*)(d + 2 * 144) = (bf16)(w.y & 0xffff); *(LAS bf16*)(d + 3 * 144) = (bf16)(w.y >> 16);
    *(LAS bf16*)(d + 4 * 144) = (bf16)(w.z & 0xffff); *(LAS bf16*)(d + 5 * 144) = (bf16)(w.z >> 16); *(LAS bf16*)(d + 6 * 144) = (bf16)(w.w & 0xffff); *(LAS bf16*)(d + 7 * 144) = (bf16)(w.w >> 16);
}
DI void stage_wg(LAS unsigned char* Kt, LAS unsigned char* VT, const bf16* kb, const bf16* vb, size_t stride, int tid, bool do_v) {
    const int key = tid >> 3, ch = tid & 7;
    *(LAS v4u*)(Kt + key * 144 + ch * 16) = *(const v4u*)(kb + key * stride + ch * 8);
    if (do_v) vt_write(VT, ch * 8, key, *(const v4u*)(vb + key * stride + ch * 8));
}
DI unsigned score_key(float s, bool valid, int idx) { return valid ? (((__float_as_uint(s) | 0x80000000u) & ~127u) | (unsigned)(127 - idx)) : 0u; }
DI int key_rank(const LAS unsigned* K, int ng4, unsigned k) {
    int r = 0;
#pragma unroll 4
    for (int g = 0; g < ng4; ++g) { const v4u v = *(const LAS v4u*)(K + 4 * g); r += (v.x > k) + (v.y > k) + (v.z > k) + (v.w > k); }
    return r;
}
DI void key_rank2(const LAS unsigned* K, int ng4, unsigned k0, unsigned k1, int& r0, int& r1) {
    int a0 = 0, a1 = 0, b0 = 0, b1 = 0;
    const int ng8 = (ng4 + 1) >> 1;
#pragma unroll 4
    for (int g = 0; g < ng8; ++g) { const v4u v = *(const LAS v4u*)(K + 8 * g), w = *(const LAS v4u*)(K + 8 * g + 4);
        a0 += (v.x > k0) + (v.y > k0) + (v.z > k0) + (v.w > k0); b0 += (w.x > k0) + (w.y > k0) + (w.z > k0) + (w.w > k0);
        a1 += (v.x > k1) + (v.y > k1) + (v.z > k1) + (v.w > k1); b1 += (w.x > k1) + (w.y > k1) + (w.z > k1) + (w.w > k1); }
    r0 = a0 + b0; r1 = a1 + b1;
}
DI int top16(float v0, float v1, int lane) {
    int sel = 0;
#pragma unroll 1
    for (int r = 0; r < 16; ++r) {
        float bv; int bi;
        if (v0 >= v1) { bv = v0; bi = lane; } else { bv = v1; bi = lane + 64; }
#define T16_STEP(M) { const float ov = shx<M>(bv, lane); const int oi = shxi<M>(bi, lane); const bool take = (ov > bv) || (ov == bv && oi < bi); bv = take ? ov : bv; bi = take ? oi : bi; }
        T16_STEP(32) T16_STEP(16) T16_STEP(8) T16_STEP(4) T16_STEP(2) T16_STEP(1)
#undef T16_STEP
        const bool h0 = (bi == lane), h1 = (bi == lane + 64);
        v0 = h0 ? -3e38f : v0; v1 = h1 ? -3e38f : v1; sel |= (h0 ? 1 : 0) | (h1 ? 2 : 0);
    }
    return sel;
}

typedef short v4i16_t __attribute__((ext_vector_type(4)));
DI s16x4 vtr(const LAS unsigned char* p) { return __builtin_bit_cast(s16x4, __builtin_amdgcn_ds_read_tr16_b64_v4i16((LAS v4i16_t*)p)); }
DI bf16x8 cat4(s16x4 a, s16x4 b) { bf16x8 r; r[0] = a[0]; r[1] = a[1]; r[2] = a[2]; r[3] = a[3]; r[4] = b[0]; r[5] = b[1]; r[6] = b[2]; r[7] = b[3]; return r; }
DI void attn_step3(const LAS unsigned char* Kt, const LAS unsigned char* Vt, const bf16x8 (&qf)[2], AttnState& st, int lo, int hi, bool active, int rl, int quad) {
    active = active && (hi >= lo);
    if (!__any(active)) return;
    f32x4 s[4]; qk_tile(Kt, qf, s, rl, quad);
    const int lane = rl + 16 * quad;
    const bool full = __all((lo <= 0 && hi >= 63) || !active);
    const int kq = 4 * quad - lo; const unsigned rng = (unsigned)(hi - lo);
    float lm;
    if (full) {
        const float a0 = fmaxf(fmaxf(s[0][0], s[0][1]), fmaxf(s[0][2], s[0][3])), a1 = fmaxf(fmaxf(s[1][0], s[1][1]), fmaxf(s[1][2], s[1][3]));
        const float a2 = fmaxf(fmaxf(s[2][0], s[2][1]), fmaxf(s[2][2], s[2][3])), a3 = fmaxf(fmaxf(s[3][0], s[3][1]), fmaxf(s[3][2], s[3][3]));
        lm = fmaxf(fmaxf(a0, a1), fmaxf(a2, a3));
    } else {
        lm = -3e38f;
#pragma unroll
        for (int kt = 0; kt < 4; ++kt)
#pragma unroll
            for (int i = 0; i < 4; ++i) lm = ((unsigned)(kq + 16 * kt + i) <= rng) ? fmaxf(lm, s[kt][i]) : lm;
    }
    lm = active ? lm : -3e38f;
    if (__any(lm > st.m + 320.f)) {
        float mx = fmaxf(lm, shx<16>(lm, lane)); mx = fmaxf(mx, shx<32>(mx, lane));
        const float mn = fmaxf(st.m, mx);
        const float alpha = __builtin_amdgcn_exp2f((st.m - mn) * SM_C);
        st.l *= alpha; st.m = mn;
#pragma unroll
        for (int dt = 0; dt < 4; ++dt) st.O[dt] *= alpha;
    }
    const float mc = active ? st.m * SM_C : __builtin_inff();
    float ls = 0.f;
    if (full) {
#pragma unroll
        for (int kt = 0; kt < 4; ++kt)
#pragma unroll
            for (int i = 0; i < 4; ++i) { const float p = __builtin_amdgcn_exp2f(s[kt][i] * SM_C - mc); s[kt][i] = p; ls += p; }
    } else {
#pragma unroll
        for (int kt = 0; kt < 4; ++kt)
#pragma unroll
            for (int i = 0; i < 4; ++i) { const float p = ((unsigned)(kq + 16 * kt + i) <= rng) ? __builtin_amdgcn_exp2f(s[kt][i] * SM_C - mc) : 0.f; s[kt][i] = p; ls += p; }
    }
    st.l += ls;
#pragma unroll
    for (int ii = 0; ii < 2; ++ii) {
        const bf16x8 pb = pack_frag(s[2 * ii], s[2 * ii + 1]);
#pragma unroll
        for (int dt = 0; dt < 4; ++dt) {
            const LAS unsigned char* vp = Vt + (32 * ii + 4 * quad + (rl >> 2)) * 144 + (16 * dt + 4 * (rl & 3)) * 2;
            st.O[dt] = mfma16(cat4(vtr(vp), vtr(vp + 16 * 144)), pb, st.O[dt]);
        }
    }
}
DI float attn_rowsum(const AttnState& st, int lane) { float l = st.l; l += shx<16>(l, lane); l += shx<32>(l, lane); return l; }
DI void attn_accum3(f32x4 (&Of)[4], const AttnState& st, float gate, int lane) {
    const float l = attn_rowsum(st, lane);
    const float sc = l > 0.f ? gate / l : 0.f;
#pragma unroll
    for (int dt = 0; dt < 4; ++dt) Of[dt] += st.O[dt] * sc;
}
#ifndef PH_NPT
#define PH_NPT (-1)
#endif
#if PH_NPT >= 0
#define NP_T(k) do { if (tid == 0) { volatile LAS unsigned long long* np_ = (volatile LAS unsigned long long*)(F.lds + LDSCTL_OFF + 464); const unsigned long long now_ = __builtin_amdgcn_s_memrealtime(); \
    if ((k) == PH_NPT) np_[0] += now_ - np_[1]; np_[1] = now_; } } while (0)
#else
#define NP_T(k) do { } while (0)
#endif
#ifndef PH_NSAC
#define PH_NSAC 1
#endif
DI float tile_max(const f32x4 (&s)[4], bool full, int kq, unsigned rng) {
    float lm;
    if (full) {
        const float a0 = fmaxf(fmaxf(s[0][0], s[0][1]), fmaxf(s[0][2], s[0][3])), a1 = fmaxf(fmaxf(s[1][0], s[1][1]), fmaxf(s[1][2], s[1][3]));
        const float a2 = fmaxf(fmaxf(s[2][0], s[2][1]), fmaxf(s[2][2], s[2][3])), a3 = fmaxf(fmaxf(s[3][0], s[3][1]), fmaxf(s[3][2], s[3][3]));
        lm = fmaxf(fmaxf(a0, a1), fmaxf(a2, a3));
    } else {
        lm = -3e38f;
#pragma unroll
        for (int kt = 0; kt < 4; ++kt)
#pragma unroll
            for (int i = 0; i < 4; ++i) lm = ((unsigned)(kq + 16 * kt + i) <= rng) ? fmaxf(lm, s[kt][i]) : lm;
    }
    return lm;
}
DI float tile_exp(f32x4 (&s)[4], bool full, int kq, unsigned rng, float mc) {
    float ls = 0.f;
    if (full) {
#pragma unroll
        for (int kt = 0; kt < 4; ++kt)
#pragma unroll
            for (int i = 0; i < 4; ++i) { const float p = __builtin_amdgcn_exp2f(s[kt][i] * SM_C - mc); s[kt][i] = p; ls += p; }
    } else {
#pragma unroll
        for (int kt = 0; kt < 4; ++kt)
#pragma unroll
            for (int i = 0; i < 4; ++i) { const float p = ((unsigned)(kq + 16 * kt + i) <= rng) ? __builtin_amdgcn_exp2f(s[kt][i] * SM_C - mc) : 0.f; s[kt][i] = p; ls += p; }
    }
    return ls;
}
DI void tile_pv(const LAS unsigned char* Vt, const f32x4 (&s)[4], f32x4 (&O)[4], int rl, int quad) {
    bf16x8 vf[2][4];
#pragma unroll
    for (int ii = 0; ii < 2; ++ii)
#pragma unroll
        for (int dt = 0; dt < 4; ++dt) { const LAS unsigned char* vp = Vt + (32 * ii + 4 * quad + (rl >> 2)) * 144 + (16 * dt + 4 * (rl & 3)) * 2; vf[ii][dt] = cat4(vtr(vp), vtr(vp + 16 * 144)); }
    const bf16x8 pb0 = pack_frag(s[0], s[1]), pb1 = pack_frag(s[2], s[3]);
    __builtin_amdgcn_s_setprio(1);
#pragma unroll
    for (int dt = 0; dt < 4; ++dt) O[dt] = mfma16(vf[0][dt], pb0, O[dt]);
#pragma unroll
    for (int dt = 0; dt < 4; ++dt) O[dt] = mfma16(vf[1][dt], pb1, O[dt]);
    __builtin_amdgcn_s_setprio(0);
}
DI void tile_vload(const LAS unsigned char* Vt, bf16x8 (&vf)[2][4], int rl, int quad) {
#pragma unroll
    for (int ii = 0; ii < 2; ++ii)
#pragma unroll
        for (int dt = 0; dt < 4; ++dt) { const LAS unsigned char* vp = Vt + (32 * ii + 4 * quad + (rl >> 2)) * 144 + (16 * dt + 4 * (rl & 3)) * 2; vf[ii][dt] = cat4(vtr(vp), vtr(vp + 16 * 144)); }
}
DI void tile_pvmma(const bf16x8 (&vf)[2][4], const f32x4 (&s)[4], f32x4 (&O)[4]) {
    const bf16x8 pb0 = pack_frag(s[0], s[1]), pb1 = pack_frag(s[2], s[3]);
    __builtin_amdgcn_s_setprio(1);
#pragma unroll
    for (int dt = 0; dt < 4; ++dt) O[dt] = mfma16(vf[0][dt], pb0, O[dt]);
#pragma unroll
    for (int dt = 0; dt < 4; ++dt) O[dt] = mfma16(vf[1][dt], pb1, O[dt]);
    __builtin_amdgcn_s_setprio(0);
}
DI void attn_step_pair(const LAS unsigned char* K0, const LAS unsigned char* V0, int lo0, int hi0, bool act0,
                       const LAS unsigned char* K1, const LAS unsigned char* V1, int lo1, int hi1, bool act1,
                       const bf16x8 (&qf)[2], AttnState& st, int rl, int quad) {
    act0 = act0 && (hi0 >= lo0); act1 = act1 && (hi1 >= lo1);
    const bool any0 = __any(act0), any1 = __any(act1);
    if (!any0 && !any1) return;
    const int lane = rl + 16 * quad;
    f32x4 s0[4], s1[4];
    if (any0 && any1) {
        bf16x8 kf0[4][2], kf1[4][2];
#pragma unroll
        for (int kt = 0; kt < 4; ++kt)
#pragma unroll
            for (int kk = 0; kk < 2; ++kk) { kf0[kt][kk] = ld_frag_l(K0 + (16 * kt + rl) * 144 + kk * 64 + quad * 16); kf1[kt][kk] = ld_frag_l(K1 + (16 * kt + rl) * 144 + kk * 64 + quad * 16); }
        __builtin_amdgcn_s_setprio(1);
#pragma unroll
        for (int kt = 0; kt < 4; ++kt) s0[kt] = mfma16(kf0[kt][0], qf[0], (f32x4){0.f, 0.f, 0.f, 0.f});
#pragma unroll
        for (int kt = 0; kt < 4; ++kt) s1[kt] = mfma16(kf1[kt][0], qf[0], (f32x4){0.f, 0.f, 0.f, 0.f});
#pragma unroll
        for (int kt = 0; kt < 4; ++kt) s0[kt] = mfma16(kf0[kt][1], qf[1], s0[kt]);
#pragma unroll
        for (int kt = 0; kt < 4; ++kt) s1[kt] = mfma16(kf1[kt][1], qf[1], s1[kt]);
        __builtin_amdgcn_s_setprio(0);
    } else {
        if (any0) qk_tile(K0, qf, s0, rl, quad);
        if (any1) qk_tile(K1, qf, s1, rl, quad);
    }
    const bool full0 = __all((lo0 <= 0 && hi0 >= 63) || !act0), full1 = __all((lo1 <= 0 && hi1 >= 63) || !act1);
    const int kq0 = 4 * quad - lo0, kq1 = 4 * quad - lo1; const unsigned rng0 = (unsigned)(hi0 - lo0), rng1 = (unsigned)(hi1 - lo1);
    float mcb = st.m * SM_C;
    bf16x8 vf0[2][4], vf1[2][4];
    if (any0) tile_vload(V0, vf0, rl, quad);
    float ls = 0.f;
    if (any0) ls += tile_exp(s0, full0, kq0, rng0, act0 ? mcb : __builtin_inff());
    if (any1) ls += tile_exp(s1, full1, kq1, rng1, act1 ? mcb : __builtin_inff());
    if (__any(!(ls <= 1e30f))) {
        if (any0) qk_tile(K0, qf, s0, rl, quad);
        if (any1) qk_tile(K1, qf, s1, rl, quad);
        float lm = -3e38f;
        if (any0) { const float a = tile_max(s0, full0, kq0, rng0); lm = act0 ? a : lm; }
        if (any1) { const float a = tile_max(s1, full1, kq1, rng1); lm = act1 ? fmaxf(lm, a) : lm; }
        float mx = fmaxf(lm, shx<16>(lm, lane)); mx = fmaxf(mx, shx<32>(mx, lane));
        const float mn = fmaxf(st.m, mx);
        const float alpha = __builtin_amdgcn_exp2f((st.m - mn) * SM_C);
        st.l *= alpha; st.m = mn;
#pragma unroll
        for (int dt = 0; dt < 4; ++dt) st.O[dt] *= alpha;
        mcb = mn * SM_C; ls = 0.f;
        if (any0) ls += tile_exp(s0, full0, kq0, rng0, act0 ? mcb : __builtin_inff());
        if (any1) ls += tile_exp(s1, full1, kq1, rng1, act1 ? mcb : __builtin_inff());
    }
    st.l += ls;
    if (any1) tile_vload(V1, vf1, rl, quad);
    if (any0) tile_pvmma(vf0, s0, st.O);
    if (any1) tile_pvmma(vf1, s1, st.O);
}
DI void nsa_prompt_unit(Frame& F, int layer, int unit) {
    int lane = F.lane, wave = F.wave; asm volatile("" : "+v"(lane), "+s"(wave));
    const int tid = wave * 64 + lane, quad = lane >> 4, rl = lane & 15;
    const int b = unit >> 9, g = (unit >> 8) & 1, tt = unit & 255, t0 = 32 * tt;
    unsigned char* ws = KWS();
    const bf16* Z = (const bf16*)(ws + WS_Z);
    const float* ZS = (const float*)(ws + WS_ZS);
    LAS unsigned char* TB = F.lds;
    LAS float* AIMP = (LAS float*)(F.lds + 73728);
    LAS unsigned* SEL = (LAS unsigned*)(F.lds + LDSCTL_OFF + 512);
    const int tk = 4 * wave + (rl >> 2), t = t0 + tk, head = 4 * g + (rl & 3);
    const size_t row = (size_t)b * TP + t;
    bf16x8 qf[2];
    qf[0] = ld_frag_g(Z + row * LDZ + ZC_Q + head * 64 + quad * 8); qf[1] = ld_frag_g(Z + row * LDZ + ZC_Q + head * 64 + 32 + quad * 8);
    const float gc = sigmoidf_(ZS[row * 32 + head * 3]), gs = sigmoidf_(ZS[row * 32 + head * 3 + 1]), gw = sigmoidf_(ZS[row * 32 + head * 3 + 2]);
    f32x4 Of[4];
#pragma unroll
    for (int i = 0; i < 4; ++i) Of[i] = (f32x4){0.f, 0.f, 0.f, 0.f};
    AttnState st;
    const int nct = (t0 >> 10) + 1;
    const bf16* KC = (const bf16*)(ws + WS_KC) + ((size_t)(0 * 2 + b) * 512 * 2 + g) * 64;
    const bf16* VC = (const bf16*)(ws + WS_KC) + ((size_t)(1 * 2 + b) * 512 * 2 + g) * 64;
    const bf16* Zb = Z + (size_t)b * TP * LDZ + g * 64;
    const int skey = tid >> 3, sch = tid & 7;
    const int wlo = (t0 - 511 > 0 ? t0 - 511 : 0) >> 6, nwin = ((t0 + 31) >> 6) - wlo + 1;
    const int nwe = (nwin + 1) & ~1, nce = (nct + 1) & ~1;
    v4u rkA, rvA, rkB, rvB;
#define COMMIT(slot, rk, rv) do { LAS unsigned char* d_ = TB + (slot) * 18432 + skey * 144 + sch * 16; *(LAS v4u*)d_ = rk; *(LAS v4u*)(d_ + 9216) = rv; } while (0)
    NP_T(0);
    const int n1 = nwe + 2 * nce;
#define SEG1_VALID(i) ((i) < nwe ? (i) < nwin : (((i) - nwe) < nce ? ((i) - nwe) < nct : ((i) - nwe - nce) < nct))
#define SEG1_ISSUE(i, rk, rv) do { int i_ = (i); i_ = i_ < n1 ? i_ : n1 - 1; const bool win_ = i_ < nwe; int wt_ = wlo + (i_ < nwin ? i_ : nwin - 1); int jt_ = (i_ - nwe) % nce; jt_ = jt_ < nct ? jt_ : nct - 1; jt_ = jt_ < 0 ? 0 : jt_; \
        const bf16* pk_ = win_ ? Zb + (size_t)(64 * wt_ + skey) * LDZ + sch * 8 + ZC_KW : KC + (size_t)(64 * jt_ + skey) * 128 + sch * 8; \
        const bf16* pv_ = win_ ? Zb + (size_t)(64 * wt_ + skey) * LDZ + sch * 8 + ZC_VW : VC + (size_t)(64 * jt_ + skey) * 128 + sch * 8; \
        rk = *(const v4u*)pk_; rv = *(const v4u*)pv_; } while (0)
    attn_reset(st);
    float mfin = 0.f, il = 0.f;
    SEG1_ISSUE(0, rkA, rvA); SEG1_ISSUE(1, rkB, rvB);
    COMMIT(0, rkA, rvA); COMMIT(1, rkB, rvB);
    SEG1_ISSUE(2, rkA, rvA); SEG1_ISSUE(3, rkB, rvB);
    __syncthreads();
    for (int i = 0; i < n1; i += 2) {
        const LAS unsigned char* K0 = TB + (i & 3) * 18432; const LAS unsigned char* K1 = TB + ((i + 1) & 3) * 18432;
        if (i < nwe) {
            const int kb0 = 64 * (wlo + i), kb1 = kb0 + 64;
            attn_step_pair(K0, K0 + 9216, t - 511 - kb0, t - kb0, true, K1, K1 + 9216, t - 511 - kb1, t - kb1, (i + 1) < nwin, qf, st, rl, quad);
            if (i + 2 == nwe) { attn_accum3(Of, st, gw, lane); attn_reset(st); }
        } else if (i < nwe + nce) {
            const int nb0 = 64 * (i - nwe), nb1 = nb0 + 64;
            attn_step_pair(K0, K0 + 9216, 0, ((t - 31) >> 4) - nb0, true, K1, K1 + 9216, 0, ((t - 31) >> 4) - nb1, (i + 1 - nwe) < nct, qf, st, rl, quad);
            if (i + 2 == nwe + nce) { attn_accum3(Of, st, gc, lane); mfin = st.m * SM_C; const float lt_ = attn_rowsum(st, lane); il = lt_ > 0.f ? 1.f / lt_ : 0.f; }
        } else {
#pragma unroll
            for (int e2 = 0; e2 < 2; ++e2) {
                const int jt = i + e2 - nwe - nce;
                if (jt < nct) {
                    f32x4 s[4]; qk_tile(e2 ? K1 : K0, qf, s, rl, quad);
#pragma unroll
                    for (int kt = 0; kt < 4; ++kt)
#pragma unroll
                        for (int e = 0; e < 4; ++e) {
                            const int n = 64 * jt + 16 * kt + 4 * quad + e;
                            float p = (16 * n + 31 <= t) ? __builtin_amdgcn_exp2f(s[kt][e] * SM_C - mfin) * il : 0.f;
                            p += shx<1>(p, lane); p += shx<2>(p, lane);
                            if ((rl & 3) == 0) AIMP[tk * 512 + n] = p;
                        }
                }
            }
        }
        if (i + 2 < n1) { if (SEG1_VALID(i + 2)) COMMIT((i + 2) & 3, rkA, rvA); if (SEG1_VALID(i + 3)) COMMIT((i + 3) & 3, rkB, rvB); }
        __syncthreads();
        SEG1_ISSUE(i + 4, rkA, rvA); SEG1_ISSUE(i + 5, rkB, rvB);
    }
    NP_T(1);
    {
        const int nav = nct * 64;
        LAS unsigned* KS = (LAS unsigned*)(TB + wave * 2048);
#pragma unroll
        for (int q = 0; q < 4; ++q) {
            const int tq = 4 * wave + q, cur = (t0 + tq) >> 6;
#pragma unroll
            for (int e = 0; e < 2; ++e) {
                const int sblk = lane + 64 * e;
                float imp = 0.f;
#pragma unroll
                for (int d = -1; d <= 3; ++d) { const int n = 4 * sblk + d; if (n >= 0 && n < nav) imp += AIMP[tq * 512 + n]; }
                const bool valid = sblk <= cur, forced = (sblk == 0) || (sblk == cur) || (sblk == cur - 1);
                KS[q * 128 + sblk] = score_key(imp + (forced ? 1000.f : 0.f), valid, sblk);
            }
        }
        asm volatile("" ::: "memory");
#pragma unroll
        for (int q = 0; q < 4; ++q) {
            const int tq = 4 * wave + q, cur = (t0 + tq) >> 6, ng4 = (cur >> 2) + 1;
            const unsigned k0 = KS[q * 128 + lane], k1 = KS[q * 128 + 64 + lane];
            int r0, r1; key_rank2(KS + q * 128, ng4, k0, k1, r0, r1);
            const bool s0 = (lane <= cur) && r0 < 16, s1 = (lane + 64 <= cur) && r1 < 16;
            const unsigned long long m0 = __ballot(s0), m1 = __ballot(s1);
            if (lane == 0) { SEL[tq * 4 + 0] = (unsigned)m0; SEL[tq * 4 + 1] = (unsigned)(m0 >> 32); SEL[tq * 4 + 2] = (unsigned)m1; SEL[tq * 4 + 3] = (unsigned)(m1 >> 32); }
        }
    }
    __syncthreads();
    unsigned un[4], my[4], wv[4];
#pragma unroll
    for (int w = 0; w < 4; ++w) { unsigned v = (lane < 32) ? SEL[lane * 4 + w] : 0u;
        v |= (unsigned)shxi<1>((int)v, lane); v |= (unsigned)shxi<2>((int)v, lane); v |= (unsigned)shxi<4>((int)v, lane); v |= (unsigned)shxi<8>((int)v, lane); v |= (unsigned)shxi<16>((int)v, lane); v |= (unsigned)shxi<32>((int)v, lane);
        un[w] = __builtin_amdgcn_readfirstlane(v); my[w] = SEL[tk * 4 + w];
        wv[w] = SEL[(4 * wave) * 4 + w] | SEL[(4 * wave + 1) * 4 + w] | SEL[(4 * wave + 2) * 4 + w] | SEL[(4 * wave + 3) * 4 + w]; wv[w] = __builtin_amdgcn_readfirstlane(wv[w]); }
#if PH_NSAC > 1
    AttnState st2; attn_reset(st2);
#endif
    NP_T(2);
    attn_reset(st);
    {
        unsigned w0 = un[0], w1 = un[1], w2 = un[2], w3 = un[3];
#define NEXT_BLK(dst) do { if (w0) { dst = __builtin_ctz(w0); w0 &= w0 - 1u; } else if (w1) { dst = 32 + __builtin_ctz(w1); w1 &= w1 - 1u; } else if (w2) { dst = 64 + __builtin_ctz(w2); w2 &= w2 - 1u; } \
        else if (w3) { dst = 96 + __builtin_ctz(w3); w3 &= w3 - 1u; } else dst = -1; } while (0)
#define SEG2_ISSUE(blk_, rk, rv) do { const int b_ = (blk_) >= 0 ? (blk_) : 0; const bf16* p_ = Zb + (size_t)(64 * b_ + skey) * LDZ + sch * 8; rk = *(const v4u*)(p_ + ZC_KS); rv = *(const v4u*)(p_ + ZC_VS); } while (0)
#define BLK_WORD(arr, blk_) (((blk_) >> 5) == 0 ? arr[0] : ((blk_) >> 5) == 1 ? arr[1] : ((blk_) >> 5) == 2 ? arr[2] : arr[3])
#define SEG2_PAIR(ca, cb, sa, sb, stt) do { const LAS unsigned char* K0 = TB + (sa) * 18432; const LAS unsigned char* K1 = TB + (sb) * 18432; \
            const int ca_ = (ca) >= 0 ? (ca) : 0, cb_ = (cb) >= 0 ? (cb) : 0; \
            const bool need0 = ((ca) >= 0) && ((BLK_WORD(wv, ca_) >> (ca_ & 31)) & 1u), need1 = ((cb) >= 0) && ((BLK_WORD(wv, cb_) >> (cb_ & 31)) & 1u); \
            const bool mine0 = need0 && ((BLK_WORD(my, ca_) >> (ca_ & 31)) & 1u), mine1 = need1 && ((BLK_WORD(my, cb_) >> (cb_ & 31)) & 1u); \
            attn_step_pair(K0, K0 + 9216, 0, t - 64 * ca_, mine0, K1, K1 + 9216, 0, t - 64 * cb_, mine1, qf, stt, rl, quad); } while (0)
        v4u rkC, rvC, rkD, rvD;
        int c0, c1, c2, c3, n0, n1b, n2, n3, m0, m1, m2, m3;
        NEXT_BLK(c0); NEXT_BLK(c1); NEXT_BLK(c2); NEXT_BLK(c3); NEXT_BLK(n0); NEXT_BLK(n1b); NEXT_BLK(n2); NEXT_BLK(n3);
        SEG2_ISSUE(c0, rkA, rvA); SEG2_ISSUE(c1, rkB, rvB); SEG2_ISSUE(c2, rkC, rvC); SEG2_ISSUE(c3, rkD, rvD);
        COMMIT(0, rkA, rvA); COMMIT(1, rkB, rvB); COMMIT(2, rkC, rvC); COMMIT(3, rkD, rvD);
        SEG2_ISSUE(n0, rkA, rvA); SEG2_ISSUE(n1b, rkB, rvB); SEG2_ISSUE(n2, rkC, rvC); SEG2_ISSUE(n3, rkD, rvD);
        __syncthreads();
        int i = 0;
        while (c0 >= 0) {
            NEXT_BLK(m0); NEXT_BLK(m1); NEXT_BLK(m2); NEXT_BLK(m3);
            SEG2_PAIR(c0, c1, i & 7, (i + 1) & 7, st);
            SEG2_PAIR(c2, c3, (i + 2) & 7, (i + 3) & 7, st);
#if PH_NSAC > 1
            SEG2_PAIR(c0, c1, i & 7, (i + 1) & 7, st2); SEG2_PAIR(c2, c3, (i + 2) & 7, (i + 3) & 7, st2);
#endif
            COMMIT((i + 4) & 7, rkA, rvA); COMMIT((i + 5) & 7, rkB, rvB); COMMIT((i + 6) & 7, rkC, rvC); COMMIT((i + 7) & 7, rkD, rvD);
            __syncthreads();
#if defined(PH_NSAX) && (PH_NSAX & 1)
            __syncthreads();
#endif
#if defined(PH_NSAX) && (PH_NSAX & 2)
            { v4u d0_, d1_; SEG2_ISSUE(m0, d0_, d1_); asm volatile("" :: "v"(d0_), "v"(d1_)); SEG2_ISSUE(m1, d0_, d1_); asm volatile("" :: "v"(d0_), "v"(d1_));
              SEG2_ISSUE(m2, d0_, d1_); asm volatile("" :: "v"(d0_), "v"(d1_)); SEG2_ISSUE(m3, d0_, d1_); asm volatile("" :: "v"(d0_), "v"(d1_)); }
#endif
            SEG2_ISSUE(m0, rkA, rvA); SEG2_ISSUE(m1, rkB, rvB); SEG2_ISSUE(m2, rkC, rvC); SEG2_ISSUE(m3, rkD, rvD);
            c0 = n0; c1 = n1b; c2 = n2; c3 = n3; n0 = m0; n1b = m1; n2 = m2; n3 = m3; i += 4;
        }
    }
    NP_T(3);
    attn_accum3(Of, st, gs, lane);
#if PH_NSAC > 1
    attn_accum3(Of, st2, (float)(layer >> 8), lane);
#endif
#undef SEG1_ISSUE
#undef SEG1_VALID
#undef SEG2_ISSUE
#undef SEG2_PAIR
#undef BLK_WORD
#undef COMMIT
#undef NEXT_BLK
    bf16* MIX = (bf16*)(ws + WS_MIX) + row * 1536 + head * 64;
#pragma unroll
    for (int dt = 0; dt < 4; ++dt) { v2u w; w.x = pk2(Of[dt][0], Of[dt][1]); w.y = pk2(Of[dt][2], Of[dt][3]); *(v2u*)(MIX + 16 * dt + 4 * quad) = w; }
    __syncthreads();
}

#define CB() asm volatile("" ::: "memory")
DI void stage_wave_f32(LAS unsigned char* Kt, LAS unsigned char* Vt, const float* kb, const float* vb, size_t stride, int lane, float* ck = nullptr, float* cv = nullptr, int rowskip = 0) {
    const int k0 = lane >> 3, ch = lane & 7;
#pragma unroll
    for (int h = 0; h < 4; ++h) {
        const float* src = (h < 2 ? kb : vb); LAS unsigned char* dst = (h < 2 ? Kt : Vt); const int r0 = (h & 1) * 32; float* cp = (h < 2 ? ck : cv);
        f32x4 a[4][2];
#pragma unroll
        for (int it = 0; it < 4; ++it) { const float* kp = src + (size_t)(r0 + it * 8 + k0) * stride + ch * 8; a[it][0] = *(const f32x4*)kp; a[it][1] = *(const f32x4*)(kp + 4); }
#pragma unroll
        for (int it = 0; it < 4; ++it) *(LAS v4u*)(dst + (r0 + it * 8 + k0) * 144 + ch * 16) = pack8(a[it][0], a[it][1]);
        if (cp) {
#pragma unroll
            for (int it = 0; it < 4; ++it) { const int rr = r0 + it * 8 + k0; if (rr >= rowskip) { float* op = cp + (size_t)rr * stride + ch * 8; *(f32x4*)op = a[it][0]; *(f32x4*)(op + 4) = a[it][1]; } }
        }
        asm volatile("" ::: "memory");
    }
}
DI void stage_wave_b16(LAS unsigned char* Kt, LAS unsigned char* Vt, const bf16* kb, const bf16* vb, size_t stride, int nvalid, int lane, bool do_v) {
    const int k0 = lane >> 3, ch = lane & 7;
    const v4u z = (v4u){0u, 0u, 0u, 0u};
#pragma unroll
    for (int it = 0; it < 8; ++it) {
        const int key = it * 8 + k0; const bool v = key < nvalid;
        *(LAS v4u*)(Kt + key * 144 + ch * 16) = v ? *(const v4u*)(kb + key * stride + ch * 8) : z;
        if (do_v) *(LAS v4u*)(Vt + key * 144 + ch * 16) = v ? *(const v4u*)(vb + key * stride + ch * 8) : z;
    }
}
DI void nsa_sample_unit(Frame& F, int layer, int s) {
    int lane = F.lane, wave = F.wave; asm volatile("" : "+v"(lane), "+s"(wave));
    const int quad = lane >> 4, rl = lane & 15;
    const int g = wave & 1, q4 = wave >> 1;
    unsigned char* ws = KWS();
    const bf16* Z = (const bf16*)(ws + WS_Z);
    const float* ZS = (const float*)(ws + WS_ZS);
    LAS unsigned char* Kt = F.lds + wave * 18432; LAS unsigned char* Vt = Kt + 9216;
    LAS float* AIMP = (LAS float*)Vt;
    const int j = rl >> 2, head = 4 * g + (rl & 3), qpos = 2048 + j;
    const size_t row = (size_t)MP + 4 * s + j;
    bf16x8 qf[2];
    qf[0] = ld_frag_g(Z + row * LDZ + ZC_Q + head * 64 + quad * 8); qf[1] = ld_frag_g(Z + row * LDZ + ZC_Q + head * 64 + 32 + quad * 8);
    const float gc = sigmoidf_(ZS[row * 32 + head * 3]), gs = sigmoidf_(ZS[row * 32 + head * 3 + 1]), gw = sigmoidf_(ZS[row * 32 + head * 3 + 2]);
    f32x4 Of[4];
#pragma unroll
    for (int i = 0; i < 4; ++i) Of[i] = (f32x4){0.f, 0.f, 0.f, 0.f};
    AttnState st;
    const bf16* KC = (const bf16*)(ws + WS_KCS) + ((size_t)(0 * 128 + s) * 128 * 2 + g) * 64;
    const bf16* VC = (const bf16*)(ws + WS_KCS) + ((size_t)(1 * 128 + s) * 128 * 2 + g) * 64;
    attn_reset(st);
#pragma unroll 1
    for (int jt = 0; jt < 2; ++jt) {
        stage_wave_b16(Kt, Vt, KC + (size_t)64 * jt * 128, VC + (size_t)64 * jt * 128, 128, 64, lane, true); CB();
        attn_step3(Kt, Vt, qf, st, 0, 126 - 64 * jt, true, rl, quad); CB();
    }
    attn_accum3(Of, st, q4 == 0 ? gc : 0.f, lane);
    {
        const float mfin = st.m * SM_C, lt = attn_rowsum(st, lane), il = lt > 0.f ? 1.f / lt : 0.f;
#pragma unroll 1
        for (int jt = 0; jt < 2; ++jt) {
            stage_wave_b16(Kt, Vt, KC + (size_t)64 * jt * 128, VC, 128, 64, lane, false); CB();
            f32x4 sv[4]; qk_tile(Kt, qf, sv, rl, quad); CB();
#pragma unroll
            for (int kt = 0; kt < 4; ++kt)
#pragma unroll
                for (int i = 0; i < 4; ++i) {
                    const int n = 64 * jt + 16 * kt + 4 * quad + i;
                    float p = (n <= 126) ? __builtin_amdgcn_exp2f(sv[kt][i] * SM_C - mfin) * il : 0.f;
                    p += shx<1>(p, lane); p += shx<2>(p, lane);
                    if ((rl & 3) == 0) AIMP[j * 128 + n] = p;
                }
        }
    }
    CB();
    unsigned long long msk[4];
    {
        unsigned keys[4];
#pragma unroll
        for (int q = 0; q < 4; ++q) {
            float imp = 0.f;
#pragma unroll
            for (int d = -1; d <= 3; ++d) { const int n = 4 * lane + d; if (n >= 0 && n <= 126 && lane < 33) imp += AIMP[q * 128 + n]; }
            const bool forced = (lane == 0) || (lane == 32) || (lane == 31);
            keys[q] = score_key(imp + (forced ? 1000.f : 0.f), lane < 33, lane);
        }
        CB();
        LAS unsigned* KS = (LAS unsigned*)Kt;
#pragma unroll
        for (int q = 0; q < 4; ++q) KS[q * 64 + lane] = keys[q];
        CB();
#pragma unroll
        for (int q = 0; q < 4; ++q) msk[q] = __ballot(lane < 33 && key_rank(KS + q * 64, 9, keys[q]) < 16);
    }
    CB();
    const unsigned long long un = msk[0] | msk[1] | msk[2] | msk[3];
    const unsigned long long mym = j == 0 ? msk[0] : j == 1 ? msk[1] : j == 2 ? msk[2] : msk[3];
    const int* pt = (const int*)KIN(7);
    AttnState sw;
    attn_reset(st); attn_reset(sw);
    {
        unsigned long long word = un; int idx = 0;
        while (word) {
            const int blk = __builtin_ctzll(word); word &= word - 1ull;
            if ((idx++ & 3) != q4) continue;
            if (blk < 32) {
                const int phys = pt[s * 16 + (blk >> 1)];
                const float* base = KIN(2) + ((size_t)(layer * 2560 + phys) * 128 + (blk & 1) * 64) * 512 + g * 64;
                stage_wave_f32(Kt, Vt, base + 256, base + 384, 512, lane); CB();
            } else {
                stage_wave_b16(Kt, Vt, Z + (size_t)(MP + 4 * s) * LDZ + ZC_KS + g * 64, Z + (size_t)(MP + 4 * s) * LDZ + ZC_VS + g * 64, LDZ, 4, lane, true); CB();
            }
            attn_step3(Kt, Vt, qf, st, 0, qpos - 64 * blk, (mym >> blk) & 1ull, rl, quad); CB();
        }
#pragma unroll 1
        for (int jt = 0; jt < 9; ++jt) {
            if ((idx++ & 3) != q4) continue;
            if (jt < 8) { const float* base = KIN(3) + ((size_t)(layer * 128 + s) * 512 + 64 * jt) * 256 + g * 64;
                float* ob = KOUT() + O_WINS + ((size_t)(layer * 128 + s) * 512 + 64 * jt) * 256 + g * 64 - (size_t)4 * 256;
                stage_wave_f32(Kt, Vt, base, base + 128, 256, lane, ob, ob + 128, jt == 0 ? 4 : 0); CB(); }
            else { stage_wave_b16(Kt, Vt, Z + (size_t)(MP + 4 * s) * LDZ + ZC_KW + g * 64, Z + (size_t)(MP + 4 * s) * LDZ + ZC_VW + g * 64, LDZ, 4, lane, true); CB(); }
            attn_step3(Kt, Vt, qf, sw, j + 1 - 64 * jt, 512 + j - 64 * jt, true, rl, quad); CB();
        }
    }
    int lane2 = lane; asm volatile("" : "+v"(lane2));
    LAS float* X = (LAS float*)(F.lds + wave * 18432);
    {
        const float ls = attn_rowsum(st, lane), lw = attn_rowsum(sw, lane);
        X[0 * 64 + lane2] = st.m; X[1 * 64 + lane2] = ls; X[18 * 64 + lane2] = sw.m; X[19 * 64 + lane2] = lw;
#pragma unroll
        for (int dt = 0; dt < 4; ++dt)
#pragma unroll
            for (int e = 0; e < 4; ++e) { X[(2 + 4 * dt + e) * 64 + lane2] = st.O[dt][e]; X[(20 + 4 * dt + e) * 64 + lane2] = sw.O[dt][e]; }
    }
    __syncthreads();
    if (q4 == 0) {
#pragma unroll
        for (int br = 0; br < 2; ++br) {
            float m[4], l[4];
#pragma unroll
            for (int q = 0; q < 4; ++q) { const LAS float* Y = (const LAS float*)(F.lds + (2 * q + g) * 18432) + br * 18 * 64; m[q] = Y[lane2]; l[q] = Y[64 + lane2]; }
            const float mm = fmaxf(fmaxf(m[0], m[1]), fmaxf(m[2], m[3]));
            float w[4], lt = 0.f;
#pragma unroll
            for (int q = 0; q < 4; ++q) { w[q] = __builtin_amdgcn_exp2f((m[q] - mm) * SM_C); lt += l[q] * w[q]; }
            const float gate = br == 0 ? gs : gw;
            const float sc = lt > 0.f ? gate / lt : 0.f;
#pragma unroll
            for (int q = 0; q < 4; ++q) { const LAS float* Y = (const LAS float*)(F.lds + (2 * q + g) * 18432) + br * 18 * 64; const float wq = w[q] * sc;
#pragma unroll
                for (int dt = 0; dt < 4; ++dt)
#pragma unroll
                    for (int e = 0; e < 4; ++e) Of[dt][e] += Y[(2 + 4 * dt + e) * 64 + lane2] * wq; }
        }
        bf16* MIX = (bf16*)(ws + WS_MIX) + row * 1536 + head * 64;
#pragma unroll
        for (int dt = 0; dt < 4; ++dt) { v2u w2; w2.x = pk2(Of[dt][0], Of[dt][1]); w2.y = pk2(Of[dt][2], Of[dt][3]); *(v2u*)(MIX + 16 * dt + 4 * quad) = w2; }
    }
    __syncthreads();
}
DI void ret_out_unit(Frame& F, int layer, int unit) {
    const int tid = F.tid, lane = F.lane, wave = F.wave, quad = lane >> 4, rl = lane & 15;
    const int b = unit >> 8, h = (unit >> 6) & 3, c = unit & 63;
    const int row0 = b * TP + 128 * c;
    unsigned char* ws = KWS();
    const bf16* Z = (const bf16*)(ws + WS_Z);
    const bf16* QR = (const bf16*)(ws + WS_QR); const bf16* KR = (const bf16*)(ws + WS_KR);
    const bf16* RST = (const bf16*)(ws + WS_RST) + (size_t)unit * 16384;
    LAS unsigned char* LQ = F.lds; LAS unsigned char* LK = F.lds + 34816; LAS unsigned char* LV = F.lds + 69632; LAS unsigned char* LS = F.lds + 104448;
    for (int it = tid; it < 2048; it += NTHREADS) {
        const int j = it >> 4, cc = it & 15;
        *(LAS v4u*)(LQ + j * 272 + cc * 16) = *(const v4u*)(QR + (size_t)(row0 + j) * 512 + h * 128 + cc * 8);
        *(LAS v4u*)(LK + j * 272 + cc * 16) = *(const v4u*)(KR + (size_t)(row0 + j) * 512 + h * 128 + cc * 8);
        *(LAS v4u*)(LS + j * 272 + cc * 16) = *(const v4u*)(RST + (size_t)j * 128 + cc * 8);
        const v4u w = *(const v4u*)(Z + (size_t)(row0 + j) * LDZ + ZC_RQKV + 1024 + h * 128 + cc * 8);
        LAS unsigned char* d = LV + (cc * 8) * 272 + j * 2;
        *(LAS bf16*)(d) = (bf16)(w.x & 0xffff); *(LAS bf16*)(d + 272) = (bf16)(w.x >> 16); *(LAS bf16*)(d + 2 * 272) = (bf16)(w.y & 0xffff); *(LAS bf16*)(d + 3 * 272) = (bf16)(w.y >> 16);
        *(LAS bf16*)(d + 4 * 272) = (bf16)(w.z & 0xffff); *(LAS bf16*)(d + 5 * 272) = (bf16)(w.z >> 16); *(LAS bf16*)(d + 6 * 272) = (bf16)(w.w & 0xffff); *(LAS bf16*)(d + 7 * 272) = (bf16)(w.w >> 16);
    }
    __syncthreads();
    const float lg = ret_lg(h);
    const int il = 16 * wave + rl;
    bf16x8 qb[4];
#pragma unroll
    for (int s = 0; s < 4; ++s) qb[s] = ld_frag_l(LQ + il * 272 + (32 * s + 8 * quad) * 2);
    f32x4 C[8];
    const float qdec = __expf((float)(il + 1) * lg);
#pragma unroll
    for (int dt = 0; dt < 8; ++dt) {
        f32x4 a = (f32x4){0.f, 0.f, 0.f, 0.f};
#pragma unroll
        for (int s = 0; s < 4; ++s) a = mfma16(ld_frag_l(LS + (16 * dt + rl) * 272 + (32 * s + 8 * quad) * 2), qb[s], a);
        C[dt] = a * qdec;
    }
    for (int s2 = 0; s2 <= (wave >> 1); ++s2) {
        f32x4 P[2];
#pragma unroll
        for (int e = 0; e < 2; ++e) {
            const int jt = 2 * s2 + e;
            f32x4 a = (f32x4){0.f, 0.f, 0.f, 0.f};
            if (jt <= wave) {
#pragma unroll
                for (int s = 0; s < 4; ++s) a = mfma16(ld_frag_l(LK + (16 * jt + rl) * 272 + (32 * s + 8 * quad) * 2), qb[s], a);
#pragma unroll
                for (int i = 0; i < 4; ++i) { const int jj = 16 * jt + 4 * quad + i; a[i] = (il >= jj) ? a[i] * __expf((float)(il - jj) * lg) : 0.f; }
            }
            P[e] = a;
        }
        const bf16x8 pb = pack_frag(P[0], P[1]);
#pragma unroll
        for (int dt = 0; dt < 8; ++dt) {
            const LAS unsigned char* vp = LV + (16 * dt + rl) * 272 + (32 * s2 + 4 * quad) * 2;
            C[dt] = mfma16(mk_frag(*(const LAS v2u*)vp, *(const LAS v2u*)(vp + 32)), pb, C[dt]);
        }
    }
    float ss = 0.f;
#pragma unroll
    for (int dt = 0; dt < 8; ++dt) ss += (C[dt][0] * C[dt][0] + C[dt][1] * C[dt][1]) + (C[dt][2] * C[dt][2] + C[dt][3] * C[dt][3]);
    ss += shx<16>(ss, lane); ss += shx<32>(ss, lane);
    const float scl = rsqrtf(ss * (1.f / 128.f) + EPS);
    const size_t row = (size_t)row0 + il;
#pragma unroll
    for (int dt = 0; dt < 8; ++dt) {
        const v2u gwd = *(const v2u*)(Z + row * LDZ + ZC_RG + h * 128 + 16 * dt + 4 * quad);
        v2u w; w.x = pk2(C[dt][0] * scl * siluf_(lo_bf(gwd.x)), C[dt][1] * scl * siluf_(hi_bf(gwd.x))); w.y = pk2(C[dt][2] * scl * siluf_(lo_bf(gwd.y)), C[dt][3] * scl * siluf_(hi_bf(gwd.y)));
        *(v2u*)((bf16*)(ws + WS_MIX) + row * 1536 + 1024 + h * 128 + 16 * dt + 4 * quad) = w;
    }
    __syncthreads();
}
DI void gdn_out_row(Frame& F, int layer, int row) {
    const int lane = F.lane;
    unsigned char* ws = KWS();
    f32x4 a, b; unpack8(*(const v4u*)((const bf16*)(ws + WS_OGDN) + (size_t)row * 512 + lane * 8), a, b);
    float ss = (a[0] * a[0] + a[1] * a[1]) + (a[2] * a[2] + a[3] * a[3]) + (b[0] * b[0] + b[1] * b[1]) + (b[2] * b[2] + b[3] * b[3]);
    ss += shx<1>(ss, lane); ss += shx<2>(ss, lane); ss += shx<4>(ss, lane); ss += shx<8>(ss, lane);
    const float scl = rsqrtf(ss * (1.f / 128.f) + EPS);
    const float* ng = KIN(18) + layer * 128 + (lane & 15) * 8;
    const f32x4 ga = *(const f32x4*)ng, gb = *(const f32x4*)(ng + 4);
    f32x4 za, zb; unpack8(*(const v4u*)((const bf16*)(ws + WS_Z) + (size_t)row * LDZ + ZC_GZ + lane * 8), za, zb);
    f32x4 ra, rb;
#pragma unroll
    for (int e = 0; e < 4; ++e) { ra[e] = a[e] * scl * ga[e] * siluf_(za[e]); rb[e] = b[e] * scl * gb[e] * siluf_(zb[e]); }
    *(v4u*)((bf16*)(ws + WS_MIX) + (size_t)row * 1536 + 512 + lane * 8) = pack8(ra, rb);
}
DI void final_row(Frame& F, int row) {
    const int lane = F.lane;
    const float* x = (const float*)(KWS() + WS_XR) + (size_t)row * DM;
    float* y = (row < MP) ? KOUT() + O_YP + (size_t)row * DM : KOUT() + O_YS + (size_t)(row - MP) * DM;
    f32x4 v[4]; float ss = 0.f;
#pragma unroll
    for (int j = 0; j < 4; ++j) { v[j] = *(const f32x4*)(x + 256 * j + lane * 4); ss += (v[j][0] * v[j][0] + v[j][1] * v[j][1]) + (v[j][2] * v[j][2] + v[j][3] * v[j][3]); }
    const float scl = rsqrtf(wave_sum(ss, lane) * (1.f / DM) + EPS);
#pragma unroll
    for (int j = 0; j < 4; ++j) *(f32x4*)(y + 256 * j + lane * 4) = v[j] * scl * *(const f32x4*)(KIN(26) + 256 * j + lane * 4);
}
template <class Epi>
DI void sgemm_tile(Frame& F, const bf16* A, int lda, const bf16* Bt, int ldb, int K, int row0, int col0, const Epi& E) {
    int lane = F.lane, wave = F.wave; asm volatile("" : "+v"(lane), "+s"(wave));
    const int tid = wave * 64 + lane, quad = lane >> 4, rl = lane & 15;
    const int kper = K >> 3, nks = kper >> 5;
    f32x4 acc[2][4];
#pragma unroll
    for (int rt = 0; rt < 2; ++rt)
#pragma unroll
        for (int ct = 0; ct < 4; ++ct) acc[rt][ct] = (f32x4){0.f, 0.f, 0.f, 0.f};
    const bf16* ap = A + (size_t)(row0 + rl) * lda + wave * kper + quad * 8;
    const bf16* bp = Bt + (size_t)(col0 + rl) * ldb + wave * kper + quad * 8;
#pragma unroll 4
    for (int ks = 0; ks < nks; ++ks) {
        bf16x8 a[2], b[4];
#pragma unroll
        for (int rt = 0; rt < 2; ++rt) a[rt] = ld_frag_g(ap + (size_t)(16 * rt) * lda + ks * 32);
#pragma unroll
        for (int ct = 0; ct < 4; ++ct) b[ct] = ld_frag_g(bp + (size_t)(16 * ct) * ldb + ks * 32);
#pragma unroll
        for (int rt = 0; rt < 2; ++rt)
#pragma unroll
            for (int ct = 0; ct < 4; ++ct) acc[rt][ct] = mfma16(a[rt], b[ct], acc[rt][ct]);
    }
    LAS float* RED = (LAS float*)F.lds;
#pragma unroll
    for (int rt = 0; rt < 2; ++rt)
#pragma unroll
        for (int ct = 0; ct < 4; ++ct)
#pragma unroll
            for (int i = 0; i < 4; ++i) RED[wave * 2176 + (16 * rt + 4 * quad + i) * 68 + 16 * ct + rl] = acc[rt][ct][i];
    __syncthreads();
    const int r = tid >> 4, c4 = (tid & 15) * 4;
    f32x4 v = *(const LAS f32x4*)(RED + r * 68 + c4);
#pragma unroll
    for (int w = 1; w < 8; ++w) v += *(const LAS f32x4*)(RED + w * 2176 + r * 68 + c4);
    E(row0 + r, col0 + c4, v, lane);
    __syncthreads();
}
struct SEpiC {
    const bf16* Z; bf16* G;
    DI void operator()(int row, int col, f32x4 v, int lane) const {
        const v2u gw = *(const v2u*)(Z + (size_t)row * LDZ + ZC_MG + col);
        v[0] *= sigmoidf_(lo_bf(gw.x)); v[1] *= sigmoidf_(hi_bf(gw.x)); v[2] *= sigmoidf_(lo_bf(gw.y)); v[3] *= sigmoidf_(hi_bf(gw.y));
        *(v2u*)(G + (size_t)row * 3072 + col) = pack4(v);
    }
};
struct SEpiCM {
    const bf16* Z; bf16* MRG; int b;
    DI void operator()(int row, int col, f32x4 v, int lane) const {
        const v2u gw = *(const v2u*)(Z + (size_t)row * LDZ + ZC_MG + b * 1024 + col);
        v[0] *= sigmoidf_(lo_bf(gw.x)); v[1] *= sigmoidf_(hi_bf(gw.x)); v[2] *= sigmoidf_(lo_bf(gw.y)); v[3] *= sigmoidf_(hi_bf(gw.y));
        bf16* o = MRG + (size_t)row * DM + col;
        if (b > 0) { const v2u pw = *(const v2u*)o; v[0] += lo_bf(pw.x); v[1] += hi_bf(pw.x); v[2] += lo_bf(pw.y); v[3] += hi_bf(pw.y); }
        *(v2u*)o = pack4(v);
    }
};
struct SEpiRes {
    float* XR; bf16* XG; const float* gvec; float* SS; float* T; int mode; const float* XRr;
    DI void operator()(int row, int col, f32x4 v, int lane) const {
        const size_t o = (size_t)row * DM + col;
        if (mode == 1) { *(v2u*)((bf16*)T + o) = pack4(v); return; }
        f32x4 x = *(const f32x4*)(XRr + o);
        if (mode == 2) { const v2u tw = *(const v2u*)((const bf16*)T + o); const f32x4 t = (f32x4){lo_bf(tw.x), hi_bf(tw.x), lo_bf(tw.y), hi_bf(tw.y)};
#pragma unroll
            for (int e = 0; e < 4; ++e) v[e] = t[e] * sigmoidf_(v[e]); }
        x += v;
        *(f32x4*)(XR + o) = x;
        if (XG) { f32x4 y = x; if (gvec) y *= *(const f32x4*)(gvec + col); *(v2u*)(XG + o) = pack4(y); }
        if (SS) { float ssq = (x[0] * x[0] + x[1] * x[1]) + (x[2] * x[2] + x[3] * x[3]);
            ssq += shx<1>(ssq, lane); ssq += shx<2>(ssq, lane); ssq += shx<4>(ssq, lane); ssq += shx<8>(ssq, lane);
            if ((lane & 15) == 0) SS[(size_t)row * 16 + (col >> 6)] = ssq; }
    }
};
struct SEpiUp {
    bf16* H; const float* SS;
    DI void operator()(int row, int col, f32x4 v, int lane) const {
        const f32x4 p0 = *(const f32x4*)(SS + (size_t)row * 16), p1 = *(const f32x4*)(SS + (size_t)row * 16 + 4), p2 = *(const f32x4*)(SS + (size_t)row * 16 + 8), p3 = *(const f32x4*)(SS + (size_t)row * 16 + 12);
        const f32x4 ps = (p0 + p1) + (p2 + p3);
        const float rstd = rsqrtf(((ps[0] + ps[1]) + (ps[2] + ps[3])) * (1.f / DM) + EPS);
#pragma unroll
        for (int e = 0; e < 4; ++e) { const float a = fmaxf(v[e] * rstd, 0.f); v[e] = a * a; }
        *(v2u*)(H + (size_t)row * DFF + col) = pack4(v);
    }
};
#ifndef PH_P0
#define PH_P0 1
#endif
#ifndef PH_A
#define PH_A 1
#endif
#ifndef PH_B0a
#define PH_B0a 1
#endif
#ifndef PH_B0b
#define PH_B0b 1
#endif
#ifndef PH_B0c
#define PH_B0c 1
#endif
#ifndef PH_B0d
#define PH_B0d 1
#endif
#ifndef PH_SCAN
#define PH_SCAN 1
#endif
#ifndef PH_RSCAN
#define PH_RSCAN 1
#endif
#ifndef PH_NSAP
#define PH_NSAP 1
#endif
#ifndef PH_NSAS
#define PH_NSAS 1
#endif
#ifndef PH_B2
#define PH_B2 1
#endif
#ifndef PH_C
#define PH_C 1
#endif
#ifndef PH_XBAR
#define PH_XBAR 0
#endif
#ifndef PH_D
#define PH_D 1
#endif
#ifndef PH_E
#define PH_E 1
#endif
#ifndef PH_F
#define PH_F 1
#endif
#ifndef PH_G1
#define PH_G1 1
#endif
#ifndef PH_G2
#define PH_G2 1
#endif
#ifndef PH_TREG
#define PH_TREG (-1)
#endif
#if PH_TREG >= 0
#define TREG_MARK(r) do { const unsigned long long now_ = __builtin_amdgcn_s_memrealtime(); if ((r) == PH_TREG) tacc_ += now_ - tlast_; tlast_ = now_; } while (0)
#define TREG_SUB(r) do { const unsigned long long now_ = __builtin_amdgcn_s_memrealtime(); if ((r) == PH_TREG) tacc_ += now_ - tsub_; tsub_ = now_; } while (0)
#else
#define TREG_MARK(r) do { } while (0)
#define TREG_SUB(r) do { } while (0)
#endif
struct Args { const void* in[27]; float* out; unsigned char* ws; };
__global__ void __launch_bounds__(NTHREADS, 2) mk_fwd(Args args) {
    extern __shared__ __attribute__((aligned(16))) unsigned char lds_raw[];
    Frame F;
    F.lds = (LAS unsigned char*)lds_raw;
    F.wave = __builtin_amdgcn_readfirstlane((int)threadIdx.x >> 6); F.lane = 0; F.tid = 0;
    F.G = gridDim.x; F.bid = blockIdx.x;
    F.ctl = (gu32*)(KWS() + WS_CTL);
    { const Frame Fp = fresh(F); for (int u = Fp.tid; u < (LDS_BYTES - LDSCTL_OFF) / 4; u += NTHREADS) ((LAS unsigned*)(F.lds + LDSCTL_OFF))[u] = 0u;
      __syncthreads();
      (void)xcd_barrier_post((unsigned*)(F.ctl + CW_BAR), (volatile LAS unsigned*)(F.lds + MISC_OFF) + 8, Fp.tid == 0); }
    const int G = F.G, bid = F.bid;
#if PH_TREG >= 0
    unsigned long long tacc_ = 0ull, tlast_ = __builtin_amdgcn_s_memrealtime(), tsub_ = tlast_;
#endif

        for (int rp_ = 0; rp_ < PH_P0; ++rp_) {
    { Frame Fp = fresh(F); p0_prologue(Fp); }
        }
    GRID_BAR();
    TREG_MARK(0);

    for (int layer = 0; layer < NLAYER; ++layer) {
        for (int rp_ = 0; rp_ < PH_A; ++rp_) {
        {
            const Frame Fg = fresh(F); const int G = Fg.G, bid = Fg.bid;
            unsigned char* ws = KWS();
            pg8::Gemm g{(const bf16*)(ws + WS_XGA), (const bf16*)(ws + WS_WIN + layer * SZ_WIN), MROWS, LDZ, DM, DM, DM, 31, 0};
            pg8::StaticOrder S; S.init(MROWS, LDZ, G, bid);
            epi::EpiA E{(bf16*)(ws + WS_Z), (float*)(ws + WS_ZS), (const float*)(ws + WS_SSA), KOUT(), layer};
            pg8::gemm_phase<epi::EpiA, pg8::StaticOrder, true, true>(Fg.lds, g, S, E, Fg.tid);
        }
        }
        GRID_BAR();
    TREG_MARK(1);
#if PH_TREG >= 0
        tsub_ = __builtin_amdgcn_s_memrealtime();
#endif
        {
            Frame Fp = fresh(F);
            gu32* qhead = F.ctl + CW_QUEUE + 512 * layer + 384;
            volatile LAS int* qslot = (volatile LAS int*)(F.lds + MISC_OFF) + 16;
            constexpr int NI = 5 * 272 * PH_B0d, N2 = 1024 * PH_B0c, N3 = 512 * PH_B0b;
            for (;;) {
                if (Fp.tid == 0) qslot[0] = (int)__hip_atomic_fetch_add(qhead, 1u, __ATOMIC_RELAXED, __HIP_MEMORY_SCOPE_AGENT);
                __syncthreads();
                int it = qslot[0];
                __syncthreads();
                it = __builtin_amdgcn_readfirstlane(it);
                if (it >= NI + N2 + N3) break;
                TREG_SUB(99);
                if (it < NI) { const int k = it / 5, r = it % 5;
                    if (r == 0) compress_job(Fp, layer, k % 272);
                    else if (k < 256 * PH_B0a) gdn_prep_unit(Fp, layer, (4 * k + r - 1) & 1023); }
                else { const int q = it - NI, g3 = q / 3, r3 = q % 3;
                    if (r3 < 2) sample_rec_unit(Fp, layer, (2 * g3 + r3) & 1023); else ret_prep_unit(Fp, layer, g3 & 511); }
                TREG_SUB(it < NI ? ((it % 5) == 0 ? 40 : 41) : (it < NI + N2 ? 42 : 43));
            }
        }
        GRID_BAR();
    TREG_MARK(2);
        {
            Frame Fp = fresh(F);
            gu32* qbase = F.ctl + CW_QUEUE + 512 * layer;
            volatile LAS int* qslot = (volatile LAS int*)(F.lds + MISC_OFF) + 16;
            constexpr int NQ = 8 * PH_SCAN, NS = 128 * PH_NSAS, NR = 32 * PH_RSCAN, NP = 256 * PH_NSAP;
            const int pref = (int)(xb_xcc_id() & 3u);
            for (;;) {
                if (Fp.tid == 0) qslot[1] = (int)__hip_atomic_fetch_add(qbase, 1u, __ATOMIC_RELAXED, __HIP_MEMORY_SCOPE_AGENT);
                __syncthreads();
                int it = qslot[1];
                __syncthreads();
                it = __builtin_amdgcn_readfirstlane(it);
                if (it >= NQ + NR) break;
                TREG_SUB(99);
                if (it < NQ) gdn_scan_chain(Fp, layer, it & 7);
                else ret_scan_part(Fp, layer, (it - NQ) & 31);
                TREG_SUB(it < NQ ? 21 : 23);
            }
            const int when = Fp.bid & 3;
            bool tried = false;
            for (int nu = 0;; ++nu) {
                if (Fp.tid == 0) {
                    int kind = -1, idx = 0;
                    if (!tried && nu >= when) {
                        tried = true;
                        const int a = (int)__hip_atomic_fetch_add(qbase + 320, 1u, __ATOMIC_RELAXED, __HIP_MEMORY_SCOPE_AGENT);
                        if (a < NS) { kind = 4; idx = a; }
                    }
                    if (kind < 0) {
                        for (int k = 0; k < 4 && kind < 0; ++k) { const int s = (pref + k) & 3;
                            if ((int)__hip_atomic_load(qbase + 64 * (1 + s), __ATOMIC_RELAXED, __HIP_MEMORY_SCOPE_AGENT) < NP) {
                                const int r = (int)__hip_atomic_fetch_add(qbase + 64 * (1 + s), 1u, __ATOMIC_RELAXED, __HIP_MEMORY_SCOPE_AGENT);
                                if (r < NP) { kind = s; idx = r; } } }
                    }
                    if (kind < 0) {
                        const int a = (int)__hip_atomic_fetch_add(qbase + 320, 1u, __ATOMIC_RELAXED, __HIP_MEMORY_SCOPE_AGENT);
                        if (a < NS) { kind = 4; idx = a; }
                    }
                    qslot[0] = kind; qslot[1] = idx;
                }
                __syncthreads();
                int kind = qslot[0], it = qslot[1];
                __syncthreads();
                kind = __builtin_amdgcn_readfirstlane(kind); it = __builtin_amdgcn_readfirstlane(it);
                if (kind < 0) break;
                TREG_SUB(99);
                if (kind < 4) nsa_prompt_unit(Fp, layer, (kind << 8) | (255 - (it & 255)));
                else nsa_sample_unit(Fp, layer, it & 127);
                TREG_SUB(kind < 4 ? 20 : 22);
            }
        }
        GRID_BAR();
    TREG_MARK(3);
        for (int rp_ = 0; rp_ < PH_B2; ++rp_) {
        { Frame Fp = fresh(F); for (int u = Fp.bid; u < 512; u += Fp.G) ret_out_unit(Fp, layer, u); }
        { Frame Fp = fresh(F); for (int r = Fp.bid * NWAVES + Fp.wave; r < MROWS; r += Fp.G * NWAVES) gdn_out_row(Fp, layer, r); }
        }
        GRID_BAR();
    TREG_MARK(4);
        for (int rp_ = 0; rp_ < PH_C; ++rp_) {
        {
            const Frame Fg = fresh(F); const int G = Fg.G, bid = Fg.bid;
            unsigned char* ws = KWS();
            pg8::Gemm g{(const bf16*)(ws + WS_MIX), (const bf16*)(ws + WS_WBR + layer * SZ_WBR), MP, 3072, 512, 1536, 512, 2, 1024};
            pg8::BranchOrder S; S.init(MP, G, bid);
            epi::EpiCM E{(const bf16*)(ws + WS_Z), (bf16*)(ws + WS_MRG), (float*)(ws + WS_PART)};
            pg8::gemm_phase<epi::EpiCM, pg8::BranchOrder, true, true>(Fg.lds, g, S, E, Fg.tid);
            TREG_SUB(99);
            {
                Frame Fs = fresh(F);
                for (int tl = Fs.bid; tl < 256; tl += Fs.G) { const int rt = tl & 15, ct = tl >> 4;
#pragma unroll 1
                    for (int b = 0; b < 3; ++b) { const SEpiCM Es{(const bf16*)(ws + WS_Z), (bf16*)(ws + WS_MRG), b};
                        sgemm_tile(Fs, (const bf16*)(ws + WS_MIX) + b * 512, 1536, (const bf16*)(ws + WS_WBR + layer * SZ_WBR) + (size_t)b * 1024 * 512, 512, 512, MP + 32 * rt, 64 * ct, Es); } }
            }
            TREG_SUB(31);
        }
        }
        GRID_BAR();
    TREG_MARK(5);
        for (int rp_ = 0; rp_ < PH_D; ++rp_) {
        {
            const Frame Fg = fresh(F); const int G = Fg.G, bid = Fg.bid;
            unsigned char* ws = KWS();
            pg8::Gemm g{(const bf16*)(ws + WS_MRG), (const bf16*)(ws + WS_WO3 + layer * SZ_WO3), MP, DM, DM, DM, 3072, 31, 0};
            pg8::StaticOrder S; S.init(MP, DM, G, bid);
            epi::EpiRes E{(float*)(ws + WS_XR), (bf16*)(ws + WS_XGB), KIN(21) + layer * DM, (float*)(ws + WS_SSB), nullptr, (rp_ + 1 < PH_D) ? 3 : 0, layer == 0 ? KIN(0) : (const float*)(ws + WS_XR)};
            pg8::gemm_phase<epi::EpiRes, pg8::StaticOrder, true, true>(Fg.lds, g, S, E, Fg.tid);
            TREG_SUB(99);
            if (rp_ + 1 == PH_D) {
                Frame Fs = fresh(F); const SEpiRes Es{(float*)(ws + WS_XR), (bf16*)(ws + WS_XGB), KIN(21) + layer * DM, (float*)(ws + WS_SSB), nullptr, 0, layer == 0 ? KIN(1) - (size_t)MP * DM : (const float*)(ws + WS_XR)};
                for (int tl = Fs.bid; tl < 256; tl += Fs.G) sgemm_tile(Fs, (const bf16*)(ws + WS_MRG), DM, (const bf16*)(ws + WS_WO3 + layer * SZ_WO3), 3072, DM, MP + 32 * (tl & 15), 64 * (tl >> 4), Es);
            }
            TREG_SUB(32);
        }
        }
        GRID_BAR();
    TREG_MARK(6);
        for (int rp_ = 0; rp_ < PH_E; ++rp_) {
        {
            const Frame Fg = fresh(F); const int G = Fg.G, bid = Fg.bid;
            unsigned char* ws = KWS();
            pg8::Gemm g{(const bf16*)(ws + WS_XGB), (const bf16*)(ws + WS_WUP + layer * SZ_WUP), MP, DFF, DM, DM, DM, 31, 0};
            pg8::StaticOrder S; S.init(MP, DFF, G, bid);
            epi::EpiUp E{(bf16*)(ws + WS_HMID), (const float*)(ws + WS_SSB)};
            pg8::gemm_phase<epi::EpiUp, pg8::StaticOrder, true, true>(Fg.lds, g, S, E, Fg.tid);
            TREG_SUB(99);
            {
                Frame Fs = fresh(F); const SEpiUp Es{(bf16*)(ws + WS_HMID), (const float*)(ws + WS_SSB)};
                for (int tl = Fs.bid; tl < 16 * 64; tl += Fs.G) sgemm_tile(Fs, (const bf16*)(ws + WS_XGB), DM, (const bf16*)(ws + WS_WUP + layer * SZ_WUP), DM, DM, MP + 32 * (tl & 15), 64 * (tl >> 4), Es);
            }
            TREG_SUB(33);
        }
        }
        GRID_BAR();
    TREG_MARK(7);
        for (int rp_ = 0; rp_ < PH_F; ++rp_) {
        {
            const Frame Fg = fresh(F); const int G = Fg.G, bid = Fg.bid;
            unsigned char* ws = KWS();
            pg8::Gemm g{(const bf16*)(ws + WS_HMID), (const bf16*)(ws + WS_WDN + layer * SZ_WDN), MP, DM, DFF, DFF, DFF, 31, 0};
            pg8::StaticOrder S; S.init(MP, DM, G, bid);
            epi::EpiRes E{(float*)(ws + WS_XR), (bf16*)(ws + WS_XGC), nullptr, nullptr, nullptr, (rp_ + 1 < PH_F) ? 3 : 0, (const float*)(ws + WS_XR)};
            pg8::gemm_phase<epi::EpiRes, pg8::StaticOrder, true, true>(Fg.lds, g, S, E, Fg.tid);
            TREG_SUB(99);
            if (rp_ + 1 == PH_F) {
                Frame Fs = fresh(F); const SEpiRes Es{(float*)(ws + WS_XR), (bf16*)(ws + WS_XGC), nullptr, nullptr, nullptr, 0, (const float*)(ws + WS_XR)};
                for (int tl = Fs.bid; tl < 256; tl += Fs.G) sgemm_tile(Fs, (const bf16*)(ws + WS_HMID), DFF, (const bf16*)(ws + WS_WDN + layer * SZ_WDN), DFF, DFF, MP + 32 * (tl & 15), 64 * (tl >> 4), Es);
            }
            TREG_SUB(34);
        }
        }
        GRID_BAR();
    TREG_MARK(8);
        for (int rp_ = 0; rp_ < PH_G1; ++rp_) {
        {
            const Frame Fg = fresh(F); const int G = Fg.G, bid = Fg.bid;
            unsigned char* ws = KWS();
            int kple = PLE; asm volatile("" : "+s"(kple));
            pg8::Gemm g{(const bf16*)(ws + WS_P16) + (size_t)layer * MROWS * PLE, (const bf16*)(ws + WS_WPL + layer * SZ_WPL), MP, DM, kple, PLE, PLE, 31, 0};
            pg8::StaticOrder S; S.init(MP, DM, G, bid);
            epi::EpiRes E{nullptr, nullptr, nullptr, nullptr, (float*)(ws + WS_TPLE), 1, nullptr};
            pg8::gemm_phase<epi::EpiRes, pg8::StaticOrder, true, true>(Fg.lds, g, S, E, Fg.tid);
            TREG_SUB(99);
            {
                Frame Fs = fresh(F); const SEpiRes Es{nullptr, nullptr, nullptr, nullptr, (float*)(ws + WS_TPLE), 1, nullptr};
                for (int tl = Fs.bid; tl < 256; tl += Fs.G) sgemm_tile(Fs, (const bf16*)(ws + WS_P16) + (size_t)layer * MROWS * PLE, PLE, (const bf16*)(ws + WS_WPL + layer * SZ_WPL), PLE, PLE, MP + 32 * (tl & 15), 64 * (tl >> 4), Es);
            }
            TREG_SUB(35);
        }
        }
        for (int rp_ = 0; rp_ < PH_G2; ++rp_) {
        {
            const Frame Fg = fresh(F); const int G = Fg.G, bid = Fg.bid;
            unsigned char* ws = KWS();
            const bool more = layer + 1 < NLAYER;
            pg8::Gemm g{(const bf16*)(ws + WS_XGC), (const bf16*)(ws + WS_WPG + layer * SZ_WPG), MP, DM, DM, DM, DM, 31, 0};
            pg8::StaticOrder S; S.init(MP, DM, G, bid);
            epi::EpiRes E{(float*)(ws + WS_XR), more ? (bf16*)(ws + WS_XGA) : nullptr, more ? KIN(10) + (layer + 1) * DM : nullptr, more ? (float*)(ws + WS_SSA) : nullptr, (float*)(ws + WS_TPLE), (rp_ + 1 < PH_G2) ? 3 : 2, (const float*)(ws + WS_XR)};
            pg8::gemm_phase<epi::EpiRes, pg8::StaticOrder, true, true>(Fg.lds, g, S, E, Fg.tid);
            TREG_SUB(99);
            if (rp_ + 1 == PH_G2) {
                Frame Fs = fresh(F); const SEpiRes Es{(float*)(ws + WS_XR), more ? (bf16*)(ws + WS_XGA) : nullptr, more ? KIN(10) + (layer + 1) * DM : nullptr, more ? (float*)(ws + WS_SSA) : nullptr, (float*)(ws + WS_TPLE), 2, (const float*)(ws + WS_XR)};
                for (int tl = Fs.bid; tl < 256; tl += Fs.G) sgemm_tile(Fs, (const bf16*)(ws + WS_XGC), DM, (const bf16*)(ws + WS_WPG + layer * SZ_WPG), DM, DM, MP + 32 * (tl & 15), 64 * (tl >> 4), Es);
            }
            TREG_SUB(36);
        }
        }
        GRID_BAR();
    TREG_MARK(9);
    }
    for (int xb_ = 0; xb_ < PH_XBAR; ++xb_) GRID_BAR();
    { Frame Fp = fresh(F); for (int r = Fp.bid * NWAVES + Fp.wave; r < MROWS; r += Fp.G * NWAVES) final_row(Fp, r); }
    TREG_MARK(10);
#if PH_TREG >= 0
#if defined(PH_GPT) && PH_GPT >= 0
    tacc_ += *(volatile LAS unsigned long long*)(F.lds + LDSCTL_OFF + 448);
#endif
#if defined(PH_NPT) && PH_NPT >= 0
    tacc_ += *(volatile LAS unsigned long long*)(F.lds + LDSCTL_OFF + 464);
#endif
      { const unsigned long long tend_ = __builtin_amdgcn_s_memrealtime() + tacc_; while (__builtin_amdgcn_s_memrealtime() < tend_) __builtin_amdgcn_s_sleep(8); }
#endif
}

extern "C" void kernel_launch(void* const* d_in, const int* in_sizes, int n_in, void* d_out, int out_size, void* d_ws, size_t ws_size, hipStream_t stream) {
    static int grid = 0;
    if (grid == 0) {
        if (n_in != 27 || ws_size < WS_END) { fprintf(stderr, "kernel_launch: unexpected shapes (n_in %d out %d ws %zu, need %zu)\n", n_in, out_size, ws_size, (size_t)WS_END); grid = -1; return; }
        int dev = 0, cus = 0;
        if (hipGetDevice(&dev) != hipSuccess || hipDeviceGetAttribute(&cus, hipDeviceAttributeMultiprocessorCount, dev) != hipSuccess) { grid = -1; return; }
        if (hipFuncSetAttribute((const void*)mk_fwd, hipFuncAttributeMaxDynamicSharedMemorySize, LDS_BYTES) != hipSuccess) { fprintf(stderr, "kernel_launch: hipFuncSetAttribute failed\n"); grid = -1; return; }
        int per_cu = 0;
        if (hipOccupancyMaxActiveBlocksPerMultiprocessor(&per_cu, (const void*)mk_fwd, NTHREADS, LDS_BYTES) != hipSuccess || per_cu < 1) fprintf(stderr, "kernel_launch: occupancy query reports %d\n", per_cu);
        (void)hipGetLastError();
        grid = cus;
    }
    if (grid < 0) return;
    if (hipMemsetAsync((char*)d_ws + WS_CTL, 0, CTL_ZERO_BYTES, stream) != hipSuccess) return;
    Args a{};
    for (int i = 0; i < 27; ++i) a.in[i] = d_in[i];
    a.out = (float*)d_out; a.ws = (unsigned char*)d_ws;
    hipLaunchKernelGGL(mk_fwd, dim3(grid), dim3(NTHREADS), LDS_BYTES, stream, a);
}
```
